# Optimizing an MI355X kernel written in HIP

```python
import jax
import jax.numpy as jnp
from jax import lax
import numpy as np

D_MODEL = 1024
BATCH = 2
SEQ = 8192
DEPTH = 2

CTX_LEN = 256
GRID_W = 64
HEAD_DIM = 64
FOURIER_W = 256
FOURIER_GROUPS = 4
ATTN_HEADS = 6
ATTN_KV_HEADS = 2
ATTN_GROUP = ATTN_HEADS // ATTN_KV_HEADS
ATTN_W = ATTN_HEADS * HEAD_DIM
KV_W = ATTN_KV_HEADS * HEAD_DIM
RWKV_HEADS = 6
RWKV_W = RWKV_HEADS * HEAD_DIM
MIX_W = FOURIER_W + ATTN_W + RWKV_W
WINDOW = 128
BLOCK = 128
ROPE_BASE = 10000.0
DECAY_LORA = 64
ICLR_LORA = 64
GATE_LORA = 128
CONV_W = 3
FFN_DIM = 2752
N_MOD = 9
NORM_EPS = 1e-6
GN_EPS = 64e-5
IN_WIDTHS = (FOURIER_W, ATTN_W, KV_W, KV_W, RWKV_W, RWKV_W, RWKV_W, DECAY_LORA, DECAY_LORA, ICLR_LORA, ICLR_LORA, GATE_LORA)
IN_W = FOURIER_W + ATTN_W + 2 * KV_W + 3 * RWKV_W + 2 * DECAY_LORA + 2 * ICLR_LORA + GATE_LORA

kernel_name = 'hybrid_fourier_swa_rwkv7_prefix_dit'


def rms_norm(x, g):
    xf = x.astype(jnp.float32)
    y = xf * lax.rsqrt(jnp.mean(xf * xf, axis=-1, keepdims=True) + NORM_EPS)
    return (y * g.astype(jnp.float32)).astype(x.dtype)


def ada_mod(cond, w, b):
    m = jax.nn.silu(cond) @ w + b
    return m.reshape(cond.shape[:-1] + (N_MOD, D_MODEL))


def swiglu(h, wi, wo):
    gate, up = jnp.split(h @ wi, 2, axis=-1)
    return (jax.nn.silu(gate) * up) @ wo


def ffn_half(x, m, g_pre, g_post, wi, wo):
    h = rms_norm(x, g_pre) * (1.0 + m[:, 1][:, None]) + m[:, 0][:, None]
    return x + 0.5 * m[:, 2][:, None] * rms_norm(swiglu(h, wi, wo), g_post)


def split_cols(z):
    parts = []
    off = 0
    for w in IN_WIDTHS:
        parts.append(z[..., off:off + w])
        off += w
    return parts


def axial_rope(n_tokens):
    rows_n = n_tokens // GRID_W
    row = jnp.repeat(jnp.arange(rows_n), GRID_W).astype(jnp.float32)
    col = jnp.tile(jnp.arange(GRID_W), rows_n).astype(jnp.float32)
    n_freq = HEAD_DIM // 4
    inv = ROPE_BASE ** (-jnp.arange(n_freq, dtype=jnp.float32) / n_freq)
    ang = jnp.concatenate([row[:, None] * inv, col[:, None] * inv], axis=-1)
    return jnp.cos(ang), jnp.sin(ang)


def apply_rope(x, cos, sin):
    xf = x.astype(jnp.float32)
    half = HEAD_DIM // 2
    x1, x2 = xf[..., :half], xf[..., half:]
    c = cos[None, :, None, :]
    s = sin[None, :, None, :]
    return jnp.concatenate([x1 * c - x2 * s, x2 * c + x1 * s], axis=-1).astype(x.dtype)


def fourier_mix(z):
    b, n = z.shape[:2]
    zf = z.astype(jnp.float32).reshape(b, n, FOURIER_GROUPS, FOURIER_W // FOURIER_GROUPS)
    y = jnp.fft.fft2(zf, axes=(1, 3), norm='ortho').real
    return y.reshape(b, n, FOURIER_W).astype(z.dtype)


def window_attention(q, k, v, kc, vc, sink):
    b, s = q.shape[:2]
    nb = s // BLOCK
    f32 = jnp.float32
    qb = q.astype(f32).reshape(b, nb, BLOCK, ATTN_KV_HEADS, ATTN_GROUP, HEAD_DIM) * (HEAD_DIM ** -0.5)
    pad = ((0, 0), (BLOCK, BLOCK), (0, 0), (0, 0))
    kp = jnp.pad(k.astype(f32), pad).reshape(b, nb + 2, BLOCK, ATTN_KV_HEADS, HEAD_DIM)
    vp = jnp.pad(v.astype(f32), pad).reshape(b, nb + 2, BLOCK, ATTN_KV_HEADS, HEAD_DIM)
    kw = jnp.concatenate([kp[:, :-2], kp[:, 1:-1], kp[:, 2:]], axis=2)
    vw = jnp.concatenate([vp[:, :-2], vp[:, 1:-1], vp[:, 2:]], axis=2)
    s_w = jnp.einsum('bnqhgd,bnkhd->bnhgqk', qb, kw)
    s_c = jnp.einsum('bnqhgd,bchd->bnhgqc', qb, kc.astype(f32))
    qpos = jnp.arange(BLOCK)[:, None]
    kpos = jnp.arange(3 * BLOCK)[None, :] - BLOCK
    abs_k = jnp.arange(nb)[:, None, None] * BLOCK + kpos[None]
    valid = (jnp.abs(kpos - qpos) <= WINDOW)[None] & (abs_k >= 0) & (abs_k < s)
    s_w = jnp.where(valid[None, :, None, None], s_w, -jnp.inf)
    sk = sink.astype(f32).reshape(ATTN_KV_HEADS, ATTN_GROUP)[None, None, :, :, None]
    m = jnp.maximum(jnp.maximum(s_w.max(-1), s_c.max(-1)), sk)
    e_w = jnp.exp(s_w - m[..., None])
    e_c = jnp.exp(s_c - m[..., None])
    den = e_w.sum(-1) + e_c.sum(-1) + jnp.exp(sk - m)
    o = jnp.einsum('bnhgqk,bnkhd->bnqhgd', e_w, vw) + jnp.einsum('bnhgqc,bchd->bnqhgd', e_c, vc.astype(f32))
    o = o / jnp.moveaxis(den, -1, 2)[..., None]
    return o.reshape(b, s, ATTN_W).astype(q.dtype)


def context_attention(qc, kc, vc, sink):
    b, n = qc.shape[:2]
    f32 = jnp.float32
    q = qc.astype(f32).reshape(b, n, ATTN_KV_HEADS, ATTN_GROUP, HEAD_DIM) * (HEAD_DIM ** -0.5)
    s = jnp.einsum('bqhgd,bkhd->bhgqk', q, kc.astype(f32))
    sk = sink.astype(f32).reshape(ATTN_KV_HEADS, ATTN_GROUP)[None, :, :, None]
    m = jnp.maximum(s.max(-1), sk)
    e = jnp.exp(s - m[..., None])
    den = e.sum(-1) + jnp.exp(sk - m)
    o = jnp.einsum('bhgqk,bkhd->bqhgd', e, vc.astype(f32)) / jnp.moveaxis(den, -1, 1)[..., None]
    return o.reshape(b, n, ATTN_W).astype(qc.dtype)


def short_conv(x, w):
    n = x.shape[1]
    half = CONV_W // 2
    xp = jnp.pad(x, ((0, 0), (half, half), (0, 0)))
    y = xp[:, 0:n] * w[0]
    for j in range(1, CONV_W):
        y = y + xp[:, j:j + n] * w[j]
    return y


def wkv_step(state, inp):
    r, w, k, v, a, b = inp
    sa = jnp.einsum('zbhij,zbhj->zbhi', state, a)
    state = state * w[..., None, :] + sa[..., None] * b[..., None, :] + v[..., None] * k[..., None, :]
    y = jnp.einsum('zbhij,zbhj->zbhi', state, r)
    return state, y


def rwkv_scan(r, k, v, zw, za, state0, conv_w, w0, w2, a0, a2, k_k, k_a):
    b, n = r.shape[:2]
    f32 = jnp.float32
    rkv = short_conv(jnp.concatenate([r, k, v], axis=-1), conv_w).astype(f32)
    r, k, v = jnp.split(rkv, 3, axis=-1)
    w = -jax.nn.softplus(-(w0.astype(f32)[:, None, None, :] + jnp.einsum('zbnr,zrc->zbnc', jnp.tanh(zw.astype(f32)), w2.astype(f32)))) - 0.5
    decay = jnp.exp(-jnp.exp(w))
    a = jax.nn.sigmoid(a0.astype(f32)[:, None, None, :] + jnp.einsum('zbnr,zrc->zbnc', za.astype(f32), a2.astype(f32)))
    kk = (k * k_k.astype(f32)).reshape(b, n, RWKV_HEADS, HEAD_DIM)
    kk = (kk * lax.rsqrt(jnp.maximum(jnp.sum(kk * kk, -1, keepdims=True), 1e-24))).reshape(b, n, RWKV_W)
    k_dir = k * (1.0 + (a - 1.0) * k_a.astype(f32))
    seqs = [jnp.broadcast_to(r, a.shape), decay, k_dir, jnp.broadcast_to(v, a.shape), jnp.broadcast_to(-kk, a.shape), kk * a]

    def time_major(t):
        t = jnp.stack([t[0], jnp.flip(t[1], axis=1)])
        return jnp.moveaxis(t.reshape(2, b, n, RWKV_HEADS, HEAD_DIM), 2, 0)

    s_fin, y = lax.scan(wkv_step, state0, [time_major(t) for t in seqs])
    y = jnp.moveaxis(y, 0, 2)
    y = y[0] + jnp.flip(y[1], axis=1)
    return y.reshape(b, n, RWKV_W), s_fin, r, k, v


def rwkv_readout(y, r, k, v, zg, g2, r_k, ln_g, ln_b, out_dtype):
    b, n = y.shape[:2]
    f32 = jnp.float32
    yh = y.reshape(b, n, RWKV_HEADS, HEAD_DIM)
    mu = yh.mean(-1, keepdims=True)
    var = jnp.mean(jnp.square(yh - mu), -1, keepdims=True)
    yh = (yh - mu) * lax.rsqrt(var + GN_EPS)
    yh = yh * ln_g.astype(f32).reshape(RWKV_HEADS, HEAD_DIM) + ln_b.astype(f32).reshape(RWKV_HEADS, HEAD_DIM)
    rh = r.reshape(b, n, RWKV_HEADS, HEAD_DIM)
    kh = k.reshape(b, n, RWKV_HEADS, HEAD_DIM)
    bonus = jnp.sum(rh * kh * r_k.astype(f32), -1, keepdims=True) * v.reshape(b, n, RWKV_HEADS, HEAD_DIM)
    gate = jax.nn.sigmoid(zg.astype(f32)) @ g2.astype(f32)
    return ((yh + bonus).reshape(b, n, RWKV_W) * gate).astype(out_dtype)


def token_mixer(hl, hc, w_in, w_out, sink, conv_w, w0, w2, a0, a2, g2, k_k, k_a, r_k, ln_g, ln_b, need_ctx_out):
    b, s = hl.shape[:2]
    n_c = hc.shape[1]
    f_l, q_l, k_l, v_l, rr_l, rk_l, rv_l, wf_l, wb_l, af_l, ab_l, g_l = split_cols(hl @ w_in)
    f_c, q_c, k_c, v_c, rr_c, rk_c, rv_c, wf_c, wb_c, af_c, ab_c, g_c = split_cols(hc @ w_in)
    cos, sin = axial_rope(s)
    q = apply_rope(q_l.reshape(b, s, ATTN_HEADS, HEAD_DIM), cos, sin)
    k = apply_rope(k_l.reshape(b, s, ATTN_KV_HEADS, HEAD_DIM), cos, sin)
    v = v_l.reshape(b, s, ATTN_KV_HEADS, HEAD_DIM)
    kc = k_c.reshape(b, n_c, ATTN_KV_HEADS, HEAD_DIM)
    vc = v_c.reshape(b, n_c, ATTN_KV_HEADS, HEAD_DIM)
    attn_l = window_attention(q, k, v, kc, vc, sink)
    state0 = jnp.zeros((2, b, RWKV_HEADS, HEAD_DIM, HEAD_DIM), jnp.float32)
    y_c, state_c, r_c, k_c2, v_c2 = rwkv_scan(rr_c, rk_c, rv_c, jnp.stack([wf_c, wb_c]), jnp.stack([af_c, ab_c]), state0, conv_w, w0, w2, a0, a2, k_k, k_a)
    y_l, _, r_l, k_l2, v_l2 = rwkv_scan(rr_l, rk_l, rv_l, jnp.stack([wf_l, wb_l]), jnp.stack([af_l, ab_l]), state_c, conv_w, w0, w2, a0, a2, k_k, k_a)
    rwkv_l = rwkv_readout(y_l, r_l, k_l2, v_l2, g_l, g2, r_k, ln_g, ln_b, hl.dtype)
    out_l = jnp.concatenate([fourier_mix(f_l), attn_l, rwkv_l], axis=-1) @ w_out
    if not need_ctx_out:
        return out_l, None
    attn_c = context_attention(q_c.reshape(b, n_c, ATTN_HEADS, HEAD_DIM), kc, vc, sink)
    rwkv_c = rwkv_readout(y_c, r_c, k_c2, v_c2, g_c, g2, r_k, ln_g, ln_b, hc.dtype)
    out_c = jnp.concatenate([fourier_mix(f_c), attn_c, rwkv_c], axis=-1) @ w_out
    return out_l, out_c


def setup_inputs(seed: int = 0) -> dict:
    key = jax.random.key(seed)
    ks = jax.random.split(key, 32)
    L, D, F = DEPTH, D_MODEL, FFN_DIM
    f32 = jnp.float32

    def nrm(i, shape, scale):
        return jax.random.normal(ks[i], shape, f32) * scale

    return {
        'x': nrm(0, (BATCH, SEQ, D), 1.0),
        'c': nrm(1, (BATCH, D), 1.0),
        'ctx': nrm(2, (BATCH, CTX_LEN, D), 1.0),
        'c_ctx': nrm(3, (D,), 1.0),
        'mod_w': nrm(4, (L, D, N_MOD * D), 0.5 * D ** -0.5),
        'mod_b': nrm(5, (L, N_MOD * D), 0.02),
        'norm_g': 1.0 + nrm(6, (L, 6, D), 0.05),
        'ffn1_wi': nrm(7, (L, D, 2 * F), D ** -0.5),
        'ffn1_wo': nrm(8, (L, F, D), F ** -0.5),
        'mix_w_in': nrm(9, (L, D, IN_W), D ** -0.5),
        'mix_w_out': nrm(10, (L, MIX_W, D), MIX_W ** -0.5),
        'attn_sink': nrm(11, (L, ATTN_HEADS), 0.5),
        'rwkv_conv': nrm(12, (L, CONV_W, 3 * RWKV_W), 0.2).at[:, CONV_W // 2].add(1.0),
        'rwkv_w0': jax.random.uniform(ks[13], (L, 2, RWKV_W), f32, -6.0, 1.0),
        'rwkv_w2': nrm(14, (L, 2, DECAY_LORA, RWKV_W), 0.1),
        'rwkv_a0': nrm(15, (L, 2, RWKV_W), 0.5),
        'rwkv_a2': nrm(16, (L, 2, ICLR_LORA, RWKV_W), 0.5 * ICLR_LORA ** -0.5),
        'rwkv_g2': nrm(17, (L, GATE_LORA, RWKV_W), GATE_LORA ** -0.5),
        'rwkv_k_k': 0.85 + nrm(18, (L, RWKV_W), 0.05),
        'rwkv_k_a': 1.0 + nrm(19, (L, RWKV_W), 0.05),
        'rwkv_r_k': nrm(20, (L, RWKV_HEADS, HEAD_DIM), 0.1),
        'rwkv_ln_g': 1.0 + nrm(21, (L, RWKV_W), 0.05),
        'rwkv_ln_b': nrm(22, (L, RWKV_W), 0.02),
        'ffn2_wi': nrm(23, (L, D, 2 * F), D ** -0.5),
        'ffn2_wo': nrm(24, (L, F, D), F ** -0.5),
    }


def reference(x, c, ctx, c_ctx, mod_w, mod_b, norm_g, ffn1_wi, ffn1_wo, mix_w_in, mix_w_out, attn_sink,
              rwkv_conv, rwkv_w0, rwkv_w2, rwkv_a0, rwkv_a2, rwkv_g2, rwkv_k_k, rwkv_k_a, rwkv_r_k,
              rwkv_ln_g, rwkv_ln_b, ffn2_wi, ffn2_wo):
    xl, xc = x, ctx
    for li in range(DEPTH):
        need_ctx_out = li < DEPTH - 1
        ml = ada_mod(c, mod_w[li], mod_b[li])
        mc = ada_mod(c_ctx, mod_w[li], mod_b[li])[None]
        g = norm_g[li]
        xl = ffn_half(xl, ml[:, 0:3], g[0], g[1], ffn1_wi[li], ffn1_wo[li])
        xc = ffn_half(xc, mc[:, 0:3], g[0], g[1], ffn1_wi[li], ffn1_wo[li])
        hl = rms_norm(xl, g[2]) * (1.0 + ml[:, 4][:, None]) + ml[:, 3][:, None]
        hc = rms_norm(xc, g[2]) * (1.0 + mc[:, 4][:, None]) + mc[:, 3][:, None]
        out_l, out_c = token_mixer(hl, hc, mix_w_in[li], mix_w_out[li], attn_sink[li], rwkv_conv[li],
                                   rwkv_w0[li], rwkv_w2[li], rwkv_a0[li], rwkv_a2[li], rwkv_g2[li],
                                   rwkv_k_k[li], rwkv_k_a[li], rwkv_r_k[li], rwkv_ln_g[li], rwkv_ln_b[li],
                                   need_ctx_out)
        xl = xl + ml[:, 5][:, None] * rms_norm(out_l, g[3])
        if need_ctx_out:
            xc = xc + mc[:, 5][:, None] * rms_norm(out_c, g[3])
            xc = ffn_half(xc, mc[:, 6:9], g[4], g[5], ffn2_wi[li], ffn2_wo[li])
        xl = ffn_half(xl, ml[:, 6:9], g[4], g[5], ffn2_wi[li], ffn2_wo[li])
    return xl
```

```cpp
#include <hip/hip_runtime.h>
#include <cstdio>
#include <cstdint>

namespace pg8 {
#define PG8_LAS __attribute__((address_space(3)))
typedef unsigned short bf16_t;
typedef short bf16x8 __attribute__((ext_vector_type(8)));
typedef float f32x4 __attribute__((ext_vector_type(4)));
typedef unsigned u32x4 __attribute__((ext_vector_type(4)));
constexpr int BM = 256, BK = 64, HALF = 128, HTB = HALF * BK * 2, STAGE_BYTES = 8 * HTB, NXCD = 8, WGM = 8;

__host__ __device__ __forceinline__ int lds_byte(int r, int c) { const int st = (r >> 4) * 2 + (c >> 5), rr = r & 15, cc = c & 31, ob = rr * 64 + cc * 2; return st * 1024 + (ob ^ (((ob >> 9) & 1) << 5)); }
__host__ __device__ __forceinline__ void stage_rc(int b, int& R, int& C) { const int st = b / 1024, sb = b % 1024, swz = sb ^ (((sb >> 9) & 1) << 5); R = (st >> 1) * 16 + swz / 64; C = (st & 1) * 32 + (swz % 64) / 2; }
__host__ __device__ __forceinline__ int perm32(int rho) { const int n = rho >> 4, i = rho & 15; return 8 * (i >> 2) + 4 * n + (i & 3); }

struct Unit { int pm, pn; };
struct Gemm { const bf16_t* A; const bf16_t* Bt; int M, N, K; };

struct StaticOrder {
    int nM, nN, nwg, G, c;
    __host__ __device__ void init(int M, int N, int G_, int c_) { nM = M / BM; nN = N / BM; nwg = nM * nN; G = G_; c = c_; }
    __host__ __device__ bool next(int i, Unit& u) const {
        const long L = (long)i * G + c; if (L >= nwg) return false;
        int wgid = (int)L; { const int q = nwg / NXCD, r = nwg % NXCD, xcd = wgid % NXCD, off = wgid / NXCD; wgid = (xcd < r ? xcd * (q + 1) : r * (q + 1) + (xcd - r) * q) + off; }
        const int nig = WGM * nN, gid = wgid / nig, fm = gid * WGM, gsz = (nM - fm) < WGM ? (nM - fm) : WGM;
        u.pm = fm + ((wgid % nig) % gsz); u.pn = (wgid % nig) / gsz; return true;
    }
    __device__ __forceinline__ void a_ready(const Unit&) const {}
    __device__ __forceinline__ void done(const Unit&) const {}
};

__device__ __forceinline__ unsigned cvt_pk_bf16(float lo, float hi) { unsigned r; asm volatile("v_cvt_pk_bf16_f32 %0, %1, %2" : "=v"(r) : "v"(lo), "v"(hi)); return r; }

struct EpiBf16 {
    static constexpr bool PERM = true, AFTER_DRAIN = false;
    bf16_t* O; int ldc;
    __device__ __forceinline__ void operator()(const f32x4 (&acc)[2][2][4][2], const Unit& u, int wr, int wc, int fr, int fq) const {
        const int row0 = u.pm * BM + wr * 64 + fr; const int col0 = u.pn * BM + wc * 32 + 8 * fq;
#pragma unroll
        for (int ai = 0; ai < 2; ++ai)
#pragma unroll
            for (int m = 0; m < 4; ++m) { bf16_t* rowp = O + (size_t)(row0 + ai * HALF + m * 16) * ldc + col0;
#pragma unroll
                for (int bj = 0; bj < 2; ++bj) { const f32x4 v0 = acc[ai][bj][m][0], v1 = acc[ai][bj][m][1];
                    u32x4 w; w.x = cvt_pk_bf16(v0[0], v0[1]); w.y = cvt_pk_bf16(v0[2], v0[3]); w.z = cvt_pk_bf16(v1[0], v1[1]); w.w = cvt_pk_bf16(v1[2], v1[3]);
                    *(u32x4*)(rowp + bj * HALF) = w; } }
    }
};
struct EpiF32 {
    static constexpr bool PERM = true, AFTER_DRAIN = false;
    float* O; int ldc;
    __device__ __forceinline__ void operator()(const f32x4 (&acc)[2][2][4][2], const Unit& u, int wr, int wc, int fr, int fq) const {
        const int row0 = u.pm * BM + wr * 64 + fr; const int col0 = u.pn * BM + wc * 32 + 8 * fq;
#pragma unroll
        for (int ai = 0; ai < 2; ++ai)
#pragma unroll
            for (int m = 0; m < 4; ++m) { float* rowp = O + (size_t)(row0 + ai * HALF + m * 16) * ldc + col0;
#pragma unroll
                for (int bj = 0; bj < 2; ++bj) { *(f32x4*)(rowp + bj * HALF) = acc[ai][bj][m][0]; *(f32x4*)(rowp + bj * HALF + 4) = acc[ai][bj][m][1]; } }
    }
};
__device__ __forceinline__ float silu_f(float x) { return x * __builtin_amdgcn_rcpf(1.0f + __expf(-x)); }
struct EpiSwiglu {
    static constexpr bool PERM = true, AFTER_DRAIN = false;
    bf16_t* O; int ldc;
    __device__ __forceinline__ void operator()(const f32x4 (&acc)[2][2][4][2], const Unit& u, int wr, int wc, int fr, int fq) const {
        const int row0 = u.pm * BM + wr * 64 + fr; const int col0 = u.pn * HALF + wc * 32 + 8 * fq;
#pragma unroll
        for (int ai = 0; ai < 2; ++ai)
#pragma unroll
            for (int m = 0; m < 4; ++m) { bf16_t* rowp = O + (size_t)(row0 + ai * HALF + m * 16) * ldc + col0;
                const f32x4 g0 = acc[ai][0][m][0], g1 = acc[ai][0][m][1], u0 = acc[ai][1][m][0], u1 = acc[ai][1][m][1];
                u32x4 w; w.x = cvt_pk_bf16(silu_f(g0[0]) * u0[0], silu_f(g0[1]) * u0[1]); w.y = cvt_pk_bf16(silu_f(g0[2]) * u0[2], silu_f(g0[3]) * u0[3]);
                w.z = cvt_pk_bf16(silu_f(g1[0]) * u1[0], silu_f(g1[1]) * u1[1]); w.w = cvt_pk_bf16(silu_f(g1[2]) * u1[2], silu_f(g1[3]) * u1[3]);
                *(u32x4*)rowp = w; }
    }
};

template <class Epi, class Sched, bool ALIGN_EPI = false, bool SP2 = false>
__device__ __forceinline__ void gemm_phase(PG8_LAS unsigned char* lds, const Gemm g, const Sched& S, const Epi& E) {
    const int tid = threadIdx.x, wid = __builtin_amdgcn_readfirstlane(tid >> 6), lane = tid & 63, wr = wid >> 2, wc = wid & 3, fr = lane & 15, fq = lane >> 4;
    const int K = g.K, nt = K / BK;
    unsigned voffA[2], voffB[2];
#pragma unroll
    for (int i = 0; i < 2; ++i) { int R, C; stage_rc(tid * 16 + i * 8192, R, C); const int Rb = Epi::PERM ? ((R & ~31) + perm32(R & 31)) : R;
        voffA[i] = (unsigned)(R * K + C) * 2u; voffB[i] = (unsigned)(Rb * K + C) * 2u; }
    const size_t kstep = (size_t)(BK * 2);
    const size_t hstep = (size_t)HALF * K * 2;
    const size_t tstep = 2 * hstep;
    const unsigned ldsw = (unsigned)wid * 1024u;
    const int aoff = lds_byte(wr * 64 + fr, fq * 8), boff = lds_byte(wc * 32 + fr, fq * 8);
#define PG8_SA(b, h) (((b) * 2 + (h)) * HTB)
#define PG8_SB(b, h) ((4 + (b) * 2 + (h)) * HTB)
#define PG8_STAGE(bufoff, gbase, voff) do { _Pragma("unroll") for (int _i = 0; _i < 2; ++_i) \
        __builtin_amdgcn_global_load_lds((const unsigned*)((const char*)(gbase) + (voff)[_i]), (PG8_LAS unsigned*)(lds + (bufoff) + ldsw + _i * 8192), 16, 0, 0); } while (0)
#define PG8_LDA(dst, b, h) do { _Pragma("unroll") for (int m = 0; m < 4; ++m) _Pragma("unroll") for (int k = 0; k < 2; ++k) dst[m][k] = *(const PG8_LAS bf16x8*)(lds + PG8_SA(b, h) + aoff + m * 2048 + k * 1024); } while (0)
#define PG8_LDB(dst, b, h) do { _Pragma("unroll") for (int n = 0; n < 2; ++n) _Pragma("unroll") for (int k = 0; k < 2; ++k) dst[n][k] = *(const PG8_LAS bf16x8*)(lds + PG8_SB(b, h) + boff + n * 2048 + k * 1024); } while (0)
#define PG8_MMA(ai, bj, At, Bt) do { __builtin_amdgcn_s_setprio(1); _Pragma("unroll") for (int m = 0; m < 4; ++m) _Pragma("unroll") for (int n = 0; n < 2; ++n) _Pragma("unroll") for (int k = 0; k < 2; ++k) \
        acc[ai][bj][m][n] = __builtin_amdgcn_mfma_f32_16x16x32_bf16(Bt[n][k], At[m][k], acc[ai][bj][m][n], 0, 0, 0); __builtin_amdgcn_s_setprio(0); } while (0)
#define PG8_WAIT_V(n) asm volatile("s_waitcnt vmcnt(" #n ")" ::: "memory")
#define PG8_WAIT_L(n) asm volatile("s_waitcnt lgkmcnt(" #n ")" ::: "memory")
#define PG8_BAR __builtin_amdgcn_s_barrier()
#define PG8_SCHED __builtin_amdgcn_sched_barrier(0)
    Unit cur, nxt; int ui = 0;
    if (!S.next(0, cur)) return;
    f32x4 acc[2][2][4][2];
#pragma unroll
    for (int a = 0; a < 2; ++a)
#pragma unroll
        for (int b = 0; b < 2; ++b)
#pragma unroll
            for (int m = 0; m < 4; ++m)
#pragma unroll
                for (int n = 0; n < 2; ++n) acc[a][b][m][n] = (f32x4){0.f, 0.f, 0.f, 0.f};
    bf16x8 At[4][2], B0[2][2], B1[2][2];
    const char* cA = (const char*)g.A + (size_t)cur.pm * tstep; const char* cB = (const char*)g.Bt + (size_t)cur.pn * tstep;
    S.a_ready(cur);
    if constexpr (SP2) {
        PG8_STAGE(PG8_SB(0, 0), cB, voffB); PG8_STAGE(PG8_SB(0, 1), cB + hstep, voffB); PG8_STAGE(PG8_SA(0, 0), cA, voffA); PG8_STAGE(PG8_SA(0, 1), cA + hstep, voffA);
        if (wr == 1) PG8_BAR;
        PG8_WAIT_V(2); PG8_BAR;
        PG8_STAGE(PG8_SB(1, 0), cB + kstep, voffB); PG8_STAGE(PG8_SA(1, 0), cA + kstep, voffA); PG8_STAGE(PG8_SB(1, 1), cB + hstep + kstep, voffB);
        PG8_WAIT_V(6); PG8_BAR;
    } else {
        PG8_STAGE(PG8_SB(0, 0), cB, voffB); PG8_STAGE(PG8_SA(0, 0), cA, voffA); PG8_STAGE(PG8_SB(0, 1), cB + hstep, voffB); PG8_STAGE(PG8_SA(0, 1), cA + hstep, voffA);
        if (wr == 1) PG8_BAR;
        PG8_WAIT_V(4); PG8_BAR;
        PG8_STAGE(PG8_SB(1, 0), cB + kstep, voffB); PG8_STAGE(PG8_SA(1, 0), cA + kstep, voffA); PG8_STAGE(PG8_SB(1, 1), cB + hstep + kstep, voffB);
        PG8_WAIT_V(6); PG8_BAR;
    }
    for (;;) {
        const bool has_next = S.next(ui + 1, nxt);
        const char* nA = has_next ? (const char*)g.A + (size_t)nxt.pm * tstep : cA; const char* nB = has_next ? (const char*)g.Bt + (size_t)nxt.pn * tstep : cB;
        for (int t = 0; t < nt; t += 2) {
            const bool last = (t == nt - 2);
            const char* a1 = cA + (size_t)(t + 1) * kstep;
            const char* a2 = last ? nA : cA + (size_t)(t + 2) * kstep; const char* b2 = last ? nB : cB + (size_t)(t + 2) * kstep;
            const char* a3 = a2 + kstep; const char* b3 = b2 + kstep;
            if (last && has_next) S.a_ready(nxt);
            if constexpr (SP2) {
            PG8_LDB(B0, 0, 0); PG8_LDB(B1, 0, 1); PG8_SCHED; PG8_LDA(At, 0, 0); PG8_STAGE(PG8_SA(1, 1), a1 + hstep, voffA);
            PG8_WAIT_V(8); PG8_WAIT_L(0); PG8_BAR; PG8_MMA(0, 0, At, B0); PG8_MMA(0, 1, At, B1); PG8_BAR; PG8_SCHED;
            PG8_LDA(At, 0, 1); PG8_STAGE(PG8_SB(0, 0), b2, voffB); PG8_STAGE(PG8_SB(0, 1), b2 + hstep, voffB); PG8_STAGE(PG8_SA(0, 0), a2, voffA);
            PG8_WAIT_V(8); PG8_WAIT_L(0); PG8_BAR; PG8_MMA(1, 0, At, B0); PG8_MMA(1, 1, At, B1); PG8_BAR; PG8_SCHED;
            PG8_LDB(B0, 1, 0); PG8_LDB(B1, 1, 1); PG8_SCHED; PG8_LDA(At, 1, 0); PG8_STAGE(PG8_SA(0, 1), a2 + hstep, voffA);
            PG8_WAIT_V(8); PG8_WAIT_L(0); PG8_BAR; PG8_MMA(0, 0, At, B0); PG8_MMA(0, 1, At, B1); PG8_BAR; PG8_SCHED;
            PG8_LDA(At, 1, 1); PG8_STAGE(PG8_SB(1, 0), b3, voffB); PG8_STAGE(PG8_SB(1, 1), b3 + hstep, voffB); PG8_STAGE(PG8_SA(1, 0), a3, voffA);
            PG8_WAIT_V(8); PG8_WAIT_L(0); PG8_BAR; PG8_MMA(1, 0, At, B0); PG8_MMA(1, 1, At, B1); PG8_BAR; PG8_SCHED;
            } else {
            PG8_LDB(B0, 0, 0); PG8_SCHED; PG8_LDA(At, 0, 0); PG8_STAGE(PG8_SA(1, 1), a1 + hstep, voffA);
            PG8_WAIT_L(8); PG8_BAR; PG8_WAIT_L(0); PG8_MMA(0, 0, At, B0); PG8_BAR; PG8_SCHED;
            PG8_LDB(B1, 0, 1); PG8_STAGE(PG8_SB(0, 0), b2, voffB);
            PG8_BAR; PG8_WAIT_L(0); PG8_MMA(0, 1, At, B1); PG8_BAR;
            PG8_LDA(At, 0, 1); PG8_STAGE(PG8_SA(0, 0), a2, voffA);
            PG8_BAR; PG8_WAIT_L(0); PG8_MMA(1, 0, At, B0); PG8_BAR; PG8_SCHED;
            PG8_STAGE(PG8_SB(0, 1), b2 + hstep, voffB);
            PG8_WAIT_V(6); PG8_BAR; PG8_MMA(1, 1, At, B1); PG8_BAR;
            PG8_LDB(B0, 1, 0); PG8_SCHED; PG8_LDA(At, 1, 0); PG8_STAGE(PG8_SA(0, 1), a2 + hstep, voffA);
            PG8_WAIT_L(8); PG8_BAR; PG8_WAIT_L(0); PG8_MMA(0, 0, At, B0); PG8_BAR; PG8_SCHED;
            PG8_LDB(B1, 1, 1); PG8_STAGE(PG8_SB(1, 0), b3, voffB);
            PG8_BAR; PG8_WAIT_L(0); PG8_MMA(0, 1, At, B1); PG8_BAR;
            PG8_LDA(At, 1, 1); PG8_STAGE(PG8_SA(1, 0), a3, voffA);
            PG8_BAR; PG8_WAIT_L(0); PG8_MMA(1, 0, At, B0); PG8_BAR; PG8_SCHED;
            PG8_STAGE(PG8_SB(1, 1), b3 + hstep, voffB);
            PG8_WAIT_V(6); PG8_BAR; PG8_MMA(1, 1, At, B1); PG8_BAR;
            }
        }
        if constexpr (ALIGN_EPI) { if (wr == 0) PG8_BAR; }
        if constexpr (!Epi::AFTER_DRAIN) { E(acc, cur, wr, wc, fr, fq); S.done(cur); }
        if (!has_next) break;
#pragma unroll
        for (int a = 0; a < 2; ++a)
#pragma unroll
            for (int b = 0; b < 2; ++b)
#pragma unroll
                for (int m = 0; m < 4; ++m)
#pragma unroll
                    for (int n = 0; n < 2; ++n) acc[a][b][m][n] = (f32x4){0.f, 0.f, 0.f, 0.f};
        cur = nxt; cA = nA; cB = nB; ++ui;
        if constexpr (ALIGN_EPI) { if (wr == 1) PG8_BAR; }
    }
    PG8_WAIT_V(0);
    if constexpr (!ALIGN_EPI) { if (wr == 0) PG8_BAR; }
    PG8_BAR;
#undef PG8_SA
#undef PG8_SB
#undef PG8_STAGE
#undef PG8_LDA
#undef PG8_LDB
#undef PG8_MMA
#undef PG8_WAIT_V
#undef PG8_WAIT_L
#undef PG8_BAR
#undef PG8_SCHED
}
}

constexpr int NWAVES = 8, NTHR = 512;
constexpr int DM = 1024, SEQ = 8192, NB = 2, CTX = 256, TL = NB * SEQ, TC = NB * CTX, TT = TL + TC;
constexpr int FFN = 2752, FFNP = 2816, NWI = 5632, INW = 2432, INWP = 2560, NMOD = 9;
constexpr int ZF = 0, ZQ = 256, ZK = 640, ZV = 768, ZRR = 896, ZRK = 1280, ZRV = 1664, ZW = 2048, ZA = 2176, ZG = 2304;
constexpr int RW = 384;
constexpr float NORM_EPS = 1e-6f, GN_EPS = 64e-5f;

constexpr size_t MiB = 1u << 20;
constexpr size_t WS_CTL = 0, WS_MOD = 1 * MiB, WS_ROPE = 2 * MiB, WS_XC = 4 * MiB, WS_GC = 6 * MiB;
constexpr size_t WS_WI1 = 8 * MiB, WS_WO1 = 19 * MiB, WS_WIN = 25 * MiB, WS_WOUT = 30 * MiB, WS_WI2 = 32 * MiB, WS_WO2 = 43 * MiB;
constexpr size_t WS_H = 49 * MiB;
constexpr size_t WS_ACT = 82 * MiB;
constexpr size_t WS_O = 173 * MiB;
constexpr size_t WS_YD = WS_O, WS_QR = WS_O + 50 * MiB, WS_KR = WS_O + 62 * MiB;
constexpr size_t WS_FA = 239 * MiB;
constexpr size_t WS_END = 271 * MiB;

constexpr int LDS_BYTES = 147456;

typedef unsigned short bf16;
typedef float f32x4 __attribute__((ext_vector_type(4)));
typedef unsigned v4u __attribute__((ext_vector_type(4)));
typedef unsigned v2u __attribute__((ext_vector_type(2)));
#define LAS __attribute__((address_space(3)))
#define LDS_WAIT() asm volatile("s_waitcnt lgkmcnt(0)" ::: "memory")

__device__ __forceinline__ unsigned f2bf(float f) { unsigned u = __builtin_bit_cast(unsigned, f); return (u + 0x7fffu + ((u >> 16) & 1u)) >> 16; }
__device__ __forceinline__ unsigned pk2(float lo, float hi) { return f2bf(lo) | (f2bf(hi) << 16); }
__device__ __forceinline__ float bf2f(unsigned short u) { return __builtin_bit_cast(float, (unsigned)u << 16); }
__device__ __forceinline__ float bflo(unsigned u) { return __builtin_bit_cast(float, u << 16); }
__device__ __forceinline__ float bfhi(unsigned u) { return __builtin_bit_cast(float, u & 0xffff0000u); }
__device__ __forceinline__ float wave_sum(float v) {
#pragma unroll
    for (int o = 1; o < 64; o <<= 1) v += __shfl_xor(v, o);
    return v;
}
__device__ __forceinline__ float wave_max(float v) {
#pragma unroll
    for (int o = 1; o < 64; o <<= 1) v = fmaxf(v, __shfl_xor(v, o));
    return v;
}

struct Args { const float* in[25]; float* out; unsigned char* ws; int ph_lo, ph_hi; };

struct Frame {
    LAS unsigned char* lds;
    int tid, lane, wave, G, bid;
    float* out; unsigned char* ws;
};
enum { I_X = 0, I_C, I_CTX, I_CCTX, I_MODW, I_MODB, I_NORMG, I_F1WI, I_F1WO, I_WIN, I_WOUT, I_SINK, I_CONV, I_W0, I_W2, I_A0, I_A2, I_G2, I_KK, I_KA, I_RK, I_LNG, I_LNB, I_F2WI, I_F2WO };

__device__ __forceinline__ const float* inp(int i) {
    const __attribute__((address_space(4))) char* p = (const __attribute__((address_space(4))) char*)__builtin_amdgcn_kernarg_segment_ptr();
    asm volatile("" : "+s"(p));
    return *(const float* const __attribute__((address_space(4)))*)(p + 8 * i);
}
__device__ __forceinline__ void cvt_item(const float* W, int ldw, int k0, int sc, bool valid, bf16* WT, int Kd, int n0d, LAS float* scr, int lane) {
#pragma unroll 8
    for (int i = 0; i < 32; ++i) { const int kk = 2 * i + (lane >> 5); scr[kk * 33 + (lane & 31)] = valid ? W[(size_t)(k0 + kk) * ldw + sc + (lane & 31)] : 0.f; }
    LDS_WAIT(); asm volatile("" ::: "memory");
    const int c = lane & 7;
#pragma unroll
    for (int j = 0; j < 4; ++j) { const int n = (lane >> 3) + 8 * j; const LAS float* s = scr + (8 * c) * 33 + n;
        v4u o; o.x = pk2(s[0 * 33], s[1 * 33]); o.y = pk2(s[2 * 33], s[3 * 33]); o.z = pk2(s[4 * 33], s[5 * 33]); o.w = pk2(s[6 * 33], s[7 * 33]);
        *(v4u*)(WT + (size_t)(n0d + n) * Kd + k0 + 8 * c) = o; }
    LDS_WAIT(); asm volatile("" ::: "memory");
}
__device__ __forceinline__ void convert_weights(Frame& F, int li) {
    LAS float* scr = (LAS float*)(F.lds + F.wave * 16384);
    const int gw = F.bid * NWAVES + F.wave, NGW = F.G * NWAVES;
    constexpr int I_WI = 16 * (NWI / 32), I_WO = (FFNP / 64) * 32, I_IN = 16 * (INWP / 32), I_OUT = 16 * 32;
    constexpr int NITEMS = 2 * I_WI + 2 * I_WO + I_IN + I_OUT;
    for (int it = gw; it < NITEMS; it += NGW) {
        int r = it;
        if (r < 2 * I_WI) { const int f = r / I_WI; r -= f * I_WI; const int nblk = NWI / 32, kb = r / nblk, nb = r % nblk;
            const int n0 = 32 * nb, pn = n0 >> 8, i = n0 & 255; const int j = 128 * pn + (i & 127); const bool valid = j < FFN; const int sc = (i < 128) ? j : FFN + j;
            cvt_item((f ? inp(I_F2WI) : inp(I_F1WI)) + (size_t)li * DM * 2 * FFN, 2 * FFN, 64 * kb, sc, valid, (bf16*)(F.ws + (f ? WS_WI2 : WS_WI1)), DM, n0, scr, F.lane); continue; }
        r -= 2 * I_WI;
        if (r < 2 * I_WO) { const int f = r / I_WO; r -= f * I_WO; const int kb = r / 32, nb = r % 32; const bool valid = 64 * kb < FFN;
            cvt_item((f ? inp(I_F2WO) : inp(I_F1WO)) + (size_t)li * FFN * DM, DM, 64 * kb, 32 * nb, valid, (bf16*)(F.ws + (f ? WS_WO2 : WS_WO1)), FFNP, 32 * nb, scr, F.lane); continue; }
        r -= 2 * I_WO;
        if (r < I_IN) { const int nblk = INWP / 32, kb = r / nblk, nb = r % nblk; const bool valid = 32 * nb < INW;
            cvt_item(inp(I_WIN) + (size_t)li * DM * INW, INW, 64 * kb, 32 * nb, valid, (bf16*)(F.ws + WS_WIN), DM, 32 * nb, scr, F.lane); continue; }
        r -= I_IN;
        { const int kb = r / 32, nb = r % 32;
            cvt_item(inp(I_WOUT) + (size_t)li * DM * DM, DM, 64 * kb, 32 * nb, true, (bf16*)(F.ws + WS_WOUT), DM, 32 * nb, scr, F.lane); }
    }
}
__device__ __forceinline__ void mod_gemv(Frame& F) {
    LAS float* sc = (LAS float*)F.lds;
    LAS float* red = sc + 3 * 1024;
    __syncthreads();
    for (int i = F.tid; i < 3 * 1024; i += NTHR) { const int v = i >> 10, k = i & 1023; const float x = v < 2 ? inp(I_C)[v * 1024 + k] : inp(I_CCTX)[k]; sc[i] = x / (1.0f + __expf(-x)); }
    __syncthreads();
    float* modv = (float*)(F.ws + WS_MOD);
    for (int u = F.bid; u < 2 * 72; u += F.G) {
        const int l = u / 72, n0 = (u % 72) * 128;
        const float* w = inp(I_MODW) + (size_t)l * DM * 9216 + n0 + 2 * F.lane;
        float a0 = 0.f, a1 = 0.f, b0 = 0.f, b1 = 0.f, c0 = 0.f, c1 = 0.f;
        const int k0 = F.wave * 128;
#pragma unroll 8
        for (int k = 0; k < 128; ++k) { const float2 wv = *(const float2*)(w + (size_t)(k0 + k) * 9216); const float s0 = sc[k0 + k], s1 = sc[1024 + k0 + k], s2 = sc[2048 + k0 + k];
            a0 += s0 * wv.x; a1 += s0 * wv.y; b0 += s1 * wv.x; b1 += s1 * wv.y; c0 += s2 * wv.x; c1 += s2 * wv.y; }
        LAS float* rw = red + F.wave * 384 + 2 * F.lane;
        rw[0] = a0; rw[1] = a1; rw[128] = b0; rw[129] = b1; rw[256] = c0; rw[257] = c1;
        __syncthreads();
        if (F.tid < 384) { float s = 0.f;
#pragma unroll
            for (int w8 = 0; w8 < 8; ++w8) s += red[w8 * 384 + F.tid];
            const int v = F.tid >> 7, n = n0 + (F.tid & 127);
            modv[(size_t)(l * 3 + v) * 9216 + n] = s + inp(I_MODB)[l * 9216 + n]; }
        __syncthreads();
    }
}
__device__ __forceinline__ void rope_tables(Frame& F) {
    float* ct = (float*)(F.ws + WS_ROPE); float* st = ct + SEQ * 32;
    for (int i = F.bid * NTHR + F.tid; i < SEQ * 32; i += F.G * NTHR) {
        const int t = i >> 5, j = i & 31; const int f = j & 15;
        const float inv = exp2f(-(float)f * (13.287712379549449f / 16.0f));
        const float pos = (float)(j < 16 ? (t >> 6) : (t & 63));
        const float ang = pos * inv;
        const double a = (double)ang; const double k = __builtin_rint(a * 0.15915494309189535); const float r = (float)(a - k * 6.283185307179586);
        ct[i] = __cosf(r); st[i] = __sinf(r);
    }
}

struct EArgs { const float* xl_src; const float* xc_src; float* xl_dst; float* xc_dst; const float* o; const float* modv_g; int gidx; float gmul; const float* gpost;
               bf16* hdst; const float* modv_h; int shidx, scidx; const float* gpre; int nrows; };
__device__ __forceinline__ void e_phase(Frame& F, const EArgs& A) {
    const int gw = F.bid * NWAVES + F.wave, NGW = F.G * NWAVES;
    for (int r = gw; r < A.nrows; r += NGW) {
        const int v = r < TL ? (r >> 13) : 2;
        const float* xs = r < TL ? A.xl_src + (size_t)r * DM : A.xc_src + (size_t)(r - TL) * DM;
        f32x4 x[4];
#pragma unroll
        for (int j = 0; j < 4; ++j) x[j] = ((const f32x4*)xs)[F.lane + 64 * j];
        if (A.o) {
            const f32x4* orow = (const f32x4*)(A.o + (size_t)r * DM); f32x4 ov[4]; float ss = 0.f;
#pragma unroll
            for (int j = 0; j < 4; ++j) { ov[j] = orow[F.lane + 64 * j]; ss += (ov[j].x * ov[j].x + ov[j].y * ov[j].y) + (ov[j].z * ov[j].z + ov[j].w * ov[j].w); }
            const float rstd = 1.0f / sqrtf(wave_sum(ss) * (1.0f / DM) + NORM_EPS) * A.gmul;
            const f32x4* gm = (const f32x4*)(A.modv_g + (size_t)v * 9216 + A.gidx * DM); const f32x4* gp = (const f32x4*)A.gpost;
            float* xd = r < TL ? A.xl_dst + (size_t)r * DM : A.xc_dst + (size_t)(r - TL) * DM;
#pragma unroll
            for (int j = 0; j < 4; ++j) { const f32x4 g = gm[F.lane + 64 * j], p = gp[F.lane + 64 * j]; x[j] = x[j] + g * (ov[j] * rstd * p); ((f32x4*)xd)[F.lane + 64 * j] = x[j]; }
        }
        if (A.hdst) {
            float ss = 0.f;
#pragma unroll
            for (int j = 0; j < 4; ++j) ss += (x[j].x * x[j].x + x[j].y * x[j].y) + (x[j].z * x[j].z + x[j].w * x[j].w);
            const float rstd = 1.0f / sqrtf(wave_sum(ss) * (1.0f / DM) + NORM_EPS);
            const f32x4* sh = (const f32x4*)(A.modv_h + (size_t)v * 9216 + A.shidx * DM); const f32x4* scl = (const f32x4*)(A.modv_h + (size_t)v * 9216 + A.scidx * DM); const f32x4* gp = (const f32x4*)A.gpre;
            v2u* hd = (v2u*)(A.hdst + (size_t)r * DM);
#pragma unroll
            for (int j = 0; j < 4; ++j) { const f32x4 s = sh[F.lane + 64 * j], c = scl[F.lane + 64 * j], p = gp[F.lane + 64 * j]; const f32x4 hv = (x[j] * rstd * p) * (1.0f + c) + s;
                v2u w; w.x = pk2(hv.x, hv.y); w.y = pk2(hv.z, hv.w); hd[F.lane + 64 * j] = w; }
        }
    }
}

__device__ __forceinline__ const bf16* zrow(const Frame& F, int row) { return (const bf16*)(F.ws + WS_ACT) + (size_t)row * INWP; }

__device__ __forceinline__ void rope_unit(Frame& F, int u) {
    const float* ct = (const float*)(F.ws + WS_ROPE); const float* st = ct + SEQ * 32;
    bf16* qr = (bf16*)(F.ws + WS_QR); bf16* kr = (bf16*)(F.ws + WS_KR);
    for (int i = F.tid; i < 256 * 8 * 32; i += NTHR) {
        const int j = i & 31, hh = (i >> 5) & 7, tok = u * 256 + (i >> 8);
        const int s = tok & (SEQ - 1);
        const bf16* z = zrow(F, tok);
        const int col = hh < 6 ? ZQ + 64 * hh : ZK + 64 * (hh - 6);
        const float x1 = bf2f(z[col + j]), x2 = bf2f(z[col + 32 + j]);
        const float c = ct[s * 32 + j], sn = st[s * 32 + j];
        float o1 = x1 * c - x2 * sn, o2 = x2 * c + x1 * sn;
        if (hh < 6) { o1 *= 0.125f; o2 *= 0.125f; qr[(size_t)tok * 384 + 64 * hh + j] = (bf16)f2bf(o1); qr[(size_t)tok * 384 + 64 * hh + 32 + j] = (bf16)f2bf(o2); }
        else { kr[(size_t)tok * 128 + 64 * (hh - 6) + j] = (bf16)f2bf(o1); kr[(size_t)tok * 128 + 64 * (hh - 6) + 32 + j] = (bf16)f2bf(o2); }
    }
}

__device__ __forceinline__ void fourier_a_unit(Frame& F, int u) {
    const int b = u >> 7, n2 = u & 127;
    LAS float* tab = (LAS float*)F.lds;
    __syncthreads();
    if (F.tid < 64) { const float a = (float)F.tid * (1.0f / 64.0f); tab[F.tid] = __builtin_amdgcn_cosf(a); tab[64 + F.tid] = __builtin_amdgcn_sinf(a); }
    __syncthreads();
    const int c = F.tid & 255, kh = F.tid >> 8;
    float f[64];
#pragma unroll
    for (int n1 = 0; n1 < 64; ++n1) f[n1] = bf2f(zrow(F, b * SEQ + 128 * n1 + n2)[ZF + c]);
    float* far = (float*)(F.ws + WS_FA); float* fai = far + (size_t)NB * 64 * 128 * 256;
    for (int kk = 0; kk < 32; ++kk) { const int k1 = kh * 32 + kk;
        float sr = 0.f, si = 0.f;
#pragma unroll
        for (int n1 = 0; n1 < 64; ++n1) { const int idx = (n1 * k1) & 63; sr += f[n1] * tab[idx]; si -= f[n1] * tab[64 + idx]; }
        const float tw = (float)(n2 * k1) * (1.0f / 8192.0f); const float tc = __builtin_amdgcn_cosf(tw), ts = -__builtin_amdgcn_sinf(tw);
        const size_t o = (((size_t)b * 64 + k1) * 128 + n2) * 256 + c;
        far[o] = sr * tc - si * ts; fai[o] = sr * ts + si * tc;
    }
}
__device__ __forceinline__ void fourier_c_unit(Frame& F, int u) {
    const int b = u >> 7, k1 = (u >> 1) & 63, half = u & 1;
    LAS float* tab = (LAS float*)F.lds;
    LAS float* tab64 = tab + 256;
    LAS float* P = tab + 512;
    __syncthreads();
    if (F.tid < 128) { const float a = (float)F.tid * (1.0f / 128.0f); tab[F.tid] = __builtin_amdgcn_cosf(a); tab[128 + F.tid] = __builtin_amdgcn_sinf(a); }
    if (F.tid >= 128 && F.tid < 192) { const float a = (float)(F.tid - 128) * (1.0f / 64.0f); tab64[F.tid - 128] = __builtin_amdgcn_cosf(a); tab64[64 + F.tid - 128] = __builtin_amdgcn_sinf(a); }
    __syncthreads();
    const int c = F.tid & 255, q = F.tid >> 8;
    const float* far = (const float*)(F.ws + WS_FA) + (((size_t)b * 64 + k1) * 128) * 256 + c; const float* fai = far + (size_t)NB * 64 * 128 * 256;
    float ar[32], ai[32];
#pragma unroll
    for (int i = 0; i < 32; ++i) { ar[i] = 0.f; ai[i] = 0.f; }
    const int k2b = 64 * half + 32 * q;
    for (int n2 = 0; n2 < 128; ++n2) { const float xr = far[(size_t)n2 * 256], xi = fai[(size_t)n2 * 256];
#pragma unroll
        for (int i = 0; i < 32; ++i) { const int idx = (n2 * (k2b + i)) & 127; const float cs = tab[idx], sn = tab[128 + idx];
            ar[i] += xr * cs + xi * sn; ai[i] += xi * cs - xr * sn; } }
    bf16* mix = (bf16*)(F.ws + WS_H);
    const int g = c >> 6;
    float y[32];
#pragma unroll
    for (int i = 0; i < 32; ++i) y[i] = 0.f;
#pragma unroll
    for (int rnd = 0; rnd < 2; ++rnd) {
        __syncthreads();
#pragma unroll
        for (int i = 0; i < 32; ++i) P[(32 * q + i) * 256 + c] = rnd == 0 ? ar[i] : ai[i];
        __syncthreads();
        const int m = c & 63;
        for (int cc = 0; cc < 64; ++cc) { const int idx = (m * cc) & 63; const float t = rnd == 0 ? tab64[idx] : tab64[64 + idx];
#pragma unroll
            for (int i = 0; i < 32; ++i) y[i] += P[(32 * q + i) * 256 + 64 * g + cc] * t; }
    }
    const float scale = 0.0013810679320049757f;
#pragma unroll
    for (int i = 0; i < 32; ++i) { const int k = k1 + 64 * (k2b + i); mix[(size_t)(b * SEQ + k) * DM + c] = (bf16)f2bf(y[i] * scale); }
}
__device__ __forceinline__ void fourier_ctx1_unit(Frame& F, int u) {
    float* gr = (float*)(F.ws + WS_GC); float* gi = gr + TC * 256;
    for (int i = F.tid; i < 32 * 256; i += NTHR) { const int tok = u * 32 + (i >> 8), gm = i & 255, g = gm >> 6, m = gm & 63;
        const bf16* z = zrow(F, TL + tok) + ZF + 64 * g; float sr = 0.f, si = 0.f;
        for (int c = 0; c < 64; ++c) { const float a = (float)((m * c) & 63) * (1.0f / 64.0f); const float x = bf2f(z[c]); sr += x * __builtin_amdgcn_cosf(a); si -= x * __builtin_amdgcn_sinf(a); }
        gr[tok * 256 + gm] = sr; gi[tok * 256 + gm] = si; }
}
__device__ __forceinline__ void fourier_ctx2_unit(Frame& F, int u) {
    const float* gr = (const float*)(F.ws + WS_GC); const float* gi = gr + TC * 256; bf16* mix = (bf16*)(F.ws + WS_H);
    const int b = u >> 4, kb = (u & 15) * 16;
    for (int i = F.tid; i < 16 * 256; i += NTHR) { const int k = kb + (i >> 8), gm = i & 255; float y = 0.f;
        for (int n = 0; n < 256; ++n) { const float a = (float)((k * n) & 255) * (1.0f / 256.0f); y += gr[(b * 256 + n) * 256 + gm] * __builtin_amdgcn_cosf(a) + gi[(b * 256 + n) * 256 + gm] * __builtin_amdgcn_sinf(a); }
        mix[(size_t)(TL + b * 256 + k) * DM + gm] = (bf16)f2bf(y * 0.0078125f); }
}

__device__ __forceinline__ float dot64(const float (&q)[64], const bf16* krow) {
    float s = 0.f;
#pragma unroll
    for (int i = 0; i < 8; ++i) { const v4u w = ((const v4u*)krow)[i];
        s += q[8 * i + 0] * bflo(w.x) + q[8 * i + 1] * bfhi(w.x) + q[8 * i + 2] * bflo(w.y) + q[8 * i + 3] * bfhi(w.y) + q[8 * i + 4] * bflo(w.z) + q[8 * i + 5] * bfhi(w.z) + q[8 * i + 6] * bflo(w.w) + q[8 * i + 7] * bfhi(w.w); }
    return s;
}
__device__ __forceinline__ void attn_v1(Frame& F, int li) {
    const int gw = F.bid * NWAVES + F.wave, NGW = F.G * NWAVES;
    const bf16* qr = (const bf16*)(F.ws + WS_QR); const bf16* kr = (const bf16*)(F.ws + WS_KR); bf16* mix = (bf16*)(F.ws + WS_H);
    const float* sink = inp(I_SINK) + li * 6;
    const int npairs = (li == 0 ? TT : TL) * 6;
    for (int p = gw; p < npairs; p += NGW) {
        const int row = p / 6, hq = p % 6, kvh = hq / 3; const bool isctx = row >= TL;
        const int b = isctx ? (row - TL) >> 8 : row >> 13, s = row & (SEQ - 1);
        float q[64];
        if (!isctx) {
#pragma unroll
            for (int i = 0; i < 8; ++i) { const v4u w = ((const v4u*)(qr + (size_t)row * 384 + 64 * hq))[i];
                q[8 * i] = bflo(w.x); q[8 * i + 1] = bfhi(w.x); q[8 * i + 2] = bflo(w.y); q[8 * i + 3] = bfhi(w.y); q[8 * i + 4] = bflo(w.z); q[8 * i + 5] = bfhi(w.z); q[8 * i + 6] = bflo(w.w); q[8 * i + 7] = bfhi(w.w); }
        } else {
#pragma unroll
            for (int i = 0; i < 8; ++i) { const v4u w = ((const v4u*)(zrow(F, row) + ZQ + 64 * hq))[i];
                q[8 * i] = 0.125f * bflo(w.x); q[8 * i + 1] = 0.125f * bfhi(w.x); q[8 * i + 2] = 0.125f * bflo(w.y); q[8 * i + 3] = 0.125f * bfhi(w.y); q[8 * i + 4] = 0.125f * bflo(w.z); q[8 * i + 5] = 0.125f * bfhi(w.z); q[8 * i + 6] = 0.125f * bflo(w.w); q[8 * i + 7] = 0.125f * bfhi(w.w); }
        }
        float sc[9]; int krow_[9];
        const float NEG = -INFINITY;
        float mx = sink[hq];
#pragma unroll
        for (int r = 0; r < 9; ++r) {
            if (r < 5) {
                const int kp = s - 128 + 64 * r + F.lane; const bool ok = !isctx && kp >= 0 && kp < SEQ && kp <= s + 128;
                const int kc = ok ? kp : 0; krow_[r] = b * SEQ + kc;
                const float d = isctx ? 0.f : dot64(q, kr + (size_t)(b * SEQ + kc) * 128 + 64 * kvh);
                sc[r] = ok ? d : NEG;
            } else {
                const int kc = 64 * (r - 5) + F.lane; krow_[r] = TL + b * CTX + kc;
                sc[r] = dot64(q, zrow(F, TL + b * CTX + kc) + ZK + 64 * kvh);
            }
            mx = fmaxf(mx, sc[r]);
        }
        mx = wave_max(mx);
        float den = 0.f;
#pragma unroll
        for (int r = 0; r < 9; ++r) { sc[r] = __expf(sc[r] - mx); den += sc[r]; }
        den = wave_sum(den) + __expf(sink[hq] - mx);
        float acc = 0.f;
#pragma unroll
        for (int r = 0; r < 9; ++r) {
            if (r < 5 && isctx) continue;
            for (int kk = 0; kk < 64; ++kk) { const float pk = __builtin_bit_cast(float, __builtin_amdgcn_readlane(__builtin_bit_cast(int, sc[r]), kk)); const int kr_ = __builtin_amdgcn_readlane(krow_[r], kk);
                acc += pk * bf2f(zrow(F, kr_)[ZV + 64 * kvh + F.lane]); }
        }
        mix[(size_t)row * DM + 256 + 64 * hq + F.lane] = (bf16)f2bf(acc / den);
    }
}

__device__ __forceinline__ float softplus_f(float x) { return fmaxf(x, 0.f) + log1pf(__expf(-fabsf(x))); }
__device__ __forceinline__ void rwkv_chain_naive(Frame& F, int li, int chain) {
    const int dir = chain / 12, b = (chain / 6) & 1, h = chain % 6;
    LAS float* W2s = (LAS float*)F.lds;
    LAS float* A2s = W2s + 4096;
    LAS float* PR = A2s + 4096, *PW = PR + 4096, *PK = PW + 4096, *PV = PK + 4096, *PA = PV + 4096, *PB = PA + 4096;
    const int j = F.lane, tg = F.wave;
    const int ch = 64 * h + j;
    __syncthreads();
    { const float* w2 = inp(I_W2) + ((size_t)(li * 2 + dir) * 64) * RW + ch; const float* a2 = inp(I_A2) + ((size_t)(li * 2 + dir) * 64) * RW + ch;
#pragma unroll
      for (int i = 0; i < 8; ++i) { const int r = tg + 8 * i; W2s[r * 64 + j] = w2[(size_t)r * RW]; A2s[r * 64 + j] = a2[(size_t)r * RW]; } }
    const float w0 = inp(I_W0)[(li * 2 + dir) * RW + ch], a0 = inp(I_A0)[(li * 2 + dir) * RW + ch];
    const float kkw = inp(I_KK)[li * RW + ch], kaw = inp(I_KA)[li * RW + ch];
    float cw[3][3];
#pragma unroll
    for (int t = 0; t < 3; ++t)
#pragma unroll
        for (int q = 0; q < 3; ++q) cw[t][q] = inp(I_CONV)[(size_t)(li * 3 + t) * (3 * RW) + q * RW + ch];
    float* yd = (float*)(F.ws + WS_YD) + (size_t)dir * TT * RW;
    float st[16];
#pragma unroll
    for (int c = 0; c < 16; ++c) st[c] = 0.f;
    const int srow = 16 * (F.wave & 3) + (F.lane >> 2), sq = F.lane & 3;
    for (int bi = 0; bi < 132; ++bi) {
        const bool isctx = bi < 4; const int L = isctx ? CTX : SEQ, cb = isctx ? bi : bi - 4, rbase = isctx ? TL + b * CTX : b * SEQ;
        __syncthreads();
#pragma unroll 1
        for (int i = 0; i < 8; ++i) { const int tt = tg + 8 * i; const int s = 64 * cb + tt; const int p = dir == 0 ? s : L - 1 - s;
            float rv = 0.f, kv = 0.f, vv = 0.f;
#pragma unroll
            for (int t = 0; t < 3; ++t) { const int pp = p + t - 1; if (pp >= 0 && pp < L) { const bf16* z = zrow(F, rbase + pp); rv += cw[t][0] * bf2f(z[ZRR + ch]); kv += cw[t][1] * bf2f(z[ZRK + ch]); vv += cw[t][2] * bf2f(z[ZRV + ch]); } }
            const bf16* zt = zrow(F, rbase + p);
            const float tzw = tanhf(bf2f(zt[ZW + 64 * dir + j])), zav = bf2f(zt[ZA + 64 * dir + j]);
            float dw = w0, da = a0;
#pragma unroll
            for (int r = 0; r < 64; ++r) { dw += __builtin_bit_cast(float, __builtin_amdgcn_readlane(__builtin_bit_cast(int, tzw), r)) * W2s[r * 64 + j]; da += __builtin_bit_cast(float, __builtin_amdgcn_readlane(__builtin_bit_cast(int, zav), r)) * A2s[r * 64 + j]; }
            const float wl = -softplus_f(-dw) - 0.5f; const float decay = __expf(-__expf(wl));
            const float ai = 1.0f / (1.0f + __expf(-da));
            const float kkr = kv * kkw; const float ss = wave_sum(kkr * kkr); const float kk = kkr * (1.0f / sqrtf(fmaxf(ss, 1e-24f)));
            const float kd = kv * (1.0f + (ai - 1.0f) * kaw);
            PR[tt * 64 + j] = rv; PW[tt * 64 + j] = decay; PK[tt * 64 + j] = kd; PV[tt * 64 + j] = vv; PA[tt * 64 + j] = -kk; PB[tt * 64 + j] = kk * ai; }
        __syncthreads();
        if (F.wave < 4) {
#pragma unroll 1
            for (int t = 0; t < 64; ++t) {
                const LAS f32x4* pa = (const LAS f32x4*)(PA + t * 64 + 16 * sq); const LAS f32x4* pw = (const LAS f32x4*)(PW + t * 64 + 16 * sq); const LAS f32x4* pb = (const LAS f32x4*)(PB + t * 64 + 16 * sq);
                const LAS f32x4* pk = (const LAS f32x4*)(PK + t * 64 + 16 * sq); const LAS f32x4* pr = (const LAS f32x4*)(PR + t * 64 + 16 * sq);
                const float vi = PV[t * 64 + srow];
                float sa = 0.f;
#pragma unroll
                for (int c4 = 0; c4 < 4; ++c4) { const f32x4 a = pa[c4]; sa += st[4 * c4] * a.x + st[4 * c4 + 1] * a.y + st[4 * c4 + 2] * a.z + st[4 * c4 + 3] * a.w; }
                sa += __shfl_xor(sa, 1); sa += __shfl_xor(sa, 2);
                float y = 0.f;
#pragma unroll
                for (int c4 = 0; c4 < 4; ++c4) { const f32x4 w = pw[c4], bb = pb[c4], k = pk[c4], r = pr[c4];
                    st[4 * c4] = st[4 * c4] * w.x + sa * bb.x + vi * k.x; st[4 * c4 + 1] = st[4 * c4 + 1] * w.y + sa * bb.y + vi * k.y;
                    st[4 * c4 + 2] = st[4 * c4 + 2] * w.z + sa * bb.z + vi * k.z; st[4 * c4 + 3] = st[4 * c4 + 3] * w.w + sa * bb.w + vi * k.w;
                    y += st[4 * c4] * r.x + st[4 * c4 + 1] * r.y + st[4 * c4 + 2] * r.z + st[4 * c4 + 3] * r.w; }
                y += __shfl_xor(y, 1); y += __shfl_xor(y, 2);
                const int s = 64 * cb + t; const int p = dir == 0 ? s : L - 1 - s;
                if (sq == 0) yd[(size_t)(rbase + p) * RW + 64 * h + srow] = y;
            }
        }
    }
}
__device__ __forceinline__ void rwkv_readout_v1(Frame& F, int li) {
    const int gw = F.bid * NWAVES + F.wave;
    if (gw >= 2046) return;
    const int h = gw % 6, ch = 64 * h + F.lane;
    float g2c[128];
#pragma unroll
    for (int r = 0; r < 128; ++r) g2c[r] = inp(I_G2)[((size_t)li * 128 + r) * RW + ch];
    float cw[3][3];
#pragma unroll
    for (int t = 0; t < 3; ++t)
#pragma unroll
        for (int q = 0; q < 3; ++q) cw[t][q] = inp(I_CONV)[(size_t)(li * 3 + t) * (3 * RW) + q * RW + ch];
    const float rk = inp(I_RK)[li * RW + ch], lg = inp(I_LNG)[li * RW + ch], lb = inp(I_LNB)[li * RW + ch];
    const float* y0 = (const float*)(F.ws + WS_YD); const float* y1 = y0 + (size_t)TT * RW; bf16* mix = (bf16*)(F.ws + WS_H);
    const int nrows = li == 0 ? TT : TL;
    for (int row = gw / 6; row < nrows; row += 341) {
        const bool isctx = row >= TL; const int L = isctx ? CTX : SEQ; const int p = isctx ? (row - TL) & (CTX - 1) : row & (SEQ - 1);
        const float y = y0[(size_t)row * RW + ch] + y1[(size_t)row * RW + ch];
        const float mu = wave_sum(y) * (1.0f / 64.0f); const float d = y - mu; const float var = wave_sum(d * d) * (1.0f / 64.0f);
        const float yn = d * (1.0f / sqrtf(var + GN_EPS)) * lg + lb;
        float rv = 0.f, kv = 0.f, vv = 0.f;
#pragma unroll
        for (int t = 0; t < 3; ++t) { const int pp = p + t - 1; if (pp >= 0 && pp < L) { const bf16* z = zrow(F, row + t - 1); rv += cw[t][0] * bf2f(z[ZRR + ch]); kv += cw[t][1] * bf2f(z[ZRK + ch]); vv += cw[t][2] * bf2f(z[ZRV + ch]); } }
        const float bonus = wave_sum(rv * kv * rk) * vv;
        const bf16* z = zrow(F, row);
        const float s0 = 1.0f / (1.0f + __expf(-bf2f(z[ZG + F.lane]))), s1 = 1.0f / (1.0f + __expf(-bf2f(z[ZG + 64 + F.lane])));
        float gate = 0.f;
#pragma unroll
        for (int r = 0; r < 64; ++r) { gate += __builtin_bit_cast(float, __builtin_amdgcn_readlane(__builtin_bit_cast(int, s0), r)) * g2c[r]; gate += __builtin_bit_cast(float, __builtin_amdgcn_readlane(__builtin_bit_cast(int, s1), r)) * g2c[64 + r]; }
        mix[(size_t)row * DM + 640 + ch] = (bf16)f2bf((yn + bonus) * gate);
    }
}

template <int KIND> __device__ __forceinline__ void run_phase(Frame& F, int li, int second) {
    float* modv = (float*)(F.ws + WS_MOD);
    float* xc = (float*)(F.ws + WS_XC);
    bf16* H = (bf16*)(F.ws + WS_H); bf16* ACT = (bf16*)(F.ws + WS_ACT); float* O = (float*)(F.ws + WS_O);
    const float* ng = inp(I_NORMG) + (size_t)li * 6 * DM; const float* mv = modv + (size_t)li * 3 * 9216;
    const bool last = li == 1;
    if constexpr (KIND == 100) { convert_weights(F, 0); mod_gemv(F); rope_tables(F); }
    if constexpr (KIND == 101) { EArgs A{}; A.xl_src = inp(I_X); A.xc_src = inp(I_CTX); A.o = nullptr; A.hdst = H; A.modv_h = modv; A.shidx = 0; A.scidx = 1; A.gpre = inp(I_NORMG); A.nrows = TT; e_phase(F, A); }
    if constexpr (KIND == 0) {
        pg8::Gemm g{H, (const bf16*)(F.ws + (second ? WS_WI2 : WS_WI1)), (last && second) ? TL : TT, NWI, DM}; pg8::StaticOrder S; S.init(g.M, g.N, F.G, F.bid);
        pg8::EpiSwiglu E{ACT, FFNP}; pg8::gemm_phase<pg8::EpiSwiglu, pg8::StaticOrder, true, true>(F.lds, g, S, E); }
    if constexpr (KIND == 1) {
        pg8::Gemm g{ACT, (const bf16*)(F.ws + (second ? WS_WO2 : WS_WO1)), (last && second) ? TL : TT, DM, FFNP}; pg8::StaticOrder S; S.init(g.M, g.N, F.G, F.bid);
        pg8::EpiF32 E{O, DM}; pg8::gemm_phase<pg8::EpiF32, pg8::StaticOrder, true, true>(F.lds, g, S, E); }
    if constexpr (KIND == 2) {
        EArgs A{}; A.xl_src = li == 0 ? inp(I_X) : F.out; A.xc_src = li == 0 ? inp(I_CTX) : xc; A.xl_dst = F.out; A.xc_dst = xc; A.o = O; A.modv_g = mv; A.gidx = 2; A.gmul = 0.5f; A.gpost = ng + 1 * DM;
        A.hdst = H; A.modv_h = mv; A.shidx = 3; A.scidx = 4; A.gpre = ng + 2 * DM; A.nrows = TT; e_phase(F, A); }
    if constexpr (KIND == 3) {
        pg8::Gemm g{H, (const bf16*)(F.ws + WS_WIN), TT, INWP, DM}; pg8::StaticOrder S; S.init(g.M, g.N, F.G, F.bid);
        pg8::EpiBf16 E{ACT, INWP}; pg8::gemm_phase<pg8::EpiBf16, pg8::StaticOrder, true, true>(F.lds, g, S, E); }
    if constexpr (KIND == 4) {
        if (F.bid < 24) rwkv_chain_naive(F, li, F.bid);
        else { const int nl = 256 + 64 + (li == 0 ? 16 : 0);
            for (int u = F.bid - 24; u < nl; u += F.G - 24) { if (u < 256) fourier_a_unit(F, u); else if (u < 320) rope_unit(F, u - 256); else fourier_ctx1_unit(F, u - 320); } } }
    if constexpr (KIND == 5) {
        for (int u = F.bid; u < 256; u += F.G) fourier_c_unit(F, u);
        if (li == 0) for (int u = F.bid; u < 32; u += F.G) fourier_ctx2_unit(F, u);
        attn_v1(F, li);
        rwkv_readout_v1(F, li); }
    if constexpr (KIND == 6) {
        pg8::Gemm g{H, (const bf16*)(F.ws + WS_WOUT), last ? TL : TT, DM, DM}; pg8::StaticOrder S; S.init(g.M, g.N, F.G, F.bid);
        pg8::EpiF32 E{O, DM}; pg8::gemm_phase<pg8::EpiF32, pg8::StaticOrder, true, true>(F.lds, g, S, E); }
    if constexpr (KIND == 7) {
        EArgs A{}; A.xl_src = F.out; A.xc_src = xc; A.xl_dst = F.out; A.xc_dst = xc; A.o = O; A.modv_g = mv; A.gidx = 5; A.gmul = 1.0f; A.gpost = ng + 3 * DM;
        A.hdst = H; A.modv_h = mv; A.shidx = 6; A.scidx = 7; A.gpre = ng + 4 * DM; A.nrows = last ? TL : TT; e_phase(F, A); }
    if constexpr (KIND == 10) {
        EArgs A{}; A.xl_src = F.out; A.xc_src = xc; A.xl_dst = F.out; A.xc_dst = xc; A.o = O; A.modv_g = mv; A.gidx = 8; A.gmul = 0.5f; A.gpost = ng + 5 * DM;
        if (!last) { A.hdst = H; A.modv_h = mv + 3 * 9216; A.shidx = 0; A.scidx = 1; A.gpre = ng + 6 * DM; }
        A.nrows = last ? TL : TT; e_phase(F, A);
        if (!last) { __syncthreads(); convert_weights(F, 1); } }
}
template <int KIND> __global__ void __launch_bounds__(NTHR, 2) mega(Args args) {
    extern __shared__ __attribute__((aligned(16))) unsigned char lds[];
    Frame F; F.lds = (LAS unsigned char*)lds; F.tid = threadIdx.x; F.lane = F.tid & 63; F.wave = __builtin_amdgcn_readfirstlane(F.tid >> 6); F.G = gridDim.x; F.bid = blockIdx.x;
    F.out = args.out; F.ws = args.ws;
    run_phase<KIND>(F, args.ph_lo, args.ph_hi);
}

extern "C" void kernel_launch(void* const* d_in, const int* in_sizes, int n_in, void* d_out, int out_size, void* d_ws, size_t ws_size, hipStream_t stream) {
    static int ready = 0;
    if (!ready) {
        if (n_in != 25 || out_size != TL * DM || ws_size < WS_END) { fprintf(stderr, "kernel_launch: unexpected shapes (n_in %d out %d ws %zu)\n", n_in, out_size, ws_size); ready = -1; return; }
        bool ok = true;
#define SETATTR(K) ok = ok && (hipFuncSetAttribute((const void*)mega<K>, hipFuncAttributeMaxDynamicSharedMemorySize, LDS_BYTES) == hipSuccess)
        SETATTR(100); SETATTR(101); SETATTR(0); SETATTR(1); SETATTR(2); SETATTR(3); SETATTR(4); SETATTR(5); SETATTR(6); SETATTR(7); SETATTR(10);
        if (!ok) { fprintf(stderr, "kernel_launch: hipFuncSetAttribute failed\n"); ready = -1; return; }
        ready = 1;
    }
    if (ready < 0) return;
    Args a{};
    for (int i = 0; i < 25; ++i) a.in[i] = (const float*)d_in[i];
    a.out = (float*)d_out; a.ws = (unsigned char*)d_ws;
#define LAUNCH(K, LI, SEC) do { a.ph_lo = (LI); a.ph_hi = (SEC); hipLaunchKernelGGL(mega<K>, dim3(256), dim3(NTHR), LDS_BYTES, stream, a); } while (0)
    LAUNCH(100, 0, 0); LAUNCH(101, 0, 0);
    for (int li = 0; li < 2; ++li) {
        LAUNCH(0, li, 0); LAUNCH(1, li, 0); LAUNCH(2, li, 0); LAUNCH(3, li, 0); LAUNCH(4, li, 0); LAUNCH(5, li, 0); LAUNCH(6, li, 0); LAUNCH(7, li, 0); LAUNCH(0, li, 1); LAUNCH(1, li, 1); LAUNCH(10, li, 0);
    }
}
```

```cpp
#include <hip/hip_runtime.h>
#include <cstdio>
#include <cstdint>

namespace pg8 {
#define PG8_LAS __attribute__((address_space(3)))
typedef unsigned short bf16_t;
typedef short bf16x8 __attribute__((ext_vector_type(8)));
typedef float f32x4 __attribute__((ext_vector_type(4)));
typedef unsigned u32x4 __attribute__((ext_vector_type(4)));
constexpr int BM = 256, BK = 64, HALF = 128, HTB = HALF * BK * 2, STAGE_BYTES = 8 * HTB, NXCD = 8, WGM = 8;

__host__ __device__ __forceinline__ int lds_byte(int r, int c) { const int st = (r >> 4) * 2 + (c >> 5), rr = r & 15, cc = c & 31, ob = rr * 64 + cc * 2; return st * 1024 + (ob ^ (((ob >> 9) & 1) << 5)); }
__host__ __device__ __forceinline__ void stage_rc(int b, int& R, int& C) { const int st = b / 1024, sb = b % 1024, swz = sb ^ (((sb >> 9) & 1) << 5); R = (st >> 1) * 16 + swz / 64; C = (st & 1) * 32 + (swz % 64) / 2; }
__host__ __device__ __forceinline__ int perm32(int rho) { const int n = rho >> 4, i = rho & 15; return 8 * (i >> 2) + 4 * n + (i & 3); }

struct Unit { int pm, pn; };
struct Gemm { const bf16_t* A; const bf16_t* Bt; int M, N, K; };

struct StaticOrder {
    int nM, nN, nwg, G, c;
    __host__ __device__ void init(int M, int N, int G_, int c_) { nM = M / BM; nN = N / BM; nwg = nM * nN; G = G_; c = c_; }
    __host__ __device__ bool next(int i, Unit& u) const {
        const long L = (long)i * G + c; if (L >= nwg) return false;
        int wgid = (int)L; { const int q = nwg / NXCD, r = nwg % NXCD, xcd = wgid % NXCD, off = wgid / NXCD; wgid = (xcd < r ? xcd * (q + 1) : r * (q + 1) + (xcd - r) * q) + off; }
        const int nig = WGM * nN, gid = wgid / nig, fm = gid * WGM, gsz = (nM - fm) < WGM ? (nM - fm) : WGM;
        u.pm = fm + ((wgid % nig) % gsz); u.pn = (wgid % nig) / gsz; return true;
    }
    __device__ __forceinline__ void a_ready(const Unit&) const {}
    __device__ __forceinline__ void done(const Unit&) const {}
};

__device__ __forceinline__ unsigned cvt_pk_bf16(float lo, float hi) { unsigned r; asm volatile("v_cvt_pk_bf16_f32 %0, %1, %2" : "=v"(r) : "v"(lo), "v"(hi)); return r; }

struct EpiBf16 {
    static constexpr bool PERM = true, AFTER_DRAIN = false;
    bf16_t* O; int ldc;
    __device__ __forceinline__ void operator()(const f32x4 (&acc)[2][2][4][2], const Unit& u, int wr, int wc, int fr, int fq) const {
        const int row0 = u.pm * BM + wr * 64 + fr; const int col0 = u.pn * BM + wc * 32 + 8 * fq;
#pragma unroll
        for (int ai = 0; ai < 2; ++ai)
#pragma unroll
            for (int m = 0; m < 4; ++m) { bf16_t* rowp = O + (size_t)(row0 + ai * HALF + m * 16) * ldc + col0;
#pragma unroll
                for (int bj = 0; bj < 2; ++bj) { const f32x4 v0 = acc[ai][bj][m][0], v1 = acc[ai][bj][m][1];
                    u32x4 w; w.x = cvt_pk_bf16(v0[0], v0[1]); w.y = cvt_pk_bf16(v0[2], v0[3]); w.z = cvt_pk_bf16(v1[0], v1[1]); w.w = cvt_pk_bf16(v1[2], v1[3]);
                    *(u32x4*)(rowp + bj * HALF) = w; } }
    }
};
struct EpiF32 {
    static constexpr bool PERM = true, AFTER_DRAIN = false;
    float* O; int ldc;
    __device__ __forceinline__ void operator()(const f32x4 (&acc)[2][2][4][2], const Unit& u, int wr, int wc, int fr, int fq) const {
        const int row0 = u.pm * BM + wr * 64 + fr; const int col0 = u.pn * BM + wc * 32 + 8 * fq;
#pragma unroll
        for (int ai = 0; ai < 2; ++ai)
#pragma unroll
            for (int m = 0; m < 4; ++m) { float* rowp = O + (size_t)(row0 + ai * HALF + m * 16) * ldc + col0;
#pragma unroll
                for (int bj = 0; bj < 2; ++bj) { *(f32x4*)(rowp + bj * HALF) = acc[ai][bj][m][0]; *(f32x4*)(rowp + bj * HALF + 4) = acc[ai][bj][m][1]; } }
    }
};
__device__ __forceinline__ float silu_f(float x) { return x * __builtin_amdgcn_rcpf(1.0f + __expf(-x)); }
struct EpiSwiglu {
    static constexpr bool PERM = true, AFTER_DRAIN = false;
    bf16_t* O; int ldc;
    __device__ __forceinline__ void operator()(const f32x4 (&acc)[2][2][4][2], const Unit& u, int wr, int wc, int fr, int fq) const {
        const int row0 = u.pm * BM + wr * 64 + fr; const int col0 = u.pn * HALF + wc * 32 + 8 * fq;
#pragma unroll
        for (int ai = 0; ai < 2; ++ai)
#pragma unroll
            for (int m = 0; m < 4; ++m) { bf16_t* rowp = O + (size_t)(row0 + ai * HALF + m * 16) * ldc + col0;
                const f32x4 g0 = acc[ai][0][m][0], g1 = acc[ai][0][m][1], u0 = acc[ai][1][m][0], u1 = acc[ai][1][m][1];
                u32x4 w; w.x = cvt_pk_bf16(silu_f(g0[0]) * u0[0], silu_f(g0[1]) * u0[1]); w.y = cvt_pk_bf16(silu_f(g0[2]) * u0[2], silu_f(g0[3]) * u0[3]);
                w.z = cvt_pk_bf16(silu_f(g1[0]) * u1[0], silu_f(g1[1]) * u1[1]); w.w = cvt_pk_bf16(silu_f(g1[2]) * u1[2], silu_f(g1[3]) * u1[3]);
                *(u32x4*)rowp = w; }
    }
};

template <class Epi, class Sched, bool ALIGN_EPI = false, bool SP2 = false>
__device__ __forceinline__ void gemm_phase(PG8_LAS unsigned char* lds, const Gemm g, const Sched& S, const Epi& E, const int tid) {
    const int wid = __builtin_amdgcn_readfirstlane(tid >> 6), lane = tid & 63, wr = wid >> 2, wc = wid & 3, fr = lane & 15, fq = lane >> 4;
    const int K = g.K, nt = K / BK;
    unsigned voffA[2], voffB[2];
#pragma unroll
    for (int i = 0; i < 2; ++i) { int R, C; stage_rc(tid * 16 + i * 8192, R, C); const int Rb = Epi::PERM ? ((R & ~31) + perm32(R & 31)) : R;
        voffA[i] = (unsigned)(R * K + C) * 2u; voffB[i] = (unsigned)(Rb * K + C) * 2u; }
    const size_t kstep = (size_t)(BK * 2);
    const size_t hstep = (size_t)HALF * K * 2;
    const size_t tstep = 2 * hstep;
    const unsigned ldsw = (unsigned)wid * 1024u;
    const int aoff = lds_byte(wr * 64 + fr, fq * 8), boff = lds_byte(wc * 32 + fr, fq * 8);
#define PG8_SA(b, h) (((b) * 2 + (h)) * HTB)
#define PG8_SB(b, h) ((4 + (b) * 2 + (h)) * HTB)
#define PG8_STAGE(bufoff, gbase, voff) do { _Pragma("unroll") for (int _i = 0; _i < 2; ++_i) \
        __builtin_amdgcn_global_load_lds((const unsigned*)((const char*)(gbase) + (voff)[_i]), (PG8_LAS unsigned*)(lds + (bufoff) + ldsw + _i * 8192), 16, 0, 0); } while (0)
#define PG8_LDA(dst, b, h) do { _Pragma("unroll") for (int m = 0; m < 4; ++m) _Pragma("unroll") for (int k = 0; k < 2; ++k) dst[m][k] = *(const PG8_LAS bf16x8*)(lds + PG8_SA(b, h) + aoff + m * 2048 + k * 1024); } while (0)
#define PG8_LDB(dst, b, h) do { _Pragma("unroll") for (int n = 0; n < 2; ++n) _Pragma("unroll") for (int k = 0; k < 2; ++k) dst[n][k] = *(const PG8_LAS bf16x8*)(lds + PG8_SB(b, h) + boff + n * 2048 + k * 1024); } while (0)
#define PG8_MMA(ai, bj, At, Bt) do { __builtin_amdgcn_s_setprio(1); _Pragma("unroll") for (int m = 0; m < 4; ++m) _Pragma("unroll") for (int n = 0; n < 2; ++n) _Pragma("unroll") for (int k = 0; k < 2; ++k) \
        acc[ai][bj][m][n] = __builtin_amdgcn_mfma_f32_16x16x32_bf16(Bt[n][k], At[m][k], acc[ai][bj][m][n], 0, 0, 0); __builtin_amdgcn_s_setprio(0); } while (0)
#define PG8_WAIT_V(n) asm volatile("s_waitcnt vmcnt(" #n ")" ::: "memory")
#define PG8_WAIT_L(n) asm volatile("s_waitcnt lgkmcnt(" #n ")" ::: "memory")
#define PG8_BAR __builtin_amdgcn_s_barrier()
#define PG8_SCHED __builtin_amdgcn_sched_barrier(0)
    Unit cur, nxt; int ui = 0;
    if (!S.next(0, cur)) return;
    f32x4 acc[2][2][4][2];
#pragma unroll
    for (int a = 0; a < 2; ++a)
#pragma unroll
        for (int b = 0; b < 2; ++b)
#pragma unroll
            for (int m = 0; m < 4; ++m)
#pragma unroll
                for (int n = 0; n < 2; ++n) acc[a][b][m][n] = (f32x4){0.f, 0.f, 0.f, 0.f};
    bf16x8 At[4][2], B0[2][2], B1[2][2];
    const char* cA = (const char*)g.A + (size_t)cur.pm * tstep; const char* cB = (const char*)g.Bt + (size_t)cur.pn * tstep;
    S.a_ready(cur);
    if constexpr (SP2) {
        PG8_STAGE(PG8_SB(0, 0), cB, voffB); PG8_STAGE(PG8_SB(0, 1), cB + hstep, voffB); PG8_STAGE(PG8_SA(0, 0), cA, voffA); PG8_STAGE(PG8_SA(0, 1), cA + hstep, voffA);
        if (wr == 1) PG8_BAR;
        PG8_WAIT_V(2); PG8_BAR;
        PG8_STAGE(PG8_SB(1, 0), cB + kstep, voffB); PG8_STAGE(PG8_SA(1, 0), cA + kstep, voffA); PG8_STAGE(PG8_SB(1, 1), cB + hstep + kstep, voffB);
        PG8_WAIT_V(6); PG8_BAR;
    } else {
        PG8_STAGE(PG8_SB(0, 0), cB, voffB); PG8_STAGE(PG8_SA(0, 0), cA, voffA); PG8_STAGE(PG8_SB(0, 1), cB + hstep, voffB); PG8_STAGE(PG8_SA(0, 1), cA + hstep, voffA);
        if (wr == 1) PG8_BAR;
        PG8_WAIT_V(4); PG8_BAR;
        PG8_STAGE(PG8_SB(1, 0), cB + kstep, voffB); PG8_STAGE(PG8_SA(1, 0), cA + kstep, voffA); PG8_STAGE(PG8_SB(1, 1), cB + hstep + kstep, voffB);
        PG8_WAIT_V(6); PG8_BAR;
    }
    for (;;) {
        const bool has_next = S.next(ui + 1, nxt);
        const char* nA = has_next ? (const char*)g.A + (size_t)nxt.pm * tstep : cA; const char* nB = has_next ? (const char*)g.Bt + (size_t)nxt.pn * tstep : cB;
        for (int t = 0; t < nt; t += 2) {
            const bool last = (t == nt - 2);
            const char* a1 = cA + (size_t)(t + 1) * kstep;
            const char* a2 = last ? nA : cA + (size_t)(t + 2) * kstep; const char* b2 = last ? nB : cB + (size_t)(t + 2) * kstep;
            const char* a3 = a2 + kstep; const char* b3 = b2 + kstep;
            if (last && has_next) S.a_ready(nxt);
            if constexpr (SP2) {
            PG8_LDB(B0, 0, 0); PG8_LDB(B1, 0, 1); PG8_SCHED; PG8_LDA(At, 0, 0); PG8_STAGE(PG8_SA(1, 1), a1 + hstep, voffA);
            PG8_WAIT_V(8); PG8_WAIT_L(0); PG8_BAR; PG8_MMA(0, 0, At, B0); PG8_MMA(0, 1, At, B1); PG8_BAR; PG8_SCHED;
            PG8_LDA(At, 0, 1); PG8_STAGE(PG8_SB(0, 0), b2, voffB); PG8_STAGE(PG8_SB(0, 1), b2 + hstep, voffB); PG8_STAGE(PG8_SA(0, 0), a2, voffA);
            PG8_WAIT_V(8); PG8_WAIT_L(0); PG8_BAR; PG8_MMA(1, 0, At, B0); PG8_MMA(1, 1, At, B1); PG8_BAR; PG8_SCHED;
            PG8_LDB(B0, 1, 0); PG8_LDB(B1, 1, 1); PG8_SCHED; PG8_LDA(At, 1, 0); PG8_STAGE(PG8_SA(0, 1), a2 + hstep, voffA);
            PG8_WAIT_V(8); PG8_WAIT_L(0); PG8_BAR; PG8_MMA(0, 0, At, B0); PG8_MMA(0, 1, At, B1); PG8_BAR; PG8_SCHED;
            PG8_LDA(At, 1, 1); PG8_STAGE(PG8_SB(1, 0), b3, voffB); PG8_STAGE(PG8_SB(1, 1), b3 + hstep, voffB); PG8_STAGE(PG8_SA(1, 0), a3, voffA);
            PG8_WAIT_V(8); PG8_WAIT_L(0); PG8_BAR; PG8_MMA(1, 0, At, B0); PG8_MMA(1, 1, At, B1); PG8_BAR; PG8_SCHED;
            } else {
            PG8_LDB(B0, 0, 0); PG8_SCHED; PG8_LDA(At, 0, 0); PG8_STAGE(PG8_SA(1, 1), a1 + hstep, voffA);
            PG8_WAIT_L(8); PG8_BAR; PG8_WAIT_L(0); PG8_MMA(0, 0, At, B0); PG8_BAR; PG8_SCHED;
            PG8_LDB(B1, 0, 1); PG8_STAGE(PG8_SB(0, 0), b2, voffB);
            PG8_BAR; PG8_WAIT_L(0); PG8_MMA(0, 1, At, B1); PG8_BAR;
            PG8_LDA(At, 0, 1); PG8_STAGE(PG8_SA(0, 0), a2, voffA);
            PG8_BAR; PG8_WAIT_L(0); PG8_MMA(1, 0, At, B0); PG8_BAR; PG8_SCHED;
            PG8_STAGE(PG8_SB(0, 1), b2 + hstep, voffB);
            PG8_WAIT_V(6); PG8_BAR; PG8_MMA(1, 1, At, B1); PG8_BAR;
            PG8_LDB(B0, 1, 0); PG8_SCHED; PG8_LDA(At, 1, 0); PG8_STAGE(PG8_SA(0, 1), a2 + hstep, voffA);
            PG8_WAIT_L(8); PG8_BAR; PG8_WAIT_L(0); PG8_MMA(0, 0, At, B0); PG8_BAR; PG8_SCHED;
            PG8_LDB(B1, 1, 1); PG8_STAGE(PG8_SB(1, 0), b3, voffB);
            PG8_BAR; PG8_WAIT_L(0); PG8_MMA(0, 1, At, B1); PG8_BAR;
            PG8_LDA(At, 1, 1); PG8_STAGE(PG8_SA(1, 0), a3, voffA);
            PG8_BAR; PG8_WAIT_L(0); PG8_MMA(1, 0, At, B0); PG8_BAR; PG8_SCHED;
            PG8_STAGE(PG8_SB(1, 1), b3 + hstep, voffB);
            PG8_WAIT_V(6); PG8_BAR; PG8_MMA(1, 1, At, B1); PG8_BAR;
            }
        }
        if constexpr (ALIGN_EPI) { if (wr == 0) PG8_BAR; }
        if constexpr (!Epi::AFTER_DRAIN) { E(acc, cur, wr, wc, fr, fq); S.done(cur); }
        if (!has_next) break;
#pragma unroll
        for (int a = 0; a < 2; ++a)
#pragma unroll
            for (int b = 0; b < 2; ++b)
#pragma unroll
                for (int m = 0; m < 4; ++m)
#pragma unroll
                    for (int n = 0; n < 2; ++n) acc[a][b][m][n] = (f32x4){0.f, 0.f, 0.f, 0.f};
        cur = nxt; cA = nA; cB = nB; ++ui;
        if constexpr (ALIGN_EPI) { if (wr == 1) PG8_BAR; }
    }
    PG8_WAIT_V(0);
    if constexpr (!ALIGN_EPI) { if (wr == 0) PG8_BAR; }
    PG8_BAR;
#undef PG8_SA
#undef PG8_SB
#undef PG8_STAGE
#undef PG8_LDA
#undef PG8_LDB
#undef PG8_MMA
#undef PG8_WAIT_V
#undef PG8_WAIT_L
#undef PG8_BAR
#undef PG8_SCHED
}
}

constexpr int NWAVES = 8, NTHR = 512;
constexpr int DM = 1024, SEQ = 8192, NB = 2, CTX = 256, TL = NB * SEQ, TC = NB * CTX, TT = TL + TC;
constexpr int FFN = 2752, FFNP = 2816, NWI = 5632, INW = 2432, INWP = 2560, NMOD = 9;
constexpr int ZF = 0, ZQ = 256, ZK = 640, ZV = 768, ZRR = 896, ZRK = 1280, ZRV = 1664, ZW = 2048, ZA = 2176, ZG = 2304;
constexpr int RW = 384;
constexpr float NORM_EPS = 1e-6f, GN_EPS = 64e-5f;

constexpr size_t MiB = 1u << 20;
constexpr size_t WS_CTL = 0, WS_MOD = 1 * MiB, WS_ROPE = 2 * MiB, WS_XC = 4 * MiB, WS_GC = 6 * MiB;
constexpr size_t WS_WI1 = 8 * MiB, WS_WO1 = 19 * MiB, WS_WIN = 25 * MiB, WS_WOUT = 30 * MiB, WS_WI2 = 32 * MiB, WS_WO2 = 43 * MiB;
constexpr size_t WS_H = 49 * MiB;
constexpr size_t WS_ACT = 82 * MiB;
constexpr size_t WS_O = 173 * MiB;
constexpr size_t WS_YD = WS_O, WS_QR = WS_O + 50 * MiB, WS_KR = WS_O + 62 * MiB;
constexpr size_t WS_W2T = WS_MOD + 256 * 1024, WS_A2T = WS_MOD + 512 * 1024, WS_G2T = WS_MOD + 768 * 1024;
constexpr size_t WS_LW = WS_O, WS_IC = WS_O + 25 * MiB;
constexpr size_t WS_FA = 239 * MiB;
constexpr size_t WS_SUM = 255 * MiB;
constexpr size_t WS_END = 293 * MiB;

constexpr int LDS_BYTES = 147456;

typedef unsigned short bf16;
typedef float f32x4 __attribute__((ext_vector_type(4)));
typedef unsigned v4u __attribute__((ext_vector_type(4)));
typedef unsigned v2u __attribute__((ext_vector_type(2)));
#define LAS __attribute__((address_space(3)))
#define LDS_WAIT() asm volatile("s_waitcnt lgkmcnt(0)" ::: "memory")

__device__ __forceinline__ unsigned f2bf(float f) { unsigned u = __builtin_bit_cast(unsigned, f); return (u + 0x7fffu + ((u >> 16) & 1u)) >> 16; }
__device__ __forceinline__ unsigned pk2(float lo, float hi) { return f2bf(lo) | (f2bf(hi) << 16); }
__device__ __forceinline__ float bf2f(unsigned short u) { return __builtin_bit_cast(float, (unsigned)u << 16); }
__device__ __forceinline__ float bflo(unsigned u) { return __builtin_bit_cast(float, u << 16); }
__device__ __forceinline__ float bfhi(unsigned u) { return __builtin_bit_cast(float, u & 0xffff0000u); }
__device__ __forceinline__ float wave_sum(float v) {
#pragma unroll
    for (int o = 1; o < 64; o <<= 1) v += __shfl_xor(v, o);
    return v;
}
__device__ __forceinline__ float wave_max(float v) {
#pragma unroll
    for (int o = 1; o < 64; o <<= 1) v = fmaxf(v, __shfl_xor(v, o));
    return v;
}

struct Args { const float* in[25]; float* out; unsigned char* ws; int ph_lo, ph_hi; };

struct Frame {
    LAS unsigned char* lds;
    int tid, lane, wave, G, bid;
    float* out; unsigned char* ws;
};
enum { I_X = 0, I_C, I_CTX, I_CCTX, I_MODW, I_MODB, I_NORMG, I_F1WI, I_F1WO, I_WIN, I_WOUT, I_SINK, I_CONV, I_W0, I_W2, I_A0, I_A2, I_G2, I_KK, I_KA, I_RK, I_LNG, I_LNB, I_F2WI, I_F2WO };

__device__ __forceinline__ const float* inp(int i) {
    const __attribute__((address_space(4))) char* p = (const __attribute__((address_space(4))) char*)__builtin_amdgcn_kernarg_segment_ptr();
    asm volatile("" : "+s"(p));
    return *(const float* const __attribute__((address_space(4)))*)(p + 8 * i);
}
__device__ __forceinline__ void cvt_item(const float* W, int ldw, int k0, int sc, bool valid, bf16* WT, int Kd, int n0d, LAS float* scr, int lane) {
#pragma unroll 8
    for (int i = 0; i < 32; ++i) { const int kk = 2 * i + (lane >> 5); scr[kk * 33 + (lane & 31)] = valid ? W[(size_t)(k0 + kk) * ldw + sc + (lane & 31)] : 0.f; }
    LDS_WAIT(); asm volatile("" ::: "memory");
    const int c = lane & 7;
#pragma unroll
    for (int j = 0; j < 4; ++j) { const int n = (lane >> 3) + 8 * j; const LAS float* s = scr + (8 * c) * 33 + n;
        v4u o; o.x = pk2(s[0 * 33], s[1 * 33]); o.y = pk2(s[2 * 33], s[3 * 33]); o.z = pk2(s[4 * 33], s[5 * 33]); o.w = pk2(s[6 * 33], s[7 * 33]);
        *(v4u*)(WT + (size_t)(n0d + n) * Kd + k0 + 8 * c) = o; }
    LDS_WAIT(); asm volatile("" ::: "memory");
}
__device__ __forceinline__ void convert_weights(Frame& F, int li) {
    LAS float* scr = (LAS float*)(F.lds + F.wave * 16384);
    const int gw = F.bid * NWAVES + F.wave, NGW = F.G * NWAVES;
    constexpr int I_WI = 16 * (NWI / 32), I_WO = (FFNP / 64) * 32, I_IN = 16 * (INWP / 32), I_OUT = 16 * 32;
    constexpr int NITEMS = 2 * I_WI + 2 * I_WO + I_IN + I_OUT;
    for (int it = gw; it < NITEMS; it += NGW) {
        int r = it;
        if (r < 2 * I_WI) { const int f = r / I_WI; r -= f * I_WI; const int nblk = NWI / 32, kb = r / nblk, nb = r % nblk;
            const int n0 = 32 * nb, pn = n0 >> 8, i = n0 & 255; const int j = 128 * pn + (i & 127); const bool valid = j < FFN; const int sc = (i < 128) ? j : FFN + j;
            cvt_item((f ? inp(I_F2WI) : inp(I_F1WI)) + (size_t)li * DM * 2 * FFN, 2 * FFN, 64 * kb, sc, valid, (bf16*)(F.ws + (f ? WS_WI2 : WS_WI1)), DM, n0, scr, F.lane); continue; }
        r -= 2 * I_WI;
        if (r < 2 * I_WO) { const int f = r / I_WO; r -= f * I_WO; const int kb = r / 32, nb = r % 32; const bool valid = 64 * kb < FFN;
            cvt_item((f ? inp(I_F2WO) : inp(I_F1WO)) + (size_t)li * FFN * DM, DM, 64 * kb, 32 * nb, valid, (bf16*)(F.ws + (f ? WS_WO2 : WS_WO1)), FFNP, 32 * nb, scr, F.lane); continue; }
        r -= 2 * I_WO;
        if (r < I_IN) { const int nblk = INWP / 32, kb = r / nblk, nb = r % nblk; const bool valid = 32 * nb < INW;
            cvt_item(inp(I_WIN) + (size_t)li * DM * INW, INW, 64 * kb, 32 * nb, valid, (bf16*)(F.ws + WS_WIN), DM, 32 * nb, scr, F.lane); continue; }
        r -= I_IN;
        { const int kb = r / 32, nb = r % 32;
            cvt_item(inp(I_WOUT) + (size_t)li * DM * DM, DM, 64 * kb, 32 * nb, true, (bf16*)(F.ws + WS_WOUT), DM, 32 * nb, scr, F.lane); }
    }
}
__device__ __forceinline__ void mod_gemv(Frame& F) {
    LAS float* sc = (LAS float*)F.lds;
    LAS float* red = sc + 3 * 1024;
    __syncthreads();
    for (int i = F.tid; i < 3 * 1024; i += NTHR) { const int v = i >> 10, k = i & 1023; const float x = v < 2 ? inp(I_C)[v * 1024 + k] : inp(I_CCTX)[k]; sc[i] = x / (1.0f + __expf(-x)); }
    __syncthreads();
    float* modv = (float*)(F.ws + WS_MOD);
    for (int u = F.bid; u < 2 * 72; u += F.G) {
        const int l = u / 72, n0 = (u % 72) * 128;
        const float* w = inp(I_MODW) + (size_t)l * DM * 9216 + n0 + 2 * F.lane;
        float a0 = 0.f, a1 = 0.f, b0 = 0.f, b1 = 0.f, c0 = 0.f, c1 = 0.f;
        const int k0 = F.wave * 128;
#pragma unroll 8
        for (int k = 0; k < 128; ++k) { const float2 wv = *(const float2*)(w + (size_t)(k0 + k) * 9216); const float s0 = sc[k0 + k], s1 = sc[1024 + k0 + k], s2 = sc[2048 + k0 + k];
            a0 += s0 * wv.x; a1 += s0 * wv.y; b0 += s1 * wv.x; b1 += s1 * wv.y; c0 += s2 * wv.x; c1 += s2 * wv.y; }
        LAS float* rw = red + F.wave * 384 + 2 * F.lane;
        rw[0] = a0; rw[1] = a1; rw[128] = b0; rw[129] = b1; rw[256] = c0; rw[257] = c1;
        __syncthreads();
        if (F.tid < 384) { float s = 0.f;
#pragma unroll
            for (int w8 = 0; w8 < 8; ++w8) s += red[w8 * 384 + F.tid];
            const int v = F.tid >> 7, n = n0 + (F.tid & 127);
            modv[(size_t)(l * 3 + v) * 9216 + n] = s + inp(I_MODB)[l * 9216 + n]; }
        __syncthreads();
    }
}
__device__ __forceinline__ void rope_tables(Frame& F) {
    float* ct = (float*)(F.ws + WS_ROPE); float* st = ct + SEQ * 32;
    for (int i = F.bid * NTHR + F.tid; i < SEQ * 32; i += F.G * NTHR) {
        const int t = i >> 5, j = i & 31; const int f = j & 15;
        const float inv = exp2f(-(float)f * (13.287712379549449f / 16.0f));
        const float pos = (float)(j < 16 ? (t >> 6) : (t & 63));
        const float ang = pos * inv;
        const double a = (double)ang; const double k = __builtin_rint(a * 0.15915494309189535); const float r = (float)(a - k * 6.283185307179586);
        ct[i] = __cosf(r); st[i] = __sinf(r);
    }
}

struct EArgs { const float* xl_src; const float* xc_src; float* xl_dst; float* xc_dst; const float* o; const float* modv_g; int gidx; float gmul; const float* gpost;
               bf16* hdst; const float* modv_h; int shidx, scidx; const float* gpre; int nrows; };
__device__ __forceinline__ void e_phase(Frame& F, const EArgs& A) {
    const int gw = F.bid * NWAVES + F.wave, NGW = F.G * NWAVES;
    for (int r = gw; r < A.nrows; r += NGW) {
        const int v = r < TL ? (r >> 13) : 2;
        const float* xs = r < TL ? A.xl_src + (size_t)r * DM : A.xc_src + (size_t)(r - TL) * DM;
        f32x4 x[4];
#pragma unroll
        for (int j = 0; j < 4; ++j) x[j] = ((const f32x4*)xs)[F.lane + 64 * j];
        if (A.o) {
            const f32x4* orow = (const f32x4*)(A.o + (size_t)r * DM); f32x4 ov[4]; float ss = 0.f;
#pragma unroll
            for (int j = 0; j < 4; ++j) { ov[j] = orow[F.lane + 64 * j]; ss += (ov[j].x * ov[j].x + ov[j].y * ov[j].y) + (ov[j].z * ov[j].z + ov[j].w * ov[j].w); }
            const float rstd = 1.0f / sqrtf(wave_sum(ss) * (1.0f / DM) + NORM_EPS) * A.gmul;
            const f32x4* gm = (const f32x4*)(A.modv_g + (size_t)v * 9216 + A.gidx * DM); const f32x4* gp = (const f32x4*)A.gpost;
            float* xd = r < TL ? A.xl_dst + (size_t)r * DM : A.xc_dst + (size_t)(r - TL) * DM;
#pragma unroll
            for (int j = 0; j < 4; ++j) { const f32x4 g = gm[F.lane + 64 * j], p = gp[F.lane + 64 * j]; x[j] = x[j] + g * (ov[j] * rstd * p); ((f32x4*)xd)[F.lane + 64 * j] = x[j]; }
        }
        if (A.hdst) {
            float ss = 0.f;
#pragma unroll
            for (int j = 0; j < 4; ++j) ss += (x[j].x * x[j].x + x[j].y * x[j].y) + (x[j].z * x[j].z + x[j].w * x[j].w);
            const float rstd = 1.0f / sqrtf(wave_sum(ss) * (1.0f / DM) + NORM_EPS);
            const f32x4* sh = (const f32x4*)(A.modv_h + (size_t)v * 9216 + A.shidx * DM); const f32x4* scl = (const f32x4*)(A.modv_h + (size_t)v * 9216 + A.scidx * DM); const f32x4* gp = (const f32x4*)A.gpre;
            v2u* hd = (v2u*)(A.hdst + (size_t)r * DM);
#pragma unroll
            for (int j = 0; j < 4; ++j) { const f32x4 s = sh[F.lane + 64 * j], c = scl[F.lane + 64 * j], p = gp[F.lane + 64 * j]; const f32x4 hv = (x[j] * rstd * p) * (1.0f + c) + s;
                v2u w; w.x = pk2(hv.x, hv.y); w.y = pk2(hv.z, hv.w); hd[F.lane + 64 * j] = w; }
        }
    }
}

__device__ __forceinline__ const bf16* zrow(const Frame& F, int row) { return (const bf16*)(F.ws + WS_ACT) + (size_t)row * INWP; }

__device__ __forceinline__ void rope_unit(Frame& F, int u) {
    const float* ct = (const float*)(F.ws + WS_ROPE); const float* st = ct + SEQ * 32;
    bf16* qr = (bf16*)(F.ws + WS_QR); bf16* kr = (bf16*)(F.ws + WS_KR);
    for (int i = F.tid; i < 256 * 8 * 32; i += NTHR) {
        const int j = i & 31, hh = (i >> 5) & 7, tok = u * 256 + (i >> 8);
        const int s = tok & (SEQ - 1);
        const bf16* z = zrow(F, tok);
        const int col = hh < 6 ? ZQ + 64 * hh : ZK + 64 * (hh - 6);
        const float x1 = bf2f(z[col + j]), x2 = bf2f(z[col + 32 + j]);
        const float c = ct[s * 32 + j], sn = st[s * 32 + j];
        float o1 = x1 * c - x2 * sn, o2 = x2 * c + x1 * sn;
        if (hh < 6) { o1 *= 0.125f; o2 *= 0.125f; qr[(size_t)tok * 384 + 64 * hh + j] = (bf16)f2bf(o1); qr[(size_t)tok * 384 + 64 * hh + 32 + j] = (bf16)f2bf(o2); }
        else { kr[(size_t)tok * 128 + 64 * (hh - 6) + j] = (bf16)f2bf(o1); kr[(size_t)tok * 128 + 64 * (hh - 6) + 32 + j] = (bf16)f2bf(o2); }
    }
}

__device__ __forceinline__ void fourier_a_unit(Frame& F, int u) {
    const int b = u >> 7, n2 = u & 127;
    LAS float* tab = (LAS float*)F.lds;
    __syncthreads();
    if (F.tid < 64) { const float a = (float)F.tid * (1.0f / 64.0f); tab[F.tid] = __builtin_amdgcn_cosf(a); tab[64 + F.tid] = __builtin_amdgcn_sinf(a); }
    __syncthreads();
    const int c = F.tid & 255, kh = F.tid >> 8;
    float f[64];
#pragma unroll
    for (int n1 = 0; n1 < 64; ++n1) f[n1] = bf2f(zrow(F, b * SEQ + 128 * n1 + n2)[ZF + c]);
    bf16* far = (bf16*)(F.ws + WS_FA); bf16* fai = far + (size_t)NB * 64 * 128 * 256;
    for (int kk = 0; kk < 32; ++kk) { const int k1 = kh * 32 + kk;
        float sr = 0.f, si = 0.f;
#pragma unroll
        for (int n1 = 0; n1 < 64; ++n1) { const int idx = (n1 * k1) & 63; sr += f[n1] * tab[idx]; si -= f[n1] * tab[64 + idx]; }
        const float tw = (float)(n2 * k1) * (1.0f / 8192.0f); const float tc = __builtin_amdgcn_cosf(tw), ts = -__builtin_amdgcn_sinf(tw);
        const size_t o = (((size_t)b * 64 + k1) * 128 + n2) * 256 + c;
        far[o] = (bf16)f2bf(sr * tc - si * ts); fai[o] = (bf16)f2bf(sr * ts + si * tc);
    }
}
__device__ __forceinline__ void fourier_c_unit(Frame& F, int u) {
    const int b = u >> 7, k1 = (u >> 1) & 63, half = u & 1;
    LAS float* tab = (LAS float*)F.lds;
    LAS float* tab64 = tab + 256;
    LAS float* P = tab + 512;
    __syncthreads();
    if (F.tid < 128) { const float a = (float)F.tid * (1.0f / 128.0f); tab[F.tid] = __builtin_amdgcn_cosf(a); tab[128 + F.tid] = __builtin_amdgcn_sinf(a); }
    if (F.tid >= 128 && F.tid < 192) { const float a = (float)(F.tid - 128) * (1.0f / 64.0f); tab64[F.tid - 128] = __builtin_amdgcn_cosf(a); tab64[64 + F.tid - 128] = __builtin_amdgcn_sinf(a); }
    __syncthreads();
    const int c = F.tid & 255, q = F.tid >> 8;
    const bf16* far = (const bf16*)(F.ws + WS_FA) + (((size_t)b * 64 + k1) * 128) * 256 + c; const bf16* fai = far + (size_t)NB * 64 * 128 * 256;
    float ar[32], ai[32];
#pragma unroll
    for (int i = 0; i < 32; ++i) { ar[i] = 0.f; ai[i] = 0.f; }
    const int k2b = 64 * half + 32 * q;
    for (int n2 = 0; n2 < 128; ++n2) { const float xr = bf2f(far[(size_t)n2 * 256]), xi = bf2f(fai[(size_t)n2 * 256]);
#pragma unroll
        for (int i = 0; i < 32; ++i) { const int idx = (n2 * (k2b + i)) & 127; const float cs = tab[idx], sn = tab[128 + idx];
            ar[i] += xr * cs + xi * sn; ai[i] += xi * cs - xr * sn; } }
    bf16* mix = (bf16*)(F.ws + WS_H);
    const int g = c >> 6;
    float y[32];
#pragma unroll
    for (int i = 0; i < 32; ++i) y[i] = 0.f;
#pragma unroll
    for (int rnd = 0; rnd < 2; ++rnd) {
        __syncthreads();
#pragma unroll
        for (int i = 0; i < 32; ++i) P[(32 * q + i) * 256 + c] = rnd == 0 ? ar[i] : ai[i];
        __syncthreads();
        const int m = c & 63;
        for (int cc = 0; cc < 64; ++cc) { const int idx = (m * cc) & 63; const float t = rnd == 0 ? tab64[idx] : tab64[64 + idx];
#pragma unroll
            for (int i = 0; i < 32; ++i) y[i] += P[(32 * q + i) * 256 + 64 * g + cc] * t; }
    }
    const float scale = 0.0013810679320049757f;
#pragma unroll
    for (int i = 0; i < 32; ++i) { const int k = k1 + 64 * (k2b + i); mix[(size_t)(b * SEQ + k) * DM + c] = (bf16)f2bf(y[i] * scale); }
}
__device__ __forceinline__ void fourier_ctx1_unit(Frame& F, int u) {
    float* gr = (float*)(F.ws + WS_GC); float* gi = gr + TC * 256;
    for (int i = F.tid; i < 32 * 256; i += NTHR) { const int tok = u * 32 + (i >> 8), gm = i & 255, g = gm >> 6, m = gm & 63;
        const bf16* z = zrow(F, TL + tok) + ZF + 64 * g; float sr = 0.f, si = 0.f;
        for (int c = 0; c < 64; ++c) { const float a = (float)((m * c) & 63) * (1.0f / 64.0f); const float x = bf2f(z[c]); sr += x * __builtin_amdgcn_cosf(a); si -= x * __builtin_amdgcn_sinf(a); }
        gr[tok * 256 + gm] = sr; gi[tok * 256 + gm] = si; }
}
__device__ __forceinline__ void fourier_ctx2_unit(Frame& F, int u) {
    const float* gr = (const float*)(F.ws + WS_GC); const float* gi = gr + TC * 256; bf16* mix = (bf16*)(F.ws + WS_H);
    const int b = u >> 4, kb = (u & 15) * 16;
    for (int i = F.tid; i < 16 * 256; i += NTHR) { const int k = kb + (i >> 8), gm = i & 255; float y = 0.f;
        for (int n = 0; n < 256; ++n) { const float a = (float)((k * n) & 255) * (1.0f / 256.0f); y += gr[(b * 256 + n) * 256 + gm] * __builtin_amdgcn_cosf(a) + gi[(b * 256 + n) * 256 + gm] * __builtin_amdgcn_sinf(a); }
        mix[(size_t)(TL + b * 256 + k) * DM + gm] = (bf16)f2bf(y * 0.0078125f); }
}

__device__ __forceinline__ float dot64(const float (&q)[64], const bf16* krow) {
    float s = 0.f;
#pragma unroll
    for (int i = 0; i < 8; ++i) { const v4u w = ((const v4u*)krow)[i];
        s += q[8 * i + 0] * bflo(w.x) + q[8 * i + 1] * bfhi(w.x) + q[8 * i + 2] * bflo(w.y) + q[8 * i + 3] * bfhi(w.y) + q[8 * i + 4] * bflo(w.z) + q[8 * i + 5] * bfhi(w.z) + q[8 * i + 6] * bflo(w.w) + q[8 * i + 7] * bfhi(w.w); }
    return s;
}
__device__ __forceinline__ void attn_v1(Frame& F, int li) {
    const int gw = F.bid * NWAVES + F.wave, NGW = F.G * NWAVES;
    const bf16* qr = (const bf16*)(F.ws + WS_QR); const bf16* kr = (const bf16*)(F.ws + WS_KR); bf16* mix = (bf16*)(F.ws + WS_H);
    const float* sink = inp(I_SINK) + li * 6;
    const int npairs = (li == 0 ? TT : TL) * 6;
    for (int p = gw; p < npairs; p += NGW) {
        const int row = p / 6, hq = p % 6, kvh = hq / 3; const bool isctx = row >= TL;
        const int b = isctx ? (row - TL) >> 8 : row >> 13, s = row & (SEQ - 1);
        float q[64];
        if (!isctx) {
#pragma unroll
            for (int i = 0; i < 8; ++i) { const v4u w = ((const v4u*)(qr + (size_t)row * 384 + 64 * hq))[i];
                q[8 * i] = bflo(w.x); q[8 * i + 1] = bfhi(w.x); q[8 * i + 2] = bflo(w.y); q[8 * i + 3] = bfhi(w.y); q[8 * i + 4] = bflo(w.z); q[8 * i + 5] = bfhi(w.z); q[8 * i + 6] = bflo(w.w); q[8 * i + 7] = bfhi(w.w); }
        } else {
#pragma unroll
            for (int i = 0; i < 8; ++i) { const v4u w = ((const v4u*)(zrow(F, row) + ZQ + 64 * hq))[i];
                q[8 * i] = 0.125f * bflo(w.x); q[8 * i + 1] = 0.125f * bfhi(w.x); q[8 * i + 2] = 0.125f * bflo(w.y); q[8 * i + 3] = 0.125f * bfhi(w.y); q[8 * i + 4] = 0.125f * bflo(w.z); q[8 * i + 5] = 0.125f * bfhi(w.z); q[8 * i + 6] = 0.125f * bflo(w.w); q[8 * i + 7] = 0.125f * bfhi(w.w); }
        }
        float sc[9]; int krow_[9];
        const float NEG = -INFINITY;
        float mx = sink[hq];
#pragma unroll
        for (int r = 0; r < 9; ++r) {
            if (r < 5) {
                const int kp = s - 128 + 64 * r + F.lane; const bool ok = !isctx && kp >= 0 && kp < SEQ && kp <= s + 128;
                const int kc = ok ? kp : 0; krow_[r] = b * SEQ + kc;
                const float d = isctx ? 0.f : dot64(q, kr + (size_t)(b * SEQ + kc) * 128 + 64 * kvh);
                sc[r] = ok ? d : NEG;
            } else {
                const int kc = 64 * (r - 5) + F.lane; krow_[r] = TL + b * CTX + kc;
                sc[r] = dot64(q, zrow(F, TL + b * CTX + kc) + ZK + 64 * kvh);
            }
            mx = fmaxf(mx, sc[r]);
        }
        mx = wave_max(mx);
        float den = 0.f;
#pragma unroll
        for (int r = 0; r < 9; ++r) { sc[r] = __expf(sc[r] - mx); den += sc[r]; }
        den = wave_sum(den) + __expf(sink[hq] - mx);
        float acc = 0.f;
#pragma unroll
        for (int r = 0; r < 9; ++r) {
            if (r < 5 && isctx) continue;
            for (int kk = 0; kk < 64; ++kk) { const float pk = __builtin_bit_cast(float, __builtin_amdgcn_readlane(__builtin_bit_cast(int, sc[r]), kk)); const int kr_ = __builtin_amdgcn_readlane(krow_[r], kk);
                acc += pk * bf2f(zrow(F, kr_)[ZV + 64 * kvh + F.lane]); }
        }
        mix[(size_t)row * DM + 256 + 64 * hq + F.lane] = (bf16)f2bf(acc / den);
    }
}

typedef short bf16x8 __attribute__((ext_vector_type(8)));
#define MFMA16(a, b, c) __builtin_amdgcn_mfma_f32_16x16x32_bf16(a, b, c, 0, 0, 0)
__device__ __forceinline__ bf16x8 mk8(unsigned a, unsigned b, unsigned c, unsigned d) { const v4u v = {a, b, c, d}; return __builtin_bit_cast(bf16x8, v); }
typedef __bf16 bf16x2_t __attribute__((ext_vector_type(2)));
typedef float f32x2_t __attribute__((ext_vector_type(2)));
__device__ __forceinline__ unsigned cvtpk(float lo, float hi) { const f32x2_t f = {lo, hi}; return __builtin_bit_cast(unsigned, __builtin_convertvector(f, bf16x2_t)); }
constexpr int NSC = 66;
constexpr int IM_AI = 0, IM_RI = 4608, IM_BI = 9216, IM_KI = 13824, IM_BKT = 18432, IM_VT = 28672, IM_GAM = 33792, IMG_BYTES = 34816;
constexpr int L_IMG0 = 0, L_IMG1 = IMG_BYTES, L_PKG = 2 * IMG_BYTES, L_YL = L_PKG + 8192, L_VB = L_YL + 128 * 68 * 4, L_BON = L_VB + 128 * 64 * 2, L_RW_END = L_BON + 512;
static_assert(L_RW_END <= 131072, "rwkv LDS map");
constexpr size_t SUM_SLOT = 24576;

__device__ __forceinline__ void lora_transposes(Frame& F) {
    bf16* w2t = (bf16*)(F.ws + WS_W2T); bf16* a2t = (bf16*)(F.ws + WS_A2T); bf16* g2t = (bf16*)(F.ws + WS_G2T);
    const float* w2 = inp(I_W2); const float* a2 = inp(I_A2); const float* g2 = inp(I_G2);
    for (int i = F.bid * NTHR + F.tid; i < 4 * 384 * 64; i += F.G * NTHR) { const int r = i & 63, col = (i >> 6) % 384, ld = i / (384 * 64);
        w2t[i] = (bf16)f2bf(w2[((size_t)ld * 64 + r) * RW + col]); a2t[i] = (bf16)f2bf(a2[((size_t)ld * 64 + r) * RW + col]); }
    for (int i = F.bid * NTHR + F.tid; i < 2 * 384 * 128; i += F.G * NTHR) { const int r = i & 127, col = (i >> 7) % 384, l = i / (384 * 128);
        g2t[i] = (bf16)f2bf(g2[((size_t)l * 128 + r) * RW + col]); }
}

__device__ __forceinline__ float softplus_fast(float x) { return fmaxf(x, 0.f) + __logf(1.0f + __expf(-fabsf(x))); }
__device__ __forceinline__ void lora_unit(Frame& F, int li, int u) {
    const int dir = u & 1, r0 = (u >> 1) * 64, q = F.lane >> 4, c16 = F.lane & 15;
    bf16* LW = (bf16*)(F.ws + WS_LW) + (size_t)dir * TT * RW; bf16* IC = (bf16*)(F.ws + WS_IC) + (size_t)dir * TT * RW;
    const bf16* w2t = (const bf16*)(F.ws + WS_W2T) + (size_t)(li * 2 + dir) * 384 * 64; const bf16* a2t = (const bf16*)(F.ws + WS_A2T) + (size_t)(li * 2 + dir) * 384 * 64;
    bf16x8 bw[4][2], ba[4][2];
#pragma unroll
    for (int rt = 0; rt < 4; ++rt)
#pragma unroll
        for (int k = 0; k < 2; ++k) { const bf16* z = zrow(F, r0 + 16 * rt + c16);
            const v4u zw = *(const v4u*)(z + ZW + 64 * dir + 32 * k + 8 * q); ba[rt][k] = *(const bf16x8*)(z + ZA + 64 * dir + 32 * k + 8 * q);
            bw[rt][k] = mk8(pk2(tanhf(bflo(zw.x)), tanhf(bfhi(zw.x))), pk2(tanhf(bflo(zw.y)), tanhf(bfhi(zw.y))), pk2(tanhf(bflo(zw.z)), tanhf(bfhi(zw.z))), pk2(tanhf(bflo(zw.w)), tanhf(bfhi(zw.w)))); }
#pragma unroll 1
    for (int cti = 0; cti < 3; ++cti) { const int ct = 3 * F.wave + cti; const int col = 16 * ct + c16;
        bf16x8 aw[2], aa[2];
#pragma unroll
        for (int k = 0; k < 2; ++k) { aw[k] = *(const bf16x8*)(w2t + (size_t)col * 64 + 32 * k + 8 * q); aa[k] = *(const bf16x8*)(a2t + (size_t)col * 64 + 32 * k + 8 * q); }
        const f32x4 w0v = *(const f32x4*)(inp(I_W0) + (li * 2 + dir) * RW + 16 * ct + 4 * q); const f32x4 a0v = *(const f32x4*)(inp(I_A0) + (li * 2 + dir) * RW + 16 * ct + 4 * q);
#pragma unroll
        for (int rt = 0; rt < 4; ++rt) { f32x4 dw = {0.f, 0.f, 0.f, 0.f}, da = {0.f, 0.f, 0.f, 0.f};
#pragma unroll
            for (int k = 0; k < 2; ++k) { dw = MFMA16(aw[k], bw[rt][k], dw); da = MFMA16(aa[k], ba[rt][k], da); }
            float lw[4], ic[4];
#pragma unroll
            for (int e = 0; e < 4; ++e) { const float x = w0v[e] + dw[e]; const float wl = -softplus_fast(-x) - 0.5f; lw[e] = -__expf(wl); ic[e] = 1.0f / (1.0f + __expf(-(a0v[e] + da[e]))); }
            const size_t o = (size_t)(r0 + 16 * rt + c16) * RW + 16 * ct + 4 * q;
            v2u w; w.x = pk2(lw[0], lw[1]); w.y = pk2(lw[2], lw[3]); *(v2u*)(LW + o) = w; w.x = pk2(ic[0], ic[1]); w.y = pk2(ic[2], ic[3]); *(v2u*)(IC + o) = w; }
    }
}

struct ChainCtx { int dir, b, h, li; float kkw, kaw, rkw; float cw[3][3]; };
__device__ __forceinline__ void chain_consts(ChainCtx& C, int li, int dir, int b, int h, int j) {
    C.dir = dir; C.b = b; C.h = h; C.li = li; const int ch = 64 * h + j;
    C.kkw = inp(I_KK)[li * RW + ch]; C.kaw = inp(I_KA)[li * RW + ch]; C.rkw = inp(I_RK)[li * RW + ch];
#pragma unroll
    for (int t = 0; t < 3; ++t)
#pragma unroll
        for (int qq = 0; qq < 3; ++qq) C.cw[t][qq] = inp(I_CONV)[(size_t)(li * 3 + t) * (3 * RW) + qq * RW + ch];
}
template <int TPT, bool BONUS>
__device__ __forceinline__ void prep_round(Frame& F, const ChainCtx& C, LAS unsigned char* img, int j, int tg, bool isctx, int step0, LAS unsigned char* lds_vb, LAS float* lds_bon, int pos0_local) {
    const int L = isctx ? CTX : SEQ, rbase = isctx ? TL + C.b * CTX : C.b * SEQ, ch = 64 * C.h + j;
    const bf16* LW = (const bf16*)(F.ws + WS_LW) + (size_t)C.dir * TT * RW + ch; const bf16* IC = (const bf16*)(F.ws + WS_IC) + (size_t)C.dir * TT * RW + ch;
    const int tok0 = tg * TPT, blk = tok0 >> 4;
    float cum = 0.f;
    for (int t = blk * 16; t < tok0; ++t) { const int s = step0 + t; const int p = C.dir ? L - 1 - s : s; cum += bf2f(LW[(size_t)(rbase + p) * RW]); }
    float eprev = __expf(cum);
    const int pj = (j & ~31) | (((j & 15) >> 2) << 3) | (((j >> 4) & 1) << 2) | (j & 3);
    LAS bf16* AI = (LAS bf16*)(img + IM_AI) + blk * 1152, *RI = (LAS bf16*)(img + IM_RI) + blk * 1152, *BI = (LAS bf16*)(img + IM_BI) + blk * 1152, *KI = (LAS bf16*)(img + IM_KI) + blk * 1152;
    LAS bf16* BKT = (LAS bf16*)(img + IM_BKT) + blk * 2560 + j * 40; LAS bf16* VT = (LAS bf16*)(img + IM_VT) + blk * 1280 + j * 20; LAS float* GAM = (LAS float*)(img + IM_GAM) + blk * 64;
#pragma unroll 2
    for (int u = 0; u < TPT; ++u) { const int t = tok0 + u, tb = t & 15; const int s = step0 + t; const int p = C.dir ? L - 1 - s : s; const int row = rbase + p;
        const float lw = bf2f(LW[(size_t)row * RW]), ai = bf2f(IC[(size_t)row * RW]);
        float rv = 0.f, kv = 0.f, vv = 0.f;
#pragma unroll
        for (int tt = 0; tt < 3; ++tt) { const int pp = p + tt - 1; if (pp >= 0 && pp < L) { const bf16* z = zrow(F, rbase + pp); rv += C.cw[tt][0] * bf2f(z[ZRR + ch]); kv += C.cw[tt][1] * bf2f(z[ZRK + ch]); vv += C.cw[tt][2] * bf2f(z[ZRV + ch]); } }
        const float kkr = kv * C.kkw; const float ss = wave_sum(kkr * kkr); const float kk = kkr * (1.0f / sqrtf(fmaxf(ss, 1e-24f)));
        const float kd = kv * (1.0f + (ai - 1.0f) * C.kaw);
        const float ec = eprev * __expf(lw), en = 1.0f / ec;
        AI[tb * 72 + pj] = (bf16)f2bf(-kk * eprev); RI[tb * 72 + pj] = (bf16)f2bf(rv * ec);
        const bf16 bt = (bf16)f2bf(kk * ai * en), kt = (bf16)f2bf(kd * en);
        BI[tb * 72 + pj] = bt; KI[tb * 72 + pj] = kt;
        BKT[(tb >> 2) * 8 + (tb & 3)] = bt; BKT[(tb >> 2) * 8 + 4 + (tb & 3)] = kt;
        VT[tb] = (bf16)f2bf(vv);
        if (tb == 15) GAM[j] = ec;
        if constexpr (BONUS) { const float bs = wave_sum(rv * kv * C.rkw); const int pl = C.dir ? pos0_local - t : pos0_local + t;
            ((LAS bf16*)lds_vb)[pl * 64 + j] = (bf16)f2bf(vv); if (j == 0) lds_bon[pl] = bs; }
        eprev = ec; }
}
template <bool WANT_Y>
__device__ __forceinline__ void block_package(LAS unsigned char* img, int blk, LAS unsigned* pkg, int lane) {
    const int q = lane >> 4, c = lane & 15;
    f32x4 mab = {0.f, 0.f, 0.f, 0.f}, mak = mab, mbr = mab, mkr = mab;
#pragma unroll
    for (int k = 0; k < 2; ++k) { const int o = blk * 2304 + c * 144 + k * 64 + q * 16;
        const bf16x8 bi = *(const LAS bf16x8*)(img + IM_BI + o), ki = *(const LAS bf16x8*)(img + IM_KI + o), ai = *(const LAS bf16x8*)(img + IM_AI + o);
        mab = MFMA16(bi, ai, mab); mak = MFMA16(ki, ai, mak);
        if constexpr (WANT_Y) { const bf16x8 ri = *(const LAS bf16x8*)(img + IM_RI + o); mbr = MFMA16(bi, ri, mbr); mkr = MFMA16(ki, ri, mkr); } }
#pragma unroll
    for (int e = 0; e < 4; ++e) { const int s = 4 * q + e; if (!(s < c)) { mab[e] = 0.f; mak[e] = 0.f; } if (!(s <= c)) { mbr[e] = 0.f; mkr[e] = 0.f; } }
    float n[16];
    { LAS float* mf = (LAS float*)pkg;
#pragma unroll
      for (int e = 0; e < 4; ++e) mf[(4 * q + e) * 16 + c] = mab[e];
      asm volatile("s_waitcnt lgkmcnt(0)" ::: "memory");
#pragma unroll
      for (int s = 15; s >= 0; --s) { float acc = (c == s) ? 1.0f : 0.0f;
#pragma unroll
          for (int t = s + 1; t < 16; ++t) acc += mf[s * 16 + t] * n[t];
          n[s] = acc; }
      asm volatile("s_waitcnt lgkmcnt(0)" ::: "memory"); }
    float nq[4];
#pragma unroll
    for (int e = 0; e < 4; ++e) nq[e] = q == 0 ? n[e] : (q == 1 ? n[4 + e] : (q == 2 ? n[8 + e] : n[12 + e]));
    pkg[0 * 64 + lane] = cvtpk(nq[0], nq[1]); pkg[1 * 64 + lane] = cvtpk(nq[2], nq[3]);
    pkg[2 * 64 + lane] = cvtpk(mak[0], mak[1]); pkg[3 * 64 + lane] = cvtpk(mak[2], mak[3]);
    if constexpr (WANT_Y) { pkg[4 * 64 + lane] = cvtpk(mbr[0], mbr[1]); pkg[5 * 64 + lane] = cvtpk(mbr[2], mbr[3]); pkg[6 * 64 + lane] = cvtpk(mkr[0], mkr[1]); pkg[7 * 64 + lane] = cvtpk(mkr[2], mkr[3]); }
}
template <bool WANT_Y, bool HAS_V>
__device__ __forceinline__ f32x4 block_scan(LAS unsigned char* img, int blk, const LAS unsigned* pkg, f32x4 (&S)[4], int wq, int lane) {
    const int q = lane >> 4, c = lane & 15;
    bf16x8 Sb[2];
#pragma unroll
    for (int k = 0; k < 2; ++k) Sb[k] = mk8(cvtpk(S[2 * k][0], S[2 * k][1]), cvtpk(S[2 * k][2], S[2 * k][3]), cvtpk(S[2 * k + 1][0], S[2 * k + 1][1]), cvtpk(S[2 * k + 1][2], S[2 * k + 1][3]));
    v2u vpk = {0u, 0u};
    if constexpr (HAS_V) vpk = *(const LAS v2u*)(img + IM_VT + blk * 2560 + (c + 16 * wq) * 40 + q * 8);
    const int ao = blk * 2304 + c * 144 + q * 16;
    f32x4 rhs = {0.f, 0.f, 0.f, 0.f};
    rhs = MFMA16(*(const LAS bf16x8*)(img + IM_AI + ao), Sb[0], rhs); rhs = MFMA16(*(const LAS bf16x8*)(img + IM_AI + ao + 64), Sb[1], rhs);
    if constexpr (HAS_V) rhs = MFMA16(mk8(0u, 0u, pkg[2 * 64 + lane], pkg[3 * 64 + lane]), mk8(0u, 0u, vpk.x, vpk.y), rhs);
    f32x4 u = {0.f, 0.f, 0.f, 0.f};
    u = MFMA16(mk8(pkg[0 * 64 + lane], pkg[1 * 64 + lane], 0u, 0u), mk8(cvtpk(rhs[0], rhs[1]), cvtpk(rhs[2], rhs[3]), 0u, 0u), u);
    const bf16x8 UV = mk8(cvtpk(u[0], u[1]), cvtpk(u[2], u[3]), vpk.x, vpk.y);
    f32x4 y = {0.f, 0.f, 0.f, 0.f};
    if constexpr (WANT_Y) { y = MFMA16(*(const LAS bf16x8*)(img + IM_RI + ao), Sb[0], y); y = MFMA16(*(const LAS bf16x8*)(img + IM_RI + ao + 64), Sb[1], y);
        y = MFMA16(mk8(pkg[4 * 64 + lane], pkg[5 * 64 + lane], pkg[6 * 64 + lane], pkg[7 * 64 + lane]), UV, y); }
#pragma unroll
    for (int T = 0; T < 4; ++T) { const bf16x8 bkt = *(const LAS bf16x8*)(img + IM_BKT + blk * 5120 + (16 * T + c) * 80 + q * 16);
        S[T] = MFMA16(bkt, UV, S[T]); const f32x4 g = *(const LAS f32x4*)(img + IM_GAM + blk * 256 + (16 * T + 4 * q) * 4); S[T] = S[T] * g; }
    return y;
}
__device__ __forceinline__ unsigned char* sum_slot(Frame& F, int chain, int sc) { return F.ws + WS_SUM + (size_t)(chain * NSC + sc) * SUM_SLOT; }

__device__ __forceinline__ void rwkv_pass1_unit(Frame& F, int li, int u) {
    const int chain = u / (NSC - 1), sc = u % (NSC - 1);
    const int dir = chain / 12, b = (chain / 6) & 1, h = chain % 6;
    const bool isctx = sc < 2; const int scl = isctx ? sc : sc - 2;
    LAS unsigned char* img = F.lds + L_IMG0; LAS unsigned* pkg = (LAS unsigned*)(F.lds + L_PKG);
    ChainCtx C; chain_consts(C, li, dir, b, h, F.lane);
    const int q = F.lane >> 4, c = F.lane & 15, wq = F.wave & 3; const bool isA = F.wave >= 4;
    f32x4 S[4];
#pragma unroll
    for (int T = 0; T < 4; ++T)
#pragma unroll
        for (int e = 0; e < 4; ++e) S[T][e] = (isA && (16 * T + 4 * q + e == c + 16 * wq)) ? 1.0f : 0.0f;
#pragma unroll 1
    for (int rd = 0; rd < 4; ++rd) {
        __syncthreads();
        prep_round<4, false>(F, C, img, F.lane, F.wave, isctx, 128 * scl + 32 * rd, nullptr, nullptr, 0);
        __syncthreads();
        if (F.wave < 2) block_package<false>(img, F.wave, pkg + F.wave * 512, F.lane);
        __syncthreads();
#pragma unroll
        for (int blk = 0; blk < 2; ++blk) { if (isA) block_scan<false, false>(img, blk, pkg + blk * 512, S, wq, F.lane); else block_scan<false, true>(img, blk, pkg + blk * 512, S, wq, F.lane); }
    }
    unsigned char* slot = sum_slot(F, chain, sc);
    if (!isA) { f32x4* braw = (f32x4*)slot;
#pragma unroll
        for (int T = 0; T < 4; ++T) braw[(wq * 4 + T) * 64 + F.lane] = S[T]; }
    else { bf16* aim = (bf16*)(slot + 16384); const int kap = wq >> 1, e = (F.lane & 3) + 4 * (wq & 1), qc = c >> 2;
#pragma unroll
        for (int T = 0; T < 4; ++T)
#pragma unroll
            for (int r = 0; r < 4; ++r) { const int lc = (4 * q + r) + 16 * qc; aim[((T * 2 + kap) * 64 + lc) * 8 + e] = (bf16)f2bf(S[T][r]); } }
}
__device__ __forceinline__ void rwkv_pass2_chain(Frame& F, int chain) {
    if (F.wave >= 4) return;
    const int wq = F.wave;
    f32x4 S[4];
#pragma unroll
    for (int T = 0; T < 4; ++T) S[T] = (f32x4){0.f, 0.f, 0.f, 0.f};
#pragma unroll 1
    for (int sc = 0; sc < NSC; ++sc) {
        unsigned char* slot = sum_slot(F, chain, sc); f32x4* braw = (f32x4*)slot; const bf16* aim = (const bf16*)(slot + 16384);
        if (sc == NSC - 1) {
#pragma unroll
            for (int T = 0; T < 4; ++T) braw[(wq * 4 + T) * 64 + F.lane] = S[T];
            break; }
        f32x4 Bc[4]; bf16x8 af[4][2];
#pragma unroll
        for (int T = 0; T < 4; ++T) { Bc[T] = braw[(wq * 4 + T) * 64 + F.lane];
#pragma unroll
            for (int k = 0; k < 2; ++k) af[T][k] = *(const bf16x8*)(aim + ((T * 2 + k) * 64 + F.lane) * 8); }
        bf16x8 Sb[2];
#pragma unroll
        for (int k = 0; k < 2; ++k) Sb[k] = mk8(cvtpk(S[2 * k][0], S[2 * k][1]), cvtpk(S[2 * k][2], S[2 * k][3]), cvtpk(S[2 * k + 1][0], S[2 * k + 1][1]), cvtpk(S[2 * k + 1][2], S[2 * k + 1][3]));
#pragma unroll
        for (int T = 0; T < 4; ++T) { braw[(wq * 4 + T) * 64 + F.lane] = S[T]; f32x4 a = MFMA16(af[T][0], Sb[0], Bc[T]); S[T] = MFMA16(af[T][1], Sb[1], a); }
    }
}
__device__ __forceinline__ void rwkv_pass3_unit(Frame& F, int li, int u) {
    const int pc = u % NSC, bh = u / NSC, b = bh / 6, h = bh % 6;
    const bool isctx = pc < 2; const int pcl = isctx ? pc : pc - 2, nsc = isctx ? 2 : 64;
    const int dir = F.wave >> 2, wq = F.wave & 3, q = F.lane >> 4, c = F.lane & 15;
    const int sc = dir == 0 ? pc : (isctx ? 1 - pcl : 2 + 63 - pcl);
    const int scl = dir == 0 ? pcl : nsc - 1 - pcl;
    const int chain = dir * 12 + b * 6 + h;
    LAS unsigned char* img = F.lds + (dir ? L_IMG1 : L_IMG0); LAS unsigned* pkg = (LAS unsigned*)(F.lds + L_PKG) + dir * 1024;
    LAS float* YL = (LAS float*)(F.lds + L_YL); LAS unsigned char* VB = F.lds + L_VB; LAS float* BON = (LAS float*)(F.lds + L_BON);
    ChainCtx C; chain_consts(C, li, dir, b, h, F.lane);
    f32x4 S[4];
    { const f32x4* braw = (const f32x4*)sum_slot(F, chain, sc);
#pragma unroll
      for (int T = 0; T < 4; ++T) S[T] = braw[(wq * 4 + T) * 64 + F.lane]; }
    __syncthreads();
    for (int i = F.tid; i < 128 * 68; i += NTHR) YL[i] = 0.f;
#pragma unroll 1
    for (int rd = 0; rd < 4; ++rd) {
        __syncthreads();
        if (dir == 0) prep_round<8, true>(F, C, img, F.lane, wq, isctx, 128 * scl + 32 * rd, VB, BON, 32 * rd);
        else prep_round<8, false>(F, C, img, F.lane, wq, isctx, 128 * scl + 32 * rd, nullptr, nullptr, 0);
        __syncthreads();
        if (wq < 2) block_package<true>(img, wq, pkg + wq * 512, F.lane);
        __syncthreads();
#pragma unroll
        for (int blk = 0; blk < 2; ++blk) { const f32x4 y = block_scan<true, true>(img, blk, pkg + blk * 512, S, wq, F.lane);
#pragma unroll
            for (int e = 0; e < 4; ++e) { const int t = 32 * rd + 16 * blk + 4 * q + e; const int pl = dir ? 127 - t : t; YL[pl * 68 + c + 16 * wq] += y[e]; } }
    }
    __syncthreads();
    const int wv = F.wave; const int rbase = (isctx ? TL + b * CTX : b * SEQ) + 128 * pcl;
    const bf16* g2t = (const bf16*)(F.ws + WS_G2T) + (size_t)li * 384 * 128;
    f32x4 gate[4];
#pragma unroll
    for (int nt = 0; nt < 4; ++nt) gate[nt] = (f32x4){0.f, 0.f, 0.f, 0.f};
#pragma unroll
    for (int k = 0; k < 4; ++k) { const v4u zg = *(const v4u*)(zrow(F, rbase + 16 * wv + c) + ZG + 32 * k + 8 * q);
#define SG(x) (1.0f / (1.0f + __expf(-(x))))
        const bf16x8 a = mk8(pk2(SG(bflo(zg.x)), SG(bfhi(zg.x))), pk2(SG(bflo(zg.y)), SG(bfhi(zg.y))), pk2(SG(bflo(zg.z)), SG(bfhi(zg.z))), pk2(SG(bflo(zg.w)), SG(bfhi(zg.w))));
#undef SG
#pragma unroll
        for (int nt = 0; nt < 4; ++nt) { const bf16x8 bb = *(const bf16x8*)(g2t + (size_t)(64 * h + 16 * nt + c) * 128 + 32 * k + 8 * q); gate[nt] = MFMA16(a, bb, gate[nt]); } }
    bf16* mix = (bf16*)(F.ws + WS_H);
    float lg[4], lb[4];
#pragma unroll
    for (int nt = 0; nt < 4; ++nt) { lg[nt] = inp(I_LNG)[li * RW + 64 * h + 16 * nt + c]; lb[nt] = inp(I_LNB)[li * RW + 64 * h + 16 * nt + c]; }
#pragma unroll
    for (int e = 0; e < 4; ++e) { const int tl = 16 * wv + 4 * q + e;
        float yv[4], s = 0.f;
#pragma unroll
        for (int nt = 0; nt < 4; ++nt) { yv[nt] = YL[tl * 68 + 16 * nt + c]; s += yv[nt]; }
        s += __shfl_xor(s, 1); s += __shfl_xor(s, 2); s += __shfl_xor(s, 4); s += __shfl_xor(s, 8);
        const float mu = s * (1.0f / 64.0f); float v2 = 0.f;
#pragma unroll
        for (int nt = 0; nt < 4; ++nt) { yv[nt] -= mu; v2 += yv[nt] * yv[nt]; }
        v2 += __shfl_xor(v2, 1); v2 += __shfl_xor(v2, 2); v2 += __shfl_xor(v2, 4); v2 += __shfl_xor(v2, 8);
        const float rs = 1.0f / sqrtf(v2 * (1.0f / 64.0f) + GN_EPS); const float bon = BON[tl];
#pragma unroll
        for (int nt = 0; nt < 4; ++nt) { const float vv = bf2f(((const LAS bf16*)VB)[tl * 64 + 16 * nt + c]);
            const float o = (yv[nt] * rs * lg[nt] + lb[nt] + bon * vv) * gate[nt][e];
            mix[(size_t)(rbase + tl) * DM + 640 + 64 * h + 16 * nt + c] = (bf16)f2bf(o); } }
}

#define XB_TMO      128
#define XB_XCNT(j)  (256  + 64 * (j))
#define XB_XSUB(j)  (1280 + 64 * (j))
#define XB_XGEN(j)  (2304 + 64 * (j))
#define XB_TOP      3328
#define XB_TOPGEN   3392
#define XCD_BAR_WORDS 3456
#define XB_SPIN_CAP (1u << 23)
__device__ __forceinline__ unsigned xb_ld(unsigned* p)              { return __hip_atomic_load(p, __ATOMIC_RELAXED, __HIP_MEMORY_SCOPE_AGENT); }
__device__ __forceinline__ unsigned xb_add(unsigned* p, unsigned v) { return __hip_atomic_fetch_add(p, v, __ATOMIC_RELAXED, __HIP_MEMORY_SCOPE_AGENT); }
__device__ __forceinline__ unsigned xb_xcc_id() { return (unsigned)__builtin_amdgcn_s_getreg((3 << 11) | 20) & 0xFu; }
#define XB_SPIN(cond, bar) do { unsigned _sp = 0; while (cond) { __builtin_amdgcn_s_sleep(1); \
    if ((++_sp & 255u) == 0u) { if (xb_ld(&(bar)[XB_TMO])) break; if (_sp > XB_SPIN_CAP) { atomicAdd(&(bar)[XB_TMO], 1u); break; } } } } while (0)
struct XcdBarrier { unsigned* bar; unsigned x; volatile LAS unsigned* st; };
__device__ __forceinline__ XcdBarrier xcd_barrier_post(unsigned* bar, volatile LAS unsigned* st) {
    XcdBarrier b; b.bar = bar; b.x = xb_xcc_id(); b.st = st;
    if (threadIdx.x == 0) (void)xb_add(&bar[XB_XCNT(b.x)], 1u);
    return b;
}
__device__ __forceinline__ void xcd_barrier_complete(unsigned* bar, unsigned x, unsigned& nloc, unsigned& nx) {
    const unsigned G = gridDim.x * gridDim.y * gridDim.z;
    unsigned sum, cnt, mine, sp = 0u;
    for (;;) {
        sum = 0u; cnt = 0u; mine = 0u;
#pragma unroll
        for (unsigned j = 0; j < 16; ++j) { const unsigned c = xb_ld(&bar[XB_XCNT(j)]); sum += c; cnt += (c > 0u) ? 1u : 0u; mine = (j == x) ? c : mine; }
        if (sum == G) break;
        __builtin_amdgcn_s_sleep(1);
        if ((++sp & 255u) == 0u) { if (xb_ld(&bar[XB_TMO])) break; if (sp > XB_SPIN_CAP) { atomicAdd(&bar[XB_TMO], 1u); break; } }
    }
    nloc = mine > 0u ? mine : 1u; nx = cnt > 0u ? cnt : 1u;
}
__device__ __forceinline__ void xcd_barrier(const XcdBarrier& b) {
    asm volatile("s_waitcnt vmcnt(0)" ::: "memory");
    __syncthreads();
    if (threadIdx.x == 0) {
        unsigned* bar = b.bar;
        __builtin_amdgcn_s_waitcnt(0);
        unsigned nloc = b.st[0], nx = b.st[1];
        if (nloc == 0u) { xcd_barrier_complete(bar, b.x, nloc, nx); b.st[0] = nloc; b.st[1] = nx; }
        const unsigned old = xb_add(&bar[XB_XSUB(b.x)], 1u);
        const unsigned gen = old / nloc;
        if (old + 1u == (gen + 1u) * nloc) {
            __builtin_amdgcn_fence(__ATOMIC_RELEASE, "agent");
            asm volatile("s_waitcnt vmcnt(0)" ::: "memory");
            const unsigned og = xb_add(&bar[XB_TOP], 1u);
            const unsigned tg = og / nx;
            if (og + 1u == (tg + 1u) * nx) xb_add(&bar[XB_TOPGEN], 1u);
            else XB_SPIN(xb_ld(&bar[XB_TOPGEN]) == tg, bar);
            __builtin_amdgcn_fence(__ATOMIC_ACQUIRE, "agent");
            xb_add(&bar[XB_XGEN(b.x)], 1u);
            asm volatile("s_waitcnt vmcnt(0)" ::: "memory");
        } else {
            XB_SPIN(xb_ld(&bar[XB_XGEN(b.x)]) == gen, bar);
            __builtin_amdgcn_fence(__ATOMIC_ACQUIRE, "agent");
            asm volatile("s_waitcnt vmcnt(0)" ::: "memory");
        }
    }
    __syncthreads();
}

template <int KIND> __device__ __forceinline__ void run_phase(const Frame& F0, int li, int second) {
    Frame F;
    { int t = threadIdx.x; asm volatile("" : "+v"(t)); F.tid = t; F.lane = t & 63; F.wave = __builtin_amdgcn_readfirstlane(t >> 6);
      int g = F0.G, b = F0.bid; asm volatile("" : "+s"(g), "+s"(b)); F.G = g; F.bid = b;
      unsigned char* w = F0.ws; float* o = F0.out; asm volatile("" : "+s"(w), "+s"(o)); F.ws = w; F.out = o;
      unsigned l = (unsigned)(size_t)F0.lds; asm volatile("" : "+s"(l)); F.lds = (LAS unsigned char*)(size_t)l;
      asm volatile("" : "+s"(li), "+s"(second)); }
    float* modv = (float*)(F.ws + WS_MOD);
    float* xc = (float*)(F.ws + WS_XC);
    bf16* H = (bf16*)(F.ws + WS_H); bf16* ACT = (bf16*)(F.ws + WS_ACT); float* O = (float*)(F.ws + WS_O);
    const float* ng = inp(I_NORMG) + (size_t)li * 6 * DM; const float* mv = modv + (size_t)li * 3 * 9216;
    const bool last = li == 1;
    if constexpr (KIND == 100) { convert_weights(F, 0); mod_gemv(F); rope_tables(F); lora_transposes(F); }
    if constexpr (KIND == 101) { EArgs A{}; A.xl_src = inp(I_X); A.xc_src = inp(I_CTX); A.o = nullptr; A.hdst = H; A.modv_h = modv; A.shidx = 0; A.scidx = 1; A.gpre = inp(I_NORMG); A.nrows = TT; e_phase(F, A); }
    if constexpr (KIND == 0) {
        pg8::Gemm g{H, (const bf16*)(F.ws + (second ? WS_WI2 : WS_WI1)), (last && second) ? TL : TT, NWI, DM}; pg8::StaticOrder S; S.init(g.M, g.N, F.G, F.bid);
        pg8::EpiSwiglu E{ACT, FFNP}; pg8::gemm_phase<pg8::EpiSwiglu, pg8::StaticOrder, true, true>(F.lds, g, S, E, F.tid); }
    if constexpr (KIND == 1) {
        pg8::Gemm g{ACT, (const bf16*)(F.ws + (second ? WS_WO2 : WS_WO1)), (last && second) ? TL : TT, DM, FFNP}; pg8::StaticOrder S; S.init(g.M, g.N, F.G, F.bid);
        pg8::EpiF32 E{O, DM}; pg8::gemm_phase<pg8::EpiF32, pg8::StaticOrder, true, true>(F.lds, g, S, E, F.tid); }
    if constexpr (KIND == 2) {
        EArgs A{}; A.xl_src = li == 0 ? inp(I_X) : F.out; A.xc_src = li == 0 ? inp(I_CTX) : xc; A.xl_dst = F.out; A.xc_dst = xc; A.o = O; A.modv_g = mv; A.gidx = 2; A.gmul = 0.5f; A.gpost = ng + 1 * DM;
        A.hdst = H; A.modv_h = mv; A.shidx = 3; A.scidx = 4; A.gpre = ng + 2 * DM; A.nrows = TT; e_phase(F, A); }
    if constexpr (KIND == 3) {
        pg8::Gemm g{H, (const bf16*)(F.ws + WS_WIN), TT, INWP, DM}; pg8::StaticOrder S; S.init(g.M, g.N, F.G, F.bid);
        pg8::EpiBf16 E{ACT, INWP}; pg8::gemm_phase<pg8::EpiBf16, pg8::StaticOrder, true, true>(F.lds, g, S, E, F.tid); }
    if constexpr (KIND == 4) {
        for (int u = F.bid; u < 528; u += F.G) lora_unit(F, li, u);
        for (int u = F.bid; u < 256; u += F.G) fourier_a_unit(F, u);
        for (int u = F.bid; u < 64; u += F.G) rope_unit(F, u);
        if (li == 0) for (int u = F.bid; u < 16; u += F.G) fourier_ctx1_unit(F, u); }
    if constexpr (KIND == 5) {
        for (int u = F.bid; u < 24 * (NSC - 1); u += F.G) rwkv_pass1_unit(F, li, u);
        attn_v1(F, li); }
    if constexpr (KIND == 11) {
        if (F.bid < 24) rwkv_pass2_chain(F, F.bid);
        for (int u = F.bid; u < 256; u += F.G) fourier_c_unit(F, u);
        if (li == 0) for (int u = F.bid; u < 32; u += F.G) fourier_ctx2_unit(F, u); }
    if constexpr (KIND == 12) {
        for (int u = F.bid; u < 12 * NSC; u += F.G) { if (li == 1 && (u % NSC) < 2) continue; rwkv_pass3_unit(F, li, u); } }
    if constexpr (KIND == 6) {
        pg8::Gemm g{H, (const bf16*)(F.ws + WS_WOUT), last ? TL : TT, DM, DM}; pg8::StaticOrder S; S.init(g.M, g.N, F.G, F.bid);
        pg8::EpiF32 E{O, DM}; pg8::gemm_phase<pg8::EpiF32, pg8::StaticOrder, true, true>(F.lds, g, S, E, F.tid); }
    if constexpr (KIND == 7) {
        EArgs A{}; A.xl_src = F.out; A.xc_src = xc; A.xl_dst = F.out; A.xc_dst = xc; A.o = O; A.modv_g = mv; A.gidx = 5; A.gmul = 1.0f; A.gpost = ng + 3 * DM;
        A.hdst = H; A.modv_h = mv; A.shidx = 6; A.scidx = 7; A.gpre = ng + 4 * DM; A.nrows = last ? TL : TT; e_phase(F, A); }
    if constexpr (KIND == 10) {
        EArgs A{}; A.xl_src = F.out; A.xc_src = xc; A.xl_dst = F.out; A.xc_dst = xc; A.o = O; A.modv_g = mv; A.gidx = 8; A.gmul = 0.5f; A.gpost = ng + 5 * DM;
        if (!last) { A.hdst = H; A.modv_h = mv + 3 * 9216; A.shidx = 0; A.scidx = 1; A.gpre = ng + 6 * DM; }
        A.nrows = last ? TL : TT; e_phase(F, A);
        if (!last) { __syncthreads(); convert_weights(F, 1); } }
}
constexpr int MISC_OFF = 131072 + 320;
__global__ void __launch_bounds__(NTHR, 2) mega_one(Args args) {
    extern __shared__ __attribute__((aligned(16))) unsigned char lds[];
    Frame F; F.lds = (LAS unsigned char*)lds; F.tid = threadIdx.x; F.lane = F.tid & 63; F.wave = __builtin_amdgcn_readfirstlane(F.tid >> 6); F.G = gridDim.x; F.bid = blockIdx.x;
    F.out = args.out; F.ws = args.ws;
    volatile LAS unsigned* MISC = (volatile LAS unsigned*)(F.lds + MISC_OFF);
    if (F.tid < 32) MISC[F.tid] = 0u;
    __syncthreads();
    XcdBarrier bar = xcd_barrier_post((unsigned*)(F.ws + WS_CTL) + 4096, MISC + 8);
#define GRID_BAR() xcd_barrier(bar)
    run_phase<100>(F, 0, 0); GRID_BAR();
    run_phase<101>(F, 0, 0); GRID_BAR();
#pragma unroll 1
    for (int li = 0; li < 2; ++li) {
        run_phase<0>(F, li, 0); GRID_BAR();
        run_phase<1>(F, li, 0); GRID_BAR();
        run_phase<2>(F, li, 0); GRID_BAR();
        run_phase<3>(F, li, 0); GRID_BAR();
        run_phase<4>(F, li, 0); GRID_BAR();
        run_phase<5>(F, li, 0); GRID_BAR();
        run_phase<11>(F, li, 0); GRID_BAR();
        run_phase<12>(F, li, 0); GRID_BAR();
        run_phase<6>(F, li, 0); GRID_BAR();
        run_phase<7>(F, li, 0); GRID_BAR();
        run_phase<0>(F, li, 1); GRID_BAR();
        run_phase<1>(F, li, 1); GRID_BAR();
        run_phase<10>(F, li, 0); GRID_BAR();
    }
}

extern "C" void kernel_launch(void* const* d_in, const int* in_sizes, int n_in, void* d_out, int out_size, void* d_ws, size_t ws_size, hipStream_t stream) {
    static int ready = 0;
    if (!ready) {
        if (n_in != 25 || out_size != TL * DM || ws_size < WS_END) { fprintf(stderr, "kernel_launch: unexpected shapes (n_in %d out %d ws %zu)\n", n_in, out_size, ws_size); ready = -1; return; }
        if (hipFuncSetAttribute((const void*)mega_one, hipFuncAttributeMaxDynamicSharedMemorySize, LDS_BYTES) != hipSuccess) { fprintf(stderr, "kernel_launch: hipFuncSetAttribute failed\n"); ready = -1; return; }
        ready = 1;
    }
    if (ready < 0) return;
    if (hipMemsetAsync((char*)d_ws + WS_CTL, 0, 65536, stream) != hipSuccess) { fprintf(stderr, "kernel_launch: memset failed\n"); return; }
    Args a{};
    for (int i = 0; i < 25; ++i) a.in[i] = (const float*)d_in[i];
    a.out = (float*)d_out; a.ws = (unsigned char*)d_ws;
    hipLaunchKernelGGL(mega_one, dim3(256), dim3(NTHR), LDS_BYTES, stream, a);
}
```

```cpp
#include <hip/hip_runtime.h>
#include <cstdio>
#include <cstdint>

namespace pg8 {
#define PG8_LAS __attribute__((address_space(3)))
typedef unsigned short bf16_t;
typedef short bf16x8 __attribute__((ext_vector_type(8)));
typedef float f32x4 __attribute__((ext_vector_type(4)));
typedef unsigned u32x4 __attribute__((ext_vector_type(4)));
constexpr int BM = 256, BK = 64, HALF = 128, HTB = HALF * BK * 2, STAGE_BYTES = 8 * HTB, NXCD = 8, WGM = 8;

__host__ __device__ __forceinline__ int lds_byte(int r, int c) { const int st = (r >> 4) * 2 + (c >> 5), rr = r & 15, cc = c & 31, ob = rr * 64 + cc * 2; return st * 1024 + (ob ^ (((ob >> 9) & 1) << 5)); }
__host__ __device__ __forceinline__ void stage_rc(int b, int& R, int& C) { const int st = b / 1024, sb = b % 1024, swz = sb ^ (((sb >> 9) & 1) << 5); R = (st >> 1) * 16 + swz / 64; C = (st & 1) * 32 + (swz % 64) / 2; }
__host__ __device__ __forceinline__ int perm32(int rho) { const int n = rho >> 4, i = rho & 15; return 8 * (i >> 2) + 4 * n + (i & 3); }

struct Unit { int pm, pn; };
struct Gemm { const bf16_t* A; const bf16_t* Bt; int M, N, K; };

struct StaticOrder {
    int nM, nN, nwg, G, c;
    __host__ __device__ void init(int M, int N, int G_, int c_) { nM = M / BM; nN = N / BM; nwg = nM * nN; G = G_; c = c_; }
    __host__ __device__ bool next(int i, Unit& u) const {
        const long L = (long)i * G + c; if (L >= nwg) return false;
        int wgid = (int)L; { const int q = nwg / NXCD, r = nwg % NXCD, xcd = wgid % NXCD, off = wgid / NXCD; wgid = (xcd < r ? xcd * (q + 1) : r * (q + 1) + (xcd - r) * q) + off; }
        const int nig = WGM * nN, gid = wgid / nig, fm = gid * WGM, gsz = (nM - fm) < WGM ? (nM - fm) : WGM;
        u.pm = fm + ((wgid % nig) % gsz); u.pn = (wgid % nig) / gsz; return true;
    }
    __device__ __forceinline__ void a_ready(const Unit&) const {}
    __device__ __forceinline__ void done(const Unit&) const {}
};

__device__ __forceinline__ unsigned cvt_pk_bf16(float lo, float hi) { unsigned r; asm volatile("v_cvt_pk_bf16_f32 %0, %1, %2" : "=v"(r) : "v"(lo), "v"(hi)); return r; }

struct EpiBf16 {
    static constexpr bool PERM = true, AFTER_DRAIN = false;
    bf16_t* O; int ldc;
    __device__ __forceinline__ void operator()(const f32x4 (&acc)[2][2][4][2], const Unit& u, int wr, int wc, int fr, int fq) const {
        const int row0 = u.pm * BM + wr * 64 + fr; const int col0 = u.pn * BM + wc * 32 + 8 * fq;
#pragma unroll
        for (int ai = 0; ai < 2; ++ai)
#pragma unroll
            for (int m = 0; m < 4; ++m) { bf16_t* rowp = O + (size_t)(row0 + ai * HALF + m * 16) * ldc + col0;
#pragma unroll
                for (int bj = 0; bj < 2; ++bj) { const f32x4 v0 = acc[ai][bj][m][0], v1 = acc[ai][bj][m][1];
                    u32x4 w; w.x = cvt_pk_bf16(v0[0], v0[1]); w.y = cvt_pk_bf16(v0[2], v0[3]); w.z = cvt_pk_bf16(v1[0], v1[1]); w.w = cvt_pk_bf16(v1[2], v1[3]);
                    *(u32x4*)(rowp + bj * HALF) = w; } }
    }
};
struct EpiF32 {
    static constexpr bool PERM = true, AFTER_DRAIN = false;
    float* O; int ldc;
    __device__ __forceinline__ void operator()(const f32x4 (&acc)[2][2][4][2], const Unit& u, int wr, int wc, int fr, int fq) const {
        const int row0 = u.pm * BM + wr * 64 + fr; const int col0 = u.pn * BM + wc * 32 + 8 * fq;
#pragma unroll
        for (int ai = 0; ai < 2; ++ai)
#pragma unroll
            for (int m = 0; m < 4; ++m) { float* rowp = O + (size_t)(row0 + ai * HALF + m * 16) * ldc + col0;
#pragma unroll
                for (int bj = 0; bj < 2; ++bj) { *(f32x4*)(rowp + bj * HALF) = acc[ai][bj][m][0]; *(f32x4*)(rowp + bj * HALF + 4) = acc[ai][bj][m][1]; } }
    }
};
__device__ __forceinline__ float silu_f(float x) { return x * __builtin_amdgcn_rcpf(1.0f + __expf(-x)); }
struct EpiSwiglu {
    static constexpr bool PERM = true, AFTER_DRAIN = false;
    bf16_t* O; int ldc;
    __device__ __forceinline__ void operator()(const f32x4 (&acc)[2][2][4][2], const Unit& u, int wr, int wc, int fr, int fq) const {
        const int row0 = u.pm * BM + wr * 64 + fr; const int col0 = u.pn * HALF + wc * 32 + 8 * fq;
#pragma unroll
        for (int ai = 0; ai < 2; ++ai)
#pragma unroll
            for (int m = 0; m < 4; ++m) { bf16_t* rowp = O + (size_t)(row0 + ai * HALF + m * 16) * ldc + col0;
                const f32x4 g0 = acc[ai][0][m][0], g1 = acc[ai][0][m][1], u0 = acc[ai][1][m][0], u1 = acc[ai][1][m][1];
                u32x4 w; w.x = cvt_pk_bf16(silu_f(g0[0]) * u0[0], silu_f(g0[1]) * u0[1]); w.y = cvt_pk_bf16(silu_f(g0[2]) * u0[2], silu_f(g0[3]) * u0[3]);
                w.z = cvt_pk_bf16(silu_f(g1[0]) * u1[0], silu_f(g1[1]) * u1[1]); w.w = cvt_pk_bf16(silu_f(g1[2]) * u1[2], silu_f(g1[3]) * u1[3]);
                *(u32x4*)rowp = w; }
    }
};

template <class Epi, class Sched, bool ALIGN_EPI = false, bool SP2 = false>
__device__ __forceinline__ void gemm_phase(PG8_LAS unsigned char* lds, const Gemm g, const Sched& S, const Epi& E, const int tid) {
    const int wid = __builtin_amdgcn_readfirstlane(tid >> 6), lane = tid & 63, wr = wid >> 2, wc = wid & 3, fr = lane & 15, fq = lane >> 4;
    const int K = g.K, nt = K / BK;
    unsigned voffA[2], voffB[2];
#pragma unroll
    for (int i = 0; i < 2; ++i) { int R, C; stage_rc(tid * 16 + i * 8192, R, C); const int Rb = Epi::PERM ? ((R & ~31) + perm32(R & 31)) : R;
        voffA[i] = (unsigned)(R * K + C) * 2u; voffB[i] = (unsigned)(Rb * K + C) * 2u; }
    const size_t kstep = (size_t)(BK * 2);
    const size_t hstep = (size_t)HALF * K * 2;
    const size_t tstep = 2 * hstep;
    const unsigned ldsw = (unsigned)wid * 1024u;
    const int aoff = lds_byte(wr * 64 + fr, fq * 8), boff = lds_byte(wc * 32 + fr, fq * 8);
#define PG8_SA(b, h) (((b) * 2 + (h)) * HTB)
#define PG8_SB(b, h) ((4 + (b) * 2 + (h)) * HTB)
#define PG8_STAGE(bufoff, gbase, voff) do { _Pragma("unroll") for (int _i = 0; _i < 2; ++_i) \
        __builtin_amdgcn_global_load_lds((const unsigned*)((const char*)(gbase) + (voff)[_i]), (PG8_LAS unsigned*)(lds + (bufoff) + ldsw + _i * 8192), 16, 0, 0); } while (0)
#define PG8_LDA(dst, b, h) do { _Pragma("unroll") for (int m = 0; m < 4; ++m) _Pragma("unroll") for (int k = 0; k < 2; ++k) dst[m][k] = *(const PG8_LAS bf16x8*)(lds + PG8_SA(b, h) + aoff + m * 2048 + k * 1024); } while (0)
#define PG8_LDB(dst, b, h) do { _Pragma("unroll") for (int n = 0; n < 2; ++n) _Pragma("unroll") for (int k = 0; k < 2; ++k) dst[n][k] = *(const PG8_LAS bf16x8*)(lds + PG8_SB(b, h) + boff + n * 2048 + k * 1024); } while (0)
#define PG8_MMA(ai, bj, At, Bt) do { __builtin_amdgcn_s_setprio(1); _Pragma("unroll") for (int m = 0; m < 4; ++m) _Pragma("unroll") for (int n = 0; n < 2; ++n) _Pragma("unroll") for (int k = 0; k < 2; ++k) \
        acc[ai][bj][m][n] = __builtin_amdgcn_mfma_f32_16x16x32_bf16(Bt[n][k], At[m][k], acc[ai][bj][m][n], 0, 0, 0); __builtin_amdgcn_s_setprio(0); } while (0)
#define PG8_WAIT_V(n) asm volatile("s_waitcnt vmcnt(" #n ")" ::: "memory")
#define PG8_WAIT_L(n) asm volatile("s_waitcnt lgkmcnt(" #n ")" ::: "memory")
#define PG8_BAR __builtin_amdgcn_s_barrier()
#define PG8_SCHED __builtin_amdgcn_sched_barrier(0)
    Unit cur, nxt; int ui = 0;
    if (!S.next(0, cur)) return;
    f32x4 acc[2][2][4][2];
#pragma unroll
    for (int a = 0; a < 2; ++a)
#pragma unroll
        for (int b = 0; b < 2; ++b)
#pragma unroll
            for (int m = 0; m < 4; ++m)
#pragma unroll
                for (int n = 0; n < 2; ++n) acc[a][b][m][n] = (f32x4){0.f, 0.f, 0.f, 0.f};
    bf16x8 At[4][2], B0[2][2], B1[2][2];
    const char* cA = (const char*)g.A + (size_t)cur.pm * tstep; const char* cB = (const char*)g.Bt + (size_t)cur.pn * tstep;
    S.a_ready(cur);
    if constexpr (SP2) {
        PG8_STAGE(PG8_SB(0, 0), cB, voffB); PG8_STAGE(PG8_SB(0, 1), cB + hstep, voffB); PG8_STAGE(PG8_SA(0, 0), cA, voffA); PG8_STAGE(PG8_SA(0, 1), cA + hstep, voffA);
        if (wr == 1) PG8_BAR;
        PG8_WAIT_V(2); PG8_BAR;
        PG8_STAGE(PG8_SB(1, 0), cB + kstep, voffB); PG8_STAGE(PG8_SA(1, 0), cA + kstep, voffA); PG8_STAGE(PG8_SB(1, 1), cB + hstep + kstep, voffB);
        PG8_WAIT_V(6); PG8_BAR;
    } else {
        PG8_STAGE(PG8_SB(0, 0), cB, voffB); PG8_STAGE(PG8_SA(0, 0), cA, voffA); PG8_STAGE(PG8_SB(0, 1), cB + hstep, voffB); PG8_STAGE(PG8_SA(0, 1), cA + hstep, voffA);
        if (wr == 1) PG8_BAR;
        PG8_WAIT_V(4); PG8_BAR;
        PG8_STAGE(PG8_SB(1, 0), cB + kstep, voffB); PG8_STAGE(PG8_SA(1, 0), cA + kstep, voffA); PG8_STAGE(PG8_SB(1, 1), cB + hstep + kstep, voffB);
        PG8_WAIT_V(6); PG8_BAR;
    }
    for (;;) {
        const bool has_next = S.next(ui + 1, nxt);
        const char* nA = has_next ? (const char*)g.A + (size_t)nxt.pm * tstep : cA; const char* nB = has_next ? (const char*)g.Bt + (size_t)nxt.pn * tstep : cB;
        for (int t = 0; t < nt; t += 2) {
            const bool last = (t == nt - 2);
            const char* a1 = cA + (size_t)(t + 1) * kstep;
            const char* a2 = last ? nA : cA + (size_t)(t + 2) * kstep; const char* b2 = last ? nB : cB + (size_t)(t + 2) * kstep;
            const char* a3 = a2 + kstep; const char* b3 = b2 + kstep;
            if (last && has_next) S.a_ready(nxt);
            if constexpr (SP2) {
            PG8_LDB(B0, 0, 0); PG8_LDB(B1, 0, 1); PG8_SCHED; PG8_LDA(At, 0, 0); PG8_STAGE(PG8_SA(1, 1), a1 + hstep, voffA);
            PG8_WAIT_V(8); PG8_WAIT_L(0); PG8_BAR; PG8_MMA(0, 0, At, B0); PG8_MMA(0, 1, At, B1); PG8_BAR; PG8_SCHED;
            PG8_LDA(At, 0, 1); PG8_STAGE(PG8_SB(0, 0), b2, voffB); PG8_STAGE(PG8_SB(0, 1), b2 + hstep, voffB); PG8_STAGE(PG8_SA(0, 0), a2, voffA);
            PG8_WAIT_V(8); PG8_WAIT_L(0); PG8_BAR; PG8_MMA(1, 0, At, B0); PG8_MMA(1, 1, At, B1); PG8_BAR; PG8_SCHED;
            PG8_LDB(B0, 1, 0); PG8_LDB(B1, 1, 1); PG8_SCHED; PG8_LDA(At, 1, 0); PG8_STAGE(PG8_SA(0, 1), a2 + hstep, voffA);
            PG8_WAIT_V(8); PG8_WAIT_L(0); PG8_BAR; PG8_MMA(0, 0, At, B0); PG8_MMA(0, 1, At, B1); PG8_BAR; PG8_SCHED;
            PG8_LDA(At, 1, 1); PG8_STAGE(PG8_SB(1, 0), b3, voffB); PG8_STAGE(PG8_SB(1, 1), b3 + hstep, voffB); PG8_STAGE(PG8_SA(1, 0), a3, voffA);
            PG8_WAIT_V(8); PG8_WAIT_L(0); PG8_BAR; PG8_MMA(1, 0, At, B0); PG8_MMA(1, 1, At, B1); PG8_BAR; PG8_SCHED;
            } else {
            PG8_LDB(B0, 0, 0); PG8_SCHED; PG8_LDA(At, 0, 0); PG8_STAGE(PG8_SA(1, 1), a1 + hstep, voffA);
            PG8_WAIT_L(8); PG8_BAR; PG8_WAIT_L(0); PG8_MMA(0, 0, At, B0); PG8_BAR; PG8_SCHED;
            PG8_LDB(B1, 0, 1); PG8_STAGE(PG8_SB(0, 0), b2, voffB);
            PG8_BAR; PG8_WAIT_L(0); PG8_MMA(0, 1, At, B1); PG8_BAR;
            PG8_LDA(At, 0, 1); PG8_STAGE(PG8_SA(0, 0), a2, voffA);
            PG8_BAR; PG8_WAIT_L(0); PG8_MMA(1, 0, At, B0); PG8_BAR; PG8_SCHED;
            PG8_STAGE(PG8_SB(0, 1), b2 + hstep, voffB);
            PG8_WAIT_V(6); PG8_BAR; PG8_MMA(1, 1, At, B1); PG8_BAR;
            PG8_LDB(B0, 1, 0); PG8_SCHED; PG8_LDA(At, 1, 0); PG8_STAGE(PG8_SA(0, 1), a2 + hstep, voffA);
            PG8_WAIT_L(8); PG8_BAR; PG8_WAIT_L(0); PG8_MMA(0, 0, At, B0); PG8_BAR; PG8_SCHED;
            PG8_LDB(B1, 1, 1); PG8_STAGE(PG8_SB(1, 0), b3, voffB);
            PG8_BAR; PG8_WAIT_L(0); PG8_MMA(0, 1, At, B1); PG8_BAR;
            PG8_LDA(At, 1, 1); PG8_STAGE(PG8_SA(1, 0), a3, voffA);
            PG8_BAR; PG8_WAIT_L(0); PG8_MMA(1, 0, At, B0); PG8_BAR; PG8_SCHED;
            PG8_STAGE(PG8_SB(1, 1), b3 + hstep, voffB);
            PG8_WAIT_V(6); PG8_BAR; PG8_MMA(1, 1, At, B1); PG8_BAR;
            }
        }
        if constexpr (ALIGN_EPI) { if (wr == 0) PG8_BAR; }
        if constexpr (!Epi::AFTER_DRAIN) { E(acc, cur, wr, wc, fr, fq); S.done(cur); }
        if (!has_next) break;
#pragma unroll
        for (int a = 0; a < 2; ++a)
#pragma unroll
            for (int b = 0; b < 2; ++b)
#pragma unroll
                for (int m = 0; m < 4; ++m)
#pragma unroll
                    for (int n = 0; n < 2; ++n) acc[a][b][m][n] = (f32x4){0.f, 0.f, 0.f, 0.f};
        cur = nxt; cA = nA; cB = nB; ++ui;
        if constexpr (ALIGN_EPI) { if (wr == 1) PG8_BAR; }
    }
    PG8_WAIT_V(0);
    if constexpr (!ALIGN_EPI) { if (wr == 0) PG8_BAR; }
    PG8_BAR;
#undef PG8_SA
#undef PG8_SB
#undef PG8_STAGE
#undef PG8_LDA
#undef PG8_LDB
#undef PG8_MMA
#undef PG8_WAIT_V
#undef PG8_WAIT_L
#undef PG8_BAR
#undef PG8_SCHED
}
}

constexpr int NWAVES = 8, NTHR = 512;
constexpr int DM = 1024, SEQ = 8192, NB = 2, CTX = 256, TL = NB * SEQ, TC = NB * CTX, TT = TL + TC;
constexpr int FFN = 2752, FFNP = 2816, NWI = 5632, INW = 2432, INWP = 2560, NMOD = 9;
constexpr int ZF = 0, ZQ = 256, ZK = 640, ZV = 768, ZRR = 896, ZRK = 1280, ZRV = 1664, ZW = 2048, ZA = 2176, ZG = 2304;
constexpr int RW = 384;
constexpr float NORM_EPS = 1e-6f, GN_EPS = 64e-5f;

constexpr size_t MiB = 1u << 20;
constexpr size_t WS_CTL = 0, WS_MOD = 1 * MiB, WS_ROPE = 2 * MiB, WS_XC = 4 * MiB, WS_GC = 6 * MiB;
constexpr size_t WS_WI1 = 8 * MiB, WS_WO1 = 19 * MiB, WS_WIN = 25 * MiB, WS_WOUT = 30 * MiB, WS_WI2 = 32 * MiB, WS_WO2 = 43 * MiB;
constexpr size_t WS_H = 49 * MiB;
constexpr size_t WS_ACT = 82 * MiB;
constexpr size_t WS_O = 173 * MiB;
constexpr size_t WS_YD = WS_O, WS_QR = WS_O + 50 * MiB, WS_KR = WS_O + 62 * MiB;
constexpr size_t WS_W2T = WS_MOD + 256 * 1024, WS_A2T = WS_MOD + 512 * 1024, WS_G2T = WS_MOD + 768 * 1024;
constexpr size_t WS_LW = WS_O, WS_IC = WS_O + 25 * MiB;
constexpr size_t WS_FA = 239 * MiB;
constexpr size_t WS_SUM = 255 * MiB;
constexpr size_t WS_END = 293 * MiB;

constexpr int LDS_BYTES = 147456;

typedef unsigned short bf16;
typedef float f32x4 __attribute__((ext_vector_type(4)));
typedef unsigned v4u __attribute__((ext_vector_type(4)));
typedef unsigned v2u __attribute__((ext_vector_type(2)));
#define LAS __attribute__((address_space(3)))
#define LDS_WAIT() asm volatile("s_waitcnt lgkmcnt(0)" ::: "memory")

__device__ __forceinline__ unsigned f2bf(float f) { unsigned u = __builtin_bit_cast(unsigned, f); return (u + 0x7fffu + ((u >> 16) & 1u)) >> 16; }
__device__ __forceinline__ unsigned pk2(float lo, float hi) { return f2bf(lo) | (f2bf(hi) << 16); }
__device__ __forceinline__ float bf2f(unsigned short u) { return __builtin_bit_cast(float, (unsigned)u << 16); }
__device__ __forceinline__ float bflo(unsigned u) { return __builtin_bit_cast(float, u << 16); }
__device__ __forceinline__ float bfhi(unsigned u) { return __builtin_bit_cast(float, u & 0xffff0000u); }
__device__ __forceinline__ float wave_sum(float v) {
#pragma unroll
    for (int o = 1; o < 64; o <<= 1) v += __shfl_xor(v, o);
    return v;
}
__device__ __forceinline__ float wave_max(float v) {
#pragma unroll
    for (int o = 1; o < 64; o <<= 1) v = fmaxf(v, __shfl_xor(v, o));
    return v;
}

struct Args { const float* in[25]; float* out; unsigned char* ws; int ph_lo, ph_hi; };

struct Frame {
    LAS unsigned char* lds;
    int tid, lane, wave, G, bid;
    float* out; unsigned char* ws;
};
enum { I_X = 0, I_C, I_CTX, I_CCTX, I_MODW, I_MODB, I_NORMG, I_F1WI, I_F1WO, I_WIN, I_WOUT, I_SINK, I_CONV, I_W0, I_W2, I_A0, I_A2, I_G2, I_KK, I_KA, I_RK, I_LNG, I_LNB, I_F2WI, I_F2WO };

__device__ __forceinline__ const float* inp(int i) {
    const __attribute__((address_space(4))) char* p = (const __attribute__((address_space(4))) char*)__builtin_amdgcn_kernarg_segment_ptr();
    asm volatile("" : "+s"(p));
    return *(const float* const __attribute__((address_space(4)))*)(p + 8 * i);
}
__device__ __forceinline__ void cvt_item(const float* W, int ldw, int k0, int sc, bool valid, bf16* WT, int Kd, int n0d, LAS float* scr, int lane) {
#pragma unroll 8
    for (int i = 0; i < 32; ++i) { const int kk = 2 * i + (lane >> 5); scr[kk * 33 + (lane & 31)] = valid ? W[(size_t)(k0 + kk) * ldw + sc + (lane & 31)] : 0.f; }
    LDS_WAIT(); asm volatile("" ::: "memory");
    const int c = lane & 7;
#pragma unroll
    for (int j = 0; j < 4; ++j) { const int n = (lane >> 3) + 8 * j; const LAS float* s = scr + (8 * c) * 33 + n;
        v4u o; o.x = pk2(s[0 * 33], s[1 * 33]); o.y = pk2(s[2 * 33], s[3 * 33]); o.z = pk2(s[4 * 33], s[5 * 33]); o.w = pk2(s[6 * 33], s[7 * 33]);
        *(v4u*)(WT + (size_t)(n0d + n) * Kd + k0 + 8 * c) = o; }
    LDS_WAIT(); asm volatile("" ::: "memory");
}
__device__ __forceinline__ void convert_weights(Frame& F, int li) {
    LAS float* scr = (LAS float*)(F.lds + F.wave * 16384);
    const int gw = F.bid * NWAVES + F.wave, NGW = F.G * NWAVES;
    constexpr int I_WI = 16 * (NWI / 32), I_WO = (FFNP / 64) * 32, I_IN = 16 * (INWP / 32), I_OUT = 16 * 32;
    constexpr int NITEMS = 2 * I_WI + 2 * I_WO + I_IN + I_OUT;
    for (int it = gw; it < NITEMS; it += NGW) {
        int r = it;
        if (r < 2 * I_WI) { const int f = r / I_WI; r -= f * I_WI; const int nblk = NWI / 32, kb = r / nblk, nb = r % nblk;
            const int n0 = 32 * nb, pn = n0 >> 8, i = n0 & 255; const int j = 128 * pn + (i & 127); const bool valid = j < FFN; const int sc = (i < 128) ? j : FFN + j;
            cvt_item((f ? inp(I_F2WI) : inp(I_F1WI)) + (size_t)li * DM * 2 * FFN, 2 * FFN, 64 * kb, sc, valid, (bf16*)(F.ws + (f ? WS_WI2 : WS_WI1)), DM, n0, scr, F.lane); continue; }
        r -= 2 * I_WI;
        if (r < 2 * I_WO) { const int f = r / I_WO; r -= f * I_WO; const int kb = r / 32, nb = r % 32; const bool valid = 64 * kb < FFN;
            cvt_item((f ? inp(I_F2WO) : inp(I_F1WO)) + (size_t)li * FFN * DM, DM, 64 * kb, 32 * nb, valid, (bf16*)(F.ws + (f ? WS_WO2 : WS_WO1)), FFNP, 32 * nb, scr, F.lane); continue; }
        r -= 2 * I_WO;
        if (r < I_IN) { const int nblk = INWP / 32, kb = r / nblk, nb = r % nblk; const bool valid = 32 * nb < INW;
            cvt_item(inp(I_WIN) + (size_t)li * DM * INW, INW, 64 * kb, 32 * nb, valid, (bf16*)(F.ws + WS_WIN), DM, 32 * nb, scr, F.lane); continue; }
        r -= I_IN;
        { const int kb = r / 32, nb = r % 32;
            cvt_item(inp(I_WOUT) + (size_t)li * DM * DM, DM, 64 * kb, 32 * nb, true, (bf16*)(F.ws + WS_WOUT), DM, 32 * nb, scr, F.lane); }
    }
}
__device__ __forceinline__ void mod_gemv(Frame& F) {
    LAS float* sc = (LAS float*)F.lds;
    LAS float* red = sc + 3 * 1024;
    __syncthreads();
    for (int i = F.tid; i < 3 * 1024; i += NTHR) { const int v = i >> 10, k = i & 1023; const float x = v < 2 ? inp(I_C)[v * 1024 + k] : inp(I_CCTX)[k]; sc[i] = x / (1.0f + __expf(-x)); }
    __syncthreads();
    float* modv = (float*)(F.ws + WS_MOD);
    for (int u = F.bid; u < 2 * 72; u += F.G) {
        const int l = u / 72, n0 = (u % 72) * 128;
        const float* w = inp(I_MODW) + (size_t)l * DM * 9216 + n0 + 2 * F.lane;
        float a0 = 0.f, a1 = 0.f, b0 = 0.f, b1 = 0.f, c0 = 0.f, c1 = 0.f;
        const int k0 = F.wave * 128;
#pragma unroll 8
        for (int k = 0; k < 128; ++k) { const float2 wv = *(const float2*)(w + (size_t)(k0 + k) * 9216); const float s0 = sc[k0 + k], s1 = sc[1024 + k0 + k], s2 = sc[2048 + k0 + k];
            a0 += s0 * wv.x; a1 += s0 * wv.y; b0 += s1 * wv.x; b1 += s1 * wv.y; c0 += s2 * wv.x; c1 += s2 * wv.y; }
        LAS float* rw = red + F.wave * 384 + 2 * F.lane;
        rw[0] = a0; rw[1] = a1; rw[128] = b0; rw[129] = b1; rw[256] = c0; rw[257] = c1;
        __syncthreads();
        if (F.tid < 384) { float s = 0.f;
#pragma unroll
            for (int w8 = 0; w8 < 8; ++w8) s += red[w8 * 384 + F.tid];
            const int v = F.tid >> 7, n = n0 + (F.tid & 127);
            modv[(size_t)(l * 3 + v) * 9216 + n] = s + inp(I_MODB)[l * 9216 + n]; }
        __syncthreads();
    }
}
__device__ __forceinline__ void rope_tables(Frame& F) {
    float* ct = (float*)(F.ws + WS_ROPE); float* st = ct + SEQ * 32;
    for (int i = F.bid * NTHR + F.tid; i < SEQ * 32; i += F.G * NTHR) {
        const int t = i >> 5, j = i & 31; const int f = j & 15;
        const float inv = exp2f(-(float)f * (13.287712379549449f / 16.0f));
        const float pos = (float)(j < 16 ? (t >> 6) : (t & 63));
        const float ang = pos * inv;
        const double a = (double)ang; const double k = __builtin_rint(a * 0.15915494309189535); const float r = (float)(a - k * 6.283185307179586);
        ct[i] = __cosf(r); st[i] = __sinf(r);
    }
}

struct EArgs { const float* xl_src; const float* xc_src; float* xl_dst; float* xc_dst; const float* o; const float* modv_g; int gidx; float gmul; const float* gpost;
               bf16* hdst; const float* modv_h; int shidx, scidx; const float* gpre; int nrows; };
__device__ __forceinline__ void e_phase(Frame& F, const EArgs& A) {
    const int gw = F.bid * NWAVES + F.wave, NGW = F.G * NWAVES;
    for (int r = gw; r < A.nrows; r += NGW) {
        const int v = r < TL ? (r >> 13) : 2;
        const float* xs = r < TL ? A.xl_src + (size_t)r * DM : A.xc_src + (size_t)(r - TL) * DM;
        f32x4 x[4];
#pragma unroll
        for (int j = 0; j < 4; ++j) x[j] = ((const f32x4*)xs)[F.lane + 64 * j];
        if (A.o) {
            const f32x4* orow = (const f32x4*)(A.o + (size_t)r * DM); f32x4 ov[4]; float ss = 0.f;
#pragma unroll
            for (int j = 0; j < 4; ++j) { ov[j] = orow[F.lane + 64 * j]; ss += (ov[j].x * ov[j].x + ov[j].y * ov[j].y) + (ov[j].z * ov[j].z + ov[j].w * ov[j].w); }
            const float rstd = 1.0f / sqrtf(wave_sum(ss) * (1.0f / DM) + NORM_EPS) * A.gmul;
            const f32x4* gm = (const f32x4*)(A.modv_g + (size_t)v * 9216 + A.gidx * DM); const f32x4* gp = (const f32x4*)A.gpost;
            float* xd = r < TL ? A.xl_dst + (size_t)r * DM : A.xc_dst + (size_t)(r - TL) * DM;
#pragma unroll
            for (int j = 0; j < 4; ++j) { const f32x4 g = gm[F.lane + 64 * j], p = gp[F.lane + 64 * j]; x[j] = x[j] + g * (ov[j] * rstd * p); ((f32x4*)xd)[F.lane + 64 * j] = x[j]; }
        }
        if (A.hdst) {
            float ss = 0.f;
#pragma unroll
            for (int j = 0; j < 4; ++j) ss += (x[j].x * x[j].x + x[j].y * x[j].y) + (x[j].z * x[j].z + x[j].w * x[j].w);
            const float rstd = 1.0f / sqrtf(wave_sum(ss) * (1.0f / DM) + NORM_EPS);
            const f32x4* sh = (const f32x4*)(A.modv_h + (size_t)v * 9216 + A.shidx * DM); const f32x4* scl = (const f32x4*)(A.modv_h + (size_t)v * 9216 + A.scidx * DM); const f32x4* gp = (const f32x4*)A.gpre;
            v2u* hd = (v2u*)(A.hdst + (size_t)r * DM);
#pragma unroll
            for (int j = 0; j < 4; ++j) { const f32x4 s = sh[F.lane + 64 * j], c = scl[F.lane + 64 * j], p = gp[F.lane + 64 * j]; const f32x4 hv = (x[j] * rstd * p) * (1.0f + c) + s;
                v2u w; w.x = pk2(hv.x, hv.y); w.y = pk2(hv.z, hv.w); hd[F.lane + 64 * j] = w; }
        }
    }
}

__device__ __forceinline__ const bf16* zrow(const Frame& F, int row) { return (const bf16*)(F.ws + WS_ACT) + (size_t)row * INWP; }

__device__ __forceinline__ void rope_unit(Frame& F, int u) {
    const float* ct = (const float*)(F.ws + WS_ROPE); const float* st = ct + SEQ * 32;
    bf16* qr = (bf16*)(F.ws + WS_QR); bf16* kr = (bf16*)(F.ws + WS_KR);
    for (int i = F.tid; i < 256 * 8 * 32; i += NTHR) {
        const int j = i & 31, hh = (i >> 5) & 7, tok = u * 256 + (i >> 8);
        const int s = tok & (SEQ - 1);
        const bf16* z = zrow(F, tok);
        const int col = hh < 6 ? ZQ + 64 * hh : ZK + 64 * (hh - 6);
        const float x1 = bf2f(z[col + j]), x2 = bf2f(z[col + 32 + j]);
        const float c = ct[s * 32 + j], sn = st[s * 32 + j];
        float o1 = x1 * c - x2 * sn, o2 = x2 * c + x1 * sn;
        if (hh < 6) { o1 *= 0.125f; o2 *= 0.125f; qr[(size_t)tok * 384 + 64 * hh + j] = (bf16)f2bf(o1); qr[(size_t)tok * 384 + 64 * hh + 32 + j] = (bf16)f2bf(o2); }
        else { kr[(size_t)tok * 128 + 64 * (hh - 6) + j] = (bf16)f2bf(o1); kr[(size_t)tok * 128 + 64 * (hh - 6) + 32 + j] = (bf16)f2bf(o2); }
    }
}

__device__ __forceinline__ void fourier_a_unit(Frame& F, int u) {
    const int b = u >> 7, n2 = u & 127;
    LAS float* tab = (LAS float*)F.lds;
    __syncthreads();
    if (F.tid < 64) { const float a = (float)F.tid * (1.0f / 64.0f); tab[F.tid] = __builtin_amdgcn_cosf(a); tab[64 + F.tid] = __builtin_amdgcn_sinf(a); }
    __syncthreads();
    const int c = F.tid & 255, kh = F.tid >> 8;
    float f[64];
#pragma unroll
    for (int n1 = 0; n1 < 64; ++n1) f[n1] = bf2f(zrow(F, b * SEQ + 128 * n1 + n2)[ZF + c]);
    bf16* far = (bf16*)(F.ws + WS_FA); bf16* fai = far + (size_t)NB * 64 * 128 * 256;
    for (int kk = 0; kk < 32; ++kk) { const int k1 = kh * 32 + kk;
        float sr = 0.f, si = 0.f;
#pragma unroll
        for (int n1 = 0; n1 < 64; ++n1) { const int idx = (n1 * k1) & 63; sr += f[n1] * tab[idx]; si -= f[n1] * tab[64 + idx]; }
        const float tw = (float)(n2 * k1) * (1.0f / 8192.0f); const float tc = __builtin_amdgcn_cosf(tw), ts = -__builtin_amdgcn_sinf(tw);
        const size_t o = (((size_t)b * 64 + k1) * 128 + n2) * 256 + c;
        far[o] = (bf16)f2bf(sr * tc - si * ts); fai[o] = (bf16)f2bf(sr * ts + si * tc);
    }
}
__device__ __forceinline__ void fourier_c_unit(Frame& F, int u) {
    const int b = u >> 7, k1 = (u >> 1) & 63, half = u & 1;
    LAS float* tab = (LAS float*)F.lds;
    LAS float* tab64 = tab + 256;
    LAS float* P = tab + 512;
    __syncthreads();
    if (F.tid < 128) { const float a = (float)F.tid * (1.0f / 128.0f); tab[F.tid] = __builtin_amdgcn_cosf(a); tab[128 + F.tid] = __builtin_amdgcn_sinf(a); }
    if (F.tid >= 128 && F.tid < 192) { const float a = (float)(F.tid - 128) * (1.0f / 64.0f); tab64[F.tid - 128] = __builtin_amdgcn_cosf(a); tab64[64 + F.tid - 128] = __builtin_amdgcn_sinf(a); }
    __syncthreads();
    const int c = F.tid & 255, q = F.tid >> 8;
    const bf16* far = (const bf16*)(F.ws + WS_FA) + (((size_t)b * 64 + k1) * 128) * 256 + c; const bf16* fai = far + (size_t)NB * 64 * 128 * 256;
    float ar[32], ai[32];
#pragma unroll
    for (int i = 0; i < 32; ++i) { ar[i] = 0.f; ai[i] = 0.f; }
    const int k2b = 64 * half + 32 * q;
    for (int n2 = 0; n2 < 128; ++n2) { const float xr = bf2f(far[(size_t)n2 * 256]), xi = bf2f(fai[(size_t)n2 * 256]);
#pragma unroll
        for (int i = 0; i < 32; ++i) { const int idx = (n2 * (k2b + i)) & 127; const float cs = tab[idx], sn = tab[128 + idx];
            ar[i] += xr * cs + xi * sn; ai[i] += xi * cs - xr * sn; } }
    bf16* mix = (bf16*)(F.ws + WS_H);
    const int g = c >> 6;
    float y[32];
#pragma unroll
    for (int i = 0; i < 32; ++i) y[i] = 0.f;
#pragma unroll
    for (int rnd = 0; rnd < 2; ++rnd) {
        __syncthreads();
#pragma unroll
        for (int i = 0; i < 32; ++i) P[(32 * q + i) * 256 + c] = rnd == 0 ? ar[i] : ai[i];
        __syncthreads();
        const int m = c & 63;
        for (int cc = 0; cc < 64; ++cc) { const int idx = (m * cc) & 63; const float t = rnd == 0 ? tab64[idx] : tab64[64 + idx];
#pragma unroll
            for (int i = 0; i < 32; ++i) y[i] += P[(32 * q + i) * 256 + 64 * g + cc] * t; }
    }
    const float scale = 0.0013810679320049757f;
#pragma unroll
    for (int i = 0; i < 32; ++i) { const int k = k1 + 64 * (k2b + i); mix[(size_t)(b * SEQ + k) * DM + c] = (bf16)f2bf(y[i] * scale); }
}
__device__ __forceinline__ void fourier_ctx1_unit(Frame& F, int u) {
    float* gr = (float*)(F.ws + WS_GC); float* gi = gr + TC * 256;
    for (int i = F.tid; i < 32 * 256; i += NTHR) { const int tok = u * 32 + (i >> 8), gm = i & 255, g = gm >> 6, m = gm & 63;
        const bf16* z = zrow(F, TL + tok) + ZF + 64 * g; float sr = 0.f, si = 0.f;
        for (int c = 0; c < 64; ++c) { const float a = (float)((m * c) & 63) * (1.0f / 64.0f); const float x = bf2f(z[c]); sr += x * __builtin_amdgcn_cosf(a); si -= x * __builtin_amdgcn_sinf(a); }
        gr[tok * 256 + gm] = sr; gi[tok * 256 + gm] = si; }
}
__device__ __forceinline__ void fourier_ctx2_unit(Frame& F, int u) {
    const float* gr = (const float*)(F.ws + WS_GC); const float* gi = gr + TC * 256; bf16* mix = (bf16*)(F.ws + WS_H);
    const int b = u >> 4, kb = (u & 15) * 16;
    for (int i = F.tid; i < 16 * 256; i += NTHR) { const int k = kb + (i >> 8), gm = i & 255; float y = 0.f;
        for (int n = 0; n < 256; ++n) { const float a = (float)((k * n) & 255) * (1.0f / 256.0f); y += gr[(b * 256 + n) * 256 + gm] * __builtin_amdgcn_cosf(a) + gi[(b * 256 + n) * 256 + gm] * __builtin_amdgcn_sinf(a); }
        mix[(size_t)(TL + b * 256 + k) * DM + gm] = (bf16)f2bf(y * 0.0078125f); }
}

__device__ __forceinline__ float dot64(const float (&q)[64], const bf16* krow) {
    float s = 0.f;
#pragma unroll
    for (int i = 0; i < 8; ++i) { const v4u w = ((const v4u*)krow)[i];
        s += q[8 * i + 0] * bflo(w.x) + q[8 * i + 1] * bfhi(w.x) + q[8 * i + 2] * bflo(w.y) + q[8 * i + 3] * bfhi(w.y) + q[8 * i + 4] * bflo(w.z) + q[8 * i + 5] * bfhi(w.z) + q[8 * i + 6] * bflo(w.w) + q[8 * i + 7] * bfhi(w.w); }
    return s;
}
__device__ __forceinline__ void attn_v1(Frame& F, int li) {
    const int gw = F.bid * NWAVES + F.wave, NGW = F.G * NWAVES;
    const bf16* qr = (const bf16*)(F.ws + WS_QR); const bf16* kr = (const bf16*)(F.ws + WS_KR); bf16* mix = (bf16*)(F.ws + WS_H);
    const float* sink = inp(I_SINK) + li * 6;
    const int npairs = (li == 0 ? TT : TL) * 6;
    for (int p = gw; p < npairs; p += NGW) {
        const int row = p / 6, hq = p % 6, kvh = hq / 3; const bool isctx = row >= TL;
        const int b = isctx ? (row - TL) >> 8 : row >> 13, s = row & (SEQ - 1);
        float q[64];
        if (!isctx) {
#pragma unroll
            for (int i = 0; i < 8; ++i) { const v4u w = ((const v4u*)(qr + (size_t)row * 384 + 64 * hq))[i];
                q[8 * i] = bflo(w.x); q[8 * i + 1] = bfhi(w.x); q[8 * i + 2] = bflo(w.y); q[8 * i + 3] = bfhi(w.y); q[8 * i + 4] = bflo(w.z); q[8 * i + 5] = bfhi(w.z); q[8 * i + 6] = bflo(w.w); q[8 * i + 7] = bfhi(w.w); }
        } else {
#pragma unroll
            for (int i = 0; i < 8; ++i) { const v4u w = ((const v4u*)(zrow(F, row) + ZQ + 64 * hq))[i];
                q[8 * i] = 0.125f * bflo(w.x); q[8 * i + 1] = 0.125f * bfhi(w.x); q[8 * i + 2] = 0.125f * bflo(w.y); q[8 * i + 3] = 0.125f * bfhi(w.y); q[8 * i + 4] = 0.125f * bflo(w.z); q[8 * i + 5] = 0.125f * bfhi(w.z); q[8 * i + 6] = 0.125f * bflo(w.w); q[8 * i + 7] = 0.125f * bfhi(w.w); }
        }
        float sc[9]; int krow_[9];
        const float NEG = -INFINITY;
        float mx = sink[hq];
#pragma unroll
        for (int r = 0; r < 9; ++r) {
            if (r < 5) {
                const int kp = s - 128 + 64 * r + F.lane; const bool ok = !isctx && kp >= 0 && kp < SEQ && kp <= s + 128;
                const int kc = ok ? kp : 0; krow_[r] = b * SEQ + kc;
                const float d = isctx ? 0.f : dot64(q, kr + (size_t)(b * SEQ + kc) * 128 + 64 * kvh);
                sc[r] = ok ? d : NEG;
            } else {
                const int kc = 64 * (r - 5) + F.lane; krow_[r] = TL + b * CTX + kc;
                sc[r] = dot64(q, zrow(F, TL + b * CTX + kc) + ZK + 64 * kvh);
            }
            mx = fmaxf(mx, sc[r]);
        }
        mx = wave_max(mx);
        float den = 0.f;
#pragma unroll
        for (int r = 0; r < 9; ++r) { sc[r] = __expf(sc[r] - mx); den += sc[r]; }
        den = wave_sum(den) + __expf(sink[hq] - mx);
        float acc = 0.f;
#pragma unroll
        for (int r = 0; r < 9; ++r) {
            if (r < 5 && isctx) continue;
            for (int kk = 0; kk < 64; ++kk) { const float pk = __builtin_bit_cast(float, __builtin_amdgcn_readlane(__builtin_bit_cast(int, sc[r]), kk)); const int kr_ = __builtin_amdgcn_readlane(krow_[r], kk);
                acc += pk * bf2f(zrow(F, kr_)[ZV + 64 * kvh + F.lane]); }
        }
        mix[(size_t)row * DM + 256 + 64 * hq + F.lane] = (bf16)f2bf(acc / den);
    }
}

typedef short bf16x8 __attribute__((ext_vector_type(8)));
#define MFMA16(a, b, c) __builtin_amdgcn_mfma_f32_16x16x32_bf16(a, b, c, 0, 0, 0)
__device__ __forceinline__ bf16x8 mk8(unsigned a, unsigned b, unsigned c, unsigned d) { const v4u v = {a, b, c, d}; return __builtin_bit_cast(bf16x8, v); }
typedef __bf16 bf16x2_t __attribute__((ext_vector_type(2)));
typedef float f32x2_t __attribute__((ext_vector_type(2)));
__device__ __forceinline__ unsigned cvtpk(float lo, float hi) { const f32x2_t f = {lo, hi}; return __builtin_bit_cast(unsigned, __builtin_convertvector(f, bf16x2_t)); }
constexpr int NSC = 66;
constexpr int IM_AI = 0, IM_RI = 4608, IM_BI = 9216, IM_KI = 13824, IM_BKT = 18432, IM_VT = 28672, IM_GAM = 33792, IMG_BYTES = 34816;
constexpr int L_IMG0 = 0, L_IMG1 = IMG_BYTES, L_PKG = 2 * IMG_BYTES, L_YL = L_PKG + 8192, L_VB = L_YL + 128 * 68 * 4, L_BON = L_VB + 128 * 64 * 2, L_RW_END = L_BON + 512;
static_assert(L_RW_END <= 131072, "rwkv LDS map");
constexpr size_t SUM_SLOT = 24576;

__device__ __forceinline__ void lora_transposes(Frame& F) {
    bf16* w2t = (bf16*)(F.ws + WS_W2T); bf16* a2t = (bf16*)(F.ws + WS_A2T); bf16* g2t = (bf16*)(F.ws + WS_G2T);
    const float* w2 = inp(I_W2); const float* a2 = inp(I_A2); const float* g2 = inp(I_G2);
    for (int i = F.bid * NTHR + F.tid; i < 4 * 384 * 64; i += F.G * NTHR) { const int r = i & 63, col = (i >> 6) % 384, ld = i / (384 * 64);
        w2t[i] = (bf16)f2bf(w2[((size_t)ld * 64 + r) * RW + col]); a2t[i] = (bf16)f2bf(a2[((size_t)ld * 64 + r) * RW + col]); }
    for (int i = F.bid * NTHR + F.tid; i < 2 * 384 * 128; i += F.G * NTHR) { const int r = i & 127, col = (i >> 7) % 384, l = i / (384 * 128);
        g2t[i] = (bf16)f2bf(g2[((size_t)l * 128 + r) * RW + col]); }
}

__device__ __forceinline__ float softplus_fast(float x) { return fmaxf(x, 0.f) + __logf(1.0f + __expf(-fabsf(x))); }
__device__ __forceinline__ void lora_unit(Frame& F, int li, int u) {
    const int dir = u & 1, r0 = (u >> 1) * 64, q = F.lane >> 4, c16 = F.lane & 15;
    bf16* LW = (bf16*)(F.ws + WS_LW) + (size_t)dir * TT * RW; bf16* IC = (bf16*)(F.ws + WS_IC) + (size_t)dir * TT * RW;
    const bf16* w2t = (const bf16*)(F.ws + WS_W2T) + (size_t)(li * 2 + dir) * 384 * 64; const bf16* a2t = (const bf16*)(F.ws + WS_A2T) + (size_t)(li * 2 + dir) * 384 * 64;
    bf16x8 bw[4][2], ba[4][2];
#pragma unroll
    for (int rt = 0; rt < 4; ++rt)
#pragma unroll
        for (int k = 0; k < 2; ++k) { const bf16* z = zrow(F, r0 + 16 * rt + c16);
            const v4u zw = *(const v4u*)(z + ZW + 64 * dir + 32 * k + 8 * q); ba[rt][k] = *(const bf16x8*)(z + ZA + 64 * dir + 32 * k + 8 * q);
            bw[rt][k] = mk8(pk2(tanhf(bflo(zw.x)), tanhf(bfhi(zw.x))), pk2(tanhf(bflo(zw.y)), tanhf(bfhi(zw.y))), pk2(tanhf(bflo(zw.z)), tanhf(bfhi(zw.z))), pk2(tanhf(bflo(zw.w)), tanhf(bfhi(zw.w)))); }
#pragma unroll 1
    for (int cti = 0; cti < 3; ++cti) { const int ct = 3 * F.wave + cti; const int col = 16 * ct + c16;
        bf16x8 aw[2], aa[2];
#pragma unroll
        for (int k = 0; k < 2; ++k) { aw[k] = *(const bf16x8*)(w2t + (size_t)col * 64 + 32 * k + 8 * q); aa[k] = *(const bf16x8*)(a2t + (size_t)col * 64 + 32 * k + 8 * q); }
        const f32x4 w0v = *(const f32x4*)(inp(I_W0) + (li * 2 + dir) * RW + 16 * ct + 4 * q); const f32x4 a0v = *(const f32x4*)(inp(I_A0) + (li * 2 + dir) * RW + 16 * ct + 4 * q);
#pragma unroll
        for (int rt = 0; rt < 4; ++rt) { f32x4 dw = {0.f, 0.f, 0.f, 0.f}, da = {0.f, 0.f, 0.f, 0.f};
#pragma unroll
            for (int k = 0; k < 2; ++k) { dw = MFMA16(aw[k], bw[rt][k], dw); da = MFMA16(aa[k], ba[rt][k], da); }
            float lw[4], ic[4];
#pragma unroll
            for (int e = 0; e < 4; ++e) { const float x = w0v[e] + dw[e]; const float wl = -softplus_fast(-x) - 0.5f; lw[e] = -__expf(wl); ic[e] = 1.0f / (1.0f + __expf(-(a0v[e] + da[e]))); }
            const size_t o = (size_t)(r0 + 16 * rt + c16) * RW + 16 * ct + 4 * q;
            v2u w; w.x = pk2(lw[0], lw[1]); w.y = pk2(lw[2], lw[3]); *(v2u*)(LW + o) = w; w.x = pk2(ic[0], ic[1]); w.y = pk2(ic[2], ic[3]); *(v2u*)(IC + o) = w; }
    }
}

struct ChainCtx { int dir, b, h, li; float kkw, kaw, rkw; float cw[3][3]; };
__device__ __forceinline__ void chain_consts(ChainCtx& C, int li, int dir, int b, int h, int j) {
    C.dir = dir; C.b = b; C.h = h; C.li = li; const int ch = 64 * h + j;
    C.kkw = inp(I_KK)[li * RW + ch]; C.kaw = inp(I_KA)[li * RW + ch]; C.rkw = inp(I_RK)[li * RW + ch];
#pragma unroll
    for (int t = 0; t < 3; ++t)
#pragma unroll
        for (int qq = 0; qq < 3; ++qq) C.cw[t][qq] = inp(I_CONV)[(size_t)(li * 3 + t) * (3 * RW) + qq * RW + ch];
}
template <int TPT, bool BONUS>
__device__ __forceinline__ void prep_round(Frame& F, const ChainCtx& C, LAS unsigned char* img, int j, int tg, bool isctx, int step0, LAS unsigned char* lds_vb, LAS float* lds_bon, int pos0_local) {
    const int L = isctx ? CTX : SEQ, rbase = isctx ? TL + C.b * CTX : C.b * SEQ, ch = 64 * C.h + j;
    const bf16* LW = (const bf16*)(F.ws + WS_LW) + (size_t)C.dir * TT * RW + ch; const bf16* IC = (const bf16*)(F.ws + WS_IC) + (size_t)C.dir * TT * RW + ch;
    const int tok0 = tg * TPT, blk = tok0 >> 4;
    float cum = 0.f;
    for (int t = blk * 16; t < tok0; ++t) { const int s = step0 + t; const int p = C.dir ? L - 1 - s : s; cum += bf2f(LW[(size_t)(rbase + p) * RW]); }
    float eprev = __expf(cum);
    const int pj = (j & ~31) | (((j & 15) >> 2) << 3) | (((j >> 4) & 1) << 2) | (j & 3);
    LAS bf16* AI = (LAS bf16*)(img + IM_AI) + blk * 1152, *RI = (LAS bf16*)(img + IM_RI) + blk * 1152, *BI = (LAS bf16*)(img + IM_BI) + blk * 1152, *KI = (LAS bf16*)(img + IM_KI) + blk * 1152;
    LAS bf16* BKT = (LAS bf16*)(img + IM_BKT) + blk * 2560 + j * 40; LAS bf16* VT = (LAS bf16*)(img + IM_VT) + blk * 1280 + j * 20; LAS float* GAM = (LAS float*)(img + IM_GAM) + blk * 64;
#pragma unroll 2
    for (int u = 0; u < TPT; ++u) { const int t = tok0 + u, tb = t & 15; const int s = step0 + t; const int p = C.dir ? L - 1 - s : s; const int row = rbase + p;
        const float lw = bf2f(LW[(size_t)row * RW]), ai = bf2f(IC[(size_t)row * RW]);
        float rv = 0.f, kv = 0.f, vv = 0.f;
#pragma unroll
        for (int tt = 0; tt < 3; ++tt) { const int pp = p + tt - 1; if (pp >= 0 && pp < L) { const bf16* z = zrow(F, rbase + pp); rv += C.cw[tt][0] * bf2f(z[ZRR + ch]); kv += C.cw[tt][1] * bf2f(z[ZRK + ch]); vv += C.cw[tt][2] * bf2f(z[ZRV + ch]); } }
        const float kkr = kv * C.kkw; const float ss = wave_sum(kkr * kkr); const float kk = kkr * (1.0f / sqrtf(fmaxf(ss, 1e-24f)));
        const float kd = kv * (1.0f + (ai - 1.0f) * C.kaw);
        const float ec = eprev * __expf(lw), en = 1.0f / ec;
        AI[tb * 72 + pj] = (bf16)f2bf(-kk * eprev); RI[tb * 72 + pj] = (bf16)f2bf(rv * ec);
        const bf16 bt = (bf16)f2bf(kk * ai * en), kt = (bf16)f2bf(kd * en);
        BI[tb * 72 + pj] = bt; KI[tb * 72 + pj] = kt;
        BKT[(tb >> 2) * 8 + (tb & 3)] = bt; BKT[(tb >> 2) * 8 + 4 + (tb & 3)] = kt;
        VT[tb] = (bf16)f2bf(vv);
        if (tb == 15) GAM[j] = ec;
        if constexpr (BONUS) { const float bs = wave_sum(rv * kv * C.rkw); const int pl = C.dir ? pos0_local - t : pos0_local + t;
            ((LAS bf16*)lds_vb)[pl * 64 + j] = (bf16)f2bf(vv); if (j == 0) lds_bon[pl] = bs; }
        eprev = ec; }
}
template <bool WANT_Y>
__device__ __forceinline__ void block_package(LAS unsigned char* img, int blk, LAS unsigned* pkg, int lane) {
    const int q = lane >> 4, c = lane & 15;
    f32x4 mab = {0.f, 0.f, 0.f, 0.f}, mak = mab, mbr = mab, mkr = mab;
#pragma unroll
    for (int k = 0; k < 2; ++k) { const int o = blk * 2304 + c * 144 + k * 64 + q * 16;
        const bf16x8 bi = *(const LAS bf16x8*)(img + IM_BI + o), ki = *(const LAS bf16x8*)(img + IM_KI + o), ai = *(const LAS bf16x8*)(img + IM_AI + o);
        mab = MFMA16(bi, ai, mab); mak = MFMA16(ki, ai, mak);
        if constexpr (WANT_Y) { const bf16x8 ri = *(const LAS bf16x8*)(img + IM_RI + o); mbr = MFMA16(bi, ri, mbr); mkr = MFMA16(ki, ri, mkr); } }
#pragma unroll
    for (int e = 0; e < 4; ++e) { const int s = 4 * q + e; if (!(s < c)) { mab[e] = 0.f; mak[e] = 0.f; } if (!(s <= c)) { mbr[e] = 0.f; mkr[e] = 0.f; } }
    float n[16];
    { LAS float* mf = (LAS float*)pkg;
#pragma unroll
      for (int e = 0; e < 4; ++e) mf[(4 * q + e) * 16 + c] = mab[e];
      asm volatile("s_waitcnt lgkmcnt(0)" ::: "memory");
#pragma unroll
      for (int s = 15; s >= 0; --s) { float acc = (c == s) ? 1.0f : 0.0f;
#pragma unroll
          for (int t = s + 1; t < 16; ++t) acc += mf[s * 16 + t] * n[t];
          n[s] = acc; }
      asm volatile("s_waitcnt lgkmcnt(0)" ::: "memory"); }
    float nq[4];
#pragma unroll
    for (int e = 0; e < 4; ++e) nq[e] = q == 0 ? n[e] : (q == 1 ? n[4 + e] : (q == 2 ? n[8 + e] : n[12 + e]));
    pkg[0 * 64 + lane] = cvtpk(nq[0], nq[1]); pkg[1 * 64 + lane] = cvtpk(nq[2], nq[3]);
    pkg[2 * 64 + lane] = cvtpk(mak[0], mak[1]); pkg[3 * 64 + lane] = cvtpk(mak[2], mak[3]);
    if constexpr (WANT_Y) { pkg[4 * 64 + lane] = cvtpk(mbr[0], mbr[1]); pkg[5 * 64 + lane] = cvtpk(mbr[2], mbr[3]); pkg[6 * 64 + lane] = cvtpk(mkr[0], mkr[1]); pkg[7 * 64 + lane] = cvtpk(mkr[2], mkr[3]); }
}
template <bool WANT_Y, bool HAS_V>
__device__ __forceinline__ f32x4 block_scan(LAS unsigned char* img, int blk, const LAS unsigned* pkg, f32x4 (&S)[4], int wq, int lane) {
    const int q = lane >> 4, c = lane & 15;
    bf16x8 Sb[2];
#pragma unroll
    for (int k = 0; k < 2; ++k) Sb[k] = mk8(cvtpk(S[2 * k][0], S[2 * k][1]), cvtpk(S[2 * k][2], S[2 * k][3]), cvtpk(S[2 * k + 1][0], S[2 * k + 1][1]), cvtpk(S[2 * k + 1][2], S[2 * k + 1][3]));
    v2u vpk = {0u, 0u};
    if constexpr (HAS_V) vpk = *(const LAS v2u*)(img + IM_VT + blk * 2560 + (c + 16 * wq) * 40 + q * 8);
    const int ao = blk * 2304 + c * 144 + q * 16;
    f32x4 rhs = {0.f, 0.f, 0.f, 0.f};
    rhs = MFMA16(*(const LAS bf16x8*)(img + IM_AI + ao), Sb[0], rhs); rhs = MFMA16(*(const LAS bf16x8*)(img + IM_AI + ao + 64), Sb[1], rhs);
    if constexpr (HAS_V) rhs = MFMA16(mk8(0u, 0u, pkg[2 * 64 + lane], pkg[3 * 64 + lane]), mk8(0u, 0u, vpk.x, vpk.y), rhs);
    f32x4 u = {0.f, 0.f, 0.f, 0.f};
    u = MFMA16(mk8(pkg[0 * 64 + lane], pkg[1 * 64 + lane], 0u, 0u), mk8(cvtpk(rhs[0], rhs[1]), cvtpk(rhs[2], rhs[3]), 0u, 0u), u);
    const bf16x8 UV = mk8(cvtpk(u[0], u[1]), cvtpk(u[2], u[3]), vpk.x, vpk.y);
    f32x4 y = {0.f, 0.f, 0.f, 0.f};
    if constexpr (WANT_Y) { y = MFMA16(*(const LAS bf16x8*)(img + IM_RI + ao), Sb[0], y); y = MFMA16(*(const LAS bf16x8*)(img + IM_RI + ao + 64), Sb[1], y);
        y = MFMA16(mk8(pkg[4 * 64 + lane], pkg[5 * 64 + lane], pkg[6 * 64 + lane], pkg[7 * 64 + lane]), UV, y); }
#pragma unroll
    for (int T = 0; T < 4; ++T) { const bf16x8 bkt = *(const LAS bf16x8*)(img + IM_BKT + blk * 5120 + (16 * T + c) * 80 + q * 16);
        S[T] = MFMA16(bkt, UV, S[T]); const f32x4 g = *(const LAS f32x4*)(img + IM_GAM + blk * 256 + (16 * T + 4 * q) * 4); S[T] = S[T] * g; }
    return y;
}
__device__ __forceinline__ unsigned char* sum_slot(Frame& F, int chain, int sc) { return F.ws + WS_SUM + (size_t)(chain * NSC + sc) * SUM_SLOT; }

__device__ __forceinline__ void rwkv_pass1_unit(Frame& F, int li, int u) {
    const int chain = u / (NSC - 1), sc = u % (NSC - 1);
    const int dir = chain / 12, b = (chain / 6) & 1, h = chain % 6;
    const bool isctx = sc < 2; const int scl = isctx ? sc : sc - 2;
    LAS unsigned char* img = F.lds + L_IMG0; LAS unsigned* pkg = (LAS unsigned*)(F.lds + L_PKG);
    ChainCtx C; chain_consts(C, li, dir, b, h, F.lane);
    const int q = F.lane >> 4, c = F.lane & 15, wq = F.wave & 3; const bool isA = F.wave >= 4;
    f32x4 S[4];
#pragma unroll
    for (int T = 0; T < 4; ++T)
#pragma unroll
        for (int e = 0; e < 4; ++e) S[T][e] = (isA && (16 * T + 4 * q + e == c + 16 * wq)) ? 1.0f : 0.0f;
#pragma unroll 1
    for (int rd = 0; rd < 4; ++rd) {
        __syncthreads();
        prep_round<4, false>(F, C, img, F.lane, F.wave, isctx, 128 * scl + 32 * rd, nullptr, nullptr, 0);
        __syncthreads();
        if (F.wave < 2) block_package<false>(img, F.wave, pkg + F.wave * 512, F.lane);
        __syncthreads();
#pragma unroll
        for (int blk = 0; blk < 2; ++blk) { if (isA) block_scan<false, false>(img, blk, pkg + blk * 512, S, wq, F.lane); else block_scan<false, true>(img, blk, pkg + blk * 512, S, wq, F.lane); }
    }
    unsigned char* slot = sum_slot(F, chain, sc);
    if (!isA) { f32x4* braw = (f32x4*)slot;
#pragma unroll
        for (int T = 0; T < 4; ++T) braw[(wq * 4 + T) * 64 + F.lane] = S[T]; }
    else { bf16* aim = (bf16*)(slot + 16384); const int kap = wq >> 1, e = (F.lane & 3) + 4 * (wq & 1), qc = c >> 2;
#pragma unroll
        for (int T = 0; T < 4; ++T)
#pragma unroll
            for (int r = 0; r < 4; ++r) { const int lc = (4 * q + r) + 16 * qc; aim[((T * 2 + kap) * 64 + lc) * 8 + e] = (bf16)f2bf(S[T][r]); } }
}
__device__ __forceinline__ void rwkv_pass2_chain(Frame& F, int chain) {
    if (F.wave >= 4) return;
    const int wq = F.wave;
    f32x4 S[4];
#pragma unroll
    for (int T = 0; T < 4; ++T) S[T] = (f32x4){0.f, 0.f, 0.f, 0.f};
#pragma unroll 1
    for (int sc = 0; sc < NSC; ++sc) {
        unsigned char* slot = sum_slot(F, chain, sc); f32x4* braw = (f32x4*)slot; const bf16* aim = (const bf16*)(slot + 16384);
        if (sc == NSC - 1) {
#pragma unroll
            for (int T = 0; T < 4; ++T) braw[(wq * 4 + T) * 64 + F.lane] = S[T];
            break; }
        f32x4 Bc[4]; bf16x8 af[4][2];
#pragma unroll
        for (int T = 0; T < 4; ++T) { Bc[T] = braw[(wq * 4 + T) * 64 + F.lane];
#pragma unroll
            for (int k = 0; k < 2; ++k) af[T][k] = *(const bf16x8*)(aim + ((T * 2 + k) * 64 + F.lane) * 8); }
        bf16x8 Sb[2];
#pragma unroll
        for (int k = 0; k < 2; ++k) Sb[k] = mk8(cvtpk(S[2 * k][0], S[2 * k][1]), cvtpk(S[2 * k][2], S[2 * k][3]), cvtpk(S[2 * k + 1][0], S[2 * k + 1][1]), cvtpk(S[2 * k + 1][2], S[2 * k + 1][3]));
#pragma unroll
        for (int T = 0; T < 4; ++T) { braw[(wq * 4 + T) * 64 + F.lane] = S[T]; f32x4 a = MFMA16(af[T][0], Sb[0], Bc[T]); S[T] = MFMA16(af[T][1], Sb[1], a); }
    }
}
__device__ __forceinline__ void rwkv_pass3_unit(Frame& F, int li, int u) {
    const int pc = u % NSC, bh = u / NSC, b = bh / 6, h = bh % 6;
    const bool isctx = pc < 2; const int pcl = isctx ? pc : pc - 2, nsc = isctx ? 2 : 64;
    const int dir = F.wave >> 2, wq = F.wave & 3, q = F.lane >> 4, c = F.lane & 15;
    const int sc = dir == 0 ? pc : (isctx ? 1 - pcl : 2 + 63 - pcl);
    const int scl = dir == 0 ? pcl : nsc - 1 - pcl;
    const int chain = dir * 12 + b * 6 + h;
    LAS unsigned char* img = F.lds + (dir ? L_IMG1 : L_IMG0); LAS unsigned* pkg = (LAS unsigned*)(F.lds + L_PKG) + dir * 1024;
    LAS float* YL = (LAS float*)(F.lds + L_YL); LAS unsigned char* VB = F.lds + L_VB; LAS float* BON = (LAS float*)(F.lds + L_BON);
    ChainCtx C; chain_consts(C, li, dir, b, h, F.lane);
    f32x4 S[4];
    { const f32x4* braw = (const f32x4*)sum_slot(F, chain, sc);
#pragma unroll
      for (int T = 0; T < 4; ++T) S[T] = braw[(wq * 4 + T) * 64 + F.lane]; }
    __syncthreads();
    for (int i = F.tid; i < 128 * 68; i += NTHR) YL[i] = 0.f;
#pragma unroll 1
    for (int rd = 0; rd < 4; ++rd) {
        __syncthreads();
        if (dir == 0) prep_round<8, true>(F, C, img, F.lane, wq, isctx, 128 * scl + 32 * rd, VB, BON, 32 * rd);
        else prep_round<8, false>(F, C, img, F.lane, wq, isctx, 128 * scl + 32 * rd, nullptr, nullptr, 0);
        __syncthreads();
        if (wq < 2) block_package<true>(img, wq, pkg + wq * 512, F.lane);
        __syncthreads();
#pragma unroll
        for (int blk = 0; blk < 2; ++blk) { const f32x4 y = block_scan<true, true>(img, blk, pkg + blk * 512, S, wq, F.lane);
#pragma unroll
            for (int e = 0; e < 4; ++e) { const int t = 32 * rd + 16 * blk + 4 * q + e; const int pl = dir ? 127 - t : t; YL[pl * 68 + c + 16 * wq] += y[e]; } }
    }
    __syncthreads();
    const int wv = F.wave; const int rbase = (isctx ? TL + b * CTX : b * SEQ) + 128 * pcl;
    const bf16* g2t = (const bf16*)(F.ws + WS_G2T) + (size_t)li * 384 * 128;
    f32x4 gate[4];
#pragma unroll
    for (int nt = 0; nt < 4; ++nt) gate[nt] = (f32x4){0.f, 0.f, 0.f, 0.f};
#pragma unroll
    for (int k = 0; k < 4; ++k) { const v4u zg = *(const v4u*)(zrow(F, rbase + 16 * wv + c) + ZG + 32 * k + 8 * q);
#define SG(x) (1.0f / (1.0f + __expf(-(x))))
        const bf16x8 a = mk8(pk2(SG(bflo(zg.x)), SG(bfhi(zg.x))), pk2(SG(bflo(zg.y)), SG(bfhi(zg.y))), pk2(SG(bflo(zg.z)), SG(bfhi(zg.z))), pk2(SG(bflo(zg.w)), SG(bfhi(zg.w))));
#undef SG
#pragma unroll
        for (int nt = 0; nt < 4; ++nt) { const bf16x8 bb = *(const bf16x8*)(g2t + (size_t)(64 * h + 16 * nt + c) * 128 + 32 * k + 8 * q); gate[nt] = MFMA16(a, bb, gate[nt]); } }
    bf16* mix = (bf16*)(F.ws + WS_H);
    float lg[4], lb[4];
#pragma unroll
    for (int nt = 0; nt < 4; ++nt) { lg[nt] = inp(I_LNG)[li * RW + 64 * h + 16 * nt + c]; lb[nt] = inp(I_LNB)[li * RW + 64 * h + 16 * nt + c]; }
#pragma unroll
    for (int e = 0; e < 4; ++e) { const int tl = 16 * wv + 4 * q + e;
        float yv[4], s = 0.f;
#pragma unroll
        for (int nt = 0; nt < 4; ++nt) { yv[nt] = YL[tl * 68 + 16 * nt + c]; s += yv[nt]; }
        s += __shfl_xor(s, 1); s += __shfl_xor(s, 2); s += __shfl_xor(s, 4); s += __shfl_xor(s, 8);
        const float mu = s * (1.0f / 64.0f); float v2 = 0.f;
#pragma unroll
        for (int nt = 0; nt < 4; ++nt) { yv[nt] -= mu; v2 += yv[nt] * yv[nt]; }
        v2 += __shfl_xor(v2, 1); v2 += __shfl_xor(v2, 2); v2 += __shfl_xor(v2, 4); v2 += __shfl_xor(v2, 8);
        const float rs = 1.0f / sqrtf(v2 * (1.0f / 64.0f) + GN_EPS); const float bon = BON[tl];
#pragma unroll
        for (int nt = 0; nt < 4; ++nt) { const float vv = bf2f(((const LAS bf16*)VB)[tl * 64 + 16 * nt + c]);
            const float o = (yv[nt] * rs * lg[nt] + lb[nt] + bon * vv) * gate[nt][e];
            mix[(size_t)(rbase + tl) * DM + 640 + 64 * h + 16 * nt + c] = (bf16)f2bf(o); } }
}

constexpr int AT_KROW = 144;
__device__ __forceinline__ void attn_unit(Frame& F, int li, int u) {
    const bool cq = u >= 256;
    int b, kvh, qb;
    if (!cq) { b = u >> 7; kvh = (u >> 6) & 1; qb = u & 63; } else { const int uu = u - 256; b = uu >> 2; kvh = (uu >> 1) & 1; qb = uu & 1; }
    const int c = F.lane & 15, q = F.lane >> 4, tb = F.wave;
    const bf16* qr = (const bf16*)(F.ws + WS_QR); const bf16* kr = (const bf16*)(F.ws + WS_KR); bf16* mix = (bf16*)(F.ws + WS_H);
    const int qrow = (cq ? TL + b * CTX : b * SEQ) + 128 * qb + 16 * tb + c;
    const int qpos = 128 * qb + 16 * tb + c;
    bf16x8 Q[3][2];
#pragma unroll
    for (int hh = 0; hh < 3; ++hh)
#pragma unroll
        for (int k = 0; k < 2; ++k) {
            if (!cq) Q[hh][k] = *(const bf16x8*)(qr + (size_t)qrow * 384 + 64 * (3 * kvh + hh) + 32 * k + 8 * q);
            else { const v4u w = *(const v4u*)(zrow(F, qrow) + ZQ + 64 * (3 * kvh + hh) + 32 * k + 8 * q);
                Q[hh][k] = mk8(pk2(0.125f * bflo(w.x), 0.125f * bfhi(w.x)), pk2(0.125f * bflo(w.y), 0.125f * bfhi(w.y)), pk2(0.125f * bflo(w.z), 0.125f * bfhi(w.z)), pk2(0.125f * bflo(w.w), 0.125f * bfhi(w.w))); } }
    float m[3], l[3]; f32x4 O[3][4];
#pragma unroll
    for (int hh = 0; hh < 3; ++hh) { m[hh] = inp(I_SINK)[li * 6 + 3 * kvh + hh]; l[hh] = q == 0 ? 1.0f : 0.0f;
#pragma unroll
        for (int dt = 0; dt < 4; ++dt) O[hh][dt] = (f32x4){0.f, 0.f, 0.f, 0.f}; }
    LAS unsigned char* KI = F.lds;
#pragma unroll 1
    for (int stage = cq ? 1 : 0; stage < 2; ++stage) {
        const int nkeys = stage == 0 ? 384 : 256; const int vstride = (nkeys + 8) * 2;
        LAS unsigned char* VTI = F.lds + 384 * AT_KROW;
        const int kpos0 = 128 * (qb - 1);
        __syncthreads();
        for (int pc = F.tid; pc < nkeys * 8; pc += NTHR) { const int key = pc >> 3, d8 = pc & 7;
            const bf16* ksrc; const bf16* vsrc;
            if (stage == 0) { int kp = kpos0 + key; kp = kp < 0 ? 0 : (kp >= SEQ ? SEQ - 1 : kp); ksrc = kr + (size_t)(b * SEQ + kp) * 128 + 64 * kvh; vsrc = zrow(F, b * SEQ + kp) + ZV + 64 * kvh; }
            else { const bf16* z = zrow(F, TL + b * CTX + key); ksrc = z + ZK + 64 * kvh; vsrc = z + ZV + 64 * kvh; }
            const v4u kv = *(const v4u*)(ksrc + 8 * d8); const v4u vv = *(const v4u*)(vsrc + 8 * d8);
            *(LAS v4u*)(KI + key * AT_KROW + d8 * 16) = kv;
            const int kl = key & 31; const int col = (key & ~31) | (((kl & 15) >> 2) << 3) | ((kl >> 4) << 2) | (kl & 3);
            LAS bf16* vt = (LAS bf16*)(VTI + (8 * d8) * vstride) + col;
            vt[0] = (bf16)(vv.x & 0xffff); *(LAS bf16*)((LAS unsigned char*)vt + vstride) = (bf16)(vv.x >> 16);
            *(LAS bf16*)((LAS unsigned char*)vt + 2 * vstride) = (bf16)(vv.y & 0xffff); *(LAS bf16*)((LAS unsigned char*)vt + 3 * vstride) = (bf16)(vv.y >> 16);
            *(LAS bf16*)((LAS unsigned char*)vt + 4 * vstride) = (bf16)(vv.z & 0xffff); *(LAS bf16*)((LAS unsigned char*)vt + 5 * vstride) = (bf16)(vv.z >> 16);
            *(LAS bf16*)((LAS unsigned char*)vt + 6 * vstride) = (bf16)(vv.w & 0xffff); *(LAS bf16*)((LAS unsigned char*)vt + 7 * vstride) = (bf16)(vv.w >> 16); }
        __syncthreads();
        const int npair = nkeys / 32;
        const int Q0 = 128 * qb + 16 * tb;
#pragma unroll 1
        for (int kp = 0; kp < npair; ++kp) {
            const int kb = kpos0 + 32 * kp;
            if (stage == 0 && (kb + 31 < Q0 - 128 || kb > Q0 + 143 || kb + 31 < 0 || kb >= SEQ)) continue;
            bf16x8 K[2][2], V[4];
#pragma unroll
            for (int t = 0; t < 2; ++t)
#pragma unroll
                for (int k = 0; k < 2; ++k) K[t][k] = *(const LAS bf16x8*)(KI + (32 * kp + 16 * t + c) * AT_KROW + k * 64 + q * 16);
#pragma unroll
            for (int dt = 0; dt < 4; ++dt) V[dt] = *(const LAS bf16x8*)(VTI + (16 * dt + c) * vstride + kp * 64 + q * 16);
            bool ok0[4], ok1[4];
#pragma unroll
            for (int e = 0; e < 4; ++e) { const int k0 = kb + 4 * q + e, k1 = k0 + 16;
                ok0[e] = stage == 1 || (k0 >= 0 && k0 < SEQ && k0 >= qpos - 128 && k0 <= qpos + 128);
                ok1[e] = stage == 1 || (k1 >= 0 && k1 < SEQ && k1 >= qpos - 128 && k1 <= qpos + 128); }
#pragma unroll
            for (int hh = 0; hh < 3; ++hh) {
                f32x4 s0 = {0.f, 0.f, 0.f, 0.f}, s1 = {0.f, 0.f, 0.f, 0.f};
                s0 = MFMA16(K[0][0], Q[hh][0], s0); s0 = MFMA16(K[0][1], Q[hh][1], s0);
                s1 = MFMA16(K[1][0], Q[hh][0], s1); s1 = MFMA16(K[1][1], Q[hh][1], s1);
                float mx = -INFINITY;
#pragma unroll
                for (int e = 0; e < 4; ++e) { s0[e] = ok0[e] ? s0[e] : -INFINITY; s1[e] = ok1[e] ? s1[e] : -INFINITY; mx = fmaxf(mx, fmaxf(s0[e], s1[e])); }
                mx = fmaxf(mx, __shfl_xor(mx, 16)); mx = fmaxf(mx, __shfl_xor(mx, 32));
                const float mn = fmaxf(m[hh], mx); const float alpha = __expf(m[hh] - mn); m[hh] = mn;
                float ps = 0.f;
#pragma unroll
                for (int e = 0; e < 4; ++e) { s0[e] = __expf(s0[e] - mn); s1[e] = __expf(s1[e] - mn); ps += s0[e] + s1[e]; }
                l[hh] = l[hh] * alpha + ps;
                const bf16x8 P = mk8(cvtpk(s0[0], s0[1]), cvtpk(s0[2], s0[3]), cvtpk(s1[0], s1[1]), cvtpk(s1[2], s1[3]));
#pragma unroll
                for (int dt = 0; dt < 4; ++dt) { O[hh][dt] = O[hh][dt] * alpha; O[hh][dt] = MFMA16(V[dt], P, O[hh][dt]); }
            }
        }
    }
#pragma unroll
    for (int hh = 0; hh < 3; ++hh) { float lt = l[hh]; lt += __shfl_xor(lt, 16); lt += __shfl_xor(lt, 32); const float inv = 1.0f / lt;
#pragma unroll
        for (int dt = 0; dt < 4; ++dt) { v2u w; w.x = pk2(O[hh][dt][0] * inv, O[hh][dt][1] * inv); w.y = pk2(O[hh][dt][2] * inv, O[hh][dt][3] * inv);
            *(v2u*)(mix + (size_t)qrow * DM + 256 + 64 * (3 * kvh + hh) + 16 * dt + 4 * q) = w; } }
}

constexpr size_t WS_FT = 7 * MiB;
constexpr size_t FT_W64C = 0, FT_W64S = 8192, FT_W128C = 16384, FT_W128S = 49152, FT_T64C = 81920, FT_T64S = 90112;
__device__ __forceinline__ void fourier_tables(Frame& F) {
    bf16* t = (bf16*)(F.ws + WS_FT);
    for (int i = F.bid * NTHR + F.tid; i < 64 * 64; i += F.G * NTHR) { const int r = i >> 6, cc = i & 63; const float a = (float)((r * cc) & 63) * (1.0f / 64.0f);
        const float cs = __builtin_amdgcn_cosf(a), sn = __builtin_amdgcn_sinf(a);
        t[FT_W64C / 2 + i] = (bf16)f2bf(cs); t[FT_W64S / 2 + i] = (bf16)f2bf(sn);
        const int pj = (cc & ~31) | (((cc & 15) >> 2) << 3) | (((cc >> 4) & 1) << 2) | (cc & 3);
        t[FT_T64C / 2 + r * 64 + pj] = (bf16)f2bf(cs); t[FT_T64S / 2 + r * 64 + pj] = (bf16)f2bf(sn); }
    for (int i = F.bid * NTHR + F.tid; i < 128 * 128; i += F.G * NTHR) { const int r = i >> 7, cc = i & 127; const float a = (float)((r * cc) & 127) * (1.0f / 128.0f);
        t[FT_W128C / 2 + i] = (bf16)f2bf(__builtin_amdgcn_cosf(a)); t[FT_W128S / 2 + i] = (bf16)f2bf(__builtin_amdgcn_sinf(a)); }
}
__device__ __forceinline__ void fourier_a_fast(Frame& F, int u) {
    const int b = u >> 7, n2 = u & 127, c = F.lane & 15, q = F.lane >> 4;
    LAS unsigned char* IMG = F.lds;
    __syncthreads();
    for (int pc = F.tid; pc < 64 * 32; pc += NTHR) { const int n1 = pc >> 5, c8 = pc & 31;
        const v4u v = *(const v4u*)(zrow(F, b * SEQ + 128 * n1 + n2) + ZF + 8 * c8);
        LAS bf16* d = (LAS bf16*)(IMG + (8 * c8) * 144) + n1;
        d[0] = (bf16)(v.x & 0xffff); d[72] = (bf16)(v.x >> 16); d[144] = (bf16)(v.y & 0xffff); d[216] = (bf16)(v.y >> 16);
        d[288] = (bf16)(v.z & 0xffff); d[360] = (bf16)(v.z >> 16); d[432] = (bf16)(v.w & 0xffff); d[504] = (bf16)(v.w >> 16); }
    __syncthreads();
    const bf16* wc = (const bf16*)(F.ws + WS_FT + FT_W64C); const bf16* wsn = (const bf16*)(F.ws + WS_FT + FT_W64S);
    bf16* far = (bf16*)(F.ws + WS_FA); bf16* fai = far + (size_t)NB * 64 * 128 * 256;
    bf16x8 Bc[4][2], Bs[4][2];
#pragma unroll
    for (int kt = 0; kt < 4; ++kt)
#pragma unroll
        for (int k = 0; k < 2; ++k) { Bc[kt][k] = *(const bf16x8*)(wc + (16 * kt + c) * 64 + 32 * k + 8 * q); Bs[kt][k] = *(const bf16x8*)(wsn + (16 * kt + c) * 64 + 32 * k + 8 * q); }
#pragma unroll
    for (int ci = 0; ci < 2; ++ci) { const int ct = 2 * F.wave + ci;
        bf16x8 A[2];
#pragma unroll
        for (int k = 0; k < 2; ++k) A[k] = *(const LAS bf16x8*)(IMG + (16 * ct + c) * 144 + k * 64 + q * 16);
#pragma unroll
        for (int kt = 0; kt < 4; ++kt) { f32x4 sr = {0.f, 0.f, 0.f, 0.f}, si = {0.f, 0.f, 0.f, 0.f};
#pragma unroll
            for (int k = 0; k < 2; ++k) { sr = MFMA16(A[k], Bc[kt][k], sr); si = MFMA16(A[k], Bs[kt][k], si); }
            const int k1 = 16 * kt + c; const float tw = (float)(n2 * k1) * (1.0f / 8192.0f); const float tc = __builtin_amdgcn_cosf(tw), ts = __builtin_amdgcn_sinf(tw);
            float xr[4], xi[4];
#pragma unroll
            for (int e = 0; e < 4; ++e) { const float ar = sr[e], ai = -si[e]; xr[e] = ar * tc + ai * ts; xi[e] = ai * tc - ar * ts; }
            const size_t o = (((size_t)b * 64 + k1) * 128 + n2) * 256 + 16 * ct + 4 * q;
            v2u w; w.x = pk2(xr[0], xr[1]); w.y = pk2(xr[2], xr[3]); *(v2u*)(far + o) = w; w.x = pk2(xi[0], xi[1]); w.y = pk2(xi[2], xi[3]); *(v2u*)(fai + o) = w; } }
}
__device__ __forceinline__ void fourier_c_fast(Frame& F, int u) {
    const int g = u & 3, k1 = (u >> 2) & 63, b = u >> 8, c = F.lane & 15, q = F.lane >> 4;
    LAS unsigned char* IR = F.lds; LAS unsigned char* II = F.lds + 64 * 272;
    const bf16* far = (const bf16*)(F.ws + WS_FA) + (((size_t)b * 64 + k1) * 128) * 256 + 64 * g; const bf16* fai = far + (size_t)NB * 64 * 128 * 256;
    __syncthreads();
    for (int pc = F.tid; pc < 128 * 8; pc += NTHR) { const int n2 = pc >> 3, c8 = pc & 7;
        const v4u vr = *(const v4u*)(far + (size_t)n2 * 256 + 8 * c8), vi = *(const v4u*)(fai + (size_t)n2 * 256 + 8 * c8);
        LAS bf16* dr = (LAS bf16*)(IR + (8 * c8) * 272) + n2; LAS bf16* di = (LAS bf16*)(II + (8 * c8) * 272) + n2;
        dr[0] = (bf16)(vr.x & 0xffff); dr[136] = (bf16)(vr.x >> 16); dr[272] = (bf16)(vr.y & 0xffff); dr[408] = (bf16)(vr.y >> 16);
        dr[544] = (bf16)(vr.z & 0xffff); dr[680] = (bf16)(vr.z >> 16); dr[816] = (bf16)(vr.w & 0xffff); dr[952] = (bf16)(vr.w >> 16);
        di[0] = (bf16)(vi.x & 0xffff); di[136] = (bf16)(vi.x >> 16); di[272] = (bf16)(vi.y & 0xffff); di[408] = (bf16)(vi.y >> 16);
        di[544] = (bf16)(vi.z & 0xffff); di[680] = (bf16)(vi.z >> 16); di[816] = (bf16)(vi.w & 0xffff); di[952] = (bf16)(vi.w >> 16); }
    __syncthreads();
    const bf16* wc = (const bf16*)(F.ws + WS_FT + FT_W128C); const bf16* wsn = (const bf16*)(F.ws + WS_FT + FT_W128S);
    const bf16* tcn = (const bf16*)(F.ws + WS_FT + FT_T64C); const bf16* tsn = (const bf16*)(F.ws + WS_FT + FT_T64S);
    f32x4 Pr[4], Pi[4];
#pragma unroll
    for (int ct = 0; ct < 4; ++ct) { Pr[ct] = (f32x4){0.f, 0.f, 0.f, 0.f}; Pi[ct] = (f32x4){0.f, 0.f, 0.f, 0.f}; }
#pragma unroll
    for (int k = 0; k < 4; ++k) { const bf16x8 bc = *(const bf16x8*)(wc + (16 * F.wave + c) * 128 + 32 * k + 8 * q), bs = *(const bf16x8*)(wsn + (16 * F.wave + c) * 128 + 32 * k + 8 * q);
        const v4u bsu = __builtin_bit_cast(v4u, bs); const bf16x8 bsn = mk8(bsu.x ^ 0x80008000u, bsu.y ^ 0x80008000u, bsu.z ^ 0x80008000u, bsu.w ^ 0x80008000u);
#pragma unroll
        for (int ct = 0; ct < 4; ++ct) { const bf16x8 ar = *(const LAS bf16x8*)(IR + (16 * ct + c) * 272 + k * 64 + q * 16), ai = *(const LAS bf16x8*)(II + (16 * ct + c) * 272 + k * 64 + q * 16);
            Pr[ct] = MFMA16(ar, bc, Pr[ct]); Pr[ct] = MFMA16(ai, bs, Pr[ct]); Pi[ct] = MFMA16(ai, bc, Pi[ct]); Pi[ct] = MFMA16(ar, bsn, Pi[ct]); } }
    bf16x8 Br[2], Bi[2];
#pragma unroll
    for (int k = 0; k < 2; ++k) { Br[k] = mk8(cvtpk(Pr[2 * k][0], Pr[2 * k][1]), cvtpk(Pr[2 * k][2], Pr[2 * k][3]), cvtpk(Pr[2 * k + 1][0], Pr[2 * k + 1][1]), cvtpk(Pr[2 * k + 1][2], Pr[2 * k + 1][3]));
        Bi[k] = mk8(cvtpk(Pi[2 * k][0], Pi[2 * k][1]), cvtpk(Pi[2 * k][2], Pi[2 * k][3]), cvtpk(Pi[2 * k + 1][0], Pi[2 * k + 1][1]), cvtpk(Pi[2 * k + 1][2], Pi[2 * k + 1][3])); }
    bf16* mix = (bf16*)(F.ws + WS_H);
    const float scale = 0.0013810679320049757f;
    const int k2 = 16 * F.wave + c; const size_t row = (size_t)b * SEQ + k1 + 64 * k2;
#pragma unroll
    for (int mt = 0; mt < 4; ++mt) { f32x4 y = {0.f, 0.f, 0.f, 0.f};
#pragma unroll
        for (int k = 0; k < 2; ++k) { const bf16x8 ac = *(const bf16x8*)(tcn + (16 * mt + c) * 64 + 32 * k + 8 * q), as = *(const bf16x8*)(tsn + (16 * mt + c) * 64 + 32 * k + 8 * q);
            y = MFMA16(ac, Br[k], y); y = MFMA16(as, Bi[k], y); }
        v2u w; w.x = pk2(y[0] * scale, y[1] * scale); w.y = pk2(y[2] * scale, y[3] * scale);
        *(v2u*)(mix + row * DM + 64 * g + 16 * mt + 4 * q) = w; }
}

#define XB_TMO      128
#define XB_XCNT(j)  (256  + 64 * (j))
#define XB_XSUB(j)  (1280 + 64 * (j))
#define XB_XGEN(j)  (2304 + 64 * (j))
#define XB_TOP      3328
#define XB_TOPGEN   3392
#define XCD_BAR_WORDS 3456
#define XB_SPIN_CAP (1u << 23)
__device__ __forceinline__ unsigned xb_ld(unsigned* p)              { return __hip_atomic_load(p, __ATOMIC_RELAXED, __HIP_MEMORY_SCOPE_AGENT); }
__device__ __forceinline__ unsigned xb_add(unsigned* p, unsigned v) { return __hip_atomic_fetch_add(p, v, __ATOMIC_RELAXED, __HIP_MEMORY_SCOPE_AGENT); }
__device__ __forceinline__ unsigned xb_xcc_id() { return (unsigned)__builtin_amdgcn_s_getreg((3 << 11) | 20) & 0xFu; }
#define XB_SPIN(cond, bar) do { unsigned _sp = 0; while (cond) { __builtin_amdgcn_s_sleep(1); \
    if ((++_sp & 255u) == 0u) { if (xb_ld(&(bar)[XB_TMO])) break; if (_sp > XB_SPIN_CAP) { atomicAdd(&(bar)[XB_TMO], 1u); break; } } } } while (0)
struct XcdBarrier { unsigned* bar; unsigned x; volatile LAS unsigned* st; };
__device__ __forceinline__ XcdBarrier xcd_barrier_post(unsigned* bar, volatile LAS unsigned* st) {
    XcdBarrier b; b.bar = bar; b.x = xb_xcc_id(); b.st = st;
    if (threadIdx.x == 0) (void)xb_add(&bar[XB_XCNT(b.x)], 1u);
    return b;
}
__device__ __forceinline__ void xcd_barrier_complete(unsigned* bar, unsigned x, unsigned& nloc, unsigned& nx) {
    const unsigned G = gridDim.x * gridDim.y * gridDim.z;
    unsigned sum, cnt, mine, sp = 0u;
    for (;;) {
        sum = 0u; cnt = 0u; mine = 0u;
#pragma unroll
        for (unsigned j = 0; j < 16; ++j) { const unsigned c = xb_ld(&bar[XB_XCNT(j)]); sum += c; cnt += (c > 0u) ? 1u : 0u; mine = (j == x) ? c : mine; }
        if (sum == G) break;
        __builtin_amdgcn_s_sleep(1);
        if ((++sp & 255u) == 0u) { if (xb_ld(&bar[XB_TMO])) break; if (sp > XB_SPIN_CAP) { atomicAdd(&bar[XB_TMO], 1u); break; } }
    }
    nloc = mine > 0u ? mine : 1u; nx = cnt > 0u ? cnt : 1u;
}
__device__ __forceinline__ void xcd_barrier(const XcdBarrier& b) {
    asm volatile("s_waitcnt vmcnt(0)" ::: "memory");
    __syncthreads();
    if (threadIdx.x == 0) {
        unsigned* bar = b.bar;
        __builtin_amdgcn_s_waitcnt(0);
        unsigned nloc = b.st[0], nx = b.st[1];
        if (nloc == 0u) { xcd_barrier_complete(bar, b.x, nloc, nx); b.st[0] = nloc; b.st[1] = nx; }
        const unsigned old = xb_add(&bar[XB_XSUB(b.x)], 1u);
        const unsigned gen = old / nloc;
        if (old + 1u == (gen + 1u) * nloc) {
            __builtin_amdgcn_fence(__ATOMIC_RELEASE, "agent");
            asm volatile("s_waitcnt vmcnt(0)" ::: "memory");
            const unsigned og = xb_add(&bar[XB_TOP], 1u);
            const unsigned tg = og / nx;
            if (og + 1u == (tg + 1u) * nx) xb_add(&bar[XB_TOPGEN], 1u);
            else XB_SPIN(xb_ld(&bar[XB_TOPGEN]) == tg, bar);
            __builtin_amdgcn_fence(__ATOMIC_ACQUIRE, "agent");
            xb_add(&bar[XB_XGEN(b.x)], 1u);
            asm volatile("s_waitcnt vmcnt(0)" ::: "memory");
        } else {
            XB_SPIN(xb_ld(&bar[XB_XGEN(b.x)]) == gen, bar);
            __builtin_amdgcn_fence(__ATOMIC_ACQUIRE, "agent");
            asm volatile("s_waitcnt vmcnt(0)" ::: "memory");
        }
    }
    __syncthreads();
}

template <int KIND> __device__ __forceinline__ void run_phase(const Frame& F0, int li, int second) {
    Frame F;
    { int t = threadIdx.x; asm volatile("" : "+v"(t)); F.tid = t; F.lane = t & 63; F.wave = __builtin_amdgcn_readfirstlane(t >> 6);
      int g = F0.G, b = F0.bid; asm volatile("" : "+s"(g), "+s"(b)); F.G = g; F.bid = b;
      unsigned char* w = F0.ws; float* o = F0.out; asm volatile("" : "+s"(w), "+s"(o)); F.ws = w; F.out = o;
      unsigned l = (unsigned)(size_t)F0.lds; asm volatile("" : "+s"(l)); F.lds = (LAS unsigned char*)(size_t)l;
      asm volatile("" : "+s"(li), "+s"(second)); }
    float* modv = (float*)(F.ws + WS_MOD);
    float* xc = (float*)(F.ws + WS_XC);
    bf16* H = (bf16*)(F.ws + WS_H); bf16* ACT = (bf16*)(F.ws + WS_ACT); float* O = (float*)(F.ws + WS_O);
    const float* ng = inp(I_NORMG) + (size_t)li * 6 * DM; const float* mv = modv + (size_t)li * 3 * 9216;
    const bool last = li == 1;
    if constexpr (KIND == 100) { convert_weights(F, 0); mod_gemv(F); rope_tables(F); lora_transposes(F); fourier_tables(F); }
    if constexpr (KIND == 101) { EArgs A{}; A.xl_src = inp(I_X); A.xc_src = inp(I_CTX); A.o = nullptr; A.hdst = H; A.modv_h = modv; A.shidx = 0; A.scidx = 1; A.gpre = inp(I_NORMG); A.nrows = TT; e_phase(F, A); }
    if constexpr (KIND == 0) {
        pg8::Gemm g{H, (const bf16*)(F.ws + (second ? WS_WI2 : WS_WI1)), (last && second) ? TL : TT, NWI, DM}; pg8::StaticOrder S; S.init(g.M, g.N, F.G, F.bid);
        pg8::EpiSwiglu E{ACT, FFNP}; pg8::gemm_phase<pg8::EpiSwiglu, pg8::StaticOrder, true, true>(F.lds, g, S, E, F.tid); }
    if constexpr (KIND == 1) {
        pg8::Gemm g{ACT, (const bf16*)(F.ws + (second ? WS_WO2 : WS_WO1)), (last && second) ? TL : TT, DM, FFNP}; pg8::StaticOrder S; S.init(g.M, g.N, F.G, F.bid);
        pg8::EpiF32 E{O, DM}; pg8::gemm_phase<pg8::EpiF32, pg8::StaticOrder, true, true>(F.lds, g, S, E, F.tid); }
    if constexpr (KIND == 2) {
        EArgs A{}; A.xl_src = li == 0 ? inp(I_X) : F.out; A.xc_src = li == 0 ? inp(I_CTX) : xc; A.xl_dst = F.out; A.xc_dst = xc; A.o = O; A.modv_g = mv; A.gidx = 2; A.gmul = 0.5f; A.gpost = ng + 1 * DM;
        A.hdst = H; A.modv_h = mv; A.shidx = 3; A.scidx = 4; A.gpre = ng + 2 * DM; A.nrows = TT; e_phase(F, A); }
    if constexpr (KIND == 3) {
        pg8::Gemm g{H, (const bf16*)(F.ws + WS_WIN), TT, INWP, DM}; pg8::StaticOrder S; S.init(g.M, g.N, F.G, F.bid);
        pg8::EpiBf16 E{ACT, INWP}; pg8::gemm_phase<pg8::EpiBf16, pg8::StaticOrder, true, true>(F.lds, g, S, E, F.tid); }
    if constexpr (KIND == 4) {
        for (int u = F.bid; u < 528; u += F.G) lora_unit(F, li, u);
        for (int u = F.bid; u < 256; u += F.G) fourier_a_fast(F, u);
        for (int u = F.bid; u < 64; u += F.G) rope_unit(F, u);
        if (li == 0) for (int u = F.bid; u < 16; u += F.G) fourier_ctx1_unit(F, u); }
    if constexpr (KIND == 5) {
        for (int u = F.bid; u < (li == 0 ? 264 : 256); u += F.G) attn_unit(F, li, u);
        for (int u = F.bid; u < 24 * (NSC - 1); u += F.G) rwkv_pass1_unit(F, li, u); }
    if constexpr (KIND == 11) {
        if (F.bid < 24) rwkv_pass2_chain(F, F.bid);
        for (int u = F.bid; u < 512; u += F.G) fourier_c_fast(F, u);
        if (li == 0) for (int u = F.bid; u < 32; u += F.G) fourier_ctx2_unit(F, u); }
    if constexpr (KIND == 12) {
        for (int u = F.bid; u < 12 * NSC; u += F.G) { if (li == 1 && (u % NSC) < 2) continue; rwkv_pass3_unit(F, li, u); } }
    if constexpr (KIND == 6) {
        pg8::Gemm g{H, (const bf16*)(F.ws + WS_WOUT), last ? TL : TT, DM, DM}; pg8::StaticOrder S; S.init(g.M, g.N, F.G, F.bid);
        pg8::EpiF32 E{O, DM}; pg8::gemm_phase<pg8::EpiF32, pg8::StaticOrder, true, true>(F.lds, g, S, E, F.tid); }
    if constexpr (KIND == 7) {
        EArgs A{}; A.xl_src = F.out; A.xc_src = xc; A.xl_dst = F.out; A.xc_dst = xc; A.o = O; A.modv_g = mv; A.gidx = 5; A.gmul = 1.0f; A.gpost = ng + 3 * DM;
        A.hdst = H; A.modv_h = mv; A.shidx = 6; A.scidx = 7; A.gpre = ng + 4 * DM; A.nrows = last ? TL : TT; e_phase(F, A); }
    if constexpr (KIND == 10) {
        EArgs A{}; A.xl_src = F.out; A.xc_src = xc; A.xl_dst = F.out; A.xc_dst = xc; A.o = O; A.modv_g = mv; A.gidx = 8; A.gmul = 0.5f; A.gpost = ng + 5 * DM;
        if (!last) { A.hdst = H; A.modv_h = mv + 3 * 9216; A.shidx = 0; A.scidx = 1; A.gpre = ng + 6 * DM; }
        A.nrows = last ? TL : TT; e_phase(F, A);
        if (!last) { __syncthreads(); convert_weights(F, 1); } }
}
constexpr int MISC_OFF = 131072 + 320;
__global__ void __launch_bounds__(NTHR, 2) mega_one(Args args) {
    extern __shared__ __attribute__((aligned(16))) unsigned char lds[];
    Frame F; F.lds = (LAS unsigned char*)lds; F.tid = threadIdx.x; F.lane = F.tid & 63; F.wave = __builtin_amdgcn_readfirstlane(F.tid >> 6); F.G = gridDim.x; F.bid = blockIdx.x;
    F.out = args.out; F.ws = args.ws;
    volatile LAS unsigned* MISC = (volatile LAS unsigned*)(F.lds + MISC_OFF);
    if (F.tid < 32) MISC[F.tid] = 0u;
    __syncthreads();
    XcdBarrier bar = xcd_barrier_post((unsigned*)(F.ws + WS_CTL) + 4096, MISC + 8);
#define GRID_BAR() xcd_barrier(bar)
    run_phase<100>(F, 0, 0); GRID_BAR();
    run_phase<101>(F, 0, 0); GRID_BAR();
#pragma unroll 1
    for (int li = 0; li < 2; ++li) {
        run_phase<0>(F, li, 0); GRID_BAR();
        run_phase<1>(F, li, 0); GRID_BAR();
        run_phase<2>(F, li, 0); GRID_BAR();
        run_phase<3>(F, li, 0); GRID_BAR();
        run_phase<4>(F, li, 0); GRID_BAR();
        run_phase<5>(F, li, 0); GRID_BAR();
        run_phase<11>(F, li, 0); GRID_BAR();
        run_phase<12>(F, li, 0); GRID_BAR();
        run_phase<6>(F, li, 0); GRID_BAR();
        run_phase<7>(F, li, 0); GRID_BAR();
        run_phase<0>(F, li, 1); GRID_BAR();
        run_phase<1>(F, li, 1); GRID_BAR();
        run_phase<10>(F, li, 0); GRID_BAR();
    }
}

extern "C" void kernel_launch(void* const* d_in, const int* in_sizes, int n_in, void* d_out, int out_size, void* d_ws, size_t ws_size, hipStream_t stream) {
    static int ready = 0;
    if (!ready) {
        if (n_in != 25 || out_size != TL * DM || ws_size < WS_END) { fprintf(stderr, "kernel_launch: unexpected shapes (n_in %d out %d ws %zu)\n", n_in, out_size, ws_size); ready = -1; return; }
        if (hipFuncSetAttribute((const void*)mega_one, hipFuncAttributeMaxDynamicSharedMemorySize, LDS_BYTES) != hipSuccess) { fprintf(stderr, "kernel_launch: hipFuncSetAttribute failed\n"); ready = -1; return; }
        ready = 1;
    }
    if (ready < 0) return;
    if (hipMemsetAsync((char*)d_ws + WS_CTL, 0, 65536, stream) != hipSuccess) { fprintf(stderr, "kernel_launch: memset failed\n"); return; }
    Args a{};
    for (int i = 0; i < 25; ++i) a.in[i] = (const float*)d_in[i];
    a.out = (float*)d_out; a.ws = (unsigned char*)d_ws;
    hipLaunchKernelGGL(mega_one, dim3(256), dim3(NTHR), LDS_BYTES, stream, a);
}
```

```cpp
#include <hip/hip_runtime.h>
#include <cstdio>
#include <cstdint>

namespace pg8 {
#define PG8_LAS __attribute__((address_space(3)))
typedef unsigned short bf16_t;
typedef short bf16x8 __attribute__((ext_vector_type(8)));
typedef float f32x4 __attribute__((ext_vector_type(4)));
typedef unsigned u32x4 __attribute__((ext_vector_type(4)));
constexpr int BM = 256, BK = 64, HALF = 128, HTB = HALF * BK * 2, STAGE_BYTES = 8 * HTB, NXCD = 8, WGM = 8;

__host__ __device__ __forceinline__ int lds_byte(int r, int c) { const int st = (r >> 4) * 2 + (c >> 5), rr = r & 15, cc = c & 31, ob = rr * 64 + cc * 2; return st * 1024 + (ob ^ (((ob >> 9) & 1) << 5)); }
__host__ __device__ __forceinline__ void stage_rc(int b, int& R, int& C) { const int st = b / 1024, sb = b % 1024, swz = sb ^ (((sb >> 9) & 1) << 5); R = (st >> 1) * 16 + swz / 64; C = (st & 1) * 32 + (swz % 64) / 2; }
__host__ __device__ __forceinline__ int perm32(int rho) { const int n = rho >> 4, i = rho & 15; return 8 * (i >> 2) + 4 * n + (i & 3); }

struct Unit { int pm, pn; };
struct Gemm { const bf16_t* A; const bf16_t* Bt; int M, N, K; };

struct StaticOrder {
    int nM, nN, nwg, G, c;
    __host__ __device__ void init(int M, int N, int G_, int c_) { nM = M / BM; nN = N / BM; nwg = nM * nN; G = G_; c = c_; }
    __host__ __device__ bool next(int i, Unit& u) const {
        const long L = (long)i * G + c; if (L >= nwg) return false;
        int wgid = (int)L; { const int q = nwg / NXCD, r = nwg % NXCD, xcd = wgid % NXCD, off = wgid / NXCD; wgid = (xcd < r ? xcd * (q + 1) : r * (q + 1) + (xcd - r) * q) + off; }
        const int nig = WGM * nN, gid = wgid / nig, fm = gid * WGM, gsz = (nM - fm) < WGM ? (nM - fm) : WGM;
        u.pm = fm + ((wgid % nig) % gsz); u.pn = (wgid % nig) / gsz; return true;
    }
    __device__ __forceinline__ void a_ready(const Unit&) const {}
    __device__ __forceinline__ void done(const Unit&) const {}
};

__device__ __forceinline__ unsigned cvt_pk_bf16(float lo, float hi) { unsigned r; asm volatile("v_cvt_pk_bf16_f32 %0, %1, %2" : "=v"(r) : "v"(lo), "v"(hi)); return r; }

struct EpiBf16 {
    static constexpr bool PERM = true, AFTER_DRAIN = false;
    bf16_t* O; int ldc;
    __device__ __forceinline__ void operator()(const f32x4 (&acc)[2][2][4][2], const Unit& u, int wr, int wc, int fr, int fq) const {
        const int row0 = u.pm * BM + wr * 64 + fr; const int col0 = u.pn * BM + wc * 32 + 8 * fq;
#pragma unroll
        for (int ai = 0; ai < 2; ++ai)
#pragma unroll
            for (int m = 0; m < 4; ++m) { bf16_t* rowp = O + (size_t)(row0 + ai * HALF + m * 16) * ldc + col0;
#pragma unroll
                for (int bj = 0; bj < 2; ++bj) { const f32x4 v0 = acc[ai][bj][m][0], v1 = acc[ai][bj][m][1];
                    u32x4 w; w.x = cvt_pk_bf16(v0[0], v0[1]); w.y = cvt_pk_bf16(v0[2], v0[3]); w.z = cvt_pk_bf16(v1[0], v1[1]); w.w = cvt_pk_bf16(v1[2], v1[3]);
                    *(u32x4*)(rowp + bj * HALF) = w; } }
    }
};
struct EpiF32 {
    static constexpr bool PERM = true, AFTER_DRAIN = false;
    float* O; int ldc;
    __device__ __forceinline__ void operator()(const f32x4 (&acc)[2][2][4][2], const Unit& u, int wr, int wc, int fr, int fq) const {
        const int row0 = u.pm * BM + wr * 64 + fr; const int col0 = u.pn * BM + wc * 32 + 8 * fq;
#pragma unroll
        for (int ai = 0; ai < 2; ++ai)
#pragma unroll
            for (int m = 0; m < 4; ++m) { float* rowp = O + (size_t)(row0 + ai * HALF + m * 16) * ldc + col0;
#pragma unroll
                for (int bj = 0; bj < 2; ++bj) { *(f32x4*)(rowp + bj * HALF) = acc[ai][bj][m][0]; *(f32x4*)(rowp + bj * HALF + 4) = acc[ai][bj][m][1]; } }
    }
};
__device__ __forceinline__ float silu_f(float x) { return x * __builtin_amdgcn_rcpf(1.0f + __expf(-x)); }
struct EpiSwiglu {
    static constexpr bool PERM = true, AFTER_DRAIN = false;
    bf16_t* O; int ldc;
    __device__ __forceinline__ void operator()(const f32x4 (&acc)[2][2][4][2], const Unit& u, int wr, int wc, int fr, int fq) const {
        const int row0 = u.pm * BM + wr * 64 + fr; const int col0 = u.pn * HALF + wc * 32 + 8 * fq;
#pragma unroll
        for (int ai = 0; ai < 2; ++ai)
#pragma unroll
            for (int m = 0; m < 4; ++m) { bf16_t* rowp = O + (size_t)(row0 + ai * HALF + m * 16) * ldc + col0;
                const f32x4 g0 = acc[ai][0][m][0], g1 = acc[ai][0][m][1], u0 = acc[ai][1][m][0], u1 = acc[ai][1][m][1];
                u32x4 w; w.x = cvt_pk_bf16(silu_f(g0[0]) * u0[0], silu_f(g0[1]) * u0[1]); w.y = cvt_pk_bf16(silu_f(g0[2]) * u0[2], silu_f(g0[3]) * u0[3]);
                w.z = cvt_pk_bf16(silu_f(g1[0]) * u1[0], silu_f(g1[1]) * u1[1]); w.w = cvt_pk_bf16(silu_f(g1[2]) * u1[2], silu_f(g1[3]) * u1[3]);
                *(u32x4*)rowp = w; }
    }
};

template <class Epi, class Sched, bool ALIGN_EPI = false, bool SP2 = false>
__device__ __forceinline__ void gemm_phase(PG8_LAS unsigned char* lds, const Gemm g, const Sched& S, const Epi& E, const int tid) {
    const int wid = __builtin_amdgcn_readfirstlane(tid >> 6), lane = tid & 63, wr = wid >> 2, wc = wid & 3, fr = lane & 15, fq = lane >> 4;
    const int K = g.K, nt = K / BK;
    unsigned voffA[2], voffB[2];
#pragma unroll
    for (int i = 0; i < 2; ++i) { int R, C; stage_rc(tid * 16 + i * 8192, R, C); const int Rb = Epi::PERM ? ((R & ~31) + perm32(R & 31)) : R;
        voffA[i] = (unsigned)(R * K + C) * 2u; voffB[i] = (unsigned)(Rb * K + C) * 2u; }
    const size_t kstep = (size_t)(BK * 2);
    const size_t hstep = (size_t)HALF * K * 2;
    const size_t tstep = 2 * hstep;
    const unsigned ldsw = (unsigned)wid * 1024u;
    const int aoff = lds_byte(wr * 64 + fr, fq * 8), boff = lds_byte(wc * 32 + fr, fq * 8);
#define PG8_SA(b, h) (((b) * 2 + (h)) * HTB)
#define PG8_SB(b, h) ((4 + (b) * 2 + (h)) * HTB)
#define PG8_STAGE(bufoff, gbase, voff) do { _Pragma("unroll") for (int _i = 0; _i < 2; ++_i) \
        __builtin_amdgcn_global_load_lds((const unsigned*)((const char*)(gbase) + (voff)[_i]), (PG8_LAS unsigned*)(lds + (bufoff) + ldsw + _i * 8192), 16, 0, 0); } while (0)
#define PG8_LDA(dst, b, h) do { _Pragma("unroll") for (int m = 0; m < 4; ++m) _Pragma("unroll") for (int k = 0; k < 2; ++k) dst[m][k] = *(const PG8_LAS bf16x8*)(lds + PG8_SA(b, h) + aoff + m * 2048 + k * 1024); } while (0)
#define PG8_LDB(dst, b, h) do { _Pragma("unroll") for (int n = 0; n < 2; ++n) _Pragma("unroll") for (int k = 0; k < 2; ++k) dst[n][k] = *(const PG8_LAS bf16x8*)(lds + PG8_SB(b, h) + boff + n * 2048 + k * 1024); } while (0)
#define PG8_MMA(ai, bj, At, Bt) do { __builtin_amdgcn_s_setprio(1); _Pragma("unroll") for (int m = 0; m < 4; ++m) _Pragma("unroll") for (int n = 0; n < 2; ++n) _Pragma("unroll") for (int k = 0; k < 2; ++k) \
        acc[ai][bj][m][n] = __builtin_amdgcn_mfma_f32_16x16x32_bf16(Bt[n][k], At[m][k], acc[ai][bj][m][n], 0, 0, 0); __builtin_amdgcn_s_setprio(0); } while (0)
#define PG8_WAIT_V(n) asm volatile("s_waitcnt vmcnt(" #n ")" ::: "memory")
#define PG8_WAIT_L(n) asm volatile("s_waitcnt lgkmcnt(" #n ")" ::: "memory")
#define PG8_BAR __builtin_amdgcn_s_barrier()
#define PG8_SCHED __builtin_amdgcn_sched_barrier(0)
    Unit cur, nxt; int ui = 0;
    if (!S.next(0, cur)) return;
    f32x4 acc[2][2][4][2];
#pragma unroll
    for (int a = 0; a < 2; ++a)
#pragma unroll
        for (int b = 0; b < 2; ++b)
#pragma unroll
            for (int m = 0; m < 4; ++m)
#pragma unroll
                for (int n = 0; n < 2; ++n) acc[a][b][m][n] = (f32x4){0.f, 0.f, 0.f, 0.f};
    bf16x8 At[4][2], B0[2][2], B1[2][2];
    const char* cA = (const char*)g.A + (size_t)cur.pm * tstep; const char* cB = (const char*)g.Bt + (size_t)cur.pn * tstep;
    S.a_ready(cur);
    if constexpr (SP2) {
        PG8_STAGE(PG8_SB(0, 0), cB, voffB); PG8_STAGE(PG8_SB(0, 1), cB + hstep, voffB); PG8_STAGE(PG8_SA(0, 0), cA, voffA); PG8_STAGE(PG8_SA(0, 1), cA + hstep, voffA);
        if (wr == 1) PG8_BAR;
        PG8_WAIT_V(2); PG8_BAR;
        PG8_STAGE(PG8_SB(1, 0), cB + kstep, voffB); PG8_STAGE(PG8_SA(1, 0), cA + kstep, voffA); PG8_STAGE(PG8_SB(1, 1), cB + hstep + kstep, voffB);
        PG8_WAIT_V(6); PG8_BAR;
    } else {
        PG8_STAGE(PG8_SB(0, 0), cB, voffB); PG8_STAGE(PG8_SA(0, 0), cA, voffA); PG8_STAGE(PG8_SB(0, 1), cB + hstep, voffB); PG8_STAGE(PG8_SA(0, 1), cA + hstep, voffA);
        if (wr == 1) PG8_BAR;
        PG8_WAIT_V(4); PG8_BAR;
        PG8_STAGE(PG8_SB(1, 0), cB + kstep, voffB); PG8_STAGE(PG8_SA(1, 0), cA + kstep, voffA); PG8_STAGE(PG8_SB(1, 1), cB + hstep + kstep, voffB);
        PG8_WAIT_V(6); PG8_BAR;
    }
    for (;;) {
        const bool has_next = S.next(ui + 1, nxt);
        const char* nA = has_next ? (const char*)g.A + (size_t)nxt.pm * tstep : cA; const char* nB = has_next ? (const char*)g.Bt + (size_t)nxt.pn * tstep : cB;
        for (int t = 0; t < nt; t += 2) {
            const bool last = (t == nt - 2);
            const char* a1 = cA + (size_t)(t + 1) * kstep;
            const char* a2 = last ? nA : cA + (size_t)(t + 2) * kstep; const char* b2 = last ? nB : cB + (size_t)(t + 2) * kstep;
            const char* a3 = a2 + kstep; const char* b3 = b2 + kstep;
            if (last && has_next) S.a_ready(nxt);
            if constexpr (SP2) {
            PG8_LDB(B0, 0, 0); PG8_LDB(B1, 0, 1); PG8_SCHED; PG8_LDA(At, 0, 0); PG8_STAGE(PG8_SA(1, 1), a1 + hstep, voffA);
            PG8_WAIT_V(8); PG8_WAIT_L(0); PG8_BAR; PG8_MMA(0, 0, At, B0); PG8_MMA(0, 1, At, B1); PG8_BAR; PG8_SCHED;
            PG8_LDA(At, 0, 1); PG8_STAGE(PG8_SB(0, 0), b2, voffB); PG8_STAGE(PG8_SB(0, 1), b2 + hstep, voffB); PG8_STAGE(PG8_SA(0, 0), a2, voffA);
            PG8_WAIT_V(8); PG8_WAIT_L(0); PG8_BAR; PG8_MMA(1, 0, At, B0); PG8_MMA(1, 1, At, B1); PG8_BAR; PG8_SCHED;
            PG8_LDB(B0, 1, 0); PG8_LDB(B1, 1, 1); PG8_SCHED; PG8_LDA(At, 1, 0); PG8_STAGE(PG8_SA(0, 1), a2 + hstep, voffA);
            PG8_WAIT_V(8); PG8_WAIT_L(0); PG8_BAR; PG8_MMA(0, 0, At, B0); PG8_MMA(0, 1, At, B1); PG8_BAR; PG8_SCHED;
            PG8_LDA(At, 1, 1); PG8_STAGE(PG8_SB(1, 0), b3, voffB); PG8_STAGE(PG8_SB(1, 1), b3 + hstep, voffB); PG8_STAGE(PG8_SA(1, 0), a3, voffA);
            PG8_WAIT_V(8); PG8_WAIT_L(0); PG8_BAR; PG8_MMA(1, 0, At, B0); PG8_MMA(1, 1, At, B1); PG8_BAR; PG8_SCHED;
            } else {
            PG8_LDB(B0, 0, 0); PG8_SCHED; PG8_LDA(At, 0, 0); PG8_STAGE(PG8_SA(1, 1), a1 + hstep, voffA);
            PG8_WAIT_L(8); PG8_BAR; PG8_WAIT_L(0); PG8_MMA(0, 0, At, B0); PG8_BAR; PG8_SCHED;
            PG8_LDB(B1, 0, 1); PG8_STAGE(PG8_SB(0, 0), b2, voffB);
            PG8_BAR; PG8_WAIT_L(0); PG8_MMA(0, 1, At, B1); PG8_BAR;
            PG8_LDA(At, 0, 1); PG8_STAGE(PG8_SA(0, 0), a2, voffA);
            PG8_BAR; PG8_WAIT_L(0); PG8_MMA(1, 0, At, B0); PG8_BAR; PG8_SCHED;
            PG8_STAGE(PG8_SB(0, 1), b2 + hstep, voffB);
            PG8_WAIT_V(6); PG8_BAR; PG8_MMA(1, 1, At, B1); PG8_BAR;
            PG8_LDB(B0, 1, 0); PG8_SCHED; PG8_LDA(At, 1, 0); PG8_STAGE(PG8_SA(0, 1), a2 + hstep, voffA);
            PG8_WAIT_L(8); PG8_BAR; PG8_WAIT_L(0); PG8_MMA(0, 0, At, B0); PG8_BAR; PG8_SCHED;
            PG8_LDB(B1, 1, 1); PG8_STAGE(PG8_SB(1, 0), b3, voffB);
            PG8_BAR; PG8_WAIT_L(0); PG8_MMA(0, 1, At, B1); PG8_BAR;
            PG8_LDA(At, 1, 1); PG8_STAGE(PG8_SA(1, 0), a3, voffA);
            PG8_BAR; PG8_WAIT_L(0); PG8_MMA(1, 0, At, B0); PG8_BAR; PG8_SCHED;
            PG8_STAGE(PG8_SB(1, 1), b3 + hstep, voffB);
            PG8_WAIT_V(6); PG8_BAR; PG8_MMA(1, 1, At, B1); PG8_BAR;
            }
        }
        if constexpr (ALIGN_EPI) { if (wr == 0) PG8_BAR; }
        if constexpr (!Epi::AFTER_DRAIN) { E(acc, cur, wr, wc, fr, fq); S.done(cur); }
        if (!has_next) break;
#pragma unroll
        for (int a = 0; a < 2; ++a)
#pragma unroll
            for (int b = 0; b < 2; ++b)
#pragma unroll
                for (int m = 0; m < 4; ++m)
#pragma unroll
                    for (int n = 0; n < 2; ++n) acc[a][b][m][n] = (f32x4){0.f, 0.f, 0.f, 0.f};
        cur = nxt; cA = nA; cB = nB; ++ui;
        if constexpr (ALIGN_EPI) { if (wr == 1) PG8_BAR; }
    }
    PG8_WAIT_V(0);
    if constexpr (!ALIGN_EPI) { if (wr == 0) PG8_BAR; }
    PG8_BAR;
#undef PG8_SA
#undef PG8_SB
#undef PG8_STAGE
#undef PG8_LDA
#undef PG8_LDB
#undef PG8_MMA
#undef PG8_WAIT_V
#undef PG8_WAIT_L
#undef PG8_BAR
#undef PG8_SCHED
}
}

constexpr int NWAVES = 8, NTHR = 512;
constexpr int DM = 1024, SEQ = 8192, NB = 2, CTX = 256, TL = NB * SEQ, TC = NB * CTX, TT = TL + TC;
constexpr int FFN = 2752, FFNP = 2816, NWI = 5632, INW = 2432, INWP = 2560, NMOD = 9;
constexpr int ZF = 0, ZQ = 256, ZK = 640, ZV = 768, ZRR = 896, ZRK = 1280, ZRV = 1664, ZW = 2048, ZA = 2176, ZG = 2304;
constexpr int RW = 384;
constexpr float NORM_EPS = 1e-6f, GN_EPS = 64e-5f;

constexpr size_t MiB = 1u << 20;
constexpr size_t WS_CTL = 0, WS_MOD = 1 * MiB, WS_ROPE = 2 * MiB, WS_XC = 4 * MiB, WS_GC = 6 * MiB;
constexpr size_t WS_WI1 = 8 * MiB, WS_WO1 = 19 * MiB, WS_WIN = 25 * MiB, WS_WOUT = 30 * MiB, WS_WI2 = 32 * MiB, WS_WO2 = 43 * MiB;
constexpr size_t WS_H = 49 * MiB;
constexpr size_t WS_ACT = 82 * MiB;
constexpr size_t WS_O = 173 * MiB;
constexpr size_t WS_YD = WS_O, WS_QR = WS_O + 50 * MiB, WS_KR = WS_O + 62 * MiB;
constexpr size_t WS_W2T = WS_MOD + 256 * 1024, WS_A2T = WS_MOD + 512 * 1024, WS_G2T = WS_MOD + 768 * 1024;
constexpr size_t WS_LW = WS_O, WS_IC = WS_O + 25 * MiB;
constexpr size_t WS_GAM32 = 165 * MiB;
constexpr size_t WS_FA = 239 * MiB;
constexpr size_t WS_SUM = 255 * MiB;
constexpr size_t WS_END = 293 * MiB;

constexpr int LDS_BYTES = 147456;

typedef unsigned short bf16;
typedef float f32x4 __attribute__((ext_vector_type(4)));
typedef unsigned v4u __attribute__((ext_vector_type(4)));
typedef unsigned v2u __attribute__((ext_vector_type(2)));
#define LAS __attribute__((address_space(3)))
#define LDS_WAIT() asm volatile("s_waitcnt lgkmcnt(0)" ::: "memory")

__device__ __forceinline__ unsigned f2bf(float f) { unsigned u = __builtin_bit_cast(unsigned, f); return (u + 0x7fffu + ((u >> 16) & 1u)) >> 16; }
__device__ __forceinline__ unsigned pk2(float lo, float hi) { return f2bf(lo) | (f2bf(hi) << 16); }
__device__ __forceinline__ float bf2f(unsigned short u) { return __builtin_bit_cast(float, (unsigned)u << 16); }
__device__ __forceinline__ float bflo(unsigned u) { return __builtin_bit_cast(float, u << 16); }
__device__ __forceinline__ float bfhi(unsigned u) { return __builtin_bit_cast(float, u & 0xffff0000u); }
__device__ __forceinline__ float wave_sum(float v) {
#pragma unroll
    for (int o = 1; o < 64; o <<= 1) v += __shfl_xor(v, o);
    return v;
}
__device__ __forceinline__ float wave_max(float v) {
#pragma unroll
    for (int o = 1; o < 64; o <<= 1) v = fmaxf(v, __shfl_xor(v, o));
    return v;
}

struct Args { const float* in[25]; float* out; unsigned char* ws; int ph_lo, ph_hi; };

struct Frame {
    LAS unsigned char* lds;
    int tid, lane, wave, G, bid;
    float* out; unsigned char* ws;
};
enum { I_X = 0, I_C, I_CTX, I_CCTX, I_MODW, I_MODB, I_NORMG, I_F1WI, I_F1WO, I_WIN, I_WOUT, I_SINK, I_CONV, I_W0, I_W2, I_A0, I_A2, I_G2, I_KK, I_KA, I_RK, I_LNG, I_LNB, I_F2WI, I_F2WO };

__device__ __forceinline__ const float* inp(int i) {
    const __attribute__((address_space(4))) char* p = (const __attribute__((address_space(4))) char*)__builtin_amdgcn_kernarg_segment_ptr();
    asm volatile("" : "+s"(p));
    return *(const float* const __attribute__((address_space(4)))*)(p + 8 * i);
}
__device__ __forceinline__ void cvt_item(const float* W, int ldw, int k0, int sc, bool valid, bf16* WT, int Kd, int n0d, LAS float* scr, int lane) {
#pragma unroll 8
    for (int i = 0; i < 32; ++i) { const int kk = 2 * i + (lane >> 5); scr[kk * 33 + (lane & 31)] = valid ? W[(size_t)(k0 + kk) * ldw + sc + (lane & 31)] : 0.f; }
    LDS_WAIT(); asm volatile("" ::: "memory");
    const int c = lane & 7;
#pragma unroll
    for (int j = 0; j < 4; ++j) { const int n = (lane >> 3) + 8 * j; const LAS float* s = scr + (8 * c) * 33 + n;
        v4u o; o.x = pk2(s[0 * 33], s[1 * 33]); o.y = pk2(s[2 * 33], s[3 * 33]); o.z = pk2(s[4 * 33], s[5 * 33]); o.w = pk2(s[6 * 33], s[7 * 33]);
        *(v4u*)(WT + (size_t)(n0d + n) * Kd + k0 + 8 * c) = o; }
    LDS_WAIT(); asm volatile("" ::: "memory");
}
__device__ __forceinline__ void convert_weights(Frame& F, int li) {
    LAS float* scr = (LAS float*)(F.lds + F.wave * 16384);
    const int gw = F.bid * NWAVES + F.wave, NGW = F.G * NWAVES;
    constexpr int I_WI = 16 * (NWI / 32), I_WO = (FFNP / 64) * 32, I_IN = 16 * (INWP / 32), I_OUT = 16 * 32;
    constexpr int NITEMS = 2 * I_WI + 2 * I_WO + I_IN + I_OUT;
    for (int it = gw; it < NITEMS; it += NGW) {
        int r = it;
        if (r < 2 * I_WI) { const int f = r / I_WI; r -= f * I_WI; const int nblk = NWI / 32, kb = r / nblk, nb = r % nblk;
            const int n0 = 32 * nb, pn = n0 >> 8, i = n0 & 255; const int j = 128 * pn + (i & 127); const bool valid = j < FFN; const int sc = (i < 128) ? j : FFN + j;
            cvt_item((f ? inp(I_F2WI) : inp(I_F1WI)) + (size_t)li * DM * 2 * FFN, 2 * FFN, 64 * kb, sc, valid, (bf16*)(F.ws + (f ? WS_WI2 : WS_WI1)), DM, n0, scr, F.lane); continue; }
        r -= 2 * I_WI;
        if (r < 2 * I_WO) { const int f = r / I_WO; r -= f * I_WO; const int kb = r / 32, nb = r % 32; const bool valid = 64 * kb < FFN;
            cvt_item((f ? inp(I_F2WO) : inp(I_F1WO)) + (size_t)li * FFN * DM, DM, 64 * kb, 32 * nb, valid, (bf16*)(F.ws + (f ? WS_WO2 : WS_WO1)), FFNP, 32 * nb, scr, F.lane); continue; }
        r -= 2 * I_WO;
        if (r < I_IN) { const int nblk = INWP / 32, kb = r / nblk, nb = r % nblk; const bool valid = 32 * nb < INW;
            cvt_item(inp(I_WIN) + (size_t)li * DM * INW, INW, 64 * kb, 32 * nb, valid, (bf16*)(F.ws + WS_WIN), DM, 32 * nb, scr, F.lane); continue; }
        r -= I_IN;
        { const int kb = r / 32, nb = r % 32;
            cvt_item(inp(I_WOUT) + (size_t)li * DM * DM, DM, 64 * kb, 32 * nb, true, (bf16*)(F.ws + WS_WOUT), DM, 32 * nb, scr, F.lane); }
    }
}
__device__ __forceinline__ void mod_gemv(Frame& F) {
    LAS float* sc = (LAS float*)F.lds;
    LAS float* red = sc + 3 * 1024;
    __syncthreads();
    for (int i = F.tid; i < 3 * 1024; i += NTHR) { const int v = i >> 10, k = i & 1023; const float x = v < 2 ? inp(I_C)[v * 1024 + k] : inp(I_CCTX)[k]; sc[i] = x / (1.0f + __expf(-x)); }
    __syncthreads();
    float* modv = (float*)(F.ws + WS_MOD);
    for (int u = F.bid; u < 2 * 72; u += F.G) {
        const int l = u / 72, n0 = (u % 72) * 128;
        const float* w = inp(I_MODW) + (size_t)l * DM * 9216 + n0 + 2 * F.lane;
        float a0 = 0.f, a1 = 0.f, b0 = 0.f, b1 = 0.f, c0 = 0.f, c1 = 0.f;
        const int k0 = F.wave * 128;
#pragma unroll 8
        for (int k = 0; k < 128; ++k) { const float2 wv = *(const float2*)(w + (size_t)(k0 + k) * 9216); const float s0 = sc[k0 + k], s1 = sc[1024 + k0 + k], s2 = sc[2048 + k0 + k];
            a0 += s0 * wv.x; a1 += s0 * wv.y; b0 += s1 * wv.x; b1 += s1 * wv.y; c0 += s2 * wv.x; c1 += s2 * wv.y; }
        LAS float* rw = red + F.wave * 384 + 2 * F.lane;
        rw[0] = a0; rw[1] = a1; rw[128] = b0; rw[129] = b1; rw[256] = c0; rw[257] = c1;
        __syncthreads();
        if (F.tid < 384) { float s = 0.f;
#pragma unroll
            for (int w8 = 0; w8 < 8; ++w8) s += red[w8 * 384 + F.tid];
            const int v = F.tid >> 7, n = n0 + (F.tid & 127);
            modv[(size_t)(l * 3 + v) * 9216 + n] = s + inp(I_MODB)[l * 9216 + n]; }
        __syncthreads();
    }
}
__device__ __forceinline__ void rope_tables(Frame& F) {
    float* ct = (float*)(F.ws + WS_ROPE); float* st = ct + SEQ * 32;
    for (int i = F.bid * NTHR + F.tid; i < SEQ * 32; i += F.G * NTHR) {
        const int t = i >> 5, j = i & 31; const int f = j & 15;
        const float inv = exp2f(-(float)f * (13.287712379549449f / 16.0f));
        const float pos = (float)(j < 16 ? (t >> 6) : (t & 63));
        const float ang = pos * inv;
        const double a = (double)ang; const double k = __builtin_rint(a * 0.15915494309189535); const float r = (float)(a - k * 6.283185307179586);
        ct[i] = __cosf(r); st[i] = __sinf(r);
    }
}

struct EArgs { const float* xl_src; const float* xc_src; float* xl_dst; float* xc_dst; const float* o; const float* modv_g; int gidx; float gmul; const float* gpost;
               bf16* hdst; const float* modv_h; int shidx, scidx; const float* gpre; int nrows; };
__device__ __forceinline__ void e_phase(Frame& F, const EArgs& A) {
    const int gw = F.bid * NWAVES + F.wave, NGW = F.G * NWAVES;
    for (int r = gw; r < A.nrows; r += NGW) {
        const int v = r < TL ? (r >> 13) : 2;
        const float* xs = r < TL ? A.xl_src + (size_t)r * DM : A.xc_src + (size_t)(r - TL) * DM;
        f32x4 x[4];
#pragma unroll
        for (int j = 0; j < 4; ++j) x[j] = ((const f32x4*)xs)[F.lane + 64 * j];
        if (A.o) {
            const f32x4* orow = (const f32x4*)(A.o + (size_t)r * DM); f32x4 ov[4]; float ss = 0.f;
#pragma unroll
            for (int j = 0; j < 4; ++j) { ov[j] = orow[F.lane + 64 * j]; ss += (ov[j].x * ov[j].x + ov[j].y * ov[j].y) + (ov[j].z * ov[j].z + ov[j].w * ov[j].w); }
            const float rstd = 1.0f / sqrtf(wave_sum(ss) * (1.0f / DM) + NORM_EPS) * A.gmul;
            const f32x4* gm = (const f32x4*)(A.modv_g + (size_t)v * 9216 + A.gidx * DM); const f32x4* gp = (const f32x4*)A.gpost;
            float* xd = r < TL ? A.xl_dst + (size_t)r * DM : A.xc_dst + (size_t)(r - TL) * DM;
#pragma unroll
            for (int j = 0; j < 4; ++j) { const f32x4 g = gm[F.lane + 64 * j], p = gp[F.lane + 64 * j]; x[j] = x[j] + g * (ov[j] * rstd * p); ((f32x4*)xd)[F.lane + 64 * j] = x[j]; }
        }
        if (A.hdst) {
            float ss = 0.f;
#pragma unroll
            for (int j = 0; j < 4; ++j) ss += (x[j].x * x[j].x + x[j].y * x[j].y) + (x[j].z * x[j].z + x[j].w * x[j].w);
            const float rstd = 1.0f / sqrtf(wave_sum(ss) * (1.0f / DM) + NORM_EPS);
            const f32x4* sh = (const f32x4*)(A.modv_h + (size_t)v * 9216 + A.shidx * DM); const f32x4* scl = (const f32x4*)(A.modv_h + (size_t)v * 9216 + A.scidx * DM); const f32x4* gp = (const f32x4*)A.gpre;
            v2u* hd = (v2u*)(A.hdst + (size_t)r * DM);
#pragma unroll
            for (int j = 0; j < 4; ++j) { const f32x4 s = sh[F.lane + 64 * j], c = scl[F.lane + 64 * j], p = gp[F.lane + 64 * j]; const f32x4 hv = (x[j] * rstd * p) * (1.0f + c) + s;
                v2u w; w.x = pk2(hv.x, hv.y); w.y = pk2(hv.z, hv.w); hd[F.lane + 64 * j] = w; }
        }
    }
}

__device__ __forceinline__ const bf16* zrow(const Frame& F, int row) { return (const bf16*)(F.ws + WS_ACT) + (size_t)row * INWP; }

__device__ __forceinline__ void rope_unit(Frame& F, int u) {
    const float* ct = (const float*)(F.ws + WS_ROPE); const float* st = ct + SEQ * 32;
    bf16* qr = (bf16*)(F.ws + WS_QR); bf16* kr = (bf16*)(F.ws + WS_KR);
    for (int i = F.tid; i < 256 * 8 * 32; i += NTHR) {
        const int j = i & 31, hh = (i >> 5) & 7, tok = u * 256 + (i >> 8);
        const int s = tok & (SEQ - 1);
        const bf16* z = zrow(F, tok);
        const int col = hh < 6 ? ZQ + 64 * hh : ZK + 64 * (hh - 6);
        const float x1 = bf2f(z[col + j]), x2 = bf2f(z[col + 32 + j]);
        const float c = ct[s * 32 + j], sn = st[s * 32 + j];
        float o1 = x1 * c - x2 * sn, o2 = x2 * c + x1 * sn;
        if (hh < 6) { o1 *= 0.125f; o2 *= 0.125f; qr[(size_t)tok * 384 + 64 * hh + j] = (bf16)f2bf(o1); qr[(size_t)tok * 384 + 64 * hh + 32 + j] = (bf16)f2bf(o2); }
        else { kr[(size_t)tok * 128 + 64 * (hh - 6) + j] = (bf16)f2bf(o1); kr[(size_t)tok * 128 + 64 * (hh - 6) + 32 + j] = (bf16)f2bf(o2); }
    }
}

__device__ __forceinline__ void fourier_a_unit(Frame& F, int u) {
    const int b = u >> 7, n2 = u & 127;
    LAS float* tab = (LAS float*)F.lds;
    __syncthreads();
    if (F.tid < 64) { const float a = (float)F.tid * (1.0f / 64.0f); tab[F.tid] = __builtin_amdgcn_cosf(a); tab[64 + F.tid] = __builtin_amdgcn_sinf(a); }
    __syncthreads();
    const int c = F.tid & 255, kh = F.tid >> 8;
    float f[64];
#pragma unroll
    for (int n1 = 0; n1 < 64; ++n1) f[n1] = bf2f(zrow(F, b * SEQ + 128 * n1 + n2)[ZF + c]);
    bf16* far = (bf16*)(F.ws + WS_FA); bf16* fai = far + (size_t)NB * 64 * 128 * 256;
    for (int kk = 0; kk < 32; ++kk) { const int k1 = kh * 32 + kk;
        float sr = 0.f, si = 0.f;
#pragma unroll
        for (int n1 = 0; n1 < 64; ++n1) { const int idx = (n1 * k1) & 63; sr += f[n1] * tab[idx]; si -= f[n1] * tab[64 + idx]; }
        const float tw = (float)(n2 * k1) * (1.0f / 8192.0f); const float tc = __builtin_amdgcn_cosf(tw), ts = -__builtin_amdgcn_sinf(tw);
        const size_t o = (((size_t)b * 64 + k1) * 128 + n2) * 256 + c;
        far[o] = (bf16)f2bf(sr * tc - si * ts); fai[o] = (bf16)f2bf(sr * ts + si * tc);
    }
}
__device__ __forceinline__ void fourier_c_unit(Frame& F, int u) {
    const int b = u >> 7, k1 = (u >> 1) & 63, half = u & 1;
    LAS float* tab = (LAS float*)F.lds;
    LAS float* tab64 = tab + 256;
    LAS float* P = tab + 512;
    __syncthreads();
    if (F.tid < 128) { const float a = (float)F.tid * (1.0f / 128.0f); tab[F.tid] = __builtin_amdgcn_cosf(a); tab[128 + F.tid] = __builtin_amdgcn_sinf(a); }
    if (F.tid >= 128 && F.tid < 192) { const float a = (float)(F.tid - 128) * (1.0f / 64.0f); tab64[F.tid - 128] = __builtin_amdgcn_cosf(a); tab64[64 + F.tid - 128] = __builtin_amdgcn_sinf(a); }
    __syncthreads();
    const int c = F.tid & 255, q = F.tid >> 8;
    const bf16* far = (const bf16*)(F.ws + WS_FA) + (((size_t)b * 64 + k1) * 128) * 256 + c; const bf16* fai = far + (size_t)NB * 64 * 128 * 256;
    float ar[32], ai[32];
#pragma unroll
    for (int i = 0; i < 32; ++i) { ar[i] = 0.f; ai[i] = 0.f; }
    const int k2b = 64 * half + 32 * q;
    for (int n2 = 0; n2 < 128; ++n2) { const float xr = bf2f(far[(size_t)n2 * 256]), xi = bf2f(fai[(size_t)n2 * 256]);
#pragma unroll
        for (int i = 0; i < 32; ++i) { const int idx = (n2 * (k2b + i)) & 127; const float cs = tab[idx], sn = tab[128 + idx];
            ar[i] += xr * cs + xi * sn; ai[i] += xi * cs - xr * sn; } }
    bf16* mix = (bf16*)(F.ws + WS_H);
    const int g = c >> 6;
    float y[32];
#pragma unroll
    for (int i = 0; i < 32; ++i) y[i] = 0.f;
#pragma unroll
    for (int rnd = 0; rnd < 2; ++rnd) {
        __syncthreads();
#pragma unroll
        for (int i = 0; i < 32; ++i) P[(32 * q + i) * 256 + c] = rnd == 0 ? ar[i] : ai[i];
        __syncthreads();
        const int m = c & 63;
        for (int cc = 0; cc < 64; ++cc) { const int idx = (m * cc) & 63; const float t = rnd == 0 ? tab64[idx] : tab64[64 + idx];
#pragma unroll
            for (int i = 0; i < 32; ++i) y[i] += P[(32 * q + i) * 256 + 64 * g + cc] * t; }
    }
    const float scale = 0.0013810679320049757f;
#pragma unroll
    for (int i = 0; i < 32; ++i) { const int k = k1 + 64 * (k2b + i); mix[(size_t)(b * SEQ + k) * DM + c] = (bf16)f2bf(y[i] * scale); }
}
__device__ __forceinline__ void fourier_ctx1_unit(Frame& F, int u) {
    float* gr = (float*)(F.ws + WS_GC); float* gi = gr + TC * 256;
    for (int i = F.tid; i < 32 * 256; i += NTHR) { const int tok = u * 32 + (i >> 8), gm = i & 255, g = gm >> 6, m = gm & 63;
        const bf16* z = zrow(F, TL + tok) + ZF + 64 * g; float sr = 0.f, si = 0.f;
        for (int c = 0; c < 64; ++c) { const float a = (float)((m * c) & 63) * (1.0f / 64.0f); const float x = bf2f(z[c]); sr += x * __builtin_amdgcn_cosf(a); si -= x * __builtin_amdgcn_sinf(a); }
        gr[tok * 256 + gm] = sr; gi[tok * 256 + gm] = si; }
}
__device__ __forceinline__ void fourier_ctx2_unit(Frame& F, int u) {
    const float* gr = (const float*)(F.ws + WS_GC); const float* gi = gr + TC * 256; bf16* mix = (bf16*)(F.ws + WS_H);
    const int b = u >> 4, kb = (u & 15) * 16;
    for (int i = F.tid; i < 16 * 256; i += NTHR) { const int k = kb + (i >> 8), gm = i & 255; float y = 0.f;
        for (int n = 0; n < 256; ++n) { const float a = (float)((k * n) & 255) * (1.0f / 256.0f); y += gr[(b * 256 + n) * 256 + gm] * __builtin_amdgcn_cosf(a) + gi[(b * 256 + n) * 256 + gm] * __builtin_amdgcn_sinf(a); }
        mix[(size_t)(TL + b * 256 + k) * DM + gm] = (bf16)f2bf(y * 0.0078125f); }
}

__device__ __forceinline__ float dot64(const float (&q)[64], const bf16* krow) {
    float s = 0.f;
#pragma unroll
    for (int i = 0; i < 8; ++i) { const v4u w = ((const v4u*)krow)[i];
        s += q[8 * i + 0] * bflo(w.x) + q[8 * i + 1] * bfhi(w.x) + q[8 * i + 2] * bflo(w.y) + q[8 * i + 3] * bfhi(w.y) + q[8 * i + 4] * bflo(w.z) + q[8 * i + 5] * bfhi(w.z) + q[8 * i + 6] * bflo(w.w) + q[8 * i + 7] * bfhi(w.w); }
    return s;
}
__device__ __forceinline__ void attn_v1(Frame& F, int li) {
    const int gw = F.bid * NWAVES + F.wave, NGW = F.G * NWAVES;
    const bf16* qr = (const bf16*)(F.ws + WS_QR); const bf16* kr = (const bf16*)(F.ws + WS_KR); bf16* mix = (bf16*)(F.ws + WS_H);
    const float* sink = inp(I_SINK) + li * 6;
    const int npairs = (li == 0 ? TT : TL) * 6;
    for (int p = gw; p < npairs; p += NGW) {
        const int row = p / 6, hq = p % 6, kvh = hq / 3; const bool isctx = row >= TL;
        const int b = isctx ? (row - TL) >> 8 : row >> 13, s = row & (SEQ - 1);
        float q[64];
        if (!isctx) {
#pragma unroll
            for (int i = 0; i < 8; ++i) { const v4u w = ((const v4u*)(qr + (size_t)row * 384 + 64 * hq))[i];
                q[8 * i] = bflo(w.x); q[8 * i + 1] = bfhi(w.x); q[8 * i + 2] = bflo(w.y); q[8 * i + 3] = bfhi(w.y); q[8 * i + 4] = bflo(w.z); q[8 * i + 5] = bfhi(w.z); q[8 * i + 6] = bflo(w.w); q[8 * i + 7] = bfhi(w.w); }
        } else {
#pragma unroll
            for (int i = 0; i < 8; ++i) { const v4u w = ((const v4u*)(zrow(F, row) + ZQ + 64 * hq))[i];
                q[8 * i] = 0.125f * bflo(w.x); q[8 * i + 1] = 0.125f * bfhi(w.x); q[8 * i + 2] = 0.125f * bflo(w.y); q[8 * i + 3] = 0.125f * bfhi(w.y); q[8 * i + 4] = 0.125f * bflo(w.z); q[8 * i + 5] = 0.125f * bfhi(w.z); q[8 * i + 6] = 0.125f * bflo(w.w); q[8 * i + 7] = 0.125f * bfhi(w.w); }
        }
        float sc[9]; int krow_[9];
        const float NEG = -INFINITY;
        float mx = sink[hq];
#pragma unroll
        for (int r = 0; r < 9; ++r) {
            if (r < 5) {
                const int kp = s - 128 + 64 * r + F.lane; const bool ok = !isctx && kp >= 0 && kp < SEQ && kp <= s + 128;
                const int kc = ok ? kp : 0; krow_[r] = b * SEQ + kc;
                const float d = isctx ? 0.f : dot64(q, kr + (size_t)(b * SEQ + kc) * 128 + 64 * kvh);
                sc[r] = ok ? d : NEG;
            } else {
                const int kc = 64 * (r - 5) + F.lane; krow_[r] = TL + b * CTX + kc;
                sc[r] = dot64(q, zrow(F, TL + b * CTX + kc) + ZK + 64 * kvh);
            }
            mx = fmaxf(mx, sc[r]);
        }
        mx = wave_max(mx);
        float den = 0.f;
#pragma unroll
        for (int r = 0; r < 9; ++r) { sc[r] = __expf(sc[r] - mx); den += sc[r]; }
        den = wave_sum(den) + __expf(sink[hq] - mx);
        float acc = 0.f;
#pragma unroll
        for (int r = 0; r < 9; ++r) {
            if (r < 5 && isctx) continue;
            for (int kk = 0; kk < 64; ++kk) { const float pk = __builtin_bit_cast(float, __builtin_amdgcn_readlane(__builtin_bit_cast(int, sc[r]), kk)); const int kr_ = __builtin_amdgcn_readlane(krow_[r], kk);
                acc += pk * bf2f(zrow(F, kr_)[ZV + 64 * kvh + F.lane]); }
        }
        mix[(size_t)row * DM + 256 + 64 * hq + F.lane] = (bf16)f2bf(acc / den);
    }
}

typedef short bf16x8 __attribute__((ext_vector_type(8)));
#define MFMA16(a, b, c) __builtin_amdgcn_mfma_f32_16x16x32_bf16(a, b, c, 0, 0, 0)
__device__ __forceinline__ bf16x8 mk8(unsigned a, unsigned b, unsigned c, unsigned d) { const v4u v = {a, b, c, d}; return __builtin_bit_cast(bf16x8, v); }
typedef __bf16 bf16x2_t __attribute__((ext_vector_type(2)));
typedef float f32x2_t __attribute__((ext_vector_type(2)));
__device__ __forceinline__ unsigned cvtpk(float lo, float hi) { const f32x2_t f = {lo, hi}; return __builtin_bit_cast(unsigned, __builtin_convertvector(f, bf16x2_t)); }
constexpr int NSC = 66;
constexpr int IM_AI = 0, IM_RI = 4608, IM_BI = 9216, IM_KI = 13824, IM_BKT = 18432, IM_VT = 28672, IM_GAM = 33792, IMG_BYTES = 34816;
constexpr int L_IMG0 = 0, L_IMG1 = IMG_BYTES, L_PKG = 2 * IMG_BYTES, L_YL = L_PKG + 8192, L_VB = L_YL + 128 * 68 * 4, L_BON = L_VB + 128 * 64 * 2, L_CST = L_BON + 512, L_RW_END = L_CST + 3072;
static_assert(L_RW_END <= 146432, "rwkv LDS map");
constexpr size_t SUM_SLOT = 24576;

__device__ __forceinline__ void lora_transposes(Frame& F) {
    bf16* w2t = (bf16*)(F.ws + WS_W2T); bf16* a2t = (bf16*)(F.ws + WS_A2T); bf16* g2t = (bf16*)(F.ws + WS_G2T);
    const float* w2 = inp(I_W2); const float* a2 = inp(I_A2); const float* g2 = inp(I_G2);
    for (int i = F.bid * NTHR + F.tid; i < 4 * 384 * 64; i += F.G * NTHR) { const int r = i & 63, col = (i >> 6) % 384, ld = i / (384 * 64);
        w2t[i] = (bf16)f2bf(w2[((size_t)ld * 64 + r) * RW + col]); a2t[i] = (bf16)f2bf(a2[((size_t)ld * 64 + r) * RW + col]); }
    for (int i = F.bid * NTHR + F.tid; i < 2 * 384 * 128; i += F.G * NTHR) { const int r = i & 127, col = (i >> 7) % 384, l = i / (384 * 128);
        g2t[i] = (bf16)f2bf(g2[((size_t)l * 128 + r) * RW + col]); }
}

__device__ __forceinline__ float softplus_fast(float x) { return fmaxf(x, 0.f) + __logf(1.0f + __expf(-fabsf(x))); }
__device__ __forceinline__ void lora_unit(Frame& F, int li, int u) {
    const int dir = u & 1, r0 = (u >> 1) * 64, q = F.lane >> 4, c16 = F.lane & 15;
    bf16* LW = (bf16*)(F.ws + WS_LW) + (size_t)dir * TT * RW; bf16* IC = (bf16*)(F.ws + WS_IC) + (size_t)dir * TT * RW;
    const bf16* w2t = (const bf16*)(F.ws + WS_W2T) + (size_t)(li * 2 + dir) * 384 * 64; const bf16* a2t = (const bf16*)(F.ws + WS_A2T) + (size_t)(li * 2 + dir) * 384 * 64;
    bf16x8 bw[4][2], ba[4][2];
#pragma unroll
    for (int rt = 0; rt < 4; ++rt)
#pragma unroll
        for (int k = 0; k < 2; ++k) { const bf16* z = zrow(F, r0 + 16 * rt + c16);
            const v4u zw = *(const v4u*)(z + ZW + 64 * dir + 32 * k + 8 * q); ba[rt][k] = *(const bf16x8*)(z + ZA + 64 * dir + 32 * k + 8 * q);
            bw[rt][k] = mk8(pk2(tanhf(bflo(zw.x)), tanhf(bfhi(zw.x))), pk2(tanhf(bflo(zw.y)), tanhf(bfhi(zw.y))), pk2(tanhf(bflo(zw.z)), tanhf(bfhi(zw.z))), pk2(tanhf(bflo(zw.w)), tanhf(bfhi(zw.w)))); }
#pragma unroll 1
    for (int cti = 0; cti < 3; ++cti) { const int ct = 3 * F.wave + cti; const int col = 16 * ct + c16;
        bf16x8 aw[2], aa[2];
#pragma unroll
        for (int k = 0; k < 2; ++k) { aw[k] = *(const bf16x8*)(w2t + (size_t)col * 64 + 32 * k + 8 * q); aa[k] = *(const bf16x8*)(a2t + (size_t)col * 64 + 32 * k + 8 * q); }
        const f32x4 w0v = *(const f32x4*)(inp(I_W0) + (li * 2 + dir) * RW + 16 * ct + 4 * q); const f32x4 a0v = *(const f32x4*)(inp(I_A0) + (li * 2 + dir) * RW + 16 * ct + 4 * q);
#pragma unroll
        for (int rt = 0; rt < 4; ++rt) { f32x4 dw = {0.f, 0.f, 0.f, 0.f}, da = {0.f, 0.f, 0.f, 0.f};
#pragma unroll
            for (int k = 0; k < 2; ++k) { dw = MFMA16(aw[k], bw[rt][k], dw); da = MFMA16(aa[k], ba[rt][k], da); }
            float lw[4], ic[4];
#pragma unroll
            for (int e = 0; e < 4; ++e) { const float x = w0v[e] + dw[e]; const float wl = -softplus_fast(-x) - 0.5f; lw[e] = -__expf(wl); ic[e] = 1.0f / (1.0f + __expf(-(a0v[e] + da[e]))); }
#pragma unroll
            for (int d = 1; d < 16; d <<= 1) {
#pragma unroll
                for (int e = 0; e < 4; ++e) { const float up = __shfl_up(lw[e], d, 16), dn = __shfl_down(lw[e], d, 16); lw[e] += dir == 0 ? (c16 >= d ? up : 0.f) : (c16 + d < 16 ? dn : 0.f); } }
#pragma unroll
            for (int e = 0; e < 4; ++e) lw[e] = __expf(lw[e]);
            if (c16 == (dir == 0 ? 15 : 0)) *(f32x4*)((float*)(F.ws + WS_GAM32) + ((size_t)dir * (TT / 16) + ((r0 + 16 * rt) >> 4)) * RW + 16 * ct + 4 * q) = (f32x4){lw[0], lw[1], lw[2], lw[3]};
            const size_t o = (size_t)(r0 + 16 * rt + c16) * RW + 16 * ct + 4 * q;
            v2u w; w.x = pk2(lw[0], lw[1]); w.y = pk2(lw[2], lw[3]); *(v2u*)(LW + o) = w; w.x = pk2(ic[0], ic[1]); w.y = pk2(ic[2], ic[3]); *(v2u*)(IC + o) = w; }
    }
}

struct ChainCtx { int dir, b, h, li; float kkw, kaw, rkw; float cw[3][3]; };
__device__ __forceinline__ void chain_consts(ChainCtx& C, int li, int dir, int b, int h, int j) {
    C.dir = dir; C.b = b; C.h = h; C.li = li; const int ch = 64 * h + j;
    C.kkw = inp(I_KK)[li * RW + ch]; C.kaw = inp(I_KA)[li * RW + ch]; C.rkw = inp(I_RK)[li * RW + ch];
#pragma unroll
    for (int t = 0; t < 3; ++t)
#pragma unroll
        for (int qq = 0; qq < 3; ++qq) C.cw[t][qq] = inp(I_CONV)[(size_t)(li * 3 + t) * (3 * RW) + qq * RW + ch];
}
template <int TPT, bool BONUS>
__device__ __forceinline__ void prep_round(Frame& F, const ChainCtx& C, LAS unsigned char* img, int j, int tg, bool isctx, int step0, LAS unsigned char* lds_vb, LAS float* lds_bon, int pos0_local) {
    const int L = isctx ? CTX : SEQ, rbase = isctx ? TL + C.b * CTX : C.b * SEQ, ch = 64 * C.h + j;
    const bf16* LW = (const bf16*)(F.ws + WS_LW) + (size_t)C.dir * TT * RW + ch; const bf16* IC = (const bf16*)(F.ws + WS_IC) + (size_t)C.dir * TT * RW + ch;
    const int tok0 = tg * TPT, blk = tok0 >> 4;
    float cum = 0.f;
    for (int t = blk * 16; t < tok0; ++t) { const int s = step0 + t; const int p = C.dir ? L - 1 - s : s; cum += bf2f(LW[(size_t)(rbase + p) * RW]); }
    float eprev = __expf(cum);
    const int pj = (j & ~31) | (((j & 15) >> 2) << 3) | (((j >> 4) & 1) << 2) | (j & 3);
    LAS bf16* AI = (LAS bf16*)(img + IM_AI) + blk * 1152, *RI = (LAS bf16*)(img + IM_RI) + blk * 1152, *BI = (LAS bf16*)(img + IM_BI) + blk * 1152, *KI = (LAS bf16*)(img + IM_KI) + blk * 1152;
    LAS bf16* BKT = (LAS bf16*)(img + IM_BKT) + blk * 2560 + j * 40; LAS bf16* VT = (LAS bf16*)(img + IM_VT) + blk * 1280 + j * 20; LAS float* GAM = (LAS float*)(img + IM_GAM) + blk * 64;
#pragma unroll 2
    for (int u = 0; u < TPT; ++u) { const int t = tok0 + u, tb = t & 15; const int s = step0 + t; const int p = C.dir ? L - 1 - s : s; const int row = rbase + p;
        const float lw = bf2f(LW[(size_t)row * RW]), ai = bf2f(IC[(size_t)row * RW]);
        float rv = 0.f, kv = 0.f, vv = 0.f;
#pragma unroll
        for (int tt = 0; tt < 3; ++tt) { const int pp = p + tt - 1; if (pp >= 0 && pp < L) { const bf16* z = zrow(F, rbase + pp); rv += C.cw[tt][0] * bf2f(z[ZRR + ch]); kv += C.cw[tt][1] * bf2f(z[ZRK + ch]); vv += C.cw[tt][2] * bf2f(z[ZRV + ch]); } }
        const float kkr = kv * C.kkw; const float ss = wave_sum(kkr * kkr); const float kk = kkr * (1.0f / sqrtf(fmaxf(ss, 1e-24f)));
        const float kd = kv * (1.0f + (ai - 1.0f) * C.kaw);
        const float ec = eprev * __expf(lw), en = 1.0f / ec;
        AI[tb * 72 + pj] = (bf16)f2bf(-kk * eprev); RI[tb * 72 + pj] = (bf16)f2bf(rv * ec);
        const bf16 bt = (bf16)f2bf(kk * ai * en), kt = (bf16)f2bf(kd * en);
        BI[tb * 72 + pj] = bt; KI[tb * 72 + pj] = kt;
        BKT[(tb >> 2) * 8 + (tb & 3)] = bt; BKT[(tb >> 2) * 8 + 4 + (tb & 3)] = kt;
        VT[tb] = (bf16)f2bf(vv);
        if (tb == 15) GAM[j] = ec;
        if constexpr (BONUS) { const float bs = wave_sum(rv * kv * C.rkw); const int pl = C.dir ? pos0_local - t : pos0_local + t;
            ((LAS bf16*)lds_vb)[pl * 64 + j] = (bf16)f2bf(vv); if (j == 0) lds_bon[pl] = bs; }
        eprev = ec; }
}
__device__ __forceinline__ void chain_consts_lds(Frame& F, LAS float* cst, int li, int h, int t256) {
    for (int i = t256; i < 12 * 64; i += 256) { const int k = i >> 6, j = i & 63, ch = 64 * h + j; float v;
        if (k == 0) v = inp(I_KK)[li * RW + ch]; else if (k == 1) v = inp(I_KA)[li * RW + ch]; else if (k == 2) v = inp(I_RK)[li * RW + ch];
        else { const int tt = (k - 3) / 3, w = (k - 3) % 3; v = inp(I_CONV)[(size_t)(li * 3 + tt) * (3 * RW) + w * RW + ch]; }
        cst[i] = v; }
}
__device__ __forceinline__ void unpack8(const v4u w, float (&f)[8]) { f[0] = bflo(w.x); f[1] = bfhi(w.x); f[2] = bflo(w.y); f[3] = bfhi(w.y); f[4] = bflo(w.z); f[5] = bfhi(w.z); f[6] = bflo(w.w); f[7] = bfhi(w.w); }
__device__ __forceinline__ void prep_round2(Frame& F, const LAS float* cst, LAS unsigned char* img, int dir, int b, int h, int tl, int o, bool isctx, int step0, LAS unsigned char* lds_vb, LAS float* lds_bon, int pos0_local) {
    const bool BONUS = lds_vb != nullptr;
    const int L = isctx ? CTX : SEQ, rbase = isctx ? TL + b * CTX : b * SEQ, ch0 = 64 * h + 8 * o;
    const bf16* LW = (const bf16*)(F.ws + WS_LW) + (size_t)dir * TT * RW + ch0; const bf16* IC = (const bf16*)(F.ws + WS_IC) + (size_t)dir * TT * RW + ch0;
    const int blk = tl >> 4, tb = tl & 15;
    const int s = step0 + tl; const int p = dir ? L - 1 - s : s; const int row = rbase + p;
    const v4u ecw = *(const v4u*)(LW + (size_t)row * RW), icv = *(const v4u*)(IC + (size_t)row * RW);
    const v4u epw = *(const v4u*)(LW + (size_t)(tb == 0 ? row : (dir ? row + 1 : row - 1)) * RW);
    v4u zr[3], zk[3], zv[3];
#pragma unroll
    for (int tt = 0; tt < 3; ++tt) { const int pp = p + tt - 1; const bool ok = pp >= 0 && pp < L; const bf16* z = zrow(F, rbase + (ok ? pp : p)) + ch0;
        const v4u z0 = {0u, 0u, 0u, 0u};
        zr[tt] = ok ? *(const v4u*)(z + ZRR) : z0; zk[tt] = ok ? *(const v4u*)(z + ZRK) : z0; zv[tt] = ok ? *(const v4u*)(z + ZRV) : z0; }
    float ecf[8], epf[8], ai[8], rv[8], kv[8], vv[8];
    unpack8(ecw, ecf); unpack8(epw, epf); unpack8(icv, ai);
#pragma unroll
    for (int e = 0; e < 8; ++e) { rv[e] = 0.f; kv[e] = 0.f; vv[e] = 0.f; }
#pragma unroll
    for (int tt = 0; tt < 3; ++tt) { float a[8], bq[8], cq[8]; unpack8(zr[tt], a); unpack8(zk[tt], bq); unpack8(zv[tt], cq);
        const LAS f32x4* w0 = (const LAS f32x4*)(cst + (3 + tt * 3 + 0) * 64 + 8 * o); const LAS f32x4* w1 = (const LAS f32x4*)(cst + (3 + tt * 3 + 1) * 64 + 8 * o); const LAS f32x4* w2 = (const LAS f32x4*)(cst + (3 + tt * 3 + 2) * 64 + 8 * o);
        const f32x4 w0a = w0[0], w0b = w0[1], w1a = w1[0], w1b = w1[1], w2a = w2[0], w2b = w2[1];
#pragma unroll
        for (int e = 0; e < 4; ++e) { rv[e] += w0a[e] * a[e]; rv[e + 4] += w0b[e] * a[e + 4]; kv[e] += w1a[e] * bq[e]; kv[e + 4] += w1b[e] * bq[e + 4]; vv[e] += w2a[e] * cq[e]; vv[e + 4] += w2b[e] * cq[e + 4]; } }
    float kkw[8], kaw[8];
    { const LAS f32x4* a = (const LAS f32x4*)(cst + 0 * 64 + 8 * o); const LAS f32x4* bq = (const LAS f32x4*)(cst + 1 * 64 + 8 * o); const f32x4 a0 = a[0], a1 = a[1], b0 = bq[0], b1 = bq[1];
#pragma unroll
      for (int e = 0; e < 4; ++e) { kkw[e] = a0[e]; kkw[e + 4] = a1[e]; kaw[e] = b0[e]; kaw[e + 4] = b1[e]; } }
    float kkr[8], ss = 0.f;
#pragma unroll
    for (int e = 0; e < 8; ++e) { kkr[e] = kv[e] * kkw[e]; ss += kkr[e] * kkr[e]; }
    ss += __shfl_xor(ss, 1); ss += __shfl_xor(ss, 2); ss += __shfl_xor(ss, 4);
    const float rn = 1.0f / sqrtf(fmaxf(ss, 1e-24f));
    float At[8], Rt[8], Bt[8], Kt[8];
#pragma unroll
    for (int e = 0; e < 8; ++e) { const float kk = kkr[e] * rn, kd = kv[e] * (1.0f + (ai[e] - 1.0f) * kaw[e]); const float eprev = tb == 0 ? 1.0f : epf[e]; const float ec = ecf[e], en = 1.0f / ec;
        At[e] = -kk * eprev; Rt[e] = rv[e] * ec; Bt[e] = kk * ai[e] * en; Kt[e] = kd * en; }
    const int P0 = 32 * (o >> 2) + 16 * (o & 1) + 4 * ((o >> 1) & 1);
    LAS bf16* AI = (LAS bf16*)(img + IM_AI) + blk * 1152 + tb * 72 + P0, *RI = (LAS bf16*)(img + IM_RI) + blk * 1152 + tb * 72 + P0, *BI = (LAS bf16*)(img + IM_BI) + blk * 1152 + tb * 72 + P0, *KI = (LAS bf16*)(img + IM_KI) + blk * 1152 + tb * 72 + P0;
    unsigned bp[4], kp[4];
#pragma unroll
    for (int e = 0; e < 4; ++e) { bp[e] = cvtpk(Bt[2 * e], Bt[2 * e + 1]); kp[e] = cvtpk(Kt[2 * e], Kt[2 * e + 1]); }
    *(LAS v2u*)AI = (v2u){cvtpk(At[0], At[1]), cvtpk(At[2], At[3])}; *(LAS v2u*)(AI + 8) = (v2u){cvtpk(At[4], At[5]), cvtpk(At[6], At[7])};
    *(LAS v2u*)RI = (v2u){cvtpk(Rt[0], Rt[1]), cvtpk(Rt[2], Rt[3])}; *(LAS v2u*)(RI + 8) = (v2u){cvtpk(Rt[4], Rt[5]), cvtpk(Rt[6], Rt[7])};
    *(LAS v2u*)BI = (v2u){bp[0], bp[1]}; *(LAS v2u*)(BI + 8) = (v2u){bp[2], bp[3]};
    *(LAS v2u*)KI = (v2u){kp[0], kp[1]}; *(LAS v2u*)(KI + 8) = (v2u){kp[2], kp[3]};
    LAS bf16* BKT = (LAS bf16*)(img + IM_BKT) + blk * 2560 + (8 * o) * 40 + (tb >> 2) * 8 + (tb & 3); LAS bf16* VT = (LAS bf16*)(img + IM_VT) + blk * 1280 + (8 * o) * 20 + tb;
    const unsigned vp[4] = {cvtpk(vv[0], vv[1]), cvtpk(vv[2], vv[3]), cvtpk(vv[4], vv[5]), cvtpk(vv[6], vv[7])};
#pragma unroll
    for (int e = 0; e < 8; ++e) { const unsigned bb = bp[e >> 1], kq = kp[e >> 1], vq = vp[e >> 1];
        BKT[e * 40] = (bf16)((e & 1) ? (bb >> 16) : (bb & 0xffff)); BKT[e * 40 + 4] = (bf16)((e & 1) ? (kq >> 16) : (kq & 0xffff)); VT[e * 20] = (bf16)((e & 1) ? (vq >> 16) : (vq & 0xffff)); }
    if (tb == 15) { const f32x4* gs = (const f32x4*)((const float*)(F.ws + WS_GAM32) + ((size_t)dir * (TT / 16) + (row >> 4)) * RW + ch0); LAS f32x4* G = (LAS f32x4*)((LAS float*)(img + IM_GAM) + blk * 64 + 8 * o); G[0] = gs[0]; G[1] = gs[1]; }
    if (BONUS) { float bs = 0.f; const LAS f32x4* rk = (const LAS f32x4*)(cst + 2 * 64 + 8 * o); const f32x4 r0 = rk[0], r1 = rk[1];
#pragma unroll
        for (int e = 0; e < 4; ++e) bs += rv[e] * kv[e] * r0[e] + rv[e + 4] * kv[e + 4] * r1[e];
        bs += __shfl_xor(bs, 1); bs += __shfl_xor(bs, 2); bs += __shfl_xor(bs, 4);
        const int pl = dir ? pos0_local - tl : pos0_local + tl;
        *(LAS v4u*)(lds_vb + (pl * 64 + 8 * o) * 2) = (v4u){vp[0], vp[1], vp[2], vp[3]}; if (o == 0) lds_bon[pl] = bs; }
}
template <bool WANT_Y>
__device__ __forceinline__ void block_package(LAS unsigned char* img, int blk, LAS unsigned* pkg, int lane) {
    const int q = lane >> 4, c = lane & 15;
    f32x4 mab = {0.f, 0.f, 0.f, 0.f}, mak = mab, mbr = mab, mkr = mab;
#pragma unroll
    for (int k = 0; k < 2; ++k) { const int o = blk * 2304 + c * 144 + k * 64 + q * 16;
        const bf16x8 bi = *(const LAS bf16x8*)(img + IM_BI + o), ki = *(const LAS bf16x8*)(img + IM_KI + o), ai = *(const LAS bf16x8*)(img + IM_AI + o);
        mab = MFMA16(bi, ai, mab); mak = MFMA16(ki, ai, mak);
        if constexpr (WANT_Y) { const bf16x8 ri = *(const LAS bf16x8*)(img + IM_RI + o); mbr = MFMA16(bi, ri, mbr); mkr = MFMA16(ki, ri, mkr); } }
#pragma unroll
    for (int e = 0; e < 4; ++e) { const int s = 4 * q + e; if (!(s < c)) { mab[e] = 0.f; mak[e] = 0.f; } if (!(s <= c)) { mbr[e] = 0.f; mkr[e] = 0.f; } }
    float n[16];
    { LAS float* mf = (LAS float*)pkg;
#pragma unroll
      for (int e = 0; e < 4; ++e) mf[(4 * q + e) * 16 + c] = mab[e];
      asm volatile("s_waitcnt lgkmcnt(0)" ::: "memory");
#pragma unroll
      for (int s = 15; s >= 0; --s) { float acc = (c == s) ? 1.0f : 0.0f;
#pragma unroll
          for (int t = s + 1; t < 16; ++t) acc += mf[s * 16 + t] * n[t];
          n[s] = acc; }
      asm volatile("s_waitcnt lgkmcnt(0)" ::: "memory"); }
    float nq[4];
#pragma unroll
    for (int e = 0; e < 4; ++e) nq[e] = q == 0 ? n[e] : (q == 1 ? n[4 + e] : (q == 2 ? n[8 + e] : n[12 + e]));
    pkg[0 * 64 + lane] = cvtpk(nq[0], nq[1]); pkg[1 * 64 + lane] = cvtpk(nq[2], nq[3]);
    pkg[2 * 64 + lane] = cvtpk(mak[0], mak[1]); pkg[3 * 64 + lane] = cvtpk(mak[2], mak[3]);
    if constexpr (WANT_Y) { pkg[4 * 64 + lane] = cvtpk(mbr[0], mbr[1]); pkg[5 * 64 + lane] = cvtpk(mbr[2], mbr[3]); pkg[6 * 64 + lane] = cvtpk(mkr[0], mkr[1]); pkg[7 * 64 + lane] = cvtpk(mkr[2], mkr[3]); }
}
template <bool WANT_Y, bool HAS_V>
__device__ __forceinline__ f32x4 block_scan(LAS unsigned char* img, int blk, const LAS unsigned* pkg, f32x4 (&S)[4], int wq, int lane) {
    const int q = lane >> 4, c = lane & 15;
    bf16x8 Sb[2];
#pragma unroll
    for (int k = 0; k < 2; ++k) Sb[k] = mk8(cvtpk(S[2 * k][0], S[2 * k][1]), cvtpk(S[2 * k][2], S[2 * k][3]), cvtpk(S[2 * k + 1][0], S[2 * k + 1][1]), cvtpk(S[2 * k + 1][2], S[2 * k + 1][3]));
    v2u vpk = {0u, 0u};
    if constexpr (HAS_V) vpk = *(const LAS v2u*)(img + IM_VT + blk * 2560 + (c + 16 * wq) * 40 + q * 8);
    const int ao = blk * 2304 + c * 144 + q * 16;
    f32x4 rhs = {0.f, 0.f, 0.f, 0.f};
    rhs = MFMA16(*(const LAS bf16x8*)(img + IM_AI + ao), Sb[0], rhs); rhs = MFMA16(*(const LAS bf16x8*)(img + IM_AI + ao + 64), Sb[1], rhs);
    if constexpr (HAS_V) rhs = MFMA16(mk8(0u, 0u, pkg[2 * 64 + lane], pkg[3 * 64 + lane]), mk8(0u, 0u, vpk.x, vpk.y), rhs);
    f32x4 u = {0.f, 0.f, 0.f, 0.f};
    u = MFMA16(mk8(pkg[0 * 64 + lane], pkg[1 * 64 + lane], 0u, 0u), mk8(cvtpk(rhs[0], rhs[1]), cvtpk(rhs[2], rhs[3]), 0u, 0u), u);
    const bf16x8 UV = mk8(cvtpk(u[0], u[1]), cvtpk(u[2], u[3]), vpk.x, vpk.y);
    f32x4 y = {0.f, 0.f, 0.f, 0.f};
    if constexpr (WANT_Y) { y = MFMA16(*(const LAS bf16x8*)(img + IM_RI + ao), Sb[0], y); y = MFMA16(*(const LAS bf16x8*)(img + IM_RI + ao + 64), Sb[1], y);
        y = MFMA16(mk8(pkg[4 * 64 + lane], pkg[5 * 64 + lane], pkg[6 * 64 + lane], pkg[7 * 64 + lane]), UV, y); }
#pragma unroll
    for (int T = 0; T < 4; ++T) { const bf16x8 bkt = *(const LAS bf16x8*)(img + IM_BKT + blk * 5120 + (16 * T + c) * 80 + q * 16);
        S[T] = MFMA16(bkt, UV, S[T]); const f32x4 g = *(const LAS f32x4*)(img + IM_GAM + blk * 256 + (16 * T + 4 * q) * 4); S[T] = S[T] * g; }
    return y;
}
__device__ __forceinline__ unsigned char* sum_slot(Frame& F, int chain, int sc) { return F.ws + WS_SUM + (size_t)(chain * NSC + sc) * SUM_SLOT; }

__device__ __forceinline__ void rwkv_pass1_unit(Frame& F, int li, int u) {
    const int chain = u / (NSC - 1), sc = u % (NSC - 1);
    const int dir = chain / 12, b = (chain / 6) & 1, h = chain % 6;
    const bool isctx = sc < 2; const int scl = isctx ? sc : sc - 2;
    LAS unsigned char* img = F.lds + L_IMG0; LAS unsigned* pkg = (LAS unsigned*)(F.lds + L_PKG);
    LAS float* cst = (LAS float*)(F.lds + L_CST);
    __syncthreads();
    if (F.tid < 256) chain_consts_lds(F, cst, li, h, F.tid);
    const int q = F.lane >> 4, c = F.lane & 15, wq = F.wave & 3; const bool isA = F.wave >= 4;
    f32x4 S[4];
#pragma unroll
    for (int T = 0; T < 4; ++T)
#pragma unroll
        for (int e = 0; e < 4; ++e) S[T][e] = (isA && (16 * T + 4 * q + e == c + 16 * wq)) ? 1.0f : 0.0f;
#pragma unroll 1
    for (int rd = 0; rd < 4; ++rd) {
        __syncthreads();
        if (F.wave < 4) prep_round2(F, cst, img, dir, b, h, 8 * F.wave + (F.lane >> 3), F.lane & 7, isctx, 128 * scl + 32 * rd, nullptr, nullptr, 0);
        __syncthreads();
        if (F.wave < 2) block_package<false>(img, F.wave, pkg + F.wave * 512, F.lane);
        __syncthreads();
#pragma unroll
        for (int blk = 0; blk < 2; ++blk) { if (isA) block_scan<false, false>(img, blk, pkg + blk * 512, S, wq, F.lane); else block_scan<false, true>(img, blk, pkg + blk * 512, S, wq, F.lane); }
    }
    unsigned char* slot = sum_slot(F, chain, sc);
    if (!isA) { f32x4* braw = (f32x4*)slot;
#pragma unroll
        for (int T = 0; T < 4; ++T) braw[(wq * 4 + T) * 64 + F.lane] = S[T]; }
    else { bf16* aim = (bf16*)(slot + 16384); const int kap = wq >> 1, e = (F.lane & 3) + 4 * (wq & 1), qc = c >> 2;
#pragma unroll
        for (int T = 0; T < 4; ++T)
#pragma unroll
            for (int r = 0; r < 4; ++r) { const int lc = (4 * q + r) + 16 * qc; aim[((T * 2 + kap) * 64 + lc) * 8 + e] = (bf16)f2bf(S[T][r]); } }
}
__device__ __forceinline__ void rwkv_pass2_chain(Frame& F, int chain) {
    if (F.wave >= 4) return;
    const int wq = F.wave;
    f32x4 S[4];
#pragma unroll
    for (int T = 0; T < 4; ++T) S[T] = (f32x4){0.f, 0.f, 0.f, 0.f};
#pragma unroll 1
    for (int sc = 0; sc < NSC; ++sc) {
        unsigned char* slot = sum_slot(F, chain, sc); f32x4* braw = (f32x4*)slot; const bf16* aim = (const bf16*)(slot + 16384);
        if (sc == NSC - 1) {
#pragma unroll
            for (int T = 0; T < 4; ++T) braw[(wq * 4 + T) * 64 + F.lane] = S[T];
            break; }
        f32x4 Bc[4]; bf16x8 af[4][2];
#pragma unroll
        for (int T = 0; T < 4; ++T) { Bc[T] = braw[(wq * 4 + T) * 64 + F.lane];
#pragma unroll
            for (int k = 0; k < 2; ++k) af[T][k] = *(const bf16x8*)(aim + ((T * 2 + k) * 64 + F.lane) * 8); }
        bf16x8 Sb[2];
#pragma unroll
        for (int k = 0; k < 2; ++k) Sb[k] = mk8(cvtpk(S[2 * k][0], S[2 * k][1]), cvtpk(S[2 * k][2], S[2 * k][3]), cvtpk(S[2 * k + 1][0], S[2 * k + 1][1]), cvtpk(S[2 * k + 1][2], S[2 * k + 1][3]));
#pragma unroll
        for (int T = 0; T < 4; ++T) { braw[(wq * 4 + T) * 64 + F.lane] = S[T]; f32x4 a = MFMA16(af[T][0], Sb[0], Bc[T]); S[T] = MFMA16(af[T][1], Sb[1], a); }
    }
}
__device__ __forceinline__ void rwkv_pass3_unit(Frame& F, int li, int u) {
    const int pc = u % NSC, bh = u / NSC, b = bh / 6, h = bh % 6;
    const bool isctx = pc < 2; const int pcl = isctx ? pc : pc - 2, nsc = isctx ? 2 : 64;
    const int dir = F.wave >> 2, wq = F.wave & 3, q = F.lane >> 4, c = F.lane & 15;
    const int sc = dir == 0 ? pc : (isctx ? 1 - pcl : 2 + 63 - pcl);
    const int scl = dir == 0 ? pcl : nsc - 1 - pcl;
    const int chain = dir * 12 + b * 6 + h;
    LAS unsigned char* img = F.lds + (dir ? L_IMG1 : L_IMG0); LAS unsigned* pkg = (LAS unsigned*)(F.lds + L_PKG) + dir * 1024;
    LAS float* YL = (LAS float*)(F.lds + L_YL); LAS unsigned char* VB = F.lds + L_VB; LAS float* BON = (LAS float*)(F.lds + L_BON);
    LAS float* cst = (LAS float*)(F.lds + L_CST);
    __syncthreads();
    if (F.tid < 256) chain_consts_lds(F, cst, li, h, F.tid);
    f32x4 S[4];
    { const f32x4* braw = (const f32x4*)sum_slot(F, chain, sc);
#pragma unroll
      for (int T = 0; T < 4; ++T) S[T] = braw[(wq * 4 + T) * 64 + F.lane]; }
    __syncthreads();
    for (int i = F.tid; i < 128 * 68; i += NTHR) YL[i] = 0.f;
#pragma unroll 1
    for (int rd = 0; rd < 4; ++rd) {
        __syncthreads();
        prep_round2(F, cst, img, dir, b, h, 8 * wq + (F.lane >> 3), F.lane & 7, isctx, 128 * scl + 32 * rd, dir == 0 ? VB : (LAS unsigned char*)nullptr, BON, 32 * rd);
        __syncthreads();
        if (wq < 2) block_package<true>(img, wq, pkg + wq * 512, F.lane);
        __syncthreads();
#pragma unroll
        for (int blk = 0; blk < 2; ++blk) { const f32x4 y = block_scan<true, true>(img, blk, pkg + blk * 512, S, wq, F.lane);
#pragma unroll
            for (int e = 0; e < 4; ++e) { const int t = 32 * rd + 16 * blk + 4 * q + e; const int pl = dir ? 127 - t : t; YL[pl * 68 + c + 16 * wq] += y[e]; } }
    }
    __syncthreads();
    const int wv = F.wave; const int rbase = (isctx ? TL + b * CTX : b * SEQ) + 128 * pcl;
    const bf16* g2t = (const bf16*)(F.ws + WS_G2T) + (size_t)li * 384 * 128;
    f32x4 gate[4];
#pragma unroll
    for (int nt = 0; nt < 4; ++nt) gate[nt] = (f32x4){0.f, 0.f, 0.f, 0.f};
#pragma unroll
    for (int k = 0; k < 4; ++k) { const v4u zg = *(const v4u*)(zrow(F, rbase + 16 * wv + c) + ZG + 32 * k + 8 * q);
#define SG(x) (1.0f / (1.0f + __expf(-(x))))
        const bf16x8 a = mk8(pk2(SG(bflo(zg.x)), SG(bfhi(zg.x))), pk2(SG(bflo(zg.y)), SG(bfhi(zg.y))), pk2(SG(bflo(zg.z)), SG(bfhi(zg.z))), pk2(SG(bflo(zg.w)), SG(bfhi(zg.w))));
#undef SG
#pragma unroll
        for (int nt = 0; nt < 4; ++nt) { const bf16x8 bb = *(const bf16x8*)(g2t + (size_t)(64 * h + 16 * nt + c) * 128 + 32 * k + 8 * q); gate[nt] = MFMA16(a, bb, gate[nt]); } }
    bf16* mix = (bf16*)(F.ws + WS_H);
    float lg[4], lb[4];
#pragma unroll
    for (int nt = 0; nt < 4; ++nt) { lg[nt] = inp(I_LNG)[li * RW + 64 * h + 16 * nt + c]; lb[nt] = inp(I_LNB)[li * RW + 64 * h + 16 * nt + c]; }
#pragma unroll
    for (int e = 0; e < 4; ++e) { const int tl = 16 * wv + 4 * q + e;
        float yv[4], s = 0.f;
#pragma unroll
        for (int nt = 0; nt < 4; ++nt) { yv[nt] = YL[tl * 68 + 16 * nt + c]; s += yv[nt]; }
        s += __shfl_xor(s, 1); s += __shfl_xor(s, 2); s += __shfl_xor(s, 4); s += __shfl_xor(s, 8);
        const float mu = s * (1.0f / 64.0f); float v2 = 0.f;
#pragma unroll
        for (int nt = 0; nt < 4; ++nt) { yv[nt] -= mu; v2 += yv[nt] * yv[nt]; }
        v2 += __shfl_xor(v2, 1); v2 += __shfl_xor(v2, 2); v2 += __shfl_xor(v2, 4); v2 += __shfl_xor(v2, 8);
        const float rs = 1.0f / sqrtf(v2 * (1.0f / 64.0f) + GN_EPS); const float bon = BON[tl];
#pragma unroll
        for (int nt = 0; nt < 4; ++nt) { const float vv = bf2f(((const LAS bf16*)VB)[tl * 64 + 16 * nt + c]);
            const float o = (yv[nt] * rs * lg[nt] + lb[nt] + bon * vv) * gate[nt][e];
            mix[(size_t)(rbase + tl) * DM + 640 + 64 * h + 16 * nt + c] = (bf16)f2bf(o); } }
}

constexpr int AT_KROW = 144;
__device__ __forceinline__ void attn_unit(Frame& F, int li, int u) {
    const bool cq = u >= 256;
    int b, kvh, qb;
    if (!cq) { b = u >> 7; kvh = (u >> 6) & 1; qb = u & 63; } else { const int uu = u - 256; b = uu >> 2; kvh = (uu >> 1) & 1; qb = uu & 1; }
    const int c = F.lane & 15, q = F.lane >> 4, tb = F.wave;
    const bf16* qr = (const bf16*)(F.ws + WS_QR); const bf16* kr = (const bf16*)(F.ws + WS_KR); bf16* mix = (bf16*)(F.ws + WS_H);
    const int qrow = (cq ? TL + b * CTX : b * SEQ) + 128 * qb + 16 * tb + c;
    const int qpos = 128 * qb + 16 * tb + c;
    bf16x8 Q[3][2];
#pragma unroll
    for (int hh = 0; hh < 3; ++hh)
#pragma unroll
        for (int k = 0; k < 2; ++k) {
            if (!cq) Q[hh][k] = *(const bf16x8*)(qr + (size_t)qrow * 384 + 64 * (3 * kvh + hh) + 32 * k + 8 * q);
            else { const v4u w = *(const v4u*)(zrow(F, qrow) + ZQ + 64 * (3 * kvh + hh) + 32 * k + 8 * q);
                Q[hh][k] = mk8(pk2(0.125f * bflo(w.x), 0.125f * bfhi(w.x)), pk2(0.125f * bflo(w.y), 0.125f * bfhi(w.y)), pk2(0.125f * bflo(w.z), 0.125f * bfhi(w.z)), pk2(0.125f * bflo(w.w), 0.125f * bfhi(w.w))); } }
    float m[3], l[3]; f32x4 O[3][4];
#pragma unroll
    for (int hh = 0; hh < 3; ++hh) { m[hh] = inp(I_SINK)[li * 6 + 3 * kvh + hh]; l[hh] = q == 0 ? 1.0f : 0.0f;
#pragma unroll
        for (int dt = 0; dt < 4; ++dt) O[hh][dt] = (f32x4){0.f, 0.f, 0.f, 0.f}; }
    LAS unsigned char* KI = F.lds;
#pragma unroll 1
    for (int stage = cq ? 1 : 0; stage < 2; ++stage) {
        const int nkeys = stage == 0 ? 384 : 256; const int vstride = (nkeys + 8) * 2;
        LAS unsigned char* VTI = F.lds + 384 * AT_KROW;
        const int kpos0 = 128 * (qb - 1);
        __syncthreads();
        for (int pc = F.tid; pc < nkeys * 8; pc += NTHR) { const int key = pc >> 3, d8 = pc & 7;
            const bf16* ksrc; const bf16* vsrc;
            if (stage == 0) { int kp = kpos0 + key; kp = kp < 0 ? 0 : (kp >= SEQ ? SEQ - 1 : kp); ksrc = kr + (size_t)(b * SEQ + kp) * 128 + 64 * kvh; vsrc = zrow(F, b * SEQ + kp) + ZV + 64 * kvh; }
            else { const bf16* z = zrow(F, TL + b * CTX + key); ksrc = z + ZK + 64 * kvh; vsrc = z + ZV + 64 * kvh; }
            const v4u kv = *(const v4u*)(ksrc + 8 * d8); const v4u vv = *(const v4u*)(vsrc + 8 * d8);
            *(LAS v4u*)(KI + key * AT_KROW + d8 * 16) = kv;
            const int kl = key & 31; const int col = (key & ~31) | (((kl & 15) >> 2) << 3) | ((kl >> 4) << 2) | (kl & 3);
            LAS bf16* vt = (LAS bf16*)(VTI + (8 * d8) * vstride) + col;
            vt[0] = (bf16)(vv.x & 0xffff); *(LAS bf16*)((LAS unsigned char*)vt + vstride) = (bf16)(vv.x >> 16);
            *(LAS bf16*)((LAS unsigned char*)vt + 2 * vstride) = (bf16)(vv.y & 0xffff); *(LAS bf16*)((LAS unsigned char*)vt + 3 * vstride) = (bf16)(vv.y >> 16);
            *(LAS bf16*)((LAS unsigned char*)vt + 4 * vstride) = (bf16)(vv.z & 0xffff); *(LAS bf16*)((LAS unsigned char*)vt + 5 * vstride) = (bf16)(vv.z >> 16);
            *(LAS bf16*)((LAS unsigned char*)vt + 6 * vstride) = (bf16)(vv.w & 0xffff); *(LAS bf16*)((LAS unsigned char*)vt + 7 * vstride) = (bf16)(vv.w >> 16); }
        __syncthreads();
        const int npair = nkeys / 32;
        const int Q0 = 128 * qb + 16 * tb;
#pragma unroll 1
        for (int kp = 0; kp < npair; ++kp) {
            const int kb = kpos0 + 32 * kp;
            if (stage == 0 && (kb + 31 < Q0 - 128 || kb > Q0 + 143 || kb + 31 < 0 || kb >= SEQ)) continue;
            bf16x8 K[2][2], V[4];
#pragma unroll
            for (int t = 0; t < 2; ++t)
#pragma unroll
                for (int k = 0; k < 2; ++k) K[t][k] = *(const LAS bf16x8*)(KI + (32 * kp + 16 * t + c) * AT_KROW + k * 64 + q * 16);
#pragma unroll
            for (int dt = 0; dt < 4; ++dt) V[dt] = *(const LAS bf16x8*)(VTI + (16 * dt + c) * vstride + kp * 64 + q * 16);
            bool ok0[4], ok1[4];
#pragma unroll
            for (int e = 0; e < 4; ++e) { const int k0 = kb + 4 * q + e, k1 = k0 + 16;
                ok0[e] = stage == 1 || (k0 >= 0 && k0 < SEQ && k0 >= qpos - 128 && k0 <= qpos + 128);
                ok1[e] = stage == 1 || (k1 >= 0 && k1 < SEQ && k1 >= qpos - 128 && k1 <= qpos + 128); }
#pragma unroll
            for (int hh = 0; hh < 3; ++hh) {
                f32x4 s0 = {0.f, 0.f, 0.f, 0.f}, s1 = {0.f, 0.f, 0.f, 0.f};
                s0 = MFMA16(K[0][0], Q[hh][0], s0); s0 = MFMA16(K[0][1], Q[hh][1], s0);
                s1 = MFMA16(K[1][0], Q[hh][0], s1); s1 = MFMA16(K[1][1], Q[hh][1], s1);
                float mx = -INFINITY;
#pragma unroll
                for (int e = 0; e < 4; ++e) { s0[e] = ok0[e] ? s0[e] : -INFINITY; s1[e] = ok1[e] ? s1[e] : -INFINITY; mx = fmaxf(mx, fmaxf(s0[e], s1[e])); }
                mx = fmaxf(mx, __shfl_xor(mx, 16)); mx = fmaxf(mx, __shfl_xor(mx, 32));
                const float mn = fmaxf(m[hh], mx); const float alpha = __expf(m[hh] - mn); m[hh] = mn;
                float ps = 0.f;
#pragma unroll
                for (int e = 0; e < 4; ++e) { s0[e] = __expf(s0[e] - mn); s1[e] = __expf(s1[e] - mn); ps += s0[e] + s1[e]; }
                l[hh] = l[hh] * alpha + ps;
                const bf16x8 P = mk8(cvtpk(s0[0], s0[1]), cvtpk(s0[2], s0[3]), cvtpk(s1[0], s1[1]), cvtpk(s1[2], s1[3]));
#pragma unroll
                for (int dt = 0; dt < 4; ++dt) { O[hh][dt] = O[hh][dt] * alpha; O[hh][dt] = MFMA16(V[dt], P, O[hh][dt]); }
            }
        }
    }
#pragma unroll
    for (int hh = 0; hh < 3; ++hh) { float lt = l[hh]; lt += __shfl_xor(lt, 16); lt += __shfl_xor(lt, 32); const float inv = 1.0f / lt;
#pragma unroll
        for (int dt = 0; dt < 4; ++dt) { v2u w; w.x = pk2(O[hh][dt][0] * inv, O[hh][dt][1] * inv); w.y = pk2(O[hh][dt][2] * inv, O[hh][dt][3] * inv);
            *(v2u*)(mix + (size_t)qrow * DM + 256 + 64 * (3 * kvh + hh) + 16 * dt + 4 * q) = w; } }
}

constexpr size_t WS_FT = 7 * MiB;
constexpr size_t FT_W64C = 0, FT_W64S = 8192, FT_W128C = 16384, FT_W128S = 49152, FT_T64C = 81920, FT_T64S = 90112;
__device__ __forceinline__ void fourier_tables(Frame& F) {
    bf16* t = (bf16*)(F.ws + WS_FT);
    for (int i = F.bid * NTHR + F.tid; i < 64 * 64; i += F.G * NTHR) { const int r = i >> 6, cc = i & 63; const float a = (float)((r * cc) & 63) * (1.0f / 64.0f);
        const float cs = __builtin_amdgcn_cosf(a), sn = __builtin_amdgcn_sinf(a);
        t[FT_W64C / 2 + i] = (bf16)f2bf(cs); t[FT_W64S / 2 + i] = (bf16)f2bf(sn);
        const int pj = (cc & ~31) | (((cc & 15) >> 2) << 3) | (((cc >> 4) & 1) << 2) | (cc & 3);
        t[FT_T64C / 2 + r * 64 + pj] = (bf16)f2bf(cs); t[FT_T64S / 2 + r * 64 + pj] = (bf16)f2bf(sn); }
    for (int i = F.bid * NTHR + F.tid; i < 128 * 128; i += F.G * NTHR) { const int r = i >> 7, cc = i & 127; const float a = (float)((r * cc) & 127) * (1.0f / 128.0f);
        t[FT_W128C / 2 + i] = (bf16)f2bf(__builtin_amdgcn_cosf(a)); t[FT_W128S / 2 + i] = (bf16)f2bf(__builtin_amdgcn_sinf(a)); }
}
__device__ __forceinline__ void fourier_a_fast(Frame& F, int u) {
    const int b = u >> 7, n2 = u & 127, c = F.lane & 15, q = F.lane >> 4;
    LAS unsigned char* IMG = F.lds;
    __syncthreads();
    for (int pc = F.tid; pc < 64 * 32; pc += NTHR) { const int n1 = pc >> 5, c8 = pc & 31;
        const v4u v = *(const v4u*)(zrow(F, b * SEQ + 128 * n1 + n2) + ZF + 8 * c8);
        LAS bf16* d = (LAS bf16*)(IMG + (8 * c8) * 144) + n1;
        d[0] = (bf16)(v.x & 0xffff); d[72] = (bf16)(v.x >> 16); d[144] = (bf16)(v.y & 0xffff); d[216] = (bf16)(v.y >> 16);
        d[288] = (bf16)(v.z & 0xffff); d[360] = (bf16)(v.z >> 16); d[432] = (bf16)(v.w & 0xffff); d[504] = (bf16)(v.w >> 16); }
    __syncthreads();
    const bf16* wc = (const bf16*)(F.ws + WS_FT + FT_W64C); const bf16* wsn = (const bf16*)(F.ws + WS_FT + FT_W64S);
    bf16* far = (bf16*)(F.ws + WS_FA); bf16* fai = far + (size_t)NB * 64 * 128 * 256;
    bf16x8 Bc[4][2], Bs[4][2];
#pragma unroll
    for (int kt = 0; kt < 4; ++kt)
#pragma unroll
        for (int k = 0; k < 2; ++k) { Bc[kt][k] = *(const bf16x8*)(wc + (16 * kt + c) * 64 + 32 * k + 8 * q); Bs[kt][k] = *(const bf16x8*)(wsn + (16 * kt + c) * 64 + 32 * k + 8 * q); }
#pragma unroll
    for (int ci = 0; ci < 2; ++ci) { const int ct = 2 * F.wave + ci;
        bf16x8 A[2];
#pragma unroll
        for (int k = 0; k < 2; ++k) A[k] = *(const LAS bf16x8*)(IMG + (16 * ct + c) * 144 + k * 64 + q * 16);
#pragma unroll
        for (int kt = 0; kt < 4; ++kt) { f32x4 sr = {0.f, 0.f, 0.f, 0.f}, si = {0.f, 0.f, 0.f, 0.f};
#pragma unroll
            for (int k = 0; k < 2; ++k) { sr = MFMA16(A[k], Bc[kt][k], sr); si = MFMA16(A[k], Bs[kt][k], si); }
            const int k1 = 16 * kt + c; const float tw = (float)(n2 * k1) * (1.0f / 8192.0f); const float tc = __builtin_amdgcn_cosf(tw), ts = __builtin_amdgcn_sinf(tw);
            float xr[4], xi[4];
#pragma unroll
            for (int e = 0; e < 4; ++e) { const float ar = sr[e], ai = -si[e]; xr[e] = ar * tc + ai * ts; xi[e] = ai * tc - ar * ts; }
            const size_t o = (((size_t)b * 64 + k1) * 128 + n2) * 256 + 16 * ct + 4 * q;
            v2u w; w.x = pk2(xr[0], xr[1]); w.y = pk2(xr[2], xr[3]); *(v2u*)(far + o) = w; w.x = pk2(xi[0], xi[1]); w.y = pk2(xi[2], xi[3]); *(v2u*)(fai + o) = w; } }
}
__device__ __forceinline__ void fourier_c_fast(Frame& F, int u) {
    const int g = u & 3, k1 = (u >> 2) & 63, b = u >> 8, c = F.lane & 15, q = F.lane >> 4;
    LAS unsigned char* IR = F.lds; LAS unsigned char* II = F.lds + 64 * 272;
    const bf16* far = (const bf16*)(F.ws + WS_FA) + (((size_t)b * 64 + k1) * 128) * 256 + 64 * g; const bf16* fai = far + (size_t)NB * 64 * 128 * 256;
    __syncthreads();
    for (int pc = F.tid; pc < 128 * 8; pc += NTHR) { const int n2 = pc >> 3, c8 = pc & 7;
        const v4u vr = *(const v4u*)(far + (size_t)n2 * 256 + 8 * c8), vi = *(const v4u*)(fai + (size_t)n2 * 256 + 8 * c8);
        LAS bf16* dr = (LAS bf16*)(IR + (8 * c8) * 272) + n2; LAS bf16* di = (LAS bf16*)(II + (8 * c8) * 272) + n2;
        dr[0] = (bf16)(vr.x & 0xffff); dr[136] = (bf16)(vr.x >> 16); dr[272] = (bf16)(vr.y & 0xffff); dr[408] = (bf16)(vr.y >> 16);
        dr[544] = (bf16)(vr.z & 0xffff); dr[680] = (bf16)(vr.z >> 16); dr[816] = (bf16)(vr.w & 0xffff); dr[952] = (bf16)(vr.w >> 16);
        di[0] = (bf16)(vi.x & 0xffff); di[136] = (bf16)(vi.x >> 16); di[272] = (bf16)(vi.y & 0xffff); di[408] = (bf16)(vi.y >> 16);
        di[544] = (bf16)(vi.z & 0xffff); di[680] = (bf16)(vi.z >> 16); di[816] = (bf16)(vi.w & 0xffff); di[952] = (bf16)(vi.w >> 16); }
    __syncthreads();
    const bf16* wc = (const bf16*)(F.ws + WS_FT + FT_W128C); const bf16* wsn = (const bf16*)(F.ws + WS_FT + FT_W128S);
    const bf16* tcn = (const bf16*)(F.ws + WS_FT + FT_T64C); const bf16* tsn = (const bf16*)(F.ws + WS_FT + FT_T64S);
    f32x4 Pr[4], Pi[4];
#pragma unroll
    for (int ct = 0; ct < 4; ++ct) { Pr[ct] = (f32x4){0.f, 0.f, 0.f, 0.f}; Pi[ct] = (f32x4){0.f, 0.f, 0.f, 0.f}; }
#pragma unroll
    for (int k = 0; k < 4; ++k) { const bf16x8 bc = *(const bf16x8*)(wc + (16 * F.wave + c) * 128 + 32 * k + 8 * q), bs = *(const bf16x8*)(wsn + (16 * F.wave + c) * 128 + 32 * k + 8 * q);
        const v4u bsu = __builtin_bit_cast(v4u, bs); const bf16x8 bsn = mk8(bsu.x ^ 0x80008000u, bsu.y ^ 0x80008000u, bsu.z ^ 0x80008000u, bsu.w ^ 0x80008000u);
#pragma unroll
        for (int ct = 0; ct < 4; ++ct) { const bf16x8 ar = *(const LAS bf16x8*)(IR + (16 * ct + c) * 272 + k * 64 + q * 16), ai = *(const LAS bf16x8*)(II + (16 * ct + c) * 272 + k * 64 + q * 16);
            Pr[ct] = MFMA16(ar, bc, Pr[ct]); Pr[ct] = MFMA16(ai, bs, Pr[ct]); Pi[ct] = MFMA16(ai, bc, Pi[ct]); Pi[ct] = MFMA16(ar, bsn, Pi[ct]); } }
    bf16x8 Br[2], Bi[2];
#pragma unroll
    for (int k = 0; k < 2; ++k) { Br[k] = mk8(cvtpk(Pr[2 * k][0], Pr[2 * k][1]), cvtpk(Pr[2 * k][2], Pr[2 * k][3]), cvtpk(Pr[2 * k + 1][0], Pr[2 * k + 1][1]), cvtpk(Pr[2 * k + 1][2], Pr[2 * k + 1][3]));
        Bi[k] = mk8(cvtpk(Pi[2 * k][0], Pi[2 * k][1]), cvtpk(Pi[2 * k][2], Pi[2 * k][3]), cvtpk(Pi[2 * k + 1][0], Pi[2 * k + 1][1]), cvtpk(Pi[2 * k + 1][2], Pi[2 * k + 1][3])); }
    bf16* mix = (bf16*)(F.ws + WS_H);
    const float scale = 0.0013810679320049757f;
    const int k2 = 16 * F.wave + c; const size_t row = (size_t)b * SEQ + k1 + 64 * k2;
#pragma unroll
    for (int mt = 0; mt < 4; ++mt) { f32x4 y = {0.f, 0.f, 0.f, 0.f};
#pragma unroll
        for (int k = 0; k < 2; ++k) { const bf16x8 ac = *(const bf16x8*)(tcn + (16 * mt + c) * 64 + 32 * k + 8 * q), as = *(const bf16x8*)(tsn + (16 * mt + c) * 64 + 32 * k + 8 * q);
            y = MFMA16(ac, Br[k], y); y = MFMA16(as, Bi[k], y); }
        v2u w; w.x = pk2(y[0] * scale, y[1] * scale); w.y = pk2(y[2] * scale, y[3] * scale);
        *(v2u*)(mix + row * DM + 64 * g + 16 * mt + 4 * q) = w; }
}

#define XB_TMO      128
#define XB_XCNT(j)  (256  + 64 * (j))
#define XB_XSUB(j)  (1280 + 64 * (j))
#define XB_XGEN(j)  (2304 + 64 * (j))
#define XB_TOP      3328
#define XB_TOPGEN   3392
#define XCD_BAR_WORDS 3456
#define XB_SPIN_CAP (1u << 23)
__device__ __forceinline__ unsigned xb_ld(unsigned* p)              { return __hip_atomic_load(p, __ATOMIC_RELAXED, __HIP_MEMORY_SCOPE_AGENT); }
__device__ __forceinline__ unsigned xb_add(unsigned* p, unsigned v) { return __hip_atomic_fetch_add(p, v, __ATOMIC_RELAXED, __HIP_MEMORY_SCOPE_AGENT); }
__device__ __forceinline__ unsigned xb_xcc_id() { return (unsigned)__builtin_amdgcn_s_getreg((3 << 11) | 20) & 0xFu; }
#define XB_SPIN(cond, bar) do { unsigned _sp = 0; while (cond) { __builtin_amdgcn_s_sleep(1); \
    if ((++_sp & 255u) == 0u) { if (xb_ld(&(bar)[XB_TMO])) break; if (_sp > XB_SPIN_CAP) { atomicAdd(&(bar)[XB_TMO], 1u); break; } } } } while (0)
struct XcdBarrier { unsigned* bar; unsigned x; volatile LAS unsigned* st; };
__device__ __forceinline__ XcdBarrier xcd_barrier_post(unsigned* bar, volatile LAS unsigned* st) {
    XcdBarrier b; b.bar = bar; b.x = xb_xcc_id(); b.st = st;
    if (threadIdx.x == 0) (void)xb_add(&bar[XB_XCNT(b.x)], 1u);
    return b;
}
__device__ __forceinline__ void xcd_barrier_complete(unsigned* bar, unsigned x, unsigned& nloc, unsigned& nx) {
    const unsigned G = gridDim.x * gridDim.y * gridDim.z;
    unsigned sum, cnt, mine, sp = 0u;
    for (;;) {
        sum = 0u; cnt = 0u; mine = 0u;
#pragma unroll
        for (unsigned j = 0; j < 16; ++j) { const unsigned c = xb_ld(&bar[XB_XCNT(j)]); sum += c; cnt += (c > 0u) ? 1u : 0u; mine = (j == x) ? c : mine; }
        if (sum == G) break;
        __builtin_amdgcn_s_sleep(1);
        if ((++sp & 255u) == 0u) { if (xb_ld(&bar[XB_TMO])) break; if (sp > XB_SPIN_CAP) { atomicAdd(&bar[XB_TMO], 1u); break; } }
    }
    nloc = mine > 0u ? mine : 1u; nx = cnt > 0u ? cnt : 1u;
}
__device__ __forceinline__ void xcd_barrier(const XcdBarrier& b) {
    asm volatile("s_waitcnt vmcnt(0)" ::: "memory");
    __syncthreads();
    if (threadIdx.x == 0) {
        unsigned* bar = b.bar;
        __builtin_amdgcn_s_waitcnt(0);
        unsigned nloc = b.st[0], nx = b.st[1];
        if (nloc == 0u) { xcd_barrier_complete(bar, b.x, nloc, nx); b.st[0] = nloc; b.st[1] = nx; }
        const unsigned old = xb_add(&bar[XB_XSUB(b.x)], 1u);
        const unsigned gen = old / nloc;
        if (old + 1u == (gen + 1u) * nloc) {
            __builtin_amdgcn_fence(__ATOMIC_RELEASE, "agent");
            asm volatile("s_waitcnt vmcnt(0)" ::: "memory");
            const unsigned og = xb_add(&bar[XB_TOP], 1u);
            const unsigned tg = og / nx;
            if (og + 1u == (tg + 1u) * nx) xb_add(&bar[XB_TOPGEN], 1u);
            else XB_SPIN(xb_ld(&bar[XB_TOPGEN]) == tg, bar);
            __builtin_amdgcn_fence(__ATOMIC_ACQUIRE, "agent");
            xb_add(&bar[XB_XGEN(b.x)], 1u);
            asm volatile("s_waitcnt vmcnt(0)" ::: "memory");
        } else {
            XB_SPIN(xb_ld(&bar[XB_XGEN(b.x)]) == gen, bar);
            __builtin_amdgcn_fence(__ATOMIC_ACQUIRE, "agent");
            asm volatile("s_waitcnt vmcnt(0)" ::: "memory");
        }
    }
    __syncthreads();
}

template <int KIND> __device__ __forceinline__ void run_phase(const Frame& F0, int li, int second) {
    Frame F;
    { int t = threadIdx.x; asm volatile("" : "+v"(t)); F.tid = t; F.lane = t & 63; F.wave = __builtin_amdgcn_readfirstlane(t >> 6);
      int g = F0.G, b = F0.bid; asm volatile("" : "+s"(g), "+s"(b)); F.G = g; F.bid = b;
      unsigned char* w = F0.ws; float* o = F0.out; asm volatile("" : "+s"(w), "+s"(o)); F.ws = w; F.out = o;
      unsigned l = (unsigned)(size_t)F0.lds; asm volatile("" : "+s"(l)); F.lds = (LAS unsigned char*)(size_t)l;
      asm volatile("" : "+s"(li), "+s"(second)); }
    float* modv = (float*)(F.ws + WS_MOD);
    float* xc = (float*)(F.ws + WS_XC);
    bf16* H = (bf16*)(F.ws + WS_H); bf16* ACT = (bf16*)(F.ws + WS_ACT); float* O = (float*)(F.ws + WS_O);
    const float* ng = inp(I_NORMG) + (size_t)li * 6 * DM; const float* mv = modv + (size_t)li * 3 * 9216;
    const bool last = li == 1;
    if constexpr (KIND == 100) { convert_weights(F, 0); mod_gemv(F); rope_tables(F); lora_transposes(F); fourier_tables(F); }
    if constexpr (KIND == 101) { EArgs A{}; A.xl_src = inp(I_X); A.xc_src = inp(I_CTX); A.o = nullptr; A.hdst = H; A.modv_h = modv; A.shidx = 0; A.scidx = 1; A.gpre = inp(I_NORMG); A.nrows = TT; e_phase(F, A); }
    if constexpr (KIND == 0) {
        pg8::Gemm g{H, (const bf16*)(F.ws + (second ? WS_WI2 : WS_WI1)), (last && second) ? TL : TT, NWI, DM}; pg8::StaticOrder S; S.init(g.M, g.N, F.G, F.bid);
        pg8::EpiSwiglu E{ACT, FFNP}; pg8::gemm_phase<pg8::EpiSwiglu, pg8::StaticOrder, true, true>(F.lds, g, S, E, F.tid); }
    if constexpr (KIND == 1) {
        pg8::Gemm g{ACT, (const bf16*)(F.ws + (second ? WS_WO2 : WS_WO1)), (last && second) ? TL : TT, DM, FFNP}; pg8::StaticOrder S; S.init(g.M, g.N, F.G, F.bid);
        pg8::EpiF32 E{O, DM}; pg8::gemm_phase<pg8::EpiF32, pg8::StaticOrder, true, true>(F.lds, g, S, E, F.tid); }
    if constexpr (KIND == 2) {
        EArgs A{}; A.xl_src = li == 0 ? inp(I_X) : F.out; A.xc_src = li == 0 ? inp(I_CTX) : xc; A.xl_dst = F.out; A.xc_dst = xc; A.o = O; A.modv_g = mv; A.gidx = 2; A.gmul = 0.5f; A.gpost = ng + 1 * DM;
        A.hdst = H; A.modv_h = mv; A.shidx = 3; A.scidx = 4; A.gpre = ng + 2 * DM; A.nrows = TT; e_phase(F, A); }
    if constexpr (KIND == 3) {
        pg8::Gemm g{H, (const bf16*)(F.ws + WS_WIN), TT, INWP, DM}; pg8::StaticOrder S; S.init(g.M, g.N, F.G, F.bid);
        pg8::EpiBf16 E{ACT, INWP}; pg8::gemm_phase<pg8::EpiBf16, pg8::StaticOrder, true, true>(F.lds, g, S, E, F.tid); }
    if constexpr (KIND == 4) {
        for (int u = F.bid; u < 528; u += F.G) lora_unit(F, li, u);
        for (int u = F.bid; u < 256; u += F.G) fourier_a_fast(F, u);
        for (int u = F.bid; u < 64; u += F.G) rope_unit(F, u);
        if (li == 0) for (int u = F.bid; u < 16; u += F.G) fourier_ctx1_unit(F, u); }
    if constexpr (KIND == 5) {
        for (int u = F.bid; u < (li == 0 ? 264 : 256); u += F.G) attn_unit(F, li, u);
        for (int u = F.bid; u < 24 * (NSC - 1); u += F.G) rwkv_pass1_unit(F, li, u); }
    if constexpr (KIND == 11) {
        if (F.bid < 24) rwkv_pass2_chain(F, F.bid);
        for (int u = F.bid; u < 512; u += F.G) fourier_c_fast(F, u);
        if (li == 0) for (int u = F.bid; u < 32; u += F.G) fourier_ctx2_unit(F, u); }
    if constexpr (KIND == 12) {
        for (int u = F.bid; u < 12 * NSC; u += F.G) { if (li == 1 && (u % NSC) < 2) continue; rwkv_pass3_unit(F, li, u); } }
    if constexpr (KIND == 6) {
        pg8::Gemm g{H, (const bf16*)(F.ws + WS_WOUT), last ? TL : TT, DM, DM}; pg8::StaticOrder S; S.init(g.M, g.N, F.G, F.bid);
        pg8::EpiF32 E{O, DM}; pg8::gemm_phase<pg8::EpiF32, pg8::StaticOrder, true, true>(F.lds, g, S, E, F.tid); }
    if constexpr (KIND == 7) {
        EArgs A{}; A.xl_src = F.out; A.xc_src = xc; A.xl_dst = F.out; A.xc_dst = xc; A.o = O; A.modv_g = mv; A.gidx = 5; A.gmul = 1.0f; A.gpost = ng + 3 * DM;
        A.hdst = H; A.modv_h = mv; A.shidx = 6; A.scidx = 7; A.gpre = ng + 4 * DM; A.nrows = last ? TL : TT; e_phase(F, A); }
    if constexpr (KIND == 10) {
        EArgs A{}; A.xl_src = F.out; A.xc_src = xc; A.xl_dst = F.out; A.xc_dst = xc; A.o = O; A.modv_g = mv; A.gidx = 8; A.gmul = 0.5f; A.gpost = ng + 5 * DM;
        if (!last) { A.hdst = H; A.modv_h = mv + 3 * 9216; A.shidx = 0; A.scidx = 1; A.gpre = ng + 6 * DM; }
        A.nrows = last ? TL : TT; e_phase(F, A);
        if (!last) { __syncthreads(); convert_weights(F, 1); } }
}
constexpr int MISC_OFF = 146432;
__global__ void __launch_bounds__(NTHR, 2) mega_one(Args args) {
    extern __shared__ __attribute__((aligned(16))) unsigned char lds[];
    Frame F; F.lds = (LAS unsigned char*)lds; F.tid = threadIdx.x; F.lane = F.tid & 63; F.wave = __builtin_amdgcn_readfirstlane(F.tid >> 6); F.G = gridDim.x; F.bid = blockIdx.x;
    F.out = args.out; F.ws = args.ws;
    volatile LAS unsigned* MISC = (volatile LAS unsigned*)(F.lds + MISC_OFF);
    if (F.tid < 32) MISC[F.tid] = 0u;
    __syncthreads();
    XcdBarrier bar = xcd_barrier_post((unsigned*)(F.ws + WS_CTL) + 4096, MISC + 8);
#define GRID_BAR() xcd_barrier(bar)
    run_phase<100>(F, 0, 0); GRID_BAR();
    run_phase<101>(F, 0, 0); GRID_BAR();
#pragma unroll 1
    for (int li = 0; li < 2; ++li) {
        run_phase<0>(F, li, 0); GRID_BAR();
        run_phase<1>(F, li, 0); GRID_BAR();
        run_phase<2>(F, li, 0); GRID_BAR();
        run_phase<3>(F, li, 0); GRID_BAR();
        run_phase<4>(F, li, 0); GRID_BAR();
        run_phase<5>(F, li, 0); GRID_BAR();
        run_phase<11>(F, li, 0); GRID_BAR();
        run_phase<12>(F, li, 0); GRID_BAR();
        run_phase<6>(F, li, 0); GRID_BAR();
        run_phase<7>(F, li, 0); GRID_BAR();
        run_phase<0>(F, li, 1); GRID_BAR();
        run_phase<1>(F, li, 1); GRID_BAR();
        run_phase<10>(F, li, 0); GRID_BAR();
    }
}

extern "C" void kernel_launch(void* const* d_in, const int* in_sizes, int n_in, void* d_out, int out_size, void* d_ws, size_t ws_size, hipStream_t stream) {
    static int ready = 0;
    if (!ready) {
        if (n_in != 25 || out_size != TL * DM || ws_size < WS_END) { fprintf(stderr, "kernel_launch: unexpected shapes (n_in %d out %d ws %zu)\n", n_in, out_size, ws_size); ready = -1; return; }
        if (hipFuncSetAttribute((const void*)mega_one, hipFuncAttributeMaxDynamicSharedMemorySize, LDS_BYTES) != hipSuccess) { fprintf(stderr, "kernel_launch: hipFuncSetAttribute failed\n"); ready = -1; return; }
        ready = 1;
    }
    if (ready < 0) return;
    if (hipMemsetAsync((char*)d_ws + WS_CTL, 0, 65536, stream) != hipSuccess) { fprintf(stderr, "kernel_launch: memset failed\n"); return; }
    Args a{};
    for (int i = 0; i < 25; ++i) a.in[i] = (const float*)d_in[i];
    a.out = (float*)d_out; a.ws = (unsigned char*)d_ws;
    hipLaunchKernelGGL(mega_one, dim3(256), dim3(NTHR), LDS_BYTES, stream, a);
}
```

```cpp
#include <hip/hip_runtime.h>
#include <cstdio>
#include <cstdint>

namespace pg8 {
#define PG8_LAS __attribute__((address_space(3)))
typedef unsigned short bf16_t;
typedef short bf16x8 __attribute__((ext_vector_type(8)));
typedef float f32x4 __attribute__((ext_vector_type(4)));
typedef unsigned u32x4 __attribute__((ext_vector_type(4)));
constexpr int BM = 256, BK = 64, HALF = 128, HTB = HALF * BK * 2, STAGE_BYTES = 8 * HTB, NXCD = 8, WGM = 8;

__host__ __device__ __forceinline__ int lds_byte(int r, int c) { const int st = (r >> 4) * 2 + (c >> 5), rr = r & 15, cc = c & 31, ob = rr * 64 + cc * 2; return st * 1024 + (ob ^ (((ob >> 9) & 1) << 5)); }
__host__ __device__ __forceinline__ void stage_rc(int b, int& R, int& C) { const int st = b / 1024, sb = b % 1024, swz = sb ^ (((sb >> 9) & 1) << 5); R = (st >> 1) * 16 + swz / 64; C = (st & 1) * 32 + (swz % 64) / 2; }
__host__ __device__ __forceinline__ int perm32(int rho) { const int n = rho >> 4, i = rho & 15; return 8 * (i >> 2) + 4 * n + (i & 3); }

struct Unit { int pm, pn; };
struct Gemm { const bf16_t* A; const bf16_t* Bt; int M, N, K; };

struct StaticOrder {
    int nM, nN, nwg, G, c;
    __host__ __device__ void init(int M, int N, int G_, int c_) { nM = M / BM; nN = N / BM; nwg = nM * nN; G = G_; c = c_; }
    __host__ __device__ bool next(int i, Unit& u) const {
        const long L = (long)i * G + c; if (L >= nwg) return false;
        int wgid = (int)L; { const int q = nwg / NXCD, r = nwg % NXCD, xcd = wgid % NXCD, off = wgid / NXCD; wgid = (xcd < r ? xcd * (q + 1) : r * (q + 1) + (xcd - r) * q) + off; }
        const int nig = WGM * nN, gid = wgid / nig, fm = gid * WGM, gsz = (nM - fm) < WGM ? (nM - fm) : WGM;
        u.pm = fm + ((wgid % nig) % gsz); u.pn = (wgid % nig) / gsz; return true;
    }
    __device__ __forceinline__ void a_ready(const Unit&) const {}
    __device__ __forceinline__ void done(const Unit&) const {}
};

__device__ __forceinline__ unsigned cvt_pk_bf16(float lo, float hi) { unsigned r; asm volatile("v_cvt_pk_bf16_f32 %0, %1, %2" : "=v"(r) : "v"(lo), "v"(hi)); return r; }

struct EpiBf16 {
    static constexpr bool PERM = true, AFTER_DRAIN = false;
    bf16_t* O; int ldc;
    __device__ __forceinline__ void operator()(const f32x4 (&acc)[2][2][4][2], const Unit& u, int wr, int wc, int fr, int fq) const {
        const int row0 = u.pm * BM + wr * 64 + fr; const int col0 = u.pn * BM + wc * 32 + 8 * fq;
#pragma unroll
        for (int ai = 0; ai < 2; ++ai)
#pragma unroll
            for (int m = 0; m < 4; ++m) { bf16_t* rowp = O + (size_t)(row0 + ai * HALF + m * 16) * ldc + col0;
#pragma unroll
                for (int bj = 0; bj < 2; ++bj) { const f32x4 v0 = acc[ai][bj][m][0], v1 = acc[ai][bj][m][1];
                    u32x4 w; w.x = cvt_pk_bf16(v0[0], v0[1]); w.y = cvt_pk_bf16(v0[2], v0[3]); w.z = cvt_pk_bf16(v1[0], v1[1]); w.w = cvt_pk_bf16(v1[2], v1[3]);
                    *(u32x4*)(rowp + bj * HALF) = w; } }
    }
};
struct EpiF32 {
    static constexpr bool PERM = true, AFTER_DRAIN = false;
    float* O; int ldc;
    __device__ __forceinline__ void operator()(const f32x4 (&acc)[2][2][4][2], const Unit& u, int wr, int wc, int fr, int fq) const {
        const int row0 = u.pm * BM + wr * 64 + fr; const int col0 = u.pn * BM + wc * 32 + 8 * fq;
#pragma unroll
        for (int ai = 0; ai < 2; ++ai)
#pragma unroll
            for (int m = 0; m < 4; ++m) { float* rowp = O + (size_t)(row0 + ai * HALF + m * 16) * ldc + col0;
#pragma unroll
                for (int bj = 0; bj < 2; ++bj) { *(f32x4*)(rowp + bj * HALF) = acc[ai][bj][m][0]; *(f32x4*)(rowp + bj * HALF + 4) = acc[ai][bj][m][1]; } }
    }
};
__device__ __forceinline__ float silu_f(float x) { return x * __builtin_amdgcn_rcpf(1.0f + __expf(-x)); }
struct EpiSwiglu {
    static constexpr bool PERM = true, AFTER_DRAIN = false;
    bf16_t* O; int ldc;
    __device__ __forceinline__ void operator()(const f32x4 (&acc)[2][2][4][2], const Unit& u, int wr, int wc, int fr, int fq) const {
        const int row0 = u.pm * BM + wr * 64 + fr; const int col0 = u.pn * HALF + wc * 32 + 8 * fq;
#pragma unroll
        for (int ai = 0; ai < 2; ++ai)
#pragma unroll
            for (int m = 0; m < 4; ++m) { bf16_t* rowp = O + (size_t)(row0 + ai * HALF + m * 16) * ldc + col0;
                const f32x4 g0 = acc[ai][0][m][0], g1 = acc[ai][0][m][1], u0 = acc[ai][1][m][0], u1 = acc[ai][1][m][1];
                u32x4 w; w.x = cvt_pk_bf16(silu_f(g0[0]) * u0[0], silu_f(g0[1]) * u0[1]); w.y = cvt_pk_bf16(silu_f(g0[2]) * u0[2], silu_f(g0[3]) * u0[3]);
                w.z = cvt_pk_bf16(silu_f(g1[0]) * u1[0], silu_f(g1[1]) * u1[1]); w.w = cvt_pk_bf16(silu_f(g1[2]) * u1[2], silu_f(g1[3]) * u1[3]);
                *(u32x4*)rowp = w; }
    }
};

template <class Epi, class Sched, bool ALIGN_EPI = false, bool SP2 = false>
__device__ __forceinline__ void gemm_phase(PG8_LAS unsigned char* lds, const Gemm g, const Sched& S, const Epi& E, const int tid) {
    const int wid = __builtin_amdgcn_readfirstlane(tid >> 6), lane = tid & 63, wr = wid >> 2, wc = wid & 3, fr = lane & 15, fq = lane >> 4;
    const int K = g.K, nt = K / BK;
    unsigned voffA[2], voffB[2];
#pragma unroll
    for (int i = 0; i < 2; ++i) { int R, C; stage_rc(tid * 16 + i * 8192, R, C); const int Rb = Epi::PERM ? ((R & ~31) + perm32(R & 31)) : R;
        voffA[i] = (unsigned)(R * K + C) * 2u; voffB[i] = (unsigned)(Rb * K + C) * 2u; }
    const size_t kstep = (size_t)(BK * 2);
    const size_t hstep = (size_t)HALF * K * 2;
    const size_t tstep = 2 * hstep;
    const unsigned ldsw = (unsigned)wid * 1024u;
    const int aoff = lds_byte(wr * 64 + fr, fq * 8), boff = lds_byte(wc * 32 + fr, fq * 8);
#define PG8_SA(b, h) (((b) * 2 + (h)) * HTB)
#define PG8_SB(b, h) ((4 + (b) * 2 + (h)) * HTB)
#define PG8_STAGE(bufoff, gbase, voff) do { _Pragma("unroll") for (int _i = 0; _i < 2; ++_i) \
        __builtin_amdgcn_global_load_lds((const unsigned*)((const char*)(gbase) + (voff)[_i]), (PG8_LAS unsigned*)(lds + (bufoff) + ldsw + _i * 8192), 16, 0, 0); } while (0)
#define PG8_LDA(dst, b, h) do { _Pragma("unroll") for (int m = 0; m < 4; ++m) _Pragma("unroll") for (int k = 0; k < 2; ++k) dst[m][k] = *(const PG8_LAS bf16x8*)(lds + PG8_SA(b, h) + aoff + m * 2048 + k * 1024); } while (0)
#define PG8_LDB(dst, b, h) do { _Pragma("unroll") for (int n = 0; n < 2; ++n) _Pragma("unroll") for (int k = 0; k < 2; ++k) dst[n][k] = *(const PG8_LAS bf16x8*)(lds + PG8_SB(b, h) + boff + n * 2048 + k * 1024); } while (0)
#define PG8_MMA(ai, bj, At, Bt) do { __builtin_amdgcn_s_setprio(1); _Pragma("unroll") for (int m = 0; m < 4; ++m) _Pragma("unroll") for (int n = 0; n < 2; ++n) _Pragma("unroll") for (int k = 0; k < 2; ++k) \
        acc[ai][bj][m][n] = __builtin_amdgcn_mfma_f32_16x16x32_bf16(Bt[n][k], At[m][k], acc[ai][bj][m][n], 0, 0, 0); __builtin_amdgcn_s_setprio(0); } while (0)
#define PG8_WAIT_V(n) asm volatile("s_waitcnt vmcnt(" #n ")" ::: "memory")
#define PG8_WAIT_L(n) asm volatile("s_waitcnt lgkmcnt(" #n ")" ::: "memory")
#define PG8_BAR __builtin_amdgcn_s_barrier()
#define PG8_SCHED __builtin_amdgcn_sched_barrier(0)
    Unit cur, nxt; int ui = 0;
    if (!S.next(0, cur)) return;
    f32x4 acc[2][2][4][2];
#pragma unroll
    for (int a = 0; a < 2; ++a)
#pragma unroll
        for (int b = 0; b < 2; ++b)
#pragma unroll
            for (int m = 0; m < 4; ++m)
#pragma unroll
                for (int n = 0; n < 2; ++n) acc[a][b][m][n] = (f32x4){0.f, 0.f, 0.f, 0.f};
    bf16x8 At[4][2], B0[2][2], B1[2][2];
    const char* cA = (const char*)g.A + (size_t)cur.pm * tstep; const char* cB = (const char*)g.Bt + (size_t)cur.pn * tstep;
    S.a_ready(cur);
    if constexpr (SP2) {
        PG8_STAGE(PG8_SB(0, 0), cB, voffB); PG8_STAGE(PG8_SB(0, 1), cB + hstep, voffB); PG8_STAGE(PG8_SA(0, 0), cA, voffA); PG8_STAGE(PG8_SA(0, 1), cA + hstep, voffA);
        if (wr == 1) PG8_BAR;
        PG8_WAIT_V(2); PG8_BAR;
        PG8_STAGE(PG8_SB(1, 0), cB + kstep, voffB); PG8_STAGE(PG8_SA(1, 0), cA + kstep, voffA); PG8_STAGE(PG8_SB(1, 1), cB + hstep + kstep, voffB);
        PG8_WAIT_V(6); PG8_BAR;
    } else {
        PG8_STAGE(PG8_SB(0, 0), cB, voffB); PG8_STAGE(PG8_SA(0, 0), cA, voffA); PG8_STAGE(PG8_SB(0, 1), cB + hstep, voffB); PG8_STAGE(PG8_SA(0, 1), cA + hstep, voffA);
        if (wr == 1) PG8_BAR;
        PG8_WAIT_V(4); PG8_BAR;
        PG8_STAGE(PG8_SB(1, 0), cB + kstep, voffB); PG8_STAGE(PG8_SA(1, 0), cA + kstep, voffA); PG8_STAGE(PG8_SB(1, 1), cB + hstep + kstep, voffB);
        PG8_WAIT_V(6); PG8_BAR;
    }
    for (;;) {
        const bool has_next = S.next(ui + 1, nxt);
        const char* nA = has_next ? (const char*)g.A + (size_t)nxt.pm * tstep : cA; const char* nB = has_next ? (const char*)g.Bt + (size_t)nxt.pn * tstep : cB;
        for (int t = 0; t < nt; t += 2) {
            const bool last = (t == nt - 2);
            const char* a1 = cA + (size_t)(t + 1) * kstep;
            const char* a2 = last ? nA : cA + (size_t)(t + 2) * kstep; const char* b2 = last ? nB : cB + (size_t)(t + 2) * kstep;
            const char* a3 = a2 + kstep; const char* b3 = b2 + kstep;
            if (last && has_next) S.a_ready(nxt);
            if constexpr (SP2) {
            PG8_LDB(B0, 0, 0); PG8_LDB(B1, 0, 1); PG8_SCHED; PG8_LDA(At, 0, 0); PG8_STAGE(PG8_SA(1, 1), a1 + hstep, voffA);
            PG8_WAIT_V(8); PG8_WAIT_L(0); PG8_BAR; PG8_MMA(0, 0, At, B0); PG8_MMA(0, 1, At, B1); PG8_BAR; PG8_SCHED;
            PG8_LDA(At, 0, 1); PG8_STAGE(PG8_SB(0, 0), b2, voffB); PG8_STAGE(PG8_SB(0, 1), b2 + hstep, voffB); PG8_STAGE(PG8_SA(0, 0), a2, voffA);
            PG8_WAIT_V(8); PG8_WAIT_L(0); PG8_BAR; PG8_MMA(1, 0, At, B0); PG8_MMA(1, 1, At, B1); PG8_BAR; PG8_SCHED;
            PG8_LDB(B0, 1, 0); PG8_LDB(B1, 1, 1); PG8_SCHED; PG8_LDA(At, 1, 0); PG8_STAGE(PG8_SA(0, 1), a2 + hstep, voffA);
            PG8_WAIT_V(8); PG8_WAIT_L(0); PG8_BAR; PG8_MMA(0, 0, At, B0); PG8_MMA(0, 1, At, B1); PG8_BAR; PG8_SCHED;
            PG8_LDA(At, 1, 1); PG8_STAGE(PG8_SB(1, 0), b3, voffB); PG8_STAGE(PG8_SB(1, 1), b3 + hstep, voffB); PG8_STAGE(PG8_SA(1, 0), a3, voffA);
            PG8_WAIT_V(8); PG8_WAIT_L(0); PG8_BAR; PG8_MMA(1, 0, At, B0); PG8_MMA(1, 1, At, B1); PG8_BAR; PG8_SCHED;
            } else {
            PG8_LDB(B0, 0, 0); PG8_SCHED; PG8_LDA(At, 0, 0); PG8_STAGE(PG8_SA(1, 1), a1 + hstep, voffA);
            PG8_WAIT_L(8); PG8_BAR; PG8_WAIT_L(0); PG8_MMA(0, 0, At, B0); PG8_BAR; PG8_SCHED;
            PG8_LDB(B1, 0, 1); PG8_STAGE(PG8_SB(0, 0), b2, voffB);
            PG8_BAR; PG8_WAIT_L(0); PG8_MMA(0, 1, At, B1); PG8_BAR;
            PG8_LDA(At, 0, 1); PG8_STAGE(PG8_SA(0, 0), a2, voffA);
            PG8_BAR; PG8_WAIT_L(0); PG8_MMA(1, 0, At, B0); PG8_BAR; PG8_SCHED;
            PG8_STAGE(PG8_SB(0, 1), b2 + hstep, voffB);
            PG8_WAIT_V(6); PG8_BAR; PG8_MMA(1, 1, At, B1); PG8_BAR;
            PG8_LDB(B0, 1, 0); PG8_SCHED; PG8_LDA(At, 1, 0); PG8_STAGE(PG8_SA(0, 1), a2 + hstep, voffA);
            PG8_WAIT_L(8); PG8_BAR; PG8_WAIT_L(0); PG8_MMA(0, 0, At, B0); PG8_BAR; PG8_SCHED;
            PG8_LDB(B1, 1, 1); PG8_STAGE(PG8_SB(1, 0), b3, voffB);
            PG8_BAR; PG8_WAIT_L(0); PG8_MMA(0, 1, At, B1); PG8_BAR;
            PG8_LDA(At, 1, 1); PG8_STAGE(PG8_SA(1, 0), a3, voffA);
            PG8_BAR; PG8_WAIT_L(0); PG8_MMA(1, 0, At, B0); PG8_BAR; PG8_SCHED;
            PG8_STAGE(PG8_SB(1, 1), b3 + hstep, voffB);
            PG8_WAIT_V(6); PG8_BAR; PG8_MMA(1, 1, At, B1); PG8_BAR;
            }
        }
        if constexpr (ALIGN_EPI) { if (wr == 0) PG8_BAR; }
        if constexpr (!Epi::AFTER_DRAIN) { E(acc, cur, wr, wc, fr, fq); S.done(cur); }
        if (!has_next) break;
#pragma unroll
        for (int a = 0; a < 2; ++a)
#pragma unroll
            for (int b = 0; b < 2; ++b)
#pragma unroll
                for (int m = 0; m < 4; ++m)
#pragma unroll
                    for (int n = 0; n < 2; ++n) acc[a][b][m][n] = (f32x4){0.f, 0.f, 0.f, 0.f};
        cur = nxt; cA = nA; cB = nB; ++ui;
        if constexpr (ALIGN_EPI) { if (wr == 1) PG8_BAR; }
    }
    PG8_WAIT_V(0);
    if constexpr (!ALIGN_EPI) { if (wr == 0) PG8_BAR; }
    PG8_BAR;
#undef PG8_SA
#undef PG8_SB
#undef PG8_STAGE
#undef PG8_LDA
#undef PG8_LDB
#undef PG8_MMA
#undef PG8_WAIT_V
#undef PG8_WAIT_L
#undef PG8_BAR
#undef PG8_SCHED
}
}

constexpr int NWAVES = 8, NTHR = 512;
constexpr int DM = 1024, SEQ = 8192, NB = 2, CTX = 256, TL = NB * SEQ, TC = NB * CTX, TT = TL + TC;
constexpr int FFN = 2752, FFNP = 2816, NWI = 5632, INW = 2432, INWP = 2560, NMOD = 9;
constexpr int ZF = 0, ZQ = 256, ZK = 640, ZV = 768, ZRR = 896, ZRK = 1280, ZRV = 1664, ZW = 2048, ZA = 2176, ZG = 2304;
constexpr int RW = 384;
constexpr float NORM_EPS = 1e-6f, GN_EPS = 64e-5f;

constexpr size_t MiB = 1u << 20;
constexpr size_t WS_CTL = 0, WS_MOD = 1 * MiB, WS_ROPE = 2 * MiB, WS_XC = 4 * MiB, WS_GC = 6 * MiB;
constexpr size_t WS_WI1 = 8 * MiB, WS_WO1 = 19 * MiB, WS_WIN = 25 * MiB, WS_WOUT = 30 * MiB, WS_WI2 = 32 * MiB, WS_WO2 = 43 * MiB;
constexpr size_t WS_H = 49 * MiB;
constexpr size_t WS_ACT = 82 * MiB;
constexpr size_t WS_O = 173 * MiB;
constexpr size_t WS_YD = WS_O, WS_QR = WS_O + 50 * MiB, WS_KR = WS_O + 62 * MiB;
constexpr size_t WS_W2T = WS_MOD + 256 * 1024, WS_A2T = WS_MOD + 512 * 1024, WS_G2T = WS_MOD + 768 * 1024;
constexpr size_t WS_LW = WS_O, WS_IC = WS_O + 25 * MiB;
constexpr size_t WS_GAM32 = 165 * MiB;
constexpr size_t WS_FA = 239 * MiB;
constexpr size_t WS_SUM = 255 * MiB;
constexpr size_t WS_END = 293 * MiB;

constexpr size_t WS_FT = 7 * MiB;
constexpr size_t FT_W64C = 0, FT_W64S = 8192, FT_W128C = 16384, FT_W128S = 49152, FT_T64C = 81920, FT_T64S = 90112;
constexpr int LDS_BYTES = 147456;

typedef unsigned short bf16;
typedef float f32x4 __attribute__((ext_vector_type(4)));
typedef unsigned v4u __attribute__((ext_vector_type(4)));
typedef unsigned v2u __attribute__((ext_vector_type(2)));
#define LAS __attribute__((address_space(3)))
#define LDS_WAIT() asm volatile("s_waitcnt lgkmcnt(0)" ::: "memory")

__device__ __forceinline__ unsigned f2bf(float f) { unsigned u = __builtin_bit_cast(unsigned, f); return (u + 0x7fffu + ((u >> 16) & 1u)) >> 16; }
__device__ __forceinline__ unsigned pk2(float lo, float hi) { return f2bf(lo) | (f2bf(hi) << 16); }
__device__ __forceinline__ float bf2f(unsigned short u) { return __builtin_bit_cast(float, (unsigned)u << 16); }
__device__ __forceinline__ float bflo(unsigned u) { return __builtin_bit_cast(float, u << 16); }
__device__ __forceinline__ float bfhi(unsigned u) { return __builtin_bit_cast(float, u & 0xffff0000u); }
__device__ __forceinline__ void unpack8(const v4u w, float (&f)[8]) { f[0] = bflo(w.x); f[1] = bfhi(w.x); f[2] = bflo(w.y); f[3] = bfhi(w.y); f[4] = bflo(w.z); f[5] = bfhi(w.z); f[6] = bflo(w.w); f[7] = bfhi(w.w); }
__device__ __forceinline__ float wave_sum(float v) {
#pragma unroll
    for (int o = 1; o < 64; o <<= 1) v += __shfl_xor(v, o);
    return v;
}
__device__ __forceinline__ float wave_max(float v) {
#pragma unroll
    for (int o = 1; o < 64; o <<= 1) v = fmaxf(v, __shfl_xor(v, o));
    return v;
}

struct Args { const float* in[25]; float* out; unsigned char* ws; int ph_lo, ph_hi; };

struct Frame {
    LAS unsigned char* lds;
    int tid, lane, wave, G, bid;
    float* out; unsigned char* ws;
};
enum { I_X = 0, I_C, I_CTX, I_CCTX, I_MODW, I_MODB, I_NORMG, I_F1WI, I_F1WO, I_WIN, I_WOUT, I_SINK, I_CONV, I_W0, I_W2, I_A0, I_A2, I_G2, I_KK, I_KA, I_RK, I_LNG, I_LNB, I_F2WI, I_F2WO };

__device__ __forceinline__ const float* inp(int i) {
    const __attribute__((address_space(4))) char* p = (const __attribute__((address_space(4))) char*)__builtin_amdgcn_kernarg_segment_ptr();
    asm volatile("" : "+s"(p));
    return *(const float* const __attribute__((address_space(4)))*)(p + 8 * i);
}
__device__ __forceinline__ void cvt_item(const float* W, int ldw, int k0, int sc, bool valid, bf16* WT, int Kd, int n0d, LAS float* scr, int lane) {
#pragma unroll 8
    for (int i = 0; i < 32; ++i) { const int kk = 2 * i + (lane >> 5); scr[kk * 33 + (lane & 31)] = valid ? W[(size_t)(k0 + kk) * ldw + sc + (lane & 31)] : 0.f; }
    LDS_WAIT(); asm volatile("" ::: "memory");
    const int c = lane & 7;
#pragma unroll
    for (int j = 0; j < 4; ++j) { const int n = (lane >> 3) + 8 * j; const LAS float* s = scr + (8 * c) * 33 + n;
        v4u o; o.x = pk2(s[0 * 33], s[1 * 33]); o.y = pk2(s[2 * 33], s[3 * 33]); o.z = pk2(s[4 * 33], s[5 * 33]); o.w = pk2(s[6 * 33], s[7 * 33]);
        *(v4u*)(WT + (size_t)(n0d + n) * Kd + k0 + 8 * c) = o; }
    LDS_WAIT(); asm volatile("" ::: "memory");
}
__device__ __forceinline__ void convert_weights(Frame& F, int li) {
    LAS float* scr = (LAS float*)(F.lds + F.wave * 16384);
    const int gw = F.bid * NWAVES + F.wave, NGW = F.G * NWAVES;
    constexpr int I_WI = 16 * (NWI / 32), I_WO = (FFNP / 64) * 32, I_IN = 16 * (INWP / 32), I_OUT = 16 * 32;
    constexpr int NITEMS = 2 * I_WI + 2 * I_WO + I_IN + I_OUT;
    for (int it = gw; it < NITEMS; it += NGW) {
        int r = it;
        if (r < 2 * I_WI) { const int f = r / I_WI; r -= f * I_WI; const int nblk = NWI / 32, kb = r / nblk, nb = r % nblk;
            const int n0 = 32 * nb, pn = n0 >> 8, i = n0 & 255; const int j = 128 * pn + (i & 127); const bool valid = j < FFN; const int sc = (i < 128) ? j : FFN + j;
            cvt_item((f ? inp(I_F2WI) : inp(I_F1WI)) + (size_t)li * DM * 2 * FFN, 2 * FFN, 64 * kb, sc, valid, (bf16*)(F.ws + (f ? WS_WI2 : WS_WI1)), DM, n0, scr, F.lane); continue; }
        r -= 2 * I_WI;
        if (r < 2 * I_WO) { const int f = r / I_WO; r -= f * I_WO; const int kb = r / 32, nb = r % 32; const bool valid = 64 * kb < FFN;
            cvt_item((f ? inp(I_F2WO) : inp(I_F1WO)) + (size_t)li * FFN * DM, DM, 64 * kb, 32 * nb, valid, (bf16*)(F.ws + (f ? WS_WO2 : WS_WO1)), FFNP, 32 * nb, scr, F.lane); continue; }
        r -= 2 * I_WO;
        if (r < I_IN) { const int nblk = INWP / 32, kb = r / nblk, nb = r % nblk; const bool valid = 32 * nb < INW;
            cvt_item(inp(I_WIN) + (size_t)li * DM * INW, INW, 64 * kb, 32 * nb, valid, (bf16*)(F.ws + WS_WIN), DM, 32 * nb, scr, F.lane); continue; }
        r -= I_IN;
        { const int kb = r / 32, nb = r % 32;
            cvt_item(inp(I_WOUT) + (size_t)li * DM * DM, DM, 64 * kb, 32 * nb, true, (bf16*)(F.ws + WS_WOUT), DM, 32 * nb, scr, F.lane); }
    }
}
__device__ __forceinline__ void mod_gemv(Frame& F) {
    LAS float* sc = (LAS float*)F.lds;
    LAS float* red = sc + 3 * 1024;
    __syncthreads();
    for (int i = F.tid; i < 3 * 1024; i += NTHR) { const int v = i >> 10, k = i & 1023; const float x = v < 2 ? inp(I_C)[v * 1024 + k] : inp(I_CCTX)[k]; sc[i] = x / (1.0f + __expf(-x)); }
    __syncthreads();
    float* modv = (float*)(F.ws + WS_MOD);
    for (int u = F.bid; u < 2 * 72; u += F.G) {
        const int l = u / 72, n0 = (u % 72) * 128;
        const float* w = inp(I_MODW) + (size_t)l * DM * 9216 + n0 + 2 * F.lane;
        float a0 = 0.f, a1 = 0.f, b0 = 0.f, b1 = 0.f, c0 = 0.f, c1 = 0.f;
        const int k0 = F.wave * 128;
#pragma unroll 8
        for (int k = 0; k < 128; ++k) { const float2 wv = *(const float2*)(w + (size_t)(k0 + k) * 9216); const float s0 = sc[k0 + k], s1 = sc[1024 + k0 + k], s2 = sc[2048 + k0 + k];
            a0 += s0 * wv.x; a1 += s0 * wv.y; b0 += s1 * wv.x; b1 += s1 * wv.y; c0 += s2 * wv.x; c1 += s2 * wv.y; }
        LAS float* rw = red + F.wave * 384 + 2 * F.lane;
        rw[0] = a0; rw[1] = a1; rw[128] = b0; rw[129] = b1; rw[256] = c0; rw[257] = c1;
        __syncthreads();
        if (F.tid < 384) { float s = 0.f;
#pragma unroll
            for (int w8 = 0; w8 < 8; ++w8) s += red[w8 * 384 + F.tid];
            const int v = F.tid >> 7, n = n0 + (F.tid & 127);
            modv[(size_t)(l * 3 + v) * 9216 + n] = s + inp(I_MODB)[l * 9216 + n]; }
        __syncthreads();
    }
}
__device__ __forceinline__ void rope_tables(Frame& F) {
    float* ct = (float*)(F.ws + WS_ROPE); float* st = ct + SEQ * 32;
    for (int i = F.bid * NTHR + F.tid; i < SEQ * 32; i += F.G * NTHR) {
        const int t = i >> 5, j = i & 31; const int f = j & 15;
        const float inv = exp2f(-(float)f * (13.287712379549449f / 16.0f));
        const float pos = (float)(j < 16 ? (t >> 6) : (t & 63));
        const float ang = pos * inv;
        const double a = (double)ang; const double k = __builtin_rint(a * 0.15915494309189535); const float r = (float)(a - k * 6.283185307179586);
        ct[i] = __cosf(r); st[i] = __sinf(r);
    }
}

struct EArgs { const float* xl_src; const float* xc_src; float* xl_dst; float* xc_dst; const float* o; const float* modv_g; int gidx; float gmul; const float* gpost;
               bf16* hdst; const float* modv_h; int shidx, scidx; const float* gpre; int nrows; };
__device__ __forceinline__ void e_phase(Frame& F, const EArgs& A) {
    const int gw = F.bid * NWAVES + F.wave, NGW = F.G * NWAVES;
    for (int r = gw; r < A.nrows; r += NGW) {
        const int v = r < TL ? (r >> 13) : 2;
        const float* xs = r < TL ? A.xl_src + (size_t)r * DM : A.xc_src + (size_t)(r - TL) * DM;
        f32x4 x[4];
#pragma unroll
        for (int j = 0; j < 4; ++j) x[j] = ((const f32x4*)xs)[F.lane + 64 * j];
        if (A.o) {
            const f32x4* orow = (const f32x4*)(A.o + (size_t)r * DM); f32x4 ov[4]; float ss = 0.f;
#pragma unroll
            for (int j = 0; j < 4; ++j) { ov[j] = orow[F.lane + 64 * j]; ss += (ov[j].x * ov[j].x + ov[j].y * ov[j].y) + (ov[j].z * ov[j].z + ov[j].w * ov[j].w); }
            const float rstd = 1.0f / sqrtf(wave_sum(ss) * (1.0f / DM) + NORM_EPS) * A.gmul;
            const f32x4* gm = (const f32x4*)(A.modv_g + (size_t)v * 9216 + A.gidx * DM); const f32x4* gp = (const f32x4*)A.gpost;
            float* xd = r < TL ? A.xl_dst + (size_t)r * DM : A.xc_dst + (size_t)(r - TL) * DM;
#pragma unroll
            for (int j = 0; j < 4; ++j) { const f32x4 g = gm[F.lane + 64 * j], p = gp[F.lane + 64 * j]; x[j] = x[j] + g * (ov[j] * rstd * p); ((f32x4*)xd)[F.lane + 64 * j] = x[j]; }
        }
        if (A.hdst) {
            float ss = 0.f;
#pragma unroll
            for (int j = 0; j < 4; ++j) ss += (x[j].x * x[j].x + x[j].y * x[j].y) + (x[j].z * x[j].z + x[j].w * x[j].w);
            const float rstd = 1.0f / sqrtf(wave_sum(ss) * (1.0f / DM) + NORM_EPS);
            const f32x4* sh = (const f32x4*)(A.modv_h + (size_t)v * 9216 + A.shidx * DM); const f32x4* scl = (const f32x4*)(A.modv_h + (size_t)v * 9216 + A.scidx * DM); const f32x4* gp = (const f32x4*)A.gpre;
            v2u* hd = (v2u*)(A.hdst + (size_t)r * DM);
#pragma unroll
            for (int j = 0; j < 4; ++j) { const f32x4 s = sh[F.lane + 64 * j], c = scl[F.lane + 64 * j], p = gp[F.lane + 64 * j]; const f32x4 hv = (x[j] * rstd * p) * (1.0f + c) + s;
                v2u w; w.x = pk2(hv.x, hv.y); w.y = pk2(hv.z, hv.w); hd[F.lane + 64 * j] = w; }
        }
    }
}

__device__ __forceinline__ const bf16* zrow(const Frame& F, int row) { return (const bf16*)(F.ws + WS_ACT) + (size_t)row * INWP; }

__device__ __forceinline__ void rope_all(Frame& F) {
    const float* ct = (const float*)(F.ws + WS_ROPE); const float* st = ct + SEQ * 32;
    bf16* qr = (bf16*)(F.ws + WS_QR); bf16* kr = (bf16*)(F.ws + WS_KR);
    for (int i = F.bid * NTHR + F.tid; i < TL * 32; i += F.G * NTHR) {
        const int o = i & 3, hh = (i >> 2) & 7, tok = i >> 5; const int s = tok & (SEQ - 1);
        const bf16* z = zrow(F, tok) + (hh < 6 ? ZQ + 64 * hh : ZK + 64 * (hh - 6)) + 8 * o;
        float x1[8], x2[8]; unpack8(*(const v4u*)z, x1); unpack8(*(const v4u*)(z + 32), x2);
        const f32x4 c0 = *(const f32x4*)(ct + s * 32 + 8 * o), c1 = *(const f32x4*)(ct + s * 32 + 8 * o + 4), s0 = *(const f32x4*)(st + s * 32 + 8 * o), s1 = *(const f32x4*)(st + s * 32 + 8 * o + 4);
        const float sc = hh < 6 ? 0.125f : 1.0f; float o1[8], o2[8];
#pragma unroll
        for (int e = 0; e < 4; ++e) { o1[e] = (x1[e] * c0[e] - x2[e] * s0[e]) * sc; o2[e] = (x2[e] * c0[e] + x1[e] * s0[e]) * sc; o1[e + 4] = (x1[e + 4] * c1[e] - x2[e + 4] * s1[e]) * sc; o2[e + 4] = (x2[e + 4] * c1[e] + x1[e + 4] * s1[e]) * sc; }
        bf16* d = hh < 6 ? qr + (size_t)tok * 384 + 64 * hh + 8 * o : kr + (size_t)tok * 128 + 64 * (hh - 6) + 8 * o;
        *(v4u*)d = (v4u){pk2(o1[0], o1[1]), pk2(o1[2], o1[3]), pk2(o1[4], o1[5]), pk2(o1[6], o1[7])};
        *(v4u*)(d + 32) = (v4u){pk2(o2[0], o2[1]), pk2(o2[2], o2[3]), pk2(o2[4], o2[5]), pk2(o2[6], o2[7])}; }
}
__device__ __forceinline__ void fourier_a_unit(Frame& F, int u) {
    const int b = u >> 7, n2 = u & 127;
    LAS float* tab = (LAS float*)F.lds;
    __syncthreads();
    if (F.tid < 64) { const float a = (float)F.tid * (1.0f / 64.0f); tab[F.tid] = __builtin_amdgcn_cosf(a); tab[64 + F.tid] = __builtin_amdgcn_sinf(a); }
    __syncthreads();
    const int c = F.tid & 255, kh = F.tid >> 8;
    float f[64];
#pragma unroll
    for (int n1 = 0; n1 < 64; ++n1) f[n1] = bf2f(zrow(F, b * SEQ + 128 * n1 + n2)[ZF + c]);
    bf16* far = (bf16*)(F.ws + WS_FA); bf16* fai = far + (size_t)NB * 64 * 128 * 256;
    for (int kk = 0; kk < 32; ++kk) { const int k1 = kh * 32 + kk;
        float sr = 0.f, si = 0.f;
#pragma unroll
        for (int n1 = 0; n1 < 64; ++n1) { const int idx = (n1 * k1) & 63; sr += f[n1] * tab[idx]; si -= f[n1] * tab[64 + idx]; }
        const float tw = (float)(n2 * k1) * (1.0f / 8192.0f); const float tc = __builtin_amdgcn_cosf(tw), ts = -__builtin_amdgcn_sinf(tw);
        const size_t o = (((size_t)b * 64 + k1) * 128 + n2) * 256 + c;
        far[o] = (bf16)f2bf(sr * tc - si * ts); fai[o] = (bf16)f2bf(sr * ts + si * tc);
    }
}
__device__ __forceinline__ void fourier_c_unit(Frame& F, int u) {
    const int b = u >> 7, k1 = (u >> 1) & 63, half = u & 1;
    LAS float* tab = (LAS float*)F.lds;
    LAS float* tab64 = tab + 256;
    LAS float* P = tab + 512;
    __syncthreads();
    if (F.tid < 128) { const float a = (float)F.tid * (1.0f / 128.0f); tab[F.tid] = __builtin_amdgcn_cosf(a); tab[128 + F.tid] = __builtin_amdgcn_sinf(a); }
    if (F.tid >= 128 && F.tid < 192) { const float a = (float)(F.tid - 128) * (1.0f / 64.0f); tab64[F.tid - 128] = __builtin_amdgcn_cosf(a); tab64[64 + F.tid - 128] = __builtin_amdgcn_sinf(a); }
    __syncthreads();
    const int c = F.tid & 255, q = F.tid >> 8;
    const bf16* far = (const bf16*)(F.ws + WS_FA) + (((size_t)b * 64 + k1) * 128) * 256 + c; const bf16* fai = far + (size_t)NB * 64 * 128 * 256;
    float ar[32], ai[32];
#pragma unroll
    for (int i = 0; i < 32; ++i) { ar[i] = 0.f; ai[i] = 0.f; }
    const int k2b = 64 * half + 32 * q;
    for (int n2 = 0; n2 < 128; ++n2) { const float xr = bf2f(far[(size_t)n2 * 256]), xi = bf2f(fai[(size_t)n2 * 256]);
#pragma unroll
        for (int i = 0; i < 32; ++i) { const int idx = (n2 * (k2b + i)) & 127; const float cs = tab[idx], sn = tab[128 + idx];
            ar[i] += xr * cs + xi * sn; ai[i] += xi * cs - xr * sn; } }
    bf16* mix = (bf16*)(F.ws + WS_H);
    const int g = c >> 6;
    float y[32];
#pragma unroll
    for (int i = 0; i < 32; ++i) y[i] = 0.f;
#pragma unroll
    for (int rnd = 0; rnd < 2; ++rnd) {
        __syncthreads();
#pragma unroll
        for (int i = 0; i < 32; ++i) P[(32 * q + i) * 256 + c] = rnd == 0 ? ar[i] : ai[i];
        __syncthreads();
        const int m = c & 63;
        for (int cc = 0; cc < 64; ++cc) { const int idx = (m * cc) & 63; const float t = rnd == 0 ? tab64[idx] : tab64[64 + idx];
#pragma unroll
            for (int i = 0; i < 32; ++i) y[i] += P[(32 * q + i) * 256 + 64 * g + cc] * t; }
    }
    const float scale = 0.0013810679320049757f;
#pragma unroll
    for (int i = 0; i < 32; ++i) { const int k = k1 + 64 * (k2b + i); mix[(size_t)(b * SEQ + k) * DM + c] = (bf16)f2bf(y[i] * scale); }
}
__device__ __forceinline__ void fourier_ctx1_all(Frame& F) {
    float* gr = (float*)(F.ws + WS_GC); float* gi = gr + TC * 256;
    const bf16* wc = (const bf16*)(F.ws + WS_FT + FT_W64C); const bf16* wsn = (const bf16*)(F.ws + WS_FT + FT_W64S);
    for (int i = F.bid * NTHR + F.tid; i < TC * 256; i += F.G * NTHR) { const int tok = i >> 8, gm = i & 255, g = gm >> 6, m = gm & 63;
        const bf16* z = zrow(F, TL + tok) + ZF + 64 * g; float sr = 0.f, si = 0.f;
#pragma unroll
        for (int c8 = 0; c8 < 8; ++c8) { float x[8], cs[8], sn[8]; unpack8(*(const v4u*)(z + 8 * c8), x); unpack8(*(const v4u*)(wc + m * 64 + 8 * c8), cs); unpack8(*(const v4u*)(wsn + m * 64 + 8 * c8), sn);
#pragma unroll
            for (int e = 0; e < 8; ++e) { sr += x[e] * cs[e]; si -= x[e] * sn[e]; } }
        gr[i] = sr; gi[i] = si; }
}
__device__ __forceinline__ void fourier_ctx2_all(Frame& F) {
    const float* gr = (const float*)(F.ws + WS_GC); const float* gi = gr + TC * 256; bf16* mix = (bf16*)(F.ws + WS_H);
    for (int i = F.bid * NTHR + F.tid; i < TC * 256; i += F.G * NTHR) { const int row = i >> 8, gm = i & 255, b = row >> 8, k = row & 255; float y = 0.f;
#pragma unroll 8
        for (int n = 0; n < 256; ++n) { const float a = (float)((k * n) & 255) * (1.0f / 256.0f); y += gr[(b * 256 + n) * 256 + gm] * __builtin_amdgcn_cosf(a) + gi[(b * 256 + n) * 256 + gm] * __builtin_amdgcn_sinf(a); }
        mix[(size_t)(TL + row) * DM + gm] = (bf16)f2bf(y * 0.0078125f); }
}
__device__ __forceinline__ float dot64(const float (&q)[64], const bf16* krow) {
    float s = 0.f;
#pragma unroll
    for (int i = 0; i < 8; ++i) { const v4u w = ((const v4u*)krow)[i];
        s += q[8 * i + 0] * bflo(w.x) + q[8 * i + 1] * bfhi(w.x) + q[8 * i + 2] * bflo(w.y) + q[8 * i + 3] * bfhi(w.y) + q[8 * i + 4] * bflo(w.z) + q[8 * i + 5] * bfhi(w.z) + q[8 * i + 6] * bflo(w.w) + q[8 * i + 7] * bfhi(w.w); }
    return s;
}
__device__ __forceinline__ void attn_v1(Frame& F, int li) {
    const int gw = F.bid * NWAVES + F.wave, NGW = F.G * NWAVES;
    const bf16* qr = (const bf16*)(F.ws + WS_QR); const bf16* kr = (const bf16*)(F.ws + WS_KR); bf16* mix = (bf16*)(F.ws + WS_H);
    const float* sink = inp(I_SINK) + li * 6;
    const int npairs = (li == 0 ? TT : TL) * 6;
    for (int p = gw; p < npairs; p += NGW) {
        const int row = p / 6, hq = p % 6, kvh = hq / 3; const bool isctx = row >= TL;
        const int b = isctx ? (row - TL) >> 8 : row >> 13, s = row & (SEQ - 1);
        float q[64];
        if (!isctx) {
#pragma unroll
            for (int i = 0; i < 8; ++i) { const v4u w = ((const v4u*)(qr + (size_t)row * 384 + 64 * hq))[i];
                q[8 * i] = bflo(w.x); q[8 * i + 1] = bfhi(w.x); q[8 * i + 2] = bflo(w.y); q[8 * i + 3] = bfhi(w.y); q[8 * i + 4] = bflo(w.z); q[8 * i + 5] = bfhi(w.z); q[8 * i + 6] = bflo(w.w); q[8 * i + 7] = bfhi(w.w); }
        } else {
#pragma unroll
            for (int i = 0; i < 8; ++i) { const v4u w = ((const v4u*)(zrow(F, row) + ZQ + 64 * hq))[i];
                q[8 * i] = 0.125f * bflo(w.x); q[8 * i + 1] = 0.125f * bfhi(w.x); q[8 * i + 2] = 0.125f * bflo(w.y); q[8 * i + 3] = 0.125f * bfhi(w.y); q[8 * i + 4] = 0.125f * bflo(w.z); q[8 * i + 5] = 0.125f * bfhi(w.z); q[8 * i + 6] = 0.125f * bflo(w.w); q[8 * i + 7] = 0.125f * bfhi(w.w); }
        }
        float sc[9]; int krow_[9];
        const float NEG = -INFINITY;
        float mx = sink[hq];
#pragma unroll
        for (int r = 0; r < 9; ++r) {
            if (r < 5) {
                const int kp = s - 128 + 64 * r + F.lane; const bool ok = !isctx && kp >= 0 && kp < SEQ && kp <= s + 128;
                const int kc = ok ? kp : 0; krow_[r] = b * SEQ + kc;
                const float d = isctx ? 0.f : dot64(q, kr + (size_t)(b * SEQ + kc) * 128 + 64 * kvh);
                sc[r] = ok ? d : NEG;
            } else {
                const int kc = 64 * (r - 5) + F.lane; krow_[r] = TL + b * CTX + kc;
                sc[r] = dot64(q, zrow(F, TL + b * CTX + kc) + ZK + 64 * kvh);
            }
            mx = fmaxf(mx, sc[r]);
        }
        mx = wave_max(mx);
        float den = 0.f;
#pragma unroll
        for (int r = 0; r < 9; ++r) { sc[r] = __expf(sc[r] - mx); den += sc[r]; }
        den = wave_sum(den) + __expf(sink[hq] - mx);
        float acc = 0.f;
#pragma unroll
        for (int r = 0; r < 9; ++r) {
            if (r < 5 && isctx) continue;
            for (int kk = 0; kk < 64; ++kk) { const float pk = __builtin_bit_cast(float, __builtin_amdgcn_readlane(__builtin_bit_cast(int, sc[r]), kk)); const int kr_ = __builtin_amdgcn_readlane(krow_[r], kk);
                acc += pk * bf2f(zrow(F, kr_)[ZV + 64 * kvh + F.lane]); }
        }
        mix[(size_t)row * DM + 256 + 64 * hq + F.lane] = (bf16)f2bf(acc / den);
    }
}

typedef short bf16x8 __attribute__((ext_vector_type(8)));
#define MFMA16(a, b, c) __builtin_amdgcn_mfma_f32_16x16x32_bf16(a, b, c, 0, 0, 0)
__device__ __forceinline__ bf16x8 mk8(unsigned a, unsigned b, unsigned c, unsigned d) { const v4u v = {a, b, c, d}; return __builtin_bit_cast(bf16x8, v); }
typedef __bf16 bf16x2_t __attribute__((ext_vector_type(2)));
typedef float f32x2_t __attribute__((ext_vector_type(2)));
__device__ __forceinline__ unsigned cvtpk(float lo, float hi) { const f32x2_t f = {lo, hi}; return __builtin_bit_cast(unsigned, __builtin_convertvector(f, bf16x2_t)); }
constexpr int NSC = 66;
constexpr int IM_AI = 0, IM_RI = 4608, IM_BI = 9216, IM_KI = 13824, IM_BKT = 18432, IM_VT = 28672, IM_GAM = 33792, IMG_BYTES = 34816;
constexpr int L_IMG0 = 0, L_IMG1 = IMG_BYTES, L_PKG = 2 * IMG_BYTES, L_YL = L_PKG + 8192, L_VB = L_YL + 128 * 68 * 4, L_BON = L_VB + 128 * 64 * 2, L_CST = L_BON + 512, L_RW_END = L_CST + 3072;
static_assert(L_RW_END <= 146432, "rwkv LDS map");
constexpr size_t SUM_SLOT = 24576;

__device__ __forceinline__ void lora_transposes(Frame& F) {
    bf16* w2t = (bf16*)(F.ws + WS_W2T); bf16* a2t = (bf16*)(F.ws + WS_A2T); bf16* g2t = (bf16*)(F.ws + WS_G2T);
    const float* w2 = inp(I_W2); const float* a2 = inp(I_A2); const float* g2 = inp(I_G2);
    for (int i = F.bid * NTHR + F.tid; i < 4 * 384 * 64; i += F.G * NTHR) { const int r = i & 63, col = (i >> 6) % 384, ld = i / (384 * 64);
        w2t[i] = (bf16)f2bf(w2[((size_t)ld * 64 + r) * RW + col]); a2t[i] = (bf16)f2bf(a2[((size_t)ld * 64 + r) * RW + col]); }
    for (int i = F.bid * NTHR + F.tid; i < 2 * 384 * 128; i += F.G * NTHR) { const int r = i & 127, col = (i >> 7) % 384, l = i / (384 * 128);
        g2t[i] = (bf16)f2bf(g2[((size_t)l * 128 + r) * RW + col]); }
}

__device__ __forceinline__ float softplus_fast(float x) { return fmaxf(x, 0.f) + __logf(1.0f + __expf(-fabsf(x))); }
__device__ __forceinline__ void lora_unit(Frame& F, int li, int u) {
    const int dir = u & 1, r0 = (u >> 1) * 64, q = F.lane >> 4, c16 = F.lane & 15;
    bf16* LW = (bf16*)(F.ws + WS_LW) + (size_t)dir * TT * RW; bf16* IC = (bf16*)(F.ws + WS_IC) + (size_t)dir * TT * RW;
    const bf16* w2t = (const bf16*)(F.ws + WS_W2T) + (size_t)(li * 2 + dir) * 384 * 64; const bf16* a2t = (const bf16*)(F.ws + WS_A2T) + (size_t)(li * 2 + dir) * 384 * 64;
    bf16x8 bw[4][2], ba[4][2];
#pragma unroll
    for (int rt = 0; rt < 4; ++rt)
#pragma unroll
        for (int k = 0; k < 2; ++k) { const bf16* z = zrow(F, r0 + 16 * rt + c16);
            const v4u zw = *(const v4u*)(z + ZW + 64 * dir + 32 * k + 8 * q); ba[rt][k] = *(const bf16x8*)(z + ZA + 64 * dir + 32 * k + 8 * q);
            bw[rt][k] = mk8(pk2(tanhf(bflo(zw.x)), tanhf(bfhi(zw.x))), pk2(tanhf(bflo(zw.y)), tanhf(bfhi(zw.y))), pk2(tanhf(bflo(zw.z)), tanhf(bfhi(zw.z))), pk2(tanhf(bflo(zw.w)), tanhf(bfhi(zw.w)))); }
#pragma unroll 1
    for (int cti = 0; cti < 3; ++cti) { const int ct = 3 * F.wave + cti; const int col = 16 * ct + c16;
        bf16x8 aw[2], aa[2];
#pragma unroll
        for (int k = 0; k < 2; ++k) { aw[k] = *(const bf16x8*)(w2t + (size_t)col * 64 + 32 * k + 8 * q); aa[k] = *(const bf16x8*)(a2t + (size_t)col * 64 + 32 * k + 8 * q); }
        const f32x4 w0v = *(const f32x4*)(inp(I_W0) + (li * 2 + dir) * RW + 16 * ct + 4 * q); const f32x4 a0v = *(const f32x4*)(inp(I_A0) + (li * 2 + dir) * RW + 16 * ct + 4 * q);
#pragma unroll
        for (int rt = 0; rt < 4; ++rt) { f32x4 dw = {0.f, 0.f, 0.f, 0.f}, da = {0.f, 0.f, 0.f, 0.f};
#pragma unroll
            for (int k = 0; k < 2; ++k) { dw = MFMA16(aw[k], bw[rt][k], dw); da = MFMA16(aa[k], ba[rt][k], da); }
            float lw[4], ic[4];
#pragma unroll
            for (int e = 0; e < 4; ++e) { const float x = w0v[e] + dw[e]; const float wl = -softplus_fast(-x) - 0.5f; lw[e] = -__expf(wl); ic[e] = 1.0f / (1.0f + __expf(-(a0v[e] + da[e]))); }
#pragma unroll
            for (int d = 1; d < 16; d <<= 1) {
#pragma unroll
                for (int e = 0; e < 4; ++e) { const float up = __shfl_up(lw[e], d, 16), dn = __shfl_down(lw[e], d, 16); lw[e] += dir == 0 ? (c16 >= d ? up : 0.f) : (c16 + d < 16 ? dn : 0.f); } }
#pragma unroll
            for (int e = 0; e < 4; ++e) lw[e] = __expf(lw[e]);
            if (c16 == (dir == 0 ? 15 : 0)) *(f32x4*)((float*)(F.ws + WS_GAM32) + ((size_t)dir * (TT / 16) + ((r0 + 16 * rt) >> 4)) * RW + 16 * ct + 4 * q) = (f32x4){lw[0], lw[1], lw[2], lw[3]};
            const size_t o = (size_t)(r0 + 16 * rt + c16) * RW + 16 * ct + 4 * q;
            v2u w; w.x = pk2(lw[0], lw[1]); w.y = pk2(lw[2], lw[3]); *(v2u*)(LW + o) = w; w.x = pk2(ic[0], ic[1]); w.y = pk2(ic[2], ic[3]); *(v2u*)(IC + o) = w; }
    }
}

struct ChainCtx { int dir, b, h, li; float kkw, kaw, rkw; float cw[3][3]; };
__device__ __forceinline__ void chain_consts(ChainCtx& C, int li, int dir, int b, int h, int j) {
    C.dir = dir; C.b = b; C.h = h; C.li = li; const int ch = 64 * h + j;
    C.kkw = inp(I_KK)[li * RW + ch]; C.kaw = inp(I_KA)[li * RW + ch]; C.rkw = inp(I_RK)[li * RW + ch];
#pragma unroll
    for (int t = 0; t < 3; ++t)
#pragma unroll
        for (int qq = 0; qq < 3; ++qq) C.cw[t][qq] = inp(I_CONV)[(size_t)(li * 3 + t) * (3 * RW) + qq * RW + ch];
}
template <int TPT, bool BONUS>
__device__ __forceinline__ void prep_round(Frame& F, const ChainCtx& C, LAS unsigned char* img, int j, int tg, bool isctx, int step0, LAS unsigned char* lds_vb, LAS float* lds_bon, int pos0_local) {
    const int L = isctx ? CTX : SEQ, rbase = isctx ? TL + C.b * CTX : C.b * SEQ, ch = 64 * C.h + j;
    const bf16* LW = (const bf16*)(F.ws + WS_LW) + (size_t)C.dir * TT * RW + ch; const bf16* IC = (const bf16*)(F.ws + WS_IC) + (size_t)C.dir * TT * RW + ch;
    const int tok0 = tg * TPT, blk = tok0 >> 4;
    float cum = 0.f;
    for (int t = blk * 16; t < tok0; ++t) { const int s = step0 + t; const int p = C.dir ? L - 1 - s : s; cum += bf2f(LW[(size_t)(rbase + p) * RW]); }
    float eprev = __expf(cum);
    const int pj = (j & ~31) | (((j & 15) >> 2) << 3) | (((j >> 4) & 1) << 2) | (j & 3);
    LAS bf16* AI = (LAS bf16*)(img + IM_AI) + blk * 1152, *RI = (LAS bf16*)(img + IM_RI) + blk * 1152, *BI = (LAS bf16*)(img + IM_BI) + blk * 1152, *KI = (LAS bf16*)(img + IM_KI) + blk * 1152;
    LAS bf16* BKT = (LAS bf16*)(img + IM_BKT) + blk * 2560 + j * 40; LAS bf16* VT = (LAS bf16*)(img + IM_VT) + blk * 1280 + j * 20; LAS float* GAM = (LAS float*)(img + IM_GAM) + blk * 64;
#pragma unroll 2
    for (int u = 0; u < TPT; ++u) { const int t = tok0 + u, tb = t & 15; const int s = step0 + t; const int p = C.dir ? L - 1 - s : s; const int row = rbase + p;
        const float lw = bf2f(LW[(size_t)row * RW]), ai = bf2f(IC[(size_t)row * RW]);
        float rv = 0.f, kv = 0.f, vv = 0.f;
#pragma unroll
        for (int tt = 0; tt < 3; ++tt) { const int pp = p + tt - 1; if (pp >= 0 && pp < L) { const bf16* z = zrow(F, rbase + pp); rv += C.cw[tt][0] * bf2f(z[ZRR + ch]); kv += C.cw[tt][1] * bf2f(z[ZRK + ch]); vv += C.cw[tt][2] * bf2f(z[ZRV + ch]); } }
        const float kkr = kv * C.kkw; const float ss = wave_sum(kkr * kkr); const float kk = kkr * (1.0f / sqrtf(fmaxf(ss, 1e-24f)));
        const float kd = kv * (1.0f + (ai - 1.0f) * C.kaw);
        const float ec = eprev * __expf(lw), en = 1.0f / ec;
        AI[tb * 72 + pj] = (bf16)f2bf(-kk * eprev); RI[tb * 72 + pj] = (bf16)f2bf(rv * ec);
        const bf16 bt = (bf16)f2bf(kk * ai * en), kt = (bf16)f2bf(kd * en);
        BI[tb * 72 + pj] = bt; KI[tb * 72 + pj] = kt;
        BKT[(tb >> 2) * 8 + (tb & 3)] = bt; BKT[(tb >> 2) * 8 + 4 + (tb & 3)] = kt;
        VT[tb] = (bf16)f2bf(vv);
        if (tb == 15) GAM[j] = ec;
        if constexpr (BONUS) { const float bs = wave_sum(rv * kv * C.rkw); const int pl = C.dir ? pos0_local - t : pos0_local + t;
            ((LAS bf16*)lds_vb)[pl * 64 + j] = (bf16)f2bf(vv); if (j == 0) lds_bon[pl] = bs; }
        eprev = ec; }
}
__device__ __forceinline__ void chain_consts_lds(Frame& F, LAS float* cst, int li, int h, int t256) {
    for (int i = t256; i < 12 * 64; i += 256) { const int k = i >> 6, j = i & 63, ch = 64 * h + j; float v;
        if (k == 0) v = inp(I_KK)[li * RW + ch]; else if (k == 1) v = inp(I_KA)[li * RW + ch]; else if (k == 2) v = inp(I_RK)[li * RW + ch];
        else { const int tt = (k - 3) / 3, w = (k - 3) % 3; v = inp(I_CONV)[(size_t)(li * 3 + tt) * (3 * RW) + w * RW + ch]; }
        cst[i] = v; }
}
struct PrepRaw { v4u zr[3], zk[3], zv[3]; };
__device__ __forceinline__ void prep_load(Frame& F, PrepRaw& R, int dir, int b, int h, int tl, int o, bool isctx, int step0) {
    const int L = isctx ? CTX : SEQ, rbase = isctx ? TL + b * CTX : b * SEQ, ch0 = 64 * h + 8 * o;
    const int s = step0 + tl; const int p = dir ? L - 1 - s : s;
#pragma unroll
    for (int tt = 0; tt < 3; ++tt) { const int pp = p + tt - 1; const bool ok = pp >= 0 && pp < L; const bf16* z = zrow(F, rbase + (ok ? pp : p)) + ch0;
        const v4u z0 = {0u, 0u, 0u, 0u};
        R.zr[tt] = ok ? *(const v4u*)(z + ZRR) : z0; R.zk[tt] = ok ? *(const v4u*)(z + ZRK) : z0; R.zv[tt] = ok ? *(const v4u*)(z + ZRV) : z0; }
}
__device__ __forceinline__ void prep_compute(Frame& F, const PrepRaw& R, const LAS float* cst, LAS unsigned char* img, int dir, int b, int h, int tl, int o, bool isctx, int step0, LAS unsigned char* lds_vb, LAS float* lds_bon, int pos0_local) {
    const bool BONUS = lds_vb != nullptr;
    const int L = isctx ? CTX : SEQ, rbase = isctx ? TL + b * CTX : b * SEQ, ch0 = 64 * h + 8 * o;
    const int blk = tl >> 4, tb = tl & 15;
    const int s = step0 + tl; const int p = dir ? L - 1 - s : s; const int row = rbase + p;
    const bf16* LW = (const bf16*)(F.ws + WS_LW) + (size_t)dir * TT * RW + ch0; const bf16* IC = (const bf16*)(F.ws + WS_IC) + (size_t)dir * TT * RW + ch0;
    const v4u ecw = *(const v4u*)(LW + (size_t)row * RW), icv = *(const v4u*)(IC + (size_t)row * RW);
    const v4u epw = *(const v4u*)(LW + (size_t)(tb == 0 ? row : (dir ? row + 1 : row - 1)) * RW);
    v4u zr[3], zk[3], zv[3];
#pragma unroll
    for (int tt = 0; tt < 3; ++tt) { zr[tt] = R.zr[tt]; zk[tt] = R.zk[tt]; zv[tt] = R.zv[tt]; }
    float ecf[8], epf[8], ai[8], rv[8], kv[8], vv[8];
    unpack8(ecw, ecf); unpack8(epw, epf); unpack8(icv, ai);
#pragma unroll
    for (int e = 0; e < 8; ++e) { rv[e] = 0.f; kv[e] = 0.f; vv[e] = 0.f; }
#pragma unroll
    for (int tt = 0; tt < 3; ++tt) { float a[8], bq[8], cq[8]; unpack8(zr[tt], a); unpack8(zk[tt], bq); unpack8(zv[tt], cq);
        const LAS f32x4* w0 = (const LAS f32x4*)(cst + (3 + tt * 3 + 0) * 64 + 8 * o); const LAS f32x4* w1 = (const LAS f32x4*)(cst + (3 + tt * 3 + 1) * 64 + 8 * o); const LAS f32x4* w2 = (const LAS f32x4*)(cst + (3 + tt * 3 + 2) * 64 + 8 * o);
        const f32x4 w0a = w0[0], w0b = w0[1], w1a = w1[0], w1b = w1[1], w2a = w2[0], w2b = w2[1];
#pragma unroll
        for (int e = 0; e < 4; ++e) { rv[e] += w0a[e] * a[e]; rv[e + 4] += w0b[e] * a[e + 4]; kv[e] += w1a[e] * bq[e]; kv[e + 4] += w1b[e] * bq[e + 4]; vv[e] += w2a[e] * cq[e]; vv[e + 4] += w2b[e] * cq[e + 4]; } }
    float kkw[8], kaw[8];
    { const LAS f32x4* a = (const LAS f32x4*)(cst + 0 * 64 + 8 * o); const LAS f32x4* bq = (const LAS f32x4*)(cst + 1 * 64 + 8 * o); const f32x4 a0 = a[0], a1 = a[1], b0 = bq[0], b1 = bq[1];
#pragma unroll
      for (int e = 0; e < 4; ++e) { kkw[e] = a0[e]; kkw[e + 4] = a1[e]; kaw[e] = b0[e]; kaw[e + 4] = b1[e]; } }
    float kkr[8], ss = 0.f;
#pragma unroll
    for (int e = 0; e < 8; ++e) { kkr[e] = kv[e] * kkw[e]; ss += kkr[e] * kkr[e]; }
    ss += __shfl_xor(ss, 1); ss += __shfl_xor(ss, 2); ss += __shfl_xor(ss, 4);
    const float rn = 1.0f / sqrtf(fmaxf(ss, 1e-24f));
    float At[8], Rt[8], Bt[8], Kt[8];
#pragma unroll
    for (int e = 0; e < 8; ++e) { const float kk = kkr[e] * rn, kd = kv[e] * (1.0f + (ai[e] - 1.0f) * kaw[e]); const float eprev = tb == 0 ? 1.0f : epf[e]; const float ec = ecf[e], en = 1.0f / ec;
        At[e] = -kk * eprev; Rt[e] = rv[e] * ec; Bt[e] = kk * ai[e] * en; Kt[e] = kd * en; }
    const int P0 = 32 * (o >> 2) + 16 * (o & 1) + 4 * ((o >> 1) & 1);
    LAS bf16* AI = (LAS bf16*)(img + IM_AI) + blk * 1152 + tb * 72 + P0, *RI = (LAS bf16*)(img + IM_RI) + blk * 1152 + tb * 72 + P0, *BI = (LAS bf16*)(img + IM_BI) + blk * 1152 + tb * 72 + P0, *KI = (LAS bf16*)(img + IM_KI) + blk * 1152 + tb * 72 + P0;
    unsigned bp[4], kp[4];
#pragma unroll
    for (int e = 0; e < 4; ++e) { bp[e] = cvtpk(Bt[2 * e], Bt[2 * e + 1]); kp[e] = cvtpk(Kt[2 * e], Kt[2 * e + 1]); }
    *(LAS v2u*)AI = (v2u){cvtpk(At[0], At[1]), cvtpk(At[2], At[3])}; *(LAS v2u*)(AI + 8) = (v2u){cvtpk(At[4], At[5]), cvtpk(At[6], At[7])};
    *(LAS v2u*)RI = (v2u){cvtpk(Rt[0], Rt[1]), cvtpk(Rt[2], Rt[3])}; *(LAS v2u*)(RI + 8) = (v2u){cvtpk(Rt[4], Rt[5]), cvtpk(Rt[6], Rt[7])};
    *(LAS v2u*)BI = (v2u){bp[0], bp[1]}; *(LAS v2u*)(BI + 8) = (v2u){bp[2], bp[3]};
    *(LAS v2u*)KI = (v2u){kp[0], kp[1]}; *(LAS v2u*)(KI + 8) = (v2u){kp[2], kp[3]};
    LAS bf16* BKT = (LAS bf16*)(img + IM_BKT) + blk * 2560 + (8 * o) * 40 + (tb >> 2) * 8 + (tb & 3); LAS bf16* VT = (LAS bf16*)(img + IM_VT) + blk * 1280 + (8 * o) * 20 + tb;
    const unsigned vp[4] = {cvtpk(vv[0], vv[1]), cvtpk(vv[2], vv[3]), cvtpk(vv[4], vv[5]), cvtpk(vv[6], vv[7])};
#pragma unroll
    for (int e = 0; e < 8; ++e) { const unsigned bb = bp[e >> 1], kq = kp[e >> 1], vq = vp[e >> 1];
        BKT[e * 40] = (bf16)((e & 1) ? (bb >> 16) : (bb & 0xffff)); BKT[e * 40 + 4] = (bf16)((e & 1) ? (kq >> 16) : (kq & 0xffff)); VT[e * 20] = (bf16)((e & 1) ? (vq >> 16) : (vq & 0xffff)); }
    if (tb == 15) { const f32x4* gs = (const f32x4*)((const float*)(F.ws + WS_GAM32) + ((size_t)dir * (TT / 16) + (row >> 4)) * RW + ch0); LAS f32x4* G = (LAS f32x4*)((LAS float*)(img + IM_GAM) + blk * 64 + 8 * o); G[0] = gs[0]; G[1] = gs[1]; }
    if (BONUS) { float bs = 0.f; const LAS f32x4* rk = (const LAS f32x4*)(cst + 2 * 64 + 8 * o); const f32x4 r0 = rk[0], r1 = rk[1];
#pragma unroll
        for (int e = 0; e < 4; ++e) bs += rv[e] * kv[e] * r0[e] + rv[e + 4] * kv[e + 4] * r1[e];
        bs += __shfl_xor(bs, 1); bs += __shfl_xor(bs, 2); bs += __shfl_xor(bs, 4);
        const int pl = dir ? pos0_local - tl : pos0_local + tl;
        *(LAS v4u*)(lds_vb + (pl * 64 + 8 * o) * 2) = (v4u){vp[0], vp[1], vp[2], vp[3]}; if (o == 0) lds_bon[pl] = bs; }
}
template <bool WANT_Y>
__device__ __forceinline__ void block_package(LAS unsigned char* img, int blk, LAS unsigned* pkg, int lane) {
    const int q = lane >> 4, c = lane & 15;
    f32x4 mab = {0.f, 0.f, 0.f, 0.f}, mak = mab, mbr = mab, mkr = mab;
#pragma unroll
    for (int k = 0; k < 2; ++k) { const int o = blk * 2304 + c * 144 + k * 64 + q * 16;
        const bf16x8 bi = *(const LAS bf16x8*)(img + IM_BI + o), ki = *(const LAS bf16x8*)(img + IM_KI + o), ai = *(const LAS bf16x8*)(img + IM_AI + o);
        mab = MFMA16(bi, ai, mab); mak = MFMA16(ki, ai, mak);
        if constexpr (WANT_Y) { const bf16x8 ri = *(const LAS bf16x8*)(img + IM_RI + o); mbr = MFMA16(bi, ri, mbr); mkr = MFMA16(ki, ri, mkr); } }
#pragma unroll
    for (int e = 0; e < 4; ++e) { const int s = 4 * q + e; if (!(s < c)) { mab[e] = 0.f; mak[e] = 0.f; } if (!(s <= c)) { mbr[e] = 0.f; mkr[e] = 0.f; } }
    f32x4 mabT = {0.f, 0.f, 0.f, 0.f};
#pragma unroll
    for (int k = 0; k < 2; ++k) { const int o = blk * 2304 + c * 144 + k * 64 + q * 16; mabT = MFMA16(*(const LAS bf16x8*)(img + IM_AI + o), *(const LAS bf16x8*)(img + IM_BI + o), mabT); }
#pragma unroll
    for (int e = 0; e < 4; ++e) if (!(c < 4 * q + e)) mabT[e] = 0.f;
    const f32x4 z4 = {0.f, 0.f, 0.f, 0.f};
#define OPND(x) mk8(cvtpk((x)[0], (x)[1]), cvtpk((x)[2], (x)[3]), 0u, 0u)
    const bf16x8 oM = OPND(mab), oMT = OPND(mabT);
    const f32x4 m2 = MFMA16(oMT, oM, z4), m2T = MFMA16(oM, oMT, z4);
    const bf16x8 oM2 = OPND(m2), oM2T = OPND(m2T);
    const f32x4 m4 = MFMA16(oM2T, oM2, z4), m4T = MFMA16(oM2, oM2T, z4);
    const f32x4 m8T = MFMA16(OPND(m4), OPND(m4T), z4);
    f32x4 nn = m2;
#pragma unroll
    for (int e = 0; e < 4; ++e) nn[e] += (4 * q + e == c) ? 1.0f : 0.0f;
    nn = MFMA16(oMT, OPND(nn), nn);
    nn = MFMA16(OPND(m4T), OPND(nn), nn);
    nn = MFMA16(OPND(m8T), OPND(nn), nn);
#undef OPND
    pkg[0 * 64 + lane] = cvtpk(nn[0], nn[1]); pkg[1 * 64 + lane] = cvtpk(nn[2], nn[3]);
    pkg[2 * 64 + lane] = cvtpk(mak[0], mak[1]); pkg[3 * 64 + lane] = cvtpk(mak[2], mak[3]);
    if constexpr (WANT_Y) { pkg[4 * 64 + lane] = cvtpk(mbr[0], mbr[1]); pkg[5 * 64 + lane] = cvtpk(mbr[2], mbr[3]); pkg[6 * 64 + lane] = cvtpk(mkr[0], mkr[1]); pkg[7 * 64 + lane] = cvtpk(mkr[2], mkr[3]); }
}
template <bool WANT_Y, bool HAS_V>
__device__ __forceinline__ f32x4 block_scan(LAS unsigned char* img, int blk, const LAS unsigned* pkg, f32x4 (&S)[4], int wq, int lane) {
    const int q = lane >> 4, c = lane & 15;
    bf16x8 Sb[2];
#pragma unroll
    for (int k = 0; k < 2; ++k) Sb[k] = mk8(cvtpk(S[2 * k][0], S[2 * k][1]), cvtpk(S[2 * k][2], S[2 * k][3]), cvtpk(S[2 * k + 1][0], S[2 * k + 1][1]), cvtpk(S[2 * k + 1][2], S[2 * k + 1][3]));
    v2u vpk = {0u, 0u};
    if constexpr (HAS_V) vpk = *(const LAS v2u*)(img + IM_VT + blk * 2560 + (c + 16 * wq) * 40 + q * 8);
    const int ao = blk * 2304 + c * 144 + q * 16;
    f32x4 rhs = {0.f, 0.f, 0.f, 0.f};
    rhs = MFMA16(*(const LAS bf16x8*)(img + IM_AI + ao), Sb[0], rhs); rhs = MFMA16(*(const LAS bf16x8*)(img + IM_AI + ao + 64), Sb[1], rhs);
    if constexpr (HAS_V) rhs = MFMA16(mk8(0u, 0u, pkg[2 * 64 + lane], pkg[3 * 64 + lane]), mk8(0u, 0u, vpk.x, vpk.y), rhs);
    f32x4 u = {0.f, 0.f, 0.f, 0.f};
    u = MFMA16(mk8(pkg[0 * 64 + lane], pkg[1 * 64 + lane], 0u, 0u), mk8(cvtpk(rhs[0], rhs[1]), cvtpk(rhs[2], rhs[3]), 0u, 0u), u);
    const bf16x8 UV = mk8(cvtpk(u[0], u[1]), cvtpk(u[2], u[3]), vpk.x, vpk.y);
    f32x4 y = {0.f, 0.f, 0.f, 0.f};
    if constexpr (WANT_Y) { y = MFMA16(*(const LAS bf16x8*)(img + IM_RI + ao), Sb[0], y); y = MFMA16(*(const LAS bf16x8*)(img + IM_RI + ao + 64), Sb[1], y);
        y = MFMA16(mk8(pkg[4 * 64 + lane], pkg[5 * 64 + lane], pkg[6 * 64 + lane], pkg[7 * 64 + lane]), UV, y); }
#pragma unroll
    for (int T = 0; T < 4; ++T) { const bf16x8 bkt = *(const LAS bf16x8*)(img + IM_BKT + blk * 5120 + (16 * T + c) * 80 + q * 16);
        S[T] = MFMA16(bkt, UV, S[T]); const f32x4 g = *(const LAS f32x4*)(img + IM_GAM + blk * 256 + (16 * T + 4 * q) * 4); S[T] = S[T] * g; }
    return y;
}
__device__ __forceinline__ unsigned char* sum_slot(Frame& F, int chain, int sc) { return F.ws + WS_SUM + (size_t)(chain * NSC + sc) * SUM_SLOT; }

__device__ __forceinline__ void rwkv_pass1_unit(Frame& F, int li, int u) {
    const int chain = u / (NSC - 1), sc = u % (NSC - 1);
    const int dir = chain / 12, b = (chain / 6) & 1, h = chain % 6;
    const bool isctx = sc < 2; const int scl = isctx ? sc : sc - 2;
    LAS unsigned char* img = F.lds + L_IMG0; LAS unsigned* pkg = (LAS unsigned*)(F.lds + L_PKG);
    LAS float* cst = (LAS float*)(F.lds + L_CST);
    __syncthreads();
    if (F.tid < 256) chain_consts_lds(F, cst, li, h, F.tid);
    const int q = F.lane >> 4, c = F.lane & 15, wq = F.wave & 3; const bool isA = F.wave >= 4;
    f32x4 S[4];
#pragma unroll
    for (int T = 0; T < 4; ++T)
#pragma unroll
        for (int e = 0; e < 4; ++e) S[T][e] = (isA && (16 * T + 4 * q + e == c + 16 * wq)) ? 1.0f : 0.0f;
    PrepRaw R;
    if (F.wave < 4) prep_load(F, R, dir, b, h, 8 * F.wave + (F.lane >> 3), F.lane & 7, isctx, 128 * scl);
#pragma unroll 1
    for (int rd = 0; rd < 4; ++rd) {
        __syncthreads();
        if (F.wave < 4) prep_compute(F, R, cst, img, dir, b, h, 8 * F.wave + (F.lane >> 3), F.lane & 7, isctx, 128 * scl + 32 * rd, nullptr, nullptr, 0);
        __syncthreads();
        if (F.wave < 4 && rd < 3) prep_load(F, R, dir, b, h, 8 * F.wave + (F.lane >> 3), F.lane & 7, isctx, 128 * scl + 32 * (rd + 1));
        if (F.wave < 2) block_package<false>(img, F.wave, pkg + F.wave * 512, F.lane);
        __syncthreads();
#pragma unroll
        for (int blk = 0; blk < 2; ++blk) { if (isA) block_scan<false, false>(img, blk, pkg + blk * 512, S, wq, F.lane); else block_scan<false, true>(img, blk, pkg + blk * 512, S, wq, F.lane); }
    }
    unsigned char* slot = sum_slot(F, chain, sc);
    if (!isA) { f32x4* braw = (f32x4*)slot;
#pragma unroll
        for (int T = 0; T < 4; ++T) braw[(wq * 4 + T) * 64 + F.lane] = S[T]; }
    else { bf16* aim = (bf16*)(slot + 16384); const int kap = wq >> 1, e = (F.lane & 3) + 4 * (wq & 1), qc = c >> 2;
#pragma unroll
        for (int T = 0; T < 4; ++T)
#pragma unroll
            for (int r = 0; r < 4; ++r) { const int lc = (4 * q + r) + 16 * qc; aim[((T * 2 + kap) * 64 + lc) * 8 + e] = (bf16)f2bf(S[T][r]); } }
}
__device__ __forceinline__ void rwkv_pass2_chain(Frame& F, int chain) {
    if (F.wave >= 4) return;
    const int wq = F.wave;
    f32x4 S[4];
#pragma unroll
    for (int T = 0; T < 4; ++T) S[T] = (f32x4){0.f, 0.f, 0.f, 0.f};
    f32x4 Bc[4]; bf16x8 af[4][2];
    { unsigned char* slot = sum_slot(F, chain, 0); const f32x4* braw = (const f32x4*)slot; const bf16* aim = (const bf16*)(slot + 16384);
#pragma unroll
      for (int T = 0; T < 4; ++T) { Bc[T] = braw[(wq * 4 + T) * 64 + F.lane];
#pragma unroll
          for (int k = 0; k < 2; ++k) af[T][k] = *(const bf16x8*)(aim + ((T * 2 + k) * 64 + F.lane) * 8); } }
#pragma unroll 1
    for (int sc = 0; sc < NSC - 1; ++sc) {
        f32x4* braw = (f32x4*)sum_slot(F, chain, sc);
        f32x4 Bn[4]; bf16x8 an[4][2];
        if (sc + 1 < NSC - 1) { unsigned char* slot = sum_slot(F, chain, sc + 1); const f32x4* bq = (const f32x4*)slot; const bf16* aim = (const bf16*)(slot + 16384);
#pragma unroll
            for (int T = 0; T < 4; ++T) { Bn[T] = bq[(wq * 4 + T) * 64 + F.lane];
#pragma unroll
                for (int k = 0; k < 2; ++k) an[T][k] = *(const bf16x8*)(aim + ((T * 2 + k) * 64 + F.lane) * 8); } }
        else {
#pragma unroll
            for (int T = 0; T < 4; ++T) { Bn[T] = Bc[T]; an[T][0] = af[T][0]; an[T][1] = af[T][1]; } }
        bf16x8 Sb[2];
#pragma unroll
        for (int k = 0; k < 2; ++k) Sb[k] = mk8(cvtpk(S[2 * k][0], S[2 * k][1]), cvtpk(S[2 * k][2], S[2 * k][3]), cvtpk(S[2 * k + 1][0], S[2 * k + 1][1]), cvtpk(S[2 * k + 1][2], S[2 * k + 1][3]));
#pragma unroll
        for (int T = 0; T < 4; ++T) { braw[(wq * 4 + T) * 64 + F.lane] = S[T]; f32x4 a = MFMA16(af[T][0], Sb[0], Bc[T]); S[T] = MFMA16(af[T][1], Sb[1], a); }
#pragma unroll
        for (int T = 0; T < 4; ++T) { Bc[T] = Bn[T]; af[T][0] = an[T][0]; af[T][1] = an[T][1]; }
    }
    { f32x4* braw = (f32x4*)sum_slot(F, chain, NSC - 1);
#pragma unroll
      for (int T = 0; T < 4; ++T) braw[(wq * 4 + T) * 64 + F.lane] = S[T]; }
}
__device__ __forceinline__ void rwkv_pass3_unit(Frame& F, int li, int u) {
    const int pc = u % NSC, bh = u / NSC, b = bh / 6, h = bh % 6;
    const bool isctx = pc < 2; const int pcl = isctx ? pc : pc - 2, nsc = isctx ? 2 : 64;
    const int dir = F.wave >> 2, wq = F.wave & 3, q = F.lane >> 4, c = F.lane & 15;
    const int sc = dir == 0 ? pc : (isctx ? 1 - pcl : 2 + 63 - pcl);
    const int scl = dir == 0 ? pcl : nsc - 1 - pcl;
    const int chain = dir * 12 + b * 6 + h;
    LAS unsigned char* img = F.lds + (dir ? L_IMG1 : L_IMG0); LAS unsigned* pkg = (LAS unsigned*)(F.lds + L_PKG) + dir * 1024;
    LAS float* YL = (LAS float*)(F.lds + L_YL); LAS unsigned char* VB = F.lds + L_VB; LAS float* BON = (LAS float*)(F.lds + L_BON);
    LAS float* cst = (LAS float*)(F.lds + L_CST);
    __syncthreads();
    if (F.tid < 256) chain_consts_lds(F, cst, li, h, F.tid);
    f32x4 S[4];
    { const f32x4* braw = (const f32x4*)sum_slot(F, chain, sc);
#pragma unroll
      for (int T = 0; T < 4; ++T) S[T] = braw[(wq * 4 + T) * 64 + F.lane]; }
    __syncthreads();
    for (int i = F.tid; i < 128 * 68; i += NTHR) YL[i] = 0.f;
#pragma unroll 1
    for (int rd = 0; rd < 4; ++rd) {
        __syncthreads();
        { PrepRaw R; prep_load(F, R, dir, b, h, 8 * wq + (F.lane >> 3), F.lane & 7, isctx, 128 * scl + 32 * rd);
          prep_compute(F, R, cst, img, dir, b, h, 8 * wq + (F.lane >> 3), F.lane & 7, isctx, 128 * scl + 32 * rd, dir == 0 ? VB : (LAS unsigned char*)nullptr, BON, 32 * rd); }
        __syncthreads();
        if (wq < 2) block_package<true>(img, wq, pkg + wq * 512, F.lane);
        __syncthreads();
#pragma unroll
        for (int blk = 0; blk < 2; ++blk) { const f32x4 y = block_scan<true, true>(img, blk, pkg + blk * 512, S, wq, F.lane);
#pragma unroll
            for (int e = 0; e < 4; ++e) { const int t = 32 * rd + 16 * blk + 4 * q + e; const int pl = dir ? 127 - t : t; YL[pl * 68 + c + 16 * wq] += y[e]; } }
    }
    __syncthreads();
    const int wv = F.wave; const int rbase = (isctx ? TL + b * CTX : b * SEQ) + 128 * pcl;
    const bf16* g2t = (const bf16*)(F.ws + WS_G2T) + (size_t)li * 384 * 128;
    f32x4 gate[4];
#pragma unroll
    for (int nt = 0; nt < 4; ++nt) gate[nt] = (f32x4){0.f, 0.f, 0.f, 0.f};
#pragma unroll
    for (int k = 0; k < 4; ++k) { const v4u zg = *(const v4u*)(zrow(F, rbase + 16 * wv + c) + ZG + 32 * k + 8 * q);
#define SG(x) (1.0f / (1.0f + __expf(-(x))))
        const bf16x8 a = mk8(pk2(SG(bflo(zg.x)), SG(bfhi(zg.x))), pk2(SG(bflo(zg.y)), SG(bfhi(zg.y))), pk2(SG(bflo(zg.z)), SG(bfhi(zg.z))), pk2(SG(bflo(zg.w)), SG(bfhi(zg.w))));
#undef SG
#pragma unroll
        for (int nt = 0; nt < 4; ++nt) { const bf16x8 bb = *(const bf16x8*)(g2t + (size_t)(64 * h + 16 * nt + c) * 128 + 32 * k + 8 * q); gate[nt] = MFMA16(a, bb, gate[nt]); } }
    bf16* mix = (bf16*)(F.ws + WS_H);
    float lg[4], lb[4];
#pragma unroll
    for (int nt = 0; nt < 4; ++nt) { lg[nt] = inp(I_LNG)[li * RW + 64 * h + 16 * nt + c]; lb[nt] = inp(I_LNB)[li * RW + 64 * h + 16 * nt + c]; }
#pragma unroll
    for (int e = 0; e < 4; ++e) { const int tl = 16 * wv + 4 * q + e;
        float yv[4], s = 0.f;
#pragma unroll
        for (int nt = 0; nt < 4; ++nt) { yv[nt] = YL[tl * 68 + 16 * nt + c]; s += yv[nt]; }
        s += __shfl_xor(s, 1); s += __shfl_xor(s, 2); s += __shfl_xor(s, 4); s += __shfl_xor(s, 8);
        const float mu = s * (1.0f / 64.0f); float v2 = 0.f;
#pragma unroll
        for (int nt = 0; nt < 4; ++nt) { yv[nt] -= mu; v2 += yv[nt] * yv[nt]; }
        v2 += __shfl_xor(v2, 1); v2 += __shfl_xor(v2, 2); v2 += __shfl_xor(v2, 4); v2 += __shfl_xor(v2, 8);
        const float rs = 1.0f / sqrtf(v2 * (1.0f / 64.0f) + GN_EPS); const float bon = BON[tl];
#pragma unroll
        for (int nt = 0; nt < 4; ++nt) { const float vv = bf2f(((const LAS bf16*)VB)[tl * 64 + 16 * nt + c]);
            const float o = (yv[nt] * rs * lg[nt] + lb[nt] + bon * vv) * gate[nt][e];
            mix[(size_t)(rbase + tl) * DM + 640 + 64 * h + 16 * nt + c] = (bf16)f2bf(o); } }
}

constexpr int AT_KROW = 144;
__device__ __forceinline__ void attn_unit(Frame& F, int li, int u) {
    const bool cq = u >= 256;
    int b, kvh, qb;
    if (!cq) { b = u >> 7; kvh = (u >> 6) & 1; qb = u & 63; } else { const int uu = u - 256; b = uu >> 2; kvh = (uu >> 1) & 1; qb = uu & 1; }
    const int c = F.lane & 15, q = F.lane >> 4, tb = F.wave;
    const bf16* qr = (const bf16*)(F.ws + WS_QR); const bf16* kr = (const bf16*)(F.ws + WS_KR); bf16* mix = (bf16*)(F.ws + WS_H);
    const int qrow = (cq ? TL + b * CTX : b * SEQ) + 128 * qb + 16 * tb + c;
    const int qpos = 128 * qb + 16 * tb + c;
    bf16x8 Q[3][2];
#pragma unroll
    for (int hh = 0; hh < 3; ++hh)
#pragma unroll
        for (int k = 0; k < 2; ++k) {
            if (!cq) Q[hh][k] = *(const bf16x8*)(qr + (size_t)qrow * 384 + 64 * (3 * kvh + hh) + 32 * k + 8 * q);
            else { const v4u w = *(const v4u*)(zrow(F, qrow) + ZQ + 64 * (3 * kvh + hh) + 32 * k + 8 * q);
                Q[hh][k] = mk8(pk2(0.125f * bflo(w.x), 0.125f * bfhi(w.x)), pk2(0.125f * bflo(w.y), 0.125f * bfhi(w.y)), pk2(0.125f * bflo(w.z), 0.125f * bfhi(w.z)), pk2(0.125f * bflo(w.w), 0.125f * bfhi(w.w))); } }
    float m[3], l[3]; f32x4 O[3][4];
#pragma unroll
    for (int hh = 0; hh < 3; ++hh) { m[hh] = inp(I_SINK)[li * 6 + 3 * kvh + hh]; l[hh] = q == 0 ? 1.0f : 0.0f;
#pragma unroll
        for (int dt = 0; dt < 4; ++dt) O[hh][dt] = (f32x4){0.f, 0.f, 0.f, 0.f}; }
    LAS unsigned char* KI = F.lds;
#pragma unroll 1
    for (int stage = cq ? 1 : 0; stage < 2; ++stage) {
        const int nkeys = stage == 0 ? 384 : 256; const int vstride = (nkeys + 8) * 2;
        LAS unsigned char* VTI = F.lds + 384 * AT_KROW;
        const int kpos0 = 128 * (qb - 1);
        __syncthreads();
        for (int pc = F.tid; pc < nkeys * 8; pc += NTHR) { const int key = pc >> 3, d8 = pc & 7;
            const bf16* ksrc; const bf16* vsrc;
            if (stage == 0) { int kp = kpos0 + key; kp = kp < 0 ? 0 : (kp >= SEQ ? SEQ - 1 : kp); ksrc = kr + (size_t)(b * SEQ + kp) * 128 + 64 * kvh; vsrc = zrow(F, b * SEQ + kp) + ZV + 64 * kvh; }
            else { const bf16* z = zrow(F, TL + b * CTX + key); ksrc = z + ZK + 64 * kvh; vsrc = z + ZV + 64 * kvh; }
            const v4u kv = *(const v4u*)(ksrc + 8 * d8); const v4u vv = *(const v4u*)(vsrc + 8 * d8);
            *(LAS v4u*)(KI + key * AT_KROW + d8 * 16) = kv;
            const int kl = key & 31; const int col = (key & ~31) | (((kl & 15) >> 2) << 3) | ((kl >> 4) << 2) | (kl & 3);
            LAS bf16* vt = (LAS bf16*)(VTI + (8 * d8) * vstride) + col;
            vt[0] = (bf16)(vv.x & 0xffff); *(LAS bf16*)((LAS unsigned char*)vt + vstride) = (bf16)(vv.x >> 16);
            *(LAS bf16*)((LAS unsigned char*)vt + 2 * vstride) = (bf16)(vv.y & 0xffff); *(LAS bf16*)((LAS unsigned char*)vt + 3 * vstride) = (bf16)(vv.y >> 16);
            *(LAS bf16*)((LAS unsigned char*)vt + 4 * vstride) = (bf16)(vv.z & 0xffff); *(LAS bf16*)((LAS unsigned char*)vt + 5 * vstride) = (bf16)(vv.z >> 16);
            *(LAS bf16*)((LAS unsigned char*)vt + 6 * vstride) = (bf16)(vv.w & 0xffff); *(LAS bf16*)((LAS unsigned char*)vt + 7 * vstride) = (bf16)(vv.w >> 16); }
        __syncthreads();
        const int npair = nkeys / 32;
        const int Q0 = 128 * qb + 16 * tb;
#pragma unroll 1
        for (int kp = 0; kp < npair; ++kp) {
            const int kb = kpos0 + 32 * kp;
            if (stage == 0 && (kb + 31 < Q0 - 128 || kb > Q0 + 143 || kb + 31 < 0 || kb >= SEQ)) continue;
            bf16x8 K[2][2], V[4];
#pragma unroll
            for (int t = 0; t < 2; ++t)
#pragma unroll
                for (int k = 0; k < 2; ++k) K[t][k] = *(const LAS bf16x8*)(KI + (32 * kp + 16 * t + c) * AT_KROW + k * 64 + q * 16);
#pragma unroll
            for (int dt = 0; dt < 4; ++dt) V[dt] = *(const LAS bf16x8*)(VTI + (16 * dt + c) * vstride + kp * 64 + q * 16);
            bool ok0[4], ok1[4];
#pragma unroll
            for (int e = 0; e < 4; ++e) { const int k0 = kb + 4 * q + e, k1 = k0 + 16;
                ok0[e] = stage == 1 || (k0 >= 0 && k0 < SEQ && k0 >= qpos - 128 && k0 <= qpos + 128);
                ok1[e] = stage == 1 || (k1 >= 0 && k1 < SEQ && k1 >= qpos - 128 && k1 <= qpos + 128); }
#pragma unroll
            for (int hh = 0; hh < 3; ++hh) {
                f32x4 s0 = {0.f, 0.f, 0.f, 0.f}, s1 = {0.f, 0.f, 0.f, 0.f};
                s0 = MFMA16(K[0][0], Q[hh][0], s0); s0 = MFMA16(K[0][1], Q[hh][1], s0);
                s1 = MFMA16(K[1][0], Q[hh][0], s1); s1 = MFMA16(K[1][1], Q[hh][1], s1);
                float mx = -INFINITY;
#pragma unroll
                for (int e = 0; e < 4; ++e) { s0[e] = ok0[e] ? s0[e] : -INFINITY; s1[e] = ok1[e] ? s1[e] : -INFINITY; mx = fmaxf(mx, fmaxf(s0[e], s1[e])); }
                mx = fmaxf(mx, __shfl_xor(mx, 16)); mx = fmaxf(mx, __shfl_xor(mx, 32));
                const float mn = fmaxf(m[hh], mx); const float alpha = __expf(m[hh] - mn); m[hh] = mn;
                float ps = 0.f;
#pragma unroll
                for (int e = 0; e < 4; ++e) { s0[e] = __expf(s0[e] - mn); s1[e] = __expf(s1[e] - mn); ps += s0[e] + s1[e]; }
                l[hh] = l[hh] * alpha + ps;
                const bf16x8 P = mk8(cvtpk(s0[0], s0[1]), cvtpk(s0[2], s0[3]), cvtpk(s1[0], s1[1]), cvtpk(s1[2], s1[3]));
#pragma unroll
                for (int dt = 0; dt < 4; ++dt) { O[hh][dt] = O[hh][dt] * alpha; O[hh][dt] = MFMA16(V[dt], P, O[hh][dt]); }
            }
        }
    }
#pragma unroll
    for (int hh = 0; hh < 3; ++hh) { float lt = l[hh]; lt += __shfl_xor(lt, 16); lt += __shfl_xor(lt, 32); const float inv = 1.0f / lt;
#pragma unroll
        for (int dt = 0; dt < 4; ++dt) { v2u w; w.x = pk2(O[hh][dt][0] * inv, O[hh][dt][1] * inv); w.y = pk2(O[hh][dt][2] * inv, O[hh][dt][3] * inv);
            *(v2u*)(mix + (size_t)qrow * DM + 256 + 64 * (3 * kvh + hh) + 16 * dt + 4 * q) = w; } }
}

__device__ __forceinline__ void fourier_tables(Frame& F) {
    bf16* t = (bf16*)(F.ws + WS_FT);
    for (int i = F.bid * NTHR + F.tid; i < 64 * 64; i += F.G * NTHR) { const int r = i >> 6, cc = i & 63; const float a = (float)((r * cc) & 63) * (1.0f / 64.0f);
        const float cs = __builtin_amdgcn_cosf(a), sn = __builtin_amdgcn_sinf(a);
        t[FT_W64C / 2 + i] = (bf16)f2bf(cs); t[FT_W64S / 2 + i] = (bf16)f2bf(sn);
        const int pj = (cc & ~31) | (((cc & 15) >> 2) << 3) | (((cc >> 4) & 1) << 2) | (cc & 3);
        t[FT_T64C / 2 + r * 64 + pj] = (bf16)f2bf(cs); t[FT_T64S / 2 + r * 64 + pj] = (bf16)f2bf(sn); }
    for (int i = F.bid * NTHR + F.tid; i < 128 * 128; i += F.G * NTHR) { const int r = i >> 7, cc = i & 127; const float a = (float)((r * cc) & 127) * (1.0f / 128.0f);
        t[FT_W128C / 2 + i] = (bf16)f2bf(__builtin_amdgcn_cosf(a)); t[FT_W128S / 2 + i] = (bf16)f2bf(__builtin_amdgcn_sinf(a)); }
}
__device__ __forceinline__ void fourier_a_fast(Frame& F, int u) {
    const int b = u >> 7, n2 = u & 127, c = F.lane & 15, q = F.lane >> 4;
    LAS unsigned char* IMG = F.lds;
    __syncthreads();
    for (int pc = F.tid; pc < 64 * 32; pc += NTHR) { const int n1 = pc >> 5, c8 = pc & 31;
        const v4u v = *(const v4u*)(zrow(F, b * SEQ + 128 * n1 + n2) + ZF + 8 * c8);
        LAS bf16* d = (LAS bf16*)(IMG + (8 * c8) * 144) + n1;
        d[0] = (bf16)(v.x & 0xffff); d[72] = (bf16)(v.x >> 16); d[144] = (bf16)(v.y & 0xffff); d[216] = (bf16)(v.y >> 16);
        d[288] = (bf16)(v.z & 0xffff); d[360] = (bf16)(v.z >> 16); d[432] = (bf16)(v.w & 0xffff); d[504] = (bf16)(v.w >> 16); }
    __syncthreads();
    const bf16* wc = (const bf16*)(F.ws + WS_FT + FT_W64C); const bf16* wsn = (const bf16*)(F.ws + WS_FT + FT_W64S);
    bf16* far = (bf16*)(F.ws + WS_FA); bf16* fai = far + (size_t)NB * 64 * 128 * 256;
    bf16x8 Bc[4][2], Bs[4][2];
#pragma unroll
    for (int kt = 0; kt < 4; ++kt)
#pragma unroll
        for (int k = 0; k < 2; ++k) { Bc[kt][k] = *(const bf16x8*)(wc + (16 * kt + c) * 64 + 32 * k + 8 * q); Bs[kt][k] = *(const bf16x8*)(wsn + (16 * kt + c) * 64 + 32 * k + 8 * q); }
#pragma unroll
    for (int ci = 0; ci < 2; ++ci) { const int ct = 2 * F.wave + ci;
        bf16x8 A[2];
#pragma unroll
        for (int k = 0; k < 2; ++k) A[k] = *(const LAS bf16x8*)(IMG + (16 * ct + c) * 144 + k * 64 + q * 16);
#pragma unroll
        for (int kt = 0; kt < 4; ++kt) { f32x4 sr = {0.f, 0.f, 0.f, 0.f}, si = {0.f, 0.f, 0.f, 0.f};
#pragma unroll
            for (int k = 0; k < 2; ++k) { sr = MFMA16(A[k], Bc[kt][k], sr); si = MFMA16(A[k], Bs[kt][k], si); }
            const int k1 = 16 * kt + c; const float tw = (float)(n2 * k1) * (1.0f / 8192.0f); const float tc = __builtin_amdgcn_cosf(tw), ts = __builtin_amdgcn_sinf(tw);
            float xr[4], xi[4];
#pragma unroll
            for (int e = 0; e < 4; ++e) { const float ar = sr[e], ai = -si[e]; xr[e] = ar * tc + ai * ts; xi[e] = ai * tc - ar * ts; }
            const size_t o = (((size_t)b * 64 + k1) * 128 + n2) * 256 + 16 * ct + 4 * q;
            v2u w; w.x = pk2(xr[0], xr[1]); w.y = pk2(xr[2], xr[3]); *(v2u*)(far + o) = w; w.x = pk2(xi[0], xi[1]); w.y = pk2(xi[2], xi[3]); *(v2u*)(fai + o) = w; } }
}
__device__ __forceinline__ void fourier_c_fast(Frame& F, int u) {
    const int g = u & 3, k1 = (u >> 2) & 63, b = u >> 8, c = F.lane & 15, q = F.lane >> 4;
    LAS unsigned char* IR = F.lds; LAS unsigned char* II = F.lds + 64 * 272;
    const bf16* far = (const bf16*)(F.ws + WS_FA) + (((size_t)b * 64 + k1) * 128) * 256 + 64 * g; const bf16* fai = far + (size_t)NB * 64 * 128 * 256;
    __syncthreads();
    for (int pc = F.tid; pc < 128 * 8; pc += NTHR) { const int n2 = pc >> 3, c8 = pc & 7;
        const v4u vr = *(const v4u*)(far + (size_t)n2 * 256 + 8 * c8), vi = *(const v4u*)(fai + (size_t)n2 * 256 + 8 * c8);
        LAS bf16* dr = (LAS bf16*)(IR + (8 * c8) * 272) + n2; LAS bf16* di = (LAS bf16*)(II + (8 * c8) * 272) + n2;
        dr[0] = (bf16)(vr.x & 0xffff); dr[136] = (bf16)(vr.x >> 16); dr[272] = (bf16)(vr.y & 0xffff); dr[408] = (bf16)(vr.y >> 16);
        dr[544] = (bf16)(vr.z & 0xffff); dr[680] = (bf16)(vr.z >> 16); dr[816] = (bf16)(vr.w & 0xffff); dr[952] = (bf16)(vr.w >> 16);
        di[0] = (bf16)(vi.x & 0xffff); di[136] = (bf16)(vi.x >> 16); di[272] = (bf16)(vi.y & 0xffff); di[408] = (bf16)(vi.y >> 16);
        di[544] = (bf16)(vi.z & 0xffff); di[680] = (bf16)(vi.z >> 16); di[816] = (bf16)(vi.w & 0xffff); di[952] = (bf16)(vi.w >> 16); }
    __syncthreads();
    const bf16* wc = (const bf16*)(F.ws + WS_FT + FT_W128C); const bf16* wsn = (const bf16*)(F.ws + WS_FT + FT_W128S);
    const bf16* tcn = (const bf16*)(F.ws + WS_FT + FT_T64C); const bf16* tsn = (const bf16*)(F.ws + WS_FT + FT_T64S);
    f32x4 Pr[4], Pi[4];
#pragma unroll
    for (int ct = 0; ct < 4; ++ct) { Pr[ct] = (f32x4){0.f, 0.f, 0.f, 0.f}; Pi[ct] = (f32x4){0.f, 0.f, 0.f, 0.f}; }
#pragma unroll
    for (int k = 0; k < 4; ++k) { const bf16x8 bc = *(const bf16x8*)(wc + (16 * F.wave + c) * 128 + 32 * k + 8 * q), bs = *(const bf16x8*)(wsn + (16 * F.wave + c) * 128 + 32 * k + 8 * q);
        const v4u bsu = __builtin_bit_cast(v4u, bs); const bf16x8 bsn = mk8(bsu.x ^ 0x80008000u, bsu.y ^ 0x80008000u, bsu.z ^ 0x80008000u, bsu.w ^ 0x80008000u);
#pragma unroll
        for (int ct = 0; ct < 4; ++ct) { const bf16x8 ar = *(const LAS bf16x8*)(IR + (16 * ct + c) * 272 + k * 64 + q * 16), ai = *(const LAS bf16x8*)(II + (16 * ct + c) * 272 + k * 64 + q * 16);
            Pr[ct] = MFMA16(ar, bc, Pr[ct]); Pr[ct] = MFMA16(ai, bs, Pr[ct]); Pi[ct] = MFMA16(ai, bc, Pi[ct]); Pi[ct] = MFMA16(ar, bsn, Pi[ct]); } }
    bf16x8 Br[2], Bi[2];
#pragma unroll
    for (int k = 0; k < 2; ++k) { Br[k] = mk8(cvtpk(Pr[2 * k][0], Pr[2 * k][1]), cvtpk(Pr[2 * k][2], Pr[2 * k][3]), cvtpk(Pr[2 * k + 1][0], Pr[2 * k + 1][1]), cvtpk(Pr[2 * k + 1][2], Pr[2 * k + 1][3]));
        Bi[k] = mk8(cvtpk(Pi[2 * k][0], Pi[2 * k][1]), cvtpk(Pi[2 * k][2], Pi[2 * k][3]), cvtpk(Pi[2 * k + 1][0], Pi[2 * k + 1][1]), cvtpk(Pi[2 * k + 1][2], Pi[2 * k + 1][3])); }
    bf16* mix = (bf16*)(F.ws + WS_H);
    const float scale = 0.0013810679320049757f;
    const int k2 = 16 * F.wave + c; const size_t row = (size_t)b * SEQ + k1 + 64 * k2;
#pragma unroll
    for (int mt = 0; mt < 4; ++mt) { f32x4 y = {0.f, 0.f, 0.f, 0.f};
#pragma unroll
        for (int k = 0; k < 2; ++k) { const bf16x8 ac = *(const bf16x8*)(tcn + (16 * mt + c) * 64 + 32 * k + 8 * q), as = *(const bf16x8*)(tsn + (16 * mt + c) * 64 + 32 * k + 8 * q);
            y = MFMA16(ac, Br[k], y); y = MFMA16(as, Bi[k], y); }
        v2u w; w.x = pk2(y[0] * scale, y[1] * scale); w.y = pk2(y[2] * scale, y[3] * scale);
        *(v2u*)(mix + row * DM + 64 * g + 16 * mt + 4 * q) = w; }
}

#define XB_TMO      128
#define XB_XCNT(j)  (256  + 64 * (j))
#define XB_XSUB(j)  (1280 + 64 * (j))
#define XB_XGEN(j)  (2304 + 64 * (j))
#define XB_TOP      3328
#define XB_TOPGEN   3392
#define XCD_BAR_WORDS 3456
#define XB_SPIN_CAP (1u << 23)
__device__ __forceinline__ unsigned xb_ld(unsigned* p)              { return __hip_atomic_load(p, __ATOMIC_RELAXED, __HIP_MEMORY_SCOPE_AGENT); }
__device__ __forceinline__ unsigned xb_add(unsigned* p, unsigned v) { return __hip_atomic_fetch_add(p, v, __ATOMIC_RELAXED, __HIP_MEMORY_SCOPE_AGENT); }
__device__ __forceinline__ unsigned xb_xcc_id() { return (unsigned)__builtin_amdgcn_s_getreg((3 << 11) | 20) & 0xFu; }
#define XB_SPIN(cond, bar) do { unsigned _sp = 0; while (cond) { __builtin_amdgcn_s_sleep(1); \
    if ((++_sp & 255u) == 0u) { if (xb_ld(&(bar)[XB_TMO])) break; if (_sp > XB_SPIN_CAP) { atomicAdd(&(bar)[XB_TMO], 1u); break; } } } } while (0)
struct XcdBarrier { unsigned* bar; unsigned x; volatile LAS unsigned* st; };
__device__ __forceinline__ XcdBarrier xcd_barrier_post(unsigned* bar, volatile LAS unsigned* st) {
    XcdBarrier b; b.bar = bar; b.x = xb_xcc_id(); b.st = st;
    if (threadIdx.x == 0) (void)xb_add(&bar[XB_XCNT(b.x)], 1u);
    return b;
}
__device__ __forceinline__ void xcd_barrier_complete(unsigned* bar, unsigned x, unsigned& nloc, unsigned& nx) {
    const unsigned G = gridDim.x * gridDim.y * gridDim.z;
    unsigned sum, cnt, mine, sp = 0u;
    for (;;) {
        sum = 0u; cnt = 0u; mine = 0u;
#pragma unroll
        for (unsigned j = 0; j < 16; ++j) { const unsigned c = xb_ld(&bar[XB_XCNT(j)]); sum += c; cnt += (c > 0u) ? 1u : 0u; mine = (j == x) ? c : mine; }
        if (sum == G) break;
        __builtin_amdgcn_s_sleep(1);
        if ((++sp & 255u) == 0u) { if (xb_ld(&bar[XB_TMO])) break; if (sp > XB_SPIN_CAP) { atomicAdd(&bar[XB_TMO], 1u); break; } }
    }
    nloc = mine > 0u ? mine : 1u; nx = cnt > 0u ? cnt : 1u;
}
__device__ __forceinline__ void xcd_barrier(const XcdBarrier& b0) {
    XcdBarrier b; { unsigned* p = b0.bar; unsigned x = __builtin_amdgcn_readfirstlane(b0.x); unsigned st = (unsigned)(size_t)b0.st; asm volatile("" : "+s"(p), "+s"(x), "+s"(st)); b.bar = p; b.x = x; b.st = (volatile LAS unsigned*)(size_t)st; }
    asm volatile("s_waitcnt vmcnt(0)" ::: "memory");
    __syncthreads();
    if (threadIdx.x == 0) {
        unsigned* bar = b.bar;
        __builtin_amdgcn_s_waitcnt(0);
        unsigned nloc = b.st[0], nx = b.st[1];
        if (nloc == 0u) { xcd_barrier_complete(bar, b.x, nloc, nx); b.st[0] = nloc; b.st[1] = nx; }
        const unsigned old = xb_add(&bar[XB_XSUB(b.x)], 1u);
        const unsigned gen = old / nloc;
        if (old + 1u == (gen + 1u) * nloc) {
            __builtin_amdgcn_fence(__ATOMIC_RELEASE, "agent");
            asm volatile("s_waitcnt vmcnt(0)" ::: "memory");
            const unsigned og = xb_add(&bar[XB_TOP], 1u);
            const unsigned tg = og / nx;
            if (og + 1u == (tg + 1u) * nx) xb_add(&bar[XB_TOPGEN], 1u);
            else XB_SPIN(xb_ld(&bar[XB_TOPGEN]) == tg, bar);
            __builtin_amdgcn_fence(__ATOMIC_ACQUIRE, "agent");
            xb_add(&bar[XB_XGEN(b.x)], 1u);
            asm volatile("s_waitcnt vmcnt(0)" ::: "memory");
        } else {
            XB_SPIN(xb_ld(&bar[XB_XGEN(b.x)]) == gen, bar);
            __builtin_amdgcn_fence(__ATOMIC_ACQUIRE, "agent");
            asm volatile("s_waitcnt vmcnt(0)" ::: "memory");
        }
    }
    __syncthreads();
}

template <int KIND> __device__ __forceinline__ void run_phase(const Frame& F0, int li, int second) {
    Frame F;
    { int t = threadIdx.x; asm volatile("" : "+v"(t)); F.tid = t; F.lane = t & 63; F.wave = __builtin_amdgcn_readfirstlane(t >> 6);
      int g = F0.G, b = F0.bid; asm volatile("" : "+s"(g), "+s"(b)); F.G = g; F.bid = b;
      unsigned char* w = F0.ws; float* o = F0.out; asm volatile("" : "+s"(w), "+s"(o)); F.ws = w; F.out = o;
      unsigned l = (unsigned)(size_t)F0.lds; asm volatile("" : "+s"(l)); F.lds = (LAS unsigned char*)(size_t)l;
      asm volatile("" : "+s"(li), "+s"(second)); }
    float* modv = (float*)(F.ws + WS_MOD);
    float* xc = (float*)(F.ws + WS_XC);
    bf16* H = (bf16*)(F.ws + WS_H); bf16* ACT = (bf16*)(F.ws + WS_ACT); float* O = (float*)(F.ws + WS_O);
    const float* ng = inp(I_NORMG) + (size_t)li * 6 * DM; const float* mv = modv + (size_t)li * 3 * 9216;
    const bool last = li == 1;
    if constexpr (KIND == 100) { convert_weights(F, 0); mod_gemv(F); rope_tables(F); lora_transposes(F); fourier_tables(F); }
    if constexpr (KIND == 101) { EArgs A{}; A.xl_src = inp(I_X); A.xc_src = inp(I_CTX); A.o = nullptr; A.hdst = H; A.modv_h = modv; A.shidx = 0; A.scidx = 1; A.gpre = inp(I_NORMG); A.nrows = TT; e_phase(F, A); }
    if constexpr (KIND == 0) {
        pg8::Gemm g{H, (const bf16*)(F.ws + (second ? WS_WI2 : WS_WI1)), (last && second) ? TL : TT, NWI, DM}; pg8::StaticOrder S; S.init(g.M, g.N, F.G, F.bid);
        pg8::EpiSwiglu E{ACT, FFNP}; pg8::gemm_phase<pg8::EpiSwiglu, pg8::StaticOrder, true, true>(F.lds, g, S, E, F.tid); }
    if constexpr (KIND == 1) {
        pg8::Gemm g{ACT, (const bf16*)(F.ws + (second ? WS_WO2 : WS_WO1)), (last && second) ? TL : TT, DM, FFNP}; pg8::StaticOrder S; S.init(g.M, g.N, F.G, F.bid);
        pg8::EpiF32 E{O, DM}; pg8::gemm_phase<pg8::EpiF32, pg8::StaticOrder, true, true>(F.lds, g, S, E, F.tid); }
    if constexpr (KIND == 2) {
        EArgs A{}; A.xl_src = li == 0 ? inp(I_X) : F.out; A.xc_src = li == 0 ? inp(I_CTX) : xc; A.xl_dst = F.out; A.xc_dst = xc; A.o = O; A.modv_g = mv; A.gidx = 2; A.gmul = 0.5f; A.gpost = ng + 1 * DM;
        A.hdst = H; A.modv_h = mv; A.shidx = 3; A.scidx = 4; A.gpre = ng + 2 * DM; A.nrows = TT; e_phase(F, A); }
    if constexpr (KIND == 3) {
        pg8::Gemm g{H, (const bf16*)(F.ws + WS_WIN), TT, INWP, DM}; pg8::StaticOrder S; S.init(g.M, g.N, F.G, F.bid);
        pg8::EpiBf16 E{ACT, INWP}; pg8::gemm_phase<pg8::EpiBf16, pg8::StaticOrder, true, true>(F.lds, g, S, E, F.tid); }
    if constexpr (KIND == 4) {
        for (int u = F.bid; u < 528; u += F.G) lora_unit(F, li, u);
        for (int u = F.bid; u < 256; u += F.G) fourier_a_fast(F, u);
        rope_all(F);
        if (li == 0) fourier_ctx1_all(F); }
    if constexpr (KIND == 5) {
        for (int u = F.bid; u < (li == 0 ? 264 : 256); u += F.G) attn_unit(F, li, u);
        for (int u = F.bid; u < 24 * (NSC - 1); u += F.G) rwkv_pass1_unit(F, li, u); }
    if constexpr (KIND == 11) {
        if (F.bid < 24) rwkv_pass2_chain(F, F.bid);
        for (int u = F.bid; u < 512; u += F.G) fourier_c_fast(F, u);
        if (li == 0) fourier_ctx2_all(F); }
    if constexpr (KIND == 12) {
        for (int u = F.bid; u < 12 * NSC; u += F.G) { if (li == 1 && (u % NSC) < 2) continue; rwkv_pass3_unit(F, li, u); } }
    if constexpr (KIND == 6) {
        pg8::Gemm g{H, (const bf16*)(F.ws + WS_WOUT), last ? TL : TT, DM, DM}; pg8::StaticOrder S; S.init(g.M, g.N, F.G, F.bid);
        pg8::EpiF32 E{O, DM}; pg8::gemm_phase<pg8::EpiF32, pg8::StaticOrder, true, true>(F.lds, g, S, E, F.tid); }
    if constexpr (KIND == 7) {
        EArgs A{}; A.xl_src = F.out; A.xc_src = xc; A.xl_dst = F.out; A.xc_dst = xc; A.o = O; A.modv_g = mv; A.gidx = 5; A.gmul = 1.0f; A.gpost = ng + 3 * DM;
        A.hdst = H; A.modv_h = mv; A.shidx = 6; A.scidx = 7; A.gpre = ng + 4 * DM; A.nrows = last ? TL : TT; e_phase(F, A); }
    if constexpr (KIND == 10) {
        EArgs A{}; A.xl_src = F.out; A.xc_src = xc; A.xl_dst = F.out; A.xc_dst = xc; A.o = O; A.modv_g = mv; A.gidx = 8; A.gmul = 0.5f; A.gpost = ng + 5 * DM;
        if (!last) { A.hdst = H; A.modv_h = mv + 3 * 9216; A.shidx = 0; A.scidx = 1; A.gpre = ng + 6 * DM; }
        A.nrows = last ? TL : TT; e_phase(F, A);
        if (!last) { __syncthreads(); convert_weights(F, 1); } }
}
constexpr int MISC_OFF = 146432;
__global__ void __launch_bounds__(NTHR, 2) mega_one(Args args) {
    extern __shared__ __attribute__((aligned(16))) unsigned char lds[];
    Frame F; F.lds = (LAS unsigned char*)lds; F.tid = threadIdx.x; F.lane = F.tid & 63; F.wave = __builtin_amdgcn_readfirstlane(F.tid >> 6); F.G = gridDim.x; F.bid = blockIdx.x;
    F.out = args.out; F.ws = args.ws;
    volatile LAS unsigned* MISC = (volatile LAS unsigned*)(F.lds + MISC_OFF);
    if (F.tid < 32) MISC[F.tid] = 0u;
    __syncthreads();
    XcdBarrier bar = xcd_barrier_post((unsigned*)(F.ws + WS_CTL) + 4096, MISC + 8);
#define GRID_BAR() xcd_barrier(bar)
    run_phase<100>(F, 0, 0); GRID_BAR();
    run_phase<101>(F, 0, 0); GRID_BAR();
#pragma unroll 1
    for (int li = 0; li < 2; ++li) {
        run_phase<0>(F, li, 0); GRID_BAR();
        run_phase<1>(F, li, 0); GRID_BAR();
        run_phase<2>(F, li, 0); GRID_BAR();
        run_phase<3>(F, li, 0); GRID_BAR();
        run_phase<4>(F, li, 0); GRID_BAR();
        run_phase<5>(F, li, 0); GRID_BAR();
        run_phase<11>(F, li, 0); GRID_BAR();
        run_phase<12>(F, li, 0); GRID_BAR();
        run_phase<6>(F, li, 0); GRID_BAR();
        run_phase<7>(F, li, 0); GRID_BAR();
        run_phase<0>(F, li, 1); GRID_BAR();
        run_phase<1>(F, li, 1); GRID_BAR();
        run_phase<10>(F, li, 0); GRID_BAR();
    }
}

extern "C" void kernel_launch(void* const* d_in, const int* in_sizes, int n_in, void* d_out, int out_size, void* d_ws, size_t ws_size, hipStream_t stream) {
    static int ready = 0;
    if (!ready) {
        if (n_in != 25 || out_size != TL * DM || ws_size < WS_END) { fprintf(stderr, "kernel_launch: unexpected shapes (n_in %d out %d ws %zu)\n", n_in, out_size, ws_size); ready = -1; return; }
        if (hipFuncSetAttribute((const void*)mega_one, hipFuncAttributeMaxDynamicSharedMemorySize, LDS_BYTES) != hipSuccess) { fprintf(stderr, "kernel_launch: hipFuncSetAttribute failed\n"); ready = -1; return; }
        ready = 1;
    }
    if (ready < 0) return;
    if (hipMemsetAsync((char*)d_ws + WS_CTL, 0, 65536, stream) != hipSuccess) { fprintf(stderr, "kernel_launch: memset failed\n"); return; }
    Args a{};
    for (int i = 0; i < 25; ++i) a.in[i] = (const float*)d_in[i];
    a.out = (float*)d_out; a.ws = (unsigned char*)d_ws;
    hipLaunchKernelGGL(mega_one, dim3(256), dim3(NTHR), LDS_BYTES, stream, a);
}
```

```cpp
#include <hip/hip_runtime.h>
#include <cstdio>
#include <cstdint>

namespace pg8 {
#define PG8_LAS __attribute__((address_space(3)))
typedef unsigned short bf16_t;
typedef short bf16x8 __attribute__((ext_vector_type(8)));
typedef float f32x4 __attribute__((ext_vector_type(4)));
typedef unsigned u32x4 __attribute__((ext_vector_type(4)));
constexpr int BM = 256, BK = 64, HALF = 128, HTB = HALF * BK * 2, STAGE_BYTES = 8 * HTB, NXCD = 8, WGM = 8;

__host__ __device__ __forceinline__ int lds_byte(int r, int c) { const int st = (r >> 4) * 2 + (c >> 5), rr = r & 15, cc = c & 31, ob = rr * 64 + cc * 2; return st * 1024 + (ob ^ (((ob >> 9) & 1) << 5)); }
__host__ __device__ __forceinline__ void stage_rc(int b, int& R, int& C) { const int st = b / 1024, sb = b % 1024, swz = sb ^ (((sb >> 9) & 1) << 5); R = (st >> 1) * 16 + swz / 64; C = (st & 1) * 32 + (swz % 64) / 2; }
__host__ __device__ __forceinline__ int perm32(int rho) { const int n = rho >> 4, i = rho & 15; return 8 * (i >> 2) + 4 * n + (i & 3); }

struct Unit { int pm, pn; };
struct Gemm { const bf16_t* A; const bf16_t* Bt; int M, N, K; };

struct StaticOrder {
    int nM, nN, nwg, G, c;
    __host__ __device__ void init(int M, int N, int G_, int c_) { nM = M / BM; nN = N / BM; nwg = nM * nN; G = G_; c = c_; }
    __host__ __device__ bool next(int i, Unit& u) const {
        const long L = (long)i * G + c; if (L >= nwg) return false;
        int wgid = (int)L; { const int q = nwg / NXCD, r = nwg % NXCD, xcd = wgid % NXCD, off = wgid / NXCD; wgid = (xcd < r ? xcd * (q + 1) : r * (q + 1) + (xcd - r) * q) + off; }
        const int nig = WGM * nN, gid = wgid / nig, fm = gid * WGM, gsz = (nM - fm) < WGM ? (nM - fm) : WGM;
        u.pm = fm + ((wgid % nig) % gsz); u.pn = (wgid % nig) / gsz; return true;
    }
    __device__ __forceinline__ void a_ready(const Unit&) const {}
    __device__ __forceinline__ void done(const Unit&) const {}
};

struct UpOrder {
    StaticOrder lat; int G, c, nN; unsigned* cnt;
    __device__ void init(int N, int G_, int c_, unsigned* cnt_) { lat.init(16384, N, G_, c_); G = G_; c = c_; nN = N / BM; cnt = cnt_; }
    __device__ bool next(int i, Unit& u) const {
        const int nctx = 2 * nN, total = nctx + lat.nwg;
        long L;
        if (G != 256) L = (long)i * G + c;
        else if (c >= 248) { if (i >= 3) return false; L = (long)i * G + c; }
        else if (c >= 172 && c < 188 && i == 5) L = (long)(3 + (c - 172) / 8) * G + 248 + (c - 172) % 8;
        else L = (long)i * G + c;
        if (L >= total) return false;
        if (L < nctx) { u.pm = 64 + (int)L / nN; u.pn = (int)L % nN; return true; }
        int wgid = (int)L - nctx; { const int nwg = lat.nwg, q = nwg / NXCD, r = nwg % NXCD, xcd = wgid % NXCD, off = wgid / NXCD; wgid = (xcd < r ? xcd * (q + 1) : r * (q + 1) + (xcd - r) * q) + off; }
        const int nig = WGM * nN, gid = wgid / nig, fm = gid * WGM, gsz = (lat.nM - fm) < WGM ? (lat.nM - fm) : WGM;
        u.pm = fm + ((wgid % nig) % gsz); u.pn = (wgid % nig) / gsz; return true;
    }
    __device__ __forceinline__ void a_ready(const Unit&) const {}
    __device__ __forceinline__ void done(const Unit& u) const {
        if (u.pm >= 64) { asm volatile("s_waitcnt vmcnt(0)" ::: "memory"); __builtin_amdgcn_fence(__ATOMIC_RELEASE, "agent"); asm volatile("s_waitcnt vmcnt(0)" ::: "memory");
            if ((threadIdx.x & 63) == 0) __hip_atomic_fetch_add(cnt, 1u, __ATOMIC_RELAXED, __HIP_MEMORY_SCOPE_AGENT); }
    }
};
struct OneUnit {
    int pm, pn;
    __device__ bool next(int i, Unit& u) const { if (i != 0) return false; u.pm = pm; u.pn = pn; return true; }
    __device__ __forceinline__ void a_ready(const Unit&) const {}
    __device__ __forceinline__ void done(const Unit&) const {}
};

__device__ __forceinline__ unsigned cvt_pk_bf16(float lo, float hi) { unsigned r; asm volatile("v_cvt_pk_bf16_f32 %0, %1, %2" : "=v"(r) : "v"(lo), "v"(hi)); return r; }

struct EpiBf16 {
    static constexpr bool PERM = true, AFTER_DRAIN = false;
    bf16_t* O; int ldc;
    __device__ __forceinline__ void operator()(const f32x4 (&acc)[2][2][4][2], const Unit& u, int wr, int wc, int fr, int fq) const {
        const int row0 = u.pm * BM + wr * 64 + fr; const int col0 = u.pn * BM + wc * 32 + 8 * fq;
#pragma unroll
        for (int ai = 0; ai < 2; ++ai)
#pragma unroll
            for (int m = 0; m < 4; ++m) { bf16_t* rowp = O + (size_t)(row0 + ai * HALF + m * 16) * ldc + col0;
#pragma unroll
                for (int bj = 0; bj < 2; ++bj) { const f32x4 v0 = acc[ai][bj][m][0], v1 = acc[ai][bj][m][1];
                    u32x4 w; w.x = cvt_pk_bf16(v0[0], v0[1]); w.y = cvt_pk_bf16(v0[2], v0[3]); w.z = cvt_pk_bf16(v1[0], v1[1]); w.w = cvt_pk_bf16(v1[2], v1[3]);
                    *(u32x4*)(rowp + bj * HALF) = w; } }
    }
};
struct EpiF32 {
    static constexpr bool PERM = true, AFTER_DRAIN = false;
    float* O; int ldc;
    __device__ __forceinline__ void operator()(const f32x4 (&acc)[2][2][4][2], const Unit& u, int wr, int wc, int fr, int fq) const {
        const int row0 = u.pm * BM + wr * 64 + fr; const int col0 = u.pn * BM + wc * 32 + 8 * fq;
#pragma unroll
        for (int ai = 0; ai < 2; ++ai)
#pragma unroll
            for (int m = 0; m < 4; ++m) { float* rowp = O + (size_t)(row0 + ai * HALF + m * 16) * ldc + col0;
#pragma unroll
                for (int bj = 0; bj < 2; ++bj) { *(f32x4*)(rowp + bj * HALF) = acc[ai][bj][m][0]; *(f32x4*)(rowp + bj * HALF + 4) = acc[ai][bj][m][1]; } }
    }
};
__device__ __forceinline__ float silu_f(float x) { return x * __builtin_amdgcn_rcpf(1.0f + __expf(-x)); }
struct EpiSwiglu {
    static constexpr bool PERM = true, AFTER_DRAIN = false;
    bf16_t* O; int ldc;
    __device__ __forceinline__ void operator()(const f32x4 (&acc)[2][2][4][2], const Unit& u, int wr, int wc, int fr, int fq) const {
        const int row0 = u.pm * BM + wr * 64 + fr; const int col0 = u.pn * HALF + wc * 32 + 8 * fq;
#pragma unroll
        for (int ai = 0; ai < 2; ++ai)
#pragma unroll
            for (int m = 0; m < 4; ++m) { bf16_t* rowp = O + (size_t)(row0 + ai * HALF + m * 16) * ldc + col0;
                const f32x4 g0 = acc[ai][0][m][0], g1 = acc[ai][0][m][1], u0 = acc[ai][1][m][0], u1 = acc[ai][1][m][1];
                u32x4 w; w.x = cvt_pk_bf16(silu_f(g0[0]) * u0[0], silu_f(g0[1]) * u0[1]); w.y = cvt_pk_bf16(silu_f(g0[2]) * u0[2], silu_f(g0[3]) * u0[3]);
                w.z = cvt_pk_bf16(silu_f(g1[0]) * u1[0], silu_f(g1[1]) * u1[1]); w.w = cvt_pk_bf16(silu_f(g1[2]) * u1[2], silu_f(g1[3]) * u1[3]);
                *(u32x4*)rowp = w; }
    }
};

template <class Epi, class Sched, bool ALIGN_EPI = false, bool SP2 = false>
__device__ __forceinline__ void gemm_phase(PG8_LAS unsigned char* lds, const Gemm g, const Sched& S, const Epi& E, const int tid) {
    const int wid = __builtin_amdgcn_readfirstlane(tid >> 6), lane = tid & 63, wr = wid >> 2, wc = wid & 3, fr = lane & 15, fq = lane >> 4;
    const int K = g.K, nt = K / BK;
    unsigned voffA[2], voffB[2];
#pragma unroll
    for (int i = 0; i < 2; ++i) { int R, C; stage_rc(tid * 16 + i * 8192, R, C); const int Rb = Epi::PERM ? ((R & ~31) + perm32(R & 31)) : R;
        voffA[i] = (unsigned)(R * K + C) * 2u; voffB[i] = (unsigned)(Rb * K + C) * 2u; }
    const size_t kstep = (size_t)(BK * 2);
    const size_t hstep = (size_t)HALF * K * 2;
    const size_t tstep = 2 * hstep;
    const unsigned ldsw = (unsigned)wid * 1024u;
    const int aoff = lds_byte(wr * 64 + fr, fq * 8), boff = lds_byte(wc * 32 + fr, fq * 8);
#define PG8_SA(b, h) (((b) * 2 + (h)) * HTB)
#define PG8_SB(b, h) ((4 + (b) * 2 + (h)) * HTB)
#define PG8_STAGE(bufoff, gbase, voff) do { _Pragma("unroll") for (int _i = 0; _i < 2; ++_i) \
        __builtin_amdgcn_global_load_lds((const unsigned*)((const char*)(gbase) + (voff)[_i]), (PG8_LAS unsigned*)(lds + (bufoff) + ldsw + _i * 8192), 16, 0, 0); } while (0)
#define PG8_LDA(dst, b, h) do { _Pragma("unroll") for (int m = 0; m < 4; ++m) _Pragma("unroll") for (int k = 0; k < 2; ++k) dst[m][k] = *(const PG8_LAS bf16x8*)(lds + PG8_SA(b, h) + aoff + m * 2048 + k * 1024); } while (0)
#define PG8_LDB(dst, b, h) do { _Pragma("unroll") for (int n = 0; n < 2; ++n) _Pragma("unroll") for (int k = 0; k < 2; ++k) dst[n][k] = *(const PG8_LAS bf16x8*)(lds + PG8_SB(b, h) + boff + n * 2048 + k * 1024); } while (0)
#define PG8_MMA(ai, bj, At, Bt) do { __builtin_amdgcn_s_setprio(1); _Pragma("unroll") for (int m = 0; m < 4; ++m) _Pragma("unroll") for (int n = 0; n < 2; ++n) _Pragma("unroll") for (int k = 0; k < 2; ++k) \
        acc[ai][bj][m][n] = __builtin_amdgcn_mfma_f32_16x16x32_bf16(Bt[n][k], At[m][k], acc[ai][bj][m][n], 0, 0, 0); __builtin_amdgcn_s_setprio(0); } while (0)
#define PG8_WAIT_V(n) asm volatile("s_waitcnt vmcnt(" #n ")" ::: "memory")
#define PG8_WAIT_L(n) asm volatile("s_waitcnt lgkmcnt(" #n ")" ::: "memory")
#define PG8_BAR __builtin_amdgcn_s_barrier()
#define PG8_SCHED __builtin_amdgcn_sched_barrier(0)
    Unit cur, nxt; int ui = 0;
    if (!S.next(0, cur)) return;
    f32x4 acc[2][2][4][2];
#pragma unroll
    for (int a = 0; a < 2; ++a)
#pragma unroll
        for (int b = 0; b < 2; ++b)
#pragma unroll
            for (int m = 0; m < 4; ++m)
#pragma unroll
                for (int n = 0; n < 2; ++n) acc[a][b][m][n] = (f32x4){0.f, 0.f, 0.f, 0.f};
    bf16x8 At[4][2], B0[2][2], B1[2][2];
    const char* cA = (const char*)g.A + (size_t)cur.pm * tstep; const char* cB = (const char*)g.Bt + (size_t)cur.pn * tstep;
    S.a_ready(cur);
    if constexpr (SP2) {
        PG8_STAGE(PG8_SB(0, 0), cB, voffB); PG8_STAGE(PG8_SB(0, 1), cB + hstep, voffB); PG8_STAGE(PG8_SA(0, 0), cA, voffA); PG8_STAGE(PG8_SA(0, 1), cA + hstep, voffA);
        if (wr == 1) PG8_BAR;
        PG8_WAIT_V(2); PG8_BAR;
        PG8_STAGE(PG8_SB(1, 0), cB + kstep, voffB); PG8_STAGE(PG8_SA(1, 0), cA + kstep, voffA); PG8_STAGE(PG8_SB(1, 1), cB + hstep + kstep, voffB);
        PG8_WAIT_V(6); PG8_BAR;
    } else {
        PG8_STAGE(PG8_SB(0, 0), cB, voffB); PG8_STAGE(PG8_SA(0, 0), cA, voffA); PG8_STAGE(PG8_SB(0, 1), cB + hstep, voffB); PG8_STAGE(PG8_SA(0, 1), cA + hstep, voffA);
        if (wr == 1) PG8_BAR;
        PG8_WAIT_V(4); PG8_BAR;
        PG8_STAGE(PG8_SB(1, 0), cB + kstep, voffB); PG8_STAGE(PG8_SA(1, 0), cA + kstep, voffA); PG8_STAGE(PG8_SB(1, 1), cB + hstep + kstep, voffB);
        PG8_WAIT_V(6); PG8_BAR;
    }
    for (;;) {
        const bool has_next = S.next(ui + 1, nxt);
        const char* nA = has_next ? (const char*)g.A + (size_t)nxt.pm * tstep : cA; const char* nB = has_next ? (const char*)g.Bt + (size_t)nxt.pn * tstep : cB;
        for (int t = 0; t < nt; t += 2) {
            const bool last = (t == nt - 2);
            const char* a1 = cA + (size_t)(t + 1) * kstep;
            const char* a2 = last ? nA : cA + (size_t)(t + 2) * kstep; const char* b2 = last ? nB : cB + (size_t)(t + 2) * kstep;
            const char* a3 = a2 + kstep; const char* b3 = b2 + kstep;
            if (last && has_next) S.a_ready(nxt);
            if constexpr (SP2) {
            PG8_LDB(B0, 0, 0); PG8_LDB(B1, 0, 1); PG8_SCHED; PG8_LDA(At, 0, 0); PG8_STAGE(PG8_SA(1, 1), a1 + hstep, voffA);
            PG8_WAIT_V(8); PG8_WAIT_L(0); PG8_BAR; PG8_MMA(0, 0, At, B0); PG8_MMA(0, 1, At, B1); PG8_BAR; PG8_SCHED;
            PG8_LDA(At, 0, 1); PG8_STAGE(PG8_SB(0, 0), b2, voffB); PG8_STAGE(PG8_SB(0, 1), b2 + hstep, voffB); PG8_STAGE(PG8_SA(0, 0), a2, voffA);
            PG8_WAIT_V(8); PG8_WAIT_L(0); PG8_BAR; PG8_MMA(1, 0, At, B0); PG8_MMA(1, 1, At, B1); PG8_BAR; PG8_SCHED;
            PG8_LDB(B0, 1, 0); PG8_LDB(B1, 1, 1); PG8_SCHED; PG8_LDA(At, 1, 0); PG8_STAGE(PG8_SA(0, 1), a2 + hstep, voffA);
            PG8_WAIT_V(8); PG8_WAIT_L(0); PG8_BAR; PG8_MMA(0, 0, At, B0); PG8_MMA(0, 1, At, B1); PG8_BAR; PG8_SCHED;
            PG8_LDA(At, 1, 1); PG8_STAGE(PG8_SB(1, 0), b3, voffB); PG8_STAGE(PG8_SB(1, 1), b3 + hstep, voffB); PG8_STAGE(PG8_SA(1, 0), a3, voffA);
            PG8_WAIT_V(8); PG8_WAIT_L(0); PG8_BAR; PG8_MMA(1, 0, At, B0); PG8_MMA(1, 1, At, B1); PG8_BAR; PG8_SCHED;
            } else {
            PG8_LDB(B0, 0, 0); PG8_SCHED; PG8_LDA(At, 0, 0); PG8_STAGE(PG8_SA(1, 1), a1 + hstep, voffA);
            PG8_WAIT_L(8); PG8_BAR; PG8_WAIT_L(0); PG8_MMA(0, 0, At, B0); PG8_BAR; PG8_SCHED;
            PG8_LDB(B1, 0, 1); PG8_STAGE(PG8_SB(0, 0), b2, voffB);
            PG8_BAR; PG8_WAIT_L(0); PG8_MMA(0, 1, At, B1); PG8_BAR;
            PG8_LDA(At, 0, 1); PG8_STAGE(PG8_SA(0, 0), a2, voffA);
            PG8_BAR; PG8_WAIT_L(0); PG8_MMA(1, 0, At, B0); PG8_BAR; PG8_SCHED;
            PG8_STAGE(PG8_SB(0, 1), b2 + hstep, voffB);
            PG8_WAIT_V(6); PG8_BAR; PG8_MMA(1, 1, At, B1); PG8_BAR;
            PG8_LDB(B0, 1, 0); PG8_SCHED; PG8_LDA(At, 1, 0); PG8_STAGE(PG8_SA(0, 1), a2 + hstep, voffA);
            PG8_WAIT_L(8); PG8_BAR; PG8_WAIT_L(0); PG8_MMA(0, 0, At, B0); PG8_BAR; PG8_SCHED;
            PG8_LDB(B1, 1, 1); PG8_STAGE(PG8_SB(1, 0), b3, voffB);
            PG8_BAR; PG8_WAIT_L(0); PG8_MMA(0, 1, At, B1); PG8_BAR;
            PG8_LDA(At, 1, 1); PG8_STAGE(PG8_SA(1, 0), a3, voffA);
            PG8_BAR; PG8_WAIT_L(0); PG8_MMA(1, 0, At, B0); PG8_BAR; PG8_SCHED;
            PG8_STAGE(PG8_SB(1, 1), b3 + hstep, voffB);
            PG8_WAIT_V(6); PG8_BAR; PG8_MMA(1, 1, At, B1); PG8_BAR;
            }
        }
        if constexpr (ALIGN_EPI) { if (wr == 0) PG8_BAR; }
        if constexpr (!Epi::AFTER_DRAIN) { E(acc, cur, wr, wc, fr, fq); S.done(cur); }
        if (!has_next) break;
#pragma unroll
        for (int a = 0; a < 2; ++a)
#pragma unroll
            for (int b = 0; b < 2; ++b)
#pragma unroll
                for (int m = 0; m < 4; ++m)
#pragma unroll
                    for (int n = 0; n < 2; ++n) acc[a][b][m][n] = (f32x4){0.f, 0.f, 0.f, 0.f};
        cur = nxt; cA = nA; cB = nB; ++ui;
        if constexpr (ALIGN_EPI) { if (wr == 1) PG8_BAR; }
    }
    PG8_WAIT_V(0);
    if constexpr (!ALIGN_EPI) { if (wr == 0) PG8_BAR; }
    PG8_BAR;
#undef PG8_SA
#undef PG8_SB
#undef PG8_STAGE
#undef PG8_LDA
#undef PG8_LDB
#undef PG8_MMA
#undef PG8_WAIT_V
#undef PG8_WAIT_L
#undef PG8_BAR
#undef PG8_SCHED
}
}

constexpr int NWAVES = 8, NTHR = 512;
constexpr int DM = 1024, SEQ = 8192, NB = 2, CTX = 256, TL = NB * SEQ, TC = NB * CTX, TT = TL + TC;
constexpr int FFN = 2752, FFNP = 2816, NWI = 5632, INW = 2432, INWP = 2560, NMOD = 9;
constexpr int ZF = 0, ZQ = 256, ZK = 640, ZV = 768, ZRR = 896, ZRK = 1280, ZRV = 1664, ZW = 2048, ZA = 2176, ZG = 2304;
constexpr int RW = 384;
constexpr float NORM_EPS = 1e-6f, GN_EPS = 64e-5f;

constexpr size_t MiB = 1u << 20;
constexpr size_t WS_CTL = 0, WS_MOD = 1 * MiB, WS_ROPE = 2 * MiB, WS_XC = 4 * MiB, WS_GC = 6 * MiB;
constexpr size_t WS_WI1 = 8 * MiB, WS_WO1 = 19 * MiB, WS_WIN = 25 * MiB, WS_WOUT = 30 * MiB, WS_WI2 = 32 * MiB, WS_WO2 = 43 * MiB;
constexpr size_t WS_H = 49 * MiB;
constexpr size_t WS_ACT = 82 * MiB;
constexpr size_t WS_O = 173 * MiB;
constexpr size_t WS_YD = WS_O, WS_QR = WS_O + 50 * MiB, WS_KR = WS_O + 62 * MiB;
constexpr size_t WS_W2T = WS_MOD + 256 * 1024, WS_A2T = WS_MOD + 512 * 1024, WS_G2T = WS_MOD + 768 * 1024;
constexpr size_t WS_LW = WS_O, WS_IC = WS_O + 25 * MiB;
constexpr size_t WS_GAM32 = 165 * MiB;
constexpr size_t WS_FA = 239 * MiB;
constexpr size_t WS_SUM = 255 * MiB;
constexpr size_t WS_END = 293 * MiB;

constexpr size_t WS_FT = 7 * MiB;
constexpr size_t FT_W64C = 0, FT_W64S = 8192, FT_W128C = 16384, FT_W128S = 49152, FT_T64C = 81920, FT_T64S = 90112;
constexpr int LDS_BYTES = 147456;

typedef unsigned short bf16;
typedef float f32x4 __attribute__((ext_vector_type(4)));
typedef unsigned v4u __attribute__((ext_vector_type(4)));
typedef unsigned v2u __attribute__((ext_vector_type(2)));
#define LAS __attribute__((address_space(3)))
#define LDS_WAIT() asm volatile("s_waitcnt lgkmcnt(0)" ::: "memory")

__device__ __forceinline__ unsigned f2bf(float f) { unsigned u = __builtin_bit_cast(unsigned, f); return (u + 0x7fffu + ((u >> 16) & 1u)) >> 16; }
__device__ __forceinline__ unsigned pk2(float lo, float hi) { return f2bf(lo) | (f2bf(hi) << 16); }
__device__ __forceinline__ float bf2f(unsigned short u) { return __builtin_bit_cast(float, (unsigned)u << 16); }
__device__ __forceinline__ float bflo(unsigned u) { return __builtin_bit_cast(float, u << 16); }
__device__ __forceinline__ float bfhi(unsigned u) { return __builtin_bit_cast(float, u & 0xffff0000u); }
__device__ __forceinline__ void unpack8(const v4u w, float (&f)[8]) { f[0] = bflo(w.x); f[1] = bfhi(w.x); f[2] = bflo(w.y); f[3] = bfhi(w.y); f[4] = bflo(w.z); f[5] = bfhi(w.z); f[6] = bflo(w.w); f[7] = bfhi(w.w); }
__device__ __forceinline__ float wave_sum(float v) {
#pragma unroll
    for (int o = 1; o < 64; o <<= 1) v += __shfl_xor(v, o);
    return v;
}
__device__ __forceinline__ float wave_max(float v) {
#pragma unroll
    for (int o = 1; o < 64; o <<= 1) v = fmaxf(v, __shfl_xor(v, o));
    return v;
}

struct Args { const float* in[25]; float* out; unsigned char* ws; int ph_lo, ph_hi; };

struct Frame {
    LAS unsigned char* lds;
    int tid, lane, wave, G, bid;
    float* out; unsigned char* ws;
};
enum { I_X = 0, I_C, I_CTX, I_CCTX, I_MODW, I_MODB, I_NORMG, I_F1WI, I_F1WO, I_WIN, I_WOUT, I_SINK, I_CONV, I_W0, I_W2, I_A0, I_A2, I_G2, I_KK, I_KA, I_RK, I_LNG, I_LNB, I_F2WI, I_F2WO };

__device__ __forceinline__ const float* inp(int i) {
    const __attribute__((address_space(4))) char* p = (const __attribute__((address_space(4))) char*)__builtin_amdgcn_kernarg_segment_ptr();
    asm volatile("" : "+s"(p));
    return *(const float* const __attribute__((address_space(4)))*)(p + 8 * i);
}
__device__ __forceinline__ void cvt_item(const float* W, int ldw, int k0, int sc, bool valid, bf16* WT, int Kd, int n0d, LAS float* scr, int lane) {
#pragma unroll 8
    for (int i = 0; i < 32; ++i) { const int kk = 2 * i + (lane >> 5); scr[kk * 33 + (lane & 31)] = valid ? W[(size_t)(k0 + kk) * ldw + sc + (lane & 31)] : 0.f; }
    LDS_WAIT(); asm volatile("" ::: "memory");
    const int c = lane & 7;
#pragma unroll
    for (int j = 0; j < 4; ++j) { const int n = (lane >> 3) + 8 * j; const LAS float* s = scr + (8 * c) * 33 + n;
        v4u o; o.x = pk2(s[0 * 33], s[1 * 33]); o.y = pk2(s[2 * 33], s[3 * 33]); o.z = pk2(s[4 * 33], s[5 * 33]); o.w = pk2(s[6 * 33], s[7 * 33]);
        *(v4u*)(WT + (size_t)(n0d + n) * Kd + k0 + 8 * c) = o; }
    LDS_WAIT(); asm volatile("" ::: "memory");
}
__device__ __forceinline__ void convert_weights(Frame& F, int li) {
    LAS float* scr = (LAS float*)(F.lds + F.wave * 16384);
    const int gw = F.bid * NWAVES + F.wave, NGW = F.G * NWAVES;
    constexpr int I_WI = 16 * (NWI / 32), I_WO = (FFNP / 64) * 32, I_IN = 16 * (INWP / 32), I_OUT = 16 * 32;
    constexpr int NITEMS = 2 * I_WI + 2 * I_WO + I_IN + I_OUT;
    for (int it = gw; it < NITEMS; it += NGW) {
        int r = it;
        if (r < 2 * I_WI) { const int f = r / I_WI; r -= f * I_WI; const int nblk = NWI / 32, kb = r / nblk, nb = r % nblk;
            const int n0 = 32 * nb, pn = n0 >> 8, i = n0 & 255; const int j = 128 * pn + (i & 127); const bool valid = j < FFN; const int sc = (i < 128) ? j : FFN + j;
            cvt_item((f ? inp(I_F2WI) : inp(I_F1WI)) + (size_t)li * DM * 2 * FFN, 2 * FFN, 64 * kb, sc, valid, (bf16*)(F.ws + (f ? WS_WI2 : WS_WI1)), DM, n0, scr, F.lane); continue; }
        r -= 2 * I_WI;
        if (r < 2 * I_WO) { const int f = r / I_WO; r -= f * I_WO; const int kb = r / 32, nb = r % 32; const bool valid = 64 * kb < FFN;
            cvt_item((f ? inp(I_F2WO) : inp(I_F1WO)) + (size_t)li * FFN * DM, DM, 64 * kb, 32 * nb, valid, (bf16*)(F.ws + (f ? WS_WO2 : WS_WO1)), FFNP, 32 * nb, scr, F.lane); continue; }
        r -= 2 * I_WO;
        if (r < I_IN) { const int nblk = INWP / 32, kb = r / nblk, nb = r % nblk; const bool valid = 32 * nb < INW;
            cvt_item(inp(I_WIN) + (size_t)li * DM * INW, INW, 64 * kb, 32 * nb, valid, (bf16*)(F.ws + WS_WIN), DM, 32 * nb, scr, F.lane); continue; }
        r -= I_IN;
        { const int kb = r / 32, nb = r % 32;
            cvt_item(inp(I_WOUT) + (size_t)li * DM * DM, DM, 64 * kb, 32 * nb, true, (bf16*)(F.ws + WS_WOUT), DM, 32 * nb, scr, F.lane); }
    }
}
__device__ __forceinline__ void mod_gemv(Frame& F) {
    LAS float* sc = (LAS float*)F.lds;
    LAS float* red = sc + 3 * 1024;
    __syncthreads();
    for (int i = F.tid; i < 3 * 1024; i += NTHR) { const int v = i >> 10, k = i & 1023; const float x = v < 2 ? inp(I_C)[v * 1024 + k] : inp(I_CCTX)[k]; sc[i] = x / (1.0f + __expf(-x)); }
    __syncthreads();
    float* modv = (float*)(F.ws + WS_MOD);
    for (int u = F.bid; u < 2 * 72; u += F.G) {
        const int l = u / 72, n0 = (u % 72) * 128;
        const float* w = inp(I_MODW) + (size_t)l * DM * 9216 + n0 + 2 * F.lane;
        float a0 = 0.f, a1 = 0.f, b0 = 0.f, b1 = 0.f, c0 = 0.f, c1 = 0.f;
        const int k0 = F.wave * 128;
#pragma unroll 8
        for (int k = 0; k < 128; ++k) { const float2 wv = *(const float2*)(w + (size_t)(k0 + k) * 9216); const float s0 = sc[k0 + k], s1 = sc[1024 + k0 + k], s2 = sc[2048 + k0 + k];
            a0 += s0 * wv.x; a1 += s0 * wv.y; b0 += s1 * wv.x; b1 += s1 * wv.y; c0 += s2 * wv.x; c1 += s2 * wv.y; }
        LAS float* rw = red + F.wave * 384 + 2 * F.lane;
        rw[0] = a0; rw[1] = a1; rw[128] = b0; rw[129] = b1; rw[256] = c0; rw[257] = c1;
        __syncthreads();
        if (F.tid < 384) { float s = 0.f;
#pragma unroll
            for (int w8 = 0; w8 < 8; ++w8) s += red[w8 * 384 + F.tid];
            const int v = F.tid >> 7, n = n0 + (F.tid & 127);
            modv[(size_t)(l * 3 + v) * 9216 + n] = s + inp(I_MODB)[l * 9216 + n]; }
        __syncthreads();
    }
}
__device__ __forceinline__ void rope_tables(Frame& F) {
    float* ct = (float*)(F.ws + WS_ROPE); float* st = ct + SEQ * 32;
    for (int i = F.bid * NTHR + F.tid; i < SEQ * 32; i += F.G * NTHR) {
        const int t = i >> 5, j = i & 31; const int f = j & 15;
        const float inv = exp2f(-(float)f * (13.287712379549449f / 16.0f));
        const float pos = (float)(j < 16 ? (t >> 6) : (t & 63));
        const float ang = pos * inv;
        const double a = (double)ang; const double k = __builtin_rint(a * 0.15915494309189535); const float r = (float)(a - k * 6.283185307179586);
        ct[i] = __cosf(r); st[i] = __sinf(r);
    }
}

struct EArgs { const float* xl_src; const float* xc_src; float* xl_dst; float* xc_dst; const float* o; const float* modv_g; int gidx; float gmul; const float* gpost;
               bf16* hdst; const float* modv_h; int shidx, scidx; const float* gpre; int nrows; };
__device__ __forceinline__ void e_phase(Frame& F, const EArgs& A) {
    const int gw = F.bid * NWAVES + F.wave, NGW = F.G * NWAVES;
    for (int r = gw; r < A.nrows; r += NGW) {
        const int v = r < TL ? (r >> 13) : 2;
        const float* xs = r < TL ? A.xl_src + (size_t)r * DM : A.xc_src + (size_t)(r - TL) * DM;
        f32x4 x[4];
#pragma unroll
        for (int j = 0; j < 4; ++j) x[j] = ((const f32x4*)xs)[F.lane + 64 * j];
        if (A.o) {
            const f32x4* orow = (const f32x4*)(A.o + (size_t)r * DM); f32x4 ov[4]; float ss = 0.f;
#pragma unroll
            for (int j = 0; j < 4; ++j) { ov[j] = orow[F.lane + 64 * j]; ss += (ov[j].x * ov[j].x + ov[j].y * ov[j].y) + (ov[j].z * ov[j].z + ov[j].w * ov[j].w); }
            const float rstd = 1.0f / sqrtf(wave_sum(ss) * (1.0f / DM) + NORM_EPS) * A.gmul;
            const f32x4* gm = (const f32x4*)(A.modv_g + (size_t)v * 9216 + A.gidx * DM); const f32x4* gp = (const f32x4*)A.gpost;
            float* xd = r < TL ? A.xl_dst + (size_t)r * DM : A.xc_dst + (size_t)(r - TL) * DM;
#pragma unroll
            for (int j = 0; j < 4; ++j) { const f32x4 g = gm[F.lane + 64 * j], p = gp[F.lane + 64 * j]; x[j] = x[j] + g * (ov[j] * rstd * p); ((f32x4*)xd)[F.lane + 64 * j] = x[j]; }
        }
        if (A.hdst) {
            float ss = 0.f;
#pragma unroll
            for (int j = 0; j < 4; ++j) ss += (x[j].x * x[j].x + x[j].y * x[j].y) + (x[j].z * x[j].z + x[j].w * x[j].w);
            const float rstd = 1.0f / sqrtf(wave_sum(ss) * (1.0f / DM) + NORM_EPS);
            const f32x4* sh = (const f32x4*)(A.modv_h + (size_t)v * 9216 + A.shidx * DM); const f32x4* scl = (const f32x4*)(A.modv_h + (size_t)v * 9216 + A.scidx * DM); const f32x4* gp = (const f32x4*)A.gpre;
            v2u* hd = (v2u*)(A.hdst + (size_t)r * DM);
#pragma unroll
            for (int j = 0; j < 4; ++j) { const f32x4 s = sh[F.lane + 64 * j], c = scl[F.lane + 64 * j], p = gp[F.lane + 64 * j]; const f32x4 hv = (x[j] * rstd * p) * (1.0f + c) + s;
                v2u w; w.x = pk2(hv.x, hv.y); w.y = pk2(hv.z, hv.w); hd[F.lane + 64 * j] = w; }
        }
    }
}

__device__ __forceinline__ const bf16* zrow(const Frame& F, int row) { return (const bf16*)(F.ws + WS_ACT) + (size_t)row * INWP; }

__device__ __forceinline__ void rope_all(Frame& F) {
    const float* ct = (const float*)(F.ws + WS_ROPE); const float* st = ct + SEQ * 32;
    bf16* qr = (bf16*)(F.ws + WS_QR); bf16* kr = (bf16*)(F.ws + WS_KR);
    for (int i = F.bid * NTHR + F.tid; i < TL * 32; i += F.G * NTHR) {
        const int o = i & 3, hh = (i >> 2) & 7, tok = i >> 5; const int s = tok & (SEQ - 1);
        const bf16* z = zrow(F, tok) + (hh < 6 ? ZQ + 64 * hh : ZK + 64 * (hh - 6)) + 8 * o;
        float x1[8], x2[8]; unpack8(*(const v4u*)z, x1); unpack8(*(const v4u*)(z + 32), x2);
        const f32x4 c0 = *(const f32x4*)(ct + s * 32 + 8 * o), c1 = *(const f32x4*)(ct + s * 32 + 8 * o + 4), s0 = *(const f32x4*)(st + s * 32 + 8 * o), s1 = *(const f32x4*)(st + s * 32 + 8 * o + 4);
        const float sc = hh < 6 ? 0.125f : 1.0f; float o1[8], o2[8];
#pragma unroll
        for (int e = 0; e < 4; ++e) { o1[e] = (x1[e] * c0[e] - x2[e] * s0[e]) * sc; o2[e] = (x2[e] * c0[e] + x1[e] * s0[e]) * sc; o1[e + 4] = (x1[e + 4] * c1[e] - x2[e + 4] * s1[e]) * sc; o2[e + 4] = (x2[e + 4] * c1[e] + x1[e + 4] * s1[e]) * sc; }
        bf16* d = hh < 6 ? qr + (size_t)tok * 384 + 64 * hh + 8 * o : kr + (size_t)tok * 128 + 64 * (hh - 6) + 8 * o;
        *(v4u*)d = (v4u){pk2(o1[0], o1[1]), pk2(o1[2], o1[3]), pk2(o1[4], o1[5]), pk2(o1[6], o1[7])};
        *(v4u*)(d + 32) = (v4u){pk2(o2[0], o2[1]), pk2(o2[2], o2[3]), pk2(o2[4], o2[5]), pk2(o2[6], o2[7])}; }
}
__device__ __forceinline__ void fourier_a_unit(Frame& F, int u) {
    const int b = u >> 7, n2 = u & 127;
    LAS float* tab = (LAS float*)F.lds;
    __syncthreads();
    if (F.tid < 64) { const float a = (float)F.tid * (1.0f / 64.0f); tab[F.tid] = __builtin_amdgcn_cosf(a); tab[64 + F.tid] = __builtin_amdgcn_sinf(a); }
    __syncthreads();
    const int c = F.tid & 255, kh = F.tid >> 8;
    float f[64];
#pragma unroll
    for (int n1 = 0; n1 < 64; ++n1) f[n1] = bf2f(zrow(F, b * SEQ + 128 * n1 + n2)[ZF + c]);
    bf16* far = (bf16*)(F.ws + WS_FA); bf16* fai = far + (size_t)NB * 64 * 128 * 256;
    for (int kk = 0; kk < 32; ++kk) { const int k1 = kh * 32 + kk;
        float sr = 0.f, si = 0.f;
#pragma unroll
        for (int n1 = 0; n1 < 64; ++n1) { const int idx = (n1 * k1) & 63; sr += f[n1] * tab[idx]; si -= f[n1] * tab[64 + idx]; }
        const float tw = (float)(n2 * k1) * (1.0f / 8192.0f); const float tc = __builtin_amdgcn_cosf(tw), ts = -__builtin_amdgcn_sinf(tw);
        const size_t o = (((size_t)b * 64 + k1) * 128 + n2) * 256 + c;
        far[o] = (bf16)f2bf(sr * tc - si * ts); fai[o] = (bf16)f2bf(sr * ts + si * tc);
    }
}
__device__ __forceinline__ void fourier_c_unit(Frame& F, int u) {
    const int b = u >> 7, k1 = (u >> 1) & 63, half = u & 1;
    LAS float* tab = (LAS float*)F.lds;
    LAS float* tab64 = tab + 256;
    LAS float* P = tab + 512;
    __syncthreads();
    if (F.tid < 128) { const float a = (float)F.tid * (1.0f / 128.0f); tab[F.tid] = __builtin_amdgcn_cosf(a); tab[128 + F.tid] = __builtin_amdgcn_sinf(a); }
    if (F.tid >= 128 && F.tid < 192) { const float a = (float)(F.tid - 128) * (1.0f / 64.0f); tab64[F.tid - 128] = __builtin_amdgcn_cosf(a); tab64[64 + F.tid - 128] = __builtin_amdgcn_sinf(a); }
    __syncthreads();
    const int c = F.tid & 255, q = F.tid >> 8;
    const bf16* far = (const bf16*)(F.ws + WS_FA) + (((size_t)b * 64 + k1) * 128) * 256 + c; const bf16* fai = far + (size_t)NB * 64 * 128 * 256;
    float ar[32], ai[32];
#pragma unroll
    for (int i = 0; i < 32; ++i) { ar[i] = 0.f; ai[i] = 0.f; }
    const int k2b = 64 * half + 32 * q;
    for (int n2 = 0; n2 < 128; ++n2) { const float xr = bf2f(far[(size_t)n2 * 256]), xi = bf2f(fai[(size_t)n2 * 256]);
#pragma unroll
        for (int i = 0; i < 32; ++i) { const int idx = (n2 * (k2b + i)) & 127; const float cs = tab[idx], sn = tab[128 + idx];
            ar[i] += xr * cs + xi * sn; ai[i] += xi * cs - xr * sn; } }
    bf16* mix = (bf16*)(F.ws + WS_H);
    const int g = c >> 6;
    float y[32];
#pragma unroll
    for (int i = 0; i < 32; ++i) y[i] = 0.f;
#pragma unroll
    for (int rnd = 0; rnd < 2; ++rnd) {
        __syncthreads();
#pragma unroll
        for (int i = 0; i < 32; ++i) P[(32 * q + i) * 256 + c] = rnd == 0 ? ar[i] : ai[i];
        __syncthreads();
        const int m = c & 63;
        for (int cc = 0; cc < 64; ++cc) { const int idx = (m * cc) & 63; const float t = rnd == 0 ? tab64[idx] : tab64[64 + idx];
#pragma unroll
            for (int i = 0; i < 32; ++i) y[i] += P[(32 * q + i) * 256 + 64 * g + cc] * t; }
    }
    const float scale = 0.0013810679320049757f;
#pragma unroll
    for (int i = 0; i < 32; ++i) { const int k = k1 + 64 * (k2b + i); mix[(size_t)(b * SEQ + k) * DM + c] = (bf16)f2bf(y[i] * scale); }
}
__device__ __forceinline__ void fourier_ctx1_all(Frame& F) {
    float* gr = (float*)(F.ws + WS_GC); float* gi = gr + TC * 256;
    const bf16* wc = (const bf16*)(F.ws + WS_FT + FT_W64C); const bf16* wsn = (const bf16*)(F.ws + WS_FT + FT_W64S);
    for (int i = F.bid * NTHR + F.tid; i < TC * 256; i += F.G * NTHR) { const int tok = i >> 8, gm = i & 255, g = gm >> 6, m = gm & 63;
        const bf16* z = zrow(F, TL + tok) + ZF + 64 * g; float sr = 0.f, si = 0.f;
#pragma unroll
        for (int c8 = 0; c8 < 8; ++c8) { float x[8], cs[8], sn[8]; unpack8(*(const v4u*)(z + 8 * c8), x); unpack8(*(const v4u*)(wc + m * 64 + 8 * c8), cs); unpack8(*(const v4u*)(wsn + m * 64 + 8 * c8), sn);
#pragma unroll
            for (int e = 0; e < 8; ++e) { sr += x[e] * cs[e]; si -= x[e] * sn[e]; } }
        gr[i] = sr; gi[i] = si; }
}
__device__ __forceinline__ void fourier_ctx2_all(Frame& F) {
    const float* gr = (const float*)(F.ws + WS_GC); const float* gi = gr + TC * 256; bf16* mix = (bf16*)(F.ws + WS_H);
    for (int i = F.bid * NTHR + F.tid; i < TC * 256; i += F.G * NTHR) { const int row = i >> 8, gm = i & 255, b = row >> 8, k = row & 255; float y = 0.f;
#pragma unroll 8
        for (int n = 0; n < 256; ++n) { const float a = (float)((k * n) & 255) * (1.0f / 256.0f); y += gr[(b * 256 + n) * 256 + gm] * __builtin_amdgcn_cosf(a) + gi[(b * 256 + n) * 256 + gm] * __builtin_amdgcn_sinf(a); }
        mix[(size_t)(TL + row) * DM + gm] = (bf16)f2bf(y * 0.0078125f); }
}
__device__ __forceinline__ float dot64(const float (&q)[64], const bf16* krow) {
    float s = 0.f;
#pragma unroll
    for (int i = 0; i < 8; ++i) { const v4u w = ((const v4u*)krow)[i];
        s += q[8 * i + 0] * bflo(w.x) + q[8 * i + 1] * bfhi(w.x) + q[8 * i + 2] * bflo(w.y) + q[8 * i + 3] * bfhi(w.y) + q[8 * i + 4] * bflo(w.z) + q[8 * i + 5] * bfhi(w.z) + q[8 * i + 6] * bflo(w.w) + q[8 * i + 7] * bfhi(w.w); }
    return s;
}
__device__ __forceinline__ void attn_v1(Frame& F, int li) {
    const int gw = F.bid * NWAVES + F.wave, NGW = F.G * NWAVES;
    const bf16* qr = (const bf16*)(F.ws + WS_QR); const bf16* kr = (const bf16*)(F.ws + WS_KR); bf16* mix = (bf16*)(F.ws + WS_H);
    const float* sink = inp(I_SINK) + li * 6;
    const int npairs = (li == 0 ? TT : TL) * 6;
    for (int p = gw; p < npairs; p += NGW) {
        const int row = p / 6, hq = p % 6, kvh = hq / 3; const bool isctx = row >= TL;
        const int b = isctx ? (row - TL) >> 8 : row >> 13, s = row & (SEQ - 1);
        float q[64];
        if (!isctx) {
#pragma unroll
            for (int i = 0; i < 8; ++i) { const v4u w = ((const v4u*)(qr + (size_t)row * 384 + 64 * hq))[i];
                q[8 * i] = bflo(w.x); q[8 * i + 1] = bfhi(w.x); q[8 * i + 2] = bflo(w.y); q[8 * i + 3] = bfhi(w.y); q[8 * i + 4] = bflo(w.z); q[8 * i + 5] = bfhi(w.z); q[8 * i + 6] = bflo(w.w); q[8 * i + 7] = bfhi(w.w); }
        } else {
#pragma unroll
            for (int i = 0; i < 8; ++i) { const v4u w = ((const v4u*)(zrow(F, row) + ZQ + 64 * hq))[i];
                q[8 * i] = 0.125f * bflo(w.x); q[8 * i + 1] = 0.125f * bfhi(w.x); q[8 * i + 2] = 0.125f * bflo(w.y); q[8 * i + 3] = 0.125f * bfhi(w.y); q[8 * i + 4] = 0.125f * bflo(w.z); q[8 * i + 5] = 0.125f * bfhi(w.z); q[8 * i + 6] = 0.125f * bflo(w.w); q[8 * i + 7] = 0.125f * bfhi(w.w); }
        }
        float sc[9]; int krow_[9];
        const float NEG = -INFINITY;
        float mx = sink[hq];
#pragma unroll
        for (int r = 0; r < 9; ++r) {
            if (r < 5) {
                const int kp = s - 128 + 64 * r + F.lane; const bool ok = !isctx && kp >= 0 && kp < SEQ && kp <= s + 128;
                const int kc = ok ? kp : 0; krow_[r] = b * SEQ + kc;
                const float d = isctx ? 0.f : dot64(q, kr + (size_t)(b * SEQ + kc) * 128 + 64 * kvh);
                sc[r] = ok ? d : NEG;
            } else {
                const int kc = 64 * (r - 5) + F.lane; krow_[r] = TL + b * CTX + kc;
                sc[r] = dot64(q, zrow(F, TL + b * CTX + kc) + ZK + 64 * kvh);
            }
            mx = fmaxf(mx, sc[r]);
        }
        mx = wave_max(mx);
        float den = 0.f;
#pragma unroll
        for (int r = 0; r < 9; ++r) { sc[r] = __expf(sc[r] - mx); den += sc[r]; }
        den = wave_sum(den) + __expf(sink[hq] - mx);
        float acc = 0.f;
#pragma unroll
        for (int r = 0; r < 9; ++r) {
            if (r < 5 && isctx) continue;
            for (int kk = 0; kk < 64; ++kk) { const float pk = __builtin_bit_cast(float, __builtin_amdgcn_readlane(__builtin_bit_cast(int, sc[r]), kk)); const int kr_ = __builtin_amdgcn_readlane(krow_[r], kk);
                acc += pk * bf2f(zrow(F, kr_)[ZV + 64 * kvh + F.lane]); }
        }
        mix[(size_t)row * DM + 256 + 64 * hq + F.lane] = (bf16)f2bf(acc / den);
    }
}

typedef short bf16x8 __attribute__((ext_vector_type(8)));
#define MFMA16(a, b, c) __builtin_amdgcn_mfma_f32_16x16x32_bf16(a, b, c, 0, 0, 0)
__device__ __forceinline__ bf16x8 mk8(unsigned a, unsigned b, unsigned c, unsigned d) { const v4u v = {a, b, c, d}; return __builtin_bit_cast(bf16x8, v); }
typedef __bf16 bf16x2_t __attribute__((ext_vector_type(2)));
typedef float f32x2_t __attribute__((ext_vector_type(2)));
__device__ __forceinline__ unsigned cvtpk(float lo, float hi) { const f32x2_t f = {lo, hi}; return __builtin_bit_cast(unsigned, __builtin_convertvector(f, bf16x2_t)); }
constexpr int NSC = 66;
constexpr int IM_AI = 0, IM_RI = 4608, IM_BI = 9216, IM_KI = 13824, IM_BKT = 18432, IM_VT = 28672, IM_GAM = 33792, IMG_BYTES = 34816;
constexpr int L_IMG0 = 0, L_IMG1 = IMG_BYTES, L_PKG = 2 * IMG_BYTES, L_YL = L_PKG + 8192, L_VB = L_YL + 128 * 68 * 4, L_BON = L_VB + 128 * 64 * 2, L_CST = L_BON + 512, L_RW_END = L_CST + 3072;
static_assert(L_RW_END <= 146432, "rwkv LDS map");
constexpr size_t SUM_SLOT = 24576;

__device__ __forceinline__ void lora_transposes(Frame& F) {
    bf16* w2t = (bf16*)(F.ws + WS_W2T); bf16* a2t = (bf16*)(F.ws + WS_A2T); bf16* g2t = (bf16*)(F.ws + WS_G2T);
    const float* w2 = inp(I_W2); const float* a2 = inp(I_A2); const float* g2 = inp(I_G2);
    for (int i = F.bid * NTHR + F.tid; i < 4 * 384 * 64; i += F.G * NTHR) { const int r = i & 63, col = (i >> 6) % 384, ld = i / (384 * 64);
        w2t[i] = (bf16)f2bf(w2[((size_t)ld * 64 + r) * RW + col]); a2t[i] = (bf16)f2bf(a2[((size_t)ld * 64 + r) * RW + col]); }
    for (int i = F.bid * NTHR + F.tid; i < 2 * 384 * 128; i += F.G * NTHR) { const int r = i & 127, col = (i >> 7) % 384, l = i / (384 * 128);
        g2t[i] = (bf16)f2bf(g2[((size_t)l * 128 + r) * RW + col]); }
}

__device__ __forceinline__ float softplus_fast(float x) { return fmaxf(x, 0.f) + __logf(1.0f + __expf(-fabsf(x))); }
__device__ __forceinline__ float tanh_fast(float x) { return 1.0f - 2.0f * __builtin_amdgcn_rcpf(1.0f + __expf(2.0f * x)); }
template <int CTRL> __device__ __forceinline__ float dpp_f(float v) { return __builtin_bit_cast(float, __builtin_amdgcn_update_dpp(0, __builtin_bit_cast(int, v), CTRL, 0xf, 0xf, true)); }
__device__ __forceinline__ void lora_pass(Frame& F, int li) {
    const int q = F.lane >> 4, c16 = F.lane & 15;
#pragma unroll 1
    for (int dir = 0; dir < 2; ++dir) {
        bf16* LW = (bf16*)(F.ws + WS_LW) + (size_t)dir * TT * RW; bf16* IC = (bf16*)(F.ws + WS_IC) + (size_t)dir * TT * RW;
        const bf16* w2t = (const bf16*)(F.ws + WS_W2T) + (size_t)(li * 2 + dir) * 384 * 64; const bf16* a2t = (const bf16*)(F.ws + WS_A2T) + (size_t)(li * 2 + dir) * 384 * 64;
        bf16x8 aw[3][2], aa[3][2]; f32x4 w0v[3], a0v[3];
#pragma unroll
        for (int cti = 0; cti < 3; ++cti) { const int ct = 3 * F.wave + cti, col = 16 * ct + c16;
#pragma unroll
            for (int k = 0; k < 2; ++k) { aw[cti][k] = *(const bf16x8*)(w2t + (size_t)col * 64 + 32 * k + 8 * q); aa[cti][k] = *(const bf16x8*)(a2t + (size_t)col * 64 + 32 * k + 8 * q); }
            w0v[cti] = *(const f32x4*)(inp(I_W0) + (li * 2 + dir) * RW + 16 * ct + 4 * q); a0v[cti] = *(const f32x4*)(inp(I_A0) + (li * 2 + dir) * RW + 16 * ct + 4 * q); }
#pragma unroll 1
        for (int rt = F.bid; rt < TT / 16; rt += F.G) {
            const bf16* z = zrow(F, 16 * rt + c16);
            bf16x8 bw[2], ba[2];
#pragma unroll
            for (int k = 0; k < 2; ++k) { const v4u zw = *(const v4u*)(z + ZW + 64 * dir + 32 * k + 8 * q); ba[k] = *(const bf16x8*)(z + ZA + 64 * dir + 32 * k + 8 * q);
                bw[k] = mk8(cvtpk(tanh_fast(bflo(zw.x)), tanh_fast(bfhi(zw.x))), cvtpk(tanh_fast(bflo(zw.y)), tanh_fast(bfhi(zw.y))), cvtpk(tanh_fast(bflo(zw.z)), tanh_fast(bfhi(zw.z))), cvtpk(tanh_fast(bflo(zw.w)), tanh_fast(bfhi(zw.w)))); }
#pragma unroll
            for (int cti = 0; cti < 3; ++cti) { const int ct = 3 * F.wave + cti;
                f32x4 dw = {0.f, 0.f, 0.f, 0.f}, da = {0.f, 0.f, 0.f, 0.f};
#pragma unroll
                for (int k = 0; k < 2; ++k) { dw = MFMA16(aw[cti][k], bw[k], dw); da = MFMA16(aa[cti][k], ba[k], da); }
                float lw[4], ic[4];
#pragma unroll
                for (int e = 0; e < 4; ++e) { const float x = w0v[cti][e] + dw[e]; const float wl = -softplus_fast(-x) - 0.5f; lw[e] = -__expf(wl); ic[e] = __builtin_amdgcn_rcpf(1.0f + __expf(-(a0v[cti][e] + da[e]))); }
                if (dir == 0) {
#pragma unroll
                    for (int e = 0; e < 4; ++e) { lw[e] += dpp_f<0x111>(lw[e]); lw[e] += dpp_f<0x112>(lw[e]); lw[e] += dpp_f<0x114>(lw[e]); lw[e] += dpp_f<0x118>(lw[e]); } }
                else {
#pragma unroll
                    for (int e = 0; e < 4; ++e) { lw[e] += dpp_f<0x101>(lw[e]); lw[e] += dpp_f<0x102>(lw[e]); lw[e] += dpp_f<0x104>(lw[e]); lw[e] += dpp_f<0x108>(lw[e]); } }
#pragma unroll
                for (int e = 0; e < 4; ++e) lw[e] = __expf(lw[e]);
                if (c16 == (dir == 0 ? 15 : 0)) *(f32x4*)((float*)(F.ws + WS_GAM32) + ((size_t)dir * (TT / 16) + rt) * RW + 16 * ct + 4 * q) = (f32x4){lw[0], lw[1], lw[2], lw[3]};
                const size_t o = (size_t)(16 * rt + c16) * RW + 16 * ct + 4 * q;
                v2u w; w.x = cvtpk(lw[0], lw[1]); w.y = cvtpk(lw[2], lw[3]); *(v2u*)(LW + o) = w; w.x = cvtpk(ic[0], ic[1]); w.y = cvtpk(ic[2], ic[3]); *(v2u*)(IC + o) = w; }
        }
    }
}
struct ChainCtx { int dir, b, h, li; float kkw, kaw, rkw; float cw[3][3]; };
__device__ __forceinline__ void chain_consts(ChainCtx& C, int li, int dir, int b, int h, int j) {
    C.dir = dir; C.b = b; C.h = h; C.li = li; const int ch = 64 * h + j;
    C.kkw = inp(I_KK)[li * RW + ch]; C.kaw = inp(I_KA)[li * RW + ch]; C.rkw = inp(I_RK)[li * RW + ch];
#pragma unroll
    for (int t = 0; t < 3; ++t)
#pragma unroll
        for (int qq = 0; qq < 3; ++qq) C.cw[t][qq] = inp(I_CONV)[(size_t)(li * 3 + t) * (3 * RW) + qq * RW + ch];
}
template <int TPT, bool BONUS>
__device__ __forceinline__ void prep_round(Frame& F, const ChainCtx& C, LAS unsigned char* img, int j, int tg, bool isctx, int step0, LAS unsigned char* lds_vb, LAS float* lds_bon, int pos0_local) {
    const int L = isctx ? CTX : SEQ, rbase = isctx ? TL + C.b * CTX : C.b * SEQ, ch = 64 * C.h + j;
    const bf16* LW = (const bf16*)(F.ws + WS_LW) + (size_t)C.dir * TT * RW + ch; const bf16* IC = (const bf16*)(F.ws + WS_IC) + (size_t)C.dir * TT * RW + ch;
    const int tok0 = tg * TPT, blk = tok0 >> 4;
    float cum = 0.f;
    for (int t = blk * 16; t < tok0; ++t) { const int s = step0 + t; const int p = C.dir ? L - 1 - s : s; cum += bf2f(LW[(size_t)(rbase + p) * RW]); }
    float eprev = __expf(cum);
    const int pj = (j & ~31) | (((j & 15) >> 2) << 3) | (((j >> 4) & 1) << 2) | (j & 3);
    LAS bf16* AI = (LAS bf16*)(img + IM_AI) + blk * 1152, *RI = (LAS bf16*)(img + IM_RI) + blk * 1152, *BI = (LAS bf16*)(img + IM_BI) + blk * 1152, *KI = (LAS bf16*)(img + IM_KI) + blk * 1152;
    LAS bf16* BKT = (LAS bf16*)(img + IM_BKT) + blk * 2560 + j * 40; LAS bf16* VT = (LAS bf16*)(img + IM_VT) + blk * 1280 + j * 20; LAS float* GAM = (LAS float*)(img + IM_GAM) + blk * 64;
#pragma unroll 2
    for (int u = 0; u < TPT; ++u) { const int t = tok0 + u, tb = t & 15; const int s = step0 + t; const int p = C.dir ? L - 1 - s : s; const int row = rbase + p;
        const float lw = bf2f(LW[(size_t)row * RW]), ai = bf2f(IC[(size_t)row * RW]);
        float rv = 0.f, kv = 0.f, vv = 0.f;
#pragma unroll
        for (int tt = 0; tt < 3; ++tt) { const int pp = p + tt - 1; if (pp >= 0 && pp < L) { const bf16* z = zrow(F, rbase + pp); rv += C.cw[tt][0] * bf2f(z[ZRR + ch]); kv += C.cw[tt][1] * bf2f(z[ZRK + ch]); vv += C.cw[tt][2] * bf2f(z[ZRV + ch]); } }
        const float kkr = kv * C.kkw; const float ss = wave_sum(kkr * kkr); const float kk = kkr * (1.0f / sqrtf(fmaxf(ss, 1e-24f)));
        const float kd = kv * (1.0f + (ai - 1.0f) * C.kaw);
        const float ec = eprev * __expf(lw), en = 1.0f / ec;
        AI[tb * 72 + pj] = (bf16)f2bf(-kk * eprev); RI[tb * 72 + pj] = (bf16)f2bf(rv * ec);
        const bf16 bt = (bf16)f2bf(kk * ai * en), kt = (bf16)f2bf(kd * en);
        BI[tb * 72 + pj] = bt; KI[tb * 72 + pj] = kt;
        BKT[(tb >> 2) * 8 + (tb & 3)] = bt; BKT[(tb >> 2) * 8 + 4 + (tb & 3)] = kt;
        VT[tb] = (bf16)f2bf(vv);
        if (tb == 15) GAM[j] = ec;
        if constexpr (BONUS) { const float bs = wave_sum(rv * kv * C.rkw); const int pl = C.dir ? pos0_local - t : pos0_local + t;
            ((LAS bf16*)lds_vb)[pl * 64 + j] = (bf16)f2bf(vv); if (j == 0) lds_bon[pl] = bs; }
        eprev = ec; }
}
__device__ __forceinline__ void chain_consts_lds(Frame& F, LAS float* cst, int li, int h, int t256) {
    for (int i = t256; i < 12 * 64; i += 256) { const int k = i >> 6, j = i & 63, ch = 64 * h + j; float v;
        if (k == 0) v = inp(I_KK)[li * RW + ch]; else if (k == 1) v = inp(I_KA)[li * RW + ch]; else if (k == 2) v = inp(I_RK)[li * RW + ch];
        else { const int tt = (k - 3) / 3, w = (k - 3) % 3; v = inp(I_CONV)[(size_t)(li * 3 + tt) * (3 * RW) + w * RW + ch]; }
        cst[i] = v; }
}
struct PrepRaw { v4u ecw, icv, epw, zr[3], zk[3], zv[3]; };
__device__ __forceinline__ void prep_load(Frame& F, PrepRaw& R, int dir, int b, int h, int tl, int o, bool isctx, int step0) {
    const int L = isctx ? CTX : SEQ, rbase = isctx ? TL + b * CTX : b * SEQ, ch0 = 64 * h + 8 * o;
    const int s = step0 + tl; const int p = dir ? L - 1 - s : s; const int row = rbase + p, tb = tl & 15;
    { const bf16* LW = (const bf16*)(F.ws + WS_LW) + (size_t)dir * TT * RW + ch0; const bf16* IC = (const bf16*)(F.ws + WS_IC) + (size_t)dir * TT * RW + ch0;
      R.ecw = *(const v4u*)(LW + (size_t)row * RW); R.icv = *(const v4u*)(IC + (size_t)row * RW); R.epw = *(const v4u*)(LW + (size_t)(tb == 0 ? row : (dir ? row + 1 : row - 1)) * RW); }
#pragma unroll
    for (int tt = 0; tt < 3; ++tt) { const int pp = p + tt - 1; const bool ok = pp >= 0 && pp < L; const bf16* z = zrow(F, rbase + (ok ? pp : p)) + ch0;
        const v4u z0 = {0u, 0u, 0u, 0u};
        R.zr[tt] = ok ? *(const v4u*)(z + ZRR) : z0; R.zk[tt] = ok ? *(const v4u*)(z + ZRK) : z0; R.zv[tt] = ok ? *(const v4u*)(z + ZRV) : z0; }
}
__device__ __forceinline__ void prep_compute(Frame& F, const PrepRaw& R, const LAS float* cst, LAS unsigned char* img, int dir, int b, int h, int tl, int o, bool isctx, int step0, LAS unsigned char* lds_vb, LAS float* lds_bon, int pos0_local) {
    const bool BONUS = lds_vb != nullptr;
    const int L = isctx ? CTX : SEQ, rbase = isctx ? TL + b * CTX : b * SEQ, ch0 = 64 * h + 8 * o;
    const int blk = tl >> 4, tb = tl & 15;
    const int s = step0 + tl; const int p = dir ? L - 1 - s : s; const int row = rbase + p;
    const v4u ecw = R.ecw, icv = R.icv, epw = R.epw;
    v4u zr[3], zk[3], zv[3];
#pragma unroll
    for (int tt = 0; tt < 3; ++tt) { zr[tt] = R.zr[tt]; zk[tt] = R.zk[tt]; zv[tt] = R.zv[tt]; }
    float ecf[8], epf[8], ai[8], rv[8], kv[8], vv[8];
    unpack8(ecw, ecf); unpack8(epw, epf); unpack8(icv, ai);
#pragma unroll
    for (int e = 0; e < 8; ++e) { rv[e] = 0.f; kv[e] = 0.f; vv[e] = 0.f; }
#pragma unroll
    for (int tt = 0; tt < 3; ++tt) { float a[8], bq[8], cq[8]; unpack8(zr[tt], a); unpack8(zk[tt], bq); unpack8(zv[tt], cq);
        const LAS f32x4* w0 = (const LAS f32x4*)(cst + (3 + tt * 3 + 0) * 64 + 8 * o); const LAS f32x4* w1 = (const LAS f32x4*)(cst + (3 + tt * 3 + 1) * 64 + 8 * o); const LAS f32x4* w2 = (const LAS f32x4*)(cst + (3 + tt * 3 + 2) * 64 + 8 * o);
        const f32x4 w0a = w0[0], w0b = w0[1], w1a = w1[0], w1b = w1[1], w2a = w2[0], w2b = w2[1];
#pragma unroll
        for (int e = 0; e < 4; ++e) { rv[e] += w0a[e] * a[e]; rv[e + 4] += w0b[e] * a[e + 4]; kv[e] += w1a[e] * bq[e]; kv[e + 4] += w1b[e] * bq[e + 4]; vv[e] += w2a[e] * cq[e]; vv[e + 4] += w2b[e] * cq[e + 4]; } }
    float kkw[8], kaw[8];
    { const LAS f32x4* a = (const LAS f32x4*)(cst + 0 * 64 + 8 * o); const LAS f32x4* bq = (const LAS f32x4*)(cst + 1 * 64 + 8 * o); const f32x4 a0 = a[0], a1 = a[1], b0 = bq[0], b1 = bq[1];
#pragma unroll
      for (int e = 0; e < 4; ++e) { kkw[e] = a0[e]; kkw[e + 4] = a1[e]; kaw[e] = b0[e]; kaw[e + 4] = b1[e]; } }
    float kkr[8], ss = 0.f;
#pragma unroll
    for (int e = 0; e < 8; ++e) { kkr[e] = kv[e] * kkw[e]; ss += kkr[e] * kkr[e]; }
    ss += __shfl_xor(ss, 1); ss += __shfl_xor(ss, 2); ss += __shfl_xor(ss, 4);
    const float rn = 1.0f / sqrtf(fmaxf(ss, 1e-24f));
    float At[8], Rt[8], Bt[8], Kt[8];
#pragma unroll
    for (int e = 0; e < 8; ++e) { const float kk = kkr[e] * rn, kd = kv[e] * (1.0f + (ai[e] - 1.0f) * kaw[e]); const float eprev = tb == 0 ? 1.0f : epf[e]; const float ec = ecf[e], en = 1.0f / ec;
        At[e] = -kk * eprev; Rt[e] = rv[e] * ec; Bt[e] = kk * ai[e] * en; Kt[e] = kd * en; }
    const int P0 = 32 * (o >> 2) + 16 * (o & 1) + 4 * ((o >> 1) & 1);
    LAS bf16* AI = (LAS bf16*)(img + IM_AI) + blk * 1152 + tb * 72 + P0, *RI = (LAS bf16*)(img + IM_RI) + blk * 1152 + tb * 72 + P0, *BI = (LAS bf16*)(img + IM_BI) + blk * 1152 + tb * 72 + P0, *KI = (LAS bf16*)(img + IM_KI) + blk * 1152 + tb * 72 + P0;
    unsigned bp[4], kp[4];
#pragma unroll
    for (int e = 0; e < 4; ++e) { bp[e] = cvtpk(Bt[2 * e], Bt[2 * e + 1]); kp[e] = cvtpk(Kt[2 * e], Kt[2 * e + 1]); }
    *(LAS v2u*)AI = (v2u){cvtpk(At[0], At[1]), cvtpk(At[2], At[3])}; *(LAS v2u*)(AI + 8) = (v2u){cvtpk(At[4], At[5]), cvtpk(At[6], At[7])};
    *(LAS v2u*)RI = (v2u){cvtpk(Rt[0], Rt[1]), cvtpk(Rt[2], Rt[3])}; *(LAS v2u*)(RI + 8) = (v2u){cvtpk(Rt[4], Rt[5]), cvtpk(Rt[6], Rt[7])};
    *(LAS v2u*)BI = (v2u){bp[0], bp[1]}; *(LAS v2u*)(BI + 8) = (v2u){bp[2], bp[3]};
    *(LAS v2u*)KI = (v2u){kp[0], kp[1]}; *(LAS v2u*)(KI + 8) = (v2u){kp[2], kp[3]};
    LAS bf16* BKT = (LAS bf16*)(img + IM_BKT) + blk * 2560 + (8 * o) * 40 + (tb >> 2) * 8 + (tb & 3); LAS bf16* VT = (LAS bf16*)(img + IM_VT) + blk * 1280 + (8 * o) * 20 + tb;
    const unsigned vp[4] = {cvtpk(vv[0], vv[1]), cvtpk(vv[2], vv[3]), cvtpk(vv[4], vv[5]), cvtpk(vv[6], vv[7])};
#pragma unroll
    for (int e = 0; e < 8; ++e) { const unsigned bb = bp[e >> 1], kq = kp[e >> 1], vq = vp[e >> 1];
        BKT[e * 40] = (bf16)((e & 1) ? (bb >> 16) : (bb & 0xffff)); BKT[e * 40 + 4] = (bf16)((e & 1) ? (kq >> 16) : (kq & 0xffff)); VT[e * 20] = (bf16)((e & 1) ? (vq >> 16) : (vq & 0xffff)); }
    if (tb == 15) { const f32x4* gs = (const f32x4*)((const float*)(F.ws + WS_GAM32) + ((size_t)dir * (TT / 16) + (row >> 4)) * RW + ch0); LAS f32x4* G = (LAS f32x4*)((LAS float*)(img + IM_GAM) + blk * 64 + 8 * o); G[0] = gs[0]; G[1] = gs[1]; }
    if (BONUS) { float bs = 0.f; const LAS f32x4* rk = (const LAS f32x4*)(cst + 2 * 64 + 8 * o); const f32x4 r0 = rk[0], r1 = rk[1];
#pragma unroll
        for (int e = 0; e < 4; ++e) bs += rv[e] * kv[e] * r0[e] + rv[e + 4] * kv[e + 4] * r1[e];
        bs += __shfl_xor(bs, 1); bs += __shfl_xor(bs, 2); bs += __shfl_xor(bs, 4);
        const int pl = dir ? pos0_local - tl : pos0_local + tl;
        *(LAS v4u*)(lds_vb + (pl * 64 + 8 * o) * 2) = (v4u){vp[0], vp[1], vp[2], vp[3]}; if (o == 0) lds_bon[pl] = bs; }
}
template <bool WANT_Y>
__device__ __forceinline__ void block_package(LAS unsigned char* img, int blk, LAS unsigned* pkg, int lane) {
    const int q = lane >> 4, c = lane & 15;
    f32x4 mab = {0.f, 0.f, 0.f, 0.f}, mak = mab, mbr = mab, mkr = mab;
#pragma unroll
    for (int k = 0; k < 2; ++k) { const int o = blk * 2304 + c * 144 + k * 64 + q * 16;
        const bf16x8 bi = *(const LAS bf16x8*)(img + IM_BI + o), ki = *(const LAS bf16x8*)(img + IM_KI + o), ai = *(const LAS bf16x8*)(img + IM_AI + o);
        mab = MFMA16(bi, ai, mab); mak = MFMA16(ki, ai, mak);
        if constexpr (WANT_Y) { const bf16x8 ri = *(const LAS bf16x8*)(img + IM_RI + o); mbr = MFMA16(bi, ri, mbr); mkr = MFMA16(ki, ri, mkr); } }
#pragma unroll
    for (int e = 0; e < 4; ++e) { const int s = 4 * q + e; if (!(s < c)) { mab[e] = 0.f; mak[e] = 0.f; } if (!(s <= c)) { mbr[e] = 0.f; mkr[e] = 0.f; } }
    f32x4 mabT = {0.f, 0.f, 0.f, 0.f};
#pragma unroll
    for (int k = 0; k < 2; ++k) { const int o = blk * 2304 + c * 144 + k * 64 + q * 16; mabT = MFMA16(*(const LAS bf16x8*)(img + IM_AI + o), *(const LAS bf16x8*)(img + IM_BI + o), mabT); }
#pragma unroll
    for (int e = 0; e < 4; ++e) if (!(c < 4 * q + e)) mabT[e] = 0.f;
    const f32x4 z4 = {0.f, 0.f, 0.f, 0.f};
#define OPND(x) mk8(cvtpk((x)[0], (x)[1]), cvtpk((x)[2], (x)[3]), 0u, 0u)
    const bf16x8 oM = OPND(mab), oMT = OPND(mabT);
    const f32x4 m2 = MFMA16(oMT, oM, z4), m2T = MFMA16(oM, oMT, z4);
    const bf16x8 oM2 = OPND(m2), oM2T = OPND(m2T);
    const f32x4 m4 = MFMA16(oM2T, oM2, z4), m4T = MFMA16(oM2, oM2T, z4);
    const f32x4 m8T = MFMA16(OPND(m4), OPND(m4T), z4);
    f32x4 nn = m2;
#pragma unroll
    for (int e = 0; e < 4; ++e) nn[e] += (4 * q + e == c) ? 1.0f : 0.0f;
    nn = MFMA16(oMT, OPND(nn), nn);
    nn = MFMA16(OPND(m4T), OPND(nn), nn);
    nn = MFMA16(OPND(m8T), OPND(nn), nn);
#undef OPND
    pkg[0 * 64 + lane] = cvtpk(nn[0], nn[1]); pkg[1 * 64 + lane] = cvtpk(nn[2], nn[3]);
    pkg[2 * 64 + lane] = cvtpk(mak[0], mak[1]); pkg[3 * 64 + lane] = cvtpk(mak[2], mak[3]);
    if constexpr (WANT_Y) { pkg[4 * 64 + lane] = cvtpk(mbr[0], mbr[1]); pkg[5 * 64 + lane] = cvtpk(mbr[2], mbr[3]); pkg[6 * 64 + lane] = cvtpk(mkr[0], mkr[1]); pkg[7 * 64 + lane] = cvtpk(mkr[2], mkr[3]); }
}
template <bool WANT_Y, bool HAS_V>
__device__ __forceinline__ f32x4 block_scan(LAS unsigned char* img, int blk, const LAS unsigned* pkg, f32x4 (&S)[4], int wq, int lane) {
    const int q = lane >> 4, c = lane & 15;
    bf16x8 Sb[2];
#pragma unroll
    for (int k = 0; k < 2; ++k) Sb[k] = mk8(cvtpk(S[2 * k][0], S[2 * k][1]), cvtpk(S[2 * k][2], S[2 * k][3]), cvtpk(S[2 * k + 1][0], S[2 * k + 1][1]), cvtpk(S[2 * k + 1][2], S[2 * k + 1][3]));
    v2u vpk = {0u, 0u};
    if constexpr (HAS_V) vpk = *(const LAS v2u*)(img + IM_VT + blk * 2560 + (c + 16 * wq) * 40 + q * 8);
    const int ao = blk * 2304 + c * 144 + q * 16;
    f32x4 rhs = {0.f, 0.f, 0.f, 0.f};
    rhs = MFMA16(*(const LAS bf16x8*)(img + IM_AI + ao), Sb[0], rhs); rhs = MFMA16(*(const LAS bf16x8*)(img + IM_AI + ao + 64), Sb[1], rhs);
    if constexpr (HAS_V) rhs = MFMA16(mk8(0u, 0u, pkg[2 * 64 + lane], pkg[3 * 64 + lane]), mk8(0u, 0u, vpk.x, vpk.y), rhs);
    f32x4 u = {0.f, 0.f, 0.f, 0.f};
    u = MFMA16(mk8(pkg[0 * 64 + lane], pkg[1 * 64 + lane], 0u, 0u), mk8(cvtpk(rhs[0], rhs[1]), cvtpk(rhs[2], rhs[3]), 0u, 0u), u);
    const bf16x8 UV = mk8(cvtpk(u[0], u[1]), cvtpk(u[2], u[3]), vpk.x, vpk.y);
    f32x4 y = {0.f, 0.f, 0.f, 0.f};
    if constexpr (WANT_Y) { y = MFMA16(*(const LAS bf16x8*)(img + IM_RI + ao), Sb[0], y); y = MFMA16(*(const LAS bf16x8*)(img + IM_RI + ao + 64), Sb[1], y);
        y = MFMA16(mk8(pkg[4 * 64 + lane], pkg[5 * 64 + lane], pkg[6 * 64 + lane], pkg[7 * 64 + lane]), UV, y); }
#pragma unroll
    for (int T = 0; T < 4; ++T) { const bf16x8 bkt = *(const LAS bf16x8*)(img + IM_BKT + blk * 5120 + (16 * T + c) * 80 + q * 16);
        S[T] = MFMA16(bkt, UV, S[T]); const f32x4 g = *(const LAS f32x4*)(img + IM_GAM + blk * 256 + (16 * T + 4 * q) * 4); S[T] = S[T] * g; }
    return y;
}
__device__ __forceinline__ unsigned char* sum_slot(Frame& F, int chain, int sc) { return F.ws + WS_SUM + (size_t)(chain * NSC + sc) * SUM_SLOT; }

__device__ __forceinline__ void rwkv_pass1_unit(Frame& F, int li, int u) {
    const int chain = u / (NSC - 1), sc = u % (NSC - 1);
    const int dir = chain / 12, b = (chain / 6) & 1, h = chain % 6;
    const bool isctx = sc < 2; const int scl = isctx ? sc : sc - 2;
    LAS unsigned char* img = F.lds + L_IMG0; LAS unsigned* pkg = (LAS unsigned*)(F.lds + L_PKG);
    LAS float* cst = (LAS float*)(F.lds + L_CST);
    __syncthreads();
    if (F.tid < 256) chain_consts_lds(F, cst, li, h, F.tid);
    const int q = F.lane >> 4, c = F.lane & 15, wq = F.wave & 3; const bool isA = F.wave >= 4;
    f32x4 S[4];
#pragma unroll
    for (int T = 0; T < 4; ++T)
#pragma unroll
        for (int e = 0; e < 4; ++e) S[T][e] = (isA && (16 * T + 4 * q + e == c + 16 * wq)) ? 1.0f : 0.0f;
    PrepRaw R;
    if (F.wave < 4) prep_load(F, R, dir, b, h, 8 * F.wave + (F.lane >> 3), F.lane & 7, isctx, 128 * scl);
#pragma unroll 1
    for (int rd = 0; rd < 4; ++rd) {
        __syncthreads();
        if (F.wave < 4) prep_compute(F, R, cst, img, dir, b, h, 8 * F.wave + (F.lane >> 3), F.lane & 7, isctx, 128 * scl + 32 * rd, nullptr, nullptr, 0);
        __syncthreads();
        if (F.wave < 4 && rd < 3) prep_load(F, R, dir, b, h, 8 * F.wave + (F.lane >> 3), F.lane & 7, isctx, 128 * scl + 32 * (rd + 1));
        if (F.wave < 2) block_package<false>(img, F.wave, pkg + F.wave * 512, F.lane);
        __syncthreads();
#pragma unroll
        for (int blk = 0; blk < 2; ++blk) { if (isA) block_scan<false, false>(img, blk, pkg + blk * 512, S, wq, F.lane); else block_scan<false, true>(img, blk, pkg + blk * 512, S, wq, F.lane); }
    }
    unsigned char* slot = sum_slot(F, chain, sc);
    if (!isA) { f32x4* braw = (f32x4*)slot;
#pragma unroll
        for (int T = 0; T < 4; ++T) braw[(wq * 4 + T) * 64 + F.lane] = S[T]; }
    else { bf16* aim = (bf16*)(slot + 16384); const int kap = wq >> 1, e = (F.lane & 3) + 4 * (wq & 1), qc = c >> 2;
#pragma unroll
        for (int T = 0; T < 4; ++T)
#pragma unroll
            for (int r = 0; r < 4; ++r) { const int lc = (4 * q + r) + 16 * qc; aim[((T * 2 + kap) * 64 + lc) * 8 + e] = (bf16)f2bf(S[T][r]); } }
}
__device__ __forceinline__ void rwkv_pass2_chain(Frame& F, int chain) {
    if (F.wave >= 4) return;
    const int wq = F.wave;
    f32x4 S[4];
#pragma unroll
    for (int T = 0; T < 4; ++T) S[T] = (f32x4){0.f, 0.f, 0.f, 0.f};
    f32x4 Bc[4]; bf16x8 af[4][2];
    { unsigned char* slot = sum_slot(F, chain, 0); const f32x4* braw = (const f32x4*)slot; const bf16* aim = (const bf16*)(slot + 16384);
#pragma unroll
      for (int T = 0; T < 4; ++T) { Bc[T] = braw[(wq * 4 + T) * 64 + F.lane];
#pragma unroll
          for (int k = 0; k < 2; ++k) af[T][k] = *(const bf16x8*)(aim + ((T * 2 + k) * 64 + F.lane) * 8); } }
#pragma unroll 1
    for (int sc = 0; sc < NSC - 1; ++sc) {
        f32x4* braw = (f32x4*)sum_slot(F, chain, sc);
        f32x4 Bn[4]; bf16x8 an[4][2];
        if (sc + 1 < NSC - 1) { unsigned char* slot = sum_slot(F, chain, sc + 1); const f32x4* bq = (const f32x4*)slot; const bf16* aim = (const bf16*)(slot + 16384);
#pragma unroll
            for (int T = 0; T < 4; ++T) { Bn[T] = bq[(wq * 4 + T) * 64 + F.lane];
#pragma unroll
                for (int k = 0; k < 2; ++k) an[T][k] = *(const bf16x8*)(aim + ((T * 2 + k) * 64 + F.lane) * 8); } }
        else {
#pragma unroll
            for (int T = 0; T < 4; ++T) { Bn[T] = Bc[T]; an[T][0] = af[T][0]; an[T][1] = af[T][1]; } }
        bf16x8 Sb[2];
#pragma unroll
        for (int k = 0; k < 2; ++k) Sb[k] = mk8(cvtpk(S[2 * k][0], S[2 * k][1]), cvtpk(S[2 * k][2], S[2 * k][3]), cvtpk(S[2 * k + 1][0], S[2 * k + 1][1]), cvtpk(S[2 * k + 1][2], S[2 * k + 1][3]));
#pragma unroll
        for (int T = 0; T < 4; ++T) { braw[(wq * 4 + T) * 64 + F.lane] = S[T]; f32x4 a = MFMA16(af[T][0], Sb[0], Bc[T]); S[T] = MFMA16(af[T][1], Sb[1], a); }
#pragma unroll
        for (int T = 0; T < 4; ++T) { Bc[T] = Bn[T]; af[T][0] = an[T][0]; af[T][1] = an[T][1]; }
    }
    { f32x4* braw = (f32x4*)sum_slot(F, chain, NSC - 1);
#pragma unroll
      for (int T = 0; T < 4; ++T) braw[(wq * 4 + T) * 64 + F.lane] = S[T]; }
}
__device__ __forceinline__ void rwkv_pass3_unit(Frame& F, int li, int u) {
    const int pc = u % NSC, bh = u / NSC, b = bh / 6, h = bh % 6;
    const bool isctx = pc < 2; const int pcl = isctx ? pc : pc - 2, nsc = isctx ? 2 : 64;
    const int dir = F.wave >> 2, wq = F.wave & 3, q = F.lane >> 4, c = F.lane & 15;
    const int sc = dir == 0 ? pc : (isctx ? 1 - pcl : 2 + 63 - pcl);
    const int scl = dir == 0 ? pcl : nsc - 1 - pcl;
    const int chain = dir * 12 + b * 6 + h;
    LAS unsigned char* img = F.lds + (dir ? L_IMG1 : L_IMG0); LAS unsigned* pkg = (LAS unsigned*)(F.lds + L_PKG) + dir * 1024;
    LAS float* YL = (LAS float*)(F.lds + L_YL); LAS unsigned char* VB = F.lds + L_VB; LAS float* BON = (LAS float*)(F.lds + L_BON);
    LAS float* cst = (LAS float*)(F.lds + L_CST);
    __syncthreads();
    if (F.tid < 256) chain_consts_lds(F, cst, li, h, F.tid);
    f32x4 S[4];
    { const f32x4* braw = (const f32x4*)sum_slot(F, chain, sc);
#pragma unroll
      for (int T = 0; T < 4; ++T) S[T] = braw[(wq * 4 + T) * 64 + F.lane]; }
    __syncthreads();
    for (int i = F.tid; i < 128 * 68; i += NTHR) YL[i] = 0.f;
    PrepRaw R;
    prep_load(F, R, dir, b, h, 8 * wq + (F.lane >> 3), F.lane & 7, isctx, 128 * scl);
#pragma unroll 1
    for (int rd = 0; rd < 4; ++rd) {
        __syncthreads();
        prep_compute(F, R, cst, img, dir, b, h, 8 * wq + (F.lane >> 3), F.lane & 7, isctx, 128 * scl + 32 * rd, dir == 0 ? VB : (LAS unsigned char*)nullptr, BON, 32 * rd);
        __syncthreads();
        if (rd < 3) prep_load(F, R, dir, b, h, 8 * wq + (F.lane >> 3), F.lane & 7, isctx, 128 * scl + 32 * (rd + 1));
        if (wq < 2) block_package<true>(img, wq, pkg + wq * 512, F.lane);
        __syncthreads();
#pragma unroll
        for (int blk = 0; blk < 2; ++blk) { const f32x4 y = block_scan<true, true>(img, blk, pkg + blk * 512, S, wq, F.lane);
#pragma unroll
            for (int e = 0; e < 4; ++e) { const int t = 32 * rd + 16 * blk + 4 * q + e; const int pl = dir ? 127 - t : t; YL[pl * 68 + c + 16 * wq] += y[e]; } }
    }
    __syncthreads();
    const int wv = F.wave; const int rbase = (isctx ? TL + b * CTX : b * SEQ) + 128 * pcl;
    const bf16* g2t = (const bf16*)(F.ws + WS_G2T) + (size_t)li * 384 * 128;
    f32x4 gate[4];
#pragma unroll
    for (int nt = 0; nt < 4; ++nt) gate[nt] = (f32x4){0.f, 0.f, 0.f, 0.f};
#pragma unroll
    for (int k = 0; k < 4; ++k) { const v4u zg = *(const v4u*)(zrow(F, rbase + 16 * wv + c) + ZG + 32 * k + 8 * q);
#define SG(x) (1.0f / (1.0f + __expf(-(x))))
        const bf16x8 a = mk8(pk2(SG(bflo(zg.x)), SG(bfhi(zg.x))), pk2(SG(bflo(zg.y)), SG(bfhi(zg.y))), pk2(SG(bflo(zg.z)), SG(bfhi(zg.z))), pk2(SG(bflo(zg.w)), SG(bfhi(zg.w))));
#undef SG
#pragma unroll
        for (int nt = 0; nt < 4; ++nt) { const bf16x8 bb = *(const bf16x8*)(g2t + (size_t)(64 * h + 16 * nt + c) * 128 + 32 * k + 8 * q); gate[nt] = MFMA16(a, bb, gate[nt]); } }
    bf16* mix = (bf16*)(F.ws + WS_H);
    float lg[4], lb[4];
#pragma unroll
    for (int nt = 0; nt < 4; ++nt) { lg[nt] = inp(I_LNG)[li * RW + 64 * h + 16 * nt + c]; lb[nt] = inp(I_LNB)[li * RW + 64 * h + 16 * nt + c]; }
#pragma unroll
    for (int e = 0; e < 4; ++e) { const int tl = 16 * wv + 4 * q + e;
        float yv[4], s = 0.f;
#pragma unroll
        for (int nt = 0; nt < 4; ++nt) { yv[nt] = YL[tl * 68 + 16 * nt + c]; s += yv[nt]; }
        s += __shfl_xor(s, 1); s += __shfl_xor(s, 2); s += __shfl_xor(s, 4); s += __shfl_xor(s, 8);
        const float mu = s * (1.0f / 64.0f); float v2 = 0.f;
#pragma unroll
        for (int nt = 0; nt < 4; ++nt) { yv[nt] -= mu; v2 += yv[nt] * yv[nt]; }
        v2 += __shfl_xor(v2, 1); v2 += __shfl_xor(v2, 2); v2 += __shfl_xor(v2, 4); v2 += __shfl_xor(v2, 8);
        const float rs = 1.0f / sqrtf(v2 * (1.0f / 64.0f) + GN_EPS); const float bon = BON[tl];
#pragma unroll
        for (int nt = 0; nt < 4; ++nt) { const float vv = bf2f(((const LAS bf16*)VB)[tl * 64 + 16 * nt + c]);
            const float o = (yv[nt] * rs * lg[nt] + lb[nt] + bon * vv) * gate[nt][e];
            mix[(size_t)(rbase + tl) * DM + 640 + 64 * h + 16 * nt + c] = (bf16)f2bf(o); } }
}

constexpr int AT_KROW = 144;
__device__ __forceinline__ void attn_unit(Frame& F, int li, int u) {
    const bool cq = u >= 256;
    int b, kvh, qb;
    if (!cq) { b = u >> 7; kvh = (u >> 6) & 1; qb = u & 63; } else { const int uu = u - 256; b = uu >> 2; kvh = (uu >> 1) & 1; qb = uu & 1; }
    const int c = F.lane & 15, q = F.lane >> 4, tb = F.wave;
    const bf16* qr = (const bf16*)(F.ws + WS_QR); const bf16* kr = (const bf16*)(F.ws + WS_KR); bf16* mix = (bf16*)(F.ws + WS_H);
    const int qrow = (cq ? TL + b * CTX : b * SEQ) + 128 * qb + 16 * tb + c;
    const int qpos = 128 * qb + 16 * tb + c;
    bf16x8 Q[3][2];
#pragma unroll
    for (int hh = 0; hh < 3; ++hh)
#pragma unroll
        for (int k = 0; k < 2; ++k) {
            if (!cq) Q[hh][k] = *(const bf16x8*)(qr + (size_t)qrow * 384 + 64 * (3 * kvh + hh) + 32 * k + 8 * q);
            else { const v4u w = *(const v4u*)(zrow(F, qrow) + ZQ + 64 * (3 * kvh + hh) + 32 * k + 8 * q);
                Q[hh][k] = mk8(pk2(0.125f * bflo(w.x), 0.125f * bfhi(w.x)), pk2(0.125f * bflo(w.y), 0.125f * bfhi(w.y)), pk2(0.125f * bflo(w.z), 0.125f * bfhi(w.z)), pk2(0.125f * bflo(w.w), 0.125f * bfhi(w.w))); } }
    float m[3], l[3]; f32x4 O[3][4];
#pragma unroll
    for (int hh = 0; hh < 3; ++hh) { m[hh] = inp(I_SINK)[li * 6 + 3 * kvh + hh]; l[hh] = q == 0 ? 1.0f : 0.0f;
#pragma unroll
        for (int dt = 0; dt < 4; ++dt) O[hh][dt] = (f32x4){0.f, 0.f, 0.f, 0.f}; }
    LAS unsigned char* KI = F.lds;
#pragma unroll 1
    for (int stage = cq ? 1 : 0; stage < 2; ++stage) {
        const int nkeys = stage == 0 ? 384 : 256; const int vstride = (nkeys + 8) * 2;
        LAS unsigned char* VTI = F.lds + 384 * AT_KROW;
        const int kpos0 = 128 * (qb - 1);
        __syncthreads();
        for (int pc = F.tid; pc < nkeys * 8; pc += NTHR) { const int key = pc >> 3, d8 = pc & 7;
            const bf16* ksrc; const bf16* vsrc;
            if (stage == 0) { int kp = kpos0 + key; kp = kp < 0 ? 0 : (kp >= SEQ ? SEQ - 1 : kp); ksrc = kr + (size_t)(b * SEQ + kp) * 128 + 64 * kvh; vsrc = zrow(F, b * SEQ + kp) + ZV + 64 * kvh; }
            else { const bf16* z = zrow(F, TL + b * CTX + key); ksrc = z + ZK + 64 * kvh; vsrc = z + ZV + 64 * kvh; }
            const v4u kv = *(const v4u*)(ksrc + 8 * d8); const v4u vv = *(const v4u*)(vsrc + 8 * d8);
            *(LAS v4u*)(KI + key * AT_KROW + d8 * 16) = kv;
            const int kl = key & 31; const int col = (key & ~31) | (((kl & 15) >> 2) << 3) | ((kl >> 4) << 2) | (kl & 3);
            LAS bf16* vt = (LAS bf16*)(VTI + (8 * d8) * vstride) + col;
            vt[0] = (bf16)(vv.x & 0xffff); *(LAS bf16*)((LAS unsigned char*)vt + vstride) = (bf16)(vv.x >> 16);
            *(LAS bf16*)((LAS unsigned char*)vt + 2 * vstride) = (bf16)(vv.y & 0xffff); *(LAS bf16*)((LAS unsigned char*)vt + 3 * vstride) = (bf16)(vv.y >> 16);
            *(LAS bf16*)((LAS unsigned char*)vt + 4 * vstride) = (bf16)(vv.z & 0xffff); *(LAS bf16*)((LAS unsigned char*)vt + 5 * vstride) = (bf16)(vv.z >> 16);
            *(LAS bf16*)((LAS unsigned char*)vt + 6 * vstride) = (bf16)(vv.w & 0xffff); *(LAS bf16*)((LAS unsigned char*)vt + 7 * vstride) = (bf16)(vv.w >> 16); }
        __syncthreads();
        const int npair = nkeys / 32;
        const int Q0 = 128 * qb + 16 * tb;
#pragma unroll 1
        for (int kp = 0; kp < npair; ++kp) {
            const int kb = kpos0 + 32 * kp;
            if (stage == 0 && (kb + 31 < Q0 - 128 || kb > Q0 + 143 || kb + 31 < 0 || kb >= SEQ)) continue;
            bf16x8 K[2][2], V[4];
#pragma unroll
            for (int t = 0; t < 2; ++t)
#pragma unroll
                for (int k = 0; k < 2; ++k) K[t][k] = *(const LAS bf16x8*)(KI + (32 * kp + 16 * t + c) * AT_KROW + k * 64 + q * 16);
#pragma unroll
            for (int dt = 0; dt < 4; ++dt) V[dt] = *(const LAS bf16x8*)(VTI + (16 * dt + c) * vstride + kp * 64 + q * 16);
            bool ok0[4], ok1[4];
#pragma unroll
            for (int e = 0; e < 4; ++e) { const int k0 = kb + 4 * q + e, k1 = k0 + 16;
                ok0[e] = stage == 1 || (k0 >= 0 && k0 < SEQ && k0 >= qpos - 128 && k0 <= qpos + 128);
                ok1[e] = stage == 1 || (k1 >= 0 && k1 < SEQ && k1 >= qpos - 128 && k1 <= qpos + 128); }
#pragma unroll
            for (int hh = 0; hh < 3; ++hh) {
                f32x4 s0 = {0.f, 0.f, 0.f, 0.f}, s1 = {0.f, 0.f, 0.f, 0.f};
                s0 = MFMA16(K[0][0], Q[hh][0], s0); s0 = MFMA16(K[0][1], Q[hh][1], s0);
                s1 = MFMA16(K[1][0], Q[hh][0], s1); s1 = MFMA16(K[1][1], Q[hh][1], s1);
                float mx = -INFINITY;
#pragma unroll
                for (int e = 0; e < 4; ++e) { s0[e] = ok0[e] ? s0[e] : -INFINITY; s1[e] = ok1[e] ? s1[e] : -INFINITY; mx = fmaxf(mx, fmaxf(s0[e], s1[e])); }
                mx = fmaxf(mx, __shfl_xor(mx, 16)); mx = fmaxf(mx, __shfl_xor(mx, 32));
                const float mn = fmaxf(m[hh], mx); const float alpha = __expf(m[hh] - mn); m[hh] = mn;
                float ps = 0.f;
#pragma unroll
                for (int e = 0; e < 4; ++e) { s0[e] = __expf(s0[e] - mn); s1[e] = __expf(s1[e] - mn); ps += s0[e] + s1[e]; }
                l[hh] = l[hh] * alpha + ps;
                const bf16x8 P = mk8(cvtpk(s0[0], s0[1]), cvtpk(s0[2], s0[3]), cvtpk(s1[0], s1[1]), cvtpk(s1[2], s1[3]));
#pragma unroll
                for (int dt = 0; dt < 4; ++dt) { O[hh][dt] = O[hh][dt] * alpha; O[hh][dt] = MFMA16(V[dt], P, O[hh][dt]); }
            }
        }
    }
#pragma unroll
    for (int hh = 0; hh < 3; ++hh) { float lt = l[hh]; lt += __shfl_xor(lt, 16); lt += __shfl_xor(lt, 32); const float inv = 1.0f / lt;
#pragma unroll
        for (int dt = 0; dt < 4; ++dt) { v2u w; w.x = pk2(O[hh][dt][0] * inv, O[hh][dt][1] * inv); w.y = pk2(O[hh][dt][2] * inv, O[hh][dt][3] * inv);
            *(v2u*)(mix + (size_t)qrow * DM + 256 + 64 * (3 * kvh + hh) + 16 * dt + 4 * q) = w; } }
}

__device__ __forceinline__ void fourier_tables(Frame& F) {
    bf16* t = (bf16*)(F.ws + WS_FT);
    for (int i = F.bid * NTHR + F.tid; i < 64 * 64; i += F.G * NTHR) { const int r = i >> 6, cc = i & 63; const float a = (float)((r * cc) & 63) * (1.0f / 64.0f);
        const float cs = __builtin_amdgcn_cosf(a), sn = __builtin_amdgcn_sinf(a);
        t[FT_W64C / 2 + i] = (bf16)f2bf(cs); t[FT_W64S / 2 + i] = (bf16)f2bf(sn);
        const int pj = (cc & ~31) | (((cc & 15) >> 2) << 3) | (((cc >> 4) & 1) << 2) | (cc & 3);
        t[FT_T64C / 2 + r * 64 + pj] = (bf16)f2bf(cs); t[FT_T64S / 2 + r * 64 + pj] = (bf16)f2bf(sn); }
    for (int i = F.bid * NTHR + F.tid; i < 128 * 128; i += F.G * NTHR) { const int r = i >> 7, cc = i & 127; const float a = (float)((r * cc) & 127) * (1.0f / 128.0f);
        t[FT_W128C / 2 + i] = (bf16)f2bf(__builtin_amdgcn_cosf(a)); t[FT_W128S / 2 + i] = (bf16)f2bf(__builtin_amdgcn_sinf(a)); }
}
__device__ __forceinline__ void fourier_a_fast(Frame& F, int u) {
    const int b = u >> 7, n2 = u & 127, c = F.lane & 15, q = F.lane >> 4;
    LAS unsigned char* IMG = F.lds;
    __syncthreads();
    for (int pc = F.tid; pc < 64 * 32; pc += NTHR) { const int n1 = pc >> 5, c8 = pc & 31;
        const v4u v = *(const v4u*)(zrow(F, b * SEQ + 128 * n1 + n2) + ZF + 8 * c8);
        LAS bf16* d = (LAS bf16*)(IMG + (8 * c8) * 144) + n1;
        d[0] = (bf16)(v.x & 0xffff); d[72] = (bf16)(v.x >> 16); d[144] = (bf16)(v.y & 0xffff); d[216] = (bf16)(v.y >> 16);
        d[288] = (bf16)(v.z & 0xffff); d[360] = (bf16)(v.z >> 16); d[432] = (bf16)(v.w & 0xffff); d[504] = (bf16)(v.w >> 16); }
    __syncthreads();
    const bf16* wc = (const bf16*)(F.ws + WS_FT + FT_W64C); const bf16* wsn = (const bf16*)(F.ws + WS_FT + FT_W64S);
    bf16* far = (bf16*)(F.ws + WS_FA); bf16* fai = far + (size_t)NB * 64 * 128 * 256;
    bf16x8 Bc[4][2], Bs[4][2];
#pragma unroll
    for (int kt = 0; kt < 4; ++kt)
#pragma unroll
        for (int k = 0; k < 2; ++k) { Bc[kt][k] = *(const bf16x8*)(wc + (16 * kt + c) * 64 + 32 * k + 8 * q); Bs[kt][k] = *(const bf16x8*)(wsn + (16 * kt + c) * 64 + 32 * k + 8 * q); }
#pragma unroll
    for (int ci = 0; ci < 2; ++ci) { const int ct = 2 * F.wave + ci;
        bf16x8 A[2];
#pragma unroll
        for (int k = 0; k < 2; ++k) A[k] = *(const LAS bf16x8*)(IMG + (16 * ct + c) * 144 + k * 64 + q * 16);
#pragma unroll
        for (int kt = 0; kt < 4; ++kt) { f32x4 sr = {0.f, 0.f, 0.f, 0.f}, si = {0.f, 0.f, 0.f, 0.f};
#pragma unroll
            for (int k = 0; k < 2; ++k) { sr = MFMA16(A[k], Bc[kt][k], sr); si = MFMA16(A[k], Bs[kt][k], si); }
            const int k1 = 16 * kt + c; const float tw = (float)(n2 * k1) * (1.0f / 8192.0f); const float tc = __builtin_amdgcn_cosf(tw), ts = __builtin_amdgcn_sinf(tw);
            float xr[4], xi[4];
#pragma unroll
            for (int e = 0; e < 4; ++e) { const float ar = sr[e], ai = -si[e]; xr[e] = ar * tc + ai * ts; xi[e] = ai * tc - ar * ts; }
            const size_t o = (((size_t)b * 64 + k1) * 128 + n2) * 256 + 16 * ct + 4 * q;
            v2u w; w.x = pk2(xr[0], xr[1]); w.y = pk2(xr[2], xr[3]); *(v2u*)(far + o) = w; w.x = pk2(xi[0], xi[1]); w.y = pk2(xi[2], xi[3]); *(v2u*)(fai + o) = w; } }
}
__device__ __forceinline__ void fourier_c_fast(Frame& F, int u) {
    const int g = u & 3, k1 = (u >> 2) & 63, b = u >> 8, c = F.lane & 15, q = F.lane >> 4;
    LAS unsigned char* IR = F.lds; LAS unsigned char* II = F.lds + 64 * 272;
    const bf16* far = (const bf16*)(F.ws + WS_FA) + (((size_t)b * 64 + k1) * 128) * 256 + 64 * g; const bf16* fai = far + (size_t)NB * 64 * 128 * 256;
    __syncthreads();
    for (int pc = F.tid; pc < 128 * 8; pc += NTHR) { const int n2 = pc >> 3, c8 = pc & 7;
        const v4u vr = *(const v4u*)(far + (size_t)n2 * 256 + 8 * c8), vi = *(const v4u*)(fai + (size_t)n2 * 256 + 8 * c8);
        LAS bf16* dr = (LAS bf16*)(IR + (8 * c8) * 272) + n2; LAS bf16* di = (LAS bf16*)(II + (8 * c8) * 272) + n2;
        dr[0] = (bf16)(vr.x & 0xffff); dr[136] = (bf16)(vr.x >> 16); dr[272] = (bf16)(vr.y & 0xffff); dr[408] = (bf16)(vr.y >> 16);
        dr[544] = (bf16)(vr.z & 0xffff); dr[680] = (bf16)(vr.z >> 16); dr[816] = (bf16)(vr.w & 0xffff); dr[952] = (bf16)(vr.w >> 16);
        di[0] = (bf16)(vi.x & 0xffff); di[136] = (bf16)(vi.x >> 16); di[272] = (bf16)(vi.y & 0xffff); di[408] = (bf16)(vi.y >> 16);
        di[544] = (bf16)(vi.z & 0xffff); di[680] = (bf16)(vi.z >> 16); di[816] = (bf16)(vi.w & 0xffff); di[952] = (bf16)(vi.w >> 16); }
    __syncthreads();
    const bf16* wc = (const bf16*)(F.ws + WS_FT + FT_W128C); const bf16* wsn = (const bf16*)(F.ws + WS_FT + FT_W128S);
    const bf16* tcn = (const bf16*)(F.ws + WS_FT + FT_T64C); const bf16* tsn = (const bf16*)(F.ws + WS_FT + FT_T64S);
    f32x4 Pr[4], Pi[4];
#pragma unroll
    for (int ct = 0; ct < 4; ++ct) { Pr[ct] = (f32x4){0.f, 0.f, 0.f, 0.f}; Pi[ct] = (f32x4){0.f, 0.f, 0.f, 0.f}; }
#pragma unroll
    for (int k = 0; k < 4; ++k) { const bf16x8 bc = *(const bf16x8*)(wc + (16 * F.wave + c) * 128 + 32 * k + 8 * q), bs = *(const bf16x8*)(wsn + (16 * F.wave + c) * 128 + 32 * k + 8 * q);
        const v4u bsu = __builtin_bit_cast(v4u, bs); const bf16x8 bsn = mk8(bsu.x ^ 0x80008000u, bsu.y ^ 0x80008000u, bsu.z ^ 0x80008000u, bsu.w ^ 0x80008000u);
#pragma unroll
        for (int ct = 0; ct < 4; ++ct) { const bf16x8 ar = *(const LAS bf16x8*)(IR + (16 * ct + c) * 272 + k * 64 + q * 16), ai = *(const LAS bf16x8*)(II + (16 * ct + c) * 272 + k * 64 + q * 16);
            Pr[ct] = MFMA16(ar, bc, Pr[ct]); Pr[ct] = MFMA16(ai, bs, Pr[ct]); Pi[ct] = MFMA16(ai, bc, Pi[ct]); Pi[ct] = MFMA16(ar, bsn, Pi[ct]); } }
    bf16x8 Br[2], Bi[2];
#pragma unroll
    for (int k = 0; k < 2; ++k) { Br[k] = mk8(cvtpk(Pr[2 * k][0], Pr[2 * k][1]), cvtpk(Pr[2 * k][2], Pr[2 * k][3]), cvtpk(Pr[2 * k + 1][0], Pr[2 * k + 1][1]), cvtpk(Pr[2 * k + 1][2], Pr[2 * k + 1][3]));
        Bi[k] = mk8(cvtpk(Pi[2 * k][0], Pi[2 * k][1]), cvtpk(Pi[2 * k][2], Pi[2 * k][3]), cvtpk(Pi[2 * k + 1][0], Pi[2 * k + 1][1]), cvtpk(Pi[2 * k + 1][2], Pi[2 * k + 1][3])); }
    bf16* mix = (bf16*)(F.ws + WS_H);
    const float scale = 0.0013810679320049757f;
    const int k2 = 16 * F.wave + c; const size_t row = (size_t)b * SEQ + k1 + 64 * k2;
#pragma unroll
    for (int mt = 0; mt < 4; ++mt) { f32x4 y = {0.f, 0.f, 0.f, 0.f};
#pragma unroll
        for (int k = 0; k < 2; ++k) { const bf16x8 ac = *(const bf16x8*)(tcn + (16 * mt + c) * 64 + 32 * k + 8 * q), as = *(const bf16x8*)(tsn + (16 * mt + c) * 64 + 32 * k + 8 * q);
            y = MFMA16(ac, Br[k], y); y = MFMA16(as, Bi[k], y); }
        v2u w; w.x = pk2(y[0] * scale, y[1] * scale); w.y = pk2(y[2] * scale, y[3] * scale);
        *(v2u*)(mix + row * DM + 64 * g + 16 * mt + 4 * q) = w; }
}

#define XB_TMO      128
#define XB_XCNT(j)  (256  + 64 * (j))
#define XB_XSUB(j)  (1280 + 64 * (j))
#define XB_XGEN(j)  (2304 + 64 * (j))
#define XB_TOP      3328
#define XB_TOPGEN   3392
#define XCD_BAR_WORDS 3456
#define XB_SPIN_CAP (1u << 23)
__device__ __forceinline__ unsigned xb_ld(unsigned* p)              { return __hip_atomic_load(p, __ATOMIC_RELAXED, __HIP_MEMORY_SCOPE_AGENT); }
__device__ __forceinline__ unsigned xb_add(unsigned* p, unsigned v) { return __hip_atomic_fetch_add(p, v, __ATOMIC_RELAXED, __HIP_MEMORY_SCOPE_AGENT); }
__device__ __forceinline__ unsigned xb_xcc_id() { return (unsigned)__builtin_amdgcn_s_getreg((3 << 11) | 20) & 0xFu; }
#define XB_SPIN(cond, bar) do { unsigned _sp = 0; while (cond) { __builtin_amdgcn_s_sleep(1); \
    if ((++_sp & 255u) == 0u) { if (xb_ld(&(bar)[XB_TMO])) break; if (_sp > XB_SPIN_CAP) { atomicAdd(&(bar)[XB_TMO], 1u); break; } } } } while (0)
struct XcdBarrier { unsigned* bar; unsigned x; volatile LAS unsigned* st; };
__device__ __forceinline__ XcdBarrier xcd_barrier_post(unsigned* bar, volatile LAS unsigned* st) {
    XcdBarrier b; b.bar = bar; b.x = xb_xcc_id(); b.st = st;
    if (threadIdx.x == 0) (void)xb_add(&bar[XB_XCNT(b.x)], 1u);
    return b;
}
__device__ __forceinline__ void xcd_barrier_complete(unsigned* bar, unsigned x, unsigned& nloc, unsigned& nx) {
    const unsigned G = gridDim.x * gridDim.y * gridDim.z;
    unsigned sum, cnt, mine, sp = 0u;
    for (;;) {
        sum = 0u; cnt = 0u; mine = 0u;
#pragma unroll
        for (unsigned j = 0; j < 16; ++j) { const unsigned c = xb_ld(&bar[XB_XCNT(j)]); sum += c; cnt += (c > 0u) ? 1u : 0u; mine = (j == x) ? c : mine; }
        if (sum == G) break;
        __builtin_amdgcn_s_sleep(1);
        if ((++sp & 255u) == 0u) { if (xb_ld(&bar[XB_TMO])) break; if (sp > XB_SPIN_CAP) { atomicAdd(&bar[XB_TMO], 1u); break; } }
    }
    nloc = mine > 0u ? mine : 1u; nx = cnt > 0u ? cnt : 1u;
}
__device__ __forceinline__ void xcd_barrier(const XcdBarrier& b0) {
    XcdBarrier b; { unsigned* p = b0.bar; unsigned x = __builtin_amdgcn_readfirstlane(b0.x); unsigned st = (unsigned)(size_t)b0.st; asm volatile("" : "+s"(p), "+s"(x), "+s"(st)); b.bar = p; b.x = x; b.st = (volatile LAS unsigned*)(size_t)st; }
    asm volatile("s_waitcnt vmcnt(0)" ::: "memory");
    __syncthreads();
    if (threadIdx.x == 0) {
        unsigned* bar = b.bar;
        __builtin_amdgcn_s_waitcnt(0);
        unsigned nloc = b.st[0], nx = b.st[1];
        if (nloc == 0u) { xcd_barrier_complete(bar, b.x, nloc, nx); b.st[0] = nloc; b.st[1] = nx; }
        const unsigned old = xb_add(&bar[XB_XSUB(b.x)], 1u);
        const unsigned gen = old / nloc;
        if (old + 1u == (gen + 1u) * nloc) {
            __builtin_amdgcn_fence(__ATOMIC_RELEASE, "agent");
            asm volatile("s_waitcnt vmcnt(0)" ::: "memory");
            const unsigned og = xb_add(&bar[XB_TOP], 1u);
            const unsigned tg = og / nx;
            if (og + 1u == (tg + 1u) * nx) xb_add(&bar[XB_TOPGEN], 1u);
            else XB_SPIN(xb_ld(&bar[XB_TOPGEN]) == tg, bar);
            __builtin_amdgcn_fence(__ATOMIC_ACQUIRE, "agent");
            xb_add(&bar[XB_XGEN(b.x)], 1u);
            asm volatile("s_waitcnt vmcnt(0)" ::: "memory");
        } else {
            XB_SPIN(xb_ld(&bar[XB_XGEN(b.x)]) == gen, bar);
            __builtin_amdgcn_fence(__ATOMIC_ACQUIRE, "agent");
            asm volatile("s_waitcnt vmcnt(0)" ::: "memory");
        }
    }
    __syncthreads();
}

template <int KIND> __device__ __forceinline__ void run_phase(const Frame& F0, int li, int second) {
    Frame F;
    { int t = threadIdx.x; asm volatile("" : "+v"(t)); F.tid = t; F.lane = t & 63; F.wave = __builtin_amdgcn_readfirstlane(t >> 6);
      int g = F0.G, b = F0.bid; asm volatile("" : "+s"(g), "+s"(b)); F.G = g; F.bid = b;
      unsigned char* w = F0.ws; float* o = F0.out; asm volatile("" : "+s"(w), "+s"(o)); F.ws = w; F.out = o;
      unsigned l = (unsigned)(size_t)F0.lds; asm volatile("" : "+s"(l)); F.lds = (LAS unsigned char*)(size_t)l;
      asm volatile("" : "+s"(li), "+s"(second)); }
    float* modv = (float*)(F.ws + WS_MOD);
    float* xc = (float*)(F.ws + WS_XC);
    bf16* H = (bf16*)(F.ws + WS_H); bf16* ACT = (bf16*)(F.ws + WS_ACT); float* O = (float*)(F.ws + WS_O);
    const float* ng = inp(I_NORMG) + (size_t)li * 6 * DM; const float* mv = modv + (size_t)li * 3 * 9216;
    const bool last = li == 1;
    if constexpr (KIND == 100) { convert_weights(F, 0); mod_gemv(F); rope_tables(F); lora_transposes(F); fourier_tables(F); }
    if constexpr (KIND == 101) { EArgs A{}; A.xl_src = inp(I_X); A.xc_src = inp(I_CTX); A.o = nullptr; A.hdst = H; A.modv_h = modv; A.shidx = 0; A.scidx = 1; A.gpre = inp(I_NORMG); A.nrows = TT; e_phase(F, A); }
    if constexpr (KIND == 0) {
        const bf16* wi = (const bf16*)(F.ws + (second ? WS_WI2 : WS_WI1)); const bool withctx = !(last && second);
        if (!withctx || F.G != 256) { pg8::Gemm g{H, wi, withctx ? TT : TL, NWI, DM}; pg8::StaticOrder S; S.init(g.M, g.N, F.G, F.bid);
            pg8::EpiSwiglu E{ACT, FFNP}; pg8::gemm_phase<pg8::EpiSwiglu, pg8::StaticOrder, true, true>(F.lds, g, S, E, F.tid); }
        else { unsigned* cnt = (unsigned*)(F.ws + WS_CTL) + 8192 + 64 * (li * 2 + second);
            pg8::Gemm g{H, wi, TT, NWI, DM}; pg8::UpOrder S; S.init(NWI, F.G, F.bid, cnt);
            pg8::EpiSwiglu E{ACT, FFNP}; pg8::gemm_phase<pg8::EpiSwiglu, pg8::UpOrder, true, true>(F.lds, g, S, E, F.tid);
            if (F.bid >= 248) {
                if (F.tid == 0) { unsigned sp = 0; while (__hip_atomic_load(cnt, __ATOMIC_RELAXED, __HIP_MEMORY_SCOPE_AGENT) < 352u && ++sp < (1u << 24)) __builtin_amdgcn_s_sleep(8);
                    __builtin_amdgcn_fence(__ATOMIC_ACQUIRE, "agent"); asm volatile("s_waitcnt vmcnt(0)" ::: "memory"); }
                __syncthreads();
                const int k = F.bid - 248; pg8::Gemm g2{ACT, (const bf16*)(F.ws + (second ? WS_WO2 : WS_WO1)), TT, DM, FFNP}; pg8::OneUnit S2{64 + (k >> 2), k & 3};
                pg8::EpiF32 E2{O, DM}; pg8::gemm_phase<pg8::EpiF32, pg8::OneUnit, false, true>(F.lds, g2, S2, E2, F.tid); } } }
    if constexpr (KIND == 1) {
        const bool ctxhere = F.G != 256 && !(last && second);
        pg8::Gemm g{ACT, (const bf16*)(F.ws + (second ? WS_WO2 : WS_WO1)), ctxhere ? TT : TL, DM, FFNP}; pg8::StaticOrder S; S.init(g.M, g.N, F.G, F.bid);
        pg8::EpiF32 E{O, DM}; pg8::gemm_phase<pg8::EpiF32, pg8::StaticOrder, true, true>(F.lds, g, S, E, F.tid); }
    if constexpr (KIND == 2) {
        EArgs A{}; A.xl_src = li == 0 ? inp(I_X) : F.out; A.xc_src = li == 0 ? inp(I_CTX) : xc; A.xl_dst = F.out; A.xc_dst = xc; A.o = O; A.modv_g = mv; A.gidx = 2; A.gmul = 0.5f; A.gpost = ng + 1 * DM;
        A.hdst = H; A.modv_h = mv; A.shidx = 3; A.scidx = 4; A.gpre = ng + 2 * DM; A.nrows = TT; e_phase(F, A); }
    if constexpr (KIND == 3) {
        pg8::Gemm g{H, (const bf16*)(F.ws + WS_WIN), TT, INWP, DM}; pg8::StaticOrder S; S.init(g.M, g.N, F.G, F.bid);
        pg8::EpiBf16 E{ACT, INWP}; pg8::gemm_phase<pg8::EpiBf16, pg8::StaticOrder, true, true>(F.lds, g, S, E, F.tid); }
    if constexpr (KIND == 4) {
        lora_pass(F, li);
        for (int u = F.bid; u < 256; u += F.G) fourier_a_fast(F, u);
        rope_all(F);
        if (li == 0) fourier_ctx1_all(F); }
    if constexpr (KIND == 5) {
        for (int u = F.bid; u < (li == 0 ? 264 : 256); u += F.G) attn_unit(F, li, u);
        for (int u = F.bid; u < 24 * (NSC - 1); u += F.G) rwkv_pass1_unit(F, li, u); }
    if constexpr (KIND == 11) {
        if (F.bid < 24) rwkv_pass2_chain(F, F.bid);
        for (int u = F.bid; u < 512; u += F.G) fourier_c_fast(F, u);
        if (li == 0) fourier_ctx2_all(F); }
    if constexpr (KIND == 12) {
        for (int u = F.bid; u < 12 * NSC; u += F.G) { if (li == 1 && (u % NSC) < 2) continue; rwkv_pass3_unit(F, li, u); } }
    if constexpr (KIND == 6) {
        pg8::Gemm g{H, (const bf16*)(F.ws + WS_WOUT), last ? TL : TT, DM, DM}; pg8::StaticOrder S; S.init(g.M, g.N, F.G, F.bid);
        pg8::EpiF32 E{O, DM}; pg8::gemm_phase<pg8::EpiF32, pg8::StaticOrder, true, true>(F.lds, g, S, E, F.tid); }
    if constexpr (KIND == 7) {
        EArgs A{}; A.xl_src = F.out; A.xc_src = xc; A.xl_dst = F.out; A.xc_dst = xc; A.o = O; A.modv_g = mv; A.gidx = 5; A.gmul = 1.0f; A.gpost = ng + 3 * DM;
        A.hdst = H; A.modv_h = mv; A.shidx = 6; A.scidx = 7; A.gpre = ng + 4 * DM; A.nrows = last ? TL : TT; e_phase(F, A); }
    if constexpr (KIND == 10) {
        EArgs A{}; A.xl_src = F.out; A.xc_src = xc; A.xl_dst = F.out; A.xc_dst = xc; A.o = O; A.modv_g = mv; A.gidx = 8; A.gmul = 0.5f; A.gpost = ng + 5 * DM;
        if (!last) { A.hdst = H; A.modv_h = mv + 3 * 9216; A.shidx = 0; A.scidx = 1; A.gpre = ng + 6 * DM; }
        A.nrows = last ? TL : TT; e_phase(F, A);
        if (!last) { __syncthreads(); convert_weights(F, 1); } }
}
constexpr int MISC_OFF = 146432;
__global__ void __launch_bounds__(NTHR, 2) mega_one(Args args) {
    extern __shared__ __attribute__((aligned(16))) unsigned char lds[];
    Frame F; F.lds = (LAS unsigned char*)lds; F.tid = threadIdx.x; F.lane = F.tid & 63; F.wave = __builtin_amdgcn_readfirstlane(F.tid >> 6); F.G = gridDim.x; F.bid = blockIdx.x;
    F.out = args.out; F.ws = args.ws;
    volatile LAS unsigned* MISC = (volatile LAS unsigned*)(F.lds + MISC_OFF);
    if (F.tid < 32) MISC[F.tid] = 0u;
    __syncthreads();
    XcdBarrier bar = xcd_barrier_post((unsigned*)(F.ws + WS_CTL) + 4096, MISC + 8);
#define GRID_BAR() xcd_barrier(bar)
    run_phase<100>(F, 0, 0); GRID_BAR();
    run_phase<101>(F, 0, 0); GRID_BAR();
#pragma unroll 1
    for (int li = 0; li < 2; ++li) {
        run_phase<0>(F, li, 0); GRID_BAR();
        run_phase<1>(F, li, 0); GRID_BAR();
        run_phase<2>(F, li, 0); GRID_BAR();
        run_phase<3>(F, li, 0); GRID_BAR();
        run_phase<4>(F, li, 0); GRID_BAR();
        run_phase<5>(F, li, 0); GRID_BAR();
        run_phase<11>(F, li, 0); GRID_BAR();
        run_phase<12>(F, li, 0); GRID_BAR();
        run_phase<6>(F, li, 0); GRID_BAR();
        run_phase<7>(F, li, 0); GRID_BAR();
        run_phase<0>(F, li, 1); GRID_BAR();
        run_phase<1>(F, li, 1); GRID_BAR();
        run_phase<10>(F, li, 0); GRID_BAR();
    }
}

extern "C" void kernel_launch(void* const* d_in, const int* in_sizes, int n_in, void* d_out, int out_size, void* d_ws, size_t ws_size, hipStream_t stream) {
    static int ready = 0;
    if (!ready) {
        if (n_in != 25 || out_size != TL * DM || ws_size < WS_END) { fprintf(stderr, "kernel_launch: unexpected shapes (n_in %d out %d ws %zu)\n", n_in, out_size, ws_size); ready = -1; return; }
        if (hipFuncSetAttribute((const void*)mega_one, hipFuncAttributeMaxDynamicSharedMemorySize, LDS_BYTES) != hipSuccess) { fprintf(stderr, "kernel_launch: hipFuncSetAttribute failed\n"); ready = -1; return; }
        ready = 1;
    }
    if (ready < 0) return;
    if (hipMemsetAsync((char*)d_ws + WS_CTL, 0, 65536, stream) != hipSuccess) { fprintf(stderr, "kernel_launch: memset failed\n"); return; }
    Args a{};
    for (int i = 0; i < 25; ++i) a.in[i] = (const float*)d_in[i];
    a.out = (float*)d_out; a.ws = (unsigned char*)d_ws;
    hipLaunchKernelGGL(mega_one, dim3(256), dim3(NTHR), LDS_BYTES, stream, a);
}
```

```cpp
#include <hip/hip_runtime.h>
#include <cstdio>
#include <cstdint>

namespace pg8 {
#define PG8_LAS __attribute__((address_space(3)))
typedef unsigned short bf16_t;
typedef short bf16x8 __attribute__((ext_vector_type(8)));
typedef float f32x4 __attribute__((ext_vector_type(4)));
typedef unsigned u32x4 __attribute__((ext_vector_type(4)));
constexpr int BM = 256, BK = 64, HALF = 128, HTB = HALF * BK * 2, STAGE_BYTES = 8 * HTB, NXCD = 8, WGM = 8;

__host__ __device__ __forceinline__ int lds_byte(int r, int c) { const int st = (r >> 4) * 2 + (c >> 5), rr = r & 15, cc = c & 31, ob = rr * 64 + cc * 2; return st * 1024 + (ob ^ (((ob >> 9) & 1) << 5)); }
__host__ __device__ __forceinline__ void stage_rc(int b, int& R, int& C) { const int st = b / 1024, sb = b % 1024, swz = sb ^ (((sb >> 9) & 1) << 5); R = (st >> 1) * 16 + swz / 64; C = (st & 1) * 32 + (swz % 64) / 2; }
__host__ __device__ __forceinline__ int perm32(int rho) { const int n = rho >> 4, i = rho & 15; return 8 * (i >> 2) + 4 * n + (i & 3); }

struct Unit { int pm, pn; };
struct Gemm { const bf16_t* A; const bf16_t* Bt; int M, N, K; };

struct StaticOrder {
    int nM, nN, nwg, G, c;
    __host__ __device__ void init(int M, int N, int G_, int c_) { nM = M / BM; nN = N / BM; nwg = nM * nN; G = G_; c = c_; }
    __host__ __device__ bool next(int i, Unit& u) const {
        const long L = (long)i * G + c; if (L >= nwg) return false;
        int wgid = (int)L; { const int q = nwg / NXCD, r = nwg % NXCD, xcd = wgid % NXCD, off = wgid / NXCD; wgid = (xcd < r ? xcd * (q + 1) : r * (q + 1) + (xcd - r) * q) + off; }
        const int nig = WGM * nN, gid = wgid / nig, fm = gid * WGM, gsz = (nM - fm) < WGM ? (nM - fm) : WGM;
        u.pm = fm + ((wgid % nig) % gsz); u.pn = (wgid % nig) / gsz; return true;
    }
    __device__ __forceinline__ void a_ready(const Unit&) const {}
    __device__ __forceinline__ void done(const Unit&) const {}
};

struct UpOrder {
    StaticOrder lat; int G, c, nN; unsigned* cnt;
    __device__ void init(int N, int G_, int c_, unsigned* cnt_) { lat.init(16384, N, G_, c_); G = G_; c = c_; nN = N / BM; cnt = cnt_; }
    __device__ bool next(int i, Unit& u) const {
        const int nctx = 2 * nN, total = nctx + lat.nwg;
        long L;
        if (G != 256) L = (long)i * G + c;
        else if (c >= 248) { if (i >= 3) return false; L = (long)i * G + c; }
        else if (c >= 172 && c < 188 && i == 5) L = (long)(3 + (c - 172) / 8) * G + 248 + (c - 172) % 8;
        else L = (long)i * G + c;
        if (L >= total) return false;
        if (L < nctx) { u.pm = 64 + (int)L / nN; u.pn = (int)L % nN; return true; }
        int wgid = (int)L - nctx; { const int nwg = lat.nwg, q = nwg / NXCD, r = nwg % NXCD, xcd = wgid % NXCD, off = wgid / NXCD; wgid = (xcd < r ? xcd * (q + 1) : r * (q + 1) + (xcd - r) * q) + off; }
        const int nig = WGM * nN, gid = wgid / nig, fm = gid * WGM, gsz = (lat.nM - fm) < WGM ? (lat.nM - fm) : WGM;
        u.pm = fm + ((wgid % nig) % gsz); u.pn = (wgid % nig) / gsz; return true;
    }
    __device__ __forceinline__ void a_ready(const Unit&) const {}
    __device__ __forceinline__ void done(const Unit& u) const {
        if (u.pm >= 64) { asm volatile("s_waitcnt vmcnt(0)" ::: "memory"); __builtin_amdgcn_fence(__ATOMIC_RELEASE, "agent"); asm volatile("s_waitcnt vmcnt(0)" ::: "memory");
            if ((threadIdx.x & 63) == 0) __hip_atomic_fetch_add(cnt, 1u, __ATOMIC_RELAXED, __HIP_MEMORY_SCOPE_AGENT); }
    }
};
struct OneUnit {
    int pm, pn;
    __device__ bool next(int i, Unit& u) const { if (i != 0) return false; u.pm = pm; u.pn = pn; return true; }
    __device__ __forceinline__ void a_ready(const Unit&) const {}
    __device__ __forceinline__ void done(const Unit&) const {}
};

__device__ __forceinline__ unsigned cvt_pk_bf16(float lo, float hi) { unsigned r; asm volatile("v_cvt_pk_bf16_f32 %0, %1, %2" : "=v"(r) : "v"(lo), "v"(hi)); return r; }

struct EpiBf16 {
    static constexpr bool PERM = true, AFTER_DRAIN = false;
    bf16_t* O; int ldc;
    __device__ __forceinline__ void operator()(const f32x4 (&acc)[2][2][4][2], const Unit& u, int wr, int wc, int fr, int fq) const {
        const int row0 = u.pm * BM + wr * 64 + fr; const int col0 = u.pn * BM + wc * 32 + 8 * fq;
#pragma unroll
        for (int ai = 0; ai < 2; ++ai)
#pragma unroll
            for (int m = 0; m < 4; ++m) { bf16_t* rowp = O + (size_t)(row0 + ai * HALF + m * 16) * ldc + col0;
#pragma unroll
                for (int bj = 0; bj < 2; ++bj) { const f32x4 v0 = acc[ai][bj][m][0], v1 = acc[ai][bj][m][1];
                    u32x4 w; w.x = cvt_pk_bf16(v0[0], v0[1]); w.y = cvt_pk_bf16(v0[2], v0[3]); w.z = cvt_pk_bf16(v1[0], v1[1]); w.w = cvt_pk_bf16(v1[2], v1[3]);
                    *(u32x4*)(rowp + bj * HALF) = w; } }
    }
};
struct EpiF32 {
    static constexpr bool PERM = true, AFTER_DRAIN = false;
    float* O; int ldc;
    __device__ __forceinline__ void operator()(const f32x4 (&acc)[2][2][4][2], const Unit& u, int wr, int wc, int fr, int fq) const {
        const int row0 = u.pm * BM + wr * 64 + fr; const int col0 = u.pn * BM + wc * 32 + 8 * fq;
#pragma unroll
        for (int ai = 0; ai < 2; ++ai)
#pragma unroll
            for (int m = 0; m < 4; ++m) { float* rowp = O + (size_t)(row0 + ai * HALF + m * 16) * ldc + col0;
#pragma unroll
                for (int bj = 0; bj < 2; ++bj) { *(f32x4*)(rowp + bj * HALF) = acc[ai][bj][m][0]; *(f32x4*)(rowp + bj * HALF + 4) = acc[ai][bj][m][1]; } }
    }
};
__device__ __forceinline__ float silu_f(float x) { return x * __builtin_amdgcn_rcpf(1.0f + __expf(-x)); }
struct EpiSwiglu {
    static constexpr bool PERM = true, AFTER_DRAIN = false;
    bf16_t* O; int ldc;
    __device__ __forceinline__ void operator()(const f32x4 (&acc)[2][2][4][2], const Unit& u, int wr, int wc, int fr, int fq) const {
        const int row0 = u.pm * BM + wr * 64 + fr; const int col0 = u.pn * HALF + wc * 32 + 8 * fq;
#pragma unroll
        for (int ai = 0; ai < 2; ++ai)
#pragma unroll
            for (int m = 0; m < 4; ++m) { bf16_t* rowp = O + (size_t)(row0 + ai * HALF + m * 16) * ldc + col0;
                const f32x4 g0 = acc[ai][0][m][0], g1 = acc[ai][0][m][1], u0 = acc[ai][1][m][0], u1 = acc[ai][1][m][1];
                u32x4 w; w.x = cvt_pk_bf16(silu_f(g0[0]) * u0[0], silu_f(g0[1]) * u0[1]); w.y = cvt_pk_bf16(silu_f(g0[2]) * u0[2], silu_f(g0[3]) * u0[3]);
                w.z = cvt_pk_bf16(silu_f(g1[0]) * u1[0], silu_f(g1[1]) * u1[1]); w.w = cvt_pk_bf16(silu_f(g1[2]) * u1[2], silu_f(g1[3]) * u1[3]);
                *(u32x4*)rowp = w; }
    }
};

template <class Epi, class Sched, bool ALIGN_EPI = false, bool SP2 = false>
__device__ __forceinline__ void gemm_phase(PG8_LAS unsigned char* lds, const Gemm g, const Sched& S, const Epi& E, const int tid) {
    const int wid = __builtin_amdgcn_readfirstlane(tid >> 6), lane = tid & 63, wr = wid >> 2, wc = wid & 3, fr = lane & 15, fq = lane >> 4;
    const int K = g.K, nt = K / BK;
    unsigned voffA[2], voffB[2];
#pragma unroll
    for (int i = 0; i < 2; ++i) { int R, C; stage_rc(tid * 16 + i * 8192, R, C); const int Rb = Epi::PERM ? ((R & ~31) + perm32(R & 31)) : R;
        voffA[i] = (unsigned)(R * K + C) * 2u; voffB[i] = (unsigned)(Rb * K + C) * 2u; }
    const size_t kstep = (size_t)(BK * 2);
    const size_t hstep = (size_t)HALF * K * 2;
    const size_t tstep = 2 * hstep;
    const unsigned ldsw = (unsigned)wid * 1024u;
    const int aoff = lds_byte(wr * 64 + fr, fq * 8), boff = lds_byte(wc * 32 + fr, fq * 8);
#define PG8_SA(b, h) (((b) * 2 + (h)) * HTB)
#define PG8_SB(b, h) ((4 + (b) * 2 + (h)) * HTB)
#define PG8_STAGE(bufoff, gbase, voff) do { _Pragma("unroll") for (int _i = 0; _i < 2; ++_i) \
        __builtin_amdgcn_global_load_lds((const unsigned*)((const char*)(gbase) + (voff)[_i]), (PG8_LAS unsigned*)(lds + (bufoff) + ldsw + _i * 8192), 16, 0, 0); } while (0)
#define PG8_LDA(dst, b, h) do { _Pragma("unroll") for (int m = 0; m < 4; ++m) _Pragma("unroll") for (int k = 0; k < 2; ++k) dst[m][k] = *(const PG8_LAS bf16x8*)(lds + PG8_SA(b, h) + aoff + m * 2048 + k * 1024); } while (0)
#define PG8_LDB(dst, b, h) do { _Pragma("unroll") for (int n = 0; n < 2; ++n) _Pragma("unroll") for (int k = 0; k < 2; ++k) dst[n][k] = *(const PG8_LAS bf16x8*)(lds + PG8_SB(b, h) + boff + n * 2048 + k * 1024); } while (0)
#define PG8_MMA(ai, bj, At, Bt) do { __builtin_amdgcn_s_setprio(1); _Pragma("unroll") for (int m = 0; m < 4; ++m) _Pragma("unroll") for (int n = 0; n < 2; ++n) _Pragma("unroll") for (int k = 0; k < 2; ++k) \
        acc[ai][bj][m][n] = __builtin_amdgcn_mfma_f32_16x16x32_bf16(Bt[n][k], At[m][k], acc[ai][bj][m][n], 0, 0, 0); __builtin_amdgcn_s_setprio(0); } while (0)
#define PG8_WAIT_V(n) asm volatile("s_waitcnt vmcnt(" #n ")" ::: "memory")
#define PG8_WAIT_L(n) asm volatile("s_waitcnt lgkmcnt(" #n ")" ::: "memory")
#define PG8_BAR __builtin_amdgcn_s_barrier()
#define PG8_SCHED __builtin_amdgcn_sched_barrier(0)
    Unit cur, nxt; int ui = 0;
    if (!S.next(0, cur)) return;
    f32x4 acc[2][2][4][2];
#pragma unroll
    for (int a = 0; a < 2; ++a)
#pragma unroll
        for (int b = 0; b < 2; ++b)
#pragma unroll
            for (int m = 0; m < 4; ++m)
#pragma unroll
                for (int n = 0; n < 2; ++n) acc[a][b][m][n] = (f32x4){0.f, 0.f, 0.f, 0.f};
    bf16x8 At[4][2], B0[2][2], B1[2][2];
    const char* cA = (const char*)g.A + (size_t)cur.pm * tstep; const char* cB = (const char*)g.Bt + (size_t)cur.pn * tstep;
    S.a_ready(cur);
    if constexpr (SP2) {
        PG8_STAGE(PG8_SB(0, 0), cB, voffB); PG8_STAGE(PG8_SB(0, 1), cB + hstep, voffB); PG8_STAGE(PG8_SA(0, 0), cA, voffA); PG8_STAGE(PG8_SA(0, 1), cA + hstep, voffA);
        if (wr == 1) PG8_BAR;
        PG8_WAIT_V(2); PG8_BAR;
        PG8_STAGE(PG8_SB(1, 0), cB + kstep, voffB); PG8_STAGE(PG8_SA(1, 0), cA + kstep, voffA); PG8_STAGE(PG8_SB(1, 1), cB + hstep + kstep, voffB);
        PG8_WAIT_V(6); PG8_BAR;
    } else {
        PG8_STAGE(PG8_SB(0, 0), cB, voffB); PG8_STAGE(PG8_SA(0, 0), cA, voffA); PG8_STAGE(PG8_SB(0, 1), cB + hstep, voffB); PG8_STAGE(PG8_SA(0, 1), cA + hstep, voffA);
        if (wr == 1) PG8_BAR;
        PG8_WAIT_V(4); PG8_BAR;
        PG8_STAGE(PG8_SB(1, 0), cB + kstep, voffB); PG8_STAGE(PG8_SA(1, 0), cA + kstep, voffA); PG8_STAGE(PG8_SB(1, 1), cB + hstep + kstep, voffB);
        PG8_WAIT_V(6); PG8_BAR;
    }
    for (;;) {
        const bool has_next = S.next(ui + 1, nxt);
        const char* nA = has_next ? (const char*)g.A + (size_t)nxt.pm * tstep : cA; const char* nB = has_next ? (const char*)g.Bt + (size_t)nxt.pn * tstep : cB;
        for (int t = 0; t < nt; t += 2) {
            const bool last = (t == nt - 2);
            const char* a1 = cA + (size_t)(t + 1) * kstep;
            const char* a2 = last ? nA : cA + (size_t)(t + 2) * kstep; const char* b2 = last ? nB : cB + (size_t)(t + 2) * kstep;
            const char* a3 = a2 + kstep; const char* b3 = b2 + kstep;
            if (last && has_next) S.a_ready(nxt);
            if constexpr (SP2) {
            PG8_LDB(B0, 0, 0); PG8_LDB(B1, 0, 1); PG8_SCHED; PG8_LDA(At, 0, 0); PG8_STAGE(PG8_SA(1, 1), a1 + hstep, voffA);
            PG8_WAIT_V(8); PG8_WAIT_L(0); PG8_BAR; PG8_MMA(0, 0, At, B0); PG8_MMA(0, 1, At, B1); PG8_BAR; PG8_SCHED;
            PG8_LDA(At, 0, 1); PG8_STAGE(PG8_SB(0, 0), b2, voffB); PG8_STAGE(PG8_SB(0, 1), b2 + hstep, voffB); PG8_STAGE(PG8_SA(0, 0), a2, voffA);
            PG8_WAIT_V(8); PG8_WAIT_L(0); PG8_BAR; PG8_MMA(1, 0, At, B0); PG8_MMA(1, 1, At, B1); PG8_BAR; PG8_SCHED;
            PG8_LDB(B0, 1, 0); PG8_LDB(B1, 1, 1); PG8_SCHED; PG8_LDA(At, 1, 0); PG8_STAGE(PG8_SA(0, 1), a2 + hstep, voffA);
            PG8_WAIT_V(8); PG8_WAIT_L(0); PG8_BAR; PG8_MMA(0, 0, At, B0); PG8_MMA(0, 1, At, B1); PG8_BAR; PG8_SCHED;
            PG8_LDA(At, 1, 1); PG8_STAGE(PG8_SB(1, 0), b3, voffB); PG8_STAGE(PG8_SB(1, 1), b3 + hstep, voffB); PG8_STAGE(PG8_SA(1, 0), a3, voffA);
            PG8_WAIT_V(8); PG8_WAIT_L(0); PG8_BAR; PG8_MMA(1, 0, At, B0); PG8_MMA(1, 1, At, B1); PG8_BAR; PG8_SCHED;
            } else {
            PG8_LDB(B0, 0, 0); PG8_SCHED; PG8_LDA(At, 0, 0); PG8_STAGE(PG8_SA(1, 1), a1 + hstep, voffA);
            PG8_WAIT_L(8); PG8_BAR; PG8_WAIT_L(0); PG8_MMA(0, 0, At, B0); PG8_BAR; PG8_SCHED;
            PG8_LDB(B1, 0, 1); PG8_STAGE(PG8_SB(0, 0), b2, voffB);
            PG8_BAR; PG8_WAIT_L(0); PG8_MMA(0, 1, At, B1); PG8_BAR;
            PG8_LDA(At, 0, 1); PG8_STAGE(PG8_SA(0, 0), a2, voffA);
            PG8_BAR; PG8_WAIT_L(0); PG8_MMA(1, 0, At, B0); PG8_BAR; PG8_SCHED;
            PG8_STAGE(PG8_SB(0, 1), b2 + hstep, voffB);
            PG8_WAIT_V(6); PG8_BAR; PG8_MMA(1, 1, At, B1); PG8_BAR;
            PG8_LDB(B0, 1, 0); PG8_SCHED; PG8_LDA(At, 1, 0); PG8_STAGE(PG8_SA(0, 1), a2 + hstep, voffA);
            PG8_WAIT_L(8); PG8_BAR; PG8_WAIT_L(0); PG8_MMA(0, 0, At, B0); PG8_BAR; PG8_SCHED;
            PG8_LDB(B1, 1, 1); PG8_STAGE(PG8_SB(1, 0), b3, voffB);
            PG8_BAR; PG8_WAIT_L(0); PG8_MMA(0, 1, At, B1); PG8_BAR;
            PG8_LDA(At, 1, 1); PG8_STAGE(PG8_SA(1, 0), a3, voffA);
            PG8_BAR; PG8_WAIT_L(0); PG8_MMA(1, 0, At, B0); PG8_BAR; PG8_SCHED;
            PG8_STAGE(PG8_SB(1, 1), b3 + hstep, voffB);
            PG8_WAIT_V(6); PG8_BAR; PG8_MMA(1, 1, At, B1); PG8_BAR;
            }
        }
        if constexpr (ALIGN_EPI) { if (wr == 0) PG8_BAR; }
        if constexpr (!Epi::AFTER_DRAIN) { E(acc, cur, wr, wc, fr, fq); S.done(cur); }
        if (!has_next) break;
#pragma unroll
        for (int a = 0; a < 2; ++a)
#pragma unroll
            for (int b = 0; b < 2; ++b)
#pragma unroll
                for (int m = 0; m < 4; ++m)
#pragma unroll
                    for (int n = 0; n < 2; ++n) acc[a][b][m][n] = (f32x4){0.f, 0.f, 0.f, 0.f};
        cur = nxt; cA = nA; cB = nB; ++ui;
        if constexpr (ALIGN_EPI) { if (wr == 1) PG8_BAR; }
    }
    PG8_WAIT_V(0);
    if constexpr (!ALIGN_EPI) { if (wr == 0) PG8_BAR; }
    PG8_BAR;
#undef PG8_SA
#undef PG8_SB
#undef PG8_STAGE
#undef PG8_LDA
#undef PG8_LDB
#undef PG8_MMA
#undef PG8_WAIT_V
#undef PG8_WAIT_L
#undef PG8_BAR
#undef PG8_SCHED
}
}

constexpr int NWAVES = 8, NTHR = 512;
constexpr int DM = 1024, SEQ = 8192, NB = 2, CTX = 256, TL = NB * SEQ, TC = NB * CTX, TT = TL + TC;
constexpr int FFN = 2752, FFNP = 2816, NWI = 5632, INW = 2432, INWP = 2560, NMOD = 9;
constexpr int ZF = 0, ZQ = 256, ZK = 640, ZV = 768, ZRR = 896, ZRK = 1280, ZRV = 1664, ZW = 2048, ZA = 2176, ZG = 2304;
constexpr int RW = 384;
constexpr float NORM_EPS = 1e-6f, GN_EPS = 64e-5f;

constexpr size_t MiB = 1u << 20;
constexpr size_t WS_CTL = 0, WS_MOD = 1 * MiB, WS_ROPE = 2 * MiB, WS_XC = 4 * MiB, WS_GC = 6 * MiB;
constexpr size_t WS_WI1 = 8 * MiB, WS_WO1 = 19 * MiB, WS_WIN = 25 * MiB, WS_WOUT = 30 * MiB, WS_WI2 = 32 * MiB, WS_WO2 = 43 * MiB;
constexpr size_t WS_H = 49 * MiB;
constexpr size_t WS_ACT = 82 * MiB;
constexpr size_t WS_O = 173 * MiB;
constexpr size_t WS_YD = WS_O, WS_QR = WS_O + 50 * MiB, WS_KR = WS_O + 62 * MiB;
constexpr size_t WS_W2T = WS_MOD + 256 * 1024, WS_A2T = WS_MOD + 512 * 1024, WS_G2T = WS_MOD + 768 * 1024;
constexpr size_t WS_LW = WS_O, WS_IC = WS_O + 25 * MiB;
constexpr size_t WS_GAM32 = 165 * MiB;
constexpr size_t WS_FA = 239 * MiB;
constexpr size_t WS_SUM = 255 * MiB;
constexpr size_t WS_END = 293 * MiB;

constexpr size_t WS_FT = 7 * MiB;
constexpr size_t FT_W64C = 0, FT_W64S = 8192, FT_W128C = 16384, FT_W128S = 49152, FT_T64C = 81920, FT_T64S = 90112;
constexpr int LDS_BYTES = 147456;
constexpr int MISC_OFF = 146432;

typedef unsigned short bf16;
typedef float f32x4 __attribute__((ext_vector_type(4)));
typedef unsigned v4u __attribute__((ext_vector_type(4)));
typedef unsigned v2u __attribute__((ext_vector_type(2)));
#define LAS __attribute__((address_space(3)))
#define LDS_WAIT() asm volatile("s_waitcnt lgkmcnt(0)" ::: "memory")

__device__ __forceinline__ unsigned f2bf(float f) { unsigned u = __builtin_bit_cast(unsigned, f); return (u + 0x7fffu + ((u >> 16) & 1u)) >> 16; }
__device__ __forceinline__ unsigned pk2(float lo, float hi) { return f2bf(lo) | (f2bf(hi) << 16); }
__device__ __forceinline__ float bf2f(unsigned short u) { return __builtin_bit_cast(float, (unsigned)u << 16); }
__device__ __forceinline__ float bflo(unsigned u) { return __builtin_bit_cast(float, u << 16); }
__device__ __forceinline__ float bfhi(unsigned u) { return __builtin_bit_cast(float, u & 0xffff0000u); }
__device__ __forceinline__ void unpack8(const v4u w, float (&f)[8]) { f[0] = bflo(w.x); f[1] = bfhi(w.x); f[2] = bflo(w.y); f[3] = bfhi(w.y); f[4] = bflo(w.z); f[5] = bfhi(w.z); f[6] = bflo(w.w); f[7] = bfhi(w.w); }
__device__ __forceinline__ float wave_sum(float v) {
#pragma unroll
    for (int o = 1; o < 64; o <<= 1) v += __shfl_xor(v, o);
    return v;
}
__device__ __forceinline__ float wave_max(float v) {
#pragma unroll
    for (int o = 1; o < 64; o <<= 1) v = fmaxf(v, __shfl_xor(v, o));
    return v;
}

struct Args { const float* in[25]; float* out; unsigned char* ws; int ph_lo, ph_hi; };

struct Frame {
    LAS unsigned char* lds;
    int tid, lane, wave, G, bid;
    float* out; unsigned char* ws;
};
enum { I_X = 0, I_C, I_CTX, I_CCTX, I_MODW, I_MODB, I_NORMG, I_F1WI, I_F1WO, I_WIN, I_WOUT, I_SINK, I_CONV, I_W0, I_W2, I_A0, I_A2, I_G2, I_KK, I_KA, I_RK, I_LNG, I_LNB, I_F2WI, I_F2WO };

__device__ __forceinline__ const float* inp(int i) {
    const __attribute__((address_space(4))) char* p = (const __attribute__((address_space(4))) char*)__builtin_amdgcn_kernarg_segment_ptr();
    asm volatile("" : "+s"(p));
    return *(const float* const __attribute__((address_space(4)))*)(p + 8 * i);
}
__device__ __forceinline__ void cvt_item(const float* W, int ldw, int k0, int sc, bool valid, bf16* WT, int Kd, int n0d, LAS float* scr, int lane) {
#pragma unroll 8
    for (int i = 0; i < 32; ++i) { const int kk = 2 * i + (lane >> 5); scr[kk * 33 + (lane & 31)] = valid ? W[(size_t)(k0 + kk) * ldw + sc + (lane & 31)] : 0.f; }
    LDS_WAIT(); asm volatile("" ::: "memory");
    const int c = lane & 7;
#pragma unroll
    for (int j = 0; j < 4; ++j) { const int n = (lane >> 3) + 8 * j; const LAS float* s = scr + (8 * c) * 33 + n;
        v4u o; o.x = pk2(s[0 * 33], s[1 * 33]); o.y = pk2(s[2 * 33], s[3 * 33]); o.z = pk2(s[4 * 33], s[5 * 33]); o.w = pk2(s[6 * 33], s[7 * 33]);
        *(v4u*)(WT + (size_t)(n0d + n) * Kd + k0 + 8 * c) = o; }
    LDS_WAIT(); asm volatile("" ::: "memory");
}
__device__ __forceinline__ void convert_weights(Frame& F, int li) {
    LAS float* scr = (LAS float*)(F.lds + F.wave * 16384);
    const int gw = F.bid * NWAVES + F.wave, NGW = F.G * NWAVES;
    constexpr int I_WI = 16 * (NWI / 32), I_WO = (FFNP / 64) * 32, I_IN = 16 * (INWP / 32), I_OUT = 16 * 32;
    constexpr int NITEMS = 2 * I_WI + 2 * I_WO + I_IN + I_OUT;
    for (int it = gw; it < NITEMS; it += NGW) {
        int r = it;
        if (r < 2 * I_WI) { const int f = r / I_WI; r -= f * I_WI; const int nblk = NWI / 32, kb = r / nblk, nb = r % nblk;
            const int n0 = 32 * nb, pn = n0 >> 8, i = n0 & 255; const int j = 128 * pn + (i & 127); const bool valid = j < FFN; const int sc = (i < 128) ? j : FFN + j;
            cvt_item((f ? inp(I_F2WI) : inp(I_F1WI)) + (size_t)li * DM * 2 * FFN, 2 * FFN, 64 * kb, sc, valid, (bf16*)(F.ws + (f ? WS_WI2 : WS_WI1)), DM, n0, scr, F.lane); continue; }
        r -= 2 * I_WI;
        if (r < 2 * I_WO) { const int f = r / I_WO; r -= f * I_WO; const int kb = r / 32, nb = r % 32; const bool valid = 64 * kb < FFN;
            cvt_item((f ? inp(I_F2WO) : inp(I_F1WO)) + (size_t)li * FFN * DM, DM, 64 * kb, 32 * nb, valid, (bf16*)(F.ws + (f ? WS_WO2 : WS_WO1)), FFNP, 32 * nb, scr, F.lane); continue; }
        r -= 2 * I_WO;
        if (r < I_IN) { const int nblk = INWP / 32, kb = r / nblk, nb = r % nblk; const bool valid = 32 * nb < INW;
            cvt_item(inp(I_WIN) + (size_t)li * DM * INW, INW, 64 * kb, 32 * nb, valid, (bf16*)(F.ws + WS_WIN), DM, 32 * nb, scr, F.lane); continue; }
        r -= I_IN;
        { const int kb = r / 32, nb = r % 32;
            cvt_item(inp(I_WOUT) + (size_t)li * DM * DM, DM, 64 * kb, 32 * nb, true, (bf16*)(F.ws + WS_WOUT), DM, 32 * nb, scr, F.lane); }
    }
}
__device__ __forceinline__ void mod_gemv(Frame& F) {
    LAS float* sc = (LAS float*)F.lds;
    LAS float* red = sc + 3 * 1024;
    __syncthreads();
    for (int i = F.tid; i < 3 * 1024; i += NTHR) { const int v = i >> 10, k = i & 1023; const float x = v < 2 ? inp(I_C)[v * 1024 + k] : inp(I_CCTX)[k]; sc[i] = x / (1.0f + __expf(-x)); }
    __syncthreads();
    float* modv = (float*)(F.ws + WS_MOD);
    for (int u = F.bid; u < 2 * 72; u += F.G) {
        const int l = u / 72, n0 = (u % 72) * 128;
        const float* w = inp(I_MODW) + (size_t)l * DM * 9216 + n0 + 2 * F.lane;
        float a0 = 0.f, a1 = 0.f, b0 = 0.f, b1 = 0.f, c0 = 0.f, c1 = 0.f;
        const int k0 = F.wave * 128;
#pragma unroll 8
        for (int k = 0; k < 128; ++k) { const float2 wv = *(const float2*)(w + (size_t)(k0 + k) * 9216); const float s0 = sc[k0 + k], s1 = sc[1024 + k0 + k], s2 = sc[2048 + k0 + k];
            a0 += s0 * wv.x; a1 += s0 * wv.y; b0 += s1 * wv.x; b1 += s1 * wv.y; c0 += s2 * wv.x; c1 += s2 * wv.y; }
        LAS float* rw = red + F.wave * 384 + 2 * F.lane;
        rw[0] = a0; rw[1] = a1; rw[128] = b0; rw[129] = b1; rw[256] = c0; rw[257] = c1;
        __syncthreads();
        if (F.tid < 384) { float s = 0.f;
#pragma unroll
            for (int w8 = 0; w8 < 8; ++w8) s += red[w8 * 384 + F.tid];
            const int v = F.tid >> 7, n = n0 + (F.tid & 127);
            modv[(size_t)(l * 3 + v) * 9216 + n] = s + inp(I_MODB)[l * 9216 + n]; }
        __syncthreads();
    }
}
__device__ __forceinline__ void rope_tables(Frame& F) {
    float* ct = (float*)(F.ws + WS_ROPE); float* st = ct + SEQ * 32;
    for (int i = F.bid * NTHR + F.tid; i < SEQ * 32; i += F.G * NTHR) {
        const int t = i >> 5, j = i & 31; const int f = j & 15;
        const float inv = exp2f(-(float)f * (13.287712379549449f / 16.0f));
        const float pos = (float)(j < 16 ? (t >> 6) : (t & 63));
        const float ang = pos * inv;
        const double a = (double)ang; const double k = __builtin_rint(a * 0.15915494309189535); const float r = (float)(a - k * 6.283185307179586);
        ct[i] = __cosf(r); st[i] = __sinf(r);
    }
}

struct EArgs { const float* xl_src; const float* xc_src; float* xl_dst; float* xc_dst; const bf16* o; const float* modv_g; int gidx; float gmul; const float* gpost;
               bf16* hdst; const float* modv_h; int shidx, scidx; const float* gpre; int nrows; };
__device__ __forceinline__ void e_phase(Frame& F, const EArgs& A) {
    const int gw = F.bid * NWAVES + F.wave, NGW = F.G * NWAVES;
    for (int r = gw; r < A.nrows; r += NGW) {
        const int v = r < TL ? (r >> 13) : 2;
        const float* xs = r < TL ? A.xl_src + (size_t)r * DM : A.xc_src + (size_t)(r - TL) * DM;
        f32x4 x[4];
#pragma unroll
        for (int j = 0; j < 4; ++j) x[j] = ((const f32x4*)xs)[F.lane + 64 * j];
        if (A.o) {
            const v2u* orow = (const v2u*)(A.o + (size_t)r * DM); f32x4 ov[4]; float ss = 0.f;
#pragma unroll
            for (int j = 0; j < 4; ++j) { const v2u w = orow[F.lane + 64 * j]; ov[j] = (f32x4){bflo(w.x), bfhi(w.x), bflo(w.y), bfhi(w.y)}; ss += (ov[j].x * ov[j].x + ov[j].y * ov[j].y) + (ov[j].z * ov[j].z + ov[j].w * ov[j].w); }
            const float rstd = 1.0f / sqrtf(wave_sum(ss) * (1.0f / DM) + NORM_EPS) * A.gmul;
            const f32x4* gm = (const f32x4*)(A.modv_g + (size_t)v * 9216 + A.gidx * DM); const f32x4* gp = (const f32x4*)A.gpost;
            float* xd = r < TL ? A.xl_dst + (size_t)r * DM : A.xc_dst + (size_t)(r - TL) * DM;
#pragma unroll
            for (int j = 0; j < 4; ++j) { const f32x4 g = gm[F.lane + 64 * j], p = gp[F.lane + 64 * j]; x[j] = x[j] + g * (ov[j] * rstd * p); ((f32x4*)xd)[F.lane + 64 * j] = x[j]; }
        }
        if (A.hdst) {
            float ss = 0.f;
#pragma unroll
            for (int j = 0; j < 4; ++j) ss += (x[j].x * x[j].x + x[j].y * x[j].y) + (x[j].z * x[j].z + x[j].w * x[j].w);
            const float rstd = 1.0f / sqrtf(wave_sum(ss) * (1.0f / DM) + NORM_EPS);
            const f32x4* sh = (const f32x4*)(A.modv_h + (size_t)v * 9216 + A.shidx * DM); const f32x4* scl = (const f32x4*)(A.modv_h + (size_t)v * 9216 + A.scidx * DM); const f32x4* gp = (const f32x4*)A.gpre;
            v2u* hd = (v2u*)(A.hdst + (size_t)r * DM);
#pragma unroll
            for (int j = 0; j < 4; ++j) { const f32x4 s = sh[F.lane + 64 * j], c = scl[F.lane + 64 * j], p = gp[F.lane + 64 * j]; const f32x4 hv = (x[j] * rstd * p) * (1.0f + c) + s;
                v2u w; w.x = pk2(hv.x, hv.y); w.y = pk2(hv.z, hv.w); hd[F.lane + 64 * j] = w; }
        }
    }
}

__device__ __forceinline__ const bf16* zrow(const Frame& F, int row) { return (const bf16*)(F.ws + WS_ACT) + (size_t)row * INWP; }

__device__ __forceinline__ void rope_all(Frame& F) {
    const float* ct = (const float*)(F.ws + WS_ROPE); const float* st = ct + SEQ * 32;
    bf16* qr = (bf16*)(F.ws + WS_QR); bf16* kr = (bf16*)(F.ws + WS_KR);
    for (int i = F.bid * NTHR + F.tid; i < TL * 32; i += F.G * NTHR) {
        const int o = i & 3, hh = (i >> 2) & 7, tok = i >> 5; const int s = tok & (SEQ - 1);
        const bf16* z = zrow(F, tok) + (hh < 6 ? ZQ + 64 * hh : ZK + 64 * (hh - 6)) + 8 * o;
        float x1[8], x2[8]; unpack8(*(const v4u*)z, x1); unpack8(*(const v4u*)(z + 32), x2);
        const f32x4 c0 = *(const f32x4*)(ct + s * 32 + 8 * o), c1 = *(const f32x4*)(ct + s * 32 + 8 * o + 4), s0 = *(const f32x4*)(st + s * 32 + 8 * o), s1 = *(const f32x4*)(st + s * 32 + 8 * o + 4);
        const float sc = hh < 6 ? 0.125f : 1.0f; float o1[8], o2[8];
#pragma unroll
        for (int e = 0; e < 4; ++e) { o1[e] = (x1[e] * c0[e] - x2[e] * s0[e]) * sc; o2[e] = (x2[e] * c0[e] + x1[e] * s0[e]) * sc; o1[e + 4] = (x1[e + 4] * c1[e] - x2[e + 4] * s1[e]) * sc; o2[e + 4] = (x2[e + 4] * c1[e] + x1[e + 4] * s1[e]) * sc; }
        bf16* d = hh < 6 ? qr + (size_t)tok * 384 + 64 * hh + 8 * o : kr + (size_t)tok * 128 + 64 * (hh - 6) + 8 * o;
        *(v4u*)d = (v4u){pk2(o1[0], o1[1]), pk2(o1[2], o1[3]), pk2(o1[4], o1[5]), pk2(o1[6], o1[7])};
        *(v4u*)(d + 32) = (v4u){pk2(o2[0], o2[1]), pk2(o2[2], o2[3]), pk2(o2[4], o2[5]), pk2(o2[6], o2[7])}; }
}
__device__ __forceinline__ void fourier_a_unit(Frame& F, int u) {
    const int b = u >> 7, n2 = u & 127;
    LAS float* tab = (LAS float*)F.lds;
    __syncthreads();
    if (F.tid < 64) { const float a = (float)F.tid * (1.0f / 64.0f); tab[F.tid] = __builtin_amdgcn_cosf(a); tab[64 + F.tid] = __builtin_amdgcn_sinf(a); }
    __syncthreads();
    const int c = F.tid & 255, kh = F.tid >> 8;
    float f[64];
#pragma unroll
    for (int n1 = 0; n1 < 64; ++n1) f[n1] = bf2f(zrow(F, b * SEQ + 128 * n1 + n2)[ZF + c]);
    bf16* far = (bf16*)(F.ws + WS_FA); bf16* fai = far + (size_t)NB * 64 * 128 * 256;
    for (int kk = 0; kk < 32; ++kk) { const int k1 = kh * 32 + kk;
        float sr = 0.f, si = 0.f;
#pragma unroll
        for (int n1 = 0; n1 < 64; ++n1) { const int idx = (n1 * k1) & 63; sr += f[n1] * tab[idx]; si -= f[n1] * tab[64 + idx]; }
        const float tw = (float)(n2 * k1) * (1.0f / 8192.0f); const float tc = __builtin_amdgcn_cosf(tw), ts = -__builtin_amdgcn_sinf(tw);
        const size_t o = (((size_t)b * 64 + k1) * 128 + n2) * 256 + c;
        far[o] = (bf16)f2bf(sr * tc - si * ts); fai[o] = (bf16)f2bf(sr * ts + si * tc);
    }
}
__device__ __forceinline__ void fourier_c_unit(Frame& F, int u) {
    const int b = u >> 7, k1 = (u >> 1) & 63, half = u & 1;
    LAS float* tab = (LAS float*)F.lds;
    LAS float* tab64 = tab + 256;
    LAS float* P = tab + 512;
    __syncthreads();
    if (F.tid < 128) { const float a = (float)F.tid * (1.0f / 128.0f); tab[F.tid] = __builtin_amdgcn_cosf(a); tab[128 + F.tid] = __builtin_amdgcn_sinf(a); }
    if (F.tid >= 128 && F.tid < 192) { const float a = (float)(F.tid - 128) * (1.0f / 64.0f); tab64[F.tid - 128] = __builtin_amdgcn_cosf(a); tab64[64 + F.tid - 128] = __builtin_amdgcn_sinf(a); }
    __syncthreads();
    const int c = F.tid & 255, q = F.tid >> 8;
    const bf16* far = (const bf16*)(F.ws + WS_FA) + (((size_t)b * 64 + k1) * 128) * 256 + c; const bf16* fai = far + (size_t)NB * 64 * 128 * 256;
    float ar[32], ai[32];
#pragma unroll
    for (int i = 0; i < 32; ++i) { ar[i] = 0.f; ai[i] = 0.f; }
    const int k2b = 64 * half + 32 * q;
    for (int n2 = 0; n2 < 128; ++n2) { const float xr = bf2f(far[(size_t)n2 * 256]), xi = bf2f(fai[(size_t)n2 * 256]);
#pragma unroll
        for (int i = 0; i < 32; ++i) { const int idx = (n2 * (k2b + i)) & 127; const float cs = tab[idx], sn = tab[128 + idx];
            ar[i] += xr * cs + xi * sn; ai[i] += xi * cs - xr * sn; } }
    bf16* mix = (bf16*)(F.ws + WS_H);
    const int g = c >> 6;
    float y[32];
#pragma unroll
    for (int i = 0; i < 32; ++i) y[i] = 0.f;
#pragma unroll
    for (int rnd = 0; rnd < 2; ++rnd) {
        __syncthreads();
#pragma unroll
        for (int i = 0; i < 32; ++i) P[(32 * q + i) * 256 + c] = rnd == 0 ? ar[i] : ai[i];
        __syncthreads();
        const int m = c & 63;
        for (int cc = 0; cc < 64; ++cc) { const int idx = (m * cc) & 63; const float t = rnd == 0 ? tab64[idx] : tab64[64 + idx];
#pragma unroll
            for (int i = 0; i < 32; ++i) y[i] += P[(32 * q + i) * 256 + 64 * g + cc] * t; }
    }
    const float scale = 0.0013810679320049757f;
#pragma unroll
    for (int i = 0; i < 32; ++i) { const int k = k1 + 64 * (k2b + i); mix[(size_t)(b * SEQ + k) * DM + c] = (bf16)f2bf(y[i] * scale); }
}
__device__ __forceinline__ void fourier_ctx1_all(Frame& F) {
    float* gr = (float*)(F.ws + WS_GC); float* gi = gr + TC * 256;
    const bf16* wc = (const bf16*)(F.ws + WS_FT + FT_W64C); const bf16* wsn = (const bf16*)(F.ws + WS_FT + FT_W64S);
    for (int i = F.bid * NTHR + F.tid; i < TC * 256; i += F.G * NTHR) { const int tok = i >> 8, gm = i & 255, g = gm >> 6, m = gm & 63;
        const bf16* z = zrow(F, TL + tok) + ZF + 64 * g; float sr = 0.f, si = 0.f;
#pragma unroll
        for (int c8 = 0; c8 < 8; ++c8) { float x[8], cs[8], sn[8]; unpack8(*(const v4u*)(z + 8 * c8), x); unpack8(*(const v4u*)(wc + m * 64 + 8 * c8), cs); unpack8(*(const v4u*)(wsn + m * 64 + 8 * c8), sn);
#pragma unroll
            for (int e = 0; e < 8; ++e) { sr += x[e] * cs[e]; si -= x[e] * sn[e]; } }
        gr[i] = sr; gi[i] = si; }
}
__device__ __forceinline__ void fourier_ctx2_all(Frame& F) {
    const float* gr = (const float*)(F.ws + WS_GC); const float* gi = gr + TC * 256; bf16* mix = (bf16*)(F.ws + WS_H);
    for (int i = F.bid * NTHR + F.tid; i < TC * 256; i += F.G * NTHR) { const int row = i >> 8, gm = i & 255, b = row >> 8, k = row & 255; float y = 0.f;
#pragma unroll 8
        for (int n = 0; n < 256; ++n) { const float a = (float)((k * n) & 255) * (1.0f / 256.0f); y += gr[(b * 256 + n) * 256 + gm] * __builtin_amdgcn_cosf(a) + gi[(b * 256 + n) * 256 + gm] * __builtin_amdgcn_sinf(a); }
        mix[(size_t)(TL + row) * DM + gm] = (bf16)f2bf(y * 0.0078125f); }
}
__device__ __forceinline__ float dot64(const float (&q)[64], const bf16* krow) {
    float s = 0.f;
#pragma unroll
    for (int i = 0; i < 8; ++i) { const v4u w = ((const v4u*)krow)[i];
        s += q[8 * i + 0] * bflo(w.x) + q[8 * i + 1] * bfhi(w.x) + q[8 * i + 2] * bflo(w.y) + q[8 * i + 3] * bfhi(w.y) + q[8 * i + 4] * bflo(w.z) + q[8 * i + 5] * bfhi(w.z) + q[8 * i + 6] * bflo(w.w) + q[8 * i + 7] * bfhi(w.w); }
    return s;
}
__device__ __forceinline__ void attn_v1(Frame& F, int li) {
    const int gw = F.bid * NWAVES + F.wave, NGW = F.G * NWAVES;
    const bf16* qr = (const bf16*)(F.ws + WS_QR); const bf16* kr = (const bf16*)(F.ws + WS_KR); bf16* mix = (bf16*)(F.ws + WS_H);
    const float* sink = inp(I_SINK) + li * 6;
    const int npairs = (li == 0 ? TT : TL) * 6;
    for (int p = gw; p < npairs; p += NGW) {
        const int row = p / 6, hq = p % 6, kvh = hq / 3; const bool isctx = row >= TL;
        const int b = isctx ? (row - TL) >> 8 : row >> 13, s = row & (SEQ - 1);
        float q[64];
        if (!isctx) {
#pragma unroll
            for (int i = 0; i < 8; ++i) { const v4u w = ((const v4u*)(qr + (size_t)row * 384 + 64 * hq))[i];
                q[8 * i] = bflo(w.x); q[8 * i + 1] = bfhi(w.x); q[8 * i + 2] = bflo(w.y); q[8 * i + 3] = bfhi(w.y); q[8 * i + 4] = bflo(w.z); q[8 * i + 5] = bfhi(w.z); q[8 * i + 6] = bflo(w.w); q[8 * i + 7] = bfhi(w.w); }
        } else {
#pragma unroll
            for (int i = 0; i < 8; ++i) { const v4u w = ((const v4u*)(zrow(F, row) + ZQ + 64 * hq))[i];
                q[8 * i] = 0.125f * bflo(w.x); q[8 * i + 1] = 0.125f * bfhi(w.x); q[8 * i + 2] = 0.125f * bflo(w.y); q[8 * i + 3] = 0.125f * bfhi(w.y); q[8 * i + 4] = 0.125f * bflo(w.z); q[8 * i + 5] = 0.125f * bfhi(w.z); q[8 * i + 6] = 0.125f * bflo(w.w); q[8 * i + 7] = 0.125f * bfhi(w.w); }
        }
        float sc[9]; int krow_[9];
        const float NEG = -INFINITY;
        float mx = sink[hq];
#pragma unroll
        for (int r = 0; r < 9; ++r) {
            if (r < 5) {
                const int kp = s - 128 + 64 * r + F.lane; const bool ok = !isctx && kp >= 0 && kp < SEQ && kp <= s + 128;
                const int kc = ok ? kp : 0; krow_[r] = b * SEQ + kc;
                const float d = isctx ? 0.f : dot64(q, kr + (size_t)(b * SEQ + kc) * 128 + 64 * kvh);
                sc[r] = ok ? d : NEG;
            } else {
                const int kc = 64 * (r - 5) + F.lane; krow_[r] = TL + b * CTX + kc;
                sc[r] = dot64(q, zrow(F, TL + b * CTX + kc) + ZK + 64 * kvh);
            }
            mx = fmaxf(mx, sc[r]);
        }
        mx = wave_max(mx);
        float den = 0.f;
#pragma unroll
        for (int r = 0; r < 9; ++r) { sc[r] = __expf(sc[r] - mx); den += sc[r]; }
        den = wave_sum(den) + __expf(sink[hq] - mx);
        float acc = 0.f;
#pragma unroll
        for (int r = 0; r < 9; ++r) {
            if (r < 5 && isctx) continue;
            for (int kk = 0; kk < 64; ++kk) { const float pk = __builtin_bit_cast(float, __builtin_amdgcn_readlane(__builtin_bit_cast(int, sc[r]), kk)); const int kr_ = __builtin_amdgcn_readlane(krow_[r], kk);
                acc += pk * bf2f(zrow(F, kr_)[ZV + 64 * kvh + F.lane]); }
        }
        mix[(size_t)row * DM + 256 + 64 * hq + F.lane] = (bf16)f2bf(acc / den);
    }
}

typedef short bf16x8 __attribute__((ext_vector_type(8)));
#define MFMA16(a, b, c) __builtin_amdgcn_mfma_f32_16x16x32_bf16(a, b, c, 0, 0, 0)
__device__ __forceinline__ bf16x8 mk8(unsigned a, unsigned b, unsigned c, unsigned d) { const v4u v = {a, b, c, d}; return __builtin_bit_cast(bf16x8, v); }
typedef __bf16 bf16x2_t __attribute__((ext_vector_type(2)));
typedef float f32x2_t __attribute__((ext_vector_type(2)));
__device__ __forceinline__ unsigned cvtpk(float lo, float hi) { const f32x2_t f = {lo, hi}; return __builtin_bit_cast(unsigned, __builtin_convertvector(f, bf16x2_t)); }
constexpr int NSC = 66;
constexpr int IM_AI = 0, IM_RI = 4608, IM_BI = 9216, IM_KI = 13824, IM_BKT = 18432, IM_VT = 28672, IM_GAM = 33792, IMG_BYTES = 34816;
constexpr int L_IMG0 = 0, L_IMG1 = IMG_BYTES, L_PKG = 2 * IMG_BYTES, L_YL = L_PKG + 8192, L_VB = L_YL + 128 * 68 * 4, L_BON = L_VB + 128 * 64 * 2, L_CST = L_BON + 512, L_RW_END = L_CST + 2 * 3072;
static_assert(L_RW_END <= 146432, "rwkv LDS map");
constexpr size_t SUM_SLOT = 24576;

__device__ __forceinline__ void lora_transposes(Frame& F) {
    bf16* w2t = (bf16*)(F.ws + WS_W2T); bf16* a2t = (bf16*)(F.ws + WS_A2T); bf16* g2t = (bf16*)(F.ws + WS_G2T);
    const float* w2 = inp(I_W2); const float* a2 = inp(I_A2); const float* g2 = inp(I_G2);
    for (int i = F.bid * NTHR + F.tid; i < 4 * 384 * 64; i += F.G * NTHR) { const int r = i & 63, col = (i >> 6) % 384, ld = i / (384 * 64);
        w2t[i] = (bf16)f2bf(w2[((size_t)ld * 64 + r) * RW + col]); a2t[i] = (bf16)f2bf(a2[((size_t)ld * 64 + r) * RW + col]); }
    for (int i = F.bid * NTHR + F.tid; i < 2 * 384 * 128; i += F.G * NTHR) { const int r = i & 127, col = (i >> 7) % 384, l = i / (384 * 128);
        g2t[i] = (bf16)f2bf(g2[((size_t)l * 128 + r) * RW + col]); }
}

__device__ __forceinline__ float softplus_fast(float x) { return fmaxf(x, 0.f) + __logf(1.0f + __expf(-fabsf(x))); }
__device__ __forceinline__ float tanh_fast(float x) { return 1.0f - 2.0f * __builtin_amdgcn_rcpf(1.0f + __expf(2.0f * x)); }
template <int CTRL> __device__ __forceinline__ float dpp_f(float v) { return __builtin_bit_cast(float, __builtin_amdgcn_update_dpp(0, __builtin_bit_cast(int, v), CTRL, 0xf, 0xf, true)); }
__device__ __forceinline__ void lora_pass(Frame& F, int li) {
    const int q = F.lane >> 4, c16 = F.lane & 15;
#pragma unroll 1
    for (int dir = 0; dir < 2; ++dir) {
        bf16* LW = (bf16*)(F.ws + WS_LW) + (size_t)dir * TT * RW; bf16* IC = (bf16*)(F.ws + WS_IC) + (size_t)dir * TT * RW;
        const bf16* w2t = (const bf16*)(F.ws + WS_W2T) + (size_t)(li * 2 + dir) * 384 * 64; const bf16* a2t = (const bf16*)(F.ws + WS_A2T) + (size_t)(li * 2 + dir) * 384 * 64;
        bf16x8 aw[3][2], aa[3][2]; f32x4 w0v[3], a0v[3];
#pragma unroll
        for (int cti = 0; cti < 3; ++cti) { const int ct = 3 * F.wave + cti, col = 16 * ct + c16;
#pragma unroll
            for (int k = 0; k < 2; ++k) { aw[cti][k] = *(const bf16x8*)(w2t + (size_t)col * 64 + 32 * k + 8 * q); aa[cti][k] = *(const bf16x8*)(a2t + (size_t)col * 64 + 32 * k + 8 * q); }
            w0v[cti] = *(const f32x4*)(inp(I_W0) + (li * 2 + dir) * RW + 16 * ct + 4 * q); a0v[cti] = *(const f32x4*)(inp(I_A0) + (li * 2 + dir) * RW + 16 * ct + 4 * q); }
#pragma unroll 1
        for (int rt = F.bid; rt < TT / 16; rt += F.G) {
            const bf16* z = zrow(F, 16 * rt + c16);
            bf16x8 bw[2], ba[2];
#pragma unroll
            for (int k = 0; k < 2; ++k) { const v4u zw = *(const v4u*)(z + ZW + 64 * dir + 32 * k + 8 * q); ba[k] = *(const bf16x8*)(z + ZA + 64 * dir + 32 * k + 8 * q);
                bw[k] = mk8(cvtpk(tanh_fast(bflo(zw.x)), tanh_fast(bfhi(zw.x))), cvtpk(tanh_fast(bflo(zw.y)), tanh_fast(bfhi(zw.y))), cvtpk(tanh_fast(bflo(zw.z)), tanh_fast(bfhi(zw.z))), cvtpk(tanh_fast(bflo(zw.w)), tanh_fast(bfhi(zw.w)))); }
#pragma unroll
            for (int cti = 0; cti < 3; ++cti) { const int ct = 3 * F.wave + cti;
                f32x4 dw = {0.f, 0.f, 0.f, 0.f}, da = {0.f, 0.f, 0.f, 0.f};
#pragma unroll
                for (int k = 0; k < 2; ++k) { dw = MFMA16(aw[cti][k], bw[k], dw); da = MFMA16(aa[cti][k], ba[k], da); }
                float lw[4], ic[4];
#pragma unroll
                for (int e = 0; e < 4; ++e) { const float x = w0v[cti][e] + dw[e]; const float wl = -softplus_fast(-x) - 0.5f; lw[e] = -__expf(wl); ic[e] = __builtin_amdgcn_rcpf(1.0f + __expf(-(a0v[cti][e] + da[e]))); }
                if (dir == 0) {
#pragma unroll
                    for (int e = 0; e < 4; ++e) { lw[e] += dpp_f<0x111>(lw[e]); lw[e] += dpp_f<0x112>(lw[e]); lw[e] += dpp_f<0x114>(lw[e]); lw[e] += dpp_f<0x118>(lw[e]); } }
                else {
#pragma unroll
                    for (int e = 0; e < 4; ++e) { lw[e] += dpp_f<0x101>(lw[e]); lw[e] += dpp_f<0x102>(lw[e]); lw[e] += dpp_f<0x104>(lw[e]); lw[e] += dpp_f<0x108>(lw[e]); } }
#pragma unroll
                for (int e = 0; e < 4; ++e) lw[e] = __expf(lw[e]);
                if (c16 == (dir == 0 ? 15 : 0)) *(f32x4*)((float*)(F.ws + WS_GAM32) + ((size_t)dir * (TT / 16) + rt) * RW + 16 * ct + 4 * q) = (f32x4){lw[0], lw[1], lw[2], lw[3]};
                const size_t o = (size_t)(16 * rt + c16) * RW + 16 * ct + 4 * q;
                v2u w; w.x = cvtpk(lw[0], lw[1]); w.y = cvtpk(lw[2], lw[3]); *(v2u*)(LW + o) = w; w.x = cvtpk(ic[0], ic[1]); w.y = cvtpk(ic[2], ic[3]); *(v2u*)(IC + o) = w; }
        }
    }
}
struct ChainCtx { int dir, b, h, li; float kkw, kaw, rkw; float cw[3][3]; };
__device__ __forceinline__ void chain_consts(ChainCtx& C, int li, int dir, int b, int h, int j) {
    C.dir = dir; C.b = b; C.h = h; C.li = li; const int ch = 64 * h + j;
    C.kkw = inp(I_KK)[li * RW + ch]; C.kaw = inp(I_KA)[li * RW + ch]; C.rkw = inp(I_RK)[li * RW + ch];
#pragma unroll
    for (int t = 0; t < 3; ++t)
#pragma unroll
        for (int qq = 0; qq < 3; ++qq) C.cw[t][qq] = inp(I_CONV)[(size_t)(li * 3 + t) * (3 * RW) + qq * RW + ch];
}
template <int TPT, bool BONUS>
__device__ __forceinline__ void prep_round(Frame& F, const ChainCtx& C, LAS unsigned char* img, int j, int tg, bool isctx, int step0, LAS unsigned char* lds_vb, LAS float* lds_bon, int pos0_local) {
    const int L = isctx ? CTX : SEQ, rbase = isctx ? TL + C.b * CTX : C.b * SEQ, ch = 64 * C.h + j;
    const bf16* LW = (const bf16*)(F.ws + WS_LW) + (size_t)C.dir * TT * RW + ch; const bf16* IC = (const bf16*)(F.ws + WS_IC) + (size_t)C.dir * TT * RW + ch;
    const int tok0 = tg * TPT, blk = tok0 >> 4;
    float cum = 0.f;
    for (int t = blk * 16; t < tok0; ++t) { const int s = step0 + t; const int p = C.dir ? L - 1 - s : s; cum += bf2f(LW[(size_t)(rbase + p) * RW]); }
    float eprev = __expf(cum);
    const int pj = (j & ~31) | (((j & 15) >> 2) << 3) | (((j >> 4) & 1) << 2) | (j & 3);
    LAS bf16* AI = (LAS bf16*)(img + IM_AI) + blk * 1152, *RI = (LAS bf16*)(img + IM_RI) + blk * 1152, *BI = (LAS bf16*)(img + IM_BI) + blk * 1152, *KI = (LAS bf16*)(img + IM_KI) + blk * 1152;
    LAS bf16* BKT = (LAS bf16*)(img + IM_BKT) + blk * 2560 + j * 40; LAS bf16* VT = (LAS bf16*)(img + IM_VT) + blk * 1280 + j * 20; LAS float* GAM = (LAS float*)(img + IM_GAM) + blk * 64;
#pragma unroll 2
    for (int u = 0; u < TPT; ++u) { const int t = tok0 + u, tb = t & 15; const int s = step0 + t; const int p = C.dir ? L - 1 - s : s; const int row = rbase + p;
        const float lw = bf2f(LW[(size_t)row * RW]), ai = bf2f(IC[(size_t)row * RW]);
        float rv = 0.f, kv = 0.f, vv = 0.f;
#pragma unroll
        for (int tt = 0; tt < 3; ++tt) { const int pp = p + tt - 1; if (pp >= 0 && pp < L) { const bf16* z = zrow(F, rbase + pp); rv += C.cw[tt][0] * bf2f(z[ZRR + ch]); kv += C.cw[tt][1] * bf2f(z[ZRK + ch]); vv += C.cw[tt][2] * bf2f(z[ZRV + ch]); } }
        const float kkr = kv * C.kkw; const float ss = wave_sum(kkr * kkr); const float kk = kkr * (1.0f / sqrtf(fmaxf(ss, 1e-24f)));
        const float kd = kv * (1.0f + (ai - 1.0f) * C.kaw);
        const float ec = eprev * __expf(lw), en = 1.0f / ec;
        AI[tb * 72 + pj] = (bf16)f2bf(-kk * eprev); RI[tb * 72 + pj] = (bf16)f2bf(rv * ec);
        const bf16 bt = (bf16)f2bf(kk * ai * en), kt = (bf16)f2bf(kd * en);
        BI[tb * 72 + pj] = bt; KI[tb * 72 + pj] = kt;
        BKT[(tb >> 2) * 8 + (tb & 3)] = bt; BKT[(tb >> 2) * 8 + 4 + (tb & 3)] = kt;
        VT[tb] = (bf16)f2bf(vv);
        if (tb == 15) GAM[j] = ec;
        if constexpr (BONUS) { const float bs = wave_sum(rv * kv * C.rkw); const int pl = C.dir ? pos0_local - t : pos0_local + t;
            ((LAS bf16*)lds_vb)[pl * 64 + j] = (bf16)f2bf(vv); if (j == 0) lds_bon[pl] = bs; }
        eprev = ec; }
}
__device__ __forceinline__ void chain_consts_lds(Frame& F, LAS float* cst, int li, int h, int t256) {
    for (int i = t256; i < 12 * 64; i += 256) { const int k = i >> 6, j = i & 63, ch = 64 * h + j; float v;
        if (k == 0) v = inp(I_KK)[li * RW + ch]; else if (k == 1) v = inp(I_KA)[li * RW + ch]; else if (k == 2) v = inp(I_RK)[li * RW + ch];
        else { const int tt = (k - 3) / 3, w = (k - 3) % 3; v = inp(I_CONV)[(size_t)(li * 3 + tt) * (3 * RW) + w * RW + ch]; }
        cst[i] = v; }
}
struct PrepRaw { v4u ecw, icv, epw, zr[3], zk[3], zv[3]; };
__device__ __forceinline__ void prep_load(Frame& F, PrepRaw& R, int dir, int b, int h, int tl, int o, bool isctx, int step0) {
    const int L = isctx ? CTX : SEQ, rbase = isctx ? TL + b * CTX : b * SEQ, ch0 = 64 * h + 8 * o;
    const int s = step0 + tl; const int p = dir ? L - 1 - s : s; const int row = rbase + p, tb = tl & 15;
    { const bf16* LW = (const bf16*)(F.ws + WS_LW) + (size_t)dir * TT * RW + ch0; const bf16* IC = (const bf16*)(F.ws + WS_IC) + (size_t)dir * TT * RW + ch0;
      R.ecw = *(const v4u*)(LW + (size_t)row * RW); R.icv = *(const v4u*)(IC + (size_t)row * RW); R.epw = *(const v4u*)(LW + (size_t)(tb == 0 ? row : (dir ? row + 1 : row - 1)) * RW); }
#pragma unroll
    for (int tt = 0; tt < 3; ++tt) { const int pp = p + tt - 1; const bool ok = pp >= 0 && pp < L; const bf16* z = zrow(F, rbase + (ok ? pp : p)) + ch0;
        const v4u z0 = {0u, 0u, 0u, 0u};
        R.zr[tt] = ok ? *(const v4u*)(z + ZRR) : z0; R.zk[tt] = ok ? *(const v4u*)(z + ZRK) : z0; R.zv[tt] = ok ? *(const v4u*)(z + ZRV) : z0; }
}
__device__ __forceinline__ void prep_compute(Frame& F, const PrepRaw& R, const LAS float* cst, LAS unsigned char* img, int dir, int b, int h, int tl, int o, bool isctx, int step0, LAS unsigned char* lds_vb, LAS float* lds_bon, int pos0_local) {
    const bool BONUS = lds_vb != nullptr;
    const int L = isctx ? CTX : SEQ, rbase = isctx ? TL + b * CTX : b * SEQ, ch0 = 64 * h + 8 * o;
    const int blk = tl >> 4, tb = tl & 15;
    const int s = step0 + tl; const int p = dir ? L - 1 - s : s; const int row = rbase + p;
    const v4u ecw = R.ecw, icv = R.icv, epw = R.epw;
    v4u zr[3], zk[3], zv[3];
#pragma unroll
    for (int tt = 0; tt < 3; ++tt) { zr[tt] = R.zr[tt]; zk[tt] = R.zk[tt]; zv[tt] = R.zv[tt]; }
    float ecf[8], epf[8], ai[8], rv[8], kv[8], vv[8];
    unpack8(ecw, ecf); unpack8(epw, epf); unpack8(icv, ai);
#pragma unroll
    for (int e = 0; e < 8; ++e) { rv[e] = 0.f; kv[e] = 0.f; vv[e] = 0.f; }
#pragma unroll
    for (int tt = 0; tt < 3; ++tt) { float a[8], bq[8], cq[8]; unpack8(zr[tt], a); unpack8(zk[tt], bq); unpack8(zv[tt], cq);
        const LAS f32x4* w0 = (const LAS f32x4*)(cst + (3 + tt * 3 + 0) * 64 + 8 * o); const LAS f32x4* w1 = (const LAS f32x4*)(cst + (3 + tt * 3 + 1) * 64 + 8 * o); const LAS f32x4* w2 = (const LAS f32x4*)(cst + (3 + tt * 3 + 2) * 64 + 8 * o);
        const f32x4 w0a = w0[0], w0b = w0[1], w1a = w1[0], w1b = w1[1], w2a = w2[0], w2b = w2[1];
#pragma unroll
        for (int e = 0; e < 4; ++e) { rv[e] += w0a[e] * a[e]; rv[e + 4] += w0b[e] * a[e + 4]; kv[e] += w1a[e] * bq[e]; kv[e + 4] += w1b[e] * bq[e + 4]; vv[e] += w2a[e] * cq[e]; vv[e + 4] += w2b[e] * cq[e + 4]; } }
    float kkw[8], kaw[8];
    { const LAS f32x4* a = (const LAS f32x4*)(cst + 0 * 64 + 8 * o); const LAS f32x4* bq = (const LAS f32x4*)(cst + 1 * 64 + 8 * o); const f32x4 a0 = a[0], a1 = a[1], b0 = bq[0], b1 = bq[1];
#pragma unroll
      for (int e = 0; e < 4; ++e) { kkw[e] = a0[e]; kkw[e + 4] = a1[e]; kaw[e] = b0[e]; kaw[e + 4] = b1[e]; } }
    float kkr[8], ss = 0.f;
#pragma unroll
    for (int e = 0; e < 8; ++e) { kkr[e] = kv[e] * kkw[e]; ss += kkr[e] * kkr[e]; }
    ss += __shfl_xor(ss, 1); ss += __shfl_xor(ss, 2); ss += __shfl_xor(ss, 4);
    const float rn = 1.0f / sqrtf(fmaxf(ss, 1e-24f));
    float At[8], Rt[8], Bt[8], Kt[8];
#pragma unroll
    for (int e = 0; e < 8; ++e) { const float kk = kkr[e] * rn, kd = kv[e] * (1.0f + (ai[e] - 1.0f) * kaw[e]); const float eprev = tb == 0 ? 1.0f : epf[e]; const float ec = ecf[e], en = 1.0f / ec;
        At[e] = -kk * eprev; Rt[e] = rv[e] * ec; Bt[e] = kk * ai[e] * en; Kt[e] = kd * en; }
    const int P0 = 32 * (o >> 2) + 16 * (o & 1) + 4 * ((o >> 1) & 1);
    LAS bf16* AI = (LAS bf16*)(img + IM_AI) + blk * 1152 + tb * 72 + P0, *RI = (LAS bf16*)(img + IM_RI) + blk * 1152 + tb * 72 + P0, *BI = (LAS bf16*)(img + IM_BI) + blk * 1152 + tb * 72 + P0, *KI = (LAS bf16*)(img + IM_KI) + blk * 1152 + tb * 72 + P0;
    unsigned bp[4], kp[4];
#pragma unroll
    for (int e = 0; e < 4; ++e) { bp[e] = cvtpk(Bt[2 * e], Bt[2 * e + 1]); kp[e] = cvtpk(Kt[2 * e], Kt[2 * e + 1]); }
    *(LAS v2u*)AI = (v2u){cvtpk(At[0], At[1]), cvtpk(At[2], At[3])}; *(LAS v2u*)(AI + 8) = (v2u){cvtpk(At[4], At[5]), cvtpk(At[6], At[7])};
    *(LAS v2u*)RI = (v2u){cvtpk(Rt[0], Rt[1]), cvtpk(Rt[2], Rt[3])}; *(LAS v2u*)(RI + 8) = (v2u){cvtpk(Rt[4], Rt[5]), cvtpk(Rt[6], Rt[7])};
    *(LAS v2u*)BI = (v2u){bp[0], bp[1]}; *(LAS v2u*)(BI + 8) = (v2u){bp[2], bp[3]};
    *(LAS v2u*)KI = (v2u){kp[0], kp[1]}; *(LAS v2u*)(KI + 8) = (v2u){kp[2], kp[3]};
    LAS bf16* BKT = (LAS bf16*)(img + IM_BKT) + blk * 2560 + (8 * o) * 40 + (tb >> 2) * 8 + (tb & 3); LAS bf16* VT = (LAS bf16*)(img + IM_VT) + blk * 1280 + (8 * o) * 20 + tb;
    const unsigned vp[4] = {cvtpk(vv[0], vv[1]), cvtpk(vv[2], vv[3]), cvtpk(vv[4], vv[5]), cvtpk(vv[6], vv[7])};
#pragma unroll
    for (int e = 0; e < 8; ++e) { const unsigned bb = bp[e >> 1], kq = kp[e >> 1], vq = vp[e >> 1];
        BKT[e * 40] = (bf16)((e & 1) ? (bb >> 16) : (bb & 0xffff)); BKT[e * 40 + 4] = (bf16)((e & 1) ? (kq >> 16) : (kq & 0xffff)); VT[e * 20] = (bf16)((e & 1) ? (vq >> 16) : (vq & 0xffff)); }
    if (tb == 15) { const f32x4* gs = (const f32x4*)((const float*)(F.ws + WS_GAM32) + ((size_t)dir * (TT / 16) + (row >> 4)) * RW + ch0); LAS f32x4* G = (LAS f32x4*)((LAS float*)(img + IM_GAM) + blk * 64 + 8 * o); G[0] = gs[0]; G[1] = gs[1]; }
    if (BONUS) { float bs = 0.f; const LAS f32x4* rk = (const LAS f32x4*)(cst + 2 * 64 + 8 * o); const f32x4 r0 = rk[0], r1 = rk[1];
#pragma unroll
        for (int e = 0; e < 4; ++e) bs += rv[e] * kv[e] * r0[e] + rv[e + 4] * kv[e + 4] * r1[e];
        bs += __shfl_xor(bs, 1); bs += __shfl_xor(bs, 2); bs += __shfl_xor(bs, 4);
        const int pl = dir ? pos0_local - tl : pos0_local + tl;
        *(LAS v4u*)(lds_vb + (pl * 64 + 8 * o) * 2) = (v4u){vp[0], vp[1], vp[2], vp[3]}; if (o == 0) lds_bon[pl] = bs; }
}
template <bool WANT_Y>
__device__ __forceinline__ void block_package(LAS unsigned char* img, int blk, LAS unsigned* pkg, int lane) {
    const int q = lane >> 4, c = lane & 15;
    f32x4 mab = {0.f, 0.f, 0.f, 0.f}, mak = mab, mbr = mab, mkr = mab;
#pragma unroll
    for (int k = 0; k < 2; ++k) { const int o = blk * 2304 + c * 144 + k * 64 + q * 16;
        const bf16x8 bi = *(const LAS bf16x8*)(img + IM_BI + o), ki = *(const LAS bf16x8*)(img + IM_KI + o), ai = *(const LAS bf16x8*)(img + IM_AI + o);
        mab = MFMA16(bi, ai, mab); mak = MFMA16(ki, ai, mak);
        if constexpr (WANT_Y) { const bf16x8 ri = *(const LAS bf16x8*)(img + IM_RI + o); mbr = MFMA16(bi, ri, mbr); mkr = MFMA16(ki, ri, mkr); } }
#pragma unroll
    for (int e = 0; e < 4; ++e) { const int s = 4 * q + e; if (!(s < c)) { mab[e] = 0.f; mak[e] = 0.f; } if (!(s <= c)) { mbr[e] = 0.f; mkr[e] = 0.f; } }
    f32x4 mabT = {0.f, 0.f, 0.f, 0.f};
#pragma unroll
    for (int k = 0; k < 2; ++k) { const int o = blk * 2304 + c * 144 + k * 64 + q * 16; mabT = MFMA16(*(const LAS bf16x8*)(img + IM_AI + o), *(const LAS bf16x8*)(img + IM_BI + o), mabT); }
#pragma unroll
    for (int e = 0; e < 4; ++e) if (!(c < 4 * q + e)) mabT[e] = 0.f;
    const f32x4 z4 = {0.f, 0.f, 0.f, 0.f};
#define OPND(x) mk8(cvtpk((x)[0], (x)[1]), cvtpk((x)[2], (x)[3]), 0u, 0u)
    const bf16x8 oM = OPND(mab), oMT = OPND(mabT);
    const f32x4 m2 = MFMA16(oMT, oM, z4), m2T = MFMA16(oM, oMT, z4);
    const bf16x8 oM2 = OPND(m2), oM2T = OPND(m2T);
    const f32x4 m4 = MFMA16(oM2T, oM2, z4), m4T = MFMA16(oM2, oM2T, z4);
    const f32x4 m8T = MFMA16(OPND(m4), OPND(m4T), z4);
    f32x4 nn = m2;
#pragma unroll
    for (int e = 0; e < 4; ++e) nn[e] += (4 * q + e == c) ? 1.0f : 0.0f;
    nn = MFMA16(oMT, OPND(nn), nn);
    nn = MFMA16(OPND(m4T), OPND(nn), nn);
    nn = MFMA16(OPND(m8T), OPND(nn), nn);
#undef OPND
    pkg[0 * 64 + lane] = cvtpk(nn[0], nn[1]); pkg[1 * 64 + lane] = cvtpk(nn[2], nn[3]);
    pkg[2 * 64 + lane] = cvtpk(mak[0], mak[1]); pkg[3 * 64 + lane] = cvtpk(mak[2], mak[3]);
    if constexpr (WANT_Y) { pkg[4 * 64 + lane] = cvtpk(mbr[0], mbr[1]); pkg[5 * 64 + lane] = cvtpk(mbr[2], mbr[3]); pkg[6 * 64 + lane] = cvtpk(mkr[0], mkr[1]); pkg[7 * 64 + lane] = cvtpk(mkr[2], mkr[3]); }
}
template <bool WANT_Y, bool HAS_V>
__device__ __forceinline__ f32x4 block_scan(LAS unsigned char* img, int blk, const LAS unsigned* pkg, f32x4 (&S)[4], int wq, int lane) {
    const int q = lane >> 4, c = lane & 15;
    bf16x8 Sb[2];
#pragma unroll
    for (int k = 0; k < 2; ++k) Sb[k] = mk8(cvtpk(S[2 * k][0], S[2 * k][1]), cvtpk(S[2 * k][2], S[2 * k][3]), cvtpk(S[2 * k + 1][0], S[2 * k + 1][1]), cvtpk(S[2 * k + 1][2], S[2 * k + 1][3]));
    v2u vpk = {0u, 0u};
    if constexpr (HAS_V) vpk = *(const LAS v2u*)(img + IM_VT + blk * 2560 + (c + 16 * wq) * 40 + q * 8);
    const int ao = blk * 2304 + c * 144 + q * 16;
    f32x4 rhs = {0.f, 0.f, 0.f, 0.f};
    rhs = MFMA16(*(const LAS bf16x8*)(img + IM_AI + ao), Sb[0], rhs); rhs = MFMA16(*(const LAS bf16x8*)(img + IM_AI + ao + 64), Sb[1], rhs);
    if constexpr (HAS_V) rhs = MFMA16(mk8(0u, 0u, pkg[2 * 64 + lane], pkg[3 * 64 + lane]), mk8(0u, 0u, vpk.x, vpk.y), rhs);
    f32x4 u = {0.f, 0.f, 0.f, 0.f};
    u = MFMA16(mk8(pkg[0 * 64 + lane], pkg[1 * 64 + lane], 0u, 0u), mk8(cvtpk(rhs[0], rhs[1]), cvtpk(rhs[2], rhs[3]), 0u, 0u), u);
    const bf16x8 UV = mk8(cvtpk(u[0], u[1]), cvtpk(u[2], u[3]), vpk.x, vpk.y);
    f32x4 y = {0.f, 0.f, 0.f, 0.f};
    if constexpr (WANT_Y) { y = MFMA16(*(const LAS bf16x8*)(img + IM_RI + ao), Sb[0], y); y = MFMA16(*(const LAS bf16x8*)(img + IM_RI + ao + 64), Sb[1], y);
        y = MFMA16(mk8(pkg[4 * 64 + lane], pkg[5 * 64 + lane], pkg[6 * 64 + lane], pkg[7 * 64 + lane]), UV, y); }
#pragma unroll
    for (int T = 0; T < 4; ++T) { const bf16x8 bkt = *(const LAS bf16x8*)(img + IM_BKT + blk * 5120 + (16 * T + c) * 80 + q * 16);
        S[T] = MFMA16(bkt, UV, S[T]); const f32x4 g = *(const LAS f32x4*)(img + IM_GAM + blk * 256 + (16 * T + 4 * q) * 4); S[T] = S[T] * g; }
    return y;
}
__device__ __forceinline__ unsigned char* sum_slot(Frame& F, int chain, int sc) { return F.ws + WS_SUM + (size_t)(chain * NSC + sc) * SUM_SLOT; }

__device__ __forceinline__ void rwkv_pass1_pair(Frame& F, int li, int pair) {
    const int g = F.wave >> 2, wq = F.wave & 3, u = 2 * pair + g;
    const int chain = u / (NSC - 1), sc = u % (NSC - 1);
    const int dir = chain / 12, b = (chain / 6) & 1, h = chain % 6;
    const bool isctx = sc < 2; const int scl = isctx ? sc : sc - 2;
    LAS unsigned char* img = F.lds + (g ? L_IMG1 : L_IMG0); LAS unsigned* pkg = (LAS unsigned*)(F.lds + L_PKG) + g * 1024;
    LAS float* cst = (LAS float*)(F.lds + L_CST) + g * 768;
    __syncthreads();
    chain_consts_lds(F, cst, li, h, F.tid & 255);
    const int q = F.lane >> 4, c = F.lane & 15;
    f32x4 SB[4], SA[4];
#pragma unroll
    for (int T = 0; T < 4; ++T)
#pragma unroll
        for (int e = 0; e < 4; ++e) { SB[T][e] = 0.0f; SA[T][e] = (16 * T + 4 * q + e == c + 16 * wq) ? 1.0f : 0.0f; }
    PrepRaw R;
    prep_load(F, R, dir, b, h, 8 * wq + (F.lane >> 3), F.lane & 7, isctx, 128 * scl);
#pragma unroll 1
    for (int rd = 0; rd < 4; ++rd) {
        __syncthreads();
        prep_compute(F, R, cst, img, dir, b, h, 8 * wq + (F.lane >> 3), F.lane & 7, isctx, 128 * scl + 32 * rd, nullptr, nullptr, 0);
        __syncthreads();
        if (rd < 3) prep_load(F, R, dir, b, h, 8 * wq + (F.lane >> 3), F.lane & 7, isctx, 128 * scl + 32 * (rd + 1));
        if (wq < 2) block_package<false>(img, wq, pkg + wq * 512, F.lane);
        __syncthreads();
#pragma unroll
        for (int blk = 0; blk < 2; ++blk) { block_scan<false, true>(img, blk, pkg + blk * 512, SB, wq, F.lane); block_scan<false, false>(img, blk, pkg + blk * 512, SA, wq, F.lane); }
    }
    unsigned char* slot = sum_slot(F, chain, sc);
    { f32x4* braw = (f32x4*)slot;
#pragma unroll
      for (int T = 0; T < 4; ++T) braw[(wq * 4 + T) * 64 + F.lane] = SB[T]; }
    { bf16* aim = (bf16*)(slot + 16384); const int kap = wq >> 1, e = (F.lane & 3) + 4 * (wq & 1), qc = c >> 2;
#pragma unroll
      for (int T = 0; T < 4; ++T)
#pragma unroll
          for (int r = 0; r < 4; ++r) { const int lc = (4 * q + r) + 16 * qc; aim[((T * 2 + kap) * 64 + lc) * 8 + e] = (bf16)f2bf(SA[T][r]); } }
}
__device__ __forceinline__ void rwkv_pass2_chain(Frame& F, int chain) {
    if (F.wave >= 4) return;
    const int wq = F.wave;
    f32x4 S[4];
#pragma unroll
    for (int T = 0; T < 4; ++T) S[T] = (f32x4){0.f, 0.f, 0.f, 0.f};
    f32x4 Bc[4]; bf16x8 af[4][2];
    { unsigned char* slot = sum_slot(F, chain, 0); const f32x4* braw = (const f32x4*)slot; const bf16* aim = (const bf16*)(slot + 16384);
#pragma unroll
      for (int T = 0; T < 4; ++T) { Bc[T] = braw[(wq * 4 + T) * 64 + F.lane];
#pragma unroll
          for (int k = 0; k < 2; ++k) af[T][k] = *(const bf16x8*)(aim + ((T * 2 + k) * 64 + F.lane) * 8); } }
#pragma unroll 1
    for (int sc = 0; sc < NSC - 1; ++sc) {
        f32x4* braw = (f32x4*)sum_slot(F, chain, sc);
        f32x4 Bn[4]; bf16x8 an[4][2];
        if (sc + 1 < NSC - 1) { unsigned char* slot = sum_slot(F, chain, sc + 1); const f32x4* bq = (const f32x4*)slot; const bf16* aim = (const bf16*)(slot + 16384);
#pragma unroll
            for (int T = 0; T < 4; ++T) { Bn[T] = bq[(wq * 4 + T) * 64 + F.lane];
#pragma unroll
                for (int k = 0; k < 2; ++k) an[T][k] = *(const bf16x8*)(aim + ((T * 2 + k) * 64 + F.lane) * 8); } }
        else {
#pragma unroll
            for (int T = 0; T < 4; ++T) { Bn[T] = Bc[T]; an[T][0] = af[T][0]; an[T][1] = af[T][1]; } }
        bf16x8 Sb[2];
#pragma unroll
        for (int k = 0; k < 2; ++k) Sb[k] = mk8(cvtpk(S[2 * k][0], S[2 * k][1]), cvtpk(S[2 * k][2], S[2 * k][3]), cvtpk(S[2 * k + 1][0], S[2 * k + 1][1]), cvtpk(S[2 * k + 1][2], S[2 * k + 1][3]));
#pragma unroll
        for (int T = 0; T < 4; ++T) { braw[(wq * 4 + T) * 64 + F.lane] = S[T]; f32x4 a = MFMA16(af[T][0], Sb[0], Bc[T]); S[T] = MFMA16(af[T][1], Sb[1], a); }
#pragma unroll
        for (int T = 0; T < 4; ++T) { Bc[T] = Bn[T]; af[T][0] = an[T][0]; af[T][1] = an[T][1]; }
    }
    { f32x4* braw = (f32x4*)sum_slot(F, chain, NSC - 1);
#pragma unroll
      for (int T = 0; T < 4; ++T) braw[(wq * 4 + T) * 64 + F.lane] = S[T]; }
}
__device__ __forceinline__ void rwkv_pass3_unit(Frame& F, int li, int u) {
    const int pc = u % NSC, bh = u / NSC, b = bh / 6, h = bh % 6;
    const bool isctx = pc < 2; const int pcl = isctx ? pc : pc - 2, nsc = isctx ? 2 : 64;
    const int dir = F.wave >> 2, wq = F.wave & 3, q = F.lane >> 4, c = F.lane & 15;
    const int sc = dir == 0 ? pc : (isctx ? 1 - pcl : 2 + 63 - pcl);
    const int scl = dir == 0 ? pcl : nsc - 1 - pcl;
    const int chain = dir * 12 + b * 6 + h;
    LAS unsigned char* img = F.lds + (dir ? L_IMG1 : L_IMG0); LAS unsigned* pkg = (LAS unsigned*)(F.lds + L_PKG) + dir * 1024;
    LAS float* YL = (LAS float*)(F.lds + L_YL); LAS unsigned char* VB = F.lds + L_VB; LAS float* BON = (LAS float*)(F.lds + L_BON);
    LAS float* cst = (LAS float*)(F.lds + L_CST);
    __syncthreads();
    if (F.tid < 256) chain_consts_lds(F, cst, li, h, F.tid);
    f32x4 S[4];
    { const f32x4* braw = (const f32x4*)sum_slot(F, chain, sc);
#pragma unroll
      for (int T = 0; T < 4; ++T) S[T] = braw[(wq * 4 + T) * 64 + F.lane]; }
    __syncthreads();
    for (int i = F.tid; i < 128 * 68; i += NTHR) YL[i] = 0.f;
    PrepRaw R;
    prep_load(F, R, dir, b, h, 8 * wq + (F.lane >> 3), F.lane & 7, isctx, 128 * scl);
#pragma unroll 1
    for (int rd = 0; rd < 4; ++rd) {
        __syncthreads();
        prep_compute(F, R, cst, img, dir, b, h, 8 * wq + (F.lane >> 3), F.lane & 7, isctx, 128 * scl + 32 * rd, dir == 0 ? VB : (LAS unsigned char*)nullptr, BON, 32 * rd);
        __syncthreads();
        if (rd < 3) prep_load(F, R, dir, b, h, 8 * wq + (F.lane >> 3), F.lane & 7, isctx, 128 * scl + 32 * (rd + 1));
        if (wq < 2) block_package<true>(img, wq, pkg + wq * 512, F.lane);
        __syncthreads();
#pragma unroll
        for (int blk = 0; blk < 2; ++blk) { const f32x4 y = block_scan<true, true>(img, blk, pkg + blk * 512, S, wq, F.lane);
#pragma unroll
            for (int e = 0; e < 4; ++e) { const int t = 32 * rd + 16 * blk + 4 * q + e; const int pl = dir ? 127 - t : t; YL[pl * 68 + c + 16 * wq] += y[e]; } }
    }
    __syncthreads();
    const int wv = F.wave; const int rbase = (isctx ? TL + b * CTX : b * SEQ) + 128 * pcl;
    const bf16* g2t = (const bf16*)(F.ws + WS_G2T) + (size_t)li * 384 * 128;
    f32x4 gate[4];
#pragma unroll
    for (int nt = 0; nt < 4; ++nt) gate[nt] = (f32x4){0.f, 0.f, 0.f, 0.f};
#pragma unroll
    for (int k = 0; k < 4; ++k) { const v4u zg = *(const v4u*)(zrow(F, rbase + 16 * wv + c) + ZG + 32 * k + 8 * q);
#define SG(x) (1.0f / (1.0f + __expf(-(x))))
        const bf16x8 a = mk8(pk2(SG(bflo(zg.x)), SG(bfhi(zg.x))), pk2(SG(bflo(zg.y)), SG(bfhi(zg.y))), pk2(SG(bflo(zg.z)), SG(bfhi(zg.z))), pk2(SG(bflo(zg.w)), SG(bfhi(zg.w))));
#undef SG
#pragma unroll
        for (int nt = 0; nt < 4; ++nt) { const bf16x8 bb = *(const bf16x8*)(g2t + (size_t)(64 * h + 16 * nt + c) * 128 + 32 * k + 8 * q); gate[nt] = MFMA16(a, bb, gate[nt]); } }
    bf16* mix = (bf16*)(F.ws + WS_H);
    float lg[4], lb[4];
#pragma unroll
    for (int nt = 0; nt < 4; ++nt) { lg[nt] = inp(I_LNG)[li * RW + 64 * h + 16 * nt + c]; lb[nt] = inp(I_LNB)[li * RW + 64 * h + 16 * nt + c]; }
#pragma unroll
    for (int e = 0; e < 4; ++e) { const int tl = 16 * wv + 4 * q + e;
        float yv[4], s = 0.f;
#pragma unroll
        for (int nt = 0; nt < 4; ++nt) { yv[nt] = YL[tl * 68 + 16 * nt + c]; s += yv[nt]; }
        s += __shfl_xor(s, 1); s += __shfl_xor(s, 2); s += __shfl_xor(s, 4); s += __shfl_xor(s, 8);
        const float mu = s * (1.0f / 64.0f); float v2 = 0.f;
#pragma unroll
        for (int nt = 0; nt < 4; ++nt) { yv[nt] -= mu; v2 += yv[nt] * yv[nt]; }
        v2 += __shfl_xor(v2, 1); v2 += __shfl_xor(v2, 2); v2 += __shfl_xor(v2, 4); v2 += __shfl_xor(v2, 8);
        const float rs = 1.0f / sqrtf(v2 * (1.0f / 64.0f) + GN_EPS); const float bon = BON[tl];
#pragma unroll
        for (int nt = 0; nt < 4; ++nt) { const float vv = bf2f(((const LAS bf16*)VB)[tl * 64 + 16 * nt + c]);
            const float o = (yv[nt] * rs * lg[nt] + lb[nt] + bon * vv) * gate[nt][e];
            mix[(size_t)(rbase + tl) * DM + 640 + 64 * h + 16 * nt + c] = (bf16)f2bf(o); } }
}

constexpr int AT_KROW = 144;
__device__ __forceinline__ void attn_unit(Frame& F, int li, int u) {
    const bool cq = u >= 256;
    int b, kvh, qb;
    if (!cq) { b = u >> 7; kvh = (u >> 6) & 1; qb = u & 63; } else { const int uu = u - 256; b = uu >> 2; kvh = (uu >> 1) & 1; qb = uu & 1; }
    const int c = F.lane & 15, q = F.lane >> 4, tb = F.wave;
    const bf16* qr = (const bf16*)(F.ws + WS_QR); const bf16* kr = (const bf16*)(F.ws + WS_KR); bf16* mix = (bf16*)(F.ws + WS_H);
    const int qrow = (cq ? TL + b * CTX : b * SEQ) + 128 * qb + 16 * tb + c;
    const int qpos = 128 * qb + 16 * tb + c;
    bf16x8 Q[3][2];
#pragma unroll
    for (int hh = 0; hh < 3; ++hh)
#pragma unroll
        for (int k = 0; k < 2; ++k) {
            if (!cq) Q[hh][k] = *(const bf16x8*)(qr + (size_t)qrow * 384 + 64 * (3 * kvh + hh) + 32 * k + 8 * q);
            else { const v4u w = *(const v4u*)(zrow(F, qrow) + ZQ + 64 * (3 * kvh + hh) + 32 * k + 8 * q);
                Q[hh][k] = mk8(pk2(0.125f * bflo(w.x), 0.125f * bfhi(w.x)), pk2(0.125f * bflo(w.y), 0.125f * bfhi(w.y)), pk2(0.125f * bflo(w.z), 0.125f * bfhi(w.z)), pk2(0.125f * bflo(w.w), 0.125f * bfhi(w.w))); } }
    float m[3], l[3]; f32x4 O[3][4];
#pragma unroll
    for (int hh = 0; hh < 3; ++hh) { m[hh] = inp(I_SINK)[li * 6 + 3 * kvh + hh]; l[hh] = q == 0 ? 1.0f : 0.0f;
#pragma unroll
        for (int dt = 0; dt < 4; ++dt) O[hh][dt] = (f32x4){0.f, 0.f, 0.f, 0.f}; }
    LAS unsigned char* KI = F.lds;
#pragma unroll 1
    for (int stage = cq ? 1 : 0; stage < 2; ++stage) {
        const int nkeys = stage == 0 ? 384 : 256; const int vstride = (nkeys + 8) * 2;
        LAS unsigned char* VTI = F.lds + 384 * AT_KROW;
        const int kpos0 = 128 * (qb - 1);
        __syncthreads();
        for (int pc = F.tid; pc < nkeys * 8; pc += NTHR) { const int key = pc >> 3, d8 = pc & 7;
            const bf16* ksrc; const bf16* vsrc;
            if (stage == 0) { int kp = kpos0 + key; kp = kp < 0 ? 0 : (kp >= SEQ ? SEQ - 1 : kp); ksrc = kr + (size_t)(b * SEQ + kp) * 128 + 64 * kvh; vsrc = zrow(F, b * SEQ + kp) + ZV + 64 * kvh; }
            else { const bf16* z = zrow(F, TL + b * CTX + key); ksrc = z + ZK + 64 * kvh; vsrc = z + ZV + 64 * kvh; }
            const v4u kv = *(const v4u*)(ksrc + 8 * d8); const v4u vv = *(const v4u*)(vsrc + 8 * d8);
            *(LAS v4u*)(KI + key * AT_KROW + d8 * 16) = kv;
            const int kl = key & 31; const int col = (key & ~31) | (((kl & 15) >> 2) << 3) | ((kl >> 4) << 2) | (kl & 3);
            LAS bf16* vt = (LAS bf16*)(VTI + (8 * d8) * vstride) + col;
            vt[0] = (bf16)(vv.x & 0xffff); *(LAS bf16*)((LAS unsigned char*)vt + vstride) = (bf16)(vv.x >> 16);
            *(LAS bf16*)((LAS unsigned char*)vt + 2 * vstride) = (bf16)(vv.y & 0xffff); *(LAS bf16*)((LAS unsigned char*)vt + 3 * vstride) = (bf16)(vv.y >> 16);
            *(LAS bf16*)((LAS unsigned char*)vt + 4 * vstride) = (bf16)(vv.z & 0xffff); *(LAS bf16*)((LAS unsigned char*)vt + 5 * vstride) = (bf16)(vv.z >> 16);
            *(LAS bf16*)((LAS unsigned char*)vt + 6 * vstride) = (bf16)(vv.w & 0xffff); *(LAS bf16*)((LAS unsigned char*)vt + 7 * vstride) = (bf16)(vv.w >> 16); }
        __syncthreads();
        const int npair = nkeys / 32;
        const int Q0 = 128 * qb + 16 * tb;
#pragma unroll 1
        for (int kp = 0; kp < npair; ++kp) {
            const int kb = kpos0 + 32 * kp;
            if (stage == 0 && (kb + 31 < Q0 - 128 || kb > Q0 + 143 || kb + 31 < 0 || kb >= SEQ)) continue;
            bf16x8 K[2][2], V[4];
#pragma unroll
            for (int t = 0; t < 2; ++t)
#pragma unroll
                for (int k = 0; k < 2; ++k) K[t][k] = *(const LAS bf16x8*)(KI + (32 * kp + 16 * t + c) * AT_KROW + k * 64 + q * 16);
#pragma unroll
            for (int dt = 0; dt < 4; ++dt) V[dt] = *(const LAS bf16x8*)(VTI + (16 * dt + c) * vstride + kp * 64 + q * 16);
            bool ok0[4], ok1[4];
#pragma unroll
            for (int e = 0; e < 4; ++e) { const int k0 = kb + 4 * q + e, k1 = k0 + 16;
                ok0[e] = stage == 1 || (k0 >= 0 && k0 < SEQ && k0 >= qpos - 128 && k0 <= qpos + 128);
                ok1[e] = stage == 1 || (k1 >= 0 && k1 < SEQ && k1 >= qpos - 128 && k1 <= qpos + 128); }
#pragma unroll
            for (int hh = 0; hh < 3; ++hh) {
                f32x4 s0 = {0.f, 0.f, 0.f, 0.f}, s1 = {0.f, 0.f, 0.f, 0.f};
                s0 = MFMA16(K[0][0], Q[hh][0], s0); s0 = MFMA16(K[0][1], Q[hh][1], s0);
                s1 = MFMA16(K[1][0], Q[hh][0], s1); s1 = MFMA16(K[1][1], Q[hh][1], s1);
                float mx = -INFINITY;
#pragma unroll
                for (int e = 0; e < 4; ++e) { s0[e] = ok0[e] ? s0[e] : -INFINITY; s1[e] = ok1[e] ? s1[e] : -INFINITY; mx = fmaxf(mx, fmaxf(s0[e], s1[e])); }
                mx = fmaxf(mx, __shfl_xor(mx, 16)); mx = fmaxf(mx, __shfl_xor(mx, 32));
                const float mn = fmaxf(m[hh], mx); const float alpha = __expf(m[hh] - mn); m[hh] = mn;
                float ps = 0.f;
#pragma unroll
                for (int e = 0; e < 4; ++e) { s0[e] = __expf(s0[e] - mn); s1[e] = __expf(s1[e] - mn); ps += s0[e] + s1[e]; }
                l[hh] = l[hh] * alpha + ps;
                const bf16x8 P = mk8(cvtpk(s0[0], s0[1]), cvtpk(s0[2], s0[3]), cvtpk(s1[0], s1[1]), cvtpk(s1[2], s1[3]));
#pragma unroll
                for (int dt = 0; dt < 4; ++dt) { O[hh][dt] = O[hh][dt] * alpha; O[hh][dt] = MFMA16(V[dt], P, O[hh][dt]); }
            }
        }
    }
#pragma unroll
    for (int hh = 0; hh < 3; ++hh) { float lt = l[hh]; lt += __shfl_xor(lt, 16); lt += __shfl_xor(lt, 32); const float inv = 1.0f / lt;
#pragma unroll
        for (int dt = 0; dt < 4; ++dt) { v2u w; w.x = pk2(O[hh][dt][0] * inv, O[hh][dt][1] * inv); w.y = pk2(O[hh][dt][2] * inv, O[hh][dt][3] * inv);
            *(v2u*)(mix + (size_t)qrow * DM + 256 + 64 * (3 * kvh + hh) + 16 * dt + 4 * q) = w; } }
}

__device__ __forceinline__ void fourier_tables(Frame& F) {
    bf16* t = (bf16*)(F.ws + WS_FT);
    for (int i = F.bid * NTHR + F.tid; i < 64 * 64; i += F.G * NTHR) { const int r = i >> 6, cc = i & 63; const float a = (float)((r * cc) & 63) * (1.0f / 64.0f);
        const float cs = __builtin_amdgcn_cosf(a), sn = __builtin_amdgcn_sinf(a);
        t[FT_W64C / 2 + i] = (bf16)f2bf(cs); t[FT_W64S / 2 + i] = (bf16)f2bf(sn);
        const int pj = (cc & ~31) | (((cc & 15) >> 2) << 3) | (((cc >> 4) & 1) << 2) | (cc & 3);
        t[FT_T64C / 2 + r * 64 + pj] = (bf16)f2bf(cs); t[FT_T64S / 2 + r * 64 + pj] = (bf16)f2bf(sn); }
    for (int i = F.bid * NTHR + F.tid; i < 128 * 128; i += F.G * NTHR) { const int r = i >> 7, cc = i & 127; const float a = (float)((r * cc) & 127) * (1.0f / 128.0f);
        t[FT_W128C / 2 + i] = (bf16)f2bf(__builtin_amdgcn_cosf(a)); t[FT_W128S / 2 + i] = (bf16)f2bf(__builtin_amdgcn_sinf(a)); }
}
__device__ __forceinline__ void fourier_a_fast(Frame& F, int u) {
    const int b = u >> 7, n2 = u & 127, c = F.lane & 15, q = F.lane >> 4;
    LAS unsigned char* IMG = F.lds;
    __syncthreads();
    for (int pc = F.tid; pc < 64 * 32; pc += NTHR) { const int n1 = pc >> 5, c8 = pc & 31;
        const v4u v = *(const v4u*)(zrow(F, b * SEQ + 128 * n1 + n2) + ZF + 8 * c8);
        LAS bf16* d = (LAS bf16*)(IMG + (8 * c8) * 144) + n1;
        d[0] = (bf16)(v.x & 0xffff); d[72] = (bf16)(v.x >> 16); d[144] = (bf16)(v.y & 0xffff); d[216] = (bf16)(v.y >> 16);
        d[288] = (bf16)(v.z & 0xffff); d[360] = (bf16)(v.z >> 16); d[432] = (bf16)(v.w & 0xffff); d[504] = (bf16)(v.w >> 16); }
    __syncthreads();
    const bf16* wc = (const bf16*)(F.ws + WS_FT + FT_W64C); const bf16* wsn = (const bf16*)(F.ws + WS_FT + FT_W64S);
    bf16* far = (bf16*)(F.ws + WS_FA); bf16* fai = far + (size_t)NB * 64 * 128 * 256;
    bf16x8 Bc[4][2], Bs[4][2];
#pragma unroll
    for (int kt = 0; kt < 4; ++kt)
#pragma unroll
        for (int k = 0; k < 2; ++k) { Bc[kt][k] = *(const bf16x8*)(wc + (16 * kt + c) * 64 + 32 * k + 8 * q); Bs[kt][k] = *(const bf16x8*)(wsn + (16 * kt + c) * 64 + 32 * k + 8 * q); }
#pragma unroll
    for (int ci = 0; ci < 2; ++ci) { const int ct = 2 * F.wave + ci;
        bf16x8 A[2];
#pragma unroll
        for (int k = 0; k < 2; ++k) A[k] = *(const LAS bf16x8*)(IMG + (16 * ct + c) * 144 + k * 64 + q * 16);
#pragma unroll
        for (int kt = 0; kt < 4; ++kt) { f32x4 sr = {0.f, 0.f, 0.f, 0.f}, si = {0.f, 0.f, 0.f, 0.f};
#pragma unroll
            for (int k = 0; k < 2; ++k) { sr = MFMA16(A[k], Bc[kt][k], sr); si = MFMA16(A[k], Bs[kt][k], si); }
            const int k1 = 16 * kt + c; const float tw = (float)(n2 * k1) * (1.0f / 8192.0f); const float tc = __builtin_amdgcn_cosf(tw), ts = __builtin_amdgcn_sinf(tw);
            float xr[4], xi[4];
#pragma unroll
            for (int e = 0; e < 4; ++e) { const float ar = sr[e], ai = -si[e]; xr[e] = ar * tc + ai * ts; xi[e] = ai * tc - ar * ts; }
            const size_t o = (((size_t)b * 64 + k1) * 128 + n2) * 256 + 16 * ct + 4 * q;
            v2u w; w.x = pk2(xr[0], xr[1]); w.y = pk2(xr[2], xr[3]); *(v2u*)(far + o) = w; w.x = pk2(xi[0], xi[1]); w.y = pk2(xi[2], xi[3]); *(v2u*)(fai + o) = w; } }
}
__device__ __forceinline__ void fourier_c_fast(Frame& F, int u) {
    const int g = u & 3, k1 = (u >> 2) & 63, b = u >> 8, c = F.lane & 15, q = F.lane >> 4;
    LAS unsigned char* IR = F.lds; LAS unsigned char* II = F.lds + 64 * 272;
    const bf16* far = (const bf16*)(F.ws + WS_FA) + (((size_t)b * 64 + k1) * 128) * 256 + 64 * g; const bf16* fai = far + (size_t)NB * 64 * 128 * 256;
    __syncthreads();
    for (int pc = F.tid; pc < 128 * 8; pc += NTHR) { const int n2 = pc >> 3, c8 = pc & 7;
        const v4u vr = *(const v4u*)(far + (size_t)n2 * 256 + 8 * c8), vi = *(const v4u*)(fai + (size_t)n2 * 256 + 8 * c8);
        LAS bf16* dr = (LAS bf16*)(IR + (8 * c8) * 272) + n2; LAS bf16* di = (LAS bf16*)(II + (8 * c8) * 272) + n2;
        dr[0] = (bf16)(vr.x & 0xffff); dr[136] = (bf16)(vr.x >> 16); dr[272] = (bf16)(vr.y & 0xffff); dr[408] = (bf16)(vr.y >> 16);
        dr[544] = (bf16)(vr.z & 0xffff); dr[680] = (bf16)(vr.z >> 16); dr[816] = (bf16)(vr.w & 0xffff); dr[952] = (bf16)(vr.w >> 16);
        di[0] = (bf16)(vi.x & 0xffff); di[136] = (bf16)(vi.x >> 16); di[272] = (bf16)(vi.y & 0xffff); di[408] = (bf16)(vi.y >> 16);
        di[544] = (bf16)(vi.z & 0xffff); di[680] = (bf16)(vi.z >> 16); di[816] = (bf16)(vi.w & 0xffff); di[952] = (bf16)(vi.w >> 16); }
    __syncthreads();
    const bf16* wc = (const bf16*)(F.ws + WS_FT + FT_W128C); const bf16* wsn = (const bf16*)(F.ws + WS_FT + FT_W128S);
    const bf16* tcn = (const bf16*)(F.ws + WS_FT + FT_T64C); const bf16* tsn = (const bf16*)(F.ws + WS_FT + FT_T64S);
    f32x4 Pr[4], Pi[4];
#pragma unroll
    for (int ct = 0; ct < 4; ++ct) { Pr[ct] = (f32x4){0.f, 0.f, 0.f, 0.f}; Pi[ct] = (f32x4){0.f, 0.f, 0.f, 0.f}; }
#pragma unroll
    for (int k = 0; k < 4; ++k) { const bf16x8 bc = *(const bf16x8*)(wc + (16 * F.wave + c) * 128 + 32 * k + 8 * q), bs = *(const bf16x8*)(wsn + (16 * F.wave + c) * 128 + 32 * k + 8 * q);
        const v4u bsu = __builtin_bit_cast(v4u, bs); const bf16x8 bsn = mk8(bsu.x ^ 0x80008000u, bsu.y ^ 0x80008000u, bsu.z ^ 0x80008000u, bsu.w ^ 0x80008000u);
#pragma unroll
        for (int ct = 0; ct < 4; ++ct) { const bf16x8 ar = *(const LAS bf16x8*)(IR + (16 * ct + c) * 272 + k * 64 + q * 16), ai = *(const LAS bf16x8*)(II + (16 * ct + c) * 272 + k * 64 + q * 16);
            Pr[ct] = MFMA16(ar, bc, Pr[ct]); Pr[ct] = MFMA16(ai, bs, Pr[ct]); Pi[ct] = MFMA16(ai, bc, Pi[ct]); Pi[ct] = MFMA16(ar, bsn, Pi[ct]); } }
    bf16x8 Br[2], Bi[2];
#pragma unroll
    for (int k = 0; k < 2; ++k) { Br[k] = mk8(cvtpk(Pr[2 * k][0], Pr[2 * k][1]), cvtpk(Pr[2 * k][2], Pr[2 * k][3]), cvtpk(Pr[2 * k + 1][0], Pr[2 * k + 1][1]), cvtpk(Pr[2 * k + 1][2], Pr[2 * k + 1][3]));
        Bi[k] = mk8(cvtpk(Pi[2 * k][0], Pi[2 * k][1]), cvtpk(Pi[2 * k][2], Pi[2 * k][3]), cvtpk(Pi[2 * k + 1][0], Pi[2 * k + 1][1]), cvtpk(Pi[2 * k + 1][2], Pi[2 * k + 1][3])); }
    bf16* mix = (bf16*)(F.ws + WS_H);
    const float scale = 0.0013810679320049757f;
    const int k2 = 16 * F.wave + c; const size_t row = (size_t)b * SEQ + k1 + 64 * k2;
#pragma unroll
    for (int mt = 0; mt < 4; ++mt) { f32x4 y = {0.f, 0.f, 0.f, 0.f};
#pragma unroll
        for (int k = 0; k < 2; ++k) { const bf16x8 ac = *(const bf16x8*)(tcn + (16 * mt + c) * 64 + 32 * k + 8 * q), as = *(const bf16x8*)(tsn + (16 * mt + c) * 64 + 32 * k + 8 * q);
            y = MFMA16(ac, Br[k], y); y = MFMA16(as, Bi[k], y); }
        v2u w; w.x = pk2(y[0] * scale, y[1] * scale); w.y = pk2(y[2] * scale, y[3] * scale);
        *(v2u*)(mix + row * DM + 64 * g + 16 * mt + 4 * q) = w; }
}

#define XB_TMO      128
#define XB_XCNT(j)  (256  + 64 * (j))
#define XB_XSUB(j)  (1280 + 64 * (j))
#define XB_XGEN(j)  (2304 + 64 * (j))
#define XB_TOP      3328
#define XB_TOPGEN   3392
#define XCD_BAR_WORDS 3456
#define XB_SPIN_CAP (1u << 23)
__device__ __forceinline__ unsigned xb_ld(unsigned* p)              { return __hip_atomic_load(p, __ATOMIC_RELAXED, __HIP_MEMORY_SCOPE_AGENT); }
__device__ __forceinline__ unsigned xb_add(unsigned* p, unsigned v) { return __hip_atomic_fetch_add(p, v, __ATOMIC_RELAXED, __HIP_MEMORY_SCOPE_AGENT); }
__device__ __forceinline__ unsigned xb_xcc_id() { return (unsigned)__builtin_amdgcn_s_getreg((3 << 11) | 20) & 0xFu; }
#define XB_SPIN(cond, bar) do { unsigned _sp = 0; while (cond) { __builtin_amdgcn_s_sleep(1); \
    if ((++_sp & 255u) == 0u) { if (xb_ld(&(bar)[XB_TMO])) break; if (_sp > XB_SPIN_CAP) { atomicAdd(&(bar)[XB_TMO], 1u); break; } } } } while (0)
struct XcdBarrier { unsigned* bar; unsigned x; volatile LAS unsigned* st; };
__device__ __forceinline__ XcdBarrier xcd_barrier_post(unsigned* bar, volatile LAS unsigned* st) {
    XcdBarrier b; b.bar = bar; b.x = xb_xcc_id(); b.st = st;
    if (threadIdx.x == 0) (void)xb_add(&bar[XB_XCNT(b.x)], 1u);
    return b;
}
__device__ __forceinline__ void xcd_barrier_complete(unsigned* bar, unsigned x, unsigned& nloc, unsigned& nx) {
    const unsigned G = gridDim.x * gridDim.y * gridDim.z;
    unsigned sum, cnt, mine, sp = 0u;
    for (;;) {
        sum = 0u; cnt = 0u; mine = 0u;
#pragma unroll
        for (unsigned j = 0; j < 16; ++j) { const unsigned c = xb_ld(&bar[XB_XCNT(j)]); sum += c; cnt += (c > 0u) ? 1u : 0u; mine = (j == x) ? c : mine; }
        if (sum == G) break;
        __builtin_amdgcn_s_sleep(1);
        if ((++sp & 255u) == 0u) { if (xb_ld(&bar[XB_TMO])) break; if (sp > XB_SPIN_CAP) { atomicAdd(&bar[XB_TMO], 1u); break; } }
    }
    nloc = mine > 0u ? mine : 1u; nx = cnt > 0u ? cnt : 1u;
}
__device__ __forceinline__ void xcd_barrier(const XcdBarrier& b0) {
    XcdBarrier b; { unsigned* p = b0.bar; unsigned x = __builtin_amdgcn_readfirstlane(b0.x); unsigned st = (unsigned)(size_t)b0.st; asm volatile("" : "+s"(p), "+s"(x), "+s"(st)); b.bar = p; b.x = x; b.st = (volatile LAS unsigned*)(size_t)st; }
    asm volatile("s_waitcnt vmcnt(0)" ::: "memory");
    __syncthreads();
    if (threadIdx.x == 0) {
        unsigned* bar = b.bar;
        __builtin_amdgcn_s_waitcnt(0);
        unsigned nloc = b.st[0], nx = b.st[1];
        if (nloc == 0u) { xcd_barrier_complete(bar, b.x, nloc, nx); b.st[0] = nloc; b.st[1] = nx; }
        const unsigned old = xb_add(&bar[XB_XSUB(b.x)], 1u);
        const unsigned gen = old / nloc;
        if (old + 1u == (gen + 1u) * nloc) {
            __builtin_amdgcn_fence(__ATOMIC_RELEASE, "agent");
            asm volatile("s_waitcnt vmcnt(0)" ::: "memory");
            const unsigned og = xb_add(&bar[XB_TOP], 1u);
            const unsigned tg = og / nx;
            if (og + 1u == (tg + 1u) * nx) xb_add(&bar[XB_TOPGEN], 1u);
            else XB_SPIN(xb_ld(&bar[XB_TOPGEN]) == tg, bar);
            __builtin_amdgcn_fence(__ATOMIC_ACQUIRE, "agent");
            xb_add(&bar[XB_XGEN(b.x)], 1u);
            asm volatile("s_waitcnt vmcnt(0)" ::: "memory");
        } else {
            XB_SPIN(xb_ld(&bar[XB_XGEN(b.x)]) == gen, bar);
            __builtin_amdgcn_fence(__ATOMIC_ACQUIRE, "agent");
            asm volatile("s_waitcnt vmcnt(0)" ::: "memory");
        }
    }
    __syncthreads();
}

__device__ __forceinline__ int queue_next(Frame& F, unsigned* cnt) {
    volatile LAS int* slot = (volatile LAS int*)(F.lds + MISC_OFF + 64);
    __syncthreads();
    if (F.tid == 0) *slot = (int)__hip_atomic_fetch_add(cnt, 1u, __ATOMIC_RELAXED, __HIP_MEMORY_SCOPE_AGENT);
    __syncthreads();
    return *slot;
}
template <int KIND> __device__ __forceinline__ void run_phase(const Frame& F0, int li, int second) {
    Frame F;
    { int t = threadIdx.x; asm volatile("" : "+v"(t)); F.tid = t; F.lane = t & 63; F.wave = __builtin_amdgcn_readfirstlane(t >> 6);
      int g = F0.G, b = F0.bid; asm volatile("" : "+s"(g), "+s"(b)); F.G = g; F.bid = b;
      unsigned char* w = F0.ws; float* o = F0.out; asm volatile("" : "+s"(w), "+s"(o)); F.ws = w; F.out = o;
      unsigned l = (unsigned)(size_t)F0.lds; asm volatile("" : "+s"(l)); F.lds = (LAS unsigned char*)(size_t)l;
      asm volatile("" : "+s"(li), "+s"(second)); }
    float* modv = (float*)(F.ws + WS_MOD);
    float* xc = (float*)(F.ws + WS_XC);
    bf16* H = (bf16*)(F.ws + WS_H); bf16* ACT = (bf16*)(F.ws + WS_ACT); bf16* O = (bf16*)(F.ws + WS_O);
    const float* ng = inp(I_NORMG) + (size_t)li * 6 * DM; const float* mv = modv + (size_t)li * 3 * 9216;
    const bool last = li == 1;
    if constexpr (KIND == 100) { convert_weights(F, 0); mod_gemv(F); rope_tables(F); lora_transposes(F); fourier_tables(F); }
    if constexpr (KIND == 101) { EArgs A{}; A.xl_src = inp(I_X); A.xc_src = inp(I_CTX); A.o = nullptr; A.hdst = H; A.modv_h = modv; A.shidx = 0; A.scidx = 1; A.gpre = inp(I_NORMG); A.nrows = TT; e_phase(F, A); }
    if constexpr (KIND == 0) {
        const bf16* wi = (const bf16*)(F.ws + (second ? WS_WI2 : WS_WI1)); const bool withctx = !(last && second);
        if (!withctx || F.G != 256) { pg8::Gemm g{H, wi, withctx ? TT : TL, NWI, DM}; pg8::StaticOrder S; S.init(g.M, g.N, F.G, F.bid);
            pg8::EpiSwiglu E{ACT, FFNP}; pg8::gemm_phase<pg8::EpiSwiglu, pg8::StaticOrder, true, true>(F.lds, g, S, E, F.tid); }
        else { unsigned* cnt = (unsigned*)(F.ws + WS_CTL) + 8192 + 64 * (li * 2 + second);
            pg8::Gemm g{H, wi, TT, NWI, DM}; pg8::UpOrder S; S.init(NWI, F.G, F.bid, cnt);
            pg8::EpiSwiglu E{ACT, FFNP}; pg8::gemm_phase<pg8::EpiSwiglu, pg8::UpOrder, true, true>(F.lds, g, S, E, F.tid);
            if (F.bid >= 248) {
                if (F.tid == 0) { unsigned sp = 0; while (__hip_atomic_load(cnt, __ATOMIC_RELAXED, __HIP_MEMORY_SCOPE_AGENT) < 352u && ++sp < (1u << 24)) __builtin_amdgcn_s_sleep(8);
                    __builtin_amdgcn_fence(__ATOMIC_ACQUIRE, "agent"); asm volatile("s_waitcnt vmcnt(0)" ::: "memory"); }
                __syncthreads();
                const int k = F.bid - 248; pg8::Gemm g2{ACT, (const bf16*)(F.ws + (second ? WS_WO2 : WS_WO1)), TT, DM, FFNP}; pg8::OneUnit S2{64 + (k >> 2), k & 3};
                pg8::EpiBf16 E2{O, DM}; pg8::gemm_phase<pg8::EpiBf16, pg8::OneUnit, false, true>(F.lds, g2, S2, E2, F.tid); } } }
    if constexpr (KIND == 1) {
        const bool ctxhere = F.G != 256 && !(last && second);
        pg8::Gemm g{ACT, (const bf16*)(F.ws + (second ? WS_WO2 : WS_WO1)), ctxhere ? TT : TL, DM, FFNP}; pg8::StaticOrder S; S.init(g.M, g.N, F.G, F.bid);
        pg8::EpiBf16 E{O, DM}; pg8::gemm_phase<pg8::EpiBf16, pg8::StaticOrder, true, true>(F.lds, g, S, E, F.tid); }
    if constexpr (KIND == 2) {
        EArgs A{}; A.xl_src = li == 0 ? inp(I_X) : F.out; A.xc_src = li == 0 ? inp(I_CTX) : xc; A.xl_dst = F.out; A.xc_dst = xc; A.o = O; A.modv_g = mv; A.gidx = 2; A.gmul = 0.5f; A.gpost = ng + 1 * DM;
        A.hdst = H; A.modv_h = mv; A.shidx = 3; A.scidx = 4; A.gpre = ng + 2 * DM; A.nrows = TT; e_phase(F, A); }
    if constexpr (KIND == 3) {
        pg8::Gemm g{H, (const bf16*)(F.ws + WS_WIN), TT, INWP, DM}; pg8::StaticOrder S; S.init(g.M, g.N, F.G, F.bid);
        pg8::EpiBf16 E{ACT, INWP}; pg8::gemm_phase<pg8::EpiBf16, pg8::StaticOrder, true, true>(F.lds, g, S, E, F.tid); }
    if constexpr (KIND == 4) {
        lora_pass(F, li);
        for (int u = F.bid; u < 256; u += F.G) fourier_a_fast(F, u);
        rope_all(F);
        if (li == 0) fourier_ctx1_all(F); }
    if constexpr (KIND == 5) {
        unsigned* cnt = (unsigned*)(F.ws + WS_CTL) + 8192 + 64 * (4 + 2 * li);
        const int na = li == 0 ? 264 : 256;
        for (int it = queue_next(F, cnt); it < na; it = queue_next(F, cnt)) attn_unit(F, li, it);
        for (int it = queue_next(F, cnt + 16); it < 12 * (NSC - 1); it = queue_next(F, cnt + 16)) rwkv_pass1_pair(F, li, it); }
    if constexpr (KIND == 11) {
        if (F.bid < 24) rwkv_pass2_chain(F, F.bid);
        if (li == 0) fourier_ctx2_all(F); }
    if constexpr (KIND == 12) {
        unsigned* cnt = (unsigned*)(F.ws + WS_CTL) + 8192 + 64 * (5 + 2 * li);
        const int np3 = li == 0 ? 12 * NSC : 12 * 64;
        for (int it = queue_next(F, cnt); it < np3; it = queue_next(F, cnt)) rwkv_pass3_unit(F, li, li == 0 ? it : (it / 64) * NSC + 2 + it % 64);
        for (int it = queue_next(F, cnt + 16); it < 512; it = queue_next(F, cnt + 16)) fourier_c_fast(F, it); }
    if constexpr (KIND == 6) {
        pg8::Gemm g{H, (const bf16*)(F.ws + WS_WOUT), last ? TL : TT, DM, DM}; pg8::StaticOrder S; S.init(g.M, g.N, F.G, F.bid);
        pg8::EpiBf16 E{O, DM}; pg8::gemm_phase<pg8::EpiBf16, pg8::StaticOrder, true, true>(F.lds, g, S, E, F.tid); }
    if constexpr (KIND == 7) {
        EArgs A{}; A.xl_src = F.out; A.xc_src = xc; A.xl_dst = F.out; A.xc_dst = xc; A.o = O; A.modv_g = mv; A.gidx = 5; A.gmul = 1.0f; A.gpost = ng + 3 * DM;
        A.hdst = H; A.modv_h = mv; A.shidx = 6; A.scidx = 7; A.gpre = ng + 4 * DM; A.nrows = last ? TL : TT; e_phase(F, A); }
    if constexpr (KIND == 10) {
        EArgs A{}; A.xl_src = F.out; A.xc_src = xc; A.xl_dst = F.out; A.xc_dst = xc; A.o = O; A.modv_g = mv; A.gidx = 8; A.gmul = 0.5f; A.gpost = ng + 5 * DM;
        if (!last) { A.hdst = H; A.modv_h = mv + 3 * 9216; A.shidx = 0; A.scidx = 1; A.gpre = ng + 6 * DM; }
        A.nrows = last ? TL : TT; e_phase(F, A);
        if (!last) { __syncthreads(); convert_weights(F, 1); } }
}
__global__ void __launch_bounds__(NTHR, 2) mega_one(Args args) {
    extern __shared__ __attribute__((aligned(16))) unsigned char lds[];
    Frame F; F.lds = (LAS unsigned char*)lds; F.tid = threadIdx.x; F.lane = F.tid & 63; F.wave = __builtin_amdgcn_readfirstlane(F.tid >> 6); F.G = gridDim.x; F.bid = blockIdx.x;
    F.out = args.out; F.ws = args.ws;
    volatile LAS unsigned* MISC = (volatile LAS unsigned*)(F.lds + MISC_OFF);
    if (F.tid < 32) MISC[F.tid] = 0u;
    __syncthreads();
    XcdBarrier bar = xcd_barrier_post((unsigned*)(F.ws + WS_CTL) + 4096, MISC + 8);
#define GRID_BAR() xcd_barrier(bar)
    run_phase<100>(F, 0, 0); GRID_BAR();
    run_phase<101>(F, 0, 0); GRID_BAR();
#pragma unroll 1
    for (int li = 0; li < 2; ++li) {
        run_phase<0>(F, li, 0); GRID_BAR();
        run_phase<1>(F, li, 0); GRID_BAR();
        run_phase<2>(F, li, 0); GRID_BAR();
        run_phase<3>(F, li, 0); GRID_BAR();
        run_phase<4>(F, li, 0); GRID_BAR();
        run_phase<5>(F, li, 0); GRID_BAR();
        run_phase<11>(F, li, 0); GRID_BAR();
        run_phase<12>(F, li, 0); GRID_BAR();
        run_phase<6>(F, li, 0); GRID_BAR();
        run_phase<7>(F, li, 0); GRID_BAR();
        run_phase<0>(F, li, 1); GRID_BAR();
        run_phase<1>(F, li, 1); GRID_BAR();
        run_phase<10>(F, li, 0); GRID_BAR();
    }
}

extern "C" void kernel_launch(void* const* d_in, const int* in_sizes, int n_in, void* d_out, int out_size, void* d_ws, size_t ws_size, hipStream_t stream) {
    static int ready = 0;
    if (!ready) {
        if (n_in != 25 || out_size != TL * DM || ws_size < WS_END) { fprintf(stderr, "kernel_launch: unexpected shapes (n_in %d out %d ws %zu)\n", n_in, out_size, ws_size); ready = -1; return; }
        if (hipFuncSetAttribute((const void*)mega_one, hipFuncAttributeMaxDynamicSharedMemorySize, LDS_BYTES) != hipSuccess) { fprintf(stderr, "kernel_launch: hipFuncSetAttribute failed\n"); ready = -1; return; }
        ready = 1;
    }
    if (ready < 0) return;
    if (hipMemsetAsync((char*)d_ws + WS_CTL, 0, 65536, stream) != hipSuccess) { fprintf(stderr, "kernel_launch: memset failed\n"); return; }
    Args a{};
    for (int i = 0; i < 25; ++i) a.in[i] = (const float*)d_in[i];
    a.out = (float*)d_out; a.ws = (unsigned char*)d_ws;
    hipLaunchKernelGGL(mega_one, dim3(256), dim3(NTHR), LDS_BYTES, stream, a);
}
```

```cpp
#include <hip/hip_runtime.h>
#include <cstdio>
#include <cstdint>

namespace pg8 {
#define PG8_LAS __attribute__((address_space(3)))
typedef unsigned short bf16_t;
typedef short bf16x8 __attribute__((ext_vector_type(8)));
typedef float f32x4 __attribute__((ext_vector_type(4)));
typedef unsigned u32x4 __attribute__((ext_vector_type(4)));
constexpr int BM = 256, BK = 64, HALF = 128, HTB = HALF * BK * 2, STAGE_BYTES = 8 * HTB, NXCD = 8, WGM = 8;

__host__ __device__ __forceinline__ int lds_byte(int r, int c) { const int st = (r >> 4) * 2 + (c >> 5), rr = r & 15, cc = c & 31, ob = rr * 64 + cc * 2; return st * 1024 + (ob ^ (((ob >> 9) & 1) << 5)); }
__host__ __device__ __forceinline__ void stage_rc(int b, int& R, int& C) { const int st = b / 1024, sb = b % 1024, swz = sb ^ (((sb >> 9) & 1) << 5); R = (st >> 1) * 16 + swz / 64; C = (st & 1) * 32 + (swz % 64) / 2; }
__host__ __device__ __forceinline__ int perm32(int rho) { const int n = rho >> 4, i = rho & 15; return 8 * (i >> 2) + 4 * n + (i & 3); }

struct Unit { int pm, pn; };
struct Gemm { const bf16_t* A; const bf16_t* Bt; int M, N, K; };

struct StaticOrder {
    int nM, nN, nwg, G, c;
    __host__ __device__ void init(int M, int N, int G_, int c_) { nM = M / BM; nN = N / BM; nwg = nM * nN; G = G_; c = c_; }
    __host__ __device__ bool next(int i, Unit& u) const {
        const long L = (long)i * G + c; if (L >= nwg) return false;
        int wgid = (int)L; { const int q = nwg / NXCD, r = nwg % NXCD, xcd = wgid % NXCD, off = wgid / NXCD; wgid = (xcd < r ? xcd * (q + 1) : r * (q + 1) + (xcd - r) * q) + off; }
        const int nig = WGM * nN, gid = wgid / nig, fm = gid * WGM, gsz = (nM - fm) < WGM ? (nM - fm) : WGM;
        u.pm = fm + ((wgid % nig) % gsz); u.pn = (wgid % nig) / gsz; return true;
    }
    __device__ __forceinline__ void a_ready(const Unit&) const {}
    __device__ __forceinline__ void done(const Unit&) const {}
};

struct UpOrder {
    StaticOrder lat; int G, c, nN; unsigned* cnt;
    __device__ void init(int N, int G_, int c_, unsigned* cnt_) { lat.init(16384, N, G_, c_); G = G_; c = c_; nN = N / BM; cnt = cnt_; }
    __device__ bool next(int i, Unit& u) const {
        const int nctx = 2 * nN, total = nctx + lat.nwg;
        long L;
        if (G != 256) L = (long)i * G + c;
        else if (c >= 248) { if (i >= 3) return false; L = (long)i * G + c; }
        else if (c >= 172 && c < 188 && i == 5) L = (long)(3 + (c - 172) / 8) * G + 248 + (c - 172) % 8;
        else L = (long)i * G + c;
        if (L >= total) return false;
        if (L < nctx) { u.pm = 64 + (int)L / nN; u.pn = (int)L % nN; return true; }
        int wgid = (int)L - nctx; { const int nwg = lat.nwg, q = nwg / NXCD, r = nwg % NXCD, xcd = wgid % NXCD, off = wgid / NXCD; wgid = (xcd < r ? xcd * (q + 1) : r * (q + 1) + (xcd - r) * q) + off; }
        const int nig = WGM * nN, gid = wgid / nig, fm = gid * WGM, gsz = (lat.nM - fm) < WGM ? (lat.nM - fm) : WGM;
        u.pm = fm + ((wgid % nig) % gsz); u.pn = (wgid % nig) / gsz; return true;
    }
    __device__ __forceinline__ void a_ready(const Unit&) const {}
    __device__ __forceinline__ void done(const Unit& u) const {
        if (u.pm >= 64) { asm volatile("s_waitcnt vmcnt(0)" ::: "memory"); __builtin_amdgcn_fence(__ATOMIC_RELEASE, "agent"); asm volatile("s_waitcnt vmcnt(0)" ::: "memory");
            if ((threadIdx.x & 63) == 0) __hip_atomic_fetch_add(cnt, 1u, __ATOMIC_RELAXED, __HIP_MEMORY_SCOPE_AGENT); }
    }
};
struct OneUnit {
    int pm, pn;
    __device__ bool next(int i, Unit& u) const { if (i != 0) return false; u.pm = pm; u.pn = pn; return true; }
    __device__ __forceinline__ void a_ready(const Unit&) const {}
    __device__ __forceinline__ void done(const Unit&) const {}
};

__device__ __forceinline__ unsigned cvt_pk_bf16(float lo, float hi) { unsigned r; asm volatile("v_cvt_pk_bf16_f32 %0, %1, %2" : "=v"(r) : "v"(lo), "v"(hi)); return r; }

struct EpiBf16 {
    static constexpr bool PERM = true, AFTER_DRAIN = false;
    bf16_t* O; int ldc;
    __device__ __forceinline__ void operator()(const f32x4 (&acc)[2][2][4][2], const Unit& u, int wr, int wc, int fr, int fq) const {
        const int row0 = u.pm * BM + wr * 64 + fr; const int col0 = u.pn * BM + wc * 32 + 8 * fq;
#pragma unroll
        for (int ai = 0; ai < 2; ++ai)
#pragma unroll
            for (int m = 0; m < 4; ++m) { bf16_t* rowp = O + (size_t)(row0 + ai * HALF + m * 16) * ldc + col0;
#pragma unroll
                for (int bj = 0; bj < 2; ++bj) { const f32x4 v0 = acc[ai][bj][m][0], v1 = acc[ai][bj][m][1];
                    u32x4 w; w.x = cvt_pk_bf16(v0[0], v0[1]); w.y = cvt_pk_bf16(v0[2], v0[3]); w.z = cvt_pk_bf16(v1[0], v1[1]); w.w = cvt_pk_bf16(v1[2], v1[3]);
                    *(u32x4*)(rowp + bj * HALF) = w; } }
    }
};
struct EpiF32 {
    static constexpr bool PERM = true, AFTER_DRAIN = false;
    float* O; int ldc;
    __device__ __forceinline__ void operator()(const f32x4 (&acc)[2][2][4][2], const Unit& u, int wr, int wc, int fr, int fq) const {
        const int row0 = u.pm * BM + wr * 64 + fr; const int col0 = u.pn * BM + wc * 32 + 8 * fq;
#pragma unroll
        for (int ai = 0; ai < 2; ++ai)
#pragma unroll
            for (int m = 0; m < 4; ++m) { float* rowp = O + (size_t)(row0 + ai * HALF + m * 16) * ldc + col0;
#pragma unroll
                for (int bj = 0; bj < 2; ++bj) { *(f32x4*)(rowp + bj * HALF) = acc[ai][bj][m][0]; *(f32x4*)(rowp + bj * HALF + 4) = acc[ai][bj][m][1]; } }
    }
};
__device__ __forceinline__ float silu_f(float x) { return x * __builtin_amdgcn_rcpf(1.0f + __expf(-x)); }
struct EpiSwiglu {
    static constexpr bool PERM = true, AFTER_DRAIN = false;
    bf16_t* O; int ldc;
    __device__ __forceinline__ void operator()(const f32x4 (&acc)[2][2][4][2], const Unit& u, int wr, int wc, int fr, int fq) const {
        const int row0 = u.pm * BM + wr * 64 + fr; const int col0 = u.pn * HALF + wc * 32 + 8 * fq;
#pragma unroll
        for (int ai = 0; ai < 2; ++ai)
#pragma unroll
            for (int m = 0; m < 4; ++m) { bf16_t* rowp = O + (size_t)(row0 + ai * HALF + m * 16) * ldc + col0;
                const f32x4 g0 = acc[ai][0][m][0], g1 = acc[ai][0][m][1], u0 = acc[ai][1][m][0], u1 = acc[ai][1][m][1];
                u32x4 w; w.x = cvt_pk_bf16(silu_f(g0[0]) * u0[0], silu_f(g0[1]) * u0[1]); w.y = cvt_pk_bf16(silu_f(g0[2]) * u0[2], silu_f(g0[3]) * u0[3]);
                w.z = cvt_pk_bf16(silu_f(g1[0]) * u1[0], silu_f(g1[1]) * u1[1]); w.w = cvt_pk_bf16(silu_f(g1[2]) * u1[2], silu_f(g1[3]) * u1[3]);
                *(u32x4*)rowp = w; }
    }
};

template <class Epi, class Sched, bool ALIGN_EPI = false, bool SP2 = false>
__device__ __forceinline__ void gemm_phase(PG8_LAS unsigned char* lds, const Gemm g, const Sched& S, const Epi& E, const int tid) {
    const int wid = __builtin_amdgcn_readfirstlane(tid >> 6), lane = tid & 63, wr = wid >> 2, wc = wid & 3, fr = lane & 15, fq = lane >> 4;
    const int K = g.K, nt = K / BK;
    unsigned voffA[2], voffB[2];
#pragma unroll
    for (int i = 0; i < 2; ++i) { int R, C; stage_rc(tid * 16 + i * 8192, R, C); const int Rb = Epi::PERM ? ((R & ~31) + perm32(R & 31)) : R;
        voffA[i] = (unsigned)(R * K + C) * 2u; voffB[i] = (unsigned)(Rb * K + C) * 2u; }
    const size_t kstep = (size_t)(BK * 2);
    const size_t hstep = (size_t)HALF * K * 2;
    const size_t tstep = 2 * hstep;
    const unsigned ldsw = (unsigned)wid * 1024u;
    const int aoff = lds_byte(wr * 64 + fr, fq * 8), boff = lds_byte(wc * 32 + fr, fq * 8);
#define PG8_SA(b, h) (((b) * 2 + (h)) * HTB)
#define PG8_SB(b, h) ((4 + (b) * 2 + (h)) * HTB)
#define PG8_STAGE(bufoff, gbase, voff) do { _Pragma("unroll") for (int _i = 0; _i < 2; ++_i) \
        __builtin_amdgcn_global_load_lds((const unsigned*)((const char*)(gbase) + (voff)[_i]), (PG8_LAS unsigned*)(lds + (bufoff) + ldsw + _i * 8192), 16, 0, 0); } while (0)
#define PG8_LDA(dst, b, h) do { _Pragma("unroll") for (int m = 0; m < 4; ++m) _Pragma("unroll") for (int k = 0; k < 2; ++k) dst[m][k] = *(const PG8_LAS bf16x8*)(lds + PG8_SA(b, h) + aoff + m * 2048 + k * 1024); } while (0)
#define PG8_LDB(dst, b, h) do { _Pragma("unroll") for (int n = 0; n < 2; ++n) _Pragma("unroll") for (int k = 0; k < 2; ++k) dst[n][k] = *(const PG8_LAS bf16x8*)(lds + PG8_SB(b, h) + boff + n * 2048 + k * 1024); } while (0)
#define PG8_MMA(ai, bj, At, Bt) do { __builtin_amdgcn_s_setprio(1); _Pragma("unroll") for (int m = 0; m < 4; ++m) _Pragma("unroll") for (int n = 0; n < 2; ++n) _Pragma("unroll") for (int k = 0; k < 2; ++k) \
        acc[ai][bj][m][n] = __builtin_amdgcn_mfma_f32_16x16x32_bf16(Bt[n][k], At[m][k], acc[ai][bj][m][n], 0, 0, 0); __builtin_amdgcn_s_setprio(0); } while (0)
#define PG8_WAIT_V(n) asm volatile("s_waitcnt vmcnt(" #n ")" ::: "memory")
#define PG8_WAIT_L(n) asm volatile("s_waitcnt lgkmcnt(" #n ")" ::: "memory")
#define PG8_BAR __builtin_amdgcn_s_barrier()
#define PG8_SCHED __builtin_amdgcn_sched_barrier(0)
    Unit cur, nxt; int ui = 0;
    if (!S.next(0, cur)) return;
    f32x4 acc[2][2][4][2];
#pragma unroll
    for (int a = 0; a < 2; ++a)
#pragma unroll
        for (int b = 0; b < 2; ++b)
#pragma unroll
            for (int m = 0; m < 4; ++m)
#pragma unroll
                for (int n = 0; n < 2; ++n) acc[a][b][m][n] = (f32x4){0.f, 0.f, 0.f, 0.f};
    bf16x8 At[4][2], B0[2][2], B1[2][2];
    const char* cA = (const char*)g.A + (size_t)cur.pm * tstep; const char* cB = (const char*)g.Bt + (size_t)cur.pn * tstep;
    S.a_ready(cur);
    if constexpr (SP2) {
        PG8_STAGE(PG8_SB(0, 0), cB, voffB); PG8_STAGE(PG8_SB(0, 1), cB + hstep, voffB); PG8_STAGE(PG8_SA(0, 0), cA, voffA); PG8_STAGE(PG8_SA(0, 1), cA + hstep, voffA);
        if (wr == 1) PG8_BAR;
        PG8_WAIT_V(2); PG8_BAR;
        PG8_STAGE(PG8_SB(1, 0), cB + kstep, voffB); PG8_STAGE(PG8_SA(1, 0), cA + kstep, voffA); PG8_STAGE(PG8_SB(1, 1), cB + hstep + kstep, voffB);
        PG8_WAIT_V(6); PG8_BAR;
    } else {
        PG8_STAGE(PG8_SB(0, 0), cB, voffB); PG8_STAGE(PG8_SA(0, 0), cA, voffA); PG8_STAGE(PG8_SB(0, 1), cB + hstep, voffB); PG8_STAGE(PG8_SA(0, 1), cA + hstep, voffA);
        if (wr == 1) PG8_BAR;
        PG8_WAIT_V(4); PG8_BAR;
        PG8_STAGE(PG8_SB(1, 0), cB + kstep, voffB); PG8_STAGE(PG8_SA(1, 0), cA + kstep, voffA); PG8_STAGE(PG8_SB(1, 1), cB + hstep + kstep, voffB);
        PG8_WAIT_V(6); PG8_BAR;
    }
    for (;;) {
        const bool has_next = S.next(ui + 1, nxt);
        const char* nA = has_next ? (const char*)g.A + (size_t)nxt.pm * tstep : cA; const char* nB = has_next ? (const char*)g.Bt + (size_t)nxt.pn * tstep : cB;
        for (int t = 0; t < nt; t += 2) {
            const bool last = (t == nt - 2);
            const char* a1 = cA + (size_t)(t + 1) * kstep;
            const char* a2 = last ? nA : cA + (size_t)(t + 2) * kstep; const char* b2 = last ? nB : cB + (size_t)(t + 2) * kstep;
            const char* a3 = a2 + kstep; const char* b3 = b2 + kstep;
            if (last && has_next) S.a_ready(nxt);
            if constexpr (SP2) {
            PG8_LDB(B0, 0, 0); PG8_LDB(B1, 0, 1); PG8_SCHED; PG8_LDA(At, 0, 0); PG8_STAGE(PG8_SA(1, 1), a1 + hstep, voffA);
            PG8_WAIT_V(8); PG8_WAIT_L(0); PG8_BAR; PG8_MMA(0, 0, At, B0); PG8_MMA(0, 1, At, B1); PG8_BAR; PG8_SCHED;
            PG8_LDA(At, 0, 1); PG8_STAGE(PG8_SB(0, 0), b2, voffB); PG8_STAGE(PG8_SB(0, 1), b2 + hstep, voffB); PG8_STAGE(PG8_SA(0, 0), a2, voffA);
            PG8_WAIT_V(8); PG8_WAIT_L(0); PG8_BAR; PG8_MMA(1, 0, At, B0); PG8_MMA(1, 1, At, B1); PG8_BAR; PG8_SCHED;
            PG8_LDB(B0, 1, 0); PG8_LDB(B1, 1, 1); PG8_SCHED; PG8_LDA(At, 1, 0); PG8_STAGE(PG8_SA(0, 1), a2 + hstep, voffA);
            PG8_WAIT_V(8); PG8_WAIT_L(0); PG8_BAR; PG8_MMA(0, 0, At, B0); PG8_MMA(0, 1, At, B1); PG8_BAR; PG8_SCHED;
            PG8_LDA(At, 1, 1); PG8_STAGE(PG8_SB(1, 0), b3, voffB); PG8_STAGE(PG8_SB(1, 1), b3 + hstep, voffB); PG8_STAGE(PG8_SA(1, 0), a3, voffA);
            PG8_WAIT_V(8); PG8_WAIT_L(0); PG8_BAR; PG8_MMA(1, 0, At, B0); PG8_MMA(1, 1, At, B1); PG8_BAR; PG8_SCHED;
            } else {
            PG8_LDB(B0, 0, 0); PG8_SCHED; PG8_LDA(At, 0, 0); PG8_STAGE(PG8_SA(1, 1), a1 + hstep, voffA);
            PG8_WAIT_L(8); PG8_BAR; PG8_WAIT_L(0); PG8_MMA(0, 0, At, B0); PG8_BAR; PG8_SCHED;
            PG8_LDB(B1, 0, 1); PG8_STAGE(PG8_SB(0, 0), b2, voffB);
            PG8_BAR; PG8_WAIT_L(0); PG8_MMA(0, 1, At, B1); PG8_BAR;
            PG8_LDA(At, 0, 1); PG8_STAGE(PG8_SA(0, 0), a2, voffA);
            PG8_BAR; PG8_WAIT_L(0); PG8_MMA(1, 0, At, B0); PG8_BAR; PG8_SCHED;
            PG8_STAGE(PG8_SB(0, 1), b2 + hstep, voffB);
            PG8_WAIT_V(6); PG8_BAR; PG8_MMA(1, 1, At, B1); PG8_BAR;
            PG8_LDB(B0, 1, 0); PG8_SCHED; PG8_LDA(At, 1, 0); PG8_STAGE(PG8_SA(0, 1), a2 + hstep, voffA);
            PG8_WAIT_L(8); PG8_BAR; PG8_WAIT_L(0); PG8_MMA(0, 0, At, B0); PG8_BAR; PG8_SCHED;
            PG8_LDB(B1, 1, 1); PG8_STAGE(PG8_SB(1, 0), b3, voffB);
            PG8_BAR; PG8_WAIT_L(0); PG8_MMA(0, 1, At, B1); PG8_BAR;
            PG8_LDA(At, 1, 1); PG8_STAGE(PG8_SA(1, 0), a3, voffA);
            PG8_BAR; PG8_WAIT_L(0); PG8_MMA(1, 0, At, B0); PG8_BAR; PG8_SCHED;
            PG8_STAGE(PG8_SB(1, 1), b3 + hstep, voffB);
            PG8_WAIT_V(6); PG8_BAR; PG8_MMA(1, 1, At, B1); PG8_BAR;
            }
        }
        if constexpr (ALIGN_EPI) { if (wr == 0) PG8_BAR; }
        if constexpr (!Epi::AFTER_DRAIN) { E(acc, cur, wr, wc, fr, fq); S.done(cur); }
        if (!has_next) break;
#pragma unroll
        for (int a = 0; a < 2; ++a)
#pragma unroll
            for (int b = 0; b < 2; ++b)
#pragma unroll
                for (int m = 0; m < 4; ++m)
#pragma unroll
                    for (int n = 0; n < 2; ++n) acc[a][b][m][n] = (f32x4){0.f, 0.f, 0.f, 0.f};
        cur = nxt; cA = nA; cB = nB; ++ui;
        if constexpr (ALIGN_EPI) { if (wr == 1) PG8_BAR; }
    }
    PG8_WAIT_V(0);
    if constexpr (!ALIGN_EPI) { if (wr == 0) PG8_BAR; }
    PG8_BAR;
#undef PG8_SA
#undef PG8_SB
#undef PG8_STAGE
#undef PG8_LDA
#undef PG8_LDB
#undef PG8_MMA
#undef PG8_WAIT_V
#undef PG8_WAIT_L
#undef PG8_BAR
#undef PG8_SCHED
}
}

constexpr int NWAVES = 8, NTHR = 512;
constexpr int DM = 1024, SEQ = 8192, NB = 2, CTX = 256, TL = NB * SEQ, TC = NB * CTX, TT = TL + TC;
constexpr int FFN = 2752, FFNP = 2816, NWI = 5632, INW = 2432, INWP = 2560, NMOD = 9;
constexpr int ZF = 0, ZQ = 256, ZK = 640, ZV = 768, ZRR = 896, ZRK = 1280, ZRV = 1664, ZW = 2048, ZA = 2176, ZG = 2304;
constexpr int RW = 384;
constexpr float NORM_EPS = 1e-6f, GN_EPS = 64e-5f;

constexpr size_t MiB = 1u << 20;
constexpr size_t WS_CTL = 0, WS_MOD = 1 * MiB, WS_ROPE = 2 * MiB, WS_XC = 4 * MiB, WS_GC = 6 * MiB;
constexpr size_t WS_WI1 = 8 * MiB, WS_WO1 = 19 * MiB, WS_WIN = 25 * MiB, WS_WOUT = 30 * MiB, WS_WI2 = 32 * MiB, WS_WO2 = 43 * MiB;
constexpr size_t WS_H = 49 * MiB;
constexpr size_t WS_ACT = 82 * MiB;
constexpr size_t WS_O = 173 * MiB;
constexpr size_t WS_YD = WS_O, WS_QR = WS_O + 50 * MiB, WS_KR = WS_O + 62 * MiB;
constexpr size_t WS_W2T = WS_MOD + 256 * 1024, WS_A2T = WS_MOD + 512 * 1024, WS_G2T = WS_MOD + 768 * 1024;
constexpr size_t WS_LW = WS_O, WS_IC = WS_O + 25 * MiB;
constexpr size_t WS_GAM32 = 165 * MiB;
constexpr size_t WS_XB = 239 * MiB;
constexpr size_t OUT_FA = 0;
constexpr size_t OUT_SUM = 16 * MiB;
constexpr size_t WS_END = 272 * MiB;

constexpr size_t WS_FT = 7 * MiB;
constexpr size_t FT_W64C = 0, FT_W64S = 8192, FT_W128C = 16384, FT_W128S = 49152, FT_T64C = 81920, FT_T64S = 90112;
constexpr int LDS_BYTES = 147456;
constexpr int MISC_OFF = 146432;

typedef unsigned short bf16;
typedef float f32x4 __attribute__((ext_vector_type(4)));
typedef unsigned v4u __attribute__((ext_vector_type(4)));
typedef unsigned v2u __attribute__((ext_vector_type(2)));
#define LAS __attribute__((address_space(3)))
#define LDS_WAIT() asm volatile("s_waitcnt lgkmcnt(0)" ::: "memory")

__device__ __forceinline__ unsigned f2bf(float f) { unsigned u = __builtin_bit_cast(unsigned, f); return (u + 0x7fffu + ((u >> 16) & 1u)) >> 16; }
__device__ __forceinline__ unsigned pk2(float lo, float hi) { return f2bf(lo) | (f2bf(hi) << 16); }
__device__ __forceinline__ float bf2f(unsigned short u) { return __builtin_bit_cast(float, (unsigned)u << 16); }
__device__ __forceinline__ float bflo(unsigned u) { return __builtin_bit_cast(float, u << 16); }
__device__ __forceinline__ float bfhi(unsigned u) { return __builtin_bit_cast(float, u & 0xffff0000u); }
__device__ __forceinline__ void unpack8(const v4u w, float (&f)[8]) { f[0] = bflo(w.x); f[1] = bfhi(w.x); f[2] = bflo(w.y); f[3] = bfhi(w.y); f[4] = bflo(w.z); f[5] = bfhi(w.z); f[6] = bflo(w.w); f[7] = bfhi(w.w); }
__device__ __forceinline__ float wave_sum(float v) {
#pragma unroll
    for (int o = 1; o < 64; o <<= 1) v += __shfl_xor(v, o);
    return v;
}
__device__ __forceinline__ float wave_max(float v) {
#pragma unroll
    for (int o = 1; o < 64; o <<= 1) v = fmaxf(v, __shfl_xor(v, o));
    return v;
}

struct Args { const float* in[25]; float* out; unsigned char* ws; int ph_lo, ph_hi; };

struct Frame {
    LAS unsigned char* lds;
    int tid, lane, wave, G, bid;
    float* out; unsigned char* ws;
};
enum { I_X = 0, I_C, I_CTX, I_CCTX, I_MODW, I_MODB, I_NORMG, I_F1WI, I_F1WO, I_WIN, I_WOUT, I_SINK, I_CONV, I_W0, I_W2, I_A0, I_A2, I_G2, I_KK, I_KA, I_RK, I_LNG, I_LNB, I_F2WI, I_F2WO };

__device__ __forceinline__ const float* inp(int i) {
    const __attribute__((address_space(4))) char* p = (const __attribute__((address_space(4))) char*)__builtin_amdgcn_kernarg_segment_ptr();
    asm volatile("" : "+s"(p));
    return *(const float* const __attribute__((address_space(4)))*)(p + 8 * i);
}
__device__ __forceinline__ void cvt_item(const float* W, int ldw, int k0, int sc, bool valid, bf16* WT, int Kd, int n0d, LAS float* scr, int lane) {
#pragma unroll 8
    for (int i = 0; i < 32; ++i) { const int kk = 2 * i + (lane >> 5); scr[kk * 33 + (lane & 31)] = valid ? W[(size_t)(k0 + kk) * ldw + sc + (lane & 31)] : 0.f; }
    LDS_WAIT(); asm volatile("" ::: "memory");
    const int c = lane & 7;
#pragma unroll
    for (int j = 0; j < 4; ++j) { const int n = (lane >> 3) + 8 * j; const LAS float* s = scr + (8 * c) * 33 + n;
        v4u o; o.x = pk2(s[0 * 33], s[1 * 33]); o.y = pk2(s[2 * 33], s[3 * 33]); o.z = pk2(s[4 * 33], s[5 * 33]); o.w = pk2(s[6 * 33], s[7 * 33]);
        *(v4u*)(WT + (size_t)(n0d + n) * Kd + k0 + 8 * c) = o; }
    LDS_WAIT(); asm volatile("" ::: "memory");
}
__device__ __forceinline__ void convert_weights(Frame& F, int li) {
    LAS float* scr = (LAS float*)(F.lds + F.wave * 16384);
    const int gw = F.bid * NWAVES + F.wave, NGW = F.G * NWAVES;
    constexpr int I_WI = 16 * (NWI / 32), I_WO = (FFNP / 64) * 32, I_IN = 16 * (INWP / 32), I_OUT = 16 * 32;
    constexpr int NITEMS = 2 * I_WI + 2 * I_WO + I_IN + I_OUT;
    for (int it = gw; it < NITEMS; it += NGW) {
        int r = it;
        if (r < 2 * I_WI) { const int f = r / I_WI; r -= f * I_WI; const int nblk = NWI / 32, kb = r / nblk, nb = r % nblk;
            const int n0 = 32 * nb, pn = n0 >> 8, i = n0 & 255; const int j = 128 * pn + (i & 127); const bool valid = j < FFN; const int sc = (i < 128) ? j : FFN + j;
            cvt_item((f ? inp(I_F2WI) : inp(I_F1WI)) + (size_t)li * DM * 2 * FFN, 2 * FFN, 64 * kb, sc, valid, (bf16*)(F.ws + (f ? WS_WI2 : WS_WI1)), DM, n0, scr, F.lane); continue; }
        r -= 2 * I_WI;
        if (r < 2 * I_WO) { const int f = r / I_WO; r -= f * I_WO; const int kb = r / 32, nb = r % 32; const bool valid = 64 * kb < FFN;
            cvt_item((f ? inp(I_F2WO) : inp(I_F1WO)) + (size_t)li * FFN * DM, DM, 64 * kb, 32 * nb, valid, (bf16*)(F.ws + (f ? WS_WO2 : WS_WO1)), FFNP, 32 * nb, scr, F.lane); continue; }
        r -= 2 * I_WO;
        if (r < I_IN) { const int nblk = INWP / 32, kb = r / nblk, nb = r % nblk; const bool valid = 32 * nb < INW;
            cvt_item(inp(I_WIN) + (size_t)li * DM * INW, INW, 64 * kb, 32 * nb, valid, (bf16*)(F.ws + WS_WIN), DM, 32 * nb, scr, F.lane); continue; }
        r -= I_IN;
        { const int kb = r / 32, nb = r % 32;
            cvt_item(inp(I_WOUT) + (size_t)li * DM * DM, DM, 64 * kb, 32 * nb, true, (bf16*)(F.ws + WS_WOUT), DM, 32 * nb, scr, F.lane); }
    }
}
__device__ __forceinline__ void mod_gemv(Frame& F) {
    LAS float* sc = (LAS float*)F.lds;
    LAS float* red = sc + 3 * 1024;
    __syncthreads();
    for (int i = F.tid; i < 3 * 1024; i += NTHR) { const int v = i >> 10, k = i & 1023; const float x = v < 2 ? inp(I_C)[v * 1024 + k] : inp(I_CCTX)[k]; sc[i] = x / (1.0f + __expf(-x)); }
    __syncthreads();
    float* modv = (float*)(F.ws + WS_MOD);
    for (int u = F.bid; u < 2 * 72; u += F.G) {
        const int l = u / 72, n0 = (u % 72) * 128;
        const float* w = inp(I_MODW) + (size_t)l * DM * 9216 + n0 + 2 * F.lane;
        float a0 = 0.f, a1 = 0.f, b0 = 0.f, b1 = 0.f, c0 = 0.f, c1 = 0.f;
        const int k0 = F.wave * 128;
#pragma unroll 8
        for (int k = 0; k < 128; ++k) { const float2 wv = *(const float2*)(w + (size_t)(k0 + k) * 9216); const float s0 = sc[k0 + k], s1 = sc[1024 + k0 + k], s2 = sc[2048 + k0 + k];
            a0 += s0 * wv.x; a1 += s0 * wv.y; b0 += s1 * wv.x; b1 += s1 * wv.y; c0 += s2 * wv.x; c1 += s2 * wv.y; }
        LAS float* rw = red + F.wave * 384 + 2 * F.lane;
        rw[0] = a0; rw[1] = a1; rw[128] = b0; rw[129] = b1; rw[256] = c0; rw[257] = c1;
        __syncthreads();
        if (F.tid < 384) { float s = 0.f;
#pragma unroll
            for (int w8 = 0; w8 < 8; ++w8) s += red[w8 * 384 + F.tid];
            const int v = F.tid >> 7, n = n0 + (F.tid & 127);
            modv[(size_t)(l * 3 + v) * 9216 + n] = s + inp(I_MODB)[l * 9216 + n]; }
        __syncthreads();
    }
}
__device__ __forceinline__ void rope_tables(Frame& F) {
    float* ct = (float*)(F.ws + WS_ROPE); float* st = ct + SEQ * 32;
    for (int i = F.bid * NTHR + F.tid; i < SEQ * 32; i += F.G * NTHR) {
        const int t = i >> 5, j = i & 31; const int f = j & 15;
        const float inv = exp2f(-(float)f * (13.287712379549449f / 16.0f));
        const float pos = (float)(j < 16 ? (t >> 6) : (t & 63));
        const float ang = pos * inv;
        const double a = (double)ang; const double k = __builtin_rint(a * 0.15915494309189535); const float r = (float)(a - k * 6.283185307179586);
        ct[i] = __cosf(r); st[i] = __sinf(r);
    }
}

struct EArgs { const float* xl_src; const float* xc_src; const bf16* xb_src; bf16* xb_dst; float* out32; const bf16* o; const float* modv_g; int gidx; float gmul; const float* gpost;
               bf16* hdst; const float* modv_h; int shidx, scidx; const float* gpre; int nrows; };
__device__ __forceinline__ void e_phase(Frame& F, const EArgs& A) {
    const int gw = F.bid * NWAVES + F.wave, NGW = F.G * NWAVES;
    for (int r = gw; r < A.nrows; r += NGW) {
        const int v = r < TL ? (r >> 13) : 2;
        f32x4 x[4];
        if (A.xb_src) { const v2u* xs = (const v2u*)(A.xb_src + (size_t)r * DM);
#pragma unroll
            for (int j = 0; j < 4; ++j) { const v2u w = xs[F.lane + 64 * j]; x[j] = (f32x4){bflo(w.x), bfhi(w.x), bflo(w.y), bfhi(w.y)}; } }
        else { const float* xs = r < TL ? A.xl_src + (size_t)r * DM : A.xc_src + (size_t)(r - TL) * DM;
#pragma unroll
            for (int j = 0; j < 4; ++j) x[j] = ((const f32x4*)xs)[F.lane + 64 * j]; }
        if (A.o) {
            const v2u* orow = (const v2u*)(A.o + (size_t)r * DM); f32x4 ov[4]; float ss = 0.f;
#pragma unroll
            for (int j = 0; j < 4; ++j) { const v2u w = orow[F.lane + 64 * j]; ov[j] = (f32x4){bflo(w.x), bfhi(w.x), bflo(w.y), bfhi(w.y)}; ss += (ov[j].x * ov[j].x + ov[j].y * ov[j].y) + (ov[j].z * ov[j].z + ov[j].w * ov[j].w); }
            const float rstd = 1.0f / sqrtf(wave_sum(ss) * (1.0f / DM) + NORM_EPS) * A.gmul;
            const f32x4* gm = (const f32x4*)(A.modv_g + (size_t)v * 9216 + A.gidx * DM); const f32x4* gp = (const f32x4*)A.gpost;
#pragma unroll
            for (int j = 0; j < 4; ++j) { const f32x4 g = gm[F.lane + 64 * j], p = gp[F.lane + 64 * j]; x[j] = x[j] + g * (ov[j] * rstd * p); }
            if (A.out32) {
#pragma unroll
                for (int j = 0; j < 4; ++j) ((f32x4*)(A.out32 + (size_t)r * DM))[F.lane + 64 * j] = x[j]; }
            else { v2u* xd = (v2u*)(A.xb_dst + (size_t)r * DM);
#pragma unroll
                for (int j = 0; j < 4; ++j) { v2u w; w.x = pk2(x[j].x, x[j].y); w.y = pk2(x[j].z, x[j].w); xd[F.lane + 64 * j] = w; } }
        }
        if (A.hdst) {
            float ss = 0.f;
#pragma unroll
            for (int j = 0; j < 4; ++j) ss += (x[j].x * x[j].x + x[j].y * x[j].y) + (x[j].z * x[j].z + x[j].w * x[j].w);
            const float rstd = 1.0f / sqrtf(wave_sum(ss) * (1.0f / DM) + NORM_EPS);
            const f32x4* sh = (const f32x4*)(A.modv_h + (size_t)v * 9216 + A.shidx * DM); const f32x4* scl = (const f32x4*)(A.modv_h + (size_t)v * 9216 + A.scidx * DM); const f32x4* gp = (const f32x4*)A.gpre;
            v2u* hd = (v2u*)(A.hdst + (size_t)r * DM);
#pragma unroll
            for (int j = 0; j < 4; ++j) { const f32x4 s = sh[F.lane + 64 * j], c = scl[F.lane + 64 * j], p = gp[F.lane + 64 * j]; const f32x4 hv = (x[j] * rstd * p) * (1.0f + c) + s;
                v2u w; w.x = pk2(hv.x, hv.y); w.y = pk2(hv.z, hv.w); hd[F.lane + 64 * j] = w; }
        }
    }
}

__device__ __forceinline__ const bf16* zrow(const Frame& F, int row) { return (const bf16*)(F.ws + WS_ACT) + (size_t)row * INWP; }

__device__ __forceinline__ void rope_all(Frame& F) {
    const float* ct = (const float*)(F.ws + WS_ROPE); const float* st = ct + SEQ * 32;
    bf16* qr = (bf16*)(F.ws + WS_QR); bf16* kr = (bf16*)(F.ws + WS_KR);
    for (int i = F.bid * NTHR + F.tid; i < TL * 32; i += F.G * NTHR) {
        const int o = i & 3, hh = (i >> 2) & 7, tok = i >> 5; const int s = tok & (SEQ - 1);
        const bf16* z = zrow(F, tok) + (hh < 6 ? ZQ + 64 * hh : ZK + 64 * (hh - 6)) + 8 * o;
        float x1[8], x2[8]; unpack8(*(const v4u*)z, x1); unpack8(*(const v4u*)(z + 32), x2);
        const f32x4 c0 = *(const f32x4*)(ct + s * 32 + 8 * o), c1 = *(const f32x4*)(ct + s * 32 + 8 * o + 4), s0 = *(const f32x4*)(st + s * 32 + 8 * o), s1 = *(const f32x4*)(st + s * 32 + 8 * o + 4);
        const float sc = hh < 6 ? 0.125f : 1.0f; float o1[8], o2[8];
#pragma unroll
        for (int e = 0; e < 4; ++e) { o1[e] = (x1[e] * c0[e] - x2[e] * s0[e]) * sc; o2[e] = (x2[e] * c0[e] + x1[e] * s0[e]) * sc; o1[e + 4] = (x1[e + 4] * c1[e] - x2[e + 4] * s1[e]) * sc; o2[e + 4] = (x2[e + 4] * c1[e] + x1[e + 4] * s1[e]) * sc; }
        bf16* d = hh < 6 ? qr + (size_t)tok * 384 + 64 * hh + 8 * o : kr + (size_t)tok * 128 + 64 * (hh - 6) + 8 * o;
        *(v4u*)d = (v4u){pk2(o1[0], o1[1]), pk2(o1[2], o1[3]), pk2(o1[4], o1[5]), pk2(o1[6], o1[7])};
        *(v4u*)(d + 32) = (v4u){pk2(o2[0], o2[1]), pk2(o2[2], o2[3]), pk2(o2[4], o2[5]), pk2(o2[6], o2[7])}; }
}
__device__ __forceinline__ void fourier_a_unit(Frame& F, int u) {
    const int b = u >> 7, n2 = u & 127;
    LAS float* tab = (LAS float*)F.lds;
    __syncthreads();
    if (F.tid < 64) { const float a = (float)F.tid * (1.0f / 64.0f); tab[F.tid] = __builtin_amdgcn_cosf(a); tab[64 + F.tid] = __builtin_amdgcn_sinf(a); }
    __syncthreads();
    const int c = F.tid & 255, kh = F.tid >> 8;
    float f[64];
#pragma unroll
    for (int n1 = 0; n1 < 64; ++n1) f[n1] = bf2f(zrow(F, b * SEQ + 128 * n1 + n2)[ZF + c]);
    bf16* far = (bf16*)((unsigned char*)F.out + OUT_FA); bf16* fai = far + (size_t)NB * 64 * 128 * 256;
    for (int kk = 0; kk < 32; ++kk) { const int k1 = kh * 32 + kk;
        float sr = 0.f, si = 0.f;
#pragma unroll
        for (int n1 = 0; n1 < 64; ++n1) { const int idx = (n1 * k1) & 63; sr += f[n1] * tab[idx]; si -= f[n1] * tab[64 + idx]; }
        const float tw = (float)(n2 * k1) * (1.0f / 8192.0f); const float tc = __builtin_amdgcn_cosf(tw), ts = -__builtin_amdgcn_sinf(tw);
        const size_t o = (((size_t)b * 64 + k1) * 128 + n2) * 256 + c;
        far[o] = (bf16)f2bf(sr * tc - si * ts); fai[o] = (bf16)f2bf(sr * ts + si * tc);
    }
}
__device__ __forceinline__ void fourier_c_unit(Frame& F, int u) {
    const int b = u >> 7, k1 = (u >> 1) & 63, half = u & 1;
    LAS float* tab = (LAS float*)F.lds;
    LAS float* tab64 = tab + 256;
    LAS float* P = tab + 512;
    __syncthreads();
    if (F.tid < 128) { const float a = (float)F.tid * (1.0f / 128.0f); tab[F.tid] = __builtin_amdgcn_cosf(a); tab[128 + F.tid] = __builtin_amdgcn_sinf(a); }
    if (F.tid >= 128 && F.tid < 192) { const float a = (float)(F.tid - 128) * (1.0f / 64.0f); tab64[F.tid - 128] = __builtin_amdgcn_cosf(a); tab64[64 + F.tid - 128] = __builtin_amdgcn_sinf(a); }
    __syncthreads();
    const int c = F.tid & 255, q = F.tid >> 8;
    const bf16* far = (const bf16*)((unsigned char*)F.out + OUT_FA) + (((size_t)b * 64 + k1) * 128) * 256 + c; const bf16* fai = far + (size_t)NB * 64 * 128 * 256;
    float ar[32], ai[32];
#pragma unroll
    for (int i = 0; i < 32; ++i) { ar[i] = 0.f; ai[i] = 0.f; }
    const int k2b = 64 * half + 32 * q;
    for (int n2 = 0; n2 < 128; ++n2) { const float xr = bf2f(far[(size_t)n2 * 256]), xi = bf2f(fai[(size_t)n2 * 256]);
#pragma unroll
        for (int i = 0; i < 32; ++i) { const int idx = (n2 * (k2b + i)) & 127; const float cs = tab[idx], sn = tab[128 + idx];
            ar[i] += xr * cs + xi * sn; ai[i] += xi * cs - xr * sn; } }
    bf16* mix = (bf16*)(F.ws + WS_H);
    const int g = c >> 6;
    float y[32];
#pragma unroll
    for (int i = 0; i < 32; ++i) y[i] = 0.f;
#pragma unroll
    for (int rnd = 0; rnd < 2; ++rnd) {
        __syncthreads();
#pragma unroll
        for (int i = 0; i < 32; ++i) P[(32 * q + i) * 256 + c] = rnd == 0 ? ar[i] : ai[i];
        __syncthreads();
        const int m = c & 63;
        for (int cc = 0; cc < 64; ++cc) { const int idx = (m * cc) & 63; const float t = rnd == 0 ? tab64[idx] : tab64[64 + idx];
#pragma unroll
            for (int i = 0; i < 32; ++i) y[i] += P[(32 * q + i) * 256 + 64 * g + cc] * t; }
    }
    const float scale = 0.0013810679320049757f;
#pragma unroll
    for (int i = 0; i < 32; ++i) { const int k = k1 + 64 * (k2b + i); mix[(size_t)(b * SEQ + k) * DM + c] = (bf16)f2bf(y[i] * scale); }
}
__device__ __forceinline__ void fourier_ctx1_all(Frame& F) {
    float* gr = (float*)(F.ws + WS_GC); float* gi = gr + TC * 256;
    const bf16* wc = (const bf16*)(F.ws + WS_FT + FT_W64C); const bf16* wsn = (const bf16*)(F.ws + WS_FT + FT_W64S);
    for (int i = F.bid * NTHR + F.tid; i < TC * 256; i += F.G * NTHR) { const int tok = i >> 8, gm = i & 255, g = gm >> 6, m = gm & 63;
        const bf16* z = zrow(F, TL + tok) + ZF + 64 * g; float sr = 0.f, si = 0.f;
#pragma unroll
        for (int c8 = 0; c8 < 8; ++c8) { float x[8], cs[8], sn[8]; unpack8(*(const v4u*)(z + 8 * c8), x); unpack8(*(const v4u*)(wc + m * 64 + 8 * c8), cs); unpack8(*(const v4u*)(wsn + m * 64 + 8 * c8), sn);
#pragma unroll
            for (int e = 0; e < 8; ++e) { sr += x[e] * cs[e]; si -= x[e] * sn[e]; } }
        gr[i] = sr; gi[i] = si; }
}
__device__ __forceinline__ void fourier_ctx2_all(Frame& F) {
    const float* gr = (const float*)(F.ws + WS_GC); const float* gi = gr + TC * 256; bf16* mix = (bf16*)(F.ws + WS_H);
    for (int i = F.bid * NTHR + F.tid; i < TC * 256; i += F.G * NTHR) { const int row = i >> 8, gm = i & 255, b = row >> 8, k = row & 255; float y = 0.f;
#pragma unroll 8
        for (int n = 0; n < 256; ++n) { const float a = (float)((k * n) & 255) * (1.0f / 256.0f); y += gr[(b * 256 + n) * 256 + gm] * __builtin_amdgcn_cosf(a) + gi[(b * 256 + n) * 256 + gm] * __builtin_amdgcn_sinf(a); }
        mix[(size_t)(TL + row) * DM + gm] = (bf16)f2bf(y * 0.0078125f); }
}
__device__ __forceinline__ float dot64(const float (&q)[64], const bf16* krow) {
    float s = 0.f;
#pragma unroll
    for (int i = 0; i < 8; ++i) { const v4u w = ((const v4u*)krow)[i];
        s += q[8 * i + 0] * bflo(w.x) + q[8 * i + 1] * bfhi(w.x) + q[8 * i + 2] * bflo(w.y) + q[8 * i + 3] * bfhi(w.y) + q[8 * i + 4] * bflo(w.z) + q[8 * i + 5] * bfhi(w.z) + q[8 * i + 6] * bflo(w.w) + q[8 * i + 7] * bfhi(w.w); }
    return s;
}
__device__ __forceinline__ void attn_v1(Frame& F, int li) {
    const int gw = F.bid * NWAVES + F.wave, NGW = F.G * NWAVES;
    const bf16* qr = (const bf16*)(F.ws + WS_QR); const bf16* kr = (const bf16*)(F.ws + WS_KR); bf16* mix = (bf16*)(F.ws + WS_H);
    const float* sink = inp(I_SINK) + li * 6;
    const int npairs = (li == 0 ? TT : TL) * 6;
    for (int p = gw; p < npairs; p += NGW) {
        const int row = p / 6, hq = p % 6, kvh = hq / 3; const bool isctx = row >= TL;
        const int b = isctx ? (row - TL) >> 8 : row >> 13, s = row & (SEQ - 1);
        float q[64];
        if (!isctx) {
#pragma unroll
            for (int i = 0; i < 8; ++i) { const v4u w = ((const v4u*)(qr + (size_t)row * 384 + 64 * hq))[i];
                q[8 * i] = bflo(w.x); q[8 * i + 1] = bfhi(w.x); q[8 * i + 2] = bflo(w.y); q[8 * i + 3] = bfhi(w.y); q[8 * i + 4] = bflo(w.z); q[8 * i + 5] = bfhi(w.z); q[8 * i + 6] = bflo(w.w); q[8 * i + 7] = bfhi(w.w); }
        } else {
#pragma unroll
            for (int i = 0; i < 8; ++i) { const v4u w = ((const v4u*)(zrow(F, row) + ZQ + 64 * hq))[i];
                q[8 * i] = 0.125f * bflo(w.x); q[8 * i + 1] = 0.125f * bfhi(w.x); q[8 * i + 2] = 0.125f * bflo(w.y); q[8 * i + 3] = 0.125f * bfhi(w.y); q[8 * i + 4] = 0.125f * bflo(w.z); q[8 * i + 5] = 0.125f * bfhi(w.z); q[8 * i + 6] = 0.125f * bflo(w.w); q[8 * i + 7] = 0.125f * bfhi(w.w); }
        }
        float sc[9]; int krow_[9];
        const float NEG = -INFINITY;
        float mx = sink[hq];
#pragma unroll
        for (int r = 0; r < 9; ++r) {
            if (r < 5) {
                const int kp = s - 128 + 64 * r + F.lane; const bool ok = !isctx && kp >= 0 && kp < SEQ && kp <= s + 128;
                const int kc = ok ? kp : 0; krow_[r] = b * SEQ + kc;
                const float d = isctx ? 0.f : dot64(q, kr + (size_t)(b * SEQ + kc) * 128 + 64 * kvh);
                sc[r] = ok ? d : NEG;
            } else {
                const int kc = 64 * (r - 5) + F.lane; krow_[r] = TL + b * CTX + kc;
                sc[r] = dot64(q, zrow(F, TL + b * CTX + kc) + ZK + 64 * kvh);
            }
            mx = fmaxf(mx, sc[r]);
        }
        mx = wave_max(mx);
        float den = 0.f;
#pragma unroll
        for (int r = 0; r < 9; ++r) { sc[r] = __expf(sc[r] - mx); den += sc[r]; }
        den = wave_sum(den) + __expf(sink[hq] - mx);
        float acc = 0.f;
#pragma unroll
        for (int r = 0; r < 9; ++r) {
            if (r < 5 && isctx) continue;
            for (int kk = 0; kk < 64; ++kk) { const float pk = __builtin_bit_cast(float, __builtin_amdgcn_readlane(__builtin_bit_cast(int, sc[r]), kk)); const int kr_ = __builtin_amdgcn_readlane(krow_[r], kk);
                acc += pk * bf2f(zrow(F, kr_)[ZV + 64 * kvh + F.lane]); }
        }
        mix[(size_t)row * DM + 256 + 64 * hq + F.lane] = (bf16)f2bf(acc / den);
    }
}

typedef short bf16x8 __attribute__((ext_vector_type(8)));
#define MFMA16(a, b, c) __builtin_amdgcn_mfma_f32_16x16x32_bf16(a, b, c, 0, 0, 0)
__device__ __forceinline__ bf16x8 mk8(unsigned a, unsigned b, unsigned c, unsigned d) { const v4u v = {a, b, c, d}; return __builtin_bit_cast(bf16x8, v); }
typedef __bf16 bf16x2_t __attribute__((ext_vector_type(2)));
typedef float f32x2_t __attribute__((ext_vector_type(2)));
__device__ __forceinline__ unsigned cvtpk(float lo, float hi) { const f32x2_t f = {lo, hi}; return __builtin_bit_cast(unsigned, __builtin_convertvector(f, bf16x2_t)); }
constexpr int NSC = 66;
constexpr int IM_AI = 0, IM_RI = 4608, IM_BI = 9216, IM_KI = 13824, IM_BKT = 18432, IM_VT = 28672, IM_GAM = 33792, IMG_BYTES = 34816;
constexpr int L_IMG0 = 0, L_IMG1 = IMG_BYTES, L_PKG = 2 * IMG_BYTES, L_YL = L_PKG + 8192, L_VB = L_YL + 128 * 68 * 4, L_BON = L_VB + 128 * 64 * 2, L_CST = L_BON + 512, L_RW_END = L_CST + 2 * 3072;
static_assert(L_RW_END <= 146432, "rwkv LDS map");
constexpr size_t SUM_SLOT = 24576;

__device__ __forceinline__ void lora_transposes(Frame& F) {
    bf16* w2t = (bf16*)(F.ws + WS_W2T); bf16* a2t = (bf16*)(F.ws + WS_A2T); bf16* g2t = (bf16*)(F.ws + WS_G2T);
    const float* w2 = inp(I_W2); const float* a2 = inp(I_A2); const float* g2 = inp(I_G2);
    for (int i = F.bid * NTHR + F.tid; i < 4 * 384 * 64; i += F.G * NTHR) { const int r = i & 63, col = (i >> 6) % 384, ld = i / (384 * 64);
        w2t[i] = (bf16)f2bf(w2[((size_t)ld * 64 + r) * RW + col]); a2t[i] = (bf16)f2bf(a2[((size_t)ld * 64 + r) * RW + col]); }
    for (int i = F.bid * NTHR + F.tid; i < 2 * 384 * 128; i += F.G * NTHR) { const int r = i & 127, col = (i >> 7) % 384, l = i / (384 * 128);
        g2t[i] = (bf16)f2bf(g2[((size_t)l * 128 + r) * RW + col]); }
}

__device__ __forceinline__ float softplus_fast(float x) { return fmaxf(x, 0.f) + __logf(1.0f + __expf(-fabsf(x))); }
__device__ __forceinline__ float tanh_fast(float x) { return 1.0f - 2.0f * __builtin_amdgcn_rcpf(1.0f + __expf(2.0f * x)); }
template <int CTRL> __device__ __forceinline__ float dpp_f(float v) { return __builtin_bit_cast(float, __builtin_amdgcn_update_dpp(0, __builtin_bit_cast(int, v), CTRL, 0xf, 0xf, true)); }
__device__ __forceinline__ void lora_pass(Frame& F, int li) {
    const int q = F.lane >> 4, c16 = F.lane & 15;
#pragma unroll 1
    for (int dir = 0; dir < 2; ++dir) {
        bf16* LW = (bf16*)(F.ws + WS_LW) + (size_t)dir * TT * RW; bf16* IC = (bf16*)(F.ws + WS_IC) + (size_t)dir * TT * RW;
        const bf16* w2t = (const bf16*)(F.ws + WS_W2T) + (size_t)(li * 2 + dir) * 384 * 64; const bf16* a2t = (const bf16*)(F.ws + WS_A2T) + (size_t)(li * 2 + dir) * 384 * 64;
        bf16x8 aw[3][2], aa[3][2]; f32x4 w0v[3], a0v[3];
#pragma unroll
        for (int cti = 0; cti < 3; ++cti) { const int ct = 3 * F.wave + cti, col = 16 * ct + c16;
#pragma unroll
            for (int k = 0; k < 2; ++k) { aw[cti][k] = *(const bf16x8*)(w2t + (size_t)col * 64 + 32 * k + 8 * q); aa[cti][k] = *(const bf16x8*)(a2t + (size_t)col * 64 + 32 * k + 8 * q); }
            w0v[cti] = *(const f32x4*)(inp(I_W0) + (li * 2 + dir) * RW + 16 * ct + 4 * q); a0v[cti] = *(const f32x4*)(inp(I_A0) + (li * 2 + dir) * RW + 16 * ct + 4 * q); }
#pragma unroll 1
        for (int rt = F.bid; rt < TT / 16; rt += F.G) {
            const bf16* z = zrow(F, 16 * rt + c16);
            bf16x8 bw[2], ba[2];
#pragma unroll
            for (int k = 0; k < 2; ++k) { const v4u zw = *(const v4u*)(z + ZW + 64 * dir + 32 * k + 8 * q); ba[k] = *(const bf16x8*)(z + ZA + 64 * dir + 32 * k + 8 * q);
                bw[k] = mk8(cvtpk(tanh_fast(bflo(zw.x)), tanh_fast(bfhi(zw.x))), cvtpk(tanh_fast(bflo(zw.y)), tanh_fast(bfhi(zw.y))), cvtpk(tanh_fast(bflo(zw.z)), tanh_fast(bfhi(zw.z))), cvtpk(tanh_fast(bflo(zw.w)), tanh_fast(bfhi(zw.w)))); }
#pragma unroll
            for (int cti = 0; cti < 3; ++cti) { const int ct = 3 * F.wave + cti;
                f32x4 dw = {0.f, 0.f, 0.f, 0.f}, da = {0.f, 0.f, 0.f, 0.f};
#pragma unroll
                for (int k = 0; k < 2; ++k) { dw = MFMA16(aw[cti][k], bw[k], dw); da = MFMA16(aa[cti][k], ba[k], da); }
                float lw[4], ic[4];
#pragma unroll
                for (int e = 0; e < 4; ++e) { const float x = w0v[cti][e] + dw[e]; const float wl = -softplus_fast(-x) - 0.5f; lw[e] = -__expf(wl); ic[e] = __builtin_amdgcn_rcpf(1.0f + __expf(-(a0v[cti][e] + da[e]))); }
                if (dir == 0) {
#pragma unroll
                    for (int e = 0; e < 4; ++e) { lw[e] += dpp_f<0x111>(lw[e]); lw[e] += dpp_f<0x112>(lw[e]); lw[e] += dpp_f<0x114>(lw[e]); lw[e] += dpp_f<0x118>(lw[e]); } }
                else {
#pragma unroll
                    for (int e = 0; e < 4; ++e) { lw[e] += dpp_f<0x101>(lw[e]); lw[e] += dpp_f<0x102>(lw[e]); lw[e] += dpp_f<0x104>(lw[e]); lw[e] += dpp_f<0x108>(lw[e]); } }
#pragma unroll
                for (int e = 0; e < 4; ++e) lw[e] = __expf(lw[e]);
                if (c16 == (dir == 0 ? 15 : 0)) *(f32x4*)((float*)(F.ws + WS_GAM32) + ((size_t)dir * (TT / 16) + rt) * RW + 16 * ct + 4 * q) = (f32x4){lw[0], lw[1], lw[2], lw[3]};
                const size_t o = (size_t)(16 * rt + c16) * RW + 16 * ct + 4 * q;
                v2u w; w.x = cvtpk(lw[0], lw[1]); w.y = cvtpk(lw[2], lw[3]); *(v2u*)(LW + o) = w; w.x = cvtpk(ic[0], ic[1]); w.y = cvtpk(ic[2], ic[3]); *(v2u*)(IC + o) = w; }
        }
    }
}
struct ChainCtx { int dir, b, h, li; float kkw, kaw, rkw; float cw[3][3]; };
__device__ __forceinline__ void chain_consts(ChainCtx& C, int li, int dir, int b, int h, int j) {
    C.dir = dir; C.b = b; C.h = h; C.li = li; const int ch = 64 * h + j;
    C.kkw = inp(I_KK)[li * RW + ch]; C.kaw = inp(I_KA)[li * RW + ch]; C.rkw = inp(I_RK)[li * RW + ch];
#pragma unroll
    for (int t = 0; t < 3; ++t)
#pragma unroll
        for (int qq = 0; qq < 3; ++qq) C.cw[t][qq] = inp(I_CONV)[(size_t)(li * 3 + t) * (3 * RW) + qq * RW + ch];
}
template <int TPT, bool BONUS>
__device__ __forceinline__ void prep_round(Frame& F, const ChainCtx& C, LAS unsigned char* img, int j, int tg, bool isctx, int step0, LAS unsigned char* lds_vb, LAS float* lds_bon, int pos0_local) {
    const int L = isctx ? CTX : SEQ, rbase = isctx ? TL + C.b * CTX : C.b * SEQ, ch = 64 * C.h + j;
    const bf16* LW = (const bf16*)(F.ws + WS_LW) + (size_t)C.dir * TT * RW + ch; const bf16* IC = (const bf16*)(F.ws + WS_IC) + (size_t)C.dir * TT * RW + ch;
    const int tok0 = tg * TPT, blk = tok0 >> 4;
    float cum = 0.f;
    for (int t = blk * 16; t < tok0; ++t) { const int s = step0 + t; const int p = C.dir ? L - 1 - s : s; cum += bf2f(LW[(size_t)(rbase + p) * RW]); }
    float eprev = __expf(cum);
    const int pj = (j & ~31) | (((j & 15) >> 2) << 3) | (((j >> 4) & 1) << 2) | (j & 3);
    LAS bf16* AI = (LAS bf16*)(img + IM_AI) + blk * 1152, *RI = (LAS bf16*)(img + IM_RI) + blk * 1152, *BI = (LAS bf16*)(img + IM_BI) + blk * 1152, *KI = (LAS bf16*)(img + IM_KI) + blk * 1152;
    LAS bf16* BKT = (LAS bf16*)(img + IM_BKT) + blk * 2560 + j * 40; LAS bf16* VT = (LAS bf16*)(img + IM_VT) + blk * 1280 + j * 20; LAS float* GAM = (LAS float*)(img + IM_GAM) + blk * 64;
#pragma unroll 2
    for (int u = 0; u < TPT; ++u) { const int t = tok0 + u, tb = t & 15; const int s = step0 + t; const int p = C.dir ? L - 1 - s : s; const int row = rbase + p;
        const float lw = bf2f(LW[(size_t)row * RW]), ai = bf2f(IC[(size_t)row * RW]);
        float rv = 0.f, kv = 0.f, vv = 0.f;
#pragma unroll
        for (int tt = 0; tt < 3; ++tt) { const int pp = p + tt - 1; if (pp >= 0 && pp < L) { const bf16* z = zrow(F, rbase + pp); rv += C.cw[tt][0] * bf2f(z[ZRR + ch]); kv += C.cw[tt][1] * bf2f(z[ZRK + ch]); vv += C.cw[tt][2] * bf2f(z[ZRV + ch]); } }
        const float kkr = kv * C.kkw; const float ss = wave_sum(kkr * kkr); const float kk = kkr * (1.0f / sqrtf(fmaxf(ss, 1e-24f)));
        const float kd = kv * (1.0f + (ai - 1.0f) * C.kaw);
        const float ec = eprev * __expf(lw), en = 1.0f / ec;
        AI[tb * 72 + pj] = (bf16)f2bf(-kk * eprev); RI[tb * 72 + pj] = (bf16)f2bf(rv * ec);
        const bf16 bt = (bf16)f2bf(kk * ai * en), kt = (bf16)f2bf(kd * en);
        BI[tb * 72 + pj] = bt; KI[tb * 72 + pj] = kt;
        BKT[(tb >> 2) * 8 + (tb & 3)] = bt; BKT[(tb >> 2) * 8 + 4 + (tb & 3)] = kt;
        VT[tb] = (bf16)f2bf(vv);
        if (tb == 15) GAM[j] = ec;
        if constexpr (BONUS) { const float bs = wave_sum(rv * kv * C.rkw); const int pl = C.dir ? pos0_local - t : pos0_local + t;
            ((LAS bf16*)lds_vb)[pl * 64 + j] = (bf16)f2bf(vv); if (j == 0) lds_bon[pl] = bs; }
        eprev = ec; }
}
__device__ __forceinline__ void chain_consts_lds(Frame& F, LAS float* cst, int li, int h, int t256) {
    for (int i = t256; i < 12 * 64; i += 256) { const int k = i >> 6, j = i & 63, ch = 64 * h + j; float v;
        if (k == 0) v = inp(I_KK)[li * RW + ch]; else if (k == 1) v = inp(I_KA)[li * RW + ch]; else if (k == 2) v = inp(I_RK)[li * RW + ch];
        else { const int tt = (k - 3) / 3, w = (k - 3) % 3; v = inp(I_CONV)[(size_t)(li * 3 + tt) * (3 * RW) + w * RW + ch]; }
        cst[i] = v; }
}
struct PrepRaw { v4u ecw, icv, epw, zr[3], zk[3], zv[3]; };
__device__ __forceinline__ void prep_load(Frame& F, PrepRaw& R, int dir, int b, int h, int tl, int o, bool isctx, int step0) {
    const int L = isctx ? CTX : SEQ, rbase = isctx ? TL + b * CTX : b * SEQ, ch0 = 64 * h + 8 * o;
    const int s = step0 + tl; const int p = dir ? L - 1 - s : s; const int row = rbase + p, tb = tl & 15;
    { const bf16* LW = (const bf16*)(F.ws + WS_LW) + (size_t)dir * TT * RW + ch0; const bf16* IC = (const bf16*)(F.ws + WS_IC) + (size_t)dir * TT * RW + ch0;
      R.ecw = *(const v4u*)(LW + (size_t)row * RW); R.icv = *(const v4u*)(IC + (size_t)row * RW); R.epw = *(const v4u*)(LW + (size_t)(tb == 0 ? row : (dir ? row + 1 : row - 1)) * RW); }
#pragma unroll
    for (int tt = 0; tt < 3; ++tt) { const int pp = p + tt - 1; const bool ok = pp >= 0 && pp < L; const bf16* z = zrow(F, rbase + (ok ? pp : p)) + ch0;
        const v4u z0 = {0u, 0u, 0u, 0u};
        R.zr[tt] = ok ? *(const v4u*)(z + ZRR) : z0; R.zk[tt] = ok ? *(const v4u*)(z + ZRK) : z0; R.zv[tt] = ok ? *(const v4u*)(z + ZRV) : z0; }
}
__device__ __forceinline__ void prep_compute(Frame& F, const PrepRaw& R, const LAS float* cst, LAS unsigned char* img, int dir, int b, int h, int tl, int o, bool isctx, int step0, LAS unsigned char* lds_vb, LAS float* lds_bon, int pos0_local) {
    const bool BONUS = lds_vb != nullptr;
    const int L = isctx ? CTX : SEQ, rbase = isctx ? TL + b * CTX : b * SEQ, ch0 = 64 * h + 8 * o;
    const int blk = tl >> 4, tb = tl & 15;
    const int s = step0 + tl; const int p = dir ? L - 1 - s : s; const int row = rbase + p;
    const v4u ecw = R.ecw, icv = R.icv, epw = R.epw;
    v4u zr[3], zk[3], zv[3];
#pragma unroll
    for (int tt = 0; tt < 3; ++tt) { zr[tt] = R.zr[tt]; zk[tt] = R.zk[tt]; zv[tt] = R.zv[tt]; }
    float ecf[8], epf[8], ai[8], rv[8], kv[8], vv[8];
    unpack8(ecw, ecf); unpack8(epw, epf); unpack8(icv, ai);
#pragma unroll
    for (int e = 0; e < 8; ++e) { rv[e] = 0.f; kv[e] = 0.f; vv[e] = 0.f; }
#pragma unroll
    for (int tt = 0; tt < 3; ++tt) { float a[8], bq[8], cq[8]; unpack8(zr[tt], a); unpack8(zk[tt], bq); unpack8(zv[tt], cq);
        const LAS f32x4* w0 = (const LAS f32x4*)(cst + (3 + tt * 3 + 0) * 64 + 8 * o); const LAS f32x4* w1 = (const LAS f32x4*)(cst + (3 + tt * 3 + 1) * 64 + 8 * o); const LAS f32x4* w2 = (const LAS f32x4*)(cst + (3 + tt * 3 + 2) * 64 + 8 * o);
        const f32x4 w0a = w0[0], w0b = w0[1], w1a = w1[0], w1b = w1[1], w2a = w2[0], w2b = w2[1];
#pragma unroll
        for (int e = 0; e < 4; ++e) { rv[e] += w0a[e] * a[e]; rv[e + 4] += w0b[e] * a[e + 4]; kv[e] += w1a[e] * bq[e]; kv[e + 4] += w1b[e] * bq[e + 4]; vv[e] += w2a[e] * cq[e]; vv[e + 4] += w2b[e] * cq[e + 4]; } }
    float kkw[8], kaw[8];
    { const LAS f32x4* a = (const LAS f32x4*)(cst + 0 * 64 + 8 * o); const LAS f32x4* bq = (const LAS f32x4*)(cst + 1 * 64 + 8 * o); const f32x4 a0 = a[0], a1 = a[1], b0 = bq[0], b1 = bq[1];
#pragma unroll
      for (int e = 0; e < 4; ++e) { kkw[e] = a0[e]; kkw[e + 4] = a1[e]; kaw[e] = b0[e]; kaw[e + 4] = b1[e]; } }
    float kkr[8], ss = 0.f;
#pragma unroll
    for (int e = 0; e < 8; ++e) { kkr[e] = kv[e] * kkw[e]; ss += kkr[e] * kkr[e]; }
    ss += __shfl_xor(ss, 1); ss += __shfl_xor(ss, 2); ss += __shfl_xor(ss, 4);
    const float rn = 1.0f / sqrtf(fmaxf(ss, 1e-24f));
    float At[8], Rt[8], Bt[8], Kt[8];
#pragma unroll
    for (int e = 0; e < 8; ++e) { const float kk = kkr[e] * rn, kd = kv[e] * (1.0f + (ai[e] - 1.0f) * kaw[e]); const float eprev = tb == 0 ? 1.0f : epf[e]; const float ec = ecf[e], en = 1.0f / ec;
        At[e] = -kk * eprev; Rt[e] = rv[e] * ec; Bt[e] = kk * ai[e] * en; Kt[e] = kd * en; }
    const int P0 = 32 * (o >> 2) + 16 * (o & 1) + 4 * ((o >> 1) & 1);
    LAS bf16* AI = (LAS bf16*)(img + IM_AI) + blk * 1152 + tb * 72 + P0, *RI = (LAS bf16*)(img + IM_RI) + blk * 1152 + tb * 72 + P0, *BI = (LAS bf16*)(img + IM_BI) + blk * 1152 + tb * 72 + P0, *KI = (LAS bf16*)(img + IM_KI) + blk * 1152 + tb * 72 + P0;
    unsigned bp[4], kp[4];
#pragma unroll
    for (int e = 0; e < 4; ++e) { bp[e] = cvtpk(Bt[2 * e], Bt[2 * e + 1]); kp[e] = cvtpk(Kt[2 * e], Kt[2 * e + 1]); }
    *(LAS v2u*)AI = (v2u){cvtpk(At[0], At[1]), cvtpk(At[2], At[3])}; *(LAS v2u*)(AI + 8) = (v2u){cvtpk(At[4], At[5]), cvtpk(At[6], At[7])};
    *(LAS v2u*)RI = (v2u){cvtpk(Rt[0], Rt[1]), cvtpk(Rt[2], Rt[3])}; *(LAS v2u*)(RI + 8) = (v2u){cvtpk(Rt[4], Rt[5]), cvtpk(Rt[6], Rt[7])};
    *(LAS v2u*)BI = (v2u){bp[0], bp[1]}; *(LAS v2u*)(BI + 8) = (v2u){bp[2], bp[3]};
    *(LAS v2u*)KI = (v2u){kp[0], kp[1]}; *(LAS v2u*)(KI + 8) = (v2u){kp[2], kp[3]};
    LAS bf16* BKT = (LAS bf16*)(img + IM_BKT) + blk * 2560 + (8 * o) * 40 + (tb >> 2) * 8 + (tb & 3); LAS bf16* VT = (LAS bf16*)(img + IM_VT) + blk * 1280 + (8 * o) * 20 + tb;
    const unsigned vp[4] = {cvtpk(vv[0], vv[1]), cvtpk(vv[2], vv[3]), cvtpk(vv[4], vv[5]), cvtpk(vv[6], vv[7])};
#pragma unroll
    for (int e = 0; e < 8; ++e) { const unsigned bb = bp[e >> 1], kq = kp[e >> 1], vq = vp[e >> 1];
        BKT[e * 40] = (bf16)((e & 1) ? (bb >> 16) : (bb & 0xffff)); BKT[e * 40 + 4] = (bf16)((e & 1) ? (kq >> 16) : (kq & 0xffff)); VT[e * 20] = (bf16)((e & 1) ? (vq >> 16) : (vq & 0xffff)); }
    if (tb == 15) { const f32x4* gs = (const f32x4*)((const float*)(F.ws + WS_GAM32) + ((size_t)dir * (TT / 16) + (row >> 4)) * RW + ch0); LAS f32x4* G = (LAS f32x4*)((LAS float*)(img + IM_GAM) + blk * 64 + 8 * o); G[0] = gs[0]; G[1] = gs[1]; }
    if (BONUS) { float bs = 0.f; const LAS f32x4* rk = (const LAS f32x4*)(cst + 2 * 64 + 8 * o); const f32x4 r0 = rk[0], r1 = rk[1];
#pragma unroll
        for (int e = 0; e < 4; ++e) bs += rv[e] * kv[e] * r0[e] + rv[e + 4] * kv[e + 4] * r1[e];
        bs += __shfl_xor(bs, 1); bs += __shfl_xor(bs, 2); bs += __shfl_xor(bs, 4);
        const int pl = dir ? pos0_local - tl : pos0_local + tl;
        *(LAS v4u*)(lds_vb + (pl * 64 + 8 * o) * 2) = (v4u){vp[0], vp[1], vp[2], vp[3]}; if (o == 0) lds_bon[pl] = bs; }
}
template <bool WANT_Y>
__device__ __forceinline__ void block_package(LAS unsigned char* img, int blk, LAS unsigned* pkg, int lane) {
    const int q = lane >> 4, c = lane & 15;
    f32x4 mab = {0.f, 0.f, 0.f, 0.f}, mak = mab, mbr = mab, mkr = mab;
#pragma unroll
    for (int k = 0; k < 2; ++k) { const int o = blk * 2304 + c * 144 + k * 64 + q * 16;
        const bf16x8 bi = *(const LAS bf16x8*)(img + IM_BI + o), ki = *(const LAS bf16x8*)(img + IM_KI + o), ai = *(const LAS bf16x8*)(img + IM_AI + o);
        mab = MFMA16(bi, ai, mab); mak = MFMA16(ki, ai, mak);
        if constexpr (WANT_Y) { const bf16x8 ri = *(const LAS bf16x8*)(img + IM_RI + o); mbr = MFMA16(bi, ri, mbr); mkr = MFMA16(ki, ri, mkr); } }
#pragma unroll
    for (int e = 0; e < 4; ++e) { const int s = 4 * q + e; if (!(s < c)) { mab[e] = 0.f; mak[e] = 0.f; } if (!(s <= c)) { mbr[e] = 0.f; mkr[e] = 0.f; } }
    f32x4 mabT = {0.f, 0.f, 0.f, 0.f};
#pragma unroll
    for (int k = 0; k < 2; ++k) { const int o = blk * 2304 + c * 144 + k * 64 + q * 16; mabT = MFMA16(*(const LAS bf16x8*)(img + IM_AI + o), *(const LAS bf16x8*)(img + IM_BI + o), mabT); }
#pragma unroll
    for (int e = 0; e < 4; ++e) if (!(c < 4 * q + e)) mabT[e] = 0.f;
    const f32x4 z4 = {0.f, 0.f, 0.f, 0.f};
#define OPND(x) mk8(cvtpk((x)[0], (x)[1]), cvtpk((x)[2], (x)[3]), 0u, 0u)
    const bf16x8 oM = OPND(mab), oMT = OPND(mabT);
    const f32x4 m2 = MFMA16(oMT, oM, z4), m2T = MFMA16(oM, oMT, z4);
    const bf16x8 oM2 = OPND(m2), oM2T = OPND(m2T);
    const f32x4 m4 = MFMA16(oM2T, oM2, z4), m4T = MFMA16(oM2, oM2T, z4);
    const f32x4 m8T = MFMA16(OPND(m4), OPND(m4T), z4);
    f32x4 nn = m2;
#pragma unroll
    for (int e = 0; e < 4; ++e) nn[e] += (4 * q + e == c) ? 1.0f : 0.0f;
    nn = MFMA16(oMT, OPND(nn), nn);
    nn = MFMA16(OPND(m4T), OPND(nn), nn);
    nn = MFMA16(OPND(m8T), OPND(nn), nn);
#undef OPND
    pkg[0 * 64 + lane] = cvtpk(nn[0], nn[1]); pkg[1 * 64 + lane] = cvtpk(nn[2], nn[3]);
    pkg[2 * 64 + lane] = cvtpk(mak[0], mak[1]); pkg[3 * 64 + lane] = cvtpk(mak[2], mak[3]);
    if constexpr (WANT_Y) { pkg[4 * 64 + lane] = cvtpk(mbr[0], mbr[1]); pkg[5 * 64 + lane] = cvtpk(mbr[2], mbr[3]); pkg[6 * 64 + lane] = cvtpk(mkr[0], mkr[1]); pkg[7 * 64 + lane] = cvtpk(mkr[2], mkr[3]); }
}
template <bool WANT_Y, bool HAS_V>
__device__ __forceinline__ f32x4 block_scan(LAS unsigned char* img, int blk, const LAS unsigned* pkg, f32x4 (&S)[4], int wq, int lane) {
    const int q = lane >> 4, c = lane & 15;
    bf16x8 Sb[2];
#pragma unroll
    for (int k = 0; k < 2; ++k) Sb[k] = mk8(cvtpk(S[2 * k][0], S[2 * k][1]), cvtpk(S[2 * k][2], S[2 * k][3]), cvtpk(S[2 * k + 1][0], S[2 * k + 1][1]), cvtpk(S[2 * k + 1][2], S[2 * k + 1][3]));
    v2u vpk = {0u, 0u};
    if constexpr (HAS_V) vpk = *(const LAS v2u*)(img + IM_VT + blk * 2560 + (c + 16 * wq) * 40 + q * 8);
    const int ao = blk * 2304 + c * 144 + q * 16;
    f32x4 rhs = {0.f, 0.f, 0.f, 0.f};
    rhs = MFMA16(*(const LAS bf16x8*)(img + IM_AI + ao), Sb[0], rhs); rhs = MFMA16(*(const LAS bf16x8*)(img + IM_AI + ao + 64), Sb[1], rhs);
    if constexpr (HAS_V) rhs = MFMA16(mk8(0u, 0u, pkg[2 * 64 + lane], pkg[3 * 64 + lane]), mk8(0u, 0u, vpk.x, vpk.y), rhs);
    f32x4 u = {0.f, 0.f, 0.f, 0.f};
    u = MFMA16(mk8(pkg[0 * 64 + lane], pkg[1 * 64 + lane], 0u, 0u), mk8(cvtpk(rhs[0], rhs[1]), cvtpk(rhs[2], rhs[3]), 0u, 0u), u);
    const bf16x8 UV = mk8(cvtpk(u[0], u[1]), cvtpk(u[2], u[3]), vpk.x, vpk.y);
    f32x4 y = {0.f, 0.f, 0.f, 0.f};
    if constexpr (WANT_Y) { y = MFMA16(*(const LAS bf16x8*)(img + IM_RI + ao), Sb[0], y); y = MFMA16(*(const LAS bf16x8*)(img + IM_RI + ao + 64), Sb[1], y);
        y = MFMA16(mk8(pkg[4 * 64 + lane], pkg[5 * 64 + lane], pkg[6 * 64 + lane], pkg[7 * 64 + lane]), UV, y); }
#pragma unroll
    for (int T = 0; T < 4; ++T) { const bf16x8 bkt = *(const LAS bf16x8*)(img + IM_BKT + blk * 5120 + (16 * T + c) * 80 + q * 16);
        S[T] = MFMA16(bkt, UV, S[T]); const f32x4 g = *(const LAS f32x4*)(img + IM_GAM + blk * 256 + (16 * T + 4 * q) * 4); S[T] = S[T] * g; }
    return y;
}
__device__ __forceinline__ unsigned char* sum_slot(Frame& F, int chain, int sc) { return (unsigned char*)F.out + OUT_SUM + (size_t)(chain * NSC + sc) * SUM_SLOT; }

__device__ __forceinline__ void rwkv_pass1_pair(Frame& F, int li, int pair) {
    const int g = F.wave >> 2, wq = F.wave & 3, u = 2 * pair + g;
    const int chain = u / (NSC - 1), sc = u % (NSC - 1);
    const int dir = chain / 12, b = (chain / 6) & 1, h = chain % 6;
    const bool isctx = sc < 2; const int scl = isctx ? sc : sc - 2;
    LAS unsigned char* img = F.lds + (g ? L_IMG1 : L_IMG0); LAS unsigned* pkg = (LAS unsigned*)(F.lds + L_PKG) + g * 1024;
    LAS float* cst = (LAS float*)(F.lds + L_CST) + g * 768;
    __syncthreads();
    chain_consts_lds(F, cst, li, h, F.tid & 255);
    const int q = F.lane >> 4, c = F.lane & 15;
    f32x4 SB[4], SA[4];
#pragma unroll
    for (int T = 0; T < 4; ++T)
#pragma unroll
        for (int e = 0; e < 4; ++e) { SB[T][e] = 0.0f; SA[T][e] = (16 * T + 4 * q + e == c + 16 * wq) ? 1.0f : 0.0f; }
    PrepRaw R;
    prep_load(F, R, dir, b, h, 8 * wq + (F.lane >> 3), F.lane & 7, isctx, 128 * scl);
#pragma unroll 1
    for (int rd = 0; rd < 4; ++rd) {
        __syncthreads();
        prep_compute(F, R, cst, img, dir, b, h, 8 * wq + (F.lane >> 3), F.lane & 7, isctx, 128 * scl + 32 * rd, nullptr, nullptr, 0);
        __syncthreads();
        if (rd < 3) prep_load(F, R, dir, b, h, 8 * wq + (F.lane >> 3), F.lane & 7, isctx, 128 * scl + 32 * (rd + 1));
        if (wq < 2) block_package<false>(img, wq, pkg + wq * 512, F.lane);
        __syncthreads();
#pragma unroll
        for (int blk = 0; blk < 2; ++blk) { block_scan<false, true>(img, blk, pkg + blk * 512, SB, wq, F.lane); block_scan<false, false>(img, blk, pkg + blk * 512, SA, wq, F.lane); }
    }
    unsigned char* slot = sum_slot(F, chain, sc);
    { f32x4* braw = (f32x4*)slot;
#pragma unroll
      for (int T = 0; T < 4; ++T) braw[(wq * 4 + T) * 64 + F.lane] = SB[T]; }
    { bf16* aim = (bf16*)(slot + 16384); const int kap = wq >> 1, e = (F.lane & 3) + 4 * (wq & 1), qc = c >> 2;
#pragma unroll
      for (int T = 0; T < 4; ++T)
#pragma unroll
          for (int r = 0; r < 4; ++r) { const int lc = (4 * q + r) + 16 * qc; aim[((T * 2 + kap) * 64 + lc) * 8 + e] = (bf16)f2bf(SA[T][r]); } }
}
struct P2Buf { f32x4 Bc[4]; bf16x8 af[4][2]; };
__device__ __forceinline__ void p2_load(Frame& F, P2Buf& X, int chain, int sc, int wq) {
    unsigned char* slot = sum_slot(F, chain, sc); const f32x4* braw = (const f32x4*)slot; const bf16* aim = (const bf16*)(slot + 16384);
#pragma unroll
    for (int T = 0; T < 4; ++T) { X.Bc[T] = braw[(wq * 4 + T) * 64 + F.lane];
#pragma unroll
        for (int k = 0; k < 2; ++k) X.af[T][k] = *(const bf16x8*)(aim + ((T * 2 + k) * 64 + F.lane) * 8); }
}
__device__ __forceinline__ void p2_step(Frame& F, const P2Buf& X, f32x4 (&S)[4], int chain, int sc, int wq) {
    f32x4* braw = (f32x4*)sum_slot(F, chain, sc);
    bf16x8 Sb[2];
#pragma unroll
    for (int k = 0; k < 2; ++k) Sb[k] = mk8(cvtpk(S[2 * k][0], S[2 * k][1]), cvtpk(S[2 * k][2], S[2 * k][3]), cvtpk(S[2 * k + 1][0], S[2 * k + 1][1]), cvtpk(S[2 * k + 1][2], S[2 * k + 1][3]));
#pragma unroll
    for (int T = 0; T < 4; ++T) { braw[(wq * 4 + T) * 64 + F.lane] = S[T]; const f32x4 a = MFMA16(X.af[T][0], Sb[0], X.Bc[T]); S[T] = MFMA16(X.af[T][1], Sb[1], a); }
}
__device__ __forceinline__ void rwkv_pass2_chain(Frame& F, int chain) {
    if (F.wave >= 4) return;
    const int wq = F.wave; constexpr int NS = NSC - 1;
    f32x4 S[4];
#pragma unroll
    for (int T = 0; T < 4; ++T) S[T] = (f32x4){0.f, 0.f, 0.f, 0.f};
    P2Buf X0, X1, X2;
    p2_load(F, X0, chain, 0, wq); p2_load(F, X1, chain, 1, wq); p2_load(F, X2, chain, 2, wq);
#pragma unroll 1
    for (int sc = 0; sc < NS; sc += 3) {
        p2_step(F, X0, S, chain, sc, wq); if (sc + 3 < NS) p2_load(F, X0, chain, sc + 3, wq);
        if (sc + 1 < NS) { p2_step(F, X1, S, chain, sc + 1, wq); if (sc + 4 < NS) p2_load(F, X1, chain, sc + 4, wq); }
        if (sc + 2 < NS) { p2_step(F, X2, S, chain, sc + 2, wq); if (sc + 5 < NS) p2_load(F, X2, chain, sc + 5, wq); }
    }
    { f32x4* braw = (f32x4*)sum_slot(F, chain, NSC - 1);
#pragma unroll
      for (int T = 0; T < 4; ++T) braw[(wq * 4 + T) * 64 + F.lane] = S[T]; }
}
__device__ __forceinline__ void rwkv_pass3_unit(Frame& F, int li, int u) {
    const int pc = u % NSC, bh = u / NSC, b = bh / 6, h = bh % 6;
    const bool isctx = pc < 2; const int pcl = isctx ? pc : pc - 2, nsc = isctx ? 2 : 64;
    const int dir = F.wave >> 2, wq = F.wave & 3, q = F.lane >> 4, c = F.lane & 15;
    const int sc = dir == 0 ? pc : (isctx ? 1 - pcl : 2 + 63 - pcl);
    const int scl = dir == 0 ? pcl : nsc - 1 - pcl;
    const int chain = dir * 12 + b * 6 + h;
    LAS unsigned char* img = F.lds + (dir ? L_IMG1 : L_IMG0); LAS unsigned* pkg = (LAS unsigned*)(F.lds + L_PKG) + dir * 1024;
    LAS float* YL = (LAS float*)(F.lds + L_YL); LAS unsigned char* VB = F.lds + L_VB; LAS float* BON = (LAS float*)(F.lds + L_BON);
    LAS float* cst = (LAS float*)(F.lds + L_CST);
    __syncthreads();
    if (F.tid < 256) chain_consts_lds(F, cst, li, h, F.tid);
    f32x4 S[4];
    { const f32x4* braw = (const f32x4*)sum_slot(F, chain, sc);
#pragma unroll
      for (int T = 0; T < 4; ++T) S[T] = braw[(wq * 4 + T) * 64 + F.lane]; }
    __syncthreads();
    for (int i = F.tid; i < 128 * 68; i += NTHR) YL[i] = 0.f;
    PrepRaw R;
    prep_load(F, R, dir, b, h, 8 * wq + (F.lane >> 3), F.lane & 7, isctx, 128 * scl);
#pragma unroll 1
    for (int rd = 0; rd < 4; ++rd) {
        __syncthreads();
        prep_compute(F, R, cst, img, dir, b, h, 8 * wq + (F.lane >> 3), F.lane & 7, isctx, 128 * scl + 32 * rd, dir == 0 ? VB : (LAS unsigned char*)nullptr, BON, 32 * rd);
        __syncthreads();
        if (rd < 3) prep_load(F, R, dir, b, h, 8 * wq + (F.lane >> 3), F.lane & 7, isctx, 128 * scl + 32 * (rd + 1));
        if (wq < 2) block_package<true>(img, wq, pkg + wq * 512, F.lane);
        __syncthreads();
#pragma unroll
        for (int blk = 0; blk < 2; ++blk) { const f32x4 y = block_scan<true, true>(img, blk, pkg + blk * 512, S, wq, F.lane);
#pragma unroll
            for (int e = 0; e < 4; ++e) { const int t = 32 * rd + 16 * blk + 4 * q + e; const int pl = dir ? 127 - t : t; YL[pl * 68 + c + 16 * wq] += y[e]; } }
    }
    __syncthreads();
    const int wv = F.wave; const int rbase = (isctx ? TL + b * CTX : b * SEQ) + 128 * pcl;
    const bf16* g2t = (const bf16*)(F.ws + WS_G2T) + (size_t)li * 384 * 128;
    f32x4 gate[4];
#pragma unroll
    for (int nt = 0; nt < 4; ++nt) gate[nt] = (f32x4){0.f, 0.f, 0.f, 0.f};
#pragma unroll
    for (int k = 0; k < 4; ++k) { const v4u zg = *(const v4u*)(zrow(F, rbase + 16 * wv + c) + ZG + 32 * k + 8 * q);
#define SG(x) (1.0f / (1.0f + __expf(-(x))))
        const bf16x8 a = mk8(pk2(SG(bflo(zg.x)), SG(bfhi(zg.x))), pk2(SG(bflo(zg.y)), SG(bfhi(zg.y))), pk2(SG(bflo(zg.z)), SG(bfhi(zg.z))), pk2(SG(bflo(zg.w)), SG(bfhi(zg.w))));
#undef SG
#pragma unroll
        for (int nt = 0; nt < 4; ++nt) { const bf16x8 bb = *(const bf16x8*)(g2t + (size_t)(64 * h + 16 * nt + c) * 128 + 32 * k + 8 * q); gate[nt] = MFMA16(a, bb, gate[nt]); } }
    bf16* mix = (bf16*)(F.ws + WS_H);
    float lg[4], lb[4];
#pragma unroll
    for (int nt = 0; nt < 4; ++nt) { lg[nt] = inp(I_LNG)[li * RW + 64 * h + 16 * nt + c]; lb[nt] = inp(I_LNB)[li * RW + 64 * h + 16 * nt + c]; }
#pragma unroll
    for (int e = 0; e < 4; ++e) { const int tl = 16 * wv + 4 * q + e;
        float yv[4], s = 0.f;
#pragma unroll
        for (int nt = 0; nt < 4; ++nt) { yv[nt] = YL[tl * 68 + 16 * nt + c]; s += yv[nt]; }
        s += __shfl_xor(s, 1); s += __shfl_xor(s, 2); s += __shfl_xor(s, 4); s += __shfl_xor(s, 8);
        const float mu = s * (1.0f / 64.0f); float v2 = 0.f;
#pragma unroll
        for (int nt = 0; nt < 4; ++nt) { yv[nt] -= mu; v2 += yv[nt] * yv[nt]; }
        v2 += __shfl_xor(v2, 1); v2 += __shfl_xor(v2, 2); v2 += __shfl_xor(v2, 4); v2 += __shfl_xor(v2, 8);
        const float rs = 1.0f / sqrtf(v2 * (1.0f / 64.0f) + GN_EPS); const float bon = BON[tl];
#pragma unroll
        for (int nt = 0; nt < 4; ++nt) { const float vv = bf2f(((const LAS bf16*)VB)[tl * 64 + 16 * nt + c]);
            const float o = (yv[nt] * rs * lg[nt] + lb[nt] + bon * vv) * gate[nt][e];
            mix[(size_t)(rbase + tl) * DM + 640 + 64 * h + 16 * nt + c] = (bf16)f2bf(o); } }
}

constexpr int AT_KROW = 144;
__device__ __forceinline__ void attn_unit(Frame& F, int li, int u) {
    const bool cq = u >= 256;
    int b, kvh, qb;
    if (!cq) { b = u >> 7; kvh = (u >> 6) & 1; qb = u & 63; } else { const int uu = u - 256; b = uu >> 2; kvh = (uu >> 1) & 1; qb = uu & 1; }
    const int c = F.lane & 15, q = F.lane >> 4, tb = F.wave;
    const bf16* qr = (const bf16*)(F.ws + WS_QR); const bf16* kr = (const bf16*)(F.ws + WS_KR); bf16* mix = (bf16*)(F.ws + WS_H);
    const int qrow = (cq ? TL + b * CTX : b * SEQ) + 128 * qb + 16 * tb + c;
    const int qpos = 128 * qb + 16 * tb + c;
    bf16x8 Q[3][2];
#pragma unroll
    for (int hh = 0; hh < 3; ++hh)
#pragma unroll
        for (int k = 0; k < 2; ++k) {
            if (!cq) Q[hh][k] = *(const bf16x8*)(qr + (size_t)qrow * 384 + 64 * (3 * kvh + hh) + 32 * k + 8 * q);
            else { const v4u w = *(const v4u*)(zrow(F, qrow) + ZQ + 64 * (3 * kvh + hh) + 32 * k + 8 * q);
                Q[hh][k] = mk8(pk2(0.125f * bflo(w.x), 0.125f * bfhi(w.x)), pk2(0.125f * bflo(w.y), 0.125f * bfhi(w.y)), pk2(0.125f * bflo(w.z), 0.125f * bfhi(w.z)), pk2(0.125f * bflo(w.w), 0.125f * bfhi(w.w))); } }
    float m[3], l[3]; f32x4 O[3][4];
#pragma unroll
    for (int hh = 0; hh < 3; ++hh) { m[hh] = inp(I_SINK)[li * 6 + 3 * kvh + hh]; l[hh] = q == 0 ? 1.0f : 0.0f;
#pragma unroll
        for (int dt = 0; dt < 4; ++dt) O[hh][dt] = (f32x4){0.f, 0.f, 0.f, 0.f}; }
    LAS unsigned char* KI = F.lds;
#pragma unroll 1
    for (int stage = cq ? 1 : 0; stage < 2; ++stage) {
        const int nkeys = stage == 0 ? 384 : 256; const int vstride = (nkeys + 8) * 2;
        LAS unsigned char* VTI = F.lds + 384 * AT_KROW;
        const int kpos0 = 128 * (qb - 1);
        __syncthreads();
        for (int pc = F.tid; pc < nkeys * 8; pc += NTHR) { const int key = pc >> 3, d8 = pc & 7;
            const bf16* ksrc; const bf16* vsrc;
            if (stage == 0) { int kp = kpos0 + key; kp = kp < 0 ? 0 : (kp >= SEQ ? SEQ - 1 : kp); ksrc = kr + (size_t)(b * SEQ + kp) * 128 + 64 * kvh; vsrc = zrow(F, b * SEQ + kp) + ZV + 64 * kvh; }
            else { const bf16* z = zrow(F, TL + b * CTX + key); ksrc = z + ZK + 64 * kvh; vsrc = z + ZV + 64 * kvh; }
            const v4u kv = *(const v4u*)(ksrc + 8 * d8); const v4u vv = *(const v4u*)(vsrc + 8 * d8);
            *(LAS v4u*)(KI + key * AT_KROW + d8 * 16) = kv;
            const int kl = key & 31; const int col = (key & ~31) | (((kl & 15) >> 2) << 3) | ((kl >> 4) << 2) | (kl & 3);
            LAS bf16* vt = (LAS bf16*)(VTI + (8 * d8) * vstride) + col;
            vt[0] = (bf16)(vv.x & 0xffff); *(LAS bf16*)((LAS unsigned char*)vt + vstride) = (bf16)(vv.x >> 16);
            *(LAS bf16*)((LAS unsigned char*)vt + 2 * vstride) = (bf16)(vv.y & 0xffff); *(LAS bf16*)((LAS unsigned char*)vt + 3 * vstride) = (bf16)(vv.y >> 16);
            *(LAS bf16*)((LAS unsigned char*)vt + 4 * vstride) = (bf16)(vv.z & 0xffff); *(LAS bf16*)((LAS unsigned char*)vt + 5 * vstride) = (bf16)(vv.z >> 16);
            *(LAS bf16*)((LAS unsigned char*)vt + 6 * vstride) = (bf16)(vv.w & 0xffff); *(LAS bf16*)((LAS unsigned char*)vt + 7 * vstride) = (bf16)(vv.w >> 16); }
        __syncthreads();
        const int npair = nkeys / 32;
        const int Q0 = 128 * qb + 16 * tb;
#pragma unroll 1
        for (int kp = 0; kp < npair; ++kp) {
            const int kb = kpos0 + 32 * kp;
            if (stage == 0 && (kb + 31 < Q0 - 128 || kb > Q0 + 143 || kb + 31 < 0 || kb >= SEQ)) continue;
            bf16x8 K[2][2], V[4];
#pragma unroll
            for (int t = 0; t < 2; ++t)
#pragma unroll
                for (int k = 0; k < 2; ++k) K[t][k] = *(const LAS bf16x8*)(KI + (32 * kp + 16 * t + c) * AT_KROW + k * 64 + q * 16);
#pragma unroll
            for (int dt = 0; dt < 4; ++dt) V[dt] = *(const LAS bf16x8*)(VTI + (16 * dt + c) * vstride + kp * 64 + q * 16);
            bool ok0[4], ok1[4];
#pragma unroll
            for (int e = 0; e < 4; ++e) { const int k0 = kb + 4 * q + e, k1 = k0 + 16;
                ok0[e] = stage == 1 || (k0 >= 0 && k0 < SEQ && k0 >= qpos - 128 && k0 <= qpos + 128);
                ok1[e] = stage == 1 || (k1 >= 0 && k1 < SEQ && k1 >= qpos - 128 && k1 <= qpos + 128); }
#pragma unroll
            for (int hh = 0; hh < 3; ++hh) {
                f32x4 s0 = {0.f, 0.f, 0.f, 0.f}, s1 = {0.f, 0.f, 0.f, 0.f};
                s0 = MFMA16(K[0][0], Q[hh][0], s0); s0 = MFMA16(K[0][1], Q[hh][1], s0);
                s1 = MFMA16(K[1][0], Q[hh][0], s1); s1 = MFMA16(K[1][1], Q[hh][1], s1);
                float mx = -INFINITY;
#pragma unroll
                for (int e = 0; e < 4; ++e) { s0[e] = ok0[e] ? s0[e] : -INFINITY; s1[e] = ok1[e] ? s1[e] : -INFINITY; mx = fmaxf(mx, fmaxf(s0[e], s1[e])); }
                mx = fmaxf(mx, __shfl_xor(mx, 16)); mx = fmaxf(mx, __shfl_xor(mx, 32));
                const float mn = fmaxf(m[hh], mx); const float alpha = __expf(m[hh] - mn); m[hh] = mn;
                float ps = 0.f;
#pragma unroll
                for (int e = 0; e < 4; ++e) { s0[e] = __expf(s0[e] - mn); s1[e] = __expf(s1[e] - mn); ps += s0[e] + s1[e]; }
                l[hh] = l[hh] * alpha + ps;
                const bf16x8 P = mk8(cvtpk(s0[0], s0[1]), cvtpk(s0[2], s0[3]), cvtpk(s1[0], s1[1]), cvtpk(s1[2], s1[3]));
#pragma unroll
                for (int dt = 0; dt < 4; ++dt) { O[hh][dt] = O[hh][dt] * alpha; O[hh][dt] = MFMA16(V[dt], P, O[hh][dt]); }
            }
        }
    }
#pragma unroll
    for (int hh = 0; hh < 3; ++hh) { float lt = l[hh]; lt += __shfl_xor(lt, 16); lt += __shfl_xor(lt, 32); const float inv = 1.0f / lt;
#pragma unroll
        for (int dt = 0; dt < 4; ++dt) { v2u w; w.x = pk2(O[hh][dt][0] * inv, O[hh][dt][1] * inv); w.y = pk2(O[hh][dt][2] * inv, O[hh][dt][3] * inv);
            *(v2u*)(mix + (size_t)qrow * DM + 256 + 64 * (3 * kvh + hh) + 16 * dt + 4 * q) = w; } }
}

__device__ __forceinline__ void fourier_tables(Frame& F) {
    bf16* t = (bf16*)(F.ws + WS_FT);
    for (int i = F.bid * NTHR + F.tid; i < 64 * 64; i += F.G * NTHR) { const int r = i >> 6, cc = i & 63; const float a = (float)((r * cc) & 63) * (1.0f / 64.0f);
        const float cs = __builtin_amdgcn_cosf(a), sn = __builtin_amdgcn_sinf(a);
        t[FT_W64C / 2 + i] = (bf16)f2bf(cs); t[FT_W64S / 2 + i] = (bf16)f2bf(sn);
        const int pj = (cc & ~31) | (((cc & 15) >> 2) << 3) | (((cc >> 4) & 1) << 2) | (cc & 3);
        t[FT_T64C / 2 + r * 64 + pj] = (bf16)f2bf(cs); t[FT_T64S / 2 + r * 64 + pj] = (bf16)f2bf(sn); }
    for (int i = F.bid * NTHR + F.tid; i < 128 * 128; i += F.G * NTHR) { const int r = i >> 7, cc = i & 127; const float a = (float)((r * cc) & 127) * (1.0f / 128.0f);
        t[FT_W128C / 2 + i] = (bf16)f2bf(__builtin_amdgcn_cosf(a)); t[FT_W128S / 2 + i] = (bf16)f2bf(__builtin_amdgcn_sinf(a)); }
}
__device__ __forceinline__ void fourier_a_fast(Frame& F, int u) {
    const int b = u >> 7, n2 = u & 127, c = F.lane & 15, q = F.lane >> 4;
    LAS unsigned char* IMG = F.lds;
    __syncthreads();
    for (int pc = F.tid; pc < 64 * 32; pc += NTHR) { const int n1 = pc >> 5, c8 = pc & 31;
        const v4u v = *(const v4u*)(zrow(F, b * SEQ + 128 * n1 + n2) + ZF + 8 * c8);
        LAS bf16* d = (LAS bf16*)(IMG + (8 * c8) * 144) + n1;
        d[0] = (bf16)(v.x & 0xffff); d[72] = (bf16)(v.x >> 16); d[144] = (bf16)(v.y & 0xffff); d[216] = (bf16)(v.y >> 16);
        d[288] = (bf16)(v.z & 0xffff); d[360] = (bf16)(v.z >> 16); d[432] = (bf16)(v.w & 0xffff); d[504] = (bf16)(v.w >> 16); }
    __syncthreads();
    const bf16* wc = (const bf16*)(F.ws + WS_FT + FT_W64C); const bf16* wsn = (const bf16*)(F.ws + WS_FT + FT_W64S);
    bf16* far = (bf16*)((unsigned char*)F.out + OUT_FA); bf16* fai = far + (size_t)NB * 64 * 128 * 256;
    bf16x8 Bc[4][2], Bs[4][2];
#pragma unroll
    for (int kt = 0; kt < 4; ++kt)
#pragma unroll
        for (int k = 0; k < 2; ++k) { Bc[kt][k] = *(const bf16x8*)(wc + (16 * kt + c) * 64 + 32 * k + 8 * q); Bs[kt][k] = *(const bf16x8*)(wsn + (16 * kt + c) * 64 + 32 * k + 8 * q); }
#pragma unroll
    for (int ci = 0; ci < 2; ++ci) { const int ct = 2 * F.wave + ci;
        bf16x8 A[2];
#pragma unroll
        for (int k = 0; k < 2; ++k) A[k] = *(const LAS bf16x8*)(IMG + (16 * ct + c) * 144 + k * 64 + q * 16);
#pragma unroll
        for (int kt = 0; kt < 4; ++kt) { f32x4 sr = {0.f, 0.f, 0.f, 0.f}, si = {0.f, 0.f, 0.f, 0.f};
#pragma unroll
            for (int k = 0; k < 2; ++k) { sr = MFMA16(A[k], Bc[kt][k], sr); si = MFMA16(A[k], Bs[kt][k], si); }
            const int k1 = 16 * kt + c; const float tw = (float)(n2 * k1) * (1.0f / 8192.0f); const float tc = __builtin_amdgcn_cosf(tw), ts = __builtin_amdgcn_sinf(tw);
            float xr[4], xi[4];
#pragma unroll
            for (int e = 0; e < 4; ++e) { const float ar = sr[e], ai = -si[e]; xr[e] = ar * tc + ai * ts; xi[e] = ai * tc - ar * ts; }
            const size_t o = (((size_t)b * 64 + k1) * 128 + n2) * 256 + 16 * ct + 4 * q;
            v2u w; w.x = pk2(xr[0], xr[1]); w.y = pk2(xr[2], xr[3]); *(v2u*)(far + o) = w; w.x = pk2(xi[0], xi[1]); w.y = pk2(xi[2], xi[3]); *(v2u*)(fai + o) = w; } }
}
__device__ __forceinline__ void fourier_c_fast(Frame& F, int u) {
    const int g = u & 3, k1 = (u >> 2) & 63, b = u >> 8, c = F.lane & 15, q = F.lane >> 4;
    LAS unsigned char* IR = F.lds; LAS unsigned char* II = F.lds + 64 * 272;
    const bf16* far = (const bf16*)((unsigned char*)F.out + OUT_FA) + (((size_t)b * 64 + k1) * 128) * 256 + 64 * g; const bf16* fai = far + (size_t)NB * 64 * 128 * 256;
    __syncthreads();
    for (int pc = F.tid; pc < 128 * 8; pc += NTHR) { const int n2 = pc >> 3, c8 = pc & 7;
        const v4u vr = *(const v4u*)(far + (size_t)n2 * 256 + 8 * c8), vi = *(const v4u*)(fai + (size_t)n2 * 256 + 8 * c8);
        LAS bf16* dr = (LAS bf16*)(IR + (8 * c8) * 272) + n2; LAS bf16* di = (LAS bf16*)(II + (8 * c8) * 272) + n2;
        dr[0] = (bf16)(vr.x & 0xffff); dr[136] = (bf16)(vr.x >> 16); dr[272] = (bf16)(vr.y & 0xffff); dr[408] = (bf16)(vr.y >> 16);
        dr[544] = (bf16)(vr.z & 0xffff); dr[680] = (bf16)(vr.z >> 16); dr[816] = (bf16)(vr.w & 0xffff); dr[952] = (bf16)(vr.w >> 16);
        di[0] = (bf16)(vi.x & 0xffff); di[136] = (bf16)(vi.x >> 16); di[272] = (bf16)(vi.y & 0xffff); di[408] = (bf16)(vi.y >> 16);
        di[544] = (bf16)(vi.z & 0xffff); di[680] = (bf16)(vi.z >> 16); di[816] = (bf16)(vi.w & 0xffff); di[952] = (bf16)(vi.w >> 16); }
    __syncthreads();
    const bf16* wc = (const bf16*)(F.ws + WS_FT + FT_W128C); const bf16* wsn = (const bf16*)(F.ws + WS_FT + FT_W128S);
    const bf16* tcn = (const bf16*)(F.ws + WS_FT + FT_T64C); const bf16* tsn = (const bf16*)(F.ws + WS_FT + FT_T64S);
    f32x4 Pr[4], Pi[4];
#pragma unroll
    for (int ct = 0; ct < 4; ++ct) { Pr[ct] = (f32x4){0.f, 0.f, 0.f, 0.f}; Pi[ct] = (f32x4){0.f, 0.f, 0.f, 0.f}; }
#pragma unroll
    for (int k = 0; k < 4; ++k) { const bf16x8 bc = *(const bf16x8*)(wc + (16 * F.wave + c) * 128 + 32 * k + 8 * q), bs = *(const bf16x8*)(wsn + (16 * F.wave + c) * 128 + 32 * k + 8 * q);
        const v4u bsu = __builtin_bit_cast(v4u, bs); const bf16x8 bsn = mk8(bsu.x ^ 0x80008000u, bsu.y ^ 0x80008000u, bsu.z ^ 0x80008000u, bsu.w ^ 0x80008000u);
#pragma unroll
        for (int ct = 0; ct < 4; ++ct) { const bf16x8 ar = *(const LAS bf16x8*)(IR + (16 * ct + c) * 272 + k * 64 + q * 16), ai = *(const LAS bf16x8*)(II + (16 * ct + c) * 272 + k * 64 + q * 16);
            Pr[ct] = MFMA16(ar, bc, Pr[ct]); Pr[ct] = MFMA16(ai, bs, Pr[ct]); Pi[ct] = MFMA16(ai, bc, Pi[ct]); Pi[ct] = MFMA16(ar, bsn, Pi[ct]); } }
    bf16x8 Br[2], Bi[2];
#pragma unroll
    for (int k = 0; k < 2; ++k) { Br[k] = mk8(cvtpk(Pr[2 * k][0], Pr[2 * k][1]), cvtpk(Pr[2 * k][2], Pr[2 * k][3]), cvtpk(Pr[2 * k + 1][0], Pr[2 * k + 1][1]), cvtpk(Pr[2 * k + 1][2], Pr[2 * k + 1][3]));
        Bi[k] = mk8(cvtpk(Pi[2 * k][0], Pi[2 * k][1]), cvtpk(Pi[2 * k][2], Pi[2 * k][3]), cvtpk(Pi[2 * k + 1][0], Pi[2 * k + 1][1]), cvtpk(Pi[2 * k + 1][2], Pi[2 * k + 1][3])); }
    bf16* mix = (bf16*)(F.ws + WS_H);
    const float scale = 0.0013810679320049757f;
    const int k2 = 16 * F.wave + c; const size_t row = (size_t)b * SEQ + k1 + 64 * k2;
#pragma unroll
    for (int mt = 0; mt < 4; ++mt) { f32x4 y = {0.f, 0.f, 0.f, 0.f};
#pragma unroll
        for (int k = 0; k < 2; ++k) { const bf16x8 ac = *(const bf16x8*)(tcn + (16 * mt + c) * 64 + 32 * k + 8 * q), as = *(const bf16x8*)(tsn + (16 * mt + c) * 64 + 32 * k + 8 * q);
            y = MFMA16(ac, Br[k], y); y = MFMA16(as, Bi[k], y); }
        v2u w; w.x = pk2(y[0] * scale, y[1] * scale); w.y = pk2(y[2] * scale, y[3] * scale);
        *(v2u*)(mix + row * DM + 64 * g + 16 * mt + 4 * q) = w; }
}

#define XB_TMO      128
#define XB_XCNT(j)  (256  + 64 * (j))
#define XB_XSUB(j)  (1280 + 64 * (j))
#define XB_XGEN(j)  (2304 + 64 * (j))
#define XB_TOP      3328
#define XB_TOPGEN   3392
#define XCD_BAR_WORDS 3456
#define XB_SPIN_CAP (1u << 23)
__device__ __forceinline__ unsigned xb_ld(unsigned* p)              { return __hip_atomic_load(p, __ATOMIC_RELAXED, __HIP_MEMORY_SCOPE_AGENT); }
__device__ __forceinline__ unsigned xb_add(unsigned* p, unsigned v) { return __hip_atomic_fetch_add(p, v, __ATOMIC_RELAXED, __HIP_MEMORY_SCOPE_AGENT); }
__device__ __forceinline__ unsigned xb_xcc_id() { return (unsigned)__builtin_amdgcn_s_getreg((3 << 11) | 20) & 0xFu; }
#define XB_SPIN(cond, bar) do { unsigned _sp = 0; while (cond) { __builtin_amdgcn_s_sleep(1); \
    if ((++_sp & 255u) == 0u) { if (xb_ld(&(bar)[XB_TMO])) break; if (_sp > XB_SPIN_CAP) { atomicAdd(&(bar)[XB_TMO], 1u); break; } } } } while (0)
struct XcdBarrier { unsigned* bar; unsigned x; volatile LAS unsigned* st; };
__device__ __forceinline__ XcdBarrier xcd_barrier_post(unsigned* bar, volatile LAS unsigned* st) {
    XcdBarrier b; b.bar = bar; b.x = xb_xcc_id(); b.st = st;
    if (threadIdx.x == 0) (void)xb_add(&bar[XB_XCNT(b.x)], 1u);
    return b;
}
__device__ __forceinline__ void xcd_barrier_complete(unsigned* bar, unsigned x, unsigned& nloc, unsigned& nx) {
    const unsigned G = gridDim.x * gridDim.y * gridDim.z;
    unsigned sum, cnt, mine, sp = 0u;
    for (;;) {
        sum = 0u; cnt = 0u; mine = 0u;
#pragma unroll
        for (unsigned j = 0; j < 16; ++j) { const unsigned c = xb_ld(&bar[XB_XCNT(j)]); sum += c; cnt += (c > 0u) ? 1u : 0u; mine = (j == x) ? c : mine; }
        if (sum == G) break;
        __builtin_amdgcn_s_sleep(1);
        if ((++sp & 255u) == 0u) { if (xb_ld(&bar[XB_TMO])) break; if (sp > XB_SPIN_CAP) { atomicAdd(&bar[XB_TMO], 1u); break; } }
    }
    nloc = mine > 0u ? mine : 1u; nx = cnt > 0u ? cnt : 1u;
}
__device__ __forceinline__ void xcd_barrier(const XcdBarrier& b0) {
    XcdBarrier b; { unsigned* p = b0.bar; unsigned x = __builtin_amdgcn_readfirstlane(b0.x); unsigned st = (unsigned)(size_t)b0.st; asm volatile("" : "+s"(p), "+s"(x), "+s"(st)); b.bar = p; b.x = x; b.st = (volatile LAS unsigned*)(size_t)st; }
    asm volatile("s_waitcnt vmcnt(0)" ::: "memory");
    __syncthreads();
    if (threadIdx.x == 0) {
        unsigned* bar = b.bar;
        __builtin_amdgcn_s_waitcnt(0);
        unsigned nloc = b.st[0], nx = b.st[1];
        if (nloc == 0u) { xcd_barrier_complete(bar, b.x, nloc, nx); b.st[0] = nloc; b.st[1] = nx; }
        const unsigned old = xb_add(&bar[XB_XSUB(b.x)], 1u);
        const unsigned gen = old / nloc;
        if (old + 1u == (gen + 1u) * nloc) {
            __builtin_amdgcn_fence(__ATOMIC_RELEASE, "agent");
            asm volatile("s_waitcnt vmcnt(0)" ::: "memory");
            const unsigned og = xb_add(&bar[XB_TOP], 1u);
            const unsigned tg = og / nx;
            if (og + 1u == (tg + 1u) * nx) xb_add(&bar[XB_TOPGEN], 1u);
            else XB_SPIN(xb_ld(&bar[XB_TOPGEN]) == tg, bar);
            __builtin_amdgcn_fence(__ATOMIC_ACQUIRE, "agent");
            xb_add(&bar[XB_XGEN(b.x)], 1u);
            asm volatile("s_waitcnt vmcnt(0)" ::: "memory");
        } else {
            XB_SPIN(xb_ld(&bar[XB_XGEN(b.x)]) == gen, bar);
            __builtin_amdgcn_fence(__ATOMIC_ACQUIRE, "agent");
            asm volatile("s_waitcnt vmcnt(0)" ::: "memory");
        }
    }
    __syncthreads();
}

__device__ __forceinline__ int queue_next(Frame& F, unsigned* cnt) {
    volatile LAS int* slot = (volatile LAS int*)(F.lds + MISC_OFF + 64);
    __syncthreads();
    if (F.tid == 0) *slot = (int)__hip_atomic_fetch_add(cnt, 1u, __ATOMIC_RELAXED, __HIP_MEMORY_SCOPE_AGENT);
    __syncthreads();
    return *slot;
}
template <int KIND> __device__ __forceinline__ void run_phase(const Frame& F0, int li, int second) {
    Frame F;
    { int t = threadIdx.x; asm volatile("" : "+v"(t)); F.tid = t; F.lane = t & 63; F.wave = __builtin_amdgcn_readfirstlane(t >> 6);
      int g = F0.G, b = F0.bid; asm volatile("" : "+s"(g), "+s"(b)); F.G = g; F.bid = b;
      unsigned char* w = F0.ws; float* o = F0.out; asm volatile("" : "+s"(w), "+s"(o)); F.ws = w; F.out = o;
      unsigned l = (unsigned)(size_t)F0.lds; asm volatile("" : "+s"(l)); F.lds = (LAS unsigned char*)(size_t)l;
      asm volatile("" : "+s"(li), "+s"(second)); }
    float* modv = (float*)(F.ws + WS_MOD);
    bf16* XB = (bf16*)(F.ws + WS_XB);
    bf16* H = (bf16*)(F.ws + WS_H); bf16* ACT = (bf16*)(F.ws + WS_ACT); bf16* O = (bf16*)(F.ws + WS_O);
    const float* ng = inp(I_NORMG) + (size_t)li * 6 * DM; const float* mv = modv + (size_t)li * 3 * 9216;
    const bool last = li == 1;
    if constexpr (KIND == 100) { convert_weights(F, 0); mod_gemv(F); rope_tables(F); lora_transposes(F); fourier_tables(F); }
    if constexpr (KIND == 101) { EArgs A{}; A.xl_src = inp(I_X); A.xc_src = inp(I_CTX); A.o = nullptr; A.hdst = H; A.modv_h = modv; A.shidx = 0; A.scidx = 1; A.gpre = inp(I_NORMG); A.nrows = TT; e_phase(F, A); }
    if constexpr (KIND == 0) {
        const bf16* wi = (const bf16*)(F.ws + (second ? WS_WI2 : WS_WI1)); const bool withctx = !(last && second);
        if (!withctx || F.G != 256) { pg8::Gemm g{H, wi, withctx ? TT : TL, NWI, DM}; pg8::StaticOrder S; S.init(g.M, g.N, F.G, F.bid);
            pg8::EpiSwiglu E{ACT, FFNP}; pg8::gemm_phase<pg8::EpiSwiglu, pg8::StaticOrder, true, true>(F.lds, g, S, E, F.tid); }
        else { unsigned* cnt = (unsigned*)(F.ws + WS_CTL) + 8192 + 64 * (li * 2 + second);
            pg8::Gemm g{H, wi, TT, NWI, DM}; pg8::UpOrder S; S.init(NWI, F.G, F.bid, cnt);
            pg8::EpiSwiglu E{ACT, FFNP}; pg8::gemm_phase<pg8::EpiSwiglu, pg8::UpOrder, true, true>(F.lds, g, S, E, F.tid);
            if (F.bid >= 248) {
                if (F.tid == 0) { unsigned sp = 0; while (__hip_atomic_load(cnt, __ATOMIC_RELAXED, __HIP_MEMORY_SCOPE_AGENT) < 352u && ++sp < (1u << 24)) __builtin_amdgcn_s_sleep(8);
                    __builtin_amdgcn_fence(__ATOMIC_ACQUIRE, "agent"); asm volatile("s_waitcnt vmcnt(0)" ::: "memory"); }
                __syncthreads();
                const int k = F.bid - 248; pg8::Gemm g2{ACT, (const bf16*)(F.ws + (second ? WS_WO2 : WS_WO1)), TT, DM, FFNP}; pg8::OneUnit S2{64 + (k >> 2), k & 3};
                pg8::EpiBf16 E2{O, DM}; pg8::gemm_phase<pg8::EpiBf16, pg8::OneUnit, false, true>(F.lds, g2, S2, E2, F.tid); } } }
    if constexpr (KIND == 1) {
        const bool ctxhere = F.G != 256 && !(last && second);
        pg8::Gemm g{ACT, (const bf16*)(F.ws + (second ? WS_WO2 : WS_WO1)), ctxhere ? TT : TL, DM, FFNP}; pg8::StaticOrder S; S.init(g.M, g.N, F.G, F.bid);
        pg8::EpiBf16 E{O, DM}; pg8::gemm_phase<pg8::EpiBf16, pg8::StaticOrder, true, true>(F.lds, g, S, E, F.tid); }
    if constexpr (KIND == 2) {
        EArgs A{}; A.xl_src = inp(I_X); A.xc_src = inp(I_CTX); A.xb_src = li == 0 ? (const bf16*)nullptr : XB; A.xb_dst = XB; A.o = O; A.modv_g = mv; A.gidx = 2; A.gmul = 0.5f; A.gpost = ng + 1 * DM;
        A.hdst = H; A.modv_h = mv; A.shidx = 3; A.scidx = 4; A.gpre = ng + 2 * DM; A.nrows = TT; e_phase(F, A); }
    if constexpr (KIND == 3) {
        pg8::Gemm g{H, (const bf16*)(F.ws + WS_WIN), TT, INWP, DM}; pg8::StaticOrder S; S.init(g.M, g.N, F.G, F.bid);
        pg8::EpiBf16 E{ACT, INWP}; pg8::gemm_phase<pg8::EpiBf16, pg8::StaticOrder, true, true>(F.lds, g, S, E, F.tid); }
    if constexpr (KIND == 4) {
        lora_pass(F, li);
        for (int u = F.bid; u < 256; u += F.G) fourier_a_fast(F, u);
        rope_all(F);
        if (li == 0) fourier_ctx1_all(F); }
    if constexpr (KIND == 5) {
        unsigned* cnt = (unsigned*)(F.ws + WS_CTL) + 8192 + 64 * (4 + 2 * li);
        const int na = li == 0 ? 264 : 256;
        for (int it = queue_next(F, cnt); it < na; it = queue_next(F, cnt)) attn_unit(F, li, it);
        for (int it = queue_next(F, cnt + 16); it < 12 * (NSC - 1); it = queue_next(F, cnt + 16)) rwkv_pass1_pair(F, li, it); }
    if constexpr (KIND == 11) {
        if (F.bid < 24) rwkv_pass2_chain(F, F.bid);
        if (li == 0) fourier_ctx2_all(F); }
    if constexpr (KIND == 12) {
        unsigned* cnt = (unsigned*)(F.ws + WS_CTL) + 8192 + 64 * (5 + 2 * li);
        const int np3 = li == 0 ? 12 * NSC : 12 * 64;
        for (int it = queue_next(F, cnt); it < np3; it = queue_next(F, cnt)) rwkv_pass3_unit(F, li, li == 0 ? it : (it / 64) * NSC + 2 + it % 64);
        for (int it = queue_next(F, cnt + 16); it < 512; it = queue_next(F, cnt + 16)) fourier_c_fast(F, it); }
    if constexpr (KIND == 6) {
        pg8::Gemm g{H, (const bf16*)(F.ws + WS_WOUT), last ? TL : TT, DM, DM}; pg8::StaticOrder S; S.init(g.M, g.N, F.G, F.bid);
        pg8::EpiBf16 E{O, DM}; pg8::gemm_phase<pg8::EpiBf16, pg8::StaticOrder, true, true>(F.lds, g, S, E, F.tid); }
    if constexpr (KIND == 7) {
        EArgs A{}; A.xb_src = XB; A.xb_dst = XB; A.o = O; A.modv_g = mv; A.gidx = 5; A.gmul = 1.0f; A.gpost = ng + 3 * DM;
        A.hdst = H; A.modv_h = mv; A.shidx = 6; A.scidx = 7; A.gpre = ng + 4 * DM; A.nrows = last ? TL : TT; e_phase(F, A); }
    if constexpr (KIND == 10) {
        EArgs A{}; A.xb_src = XB; A.xb_dst = XB; A.out32 = last ? F.out : (float*)nullptr; A.o = O; A.modv_g = mv; A.gidx = 8; A.gmul = 0.5f; A.gpost = ng + 5 * DM;
        if (!last) { A.hdst = H; A.modv_h = mv + 3 * 9216; A.shidx = 0; A.scidx = 1; A.gpre = ng + 6 * DM; }
        A.nrows = last ? TL : TT; e_phase(F, A);
        if (!last) { __syncthreads(); convert_weights(F, 1); } }
}
__global__ void __launch_bounds__(NTHR, 2) mega_one(Args args) {
    extern __shared__ __attribute__((aligned(16))) unsigned char lds[];
    Frame F; F.lds = (LAS unsigned char*)lds; F.tid = threadIdx.x; F.lane = F.tid & 63; F.wave = __builtin_amdgcn_readfirstlane(F.tid >> 6); F.G = gridDim.x; F.bid = blockIdx.x;
    F.out = args.out; F.ws = args.ws;
    volatile LAS unsigned* MISC = (volatile LAS unsigned*)(F.lds + MISC_OFF);
    if (F.tid < 32) MISC[F.tid] = 0u;
    __syncthreads();
    XcdBarrier bar = xcd_barrier_post((unsigned*)(F.ws + WS_CTL) + 4096, MISC + 8);
#define GRID_BAR() xcd_barrier(bar)
    run_phase<100>(F, 0, 0); GRID_BAR();
    run_phase<101>(F, 0, 0); GRID_BAR();
#pragma unroll 1
    for (int li = 0; li < 2; ++li) {
        run_phase<0>(F, li, 0); GRID_BAR();
        run_phase<1>(F, li, 0); GRID_BAR();
        run_phase<2>(F, li, 0); GRID_BAR();
        run_phase<3>(F, li, 0); GRID_BAR();
        run_phase<4>(F, li, 0); GRID_BAR();
        run_phase<5>(F, li, 0); GRID_BAR();
        run_phase<11>(F, li, 0); GRID_BAR();
        run_phase<12>(F, li, 0); GRID_BAR();
        run_phase<6>(F, li, 0); GRID_BAR();
        run_phase<7>(F, li, 0); GRID_BAR();
        run_phase<0>(F, li, 1); GRID_BAR();
        run_phase<1>(F, li, 1); GRID_BAR();
        run_phase<10>(F, li, 0); GRID_BAR();
    }
}

extern "C" void kernel_launch(void* const* d_in, const int* in_sizes, int n_in, void* d_out, int out_size, void* d_ws, size_t ws_size, hipStream_t stream) {
    static int ready = 0;
    if (!ready) {
        if (n_in != 25 || out_size != TL * DM || ws_size < WS_END) { fprintf(stderr, "kernel_launch: unexpected shapes (n_in %d out %d ws %zu)\n", n_in, out_size, ws_size); ready = -1; return; }
        if (hipFuncSetAttribute((const void*)mega_one, hipFuncAttributeMaxDynamicSharedMemorySize, LDS_BYTES) != hipSuccess) { fprintf(stderr, "kernel_launch: hipFuncSetAttribute failed\n"); ready = -1; return; }
        ready = 1;
    }
    if (ready < 0) return;
    if (hipMemsetAsync((char*)d_ws + WS_CTL, 0, 65536, stream) != hipSuccess) { fprintf(stderr, "kernel_launch: memset failed\n"); return; }
    Args a{};
    for (int i = 0; i < 25; ++i) a.in[i] = (const float*)d_in[i];
    a.out = (float*)d_out; a.ws = (unsigned char*)d_ws;
    hipLaunchKernelGGL(mega_one, dim3(256), dim3(NTHR), LDS_BYTES, stream, a);
}
```

```cpp
#include <hip/hip_runtime.h>
#include <cstdio>
#include <cstdint>

namespace pg8 {
#define PG8_LAS __attribute__((address_space(3)))
typedef unsigned short bf16_t;
typedef short bf16x8 __attribute__((ext_vector_type(8)));
typedef float f32x4 __attribute__((ext_vector_type(4)));
typedef unsigned u32x4 __attribute__((ext_vector_type(4)));
constexpr int BM = 256, BK = 64, HALF = 128, HTB = HALF * BK * 2, STAGE_BYTES = 8 * HTB, NXCD = 8, WGM = 8;

__host__ __device__ __forceinline__ int lds_byte(int r, int c) { const int st = (r >> 4) * 2 + (c >> 5), rr = r & 15, cc = c & 31, ob = rr * 64 + cc * 2; return st * 1024 + (ob ^ (((ob >> 9) & 1) << 5)); }
__host__ __device__ __forceinline__ void stage_rc(int b, int& R, int& C) { const int st = b / 1024, sb = b % 1024, swz = sb ^ (((sb >> 9) & 1) << 5); R = (st >> 1) * 16 + swz / 64; C = (st & 1) * 32 + (swz % 64) / 2; }
__host__ __device__ __forceinline__ int perm32(int rho) { const int n = rho >> 4, i = rho & 15; return 8 * (i >> 2) + 4 * n + (i & 3); }

struct Unit { int pm, pn; };
struct Gemm { const bf16_t* A; const bf16_t* Bt; int M, N, K; };

struct StaticOrder {
    int nM, nN, nwg, G, c;
    __host__ __device__ void init(int M, int N, int G_, int c_) { nM = M / BM; nN = N / BM; nwg = nM * nN; G = G_; c = c_; }
    __host__ __device__ bool next(int i, Unit& u) const {
        const long L = (long)i * G + c; if (L >= nwg) return false;
        int wgid = (int)L; { const int q = nwg / NXCD, r = nwg % NXCD, xcd = wgid % NXCD, off = wgid / NXCD; wgid = (xcd < r ? xcd * (q + 1) : r * (q + 1) + (xcd - r) * q) + off; }
        const int nig = WGM * nN, gid = wgid / nig, fm = gid * WGM, gsz = (nM - fm) < WGM ? (nM - fm) : WGM;
        u.pm = fm + ((wgid % nig) % gsz); u.pn = (wgid % nig) / gsz; return true;
    }
    __device__ __forceinline__ void a_ready(const Unit&) const {}
    __device__ __forceinline__ void done(const Unit&) const {}
};

struct UpOrder {
    StaticOrder lat; int G, c, nN; unsigned* cnt;
    __device__ void init(int N, int G_, int c_, unsigned* cnt_) { lat.init(16384, N, G_, c_); G = G_; c = c_; nN = N / BM; cnt = cnt_; }
    __device__ bool next(int i, Unit& u) const {
        const int nctx = 2 * nN, total = nctx + lat.nwg;
        long L;
        if (G != 256) L = (long)i * G + c;
        else if (c >= 248) { if (i >= 3) return false; L = (long)i * G + c; }
        else if (c >= 172 && c < 188 && i == 5) L = (long)(3 + (c - 172) / 8) * G + 248 + (c - 172) % 8;
        else L = (long)i * G + c;
        if (L >= total) return false;
        if (L < nctx) { u.pm = 64 + (int)L / nN; u.pn = (int)L % nN; return true; }
        int wgid = (int)L - nctx; { const int nwg = lat.nwg, q = nwg / NXCD, r = nwg % NXCD, xcd = wgid % NXCD, off = wgid / NXCD; wgid = (xcd < r ? xcd * (q + 1) : r * (q + 1) + (xcd - r) * q) + off; }
        const int nig = WGM * nN, gid = wgid / nig, fm = gid * WGM, gsz = (lat.nM - fm) < WGM ? (lat.nM - fm) : WGM;
        u.pm = fm + ((wgid % nig) % gsz); u.pn = (wgid % nig) / gsz; return true;
    }
    __device__ __forceinline__ void a_ready(const Unit&) const {}
    __device__ __forceinline__ void done(const Unit& u) const {
        if (u.pm >= 64) { asm volatile("s_waitcnt vmcnt(0)" ::: "memory"); __builtin_amdgcn_fence(__ATOMIC_RELEASE, "agent"); asm volatile("s_waitcnt vmcnt(0)" ::: "memory");
            if ((threadIdx.x & 63) == 0) __hip_atomic_fetch_add(cnt, 1u, __ATOMIC_RELAXED, __HIP_MEMORY_SCOPE_AGENT); }
    }
};
struct OneUnit {
    int pm, pn;
    __device__ bool next(int i, Unit& u) const { if (i != 0) return false; u.pm = pm; u.pn = pn; return true; }
    __device__ __forceinline__ void a_ready(const Unit&) const {}
    __device__ __forceinline__ void done(const Unit&) const {}
};

__device__ __forceinline__ unsigned cvt_pk_bf16(float lo, float hi) { unsigned r; asm volatile("v_cvt_pk_bf16_f32 %0, %1, %2" : "=v"(r) : "v"(lo), "v"(hi)); return r; }

struct EpiBf16 {
    static constexpr bool PERM = true, AFTER_DRAIN = false;
    bf16_t* O; int ldc;
    __device__ __forceinline__ void operator()(const f32x4 (&acc)[2][2][4][2], const Unit& u, int wr, int wc, int fr, int fq) const {
        const int row0 = u.pm * BM + wr * 64 + fr; const int col0 = u.pn * BM + wc * 32 + 8 * fq;
#pragma unroll
        for (int ai = 0; ai < 2; ++ai)
#pragma unroll
            for (int m = 0; m < 4; ++m) { bf16_t* rowp = O + (size_t)(row0 + ai * HALF + m * 16) * ldc + col0;
#pragma unroll
                for (int bj = 0; bj < 2; ++bj) { const f32x4 v0 = acc[ai][bj][m][0], v1 = acc[ai][bj][m][1];
                    u32x4 w; w.x = cvt_pk_bf16(v0[0], v0[1]); w.y = cvt_pk_bf16(v0[2], v0[3]); w.z = cvt_pk_bf16(v1[0], v1[1]); w.w = cvt_pk_bf16(v1[2], v1[3]);
                    *(u32x4*)(rowp + bj * HALF) = w; } }
    }
};
struct EpiF32 {
    static constexpr bool PERM = true, AFTER_DRAIN = false;
    float* O; int ldc;
    __device__ __forceinline__ void operator()(const f32x4 (&acc)[2][2][4][2], const Unit& u, int wr, int wc, int fr, int fq) const {
        const int row0 = u.pm * BM + wr * 64 + fr; const int col0 = u.pn * BM + wc * 32 + 8 * fq;
#pragma unroll
        for (int ai = 0; ai < 2; ++ai)
#pragma unroll
            for (int m = 0; m < 4; ++m) { float* rowp = O + (size_t)(row0 + ai * HALF + m * 16) * ldc + col0;
#pragma unroll
                for (int bj = 0; bj < 2; ++bj) { *(f32x4*)(rowp + bj * HALF) = acc[ai][bj][m][0]; *(f32x4*)(rowp + bj * HALF + 4) = acc[ai][bj][m][1]; } }
    }
};
__device__ __forceinline__ float silu_f(float x) { return x * __builtin_amdgcn_rcpf(1.0f + __expf(-x)); }
struct EpiSwiglu {
    static constexpr bool PERM = true, AFTER_DRAIN = false;
    bf16_t* O; int ldc;
    __device__ __forceinline__ void operator()(const f32x4 (&acc)[2][2][4][2], const Unit& u, int wr, int wc, int fr, int fq) const {
        const int row0 = u.pm * BM + wr * 64 + fr; const int col0 = u.pn * HALF + wc * 32 + 8 * fq;
#pragma unroll
        for (int ai = 0; ai < 2; ++ai)
#pragma unroll
            for (int m = 0; m < 4; ++m) { bf16_t* rowp = O + (size_t)(row0 + ai * HALF + m * 16) * ldc + col0;
                const f32x4 g0 = acc[ai][0][m][0], g1 = acc[ai][0][m][1], u0 = acc[ai][1][m][0], u1 = acc[ai][1][m][1];
                u32x4 w; w.x = cvt_pk_bf16(silu_f(g0[0]) * u0[0], silu_f(g0[1]) * u0[1]); w.y = cvt_pk_bf16(silu_f(g0[2]) * u0[2], silu_f(g0[3]) * u0[3]);
                w.z = cvt_pk_bf16(silu_f(g1[0]) * u1[0], silu_f(g1[1]) * u1[1]); w.w = cvt_pk_bf16(silu_f(g1[2]) * u1[2], silu_f(g1[3]) * u1[3]);
                *(u32x4*)rowp = w; }
    }
};

template <class Epi, class Sched, bool ALIGN_EPI = false, bool SP2 = false>
__device__ __forceinline__ void gemm_phase(PG8_LAS unsigned char* lds, const Gemm g, const Sched& S, const Epi& E, const int tid) {
    const int wid = __builtin_amdgcn_readfirstlane(tid >> 6), lane = tid & 63, wr = wid >> 2, wc = wid & 3, fr = lane & 15, fq = lane >> 4;
    const int K = g.K, nt = K / BK;
    unsigned voffA[2], voffB[2];
#pragma unroll
    for (int i = 0; i < 2; ++i) { int R, C; stage_rc(tid * 16 + i * 8192, R, C); const int Rb = Epi::PERM ? ((R & ~31) + perm32(R & 31)) : R;
        voffA[i] = (unsigned)(R * K + C) * 2u; voffB[i] = (unsigned)(Rb * K + C) * 2u; }
    const size_t kstep = (size_t)(BK * 2);
    const size_t hstep = (size_t)HALF * K * 2;
    const size_t tstep = 2 * hstep;
    const unsigned ldsw = (unsigned)wid * 1024u;
    const int aoff = lds_byte(wr * 64 + fr, fq * 8), boff = lds_byte(wc * 32 + fr, fq * 8);
#define PG8_SA(b, h) (((b) * 2 + (h)) * HTB)
#define PG8_SB(b, h) ((4 + (b) * 2 + (h)) * HTB)
#define PG8_STAGE(bufoff, gbase, voff) do { _Pragma("unroll") for (int _i = 0; _i < 2; ++_i) \
        __builtin_amdgcn_global_load_lds((const unsigned*)((const char*)(gbase) + (voff)[_i]), (PG8_LAS unsigned*)(lds + (bufoff) + ldsw + _i * 8192), 16, 0, 0); } while (0)
#define PG8_LDA(dst, b, h) do { _Pragma("unroll") for (int m = 0; m < 4; ++m) _Pragma("unroll") for (int k = 0; k < 2; ++k) dst[m][k] = *(const PG8_LAS bf16x8*)(lds + PG8_SA(b, h) + aoff + m * 2048 + k * 1024); } while (0)
#define PG8_LDB(dst, b, h) do { _Pragma("unroll") for (int n = 0; n < 2; ++n) _Pragma("unroll") for (int k = 0; k < 2; ++k) dst[n][k] = *(const PG8_LAS bf16x8*)(lds + PG8_SB(b, h) + boff + n * 2048 + k * 1024); } while (0)
#define PG8_MMA(ai, bj, At, Bt) do { __builtin_amdgcn_s_setprio(1); _Pragma("unroll") for (int m = 0; m < 4; ++m) _Pragma("unroll") for (int n = 0; n < 2; ++n) _Pragma("unroll") for (int k = 0; k < 2; ++k) \
        acc[ai][bj][m][n] = __builtin_amdgcn_mfma_f32_16x16x32_bf16(Bt[n][k], At[m][k], acc[ai][bj][m][n], 0, 0, 0); __builtin_amdgcn_s_setprio(0); } while (0)
#define PG8_WAIT_V(n) asm volatile("s_waitcnt vmcnt(" #n ")" ::: "memory")
#define PG8_WAIT_L(n) asm volatile("s_waitcnt lgkmcnt(" #n ")" ::: "memory")
#define PG8_BAR __builtin_amdgcn_s_barrier()
#define PG8_SCHED __builtin_amdgcn_sched_barrier(0)
    Unit cur, nxt; int ui = 0;
    if (!S.next(0, cur)) return;
    f32x4 acc[2][2][4][2];
#pragma unroll
    for (int a = 0; a < 2; ++a)
#pragma unroll
        for (int b = 0; b < 2; ++b)
#pragma unroll
            for (int m = 0; m < 4; ++m)
#pragma unroll
                for (int n = 0; n < 2; ++n) acc[a][b][m][n] = (f32x4){0.f, 0.f, 0.f, 0.f};
    bf16x8 At[4][2], B0[2][2], B1[2][2];
    const char* cA = (const char*)g.A + (size_t)cur.pm * tstep; const char* cB = (const char*)g.Bt + (size_t)cur.pn * tstep;
    S.a_ready(cur);
    if constexpr (SP2) {
        PG8_STAGE(PG8_SB(0, 0), cB, voffB); PG8_STAGE(PG8_SB(0, 1), cB + hstep, voffB); PG8_STAGE(PG8_SA(0, 0), cA, voffA); PG8_STAGE(PG8_SA(0, 1), cA + hstep, voffA);
        if (wr == 1) PG8_BAR;
        PG8_WAIT_V(2); PG8_BAR;
        PG8_STAGE(PG8_SB(1, 0), cB + kstep, voffB); PG8_STAGE(PG8_SA(1, 0), cA + kstep, voffA); PG8_STAGE(PG8_SB(1, 1), cB + hstep + kstep, voffB);
        PG8_WAIT_V(6); PG8_BAR;
    } else {
        PG8_STAGE(PG8_SB(0, 0), cB, voffB); PG8_STAGE(PG8_SA(0, 0), cA, voffA); PG8_STAGE(PG8_SB(0, 1), cB + hstep, voffB); PG8_STAGE(PG8_SA(0, 1), cA + hstep, voffA);
        if (wr == 1) PG8_BAR;
        PG8_WAIT_V(4); PG8_BAR;
        PG8_STAGE(PG8_SB(1, 0), cB + kstep, voffB); PG8_STAGE(PG8_SA(1, 0), cA + kstep, voffA); PG8_STAGE(PG8_SB(1, 1), cB + hstep + kstep, voffB);
        PG8_WAIT_V(6); PG8_BAR;
    }
    for (;;) {
        const bool has_next = S.next(ui + 1, nxt);
        const char* nA = has_next ? (const char*)g.A + (size_t)nxt.pm * tstep : cA; const char* nB = has_next ? (const char*)g.Bt + (size_t)nxt.pn * tstep : cB;
        for (int t = 0; t < nt; t += 2) {
            const bool last = (t == nt - 2);
            const char* a1 = cA + (size_t)(t + 1) * kstep;
            const char* a2 = last ? nA : cA + (size_t)(t + 2) * kstep; const char* b2 = last ? nB : cB + (size_t)(t + 2) * kstep;
            const char* a3 = a2 + kstep; const char* b3 = b2 + kstep;
            if (last && has_next) S.a_ready(nxt);
            if constexpr (SP2) {
            PG8_LDB(B0, 0, 0); PG8_LDB(B1, 0, 1); PG8_SCHED; PG8_LDA(At, 0, 0); PG8_STAGE(PG8_SA(1, 1), a1 + hstep, voffA);
            PG8_WAIT_V(8); PG8_WAIT_L(0); PG8_BAR; PG8_MMA(0, 0, At, B0); PG8_MMA(0, 1, At, B1); PG8_BAR; PG8_SCHED;
            PG8_LDA(At, 0, 1); PG8_STAGE(PG8_SB(0, 0), b2, voffB); PG8_STAGE(PG8_SB(0, 1), b2 + hstep, voffB); PG8_STAGE(PG8_SA(0, 0), a2, voffA);
            PG8_WAIT_V(8); PG8_WAIT_L(0); PG8_BAR; PG8_MMA(1, 0, At, B0); PG8_MMA(1, 1, At, B1); PG8_BAR; PG8_SCHED;
            PG8_LDB(B0, 1, 0); PG8_LDB(B1, 1, 1); PG8_SCHED; PG8_LDA(At, 1, 0); PG8_STAGE(PG8_SA(0, 1), a2 + hstep, voffA);
            PG8_WAIT_V(8); PG8_WAIT_L(0); PG8_BAR; PG8_MMA(0, 0, At, B0); PG8_MMA(0, 1, At, B1); PG8_BAR; PG8_SCHED;
            PG8_LDA(At, 1, 1); PG8_STAGE(PG8_SB(1, 0), b3, voffB); PG8_STAGE(PG8_SB(1, 1), b3 + hstep, voffB); PG8_STAGE(PG8_SA(1, 0), a3, voffA);
            PG8_WAIT_V(8); PG8_WAIT_L(0); PG8_BAR; PG8_MMA(1, 0, At, B0); PG8_MMA(1, 1, At, B1); PG8_BAR; PG8_SCHED;
            } else {
            PG8_LDB(B0, 0, 0); PG8_SCHED; PG8_LDA(At, 0, 0); PG8_STAGE(PG8_SA(1, 1), a1 + hstep, voffA);
            PG8_WAIT_L(8); PG8_BAR; PG8_WAIT_L(0); PG8_MMA(0, 0, At, B0); PG8_BAR; PG8_SCHED;
            PG8_LDB(B1, 0, 1); PG8_STAGE(PG8_SB(0, 0), b2, voffB);
            PG8_BAR; PG8_WAIT_L(0); PG8_MMA(0, 1, At, B1); PG8_BAR;
            PG8_LDA(At, 0, 1); PG8_STAGE(PG8_SA(0, 0), a2, voffA);
            PG8_BAR; PG8_WAIT_L(0); PG8_MMA(1, 0, At, B0); PG8_BAR; PG8_SCHED;
            PG8_STAGE(PG8_SB(0, 1), b2 + hstep, voffB);
            PG8_WAIT_V(6); PG8_BAR; PG8_MMA(1, 1, At, B1); PG8_BAR;
            PG8_LDB(B0, 1, 0); PG8_SCHED; PG8_LDA(At, 1, 0); PG8_STAGE(PG8_SA(0, 1), a2 + hstep, voffA);
            PG8_WAIT_L(8); PG8_BAR; PG8_WAIT_L(0); PG8_MMA(0, 0, At, B0); PG8_BAR; PG8_SCHED;
            PG8_LDB(B1, 1, 1); PG8_STAGE(PG8_SB(1, 0), b3, voffB);
            PG8_BAR; PG8_WAIT_L(0); PG8_MMA(0, 1, At, B1); PG8_BAR;
            PG8_LDA(At, 1, 1); PG8_STAGE(PG8_SA(1, 0), a3, voffA);
            PG8_BAR; PG8_WAIT_L(0); PG8_MMA(1, 0, At, B0); PG8_BAR; PG8_SCHED;
            PG8_STAGE(PG8_SB(1, 1), b3 + hstep, voffB);
            PG8_WAIT_V(6); PG8_BAR; PG8_MMA(1, 1, At, B1); PG8_BAR;
            }
        }
        if constexpr (ALIGN_EPI) { if (wr == 0) PG8_BAR; }
        if constexpr (!Epi::AFTER_DRAIN) { E(acc, cur, wr, wc, fr, fq); S.done(cur); }
        if (!has_next) break;
#pragma unroll
        for (int a = 0; a < 2; ++a)
#pragma unroll
            for (int b = 0; b < 2; ++b)
#pragma unroll
                for (int m = 0; m < 4; ++m)
#pragma unroll
                    for (int n = 0; n < 2; ++n) acc[a][b][m][n] = (f32x4){0.f, 0.f, 0.f, 0.f};
        cur = nxt; cA = nA; cB = nB; ++ui;
        if constexpr (ALIGN_EPI) { if (wr == 1) PG8_BAR; }
    }
    PG8_WAIT_V(0);
    if constexpr (!ALIGN_EPI) { if (wr == 0) PG8_BAR; }
    PG8_BAR;
#undef PG8_SA
#undef PG8_SB
#undef PG8_STAGE
#undef PG8_LDA
#undef PG8_LDB
#undef PG8_MMA
#undef PG8_WAIT_V
#undef PG8_WAIT_L
#undef PG8_BAR
#undef PG8_SCHED
}
}

constexpr int NWAVES = 8, NTHR = 512;
constexpr int DM = 1024, SEQ = 8192, NB = 2, CTX = 256, TL = NB * SEQ, TC = NB * CTX, TT = TL + TC;
constexpr int FFN = 2752, FFNP = 2816, NWI = 5632, INW = 2432, INWP = 2560, NMOD = 9;
constexpr int ZF = 0, ZQ = 256, ZK = 640, ZV = 768, ZRR = 896, ZRK = 1280, ZRV = 1664, ZW = 2048, ZA = 2176, ZG = 2304;
constexpr int RW = 384;
constexpr float NORM_EPS = 1e-6f, GN_EPS = 64e-5f;

constexpr size_t MiB = 1u << 20;
constexpr size_t WS_CTL = 0, WS_MOD = 1 * MiB, WS_ROPE = 2 * MiB, WS_XC = 4 * MiB, WS_GC = 6 * MiB;
constexpr size_t WS_WI1 = 8 * MiB, WS_WO1 = 19 * MiB, WS_WIN = 25 * MiB, WS_WOUT = 30 * MiB, WS_WI2 = 32 * MiB, WS_WO2 = 43 * MiB;
constexpr size_t WS_H = 49 * MiB;
constexpr size_t WS_ACT = 82 * MiB;
constexpr size_t WS_O = 173 * MiB;
constexpr size_t WS_YD = WS_O, WS_QR = WS_O + 50 * MiB, WS_KR = WS_O + 62 * MiB;
constexpr size_t WS_W2T = WS_MOD + 256 * 1024, WS_A2T = WS_MOD + 512 * 1024, WS_G2T = WS_MOD + 768 * 1024;
constexpr size_t WS_LW = WS_O, WS_IC = WS_O + 25 * MiB;
constexpr size_t WS_GAM32 = 165 * MiB;
constexpr size_t WS_XB = 239 * MiB;
constexpr size_t OUT_FA = 0;
constexpr size_t OUT_SUM = 16 * MiB;
constexpr size_t WS_END = 272 * MiB;

constexpr size_t WS_FT = 7 * MiB;
constexpr size_t FT_W64C = 0, FT_W64S = 8192, FT_W128C = 16384, FT_W128S = 49152, FT_T64C = 81920, FT_T64S = 90112;
constexpr int LDS_BYTES = 147456;
constexpr int MISC_OFF = 146432;

typedef unsigned short bf16;
typedef float f32x4 __attribute__((ext_vector_type(4)));
typedef unsigned v4u __attribute__((ext_vector_type(4)));
typedef unsigned v2u __attribute__((ext_vector_type(2)));
#define LAS __attribute__((address_space(3)))
#define LDS_WAIT() asm volatile("s_waitcnt lgkmcnt(0)" ::: "memory")

__device__ __forceinline__ unsigned f2bf(float f) { unsigned u = __builtin_bit_cast(unsigned, f); return (u + 0x7fffu + ((u >> 16) & 1u)) >> 16; }
__device__ __forceinline__ unsigned pk2(float lo, float hi) { return f2bf(lo) | (f2bf(hi) << 16); }
__device__ __forceinline__ float bf2f(unsigned short u) { return __builtin_bit_cast(float, (unsigned)u << 16); }
__device__ __forceinline__ float bflo(unsigned u) { return __builtin_bit_cast(float, u << 16); }
__device__ __forceinline__ float bfhi(unsigned u) { return __builtin_bit_cast(float, u & 0xffff0000u); }
__device__ __forceinline__ void unpack8(const v4u w, float (&f)[8]) { f[0] = bflo(w.x); f[1] = bfhi(w.x); f[2] = bflo(w.y); f[3] = bfhi(w.y); f[4] = bflo(w.z); f[5] = bfhi(w.z); f[6] = bflo(w.w); f[7] = bfhi(w.w); }
__device__ __forceinline__ float wave_sum(float v) {
#pragma unroll
    for (int o = 1; o < 64; o <<= 1) v += __shfl_xor(v, o);
    return v;
}
__device__ __forceinline__ float wave_max(float v) {
#pragma unroll
    for (int o = 1; o < 64; o <<= 1) v = fmaxf(v, __shfl_xor(v, o));
    return v;
}

struct Args { const float* in[25]; float* out; unsigned char* ws; int ph_lo, ph_hi; };

struct Frame {
    LAS unsigned char* lds;
    int tid, lane, wave, G, bid;
    float* out; unsigned char* ws;
};
enum { I_X = 0, I_C, I_CTX, I_CCTX, I_MODW, I_MODB, I_NORMG, I_F1WI, I_F1WO, I_WIN, I_WOUT, I_SINK, I_CONV, I_W0, I_W2, I_A0, I_A2, I_G2, I_KK, I_KA, I_RK, I_LNG, I_LNB, I_F2WI, I_F2WO };

__device__ __forceinline__ const float* inp(int i) {
    const __attribute__((address_space(4))) char* p = (const __attribute__((address_space(4))) char*)__builtin_amdgcn_kernarg_segment_ptr();
    asm volatile("" : "+s"(p));
    return *(const float* const __attribute__((address_space(4)))*)(p + 8 * i);
}
__device__ __forceinline__ void cvt_item(const float* W, int ldw, int k0, int sc, bool valid, bf16* WT, int Kd, int n0d, LAS float* scr, int lane) {
#pragma unroll 8
    for (int i = 0; i < 32; ++i) { const int kk = 2 * i + (lane >> 5); scr[kk * 33 + (lane & 31)] = valid ? W[(size_t)(k0 + kk) * ldw + sc + (lane & 31)] : 0.f; }
    LDS_WAIT(); asm volatile("" ::: "memory");
    const int c = lane & 7;
#pragma unroll
    for (int j = 0; j < 4; ++j) { const int n = (lane >> 3) + 8 * j; const LAS float* s = scr + (8 * c) * 33 + n;
        v4u o; o.x = pk2(s[0 * 33], s[1 * 33]); o.y = pk2(s[2 * 33], s[3 * 33]); o.z = pk2(s[4 * 33], s[5 * 33]); o.w = pk2(s[6 * 33], s[7 * 33]);
        *(v4u*)(WT + (size_t)(n0d + n) * Kd + k0 + 8 * c) = o; }
    LDS_WAIT(); asm volatile("" ::: "memory");
}
__device__ __forceinline__ void convert_weights(Frame& F, int li, int set = 0, int bid0 = 0, int nblk = 0) {
    if (nblk == 0) nblk = F.G;
    if (F.bid < bid0 || F.bid >= bid0 + nblk) return;
    LAS float* scr = (LAS float*)(F.lds + F.wave * 16384);
    const int gw = (F.bid - bid0) * NWAVES + F.wave, NGW = nblk * NWAVES;
    constexpr int I_WI = 16 * (NWI / 32), I_WO = (FFNP / 64) * 32, I_IN = 16 * (INWP / 32), I_OUT = 16 * 32;
    constexpr int NITEMS = 2 * I_WI + 2 * I_WO + I_IN + I_OUT;
    for (int it = gw; it < NITEMS; it += NGW) {
        int r = it;
        if (set) { const bool inA = r < I_WI || (r >= 2 * I_WI && r < 2 * I_WI + I_WO) || (r >= 2 * I_WI + 2 * I_WO && r < 2 * I_WI + 2 * I_WO + I_IN); if (inA != (set == 1)) continue; }
        if (r < 2 * I_WI) { const int f = r / I_WI; r -= f * I_WI; const int nblk = NWI / 32, kb = r / nblk, nb = r % nblk;
            const int n0 = 32 * nb, pn = n0 >> 8, i = n0 & 255; const int j = 128 * pn + (i & 127); const bool valid = j < FFN; const int sc = (i < 128) ? j : FFN + j;
            cvt_item((f ? inp(I_F2WI) : inp(I_F1WI)) + (size_t)li * DM * 2 * FFN, 2 * FFN, 64 * kb, sc, valid, (bf16*)(F.ws + (f ? WS_WI2 : WS_WI1)), DM, n0, scr, F.lane); continue; }
        r -= 2 * I_WI;
        if (r < 2 * I_WO) { const int f = r / I_WO; r -= f * I_WO; const int kb = r / 32, nb = r % 32; const bool valid = 64 * kb < FFN;
            cvt_item((f ? inp(I_F2WO) : inp(I_F1WO)) + (size_t)li * FFN * DM, DM, 64 * kb, 32 * nb, valid, (bf16*)(F.ws + (f ? WS_WO2 : WS_WO1)), FFNP, 32 * nb, scr, F.lane); continue; }
        r -= 2 * I_WO;
        if (r < I_IN) { const int nblk = INWP / 32, kb = r / nblk, nb = r % nblk; const bool valid = 32 * nb < INW;
            cvt_item(inp(I_WIN) + (size_t)li * DM * INW, INW, 64 * kb, 32 * nb, valid, (bf16*)(F.ws + WS_WIN), DM, 32 * nb, scr, F.lane); continue; }
        r -= I_IN;
        { const int kb = r / 32, nb = r % 32;
            cvt_item(inp(I_WOUT) + (size_t)li * DM * DM, DM, 64 * kb, 32 * nb, true, (bf16*)(F.ws + WS_WOUT), DM, 32 * nb, scr, F.lane); }
    }
}
__device__ __forceinline__ void mod_gemv(Frame& F) {
    LAS float* sc = (LAS float*)F.lds;
    LAS float* red = sc + 3 * 1024;
    __syncthreads();
    for (int i = F.tid; i < 3 * 1024; i += NTHR) { const int v = i >> 10, k = i & 1023; const float x = v < 2 ? inp(I_C)[v * 1024 + k] : inp(I_CCTX)[k]; sc[i] = x / (1.0f + __expf(-x)); }
    __syncthreads();
    float* modv = (float*)(F.ws + WS_MOD);
    for (int u = F.bid; u < 2 * 72; u += F.G) {
        const int l = u / 72, n0 = (u % 72) * 128;
        const float* w = inp(I_MODW) + (size_t)l * DM * 9216 + n0 + 2 * F.lane;
        float a0 = 0.f, a1 = 0.f, b0 = 0.f, b1 = 0.f, c0 = 0.f, c1 = 0.f;
        const int k0 = F.wave * 128;
#pragma unroll 8
        for (int k = 0; k < 128; ++k) { const float2 wv = *(const float2*)(w + (size_t)(k0 + k) * 9216); const float s0 = sc[k0 + k], s1 = sc[1024 + k0 + k], s2 = sc[2048 + k0 + k];
            a0 += s0 * wv.x; a1 += s0 * wv.y; b0 += s1 * wv.x; b1 += s1 * wv.y; c0 += s2 * wv.x; c1 += s2 * wv.y; }
        LAS float* rw = red + F.wave * 384 + 2 * F.lane;
        rw[0] = a0; rw[1] = a1; rw[128] = b0; rw[129] = b1; rw[256] = c0; rw[257] = c1;
        __syncthreads();
        if (F.tid < 384) { float s = 0.f;
#pragma unroll
            for (int w8 = 0; w8 < 8; ++w8) s += red[w8 * 384 + F.tid];
            const int v = F.tid >> 7, n = n0 + (F.tid & 127);
            modv[(size_t)(l * 3 + v) * 9216 + n] = s + inp(I_MODB)[l * 9216 + n]; }
        __syncthreads();
    }
}
__device__ __forceinline__ void rope_tables(Frame& F) {
    float* ct = (float*)(F.ws + WS_ROPE); float* st = ct + SEQ * 32;
    for (int i = F.bid * NTHR + F.tid; i < SEQ * 32; i += F.G * NTHR) {
        const int t = i >> 5, j = i & 31; const int f = j & 15;
        const float inv = exp2f(-(float)f * (13.287712379549449f / 16.0f));
        const float pos = (float)(j < 16 ? (t >> 6) : (t & 63));
        const float ang = pos * inv;
        const double a = (double)ang; const double k = __builtin_rint(a * 0.15915494309189535); const float r = (float)(a - k * 6.283185307179586);
        ct[i] = __cosf(r); st[i] = __sinf(r);
    }
}

struct EArgs { const float* xl_src; const float* xc_src; const bf16* xb_src; bf16* xb_dst; float* out32; const bf16* o; const float* modv_g; int gidx; float gmul; const float* gpost;
               bf16* hdst; const float* modv_h; int shidx, scidx; const float* gpre; int nrows; };
__device__ __forceinline__ void e_phase(Frame& F, const EArgs& A) {
    const int gw = F.bid * NWAVES + F.wave, NGW = F.G * NWAVES;
    for (int r = gw; r < A.nrows; r += NGW) {
        const int v = r < TL ? (r >> 13) : 2;
        f32x4 x[4];
        if (A.xb_src) { const v2u* xs = (const v2u*)(A.xb_src + (size_t)r * DM);
#pragma unroll
            for (int j = 0; j < 4; ++j) { const v2u w = xs[F.lane + 64 * j]; x[j] = (f32x4){bflo(w.x), bfhi(w.x), bflo(w.y), bfhi(w.y)}; } }
        else { const float* xs = r < TL ? A.xl_src + (size_t)r * DM : A.xc_src + (size_t)(r - TL) * DM;
#pragma unroll
            for (int j = 0; j < 4; ++j) x[j] = ((const f32x4*)xs)[F.lane + 64 * j]; }
        if (A.o) {
            const v2u* orow = (const v2u*)(A.o + (size_t)r * DM); f32x4 ov[4]; float ss = 0.f;
#pragma unroll
            for (int j = 0; j < 4; ++j) { const v2u w = orow[F.lane + 64 * j]; ov[j] = (f32x4){bflo(w.x), bfhi(w.x), bflo(w.y), bfhi(w.y)}; ss += (ov[j].x * ov[j].x + ov[j].y * ov[j].y) + (ov[j].z * ov[j].z + ov[j].w * ov[j].w); }
            const float rstd = 1.0f / sqrtf(wave_sum(ss) * (1.0f / DM) + NORM_EPS) * A.gmul;
            const f32x4* gm = (const f32x4*)(A.modv_g + (size_t)v * 9216 + A.gidx * DM); const f32x4* gp = (const f32x4*)A.gpost;
#pragma unroll
            for (int j = 0; j < 4; ++j) { const f32x4 g = gm[F.lane + 64 * j], p = gp[F.lane + 64 * j]; x[j] = x[j] + g * (ov[j] * rstd * p); }
            if (A.out32) {
#pragma unroll
                for (int j = 0; j < 4; ++j) ((f32x4*)(A.out32 + (size_t)r * DM))[F.lane + 64 * j] = x[j]; }
            else { v2u* xd = (v2u*)(A.xb_dst + (size_t)r * DM);
#pragma unroll
                for (int j = 0; j < 4; ++j) { v2u w; w.x = pk2(x[j].x, x[j].y); w.y = pk2(x[j].z, x[j].w); xd[F.lane + 64 * j] = w; } }
        }
        if (A.hdst) {
            float ss = 0.f;
#pragma unroll
            for (int j = 0; j < 4; ++j) ss += (x[j].x * x[j].x + x[j].y * x[j].y) + (x[j].z * x[j].z + x[j].w * x[j].w);
            const float rstd = 1.0f / sqrtf(wave_sum(ss) * (1.0f / DM) + NORM_EPS);
            const f32x4* sh = (const f32x4*)(A.modv_h + (size_t)v * 9216 + A.shidx * DM); const f32x4* scl = (const f32x4*)(A.modv_h + (size_t)v * 9216 + A.scidx * DM); const f32x4* gp = (const f32x4*)A.gpre;
            v2u* hd = (v2u*)(A.hdst + (size_t)r * DM);
#pragma unroll
            for (int j = 0; j < 4; ++j) { const f32x4 s = sh[F.lane + 64 * j], c = scl[F.lane + 64 * j], p = gp[F.lane + 64 * j]; const f32x4 hv = (x[j] * rstd * p) * (1.0f + c) + s;
                v2u w; w.x = pk2(hv.x, hv.y); w.y = pk2(hv.z, hv.w); hd[F.lane + 64 * j] = w; }
        }
    }
}

__device__ __forceinline__ const bf16* zrow(const Frame& F, int row) { return (const bf16*)(F.ws + WS_ACT) + (size_t)row * INWP; }

__device__ __forceinline__ void rope_all(Frame& F) {
    const float* ct = (const float*)(F.ws + WS_ROPE); const float* st = ct + SEQ * 32;
    bf16* qr = (bf16*)(F.ws + WS_QR); bf16* kr = (bf16*)(F.ws + WS_KR);
    for (int i = F.bid * NTHR + F.tid; i < TL * 32; i += F.G * NTHR) {
        const int o = i & 3, hh = (i >> 2) & 7, tok = i >> 5; const int s = tok & (SEQ - 1);
        const bf16* z = zrow(F, tok) + (hh < 6 ? ZQ + 64 * hh : ZK + 64 * (hh - 6)) + 8 * o;
        float x1[8], x2[8]; unpack8(*(const v4u*)z, x1); unpack8(*(const v4u*)(z + 32), x2);
        const f32x4 c0 = *(const f32x4*)(ct + s * 32 + 8 * o), c1 = *(const f32x4*)(ct + s * 32 + 8 * o + 4), s0 = *(const f32x4*)(st + s * 32 + 8 * o), s1 = *(const f32x4*)(st + s * 32 + 8 * o + 4);
        const float sc = hh < 6 ? 0.125f : 1.0f; float o1[8], o2[8];
#pragma unroll
        for (int e = 0; e < 4; ++e) { o1[e] = (x1[e] * c0[e] - x2[e] * s0[e]) * sc; o2[e] = (x2[e] * c0[e] + x1[e] * s0[e]) * sc; o1[e + 4] = (x1[e + 4] * c1[e] - x2[e + 4] * s1[e]) * sc; o2[e + 4] = (x2[e + 4] * c1[e] + x1[e + 4] * s1[e]) * sc; }
        bf16* d = hh < 6 ? qr + (size_t)tok * 384 + 64 * hh + 8 * o : kr + (size_t)tok * 128 + 64 * (hh - 6) + 8 * o;
        *(v4u*)d = (v4u){pk2(o1[0], o1[1]), pk2(o1[2], o1[3]), pk2(o1[4], o1[5]), pk2(o1[6], o1[7])};
        *(v4u*)(d + 32) = (v4u){pk2(o2[0], o2[1]), pk2(o2[2], o2[3]), pk2(o2[4], o2[5]), pk2(o2[6], o2[7])}; }
}
__device__ __forceinline__ void fourier_ctx1_all(Frame& F) {
    float* gr = (float*)(F.ws + WS_GC); float* gi = gr + TC * 256;
    const bf16* wc = (const bf16*)(F.ws + WS_FT + FT_W64C); const bf16* wsn = (const bf16*)(F.ws + WS_FT + FT_W64S);
    for (int i = F.bid * NTHR + F.tid; i < TC * 256; i += F.G * NTHR) { const int tok = i >> 8, gm = i & 255, g = gm >> 6, m = gm & 63;
        const bf16* z = zrow(F, TL + tok) + ZF + 64 * g; float sr = 0.f, si = 0.f;
#pragma unroll
        for (int c8 = 0; c8 < 8; ++c8) { float x[8], cs[8], sn[8]; unpack8(*(const v4u*)(z + 8 * c8), x); unpack8(*(const v4u*)(wc + m * 64 + 8 * c8), cs); unpack8(*(const v4u*)(wsn + m * 64 + 8 * c8), sn);
#pragma unroll
            for (int e = 0; e < 8; ++e) { sr += x[e] * cs[e]; si -= x[e] * sn[e]; } }
        gr[i] = sr; gi[i] = si; }
}
__device__ __forceinline__ void fourier_ctx2_all(Frame& F) {
    const float* gr = (const float*)(F.ws + WS_GC); const float* gi = gr + TC * 256; bf16* mix = (bf16*)(F.ws + WS_H);
    for (int i = F.bid * NTHR + F.tid; i < TC * 256; i += F.G * NTHR) { const int row = i >> 8, gm = i & 255, b = row >> 8, k = row & 255; float y = 0.f;
#pragma unroll 8
        for (int n = 0; n < 256; ++n) { const float a = (float)((k * n) & 255) * (1.0f / 256.0f); y += gr[(b * 256 + n) * 256 + gm] * __builtin_amdgcn_cosf(a) + gi[(b * 256 + n) * 256 + gm] * __builtin_amdgcn_sinf(a); }
        mix[(size_t)(TL + row) * DM + gm] = (bf16)f2bf(y * 0.0078125f); }
}
typedef short bf16x8 __attribute__((ext_vector_type(8)));
#define MFMA16(a, b, c) __builtin_amdgcn_mfma_f32_16x16x32_bf16(a, b, c, 0, 0, 0)
__device__ __forceinline__ bf16x8 mk8(unsigned a, unsigned b, unsigned c, unsigned d) { const v4u v = {a, b, c, d}; return __builtin_bit_cast(bf16x8, v); }
typedef __bf16 bf16x2_t __attribute__((ext_vector_type(2)));
typedef float f32x2_t __attribute__((ext_vector_type(2)));
__device__ __forceinline__ unsigned cvtpk(float lo, float hi) { const f32x2_t f = {lo, hi}; return __builtin_bit_cast(unsigned, __builtin_convertvector(f, bf16x2_t)); }
constexpr int NSC = 66;
constexpr int IM_AI = 0, IM_RI = 4608, IM_BI = 9216, IM_KI = 13824, IM_BKT = 18432, IM_VT = 28672, IM_GAM = 33792, IMG_BYTES = 34816;
constexpr int L_IMG0 = 0, L_IMG1 = IMG_BYTES, L_PKG = 2 * IMG_BYTES, L_YL = L_PKG + 8192, L_VB = L_YL + 128 * 68 * 4, L_BON = L_VB + 128 * 64 * 2, L_CST = L_BON + 512, L_RW_END = L_CST + 2 * 3072;
static_assert(L_RW_END <= 146432, "rwkv LDS map");
constexpr size_t SUM_SLOT = 24576;

__device__ __forceinline__ void lora_transposes(Frame& F) {
    bf16* w2t = (bf16*)(F.ws + WS_W2T); bf16* a2t = (bf16*)(F.ws + WS_A2T); bf16* g2t = (bf16*)(F.ws + WS_G2T);
    const float* w2 = inp(I_W2); const float* a2 = inp(I_A2); const float* g2 = inp(I_G2);
    for (int i = F.bid * NTHR + F.tid; i < 4 * 384 * 64; i += F.G * NTHR) { const int r = i & 63, col = (i >> 6) % 384, ld = i / (384 * 64);
        w2t[i] = (bf16)f2bf(w2[((size_t)ld * 64 + r) * RW + col]); a2t[i] = (bf16)f2bf(a2[((size_t)ld * 64 + r) * RW + col]); }
    for (int i = F.bid * NTHR + F.tid; i < 2 * 384 * 128; i += F.G * NTHR) { const int r = i & 127, col = (i >> 7) % 384, l = i / (384 * 128);
        g2t[i] = (bf16)f2bf(g2[((size_t)l * 128 + r) * RW + col]); }
}

__device__ __forceinline__ float softplus_fast(float x) { return fmaxf(x, 0.f) + __logf(1.0f + __expf(-fabsf(x))); }
__device__ __forceinline__ float tanh_fast(float x) { return 1.0f - 2.0f * __builtin_amdgcn_rcpf(1.0f + __expf(2.0f * x)); }
template <int CTRL> __device__ __forceinline__ float dpp_f(float v) { return __builtin_bit_cast(float, __builtin_amdgcn_update_dpp(0, __builtin_bit_cast(int, v), CTRL, 0xf, 0xf, true)); }
__device__ __forceinline__ void lora_pass(Frame& F, int li) {
    const int q = F.lane >> 4, c16 = F.lane & 15;
#pragma unroll 1
    for (int dir = 0; dir < 2; ++dir) {
        bf16* LW = (bf16*)(F.ws + WS_LW) + (size_t)dir * TT * RW; bf16* IC = (bf16*)(F.ws + WS_IC) + (size_t)dir * TT * RW;
        const bf16* w2t = (const bf16*)(F.ws + WS_W2T) + (size_t)(li * 2 + dir) * 384 * 64; const bf16* a2t = (const bf16*)(F.ws + WS_A2T) + (size_t)(li * 2 + dir) * 384 * 64;
        bf16x8 aw[3][2], aa[3][2]; f32x4 w0v[3], a0v[3];
#pragma unroll
        for (int cti = 0; cti < 3; ++cti) { const int ct = 3 * F.wave + cti, col = 16 * ct + c16;
#pragma unroll
            for (int k = 0; k < 2; ++k) { aw[cti][k] = *(const bf16x8*)(w2t + (size_t)col * 64 + 32 * k + 8 * q); aa[cti][k] = *(const bf16x8*)(a2t + (size_t)col * 64 + 32 * k + 8 * q); }
            w0v[cti] = *(const f32x4*)(inp(I_W0) + (li * 2 + dir) * RW + 16 * ct + 4 * q); a0v[cti] = *(const f32x4*)(inp(I_A0) + (li * 2 + dir) * RW + 16 * ct + 4 * q); }
#pragma unroll 1
        for (int rt = F.bid; rt < TT / 16; rt += F.G) {
            const bf16* z = zrow(F, 16 * rt + c16);
            bf16x8 bw[2], ba[2];
#pragma unroll
            for (int k = 0; k < 2; ++k) { const v4u zw = *(const v4u*)(z + ZW + 64 * dir + 32 * k + 8 * q); ba[k] = *(const bf16x8*)(z + ZA + 64 * dir + 32 * k + 8 * q);
                bw[k] = mk8(cvtpk(tanh_fast(bflo(zw.x)), tanh_fast(bfhi(zw.x))), cvtpk(tanh_fast(bflo(zw.y)), tanh_fast(bfhi(zw.y))), cvtpk(tanh_fast(bflo(zw.z)), tanh_fast(bfhi(zw.z))), cvtpk(tanh_fast(bflo(zw.w)), tanh_fast(bfhi(zw.w)))); }
#pragma unroll
            for (int cti = 0; cti < 3; ++cti) { const int ct = 3 * F.wave + cti;
                f32x4 dw = {0.f, 0.f, 0.f, 0.f}, da = {0.f, 0.f, 0.f, 0.f};
#pragma unroll
                for (int k = 0; k < 2; ++k) { dw = MFMA16(aw[cti][k], bw[k], dw); da = MFMA16(aa[cti][k], ba[k], da); }
                float lw[4], ic[4];
#pragma unroll
                for (int e = 0; e < 4; ++e) { const float x = w0v[cti][e] + dw[e]; const float wl = -softplus_fast(-x) - 0.5f; lw[e] = -__expf(wl); ic[e] = __builtin_amdgcn_rcpf(1.0f + __expf(-(a0v[cti][e] + da[e]))); }
                if (dir == 0) {
#pragma unroll
                    for (int e = 0; e < 4; ++e) { lw[e] += dpp_f<0x111>(lw[e]); lw[e] += dpp_f<0x112>(lw[e]); lw[e] += dpp_f<0x114>(lw[e]); lw[e] += dpp_f<0x118>(lw[e]); } }
                else {
#pragma unroll
                    for (int e = 0; e < 4; ++e) { lw[e] += dpp_f<0x101>(lw[e]); lw[e] += dpp_f<0x102>(lw[e]); lw[e] += dpp_f<0x104>(lw[e]); lw[e] += dpp_f<0x108>(lw[e]); } }
#pragma unroll
                for (int e = 0; e < 4; ++e) lw[e] = __expf(lw[e]);
                if (c16 == (dir == 0 ? 15 : 0)) *(f32x4*)((float*)(F.ws + WS_GAM32) + ((size_t)dir * (TT / 16) + rt) * RW + 16 * ct + 4 * q) = (f32x4){lw[0], lw[1], lw[2], lw[3]};
                const size_t o = (size_t)(16 * rt + c16) * RW + 16 * ct + 4 * q;
                v2u w; w.x = cvtpk(lw[0], lw[1]); w.y = cvtpk(lw[2], lw[3]); *(v2u*)(LW + o) = w; w.x = cvtpk(ic[0], ic[1]); w.y = cvtpk(ic[2], ic[3]); *(v2u*)(IC + o) = w; }
        }
    }
}
__device__ __forceinline__ void chain_consts_lds(Frame& F, LAS float* cst, int li, int h, int t256) {
    for (int i = t256; i < 12 * 64; i += 256) { const int k = i >> 6, j = i & 63, ch = 64 * h + j; float v;
        if (k == 0) v = inp(I_KK)[li * RW + ch]; else if (k == 1) v = inp(I_KA)[li * RW + ch]; else if (k == 2) v = inp(I_RK)[li * RW + ch];
        else { const int tt = (k - 3) / 3, w = (k - 3) % 3; v = inp(I_CONV)[(size_t)(li * 3 + tt) * (3 * RW) + w * RW + ch]; }
        cst[i] = v; }
}
struct PrepRaw { v4u ecw, icv, epw, zr[3], zk[3], zv[3]; };
__device__ __forceinline__ void prep_load(Frame& F, PrepRaw& R, int dir, int b, int h, int tl, int o, bool isctx, int step0) {
    const int L = isctx ? CTX : SEQ, rbase = isctx ? TL + b * CTX : b * SEQ, ch0 = 64 * h + 8 * o;
    const int s = step0 + tl; const int p = dir ? L - 1 - s : s; const int row = rbase + p, tb = tl & 15;
    { const bf16* LW = (const bf16*)(F.ws + WS_LW) + (size_t)dir * TT * RW + ch0; const bf16* IC = (const bf16*)(F.ws + WS_IC) + (size_t)dir * TT * RW + ch0;
      R.ecw = *(const v4u*)(LW + (size_t)row * RW); R.icv = *(const v4u*)(IC + (size_t)row * RW); R.epw = *(const v4u*)(LW + (size_t)(tb == 0 ? row : (dir ? row + 1 : row - 1)) * RW); }
#pragma unroll
    for (int tt = 0; tt < 3; ++tt) { const int pp = p + tt - 1; const bool ok = pp >= 0 && pp < L; const bf16* z = zrow(F, rbase + (ok ? pp : p)) + ch0;
        const v4u z0 = {0u, 0u, 0u, 0u};
        R.zr[tt] = ok ? *(const v4u*)(z + ZRR) : z0; R.zk[tt] = ok ? *(const v4u*)(z + ZRK) : z0; R.zv[tt] = ok ? *(const v4u*)(z + ZRV) : z0; }
}
__device__ __forceinline__ void prep_compute(Frame& F, const PrepRaw& R, const LAS float* cst, LAS unsigned char* img, int dir, int b, int h, int tl, int o, bool isctx, int step0, LAS unsigned char* lds_vb, LAS float* lds_bon, int pos0_local) {
    const bool BONUS = lds_vb != nullptr;
    const int L = isctx ? CTX : SEQ, rbase = isctx ? TL + b * CTX : b * SEQ, ch0 = 64 * h + 8 * o;
    const int blk = tl >> 4, tb = tl & 15;
    const int s = step0 + tl; const int p = dir ? L - 1 - s : s; const int row = rbase + p;
    const v4u ecw = R.ecw, icv = R.icv, epw = R.epw;
    v4u zr[3], zk[3], zv[3];
#pragma unroll
    for (int tt = 0; tt < 3; ++tt) { zr[tt] = R.zr[tt]; zk[tt] = R.zk[tt]; zv[tt] = R.zv[tt]; }
    float ecf[8], epf[8], ai[8], rv[8], kv[8], vv[8];
    unpack8(ecw, ecf); unpack8(epw, epf); unpack8(icv, ai);
#pragma unroll
    for (int e = 0; e < 8; ++e) { rv[e] = 0.f; kv[e] = 0.f; vv[e] = 0.f; }
#pragma unroll
    for (int tt = 0; tt < 3; ++tt) { float a[8], bq[8], cq[8]; unpack8(zr[tt], a); unpack8(zk[tt], bq); unpack8(zv[tt], cq);
        const LAS f32x4* w0 = (const LAS f32x4*)(cst + (3 + tt * 3 + 0) * 64 + 8 * o); const LAS f32x4* w1 = (const LAS f32x4*)(cst + (3 + tt * 3 + 1) * 64 + 8 * o); const LAS f32x4* w2 = (const LAS f32x4*)(cst + (3 + tt * 3 + 2) * 64 + 8 * o);
        const f32x4 w0a = w0[0], w0b = w0[1], w1a = w1[0], w1b = w1[1], w2a = w2[0], w2b = w2[1];
#pragma unroll
        for (int e = 0; e < 4; ++e) { rv[e] += w0a[e] * a[e]; rv[e + 4] += w0b[e] * a[e + 4]; kv[e] += w1a[e] * bq[e]; kv[e + 4] += w1b[e] * bq[e + 4]; vv[e] += w2a[e] * cq[e]; vv[e + 4] += w2b[e] * cq[e + 4]; } }
    float kkw[8], kaw[8];
    { const LAS f32x4* a = (const LAS f32x4*)(cst + 0 * 64 + 8 * o); const LAS f32x4* bq = (const LAS f32x4*)(cst + 1 * 64 + 8 * o); const f32x4 a0 = a[0], a1 = a[1], b0 = bq[0], b1 = bq[1];
#pragma unroll
      for (int e = 0; e < 4; ++e) { kkw[e] = a0[e]; kkw[e + 4] = a1[e]; kaw[e] = b0[e]; kaw[e + 4] = b1[e]; } }
    float kkr[8], ss = 0.f;
#pragma unroll
    for (int e = 0; e < 8; ++e) { kkr[e] = kv[e] * kkw[e]; ss += kkr[e] * kkr[e]; }
    ss += __shfl_xor(ss, 1); ss += __shfl_xor(ss, 2); ss += __shfl_xor(ss, 4);
    const float rn = 1.0f / sqrtf(fmaxf(ss, 1e-24f));
    float At[8], Rt[8], Bt[8], Kt[8];
#pragma unroll
    for (int e = 0; e < 8; ++e) { const float kk = kkr[e] * rn, kd = kv[e] * (1.0f + (ai[e] - 1.0f) * kaw[e]); const float eprev = tb == 0 ? 1.0f : epf[e]; const float ec = ecf[e], en = 1.0f / ec;
        At[e] = -kk * eprev; Rt[e] = rv[e] * ec; Bt[e] = kk * ai[e] * en; Kt[e] = kd * en; }
    const int P0 = 32 * (o >> 2) + 16 * (o & 1) + 4 * ((o >> 1) & 1);
    LAS bf16* AI = (LAS bf16*)(img + IM_AI) + blk * 1152 + tb * 72 + P0, *RI = (LAS bf16*)(img + IM_RI) + blk * 1152 + tb * 72 + P0, *BI = (LAS bf16*)(img + IM_BI) + blk * 1152 + tb * 72 + P0, *KI = (LAS bf16*)(img + IM_KI) + blk * 1152 + tb * 72 + P0;
    unsigned bp[4], kp[4];
#pragma unroll
    for (int e = 0; e < 4; ++e) { bp[e] = cvtpk(Bt[2 * e], Bt[2 * e + 1]); kp[e] = cvtpk(Kt[2 * e], Kt[2 * e + 1]); }
    *(LAS v2u*)AI = (v2u){cvtpk(At[0], At[1]), cvtpk(At[2], At[3])}; *(LAS v2u*)(AI + 8) = (v2u){cvtpk(At[4], At[5]), cvtpk(At[6], At[7])};
    *(LAS v2u*)RI = (v2u){cvtpk(Rt[0], Rt[1]), cvtpk(Rt[2], Rt[3])}; *(LAS v2u*)(RI + 8) = (v2u){cvtpk(Rt[4], Rt[5]), cvtpk(Rt[6], Rt[7])};
    *(LAS v2u*)BI = (v2u){bp[0], bp[1]}; *(LAS v2u*)(BI + 8) = (v2u){bp[2], bp[3]};
    *(LAS v2u*)KI = (v2u){kp[0], kp[1]}; *(LAS v2u*)(KI + 8) = (v2u){kp[2], kp[3]};
    LAS bf16* BKT = (LAS bf16*)(img + IM_BKT) + blk * 2560 + (8 * o) * 40 + (tb >> 2) * 8 + (tb & 3); LAS bf16* VT = (LAS bf16*)(img + IM_VT) + blk * 1280 + (8 * o) * 20 + tb;
    const unsigned vp[4] = {cvtpk(vv[0], vv[1]), cvtpk(vv[2], vv[3]), cvtpk(vv[4], vv[5]), cvtpk(vv[6], vv[7])};
#pragma unroll
    for (int e = 0; e < 8; ++e) { const unsigned bb = bp[e >> 1], kq = kp[e >> 1], vq = vp[e >> 1];
        BKT[e * 40] = (bf16)((e & 1) ? (bb >> 16) : (bb & 0xffff)); BKT[e * 40 + 4] = (bf16)((e & 1) ? (kq >> 16) : (kq & 0xffff)); VT[e * 20] = (bf16)((e & 1) ? (vq >> 16) : (vq & 0xffff)); }
    if (tb == 15) { const f32x4* gs = (const f32x4*)((const float*)(F.ws + WS_GAM32) + ((size_t)dir * (TT / 16) + (row >> 4)) * RW + ch0); LAS f32x4* G = (LAS f32x4*)((LAS float*)(img + IM_GAM) + blk * 64 + 8 * o); G[0] = gs[0]; G[1] = gs[1]; }
    if (BONUS) { float bs = 0.f; const LAS f32x4* rk = (const LAS f32x4*)(cst + 2 * 64 + 8 * o); const f32x4 r0 = rk[0], r1 = rk[1];
#pragma unroll
        for (int e = 0; e < 4; ++e) bs += rv[e] * kv[e] * r0[e] + rv[e + 4] * kv[e + 4] * r1[e];
        bs += __shfl_xor(bs, 1); bs += __shfl_xor(bs, 2); bs += __shfl_xor(bs, 4);
        const int pl = dir ? pos0_local - tl : pos0_local + tl;
        *(LAS v4u*)(lds_vb + (pl * 64 + 8 * o) * 2) = (v4u){vp[0], vp[1], vp[2], vp[3]}; if (o == 0) lds_bon[pl] = bs; }
}
template <bool WANT_Y>
__device__ __forceinline__ void block_package(LAS unsigned char* img, int blk, LAS unsigned* pkg, int lane) {
    const int q = lane >> 4, c = lane & 15;
    f32x4 mab = {0.f, 0.f, 0.f, 0.f}, mak = mab, mbr = mab, mkr = mab;
#pragma unroll
    for (int k = 0; k < 2; ++k) { const int o = blk * 2304 + c * 144 + k * 64 + q * 16;
        const bf16x8 bi = *(const LAS bf16x8*)(img + IM_BI + o), ki = *(const LAS bf16x8*)(img + IM_KI + o), ai = *(const LAS bf16x8*)(img + IM_AI + o);
        mab = MFMA16(bi, ai, mab); mak = MFMA16(ki, ai, mak);
        if constexpr (WANT_Y) { const bf16x8 ri = *(const LAS bf16x8*)(img + IM_RI + o); mbr = MFMA16(bi, ri, mbr); mkr = MFMA16(ki, ri, mkr); } }
#pragma unroll
    for (int e = 0; e < 4; ++e) { const int s = 4 * q + e; if (!(s < c)) { mab[e] = 0.f; mak[e] = 0.f; } if (!(s <= c)) { mbr[e] = 0.f; mkr[e] = 0.f; } }
    f32x4 mabT = {0.f, 0.f, 0.f, 0.f};
#pragma unroll
    for (int k = 0; k < 2; ++k) { const int o = blk * 2304 + c * 144 + k * 64 + q * 16; mabT = MFMA16(*(const LAS bf16x8*)(img + IM_AI + o), *(const LAS bf16x8*)(img + IM_BI + o), mabT); }
#pragma unroll
    for (int e = 0; e < 4; ++e) if (!(c < 4 * q + e)) mabT[e] = 0.f;
    const f32x4 z4 = {0.f, 0.f, 0.f, 0.f};
#define OPND(x) mk8(cvtpk((x)[0], (x)[1]), cvtpk((x)[2], (x)[3]), 0u, 0u)
    const bf16x8 oM = OPND(mab), oMT = OPND(mabT);
    const f32x4 m2 = MFMA16(oMT, oM, z4), m2T = MFMA16(oM, oMT, z4);
    const bf16x8 oM2 = OPND(m2), oM2T = OPND(m2T);
    const f32x4 m4 = MFMA16(oM2T, oM2, z4), m4T = MFMA16(oM2, oM2T, z4);
    const f32x4 m8T = MFMA16(OPND(m4), OPND(m4T), z4);
    f32x4 nn = m2;
#pragma unroll
    for (int e = 0; e < 4; ++e) nn[e] += (4 * q + e == c) ? 1.0f : 0.0f;
    nn = MFMA16(oMT, OPND(nn), nn);
    nn = MFMA16(OPND(m4T), OPND(nn), nn);
    nn = MFMA16(OPND(m8T), OPND(nn), nn);
#undef OPND
    pkg[0 * 64 + lane] = cvtpk(nn[0], nn[1]); pkg[1 * 64 + lane] = cvtpk(nn[2], nn[3]);
    pkg[2 * 64 + lane] = cvtpk(mak[0], mak[1]); pkg[3 * 64 + lane] = cvtpk(mak[2], mak[3]);
    if constexpr (WANT_Y) { pkg[4 * 64 + lane] = cvtpk(mbr[0], mbr[1]); pkg[5 * 64 + lane] = cvtpk(mbr[2], mbr[3]); pkg[6 * 64 + lane] = cvtpk(mkr[0], mkr[1]); pkg[7 * 64 + lane] = cvtpk(mkr[2], mkr[3]); }
}
template <bool WANT_Y, bool HAS_V>
__device__ __forceinline__ f32x4 block_scan(LAS unsigned char* img, int blk, const LAS unsigned* pkg, f32x4 (&S)[4], int wq, int lane) {
    const int q = lane >> 4, c = lane & 15;
    bf16x8 Sb[2];
#pragma unroll
    for (int k = 0; k < 2; ++k) Sb[k] = mk8(cvtpk(S[2 * k][0], S[2 * k][1]), cvtpk(S[2 * k][2], S[2 * k][3]), cvtpk(S[2 * k + 1][0], S[2 * k + 1][1]), cvtpk(S[2 * k + 1][2], S[2 * k + 1][3]));
    v2u vpk = {0u, 0u};
    if constexpr (HAS_V) vpk = *(const LAS v2u*)(img + IM_VT + blk * 2560 + (c + 16 * wq) * 40 + q * 8);
    const int ao = blk * 2304 + c * 144 + q * 16;
    f32x4 rhs = {0.f, 0.f, 0.f, 0.f};
    rhs = MFMA16(*(const LAS bf16x8*)(img + IM_AI + ao), Sb[0], rhs); rhs = MFMA16(*(const LAS bf16x8*)(img + IM_AI + ao + 64), Sb[1], rhs);
    if constexpr (HAS_V) rhs = MFMA16(mk8(0u, 0u, pkg[2 * 64 + lane], pkg[3 * 64 + lane]), mk8(0u, 0u, vpk.x, vpk.y), rhs);
    f32x4 u = {0.f, 0.f, 0.f, 0.f};
    u = MFMA16(mk8(pkg[0 * 64 + lane], pkg[1 * 64 + lane], 0u, 0u), mk8(cvtpk(rhs[0], rhs[1]), cvtpk(rhs[2], rhs[3]), 0u, 0u), u);
    const bf16x8 UV = mk8(cvtpk(u[0], u[1]), cvtpk(u[2], u[3]), vpk.x, vpk.y);
    f32x4 y = {0.f, 0.f, 0.f, 0.f};
    if constexpr (WANT_Y) { y = MFMA16(*(const LAS bf16x8*)(img + IM_RI + ao), Sb[0], y); y = MFMA16(*(const LAS bf16x8*)(img + IM_RI + ao + 64), Sb[1], y);
        y = MFMA16(mk8(pkg[4 * 64 + lane], pkg[5 * 64 + lane], pkg[6 * 64 + lane], pkg[7 * 64 + lane]), UV, y); }
#pragma unroll
    for (int T = 0; T < 4; ++T) { const bf16x8 bkt = *(const LAS bf16x8*)(img + IM_BKT + blk * 5120 + (16 * T + c) * 80 + q * 16);
        S[T] = MFMA16(bkt, UV, S[T]); const f32x4 g = *(const LAS f32x4*)(img + IM_GAM + blk * 256 + (16 * T + 4 * q) * 4); S[T] = S[T] * g; }
    return y;
}
__device__ __forceinline__ unsigned char* sum_slot(Frame& F, int chain, int sc) { return (unsigned char*)F.out + OUT_SUM + (size_t)(chain * NSC + sc) * SUM_SLOT; }

__device__ __forceinline__ void rwkv_pass1_pair(Frame& F, int li, int pair) {
    const int g = F.wave >> 2, wq = F.wave & 3, u = 2 * pair + g;
    const int chain = u / (NSC - 1), sc = u % (NSC - 1);
    const int dir = chain / 12, b = (chain / 6) & 1, h = chain % 6;
    const bool isctx = sc < 2; const int scl = isctx ? sc : sc - 2;
    LAS unsigned char* img = F.lds + (g ? L_IMG1 : L_IMG0); LAS unsigned* pkg = (LAS unsigned*)(F.lds + L_PKG) + g * 1024;
    LAS float* cst = (LAS float*)(F.lds + L_CST) + g * 768;
    __syncthreads();
    chain_consts_lds(F, cst, li, h, F.tid & 255);
    const int q = F.lane >> 4, c = F.lane & 15;
    f32x4 SB[4], SA[4];
#pragma unroll
    for (int T = 0; T < 4; ++T)
#pragma unroll
        for (int e = 0; e < 4; ++e) { SB[T][e] = 0.0f; SA[T][e] = (16 * T + 4 * q + e == c + 16 * wq) ? 1.0f : 0.0f; }
    PrepRaw R;
    prep_load(F, R, dir, b, h, 8 * wq + (F.lane >> 3), F.lane & 7, isctx, 128 * scl);
#pragma unroll 1
    for (int rd = 0; rd < 4; ++rd) {
        __syncthreads();
        prep_compute(F, R, cst, img, dir, b, h, 8 * wq + (F.lane >> 3), F.lane & 7, isctx, 128 * scl + 32 * rd, nullptr, nullptr, 0);
        __syncthreads();
        if (rd < 3) prep_load(F, R, dir, b, h, 8 * wq + (F.lane >> 3), F.lane & 7, isctx, 128 * scl + 32 * (rd + 1));
        if (wq < 2) block_package<false>(img, wq, pkg + wq * 512, F.lane);
        __syncthreads();
#pragma unroll
        for (int blk = 0; blk < 2; ++blk) { block_scan<false, true>(img, blk, pkg + blk * 512, SB, wq, F.lane); block_scan<false, false>(img, blk, pkg + blk * 512, SA, wq, F.lane); }
    }
    unsigned char* slot = sum_slot(F, chain, sc);
    { f32x4* braw = (f32x4*)slot;
#pragma unroll
      for (int T = 0; T < 4; ++T) braw[(wq * 4 + T) * 64 + F.lane] = SB[T]; }
    { bf16* aim = (bf16*)(slot + 16384); const int kap = wq >> 1, e = (F.lane & 3) + 4 * (wq & 1), qc = c >> 2;
#pragma unroll
      for (int T = 0; T < 4; ++T)
#pragma unroll
          for (int r = 0; r < 4; ++r) { const int lc = (4 * q + r) + 16 * qc; aim[((T * 2 + kap) * 64 + lc) * 8 + e] = (bf16)f2bf(SA[T][r]); } }
}
struct P2Buf { f32x4 Bc[4]; bf16x8 af[4][2]; };
__device__ __forceinline__ void p2_load(Frame& F, P2Buf& X, int chain, int sc, int wq) {
    unsigned char* slot = sum_slot(F, chain, sc); const f32x4* braw = (const f32x4*)slot; const bf16* aim = (const bf16*)(slot + 16384);
#pragma unroll
    for (int T = 0; T < 4; ++T) { X.Bc[T] = braw[(wq * 4 + T) * 64 + F.lane];
#pragma unroll
        for (int k = 0; k < 2; ++k) X.af[T][k] = *(const bf16x8*)(aim + ((T * 2 + k) * 64 + F.lane) * 8); }
}
__device__ __forceinline__ void p2_step(Frame& F, const P2Buf& X, f32x4 (&S)[4], int chain, int sc, int wq) {
    f32x4* braw = (f32x4*)sum_slot(F, chain, sc);
    bf16x8 Sb[2];
#pragma unroll
    for (int k = 0; k < 2; ++k) Sb[k] = mk8(cvtpk(S[2 * k][0], S[2 * k][1]), cvtpk(S[2 * k][2], S[2 * k][3]), cvtpk(S[2 * k + 1][0], S[2 * k + 1][1]), cvtpk(S[2 * k + 1][2], S[2 * k + 1][3]));
#pragma unroll
    for (int T = 0; T < 4; ++T) { braw[(wq * 4 + T) * 64 + F.lane] = S[T]; const f32x4 a = MFMA16(X.af[T][0], Sb[0], X.Bc[T]); S[T] = MFMA16(X.af[T][1], Sb[1], a); }
}
__device__ __forceinline__ void rwkv_pass2_chain(Frame& F, int chain) {
    if (F.wave >= 4) return;
    const int wq = F.wave; constexpr int NS = NSC - 1;
    f32x4 S[4];
#pragma unroll
    for (int T = 0; T < 4; ++T) S[T] = (f32x4){0.f, 0.f, 0.f, 0.f};
    P2Buf X0, X1, X2;
    p2_load(F, X0, chain, 0, wq); p2_load(F, X1, chain, 1, wq); p2_load(F, X2, chain, 2, wq);
#pragma unroll 1
    for (int sc = 0; sc < NS; sc += 3) {
        p2_step(F, X0, S, chain, sc, wq); if (sc + 3 < NS) p2_load(F, X0, chain, sc + 3, wq);
        if (sc + 1 < NS) { p2_step(F, X1, S, chain, sc + 1, wq); if (sc + 4 < NS) p2_load(F, X1, chain, sc + 4, wq); }
        if (sc + 2 < NS) { p2_step(F, X2, S, chain, sc + 2, wq); if (sc + 5 < NS) p2_load(F, X2, chain, sc + 5, wq); }
    }
    { f32x4* braw = (f32x4*)sum_slot(F, chain, NSC - 1);
#pragma unroll
      for (int T = 0; T < 4; ++T) braw[(wq * 4 + T) * 64 + F.lane] = S[T]; }
}
__device__ __forceinline__ void rwkv_pass3_unit(Frame& F, int li, int u) {
    const int pc = u % NSC, bh = u / NSC, b = bh / 6, h = bh % 6;
    const bool isctx = pc < 2; const int pcl = isctx ? pc : pc - 2, nsc = isctx ? 2 : 64;
    const int dir = F.wave >> 2, wq = F.wave & 3, q = F.lane >> 4, c = F.lane & 15;
    const int sc = dir == 0 ? pc : (isctx ? 1 - pcl : 2 + 63 - pcl);
    const int scl = dir == 0 ? pcl : nsc - 1 - pcl;
    const int chain = dir * 12 + b * 6 + h;
    LAS unsigned char* img = F.lds + (dir ? L_IMG1 : L_IMG0); LAS unsigned* pkg = (LAS unsigned*)(F.lds + L_PKG) + dir * 1024;
    LAS float* YL = (LAS float*)(F.lds + L_YL); LAS unsigned char* VB = F.lds + L_VB; LAS float* BON = (LAS float*)(F.lds + L_BON);
    LAS float* cst = (LAS float*)(F.lds + L_CST);
    __syncthreads();
    if (F.tid < 256) chain_consts_lds(F, cst, li, h, F.tid);
    f32x4 S[4];
    { const f32x4* braw = (const f32x4*)sum_slot(F, chain, sc);
#pragma unroll
      for (int T = 0; T < 4; ++T) S[T] = braw[(wq * 4 + T) * 64 + F.lane]; }
    __syncthreads();
    for (int i = F.tid; i < 128 * 68; i += NTHR) YL[i] = 0.f;
    PrepRaw R;
    prep_load(F, R, dir, b, h, 8 * wq + (F.lane >> 3), F.lane & 7, isctx, 128 * scl);
#pragma unroll 1
    for (int rd = 0; rd < 4; ++rd) {
        __syncthreads();
        prep_compute(F, R, cst, img, dir, b, h, 8 * wq + (F.lane >> 3), F.lane & 7, isctx, 128 * scl + 32 * rd, dir == 0 ? VB : (LAS unsigned char*)nullptr, BON, 32 * rd);
        __syncthreads();
        if (rd < 3) prep_load(F, R, dir, b, h, 8 * wq + (F.lane >> 3), F.lane & 7, isctx, 128 * scl + 32 * (rd + 1));
        if (wq < 2) block_package<true>(img, wq, pkg + wq * 512, F.lane);
        __syncthreads();
#pragma unroll
        for (int blk = 0; blk < 2; ++blk) { const f32x4 y = block_scan<true, true>(img, blk, pkg + blk * 512, S, wq, F.lane);
#pragma unroll
            for (int e = 0; e < 4; ++e) { const int t = 32 * rd + 16 * blk + 4 * q + e; const int pl = dir ? 127 - t : t; YL[pl * 68 + c + 16 * wq] += y[e]; } }
    }
    __syncthreads();
    const int wv = F.wave; const int rbase = (isctx ? TL + b * CTX : b * SEQ) + 128 * pcl;
    const bf16* g2t = (const bf16*)(F.ws + WS_G2T) + (size_t)li * 384 * 128;
    f32x4 gate[4];
#pragma unroll
    for (int nt = 0; nt < 4; ++nt) gate[nt] = (f32x4){0.f, 0.f, 0.f, 0.f};
#pragma unroll
    for (int k = 0; k < 4; ++k) { const v4u zg = *(const v4u*)(zrow(F, rbase + 16 * wv + c) + ZG + 32 * k + 8 * q);
#define SG(x) (1.0f / (1.0f + __expf(-(x))))
        const bf16x8 a = mk8(pk2(SG(bflo(zg.x)), SG(bfhi(zg.x))), pk2(SG(bflo(zg.y)), SG(bfhi(zg.y))), pk2(SG(bflo(zg.z)), SG(bfhi(zg.z))), pk2(SG(bflo(zg.w)), SG(bfhi(zg.w))));
#undef SG
#pragma unroll
        for (int nt = 0; nt < 4; ++nt) { const bf16x8 bb = *(const bf16x8*)(g2t + (size_t)(64 * h + 16 * nt + c) * 128 + 32 * k + 8 * q); gate[nt] = MFMA16(a, bb, gate[nt]); } }
    bf16* mix = (bf16*)(F.ws + WS_H);
    float lg[4], lb[4];
#pragma unroll
    for (int nt = 0; nt < 4; ++nt) { lg[nt] = inp(I_LNG)[li * RW + 64 * h + 16 * nt + c]; lb[nt] = inp(I_LNB)[li * RW + 64 * h + 16 * nt + c]; }
#pragma unroll
    for (int e = 0; e < 4; ++e) { const int tl = 16 * wv + 4 * q + e;
        float yv[4], s = 0.f;
#pragma unroll
        for (int nt = 0; nt < 4; ++nt) { yv[nt] = YL[tl * 68 + 16 * nt + c]; s += yv[nt]; }
        s += __shfl_xor(s, 1); s += __shfl_xor(s, 2); s += __shfl_xor(s, 4); s += __shfl_xor(s, 8);
        const float mu = s * (1.0f / 64.0f); float v2 = 0.f;
#pragma unroll
        for (int nt = 0; nt < 4; ++nt) { yv[nt] -= mu; v2 += yv[nt] * yv[nt]; }
        v2 += __shfl_xor(v2, 1); v2 += __shfl_xor(v2, 2); v2 += __shfl_xor(v2, 4); v2 += __shfl_xor(v2, 8);
        const float rs = 1.0f / sqrtf(v2 * (1.0f / 64.0f) + GN_EPS); const float bon = BON[tl];
#pragma unroll
        for (int nt = 0; nt < 4; ++nt) { const float vv = bf2f(((const LAS bf16*)VB)[tl * 64 + 16 * nt + c]);
            const float o = (yv[nt] * rs * lg[nt] + lb[nt] + bon * vv) * gate[nt][e];
            mix[(size_t)(rbase + tl) * DM + 640 + 64 * h + 16 * nt + c] = (bf16)f2bf(o); } }
}

constexpr int AT_KROW = 144;
__device__ __forceinline__ void attn_unit(Frame& F, int li, int u) {
    const bool cq = u >= 256;
    int b, kvh, qb;
    if (!cq) { b = u >> 7; kvh = (u >> 6) & 1; qb = u & 63; } else { const int uu = u - 256; b = uu >> 2; kvh = (uu >> 1) & 1; qb = uu & 1; }
    const int c = F.lane & 15, q = F.lane >> 4, tb = F.wave;
    const bf16* qr = (const bf16*)(F.ws + WS_QR); const bf16* kr = (const bf16*)(F.ws + WS_KR); bf16* mix = (bf16*)(F.ws + WS_H);
    const int qrow = (cq ? TL + b * CTX : b * SEQ) + 128 * qb + 16 * tb + c;
    const int qpos = 128 * qb + 16 * tb + c;
    bf16x8 Q[3][2];
#pragma unroll
    for (int hh = 0; hh < 3; ++hh)
#pragma unroll
        for (int k = 0; k < 2; ++k) {
            if (!cq) Q[hh][k] = *(const bf16x8*)(qr + (size_t)qrow * 384 + 64 * (3 * kvh + hh) + 32 * k + 8 * q);
            else { const v4u w = *(const v4u*)(zrow(F, qrow) + ZQ + 64 * (3 * kvh + hh) + 32 * k + 8 * q);
                Q[hh][k] = mk8(pk2(0.125f * bflo(w.x), 0.125f * bfhi(w.x)), pk2(0.125f * bflo(w.y), 0.125f * bfhi(w.y)), pk2(0.125f * bflo(w.z), 0.125f * bfhi(w.z)), pk2(0.125f * bflo(w.w), 0.125f * bfhi(w.w))); } }
    float m[3], l[3]; f32x4 O[3][4];
#pragma unroll
    for (int hh = 0; hh < 3; ++hh) { m[hh] = inp(I_SINK)[li * 6 + 3 * kvh + hh]; l[hh] = q == 0 ? 1.0f : 0.0f;
#pragma unroll
        for (int dt = 0; dt < 4; ++dt) O[hh][dt] = (f32x4){0.f, 0.f, 0.f, 0.f}; }
    LAS unsigned char* KI = F.lds;
#pragma unroll 1
    for (int stage = cq ? 1 : 0; stage < 2; ++stage) {
        const int nkeys = stage == 0 ? 384 : 256; const int vstride = (nkeys + 8) * 2;
        LAS unsigned char* VTI = F.lds + 384 * AT_KROW;
        const int kpos0 = 128 * (qb - 1);
        __syncthreads();
        for (int pc = F.tid; pc < nkeys * 8; pc += NTHR) { const int key = pc >> 3, d8 = pc & 7;
            const bf16* ksrc; const bf16* vsrc;
            if (stage == 0) { int kp = kpos0 + key; kp = kp < 0 ? 0 : (kp >= SEQ ? SEQ - 1 : kp); ksrc = kr + (size_t)(b * SEQ + kp) * 128 + 64 * kvh; vsrc = zrow(F, b * SEQ + kp) + ZV + 64 * kvh; }
            else { const bf16* z = zrow(F, TL + b * CTX + key); ksrc = z + ZK + 64 * kvh; vsrc = z + ZV + 64 * kvh; }
            const v4u kv = *(const v4u*)(ksrc + 8 * d8); const v4u vv = *(const v4u*)(vsrc + 8 * d8);
            *(LAS v4u*)(KI + key * AT_KROW + d8 * 16) = kv;
            const int kl = key & 31; const int col = (key & ~31) | (((kl & 15) >> 2) << 3) | ((kl >> 4) << 2) | (kl & 3);
            LAS bf16* vt = (LAS bf16*)(VTI + (8 * d8) * vstride) + col;
            vt[0] = (bf16)(vv.x & 0xffff); *(LAS bf16*)((LAS unsigned char*)vt + vstride) = (bf16)(vv.x >> 16);
            *(LAS bf16*)((LAS unsigned char*)vt + 2 * vstride) = (bf16)(vv.y & 0xffff); *(LAS bf16*)((LAS unsigned char*)vt + 3 * vstride) = (bf16)(vv.y >> 16);
            *(LAS bf16*)((LAS unsigned char*)vt + 4 * vstride) = (bf16)(vv.z & 0xffff); *(LAS bf16*)((LAS unsigned char*)vt + 5 * vstride) = (bf16)(vv.z >> 16);
            *(LAS bf16*)((LAS unsigned char*)vt + 6 * vstride) = (bf16)(vv.w & 0xffff); *(LAS bf16*)((LAS unsigned char*)vt + 7 * vstride) = (bf16)(vv.w >> 16); }
        __syncthreads();
        const int npair = nkeys / 32;
        const int Q0 = 128 * qb + 16 * tb;
#pragma unroll 1
        for (int kp = 0; kp < npair; ++kp) {
            const int kb = kpos0 + 32 * kp;
            if (stage == 0 && (kb + 31 < Q0 - 128 || kb > Q0 + 143 || kb + 31 < 0 || kb >= SEQ)) continue;
            bf16x8 K[2][2], V[4];
#pragma unroll
            for (int t = 0; t < 2; ++t)
#pragma unroll
                for (int k = 0; k < 2; ++k) K[t][k] = *(const LAS bf16x8*)(KI + (32 * kp + 16 * t + c) * AT_KROW + k * 64 + q * 16);
#pragma unroll
            for (int dt = 0; dt < 4; ++dt) V[dt] = *(const LAS bf16x8*)(VTI + (16 * dt + c) * vstride + kp * 64 + q * 16);
            bool ok0[4], ok1[4];
#pragma unroll
            for (int e = 0; e < 4; ++e) { const int k0 = kb + 4 * q + e, k1 = k0 + 16;
                ok0[e] = stage == 1 || (k0 >= 0 && k0 < SEQ && k0 >= qpos - 128 && k0 <= qpos + 128);
                ok1[e] = stage == 1 || (k1 >= 0 && k1 < SEQ && k1 >= qpos - 128 && k1 <= qpos + 128); }
#pragma unroll
            for (int hh = 0; hh < 3; ++hh) {
                f32x4 s0 = {0.f, 0.f, 0.f, 0.f}, s1 = {0.f, 0.f, 0.f, 0.f};
                s0 = MFMA16(K[0][0], Q[hh][0], s0); s0 = MFMA16(K[0][1], Q[hh][1], s0);
                s1 = MFMA16(K[1][0], Q[hh][0], s1); s1 = MFMA16(K[1][1], Q[hh][1], s1);
                float mx = -INFINITY;
#pragma unroll
                for (int e = 0; e < 4; ++e) { s0[e] = ok0[e] ? s0[e] : -INFINITY; s1[e] = ok1[e] ? s1[e] : -INFINITY; mx = fmaxf(mx, fmaxf(s0[e], s1[e])); }
                mx = fmaxf(mx, __shfl_xor(mx, 16)); mx = fmaxf(mx, __shfl_xor(mx, 32));
                const float mn = fmaxf(m[hh], mx); const float alpha = __expf(m[hh] - mn); m[hh] = mn;
                float ps = 0.f;
#pragma unroll
                for (int e = 0; e < 4; ++e) { s0[e] = __expf(s0[e] - mn); s1[e] = __expf(s1[e] - mn); ps += s0[e] + s1[e]; }
                l[hh] = l[hh] * alpha + ps;
                const bf16x8 P = mk8(cvtpk(s0[0], s0[1]), cvtpk(s0[2], s0[3]), cvtpk(s1[0], s1[1]), cvtpk(s1[2], s1[3]));
#pragma unroll
                for (int dt = 0; dt < 4; ++dt) { O[hh][dt] = O[hh][dt] * alpha; O[hh][dt] = MFMA16(V[dt], P, O[hh][dt]); }
            }
        }
    }
#pragma unroll
    for (int hh = 0; hh < 3; ++hh) { float lt = l[hh]; lt += __shfl_xor(lt, 16); lt += __shfl_xor(lt, 32); const float inv = 1.0f / lt;
#pragma unroll
        for (int dt = 0; dt < 4; ++dt) { v2u w; w.x = pk2(O[hh][dt][0] * inv, O[hh][dt][1] * inv); w.y = pk2(O[hh][dt][2] * inv, O[hh][dt][3] * inv);
            *(v2u*)(mix + (size_t)qrow * DM + 256 + 64 * (3 * kvh + hh) + 16 * dt + 4 * q) = w; } }
}

__device__ __forceinline__ void fourier_tables(Frame& F) {
    bf16* t = (bf16*)(F.ws + WS_FT);
    for (int i = F.bid * NTHR + F.tid; i < 64 * 64; i += F.G * NTHR) { const int r = i >> 6, cc = i & 63; const float a = (float)((r * cc) & 63) * (1.0f / 64.0f);
        const float cs = __builtin_amdgcn_cosf(a), sn = __builtin_amdgcn_sinf(a);
        t[FT_W64C / 2 + i] = (bf16)f2bf(cs); t[FT_W64S / 2 + i] = (bf16)f2bf(sn);
        const int pj = (cc & ~31) | (((cc & 15) >> 2) << 3) | (((cc >> 4) & 1) << 2) | (cc & 3);
        t[FT_T64C / 2 + r * 64 + pj] = (bf16)f2bf(cs); t[FT_T64S / 2 + r * 64 + pj] = (bf16)f2bf(sn); }
    for (int i = F.bid * NTHR + F.tid; i < 128 * 128; i += F.G * NTHR) { const int r = i >> 7, cc = i & 127; const float a = (float)((r * cc) & 127) * (1.0f / 128.0f);
        t[FT_W128C / 2 + i] = (bf16)f2bf(__builtin_amdgcn_cosf(a)); t[FT_W128S / 2 + i] = (bf16)f2bf(__builtin_amdgcn_sinf(a)); }
}
__device__ __forceinline__ void fourier_a_fast(Frame& F, int u) {
    const int b = u >> 7, n2 = u & 127, c = F.lane & 15, q = F.lane >> 4;
    LAS unsigned char* IMG = F.lds;
    __syncthreads();
    for (int pc = F.tid; pc < 64 * 32; pc += NTHR) { const int n1 = pc >> 5, c8 = pc & 31;
        const v4u v = *(const v4u*)(zrow(F, b * SEQ + 128 * n1 + n2) + ZF + 8 * c8);
        LAS bf16* d = (LAS bf16*)(IMG + (8 * c8) * 144) + n1;
        d[0] = (bf16)(v.x & 0xffff); d[72] = (bf16)(v.x >> 16); d[144] = (bf16)(v.y & 0xffff); d[216] = (bf16)(v.y >> 16);
        d[288] = (bf16)(v.z & 0xffff); d[360] = (bf16)(v.z >> 16); d[432] = (bf16)(v.w & 0xffff); d[504] = (bf16)(v.w >> 16); }
    __syncthreads();
    const bf16* wc = (const bf16*)(F.ws + WS_FT + FT_W64C); const bf16* wsn = (const bf16*)(F.ws + WS_FT + FT_W64S);
    bf16* far = (bf16*)((unsigned char*)F.out + OUT_FA); bf16* fai = far + (size_t)NB * 64 * 128 * 256;
    bf16x8 Bc[4][2], Bs[4][2];
#pragma unroll
    for (int kt = 0; kt < 4; ++kt)
#pragma unroll
        for (int k = 0; k < 2; ++k) { Bc[kt][k] = *(const bf16x8*)(wc + (16 * kt + c) * 64 + 32 * k + 8 * q); Bs[kt][k] = *(const bf16x8*)(wsn + (16 * kt + c) * 64 + 32 * k + 8 * q); }
#pragma unroll
    for (int ci = 0; ci < 2; ++ci) { const int ct = 2 * F.wave + ci;
        bf16x8 A[2];
#pragma unroll
        for (int k = 0; k < 2; ++k) A[k] = *(const LAS bf16x8*)(IMG + (16 * ct + c) * 144 + k * 64 + q * 16);
#pragma unroll
        for (int kt = 0; kt < 4; ++kt) { f32x4 sr = {0.f, 0.f, 0.f, 0.f}, si = {0.f, 0.f, 0.f, 0.f};
#pragma unroll
            for (int k = 0; k < 2; ++k) { sr = MFMA16(A[k], Bc[kt][k], sr); si = MFMA16(A[k], Bs[kt][k], si); }
            const int k1 = 16 * kt + c; const float tw = (float)(n2 * k1) * (1.0f / 8192.0f); const float tc = __builtin_amdgcn_cosf(tw), ts = __builtin_amdgcn_sinf(tw);
            float xr[4], xi[4];
#pragma unroll
            for (int e = 0; e < 4; ++e) { const float ar = sr[e], ai = -si[e]; xr[e] = ar * tc + ai * ts; xi[e] = ai * tc - ar * ts; }
            const size_t o = (((size_t)b * 64 + k1) * 128 + n2) * 256 + 16 * ct + 4 * q;
            v2u w; w.x = pk2(xr[0], xr[1]); w.y = pk2(xr[2], xr[3]); *(v2u*)(far + o) = w; w.x = pk2(xi[0], xi[1]); w.y = pk2(xi[2], xi[3]); *(v2u*)(fai + o) = w; } }
}
__device__ __forceinline__ void fourier_c_fast(Frame& F, int u) {
    const int g = u & 3, k1 = (u >> 2) & 63, b = u >> 8, c = F.lane & 15, q = F.lane >> 4;
    LAS unsigned char* IR = F.lds; LAS unsigned char* II = F.lds + 64 * 272;
    const bf16* far = (const bf16*)((unsigned char*)F.out + OUT_FA) + (((size_t)b * 64 + k1) * 128) * 256 + 64 * g; const bf16* fai = far + (size_t)NB * 64 * 128 * 256;
    __syncthreads();
    for (int pc = F.tid; pc < 128 * 8; pc += NTHR) { const int n2 = pc >> 3, c8 = pc & 7;
        const v4u vr = *(const v4u*)(far + (size_t)n2 * 256 + 8 * c8), vi = *(const v4u*)(fai + (size_t)n2 * 256 + 8 * c8);
        LAS bf16* dr = (LAS bf16*)(IR + (8 * c8) * 272) + n2; LAS bf16* di = (LAS bf16*)(II + (8 * c8) * 272) + n2;
        dr[0] = (bf16)(vr.x & 0xffff); dr[136] = (bf16)(vr.x >> 16); dr[272] = (bf16)(vr.y & 0xffff); dr[408] = (bf16)(vr.y >> 16);
        dr[544] = (bf16)(vr.z & 0xffff); dr[680] = (bf16)(vr.z >> 16); dr[816] = (bf16)(vr.w & 0xffff); dr[952] = (bf16)(vr.w >> 16);
        di[0] = (bf16)(vi.x & 0xffff); di[136] = (bf16)(vi.x >> 16); di[272] = (bf16)(vi.y & 0xffff); di[408] = (bf16)(vi.y >> 16);
        di[544] = (bf16)(vi.z & 0xffff); di[680] = (bf16)(vi.z >> 16); di[816] = (bf16)(vi.w & 0xffff); di[952] = (bf16)(vi.w >> 16); }
    __syncthreads();
    const bf16* wc = (const bf16*)(F.ws + WS_FT + FT_W128C); const bf16* wsn = (const bf16*)(F.ws + WS_FT + FT_W128S);
    const bf16* tcn = (const bf16*)(F.ws + WS_FT + FT_T64C); const bf16* tsn = (const bf16*)(F.ws + WS_FT + FT_T64S);
    f32x4 Pr[4], Pi[4];
#pragma unroll
    for (int ct = 0; ct < 4; ++ct) { Pr[ct] = (f32x4){0.f, 0.f, 0.f, 0.f}; Pi[ct] = (f32x4){0.f, 0.f, 0.f, 0.f}; }
#pragma unroll
    for (int k = 0; k < 4; ++k) { const bf16x8 bc = *(const bf16x8*)(wc + (16 * F.wave + c) * 128 + 32 * k + 8 * q), bs = *(const bf16x8*)(wsn + (16 * F.wave + c) * 128 + 32 * k + 8 * q);
        const v4u bsu = __builtin_bit_cast(v4u, bs); const bf16x8 bsn = mk8(bsu.x ^ 0x80008000u, bsu.y ^ 0x80008000u, bsu.z ^ 0x80008000u, bsu.w ^ 0x80008000u);
#pragma unroll
        for (int ct = 0; ct < 4; ++ct) { const bf16x8 ar = *(const LAS bf16x8*)(IR + (16 * ct + c) * 272 + k * 64 + q * 16), ai = *(const LAS bf16x8*)(II + (16 * ct + c) * 272 + k * 64 + q * 16);
            Pr[ct] = MFMA16(ar, bc, Pr[ct]); Pr[ct] = MFMA16(ai, bs, Pr[ct]); Pi[ct] = MFMA16(ai, bc, Pi[ct]); Pi[ct] = MFMA16(ar, bsn, Pi[ct]); } }
    bf16x8 Br[2], Bi[2];
#pragma unroll
    for (int k = 0; k < 2; ++k) { Br[k] = mk8(cvtpk(Pr[2 * k][0], Pr[2 * k][1]), cvtpk(Pr[2 * k][2], Pr[2 * k][3]), cvtpk(Pr[2 * k + 1][0], Pr[2 * k + 1][1]), cvtpk(Pr[2 * k + 1][2], Pr[2 * k + 1][3]));
        Bi[k] = mk8(cvtpk(Pi[2 * k][0], Pi[2 * k][1]), cvtpk(Pi[2 * k][2], Pi[2 * k][3]), cvtpk(Pi[2 * k + 1][0], Pi[2 * k + 1][1]), cvtpk(Pi[2 * k + 1][2], Pi[2 * k + 1][3])); }
    bf16* mix = (bf16*)(F.ws + WS_H);
    const float scale = 0.0013810679320049757f;
    const int k2 = 16 * F.wave + c; const size_t row = (size_t)b * SEQ + k1 + 64 * k2;
#pragma unroll
    for (int mt = 0; mt < 4; ++mt) { f32x4 y = {0.f, 0.f, 0.f, 0.f};
#pragma unroll
        for (int k = 0; k < 2; ++k) { const bf16x8 ac = *(const bf16x8*)(tcn + (16 * mt + c) * 64 + 32 * k + 8 * q), as = *(const bf16x8*)(tsn + (16 * mt + c) * 64 + 32 * k + 8 * q);
            y = MFMA16(ac, Br[k], y); y = MFMA16(as, Bi[k], y); }
        v2u w; w.x = pk2(y[0] * scale, y[1] * scale); w.y = pk2(y[2] * scale, y[3] * scale);
        *(v2u*)(mix + row * DM + 64 * g + 16 * mt + 4 * q) = w; }
}

#define XB_TMO      128
#define XB_XCNT(j)  (256  + 64 * (j))
#define XB_XSUB(j)  (1280 + 64 * (j))
#define XB_XGEN(j)  (2304 + 64 * (j))
#define XB_TOP      3328
#define XB_TOPGEN   3392
#define XCD_BAR_WORDS 3456
#define XB_SPIN_CAP (1u << 23)
__device__ __forceinline__ unsigned xb_ld(unsigned* p)              { return __hip_atomic_load(p, __ATOMIC_RELAXED, __HIP_MEMORY_SCOPE_AGENT); }
__device__ __forceinline__ unsigned xb_add(unsigned* p, unsigned v) { return __hip_atomic_fetch_add(p, v, __ATOMIC_RELAXED, __HIP_MEMORY_SCOPE_AGENT); }
__device__ __forceinline__ unsigned xb_xcc_id() { return (unsigned)__builtin_amdgcn_s_getreg((3 << 11) | 20) & 0xFu; }
#define XB_SPIN(cond, bar) do { unsigned _sp = 0; while (cond) { __builtin_amdgcn_s_sleep(1); \
    if ((++_sp & 255u) == 0u) { if (xb_ld(&(bar)[XB_TMO])) break; if (_sp > XB_SPIN_CAP) { atomicAdd(&(bar)[XB_TMO], 1u); break; } } } } while (0)
struct XcdBarrier { unsigned* bar; unsigned x; volatile LAS unsigned* st; };
__device__ __forceinline__ XcdBarrier xcd_barrier_post(unsigned* bar, volatile LAS unsigned* st) {
    XcdBarrier b; b.bar = bar; b.x = xb_xcc_id(); b.st = st;
    if (threadIdx.x == 0) (void)xb_add(&bar[XB_XCNT(b.x)], 1u);
    return b;
}
__device__ __forceinline__ void xcd_barrier_complete(unsigned* bar, unsigned x, unsigned& nloc, unsigned& nx) {
    const unsigned G = gridDim.x * gridDim.y * gridDim.z;
    unsigned sum, cnt, mine, sp = 0u;
    for (;;) {
        sum = 0u; cnt = 0u; mine = 0u;
#pragma unroll
        for (unsigned j = 0; j < 16; ++j) { const unsigned c = xb_ld(&bar[XB_XCNT(j)]); sum += c; cnt += (c > 0u) ? 1u : 0u; mine = (j == x) ? c : mine; }
        if (sum == G) break;
        __builtin_amdgcn_s_sleep(1);
        if ((++sp & 255u) == 0u) { if (xb_ld(&bar[XB_TMO])) break; if (sp > XB_SPIN_CAP) { atomicAdd(&bar[XB_TMO], 1u); break; } }
    }
    nloc = mine > 0u ? mine : 1u; nx = cnt > 0u ? cnt : 1u;
}
__device__ __forceinline__ void xcd_barrier(const XcdBarrier& b0) {
    XcdBarrier b; { unsigned* p = b0.bar; unsigned x = __builtin_amdgcn_readfirstlane(b0.x); unsigned st = (unsigned)(size_t)b0.st; asm volatile("" : "+s"(p), "+s"(x), "+s"(st)); b.bar = p; b.x = x; b.st = (volatile LAS unsigned*)(size_t)st; }
    asm volatile("s_waitcnt vmcnt(0)" ::: "memory");
    __syncthreads();
    if (threadIdx.x == 0) {
        unsigned* bar = b.bar;
        __builtin_amdgcn_s_waitcnt(0);
        unsigned nloc = b.st[0], nx = b.st[1];
        if (nloc == 0u) { xcd_barrier_complete(bar, b.x, nloc, nx); b.st[0] = nloc; b.st[1] = nx; }
        const unsigned old = xb_add(&bar[XB_XSUB(b.x)], 1u);
        const unsigned gen = old / nloc;
        if (old + 1u == (gen + 1u) * nloc) {
            __builtin_amdgcn_fence(__ATOMIC_RELEASE, "agent");
            asm volatile("s_waitcnt vmcnt(0)" ::: "memory");
            const unsigned og = xb_add(&bar[XB_TOP], 1u);
            const unsigned tg = og / nx;
            if (og + 1u == (tg + 1u) * nx) xb_add(&bar[XB_TOPGEN], 1u);
            else XB_SPIN(xb_ld(&bar[XB_TOPGEN]) == tg, bar);
            __builtin_amdgcn_fence(__ATOMIC_ACQUIRE, "agent");
            xb_add(&bar[XB_XGEN(b.x)], 1u);
            asm volatile("s_waitcnt vmcnt(0)" ::: "memory");
        } else {
            XB_SPIN(xb_ld(&bar[XB_XGEN(b.x)]) == gen, bar);
            __builtin_amdgcn_fence(__ATOMIC_ACQUIRE, "agent");
            asm volatile("s_waitcnt vmcnt(0)" ::: "memory");
        }
    }
    __syncthreads();
}

__device__ __forceinline__ int queue_next(Frame& F, unsigned* cnt) {
    volatile LAS int* slot = (volatile LAS int*)(F.lds + MISC_OFF + 64);
    __syncthreads();
    if (F.tid == 0) *slot = (int)__hip_atomic_fetch_add(cnt, 1u, __ATOMIC_RELAXED, __HIP_MEMORY_SCOPE_AGENT);
    __syncthreads();
    return *slot;
}
template <int KIND> __device__ __forceinline__ void run_phase(const Frame& F0, int li, int second) {
    Frame F;
    { int t = threadIdx.x; asm volatile("" : "+v"(t)); F.tid = t; F.lane = t & 63; F.wave = __builtin_amdgcn_readfirstlane(t >> 6);
      int g = F0.G, b = F0.bid; asm volatile("" : "+s"(g), "+s"(b)); F.G = g; F.bid = b;
      unsigned char* w = F0.ws; float* o = F0.out; asm volatile("" : "+s"(w), "+s"(o)); F.ws = w; F.out = o;
      unsigned l = (unsigned)(size_t)F0.lds; asm volatile("" : "+s"(l)); F.lds = (LAS unsigned char*)(size_t)l;
      asm volatile("" : "+s"(li), "+s"(second)); }
    float* modv = (float*)(F.ws + WS_MOD);
    bf16* XB = (bf16*)(F.ws + WS_XB);
    bf16* H = (bf16*)(F.ws + WS_H); bf16* ACT = (bf16*)(F.ws + WS_ACT); bf16* O = (bf16*)(F.ws + WS_O);
    const float* ng = inp(I_NORMG) + (size_t)li * 6 * DM; const float* mv = modv + (size_t)li * 3 * 9216;
    const bool last = li == 1;
    if constexpr (KIND == 100) { convert_weights(F, 0); mod_gemv(F); rope_tables(F); lora_transposes(F); fourier_tables(F); }
    if constexpr (KIND == 101) { EArgs A{}; A.xl_src = inp(I_X); A.xc_src = inp(I_CTX); A.o = nullptr; A.hdst = H; A.modv_h = modv; A.shidx = 0; A.scidx = 1; A.gpre = inp(I_NORMG); A.nrows = TT; e_phase(F, A); }
    if constexpr (KIND == 0) {
        const bf16* wi = (const bf16*)(F.ws + (second ? WS_WI2 : WS_WI1)); const bool withctx = !(last && second);
        if (!withctx || F.G != 256) { pg8::Gemm g{H, wi, withctx ? TT : TL, NWI, DM}; pg8::StaticOrder S; S.init(g.M, g.N, F.G, F.bid);
            pg8::EpiSwiglu E{ACT, FFNP}; pg8::gemm_phase<pg8::EpiSwiglu, pg8::StaticOrder, true, true>(F.lds, g, S, E, F.tid); }
        else { unsigned* cnt = (unsigned*)(F.ws + WS_CTL) + 8192 + 64 * (li * 2 + second);
            pg8::Gemm g{H, wi, TT, NWI, DM}; pg8::UpOrder S; S.init(NWI, F.G, F.bid, cnt);
            pg8::EpiSwiglu E{ACT, FFNP}; pg8::gemm_phase<pg8::EpiSwiglu, pg8::UpOrder, true, true>(F.lds, g, S, E, F.tid);
            if (F.bid >= 248) {
                if (F.tid == 0) { unsigned sp = 0; while (__hip_atomic_load(cnt, __ATOMIC_RELAXED, __HIP_MEMORY_SCOPE_AGENT) < 352u && ++sp < (1u << 24)) __builtin_amdgcn_s_sleep(8);
                    __builtin_amdgcn_fence(__ATOMIC_ACQUIRE, "agent"); asm volatile("s_waitcnt vmcnt(0)" ::: "memory"); }
                __syncthreads();
                const int k = F.bid - 248; pg8::Gemm g2{ACT, (const bf16*)(F.ws + (second ? WS_WO2 : WS_WO1)), TT, DM, FFNP}; pg8::OneUnit S2{64 + (k >> 2), k & 3};
                pg8::EpiBf16 E2{O, DM}; pg8::gemm_phase<pg8::EpiBf16, pg8::OneUnit, false, true>(F.lds, g2, S2, E2, F.tid); } } }
    if constexpr (KIND == 1) {
        const bool ctxhere = F.G != 256 && !(last && second);
        pg8::Gemm g{ACT, (const bf16*)(F.ws + (second ? WS_WO2 : WS_WO1)), ctxhere ? TT : TL, DM, FFNP}; pg8::StaticOrder S; S.init(g.M, g.N, F.G, F.bid);
        pg8::EpiBf16 E{O, DM}; pg8::gemm_phase<pg8::EpiBf16, pg8::StaticOrder, true, true>(F.lds, g, S, E, F.tid); }
    if constexpr (KIND == 2) {
        EArgs A{}; A.xl_src = inp(I_X); A.xc_src = inp(I_CTX); A.xb_src = li == 0 ? (const bf16*)nullptr : XB; A.xb_dst = XB; A.o = O; A.modv_g = mv; A.gidx = 2; A.gmul = 0.5f; A.gpost = ng + 1 * DM;
        A.hdst = H; A.modv_h = mv; A.shidx = 3; A.scidx = 4; A.gpre = ng + 2 * DM; A.nrows = TT; e_phase(F, A); }
    if constexpr (KIND == 3) {
        pg8::Gemm g{H, (const bf16*)(F.ws + WS_WIN), TT, INWP, DM}; pg8::StaticOrder S; S.init(g.M, g.N, F.G, F.bid);
        pg8::EpiBf16 E{ACT, INWP}; pg8::gemm_phase<pg8::EpiBf16, pg8::StaticOrder, true, true>(F.lds, g, S, E, F.tid); }
    if constexpr (KIND == 4) {
        lora_pass(F, li);
        for (int u = F.bid; u < 256; u += F.G) fourier_a_fast(F, u);
        rope_all(F);
        if (li == 0) fourier_ctx1_all(F); }
    if constexpr (KIND == 5) {
        unsigned* cnt = (unsigned*)(F.ws + WS_CTL) + 8192 + 64 * (4 + 2 * li);
        const int na = li == 0 ? 264 : 256;
        for (int it = queue_next(F, cnt); it < na; it = queue_next(F, cnt)) attn_unit(F, li, it);
        for (int it = queue_next(F, cnt + 16); it < 12 * (NSC - 1); it = queue_next(F, cnt + 16)) rwkv_pass1_pair(F, li, it); }
    if constexpr (KIND == 11) {
        if (F.bid < 24) rwkv_pass2_chain(F, F.bid);
        else convert_weights(F, 1, li == 0 ? 1 : 2, 24, F.G - 24);
        if (li == 0) fourier_ctx2_all(F); }
    if constexpr (KIND == 12) {
        unsigned* cnt = (unsigned*)(F.ws + WS_CTL) + 8192 + 64 * (5 + 2 * li);
        const int np3 = li == 0 ? 12 * NSC : 12 * 64;
        for (int it = queue_next(F, cnt); it < np3; it = queue_next(F, cnt)) rwkv_pass3_unit(F, li, li == 0 ? it : (it / 64) * NSC + 2 + it % 64);
        for (int it = queue_next(F, cnt + 16); it < 512; it = queue_next(F, cnt + 16)) fourier_c_fast(F, it); }
    if constexpr (KIND == 6) {
        pg8::Gemm g{H, (const bf16*)(F.ws + WS_WOUT), last ? TL : TT, DM, DM}; pg8::StaticOrder S; S.init(g.M, g.N, F.G, F.bid);
        pg8::EpiBf16 E{O, DM}; pg8::gemm_phase<pg8::EpiBf16, pg8::StaticOrder, true, true>(F.lds, g, S, E, F.tid); }
    if constexpr (KIND == 7) {
        EArgs A{}; A.xb_src = XB; A.xb_dst = XB; A.o = O; A.modv_g = mv; A.gidx = 5; A.gmul = 1.0f; A.gpost = ng + 3 * DM;
        A.hdst = H; A.modv_h = mv; A.shidx = 6; A.scidx = 7; A.gpre = ng + 4 * DM; A.nrows = last ? TL : TT; e_phase(F, A); }
    if constexpr (KIND == 10) {
        EArgs A{}; A.xb_src = XB; A.xb_dst = XB; A.out32 = last ? F.out : (float*)nullptr; A.o = O; A.modv_g = mv; A.gidx = 8; A.gmul = 0.5f; A.gpost = ng + 5 * DM;
        if (!last) { A.hdst = H; A.modv_h = mv + 3 * 9216; A.shidx = 0; A.scidx = 1; A.gpre = ng + 6 * DM; }
        A.nrows = last ? TL : TT; e_phase(F, A);
        }
}
__global__ void __launch_bounds__(NTHR, 2) mega_one(Args args) {
    extern __shared__ __attribute__((aligned(16))) unsigned char lds[];
    Frame F; F.lds = (LAS unsigned char*)lds; F.tid = threadIdx.x; F.lane = F.tid & 63; F.wave = __builtin_amdgcn_readfirstlane(F.tid >> 6); F.G = gridDim.x; F.bid = blockIdx.x;
    F.out = args.out; F.ws = args.ws;
    volatile LAS unsigned* MISC = (volatile LAS unsigned*)(F.lds + MISC_OFF);
    if (F.tid < 32) MISC[F.tid] = 0u;
    __syncthreads();
    XcdBarrier bar = xcd_barrier_post((unsigned*)(F.ws + WS_CTL) + 4096, MISC + 8);
#define GRID_BAR() xcd_barrier(bar)
    run_phase<100>(F, 0, 0); GRID_BAR();
    run_phase<101>(F, 0, 0); GRID_BAR();
#pragma unroll 1
    for (int li = 0; li < 2; ++li) {
        run_phase<0>(F, li, 0); GRID_BAR();
        run_phase<1>(F, li, 0); GRID_BAR();
        run_phase<2>(F, li, 0); GRID_BAR();
        run_phase<3>(F, li, 0); GRID_BAR();
        run_phase<4>(F, li, 0); GRID_BAR();
        run_phase<5>(F, li, 0); GRID_BAR();
        run_phase<11>(F, li, 0); GRID_BAR();
        run_phase<12>(F, li, 0); GRID_BAR();
        run_phase<6>(F, li, 0); GRID_BAR();
        run_phase<7>(F, li, 0); GRID_BAR();
        run_phase<0>(F, li, 1); GRID_BAR();
        run_phase<1>(F, li, 1); GRID_BAR();
        run_phase<10>(F, li, 0); GRID_BAR();
    }
}

extern "C" void kernel_launch(void* const* d_in, const int* in_sizes, int n_in, void* d_out, int out_size, void* d_ws, size_t ws_size, hipStream_t stream) {
    static int ready = 0;
    if (!ready) {
        if (n_in != 25 || out_size != TL * DM || ws_size < WS_END) { fprintf(stderr, "kernel_launch: unexpected shapes (n_in %d out %d ws %zu)\n", n_in, out_size, ws_size); ready = -1; return; }
        if (hipFuncSetAttribute((const void*)mega_one, hipFuncAttributeMaxDynamicSharedMemorySize, LDS_BYTES) != hipSuccess) { fprintf(stderr, "kernel_launch: hipFuncSetAttribute failed\n"); ready = -1; return; }
        int dev = 0, cus = 0; if (hipGetDevice(&dev) != hipSuccess || hipDeviceGetAttribute(&cus, hipDeviceAttributeMultiprocessorCount, dev) != hipSuccess || cus < 32) cus = 256;
        ready = cus < 256 ? cus : 256;
    }
    if (ready < 0) return;
    if (hipMemsetAsync((char*)d_ws + WS_CTL, 0, 65536, stream) != hipSuccess) { fprintf(stderr, "kernel_launch: memset failed\n"); return; }
    Args a{};
    for (int i = 0; i < 25; ++i) a.in[i] = (const float*)d_in[i];
    a.out = (float*)d_out; a.ws = (unsigned char*)d_ws;
    hipLaunchKernelGGL(mega_one, dim3(ready), dim3(NTHR), LDS_BYTES, stream, a);
}
```

```cpp
#include <hip/hip_runtime.h>
#include <cstdio>
#include <cstdint>

namespace pg8 {
#define PG8_LAS __attribute__((address_space(3)))
typedef unsigned short bf16_t;
typedef short bf16x8 __attribute__((ext_vector_type(8)));
typedef float f32x4 __attribute__((ext_vector_type(4)));
typedef unsigned u32x4 __attribute__((ext_vector_type(4)));
constexpr int BM = 256, BK = 64, HALF = 128, HTB = HALF * BK * 2, STAGE_BYTES = 8 * HTB, NXCD = 8, WGM = 8;

__host__ __device__ __forceinline__ int lds_byte(int r, int c) { const int st = (r >> 4) * 2 + (c >> 5), rr = r & 15, cc = c & 31, ob = rr * 64 + cc * 2; return st * 1024 + (ob ^ (((ob >> 9) & 1) << 5)); }
__host__ __device__ __forceinline__ void stage_rc(int b, int& R, int& C) { const int st = b / 1024, sb = b % 1024, swz = sb ^ (((sb >> 9) & 1) << 5); R = (st >> 1) * 16 + swz / 64; C = (st & 1) * 32 + (swz % 64) / 2; }
__host__ __device__ __forceinline__ int perm32(int rho) { const int n = rho >> 4, i = rho & 15; return 8 * (i >> 2) + 4 * n + (i & 3); }

struct Unit { int pm, pn; };
struct Gemm { const bf16_t* A; const bf16_t* Bt; int M, N, K; };

struct StaticOrder {
    int nM, nN, nwg, G, c;
    __host__ __device__ void init(int M, int N, int G_, int c_) { nM = M / BM; nN = N / BM; nwg = nM * nN; G = G_; c = c_; }
    __host__ __device__ bool next(int i, Unit& u) const {
        const long L = (long)i * G + c; if (L >= nwg) return false;
        int wgid = (int)L; { const int q = nwg / NXCD, r = nwg % NXCD, xcd = wgid % NXCD, off = wgid / NXCD; wgid = (xcd < r ? xcd * (q + 1) : r * (q + 1) + (xcd - r) * q) + off; }
        const int nig = WGM * nN, gid = wgid / nig, fm = gid * WGM, gsz = (nM - fm) < WGM ? (nM - fm) : WGM;
        u.pm = fm + ((wgid % nig) % gsz); u.pn = (wgid % nig) / gsz; return true;
    }
    __device__ __forceinline__ void a_ready(const Unit&) const {}
    __device__ __forceinline__ void done(const Unit&) const {}
};

struct UpOrder {
    StaticOrder lat; int G, c, nN; unsigned* cnt;
    __device__ void init(int N, int G_, int c_, unsigned* cnt_) { lat.init(16384, N, G_, c_); G = G_; c = c_; nN = N / BM; cnt = cnt_; }
    __device__ bool next(int i, Unit& u) const {
        const int nctx = 2 * nN, total = nctx + lat.nwg;
        long L;
        if (G != 256) L = (long)i * G + c;
        else if (c >= 248) { if (i >= 3) return false; L = (long)i * G + c; }
        else if (c >= 172 && c < 188 && i == 5) L = (long)(3 + (c - 172) / 8) * G + 248 + (c - 172) % 8;
        else L = (long)i * G + c;
        if (L >= total) return false;
        if (L < nctx) { u.pm = 64 + (int)L / nN; u.pn = (int)L % nN; return true; }
        int wgid = (int)L - nctx; { const int nwg = lat.nwg, q = nwg / NXCD, r = nwg % NXCD, xcd = wgid % NXCD, off = wgid / NXCD; wgid = (xcd < r ? xcd * (q + 1) : r * (q + 1) + (xcd - r) * q) + off; }
        const int nig = WGM * nN, gid = wgid / nig, fm = gid * WGM, gsz = (lat.nM - fm) < WGM ? (lat.nM - fm) : WGM;
        u.pm = fm + ((wgid % nig) % gsz); u.pn = (wgid % nig) / gsz; return true;
    }
    __device__ __forceinline__ void a_ready(const Unit&) const {}
    __device__ __forceinline__ void done(const Unit& u) const {
        if (u.pm >= 64) { asm volatile("s_waitcnt vmcnt(0)" ::: "memory"); __builtin_amdgcn_fence(__ATOMIC_RELEASE, "agent"); asm volatile("s_waitcnt vmcnt(0)" ::: "memory");
            if ((threadIdx.x & 63) == 0) __hip_atomic_fetch_add(cnt, 1u, __ATOMIC_RELAXED, __HIP_MEMORY_SCOPE_AGENT); }
    }
};
struct OneUnit {
    int pm, pn;
    __device__ bool next(int i, Unit& u) const { if (i != 0) return false; u.pm = pm; u.pn = pn; return true; }
    __device__ __forceinline__ void a_ready(const Unit&) const {}
    __device__ __forceinline__ void done(const Unit&) const {}
};

__device__ __forceinline__ unsigned cvt_pk_bf16(float lo, float hi) { unsigned r; asm volatile("v_cvt_pk_bf16_f32 %0, %1, %2" : "=v"(r) : "v"(lo), "v"(hi)); return r; }

struct EpiBf16 {
    static constexpr bool PERM = true, AFTER_DRAIN = false;
    bf16_t* O; int ldc;
    __device__ __forceinline__ void operator()(const f32x4 (&acc)[2][2][4][2], const Unit& u, int wr, int wc, int fr, int fq) const {
        const int row0 = u.pm * BM + wr * 64 + fr; const int col0 = u.pn * BM + wc * 32 + 8 * fq;
#pragma unroll
        for (int ai = 0; ai < 2; ++ai)
#pragma unroll
            for (int m = 0; m < 4; ++m) { bf16_t* rowp = O + (size_t)(row0 + ai * HALF + m * 16) * ldc + col0;
#pragma unroll
                for (int bj = 0; bj < 2; ++bj) { const f32x4 v0 = acc[ai][bj][m][0], v1 = acc[ai][bj][m][1];
                    u32x4 w; w.x = cvt_pk_bf16(v0[0], v0[1]); w.y = cvt_pk_bf16(v0[2], v0[3]); w.z = cvt_pk_bf16(v1[0], v1[1]); w.w = cvt_pk_bf16(v1[2], v1[3]);
                    *(u32x4*)(rowp + bj * HALF) = w; } }
    }
};
struct EpiF32 {
    static constexpr bool PERM = true, AFTER_DRAIN = false;
    float* O; int ldc;
    __device__ __forceinline__ void operator()(const f32x4 (&acc)[2][2][4][2], const Unit& u, int wr, int wc, int fr, int fq) const {
        const int row0 = u.pm * BM + wr * 64 + fr; const int col0 = u.pn * BM + wc * 32 + 8 * fq;
#pragma unroll
        for (int ai = 0; ai < 2; ++ai)
#pragma unroll
            for (int m = 0; m < 4; ++m) { float* rowp = O + (size_t)(row0 + ai * HALF + m * 16) * ldc + col0;
#pragma unroll
                for (int bj = 0; bj < 2; ++bj) { *(f32x4*)(rowp + bj * HALF) = acc[ai][bj][m][0]; *(f32x4*)(rowp + bj * HALF + 4) = acc[ai][bj][m][1]; } }
    }
};
__device__ __forceinline__ float silu_f(float x) { return x * __builtin_amdgcn_rcpf(1.0f + __expf(-x)); }
struct EpiSwiglu {
    static constexpr bool PERM = true, AFTER_DRAIN = false;
    bf16_t* O; int ldc;
    __device__ __forceinline__ void operator()(const f32x4 (&acc)[2][2][4][2], const Unit& u, int wr, int wc, int fr, int fq) const {
        const int row0 = u.pm * BM + wr * 64 + fr; const int col0 = u.pn * HALF + wc * 32 + 8 * fq;
#pragma unroll
        for (int ai = 0; ai < 2; ++ai)
#pragma unroll
            for (int m = 0; m < 4; ++m) { bf16_t* rowp = O + (size_t)(row0 + ai * HALF + m * 16) * ldc + col0;
                const f32x4 g0 = acc[ai][0][m][0], g1 = acc[ai][0][m][1], u0 = acc[ai][1][m][0], u1 = acc[ai][1][m][1];
                u32x4 w; w.x = cvt_pk_bf16(silu_f(g0[0]) * u0[0], silu_f(g0[1]) * u0[1]); w.y = cvt_pk_bf16(silu_f(g0[2]) * u0[2], silu_f(g0[3]) * u0[3]);
                w.z = cvt_pk_bf16(silu_f(g1[0]) * u1[0], silu_f(g1[1]) * u1[1]); w.w = cvt_pk_bf16(silu_f(g1[2]) * u1[2], silu_f(g1[3]) * u1[3]);
                *(u32x4*)rowp = w; }
    }
};

template <class Epi, class Sched, bool ALIGN_EPI = false, bool SP2 = false>
__device__ __forceinline__ void gemm_phase(PG8_LAS unsigned char* lds, const Gemm g, const Sched& S, const Epi& E, const int tid) {
    const int wid = __builtin_amdgcn_readfirstlane(tid >> 6), lane = tid & 63, wr = wid >> 2, wc = wid & 3, fr = lane & 15, fq = lane >> 4;
    const int K = g.K, nt = K / BK;
    unsigned voffA[2], voffB[2];
#pragma unroll
    for (int i = 0; i < 2; ++i) { int R, C; stage_rc(tid * 16 + i * 8192, R, C); const int Rb = Epi::PERM ? ((R & ~31) + perm32(R & 31)) : R;
        voffA[i] = (unsigned)(R * K + C) * 2u; voffB[i] = (unsigned)(Rb * K + C) * 2u; }
    const size_t kstep = (size_t)(BK * 2);
    const size_t hstep = (size_t)HALF * K * 2;
    const size_t tstep = 2 * hstep;
    const unsigned ldsw = (unsigned)wid * 1024u;
    const int aoff = lds_byte(wr * 64 + fr, fq * 8), boff = lds_byte(wc * 32 + fr, fq * 8);
#define PG8_SA(b, h) (((b) * 2 + (h)) * HTB)
#define PG8_SB(b, h) ((4 + (b) * 2 + (h)) * HTB)
#define PG8_STAGE(bufoff, gbase, voff) do { _Pragma("unroll") for (int _i = 0; _i < 2; ++_i) \
        __builtin_amdgcn_global_load_lds((const unsigned*)((const char*)(gbase) + (voff)[_i]), (PG8_LAS unsigned*)(lds + (bufoff) + ldsw + _i * 8192), 16, 0, 0); } while (0)
#define PG8_LDA(dst, b, h) do { _Pragma("unroll") for (int m = 0; m < 4; ++m) _Pragma("unroll") for (int k = 0; k < 2; ++k) dst[m][k] = *(const PG8_LAS bf16x8*)(lds + PG8_SA(b, h) + aoff + m * 2048 + k * 1024); } while (0)
#define PG8_LDB(dst, b, h) do { _Pragma("unroll") for (int n = 0; n < 2; ++n) _Pragma("unroll") for (int k = 0; k < 2; ++k) dst[n][k] = *(const PG8_LAS bf16x8*)(lds + PG8_SB(b, h) + boff + n * 2048 + k * 1024); } while (0)
#define PG8_MMA(ai, bj, At, Bt) do { __builtin_amdgcn_s_setprio(1); _Pragma("unroll") for (int m = 0; m < 4; ++m) _Pragma("unroll") for (int n = 0; n < 2; ++n) _Pragma("unroll") for (int k = 0; k < 2; ++k) \
        acc[ai][bj][m][n] = __builtin_amdgcn_mfma_f32_16x16x32_bf16(Bt[n][k], At[m][k], acc[ai][bj][m][n], 0, 0, 0); __builtin_amdgcn_s_setprio(0); } while (0)
#define PG8_WAIT_V(n) asm volatile("s_waitcnt vmcnt(" #n ")" ::: "memory")
#define PG8_WAIT_L(n) asm volatile("s_waitcnt lgkmcnt(" #n ")" ::: "memory")
#define PG8_BAR __builtin_amdgcn_s_barrier()
#define PG8_SCHED __builtin_amdgcn_sched_barrier(0)
    Unit cur, nxt; int ui = 0;
    if (!S.next(0, cur)) return;
    f32x4 acc[2][2][4][2];
#pragma unroll
    for (int a = 0; a < 2; ++a)
#pragma unroll
        for (int b = 0; b < 2; ++b)
#pragma unroll
            for (int m = 0; m < 4; ++m)
#pragma unroll
                for (int n = 0; n < 2; ++n) acc[a][b][m][n] = (f32x4){0.f, 0.f, 0.f, 0.f};
    bf16x8 At[4][2], B0[2][2], B1[2][2];
    const char* cA = (const char*)g.A + (size_t)cur.pm * tstep; const char* cB = (const char*)g.Bt + (size_t)cur.pn * tstep;
    S.a_ready(cur);
    if constexpr (SP2) {
        PG8_STAGE(PG8_SB(0, 0), cB, voffB); PG8_STAGE(PG8_SB(0, 1), cB + hstep, voffB); PG8_STAGE(PG8_SA(0, 0), cA, voffA); PG8_STAGE(PG8_SA(0, 1), cA + hstep, voffA);
        if (wr == 1) PG8_BAR;
        PG8_WAIT_V(2); PG8_BAR;
        PG8_STAGE(PG8_SB(1, 0), cB + kstep, voffB); PG8_STAGE(PG8_SA(1, 0), cA + kstep, voffA); PG8_STAGE(PG8_SB(1, 1), cB + hstep + kstep, voffB);
        PG8_WAIT_V(6); PG8_BAR;
    } else {
        PG8_STAGE(PG8_SB(0, 0), cB, voffB); PG8_STAGE(PG8_SA(0, 0), cA, voffA); PG8_STAGE(PG8_SB(0, 1), cB + hstep, voffB); PG8_STAGE(PG8_SA(0, 1), cA + hstep, voffA);
        if (wr == 1) PG8_BAR;
        PG8_WAIT_V(4); PG8_BAR;
        PG8_STAGE(PG8_SB(1, 0), cB + kstep, voffB); PG8_STAGE(PG8_SA(1, 0), cA + kstep, voffA); PG8_STAGE(PG8_SB(1, 1), cB + hstep + kstep, voffB);
        PG8_WAIT_V(6); PG8_BAR;
    }
    for (;;) {
        const bool has_next = S.next(ui + 1, nxt);
        const char* nA = has_next ? (const char*)g.A + (size_t)nxt.pm * tstep : cA; const char* nB = has_next ? (const char*)g.Bt + (size_t)nxt.pn * tstep : cB;
        for (int t = 0; t < nt; t += 2) {
            const bool last = (t == nt - 2);
            const char* a1 = cA + (size_t)(t + 1) * kstep;
            const char* a2 = last ? nA : cA + (size_t)(t + 2) * kstep; const char* b2 = last ? nB : cB + (size_t)(t + 2) * kstep;
            const char* a3 = a2 + kstep; const char* b3 = b2 + kstep;
            if (last && has_next) S.a_ready(nxt);
            if constexpr (SP2) {
            PG8_LDB(B0, 0, 0); PG8_LDB(B1, 0, 1); PG8_SCHED; PG8_LDA(At, 0, 0); PG8_STAGE(PG8_SA(1, 1), a1 + hstep, voffA);
            PG8_WAIT_V(8); PG8_WAIT_L(0); PG8_BAR; PG8_MMA(0, 0, At, B0); PG8_MMA(0, 1, At, B1); PG8_BAR; PG8_SCHED;
            PG8_LDA(At, 0, 1); PG8_STAGE(PG8_SB(0, 0), b2, voffB); PG8_STAGE(PG8_SB(0, 1), b2 + hstep, voffB); PG8_STAGE(PG8_SA(0, 0), a2, voffA);
            PG8_WAIT_V(8); PG8_WAIT_L(0); PG8_BAR; PG8_MMA(1, 0, At, B0); PG8_MMA(1, 1, At, B1); PG8_BAR; PG8_SCHED;
            PG8_LDB(B0, 1, 0); PG8_LDB(B1, 1, 1); PG8_SCHED; PG8_LDA(At, 1, 0); PG8_STAGE(PG8_SA(0, 1), a2 + hstep, voffA);
            PG8_WAIT_V(8); PG8_WAIT_L(0); PG8_BAR; PG8_MMA(0, 0, At, B0); PG8_MMA(0, 1, At, B1); PG8_BAR; PG8_SCHED;
            PG8_LDA(At, 1, 1); PG8_STAGE(PG8_SB(1, 0), b3, voffB); PG8_STAGE(PG8_SB(1, 1), b3 + hstep, voffB); PG8_STAGE(PG8_SA(1, 0), a3, voffA);
            PG8_WAIT_V(8); PG8_WAIT_L(0); PG8_BAR; PG8_MMA(1, 0, At, B0); PG8_MMA(1, 1, At, B1); PG8_BAR; PG8_SCHED;
            } else {
            PG8_LDB(B0, 0, 0); PG8_SCHED; PG8_LDA(At, 0, 0); PG8_STAGE(PG8_SA(1, 1), a1 + hstep, voffA);
            PG8_WAIT_L(8); PG8_BAR; PG8_WAIT_L(0); PG8_MMA(0, 0, At, B0); PG8_BAR; PG8_SCHED;
            PG8_LDB(B1, 0, 1); PG8_STAGE(PG8_SB(0, 0), b2, voffB);
            PG8_BAR; PG8_WAIT_L(0); PG8_MMA(0, 1, At, B1); PG8_BAR;
            PG8_LDA(At, 0, 1); PG8_STAGE(PG8_SA(0, 0), a2, voffA);
            PG8_BAR; PG8_WAIT_L(0); PG8_MMA(1, 0, At, B0); PG8_BAR; PG8_SCHED;
            PG8_STAGE(PG8_SB(0, 1), b2 + hstep, voffB);
            PG8_WAIT_V(6); PG8_BAR; PG8_MMA(1, 1, At, B1); PG8_BAR;
            PG8_LDB(B0, 1, 0); PG8_SCHED; PG8_LDA(At, 1, 0); PG8_STAGE(PG8_SA(0, 1), a2 + hstep, voffA);
            PG8_WAIT_L(8); PG8_BAR; PG8_WAIT_L(0); PG8_MMA(0, 0, At, B0); PG8_BAR; PG8_SCHED;
            PG8_LDB(B1, 1, 1); PG8_STAGE(PG8_SB(1, 0), b3, voffB);
            PG8_BAR; PG8_WAIT_L(0); PG8_MMA(0, 1, At, B1); PG8_BAR;
            PG8_LDA(At, 1, 1); PG8_STAGE(PG8_SA(1, 0), a3, voffA);
            PG8_BAR; PG8_WAIT_L(0); PG8_MMA(1, 0, At, B0); PG8_BAR; PG8_SCHED;
            PG8_STAGE(PG8_SB(1, 1), b3 + hstep, voffB);
            PG8_WAIT_V(6); PG8_BAR; PG8_MMA(1, 1, At, B1); PG8_BAR;
            }
        }
        if constexpr (ALIGN_EPI) { if (wr == 0) PG8_BAR; }
        if constexpr (!Epi::AFTER_DRAIN) { E(acc, cur, wr, wc, fr, fq); S.done(cur); }
        if (!has_next) break;
#pragma unroll
        for (int a = 0; a < 2; ++a)
#pragma unroll
            for (int b = 0; b < 2; ++b)
#pragma unroll
                for (int m = 0; m < 4; ++m)
#pragma unroll
                    for (int n = 0; n < 2; ++n) acc[a][b][m][n] = (f32x4){0.f, 0.f, 0.f, 0.f};
        cur = nxt; cA = nA; cB = nB; ++ui;
        if constexpr (ALIGN_EPI) { if (wr == 1) PG8_BAR; }
    }
    PG8_WAIT_V(0);
    if constexpr (!ALIGN_EPI) { if (wr == 0) PG8_BAR; }
    PG8_BAR;
#undef PG8_SA
#undef PG8_SB
#undef PG8_STAGE
#undef PG8_LDA
#undef PG8_LDB
#undef PG8_MMA
#undef PG8_WAIT_V
#undef PG8_WAIT_L
#undef PG8_BAR
#undef PG8_SCHED
}
}

constexpr int NWAVES = 8, NTHR = 512;
constexpr int DM = 1024, SEQ = 8192, NB = 2, CTX = 256, TL = NB * SEQ, TC = NB * CTX, TT = TL + TC;
constexpr int FFN = 2752, FFNP = 2816, NWI = 5632, INW = 2432, INWP = 2560, NMOD = 9;
constexpr int ZF = 0, ZQ = 256, ZK = 640, ZV = 768, ZRR = 896, ZRK = 1280, ZRV = 1664, ZW = 2048, ZA = 2176, ZG = 2304;
constexpr int RW = 384;
constexpr float NORM_EPS = 1e-6f, GN_EPS = 64e-5f;

constexpr size_t MiB = 1u << 20;
constexpr size_t WS_CTL = 0, WS_MOD = 1 * MiB, WS_ROPE = 2 * MiB, WS_XC = 4 * MiB, WS_GC = 6 * MiB;
constexpr size_t WS_WI1 = 8 * MiB, WS_WO1 = 19 * MiB, WS_WIN = 25 * MiB, WS_WOUT = 30 * MiB, WS_WI2 = 32 * MiB, WS_WO2 = 43 * MiB;
constexpr size_t WS_H = 49 * MiB;
constexpr size_t WS_ACT = 82 * MiB;
constexpr size_t WS_O = 173 * MiB;
constexpr size_t WS_YD = WS_O, WS_QR = WS_O + 50 * MiB, WS_KR = WS_O + 62 * MiB;
constexpr size_t WS_W2T = WS_MOD + 256 * 1024, WS_A2T = WS_MOD + 512 * 1024, WS_G2T = WS_MOD + 768 * 1024;
constexpr size_t WS_LW = WS_O, WS_IC = WS_O + 25 * MiB;
constexpr size_t WS_GAM32 = 165 * MiB;
constexpr size_t WS_XB = 239 * MiB;
constexpr size_t OUT_FA = 0;
constexpr size_t OUT_SUM = 16 * MiB;
constexpr size_t WS_END = 272 * MiB;

constexpr size_t WS_FT = 7 * MiB;
constexpr size_t FT_W64C = 0, FT_W64S = 8192, FT_W128C = 16384, FT_W128S = 49152, FT_T64C = 81920, FT_T64S = 90112;
constexpr int LDS_BYTES = 147456;
constexpr int MISC_OFF = 146432;

typedef unsigned short bf16;
typedef float f32x4 __attribute__((ext_vector_type(4)));
typedef unsigned v4u __attribute__((ext_vector_type(4)));
typedef unsigned v2u __attribute__((ext_vector_type(2)));
#define LAS __attribute__((address_space(3)))
#define LDS_WAIT() asm volatile("s_waitcnt lgkmcnt(0)" ::: "memory")

__device__ __forceinline__ unsigned f2bf(float f) { unsigned u = __builtin_bit_cast(unsigned, f); return (u + 0x7fffu + ((u >> 16) & 1u)) >> 16; }
__device__ __forceinline__ unsigned pk2(float lo, float hi) { return f2bf(lo) | (f2bf(hi) << 16); }
__device__ __forceinline__ float bf2f(unsigned short u) { return __builtin_bit_cast(float, (unsigned)u << 16); }
__device__ __forceinline__ float bflo(unsigned u) { return __builtin_bit_cast(float, u << 16); }
__device__ __forceinline__ float bfhi(unsigned u) { return __builtin_bit_cast(float, u & 0xffff0000u); }
__device__ __forceinline__ void unpack8(const v4u w, float (&f)[8]) { f[0] = bflo(w.x); f[1] = bfhi(w.x); f[2] = bflo(w.y); f[3] = bfhi(w.y); f[4] = bflo(w.z); f[5] = bfhi(w.z); f[6] = bflo(w.w); f[7] = bfhi(w.w); }
__device__ __forceinline__ float wave_sum(float v) {
#pragma unroll
    for (int o = 1; o < 64; o <<= 1) v += __shfl_xor(v, o);
    return v;
}
__device__ __forceinline__ float wave_max(float v) {
#pragma unroll
    for (int o = 1; o < 64; o <<= 1) v = fmaxf(v, __shfl_xor(v, o));
    return v;
}

struct Args { const float* in[25]; float* out; unsigned char* ws; int ph_lo, ph_hi; };

struct Frame {
    LAS unsigned char* lds;
    int tid, lane, wave, G, bid;
    float* out; unsigned char* ws;
};
enum { I_X = 0, I_C, I_CTX, I_CCTX, I_MODW, I_MODB, I_NORMG, I_F1WI, I_F1WO, I_WIN, I_WOUT, I_SINK, I_CONV, I_W0, I_W2, I_A0, I_A2, I_G2, I_KK, I_KA, I_RK, I_LNG, I_LNB, I_F2WI, I_F2WO };

__device__ __forceinline__ const float* inp(int i) {
    const __attribute__((address_space(4))) char* p = (const __attribute__((address_space(4))) char*)__builtin_amdgcn_kernarg_segment_ptr();
    asm volatile("" : "+s"(p));
    return *(const float* const __attribute__((address_space(4)))*)(p + 8 * i);
}
struct CvtDesc { const float* W; bf16* WT; int ldw, k0, sc, Kd, n0d; bool valid, live; };
__device__ __forceinline__ void cvt_load(const CvtDesc& d, f32x4 (&v)[8], int lane) {
    const int c4 = lane & 7, r8 = lane >> 3;
#pragma unroll
    for (int i = 0; i < 8; ++i) v[i] = (d.live && d.valid) ? *(const f32x4*)(d.W + (size_t)(d.k0 + 8 * i + r8) * d.ldw + d.sc + 4 * c4) : (f32x4){0.f, 0.f, 0.f, 0.f};
}
__device__ __forceinline__ void cvt_finish(const CvtDesc& d, const f32x4 (&v)[8], LAS float* scr, int lane) {
    if (!d.live) return;
    const int c4 = lane & 7, r8 = lane >> 3;
#pragma unroll
    for (int i = 0; i < 8; ++i) *(LAS f32x4*)(scr + (8 * i + r8) * 36 + 4 * c4) = v[i];
    LDS_WAIT(); asm volatile("" ::: "memory");
    const int c = lane & 7;
#pragma unroll
    for (int j = 0; j < 4; ++j) { const int n = (lane >> 3) + 8 * j; const LAS float* s = scr + (8 * c) * 36 + n;
        v4u o; o.x = pk2(s[0 * 36], s[1 * 36]); o.y = pk2(s[2 * 36], s[3 * 36]); o.z = pk2(s[4 * 36], s[5 * 36]); o.w = pk2(s[6 * 36], s[7 * 36]);
        *(v4u*)(d.WT + (size_t)(d.n0d + n) * d.Kd + d.k0 + 8 * c) = o; }
    LDS_WAIT(); asm volatile("" ::: "memory");
}
__device__ __forceinline__ CvtDesc cvt_decode(Frame& F, int li, int set, int it) {
    constexpr int I_WI = 16 * (NWI / 32), I_WO = (FFNP / 64) * 32, I_IN = 16 * (INWP / 32), I_OUT = 16 * 32;
    constexpr int NITEMS = 2 * I_WI + 2 * I_WO + I_IN + I_OUT;
    CvtDesc d{}; d.live = it < NITEMS; if (!d.live) return d;
    int r = it;
    if (set) { const bool inA = r < I_WI || (r >= 2 * I_WI && r < 2 * I_WI + I_WO) || (r >= 2 * I_WI + 2 * I_WO && r < 2 * I_WI + 2 * I_WO + I_IN); if (inA != (set == 1)) { d.live = false; return d; } }
    if (r < 2 * I_WI) { const int f = r / I_WI; r -= f * I_WI; const int nblk = NWI / 32, kb = r / nblk, nb = r % nblk;
        const int n0 = 32 * nb, pn = n0 >> 8, i = n0 & 255; const int j = 128 * pn + (i & 127);
        d.W = (f ? inp(I_F2WI) : inp(I_F1WI)) + (size_t)li * DM * 2 * FFN; d.ldw = 2 * FFN; d.k0 = 64 * kb; d.sc = (i < 128) ? j : FFN + j; d.valid = j < FFN; d.WT = (bf16*)(F.ws + (f ? WS_WI2 : WS_WI1)); d.Kd = DM; d.n0d = n0; return d; }
    r -= 2 * I_WI;
    if (r < 2 * I_WO) { const int f = r / I_WO; r -= f * I_WO; const int kb = r / 32, nb = r % 32;
        d.W = (f ? inp(I_F2WO) : inp(I_F1WO)) + (size_t)li * FFN * DM; d.ldw = DM; d.k0 = 64 * kb; d.sc = 32 * nb; d.valid = 64 * kb < FFN; d.WT = (bf16*)(F.ws + (f ? WS_WO2 : WS_WO1)); d.Kd = FFNP; d.n0d = 32 * nb; return d; }
    r -= 2 * I_WO;
    if (r < I_IN) { const int nblk = INWP / 32, kb = r / nblk, nb = r % nblk;
        d.W = inp(I_WIN) + (size_t)li * DM * INW; d.ldw = INW; d.k0 = 64 * kb; d.sc = 32 * nb; d.valid = 32 * nb < INW; d.WT = (bf16*)(F.ws + WS_WIN); d.Kd = DM; d.n0d = 32 * nb; return d; }
    r -= I_IN;
    { const int kb = r / 32, nb = r % 32;
        d.W = inp(I_WOUT) + (size_t)li * DM * DM; d.ldw = DM; d.k0 = 64 * kb; d.sc = 32 * nb; d.valid = true; d.WT = (bf16*)(F.ws + WS_WOUT); d.Kd = DM; d.n0d = 32 * nb; return d; }
}
__device__ __forceinline__ void convert_weights(Frame& F, int li, int set = 0, int bid0 = 0, int nblk = 0) {
    if (nblk == 0) nblk = F.G;
    if (F.bid < bid0 || F.bid >= bid0 + nblk) return;
    LAS float* scr = (LAS float*)(F.lds + F.wave * 16384);
    const int gw = (F.bid - bid0) * NWAVES + F.wave, NGW = nblk * NWAVES;
    constexpr int NITEMS = 2 * 16 * (NWI / 32) + 2 * (FFNP / 64) * 32 + 16 * (INWP / 32) + 16 * 32;
    for (int it = gw; it < NITEMS; it += 2 * NGW) {
        const CvtDesc d0 = cvt_decode(F, li, set, it), d1 = cvt_decode(F, li, set, it + NGW);
        f32x4 v0[8], v1[8];
        cvt_load(d0, v0, F.lane); cvt_load(d1, v1, F.lane);
        cvt_finish(d0, v0, scr, F.lane); cvt_finish(d1, v1, scr, F.lane);
    }
}
__device__ __forceinline__ void mod_gemv(Frame& F) {
    LAS float* sc = (LAS float*)F.lds;
    LAS float* red = sc + 3 * 1024;
    __syncthreads();
    for (int i = F.tid; i < 3 * 1024; i += NTHR) { const int v = i >> 10, k = i & 1023; const float x = v < 2 ? inp(I_C)[v * 1024 + k] : inp(I_CCTX)[k]; sc[i] = x / (1.0f + __expf(-x)); }
    __syncthreads();
    float* modv = (float*)(F.ws + WS_MOD);
    for (int u = F.bid; u < 2 * 72; u += F.G) {
        const int l = u / 72, n0 = (u % 72) * 128;
        const float* w = inp(I_MODW) + (size_t)l * DM * 9216 + n0 + 2 * F.lane;
        float a0 = 0.f, a1 = 0.f, b0 = 0.f, b1 = 0.f, c0 = 0.f, c1 = 0.f;
        const int k0 = F.wave * 128;
#pragma unroll 8
        for (int k = 0; k < 128; ++k) { const float2 wv = *(const float2*)(w + (size_t)(k0 + k) * 9216); const float s0 = sc[k0 + k], s1 = sc[1024 + k0 + k], s2 = sc[2048 + k0 + k];
            a0 += s0 * wv.x; a1 += s0 * wv.y; b0 += s1 * wv.x; b1 += s1 * wv.y; c0 += s2 * wv.x; c1 += s2 * wv.y; }
        LAS float* rw = red + F.wave * 384 + 2 * F.lane;
        rw[0] = a0; rw[1] = a1; rw[128] = b0; rw[129] = b1; rw[256] = c0; rw[257] = c1;
        __syncthreads();
        if (F.tid < 384) { float s = 0.f;
#pragma unroll
            for (int w8 = 0; w8 < 8; ++w8) s += red[w8 * 384 + F.tid];
            const int v = F.tid >> 7, n = n0 + (F.tid & 127);
            modv[(size_t)(l * 3 + v) * 9216 + n] = s + inp(I_MODB)[l * 9216 + n]; }
        __syncthreads();
    }
}
__device__ __forceinline__ void rope_tables(Frame& F) {
    float* ct = (float*)(F.ws + WS_ROPE); float* st = ct + SEQ * 32;
    for (int i = F.bid * NTHR + F.tid; i < SEQ * 32; i += F.G * NTHR) {
        const int t = i >> 5, j = i & 31; const int f = j & 15;
        const float inv = exp2f(-(float)f * (13.287712379549449f / 16.0f));
        const float pos = (float)(j < 16 ? (t >> 6) : (t & 63));
        const float ang = pos * inv;
        const double a = (double)ang; const double k = __builtin_rint(a * 0.15915494309189535); const float r = (float)(a - k * 6.283185307179586);
        ct[i] = __cosf(r); st[i] = __sinf(r);
    }
}

struct EArgs { const float* xl_src; const float* xc_src; const bf16* xb_src; bf16* xb_dst; float* out32; const bf16* o; const float* modv_g; int gidx; float gmul; const float* gpost;
               bf16* hdst; const float* modv_h; int shidx, scidx; const float* gpre; int nrows; };
template <int R>
__device__ __forceinline__ void e_rows(Frame& F, const EArgs& A, int v, int r0) {
    f32x4 cg[4], ch[4], cs[4];
#pragma unroll
    for (int j = 0; j < 4; ++j) { const int c = F.lane + 64 * j;
        if (A.o) cg[j] = ((const f32x4*)(A.modv_g + (size_t)v * 9216 + A.gidx * DM))[c] * ((const f32x4*)A.gpost)[c] * A.gmul;
        if (A.hdst) { ch[j] = ((const f32x4*)A.gpre)[c] * (1.0f + ((const f32x4*)(A.modv_h + (size_t)v * 9216 + A.scidx * DM))[c]); cs[j] = ((const f32x4*)(A.modv_h + (size_t)v * 9216 + A.shidx * DM))[c]; } }
    f32x4 x[R][4]; v2u ow[R][4];
#pragma unroll
    for (int i = 0; i < R; ++i) { const int r = r0 + i;
        if (A.xb_src) { const v2u* xs = (const v2u*)(A.xb_src + (size_t)r * DM);
#pragma unroll
            for (int j = 0; j < 4; ++j) { const v2u w = xs[F.lane + 64 * j]; x[i][j] = (f32x4){bflo(w.x), bfhi(w.x), bflo(w.y), bfhi(w.y)}; } }
        else { const float* xs = r < TL ? A.xl_src + (size_t)r * DM : A.xc_src + (size_t)(r - TL) * DM;
#pragma unroll
            for (int j = 0; j < 4; ++j) x[i][j] = ((const f32x4*)xs)[F.lane + 64 * j]; }
        if (A.o) { const v2u* orow = (const v2u*)(A.o + (size_t)r * DM);
#pragma unroll
            for (int j = 0; j < 4; ++j) ow[i][j] = orow[F.lane + 64 * j]; } }
#pragma unroll
    for (int i = 0; i < R; ++i) { const int r = r0 + i;
        if (A.o) { f32x4 ov[4]; float ss = 0.f;
#pragma unroll
            for (int j = 0; j < 4; ++j) { const v2u w = ow[i][j]; ov[j] = (f32x4){bflo(w.x), bfhi(w.x), bflo(w.y), bfhi(w.y)}; ss += (ov[j].x * ov[j].x + ov[j].y * ov[j].y) + (ov[j].z * ov[j].z + ov[j].w * ov[j].w); }
            const float rstd = 1.0f / sqrtf(wave_sum(ss) * (1.0f / DM) + NORM_EPS);
#pragma unroll
            for (int j = 0; j < 4; ++j) x[i][j] = x[i][j] + cg[j] * (ov[j] * rstd);
            if (A.out32) {
#pragma unroll
                for (int j = 0; j < 4; ++j) ((f32x4*)(A.out32 + (size_t)r * DM))[F.lane + 64 * j] = x[i][j]; }
            else { v2u* xd = (v2u*)(A.xb_dst + (size_t)r * DM);
#pragma unroll
                for (int j = 0; j < 4; ++j) { v2u w; w.x = pk2(x[i][j].x, x[i][j].y); w.y = pk2(x[i][j].z, x[i][j].w); xd[F.lane + 64 * j] = w; } } }
        if (A.hdst) { float ss = 0.f;
#pragma unroll
            for (int j = 0; j < 4; ++j) ss += (x[i][j].x * x[i][j].x + x[i][j].y * x[i][j].y) + (x[i][j].z * x[i][j].z + x[i][j].w * x[i][j].w);
            const float rstd = 1.0f / sqrtf(wave_sum(ss) * (1.0f / DM) + NORM_EPS);
            v2u* hd = (v2u*)(A.hdst + (size_t)r * DM);
#pragma unroll
            for (int j = 0; j < 4; ++j) { const f32x4 hv = (x[i][j] * rstd) * ch[j] + cs[j]; v2u w; w.x = pk2(hv.x, hv.y); w.y = pk2(hv.z, hv.w); hd[F.lane + 64 * j] = w; } } }
}
__device__ __forceinline__ void e_phase(Frame& F, const EArgs& A) {
    const int gw = F.bid * NWAVES + F.wave, NGW = F.G * NWAVES;
    if (NGW == 2048) {
        const int b = gw >> 10, r0 = b * SEQ + (gw & 1023) * 8;
        e_rows<4>(F, A, b, r0); e_rows<4>(F, A, b, r0 + 4);
        if (A.nrows > TL && (gw & 3) == 0) e_rows<1>(F, A, 2, TL + (gw >> 2));
    } else { for (int r = gw; r < A.nrows; r += NGW) e_rows<1>(F, A, r < TL ? (r >> 13) : 2, r); }
}

__device__ __forceinline__ const bf16* zrow(const Frame& F, int row) { return (const bf16*)(F.ws + WS_ACT) + (size_t)row * INWP; }

__device__ __forceinline__ void rope_all(Frame& F) {
    const float* ct = (const float*)(F.ws + WS_ROPE); const float* st = ct + SEQ * 32;
    bf16* qr = (bf16*)(F.ws + WS_QR); bf16* kr = (bf16*)(F.ws + WS_KR);
    for (int i = F.bid * NTHR + F.tid; i < TL * 32; i += F.G * NTHR) {
        const int o = i & 3, hh = (i >> 2) & 7, tok = i >> 5; const int s = tok & (SEQ - 1);
        const bf16* z = zrow(F, tok) + (hh < 6 ? ZQ + 64 * hh : ZK + 64 * (hh - 6)) + 8 * o;
        float x1[8], x2[8]; unpack8(*(const v4u*)z, x1); unpack8(*(const v4u*)(z + 32), x2);
        const f32x4 c0 = *(const f32x4*)(ct + s * 32 + 8 * o), c1 = *(const f32x4*)(ct + s * 32 + 8 * o + 4), s0 = *(const f32x4*)(st + s * 32 + 8 * o), s1 = *(const f32x4*)(st + s * 32 + 8 * o + 4);
        const float sc = hh < 6 ? 0.125f : 1.0f; float o1[8], o2[8];
#pragma unroll
        for (int e = 0; e < 4; ++e) { o1[e] = (x1[e] * c0[e] - x2[e] * s0[e]) * sc; o2[e] = (x2[e] * c0[e] + x1[e] * s0[e]) * sc; o1[e + 4] = (x1[e + 4] * c1[e] - x2[e + 4] * s1[e]) * sc; o2[e + 4] = (x2[e + 4] * c1[e] + x1[e + 4] * s1[e]) * sc; }
        bf16* d = hh < 6 ? qr + (size_t)tok * 384 + 64 * hh + 8 * o : kr + (size_t)tok * 128 + 64 * (hh - 6) + 8 * o;
        *(v4u*)d = (v4u){pk2(o1[0], o1[1]), pk2(o1[2], o1[3]), pk2(o1[4], o1[5]), pk2(o1[6], o1[7])};
        *(v4u*)(d + 32) = (v4u){pk2(o2[0], o2[1]), pk2(o2[2], o2[3]), pk2(o2[4], o2[5]), pk2(o2[6], o2[7])}; }
}
__device__ __forceinline__ void fourier_ctx1_all(Frame& F) {
    float* gr = (float*)(F.ws + WS_GC); float* gi = gr + TC * 256;
    const bf16* wc = (const bf16*)(F.ws + WS_FT + FT_W64C); const bf16* wsn = (const bf16*)(F.ws + WS_FT + FT_W64S);
    for (int i = F.bid * NTHR + F.tid; i < TC * 256; i += F.G * NTHR) { const int tok = i >> 8, gm = i & 255, g = gm >> 6, m = gm & 63;
        const bf16* z = zrow(F, TL + tok) + ZF + 64 * g; float sr = 0.f, si = 0.f;
#pragma unroll
        for (int c8 = 0; c8 < 8; ++c8) { float x[8], cs[8], sn[8]; unpack8(*(const v4u*)(z + 8 * c8), x); unpack8(*(const v4u*)(wc + m * 64 + 8 * c8), cs); unpack8(*(const v4u*)(wsn + m * 64 + 8 * c8), sn);
#pragma unroll
            for (int e = 0; e < 8; ++e) { sr += x[e] * cs[e]; si -= x[e] * sn[e]; } }
        gr[i] = sr; gi[i] = si; }
}
__device__ __forceinline__ void fourier_ctx2_all(Frame& F) {
    const float* gr = (const float*)(F.ws + WS_GC); const float* gi = gr + TC * 256; bf16* mix = (bf16*)(F.ws + WS_H);
    for (int i = F.bid * NTHR + F.tid; i < TC * 256; i += F.G * NTHR) { const int row = i >> 8, gm = i & 255, b = row >> 8, k = row & 255; float y = 0.f;
#pragma unroll 8
        for (int n = 0; n < 256; ++n) { const float a = (float)((k * n) & 255) * (1.0f / 256.0f); y += gr[(b * 256 + n) * 256 + gm] * __builtin_amdgcn_cosf(a) + gi[(b * 256 + n) * 256 + gm] * __builtin_amdgcn_sinf(a); }
        mix[(size_t)(TL + row) * DM + gm] = (bf16)f2bf(y * 0.0078125f); }
}
typedef short bf16x8 __attribute__((ext_vector_type(8)));
#define MFMA16(a, b, c) __builtin_amdgcn_mfma_f32_16x16x32_bf16(a, b, c, 0, 0, 0)
__device__ __forceinline__ bf16x8 mk8(unsigned a, unsigned b, unsigned c, unsigned d) { const v4u v = {a, b, c, d}; return __builtin_bit_cast(bf16x8, v); }
typedef __bf16 bf16x2_t __attribute__((ext_vector_type(2)));
typedef float f32x2_t __attribute__((ext_vector_type(2)));
__device__ __forceinline__ unsigned cvtpk(float lo, float hi) { const f32x2_t f = {lo, hi}; return __builtin_bit_cast(unsigned, __builtin_convertvector(f, bf16x2_t)); }
constexpr int NSC = 66;
constexpr int IM_AI = 0, IM_RI = 4608, IM_BI = 9216, IM_KI = 13824, IM_BKT = 18432, IM_VT = 28672, IM_GAM = 33792, IMG_BYTES = 34816;
constexpr int L_IMG0 = 0, L_IMG1 = IMG_BYTES, L_PKG = 2 * IMG_BYTES, L_YL = L_PKG + 8192, L_VB = L_YL + 128 * 68 * 4, L_BON = L_VB + 128 * 64 * 2, L_CST = L_BON + 512, L_RW_END = L_CST + 2 * 3072;
static_assert(L_RW_END <= 146432, "rwkv LDS map");
constexpr size_t SUM_SLOT = 24576;

__device__ __forceinline__ void lora_transposes(Frame& F) {
    bf16* w2t = (bf16*)(F.ws + WS_W2T); bf16* a2t = (bf16*)(F.ws + WS_A2T); bf16* g2t = (bf16*)(F.ws + WS_G2T);
    const float* w2 = inp(I_W2); const float* a2 = inp(I_A2); const float* g2 = inp(I_G2);
    for (int i = F.bid * NTHR + F.tid; i < 4 * 384 * 64; i += F.G * NTHR) { const int r = i & 63, col = (i >> 6) % 384, ld = i / (384 * 64);
        w2t[i] = (bf16)f2bf(w2[((size_t)ld * 64 + r) * RW + col]); a2t[i] = (bf16)f2bf(a2[((size_t)ld * 64 + r) * RW + col]); }
    for (int i = F.bid * NTHR + F.tid; i < 2 * 384 * 128; i += F.G * NTHR) { const int r = i & 127, col = (i >> 7) % 384, l = i / (384 * 128);
        g2t[i] = (bf16)f2bf(g2[((size_t)l * 128 + r) * RW + col]); }
}

__device__ __forceinline__ float softplus_fast(float x) { return fmaxf(x, 0.f) + __logf(1.0f + __expf(-fabsf(x))); }
__device__ __forceinline__ float tanh_fast(float x) { return 1.0f - 2.0f * __builtin_amdgcn_rcpf(1.0f + __expf(2.0f * x)); }
template <int CTRL> __device__ __forceinline__ float dpp_f(float v) { return __builtin_bit_cast(float, __builtin_amdgcn_update_dpp(0, __builtin_bit_cast(int, v), CTRL, 0xf, 0xf, true)); }
__device__ __forceinline__ void lora_pass(Frame& F, int li) {
    const int q = F.lane >> 4, c16 = F.lane & 15;
#pragma unroll 1
    for (int dir = 0; dir < 2; ++dir) {
        bf16* LW = (bf16*)(F.ws + WS_LW) + (size_t)dir * TT * RW; bf16* IC = (bf16*)(F.ws + WS_IC) + (size_t)dir * TT * RW;
        const bf16* w2t = (const bf16*)(F.ws + WS_W2T) + (size_t)(li * 2 + dir) * 384 * 64; const bf16* a2t = (const bf16*)(F.ws + WS_A2T) + (size_t)(li * 2 + dir) * 384 * 64;
        bf16x8 aw[3][2], aa[3][2]; f32x4 w0v[3], a0v[3];
#pragma unroll
        for (int cti = 0; cti < 3; ++cti) { const int ct = 3 * F.wave + cti, col = 16 * ct + c16;
#pragma unroll
            for (int k = 0; k < 2; ++k) { aw[cti][k] = *(const bf16x8*)(w2t + (size_t)col * 64 + 32 * k + 8 * q); aa[cti][k] = *(const bf16x8*)(a2t + (size_t)col * 64 + 32 * k + 8 * q); }
            w0v[cti] = *(const f32x4*)(inp(I_W0) + (li * 2 + dir) * RW + 16 * ct + 4 * q); a0v[cti] = *(const f32x4*)(inp(I_A0) + (li * 2 + dir) * RW + 16 * ct + 4 * q); }
#pragma unroll 1
        for (int rt = F.bid; rt < TT / 16; rt += F.G) {
            const bf16* z = zrow(F, 16 * rt + c16);
            bf16x8 bw[2], ba[2];
#pragma unroll
            for (int k = 0; k < 2; ++k) { const v4u zw = *(const v4u*)(z + ZW + 64 * dir + 32 * k + 8 * q); ba[k] = *(const bf16x8*)(z + ZA + 64 * dir + 32 * k + 8 * q);
                bw[k] = mk8(cvtpk(tanh_fast(bflo(zw.x)), tanh_fast(bfhi(zw.x))), cvtpk(tanh_fast(bflo(zw.y)), tanh_fast(bfhi(zw.y))), cvtpk(tanh_fast(bflo(zw.z)), tanh_fast(bfhi(zw.z))), cvtpk(tanh_fast(bflo(zw.w)), tanh_fast(bfhi(zw.w)))); }
#pragma unroll
            for (int cti = 0; cti < 3; ++cti) { const int ct = 3 * F.wave + cti;
                f32x4 dw = {0.f, 0.f, 0.f, 0.f}, da = {0.f, 0.f, 0.f, 0.f};
#pragma unroll
                for (int k = 0; k < 2; ++k) { dw = MFMA16(aw[cti][k], bw[k], dw); da = MFMA16(aa[cti][k], ba[k], da); }
                float lw[4], ic[4];
#pragma unroll
                for (int e = 0; e < 4; ++e) { const float x = w0v[cti][e] + dw[e]; const float wl = -softplus_fast(-x) - 0.5f; lw[e] = -__expf(wl); ic[e] = __builtin_amdgcn_rcpf(1.0f + __expf(-(a0v[cti][e] + da[e]))); }
                if (dir == 0) {
#pragma unroll
                    for (int e = 0; e < 4; ++e) { lw[e] += dpp_f<0x111>(lw[e]); lw[e] += dpp_f<0x112>(lw[e]); lw[e] += dpp_f<0x114>(lw[e]); lw[e] += dpp_f<0x118>(lw[e]); } }
                else {
#pragma unroll
                    for (int e = 0; e < 4; ++e) { lw[e] += dpp_f<0x101>(lw[e]); lw[e] += dpp_f<0x102>(lw[e]); lw[e] += dpp_f<0x104>(lw[e]); lw[e] += dpp_f<0x108>(lw[e]); } }
#pragma unroll
                for (int e = 0; e < 4; ++e) lw[e] = __expf(lw[e]);
                if (c16 == (dir == 0 ? 15 : 0)) *(f32x4*)((float*)(F.ws + WS_GAM32) + ((size_t)dir * (TT / 16) + rt) * RW + 16 * ct + 4 * q) = (f32x4){lw[0], lw[1], lw[2], lw[3]};
                const size_t o = (size_t)(16 * rt + c16) * RW + 16 * ct + 4 * q;
                v2u w; w.x = cvtpk(lw[0], lw[1]); w.y = cvtpk(lw[2], lw[3]); *(v2u*)(LW + o) = w; w.x = cvtpk(ic[0], ic[1]); w.y = cvtpk(ic[2], ic[3]); *(v2u*)(IC + o) = w; }
        }
    }
}
__device__ __forceinline__ void chain_consts_lds(Frame& F, LAS float* cst, int li, int h, int t256) {
    for (int i = t256; i < 12 * 64; i += 256) { const int k = i >> 6, j = i & 63, ch = 64 * h + j; float v;
        if (k == 0) v = inp(I_KK)[li * RW + ch]; else if (k == 1) v = inp(I_KA)[li * RW + ch]; else if (k == 2) v = inp(I_RK)[li * RW + ch];
        else { const int tt = (k - 3) / 3, w = (k - 3) % 3; v = inp(I_CONV)[(size_t)(li * 3 + tt) * (3 * RW) + w * RW + ch]; }
        cst[i] = v; }
}
struct PrepRaw { v4u ecw, icv, epw, zr[3], zk[3], zv[3]; };
__device__ __forceinline__ void prep_load(Frame& F, PrepRaw& R, int dir, int b, int h, int tl, int o, bool isctx, int step0) {
    const int L = isctx ? CTX : SEQ, rbase = isctx ? TL + b * CTX : b * SEQ, ch0 = 64 * h + 8 * o;
    const int s = step0 + tl; const int p = dir ? L - 1 - s : s; const int row = rbase + p, tb = tl & 15;
    { const bf16* LW = (const bf16*)(F.ws + WS_LW) + (size_t)dir * TT * RW + ch0; const bf16* IC = (const bf16*)(F.ws + WS_IC) + (size_t)dir * TT * RW + ch0;
      R.ecw = *(const v4u*)(LW + (size_t)row * RW); R.icv = *(const v4u*)(IC + (size_t)row * RW); R.epw = *(const v4u*)(LW + (size_t)(tb == 0 ? row : (dir ? row + 1 : row - 1)) * RW); }
#pragma unroll
    for (int tt = 0; tt < 3; ++tt) { const int pp = p + tt - 1; const bool ok = pp >= 0 && pp < L; const bf16* z = zrow(F, rbase + (ok ? pp : p)) + ch0;
        const v4u z0 = {0u, 0u, 0u, 0u};
        R.zr[tt] = ok ? *(const v4u*)(z + ZRR) : z0; R.zk[tt] = ok ? *(const v4u*)(z + ZRK) : z0; R.zv[tt] = ok ? *(const v4u*)(z + ZRV) : z0; }
}
__device__ __forceinline__ void prep_compute(Frame& F, const PrepRaw& R, const LAS float* cst, LAS unsigned char* img, int dir, int b, int h, int tl, int o, bool isctx, int step0, LAS unsigned char* lds_vb, LAS float* lds_bon, int pos0_local) {
    const bool BONUS = lds_vb != nullptr;
    const int L = isctx ? CTX : SEQ, rbase = isctx ? TL + b * CTX : b * SEQ, ch0 = 64 * h + 8 * o;
    const int blk = tl >> 4, tb = tl & 15;
    const int s = step0 + tl; const int p = dir ? L - 1 - s : s; const int row = rbase + p;
    const v4u ecw = R.ecw, icv = R.icv, epw = R.epw;
    v4u zr[3], zk[3], zv[3];
#pragma unroll
    for (int tt = 0; tt < 3; ++tt) { zr[tt] = R.zr[tt]; zk[tt] = R.zk[tt]; zv[tt] = R.zv[tt]; }
    float ecf[8], epf[8], ai[8], rv[8], kv[8], vv[8];
    unpack8(ecw, ecf); unpack8(epw, epf); unpack8(icv, ai);
#pragma unroll
    for (int e = 0; e < 8; ++e) { rv[e] = 0.f; kv[e] = 0.f; vv[e] = 0.f; }
#pragma unroll
    for (int tt = 0; tt < 3; ++tt) { float a[8], bq[8], cq[8]; unpack8(zr[tt], a); unpack8(zk[tt], bq); unpack8(zv[tt], cq);
        const LAS f32x4* w0 = (const LAS f32x4*)(cst + (3 + tt * 3 + 0) * 64 + 8 * o); const LAS f32x4* w1 = (const LAS f32x4*)(cst + (3 + tt * 3 + 1) * 64 + 8 * o); const LAS f32x4* w2 = (const LAS f32x4*)(cst + (3 + tt * 3 + 2) * 64 + 8 * o);
        const f32x4 w0a = w0[0], w0b = w0[1], w1a = w1[0], w1b = w1[1], w2a = w2[0], w2b = w2[1];
#pragma unroll
        for (int e = 0; e < 4; ++e) { rv[e] += w0a[e] * a[e]; rv[e + 4] += w0b[e] * a[e + 4]; kv[e] += w1a[e] * bq[e]; kv[e + 4] += w1b[e] * bq[e + 4]; vv[e] += w2a[e] * cq[e]; vv[e + 4] += w2b[e] * cq[e + 4]; } }
    float kkw[8], kaw[8];
    { const LAS f32x4* a = (const LAS f32x4*)(cst + 0 * 64 + 8 * o); const LAS f32x4* bq = (const LAS f32x4*)(cst + 1 * 64 + 8 * o); const f32x4 a0 = a[0], a1 = a[1], b0 = bq[0], b1 = bq[1];
#pragma unroll
      for (int e = 0; e < 4; ++e) { kkw[e] = a0[e]; kkw[e + 4] = a1[e]; kaw[e] = b0[e]; kaw[e + 4] = b1[e]; } }
    float kkr[8], ss = 0.f;
#pragma unroll
    for (int e = 0; e < 8; ++e) { kkr[e] = kv[e] * kkw[e]; ss += kkr[e] * kkr[e]; }
    ss += __shfl_xor(ss, 1); ss += __shfl_xor(ss, 2); ss += __shfl_xor(ss, 4);
    const float rn = 1.0f / sqrtf(fmaxf(ss, 1e-24f));
    float At[8], Rt[8], Bt[8], Kt[8];
#pragma unroll
    for (int e = 0; e < 8; ++e) { const float kk = kkr[e] * rn, kd = kv[e] * (1.0f + (ai[e] - 1.0f) * kaw[e]); const float eprev = tb == 0 ? 1.0f : epf[e]; const float ec = ecf[e], en = 1.0f / ec;
        At[e] = -kk * eprev; Rt[e] = rv[e] * ec; Bt[e] = kk * ai[e] * en; Kt[e] = kd * en; }
    const int P0 = 32 * (o >> 2) + 16 * (o & 1) + 4 * ((o >> 1) & 1);
    LAS bf16* AI = (LAS bf16*)(img + IM_AI) + blk * 1152 + tb * 72 + P0, *RI = (LAS bf16*)(img + IM_RI) + blk * 1152 + tb * 72 + P0, *BI = (LAS bf16*)(img + IM_BI) + blk * 1152 + tb * 72 + P0, *KI = (LAS bf16*)(img + IM_KI) + blk * 1152 + tb * 72 + P0;
    unsigned bp[4], kp[4];
#pragma unroll
    for (int e = 0; e < 4; ++e) { bp[e] = cvtpk(Bt[2 * e], Bt[2 * e + 1]); kp[e] = cvtpk(Kt[2 * e], Kt[2 * e + 1]); }
    *(LAS v2u*)AI = (v2u){cvtpk(At[0], At[1]), cvtpk(At[2], At[3])}; *(LAS v2u*)(AI + 8) = (v2u){cvtpk(At[4], At[5]), cvtpk(At[6], At[7])};
    *(LAS v2u*)RI = (v2u){cvtpk(Rt[0], Rt[1]), cvtpk(Rt[2], Rt[3])}; *(LAS v2u*)(RI + 8) = (v2u){cvtpk(Rt[4], Rt[5]), cvtpk(Rt[6], Rt[7])};
    *(LAS v2u*)BI = (v2u){bp[0], bp[1]}; *(LAS v2u*)(BI + 8) = (v2u){bp[2], bp[3]};
    *(LAS v2u*)KI = (v2u){kp[0], kp[1]}; *(LAS v2u*)(KI + 8) = (v2u){kp[2], kp[3]};
    LAS bf16* BKT = (LAS bf16*)(img + IM_BKT) + blk * 2560 + (8 * o) * 40 + (tb >> 2) * 8 + (tb & 3); LAS bf16* VT = (LAS bf16*)(img + IM_VT) + blk * 1280 + (8 * o) * 20 + tb;
    const unsigned vp[4] = {cvtpk(vv[0], vv[1]), cvtpk(vv[2], vv[3]), cvtpk(vv[4], vv[5]), cvtpk(vv[6], vv[7])};
#pragma unroll
    for (int e = 0; e < 8; ++e) { const unsigned bb = bp[e >> 1], kq = kp[e >> 1], vq = vp[e >> 1];
        BKT[e * 40] = (bf16)((e & 1) ? (bb >> 16) : (bb & 0xffff)); BKT[e * 40 + 4] = (bf16)((e & 1) ? (kq >> 16) : (kq & 0xffff)); VT[e * 20] = (bf16)((e & 1) ? (vq >> 16) : (vq & 0xffff)); }
    if (tb == 15) { const f32x4* gs = (const f32x4*)((const float*)(F.ws + WS_GAM32) + ((size_t)dir * (TT / 16) + (row >> 4)) * RW + ch0); LAS f32x4* G = (LAS f32x4*)((LAS float*)(img + IM_GAM) + blk * 64 + 8 * o); G[0] = gs[0]; G[1] = gs[1]; }
    if (BONUS) { float bs = 0.f; const LAS f32x4* rk = (const LAS f32x4*)(cst + 2 * 64 + 8 * o); const f32x4 r0 = rk[0], r1 = rk[1];
#pragma unroll
        for (int e = 0; e < 4; ++e) bs += rv[e] * kv[e] * r0[e] + rv[e + 4] * kv[e + 4] * r1[e];
        bs += __shfl_xor(bs, 1); bs += __shfl_xor(bs, 2); bs += __shfl_xor(bs, 4);
        const int pl = dir ? pos0_local - tl : pos0_local + tl;
        *(LAS v4u*)(lds_vb + (pl * 64 + 8 * o) * 2) = (v4u){vp[0], vp[1], vp[2], vp[3]}; if (o == 0) lds_bon[pl] = bs; }
}
template <bool WANT_Y>
__device__ __forceinline__ void block_package(LAS unsigned char* img, int blk, LAS unsigned* pkg, int lane) {
    const int q = lane >> 4, c = lane & 15;
    f32x4 mab = {0.f, 0.f, 0.f, 0.f}, mak = mab, mbr = mab, mkr = mab;
#pragma unroll
    for (int k = 0; k < 2; ++k) { const int o = blk * 2304 + c * 144 + k * 64 + q * 16;
        const bf16x8 bi = *(const LAS bf16x8*)(img + IM_BI + o), ki = *(const LAS bf16x8*)(img + IM_KI + o), ai = *(const LAS bf16x8*)(img + IM_AI + o);
        mab = MFMA16(bi, ai, mab); mak = MFMA16(ki, ai, mak);
        if constexpr (WANT_Y) { const bf16x8 ri = *(const LAS bf16x8*)(img + IM_RI + o); mbr = MFMA16(bi, ri, mbr); mkr = MFMA16(ki, ri, mkr); } }
#pragma unroll
    for (int e = 0; e < 4; ++e) { const int s = 4 * q + e; if (!(s < c)) { mab[e] = 0.f; mak[e] = 0.f; } if (!(s <= c)) { mbr[e] = 0.f; mkr[e] = 0.f; } }
    f32x4 mabT = {0.f, 0.f, 0.f, 0.f};
#pragma unroll
    for (int k = 0; k < 2; ++k) { const int o = blk * 2304 + c * 144 + k * 64 + q * 16; mabT = MFMA16(*(const LAS bf16x8*)(img + IM_AI + o), *(const LAS bf16x8*)(img + IM_BI + o), mabT); }
#pragma unroll
    for (int e = 0; e < 4; ++e) if (!(c < 4 * q + e)) mabT[e] = 0.f;
    const f32x4 z4 = {0.f, 0.f, 0.f, 0.f};
#define OPND(x) mk8(cvtpk((x)[0], (x)[1]), cvtpk((x)[2], (x)[3]), 0u, 0u)
    const bf16x8 oM = OPND(mab), oMT = OPND(mabT);
    const f32x4 m2 = MFMA16(oMT, oM, z4), m2T = MFMA16(oM, oMT, z4);
    const bf16x8 oM2 = OPND(m2), oM2T = OPND(m2T);
    const f32x4 m4 = MFMA16(oM2T, oM2, z4), m4T = MFMA16(oM2, oM2T, z4);
    const f32x4 m8T = MFMA16(OPND(m4), OPND(m4T), z4);
    f32x4 nn = m2;
#pragma unroll
    for (int e = 0; e < 4; ++e) nn[e] += (4 * q + e == c) ? 1.0f : 0.0f;
    nn = MFMA16(oMT, OPND(nn), nn);
    nn = MFMA16(OPND(m4T), OPND(nn), nn);
    nn = MFMA16(OPND(m8T), OPND(nn), nn);
#undef OPND
    pkg[0 * 64 + lane] = cvtpk(nn[0], nn[1]); pkg[1 * 64 + lane] = cvtpk(nn[2], nn[3]);
    pkg[2 * 64 + lane] = cvtpk(mak[0], mak[1]); pkg[3 * 64 + lane] = cvtpk(mak[2], mak[3]);
    if constexpr (WANT_Y) { pkg[4 * 64 + lane] = cvtpk(mbr[0], mbr[1]); pkg[5 * 64 + lane] = cvtpk(mbr[2], mbr[3]); pkg[6 * 64 + lane] = cvtpk(mkr[0], mkr[1]); pkg[7 * 64 + lane] = cvtpk(mkr[2], mkr[3]); }
}
template <bool WANT_Y, bool HAS_V>
__device__ __forceinline__ f32x4 block_scan(LAS unsigned char* img, int blk, const LAS unsigned* pkg, f32x4 (&S)[4], int wq, int lane) {
    const int q = lane >> 4, c = lane & 15;
    bf16x8 Sb[2];
#pragma unroll
    for (int k = 0; k < 2; ++k) Sb[k] = mk8(cvtpk(S[2 * k][0], S[2 * k][1]), cvtpk(S[2 * k][2], S[2 * k][3]), cvtpk(S[2 * k + 1][0], S[2 * k + 1][1]), cvtpk(S[2 * k + 1][2], S[2 * k + 1][3]));
    v2u vpk = {0u, 0u};
    if constexpr (HAS_V) vpk = *(const LAS v2u*)(img + IM_VT + blk * 2560 + (c + 16 * wq) * 40 + q * 8);
    const int ao = blk * 2304 + c * 144 + q * 16;
    f32x4 rhs = {0.f, 0.f, 0.f, 0.f};
    rhs = MFMA16(*(const LAS bf16x8*)(img + IM_AI + ao), Sb[0], rhs); rhs = MFMA16(*(const LAS bf16x8*)(img + IM_AI + ao + 64), Sb[1], rhs);
    if constexpr (HAS_V) rhs = MFMA16(mk8(0u, 0u, pkg[2 * 64 + lane], pkg[3 * 64 + lane]), mk8(0u, 0u, vpk.x, vpk.y), rhs);
    f32x4 u = {0.f, 0.f, 0.f, 0.f};
    u = MFMA16(mk8(pkg[0 * 64 + lane], pkg[1 * 64 + lane], 0u, 0u), mk8(cvtpk(rhs[0], rhs[1]), cvtpk(rhs[2], rhs[3]), 0u, 0u), u);
    const bf16x8 UV = mk8(cvtpk(u[0], u[1]), cvtpk(u[2], u[3]), vpk.x, vpk.y);
    f32x4 y = {0.f, 0.f, 0.f, 0.f};
    if constexpr (WANT_Y) { y = MFMA16(*(const LAS bf16x8*)(img + IM_RI + ao), Sb[0], y); y = MFMA16(*(const LAS bf16x8*)(img + IM_RI + ao + 64), Sb[1], y);
        y = MFMA16(mk8(pkg[4 * 64 + lane], pkg[5 * 64 + lane], pkg[6 * 64 + lane], pkg[7 * 64 + lane]), UV, y); }
#pragma unroll
    for (int T = 0; T < 4; ++T) { const bf16x8 bkt = *(const LAS bf16x8*)(img + IM_BKT + blk * 5120 + (16 * T + c) * 80 + q * 16);
        S[T] = MFMA16(bkt, UV, S[T]); const f32x4 g = *(const LAS f32x4*)(img + IM_GAM + blk * 256 + (16 * T + 4 * q) * 4); S[T] = S[T] * g; }
    return y;
}
__device__ __forceinline__ unsigned char* sum_slot(Frame& F, int chain, int sc) { return (unsigned char*)F.out + OUT_SUM + (size_t)(chain * NSC + sc) * SUM_SLOT; }

__device__ __forceinline__ void rwkv_pass1_pair(Frame& F, int li, int pair) {
    const int g = F.wave >> 2, wq = F.wave & 3, u = 2 * pair + g;
    const int chain = u / (NSC - 1), sc = u % (NSC - 1);
    const int dir = chain / 12, b = (chain / 6) & 1, h = chain % 6;
    const bool isctx = sc < 2; const int scl = isctx ? sc : sc - 2;
    LAS unsigned char* img = F.lds + (g ? L_IMG1 : L_IMG0); LAS unsigned* pkg = (LAS unsigned*)(F.lds + L_PKG) + g * 1024;
    LAS float* cst = (LAS float*)(F.lds + L_CST) + g * 768;
    __syncthreads();
    chain_consts_lds(F, cst, li, h, F.tid & 255);
    const int q = F.lane >> 4, c = F.lane & 15;
    f32x4 SB[4], SA[4];
#pragma unroll
    for (int T = 0; T < 4; ++T)
#pragma unroll
        for (int e = 0; e < 4; ++e) { SB[T][e] = 0.0f; SA[T][e] = (16 * T + 4 * q + e == c + 16 * wq) ? 1.0f : 0.0f; }
    PrepRaw R;
    prep_load(F, R, dir, b, h, 8 * wq + (F.lane >> 3), F.lane & 7, isctx, 128 * scl);
#pragma unroll 1
    for (int rd = 0; rd < 4; ++rd) {
        __syncthreads();
        prep_compute(F, R, cst, img, dir, b, h, 8 * wq + (F.lane >> 3), F.lane & 7, isctx, 128 * scl + 32 * rd, nullptr, nullptr, 0);
        __syncthreads();
        if (rd < 3) prep_load(F, R, dir, b, h, 8 * wq + (F.lane >> 3), F.lane & 7, isctx, 128 * scl + 32 * (rd + 1));
        if (wq < 2) block_package<false>(img, wq, pkg + wq * 512, F.lane);
        __syncthreads();
#pragma unroll
        for (int blk = 0; blk < 2; ++blk) { block_scan<false, true>(img, blk, pkg + blk * 512, SB, wq, F.lane); block_scan<false, false>(img, blk, pkg + blk * 512, SA, wq, F.lane); }
    }
    unsigned char* slot = sum_slot(F, chain, sc);
    { f32x4* braw = (f32x4*)slot;
#pragma unroll
      for (int T = 0; T < 4; ++T) braw[(wq * 4 + T) * 64 + F.lane] = SB[T]; }
    { bf16* aim = (bf16*)(slot + 16384); const int kap = wq >> 1, e = (F.lane & 3) + 4 * (wq & 1), qc = c >> 2;
#pragma unroll
      for (int T = 0; T < 4; ++T)
#pragma unroll
          for (int r = 0; r < 4; ++r) { const int lc = (4 * q + r) + 16 * qc; aim[((T * 2 + kap) * 64 + lc) * 8 + e] = (bf16)f2bf(SA[T][r]); } }
}
struct P2Buf { f32x4 Bc[4]; bf16x8 af[4][2]; };
__device__ __forceinline__ void p2_load(Frame& F, P2Buf& X, int chain, int sc, int wq) {
    unsigned char* slot = sum_slot(F, chain, sc); const f32x4* braw = (const f32x4*)slot; const bf16* aim = (const bf16*)(slot + 16384);
#pragma unroll
    for (int T = 0; T < 4; ++T) { X.Bc[T] = braw[(wq * 4 + T) * 64 + F.lane];
#pragma unroll
        for (int k = 0; k < 2; ++k) X.af[T][k] = *(const bf16x8*)(aim + ((T * 2 + k) * 64 + F.lane) * 8); }
}
__device__ __forceinline__ void p2_step(Frame& F, const P2Buf& X, f32x4 (&S)[4], int chain, int sc, int wq) {
    f32x4* braw = (f32x4*)sum_slot(F, chain, sc);
    bf16x8 Sb[2];
#pragma unroll
    for (int k = 0; k < 2; ++k) Sb[k] = mk8(cvtpk(S[2 * k][0], S[2 * k][1]), cvtpk(S[2 * k][2], S[2 * k][3]), cvtpk(S[2 * k + 1][0], S[2 * k + 1][1]), cvtpk(S[2 * k + 1][2], S[2 * k + 1][3]));
#pragma unroll
    for (int T = 0; T < 4; ++T) { braw[(wq * 4 + T) * 64 + F.lane] = S[T]; const f32x4 a = MFMA16(X.af[T][0], Sb[0], X.Bc[T]); S[T] = MFMA16(X.af[T][1], Sb[1], a); }
}
__device__ __forceinline__ void rwkv_pass2_chain(Frame& F, int chain) {
    if (F.wave >= 4) return;
    const int wq = F.wave; constexpr int NS = NSC - 1;
    f32x4 S[4];
#pragma unroll
    for (int T = 0; T < 4; ++T) S[T] = (f32x4){0.f, 0.f, 0.f, 0.f};
    P2Buf X0, X1, X2;
    p2_load(F, X0, chain, 0, wq); p2_load(F, X1, chain, 1, wq); p2_load(F, X2, chain, 2, wq);
#pragma unroll 1
    for (int sc = 0; sc < NS; sc += 3) {
        p2_step(F, X0, S, chain, sc, wq); if (sc + 3 < NS) p2_load(F, X0, chain, sc + 3, wq);
        if (sc + 1 < NS) { p2_step(F, X1, S, chain, sc + 1, wq); if (sc + 4 < NS) p2_load(F, X1, chain, sc + 4, wq); }
        if (sc + 2 < NS) { p2_step(F, X2, S, chain, sc + 2, wq); if (sc + 5 < NS) p2_load(F, X2, chain, sc + 5, wq); }
    }
    { f32x4* braw = (f32x4*)sum_slot(F, chain, NSC - 1);
#pragma unroll
      for (int T = 0; T < 4; ++T) braw[(wq * 4 + T) * 64 + F.lane] = S[T]; }
}
__device__ __forceinline__ void rwkv_pass3_unit(Frame& F, int li, int u) {
    const int pc = u % NSC, bh = u / NSC, b = bh / 6, h = bh % 6;
    const bool isctx = pc < 2; const int pcl = isctx ? pc : pc - 2, nsc = isctx ? 2 : 64;
    const int dir = F.wave >> 2, wq = F.wave & 3, q = F.lane >> 4, c = F.lane & 15;
    const int sc = dir == 0 ? pc : (isctx ? 1 - pcl : 2 + 63 - pcl);
    const int scl = dir == 0 ? pcl : nsc - 1 - pcl;
    const int chain = dir * 12 + b * 6 + h;
    LAS unsigned char* img = F.lds + (dir ? L_IMG1 : L_IMG0); LAS unsigned* pkg = (LAS unsigned*)(F.lds + L_PKG) + dir * 1024;
    LAS float* YL = (LAS float*)(F.lds + L_YL); LAS unsigned char* VB = F.lds + L_VB; LAS float* BON = (LAS float*)(F.lds + L_BON);
    LAS float* cst = (LAS float*)(F.lds + L_CST);
    __syncthreads();
    if (F.tid < 256) chain_consts_lds(F, cst, li, h, F.tid);
    f32x4 S[4];
    { const f32x4* braw = (const f32x4*)sum_slot(F, chain, sc);
#pragma unroll
      for (int T = 0; T < 4; ++T) S[T] = braw[(wq * 4 + T) * 64 + F.lane]; }
    __syncthreads();
    for (int i = F.tid; i < 128 * 68; i += NTHR) YL[i] = 0.f;
    PrepRaw R;
    prep_load(F, R, dir, b, h, 8 * wq + (F.lane >> 3), F.lane & 7, isctx, 128 * scl);
#pragma unroll 1
    for (int rd = 0; rd < 4; ++rd) {
        __syncthreads();
        prep_compute(F, R, cst, img, dir, b, h, 8 * wq + (F.lane >> 3), F.lane & 7, isctx, 128 * scl + 32 * rd, dir == 0 ? VB : (LAS unsigned char*)nullptr, BON, 32 * rd);
        __syncthreads();
        if (rd < 3) prep_load(F, R, dir, b, h, 8 * wq + (F.lane >> 3), F.lane & 7, isctx, 128 * scl + 32 * (rd + 1));
        if (wq < 2) block_package<true>(img, wq, pkg + wq * 512, F.lane);
        __syncthreads();
#pragma unroll
        for (int blk = 0; blk < 2; ++blk) { const f32x4 y = block_scan<true, true>(img, blk, pkg + blk * 512, S, wq, F.lane);
#pragma unroll
            for (int e = 0; e < 4; ++e) { const int t = 32 * rd + 16 * blk + 4 * q + e; const int pl = dir ? 127 - t : t; YL[pl * 68 + c + 16 * wq] += y[e]; } }
    }
    __syncthreads();
    const int wv = F.wave; const int rbase = (isctx ? TL + b * CTX : b * SEQ) + 128 * pcl;
    const bf16* g2t = (const bf16*)(F.ws + WS_G2T) + (size_t)li * 384 * 128;
    f32x4 gate[4];
#pragma unroll
    for (int nt = 0; nt < 4; ++nt) gate[nt] = (f32x4){0.f, 0.f, 0.f, 0.f};
#pragma unroll
    for (int k = 0; k < 4; ++k) { const v4u zg = *(const v4u*)(zrow(F, rbase + 16 * wv + c) + ZG + 32 * k + 8 * q);
#define SG(x) (1.0f / (1.0f + __expf(-(x))))
        const bf16x8 a = mk8(pk2(SG(bflo(zg.x)), SG(bfhi(zg.x))), pk2(SG(bflo(zg.y)), SG(bfhi(zg.y))), pk2(SG(bflo(zg.z)), SG(bfhi(zg.z))), pk2(SG(bflo(zg.w)), SG(bfhi(zg.w))));
#undef SG
#pragma unroll
        for (int nt = 0; nt < 4; ++nt) { const bf16x8 bb = *(const bf16x8*)(g2t + (size_t)(64 * h + 16 * nt + c) * 128 + 32 * k + 8 * q); gate[nt] = MFMA16(a, bb, gate[nt]); } }
    bf16* mix = (bf16*)(F.ws + WS_H);
    float lg[4], lb[4];
#pragma unroll
    for (int nt = 0; nt < 4; ++nt) { lg[nt] = inp(I_LNG)[li * RW + 64 * h + 16 * nt + c]; lb[nt] = inp(I_LNB)[li * RW + 64 * h + 16 * nt + c]; }
#pragma unroll
    for (int e = 0; e < 4; ++e) { const int tl = 16 * wv + 4 * q + e;
        float yv[4], s = 0.f;
#pragma unroll
        for (int nt = 0; nt < 4; ++nt) { yv[nt] = YL[tl * 68 + 16 * nt + c]; s += yv[nt]; }
        s += __shfl_xor(s, 1); s += __shfl_xor(s, 2); s += __shfl_xor(s, 4); s += __shfl_xor(s, 8);
        const float mu = s * (1.0f / 64.0f); float v2 = 0.f;
#pragma unroll
        for (int nt = 0; nt < 4; ++nt) { yv[nt] -= mu; v2 += yv[nt] * yv[nt]; }
        v2 += __shfl_xor(v2, 1); v2 += __shfl_xor(v2, 2); v2 += __shfl_xor(v2, 4); v2 += __shfl_xor(v2, 8);
        const float rs = 1.0f / sqrtf(v2 * (1.0f / 64.0f) + GN_EPS); const float bon = BON[tl];
#pragma unroll
        for (int nt = 0; nt < 4; ++nt) { const float vv = bf2f(((const LAS bf16*)VB)[tl * 64 + 16 * nt + c]);
            const float o = (yv[nt] * rs * lg[nt] + lb[nt] + bon * vv) * gate[nt][e];
            mix[(size_t)(rbase + tl) * DM + 640 + 64 * h + 16 * nt + c] = (bf16)f2bf(o); } }
}

constexpr int AT_KROW = 144;
__device__ __forceinline__ void attn_unit(Frame& F, int li, int u) {
    const bool cq = u >= 256;
    int b, kvh, qb;
    if (!cq) { b = u >> 7; kvh = (u >> 6) & 1; qb = u & 63; } else { const int uu = u - 256; b = uu >> 2; kvh = (uu >> 1) & 1; qb = uu & 1; }
    const int c = F.lane & 15, q = F.lane >> 4, tb = F.wave;
    const bf16* qr = (const bf16*)(F.ws + WS_QR); const bf16* kr = (const bf16*)(F.ws + WS_KR); bf16* mix = (bf16*)(F.ws + WS_H);
    const int qrow = (cq ? TL + b * CTX : b * SEQ) + 128 * qb + 16 * tb + c;
    const int qpos = 128 * qb + 16 * tb + c;
    bf16x8 Q[3][2];
#pragma unroll
    for (int hh = 0; hh < 3; ++hh)
#pragma unroll
        for (int k = 0; k < 2; ++k) {
            if (!cq) Q[hh][k] = *(const bf16x8*)(qr + (size_t)qrow * 384 + 64 * (3 * kvh + hh) + 32 * k + 8 * q);
            else { const v4u w = *(const v4u*)(zrow(F, qrow) + ZQ + 64 * (3 * kvh + hh) + 32 * k + 8 * q);
                Q[hh][k] = mk8(pk2(0.125f * bflo(w.x), 0.125f * bfhi(w.x)), pk2(0.125f * bflo(w.y), 0.125f * bfhi(w.y)), pk2(0.125f * bflo(w.z), 0.125f * bfhi(w.z)), pk2(0.125f * bflo(w.w), 0.125f * bfhi(w.w))); } }
    float m[3], l[3]; f32x4 O[3][4];
#pragma unroll
    for (int hh = 0; hh < 3; ++hh) { m[hh] = inp(I_SINK)[li * 6 + 3 * kvh + hh]; l[hh] = q == 0 ? 1.0f : 0.0f;
#pragma unroll
        for (int dt = 0; dt < 4; ++dt) O[hh][dt] = (f32x4){0.f, 0.f, 0.f, 0.f}; }
    LAS unsigned char* KI = F.lds;
#pragma unroll 1
    for (int stage = cq ? 1 : 0; stage < 2; ++stage) {
        const int nkeys = stage == 0 ? 384 : 256; const int vstride = (nkeys + 8) * 2;
        LAS unsigned char* VTI = F.lds + 384 * AT_KROW;
        const int kpos0 = 128 * (qb - 1);
        __syncthreads();
        for (int pc = F.tid; pc < nkeys * 8; pc += NTHR) { const int key = pc >> 3, d8 = pc & 7;
            const bf16* ksrc; const bf16* vsrc;
            if (stage == 0) { int kp = kpos0 + key; kp = kp < 0 ? 0 : (kp >= SEQ ? SEQ - 1 : kp); ksrc = kr + (size_t)(b * SEQ + kp) * 128 + 64 * kvh; vsrc = zrow(F, b * SEQ + kp) + ZV + 64 * kvh; }
            else { const bf16* z = zrow(F, TL + b * CTX + key); ksrc = z + ZK + 64 * kvh; vsrc = z + ZV + 64 * kvh; }
            const v4u kv = *(const v4u*)(ksrc + 8 * d8); const v4u vv = *(const v4u*)(vsrc + 8 * d8);
            *(LAS v4u*)(KI + key * AT_KROW + d8 * 16) = kv;
            const int kl = key & 31; const int col = (key & ~31) | (((kl & 15) >> 2) << 3) | ((kl >> 4) << 2) | (kl & 3);
            LAS bf16* vt = (LAS bf16*)(VTI + (8 * d8) * vstride) + col;
            vt[0] = (bf16)(vv.x & 0xffff); *(LAS bf16*)((LAS unsigned char*)vt + vstride) = (bf16)(vv.x >> 16);
            *(LAS bf16*)((LAS unsigned char*)vt + 2 * vstride) = (bf16)(vv.y & 0xffff); *(LAS bf16*)((LAS unsigned char*)vt + 3 * vstride) = (bf16)(vv.y >> 16);
            *(LAS bf16*)((LAS unsigned char*)vt + 4 * vstride) = (bf16)(vv.z & 0xffff); *(LAS bf16*)((LAS unsigned char*)vt + 5 * vstride) = (bf16)(vv.z >> 16);
            *(LAS bf16*)((LAS unsigned char*)vt + 6 * vstride) = (bf16)(vv.w & 0xffff); *(LAS bf16*)((LAS unsigned char*)vt + 7 * vstride) = (bf16)(vv.w >> 16); }
        __syncthreads();
        const int npair = nkeys / 32;
        const int Q0 = 128 * qb + 16 * tb;
#pragma unroll 1
        for (int kp = 0; kp < npair; ++kp) {
            const int kb = kpos0 + 32 * kp;
            if (stage == 0 && (kb + 31 < Q0 - 128 || kb > Q0 + 143 || kb + 31 < 0 || kb >= SEQ)) continue;
            bf16x8 K[2][2], V[4];
#pragma unroll
            for (int t = 0; t < 2; ++t)
#pragma unroll
                for (int k = 0; k < 2; ++k) K[t][k] = *(const LAS bf16x8*)(KI + (32 * kp + 16 * t + c) * AT_KROW + k * 64 + q * 16);
#pragma unroll
            for (int dt = 0; dt < 4; ++dt) V[dt] = *(const LAS bf16x8*)(VTI + (16 * dt + c) * vstride + kp * 64 + q * 16);
            bool ok0[4], ok1[4];
#pragma unroll
            for (int e = 0; e < 4; ++e) { const int k0 = kb + 4 * q + e, k1 = k0 + 16;
                ok0[e] = stage == 1 || (k0 >= 0 && k0 < SEQ && k0 >= qpos - 128 && k0 <= qpos + 128);
                ok1[e] = stage == 1 || (k1 >= 0 && k1 < SEQ && k1 >= qpos - 128 && k1 <= qpos + 128); }
#pragma unroll
            for (int hh = 0; hh < 3; ++hh) {
                f32x4 s0 = {0.f, 0.f, 0.f, 0.f}, s1 = {0.f, 0.f, 0.f, 0.f};
                s0 = MFMA16(K[0][0], Q[hh][0], s0); s0 = MFMA16(K[0][1], Q[hh][1], s0);
                s1 = MFMA16(K[1][0], Q[hh][0], s1); s1 = MFMA16(K[1][1], Q[hh][1], s1);
                float mx = -INFINITY;
#pragma unroll
                for (int e = 0; e < 4; ++e) { s0[e] = ok0[e] ? s0[e] : -INFINITY; s1[e] = ok1[e] ? s1[e] : -INFINITY; mx = fmaxf(mx, fmaxf(s0[e], s1[e])); }
                mx = fmaxf(mx, __shfl_xor(mx, 16)); mx = fmaxf(mx, __shfl_xor(mx, 32));
                const float mn = fmaxf(m[hh], mx); const float alpha = __expf(m[hh] - mn); m[hh] = mn;
                float ps = 0.f;
#pragma unroll
                for (int e = 0; e < 4; ++e) { s0[e] = __expf(s0[e] - mn); s1[e] = __expf(s1[e] - mn); ps += s0[e] + s1[e]; }
                l[hh] = l[hh] * alpha + ps;
                const bf16x8 P = mk8(cvtpk(s0[0], s0[1]), cvtpk(s0[2], s0[3]), cvtpk(s1[0], s1[1]), cvtpk(s1[2], s1[3]));
#pragma unroll
                for (int dt = 0; dt < 4; ++dt) { O[hh][dt] = O[hh][dt] * alpha; O[hh][dt] = MFMA16(V[dt], P, O[hh][dt]); }
            }
        }
    }
#pragma unroll
    for (int hh = 0; hh < 3; ++hh) { float lt = l[hh]; lt += __shfl_xor(lt, 16); lt += __shfl_xor(lt, 32); const float inv = 1.0f / lt;
#pragma unroll
        for (int dt = 0; dt < 4; ++dt) { v2u w; w.x = pk2(O[hh][dt][0] * inv, O[hh][dt][1] * inv); w.y = pk2(O[hh][dt][2] * inv, O[hh][dt][3] * inv);
            *(v2u*)(mix + (size_t)qrow * DM + 256 + 64 * (3 * kvh + hh) + 16 * dt + 4 * q) = w; } }
}

__device__ __forceinline__ void fourier_tables(Frame& F) {
    bf16* t = (bf16*)(F.ws + WS_FT);
    for (int i = F.bid * NTHR + F.tid; i < 64 * 64; i += F.G * NTHR) { const int r = i >> 6, cc = i & 63; const float a = (float)((r * cc) & 63) * (1.0f / 64.0f);
        const float cs = __builtin_amdgcn_cosf(a), sn = __builtin_amdgcn_sinf(a);
        t[FT_W64C / 2 + i] = (bf16)f2bf(cs); t[FT_W64S / 2 + i] = (bf16)f2bf(sn);
        const int pj = (cc & ~31) | (((cc & 15) >> 2) << 3) | (((cc >> 4) & 1) << 2) | (cc & 3);
        t[FT_T64C / 2 + r * 64 + pj] = (bf16)f2bf(cs); t[FT_T64S / 2 + r * 64 + pj] = (bf16)f2bf(sn); }
    for (int i = F.bid * NTHR + F.tid; i < 128 * 128; i += F.G * NTHR) { const int r = i >> 7, cc = i & 127; const float a = (float)((r * cc) & 127) * (1.0f / 128.0f);
        t[FT_W128C / 2 + i] = (bf16)f2bf(__builtin_amdgcn_cosf(a)); t[FT_W128S / 2 + i] = (bf16)f2bf(__builtin_amdgcn_sinf(a)); }
}
__device__ __forceinline__ void fourier_a_fast(Frame& F, int u) {
    const int b = u >> 7, n2 = u & 127, c = F.lane & 15, q = F.lane >> 4;
    LAS unsigned char* IMG = F.lds;
    __syncthreads();
    for (int pc = F.tid; pc < 64 * 32; pc += NTHR) { const int n1 = pc >> 5, c8 = pc & 31;
        const v4u v = *(const v4u*)(zrow(F, b * SEQ + 128 * n1 + n2) + ZF + 8 * c8);
        LAS bf16* d = (LAS bf16*)(IMG + (8 * c8) * 144) + n1;
        d[0] = (bf16)(v.x & 0xffff); d[72] = (bf16)(v.x >> 16); d[144] = (bf16)(v.y & 0xffff); d[216] = (bf16)(v.y >> 16);
        d[288] = (bf16)(v.z & 0xffff); d[360] = (bf16)(v.z >> 16); d[432] = (bf16)(v.w & 0xffff); d[504] = (bf16)(v.w >> 16); }
    __syncthreads();
    const bf16* wc = (const bf16*)(F.ws + WS_FT + FT_W64C); const bf16* wsn = (const bf16*)(F.ws + WS_FT + FT_W64S);
    bf16* far = (bf16*)((unsigned char*)F.out + OUT_FA); bf16* fai = far + (size_t)NB * 64 * 128 * 256;
    bf16x8 Bc[4][2], Bs[4][2];
#pragma unroll
    for (int kt = 0; kt < 4; ++kt)
#pragma unroll
        for (int k = 0; k < 2; ++k) { Bc[kt][k] = *(const bf16x8*)(wc + (16 * kt + c) * 64 + 32 * k + 8 * q); Bs[kt][k] = *(const bf16x8*)(wsn + (16 * kt + c) * 64 + 32 * k + 8 * q); }
#pragma unroll
    for (int ci = 0; ci < 2; ++ci) { const int ct = 2 * F.wave + ci;
        bf16x8 A[2];
#pragma unroll
        for (int k = 0; k < 2; ++k) A[k] = *(const LAS bf16x8*)(IMG + (16 * ct + c) * 144 + k * 64 + q * 16);
#pragma unroll
        for (int kt = 0; kt < 4; ++kt) { f32x4 sr = {0.f, 0.f, 0.f, 0.f}, si = {0.f, 0.f, 0.f, 0.f};
#pragma unroll
            for (int k = 0; k < 2; ++k) { sr = MFMA16(A[k], Bc[kt][k], sr); si = MFMA16(A[k], Bs[kt][k], si); }
            const int k1 = 16 * kt + c; const float tw = (float)(n2 * k1) * (1.0f / 8192.0f); const float tc = __builtin_amdgcn_cosf(tw), ts = __builtin_amdgcn_sinf(tw);
            float xr[4], xi[4];
#pragma unroll
            for (int e = 0; e < 4; ++e) { const float ar = sr[e], ai = -si[e]; xr[e] = ar * tc + ai * ts; xi[e] = ai * tc - ar * ts; }
            const size_t o = (((size_t)b * 64 + k1) * 128 + n2) * 256 + 16 * ct + 4 * q;
            v2u w; w.x = pk2(xr[0], xr[1]); w.y = pk2(xr[2], xr[3]); *(v2u*)(far + o) = w; w.x = pk2(xi[0], xi[1]); w.y = pk2(xi[2], xi[3]); *(v2u*)(fai + o) = w; } }
}
__device__ __forceinline__ void fourier_c_fast(Frame& F, int u) {
    const int g = u & 3, k1 = (u >> 2) & 63, b = u >> 8, c = F.lane & 15, q = F.lane >> 4;
    LAS unsigned char* IR = F.lds; LAS unsigned char* II = F.lds + 64 * 272;
    const bf16* far = (const bf16*)((unsigned char*)F.out + OUT_FA) + (((size_t)b * 64 + k1) * 128) * 256 + 64 * g; const bf16* fai = far + (size_t)NB * 64 * 128 * 256;
    __syncthreads();
    for (int pc = F.tid; pc < 128 * 8; pc += NTHR) { const int n2 = pc >> 3, c8 = pc & 7;
        const v4u vr = *(const v4u*)(far + (size_t)n2 * 256 + 8 * c8), vi = *(const v4u*)(fai + (size_t)n2 * 256 + 8 * c8);
        LAS bf16* dr = (LAS bf16*)(IR + (8 * c8) * 272) + n2; LAS bf16* di = (LAS bf16*)(II + (8 * c8) * 272) + n2;
        dr[0] = (bf16)(vr.x & 0xffff); dr[136] = (bf16)(vr.x >> 16); dr[272] = (bf16)(vr.y & 0xffff); dr[408] = (bf16)(vr.y >> 16);
        dr[544] = (bf16)(vr.z & 0xffff); dr[680] = (bf16)(vr.z >> 16); dr[816] = (bf16)(vr.w & 0xffff); dr[952] = (bf16)(vr.w >> 16);
        di[0] = (bf16)(vi.x & 0xffff); di[136] = (bf16)(vi.x >> 16); di[272] = (bf16)(vi.y & 0xffff); di[408] = (bf16)(vi.y >> 16);
        di[544] = (bf16)(vi.z & 0xffff); di[680] = (bf16)(vi.z >> 16); di[816] = (bf16)(vi.w & 0xffff); di[952] = (bf16)(vi.w >> 16); }
    __syncthreads();
    const bf16* wc = (const bf16*)(F.ws + WS_FT + FT_W128C); const bf16* wsn = (const bf16*)(F.ws + WS_FT + FT_W128S);
    const bf16* tcn = (const bf16*)(F.ws + WS_FT + FT_T64C); const bf16* tsn = (const bf16*)(F.ws + WS_FT + FT_T64S);
    f32x4 Pr[4], Pi[4];
#pragma unroll
    for (int ct = 0; ct < 4; ++ct) { Pr[ct] = (f32x4){0.f, 0.f, 0.f, 0.f}; Pi[ct] = (f32x4){0.f, 0.f, 0.f, 0.f}; }
#pragma unroll
    for (int k = 0; k < 4; ++k) { const bf16x8 bc = *(const bf16x8*)(wc + (16 * F.wave + c) * 128 + 32 * k + 8 * q), bs = *(const bf16x8*)(wsn + (16 * F.wave + c) * 128 + 32 * k + 8 * q);
        const v4u bsu = __builtin_bit_cast(v4u, bs); const bf16x8 bsn = mk8(bsu.x ^ 0x80008000u, bsu.y ^ 0x80008000u, bsu.z ^ 0x80008000u, bsu.w ^ 0x80008000u);
#pragma unroll
        for (int ct = 0; ct < 4; ++ct) { const bf16x8 ar = *(const LAS bf16x8*)(IR + (16 * ct + c) * 272 + k * 64 + q * 16), ai = *(const LAS bf16x8*)(II + (16 * ct + c) * 272 + k * 64 + q * 16);
            Pr[ct] = MFMA16(ar, bc, Pr[ct]); Pr[ct] = MFMA16(ai, bs, Pr[ct]); Pi[ct] = MFMA16(ai, bc, Pi[ct]); Pi[ct] = MFMA16(ar, bsn, Pi[ct]); } }
    bf16x8 Br[2], Bi[2];
#pragma unroll
    for (int k = 0; k < 2; ++k) { Br[k] = mk8(cvtpk(Pr[2 * k][0], Pr[2 * k][1]), cvtpk(Pr[2 * k][2], Pr[2 * k][3]), cvtpk(Pr[2 * k + 1][0], Pr[2 * k + 1][1]), cvtpk(Pr[2 * k + 1][2], Pr[2 * k + 1][3]));
        Bi[k] = mk8(cvtpk(Pi[2 * k][0], Pi[2 * k][1]), cvtpk(Pi[2 * k][2], Pi[2 * k][3]), cvtpk(Pi[2 * k + 1][0], Pi[2 * k + 1][1]), cvtpk(Pi[2 * k + 1][2], Pi[2 * k + 1][3])); }
    bf16* mix = (bf16*)(F.ws + WS_H);
    const float scale = 0.0013810679320049757f;
    const int k2 = 16 * F.wave + c; const size_t row = (size_t)b * SEQ + k1 + 64 * k2;
#pragma unroll
    for (int mt = 0; mt < 4; ++mt) { f32x4 y = {0.f, 0.f, 0.f, 0.f};
#pragma unroll
        for (int k = 0; k < 2; ++k) { const bf16x8 ac = *(const bf16x8*)(tcn + (16 * mt + c) * 64 + 32 * k + 8 * q), as = *(const bf16x8*)(tsn + (16 * mt + c) * 64 + 32 * k + 8 * q);
            y = MFMA16(ac, Br[k], y); y = MFMA16(as, Bi[k], y); }
        v2u w; w.x = pk2(y[0] * scale, y[1] * scale); w.y = pk2(y[2] * scale, y[3] * scale);
        *(v2u*)(mix + row * DM + 64 * g + 16 * mt + 4 * q) = w; }
}

#define XB_TMO      128
#define XB_XCNT(j)  (256  + 64 * (j))
#define XB_XSUB(j)  (1280 + 64 * (j))
#define XB_XGEN(j)  (2304 + 64 * (j))
#define XB_TOP      3328
#define XB_TOPGEN   3392
#define XCD_BAR_WORDS 3456
#define XB_SPIN_CAP (1u << 23)
__device__ __forceinline__ unsigned xb_ld(unsigned* p)              { return __hip_atomic_load(p, __ATOMIC_RELAXED, __HIP_MEMORY_SCOPE_AGENT); }
__device__ __forceinline__ unsigned xb_add(unsigned* p, unsigned v) { return __hip_atomic_fetch_add(p, v, __ATOMIC_RELAXED, __HIP_MEMORY_SCOPE_AGENT); }
__device__ __forceinline__ unsigned xb_xcc_id() { return (unsigned)__builtin_amdgcn_s_getreg((3 << 11) | 20) & 0xFu; }
#define XB_SPIN(cond, bar) do { unsigned _sp = 0; while (cond) { __builtin_amdgcn_s_sleep(1); \
    if ((++_sp & 255u) == 0u) { if (xb_ld(&(bar)[XB_TMO])) break; if (_sp > XB_SPIN_CAP) { atomicAdd(&(bar)[XB_TMO], 1u); break; } } } } while (0)
struct XcdBarrier { unsigned* bar; unsigned x; volatile LAS unsigned* st; };
__device__ __forceinline__ XcdBarrier xcd_barrier_post(unsigned* bar, volatile LAS unsigned* st) {
    XcdBarrier b; b.bar = bar; b.x = xb_xcc_id(); b.st = st;
    if (threadIdx.x == 0) (void)xb_add(&bar[XB_XCNT(b.x)], 1u);
    return b;
}
__device__ __forceinline__ void xcd_barrier_complete(unsigned* bar, unsigned x, unsigned& nloc, unsigned& nx) {
    const unsigned G = gridDim.x * gridDim.y * gridDim.z;
    unsigned sum, cnt, mine, sp = 0u;
    for (;;) {
        sum = 0u; cnt = 0u; mine = 0u;
#pragma unroll
        for (unsigned j = 0; j < 16; ++j) { const unsigned c = xb_ld(&bar[XB_XCNT(j)]); sum += c; cnt += (c > 0u) ? 1u : 0u; mine = (j == x) ? c : mine; }
        if (sum == G) break;
        __builtin_amdgcn_s_sleep(1);
        if ((++sp & 255u) == 0u) { if (xb_ld(&bar[XB_TMO])) break; if (sp > XB_SPIN_CAP) { atomicAdd(&bar[XB_TMO], 1u); break; } }
    }
    nloc = mine > 0u ? mine : 1u; nx = cnt > 0u ? cnt : 1u;
}
__device__ __forceinline__ void xcd_barrier(const XcdBarrier& b0) {
    XcdBarrier b; { unsigned* p = b0.bar; unsigned x = __builtin_amdgcn_readfirstlane(b0.x); unsigned st = (unsigned)(size_t)b0.st; asm volatile("" : "+s"(p), "+s"(x), "+s"(st)); b.bar = p; b.x = x; b.st = (volatile LAS unsigned*)(size_t)st; }
    asm volatile("s_waitcnt vmcnt(0)" ::: "memory");
    __syncthreads();
    if (threadIdx.x == 0) {
        unsigned* bar = b.bar;
        __builtin_amdgcn_s_waitcnt(0);
        unsigned nloc = b.st[0], nx = b.st[1];
        if (nloc == 0u) { xcd_barrier_complete(bar, b.x, nloc, nx); b.st[0] = nloc; b.st[1] = nx; }
        const unsigned old = xb_add(&bar[XB_XSUB(b.x)], 1u);
        const unsigned gen = old / nloc;
        if (old + 1u == (gen + 1u) * nloc) {
            __builtin_amdgcn_fence(__ATOMIC_RELEASE, "agent");
            asm volatile("s_waitcnt vmcnt(0)" ::: "memory");
            const unsigned og = xb_add(&bar[XB_TOP], 1u);
            const unsigned tg = og / nx;
            if (og + 1u == (tg + 1u) * nx) xb_add(&bar[XB_TOPGEN], 1u);
            else XB_SPIN(xb_ld(&bar[XB_TOPGEN]) == tg, bar);
            __builtin_amdgcn_fence(__ATOMIC_ACQUIRE, "agent");
            xb_add(&bar[XB_XGEN(b.x)], 1u);
            asm volatile("s_waitcnt vmcnt(0)" ::: "memory");
        } else {
            XB_SPIN(xb_ld(&bar[XB_XGEN(b.x)]) == gen, bar);
            __builtin_amdgcn_fence(__ATOMIC_ACQUIRE, "agent");
            asm volatile("s_waitcnt vmcnt(0)" ::: "memory");
        }
    }
    __syncthreads();
}

__device__ __forceinline__ int queue_next(Frame& F, unsigned* cnt) {
    volatile LAS int* slot = (volatile LAS int*)(F.lds + MISC_OFF + 64);
    __syncthreads();
    if (F.tid == 0) *slot = (int)__hip_atomic_fetch_add(cnt, 1u, __ATOMIC_RELAXED, __HIP_MEMORY_SCOPE_AGENT);
    __syncthreads();
    return *slot;
}
template <int KIND> __device__ __forceinline__ void run_phase(const Frame& F0, int li, int second) {
    Frame F;
    { int t = threadIdx.x; asm volatile("" : "+v"(t)); F.tid = t; F.lane = t & 63; F.wave = __builtin_amdgcn_readfirstlane(t >> 6);
      int g = F0.G, b = F0.bid; asm volatile("" : "+s"(g), "+s"(b)); F.G = g; F.bid = b;
      unsigned char* w = F0.ws; float* o = F0.out; asm volatile("" : "+s"(w), "+s"(o)); F.ws = w; F.out = o;
      unsigned l = (unsigned)(size_t)F0.lds; asm volatile("" : "+s"(l)); F.lds = (LAS unsigned char*)(size_t)l;
      asm volatile("" : "+s"(li), "+s"(second)); }
    float* modv = (float*)(F.ws + WS_MOD);
    bf16* XB = (bf16*)(F.ws + WS_XB);
    bf16* H = (bf16*)(F.ws + WS_H); bf16* ACT = (bf16*)(F.ws + WS_ACT); bf16* O = (bf16*)(F.ws + WS_O);
    const float* ng = inp(I_NORMG) + (size_t)li * 6 * DM; const float* mv = modv + (size_t)li * 3 * 9216;
    const bool last = li == 1;
    if constexpr (KIND == 100) { convert_weights(F, 0); mod_gemv(F); rope_tables(F); lora_transposes(F); fourier_tables(F); }
    if constexpr (KIND == 101) { EArgs A{}; A.xl_src = inp(I_X); A.xc_src = inp(I_CTX); A.o = nullptr; A.hdst = H; A.modv_h = modv; A.shidx = 0; A.scidx = 1; A.gpre = inp(I_NORMG); A.nrows = TT; e_phase(F, A); }
    if constexpr (KIND == 0) {
        const bf16* wi = (const bf16*)(F.ws + (second ? WS_WI2 : WS_WI1)); const bool withctx = !(last && second);
        if (!withctx || F.G != 256) { pg8::Gemm g{H, wi, withctx ? TT : TL, NWI, DM}; pg8::StaticOrder S; S.init(g.M, g.N, F.G, F.bid);
            pg8::EpiSwiglu E{ACT, FFNP}; pg8::gemm_phase<pg8::EpiSwiglu, pg8::StaticOrder, true, true>(F.lds, g, S, E, F.tid); }
        else { unsigned* cnt = (unsigned*)(F.ws + WS_CTL) + 8192 + 64 * (li * 2 + second);
            pg8::Gemm g{H, wi, TT, NWI, DM}; pg8::UpOrder S; S.init(NWI, F.G, F.bid, cnt);
            pg8::EpiSwiglu E{ACT, FFNP}; pg8::gemm_phase<pg8::EpiSwiglu, pg8::UpOrder, true, true>(F.lds, g, S, E, F.tid);
            if (F.bid >= 248) {
                if (F.tid == 0) { unsigned sp = 0; while (__hip_atomic_load(cnt, __ATOMIC_RELAXED, __HIP_MEMORY_SCOPE_AGENT) < 352u && ++sp < (1u << 24)) __builtin_amdgcn_s_sleep(8);
                    __builtin_amdgcn_fence(__ATOMIC_ACQUIRE, "agent"); asm volatile("s_waitcnt vmcnt(0)" ::: "memory"); }
                __syncthreads();
                const int k = F.bid - 248; pg8::Gemm g2{ACT, (const bf16*)(F.ws + (second ? WS_WO2 : WS_WO1)), TT, DM, FFNP}; pg8::OneUnit S2{64 + (k >> 2), k & 3};
                pg8::EpiBf16 E2{O, DM}; pg8::gemm_phase<pg8::EpiBf16, pg8::OneUnit, false, true>(F.lds, g2, S2, E2, F.tid); } } }
    if constexpr (KIND == 1) {
        const bool ctxhere = F.G != 256 && !(last && second);
        pg8::Gemm g{ACT, (const bf16*)(F.ws + (second ? WS_WO2 : WS_WO1)), ctxhere ? TT : TL, DM, FFNP}; pg8::StaticOrder S; S.init(g.M, g.N, F.G, F.bid);
        pg8::EpiBf16 E{O, DM}; pg8::gemm_phase<pg8::EpiBf16, pg8::StaticOrder, true, true>(F.lds, g, S, E, F.tid); }
    if constexpr (KIND == 2) {
        EArgs A{}; A.xl_src = inp(I_X); A.xc_src = inp(I_CTX); A.xb_src = li == 0 ? (const bf16*)nullptr : XB; A.xb_dst = XB; A.o = O; A.modv_g = mv; A.gidx = 2; A.gmul = 0.5f; A.gpost = ng + 1 * DM;
        A.hdst = H; A.modv_h = mv; A.shidx = 3; A.scidx = 4; A.gpre = ng + 2 * DM; A.nrows = TT; e_phase(F, A); }
    if constexpr (KIND == 3) {
        pg8::Gemm g{H, (const bf16*)(F.ws + WS_WIN), TT, INWP, DM}; pg8::StaticOrder S; S.init(g.M, g.N, F.G, F.bid);
        pg8::EpiBf16 E{ACT, INWP}; pg8::gemm_phase<pg8::EpiBf16, pg8::StaticOrder, true, true>(F.lds, g, S, E, F.tid); }
    if constexpr (KIND == 4) {
        lora_pass(F, li);
        for (int u = F.bid; u < 256; u += F.G) fourier_a_fast(F, u);
        rope_all(F);
        if (li == 0) fourier_ctx1_all(F); }
    if constexpr (KIND == 5) {
        unsigned* cnt = (unsigned*)(F.ws + WS_CTL) + 8192 + 64 * (4 + 2 * li);
        const int na = li == 0 ? 264 : 256;
        for (int it = queue_next(F, cnt); it < na; it = queue_next(F, cnt)) attn_unit(F, li, it);
        for (int it = queue_next(F, cnt + 16); it < 12 * (NSC - 1); it = queue_next(F, cnt + 16)) rwkv_pass1_pair(F, li, it); }
    if constexpr (KIND == 11) {
        if (F.bid < 24) rwkv_pass2_chain(F, F.bid);
        else convert_weights(F, 1, li == 0 ? 1 : 2, 24, F.G - 24);
        if (li == 0) fourier_ctx2_all(F); }
    if constexpr (KIND == 12) {
        unsigned* cnt = (unsigned*)(F.ws + WS_CTL) + 8192 + 64 * (5 + 2 * li);
        const int np3 = li == 0 ? 12 * NSC : 12 * 64;
        for (int it = queue_next(F, cnt); it < np3; it = queue_next(F, cnt)) rwkv_pass3_unit(F, li, li == 0 ? it : (it / 64) * NSC + 2 + it % 64);
        for (int it = queue_next(F, cnt + 16); it < 512; it = queue_next(F, cnt + 16)) fourier_c_fast(F, it); }
    if constexpr (KIND == 6) {
        pg8::Gemm g{H, (const bf16*)(F.ws + WS_WOUT), last ? TL : TT, DM, DM}; pg8::StaticOrder S; S.init(g.M, g.N, F.G, F.bid);
        pg8::EpiBf16 E{O, DM}; pg8::gemm_phase<pg8::EpiBf16, pg8::StaticOrder, true, true>(F.lds, g, S, E, F.tid); }
    if constexpr (KIND == 7) {
        EArgs A{}; A.xb_src = XB; A.xb_dst = XB; A.o = O; A.modv_g = mv; A.gidx = 5; A.gmul = 1.0f; A.gpost = ng + 3 * DM;
        A.hdst = H; A.modv_h = mv; A.shidx = 6; A.scidx = 7; A.gpre = ng + 4 * DM; A.nrows = last ? TL : TT; e_phase(F, A); }
    if constexpr (KIND == 10) {
        EArgs A{}; A.xb_src = XB; A.xb_dst = XB; A.out32 = last ? F.out : (float*)nullptr; A.o = O; A.modv_g = mv; A.gidx = 8; A.gmul = 0.5f; A.gpost = ng + 5 * DM;
        if (!last) { A.hdst = H; A.modv_h = mv + 3 * 9216; A.shidx = 0; A.scidx = 1; A.gpre = ng + 6 * DM; }
        A.nrows = last ? TL : TT; e_phase(F, A);
        }
}
__global__ void __launch_bounds__(NTHR, 2) mega_one(Args args) {
    extern __shared__ __attribute__((aligned(16))) unsigned char lds[];
    Frame F; F.lds = (LAS unsigned char*)lds; F.tid = threadIdx.x; F.lane = F.tid & 63; F.wave = __builtin_amdgcn_readfirstlane(F.tid >> 6); F.G = gridDim.x; F.bid = blockIdx.x;
    F.out = args.out; F.ws = args.ws;
    volatile LAS unsigned* MISC = (volatile LAS unsigned*)(F.lds + MISC_OFF);
    if (F.tid < 32) MISC[F.tid] = 0u;
    __syncthreads();
    XcdBarrier bar = xcd_barrier_post((unsigned*)(F.ws + WS_CTL) + 4096, MISC + 8);
#define GRID_BAR() xcd_barrier(bar)
    run_phase<100>(F, 0, 0); GRID_BAR();
    run_phase<101>(F, 0, 0); GRID_BAR();
#pragma unroll 1
    for (int li = 0; li < 2; ++li) {
        run_phase<0>(F, li, 0); GRID_BAR();
        run_phase<1>(F, li, 0); GRID_BAR();
        run_phase<2>(F, li, 0); GRID_BAR();
        run_phase<3>(F, li, 0); GRID_BAR();
        run_phase<4>(F, li, 0); GRID_BAR();
        run_phase<5>(F, li, 0); GRID_BAR();
        run_phase<11>(F, li, 0); GRID_BAR();
        run_phase<12>(F, li, 0); GRID_BAR();
        run_phase<6>(F, li, 0); GRID_BAR();
        run_phase<7>(F, li, 0); GRID_BAR();
        run_phase<0>(F, li, 1); GRID_BAR();
        run_phase<1>(F, li, 1); GRID_BAR();
        run_phase<10>(F, li, 0); GRID_BAR();
    }
}

extern "C" void kernel_launch(void* const* d_in, const int* in_sizes, int n_in, void* d_out, int out_size, void* d_ws, size_t ws_size, hipStream_t stream) {
    static int ready = 0;
    if (!ready) {
        if (n_in != 25 || out_size != TL * DM || ws_size < WS_END) { fprintf(stderr, "kernel_launch: unexpected shapes (n_in %d out %d ws %zu)\n", n_in, out_size, ws_size); ready = -1; return; }
        if (hipFuncSetAttribute((const void*)mega_one, hipFuncAttributeMaxDynamicSharedMemorySize, LDS_BYTES) != hipSuccess) { fprintf(stderr, "kernel_launch: hipFuncSetAttribute failed\n"); ready = -1; return; }
        int dev = 0, cus = 0; if (hipGetDevice(&dev) != hipSuccess || hipDeviceGetAttribute(&cus, hipDeviceAttributeMultiprocessorCount, dev) != hipSuccess || cus < 32) cus = 256;
        ready = cus < 256 ? cus : 256;
    }
    if (ready < 0) return;
    if (hipMemsetAsync((char*)d_ws + WS_CTL, 0, 65536, stream) != hipSuccess) { fprintf(stderr, "kernel_launch: memset failed\n"); return; }
    Args a{};
    for (int i = 0; i < 25; ++i) a.in[i] = (const float*)d_in[i];
    a.out = (float*)d_out; a.ws = (unsigned char*)d_ws;
    hipLaunchKernelGGL(mega_one, dim3(ready), dim3(NTHR), LDS_BYTES, stream, a);
}
```

```cpp
#include <hip/hip_runtime.h>
#include <cstdio>
#include <cstdint>

namespace pg8 {
#define PG8_LAS __attribute__((address_space(3)))
typedef unsigned short bf16_t;
typedef short bf16x8 __attribute__((ext_vector_type(8)));
typedef float f32x4 __attribute__((ext_vector_type(4)));
typedef unsigned u32x4 __attribute__((ext_vector_type(4)));
constexpr int BM = 256, BK = 64, HALF = 128, HTB = HALF * BK * 2, STAGE_BYTES = 8 * HTB, NXCD = 8, WGM = 8;

__host__ __device__ __forceinline__ int lds_byte(int r, int c) { const int st = (r >> 4) * 2 + (c >> 5), rr = r & 15, cc = c & 31, ob = rr * 64 + cc * 2; return st * 1024 + (ob ^ (((ob >> 9) & 1) << 5)); }
__host__ __device__ __forceinline__ void stage_rc(int b, int& R, int& C) { const int st = b / 1024, sb = b % 1024, swz = sb ^ (((sb >> 9) & 1) << 5); R = (st >> 1) * 16 + swz / 64; C = (st & 1) * 32 + (swz % 64) / 2; }
__host__ __device__ __forceinline__ int perm32(int rho) { const int n = rho >> 4, i = rho & 15; return 8 * (i >> 2) + 4 * n + (i & 3); }

struct Unit { int pm, pn; };
struct Gemm { const bf16_t* A; const bf16_t* Bt; int M, N, K; };

struct StaticOrder {
    int nM, nN, nwg, G, c;
    __host__ __device__ void init(int M, int N, int G_, int c_) { nM = M / BM; nN = N / BM; nwg = nM * nN; G = G_; c = c_; }
    __host__ __device__ bool next(int i, Unit& u) const {
        const long L = (long)i * G + c; if (L >= nwg) return false;
        int wgid = (int)L; { const int q = nwg / NXCD, r = nwg % NXCD, xcd = wgid % NXCD, off = wgid / NXCD; wgid = (xcd < r ? xcd * (q + 1) : r * (q + 1) + (xcd - r) * q) + off; }
        const int nig = WGM * nN, gid = wgid / nig, fm = gid * WGM, gsz = (nM - fm) < WGM ? (nM - fm) : WGM;
        u.pm = fm + ((wgid % nig) % gsz); u.pn = (wgid % nig) / gsz; return true;
    }
    __device__ __forceinline__ void a_ready(const Unit&) const {}
    __device__ __forceinline__ void done(const Unit&) const {}
};

struct UpOrder {
    StaticOrder lat; int G, c, nN; unsigned* cnt;
    __device__ void init(int N, int G_, int c_, unsigned* cnt_) { lat.init(16384, N, G_, c_); G = G_; c = c_; nN = N / BM; cnt = cnt_; }
    __device__ bool next(int i, Unit& u) const {
        const int nctx = 2 * nN, total = nctx + lat.nwg;
        long L;
        if (G != 256) L = (long)i * G + c;
        else if (c >= 248) { if (i >= 3) return false; L = (long)i * G + c; }
        else if (c >= 172 && c < 188 && i == 5) L = (long)(3 + (c - 172) / 8) * G + 248 + (c - 172) % 8;
        else L = (long)i * G + c;
        if (L >= total) return false;
        if (L < nctx) { u.pm = 64 + (int)L / nN; u.pn = (int)L % nN; return true; }
        int wgid = (int)L - nctx; { const int nwg = lat.nwg, q = nwg / NXCD, r = nwg % NXCD, xcd = wgid % NXCD, off = wgid / NXCD; wgid = (xcd < r ? xcd * (q + 1) : r * (q + 1) + (xcd - r) * q) + off; }
        const int nig = WGM * nN, gid = wgid / nig, fm = gid * WGM, gsz = (lat.nM - fm) < WGM ? (lat.nM - fm) : WGM;
        u.pm = fm + ((wgid % nig) % gsz); u.pn = (wgid % nig) / gsz; return true;
    }
    __device__ __forceinline__ void a_ready(const Unit&) const {}
    __device__ __forceinline__ void done(const Unit& u) const {
        if (u.pm >= 64) { asm volatile("s_waitcnt vmcnt(0)" ::: "memory"); __builtin_amdgcn_fence(__ATOMIC_RELEASE, "agent"); asm volatile("s_waitcnt vmcnt(0)" ::: "memory");
            if ((threadIdx.x & 63) == 0) __hip_atomic_fetch_add(cnt, 1u, __ATOMIC_RELAXED, __HIP_MEMORY_SCOPE_AGENT); }
    }
};
struct OneUnit {
    int pm, pn;
    __device__ bool next(int i, Unit& u) const { if (i != 0) return false; u.pm = pm; u.pn = pn; return true; }
    __device__ __forceinline__ void a_ready(const Unit&) const {}
    __device__ __forceinline__ void done(const Unit&) const {}
};

__device__ __forceinline__ unsigned cvt_pk_bf16(float lo, float hi) { unsigned r; asm volatile("v_cvt_pk_bf16_f32 %0, %1, %2" : "=v"(r) : "v"(lo), "v"(hi)); return r; }

struct EpiBf16 {
    static constexpr bool PERM = true, AFTER_DRAIN = false;
    bf16_t* O; int ldc;
    __device__ __forceinline__ void operator()(const f32x4 (&acc)[2][2][4][2], const Unit& u, int wr, int wc, int fr, int fq) const {
        const int row0 = u.pm * BM + wr * 64 + fr; const int col0 = u.pn * BM + wc * 32 + 8 * fq;
#pragma unroll
        for (int ai = 0; ai < 2; ++ai)
#pragma unroll
            for (int m = 0; m < 4; ++m) { bf16_t* rowp = O + (size_t)(row0 + ai * HALF + m * 16) * ldc + col0;
#pragma unroll
                for (int bj = 0; bj < 2; ++bj) { const f32x4 v0 = acc[ai][bj][m][0], v1 = acc[ai][bj][m][1];
                    u32x4 w; w.x = cvt_pk_bf16(v0[0], v0[1]); w.y = cvt_pk_bf16(v0[2], v0[3]); w.z = cvt_pk_bf16(v1[0], v1[1]); w.w = cvt_pk_bf16(v1[2], v1[3]);
                    *(u32x4*)(rowp + bj * HALF) = w; } }
    }
};
struct EpiF32 {
    static constexpr bool PERM = true, AFTER_DRAIN = false;
    float* O; int ldc;
    __device__ __forceinline__ void operator()(const f32x4 (&acc)[2][2][4][2], const Unit& u, int wr, int wc, int fr, int fq) const {
        const int row0 = u.pm * BM + wr * 64 + fr; const int col0 = u.pn * BM + wc * 32 + 8 * fq;
#pragma unroll
        for (int ai = 0; ai < 2; ++ai)
#pragma unroll
            for (int m = 0; m < 4; ++m) { float* rowp = O + (size_t)(row0 + ai * HALF + m * 16) * ldc + col0;
#pragma unroll
                for (int bj = 0; bj < 2; ++bj) { *(f32x4*)(rowp + bj * HALF) = acc[ai][bj][m][0]; *(f32x4*)(rowp + bj * HALF + 4) = acc[ai][bj][m][1]; } }
    }
};
__device__ __forceinline__ float silu_f(float x) { return x * __builtin_amdgcn_rcpf(1.0f + __expf(-x)); }
struct EpiSwiglu {
    static constexpr bool PERM = true, AFTER_DRAIN = false;
    bf16_t* O; int ldc;
    __device__ __forceinline__ void operator()(const f32x4 (&acc)[2][2][4][2], const Unit& u, int wr, int wc, int fr, int fq) const {
        const int row0 = u.pm * BM + wr * 64 + fr; const int col0 = u.pn * HALF + wc * 32 + 8 * fq;
#pragma unroll
        for (int ai = 0; ai < 2; ++ai)
#pragma unroll
            for (int m = 0; m < 4; ++m) { bf16_t* rowp = O + (size_t)(row0 + ai * HALF + m * 16) * ldc + col0;
                const f32x4 g0 = acc[ai][0][m][0], g1 = acc[ai][0][m][1], u0 = acc[ai][1][m][0], u1 = acc[ai][1][m][1];
                u32x4 w; w.x = cvt_pk_bf16(silu_f(g0[0]) * u0[0], silu_f(g0[1]) * u0[1]); w.y = cvt_pk_bf16(silu_f(g0[2]) * u0[2], silu_f(g0[3]) * u0[3]);
                w.z = cvt_pk_bf16(silu_f(g1[0]) * u1[0], silu_f(g1[1]) * u1[1]); w.w = cvt_pk_bf16(silu_f(g1[2]) * u1[2], silu_f(g1[3]) * u1[3]);
                *(u32x4*)rowp = w; }
    }
};

template <class Epi, class Sched, bool ALIGN_EPI = false, bool SP2 = false>
__device__ __forceinline__ void gemm_phase(PG8_LAS unsigned char* lds, const Gemm g, const Sched& S, const Epi& E, const int tid) {
    const int wid = __builtin_amdgcn_readfirstlane(tid >> 6), lane = tid & 63, wr = wid >> 2, wc = wid & 3, fr = lane & 15, fq = lane >> 4;
    const int K = g.K, nt = K / BK;
    unsigned voffA[2], voffB[2];
#pragma unroll
    for (int i = 0; i < 2; ++i) { int R, C; stage_rc(tid * 16 + i * 8192, R, C); const int Rb = Epi::PERM ? ((R & ~31) + perm32(R & 31)) : R;
        voffA[i] = (unsigned)(R * K + C) * 2u; voffB[i] = (unsigned)(Rb * K + C) * 2u; }
    const size_t kstep = (size_t)(BK * 2);
    const size_t hstep = (size_t)HALF * K * 2;
    const size_t tstep = 2 * hstep;
    const unsigned ldsw = (unsigned)wid * 1024u;
    const int aoff = lds_byte(wr * 64 + fr, fq * 8), boff = lds_byte(wc * 32 + fr, fq * 8);
#define PG8_SA(b, h) (((b) * 2 + (h)) * HTB)
#define PG8_SB(b, h) ((4 + (b) * 2 + (h)) * HTB)
#define PG8_STAGE(bufoff, gbase, voff) do { _Pragma("unroll") for (int _i = 0; _i < 2; ++_i) \
        __builtin_amdgcn_global_load_lds((const unsigned*)((const char*)(gbase) + (voff)[_i]), (PG8_LAS unsigned*)(lds + (bufoff) + ldsw + _i * 8192), 16, 0, 0); } while (0)
#define PG8_LDA(dst, b, h) do { _Pragma("unroll") for (int m = 0; m < 4; ++m) _Pragma("unroll") for (int k = 0; k < 2; ++k) dst[m][k] = *(const PG8_LAS bf16x8*)(lds + PG8_SA(b, h) + aoff + m * 2048 + k * 1024); } while (0)
#define PG8_LDB(dst, b, h) do { _Pragma("unroll") for (int n = 0; n < 2; ++n) _Pragma("unroll") for (int k = 0; k < 2; ++k) dst[n][k] = *(const PG8_LAS bf16x8*)(lds + PG8_SB(b, h) + boff + n * 2048 + k * 1024); } while (0)
#define PG8_MMA(ai, bj, At, Bt) do { __builtin_amdgcn_s_setprio(1); _Pragma("unroll") for (int m = 0; m < 4; ++m) _Pragma("unroll") for (int n = 0; n < 2; ++n) _Pragma("unroll") for (int k = 0; k < 2; ++k) \
        acc[ai][bj][m][n] = __builtin_amdgcn_mfma_f32_16x16x32_bf16(Bt[n][k], At[m][k], acc[ai][bj][m][n], 0, 0, 0); __builtin_amdgcn_s_setprio(0); } while (0)
#define PG8_WAIT_V(n) asm volatile("s_waitcnt vmcnt(" #n ")" ::: "memory")
#define PG8_WAIT_L(n) asm volatile("s_waitcnt lgkmcnt(" #n ")" ::: "memory")
#define PG8_BAR __builtin_amdgcn_s_barrier()
#define PG8_SCHED __builtin_amdgcn_sched_barrier(0)
    Unit cur, nxt; int ui = 0;
    if (!S.next(0, cur)) return;
    f32x4 acc[2][2][4][2];
#pragma unroll
    for (int a = 0; a < 2; ++a)
#pragma unroll
        for (int b = 0; b < 2; ++b)
#pragma unroll
            for (int m = 0; m < 4; ++m)
#pragma unroll
                for (int n = 0; n < 2; ++n) acc[a][b][m][n] = (f32x4){0.f, 0.f, 0.f, 0.f};
    bf16x8 At[4][2], B0[2][2], B1[2][2];
    const char* cA = (const char*)g.A + (size_t)cur.pm * tstep; const char* cB = (const char*)g.Bt + (size_t)cur.pn * tstep;
    S.a_ready(cur);
    if constexpr (SP2) {
        PG8_STAGE(PG8_SB(0, 0), cB, voffB); PG8_STAGE(PG8_SB(0, 1), cB + hstep, voffB); PG8_STAGE(PG8_SA(0, 0), cA, voffA); PG8_STAGE(PG8_SA(0, 1), cA + hstep, voffA);
        if (wr == 1) PG8_BAR;
        PG8_WAIT_V(2); PG8_BAR;
        PG8_STAGE(PG8_SB(1, 0), cB + kstep, voffB); PG8_STAGE(PG8_SA(1, 0), cA + kstep, voffA); PG8_STAGE(PG8_SB(1, 1), cB + hstep + kstep, voffB);
        PG8_WAIT_V(6); PG8_BAR;
    } else {
        PG8_STAGE(PG8_SB(0, 0), cB, voffB); PG8_STAGE(PG8_SA(0, 0), cA, voffA); PG8_STAGE(PG8_SB(0, 1), cB + hstep, voffB); PG8_STAGE(PG8_SA(0, 1), cA + hstep, voffA);
        if (wr == 1) PG8_BAR;
        PG8_WAIT_V(4); PG8_BAR;
        PG8_STAGE(PG8_SB(1, 0), cB + kstep, voffB); PG8_STAGE(PG8_SA(1, 0), cA + kstep, voffA); PG8_STAGE(PG8_SB(1, 1), cB + hstep + kstep, voffB);
        PG8_WAIT_V(6); PG8_BAR;
    }
    for (;;) {
        const bool has_next = S.next(ui + 1, nxt);
        const char* nA = has_next ? (const char*)g.A + (size_t)nxt.pm * tstep : cA; const char* nB = has_next ? (const char*)g.Bt + (size_t)nxt.pn * tstep : cB;
        for (int t = 0; t < nt; t += 2) {
            const bool last = (t == nt - 2);
            const char* a1 = cA + (size_t)(t + 1) * kstep;
            const char* a2 = last ? nA : cA + (size_t)(t + 2) * kstep; const char* b2 = last ? nB : cB + (size_t)(t + 2) * kstep;
            const char* a3 = a2 + kstep; const char* b3 = b2 + kstep;
            if (last && has_next) S.a_ready(nxt);
            if constexpr (SP2) {
            PG8_LDB(B0, 0, 0); PG8_LDB(B1, 0, 1); PG8_SCHED; PG8_LDA(At, 0, 0); PG8_STAGE(PG8_SA(1, 1), a1 + hstep, voffA);
            PG8_WAIT_V(8); PG8_WAIT_L(0); PG8_BAR; PG8_MMA(0, 0, At, B0); PG8_MMA(0, 1, At, B1); PG8_BAR; PG8_SCHED;
            PG8_LDA(At, 0, 1); PG8_STAGE(PG8_SB(0, 0), b2, voffB); PG8_STAGE(PG8_SB(0, 1), b2 + hstep, voffB); PG8_STAGE(PG8_SA(0, 0), a2, voffA);
            PG8_WAIT_V(8); PG8_WAIT_L(0); PG8_BAR; PG8_MMA(1, 0, At, B0); PG8_MMA(1, 1, At, B1); PG8_BAR; PG8_SCHED;
            PG8_LDB(B0, 1, 0); PG8_LDB(B1, 1, 1); PG8_SCHED; PG8_LDA(At, 1, 0); PG8_STAGE(PG8_SA(0, 1), a2 + hstep, voffA);
            PG8_WAIT_V(8); PG8_WAIT_L(0); PG8_BAR; PG8_MMA(0, 0, At, B0); PG8_MMA(0, 1, At, B1); PG8_BAR; PG8_SCHED;
            PG8_LDA(At, 1, 1); PG8_STAGE(PG8_SB(1, 0), b3, voffB); PG8_STAGE(PG8_SB(1, 1), b3 + hstep, voffB); PG8_STAGE(PG8_SA(1, 0), a3, voffA);
            PG8_WAIT_V(8); PG8_WAIT_L(0); PG8_BAR; PG8_MMA(1, 0, At, B0); PG8_MMA(1, 1, At, B1); PG8_BAR; PG8_SCHED;
            } else {
            PG8_LDB(B0, 0, 0); PG8_SCHED; PG8_LDA(At, 0, 0); PG8_STAGE(PG8_SA(1, 1), a1 + hstep, voffA);
            PG8_WAIT_L(8); PG8_BAR; PG8_WAIT_L(0); PG8_MMA(0, 0, At, B0); PG8_BAR; PG8_SCHED;
            PG8_LDB(B1, 0, 1); PG8_STAGE(PG8_SB(0, 0), b2, voffB);
            PG8_BAR; PG8_WAIT_L(0); PG8_MMA(0, 1, At, B1); PG8_BAR;
            PG8_LDA(At, 0, 1); PG8_STAGE(PG8_SA(0, 0), a2, voffA);
            PG8_BAR; PG8_WAIT_L(0); PG8_MMA(1, 0, At, B0); PG8_BAR; PG8_SCHED;
            PG8_STAGE(PG8_SB(0, 1), b2 + hstep, voffB);
            PG8_WAIT_V(6); PG8_BAR; PG8_MMA(1, 1, At, B1); PG8_BAR;
            PG8_LDB(B0, 1, 0); PG8_SCHED; PG8_LDA(At, 1, 0); PG8_STAGE(PG8_SA(0, 1), a2 + hstep, voffA);
            PG8_WAIT_L(8); PG8_BAR; PG8_WAIT_L(0); PG8_MMA(0, 0, At, B0); PG8_BAR; PG8_SCHED;
            PG8_LDB(B1, 1, 1); PG8_STAGE(PG8_SB(1, 0), b3, voffB);
            PG8_BAR; PG8_WAIT_L(0); PG8_MMA(0, 1, At, B1); PG8_BAR;
            PG8_LDA(At, 1, 1); PG8_STAGE(PG8_SA(1, 0), a3, voffA);
            PG8_BAR; PG8_WAIT_L(0); PG8_MMA(1, 0, At, B0); PG8_BAR; PG8_SCHED;
            PG8_STAGE(PG8_SB(1, 1), b3 + hstep, voffB);
            PG8_WAIT_V(6); PG8_BAR; PG8_MMA(1, 1, At, B1); PG8_BAR;
            }
        }
        if constexpr (ALIGN_EPI) { if (wr == 0) PG8_BAR; }
        if constexpr (!Epi::AFTER_DRAIN) { E(acc, cur, wr, wc, fr, fq); S.done(cur); }
        if (!has_next) break;
#pragma unroll
        for (int a = 0; a < 2; ++a)
#pragma unroll
            for (int b = 0; b < 2; ++b)
#pragma unroll
                for (int m = 0; m < 4; ++m)
#pragma unroll
                    for (int n = 0; n < 2; ++n) acc[a][b][m][n] = (f32x4){0.f, 0.f, 0.f, 0.f};
        cur = nxt; cA = nA; cB = nB; ++ui;
        if constexpr (ALIGN_EPI) { if (wr == 1) PG8_BAR; }
    }
    PG8_WAIT_V(0);
    if constexpr (!ALIGN_EPI) { if (wr == 0) PG8_BAR; }
    PG8_BAR;
#undef PG8_SA
#undef PG8_SB
#undef PG8_STAGE
#undef PG8_LDA
#undef PG8_LDB
#undef PG8_MMA
#undef PG8_WAIT_V
#undef PG8_WAIT_L
#undef PG8_BAR
#undef PG8_SCHED
}
}

constexpr int NWAVES = 8, NTHR = 512;
constexpr int DM = 1024, SEQ = 8192, NB = 2, CTX = 256, TL = NB * SEQ, TC = NB * CTX, TT = TL + TC;
constexpr int FFN = 2752, FFNP = 2816, NWI = 5632, INW = 2432, INWP = 2560, NMOD = 9;
constexpr int ZF = 0, ZQ = 256, ZK = 640, ZV = 768, ZRR = 896, ZRK = 1280, ZRV = 1664, ZW = 2048, ZA = 2176, ZG = 2304;
constexpr int RW = 384;
constexpr float NORM_EPS = 1e-6f, GN_EPS = 64e-5f;

constexpr size_t MiB = 1u << 20;
constexpr size_t WS_CTL = 0, WS_MOD = 1 * MiB, WS_ROPE = 2 * MiB, WS_XC = 4 * MiB, WS_GC = 6 * MiB;
constexpr size_t WS_WI1 = 8 * MiB, WS_WO1 = 19 * MiB, WS_WIN = 25 * MiB, WS_WOUT = 30 * MiB, WS_WI2 = 32 * MiB, WS_WO2 = 43 * MiB;
constexpr size_t WS_H = 49 * MiB;
constexpr size_t WS_ACT = 82 * MiB;
constexpr size_t WS_O = 173 * MiB;
constexpr size_t WS_YD = WS_O, WS_QR = WS_O + 50 * MiB, WS_KR = WS_O + 62 * MiB;
constexpr size_t WS_W2T = WS_MOD + 256 * 1024, WS_A2T = WS_MOD + 512 * 1024, WS_G2T = WS_MOD + 768 * 1024;
constexpr size_t WS_LW = WS_O, WS_IC = WS_O + 25 * MiB;
constexpr size_t WS_GAM32 = 165 * MiB;
constexpr size_t WS_XB = 239 * MiB;
constexpr size_t OUT_FA = 0;
constexpr size_t OUT_SUM = 16 * MiB;
constexpr size_t WS_END = 272 * MiB;

constexpr size_t WS_FT = 7 * MiB;
constexpr size_t FT_W64C = 0, FT_W64S = 8192, FT_W128C = 16384, FT_W128S = 49152, FT_T64C = 81920, FT_T64S = 90112;
constexpr int LDS_BYTES = 147456;
constexpr int MISC_OFF = 146432;

typedef unsigned short bf16;
typedef float f32x4 __attribute__((ext_vector_type(4)));
typedef unsigned v4u __attribute__((ext_vector_type(4)));
typedef unsigned v2u __attribute__((ext_vector_type(2)));
#define LAS __attribute__((address_space(3)))
#define LDS_WAIT() asm volatile("s_waitcnt lgkmcnt(0)" ::: "memory")

__device__ __forceinline__ unsigned f2bf(float f) { unsigned u = __builtin_bit_cast(unsigned, f); return (u + 0x7fffu + ((u >> 16) & 1u)) >> 16; }
__device__ __forceinline__ unsigned pk2(float lo, float hi) { return f2bf(lo) | (f2bf(hi) << 16); }
__device__ __forceinline__ float bf2f(unsigned short u) { return __builtin_bit_cast(float, (unsigned)u << 16); }
__device__ __forceinline__ float bflo(unsigned u) { return __builtin_bit_cast(float, u << 16); }
__device__ __forceinline__ float bfhi(unsigned u) { return __builtin_bit_cast(float, u & 0xffff0000u); }
__device__ __forceinline__ void unpack8(const v4u w, float (&f)[8]) { f[0] = bflo(w.x); f[1] = bfhi(w.x); f[2] = bflo(w.y); f[3] = bfhi(w.y); f[4] = bflo(w.z); f[5] = bfhi(w.z); f[6] = bflo(w.w); f[7] = bfhi(w.w); }
__device__ __forceinline__ float wave_sum(float v) {
#pragma unroll
    for (int o = 1; o < 64; o <<= 1) v += __shfl_xor(v, o);
    return v;
}
__device__ __forceinline__ float wave_max(float v) {
#pragma unroll
    for (int o = 1; o < 64; o <<= 1) v = fmaxf(v, __shfl_xor(v, o));
    return v;
}

struct Args { const float* in[25]; float* out; unsigned char* ws; int ph_lo, ph_hi; };

struct Frame {
    LAS unsigned char* lds;
    int tid, lane, wave, G, bid;
    float* out; unsigned char* ws;
};
enum { I_X = 0, I_C, I_CTX, I_CCTX, I_MODW, I_MODB, I_NORMG, I_F1WI, I_F1WO, I_WIN, I_WOUT, I_SINK, I_CONV, I_W0, I_W2, I_A0, I_A2, I_G2, I_KK, I_KA, I_RK, I_LNG, I_LNB, I_F2WI, I_F2WO };

__device__ __forceinline__ const float* inp(int i) {
    const __attribute__((address_space(4))) char* p = (const __attribute__((address_space(4))) char*)__builtin_amdgcn_kernarg_segment_ptr();
    asm volatile("" : "+s"(p));
    return *(const float* const __attribute__((address_space(4)))*)(p + 8 * i);
}
struct CvtDesc { const float* W; bf16* WT; int ldw, k0, sc, Kd, n0d; bool valid, live; };
__device__ __forceinline__ void cvt_load(const CvtDesc& d, f32x4 (&v)[8], int lane) {
    const int c4 = lane & 7, r8 = lane >> 3;
#pragma unroll
    for (int i = 0; i < 8; ++i) v[i] = (d.live && d.valid) ? *(const f32x4*)(d.W + (size_t)(d.k0 + 8 * i + r8) * d.ldw + d.sc + 4 * c4) : (f32x4){0.f, 0.f, 0.f, 0.f};
}
__device__ __forceinline__ void cvt_finish(const CvtDesc& d, const f32x4 (&v)[8], LAS float* scr, int lane) {
    if (!d.live) return;
    const int c4 = lane & 7, r8 = lane >> 3;
#pragma unroll
    for (int i = 0; i < 8; ++i) *(LAS f32x4*)(scr + (8 * i + r8) * 36 + 4 * c4) = v[i];
    LDS_WAIT(); asm volatile("" ::: "memory");
    const int c = lane & 7;
#pragma unroll
    for (int j = 0; j < 4; ++j) { const int n = (lane >> 3) + 8 * j; const LAS float* s = scr + (8 * c) * 36 + n;
        v4u o; o.x = pk2(s[0 * 36], s[1 * 36]); o.y = pk2(s[2 * 36], s[3 * 36]); o.z = pk2(s[4 * 36], s[5 * 36]); o.w = pk2(s[6 * 36], s[7 * 36]);
        *(v4u*)(d.WT + (size_t)(d.n0d + n) * d.Kd + d.k0 + 8 * c) = o; }
    LDS_WAIT(); asm volatile("" ::: "memory");
}
__device__ __forceinline__ CvtDesc cvt_decode(Frame& F, int li, int set, int it) {
    constexpr int I_WI = 16 * (NWI / 32), I_WO = (FFNP / 64) * 32, I_IN = 16 * (INWP / 32), I_OUT = 16 * 32;
    constexpr int NITEMS = 2 * I_WI + 2 * I_WO + I_IN + I_OUT;
    CvtDesc d{}; d.live = it < NITEMS; if (!d.live) return d;
    int r = it;
    if (set) { const bool inA = r < I_WI || (r >= 2 * I_WI && r < 2 * I_WI + I_WO) || (r >= 2 * I_WI + 2 * I_WO && r < 2 * I_WI + 2 * I_WO + I_IN); if (inA != (set == 1)) { d.live = false; return d; } }
    if (r < 2 * I_WI) { const int f = r / I_WI; r -= f * I_WI; const int nblk = NWI / 32, kb = r / nblk, nb = r % nblk;
        const int n0 = 32 * nb, pn = n0 >> 8, i = n0 & 255; const int j = 128 * pn + (i & 127);
        d.W = (f ? inp(I_F2WI) : inp(I_F1WI)) + (size_t)li * DM * 2 * FFN; d.ldw = 2 * FFN; d.k0 = 64 * kb; d.sc = (i < 128) ? j : FFN + j; d.valid = j < FFN; d.WT = (bf16*)(F.ws + (f ? WS_WI2 : WS_WI1)); d.Kd = DM; d.n0d = n0; return d; }
    r -= 2 * I_WI;
    if (r < 2 * I_WO) { const int f = r / I_WO; r -= f * I_WO; const int kb = r / 32, nb = r % 32;
        d.W = (f ? inp(I_F2WO) : inp(I_F1WO)) + (size_t)li * FFN * DM; d.ldw = DM; d.k0 = 64 * kb; d.sc = 32 * nb; d.valid = 64 * kb < FFN; d.WT = (bf16*)(F.ws + (f ? WS_WO2 : WS_WO1)); d.Kd = FFNP; d.n0d = 32 * nb; return d; }
    r -= 2 * I_WO;
    if (r < I_IN) { const int nblk = INWP / 32, kb = r / nblk, nb = r % nblk;
        d.W = inp(I_WIN) + (size_t)li * DM * INW; d.ldw = INW; d.k0 = 64 * kb; d.sc = 32 * nb; d.valid = 32 * nb < INW; d.WT = (bf16*)(F.ws + WS_WIN); d.Kd = DM; d.n0d = 32 * nb; return d; }
    r -= I_IN;
    { const int kb = r / 32, nb = r % 32;
        d.W = inp(I_WOUT) + (size_t)li * DM * DM; d.ldw = DM; d.k0 = 64 * kb; d.sc = 32 * nb; d.valid = true; d.WT = (bf16*)(F.ws + WS_WOUT); d.Kd = DM; d.n0d = 32 * nb; return d; }
}
__device__ __forceinline__ void convert_weights(Frame& F, int li, int set = 0, int bid0 = 0, int nblk = 0) {
    if (nblk == 0) nblk = F.G;
    if (F.bid < bid0 || F.bid >= bid0 + nblk) return;
    LAS float* scr = (LAS float*)(F.lds + F.wave * 16384);
    const int gw = (F.bid - bid0) * NWAVES + F.wave, NGW = nblk * NWAVES;
    constexpr int NITEMS = 2 * 16 * (NWI / 32) + 2 * (FFNP / 64) * 32 + 16 * (INWP / 32) + 16 * 32;
    for (int it = gw; it < NITEMS; it += 2 * NGW) {
        const CvtDesc d0 = cvt_decode(F, li, set, it), d1 = cvt_decode(F, li, set, it + NGW);
        f32x4 v0[8], v1[8];
        cvt_load(d0, v0, F.lane); cvt_load(d1, v1, F.lane);
        cvt_finish(d0, v0, scr, F.lane); cvt_finish(d1, v1, scr, F.lane);
    }
}
__device__ __forceinline__ void mod_gemv(Frame& F) {
    LAS float* sc = (LAS float*)F.lds;
    LAS float* red = sc + 3 * 1024;
    __syncthreads();
    for (int i = F.tid; i < 3 * 1024; i += NTHR) { const int v = i >> 10, k = i & 1023; const float x = v < 2 ? inp(I_C)[v * 1024 + k] : inp(I_CCTX)[k]; sc[i] = x / (1.0f + __expf(-x)); }
    __syncthreads();
    float* modv = (float*)(F.ws + WS_MOD);
    for (int u = F.bid; u < 2 * 72; u += F.G) {
        const int l = u / 72, n0 = (u % 72) * 128;
        const float* w = inp(I_MODW) + (size_t)l * DM * 9216 + n0 + 2 * F.lane;
        float a0 = 0.f, a1 = 0.f, b0 = 0.f, b1 = 0.f, c0 = 0.f, c1 = 0.f;
        const int k0 = F.wave * 128;
#pragma unroll 8
        for (int k = 0; k < 128; ++k) { const float2 wv = *(const float2*)(w + (size_t)(k0 + k) * 9216); const float s0 = sc[k0 + k], s1 = sc[1024 + k0 + k], s2 = sc[2048 + k0 + k];
            a0 += s0 * wv.x; a1 += s0 * wv.y; b0 += s1 * wv.x; b1 += s1 * wv.y; c0 += s2 * wv.x; c1 += s2 * wv.y; }
        LAS float* rw = red + F.wave * 384 + 2 * F.lane;
        rw[0] = a0; rw[1] = a1; rw[128] = b0; rw[129] = b1; rw[256] = c0; rw[257] = c1;
        __syncthreads();
        if (F.tid < 384) { float s = 0.f;
#pragma unroll
            for (int w8 = 0; w8 < 8; ++w8) s += red[w8 * 384 + F.tid];
            const int v = F.tid >> 7, n = n0 + (F.tid & 127);
            modv[(size_t)(l * 3 + v) * 9216 + n] = s + inp(I_MODB)[l * 9216 + n]; }
        __syncthreads();
    }
}
__device__ __forceinline__ void rope_tables(Frame& F) {
    float* ct = (float*)(F.ws + WS_ROPE); float* st = ct + SEQ * 32;
    for (int i = F.bid * NTHR + F.tid; i < SEQ * 32; i += F.G * NTHR) {
        const int t = i >> 5, j = i & 31; const int f = j & 15;
        const float inv = exp2f(-(float)f * (13.287712379549449f / 16.0f));
        const float pos = (float)(j < 16 ? (t >> 6) : (t & 63));
        const float ang = pos * inv;
        const double a = (double)ang; const double k = __builtin_rint(a * 0.15915494309189535); const float r = (float)(a - k * 6.283185307179586);
        ct[i] = __cosf(r); st[i] = __sinf(r);
    }
}

struct EArgs { const float* xl_src; const float* xc_src; const bf16* xb_src; bf16* xb_dst; float* out32; const bf16* o; const float* modv_g; int gidx; float gmul; const float* gpost;
               bf16* hdst; const float* modv_h; int shidx, scidx; const float* gpre; int nrows; };
template <int R>
__device__ __forceinline__ void e_rows(Frame& F, const EArgs& A, int v, int r0) {
    f32x4 cg[4], ch[4], cs[4];
#pragma unroll
    for (int j = 0; j < 4; ++j) { const int c = F.lane + 64 * j;
        if (A.o) cg[j] = ((const f32x4*)(A.modv_g + (size_t)v * 9216 + A.gidx * DM))[c] * ((const f32x4*)A.gpost)[c] * A.gmul;
        if (A.hdst) { ch[j] = ((const f32x4*)A.gpre)[c] * (1.0f + ((const f32x4*)(A.modv_h + (size_t)v * 9216 + A.scidx * DM))[c]); cs[j] = ((const f32x4*)(A.modv_h + (size_t)v * 9216 + A.shidx * DM))[c]; } }
    f32x4 x[R][4]; v2u ow[R][4];
#pragma unroll
    for (int i = 0; i < R; ++i) { const int r = r0 + i;
        if (A.xb_src) { const v2u* xs = (const v2u*)(A.xb_src + (size_t)r * DM);
#pragma unroll
            for (int j = 0; j < 4; ++j) { const v2u w = xs[F.lane + 64 * j]; x[i][j] = (f32x4){bflo(w.x), bfhi(w.x), bflo(w.y), bfhi(w.y)}; } }
        else { const float* xs = r < TL ? A.xl_src + (size_t)r * DM : A.xc_src + (size_t)(r - TL) * DM;
#pragma unroll
            for (int j = 0; j < 4; ++j) x[i][j] = ((const f32x4*)xs)[F.lane + 64 * j]; }
        if (A.o) { const v2u* orow = (const v2u*)(A.o + (size_t)r * DM);
#pragma unroll
            for (int j = 0; j < 4; ++j) ow[i][j] = orow[F.lane + 64 * j]; } }
#pragma unroll
    for (int i = 0; i < R; ++i) { const int r = r0 + i;
        if (A.o) { f32x4 ov[4]; float ss = 0.f;
#pragma unroll
            for (int j = 0; j < 4; ++j) { const v2u w = ow[i][j]; ov[j] = (f32x4){bflo(w.x), bfhi(w.x), bflo(w.y), bfhi(w.y)}; ss += (ov[j].x * ov[j].x + ov[j].y * ov[j].y) + (ov[j].z * ov[j].z + ov[j].w * ov[j].w); }
            const float rstd = 1.0f / sqrtf(wave_sum(ss) * (1.0f / DM) + NORM_EPS);
#pragma unroll
            for (int j = 0; j < 4; ++j) x[i][j] = x[i][j] + cg[j] * (ov[j] * rstd);
            if (A.out32) {
#pragma unroll
                for (int j = 0; j < 4; ++j) ((f32x4*)(A.out32 + (size_t)r * DM))[F.lane + 64 * j] = x[i][j]; }
            else { v2u* xd = (v2u*)(A.xb_dst + (size_t)r * DM);
#pragma unroll
                for (int j = 0; j < 4; ++j) { v2u w; w.x = pk2(x[i][j].x, x[i][j].y); w.y = pk2(x[i][j].z, x[i][j].w); xd[F.lane + 64 * j] = w; } } }
        if (A.hdst) { float ss = 0.f;
#pragma unroll
            for (int j = 0; j < 4; ++j) ss += (x[i][j].x * x[i][j].x + x[i][j].y * x[i][j].y) + (x[i][j].z * x[i][j].z + x[i][j].w * x[i][j].w);
            const float rstd = 1.0f / sqrtf(wave_sum(ss) * (1.0f / DM) + NORM_EPS);
            v2u* hd = (v2u*)(A.hdst + (size_t)r * DM);
#pragma unroll
            for (int j = 0; j < 4; ++j) { const f32x4 hv = (x[i][j] * rstd) * ch[j] + cs[j]; v2u w; w.x = pk2(hv.x, hv.y); w.y = pk2(hv.z, hv.w); hd[F.lane + 64 * j] = w; } } }
}
__device__ __forceinline__ void e_phase(Frame& F, const EArgs& A) {
    const int gw = F.bid * NWAVES + F.wave, NGW = F.G * NWAVES;
    if (NGW == 2048) {
        const int b = gw >> 10, r0 = b * SEQ + (gw & 1023) * 8;
        e_rows<4>(F, A, b, r0); e_rows<4>(F, A, b, r0 + 4);
        if (A.nrows > TL && (gw & 3) == 0) e_rows<1>(F, A, 2, TL + (gw >> 2));
    } else { for (int r = gw; r < A.nrows; r += NGW) e_rows<1>(F, A, r < TL ? (r >> 13) : 2, r); }
}

__device__ __forceinline__ const bf16* zrow(const Frame& F, int row) { return (const bf16*)(F.ws + WS_ACT) + (size_t)row * INWP; }

__device__ __forceinline__ void fourier_ctx1_all(Frame& F) {
    float* gr = (float*)(F.ws + WS_GC); float* gi = gr + TC * 256;
    const bf16* wc = (const bf16*)(F.ws + WS_FT + FT_W64C); const bf16* wsn = (const bf16*)(F.ws + WS_FT + FT_W64S);
    for (int i = F.bid * NTHR + F.tid; i < TC * 256; i += F.G * NTHR) { const int tok = i >> 8, gm = i & 255, g = gm >> 6, m = gm & 63;
        const bf16* z = zrow(F, TL + tok) + ZF + 64 * g; float sr = 0.f, si = 0.f;
#pragma unroll
        for (int c8 = 0; c8 < 8; ++c8) { float x[8], cs[8], sn[8]; unpack8(*(const v4u*)(z + 8 * c8), x); unpack8(*(const v4u*)(wc + m * 64 + 8 * c8), cs); unpack8(*(const v4u*)(wsn + m * 64 + 8 * c8), sn);
#pragma unroll
            for (int e = 0; e < 8; ++e) { sr += x[e] * cs[e]; si -= x[e] * sn[e]; } }
        gr[i] = sr; gi[i] = si; }
}
__device__ __forceinline__ void fourier_ctx2_all(Frame& F) {
    const float* gr = (const float*)(F.ws + WS_GC); const float* gi = gr + TC * 256; bf16* mix = (bf16*)(F.ws + WS_H);
    for (int i = F.bid * NTHR + F.tid; i < TC * 256; i += F.G * NTHR) { const int row = i >> 8, gm = i & 255, b = row >> 8, k = row & 255; float y = 0.f;
#pragma unroll 8
        for (int n = 0; n < 256; ++n) { const float a = (float)((k * n) & 255) * (1.0f / 256.0f); y += gr[(b * 256 + n) * 256 + gm] * __builtin_amdgcn_cosf(a) + gi[(b * 256 + n) * 256 + gm] * __builtin_amdgcn_sinf(a); }
        mix[(size_t)(TL + row) * DM + gm] = (bf16)f2bf(y * 0.0078125f); }
}
typedef short bf16x8 __attribute__((ext_vector_type(8)));
#define MFMA16(a, b, c) __builtin_amdgcn_mfma_f32_16x16x32_bf16(a, b, c, 0, 0, 0)
__device__ __forceinline__ bf16x8 mk8(unsigned a, unsigned b, unsigned c, unsigned d) { const v4u v = {a, b, c, d}; return __builtin_bit_cast(bf16x8, v); }
typedef __bf16 bf16x2_t __attribute__((ext_vector_type(2)));
typedef float f32x2_t __attribute__((ext_vector_type(2)));
__device__ __forceinline__ unsigned cvtpk(float lo, float hi) { const f32x2_t f = {lo, hi}; return __builtin_bit_cast(unsigned, __builtin_convertvector(f, bf16x2_t)); }
constexpr int NSC = 66;
constexpr int IM_AI = 0, IM_RI = 4608, IM_BI = 9216, IM_KI = 13824, IM_BKT = 18432, IM_VT = 28672, IM_GAM = 33792, IMG_BYTES = 34816;
constexpr int L_IMG0 = 0, L_IMG1 = IMG_BYTES, L_PKG = 2 * IMG_BYTES, L_YL = L_PKG + 8192, L_VB = L_YL + 128 * 68 * 4, L_BON = L_VB + 128 * 64 * 2, L_CST = L_BON + 512, L_RW_END = L_CST + 2 * 3072;
static_assert(L_RW_END <= 146432, "rwkv LDS map");
constexpr size_t SUM_SLOT = 24576;

__device__ __forceinline__ void lora_transposes(Frame& F) {
    bf16* w2t = (bf16*)(F.ws + WS_W2T); bf16* a2t = (bf16*)(F.ws + WS_A2T); bf16* g2t = (bf16*)(F.ws + WS_G2T);
    const float* w2 = inp(I_W2); const float* a2 = inp(I_A2); const float* g2 = inp(I_G2);
    for (int i = F.bid * NTHR + F.tid; i < 4 * 384 * 64; i += F.G * NTHR) { const int r = i & 63, col = (i >> 6) % 384, ld = i / (384 * 64);
        w2t[i] = (bf16)f2bf(w2[((size_t)ld * 64 + r) * RW + col]); a2t[i] = (bf16)f2bf(a2[((size_t)ld * 64 + r) * RW + col]); }
    for (int i = F.bid * NTHR + F.tid; i < 2 * 384 * 128; i += F.G * NTHR) { const int r = i & 127, col = (i >> 7) % 384, l = i / (384 * 128);
        g2t[i] = (bf16)f2bf(g2[((size_t)l * 128 + r) * RW + col]); }
}

__device__ __forceinline__ float softplus_fast(float x) { return fmaxf(x, 0.f) + __logf(1.0f + __expf(-fabsf(x))); }
__device__ __forceinline__ float tanh_fast(float x) { return 1.0f - 2.0f * __builtin_amdgcn_rcpf(1.0f + __expf(2.0f * x)); }
template <int CTRL> __device__ __forceinline__ float dpp_f(float v) { return __builtin_bit_cast(float, __builtin_amdgcn_update_dpp(0, __builtin_bit_cast(int, v), CTRL, 0xf, 0xf, true)); }
__device__ __forceinline__ void lora_pass(Frame& F, int li) {
    const int q = F.lane >> 4, c16 = F.lane & 15;
#pragma unroll 1
    for (int dir = 0; dir < 2; ++dir) {
        bf16* LW = (bf16*)(F.ws + WS_LW) + (size_t)dir * TT * RW; bf16* IC = (bf16*)(F.ws + WS_IC) + (size_t)dir * TT * RW;
        const bf16* w2t = (const bf16*)(F.ws + WS_W2T) + (size_t)(li * 2 + dir) * 384 * 64; const bf16* a2t = (const bf16*)(F.ws + WS_A2T) + (size_t)(li * 2 + dir) * 384 * 64;
        bf16x8 aw[3][2], aa[3][2]; f32x4 w0v[3], a0v[3];
#pragma unroll
        for (int cti = 0; cti < 3; ++cti) { const int ct = 3 * F.wave + cti, col = 16 * ct + c16;
#pragma unroll
            for (int k = 0; k < 2; ++k) { aw[cti][k] = *(const bf16x8*)(w2t + (size_t)col * 64 + 32 * k + 8 * q); aa[cti][k] = *(const bf16x8*)(a2t + (size_t)col * 64 + 32 * k + 8 * q); }
            w0v[cti] = *(const f32x4*)(inp(I_W0) + (li * 2 + dir) * RW + 16 * ct + 4 * q); a0v[cti] = *(const f32x4*)(inp(I_A0) + (li * 2 + dir) * RW + 16 * ct + 4 * q); }
#pragma unroll 1
        for (int rt = F.bid; rt < TT / 16; rt += F.G) {
            const bf16* z = zrow(F, 16 * rt + c16);
            bf16x8 bw[2], ba[2];
#pragma unroll
            for (int k = 0; k < 2; ++k) { const v4u zw = *(const v4u*)(z + ZW + 64 * dir + 32 * k + 8 * q); ba[k] = *(const bf16x8*)(z + ZA + 64 * dir + 32 * k + 8 * q);
                bw[k] = mk8(cvtpk(tanh_fast(bflo(zw.x)), tanh_fast(bfhi(zw.x))), cvtpk(tanh_fast(bflo(zw.y)), tanh_fast(bfhi(zw.y))), cvtpk(tanh_fast(bflo(zw.z)), tanh_fast(bfhi(zw.z))), cvtpk(tanh_fast(bflo(zw.w)), tanh_fast(bfhi(zw.w)))); }
#pragma unroll
            for (int cti = 0; cti < 3; ++cti) { const int ct = 3 * F.wave + cti;
                f32x4 dw = {0.f, 0.f, 0.f, 0.f}, da = {0.f, 0.f, 0.f, 0.f};
#pragma unroll
                for (int k = 0; k < 2; ++k) { dw = MFMA16(aw[cti][k], bw[k], dw); da = MFMA16(aa[cti][k], ba[k], da); }
                float lw[4], ic[4];
#pragma unroll
                for (int e = 0; e < 4; ++e) { const float x = w0v[cti][e] + dw[e]; const float wl = -softplus_fast(-x) - 0.5f; lw[e] = -__expf(wl); ic[e] = __builtin_amdgcn_rcpf(1.0f + __expf(-(a0v[cti][e] + da[e]))); }
                if (dir == 0) {
#pragma unroll
                    for (int e = 0; e < 4; ++e) { lw[e] += dpp_f<0x111>(lw[e]); lw[e] += dpp_f<0x112>(lw[e]); lw[e] += dpp_f<0x114>(lw[e]); lw[e] += dpp_f<0x118>(lw[e]); } }
                else {
#pragma unroll
                    for (int e = 0; e < 4; ++e) { lw[e] += dpp_f<0x101>(lw[e]); lw[e] += dpp_f<0x102>(lw[e]); lw[e] += dpp_f<0x104>(lw[e]); lw[e] += dpp_f<0x108>(lw[e]); } }
#pragma unroll
                for (int e = 0; e < 4; ++e) lw[e] = __expf(lw[e]);
                if (c16 == (dir == 0 ? 15 : 0)) *(f32x4*)((float*)(F.ws + WS_GAM32) + ((size_t)dir * (TT / 16) + rt) * RW + 16 * ct + 4 * q) = (f32x4){lw[0], lw[1], lw[2], lw[3]};
                const size_t o = (size_t)(16 * rt + c16) * RW + 16 * ct + 4 * q;
                v2u w; w.x = cvtpk(lw[0], lw[1]); w.y = cvtpk(lw[2], lw[3]); *(v2u*)(LW + o) = w; w.x = cvtpk(ic[0], ic[1]); w.y = cvtpk(ic[2], ic[3]); *(v2u*)(IC + o) = w; }
        }
    }
}
__device__ __forceinline__ void chain_consts_lds(Frame& F, LAS float* cst, int li, int h, int t256) {
    for (int i = t256; i < 12 * 64; i += 256) { const int k = i >> 6, j = i & 63, ch = 64 * h + j; float v;
        if (k == 0) v = inp(I_KK)[li * RW + ch]; else if (k == 1) v = inp(I_KA)[li * RW + ch]; else if (k == 2) v = inp(I_RK)[li * RW + ch];
        else { const int tt = (k - 3) / 3, w = (k - 3) % 3; v = inp(I_CONV)[(size_t)(li * 3 + tt) * (3 * RW) + w * RW + ch]; }
        cst[i] = v; }
}
struct PrepRaw { v4u ecw, icv, epw, zr[3], zk[3], zv[3]; };
__device__ __forceinline__ void prep_load(Frame& F, PrepRaw& R, int dir, int b, int h, int tl, int o, bool isctx, int step0) {
    const int L = isctx ? CTX : SEQ, rbase = isctx ? TL + b * CTX : b * SEQ, ch0 = 64 * h + 8 * o;
    const int s = step0 + tl; const int p = dir ? L - 1 - s : s; const int row = rbase + p, tb = tl & 15;
    { const bf16* LW = (const bf16*)(F.ws + WS_LW) + (size_t)dir * TT * RW + ch0; const bf16* IC = (const bf16*)(F.ws + WS_IC) + (size_t)dir * TT * RW + ch0;
      R.ecw = *(const v4u*)(LW + (size_t)row * RW); R.icv = *(const v4u*)(IC + (size_t)row * RW); R.epw = *(const v4u*)(LW + (size_t)(tb == 0 ? row : (dir ? row + 1 : row - 1)) * RW); }
#pragma unroll
    for (int tt = 0; tt < 3; ++tt) { const int pp = p + tt - 1; const bool ok = pp >= 0 && pp < L; const bf16* z = zrow(F, rbase + (ok ? pp : p)) + ch0;
        const v4u z0 = {0u, 0u, 0u, 0u};
        R.zr[tt] = ok ? *(const v4u*)(z + ZRR) : z0; R.zk[tt] = ok ? *(const v4u*)(z + ZRK) : z0; R.zv[tt] = ok ? *(const v4u*)(z + ZRV) : z0; }
}
__device__ __forceinline__ void prep_compute(Frame& F, const PrepRaw& R, const LAS float* cst, LAS unsigned char* img, int dir, int b, int h, int tl, int o, bool isctx, int step0, LAS unsigned char* lds_vb, LAS float* lds_bon, int pos0_local) {
    const bool BONUS = lds_vb != nullptr;
    const int L = isctx ? CTX : SEQ, rbase = isctx ? TL + b * CTX : b * SEQ, ch0 = 64 * h + 8 * o;
    const int blk = tl >> 4, tb = tl & 15;
    const int s = step0 + tl; const int p = dir ? L - 1 - s : s; const int row = rbase + p;
    const v4u ecw = R.ecw, icv = R.icv, epw = R.epw;
    v4u zr[3], zk[3], zv[3];
#pragma unroll
    for (int tt = 0; tt < 3; ++tt) { zr[tt] = R.zr[tt]; zk[tt] = R.zk[tt]; zv[tt] = R.zv[tt]; }
    float ecf[8], epf[8], ai[8], rv[8], kv[8], vv[8];
    unpack8(ecw, ecf); unpack8(epw, epf); unpack8(icv, ai);
#pragma unroll
    for (int e = 0; e < 8; ++e) { rv[e] = 0.f; kv[e] = 0.f; vv[e] = 0.f; }
#pragma unroll
    for (int tt = 0; tt < 3; ++tt) { float a[8], bq[8], cq[8]; unpack8(zr[tt], a); unpack8(zk[tt], bq); unpack8(zv[tt], cq);
        const LAS f32x4* w0 = (const LAS f32x4*)(cst + (3 + tt * 3 + 0) * 64 + 8 * o); const LAS f32x4* w1 = (const LAS f32x4*)(cst + (3 + tt * 3 + 1) * 64 + 8 * o); const LAS f32x4* w2 = (const LAS f32x4*)(cst + (3 + tt * 3 + 2) * 64 + 8 * o);
        const f32x4 w0a = w0[0], w0b = w0[1], w1a = w1[0], w1b = w1[1], w2a = w2[0], w2b = w2[1];
#pragma unroll
        for (int e = 0; e < 4; ++e) { rv[e] += w0a[e] * a[e]; rv[e + 4] += w0b[e] * a[e + 4]; kv[e] += w1a[e] * bq[e]; kv[e + 4] += w1b[e] * bq[e + 4]; vv[e] += w2a[e] * cq[e]; vv[e + 4] += w2b[e] * cq[e + 4]; } }
    float kkw[8], kaw[8];
    { const LAS f32x4* a = (const LAS f32x4*)(cst + 0 * 64 + 8 * o); const LAS f32x4* bq = (const LAS f32x4*)(cst + 1 * 64 + 8 * o); const f32x4 a0 = a[0], a1 = a[1], b0 = bq[0], b1 = bq[1];
#pragma unroll
      for (int e = 0; e < 4; ++e) { kkw[e] = a0[e]; kkw[e + 4] = a1[e]; kaw[e] = b0[e]; kaw[e + 4] = b1[e]; } }
    float kkr[8], ss = 0.f;
#pragma unroll
    for (int e = 0; e < 8; ++e) { kkr[e] = kv[e] * kkw[e]; ss += kkr[e] * kkr[e]; }
    ss += __shfl_xor(ss, 1); ss += __shfl_xor(ss, 2); ss += __shfl_xor(ss, 4);
    const float rn = 1.0f / sqrtf(fmaxf(ss, 1e-24f));
    float At[8], Rt[8], Bt[8], Kt[8];
#pragma unroll
    for (int e = 0; e < 8; ++e) { const float kk = kkr[e] * rn, kd = kv[e] * (1.0f + (ai[e] - 1.0f) * kaw[e]); const float eprev = tb == 0 ? 1.0f : epf[e]; const float ec = ecf[e], en = 1.0f / ec;
        At[e] = -kk * eprev; Rt[e] = rv[e] * ec; Bt[e] = kk * ai[e] * en; Kt[e] = kd * en; }
    const int P0 = 32 * (o >> 2) + 16 * (o & 1) + 4 * ((o >> 1) & 1);
    LAS bf16* AI = (LAS bf16*)(img + IM_AI) + blk * 1152 + tb * 72 + P0, *RI = (LAS bf16*)(img + IM_RI) + blk * 1152 + tb * 72 + P0, *BI = (LAS bf16*)(img + IM_BI) + blk * 1152 + tb * 72 + P0, *KI = (LAS bf16*)(img + IM_KI) + blk * 1152 + tb * 72 + P0;
    unsigned bp[4], kp[4];
#pragma unroll
    for (int e = 0; e < 4; ++e) { bp[e] = cvtpk(Bt[2 * e], Bt[2 * e + 1]); kp[e] = cvtpk(Kt[2 * e], Kt[2 * e + 1]); }
    *(LAS v2u*)AI = (v2u){cvtpk(At[0], At[1]), cvtpk(At[2], At[3])}; *(LAS v2u*)(AI + 8) = (v2u){cvtpk(At[4], At[5]), cvtpk(At[6], At[7])};
    *(LAS v2u*)RI = (v2u){cvtpk(Rt[0], Rt[1]), cvtpk(Rt[2], Rt[3])}; *(LAS v2u*)(RI + 8) = (v2u){cvtpk(Rt[4], Rt[5]), cvtpk(Rt[6], Rt[7])};
    *(LAS v2u*)BI = (v2u){bp[0], bp[1]}; *(LAS v2u*)(BI + 8) = (v2u){bp[2], bp[3]};
    *(LAS v2u*)KI = (v2u){kp[0], kp[1]}; *(LAS v2u*)(KI + 8) = (v2u){kp[2], kp[3]};
    LAS bf16* BKT = (LAS bf16*)(img + IM_BKT) + blk * 2560 + (8 * o) * 40 + (tb >> 2) * 8 + (tb & 3); LAS bf16* VT = (LAS bf16*)(img + IM_VT) + blk * 1280 + (8 * o) * 20 + tb;
    const unsigned vp[4] = {cvtpk(vv[0], vv[1]), cvtpk(vv[2], vv[3]), cvtpk(vv[4], vv[5]), cvtpk(vv[6], vv[7])};
#pragma unroll
    for (int e = 0; e < 8; ++e) { const unsigned bb = bp[e >> 1], kq = kp[e >> 1], vq = vp[e >> 1];
        BKT[e * 40] = (bf16)((e & 1) ? (bb >> 16) : (bb & 0xffff)); BKT[e * 40 + 4] = (bf16)((e & 1) ? (kq >> 16) : (kq & 0xffff)); VT[e * 20] = (bf16)((e & 1) ? (vq >> 16) : (vq & 0xffff)); }
    if (tb == 15) { const f32x4* gs = (const f32x4*)((const float*)(F.ws + WS_GAM32) + ((size_t)dir * (TT / 16) + (row >> 4)) * RW + ch0); LAS f32x4* G = (LAS f32x4*)((LAS float*)(img + IM_GAM) + blk * 64 + 8 * o); G[0] = gs[0]; G[1] = gs[1]; }
    if (BONUS) { float bs = 0.f; const LAS f32x4* rk = (const LAS f32x4*)(cst + 2 * 64 + 8 * o); const f32x4 r0 = rk[0], r1 = rk[1];
#pragma unroll
        for (int e = 0; e < 4; ++e) bs += rv[e] * kv[e] * r0[e] + rv[e + 4] * kv[e + 4] * r1[e];
        bs += __shfl_xor(bs, 1); bs += __shfl_xor(bs, 2); bs += __shfl_xor(bs, 4);
        const int pl = dir ? pos0_local - tl : pos0_local + tl;
        *(LAS v4u*)(lds_vb + (pl * 64 + 8 * o) * 2) = (v4u){vp[0], vp[1], vp[2], vp[3]}; if (o == 0) lds_bon[pl] = bs; }
}
template <bool WANT_Y>
__device__ __forceinline__ void block_package(LAS unsigned char* img, int blk, LAS unsigned* pkg, int lane) {
    const int q = lane >> 4, c = lane & 15;
    f32x4 mab = {0.f, 0.f, 0.f, 0.f}, mak = mab, mbr = mab, mkr = mab;
#pragma unroll
    for (int k = 0; k < 2; ++k) { const int o = blk * 2304 + c * 144 + k * 64 + q * 16;
        const bf16x8 bi = *(const LAS bf16x8*)(img + IM_BI + o), ki = *(const LAS bf16x8*)(img + IM_KI + o), ai = *(const LAS bf16x8*)(img + IM_AI + o);
        mab = MFMA16(bi, ai, mab); mak = MFMA16(ki, ai, mak);
        if constexpr (WANT_Y) { const bf16x8 ri = *(const LAS bf16x8*)(img + IM_RI + o); mbr = MFMA16(bi, ri, mbr); mkr = MFMA16(ki, ri, mkr); } }
#pragma unroll
    for (int e = 0; e < 4; ++e) { const int s = 4 * q + e; if (!(s < c)) { mab[e] = 0.f; mak[e] = 0.f; } if (!(s <= c)) { mbr[e] = 0.f; mkr[e] = 0.f; } }
    f32x4 mabT = {0.f, 0.f, 0.f, 0.f};
#pragma unroll
    for (int k = 0; k < 2; ++k) { const int o = blk * 2304 + c * 144 + k * 64 + q * 16; mabT = MFMA16(*(const LAS bf16x8*)(img + IM_AI + o), *(const LAS bf16x8*)(img + IM_BI + o), mabT); }
#pragma unroll
    for (int e = 0; e < 4; ++e) if (!(c < 4 * q + e)) mabT[e] = 0.f;
    const f32x4 z4 = {0.f, 0.f, 0.f, 0.f};
#define OPND(x) mk8(cvtpk((x)[0], (x)[1]), cvtpk((x)[2], (x)[3]), 0u, 0u)
    const bf16x8 oM = OPND(mab), oMT = OPND(mabT);
    const f32x4 m2 = MFMA16(oMT, oM, z4), m2T = MFMA16(oM, oMT, z4);
    const bf16x8 oM2 = OPND(m2), oM2T = OPND(m2T);
    const f32x4 m4 = MFMA16(oM2T, oM2, z4), m4T = MFMA16(oM2, oM2T, z4);
    const f32x4 m8T = MFMA16(OPND(m4), OPND(m4T), z4);
    f32x4 nn = m2;
#pragma unroll
    for (int e = 0; e < 4; ++e) nn[e] += (4 * q + e == c) ? 1.0f : 0.0f;
    nn = MFMA16(oMT, OPND(nn), nn);
    nn = MFMA16(OPND(m4T), OPND(nn), nn);
    nn = MFMA16(OPND(m8T), OPND(nn), nn);
#undef OPND
    pkg[0 * 64 + lane] = cvtpk(nn[0], nn[1]); pkg[1 * 64 + lane] = cvtpk(nn[2], nn[3]);
    pkg[2 * 64 + lane] = cvtpk(mak[0], mak[1]); pkg[3 * 64 + lane] = cvtpk(mak[2], mak[3]);
    if constexpr (WANT_Y) { pkg[4 * 64 + lane] = cvtpk(mbr[0], mbr[1]); pkg[5 * 64 + lane] = cvtpk(mbr[2], mbr[3]); pkg[6 * 64 + lane] = cvtpk(mkr[0], mkr[1]); pkg[7 * 64 + lane] = cvtpk(mkr[2], mkr[3]); }
}
template <bool WANT_Y, bool HAS_V>
__device__ __forceinline__ f32x4 block_scan(LAS unsigned char* img, int blk, const LAS unsigned* pkg, f32x4 (&S)[4], int wq, int lane) {
    const int q = lane >> 4, c = lane & 15;
    bf16x8 Sb[2];
#pragma unroll
    for (int k = 0; k < 2; ++k) Sb[k] = mk8(cvtpk(S[2 * k][0], S[2 * k][1]), cvtpk(S[2 * k][2], S[2 * k][3]), cvtpk(S[2 * k + 1][0], S[2 * k + 1][1]), cvtpk(S[2 * k + 1][2], S[2 * k + 1][3]));
    v2u vpk = {0u, 0u};
    if constexpr (HAS_V) vpk = *(const LAS v2u*)(img + IM_VT + blk * 2560 + (c + 16 * wq) * 40 + q * 8);
    const int ao = blk * 2304 + c * 144 + q * 16;
    f32x4 rhs = {0.f, 0.f, 0.f, 0.f};
    rhs = MFMA16(*(const LAS bf16x8*)(img + IM_AI + ao), Sb[0], rhs); rhs = MFMA16(*(const LAS bf16x8*)(img + IM_AI + ao + 64), Sb[1], rhs);
    if constexpr (HAS_V) rhs = MFMA16(mk8(0u, 0u, pkg[2 * 64 + lane], pkg[3 * 64 + lane]), mk8(0u, 0u, vpk.x, vpk.y), rhs);
    f32x4 u = {0.f, 0.f, 0.f, 0.f};
    u = MFMA16(mk8(pkg[0 * 64 + lane], pkg[1 * 64 + lane], 0u, 0u), mk8(cvtpk(rhs[0], rhs[1]), cvtpk(rhs[2], rhs[3]), 0u, 0u), u);
    const bf16x8 UV = mk8(cvtpk(u[0], u[1]), cvtpk(u[2], u[3]), vpk.x, vpk.y);
    f32x4 y = {0.f, 0.f, 0.f, 0.f};
    if constexpr (WANT_Y) { y = MFMA16(*(const LAS bf16x8*)(img + IM_RI + ao), Sb[0], y); y = MFMA16(*(const LAS bf16x8*)(img + IM_RI + ao + 64), Sb[1], y);
        y = MFMA16(mk8(pkg[4 * 64 + lane], pkg[5 * 64 + lane], pkg[6 * 64 + lane], pkg[7 * 64 + lane]), UV, y); }
#pragma unroll
    for (int T = 0; T < 4; ++T) { const bf16x8 bkt = *(const LAS bf16x8*)(img + IM_BKT + blk * 5120 + (16 * T + c) * 80 + q * 16);
        S[T] = MFMA16(bkt, UV, S[T]); const f32x4 g = *(const LAS f32x4*)(img + IM_GAM + blk * 256 + (16 * T + 4 * q) * 4); S[T] = S[T] * g; }
    return y;
}
__device__ __forceinline__ unsigned char* sum_slot(Frame& F, int chain, int sc) { return (unsigned char*)F.out + OUT_SUM + (size_t)(chain * NSC + sc) * SUM_SLOT; }

__device__ __forceinline__ void rwkv_pass1_pair(Frame& F, int li, int pair) {
    const int g = F.wave >> 2, wq = F.wave & 3, u = 2 * pair + g;
    const int chain = u / (NSC - 1), sc = u % (NSC - 1);
    const int dir = chain / 12, b = (chain / 6) & 1, h = chain % 6;
    const bool isctx = sc < 2; const int scl = isctx ? sc : sc - 2;
    LAS unsigned char* img = F.lds + (g ? L_IMG1 : L_IMG0); LAS unsigned* pkg = (LAS unsigned*)(F.lds + L_PKG) + g * 1024;
    LAS float* cst = (LAS float*)(F.lds + L_CST) + g * 768;
    __syncthreads();
    chain_consts_lds(F, cst, li, h, F.tid & 255);
    const int q = F.lane >> 4, c = F.lane & 15;
    f32x4 SB[4], SA[4];
#pragma unroll
    for (int T = 0; T < 4; ++T)
#pragma unroll
        for (int e = 0; e < 4; ++e) { SB[T][e] = 0.0f; SA[T][e] = (16 * T + 4 * q + e == c + 16 * wq) ? 1.0f : 0.0f; }
    PrepRaw R;
    prep_load(F, R, dir, b, h, 8 * wq + (F.lane >> 3), F.lane & 7, isctx, 128 * scl);
#pragma unroll 1
    for (int rd = 0; rd < 4; ++rd) {
        __syncthreads();
        prep_compute(F, R, cst, img, dir, b, h, 8 * wq + (F.lane >> 3), F.lane & 7, isctx, 128 * scl + 32 * rd, nullptr, nullptr, 0);
        __syncthreads();
        if (rd < 3) prep_load(F, R, dir, b, h, 8 * wq + (F.lane >> 3), F.lane & 7, isctx, 128 * scl + 32 * (rd + 1));
        if (wq < 2) block_package<false>(img, wq, pkg + wq * 512, F.lane);
        __syncthreads();
#pragma unroll
        for (int blk = 0; blk < 2; ++blk) { block_scan<false, true>(img, blk, pkg + blk * 512, SB, wq, F.lane); block_scan<false, false>(img, blk, pkg + blk * 512, SA, wq, F.lane); }
    }
    unsigned char* slot = sum_slot(F, chain, sc);
    { f32x4* braw = (f32x4*)slot;
#pragma unroll
      for (int T = 0; T < 4; ++T) braw[(wq * 4 + T) * 64 + F.lane] = SB[T]; }
    { bf16* aim = (bf16*)(slot + 16384); const int kap = wq >> 1, e = (F.lane & 3) + 4 * (wq & 1), qc = c >> 2;
#pragma unroll
      for (int T = 0; T < 4; ++T)
#pragma unroll
          for (int r = 0; r < 4; ++r) { const int lc = (4 * q + r) + 16 * qc; aim[((T * 2 + kap) * 64 + lc) * 8 + e] = (bf16)f2bf(SA[T][r]); } }
}
struct P2Buf { f32x4 Bc[4]; bf16x8 af[4][2]; };
__device__ __forceinline__ void p2_load(Frame& F, P2Buf& X, int chain, int sc, int wq) {
    unsigned char* slot = sum_slot(F, chain, sc); const f32x4* braw = (const f32x4*)slot; const bf16* aim = (const bf16*)(slot + 16384);
#pragma unroll
    for (int T = 0; T < 4; ++T) { X.Bc[T] = braw[(wq * 4 + T) * 64 + F.lane];
#pragma unroll
        for (int k = 0; k < 2; ++k) X.af[T][k] = *(const bf16x8*)(aim + ((T * 2 + k) * 64 + F.lane) * 8); }
}
__device__ __forceinline__ void p2_step(Frame& F, const P2Buf& X, f32x4 (&S)[4], int chain, int sc, int wq) {
    f32x4* braw = (f32x4*)sum_slot(F, chain, sc);
    bf16x8 Sb[2];
#pragma unroll
    for (int k = 0; k < 2; ++k) Sb[k] = mk8(cvtpk(S[2 * k][0], S[2 * k][1]), cvtpk(S[2 * k][2], S[2 * k][3]), cvtpk(S[2 * k + 1][0], S[2 * k + 1][1]), cvtpk(S[2 * k + 1][2], S[2 * k + 1][3]));
#pragma unroll
    for (int T = 0; T < 4; ++T) { braw[(wq * 4 + T) * 64 + F.lane] = S[T]; const f32x4 a = MFMA16(X.af[T][0], Sb[0], X.Bc[T]); S[T] = MFMA16(X.af[T][1], Sb[1], a); }
}
__device__ __forceinline__ void rwkv_pass2_chain(Frame& F, int chain) {
    if (F.wave >= 4) return;
    const int wq = F.wave; constexpr int NS = NSC - 1;
    f32x4 S[4];
#pragma unroll
    for (int T = 0; T < 4; ++T) S[T] = (f32x4){0.f, 0.f, 0.f, 0.f};
    P2Buf X0, X1, X2;
    p2_load(F, X0, chain, 0, wq); p2_load(F, X1, chain, 1, wq); p2_load(F, X2, chain, 2, wq);
#pragma unroll 1
    for (int sc = 0; sc < NS; sc += 3) {
        p2_step(F, X0, S, chain, sc, wq); if (sc + 3 < NS) p2_load(F, X0, chain, sc + 3, wq);
        if (sc + 1 < NS) { p2_step(F, X1, S, chain, sc + 1, wq); if (sc + 4 < NS) p2_load(F, X1, chain, sc + 4, wq); }
        if (sc + 2 < NS) { p2_step(F, X2, S, chain, sc + 2, wq); if (sc + 5 < NS) p2_load(F, X2, chain, sc + 5, wq); }
    }
    { f32x4* braw = (f32x4*)sum_slot(F, chain, NSC - 1);
#pragma unroll
      for (int T = 0; T < 4; ++T) braw[(wq * 4 + T) * 64 + F.lane] = S[T]; }
}
__device__ __forceinline__ void rwkv_pass3_unit(Frame& F, int li, int u) {
    const int pc = u % NSC, bh = u / NSC, b = bh / 6, h = bh % 6;
    const bool isctx = pc < 2; const int pcl = isctx ? pc : pc - 2, nsc = isctx ? 2 : 64;
    const int dir = F.wave >> 2, wq = F.wave & 3, q = F.lane >> 4, c = F.lane & 15;
    const int sc = dir == 0 ? pc : (isctx ? 1 - pcl : 2 + 63 - pcl);
    const int scl = dir == 0 ? pcl : nsc - 1 - pcl;
    const int chain = dir * 12 + b * 6 + h;
    LAS unsigned char* img = F.lds + (dir ? L_IMG1 : L_IMG0); LAS unsigned* pkg = (LAS unsigned*)(F.lds + L_PKG) + dir * 1024;
    LAS float* YL = (LAS float*)(F.lds + L_YL); LAS unsigned char* VB = F.lds + L_VB; LAS float* BON = (LAS float*)(F.lds + L_BON);
    LAS float* cst = (LAS float*)(F.lds + L_CST);
    __syncthreads();
    if (F.tid < 256) chain_consts_lds(F, cst, li, h, F.tid);
    f32x4 S[4];
    { const f32x4* braw = (const f32x4*)sum_slot(F, chain, sc);
#pragma unroll
      for (int T = 0; T < 4; ++T) S[T] = braw[(wq * 4 + T) * 64 + F.lane]; }
    __syncthreads();
    for (int i = F.tid; i < 128 * 68; i += NTHR) YL[i] = 0.f;
    PrepRaw R;
    prep_load(F, R, dir, b, h, 8 * wq + (F.lane >> 3), F.lane & 7, isctx, 128 * scl);
#pragma unroll 1
    for (int rd = 0; rd < 4; ++rd) {
        __syncthreads();
        prep_compute(F, R, cst, img, dir, b, h, 8 * wq + (F.lane >> 3), F.lane & 7, isctx, 128 * scl + 32 * rd, dir == 0 ? VB : (LAS unsigned char*)nullptr, BON, 32 * rd);
        __syncthreads();
        if (rd < 3) prep_load(F, R, dir, b, h, 8 * wq + (F.lane >> 3), F.lane & 7, isctx, 128 * scl + 32 * (rd + 1));
        if (wq < 2) block_package<true>(img, wq, pkg + wq * 512, F.lane);
        __syncthreads();
#pragma unroll
        for (int blk = 0; blk < 2; ++blk) { const f32x4 y = block_scan<true, true>(img, blk, pkg + blk * 512, S, wq, F.lane);
#pragma unroll
            for (int e = 0; e < 4; ++e) { const int t = 32 * rd + 16 * blk + 4 * q + e; const int pl = dir ? 127 - t : t; YL[pl * 68 + c + 16 * wq] += y[e]; } }
    }
    __syncthreads();
    const int wv = F.wave; const int rbase = (isctx ? TL + b * CTX : b * SEQ) + 128 * pcl;
    const bf16* g2t = (const bf16*)(F.ws + WS_G2T) + (size_t)li * 384 * 128;
    f32x4 gate[4];
#pragma unroll
    for (int nt = 0; nt < 4; ++nt) gate[nt] = (f32x4){0.f, 0.f, 0.f, 0.f};
#pragma unroll
    for (int k = 0; k < 4; ++k) { const v4u zg = *(const v4u*)(zrow(F, rbase + 16 * wv + c) + ZG + 32 * k + 8 * q);
#define SG(x) (1.0f / (1.0f + __expf(-(x))))
        const bf16x8 a = mk8(pk2(SG(bflo(zg.x)), SG(bfhi(zg.x))), pk2(SG(bflo(zg.y)), SG(bfhi(zg.y))), pk2(SG(bflo(zg.z)), SG(bfhi(zg.z))), pk2(SG(bflo(zg.w)), SG(bfhi(zg.w))));
#undef SG
#pragma unroll
        for (int nt = 0; nt < 4; ++nt) { const bf16x8 bb = *(const bf16x8*)(g2t + (size_t)(64 * h + 16 * nt + c) * 128 + 32 * k + 8 * q); gate[nt] = MFMA16(a, bb, gate[nt]); } }
    bf16* mix = (bf16*)(F.ws + WS_H);
    float lg[4], lb[4];
#pragma unroll
    for (int nt = 0; nt < 4; ++nt) { lg[nt] = inp(I_LNG)[li * RW + 64 * h + 16 * nt + c]; lb[nt] = inp(I_LNB)[li * RW + 64 * h + 16 * nt + c]; }
#pragma unroll
    for (int e = 0; e < 4; ++e) { const int tl = 16 * wv + 4 * q + e;
        float yv[4], s = 0.f;
#pragma unroll
        for (int nt = 0; nt < 4; ++nt) { yv[nt] = YL[tl * 68 + 16 * nt + c]; s += yv[nt]; }
        s += __shfl_xor(s, 1); s += __shfl_xor(s, 2); s += __shfl_xor(s, 4); s += __shfl_xor(s, 8);
        const float mu = s * (1.0f / 64.0f); float v2 = 0.f;
#pragma unroll
        for (int nt = 0; nt < 4; ++nt) { yv[nt] -= mu; v2 += yv[nt] * yv[nt]; }
        v2 += __shfl_xor(v2, 1); v2 += __shfl_xor(v2, 2); v2 += __shfl_xor(v2, 4); v2 += __shfl_xor(v2, 8);
        const float rs = 1.0f / sqrtf(v2 * (1.0f / 64.0f) + GN_EPS); const float bon = BON[tl];
#pragma unroll
        for (int nt = 0; nt < 4; ++nt) { const float vv = bf2f(((const LAS bf16*)VB)[tl * 64 + 16 * nt + c]);
            const float o = (yv[nt] * rs * lg[nt] + lb[nt] + bon * vv) * gate[nt][e];
            mix[(size_t)(rbase + tl) * DM + 640 + 64 * h + 16 * nt + c] = (bf16)f2bf(o); } }
}

constexpr int AT_KROW = 144;
__device__ __forceinline__ void attn_unit(Frame& F, int li, int u) {
    const bool cq = u >= 256;
    int b, kvh, qb;
    if (!cq) { b = u >> 7; kvh = (u >> 6) & 1; qb = u & 63; } else { const int uu = u - 256; b = uu >> 2; kvh = (uu >> 1) & 1; qb = uu & 1; }
    const int c = F.lane & 15, q = F.lane >> 4, tb = F.wave;
    bf16* mix = (bf16*)(F.ws + WS_H);
    const float* rct = (const float*)(F.ws + WS_ROPE); const float* rst = rct + SEQ * 32;
    const int qrow = (cq ? TL + b * CTX : b * SEQ) + 128 * qb + 16 * tb + c;
    const int qpos = 128 * qb + 16 * tb + c;
    bf16x8 Q[3][2];
    { float cs[8], sn[8];
      if (!cq) { const f32x4 c0 = *(const f32x4*)(rct + qpos * 32 + 8 * q), c1 = *(const f32x4*)(rct + qpos * 32 + 8 * q + 4), s0 = *(const f32x4*)(rst + qpos * 32 + 8 * q), s1 = *(const f32x4*)(rst + qpos * 32 + 8 * q + 4);
#pragma unroll
          for (int e = 0; e < 4; ++e) { cs[e] = c0[e]; cs[e + 4] = c1[e]; sn[e] = s0[e]; sn[e + 4] = s1[e]; } }
      else {
#pragma unroll
          for (int e = 0; e < 8; ++e) { cs[e] = 1.0f; sn[e] = 0.0f; } }
#pragma unroll
      for (int hh = 0; hh < 3; ++hh) { const bf16* zq = zrow(F, qrow) + ZQ + 64 * (3 * kvh + hh) + 8 * q; float x1[8], x2[8]; unpack8(*(const v4u*)zq, x1); unpack8(*(const v4u*)(zq + 32), x2);
          float o1[8], o2[8];
#pragma unroll
          for (int e = 0; e < 8; ++e) { o1[e] = 0.125f * (x1[e] * cs[e] - x2[e] * sn[e]); o2[e] = 0.125f * (x2[e] * cs[e] + x1[e] * sn[e]); }
          Q[hh][0] = mk8(pk2(o1[0], o1[1]), pk2(o1[2], o1[3]), pk2(o1[4], o1[5]), pk2(o1[6], o1[7])); Q[hh][1] = mk8(pk2(o2[0], o2[1]), pk2(o2[2], o2[3]), pk2(o2[4], o2[5]), pk2(o2[6], o2[7])); } }
    float m[3], l[3]; f32x4 O[3][4];
#pragma unroll
    for (int hh = 0; hh < 3; ++hh) { m[hh] = inp(I_SINK)[li * 6 + 3 * kvh + hh]; l[hh] = q == 0 ? 1.0f : 0.0f;
#pragma unroll
        for (int dt = 0; dt < 4; ++dt) O[hh][dt] = (f32x4){0.f, 0.f, 0.f, 0.f}; }
    LAS unsigned char* KI = F.lds;
#pragma unroll 1
    for (int stage = cq ? 1 : 0; stage < 2; ++stage) {
        const int nkeys = stage == 0 ? 384 : 256; const int vstride = (nkeys + 8) * 2;
        LAS unsigned char* VTI = F.lds + 384 * AT_KROW;
        const int kpos0 = 128 * (qb - 1);
        __syncthreads();
        for (int pc = F.tid; pc < nkeys * 4; pc += NTHR) { const int key = pc >> 2, o = pc & 3;
            const bf16* zk; float cs[8], sn[8];
            if (stage == 0) { int kp = kpos0 + key; kp = kp < 0 ? 0 : (kp >= SEQ ? SEQ - 1 : kp); zk = zrow(F, b * SEQ + kp) + 64 * kvh + 8 * o;
                const f32x4 c0 = *(const f32x4*)(rct + kp * 32 + 8 * o), c1 = *(const f32x4*)(rct + kp * 32 + 8 * o + 4), s0 = *(const f32x4*)(rst + kp * 32 + 8 * o), s1 = *(const f32x4*)(rst + kp * 32 + 8 * o + 4);
#pragma unroll
                for (int e = 0; e < 4; ++e) { cs[e] = c0[e]; cs[e + 4] = c1[e]; sn[e] = s0[e]; sn[e + 4] = s1[e]; } }
            else { zk = zrow(F, TL + b * CTX + key) + 64 * kvh + 8 * o;
#pragma unroll
                for (int e = 0; e < 8; ++e) { cs[e] = 1.0f; sn[e] = 0.0f; } }
            const v4u k1 = *(const v4u*)(zk + ZK), k2 = *(const v4u*)(zk + ZK + 32), v1 = *(const v4u*)(zk + ZV), v2 = *(const v4u*)(zk + ZV + 32);
            float x1[8], x2[8]; unpack8(k1, x1); unpack8(k2, x2);
            float o1[8], o2[8];
#pragma unroll
            for (int e = 0; e < 8; ++e) { o1[e] = x1[e] * cs[e] - x2[e] * sn[e]; o2[e] = x2[e] * cs[e] + x1[e] * sn[e]; }
            *(LAS v4u*)(KI + key * AT_KROW + o * 16) = (v4u){pk2(o1[0], o1[1]), pk2(o1[2], o1[3]), pk2(o1[4], o1[5]), pk2(o1[6], o1[7])};
            *(LAS v4u*)(KI + key * AT_KROW + 64 + o * 16) = (v4u){pk2(o2[0], o2[1]), pk2(o2[2], o2[3]), pk2(o2[4], o2[5]), pk2(o2[6], o2[7])};
            const int kl = key & 31; const int col = (key & ~31) | (((kl & 15) >> 2) << 3) | ((kl >> 4) << 2) | (kl & 3);
#pragma unroll
            for (int hv = 0; hv < 2; ++hv) { const v4u vv = hv ? v2 : v1; LAS bf16* vt = (LAS bf16*)(VTI + (8 * (o + 4 * hv)) * vstride) + col;
                vt[0] = (bf16)(vv.x & 0xffff); *(LAS bf16*)((LAS unsigned char*)vt + vstride) = (bf16)(vv.x >> 16);
                *(LAS bf16*)((LAS unsigned char*)vt + 2 * vstride) = (bf16)(vv.y & 0xffff); *(LAS bf16*)((LAS unsigned char*)vt + 3 * vstride) = (bf16)(vv.y >> 16);
                *(LAS bf16*)((LAS unsigned char*)vt + 4 * vstride) = (bf16)(vv.z & 0xffff); *(LAS bf16*)((LAS unsigned char*)vt + 5 * vstride) = (bf16)(vv.z >> 16);
                *(LAS bf16*)((LAS unsigned char*)vt + 6 * vstride) = (bf16)(vv.w & 0xffff); *(LAS bf16*)((LAS unsigned char*)vt + 7 * vstride) = (bf16)(vv.w >> 16); } }
        __syncthreads();
        const int npair = nkeys / 32;
        const int Q0 = 128 * qb + 16 * tb;
#pragma unroll 1
        for (int kp = 0; kp < npair; ++kp) {
            const int kb = kpos0 + 32 * kp;
            if (stage == 0 && (kb + 31 < Q0 - 128 || kb > Q0 + 143 || kb + 31 < 0 || kb >= SEQ)) continue;
            bf16x8 K[2][2], V[4];
#pragma unroll
            for (int t = 0; t < 2; ++t)
#pragma unroll
                for (int k = 0; k < 2; ++k) K[t][k] = *(const LAS bf16x8*)(KI + (32 * kp + 16 * t + c) * AT_KROW + k * 64 + q * 16);
#pragma unroll
            for (int dt = 0; dt < 4; ++dt) V[dt] = *(const LAS bf16x8*)(VTI + (16 * dt + c) * vstride + kp * 64 + q * 16);
            bool ok0[4], ok1[4];
#pragma unroll
            for (int e = 0; e < 4; ++e) { const int k0 = kb + 4 * q + e, k1 = k0 + 16;
                ok0[e] = stage == 1 || (k0 >= 0 && k0 < SEQ && k0 >= qpos - 128 && k0 <= qpos + 128);
                ok1[e] = stage == 1 || (k1 >= 0 && k1 < SEQ && k1 >= qpos - 128 && k1 <= qpos + 128); }
#pragma unroll
            for (int hh = 0; hh < 3; ++hh) {
                f32x4 s0 = {0.f, 0.f, 0.f, 0.f}, s1 = {0.f, 0.f, 0.f, 0.f};
                s0 = MFMA16(K[0][0], Q[hh][0], s0); s0 = MFMA16(K[0][1], Q[hh][1], s0);
                s1 = MFMA16(K[1][0], Q[hh][0], s1); s1 = MFMA16(K[1][1], Q[hh][1], s1);
                float mx = -INFINITY;
#pragma unroll
                for (int e = 0; e < 4; ++e) { s0[e] = ok0[e] ? s0[e] : -INFINITY; s1[e] = ok1[e] ? s1[e] : -INFINITY; mx = fmaxf(mx, fmaxf(s0[e], s1[e])); }
                mx = fmaxf(mx, __shfl_xor(mx, 16)); mx = fmaxf(mx, __shfl_xor(mx, 32));
                const float mn = fmaxf(m[hh], mx); const float alpha = __expf(m[hh] - mn); m[hh] = mn;
                float ps = 0.f;
#pragma unroll
                for (int e = 0; e < 4; ++e) { s0[e] = __expf(s0[e] - mn); s1[e] = __expf(s1[e] - mn); ps += s0[e] + s1[e]; }
                l[hh] = l[hh] * alpha + ps;
                const bf16x8 P = mk8(cvtpk(s0[0], s0[1]), cvtpk(s0[2], s0[3]), cvtpk(s1[0], s1[1]), cvtpk(s1[2], s1[3]));
#pragma unroll
                for (int dt = 0; dt < 4; ++dt) { O[hh][dt] = O[hh][dt] * alpha; O[hh][dt] = MFMA16(V[dt], P, O[hh][dt]); }
            }
        }
    }
#pragma unroll
    for (int hh = 0; hh < 3; ++hh) { float lt = l[hh]; lt += __shfl_xor(lt, 16); lt += __shfl_xor(lt, 32); const float inv = 1.0f / lt;
#pragma unroll
        for (int dt = 0; dt < 4; ++dt) { v2u w; w.x = pk2(O[hh][dt][0] * inv, O[hh][dt][1] * inv); w.y = pk2(O[hh][dt][2] * inv, O[hh][dt][3] * inv);
            *(v2u*)(mix + (size_t)qrow * DM + 256 + 64 * (3 * kvh + hh) + 16 * dt + 4 * q) = w; } }
}

__device__ __forceinline__ void fourier_tables(Frame& F) {
    bf16* t = (bf16*)(F.ws + WS_FT);
    for (int i = F.bid * NTHR + F.tid; i < 64 * 64; i += F.G * NTHR) { const int r = i >> 6, cc = i & 63; const float a = (float)((r * cc) & 63) * (1.0f / 64.0f);
        const float cs = __builtin_amdgcn_cosf(a), sn = __builtin_amdgcn_sinf(a);
        t[FT_W64C / 2 + i] = (bf16)f2bf(cs); t[FT_W64S / 2 + i] = (bf16)f2bf(sn);
        const int pj = (cc & ~31) | (((cc & 15) >> 2) << 3) | (((cc >> 4) & 1) << 2) | (cc & 3);
        t[FT_T64C / 2 + r * 64 + pj] = (bf16)f2bf(cs); t[FT_T64S / 2 + r * 64 + pj] = (bf16)f2bf(sn); }
    for (int i = F.bid * NTHR + F.tid; i < 128 * 128; i += F.G * NTHR) { const int r = i >> 7, cc = i & 127; const float a = (float)((r * cc) & 127) * (1.0f / 128.0f);
        t[FT_W128C / 2 + i] = (bf16)f2bf(__builtin_amdgcn_cosf(a)); t[FT_W128S / 2 + i] = (bf16)f2bf(__builtin_amdgcn_sinf(a)); }
}
__device__ __forceinline__ void fourier_a_fast(Frame& F, int u) {
    const int b = u >> 7, n2 = u & 127, c = F.lane & 15, q = F.lane >> 4;
    LAS unsigned char* IMG = F.lds;
    __syncthreads();
    for (int pc = F.tid; pc < 64 * 32; pc += NTHR) { const int n1 = pc >> 5, c8 = pc & 31;
        const v4u v = *(const v4u*)(zrow(F, b * SEQ + 128 * n1 + n2) + ZF + 8 * c8);
        LAS bf16* d = (LAS bf16*)(IMG + (8 * c8) * 144) + n1;
        d[0] = (bf16)(v.x & 0xffff); d[72] = (bf16)(v.x >> 16); d[144] = (bf16)(v.y & 0xffff); d[216] = (bf16)(v.y >> 16);
        d[288] = (bf16)(v.z & 0xffff); d[360] = (bf16)(v.z >> 16); d[432] = (bf16)(v.w & 0xffff); d[504] = (bf16)(v.w >> 16); }
    __syncthreads();
    const bf16* wc = (const bf16*)(F.ws + WS_FT + FT_W64C); const bf16* wsn = (const bf16*)(F.ws + WS_FT + FT_W64S);
    bf16* far = (bf16*)((unsigned char*)F.out + OUT_FA); bf16* fai = far + (size_t)NB * 64 * 128 * 256;
    bf16x8 Bc[4][2], Bs[4][2];
#pragma unroll
    for (int kt = 0; kt < 4; ++kt)
#pragma unroll
        for (int k = 0; k < 2; ++k) { Bc[kt][k] = *(const bf16x8*)(wc + (16 * kt + c) * 64 + 32 * k + 8 * q); Bs[kt][k] = *(const bf16x8*)(wsn + (16 * kt + c) * 64 + 32 * k + 8 * q); }
#pragma unroll
    for (int ci = 0; ci < 2; ++ci) { const int ct = 2 * F.wave + ci;
        bf16x8 A[2];
#pragma unroll
        for (int k = 0; k < 2; ++k) A[k] = *(const LAS bf16x8*)(IMG + (16 * ct + c) * 144 + k * 64 + q * 16);
#pragma unroll
        for (int kt = 0; kt < 4; ++kt) { f32x4 sr = {0.f, 0.f, 0.f, 0.f}, si = {0.f, 0.f, 0.f, 0.f};
#pragma unroll
            for (int k = 0; k < 2; ++k) { sr = MFMA16(A[k], Bc[kt][k], sr); si = MFMA16(A[k], Bs[kt][k], si); }
            const int k1 = 16 * kt + c; const float tw = (float)(n2 * k1) * (1.0f / 8192.0f); const float tc = __builtin_amdgcn_cosf(tw), ts = __builtin_amdgcn_sinf(tw);
            float xr[4], xi[4];
#pragma unroll
            for (int e = 0; e < 4; ++e) { const float ar = sr[e], ai = -si[e]; xr[e] = ar * tc + ai * ts; xi[e] = ai * tc - ar * ts; }
            const size_t o = (((size_t)b * 64 + k1) * 128 + n2) * 256 + 16 * ct + 4 * q;
            v2u w; w.x = pk2(xr[0], xr[1]); w.y = pk2(xr[2], xr[3]); *(v2u*)(far + o) = w; w.x = pk2(xi[0], xi[1]); w.y = pk2(xi[2], xi[3]); *(v2u*)(fai + o) = w; } }
}
__device__ __forceinline__ void fourier_c_fast(Frame& F, int u) {
    const int g = u & 3, k1 = (u >> 2) & 63, b = u >> 8, c = F.lane & 15, q = F.lane >> 4;
    LAS unsigned char* IR = F.lds; LAS unsigned char* II = F.lds + 64 * 272;
    const bf16* far = (const bf16*)((unsigned char*)F.out + OUT_FA) + (((size_t)b * 64 + k1) * 128) * 256 + 64 * g; const bf16* fai = far + (size_t)NB * 64 * 128 * 256;
    __syncthreads();
    for (int pc = F.tid; pc < 128 * 8; pc += NTHR) { const int n2 = pc >> 3, c8 = pc & 7;
        const v4u vr = *(const v4u*)(far + (size_t)n2 * 256 + 8 * c8), vi = *(const v4u*)(fai + (size_t)n2 * 256 + 8 * c8);
        LAS bf16* dr = (LAS bf16*)(IR + (8 * c8) * 272) + n2; LAS bf16* di = (LAS bf16*)(II + (8 * c8) * 272) + n2;
        dr[0] = (bf16)(vr.x & 0xffff); dr[136] = (bf16)(vr.x >> 16); dr[272] = (bf16)(vr.y & 0xffff); dr[408] = (bf16)(vr.y >> 16);
        dr[544] = (bf16)(vr.z & 0xffff); dr[680] = (bf16)(vr.z >> 16); dr[816] = (bf16)(vr.w & 0xffff); dr[952] = (bf16)(vr.w >> 16);
        di[0] = (bf16)(vi.x & 0xffff); di[136] = (bf16)(vi.x >> 16); di[272] = (bf16)(vi.y & 0xffff); di[408] = (bf16)(vi.y >> 16);
        di[544] = (bf16)(vi.z & 0xffff); di[680] = (bf16)(vi.z >> 16); di[816] = (bf16)(vi.w & 0xffff); di[952] = (bf16)(vi.w >> 16); }
    __syncthreads();
    const bf16* wc = (const bf16*)(F.ws + WS_FT + FT_W128C); const bf16* wsn = (const bf16*)(F.ws + WS_FT + FT_W128S);
    const bf16* tcn = (const bf16*)(F.ws + WS_FT + FT_T64C); const bf16* tsn = (const bf16*)(F.ws + WS_FT + FT_T64S);
    f32x4 Pr[4], Pi[4];
#pragma unroll
    for (int ct = 0; ct < 4; ++ct) { Pr[ct] = (f32x4){0.f, 0.f, 0.f, 0.f}; Pi[ct] = (f32x4){0.f, 0.f, 0.f, 0.f}; }
#pragma unroll
    for (int k = 0; k < 4; ++k) { const bf16x8 bc = *(const bf16x8*)(wc + (16 * F.wave + c) * 128 + 32 * k + 8 * q), bs = *(const bf16x8*)(wsn + (16 * F.wave + c) * 128 + 32 * k + 8 * q);
        const v4u bsu = __builtin_bit_cast(v4u, bs); const bf16x8 bsn = mk8(bsu.x ^ 0x80008000u, bsu.y ^ 0x80008000u, bsu.z ^ 0x80008000u, bsu.w ^ 0x80008000u);
#pragma unroll
        for (int ct = 0; ct < 4; ++ct) { const bf16x8 ar = *(const LAS bf16x8*)(IR + (16 * ct + c) * 272 + k * 64 + q * 16), ai = *(const LAS bf16x8*)(II + (16 * ct + c) * 272 + k * 64 + q * 16);
            Pr[ct] = MFMA16(ar, bc, Pr[ct]); Pr[ct] = MFMA16(ai, bs, Pr[ct]); Pi[ct] = MFMA16(ai, bc, Pi[ct]); Pi[ct] = MFMA16(ar, bsn, Pi[ct]); } }
    bf16x8 Br[2], Bi[2];
#pragma unroll
    for (int k = 0; k < 2; ++k) { Br[k] = mk8(cvtpk(Pr[2 * k][0], Pr[2 * k][1]), cvtpk(Pr[2 * k][2], Pr[2 * k][3]), cvtpk(Pr[2 * k + 1][0], Pr[2 * k + 1][1]), cvtpk(Pr[2 * k + 1][2], Pr[2 * k + 1][3]));
        Bi[k] = mk8(cvtpk(Pi[2 * k][0], Pi[2 * k][1]), cvtpk(Pi[2 * k][2], Pi[2 * k][3]), cvtpk(Pi[2 * k + 1][0], Pi[2 * k + 1][1]), cvtpk(Pi[2 * k + 1][2], Pi[2 * k + 1][3])); }
    bf16* mix = (bf16*)(F.ws + WS_H);
    const float scale = 0.0013810679320049757f;
    const int k2 = 16 * F.wave + c; const size_t row = (size_t)b * SEQ + k1 + 64 * k2;
#pragma unroll
    for (int mt = 0; mt < 4; ++mt) { f32x4 y = {0.f, 0.f, 0.f, 0.f};
#pragma unroll
        for (int k = 0; k < 2; ++k) { const bf16x8 ac = *(const bf16x8*)(tcn + (16 * mt + c) * 64 + 32 * k + 8 * q), as = *(const bf16x8*)(tsn + (16 * mt + c) * 64 + 32 * k + 8 * q);
            y = MFMA16(ac, Br[k], y); y = MFMA16(as, Bi[k], y); }
        v2u w; w.x = pk2(y[0] * scale, y[1] * scale); w.y = pk2(y[2] * scale, y[3] * scale);
        *(v2u*)(mix + row * DM + 64 * g + 16 * mt + 4 * q) = w; }
}

#define XB_TMO      128
#define XB_XCNT(j)  (256  + 64 * (j))
#define XB_XSUB(j)  (1280 + 64 * (j))
#define XB_XGEN(j)  (2304 + 64 * (j))
#define XB_TOP      3328
#define XB_TOPGEN   3392
#define XCD_BAR_WORDS 3456
#define XB_SPIN_CAP (1u << 23)
__device__ __forceinline__ unsigned xb_ld(unsigned* p)              { return __hip_atomic_load(p, __ATOMIC_RELAXED, __HIP_MEMORY_SCOPE_AGENT); }
__device__ __forceinline__ unsigned xb_add(unsigned* p, unsigned v) { return __hip_atomic_fetch_add(p, v, __ATOMIC_RELAXED, __HIP_MEMORY_SCOPE_AGENT); }
__device__ __forceinline__ unsigned xb_xcc_id() { return (unsigned)__builtin_amdgcn_s_getreg((3 << 11) | 20) & 0xFu; }
#define XB_SPIN(cond, bar) do { unsigned _sp = 0; while (cond) { __builtin_amdgcn_s_sleep(1); \
    if ((++_sp & 255u) == 0u) { if (xb_ld(&(bar)[XB_TMO])) break; if (_sp > XB_SPIN_CAP) { atomicAdd(&(bar)[XB_TMO], 1u); break; } } } } while (0)
struct XcdBarrier { unsigned* bar; unsigned x; volatile LAS unsigned* st; };
__device__ __forceinline__ XcdBarrier xcd_barrier_post(unsigned* bar, volatile LAS unsigned* st) {
    XcdBarrier b; b.bar = bar; b.x = xb_xcc_id(); b.st = st;
    if (threadIdx.x == 0) (void)xb_add(&bar[XB_XCNT(b.x)], 1u);
    return b;
}
__device__ __forceinline__ void xcd_barrier_complete(unsigned* bar, unsigned x, unsigned& nloc, unsigned& nx) {
    const unsigned G = gridDim.x * gridDim.y * gridDim.z;
    unsigned sum, cnt, mine, sp = 0u;
    for (;;) {
        sum = 0u; cnt = 0u; mine = 0u;
#pragma unroll
        for (unsigned j = 0; j < 16; ++j) { const unsigned c = xb_ld(&bar[XB_XCNT(j)]); sum += c; cnt += (c > 0u) ? 1u : 0u; mine = (j == x) ? c : mine; }
        if (sum == G) break;
        __builtin_amdgcn_s_sleep(1);
        if ((++sp & 255u) == 0u) { if (xb_ld(&bar[XB_TMO])) break; if (sp > XB_SPIN_CAP) { atomicAdd(&bar[XB_TMO], 1u); break; } }
    }
    nloc = mine > 0u ? mine : 1u; nx = cnt > 0u ? cnt : 1u;
}
__device__ __forceinline__ void xcd_barrier(const XcdBarrier& b0) {
    XcdBarrier b; { unsigned* p = b0.bar; unsigned x = __builtin_amdgcn_readfirstlane(b0.x); unsigned st = (unsigned)(size_t)b0.st; asm volatile("" : "+s"(p), "+s"(x), "+s"(st)); b.bar = p; b.x = x; b.st = (volatile LAS unsigned*)(size_t)st; }
    asm volatile("s_waitcnt vmcnt(0)" ::: "memory");
    __syncthreads();
    if (threadIdx.x == 0) {
        unsigned* bar = b.bar;
        __builtin_amdgcn_s_waitcnt(0);
        unsigned nloc = b.st[0], nx = b.st[1];
        if (nloc == 0u) { xcd_barrier_complete(bar, b.x, nloc, nx); b.st[0] = nloc; b.st[1] = nx; }
        const unsigned old = xb_add(&bar[XB_XSUB(b.x)], 1u);
        const unsigned gen = old / nloc;
        if (old + 1u == (gen + 1u) * nloc) {
            __builtin_amdgcn_fence(__ATOMIC_RELEASE, "agent");
            asm volatile("s_waitcnt vmcnt(0)" ::: "memory");
            const unsigned og = xb_add(&bar[XB_TOP], 1u);
            const unsigned tg = og / nx;
            if (og + 1u == (tg + 1u) * nx) xb_add(&bar[XB_TOPGEN], 1u);
            else XB_SPIN(xb_ld(&bar[XB_TOPGEN]) == tg, bar);
            __builtin_amdgcn_fence(__ATOMIC_ACQUIRE, "agent");
            xb_add(&bar[XB_XGEN(b.x)], 1u);
            asm volatile("s_waitcnt vmcnt(0)" ::: "memory");
        } else {
            XB_SPIN(xb_ld(&bar[XB_XGEN(b.x)]) == gen, bar);
            __builtin_amdgcn_fence(__ATOMIC_ACQUIRE, "agent");
            asm volatile("s_waitcnt vmcnt(0)" ::: "memory");
        }
    }
    __syncthreads();
}

__device__ __forceinline__ int queue_next(Frame& F, unsigned* cnt) {
    volatile LAS int* slot = (volatile LAS int*)(F.lds + MISC_OFF + 64);
    __syncthreads();
    if (F.tid == 0) *slot = (int)__hip_atomic_fetch_add(cnt, 1u, __ATOMIC_RELAXED, __HIP_MEMORY_SCOPE_AGENT);
    __syncthreads();
    return *slot;
}
template <int KIND> __device__ __forceinline__ void run_phase(const Frame& F0, int li, int second) {
    Frame F;
    { int t = threadIdx.x; asm volatile("" : "+v"(t)); F.tid = t; F.lane = t & 63; F.wave = __builtin_amdgcn_readfirstlane(t >> 6);
      int g = F0.G, b = F0.bid; asm volatile("" : "+s"(g), "+s"(b)); F.G = g; F.bid = b;
      unsigned char* w = F0.ws; float* o = F0.out; asm volatile("" : "+s"(w), "+s"(o)); F.ws = w; F.out = o;
      unsigned l = (unsigned)(size_t)F0.lds; asm volatile("" : "+s"(l)); F.lds = (LAS unsigned char*)(size_t)l;
      asm volatile("" : "+s"(li), "+s"(second)); }
    float* modv = (float*)(F.ws + WS_MOD);
    bf16* XB = (bf16*)(F.ws + WS_XB);
    bf16* H = (bf16*)(F.ws + WS_H); bf16* ACT = (bf16*)(F.ws + WS_ACT); bf16* O = (bf16*)(F.ws + WS_O);
    const float* ng = inp(I_NORMG) + (size_t)li * 6 * DM; const float* mv = modv + (size_t)li * 3 * 9216;
    const bool last = li == 1;
    if constexpr (KIND == 100) { convert_weights(F, 0); mod_gemv(F); rope_tables(F); lora_transposes(F); fourier_tables(F); }
    if constexpr (KIND == 101) { EArgs A{}; A.xl_src = inp(I_X); A.xc_src = inp(I_CTX); A.o = nullptr; A.hdst = H; A.modv_h = modv; A.shidx = 0; A.scidx = 1; A.gpre = inp(I_NORMG); A.nrows = TT; e_phase(F, A); }
    if constexpr (KIND == 0) {
        const bf16* wi = (const bf16*)(F.ws + (second ? WS_WI2 : WS_WI1)); const bool withctx = !(last && second);
        if (!withctx || F.G != 256) { pg8::Gemm g{H, wi, withctx ? TT : TL, NWI, DM}; pg8::StaticOrder S; S.init(g.M, g.N, F.G, F.bid);
            pg8::EpiSwiglu E{ACT, FFNP}; pg8::gemm_phase<pg8::EpiSwiglu, pg8::StaticOrder, true, true>(F.lds, g, S, E, F.tid); }
        else { unsigned* cnt = (unsigned*)(F.ws + WS_CTL) + 8192 + 64 * (li * 2 + second);
            pg8::Gemm g{H, wi, TT, NWI, DM}; pg8::UpOrder S; S.init(NWI, F.G, F.bid, cnt);
            pg8::EpiSwiglu E{ACT, FFNP}; pg8::gemm_phase<pg8::EpiSwiglu, pg8::UpOrder, true, true>(F.lds, g, S, E, F.tid);
            if (F.bid >= 248) {
                if (F.tid == 0) { unsigned sp = 0; while (__hip_atomic_load(cnt, __ATOMIC_RELAXED, __HIP_MEMORY_SCOPE_AGENT) < 352u && ++sp < (1u << 24)) __builtin_amdgcn_s_sleep(8);
                    __builtin_amdgcn_fence(__ATOMIC_ACQUIRE, "agent"); asm volatile("s_waitcnt vmcnt(0)" ::: "memory"); }
                __syncthreads();
                const int k = F.bid - 248; pg8::Gemm g2{ACT, (const bf16*)(F.ws + (second ? WS_WO2 : WS_WO1)), TT, DM, FFNP}; pg8::OneUnit S2{64 + (k >> 2), k & 3};
                pg8::EpiBf16 E2{O, DM}; pg8::gemm_phase<pg8::EpiBf16, pg8::OneUnit, false, true>(F.lds, g2, S2, E2, F.tid); } } }
    if constexpr (KIND == 1) {
        const bool ctxhere = F.G != 256 && !(last && second);
        pg8::Gemm g{ACT, (const bf16*)(F.ws + (second ? WS_WO2 : WS_WO1)), ctxhere ? TT : TL, DM, FFNP}; pg8::StaticOrder S; S.init(g.M, g.N, F.G, F.bid);
        pg8::EpiBf16 E{O, DM}; pg8::gemm_phase<pg8::EpiBf16, pg8::StaticOrder, true, true>(F.lds, g, S, E, F.tid); }
    if constexpr (KIND == 2) {
        EArgs A{}; A.xl_src = inp(I_X); A.xc_src = inp(I_CTX); A.xb_src = li == 0 ? (const bf16*)nullptr : XB; A.xb_dst = XB; A.o = O; A.modv_g = mv; A.gidx = 2; A.gmul = 0.5f; A.gpost = ng + 1 * DM;
        A.hdst = H; A.modv_h = mv; A.shidx = 3; A.scidx = 4; A.gpre = ng + 2 * DM; A.nrows = TT; e_phase(F, A); }
    if constexpr (KIND == 3) {
        pg8::Gemm g{H, (const bf16*)(F.ws + WS_WIN), TT, INWP, DM}; pg8::StaticOrder S; S.init(g.M, g.N, F.G, F.bid);
        pg8::EpiBf16 E{ACT, INWP}; pg8::gemm_phase<pg8::EpiBf16, pg8::StaticOrder, true, true>(F.lds, g, S, E, F.tid); }
    if constexpr (KIND == 4) {
        lora_pass(F, li);
        for (int u = F.bid; u < 256; u += F.G) fourier_a_fast(F, u);
        if (li == 0) fourier_ctx1_all(F); }
    if constexpr (KIND == 5) {
        unsigned* cnt = (unsigned*)(F.ws + WS_CTL) + 8192 + 64 * (4 + 2 * li);
        const int na = li == 0 ? 264 : 256;
        for (int it = queue_next(F, cnt); it < na; it = queue_next(F, cnt)) attn_unit(F, li, it);
        for (int it = queue_next(F, cnt + 16); it < 12 * (NSC - 1); it = queue_next(F, cnt + 16)) rwkv_pass1_pair(F, li, it); }
    if constexpr (KIND == 11) {
        if (F.bid < 24) rwkv_pass2_chain(F, F.bid);
        else convert_weights(F, 1, li == 0 ? 1 : 2, 24, F.G - 24);
        if (li == 0) fourier_ctx2_all(F); }
    if constexpr (KIND == 12) {
        unsigned* cnt = (unsigned*)(F.ws + WS_CTL) + 8192 + 64 * (5 + 2 * li);
        const int np3 = li == 0 ? 12 * NSC : 12 * 64;
        for (int it = queue_next(F, cnt); it < np3; it = queue_next(F, cnt)) rwkv_pass3_unit(F, li, li == 0 ? it : (it / 64) * NSC + 2 + it % 64);
        for (int it = queue_next(F, cnt + 16); it < 512; it = queue_next(F, cnt + 16)) fourier_c_fast(F, it); }
    if constexpr (KIND == 6) {
        pg8::Gemm g{H, (const bf16*)(F.ws + WS_WOUT), last ? TL : TT, DM, DM}; pg8::StaticOrder S; S.init(g.M, g.N, F.G, F.bid);
        pg8::EpiBf16 E{O, DM}; pg8::gemm_phase<pg8::EpiBf16, pg8::StaticOrder, true, true>(F.lds, g, S, E, F.tid); }
    if constexpr (KIND == 7) {
        EArgs A{}; A.xb_src = XB; A.xb_dst = XB; A.o = O; A.modv_g = mv; A.gidx = 5; A.gmul = 1.0f; A.gpost = ng + 3 * DM;
        A.hdst = H; A.modv_h = mv; A.shidx = 6; A.scidx = 7; A.gpre = ng + 4 * DM; A.nrows = last ? TL : TT; e_phase(F, A); }
    if constexpr (KIND == 10) {
        EArgs A{}; A.xb_src = XB; A.xb_dst = XB; A.out32 = last ? F.out : (float*)nullptr; A.o = O; A.modv_g = mv; A.gidx = 8; A.gmul = 0.5f; A.gpost = ng + 5 * DM;
        if (!last) { A.hdst = H; A.modv_h = mv + 3 * 9216; A.shidx = 0; A.scidx = 1; A.gpre = ng + 6 * DM; }
        A.nrows = last ? TL : TT; e_phase(F, A);
        }
}
__global__ void __launch_bounds__(NTHR, 2) mega_one(Args args) {
    extern __shared__ __attribute__((aligned(16))) unsigned char lds[];
    Frame F; F.lds = (LAS unsigned char*)lds; F.tid = threadIdx.x; F.lane = F.tid & 63; F.wave = __builtin_amdgcn_readfirstlane(F.tid >> 6); F.G = gridDim.x; F.bid = blockIdx.x;
    F.out = args.out; F.ws = args.ws;
    volatile LAS unsigned* MISC = (volatile LAS unsigned*)(F.lds + MISC_OFF);
    if (F.tid < 32) MISC[F.tid] = 0u;
    __syncthreads();
    XcdBarrier bar = xcd_barrier_post((unsigned*)(F.ws + WS_CTL) + 4096, MISC + 8);
#define GRID_BAR() xcd_barrier(bar)
    run_phase<100>(F, 0, 0); GRID_BAR();
    run_phase<101>(F, 0, 0); GRID_BAR();
#pragma unroll 1
    for (int li = 0; li < 2; ++li) {
        run_phase<0>(F, li, 0); GRID_BAR();
        run_phase<1>(F, li, 0); GRID_BAR();
        run_phase<2>(F, li, 0); GRID_BAR();
        run_phase<3>(F, li, 0); GRID_BAR();
        run_phase<4>(F, li, 0); GRID_BAR();
        run_phase<5>(F, li, 0); GRID_BAR();
        run_phase<11>(F, li, 0); GRID_BAR();
        run_phase<12>(F, li, 0); GRID_BAR();
        run_phase<6>(F, li, 0); GRID_BAR();
        run_phase<7>(F, li, 0); GRID_BAR();
        run_phase<0>(F, li, 1); GRID_BAR();
        run_phase<1>(F, li, 1); GRID_BAR();
        run_phase<10>(F, li, 0); GRID_BAR();
    }
}

extern "C" void kernel_launch(void* const* d_in, const int* in_sizes, int n_in, void* d_out, int out_size, void* d_ws, size_t ws_size, hipStream_t stream) {
    static int ready = 0;
    if (!ready) {
        if (n_in != 25 || out_size != TL * DM || ws_size < WS_END) { fprintf(stderr, "kernel_launch: unexpected shapes (n_in %d out %d ws %zu)\n", n_in, out_size, ws_size); ready = -1; return; }
        if (hipFuncSetAttribute((const void*)mega_one, hipFuncAttributeMaxDynamicSharedMemorySize, LDS_BYTES) != hipSuccess) { fprintf(stderr, "kernel_launch: hipFuncSetAttribute failed\n"); ready = -1; return; }
        int dev = 0, cus = 0; if (hipGetDevice(&dev) != hipSuccess || hipDeviceGetAttribute(&cus, hipDeviceAttributeMultiprocessorCount, dev) != hipSuccess || cus < 32) cus = 256;
        ready = cus < 256 ? cus : 256;
    }
    if (ready < 0) return;
    if (hipMemsetAsync((char*)d_ws + WS_CTL, 0, 65536, stream) != hipSuccess) { fprintf(stderr, "kernel_launch: memset failed\n"); return; }
    Args a{};
    for (int i = 0; i < 25; ++i) a.in[i] = (const float*)d_in[i];
    a.out = (float*)d_out; a.ws = (unsigned char*)d_ws;
    hipLaunchKernelGGL(mega_one, dim3(ready), dim3(NTHR), LDS_BYTES, stream, a);
}
```

```cpp
#include <hip/hip_runtime.h>
#include <cstdio>
#include <cstdint>

namespace pg8 {
#define PG8_LAS __attribute__((address_space(3)))
typedef unsigned short bf16_t;
typedef short bf16x8 __attribute__((ext_vector_type(8)));
typedef float f32x4 __attribute__((ext_vector_type(4)));
typedef unsigned u32x4 __attribute__((ext_vector_type(4)));
constexpr int BM = 256, BK = 64, HALF = 128, HTB = HALF * BK * 2, STAGE_BYTES = 8 * HTB, NXCD = 8, WGM = 8;

__host__ __device__ __forceinline__ int lds_byte(int r, int c) { const int st = (r >> 4) * 2 + (c >> 5), rr = r & 15, cc = c & 31, ob = rr * 64 + cc * 2; return st * 1024 + (ob ^ (((ob >> 9) & 1) << 5)); }
__host__ __device__ __forceinline__ void stage_rc(int b, int& R, int& C) { const int st = b / 1024, sb = b % 1024, swz = sb ^ (((sb >> 9) & 1) << 5); R = (st >> 1) * 16 + swz / 64; C = (st & 1) * 32 + (swz % 64) / 2; }
__host__ __device__ __forceinline__ int perm32(int rho) { const int n = rho >> 4, i = rho & 15; return 8 * (i >> 2) + 4 * n + (i & 3); }

struct Unit { int pm, pn; };
struct Gemm { const bf16_t* A; const bf16_t* Bt; int M, N, K; };

struct StaticOrder {
    int nM, nN, nwg, G, c;
    __host__ __device__ void init(int M, int N, int G_, int c_) { nM = M / BM; nN = N / BM; nwg = nM * nN; G = G_; c = c_; }
    __host__ __device__ bool next(int i, Unit& u) const {
        const long L = (long)i * G + c; if (L >= nwg) return false;
        int wgid = (int)L; { const int q = nwg / NXCD, r = nwg % NXCD, xcd = wgid % NXCD, off = wgid / NXCD; wgid = (xcd < r ? xcd * (q + 1) : r * (q + 1) + (xcd - r) * q) + off; }
        const int nig = WGM * nN, gid = wgid / nig, fm = gid * WGM, gsz = (nM - fm) < WGM ? (nM - fm) : WGM;
        u.pm = fm + ((wgid % nig) % gsz); u.pn = (wgid % nig) / gsz; return true;
    }
    __device__ __forceinline__ void a_ready(const Unit&) const {}
    __device__ __forceinline__ void done(const Unit&) const {}
};

struct UpOrder {
    StaticOrder lat; int G, c, nN; unsigned* cnt;
    __device__ void init(int N, int G_, int c_, unsigned* cnt_) { lat.init(16384, N, G_, c_); G = G_; c = c_; nN = N / BM; cnt = cnt_; }
    __device__ bool next(int i, Unit& u) const {
        const int nctx = 2 * nN, total = nctx + lat.nwg;
        long L;
        if (G != 256) L = (long)i * G + c;
        else if (c >= 248) { if (i >= 3) return false; L = (long)i * G + c; }
        else if (c >= 172 && c < 188 && i == 5) L = (long)(3 + (c - 172) / 8) * G + 248 + (c - 172) % 8;
        else L = (long)i * G + c;
        if (L >= total) return false;
        if (L < nctx) { u.pm = 64 + (int)L / nN; u.pn = (int)L % nN; return true; }
        int wgid = (int)L - nctx; { const int nwg = lat.nwg, q = nwg / NXCD, r = nwg % NXCD, xcd = wgid % NXCD, off = wgid / NXCD; wgid = (xcd < r ? xcd * (q + 1) : r * (q + 1) + (xcd - r) * q) + off; }
        const int nig = WGM * nN, gid = wgid / nig, fm = gid * WGM, gsz = (lat.nM - fm) < WGM ? (lat.nM - fm) : WGM;
        u.pm = fm + ((wgid % nig) % gsz); u.pn = (wgid % nig) / gsz; return true;
    }
    __device__ __forceinline__ void a_ready(const Unit&) const {}
    __device__ __forceinline__ void done(const Unit& u) const {
        if (u.pm >= 64) { asm volatile("s_waitcnt vmcnt(0)" ::: "memory"); __builtin_amdgcn_fence(__ATOMIC_RELEASE, "agent"); asm volatile("s_waitcnt vmcnt(0)" ::: "memory");
            if ((threadIdx.x & 63) == 0) __hip_atomic_fetch_add(cnt, 1u, __ATOMIC_RELAXED, __HIP_MEMORY_SCOPE_AGENT); }
    }
};
struct OneUnit {
    int pm, pn;
    __device__ bool next(int i, Unit& u) const { if (i != 0) return false; u.pm = pm; u.pn = pn; return true; }
    __device__ __forceinline__ void a_ready(const Unit&) const {}
    __device__ __forceinline__ void done(const Unit&) const {}
};

__device__ __forceinline__ unsigned cvt_pk_bf16(float lo, float hi) { unsigned r; asm volatile("v_cvt_pk_bf16_f32 %0, %1, %2" : "=v"(r) : "v"(lo), "v"(hi)); return r; }

struct EpiBf16 {
    static constexpr bool PERM = true, AFTER_DRAIN = false;
    bf16_t* O; int ldc;
    __device__ __forceinline__ void operator()(const f32x4 (&acc)[2][2][4][2], const Unit& u, int wr, int wc, int fr, int fq) const {
        const int row0 = u.pm * BM + wr * 64 + fr; const int col0 = u.pn * BM + wc * 32 + 8 * fq;
#pragma unroll
        for (int ai = 0; ai < 2; ++ai)
#pragma unroll
            for (int m = 0; m < 4; ++m) { bf16_t* rowp = O + (size_t)(row0 + ai * HALF + m * 16) * ldc + col0;
#pragma unroll
                for (int bj = 0; bj < 2; ++bj) { const f32x4 v0 = acc[ai][bj][m][0], v1 = acc[ai][bj][m][1];
                    u32x4 w; w.x = cvt_pk_bf16(v0[0], v0[1]); w.y = cvt_pk_bf16(v0[2], v0[3]); w.z = cvt_pk_bf16(v1[0], v1[1]); w.w = cvt_pk_bf16(v1[2], v1[3]);
                    *(u32x4*)(rowp + bj * HALF) = w; } }
    }
};
struct EpiF32 {
    static constexpr bool PERM = true, AFTER_DRAIN = false;
    float* O; int ldc;
    __device__ __forceinline__ void operator()(const f32x4 (&acc)[2][2][4][2], const Unit& u, int wr, int wc, int fr, int fq) const {
        const int row0 = u.pm * BM + wr * 64 + fr; const int col0 = u.pn * BM + wc * 32 + 8 * fq;
#pragma unroll
        for (int ai = 0; ai < 2; ++ai)
#pragma unroll
            for (int m = 0; m < 4; ++m) { float* rowp = O + (size_t)(row0 + ai * HALF + m * 16) * ldc + col0;
#pragma unroll
                for (int bj = 0; bj < 2; ++bj) { *(f32x4*)(rowp + bj * HALF) = acc[ai][bj][m][0]; *(f32x4*)(rowp + bj * HALF + 4) = acc[ai][bj][m][1]; } }
    }
};
__device__ __forceinline__ float silu_f(float x) { return x * __builtin_amdgcn_rcpf(1.0f + __expf(-x)); }
struct EpiSwiglu {
    static constexpr bool PERM = true, AFTER_DRAIN = false;
    bf16_t* O; int ldc;
    __device__ __forceinline__ void operator()(const f32x4 (&acc)[2][2][4][2], const Unit& u, int wr, int wc, int fr, int fq) const {
        const int row0 = u.pm * BM + wr * 64 + fr; const int col0 = u.pn * HALF + wc * 32 + 8 * fq;
#pragma unroll
        for (int ai = 0; ai < 2; ++ai)
#pragma unroll
            for (int m = 0; m < 4; ++m) { bf16_t* rowp = O + (size_t)(row0 + ai * HALF + m * 16) * ldc + col0;
                const f32x4 g0 = acc[ai][0][m][0], g1 = acc[ai][0][m][1], u0 = acc[ai][1][m][0], u1 = acc[ai][1][m][1];
                u32x4 w; w.x = cvt_pk_bf16(silu_f(g0[0]) * u0[0], silu_f(g0[1]) * u0[1]); w.y = cvt_pk_bf16(silu_f(g0[2]) * u0[2], silu_f(g0[3]) * u0[3]);
                w.z = cvt_pk_bf16(silu_f(g1[0]) * u1[0], silu_f(g1[1]) * u1[1]); w.w = cvt_pk_bf16(silu_f(g1[2]) * u1[2], silu_f(g1[3]) * u1[3]);
                *(u32x4*)rowp = w; }
    }
};

template <class Epi, class Sched, bool ALIGN_EPI = false, bool SP2 = false>
__device__ __forceinline__ void gemm_phase(PG8_LAS unsigned char* lds, const Gemm g, const Sched& S, const Epi& E, const int tid) {
    const int wid = __builtin_amdgcn_readfirstlane(tid >> 6), lane = tid & 63, wr = wid >> 2, wc = wid & 3, fr = lane & 15, fq = lane >> 4;
    const int K = g.K, nt = K / BK;
    unsigned voffA[2], voffB[2];
#pragma unroll
    for (int i = 0; i < 2; ++i) { int R, C; stage_rc(tid * 16 + i * 8192, R, C); const int Rb = Epi::PERM ? ((R & ~31) + perm32(R & 31)) : R;
        voffA[i] = (unsigned)(R * K + C) * 2u; voffB[i] = (unsigned)(Rb * K + C) * 2u; }
    const size_t kstep = (size_t)(BK * 2);
    const size_t hstep = (size_t)HALF * K * 2;
    const size_t tstep = 2 * hstep;
    const unsigned ldsw = (unsigned)wid * 1024u;
    const int aoff = lds_byte(wr * 64 + fr, fq * 8), boff = lds_byte(wc * 32 + fr, fq * 8);
#define PG8_SA(b, h) (((b) * 2 + (h)) * HTB)
#define PG8_SB(b, h) ((4 + (b) * 2 + (h)) * HTB)
#define PG8_STAGE(bufoff, gbase, voff) do { _Pragma("unroll") for (int _i = 0; _i < 2; ++_i) \
        __builtin_amdgcn_global_load_lds((const unsigned*)((const char*)(gbase) + (voff)[_i]), (PG8_LAS unsigned*)(lds + (bufoff) + ldsw + _i * 8192), 16, 0, 0); } while (0)
#define PG8_LDA(dst, b, h) do { _Pragma("unroll") for (int m = 0; m < 4; ++m) _Pragma("unroll") for (int k = 0; k < 2; ++k) dst[m][k] = *(const PG8_LAS bf16x8*)(lds + PG8_SA(b, h) + aoff + m * 2048 + k * 1024); } while (0)
#define PG8_LDB(dst, b, h) do { _Pragma("unroll") for (int n = 0; n < 2; ++n) _Pragma("unroll") for (int k = 0; k < 2; ++k) dst[n][k] = *(const PG8_LAS bf16x8*)(lds + PG8_SB(b, h) + boff + n * 2048 + k * 1024); } while (0)
#define PG8_MMA(ai, bj, At, Bt) do { __builtin_amdgcn_s_setprio(1); _Pragma("unroll") for (int m = 0; m < 4; ++m) _Pragma("unroll") for (int n = 0; n < 2; ++n) _Pragma("unroll") for (int k = 0; k < 2; ++k) \
        acc[ai][bj][m][n] = __builtin_amdgcn_mfma_f32_16x16x32_bf16(Bt[n][k], At[m][k], acc[ai][bj][m][n], 0, 0, 0); __builtin_amdgcn_s_setprio(0); } while (0)
#define PG8_WAIT_V(n) asm volatile("s_waitcnt vmcnt(" #n ")" ::: "memory")
#define PG8_WAIT_L(n) asm volatile("s_waitcnt lgkmcnt(" #n ")" ::: "memory")
#define PG8_BAR __builtin_amdgcn_s_barrier()
#define PG8_SCHED __builtin_amdgcn_sched_barrier(0)
    Unit cur, nxt; int ui = 0;
    if (!S.next(0, cur)) return;
    f32x4 acc[2][2][4][2];
#pragma unroll
    for (int a = 0; a < 2; ++a)
#pragma unroll
        for (int b = 0; b < 2; ++b)
#pragma unroll
            for (int m = 0; m < 4; ++m)
#pragma unroll
                for (int n = 0; n < 2; ++n) acc[a][b][m][n] = (f32x4){0.f, 0.f, 0.f, 0.f};
    bf16x8 At[4][2], B0[2][2], B1[2][2];
    const char* cA = (const char*)g.A + (size_t)cur.pm * tstep; const char* cB = (const char*)g.Bt + (size_t)cur.pn * tstep;
    S.a_ready(cur);
    if constexpr (SP2) {
        PG8_STAGE(PG8_SB(0, 0), cB, voffB); PG8_STAGE(PG8_SB(0, 1), cB + hstep, voffB); PG8_STAGE(PG8_SA(0, 0), cA, voffA); PG8_STAGE(PG8_SA(0, 1), cA + hstep, voffA);
        if (wr == 1) PG8_BAR;
        PG8_WAIT_V(2); PG8_BAR;
        PG8_STAGE(PG8_SB(1, 0), cB + kstep, voffB); PG8_STAGE(PG8_SA(1, 0), cA + kstep, voffA); PG8_STAGE(PG8_SB(1, 1), cB + hstep + kstep, voffB);
        PG8_WAIT_V(6); PG8_BAR;
    } else {
        PG8_STAGE(PG8_SB(0, 0), cB, voffB); PG8_STAGE(PG8_SA(0, 0), cA, voffA); PG8_STAGE(PG8_SB(0, 1), cB + hstep, voffB); PG8_STAGE(PG8_SA(0, 1), cA + hstep, voffA);
        if (wr == 1) PG8_BAR;
        PG8_WAIT_V(4); PG8_BAR;
        PG8_STAGE(PG8_SB(1, 0), cB + kstep, voffB); PG8_STAGE(PG8_SA(1, 0), cA + kstep, voffA); PG8_STAGE(PG8_SB(1, 1), cB + hstep + kstep, voffB);
        PG8_WAIT_V(6); PG8_BAR;
    }
    for (;;) {
        const bool has_next = S.next(ui + 1, nxt);
        const char* nA = has_next ? (const char*)g.A + (size_t)nxt.pm * tstep : cA; const char* nB = has_next ? (const char*)g.Bt + (size_t)nxt.pn * tstep : cB;
        for (int t = 0; t < nt; t += 2) {
            const bool last = (t == nt - 2);
            const char* a1 = cA + (size_t)(t + 1) * kstep;
            const char* a2 = last ? nA : cA + (size_t)(t + 2) * kstep; const char* b2 = last ? nB : cB + (size_t)(t + 2) * kstep;
            const char* a3 = a2 + kstep; const char* b3 = b2 + kstep;
            if (last && has_next) S.a_ready(nxt);
            if constexpr (SP2) {
            PG8_LDB(B0, 0, 0); PG8_LDB(B1, 0, 1); PG8_SCHED; PG8_LDA(At, 0, 0); PG8_STAGE(PG8_SA(1, 1), a1 + hstep, voffA);
            PG8_WAIT_V(8); PG8_WAIT_L(0); PG8_BAR; PG8_MMA(0, 0, At, B0); PG8_MMA(0, 1, At, B1); PG8_BAR; PG8_SCHED;
            PG8_LDA(At, 0, 1); PG8_STAGE(PG8_SB(0, 0), b2, voffB); PG8_STAGE(PG8_SB(0, 1), b2 + hstep, voffB); PG8_STAGE(PG8_SA(0, 0), a2, voffA);
            PG8_WAIT_V(8); PG8_WAIT_L(0); PG8_BAR; PG8_MMA(1, 0, At, B0); PG8_MMA(1, 1, At, B1); PG8_BAR; PG8_SCHED;
            PG8_LDB(B0, 1, 0); PG8_LDB(B1, 1, 1); PG8_SCHED; PG8_LDA(At, 1, 0); PG8_STAGE(PG8_SA(0, 1), a2 + hstep, voffA);
            PG8_WAIT_V(8); PG8_WAIT_L(0); PG8_BAR; PG8_MMA(0, 0, At, B0); PG8_MMA(0, 1, At, B1); PG8_BAR; PG8_SCHED;
            PG8_LDA(At, 1, 1); PG8_STAGE(PG8_SB(1, 0), b3, voffB); PG8_STAGE(PG8_SB(1, 1), b3 + hstep, voffB); PG8_STAGE(PG8_SA(1, 0), a3, voffA);
            PG8_WAIT_V(8); PG8_WAIT_L(0); PG8_BAR; PG8_MMA(1, 0, At, B0); PG8_MMA(1, 1, At, B1); PG8_BAR; PG8_SCHED;
            } else {
            PG8_LDB(B0, 0, 0); PG8_SCHED; PG8_LDA(At, 0, 0); PG8_STAGE(PG8_SA(1, 1), a1 + hstep, voffA);
            PG8_WAIT_L(8); PG8_BAR; PG8_WAIT_L(0); PG8_MMA(0, 0, At, B0); PG8_BAR; PG8_SCHED;
            PG8_LDB(B1, 0, 1); PG8_STAGE(PG8_SB(0, 0), b2, voffB);
            PG8_BAR; PG8_WAIT_L(0); PG8_MMA(0, 1, At, B1); PG8_BAR;
            PG8_LDA(At, 0, 1); PG8_STAGE(PG8_SA(0, 0), a2, voffA);
            PG8_BAR; PG8_WAIT_L(0); PG8_MMA(1, 0, At, B0); PG8_BAR; PG8_SCHED;
            PG8_STAGE(PG8_SB(0, 1), b2 + hstep, voffB);
            PG8_WAIT_V(6); PG8_BAR; PG8_MMA(1, 1, At, B1); PG8_BAR;
            PG8_LDB(B0, 1, 0); PG8_SCHED; PG8_LDA(At, 1, 0); PG8_STAGE(PG8_SA(0, 1), a2 + hstep, voffA);
            PG8_WAIT_L(8); PG8_BAR; PG8_WAIT_L(0); PG8_MMA(0, 0, At, B0); PG8_BAR; PG8_SCHED;
            PG8_LDB(B1, 1, 1); PG8_STAGE(PG8_SB(1, 0), b3, voffB);
            PG8_BAR; PG8_WAIT_L(0); PG8_MMA(0, 1, At, B1); PG8_BAR;
            PG8_LDA(At, 1, 1); PG8_STAGE(PG8_SA(1, 0), a3, voffA);
            PG8_BAR; PG8_WAIT_L(0); PG8_MMA(1, 0, At, B0); PG8_BAR; PG8_SCHED;
            PG8_STAGE(PG8_SB(1, 1), b3 + hstep, voffB);
            PG8_WAIT_V(6); PG8_BAR; PG8_MMA(1, 1, At, B1); PG8_BAR;
            }
        }
        if constexpr (ALIGN_EPI) { if (wr == 0) PG8_BAR; }
        if constexpr (!Epi::AFTER_DRAIN) { E(acc, cur, wr, wc, fr, fq); S.done(cur); }
        if (!has_next) break;
#pragma unroll
        for (int a = 0; a < 2; ++a)
#pragma unroll
            for (int b = 0; b < 2; ++b)
#pragma unroll
                for (int m = 0; m < 4; ++m)
#pragma unroll
                    for (int n = 0; n < 2; ++n) acc[a][b][m][n] = (f32x4){0.f, 0.f, 0.f, 0.f};
        cur = nxt; cA = nA; cB = nB; ++ui;
        if constexpr (ALIGN_EPI) { if (wr == 1) PG8_BAR; }
    }
    PG8_WAIT_V(0);
    if constexpr (!ALIGN_EPI) { if (wr == 0) PG8_BAR; }
    PG8_BAR;
#undef PG8_SA
#undef PG8_SB
#undef PG8_STAGE
#undef PG8_LDA
#undef PG8_LDB
#undef PG8_MMA
#undef PG8_WAIT_V
#undef PG8_WAIT_L
#undef PG8_BAR
#undef PG8_SCHED
}
}

constexpr int NWAVES = 8, NTHR = 512;
constexpr int DM = 1024, SEQ = 8192, NB = 2, CTX = 256, TL = NB * SEQ, TC = NB * CTX, TT = TL + TC;
constexpr int FFN = 2752, FFNP = 2816, NWI = 5632, INW = 2432, INWP = 2560, NMOD = 9;
constexpr int ZF = 0, ZQ = 256, ZK = 640, ZV = 768, ZRR = 896, ZRK = 1280, ZRV = 1664, ZW = 2048, ZA = 2176, ZG = 2304;
constexpr int RW = 384;
constexpr float NORM_EPS = 1e-6f, GN_EPS = 64e-5f;

constexpr size_t MiB = 1u << 20;
constexpr size_t WS_CTL = 0, WS_MOD = 1 * MiB, WS_ROPE = 2 * MiB, WS_XC = 4 * MiB, WS_GC = 6 * MiB;
constexpr size_t WS_WI1 = 8 * MiB, WS_WO1 = 19 * MiB, WS_WIN = 25 * MiB, WS_WOUT = 30 * MiB, WS_WI2 = 32 * MiB, WS_WO2 = 43 * MiB;
constexpr size_t WS_H = 49 * MiB;
constexpr size_t WS_ACT = 82 * MiB;
constexpr size_t WS_O = 173 * MiB;
constexpr size_t WS_W2T = WS_MOD + 256 * 1024, WS_A2T = WS_MOD + 512 * 1024, WS_G2T = WS_MOD + 768 * 1024;
constexpr size_t WS_LW = WS_O, WS_IC = WS_O + 25 * MiB;
constexpr size_t WS_GAM32 = 165 * MiB;
constexpr size_t WS_XB = 239 * MiB;
constexpr size_t OUT_FA = 0;
constexpr size_t OUT_SUM = 16 * MiB;
constexpr size_t WS_END = 272 * MiB;

constexpr size_t WS_FT = 7 * MiB;
constexpr size_t FT_W64C = 0, FT_W64S = 8192, FT_W128C = 16384, FT_W128S = 49152, FT_T64C = 81920, FT_T64S = 90112;
constexpr int LDS_BYTES = 147456;
constexpr int MISC_OFF = 146432;

typedef unsigned short bf16;
typedef float f32x4 __attribute__((ext_vector_type(4)));
typedef unsigned v4u __attribute__((ext_vector_type(4)));
typedef unsigned v2u __attribute__((ext_vector_type(2)));
#define LAS __attribute__((address_space(3)))
#define LDS_WAIT() asm volatile("s_waitcnt lgkmcnt(0)" ::: "memory")

__device__ __forceinline__ unsigned f2bf(float f) { unsigned u = __builtin_bit_cast(unsigned, f); return (u + 0x7fffu + ((u >> 16) & 1u)) >> 16; }
__device__ __forceinline__ unsigned pk2(float lo, float hi) { return f2bf(lo) | (f2bf(hi) << 16); }
__device__ __forceinline__ float bf2f(unsigned short u) { return __builtin_bit_cast(float, (unsigned)u << 16); }
__device__ __forceinline__ float bflo(unsigned u) { return __builtin_bit_cast(float, u << 16); }
__device__ __forceinline__ float bfhi(unsigned u) { return __builtin_bit_cast(float, u & 0xffff0000u); }
__device__ __forceinline__ void unpack8(const v4u w, float (&f)[8]) { f[0] = bflo(w.x); f[1] = bfhi(w.x); f[2] = bflo(w.y); f[3] = bfhi(w.y); f[4] = bflo(w.z); f[5] = bfhi(w.z); f[6] = bflo(w.w); f[7] = bfhi(w.w); }
__device__ __forceinline__ float wave_sum(float v) {
#pragma unroll
    for (int o = 1; o < 64; o <<= 1) v += __shfl_xor(v, o);
    return v;
}
__device__ __forceinline__ float wave_max(float v) {
#pragma unroll
    for (int o = 1; o < 64; o <<= 1) v = fmaxf(v, __shfl_xor(v, o));
    return v;
}

struct Args { const float* in[25]; float* out; unsigned char* ws; int ph_lo, ph_hi; };

struct Frame {
    LAS unsigned char* lds;
    int tid, lane, wave, G, bid;
    float* out; unsigned char* ws;
};
enum { I_X = 0, I_C, I_CTX, I_CCTX, I_MODW, I_MODB, I_NORMG, I_F1WI, I_F1WO, I_WIN, I_WOUT, I_SINK, I_CONV, I_W0, I_W2, I_A0, I_A2, I_G2, I_KK, I_KA, I_RK, I_LNG, I_LNB, I_F2WI, I_F2WO };

__device__ __forceinline__ const float* inp(int i) {
    const __attribute__((address_space(4))) char* p = (const __attribute__((address_space(4))) char*)__builtin_amdgcn_kernarg_segment_ptr();
    asm volatile("" : "+s"(p));
    return *(const float* const __attribute__((address_space(4)))*)(p + 8 * i);
}
struct CvtDesc { const float* W; bf16* WT; int ldw, k0, sc, Kd, n0d; bool valid, live; };
__device__ __forceinline__ void cvt_load(const CvtDesc& d, f32x4 (&v)[8], int lane) {
    const int c4 = lane & 7, r8 = lane >> 3;
#pragma unroll
    for (int i = 0; i < 8; ++i) v[i] = (d.live && d.valid) ? *(const f32x4*)(d.W + (size_t)(d.k0 + 8 * i + r8) * d.ldw + d.sc + 4 * c4) : (f32x4){0.f, 0.f, 0.f, 0.f};
}
__device__ __forceinline__ void cvt_finish(const CvtDesc& d, const f32x4 (&v)[8], LAS float* scr, int lane) {
    if (!d.live) return;
    const int c4 = lane & 7, r8 = lane >> 3;
#pragma unroll
    for (int i = 0; i < 8; ++i) *(LAS f32x4*)(scr + (8 * i + r8) * 36 + 4 * c4) = v[i];
    LDS_WAIT(); asm volatile("" ::: "memory");
    const int c = lane & 7;
#pragma unroll
    for (int j = 0; j < 4; ++j) { const int n = (lane >> 3) + 8 * j; const LAS float* s = scr + (8 * c) * 36 + n;
        v4u o; o.x = pk2(s[0 * 36], s[1 * 36]); o.y = pk2(s[2 * 36], s[3 * 36]); o.z = pk2(s[4 * 36], s[5 * 36]); o.w = pk2(s[6 * 36], s[7 * 36]);
        *(v4u*)(d.WT + (size_t)(d.n0d + n) * d.Kd + d.k0 + 8 * c) = o; }
    LDS_WAIT(); asm volatile("" ::: "memory");
}
__device__ __forceinline__ CvtDesc cvt_decode(Frame& F, int li, int set, int it) {
    constexpr int I_WI = 16 * (NWI / 32), I_WO = (FFNP / 64) * 32, I_IN = 16 * (INWP / 32), I_OUT = 16 * 32;
    constexpr int NITEMS = 2 * I_WI + 2 * I_WO + I_IN + I_OUT;
    CvtDesc d{}; d.live = it < NITEMS; if (!d.live) return d;
    int r = it;
    if (set) { const bool inA = r < I_WI || (r >= 2 * I_WI && r < 2 * I_WI + I_WO) || (r >= 2 * I_WI + 2 * I_WO && r < 2 * I_WI + 2 * I_WO + I_IN); if (inA != (set == 1)) { d.live = false; return d; } }
    if (r < 2 * I_WI) { const int f = r / I_WI; r -= f * I_WI; const int nblk = NWI / 32, kb = r / nblk, nb = r % nblk;
        const int n0 = 32 * nb, pn = n0 >> 8, i = n0 & 255; const int j = 128 * pn + (i & 127);
        d.W = (f ? inp(I_F2WI) : inp(I_F1WI)) + (size_t)li * DM * 2 * FFN; d.ldw = 2 * FFN; d.k0 = 64 * kb; d.sc = (i < 128) ? j : FFN + j; d.valid = j < FFN; d.WT = (bf16*)(F.ws + (f ? WS_WI2 : WS_WI1)); d.Kd = DM; d.n0d = n0; return d; }
    r -= 2 * I_WI;
    if (r < 2 * I_WO) { const int f = r / I_WO; r -= f * I_WO; const int kb = r / 32, nb = r % 32;
        d.W = (f ? inp(I_F2WO) : inp(I_F1WO)) + (size_t)li * FFN * DM; d.ldw = DM; d.k0 = 64 * kb; d.sc = 32 * nb; d.valid = 64 * kb < FFN; d.WT = (bf16*)(F.ws + (f ? WS_WO2 : WS_WO1)); d.Kd = FFNP; d.n0d = 32 * nb; return d; }
    r -= 2 * I_WO;
    if (r < I_IN) { const int nblk = INWP / 32, kb = r / nblk, nb = r % nblk;
        d.W = inp(I_WIN) + (size_t)li * DM * INW; d.ldw = INW; d.k0 = 64 * kb; d.sc = 32 * nb; d.valid = 32 * nb < INW; d.WT = (bf16*)(F.ws + WS_WIN); d.Kd = DM; d.n0d = 32 * nb; return d; }
    r -= I_IN;
    { const int kb = r / 32, nb = r % 32;
        d.W = inp(I_WOUT) + (size_t)li * DM * DM; d.ldw = DM; d.k0 = 64 * kb; d.sc = 32 * nb; d.valid = true; d.WT = (bf16*)(F.ws + WS_WOUT); d.Kd = DM; d.n0d = 32 * nb; return d; }
}
__device__ __forceinline__ void convert_weights(Frame& F, int li, int set = 0, int bid0 = 0, int nblk = 0) {
    if (nblk == 0) nblk = F.G;
    if (F.bid < bid0 || F.bid >= bid0 + nblk) return;
    LAS float* scr = (LAS float*)(F.lds + F.wave * 16384);
    const int gw = (F.bid - bid0) * NWAVES + F.wave, NGW = nblk * NWAVES;
    constexpr int NITEMS = 2 * 16 * (NWI / 32) + 2 * (FFNP / 64) * 32 + 16 * (INWP / 32) + 16 * 32;
    for (int it = gw; it < NITEMS; it += 2 * NGW) {
        const CvtDesc d0 = cvt_decode(F, li, set, it), d1 = cvt_decode(F, li, set, it + NGW);
        f32x4 v0[8], v1[8];
        cvt_load(d0, v0, F.lane); cvt_load(d1, v1, F.lane);
        cvt_finish(d0, v0, scr, F.lane); cvt_finish(d1, v1, scr, F.lane);
    }
}
__device__ __forceinline__ void mod_gemv(Frame& F) {
    LAS float* sc = (LAS float*)F.lds;
    LAS float* red = sc + 3 * 1024;
    __syncthreads();
    for (int i = F.tid; i < 3 * 1024; i += NTHR) { const int v = i >> 10, k = i & 1023; const float x = v < 2 ? inp(I_C)[v * 1024 + k] : inp(I_CCTX)[k]; sc[i] = x / (1.0f + __expf(-x)); }
    __syncthreads();
    float* modv = (float*)(F.ws + WS_MOD);
    for (int u = F.bid; u < 2 * 72; u += F.G) {
        const int l = u / 72, n0 = (u % 72) * 128;
        const float* w = inp(I_MODW) + (size_t)l * DM * 9216 + n0 + 2 * F.lane;
        float a0 = 0.f, a1 = 0.f, b0 = 0.f, b1 = 0.f, c0 = 0.f, c1 = 0.f;
        const int k0 = F.wave * 128;
#pragma unroll 8
        for (int k = 0; k < 128; ++k) { const float2 wv = *(const float2*)(w + (size_t)(k0 + k) * 9216); const float s0 = sc[k0 + k], s1 = sc[1024 + k0 + k], s2 = sc[2048 + k0 + k];
            a0 += s0 * wv.x; a1 += s0 * wv.y; b0 += s1 * wv.x; b1 += s1 * wv.y; c0 += s2 * wv.x; c1 += s2 * wv.y; }
        LAS float* rw = red + F.wave * 384 + 2 * F.lane;
        rw[0] = a0; rw[1] = a1; rw[128] = b0; rw[129] = b1; rw[256] = c0; rw[257] = c1;
        __syncthreads();
        if (F.tid < 384) { float s = 0.f;
#pragma unroll
            for (int w8 = 0; w8 < 8; ++w8) s += red[w8 * 384 + F.tid];
            const int v = F.tid >> 7, n = n0 + (F.tid & 127);
            modv[(size_t)(l * 3 + v) * 9216 + n] = s + inp(I_MODB)[l * 9216 + n]; }
        __syncthreads();
    }
}
__device__ __forceinline__ void rope_tables(Frame& F) {
    float* ct = (float*)(F.ws + WS_ROPE); float* st = ct + SEQ * 32;
    for (int i = F.bid * NTHR + F.tid; i < SEQ * 32; i += F.G * NTHR) {
        const int t = i >> 5, j = i & 31; const int f = j & 15;
        const float inv = exp2f(-(float)f * (13.287712379549449f / 16.0f));
        const float pos = (float)(j < 16 ? (t >> 6) : (t & 63));
        const float ang = pos * inv;
        const double a = (double)ang; const double k = __builtin_rint(a * 0.15915494309189535); const float r = (float)(a - k * 6.283185307179586);
        ct[i] = __cosf(r); st[i] = __sinf(r);
    }
}

struct EArgs { const float* xl_src; const float* xc_src; const bf16* xb_src; bf16* xb_dst; float* out32; const bf16* o; const float* modv_g; int gidx; float gmul; const float* gpost;
               bf16* hdst; const float* modv_h; int shidx, scidx; const float* gpre; int nrows; };
template <int R>
__device__ __forceinline__ void e_rows(Frame& F, const EArgs& A, int v, int r0) {
    f32x4 cg[4], ch[4], cs[4];
#pragma unroll
    for (int j = 0; j < 4; ++j) { const int c = F.lane + 64 * j;
        if (A.o) cg[j] = ((const f32x4*)(A.modv_g + (size_t)v * 9216 + A.gidx * DM))[c] * ((const f32x4*)A.gpost)[c] * A.gmul;
        if (A.hdst) { ch[j] = ((const f32x4*)A.gpre)[c] * (1.0f + ((const f32x4*)(A.modv_h + (size_t)v * 9216 + A.scidx * DM))[c]); cs[j] = ((const f32x4*)(A.modv_h + (size_t)v * 9216 + A.shidx * DM))[c]; } }
    f32x4 x[R][4]; v2u ow[R][4];
#pragma unroll
    for (int i = 0; i < R; ++i) { const int r = r0 + i;
        if (A.xb_src) { const v2u* xs = (const v2u*)(A.xb_src + (size_t)r * DM);
#pragma unroll
            for (int j = 0; j < 4; ++j) { const v2u w = xs[F.lane + 64 * j]; x[i][j] = (f32x4){bflo(w.x), bfhi(w.x), bflo(w.y), bfhi(w.y)}; } }
        else { const float* xs = r < TL ? A.xl_src + (size_t)r * DM : A.xc_src + (size_t)(r - TL) * DM;
#pragma unroll
            for (int j = 0; j < 4; ++j) x[i][j] = ((const f32x4*)xs)[F.lane + 64 * j]; }
        if (A.o) { const v2u* orow = (const v2u*)(A.o + (size_t)r * DM);
#pragma unroll
            for (int j = 0; j < 4; ++j) ow[i][j] = orow[F.lane + 64 * j]; } }
#pragma unroll
    for (int i = 0; i < R; ++i) { const int r = r0 + i;
        if (A.o) { f32x4 ov[4]; float ss = 0.f;
#pragma unroll
            for (int j = 0; j < 4; ++j) { const v2u w = ow[i][j]; ov[j] = (f32x4){bflo(w.x), bfhi(w.x), bflo(w.y), bfhi(w.y)}; ss += (ov[j].x * ov[j].x + ov[j].y * ov[j].y) + (ov[j].z * ov[j].z + ov[j].w * ov[j].w); }
            const float rstd = 1.0f / sqrtf(wave_sum(ss) * (1.0f / DM) + NORM_EPS);
#pragma unroll
            for (int j = 0; j < 4; ++j) x[i][j] = x[i][j] + cg[j] * (ov[j] * rstd);
            if (A.out32) {
#pragma unroll
                for (int j = 0; j < 4; ++j) ((f32x4*)(A.out32 + (size_t)r * DM))[F.lane + 64 * j] = x[i][j]; }
            else { v2u* xd = (v2u*)(A.xb_dst + (size_t)r * DM);
#pragma unroll
                for (int j = 0; j < 4; ++j) { v2u w; w.x = pk2(x[i][j].x, x[i][j].y); w.y = pk2(x[i][j].z, x[i][j].w); xd[F.lane + 64 * j] = w; } } }
        if (A.hdst) { float ss = 0.f;
#pragma unroll
            for (int j = 0; j < 4; ++j) ss += (x[i][j].x * x[i][j].x + x[i][j].y * x[i][j].y) + (x[i][j].z * x[i][j].z + x[i][j].w * x[i][j].w);
            const float rstd = 1.0f / sqrtf(wave_sum(ss) * (1.0f / DM) + NORM_EPS);
            v2u* hd = (v2u*)(A.hdst + (size_t)r * DM);
#pragma unroll
            for (int j = 0; j < 4; ++j) { const f32x4 hv = (x[i][j] * rstd) * ch[j] + cs[j]; v2u w; w.x = pk2(hv.x, hv.y); w.y = pk2(hv.z, hv.w); hd[F.lane + 64 * j] = w; } } }
}
__device__ __forceinline__ void e_phase(Frame& F, const EArgs& A) {
    const int gw = F.bid * NWAVES + F.wave, NGW = F.G * NWAVES;
    if (NGW == 2048) {
        const int b = gw >> 10, r0 = b * SEQ + (gw & 1023) * 8;
        e_rows<4>(F, A, b, r0); e_rows<4>(F, A, b, r0 + 4);
        if (A.nrows > TL && (gw & 3) == 0) e_rows<1>(F, A, 2, TL + (gw >> 2));
    } else { for (int r = gw; r < A.nrows; r += NGW) e_rows<1>(F, A, r < TL ? (r >> 13) : 2, r); }
}

__device__ __forceinline__ const bf16* zrow(const Frame& F, int row) { return (const bf16*)(F.ws + WS_ACT) + (size_t)row * INWP; }

__device__ __forceinline__ void fourier_ctx1_all(Frame& F) {
    float* gr = (float*)(F.ws + WS_GC); float* gi = gr + TC * 256;
    const bf16* wc = (const bf16*)(F.ws + WS_FT + FT_W64C); const bf16* wsn = (const bf16*)(F.ws + WS_FT + FT_W64S);
    for (int i = F.bid * NTHR + F.tid; i < TC * 256; i += F.G * NTHR) { const int tok = i >> 8, gm = i & 255, g = gm >> 6, m = gm & 63;
        const bf16* z = zrow(F, TL + tok) + ZF + 64 * g; float sr = 0.f, si = 0.f;
#pragma unroll
        for (int c8 = 0; c8 < 8; ++c8) { float x[8], cs[8], sn[8]; unpack8(*(const v4u*)(z + 8 * c8), x); unpack8(*(const v4u*)(wc + m * 64 + 8 * c8), cs); unpack8(*(const v4u*)(wsn + m * 64 + 8 * c8), sn);
#pragma unroll
            for (int e = 0; e < 8; ++e) { sr += x[e] * cs[e]; si -= x[e] * sn[e]; } }
        gr[i] = sr; gi[i] = si; }
}
__device__ __forceinline__ void fourier_ctx2_all(Frame& F) {
    const float* gr = (const float*)(F.ws + WS_GC); const float* gi = gr + TC * 256; bf16* mix = (bf16*)(F.ws + WS_H);
    for (int i = F.bid * NTHR + F.tid; i < TC * 256; i += F.G * NTHR) { const int row = i >> 8, gm = i & 255, b = row >> 8, k = row & 255; float y = 0.f;
#pragma unroll 8
        for (int n = 0; n < 256; ++n) { const float a = (float)((k * n) & 255) * (1.0f / 256.0f); y += gr[(b * 256 + n) * 256 + gm] * __builtin_amdgcn_cosf(a) + gi[(b * 256 + n) * 256 + gm] * __builtin_amdgcn_sinf(a); }
        mix[(size_t)(TL + row) * DM + gm] = (bf16)f2bf(y * 0.0078125f); }
}
typedef short bf16x8 __attribute__((ext_vector_type(8)));
#define MFMA16(a, b, c) __builtin_amdgcn_mfma_f32_16x16x32_bf16(a, b, c, 0, 0, 0)
__device__ __forceinline__ bf16x8 mk8(unsigned a, unsigned b, unsigned c, unsigned d) { const v4u v = {a, b, c, d}; return __builtin_bit_cast(bf16x8, v); }
typedef __bf16 bf16x2_t __attribute__((ext_vector_type(2)));
typedef float f32x2_t __attribute__((ext_vector_type(2)));
__device__ __forceinline__ unsigned cvtpk(float lo, float hi) { const f32x2_t f = {lo, hi}; return __builtin_bit_cast(unsigned, __builtin_convertvector(f, bf16x2_t)); }
constexpr int NSC = 66;
constexpr int IM_AI = 0, IM_RI = 4608, IM_BI = 9216, IM_KI = 13824, IM_BKT = 18432, IM_VT = 28672, IM_GAM = 33792, IMG_BYTES = 34816;
constexpr int L_IMG0 = 0, L_IMG1 = IMG_BYTES, L_PKG = 2 * IMG_BYTES, L_YL = L_PKG + 8192, L_VB = L_YL + 128 * 68 * 4, L_BON = L_VB + 128 * 64 * 2, L_CST = L_BON + 512, L_RW_END = L_CST + 2 * 3072;
static_assert(L_RW_END <= 146432, "rwkv LDS map");
constexpr size_t SUM_SLOT = 24576;

__device__ __forceinline__ void lora_transposes(Frame& F) {
    bf16* w2t = (bf16*)(F.ws + WS_W2T); bf16* a2t = (bf16*)(F.ws + WS_A2T); bf16* g2t = (bf16*)(F.ws + WS_G2T);
    const float* w2 = inp(I_W2); const float* a2 = inp(I_A2); const float* g2 = inp(I_G2);
    for (int i = F.bid * NTHR + F.tid; i < 4 * 384 * 64; i += F.G * NTHR) { const int r = i & 63, col = (i >> 6) % 384, ld = i / (384 * 64);
        w2t[i] = (bf16)f2bf(w2[((size_t)ld * 64 + r) * RW + col]); a2t[i] = (bf16)f2bf(a2[((size_t)ld * 64 + r) * RW + col]); }
    for (int i = F.bid * NTHR + F.tid; i < 2 * 384 * 128; i += F.G * NTHR) { const int r = i & 127, col = (i >> 7) % 384, l = i / (384 * 128);
        g2t[i] = (bf16)f2bf(g2[((size_t)l * 128 + r) * RW + col]); }
}

__device__ __forceinline__ float softplus_fast(float x) { return fmaxf(x, 0.f) + __logf(1.0f + __expf(-fabsf(x))); }
__device__ __forceinline__ float tanh_fast(float x) { return 1.0f - 2.0f * __builtin_amdgcn_rcpf(1.0f + __expf(2.0f * x)); }
template <int CTRL> __device__ __forceinline__ float dpp_f(float v) { return __builtin_bit_cast(float, __builtin_amdgcn_update_dpp(0, __builtin_bit_cast(int, v), CTRL, 0xf, 0xf, true)); }
__device__ __forceinline__ void lora_pass(Frame& F, int li) {
    const int q = F.lane >> 4, c16 = F.lane & 15;
#pragma unroll 1
    for (int dir = 0; dir < 2; ++dir) {
        bf16* LW = (bf16*)(F.ws + WS_LW) + (size_t)dir * TT * RW; bf16* IC = (bf16*)(F.ws + WS_IC) + (size_t)dir * TT * RW;
        const bf16* w2t = (const bf16*)(F.ws + WS_W2T) + (size_t)(li * 2 + dir) * 384 * 64; const bf16* a2t = (const bf16*)(F.ws + WS_A2T) + (size_t)(li * 2 + dir) * 384 * 64;
        bf16x8 aw[3][2], aa[3][2]; f32x4 w0v[3], a0v[3];
#pragma unroll
        for (int cti = 0; cti < 3; ++cti) { const int ct = 3 * F.wave + cti, col = 16 * ct + c16;
#pragma unroll
            for (int k = 0; k < 2; ++k) { aw[cti][k] = *(const bf16x8*)(w2t + (size_t)col * 64 + 32 * k + 8 * q); aa[cti][k] = *(const bf16x8*)(a2t + (size_t)col * 64 + 32 * k + 8 * q); }
            w0v[cti] = *(const f32x4*)(inp(I_W0) + (li * 2 + dir) * RW + 16 * ct + 4 * q); a0v[cti] = *(const f32x4*)(inp(I_A0) + (li * 2 + dir) * RW + 16 * ct + 4 * q); }
#pragma unroll 1
        for (int rt = F.bid; rt < TT / 16; rt += F.G) {
            const bf16* z = zrow(F, 16 * rt + c16);
            bf16x8 bw[2], ba[2];
#pragma unroll
            for (int k = 0; k < 2; ++k) { const v4u zw = *(const v4u*)(z + ZW + 64 * dir + 32 * k + 8 * q); ba[k] = *(const bf16x8*)(z + ZA + 64 * dir + 32 * k + 8 * q);
                bw[k] = mk8(cvtpk(tanh_fast(bflo(zw.x)), tanh_fast(bfhi(zw.x))), cvtpk(tanh_fast(bflo(zw.y)), tanh_fast(bfhi(zw.y))), cvtpk(tanh_fast(bflo(zw.z)), tanh_fast(bfhi(zw.z))), cvtpk(tanh_fast(bflo(zw.w)), tanh_fast(bfhi(zw.w)))); }
#pragma unroll
            for (int cti = 0; cti < 3; ++cti) { const int ct = 3 * F.wave + cti;
                f32x4 dw = {0.f, 0.f, 0.f, 0.f}, da = {0.f, 0.f, 0.f, 0.f};
#pragma unroll
                for (int k = 0; k < 2; ++k) { dw = MFMA16(aw[cti][k], bw[k], dw); da = MFMA16(aa[cti][k], ba[k], da); }
                float lw[4], ic[4];
#pragma unroll
                for (int e = 0; e < 4; ++e) { const float x = w0v[cti][e] + dw[e]; const float wl = -softplus_fast(-x) - 0.5f; lw[e] = -__expf(wl); ic[e] = __builtin_amdgcn_rcpf(1.0f + __expf(-(a0v[cti][e] + da[e]))); }
                if (dir == 0) {
#pragma unroll
                    for (int e = 0; e < 4; ++e) { lw[e] += dpp_f<0x111>(lw[e]); lw[e] += dpp_f<0x112>(lw[e]); lw[e] += dpp_f<0x114>(lw[e]); lw[e] += dpp_f<0x118>(lw[e]); } }
                else {
#pragma unroll
                    for (int e = 0; e < 4; ++e) { lw[e] += dpp_f<0x101>(lw[e]); lw[e] += dpp_f<0x102>(lw[e]); lw[e] += dpp_f<0x104>(lw[e]); lw[e] += dpp_f<0x108>(lw[e]); } }
#pragma unroll
                for (int e = 0; e < 4; ++e) lw[e] = __expf(lw[e]);
                if (c16 == (dir == 0 ? 15 : 0)) *(f32x4*)((float*)(F.ws + WS_GAM32) + ((size_t)dir * (TT / 16) + rt) * RW + 16 * ct + 4 * q) = (f32x4){lw[0], lw[1], lw[2], lw[3]};
                const size_t o = (size_t)(16 * rt + c16) * RW + 16 * ct + 4 * q;
                v2u w; w.x = cvtpk(lw[0], lw[1]); w.y = cvtpk(lw[2], lw[3]); *(v2u*)(LW + o) = w; w.x = cvtpk(ic[0], ic[1]); w.y = cvtpk(ic[2], ic[3]); *(v2u*)(IC + o) = w; }
        }
    }
}
__device__ __forceinline__ void chain_consts_lds(Frame& F, LAS float* cst, int li, int h, int t256) {
    for (int i = t256; i < 12 * 64; i += 256) { const int k = i >> 6, j = i & 63, ch = 64 * h + j; float v;
        if (k == 0) v = inp(I_KK)[li * RW + ch]; else if (k == 1) v = inp(I_KA)[li * RW + ch]; else if (k == 2) v = inp(I_RK)[li * RW + ch];
        else { const int tt = (k - 3) / 3, w = (k - 3) % 3; v = inp(I_CONV)[(size_t)(li * 3 + tt) * (3 * RW) + w * RW + ch]; }
        cst[i] = v; }
}
struct PrepRaw { v4u ecw, icv, epw, zr[3], zk[3], zv[3]; };
__device__ __forceinline__ void prep_load(Frame& F, PrepRaw& R, int dir, int b, int h, int tl, int o, bool isctx, int step0) {
    const int L = isctx ? CTX : SEQ, rbase = isctx ? TL + b * CTX : b * SEQ, ch0 = 64 * h + 8 * o;
    const int s = step0 + tl; const int p = dir ? L - 1 - s : s; const int row = rbase + p, tb = tl & 15;
    { const bf16* LW = (const bf16*)(F.ws + WS_LW) + (size_t)dir * TT * RW + ch0; const bf16* IC = (const bf16*)(F.ws + WS_IC) + (size_t)dir * TT * RW + ch0;
      R.ecw = *(const v4u*)(LW + (size_t)row * RW); R.icv = *(const v4u*)(IC + (size_t)row * RW); R.epw = *(const v4u*)(LW + (size_t)(tb == 0 ? row : (dir ? row + 1 : row - 1)) * RW); }
#pragma unroll
    for (int tt = 0; tt < 3; ++tt) { const int pp = p + tt - 1; const bool ok = pp >= 0 && pp < L; const bf16* z = zrow(F, rbase + (ok ? pp : p)) + ch0;
        const v4u z0 = {0u, 0u, 0u, 0u};
        R.zr[tt] = ok ? *(const v4u*)(z + ZRR) : z0; R.zk[tt] = ok ? *(const v4u*)(z + ZRK) : z0; R.zv[tt] = ok ? *(const v4u*)(z + ZRV) : z0; }
}
__device__ __forceinline__ void prep_compute(Frame& F, const PrepRaw& R, const LAS float* cst, LAS unsigned char* img, int dir, int b, int h, int tl, int o, bool isctx, int step0, LAS unsigned char* lds_vb, LAS float* lds_bon, int pos0_local) {
    const bool BONUS = lds_vb != nullptr;
    const int L = isctx ? CTX : SEQ, rbase = isctx ? TL + b * CTX : b * SEQ, ch0 = 64 * h + 8 * o;
    const int blk = tl >> 4, tb = tl & 15;
    const int s = step0 + tl; const int p = dir ? L - 1 - s : s; const int row = rbase + p;
    const v4u ecw = R.ecw, icv = R.icv, epw = R.epw;
    v4u zr[3], zk[3], zv[3];
#pragma unroll
    for (int tt = 0; tt < 3; ++tt) { zr[tt] = R.zr[tt]; zk[tt] = R.zk[tt]; zv[tt] = R.zv[tt]; }
    float ecf[8], epf[8], ai[8], rv[8], kv[8], vv[8];
    unpack8(ecw, ecf); unpack8(epw, epf); unpack8(icv, ai);
#pragma unroll
    for (int e = 0; e < 8; ++e) { rv[e] = 0.f; kv[e] = 0.f; vv[e] = 0.f; }
#pragma unroll
    for (int tt = 0; tt < 3; ++tt) { float a[8], bq[8], cq[8]; unpack8(zr[tt], a); unpack8(zk[tt], bq); unpack8(zv[tt], cq);
        const LAS f32x4* w0 = (const LAS f32x4*)(cst + (3 + tt * 3 + 0) * 64 + 8 * o); const LAS f32x4* w1 = (const LAS f32x4*)(cst + (3 + tt * 3 + 1) * 64 + 8 * o); const LAS f32x4* w2 = (const LAS f32x4*)(cst + (3 + tt * 3 + 2) * 64 + 8 * o);
        const f32x4 w0a = w0[0], w0b = w0[1], w1a = w1[0], w1b = w1[1], w2a = w2[0], w2b = w2[1];
#pragma unroll
        for (int e = 0; e < 4; ++e) { rv[e] += w0a[e] * a[e]; rv[e + 4] += w0b[e] * a[e + 4]; kv[e] += w1a[e] * bq[e]; kv[e + 4] += w1b[e] * bq[e + 4]; vv[e] += w2a[e] * cq[e]; vv[e + 4] += w2b[e] * cq[e + 4]; } }
    float kkw[8], kaw[8];
    { const LAS f32x4* a = (const LAS f32x4*)(cst + 0 * 64 + 8 * o); const LAS f32x4* bq = (const LAS f32x4*)(cst + 1 * 64 + 8 * o); const f32x4 a0 = a[0], a1 = a[1], b0 = bq[0], b1 = bq[1];
#pragma unroll
      for (int e = 0; e < 4; ++e) { kkw[e] = a0[e]; kkw[e + 4] = a1[e]; kaw[e] = b0[e]; kaw[e + 4] = b1[e]; } }
    float kkr[8], ss = 0.f;
#pragma unroll
    for (int e = 0; e < 8; ++e) { kkr[e] = kv[e] * kkw[e]; ss += kkr[e] * kkr[e]; }
    ss += __shfl_xor(ss, 1); ss += __shfl_xor(ss, 2); ss += __shfl_xor(ss, 4);
    const float rn = 1.0f / sqrtf(fmaxf(ss, 1e-24f));
    float At[8], Rt[8], Bt[8], Kt[8];
#pragma unroll
    for (int e = 0; e < 8; ++e) { const float kk = kkr[e] * rn, kd = kv[e] * (1.0f + (ai[e] - 1.0f) * kaw[e]); const float eprev = tb == 0 ? 1.0f : epf[e]; const float ec = ecf[e], en = 1.0f / ec;
        At[e] = -kk * eprev; Rt[e] = rv[e] * ec; Bt[e] = kk * ai[e] * en; Kt[e] = kd * en; }
    const int P0 = 32 * (o >> 2) + 16 * (o & 1) + 4 * ((o >> 1) & 1);
    LAS bf16* AI = (LAS bf16*)(img + IM_AI) + blk * 1152 + tb * 72 + P0, *RI = (LAS bf16*)(img + IM_RI) + blk * 1152 + tb * 72 + P0, *BI = (LAS bf16*)(img + IM_BI) + blk * 1152 + tb * 72 + P0, *KI = (LAS bf16*)(img + IM_KI) + blk * 1152 + tb * 72 + P0;
    unsigned bp[4], kp[4];
#pragma unroll
    for (int e = 0; e < 4; ++e) { bp[e] = cvtpk(Bt[2 * e], Bt[2 * e + 1]); kp[e] = cvtpk(Kt[2 * e], Kt[2 * e + 1]); }
    *(LAS v2u*)AI = (v2u){cvtpk(At[0], At[1]), cvtpk(At[2], At[3])}; *(LAS v2u*)(AI + 8) = (v2u){cvtpk(At[4], At[5]), cvtpk(At[6], At[7])};
    *(LAS v2u*)RI = (v2u){cvtpk(Rt[0], Rt[1]), cvtpk(Rt[2], Rt[3])}; *(LAS v2u*)(RI + 8) = (v2u){cvtpk(Rt[4], Rt[5]), cvtpk(Rt[6], Rt[7])};
    *(LAS v2u*)BI = (v2u){bp[0], bp[1]}; *(LAS v2u*)(BI + 8) = (v2u){bp[2], bp[3]};
    *(LAS v2u*)KI = (v2u){kp[0], kp[1]}; *(LAS v2u*)(KI + 8) = (v2u){kp[2], kp[3]};
    LAS bf16* BKT = (LAS bf16*)(img + IM_BKT) + blk * 2560 + (8 * o) * 40 + (tb >> 2) * 8 + (tb & 3); LAS bf16* VT = (LAS bf16*)(img + IM_VT) + blk * 1280 + (8 * o) * 20 + tb;
    const unsigned vp[4] = {cvtpk(vv[0], vv[1]), cvtpk(vv[2], vv[3]), cvtpk(vv[4], vv[5]), cvtpk(vv[6], vv[7])};
#pragma unroll
    for (int e = 0; e < 8; ++e) { const unsigned bb = bp[e >> 1], kq = kp[e >> 1], vq = vp[e >> 1];
        BKT[e * 40] = (bf16)((e & 1) ? (bb >> 16) : (bb & 0xffff)); BKT[e * 40 + 4] = (bf16)((e & 1) ? (kq >> 16) : (kq & 0xffff)); VT[e * 20] = (bf16)((e & 1) ? (vq >> 16) : (vq & 0xffff)); }
    if (tb == 15) { const f32x4* gs = (const f32x4*)((const float*)(F.ws + WS_GAM32) + ((size_t)dir * (TT / 16) + (row >> 4)) * RW + ch0); LAS f32x4* G = (LAS f32x4*)((LAS float*)(img + IM_GAM) + blk * 64 + 8 * o); G[0] = gs[0]; G[1] = gs[1]; }
    if (BONUS) { float bs = 0.f; const LAS f32x4* rk = (const LAS f32x4*)(cst + 2 * 64 + 8 * o); const f32x4 r0 = rk[0], r1 = rk[1];
#pragma unroll
        for (int e = 0; e < 4; ++e) bs += rv[e] * kv[e] * r0[e] + rv[e + 4] * kv[e + 4] * r1[e];
        bs += __shfl_xor(bs, 1); bs += __shfl_xor(bs, 2); bs += __shfl_xor(bs, 4);
        const int pl = dir ? pos0_local - tl : pos0_local + tl;
        *(LAS v4u*)(lds_vb + (pl * 64 + 8 * o) * 2) = (v4u){vp[0], vp[1], vp[2], vp[3]}; if (o == 0) lds_bon[pl] = bs; }
}
template <bool WANT_Y>
__device__ __forceinline__ void block_package(LAS unsigned char* img, int blk, LAS unsigned* pkg, int lane) {
    const int q = lane >> 4, c = lane & 15;
    f32x4 mab = {0.f, 0.f, 0.f, 0.f}, mak = mab, mbr = mab, mkr = mab;
#pragma unroll
    for (int k = 0; k < 2; ++k) { const int o = blk * 2304 + c * 144 + k * 64 + q * 16;
        const bf16x8 bi = *(const LAS bf16x8*)(img + IM_BI + o), ki = *(const LAS bf16x8*)(img + IM_KI + o), ai = *(const LAS bf16x8*)(img + IM_AI + o);
        mab = MFMA16(bi, ai, mab); mak = MFMA16(ki, ai, mak);
        if constexpr (WANT_Y) { const bf16x8 ri = *(const LAS bf16x8*)(img + IM_RI + o); mbr = MFMA16(bi, ri, mbr); mkr = MFMA16(ki, ri, mkr); } }
#pragma unroll
    for (int e = 0; e < 4; ++e) { const int s = 4 * q + e; if (!(s < c)) { mab[e] = 0.f; mak[e] = 0.f; } if (!(s <= c)) { mbr[e] = 0.f; mkr[e] = 0.f; } }
    f32x4 mabT = {0.f, 0.f, 0.f, 0.f};
#pragma unroll
    for (int k = 0; k < 2; ++k) { const int o = blk * 2304 + c * 144 + k * 64 + q * 16; mabT = MFMA16(*(const LAS bf16x8*)(img + IM_AI + o), *(const LAS bf16x8*)(img + IM_BI + o), mabT); }
#pragma unroll
    for (int e = 0; e < 4; ++e) if (!(c < 4 * q + e)) mabT[e] = 0.f;
    const f32x4 z4 = {0.f, 0.f, 0.f, 0.f};
#define OPND(x) mk8(cvtpk((x)[0], (x)[1]), cvtpk((x)[2], (x)[3]), 0u, 0u)
    const bf16x8 oM = OPND(mab), oMT = OPND(mabT);
    const f32x4 m2 = MFMA16(oMT, oM, z4), m2T = MFMA16(oM, oMT, z4);
    const bf16x8 oM2 = OPND(m2), oM2T = OPND(m2T);
    const f32x4 m4 = MFMA16(oM2T, oM2, z4), m4T = MFMA16(oM2, oM2T, z4);
    const f32x4 m8T = MFMA16(OPND(m4), OPND(m4T), z4);
    f32x4 nn = m2;
#pragma unroll
    for (int e = 0; e < 4; ++e) nn[e] += (4 * q + e == c) ? 1.0f : 0.0f;
    nn = MFMA16(oMT, OPND(nn), nn);
    nn = MFMA16(OPND(m4T), OPND(nn), nn);
    nn = MFMA16(OPND(m8T), OPND(nn), nn);
#undef OPND
    pkg[0 * 64 + lane] = cvtpk(nn[0], nn[1]); pkg[1 * 64 + lane] = cvtpk(nn[2], nn[3]);
    pkg[2 * 64 + lane] = cvtpk(mak[0], mak[1]); pkg[3 * 64 + lane] = cvtpk(mak[2], mak[3]);
    if constexpr (WANT_Y) { pkg[4 * 64 + lane] = cvtpk(mbr[0], mbr[1]); pkg[5 * 64 + lane] = cvtpk(mbr[2], mbr[3]); pkg[6 * 64 + lane] = cvtpk(mkr[0], mkr[1]); pkg[7 * 64 + lane] = cvtpk(mkr[2], mkr[3]); }
}
template <bool WANT_Y, bool HAS_V>
__device__ __forceinline__ f32x4 block_scan(LAS unsigned char* img, int blk, const LAS unsigned* pkg, f32x4 (&S)[4], int wq, int lane) {
    const int q = lane >> 4, c = lane & 15;
    bf16x8 Sb[2];
#pragma unroll
    for (int k = 0; k < 2; ++k) Sb[k] = mk8(cvtpk(S[2 * k][0], S[2 * k][1]), cvtpk(S[2 * k][2], S[2 * k][3]), cvtpk(S[2 * k + 1][0], S[2 * k + 1][1]), cvtpk(S[2 * k + 1][2], S[2 * k + 1][3]));
    v2u vpk = {0u, 0u};
    if constexpr (HAS_V) vpk = *(const LAS v2u*)(img + IM_VT + blk * 2560 + (c + 16 * wq) * 40 + q * 8);
    const int ao = blk * 2304 + c * 144 + q * 16;
    f32x4 rhs = {0.f, 0.f, 0.f, 0.f};
    rhs = MFMA16(*(const LAS bf16x8*)(img + IM_AI + ao), Sb[0], rhs); rhs = MFMA16(*(const LAS bf16x8*)(img + IM_AI + ao + 64), Sb[1], rhs);
    if constexpr (HAS_V) rhs = MFMA16(mk8(0u, 0u, pkg[2 * 64 + lane], pkg[3 * 64 + lane]), mk8(0u, 0u, vpk.x, vpk.y), rhs);
    f32x4 u = {0.f, 0.f, 0.f, 0.f};
    u = MFMA16(mk8(pkg[0 * 64 + lane], pkg[1 * 64 + lane], 0u, 0u), mk8(cvtpk(rhs[0], rhs[1]), cvtpk(rhs[2], rhs[3]), 0u, 0u), u);
    const bf16x8 UV = mk8(cvtpk(u[0], u[1]), cvtpk(u[2], u[3]), vpk.x, vpk.y);
    f32x4 y = {0.f, 0.f, 0.f, 0.f};
    if constexpr (WANT_Y) { y = MFMA16(*(const LAS bf16x8*)(img + IM_RI + ao), Sb[0], y); y = MFMA16(*(const LAS bf16x8*)(img + IM_RI + ao + 64), Sb[1], y);
        y = MFMA16(mk8(pkg[4 * 64 + lane], pkg[5 * 64 + lane], pkg[6 * 64 + lane], pkg[7 * 64 + lane]), UV, y); }
#pragma unroll
    for (int T = 0; T < 4; ++T) { const bf16x8 bkt = *(const LAS bf16x8*)(img + IM_BKT + blk * 5120 + (16 * T + c) * 80 + q * 16);
        S[T] = MFMA16(bkt, UV, S[T]); const f32x4 g = *(const LAS f32x4*)(img + IM_GAM + blk * 256 + (16 * T + 4 * q) * 4); S[T] = S[T] * g; }
    return y;
}
__device__ __forceinline__ unsigned char* sum_slot(Frame& F, int chain, int sc) { return (unsigned char*)F.out + OUT_SUM + (size_t)(chain * NSC + sc) * SUM_SLOT; }

__device__ __forceinline__ void rwkv_pass1_pair(Frame& F, int li, int pair) {
    const int g = F.wave >> 2, wq = F.wave & 3, u = 2 * pair + g;
    const int chain = u / (NSC - 1), sc = u % (NSC - 1);
    const int dir = chain / 12, b = (chain / 6) & 1, h = chain % 6;
    const bool isctx = sc < 2; const int scl = isctx ? sc : sc - 2;
    LAS unsigned char* img = F.lds + (g ? L_IMG1 : L_IMG0); LAS unsigned* pkg = (LAS unsigned*)(F.lds + L_PKG) + g * 1024;
    LAS float* cst = (LAS float*)(F.lds + L_CST) + g * 768;
    __syncthreads();
    chain_consts_lds(F, cst, li, h, F.tid & 255);
    const int q = F.lane >> 4, c = F.lane & 15;
    f32x4 SB[4], SA[4];
#pragma unroll
    for (int T = 0; T < 4; ++T)
#pragma unroll
        for (int e = 0; e < 4; ++e) { SB[T][e] = 0.0f; SA[T][e] = (16 * T + 4 * q + e == c + 16 * wq) ? 1.0f : 0.0f; }
    PrepRaw R;
    prep_load(F, R, dir, b, h, 8 * wq + (F.lane >> 3), F.lane & 7, isctx, 128 * scl);
#pragma unroll 1
    for (int rd = 0; rd < 4; ++rd) {
        __syncthreads();
        prep_compute(F, R, cst, img, dir, b, h, 8 * wq + (F.lane >> 3), F.lane & 7, isctx, 128 * scl + 32 * rd, nullptr, nullptr, 0);
        __syncthreads();
        if (rd < 3) prep_load(F, R, dir, b, h, 8 * wq + (F.lane >> 3), F.lane & 7, isctx, 128 * scl + 32 * (rd + 1));
        if (wq < 2) block_package<false>(img, wq, pkg + wq * 512, F.lane);
        __syncthreads();
#pragma unroll
        for (int blk = 0; blk < 2; ++blk) { block_scan<false, true>(img, blk, pkg + blk * 512, SB, wq, F.lane); block_scan<false, false>(img, blk, pkg + blk * 512, SA, wq, F.lane); }
    }
    unsigned char* slot = sum_slot(F, chain, sc);
    { f32x4* braw = (f32x4*)slot;
#pragma unroll
      for (int T = 0; T < 4; ++T) braw[(wq * 4 + T) * 64 + F.lane] = SB[T]; }
    { bf16* aim = (bf16*)(slot + 16384); const int kap = wq >> 1, e = (F.lane & 3) + 4 * (wq & 1), qc = c >> 2;
#pragma unroll
      for (int T = 0; T < 4; ++T)
#pragma unroll
          for (int r = 0; r < 4; ++r) { const int lc = (4 * q + r) + 16 * qc; aim[((T * 2 + kap) * 64 + lc) * 8 + e] = (bf16)f2bf(SA[T][r]); } }
}
struct P2Buf { f32x4 Bc[4]; bf16x8 af[4][2]; };
__device__ __forceinline__ void p2_load(Frame& F, P2Buf& X, int chain, int sc, int wq) {
    unsigned char* slot = sum_slot(F, chain, sc); const f32x4* braw = (const f32x4*)slot; const bf16* aim = (const bf16*)(slot + 16384);
#pragma unroll
    for (int T = 0; T < 4; ++T) { X.Bc[T] = braw[(wq * 4 + T) * 64 + F.lane];
#pragma unroll
        for (int k = 0; k < 2; ++k) X.af[T][k] = *(const bf16x8*)(aim + ((T * 2 + k) * 64 + F.lane) * 8); }
}
__device__ __forceinline__ void p2_step(Frame& F, const P2Buf& X, f32x4 (&S)[4], int chain, int sc, int wq) {
    f32x4* braw = (f32x4*)sum_slot(F, chain, sc);
    bf16x8 Sb[2];
#pragma unroll
    for (int k = 0; k < 2; ++k) Sb[k] = mk8(cvtpk(S[2 * k][0], S[2 * k][1]), cvtpk(S[2 * k][2], S[2 * k][3]), cvtpk(S[2 * k + 1][0], S[2 * k + 1][1]), cvtpk(S[2 * k + 1][2], S[2 * k + 1][3]));
#pragma unroll
    for (int T = 0; T < 4; ++T) { braw[(wq * 4 + T) * 64 + F.lane] = S[T]; const f32x4 a = MFMA16(X.af[T][0], Sb[0], X.Bc[T]); S[T] = MFMA16(X.af[T][1], Sb[1], a); }
}
__device__ __forceinline__ void rwkv_pass2_chain(Frame& F, int chain) {
    if (F.wave >= 4) return;
    const int wq = F.wave; constexpr int NS = NSC - 1;
    f32x4 S[4];
#pragma unroll
    for (int T = 0; T < 4; ++T) S[T] = (f32x4){0.f, 0.f, 0.f, 0.f};
    P2Buf X0, X1, X2;
    p2_load(F, X0, chain, 0, wq); p2_load(F, X1, chain, 1, wq); p2_load(F, X2, chain, 2, wq);
#pragma unroll 1
    for (int sc = 0; sc < NS; sc += 3) {
        p2_step(F, X0, S, chain, sc, wq); if (sc + 3 < NS) p2_load(F, X0, chain, sc + 3, wq);
        if (sc + 1 < NS) { p2_step(F, X1, S, chain, sc + 1, wq); if (sc + 4 < NS) p2_load(F, X1, chain, sc + 4, wq); }
        if (sc + 2 < NS) { p2_step(F, X2, S, chain, sc + 2, wq); if (sc + 5 < NS) p2_load(F, X2, chain, sc + 5, wq); }
    }
    { f32x4* braw = (f32x4*)sum_slot(F, chain, NSC - 1);
#pragma unroll
      for (int T = 0; T < 4; ++T) braw[(wq * 4 + T) * 64 + F.lane] = S[T]; }
}
__device__ __forceinline__ void rwkv_pass3_unit(Frame& F, int li, int u) {
    const int pc = u % NSC, bh = u / NSC, b = bh / 6, h = bh % 6;
    const bool isctx = pc < 2; const int pcl = isctx ? pc : pc - 2, nsc = isctx ? 2 : 64;
    const int dir = F.wave >> 2, wq = F.wave & 3, q = F.lane >> 4, c = F.lane & 15;
    const int sc = dir == 0 ? pc : (isctx ? 1 - pcl : 2 + 63 - pcl);
    const int scl = dir == 0 ? pcl : nsc - 1 - pcl;
    const int chain = dir * 12 + b * 6 + h;
    LAS unsigned char* img = F.lds + (dir ? L_IMG1 : L_IMG0); LAS unsigned* pkg = (LAS unsigned*)(F.lds + L_PKG) + dir * 1024;
    LAS float* YL = (LAS float*)(F.lds + L_YL); LAS unsigned char* VB = F.lds + L_VB; LAS float* BON = (LAS float*)(F.lds + L_BON);
    LAS float* cst = (LAS float*)(F.lds + L_CST);
    __syncthreads();
    if (F.tid < 256) chain_consts_lds(F, cst, li, h, F.tid);
    f32x4 S[4];
    { const f32x4* braw = (const f32x4*)sum_slot(F, chain, sc);
#pragma unroll
      for (int T = 0; T < 4; ++T) S[T] = braw[(wq * 4 + T) * 64 + F.lane]; }
    __syncthreads();
    for (int i = F.tid; i < 128 * 68; i += NTHR) YL[i] = 0.f;
    PrepRaw R;
    prep_load(F, R, dir, b, h, 8 * wq + (F.lane >> 3), F.lane & 7, isctx, 128 * scl);
#pragma unroll 1
    for (int rd = 0; rd < 4; ++rd) {
        __syncthreads();
        prep_compute(F, R, cst, img, dir, b, h, 8 * wq + (F.lane >> 3), F.lane & 7, isctx, 128 * scl + 32 * rd, dir == 0 ? VB : (LAS unsigned char*)nullptr, BON, 32 * rd);
        __syncthreads();
        if (rd < 3) prep_load(F, R, dir, b, h, 8 * wq + (F.lane >> 3), F.lane & 7, isctx, 128 * scl + 32 * (rd + 1));
        if (wq < 2) block_package<true>(img, wq, pkg + wq * 512, F.lane);
        __syncthreads();
#pragma unroll
        for (int blk = 0; blk < 2; ++blk) { const f32x4 y = block_scan<true, true>(img, blk, pkg + blk * 512, S, wq, F.lane);
#pragma unroll
            for (int e = 0; e < 4; ++e) { const int t = 32 * rd + 16 * blk + 4 * q + e; const int pl = dir ? 127 - t : t; YL[pl * 68 + c + 16 * wq] += y[e]; } }
    }
    __syncthreads();
    const int wv = F.wave; const int rbase = (isctx ? TL + b * CTX : b * SEQ) + 128 * pcl;
    const bf16* g2t = (const bf16*)(F.ws + WS_G2T) + (size_t)li * 384 * 128;
    f32x4 gate[4];
#pragma unroll
    for (int nt = 0; nt < 4; ++nt) gate[nt] = (f32x4){0.f, 0.f, 0.f, 0.f};
#pragma unroll
    for (int k = 0; k < 4; ++k) { const v4u zg = *(const v4u*)(zrow(F, rbase + 16 * wv + c) + ZG + 32 * k + 8 * q);
#define SG(x) (1.0f / (1.0f + __expf(-(x))))
        const bf16x8 a = mk8(pk2(SG(bflo(zg.x)), SG(bfhi(zg.x))), pk2(SG(bflo(zg.y)), SG(bfhi(zg.y))), pk2(SG(bflo(zg.z)), SG(bfhi(zg.z))), pk2(SG(bflo(zg.w)), SG(bfhi(zg.w))));
#undef SG
#pragma unroll
        for (int nt = 0; nt < 4; ++nt) { const bf16x8 bb = *(const bf16x8*)(g2t + (size_t)(64 * h + 16 * nt + c) * 128 + 32 * k + 8 * q); gate[nt] = MFMA16(a, bb, gate[nt]); } }
    bf16* mix = (bf16*)(F.ws + WS_H);
    float lg[4], lb[4];
#pragma unroll
    for (int nt = 0; nt < 4; ++nt) { lg[nt] = inp(I_LNG)[li * RW + 64 * h + 16 * nt + c]; lb[nt] = inp(I_LNB)[li * RW + 64 * h + 16 * nt + c]; }
#pragma unroll
    for (int e = 0; e < 4; ++e) { const int tl = 16 * wv + 4 * q + e;
        float yv[4], s = 0.f;
#pragma unroll
        for (int nt = 0; nt < 4; ++nt) { yv[nt] = YL[tl * 68 + 16 * nt + c]; s += yv[nt]; }
        s += __shfl_xor(s, 1); s += __shfl_xor(s, 2); s += __shfl_xor(s, 4); s += __shfl_xor(s, 8);
        const float mu = s * (1.0f / 64.0f); float v2 = 0.f;
#pragma unroll
        for (int nt = 0; nt < 4; ++nt) { yv[nt] -= mu; v2 += yv[nt] * yv[nt]; }
        v2 += __shfl_xor(v2, 1); v2 += __shfl_xor(v2, 2); v2 += __shfl_xor(v2, 4); v2 += __shfl_xor(v2, 8);
        const float rs = 1.0f / sqrtf(v2 * (1.0f / 64.0f) + GN_EPS); const float bon = BON[tl];
#pragma unroll
        for (int nt = 0; nt < 4; ++nt) { const float vv = bf2f(((const LAS bf16*)VB)[tl * 64 + 16 * nt + c]);
            const float o = (yv[nt] * rs * lg[nt] + lb[nt] + bon * vv) * gate[nt][e];
            mix[(size_t)(rbase + tl) * DM + 640 + 64 * h + 16 * nt + c] = (bf16)f2bf(o); } }
}

constexpr int AT_KROW = 144;
__device__ __forceinline__ void attn_unit(Frame& F, int li, int u) {
    const bool cq = u >= 256;
    int b, kvh, qb;
    if (!cq) { b = u >> 7; kvh = (u >> 6) & 1; qb = u & 63; } else { const int uu = u - 256; b = uu >> 2; kvh = (uu >> 1) & 1; qb = uu & 1; }
    const int c = F.lane & 15, q = F.lane >> 4, tb = F.wave;
    bf16* mix = (bf16*)(F.ws + WS_H);
    const float* rct = (const float*)(F.ws + WS_ROPE); const float* rst = rct + SEQ * 32;
    const int qrow = (cq ? TL + b * CTX : b * SEQ) + 128 * qb + 16 * tb + c;
    const int qpos = 128 * qb + 16 * tb + c;
    bf16x8 Q[3][2];
    { float cs[8], sn[8];
      if (!cq) { const f32x4 c0 = *(const f32x4*)(rct + qpos * 32 + 8 * q), c1 = *(const f32x4*)(rct + qpos * 32 + 8 * q + 4), s0 = *(const f32x4*)(rst + qpos * 32 + 8 * q), s1 = *(const f32x4*)(rst + qpos * 32 + 8 * q + 4);
#pragma unroll
          for (int e = 0; e < 4; ++e) { cs[e] = c0[e]; cs[e + 4] = c1[e]; sn[e] = s0[e]; sn[e + 4] = s1[e]; } }
      else {
#pragma unroll
          for (int e = 0; e < 8; ++e) { cs[e] = 1.0f; sn[e] = 0.0f; } }
#pragma unroll
      for (int hh = 0; hh < 3; ++hh) { const bf16* zq = zrow(F, qrow) + ZQ + 64 * (3 * kvh + hh) + 8 * q; float x1[8], x2[8]; unpack8(*(const v4u*)zq, x1); unpack8(*(const v4u*)(zq + 32), x2);
          float o1[8], o2[8];
#pragma unroll
          for (int e = 0; e < 8; ++e) { o1[e] = 0.125f * (x1[e] * cs[e] - x2[e] * sn[e]); o2[e] = 0.125f * (x2[e] * cs[e] + x1[e] * sn[e]); }
          Q[hh][0] = mk8(pk2(o1[0], o1[1]), pk2(o1[2], o1[3]), pk2(o1[4], o1[5]), pk2(o1[6], o1[7])); Q[hh][1] = mk8(pk2(o2[0], o2[1]), pk2(o2[2], o2[3]), pk2(o2[4], o2[5]), pk2(o2[6], o2[7])); } }
    float m[3], l[3]; f32x4 O[3][4];
#pragma unroll
    for (int hh = 0; hh < 3; ++hh) { m[hh] = inp(I_SINK)[li * 6 + 3 * kvh + hh]; l[hh] = q == 0 ? 1.0f : 0.0f;
#pragma unroll
        for (int dt = 0; dt < 4; ++dt) O[hh][dt] = (f32x4){0.f, 0.f, 0.f, 0.f}; }
    LAS unsigned char* KI = F.lds;
#pragma unroll 1
    for (int stage = cq ? 1 : 0; stage < 2; ++stage) {
        const int nkeys = stage == 0 ? 384 : 256; const int vstride = (nkeys + 8) * 2;
        LAS unsigned char* VTI = F.lds + 384 * AT_KROW;
        const int kpos0 = 128 * (qb - 1);
        __syncthreads();
        for (int pc = F.tid; pc < nkeys * 4; pc += NTHR) { const int key = pc >> 2, o = pc & 3;
            const bf16* zk; float cs[8], sn[8];
            if (stage == 0) { int kp = kpos0 + key; kp = kp < 0 ? 0 : (kp >= SEQ ? SEQ - 1 : kp); zk = zrow(F, b * SEQ + kp) + 64 * kvh + 8 * o;
                const f32x4 c0 = *(const f32x4*)(rct + kp * 32 + 8 * o), c1 = *(const f32x4*)(rct + kp * 32 + 8 * o + 4), s0 = *(const f32x4*)(rst + kp * 32 + 8 * o), s1 = *(const f32x4*)(rst + kp * 32 + 8 * o + 4);
#pragma unroll
                for (int e = 0; e < 4; ++e) { cs[e] = c0[e]; cs[e + 4] = c1[e]; sn[e] = s0[e]; sn[e + 4] = s1[e]; } }
            else { zk = zrow(F, TL + b * CTX + key) + 64 * kvh + 8 * o;
#pragma unroll
                for (int e = 0; e < 8; ++e) { cs[e] = 1.0f; sn[e] = 0.0f; } }
            const v4u k1 = *(const v4u*)(zk + ZK), k2 = *(const v4u*)(zk + ZK + 32), v1 = *(const v4u*)(zk + ZV), v2 = *(const v4u*)(zk + ZV + 32);
            float x1[8], x2[8]; unpack8(k1, x1); unpack8(k2, x2);
            float o1[8], o2[8];
#pragma unroll
            for (int e = 0; e < 8; ++e) { o1[e] = x1[e] * cs[e] - x2[e] * sn[e]; o2[e] = x2[e] * cs[e] + x1[e] * sn[e]; }
            *(LAS v4u*)(KI + key * AT_KROW + o * 16) = (v4u){pk2(o1[0], o1[1]), pk2(o1[2], o1[3]), pk2(o1[4], o1[5]), pk2(o1[6], o1[7])};
            *(LAS v4u*)(KI + key * AT_KROW + 64 + o * 16) = (v4u){pk2(o2[0], o2[1]), pk2(o2[2], o2[3]), pk2(o2[4], o2[5]), pk2(o2[6], o2[7])};
            const int kl = key & 31; const int col = (key & ~31) | (((kl & 15) >> 2) << 3) | ((kl >> 4) << 2) | (kl & 3);
#pragma unroll
            for (int hv = 0; hv < 2; ++hv) { const v4u vv = hv ? v2 : v1; LAS bf16* vt = (LAS bf16*)(VTI + (8 * (o + 4 * hv)) * vstride) + col;
                vt[0] = (bf16)(vv.x & 0xffff); *(LAS bf16*)((LAS unsigned char*)vt + vstride) = (bf16)(vv.x >> 16);
                *(LAS bf16*)((LAS unsigned char*)vt + 2 * vstride) = (bf16)(vv.y & 0xffff); *(LAS bf16*)((LAS unsigned char*)vt + 3 * vstride) = (bf16)(vv.y >> 16);
                *(LAS bf16*)((LAS unsigned char*)vt + 4 * vstride) = (bf16)(vv.z & 0xffff); *(LAS bf16*)((LAS unsigned char*)vt + 5 * vstride) = (bf16)(vv.z >> 16);
                *(LAS bf16*)((LAS unsigned char*)vt + 6 * vstride) = (bf16)(vv.w & 0xffff); *(LAS bf16*)((LAS unsigned char*)vt + 7 * vstride) = (bf16)(vv.w >> 16); } }
        __syncthreads();
        const int npair = nkeys / 32;
        const int Q0 = 128 * qb + 16 * tb;
#pragma unroll 1
        for (int kp = 0; kp < npair; ++kp) {
            const int kb = kpos0 + 32 * kp;
            if (stage == 0 && (kb + 31 < Q0 - 128 || kb > Q0 + 143 || kb + 31 < 0 || kb >= SEQ)) continue;
            bf16x8 K[2][2], V[4];
#pragma unroll
            for (int t = 0; t < 2; ++t)
#pragma unroll
                for (int k = 0; k < 2; ++k) K[t][k] = *(const LAS bf16x8*)(KI + (32 * kp + 16 * t + c) * AT_KROW + k * 64 + q * 16);
#pragma unroll
            for (int dt = 0; dt < 4; ++dt) V[dt] = *(const LAS bf16x8*)(VTI + (16 * dt + c) * vstride + kp * 64 + q * 16);
            bool ok0[4], ok1[4];
#pragma unroll
            for (int e = 0; e < 4; ++e) { const int k0 = kb + 4 * q + e, k1 = k0 + 16;
                ok0[e] = stage == 1 || (k0 >= 0 && k0 < SEQ && k0 >= qpos - 128 && k0 <= qpos + 128);
                ok1[e] = stage == 1 || (k1 >= 0 && k1 < SEQ && k1 >= qpos - 128 && k1 <= qpos + 128); }
#pragma unroll
            for (int hh = 0; hh < 3; ++hh) {
                f32x4 s0 = {0.f, 0.f, 0.f, 0.f}, s1 = {0.f, 0.f, 0.f, 0.f};
                s0 = MFMA16(K[0][0], Q[hh][0], s0); s0 = MFMA16(K[0][1], Q[hh][1], s0);
                s1 = MFMA16(K[1][0], Q[hh][0], s1); s1 = MFMA16(K[1][1], Q[hh][1], s1);
                float mx = -INFINITY;
#pragma unroll
                for (int e = 0; e < 4; ++e) { s0[e] = ok0[e] ? s0[e] : -INFINITY; s1[e] = ok1[e] ? s1[e] : -INFINITY; mx = fmaxf(mx, fmaxf(s0[e], s1[e])); }
                mx = fmaxf(mx, __shfl_xor(mx, 16)); mx = fmaxf(mx, __shfl_xor(mx, 32));
                const float mn = fmaxf(m[hh], mx); const float alpha = __expf(m[hh] - mn); m[hh] = mn;
                float ps = 0.f;
#pragma unroll
                for (int e = 0; e < 4; ++e) { s0[e] = __expf(s0[e] - mn); s1[e] = __expf(s1[e] - mn); ps += s0[e] + s1[e]; }
                l[hh] = l[hh] * alpha + ps;
                const bf16x8 P = mk8(cvtpk(s0[0], s0[1]), cvtpk(s0[2], s0[3]), cvtpk(s1[0], s1[1]), cvtpk(s1[2], s1[3]));
#pragma unroll
                for (int dt = 0; dt < 4; ++dt) { O[hh][dt] = O[hh][dt] * alpha; O[hh][dt] = MFMA16(V[dt], P, O[hh][dt]); }
            }
        }
    }
#pragma unroll
    for (int hh = 0; hh < 3; ++hh) { float lt = l[hh]; lt += __shfl_xor(lt, 16); lt += __shfl_xor(lt, 32); const float inv = 1.0f / lt;
#pragma unroll
        for (int dt = 0; dt < 4; ++dt) { v2u w; w.x = pk2(O[hh][dt][0] * inv, O[hh][dt][1] * inv); w.y = pk2(O[hh][dt][2] * inv, O[hh][dt][3] * inv);
            *(v2u*)(mix + (size_t)qrow * DM + 256 + 64 * (3 * kvh + hh) + 16 * dt + 4 * q) = w; } }
}

__device__ __forceinline__ void fourier_tables(Frame& F) {
    bf16* t = (bf16*)(F.ws + WS_FT);
    for (int i = F.bid * NTHR + F.tid; i < 64 * 64; i += F.G * NTHR) { const int r = i >> 6, cc = i & 63; const float a = (float)((r * cc) & 63) * (1.0f / 64.0f);
        const float cs = __builtin_amdgcn_cosf(a), sn = __builtin_amdgcn_sinf(a);
        t[FT_W64C / 2 + i] = (bf16)f2bf(cs); t[FT_W64S / 2 + i] = (bf16)f2bf(sn);
        const int pj = (cc & ~31) | (((cc & 15) >> 2) << 3) | (((cc >> 4) & 1) << 2) | (cc & 3);
        t[FT_T64C / 2 + r * 64 + pj] = (bf16)f2bf(cs); t[FT_T64S / 2 + r * 64 + pj] = (bf16)f2bf(sn); }
    for (int i = F.bid * NTHR + F.tid; i < 128 * 128; i += F.G * NTHR) { const int r = i >> 7, cc = i & 127; const float a = (float)((r * cc) & 127) * (1.0f / 128.0f);
        t[FT_W128C / 2 + i] = (bf16)f2bf(__builtin_amdgcn_cosf(a)); t[FT_W128S / 2 + i] = (bf16)f2bf(__builtin_amdgcn_sinf(a)); }
}
__device__ __forceinline__ void fourier_a_fast(Frame& F, int u) {
    const int b = u >> 7, n2 = u & 127, c = F.lane & 15, q = F.lane >> 4;
    LAS unsigned char* IMG = F.lds;
    __syncthreads();
    for (int pc = F.tid; pc < 64 * 32; pc += NTHR) { const int n1 = pc >> 5, c8 = pc & 31;
        const v4u v = *(const v4u*)(zrow(F, b * SEQ + 128 * n1 + n2) + ZF + 8 * c8);
        LAS bf16* d = (LAS bf16*)(IMG + (8 * c8) * 144) + n1;
        d[0] = (bf16)(v.x & 0xffff); d[72] = (bf16)(v.x >> 16); d[144] = (bf16)(v.y & 0xffff); d[216] = (bf16)(v.y >> 16);
        d[288] = (bf16)(v.z & 0xffff); d[360] = (bf16)(v.z >> 16); d[432] = (bf16)(v.w & 0xffff); d[504] = (bf16)(v.w >> 16); }
    __syncthreads();
    const bf16* wc = (const bf16*)(F.ws + WS_FT + FT_W64C); const bf16* wsn = (const bf16*)(F.ws + WS_FT + FT_W64S);
    bf16* far = (bf16*)((unsigned char*)F.out + OUT_FA); bf16* fai = far + (size_t)NB * 64 * 128 * 256;
    bf16x8 Bc[4][2], Bs[4][2];
#pragma unroll
    for (int kt = 0; kt < 4; ++kt)
#pragma unroll
        for (int k = 0; k < 2; ++k) { Bc[kt][k] = *(const bf16x8*)(wc + (16 * kt + c) * 64 + 32 * k + 8 * q); Bs[kt][k] = *(const bf16x8*)(wsn + (16 * kt + c) * 64 + 32 * k + 8 * q); }
#pragma unroll
    for (int ci = 0; ci < 2; ++ci) { const int ct = 2 * F.wave + ci;
        bf16x8 A[2];
#pragma unroll
        for (int k = 0; k < 2; ++k) A[k] = *(const LAS bf16x8*)(IMG + (16 * ct + c) * 144 + k * 64 + q * 16);
#pragma unroll
        for (int kt = 0; kt < 4; ++kt) { f32x4 sr = {0.f, 0.f, 0.f, 0.f}, si = {0.f, 0.f, 0.f, 0.f};
#pragma unroll
            for (int k = 0; k < 2; ++k) { sr = MFMA16(A[k], Bc[kt][k], sr); si = MFMA16(A[k], Bs[kt][k], si); }
            const int k1 = 16 * kt + c; const float tw = (float)(n2 * k1) * (1.0f / 8192.0f); const float tc = __builtin_amdgcn_cosf(tw), ts = __builtin_amdgcn_sinf(tw);
            float xr[4], xi[4];
#pragma unroll
            for (int e = 0; e < 4; ++e) { const float ar = sr[e], ai = -si[e]; xr[e] = ar * tc + ai * ts; xi[e] = ai * tc - ar * ts; }
            const size_t o = (((size_t)b * 64 + k1) * 128 + n2) * 256 + 16 * ct + 4 * q;
            v2u w; w.x = pk2(xr[0], xr[1]); w.y = pk2(xr[2], xr[3]); *(v2u*)(far + o) = w; w.x = pk2(xi[0], xi[1]); w.y = pk2(xi[2], xi[3]); *(v2u*)(fai + o) = w; } }
}
__device__ __forceinline__ void fourier_c_fast(Frame& F, int u) {
    const int g = u & 3, k1 = (u >> 2) & 63, b = u >> 8, c = F.lane & 15, q = F.lane >> 4;
    LAS unsigned char* IR = F.lds; LAS unsigned char* II = F.lds + 64 * 272;
    const bf16* far = (const bf16*)((unsigned char*)F.out + OUT_FA) + (((size_t)b * 64 + k1) * 128) * 256 + 64 * g; const bf16* fai = far + (size_t)NB * 64 * 128 * 256;
    __syncthreads();
    for (int pc = F.tid; pc < 128 * 8; pc += NTHR) { const int n2 = pc >> 3, c8 = pc & 7;
        const v4u vr = *(const v4u*)(far + (size_t)n2 * 256 + 8 * c8), vi = *(const v4u*)(fai + (size_t)n2 * 256 + 8 * c8);
        LAS bf16* dr = (LAS bf16*)(IR + (8 * c8) * 272) + n2; LAS bf16* di = (LAS bf16*)(II + (8 * c8) * 272) + n2;
        dr[0] = (bf16)(vr.x & 0xffff); dr[136] = (bf16)(vr.x >> 16); dr[272] = (bf16)(vr.y & 0xffff); dr[408] = (bf16)(vr.y >> 16);
        dr[544] = (bf16)(vr.z & 0xffff); dr[680] = (bf16)(vr.z >> 16); dr[816] = (bf16)(vr.w & 0xffff); dr[952] = (bf16)(vr.w >> 16);
        di[0] = (bf16)(vi.x & 0xffff); di[136] = (bf16)(vi.x >> 16); di[272] = (bf16)(vi.y & 0xffff); di[408] = (bf16)(vi.y >> 16);
        di[544] = (bf16)(vi.z & 0xffff); di[680] = (bf16)(vi.z >> 16); di[816] = (bf16)(vi.w & 0xffff); di[952] = (bf16)(vi.w >> 16); }
    __syncthreads();
    const bf16* wc = (const bf16*)(F.ws + WS_FT + FT_W128C); const bf16* wsn = (const bf16*)(F.ws + WS_FT + FT_W128S);
    const bf16* tcn = (const bf16*)(F.ws + WS_FT + FT_T64C); const bf16* tsn = (const bf16*)(F.ws + WS_FT + FT_T64S);
    f32x4 Pr[4], Pi[4];
#pragma unroll
    for (int ct = 0; ct < 4; ++ct) { Pr[ct] = (f32x4){0.f, 0.f, 0.f, 0.f}; Pi[ct] = (f32x4){0.f, 0.f, 0.f, 0.f}; }
#pragma unroll
    for (int k = 0; k < 4; ++k) { const bf16x8 bc = *(const bf16x8*)(wc + (16 * F.wave + c) * 128 + 32 * k + 8 * q), bs = *(const bf16x8*)(wsn + (16 * F.wave + c) * 128 + 32 * k + 8 * q);
        const v4u bsu = __builtin_bit_cast(v4u, bs); const bf16x8 bsn = mk8(bsu.x ^ 0x80008000u, bsu.y ^ 0x80008000u, bsu.z ^ 0x80008000u, bsu.w ^ 0x80008000u);
#pragma unroll
        for (int ct = 0; ct < 4; ++ct) { const bf16x8 ar = *(const LAS bf16x8*)(IR + (16 * ct + c) * 272 + k * 64 + q * 16), ai = *(const LAS bf16x8*)(II + (16 * ct + c) * 272 + k * 64 + q * 16);
            Pr[ct] = MFMA16(ar, bc, Pr[ct]); Pr[ct] = MFMA16(ai, bs, Pr[ct]); Pi[ct] = MFMA16(ai, bc, Pi[ct]); Pi[ct] = MFMA16(ar, bsn, Pi[ct]); } }
    bf16x8 Br[2], Bi[2];
#pragma unroll
    for (int k = 0; k < 2; ++k) { Br[k] = mk8(cvtpk(Pr[2 * k][0], Pr[2 * k][1]), cvtpk(Pr[2 * k][2], Pr[2 * k][3]), cvtpk(Pr[2 * k + 1][0], Pr[2 * k + 1][1]), cvtpk(Pr[2 * k + 1][2], Pr[2 * k + 1][3]));
        Bi[k] = mk8(cvtpk(Pi[2 * k][0], Pi[2 * k][1]), cvtpk(Pi[2 * k][2], Pi[2 * k][3]), cvtpk(Pi[2 * k + 1][0], Pi[2 * k + 1][1]), cvtpk(Pi[2 * k + 1][2], Pi[2 * k + 1][3])); }
    bf16* mix = (bf16*)(F.ws + WS_H);
    const float scale = 0.0013810679320049757f;
    const int k2 = 16 * F.wave + c; const size_t row = (size_t)b * SEQ + k1 + 64 * k2;
#pragma unroll
    for (int mt = 0; mt < 4; ++mt) { f32x4 y = {0.f, 0.f, 0.f, 0.f};
#pragma unroll
        for (int k = 0; k < 2; ++k) { const bf16x8 ac = *(const bf16x8*)(tcn + (16 * mt + c) * 64 + 32 * k + 8 * q), as = *(const bf16x8*)(tsn + (16 * mt + c) * 64 + 32 * k + 8 * q);
            y = MFMA16(ac, Br[k], y); y = MFMA16(as, Bi[k], y); }
        v2u w; w.x = pk2(y[0] * scale, y[1] * scale); w.y = pk2(y[2] * scale, y[3] * scale);
        *(v2u*)(mix + row * DM + 64 * g + 16 * mt + 4 * q) = w; }
}

#define XB_TMO      128
#define XB_XCNT(j)  (256  + 64 * (j))
#define XB_XSUB(j)  (1280 + 64 * (j))
#define XB_XGEN(j)  (2304 + 64 * (j))
#define XB_TOP      3328
#define XB_TOPGEN   3392
#define XCD_BAR_WORDS 3456
#define XB_SPIN_CAP (1u << 23)
__device__ __forceinline__ unsigned xb_ld(unsigned* p)              { return __hip_atomic_load(p, __ATOMIC_RELAXED, __HIP_MEMORY_SCOPE_AGENT); }
__device__ __forceinline__ unsigned xb_add(unsigned* p, unsigned v) { return __hip_atomic_fetch_add(p, v, __ATOMIC_RELAXED, __HIP_MEMORY_SCOPE_AGENT); }
__device__ __forceinline__ unsigned xb_xcc_id() { return (unsigned)__builtin_amdgcn_s_getreg((3 << 11) | 20) & 0xFu; }
#define XB_SPIN(cond, bar) do { unsigned _sp = 0; while (cond) { __builtin_amdgcn_s_sleep(1); \
    if ((++_sp & 255u) == 0u) { if (xb_ld(&(bar)[XB_TMO])) break; if (_sp > XB_SPIN_CAP) { atomicAdd(&(bar)[XB_TMO], 1u); break; } } } } while (0)
struct XcdBarrier { unsigned* bar; unsigned x; volatile LAS unsigned* st; };
__device__ __forceinline__ XcdBarrier xcd_barrier_post(unsigned* bar, volatile LAS unsigned* st) {
    XcdBarrier b; b.bar = bar; b.x = xb_xcc_id(); b.st = st;
    if (threadIdx.x == 0) (void)xb_add(&bar[XB_XCNT(b.x)], 1u);
    return b;
}
__device__ __forceinline__ void xcd_barrier_complete(unsigned* bar, unsigned x, unsigned& nloc, unsigned& nx) {
    const unsigned G = gridDim.x * gridDim.y * gridDim.z;
    unsigned sum, cnt, mine, sp = 0u;
    for (;;) {
        sum = 0u; cnt = 0u; mine = 0u;
#pragma unroll
        for (unsigned j = 0; j < 16; ++j) { const unsigned c = xb_ld(&bar[XB_XCNT(j)]); sum += c; cnt += (c > 0u) ? 1u : 0u; mine = (j == x) ? c : mine; }
        if (sum == G) break;
        __builtin_amdgcn_s_sleep(1);
        if ((++sp & 255u) == 0u) { if (xb_ld(&bar[XB_TMO])) break; if (sp > XB_SPIN_CAP) { atomicAdd(&bar[XB_TMO], 1u); break; } }
    }
    nloc = mine > 0u ? mine : 1u; nx = cnt > 0u ? cnt : 1u;
}
__device__ __forceinline__ void xcd_barrier(const XcdBarrier& b0) {
    XcdBarrier b; { unsigned* p = b0.bar; unsigned x = __builtin_amdgcn_readfirstlane(b0.x); unsigned st = (unsigned)(size_t)b0.st; asm volatile("" : "+s"(p), "+s"(x), "+s"(st)); b.bar = p; b.x = x; b.st = (volatile LAS unsigned*)(size_t)st; }
    asm volatile("s_waitcnt vmcnt(0)" ::: "memory");
    __syncthreads();
    if (threadIdx.x == 0) {
        unsigned* bar = b.bar;
        __builtin_amdgcn_s_waitcnt(0);
        unsigned nloc = b.st[0], nx = b.st[1];
        if (nloc == 0u) { xcd_barrier_complete(bar, b.x, nloc, nx); b.st[0] = nloc; b.st[1] = nx; }
        const unsigned old = xb_add(&bar[XB_XSUB(b.x)], 1u);
        const unsigned gen = old / nloc;
        if (old + 1u == (gen + 1u) * nloc) {
            __builtin_amdgcn_fence(__ATOMIC_RELEASE, "agent");
            asm volatile("s_waitcnt vmcnt(0)" ::: "memory");
            const unsigned og = xb_add(&bar[XB_TOP], 1u);
            const unsigned tg = og / nx;
            if (og + 1u == (tg + 1u) * nx) xb_add(&bar[XB_TOPGEN], 1u);
            else XB_SPIN(xb_ld(&bar[XB_TOPGEN]) == tg, bar);
            __builtin_amdgcn_fence(__ATOMIC_ACQUIRE, "agent");
            xb_add(&bar[XB_XGEN(b.x)], 1u);
            asm volatile("s_waitcnt vmcnt(0)" ::: "memory");
        } else {
            XB_SPIN(xb_ld(&bar[XB_XGEN(b.x)]) == gen, bar);
            __builtin_amdgcn_fence(__ATOMIC_ACQUIRE, "agent");
            asm volatile("s_waitcnt vmcnt(0)" ::: "memory");
        }
    }
    __syncthreads();
}

__device__ __forceinline__ int queue_next(Frame& F, unsigned* cnt) {
    volatile LAS int* slot = (volatile LAS int*)(F.lds + MISC_OFF + 64);
    __syncthreads();
    if (F.tid == 0) *slot = (int)__hip_atomic_fetch_add(cnt, 1u, __ATOMIC_RELAXED, __HIP_MEMORY_SCOPE_AGENT);
    __syncthreads();
    return *slot;
}
template <int KIND> __device__ __forceinline__ void run_phase(const Frame& F0, int li, int second) {
    Frame F;
    { int t = threadIdx.x; asm volatile("" : "+v"(t)); F.tid = t; F.lane = t & 63; F.wave = __builtin_amdgcn_readfirstlane(t >> 6);
      int g = F0.G, b = F0.bid; asm volatile("" : "+s"(g), "+s"(b)); F.G = g; F.bid = b;
      unsigned char* w = F0.ws; float* o = F0.out; asm volatile("" : "+s"(w), "+s"(o)); F.ws = w; F.out = o;
      unsigned l = (unsigned)(size_t)F0.lds; asm volatile("" : "+s"(l)); F.lds = (LAS unsigned char*)(size_t)l;
      asm volatile("" : "+s"(li), "+s"(second)); }
    float* modv = (float*)(F.ws + WS_MOD);
    bf16* XB = (bf16*)(F.ws + WS_XB);
    bf16* H = (bf16*)(F.ws + WS_H); bf16* ACT = (bf16*)(F.ws + WS_ACT); bf16* O = (bf16*)(F.ws + WS_O);
    const float* ng = inp(I_NORMG) + (size_t)li * 6 * DM; const float* mv = modv + (size_t)li * 3 * 9216;
    const bool last = li == 1;
    if constexpr (KIND == 100) { convert_weights(F, 0); mod_gemv(F); rope_tables(F); lora_transposes(F); fourier_tables(F); }
    if constexpr (KIND == 101) { EArgs A{}; A.xl_src = inp(I_X); A.xc_src = inp(I_CTX); A.o = nullptr; A.hdst = H; A.modv_h = modv; A.shidx = 0; A.scidx = 1; A.gpre = inp(I_NORMG); A.nrows = TT; e_phase(F, A); }
    if constexpr (KIND == 0) {
        const bf16* wi = (const bf16*)(F.ws + (second ? WS_WI2 : WS_WI1)); const bool withctx = !(last && second);
        if (!withctx || F.G != 256) { pg8::Gemm g{H, wi, withctx ? TT : TL, NWI, DM}; pg8::StaticOrder S; S.init(g.M, g.N, F.G, F.bid);
            pg8::EpiSwiglu E{ACT, FFNP}; pg8::gemm_phase<pg8::EpiSwiglu, pg8::StaticOrder, true, true>(F.lds, g, S, E, F.tid); }
        else { unsigned* cnt = (unsigned*)(F.ws + WS_CTL) + 8192 + 64 * (li * 2 + second);
            pg8::Gemm g{H, wi, TT, NWI, DM}; pg8::UpOrder S; S.init(NWI, F.G, F.bid, cnt);
            pg8::EpiSwiglu E{ACT, FFNP}; pg8::gemm_phase<pg8::EpiSwiglu, pg8::UpOrder, true, true>(F.lds, g, S, E, F.tid);
            if (F.bid >= 248) {
                if (F.tid == 0) { unsigned sp = 0; while (__hip_atomic_load(cnt, __ATOMIC_RELAXED, __HIP_MEMORY_SCOPE_AGENT) < 352u && ++sp < (1u << 24)) __builtin_amdgcn_s_sleep(8);
                    __builtin_amdgcn_fence(__ATOMIC_ACQUIRE, "agent"); asm volatile("s_waitcnt vmcnt(0)" ::: "memory"); }
                __syncthreads();
                const int k = F.bid - 248; pg8::Gemm g2{ACT, (const bf16*)(F.ws + (second ? WS_WO2 : WS_WO1)), TT, DM, FFNP}; pg8::OneUnit S2{64 + (k >> 2), k & 3};
                pg8::EpiBf16 E2{O, DM}; pg8::gemm_phase<pg8::EpiBf16, pg8::OneUnit, false, true>(F.lds, g2, S2, E2, F.tid); } } }
    if constexpr (KIND == 1) {
        const bool ctxhere = F.G != 256 && !(last && second);
        pg8::Gemm g{ACT, (const bf16*)(F.ws + (second ? WS_WO2 : WS_WO1)), ctxhere ? TT : TL, DM, FFNP}; pg8::StaticOrder S; S.init(g.M, g.N, F.G, F.bid);
        pg8::EpiBf16 E{O, DM}; pg8::gemm_phase<pg8::EpiBf16, pg8::StaticOrder, true, true>(F.lds, g, S, E, F.tid); }
    if constexpr (KIND == 2) {
        EArgs A{}; A.xl_src = inp(I_X); A.xc_src = inp(I_CTX); A.xb_src = li == 0 ? (const bf16*)nullptr : XB; A.xb_dst = XB; A.o = O; A.modv_g = mv; A.gidx = 2; A.gmul = 0.5f; A.gpost = ng + 1 * DM;
        A.hdst = H; A.modv_h = mv; A.shidx = 3; A.scidx = 4; A.gpre = ng + 2 * DM; A.nrows = TT; e_phase(F, A); }
    if constexpr (KIND == 3) {
        pg8::Gemm g{H, (const bf16*)(F.ws + WS_WIN), TT, INWP, DM}; pg8::StaticOrder S; S.init(g.M, g.N, F.G, F.bid);
        pg8::EpiBf16 E{ACT, INWP}; pg8::gemm_phase<pg8::EpiBf16, pg8::StaticOrder, true, true>(F.lds, g, S, E, F.tid); }
    if constexpr (KIND == 4) {
        lora_pass(F, li);
        for (int u = F.bid; u < 256; u += F.G) fourier_a_fast(F, u);
        if (li == 0) fourier_ctx1_all(F); }
    if constexpr (KIND == 5) {
        unsigned* cnt = (unsigned*)(F.ws + WS_CTL) + 8192 + 64 * (4 + 2 * li);
        const int na = li == 0 ? 264 : 256;
        for (int it = queue_next(F, cnt); it < na; it = queue_next(F, cnt)) attn_unit(F, li, it);
        for (int it = queue_next(F, cnt + 16); it < 12 * (NSC - 1); it = queue_next(F, cnt + 16)) rwkv_pass1_pair(F, li, it); }
    if constexpr (KIND == 11) {
        if (F.bid < 24) rwkv_pass2_chain(F, F.bid);
        else convert_weights(F, 1, li == 0 ? 1 : 2, 24, F.G - 24);
        if (li == 0) fourier_ctx2_all(F); }
    if constexpr (KIND == 12) {
        unsigned* cnt = (unsigned*)(F.ws + WS_CTL) + 8192 + 64 * (5 + 2 * li);
        const int np3 = li == 0 ? 12 * NSC : 12 * 64;
        for (int it = queue_next(F, cnt); it < np3; it = queue_next(F, cnt)) rwkv_pass3_unit(F, li, li == 0 ? it : (it / 64) * NSC + 2 + it % 64);
        for (int it = queue_next(F, cnt + 16); it < 512; it = queue_next(F, cnt + 16)) fourier_c_fast(F, it); }
    if constexpr (KIND == 6) {
        pg8::Gemm g{H, (const bf16*)(F.ws + WS_WOUT), last ? TL : TT, DM, DM}; pg8::StaticOrder S; S.init(g.M, g.N, F.G, F.bid);
        pg8::EpiBf16 E{O, DM}; pg8::gemm_phase<pg8::EpiBf16, pg8::StaticOrder, true, true>(F.lds, g, S, E, F.tid); }
    if constexpr (KIND == 7) {
        EArgs A{}; A.xb_src = XB; A.xb_dst = XB; A.o = O; A.modv_g = mv; A.gidx = 5; A.gmul = 1.0f; A.gpost = ng + 3 * DM;
        A.hdst = H; A.modv_h = mv; A.shidx = 6; A.scidx = 7; A.gpre = ng + 4 * DM; A.nrows = last ? TL : TT; e_phase(F, A); }
    if constexpr (KIND == 10) {
        EArgs A{}; A.xb_src = XB; A.xb_dst = XB; A.out32 = last ? F.out : (float*)nullptr; A.o = O; A.modv_g = mv; A.gidx = 8; A.gmul = 0.5f; A.gpost = ng + 5 * DM;
        if (!last) { A.hdst = H; A.modv_h = mv + 3 * 9216; A.shidx = 0; A.scidx = 1; A.gpre = ng + 6 * DM; }
        A.nrows = last ? TL : TT; e_phase(F, A);
        }
}
__global__ void __launch_bounds__(NTHR, 2) mega_one(Args args) {
    extern __shared__ __attribute__((aligned(16))) unsigned char lds[];
    Frame F; F.lds = (LAS unsigned char*)lds; F.tid = threadIdx.x; F.lane = F.tid & 63; F.wave = __builtin_amdgcn_readfirstlane(F.tid >> 6); F.G = gridDim.x; F.bid = blockIdx.x;
    F.out = args.out; F.ws = args.ws;
    volatile LAS unsigned* MISC = (volatile LAS unsigned*)(F.lds + MISC_OFF);
    if (F.tid < 32) MISC[F.tid] = 0u;
    __syncthreads();
    XcdBarrier bar = xcd_barrier_post((unsigned*)(F.ws + WS_CTL) + 4096, MISC + 8);
#define GRID_BAR() xcd_barrier(bar)
    run_phase<100>(F, 0, 0); GRID_BAR();
    run_phase<101>(F, 0, 0); GRID_BAR();
#pragma unroll 1
    for (int li = 0; li < 2; ++li) {
        run_phase<0>(F, li, 0); GRID_BAR();
        run_phase<1>(F, li, 0); GRID_BAR();
        run_phase<2>(F, li, 0); GRID_BAR();
        run_phase<3>(F, li, 0); GRID_BAR();
        run_phase<4>(F, li, 0); GRID_BAR();
        run_phase<5>(F, li, 0); GRID_BAR();
        run_phase<11>(F, li, 0); GRID_BAR();
        run_phase<12>(F, li, 0); GRID_BAR();
        run_phase<6>(F, li, 0); GRID_BAR();
        run_phase<7>(F, li, 0); GRID_BAR();
        run_phase<0>(F, li, 1); GRID_BAR();
        run_phase<1>(F, li, 1); GRID_BAR();
        run_phase<10>(F, li, 0); GRID_BAR();
    }
}

extern "C" void kernel_launch(void* const* d_in, const int* in_sizes, int n_in, void* d_out, int out_size, void* d_ws, size_t ws_size, hipStream_t stream) {
    static int ready = 0;
    if (!ready) {
        if (n_in != 25 || out_size != TL * DM || ws_size < WS_END) { fprintf(stderr, "kernel_launch: unexpected shapes (n_in %d out %d ws %zu)\n", n_in, out_size, ws_size); ready = -1; return; }
        if (hipFuncSetAttribute((const void*)mega_one, hipFuncAttributeMaxDynamicSharedMemorySize, LDS_BYTES) != hipSuccess) { fprintf(stderr, "kernel_launch: hipFuncSetAttribute failed\n"); ready = -1; return; }
        int dev = 0, cus = 0; if (hipGetDevice(&dev) != hipSuccess || hipDeviceGetAttribute(&cus, hipDeviceAttributeMultiprocessorCount, dev) != hipSuccess || cus < 32) cus = 256;
        ready = cus < 256 ? cus : 256;
    }
    if (ready < 0) return;
    if (hipMemsetAsync((char*)d_ws + WS_CTL, 0, 65536, stream) != hipSuccess) { fprintf(stderr, "kernel_launch: memset failed\n"); return; }
    Args a{};
    for (int i = 0; i < 25; ++i) a.in[i] = (const float*)d_in[i];
    a.out = (float*)d_out; a.ws = (unsigned char*)d_ws;
    hipLaunchKernelGGL(mega_one, dim3(ready), dim3(NTHR), LDS_BYTES, stream, a);
}
```

```cpp
#include <hip/hip_runtime.h>
#include <cstdio>
#include <cstdint>

namespace pg8 {
#define PG8_LAS __attribute__((address_space(3)))
typedef unsigned short bf16_t;
typedef short bf16x8 __attribute__((ext_vector_type(8)));
typedef float f32x4 __attribute__((ext_vector_type(4)));
typedef unsigned u32x4 __attribute__((ext_vector_type(4)));
constexpr int BM = 256, BK = 64, HALF = 128, HTB = HALF * BK * 2, STAGE_BYTES = 8 * HTB, NXCD = 8, WGM = 8;

__host__ __device__ __forceinline__ int lds_byte(int r, int c) { const int st = (r >> 4) * 2 + (c >> 5), rr = r & 15, cc = c & 31, ob = rr * 64 + cc * 2; return st * 1024 + (ob ^ (((ob >> 9) & 1) << 5)); }
__host__ __device__ __forceinline__ void stage_rc(int b, int& R, int& C) { const int st = b / 1024, sb = b % 1024, swz = sb ^ (((sb >> 9) & 1) << 5); R = (st >> 1) * 16 + swz / 64; C = (st & 1) * 32 + (swz % 64) / 2; }
__host__ __device__ __forceinline__ int perm32(int rho) { const int n = rho >> 4, i = rho & 15; return 8 * (i >> 2) + 4 * n + (i & 3); }

struct Unit { int pm, pn; };
struct Gemm { const bf16_t* A; const bf16_t* Bt; int M, N, K; };

struct StaticOrder {
    int nM, nN, nwg, G, c;
    __host__ __device__ void init(int M, int N, int G_, int c_) { nM = M / BM; nN = N / BM; nwg = nM * nN; G = G_; c = c_; }
    __host__ __device__ bool next(int i, Unit& u) const {
        const long L = (long)i * G + c; if (L >= nwg) return false;
        int wgid = (int)L; { const int q = nwg / NXCD, r = nwg % NXCD, xcd = wgid % NXCD, off = wgid / NXCD; wgid = (xcd < r ? xcd * (q + 1) : r * (q + 1) + (xcd - r) * q) + off; }
        const int nig = WGM * nN, gid = wgid / nig, fm = gid * WGM, gsz = (nM - fm) < WGM ? (nM - fm) : WGM;
        u.pm = fm + ((wgid % nig) % gsz); u.pn = (wgid % nig) / gsz; return true;
    }
    __device__ __forceinline__ void a_ready(const Unit&) const {}
    __device__ __forceinline__ void done(const Unit&) const {}
};

struct UpOrder {
    StaticOrder lat; int G, c, nN; unsigned* cnt;
    __device__ void init(int N, int G_, int c_, unsigned* cnt_) { lat.init(16384, N, G_, c_); G = G_; c = c_; nN = N / BM; cnt = cnt_; }
    __device__ bool next(int i, Unit& u) const {
        const int nctx = 2 * nN, total = nctx + lat.nwg;
        long L;
        if (G != 256) L = (long)i * G + c;
        else if (c >= 248) { if (i >= 3) return false; L = (long)i * G + c; }
        else if (c >= 172 && c < 188 && i == 5) L = (long)(3 + (c - 172) / 8) * G + 248 + (c - 172) % 8;
        else L = (long)i * G + c;
        if (L >= total) return false;
        if (L < nctx) { u.pm = 64 + (int)L / nN; u.pn = (int)L % nN; return true; }
        int wgid = (int)L - nctx; { const int nwg = lat.nwg, q = nwg / NXCD, r = nwg % NXCD, xcd = wgid % NXCD, off = wgid / NXCD; wgid = (xcd < r ? xcd * (q + 1) : r * (q + 1) + (xcd - r) * q) + off; }
        const int nig = WGM * nN, gid = wgid / nig, fm = gid * WGM, gsz = (lat.nM - fm) < WGM ? (lat.nM - fm) : WGM;
        u.pm = fm + ((wgid % nig) % gsz); u.pn = (wgid % nig) / gsz; return true;
    }
    __device__ __forceinline__ void a_ready(const Unit&) const {}
    __device__ __forceinline__ void done(const Unit& u) const {
        if (u.pm >= 64) { asm volatile("s_waitcnt vmcnt(0)" ::: "memory"); __builtin_amdgcn_fence(__ATOMIC_RELEASE, "agent"); asm volatile("s_waitcnt vmcnt(0)" ::: "memory");
            if ((threadIdx.x & 63) == 0) __hip_atomic_fetch_add(cnt, 1u, __ATOMIC_RELAXED, __HIP_MEMORY_SCOPE_AGENT); }
    }
};
struct OneUnit {
    int pm, pn;
    __device__ bool next(int i, Unit& u) const { if (i != 0) return false; u.pm = pm; u.pn = pn; return true; }
    __device__ __forceinline__ void a_ready(const Unit&) const {}
    __device__ __forceinline__ void done(const Unit&) const {}
};

__device__ __forceinline__ unsigned cvt_pk_bf16(float lo, float hi) { unsigned r; asm volatile("v_cvt_pk_bf16_f32 %0, %1, %2" : "=v"(r) : "v"(lo), "v"(hi)); return r; }

struct EpiBf16 {
    static constexpr bool PERM = true, AFTER_DRAIN = false;
    bf16_t* O; int ldc;
    __device__ __forceinline__ void operator()(const f32x4 (&acc)[2][2][4][2], const Unit& u, int wr, int wc, int fr, int fq) const {
        const int row0 = u.pm * BM + wr * 64 + fr; const int col0 = u.pn * BM + wc * 32 + 8 * fq;
#pragma unroll
        for (int ai = 0; ai < 2; ++ai)
#pragma unroll
            for (int m = 0; m < 4; ++m) { bf16_t* rowp = O + (size_t)(row0 + ai * HALF + m * 16) * ldc + col0;
#pragma unroll
                for (int bj = 0; bj < 2; ++bj) { const f32x4 v0 = acc[ai][bj][m][0], v1 = acc[ai][bj][m][1];
                    u32x4 w; w.x = cvt_pk_bf16(v0[0], v0[1]); w.y = cvt_pk_bf16(v0[2], v0[3]); w.z = cvt_pk_bf16(v1[0], v1[1]); w.w = cvt_pk_bf16(v1[2], v1[3]);
                    *(u32x4*)(rowp + bj * HALF) = w; } }
    }
};
struct EpiF32 {
    static constexpr bool PERM = true, AFTER_DRAIN = false;
    float* O; int ldc;
    __device__ __forceinline__ void operator()(const f32x4 (&acc)[2][2][4][2], const Unit& u, int wr, int wc, int fr, int fq) const {
        const int row0 = u.pm * BM + wr * 64 + fr; const int col0 = u.pn * BM + wc * 32 + 8 * fq;
#pragma unroll
        for (int ai = 0; ai < 2; ++ai)
#pragma unroll
            for (int m = 0; m < 4; ++m) { float* rowp = O + (size_t)(row0 + ai * HALF + m * 16) * ldc + col0;
#pragma unroll
                for (int bj = 0; bj < 2; ++bj) { *(f32x4*)(rowp + bj * HALF) = acc[ai][bj][m][0]; *(f32x4*)(rowp + bj * HALF + 4) = acc[ai][bj][m][1]; } }
    }
};
__device__ __forceinline__ float silu_f(float x) { return x * __builtin_amdgcn_rcpf(1.0f + __expf(-x)); }
struct EpiSwiglu {
    static constexpr bool PERM = true, AFTER_DRAIN = false;
    bf16_t* O; int ldc;
    __device__ __forceinline__ void operator()(const f32x4 (&acc)[2][2][4][2], const Unit& u, int wr, int wc, int fr, int fq) const {
        const int row0 = u.pm * BM + wr * 64 + fr; const int col0 = u.pn * HALF + wc * 32 + 8 * fq;
#pragma unroll
        for (int ai = 0; ai < 2; ++ai)
#pragma unroll
            for (int m = 0; m < 4; ++m) { bf16_t* rowp = O + (size_t)(row0 + ai * HALF + m * 16) * ldc + col0;
                const f32x4 g0 = acc[ai][0][m][0], g1 = acc[ai][0][m][1], u0 = acc[ai][1][m][0], u1 = acc[ai][1][m][1];
                u32x4 w; w.x = cvt_pk_bf16(silu_f(g0[0]) * u0[0], silu_f(g0[1]) * u0[1]); w.y = cvt_pk_bf16(silu_f(g0[2]) * u0[2], silu_f(g0[3]) * u0[3]);
                w.z = cvt_pk_bf16(silu_f(g1[0]) * u1[0], silu_f(g1[1]) * u1[1]); w.w = cvt_pk_bf16(silu_f(g1[2]) * u1[2], silu_f(g1[3]) * u1[3]);
                *(u32x4*)rowp = w; }
    }
};

template <class Epi, class Sched, bool ALIGN_EPI = false, bool SP2 = false>
__device__ __forceinline__ void gemm_phase(PG8_LAS unsigned char* lds, const Gemm g, const Sched& S, const Epi& E, const int tid) {
    const int wid = __builtin_amdgcn_readfirstlane(tid >> 6), lane = tid & 63, wr = wid >> 2, wc = wid & 3, fr = lane & 15, fq = lane >> 4;
    const int K = g.K, nt = K / BK;
    unsigned voffA[2], voffB[2];
#pragma unroll
    for (int i = 0; i < 2; ++i) { int R, C; stage_rc(tid * 16 + i * 8192, R, C); const int Rb = Epi::PERM ? ((R & ~31) + perm32(R & 31)) : R;
        voffA[i] = (unsigned)(R * K + C) * 2u; voffB[i] = (unsigned)(Rb * K + C) * 2u; }
    const size_t kstep = (size_t)(BK * 2);
    const size_t hstep = (size_t)HALF * K * 2;
    const size_t tstep = 2 * hstep;
    const unsigned ldsw = (unsigned)wid * 1024u;
    const int aoff = lds_byte(wr * 64 + fr, fq * 8), boff = lds_byte(wc * 32 + fr, fq * 8);
#define PG8_SA(b, h) (((b) * 2 + (h)) * HTB)
#define PG8_SB(b, h) ((4 + (b) * 2 + (h)) * HTB)
#define PG8_STAGE(bufoff, gbase, voff) do { _Pragma("unroll") for (int _i = 0; _i < 2; ++_i) \
        __builtin_amdgcn_global_load_lds((const unsigned*)((const char*)(gbase) + (voff)[_i]), (PG8_LAS unsigned*)(lds + (bufoff) + ldsw + _i * 8192), 16, 0, 0); } while (0)
#define PG8_LDA(dst, b, h) do { _Pragma("unroll") for (int m = 0; m < 4; ++m) _Pragma("unroll") for (int k = 0; k < 2; ++k) dst[m][k] = *(const PG8_LAS bf16x8*)(lds + PG8_SA(b, h) + aoff + m * 2048 + k * 1024); } while (0)
#define PG8_LDB(dst, b, h) do { _Pragma("unroll") for (int n = 0; n < 2; ++n) _Pragma("unroll") for (int k = 0; k < 2; ++k) dst[n][k] = *(const PG8_LAS bf16x8*)(lds + PG8_SB(b, h) + boff + n * 2048 + k * 1024); } while (0)
#define PG8_MMA(ai, bj, At, Bt) do { __builtin_amdgcn_s_setprio(1); _Pragma("unroll") for (int m = 0; m < 4; ++m) _Pragma("unroll") for (int n = 0; n < 2; ++n) _Pragma("unroll") for (int k = 0; k < 2; ++k) \
        acc[ai][bj][m][n] = __builtin_amdgcn_mfma_f32_16x16x32_bf16(Bt[n][k], At[m][k], acc[ai][bj][m][n], 0, 0, 0); __builtin_amdgcn_s_setprio(0); } while (0)
#define PG8_WAIT_V(n) asm volatile("s_waitcnt vmcnt(" #n ")" ::: "memory")
#define PG8_WAIT_L(n) asm volatile("s_waitcnt lgkmcnt(" #n ")" ::: "memory")
#define PG8_BAR __builtin_amdgcn_s_barrier()
#define PG8_SCHED __builtin_amdgcn_sched_barrier(0)
    Unit cur, nxt; int ui = 0;
    if (!S.next(0, cur)) return;
    f32x4 acc[2][2][4][2];
#pragma unroll
    for (int a = 0; a < 2; ++a)
#pragma unroll
        for (int b = 0; b < 2; ++b)
#pragma unroll
            for (int m = 0; m < 4; ++m)
#pragma unroll
                for (int n = 0; n < 2; ++n) acc[a][b][m][n] = (f32x4){0.f, 0.f, 0.f, 0.f};
    bf16x8 At[4][2], B0[2][2], B1[2][2];
    const char* cA = (const char*)g.A + (size_t)cur.pm * tstep; const char* cB = (const char*)g.Bt + (size_t)cur.pn * tstep;
    S.a_ready(cur);
    if constexpr (SP2) {
        PG8_STAGE(PG8_SB(0, 0), cB, voffB); PG8_STAGE(PG8_SB(0, 1), cB + hstep, voffB); PG8_STAGE(PG8_SA(0, 0), cA, voffA); PG8_STAGE(PG8_SA(0, 1), cA + hstep, voffA);
        if (wr == 1) PG8_BAR;
        PG8_WAIT_V(2); PG8_BAR;
        PG8_STAGE(PG8_SB(1, 0), cB + kstep, voffB); PG8_STAGE(PG8_SA(1, 0), cA + kstep, voffA); PG8_STAGE(PG8_SB(1, 1), cB + hstep + kstep, voffB);
        PG8_WAIT_V(6); PG8_BAR;
    } else {
        PG8_STAGE(PG8_SB(0, 0), cB, voffB); PG8_STAGE(PG8_SA(0, 0), cA, voffA); PG8_STAGE(PG8_SB(0, 1), cB + hstep, voffB); PG8_STAGE(PG8_SA(0, 1), cA + hstep, voffA);
        if (wr == 1) PG8_BAR;
        PG8_WAIT_V(4); PG8_BAR;
        PG8_STAGE(PG8_SB(1, 0), cB + kstep, voffB); PG8_STAGE(PG8_SA(1, 0), cA + kstep, voffA); PG8_STAGE(PG8_SB(1, 1), cB + hstep + kstep, voffB);
        PG8_WAIT_V(6); PG8_BAR;
    }
    for (;;) {
        const bool has_next = S.next(ui + 1, nxt);
        const char* nA = has_next ? (const char*)g.A + (size_t)nxt.pm * tstep : cA; const char* nB = has_next ? (const char*)g.Bt + (size_t)nxt.pn * tstep : cB;
        for (int t = 0; t < nt; t += 2) {
            const bool last = (t == nt - 2);
            const char* a1 = cA + (size_t)(t + 1) * kstep;
            const char* a2 = last ? nA : cA + (size_t)(t + 2) * kstep; const char* b2 = last ? nB : cB + (size_t)(t + 2) * kstep;
            const char* a3 = a2 + kstep; const char* b3 = b2 + kstep;
            if (last && has_next) S.a_ready(nxt);
            if constexpr (SP2) {
            PG8_LDB(B0, 0, 0); PG8_LDB(B1, 0, 1); PG8_SCHED; PG8_LDA(At, 0, 0); PG8_STAGE(PG8_SA(1, 1), a1 + hstep, voffA);
            PG8_WAIT_V(8); PG8_WAIT_L(0); PG8_BAR; PG8_MMA(0, 0, At, B0); PG8_MMA(0, 1, At, B1); PG8_BAR; PG8_SCHED;
            PG8_LDA(At, 0, 1); PG8_STAGE(PG8_SB(0, 0), b2, voffB); PG8_STAGE(PG8_SB(0, 1), b2 + hstep, voffB); PG8_STAGE(PG8_SA(0, 0), a2, voffA);
            PG8_WAIT_V(8); PG8_WAIT_L(0); PG8_BAR; PG8_MMA(1, 0, At, B0); PG8_MMA(1, 1, At, B1); PG8_BAR; PG8_SCHED;
            PG8_LDB(B0, 1, 0); PG8_LDB(B1, 1, 1); PG8_SCHED; PG8_LDA(At, 1, 0); PG8_STAGE(PG8_SA(0, 1), a2 + hstep, voffA);
            PG8_WAIT_V(8); PG8_WAIT_L(0); PG8_BAR; PG8_MMA(0, 0, At, B0); PG8_MMA(0, 1, At, B1); PG8_BAR; PG8_SCHED;
            PG8_LDA(At, 1, 1); PG8_STAGE(PG8_SB(1, 0), b3, voffB); PG8_STAGE(PG8_SB(1, 1), b3 + hstep, voffB); PG8_STAGE(PG8_SA(1, 0), a3, voffA);
            PG8_WAIT_V(8); PG8_WAIT_L(0); PG8_BAR; PG8_MMA(1, 0, At, B0); PG8_MMA(1, 1, At, B1); PG8_BAR; PG8_SCHED;
            } else {
            PG8_LDB(B0, 0, 0); PG8_SCHED; PG8_LDA(At, 0, 0); PG8_STAGE(PG8_SA(1, 1), a1 + hstep, voffA);
            PG8_WAIT_L(8); PG8_BAR; PG8_WAIT_L(0); PG8_MMA(0, 0, At, B0); PG8_BAR; PG8_SCHED;
            PG8_LDB(B1, 0, 1); PG8_STAGE(PG8_SB(0, 0), b2, voffB);
            PG8_BAR; PG8_WAIT_L(0); PG8_MMA(0, 1, At, B1); PG8_BAR;
            PG8_LDA(At, 0, 1); PG8_STAGE(PG8_SA(0, 0), a2, voffA);
            PG8_BAR; PG8_WAIT_L(0); PG8_MMA(1, 0, At, B0); PG8_BAR; PG8_SCHED;
            PG8_STAGE(PG8_SB(0, 1), b2 + hstep, voffB);
            PG8_WAIT_V(6); PG8_BAR; PG8_MMA(1, 1, At, B1); PG8_BAR;
            PG8_LDB(B0, 1, 0); PG8_SCHED; PG8_LDA(At, 1, 0); PG8_STAGE(PG8_SA(0, 1), a2 + hstep, voffA);
            PG8_WAIT_L(8); PG8_BAR; PG8_WAIT_L(0); PG8_MMA(0, 0, At, B0); PG8_BAR; PG8_SCHED;
            PG8_LDB(B1, 1, 1); PG8_STAGE(PG8_SB(1, 0), b3, voffB);
            PG8_BAR; PG8_WAIT_L(0); PG8_MMA(0, 1, At, B1); PG8_BAR;
            PG8_LDA(At, 1, 1); PG8_STAGE(PG8_SA(1, 0), a3, voffA);
            PG8_BAR; PG8_WAIT_L(0); PG8_MMA(1, 0, At, B0); PG8_BAR; PG8_SCHED;
            PG8_STAGE(PG8_SB(1, 1), b3 + hstep, voffB);
            PG8_WAIT_V(6); PG8_BAR; PG8_MMA(1, 1, At, B1); PG8_BAR;
            }
        }
        if constexpr (ALIGN_EPI) { if (wr == 0) PG8_BAR; }
        if constexpr (!Epi::AFTER_DRAIN) { E(acc, cur, wr, wc, fr, fq); S.done(cur); }
        if (!has_next) break;
#pragma unroll
        for (int a = 0; a < 2; ++a)
#pragma unroll
            for (int b = 0; b < 2; ++b)
#pragma unroll
                for (int m = 0; m < 4; ++m)
#pragma unroll
                    for (int n = 0; n < 2; ++n) acc[a][b][m][n] = (f32x4){0.f, 0.f, 0.f, 0.f};
        cur = nxt; cA = nA; cB = nB; ++ui;
        if constexpr (ALIGN_EPI) { if (wr == 1) PG8_BAR; }
    }
    PG8_WAIT_V(0);
    if constexpr (!ALIGN_EPI) { if (wr == 0) PG8_BAR; }
    PG8_BAR;
#undef PG8_SA
#undef PG8_SB
#undef PG8_STAGE
#undef PG8_LDA
#undef PG8_LDB
#undef PG8_MMA
#undef PG8_WAIT_V
#undef PG8_WAIT_L
#undef PG8_BAR
#undef PG8_SCHED
}
}

constexpr int NWAVES = 8, NTHR = 512;
constexpr int DM = 1024, SEQ = 8192, NB = 2, CTX = 256, TL = NB * SEQ, TC = NB * CTX, TT = TL + TC;
constexpr int FFN = 2752, FFNP = 2816, NWI = 5632, INW = 2432, INWP = 2560, NMOD = 9;
constexpr int ZF = 0, ZQ = 256, ZK = 640, ZV = 768, ZRR = 896, ZRK = 1280, ZRV = 1664, ZW = 2048, ZA = 2176, ZG = 2304;
constexpr int RW = 384;
constexpr float NORM_EPS = 1e-6f, GN_EPS = 64e-5f;

constexpr size_t MiB = 1u << 20;
constexpr size_t WS_CTL = 0, WS_MOD = 1 * MiB, WS_ROPE = 2 * MiB, WS_XC = 4 * MiB, WS_GC = 6 * MiB;
constexpr size_t WS_WI1 = 8 * MiB, WS_WO1 = 19 * MiB, WS_WIN = 25 * MiB, WS_WOUT = 30 * MiB, WS_WI2 = 32 * MiB, WS_WO2 = 43 * MiB;
constexpr size_t WS_H = 49 * MiB;
constexpr size_t WS_ACT = 82 * MiB;
constexpr size_t WS_O = 173 * MiB;
constexpr size_t WS_W2T = WS_MOD + 256 * 1024, WS_A2T = WS_MOD + 512 * 1024, WS_G2T = WS_MOD + 768 * 1024;
constexpr size_t WS_LW = WS_O, WS_IC = WS_O + 25 * MiB;
constexpr size_t WS_GAM32 = 165 * MiB;
constexpr size_t WS_XB = 239 * MiB;
constexpr size_t OUT_FA = 0;
constexpr size_t OUT_SUM = 16 * MiB;
constexpr size_t WS_END = 272 * MiB;

constexpr size_t WS_FT = 7 * MiB;
constexpr size_t FT_W64C = 0, FT_W64S = 8192, FT_W128C = 16384, FT_W128S = 49152, FT_T64C = 81920, FT_T64S = 90112;
constexpr int LDS_BYTES = 147456;
constexpr int MISC_OFF = 146432;

typedef unsigned short bf16;
typedef float f32x4 __attribute__((ext_vector_type(4)));
typedef unsigned v4u __attribute__((ext_vector_type(4)));
typedef unsigned v2u __attribute__((ext_vector_type(2)));
#define LAS __attribute__((address_space(3)))
#define LDS_WAIT() asm volatile("s_waitcnt lgkmcnt(0)" ::: "memory")

__device__ __forceinline__ unsigned f2bf(float f) { unsigned u = __builtin_bit_cast(unsigned, f); return (u + 0x7fffu + ((u >> 16) & 1u)) >> 16; }
__device__ __forceinline__ unsigned pk2(float lo, float hi) { return f2bf(lo) | (f2bf(hi) << 16); }
__device__ __forceinline__ float bf2f(unsigned short u) { return __builtin_bit_cast(float, (unsigned)u << 16); }
__device__ __forceinline__ float bflo(unsigned u) { return __builtin_bit_cast(float, u << 16); }
__device__ __forceinline__ float bfhi(unsigned u) { return __builtin_bit_cast(float, u & 0xffff0000u); }
__device__ __forceinline__ void unpack8(const v4u w, float (&f)[8]) { f[0] = bflo(w.x); f[1] = bfhi(w.x); f[2] = bflo(w.y); f[3] = bfhi(w.y); f[4] = bflo(w.z); f[5] = bfhi(w.z); f[6] = bflo(w.w); f[7] = bfhi(w.w); }
template <int CTRL> __device__ __forceinline__ float dppx(float v) { return __builtin_bit_cast(float, __builtin_amdgcn_update_dpp(0, __builtin_bit_cast(int, v), CTRL, 0xf, 0xf, true)); }
__device__ __forceinline__ float sum8(float v) { v += dppx<0xB1>(v); v += dppx<0x4E>(v); v += dppx<0x141>(v); return v; }
__device__ __forceinline__ float sum16(float v) { v = sum8(v); v += dppx<0x140>(v); return v; }
__device__ __forceinline__ float xrow_sum(float v) {
    float a = v, b2 = v; asm volatile("s_nop 1\n\tv_permlane16_swap_b32 %0, %1" : "+v"(a), "+v"(b2)); v = a + b2;
    a = v; b2 = v; asm volatile("s_nop 1\n\tv_permlane32_swap_b32 %0, %1" : "+v"(a), "+v"(b2)); return a + b2; }
__device__ __forceinline__ float xrow_max(float v) {
    float a = v, b2 = v; asm volatile("s_nop 1\n\tv_permlane16_swap_b32 %0, %1" : "+v"(a), "+v"(b2)); v = fmaxf(a, b2);
    a = v; b2 = v; asm volatile("s_nop 1\n\tv_permlane32_swap_b32 %0, %1" : "+v"(a), "+v"(b2)); return fmaxf(a, b2); }
__device__ __forceinline__ float wave_sum(float v) { return xrow_sum(sum16(v)); }
__device__ __forceinline__ float wave_max(float v) {
#pragma unroll
    for (int o = 1; o < 64; o <<= 1) v = fmaxf(v, __shfl_xor(v, o));
    return v;
}

struct Args { const float* in[25]; float* out; unsigned char* ws; int ph_lo, ph_hi; };

struct Frame {
    LAS unsigned char* lds;
    int tid, lane, wave, G, bid;
    float* out; unsigned char* ws;
};
enum { I_X = 0, I_C, I_CTX, I_CCTX, I_MODW, I_MODB, I_NORMG, I_F1WI, I_F1WO, I_WIN, I_WOUT, I_SINK, I_CONV, I_W0, I_W2, I_A0, I_A2, I_G2, I_KK, I_KA, I_RK, I_LNG, I_LNB, I_F2WI, I_F2WO };

__device__ __forceinline__ const float* inp(int i) {
    const __attribute__((address_space(4))) char* p = (const __attribute__((address_space(4))) char*)__builtin_amdgcn_kernarg_segment_ptr();
    asm volatile("" : "+s"(p));
    return *(const float* const __attribute__((address_space(4)))*)(p + 8 * i);
}
struct CvtDesc { const float* W; bf16* WT; int ldw, k0, sc, Kd, n0d; bool valid, live; };
__device__ __forceinline__ void cvt_load(const CvtDesc& d, f32x4 (&v)[8], int lane) {
    const int c4 = lane & 7, r8 = lane >> 3;
#pragma unroll
    for (int i = 0; i < 8; ++i) v[i] = (d.live && d.valid) ? *(const f32x4*)(d.W + (size_t)(d.k0 + 8 * i + r8) * d.ldw + d.sc + 4 * c4) : (f32x4){0.f, 0.f, 0.f, 0.f};
}
__device__ __forceinline__ void cvt_finish(const CvtDesc& d, const f32x4 (&v)[8], LAS float* scr, int lane) {
    if (!d.live) return;
    const int c4 = lane & 7, r8 = lane >> 3;
#pragma unroll
    for (int i = 0; i < 8; ++i) *(LAS f32x4*)(scr + (8 * i + r8) * 36 + 4 * c4) = v[i];
    LDS_WAIT(); asm volatile("" ::: "memory");
    const int c = lane & 7;
#pragma unroll
    for (int j = 0; j < 4; ++j) { const int n = (lane >> 3) + 8 * j; const LAS float* s = scr + (8 * c) * 36 + n;
        v4u o; o.x = pk2(s[0 * 36], s[1 * 36]); o.y = pk2(s[2 * 36], s[3 * 36]); o.z = pk2(s[4 * 36], s[5 * 36]); o.w = pk2(s[6 * 36], s[7 * 36]);
        *(v4u*)(d.WT + (size_t)(d.n0d + n) * d.Kd + d.k0 + 8 * c) = o; }
    LDS_WAIT(); asm volatile("" ::: "memory");
}
__device__ __forceinline__ CvtDesc cvt_decode(Frame& F, int li, int set, int it) {
    constexpr int I_WI = 16 * (NWI / 32), I_WO = (FFNP / 64) * 32, I_IN = 16 * (INWP / 32), I_OUT = 16 * 32;
    constexpr int NITEMS = 2 * I_WI + 2 * I_WO + I_IN + I_OUT;
    CvtDesc d{}; d.live = it < NITEMS; if (!d.live) return d;
    int r = it;
    if (set) { const bool inA = r < I_WI || (r >= 2 * I_WI && r < 2 * I_WI + I_WO) || (r >= 2 * I_WI + 2 * I_WO && r < 2 * I_WI + 2 * I_WO + I_IN); if (inA != (set == 1)) { d.live = false; return d; } }
    if (r < 2 * I_WI) { const int f = r / I_WI; r -= f * I_WI; const int nblk = NWI / 32, kb = r / nblk, nb = r % nblk;
        const int n0 = 32 * nb, pn = n0 >> 8, i = n0 & 255; const int j = 128 * pn + (i & 127);
        d.W = (f ? inp(I_F2WI) : inp(I_F1WI)) + (size_t)li * DM * 2 * FFN; d.ldw = 2 * FFN; d.k0 = 64 * kb; d.sc = (i < 128) ? j : FFN + j; d.valid = j < FFN; d.WT = (bf16*)(F.ws + (f ? WS_WI2 : WS_WI1)); d.Kd = DM; d.n0d = n0; return d; }
    r -= 2 * I_WI;
    if (r < 2 * I_WO) { const int f = r / I_WO; r -= f * I_WO; const int kb = r / 32, nb = r % 32;
        d.W = (f ? inp(I_F2WO) : inp(I_F1WO)) + (size_t)li * FFN * DM; d.ldw = DM; d.k0 = 64 * kb; d.sc = 32 * nb; d.valid = 64 * kb < FFN; d.WT = (bf16*)(F.ws + (f ? WS_WO2 : WS_WO1)); d.Kd = FFNP; d.n0d = 32 * nb; return d; }
    r -= 2 * I_WO;
    if (r < I_IN) { const int nblk = INWP / 32, kb = r / nblk, nb = r % nblk;
        d.W = inp(I_WIN) + (size_t)li * DM * INW; d.ldw = INW; d.k0 = 64 * kb; d.sc = 32 * nb; d.valid = 32 * nb < INW; d.WT = (bf16*)(F.ws + WS_WIN); d.Kd = DM; d.n0d = 32 * nb; return d; }
    r -= I_IN;
    { const int kb = r / 32, nb = r % 32;
        d.W = inp(I_WOUT) + (size_t)li * DM * DM; d.ldw = DM; d.k0 = 64 * kb; d.sc = 32 * nb; d.valid = true; d.WT = (bf16*)(F.ws + WS_WOUT); d.Kd = DM; d.n0d = 32 * nb; return d; }
}
__device__ __forceinline__ void convert_weights(Frame& F, int li, int set = 0, int bid0 = 0, int nblk = 0) {
    if (nblk == 0) nblk = F.G;
    if (F.bid < bid0 || F.bid >= bid0 + nblk) return;
    LAS float* scr = (LAS float*)(F.lds + F.wave * 16384);
    const int gw = (F.bid - bid0) * NWAVES + F.wave, NGW = nblk * NWAVES;
    constexpr int NITEMS = 2 * 16 * (NWI / 32) + 2 * (FFNP / 64) * 32 + 16 * (INWP / 32) + 16 * 32;
    for (int it = gw; it < NITEMS; it += 2 * NGW) {
        const CvtDesc d0 = cvt_decode(F, li, set, it), d1 = cvt_decode(F, li, set, it + NGW);
        f32x4 v0[8], v1[8];
        cvt_load(d0, v0, F.lane); cvt_load(d1, v1, F.lane);
        cvt_finish(d0, v0, scr, F.lane); cvt_finish(d1, v1, scr, F.lane);
    }
}
__device__ __forceinline__ void mod_gemv(Frame& F) {
    LAS float* sc = (LAS float*)F.lds;
    LAS float* red = sc + 3 * 1024;
    __syncthreads();
    for (int i = F.tid; i < 3 * 1024; i += NTHR) { const int v = i >> 10, k = i & 1023; const float x = v < 2 ? inp(I_C)[v * 1024 + k] : inp(I_CCTX)[k]; sc[i] = x / (1.0f + __expf(-x)); }
    __syncthreads();
    float* modv = (float*)(F.ws + WS_MOD);
    for (int u = F.bid; u < 2 * 72; u += F.G) {
        const int l = u / 72, n0 = (u % 72) * 128;
        const float* w = inp(I_MODW) + (size_t)l * DM * 9216 + n0 + 2 * F.lane;
        float a0 = 0.f, a1 = 0.f, b0 = 0.f, b1 = 0.f, c0 = 0.f, c1 = 0.f;
        const int k0 = F.wave * 128;
#pragma unroll 8
        for (int k = 0; k < 128; ++k) { const float2 wv = *(const float2*)(w + (size_t)(k0 + k) * 9216); const float s0 = sc[k0 + k], s1 = sc[1024 + k0 + k], s2 = sc[2048 + k0 + k];
            a0 += s0 * wv.x; a1 += s0 * wv.y; b0 += s1 * wv.x; b1 += s1 * wv.y; c0 += s2 * wv.x; c1 += s2 * wv.y; }
        LAS float* rw = red + F.wave * 384 + 2 * F.lane;
        rw[0] = a0; rw[1] = a1; rw[128] = b0; rw[129] = b1; rw[256] = c0; rw[257] = c1;
        __syncthreads();
        if (F.tid < 384) { float s = 0.f;
#pragma unroll
            for (int w8 = 0; w8 < 8; ++w8) s += red[w8 * 384 + F.tid];
            const int v = F.tid >> 7, n = n0 + (F.tid & 127);
            modv[(size_t)(l * 3 + v) * 9216 + n] = s + inp(I_MODB)[l * 9216 + n]; }
        __syncthreads();
    }
}
__device__ __forceinline__ void rope_tables(Frame& F) {
    float* ct = (float*)(F.ws + WS_ROPE); float* st = ct + SEQ * 32;
    for (int i = F.bid * NTHR + F.tid; i < SEQ * 32; i += F.G * NTHR) {
        const int t = i >> 5, j = i & 31; const int f = j & 15;
        const float inv = exp2f(-(float)f * (13.287712379549449f / 16.0f));
        const float pos = (float)(j < 16 ? (t >> 6) : (t & 63));
        const float ang = pos * inv;
        const double a = (double)ang; const double k = __builtin_rint(a * 0.15915494309189535); const float r = (float)(a - k * 6.283185307179586);
        ct[i] = __cosf(r); st[i] = __sinf(r);
    }
}

struct EArgs { const float* xl_src; const float* xc_src; const bf16* xb_src; bf16* xb_dst; float* out32; const bf16* o; const float* modv_g; int gidx; float gmul; const float* gpost;
               bf16* hdst; const float* modv_h; int shidx, scidx; const float* gpre; int nrows; };
template <int R>
__device__ __forceinline__ void e_rows(Frame& F, const EArgs& A, int v, int r0) {
    f32x4 cg[4], ch[4], cs[4];
#pragma unroll
    for (int j = 0; j < 4; ++j) { const int c = F.lane + 64 * j;
        if (A.o) cg[j] = ((const f32x4*)(A.modv_g + (size_t)v * 9216 + A.gidx * DM))[c] * ((const f32x4*)A.gpost)[c] * A.gmul;
        if (A.hdst) { ch[j] = ((const f32x4*)A.gpre)[c] * (1.0f + ((const f32x4*)(A.modv_h + (size_t)v * 9216 + A.scidx * DM))[c]); cs[j] = ((const f32x4*)(A.modv_h + (size_t)v * 9216 + A.shidx * DM))[c]; } }
    f32x4 x[R][4]; v2u ow[R][4];
#pragma unroll
    for (int i = 0; i < R; ++i) { const int r = r0 + i;
        if (A.xb_src) { const v2u* xs = (const v2u*)(A.xb_src + (size_t)r * DM);
#pragma unroll
            for (int j = 0; j < 4; ++j) { const v2u w = xs[F.lane + 64 * j]; x[i][j] = (f32x4){bflo(w.x), bfhi(w.x), bflo(w.y), bfhi(w.y)}; } }
        else { const float* xs = r < TL ? A.xl_src + (size_t)r * DM : A.xc_src + (size_t)(r - TL) * DM;
#pragma unroll
            for (int j = 0; j < 4; ++j) x[i][j] = ((const f32x4*)xs)[F.lane + 64 * j]; }
        if (A.o) { const v2u* orow = (const v2u*)(A.o + (size_t)r * DM);
#pragma unroll
            for (int j = 0; j < 4; ++j) ow[i][j] = orow[F.lane + 64 * j]; } }
#pragma unroll
    for (int i = 0; i < R; ++i) { const int r = r0 + i;
        if (A.o) { f32x4 ov[4]; float ss = 0.f;
#pragma unroll
            for (int j = 0; j < 4; ++j) { const v2u w = ow[i][j]; ov[j] = (f32x4){bflo(w.x), bfhi(w.x), bflo(w.y), bfhi(w.y)}; ss += (ov[j].x * ov[j].x + ov[j].y * ov[j].y) + (ov[j].z * ov[j].z + ov[j].w * ov[j].w); }
            const float rstd = 1.0f / sqrtf(wave_sum(ss) * (1.0f / DM) + NORM_EPS);
#pragma unroll
            for (int j = 0; j < 4; ++j) x[i][j] = x[i][j] + cg[j] * (ov[j] * rstd);
            if (A.out32) {
#pragma unroll
                for (int j = 0; j < 4; ++j) ((f32x4*)(A.out32 + (size_t)r * DM))[F.lane + 64 * j] = x[i][j]; }
            else { v2u* xd = (v2u*)(A.xb_dst + (size_t)r * DM);
#pragma unroll
                for (int j = 0; j < 4; ++j) { v2u w; w.x = pk2(x[i][j].x, x[i][j].y); w.y = pk2(x[i][j].z, x[i][j].w); xd[F.lane + 64 * j] = w; } } }
        if (A.hdst) { float ss = 0.f;
#pragma unroll
            for (int j = 0; j < 4; ++j) ss += (x[i][j].x * x[i][j].x + x[i][j].y * x[i][j].y) + (x[i][j].z * x[i][j].z + x[i][j].w * x[i][j].w);
            const float rstd = 1.0f / sqrtf(wave_sum(ss) * (1.0f / DM) + NORM_EPS);
            v2u* hd = (v2u*)(A.hdst + (size_t)r * DM);
#pragma unroll
            for (int j = 0; j < 4; ++j) { const f32x4 hv = (x[i][j] * rstd) * ch[j] + cs[j]; v2u w; w.x = pk2(hv.x, hv.y); w.y = pk2(hv.z, hv.w); hd[F.lane + 64 * j] = w; } } }
}
__device__ __forceinline__ void e_phase(Frame& F, const EArgs& A) {
    const int gw = F.bid * NWAVES + F.wave, NGW = F.G * NWAVES;
    if (NGW == 2048) {
        const int b = gw >> 10, r0 = b * SEQ + (gw & 1023) * 8;
        e_rows<4>(F, A, b, r0); e_rows<4>(F, A, b, r0 + 4);
        if (A.nrows > TL && (gw & 3) == 0) e_rows<1>(F, A, 2, TL + (gw >> 2));
    } else { for (int r = gw; r < A.nrows; r += NGW) e_rows<1>(F, A, r < TL ? (r >> 13) : 2, r); }
}

__device__ __forceinline__ const bf16* zrow(const Frame& F, int row) { return (const bf16*)(F.ws + WS_ACT) + (size_t)row * INWP; }

__device__ __forceinline__ void fourier_ctx1_all(Frame& F) {
    float* gr = (float*)(F.ws + WS_GC); float* gi = gr + TC * 256;
    const bf16* wc = (const bf16*)(F.ws + WS_FT + FT_W64C); const bf16* wsn = (const bf16*)(F.ws + WS_FT + FT_W64S);
    for (int i = F.bid * NTHR + F.tid; i < TC * 256; i += F.G * NTHR) { const int tok = i >> 8, gm = i & 255, g = gm >> 6, m = gm & 63;
        const bf16* z = zrow(F, TL + tok) + ZF + 64 * g; float sr = 0.f, si = 0.f;
#pragma unroll
        for (int c8 = 0; c8 < 8; ++c8) { float x[8], cs[8], sn[8]; unpack8(*(const v4u*)(z + 8 * c8), x); unpack8(*(const v4u*)(wc + m * 64 + 8 * c8), cs); unpack8(*(const v4u*)(wsn + m * 64 + 8 * c8), sn);
#pragma unroll
            for (int e = 0; e < 8; ++e) { sr += x[e] * cs[e]; si -= x[e] * sn[e]; } }
        gr[i] = sr; gi[i] = si; }
}
__device__ __forceinline__ void fourier_ctx2_all(Frame& F) {
    const float* gr = (const float*)(F.ws + WS_GC); const float* gi = gr + TC * 256; bf16* mix = (bf16*)(F.ws + WS_H);
    for (int i = F.bid * NTHR + F.tid; i < TC * 256; i += F.G * NTHR) { const int row = i >> 8, gm = i & 255, b = row >> 8, k = row & 255; float y = 0.f;
#pragma unroll 8
        for (int n = 0; n < 256; ++n) { const float a = (float)((k * n) & 255) * (1.0f / 256.0f); y += gr[(b * 256 + n) * 256 + gm] * __builtin_amdgcn_cosf(a) + gi[(b * 256 + n) * 256 + gm] * __builtin_amdgcn_sinf(a); }
        mix[(size_t)(TL + row) * DM + gm] = (bf16)f2bf(y * 0.0078125f); }
}
typedef short bf16x8 __attribute__((ext_vector_type(8)));
#define MFMA16(a, b, c) __builtin_amdgcn_mfma_f32_16x16x32_bf16(a, b, c, 0, 0, 0)
__device__ __forceinline__ bf16x8 mk8(unsigned a, unsigned b, unsigned c, unsigned d) { const v4u v = {a, b, c, d}; return __builtin_bit_cast(bf16x8, v); }
typedef __bf16 bf16x2_t __attribute__((ext_vector_type(2)));
typedef float f32x2_t __attribute__((ext_vector_type(2)));
__device__ __forceinline__ unsigned cvtpk(float lo, float hi) { const f32x2_t f = {lo, hi}; return __builtin_bit_cast(unsigned, __builtin_convertvector(f, bf16x2_t)); }
constexpr int NSC = 66;
constexpr int IM_AI = 0, IM_RI = 4608, IM_BI = 9216, IM_KI = 13824, IM_BKT = 18432, IM_VT = 28928, IM_GAM = 34176, IMG_BYTES = 34816;
constexpr int L_IMG0 = 0, L_IMG1 = IMG_BYTES, L_PKG = 2 * IMG_BYTES, L_YL = L_PKG + 8192, L_VB = L_YL + 128 * 68 * 4, L_BON = L_VB + 128 * 64 * 2, L_CST = L_BON + 512, L_RW_END = L_CST + 2 * 3072;
static_assert(L_RW_END <= 146432, "rwkv LDS map");
constexpr size_t SUM_SLOT = 24576;

__device__ __forceinline__ void lora_transposes(Frame& F) {
    bf16* w2t = (bf16*)(F.ws + WS_W2T); bf16* a2t = (bf16*)(F.ws + WS_A2T); bf16* g2t = (bf16*)(F.ws + WS_G2T);
    const float* w2 = inp(I_W2); const float* a2 = inp(I_A2); const float* g2 = inp(I_G2);
    for (int i = F.bid * NTHR + F.tid; i < 4 * 384 * 64; i += F.G * NTHR) { const int r = i & 63, col = (i >> 6) % 384, ld = i / (384 * 64);
        w2t[i] = (bf16)f2bf(w2[((size_t)ld * 64 + r) * RW + col]); a2t[i] = (bf16)f2bf(a2[((size_t)ld * 64 + r) * RW + col]); }
    for (int i = F.bid * NTHR + F.tid; i < 2 * 384 * 128; i += F.G * NTHR) { const int r = i & 127, col = (i >> 7) % 384, l = i / (384 * 128);
        g2t[i] = (bf16)f2bf(g2[((size_t)l * 128 + r) * RW + col]); }
}

__device__ __forceinline__ float softplus_fast(float x) { return fmaxf(x, 0.f) + __logf(1.0f + __expf(-fabsf(x))); }
__device__ __forceinline__ float tanh_fast(float x) { return 1.0f - 2.0f * __builtin_amdgcn_rcpf(1.0f + __expf(2.0f * x)); }
template <int CTRL> __device__ __forceinline__ float dpp_f(float v) { return __builtin_bit_cast(float, __builtin_amdgcn_update_dpp(0, __builtin_bit_cast(int, v), CTRL, 0xf, 0xf, true)); }
__device__ __forceinline__ void lora_pass(Frame& F, int li) {
    const int q = F.lane >> 4, c16 = F.lane & 15;
#pragma unroll 1
    for (int dir = 0; dir < 2; ++dir) {
        bf16* LW = (bf16*)(F.ws + WS_LW) + (size_t)dir * TT * RW; bf16* IC = (bf16*)(F.ws + WS_IC) + (size_t)dir * TT * RW;
        const bf16* w2t = (const bf16*)(F.ws + WS_W2T) + (size_t)(li * 2 + dir) * 384 * 64; const bf16* a2t = (const bf16*)(F.ws + WS_A2T) + (size_t)(li * 2 + dir) * 384 * 64;
        bf16x8 aw[3][2], aa[3][2]; f32x4 w0v[3], a0v[3];
#pragma unroll
        for (int cti = 0; cti < 3; ++cti) { const int ct = 3 * F.wave + cti, col = 16 * ct + c16;
#pragma unroll
            for (int k = 0; k < 2; ++k) { aw[cti][k] = *(const bf16x8*)(w2t + (size_t)col * 64 + 32 * k + 8 * q); aa[cti][k] = *(const bf16x8*)(a2t + (size_t)col * 64 + 32 * k + 8 * q); }
            w0v[cti] = *(const f32x4*)(inp(I_W0) + (li * 2 + dir) * RW + 16 * ct + 4 * q); a0v[cti] = *(const f32x4*)(inp(I_A0) + (li * 2 + dir) * RW + 16 * ct + 4 * q); }
#pragma unroll 1
        for (int rt = F.bid; rt < TT / 16; rt += F.G) {
            const bf16* z = zrow(F, 16 * rt + c16);
            bf16x8 bw[2], ba[2];
#pragma unroll
            for (int k = 0; k < 2; ++k) { const v4u zw = *(const v4u*)(z + ZW + 64 * dir + 32 * k + 8 * q); ba[k] = *(const bf16x8*)(z + ZA + 64 * dir + 32 * k + 8 * q);
                bw[k] = mk8(cvtpk(tanh_fast(bflo(zw.x)), tanh_fast(bfhi(zw.x))), cvtpk(tanh_fast(bflo(zw.y)), tanh_fast(bfhi(zw.y))), cvtpk(tanh_fast(bflo(zw.z)), tanh_fast(bfhi(zw.z))), cvtpk(tanh_fast(bflo(zw.w)), tanh_fast(bfhi(zw.w)))); }
#pragma unroll
            for (int cti = 0; cti < 3; ++cti) { const int ct = 3 * F.wave + cti;
                f32x4 dw = {0.f, 0.f, 0.f, 0.f}, da = {0.f, 0.f, 0.f, 0.f};
#pragma unroll
                for (int k = 0; k < 2; ++k) { dw = MFMA16(aw[cti][k], bw[k], dw); da = MFMA16(aa[cti][k], ba[k], da); }
                float lw[4], ic[4];
#pragma unroll
                for (int e = 0; e < 4; ++e) { const float x = w0v[cti][e] + dw[e]; const float wl = -softplus_fast(-x) - 0.5f; lw[e] = -__expf(wl); ic[e] = __builtin_amdgcn_rcpf(1.0f + __expf(-(a0v[cti][e] + da[e]))); }
                if (dir == 0) {
#pragma unroll
                    for (int e = 0; e < 4; ++e) { lw[e] += dpp_f<0x111>(lw[e]); lw[e] += dpp_f<0x112>(lw[e]); lw[e] += dpp_f<0x114>(lw[e]); lw[e] += dpp_f<0x118>(lw[e]); } }
                else {
#pragma unroll
                    for (int e = 0; e < 4; ++e) { lw[e] += dpp_f<0x101>(lw[e]); lw[e] += dpp_f<0x102>(lw[e]); lw[e] += dpp_f<0x104>(lw[e]); lw[e] += dpp_f<0x108>(lw[e]); } }
#pragma unroll
                for (int e = 0; e < 4; ++e) lw[e] = __expf(lw[e]);
                if (c16 == (dir == 0 ? 15 : 0)) *(f32x4*)((float*)(F.ws + WS_GAM32) + ((size_t)dir * (TT / 16) + rt) * RW + 16 * ct + 4 * q) = (f32x4){lw[0], lw[1], lw[2], lw[3]};
                const size_t o = (size_t)(16 * rt + c16) * RW + 16 * ct + 4 * q;
                v2u w; w.x = cvtpk(lw[0], lw[1]); w.y = cvtpk(lw[2], lw[3]); *(v2u*)(LW + o) = w; w.x = cvtpk(ic[0], ic[1]); w.y = cvtpk(ic[2], ic[3]); *(v2u*)(IC + o) = w; }
        }
    }
}
__device__ __forceinline__ void chain_consts_lds(Frame& F, LAS float* cst, int li, int h, int t256) {
    for (int i = t256; i < 12 * 64; i += 256) { const int k = i >> 6, j = i & 63, ch = 64 * h + j; float v;
        if (k == 0) v = inp(I_KK)[li * RW + ch]; else if (k == 1) v = inp(I_KA)[li * RW + ch]; else if (k == 2) v = inp(I_RK)[li * RW + ch];
        else { const int tt = (k - 3) / 3, w = (k - 3) % 3; v = inp(I_CONV)[(size_t)(li * 3 + tt) * (3 * RW) + w * RW + ch]; }
        cst[i] = v; }
}
struct PrepRaw { v4u ecw, icv, epw, zr[3], zk[3], zv[3]; };
__device__ __forceinline__ void prep_load(Frame& F, PrepRaw& R, int dir, int b, int h, int tl, int o, bool isctx, int step0) {
    const int L = isctx ? CTX : SEQ, rbase = isctx ? TL + b * CTX : b * SEQ, ch0 = 64 * h + 8 * o;
    const int s = step0 + tl; const int p = dir ? L - 1 - s : s; const int row = rbase + p, tb = tl & 15;
    { const bf16* LW = (const bf16*)(F.ws + WS_LW) + (size_t)dir * TT * RW + ch0; const bf16* IC = (const bf16*)(F.ws + WS_IC) + (size_t)dir * TT * RW + ch0;
      R.ecw = *(const v4u*)(LW + (size_t)row * RW); R.icv = *(const v4u*)(IC + (size_t)row * RW); R.epw = *(const v4u*)(LW + (size_t)(tb == 0 ? row : (dir ? row + 1 : row - 1)) * RW); }
#pragma unroll
    for (int tt = 0; tt < 3; ++tt) { const int pp = p + tt - 1; const bool ok = pp >= 0 && pp < L; const bf16* z = zrow(F, rbase + (ok ? pp : p)) + ch0;
        const v4u z0 = {0u, 0u, 0u, 0u};
        R.zr[tt] = ok ? *(const v4u*)(z + ZRR) : z0; R.zk[tt] = ok ? *(const v4u*)(z + ZRK) : z0; R.zv[tt] = ok ? *(const v4u*)(z + ZRV) : z0; }
}
__device__ __forceinline__ void prep_compute(Frame& F, const PrepRaw& R, const LAS float* cst, LAS unsigned char* img, int dir, int b, int h, int tl, int o, bool isctx, int step0, LAS unsigned char* lds_vb, LAS float* lds_bon, int pos0_local) {
    const bool BONUS = lds_vb != nullptr;
    const int L = isctx ? CTX : SEQ, rbase = isctx ? TL + b * CTX : b * SEQ, ch0 = 64 * h + 8 * o;
    const int blk = tl >> 4, tb = tl & 15;
    const int s = step0 + tl; const int p = dir ? L - 1 - s : s; const int row = rbase + p;
    const v4u ecw = R.ecw, icv = R.icv, epw = R.epw;
    v4u zr[3], zk[3], zv[3];
#pragma unroll
    for (int tt = 0; tt < 3; ++tt) { zr[tt] = R.zr[tt]; zk[tt] = R.zk[tt]; zv[tt] = R.zv[tt]; }
    float ecf[8], epf[8], ai[8], rv[8], kv[8], vv[8];
    unpack8(ecw, ecf); unpack8(epw, epf); unpack8(icv, ai);
#pragma unroll
    for (int e = 0; e < 8; ++e) { rv[e] = 0.f; kv[e] = 0.f; vv[e] = 0.f; }
#pragma unroll
    for (int tt = 0; tt < 3; ++tt) { float a[8], bq[8], cq[8]; unpack8(zr[tt], a); unpack8(zk[tt], bq); unpack8(zv[tt], cq);
        const LAS f32x4* w0 = (const LAS f32x4*)(cst + (3 + tt * 3 + 0) * 64 + 8 * o); const LAS f32x4* w1 = (const LAS f32x4*)(cst + (3 + tt * 3 + 1) * 64 + 8 * o); const LAS f32x4* w2 = (const LAS f32x4*)(cst + (3 + tt * 3 + 2) * 64 + 8 * o);
        const f32x4 w0a = w0[0], w0b = w0[1], w1a = w1[0], w1b = w1[1], w2a = w2[0], w2b = w2[1];
#pragma unroll
        for (int e = 0; e < 4; ++e) { rv[e] += w0a[e] * a[e]; rv[e + 4] += w0b[e] * a[e + 4]; kv[e] += w1a[e] * bq[e]; kv[e + 4] += w1b[e] * bq[e + 4]; vv[e] += w2a[e] * cq[e]; vv[e + 4] += w2b[e] * cq[e + 4]; } }
    float kkw[8], kaw[8];
    { const LAS f32x4* a = (const LAS f32x4*)(cst + 0 * 64 + 8 * o); const LAS f32x4* bq = (const LAS f32x4*)(cst + 1 * 64 + 8 * o); const f32x4 a0 = a[0], a1 = a[1], b0 = bq[0], b1 = bq[1];
#pragma unroll
      for (int e = 0; e < 4; ++e) { kkw[e] = a0[e]; kkw[e + 4] = a1[e]; kaw[e] = b0[e]; kaw[e + 4] = b1[e]; } }
    float kkr[8], ss = 0.f;
#pragma unroll
    for (int e = 0; e < 8; ++e) { kkr[e] = kv[e] * kkw[e]; ss += kkr[e] * kkr[e]; }
    ss = sum8(ss);
    const float rn = 1.0f / sqrtf(fmaxf(ss, 1e-24f));
    float At[8], Rt[8], Bt[8], Kt[8];
#pragma unroll
    for (int e = 0; e < 8; ++e) { const float kk = kkr[e] * rn, kd = kv[e] * (1.0f + (ai[e] - 1.0f) * kaw[e]); const float eprev = tb == 0 ? 1.0f : epf[e]; const float ec = ecf[e], en = 1.0f / ec;
        At[e] = -kk * eprev; Rt[e] = rv[e] * ec; Bt[e] = kk * ai[e] * en; Kt[e] = kd * en; }
    const int P0 = 32 * (o >> 2) + 16 * (o & 1) + 4 * ((o >> 1) & 1);
    LAS bf16* AI = (LAS bf16*)(img + IM_AI) + blk * 1152 + tb * 72 + P0, *RI = (LAS bf16*)(img + IM_RI) + blk * 1152 + tb * 72 + P0, *BI = (LAS bf16*)(img + IM_BI) + blk * 1152 + tb * 72 + P0, *KI = (LAS bf16*)(img + IM_KI) + blk * 1152 + tb * 72 + P0;
    unsigned bp[4], kp[4];
#pragma unroll
    for (int e = 0; e < 4; ++e) { bp[e] = cvtpk(Bt[2 * e], Bt[2 * e + 1]); kp[e] = cvtpk(Kt[2 * e], Kt[2 * e + 1]); }
    *(LAS v2u*)AI = (v2u){cvtpk(At[0], At[1]), cvtpk(At[2], At[3])}; *(LAS v2u*)(AI + 8) = (v2u){cvtpk(At[4], At[5]), cvtpk(At[6], At[7])};
    *(LAS v2u*)RI = (v2u){cvtpk(Rt[0], Rt[1]), cvtpk(Rt[2], Rt[3])}; *(LAS v2u*)(RI + 8) = (v2u){cvtpk(Rt[4], Rt[5]), cvtpk(Rt[6], Rt[7])};
    *(LAS v2u*)BI = (v2u){bp[0], bp[1]}; *(LAS v2u*)(BI + 8) = (v2u){bp[2], bp[3]};
    *(LAS v2u*)KI = (v2u){kp[0], kp[1]}; *(LAS v2u*)(KI + 8) = (v2u){kp[2], kp[3]};
    LAS bf16* BKT = (LAS bf16*)(img + IM_BKT) + blk * 2624 + (8 * o) * 40 + o * 8 + (tb >> 2) * 8 + (tb & 3); LAS bf16* VT = (LAS bf16*)(img + IM_VT) + blk * 1312 + (8 * o) * 20 + o * 4 + tb;
    const unsigned vp[4] = {cvtpk(vv[0], vv[1]), cvtpk(vv[2], vv[3]), cvtpk(vv[4], vv[5]), cvtpk(vv[6], vv[7])};
#pragma unroll
    for (int e = 0; e < 8; ++e) { const unsigned bb = bp[e >> 1], kq = kp[e >> 1], vq = vp[e >> 1];
        BKT[e * 40] = (bf16)((e & 1) ? (bb >> 16) : (bb & 0xffff)); BKT[e * 40 + 4] = (bf16)((e & 1) ? (kq >> 16) : (kq & 0xffff)); VT[e * 20] = (bf16)((e & 1) ? (vq >> 16) : (vq & 0xffff)); }
    if (tb == 15) { const f32x4* gs = (const f32x4*)((const float*)(F.ws + WS_GAM32) + ((size_t)dir * (TT / 16) + (row >> 4)) * RW + ch0); LAS f32x4* G = (LAS f32x4*)((LAS float*)(img + IM_GAM) + blk * 64 + 8 * o); G[0] = gs[0]; G[1] = gs[1]; }
    if (BONUS) { float bs = 0.f; const LAS f32x4* rk = (const LAS f32x4*)(cst + 2 * 64 + 8 * o); const f32x4 r0 = rk[0], r1 = rk[1];
#pragma unroll
        for (int e = 0; e < 4; ++e) bs += rv[e] * kv[e] * r0[e] + rv[e + 4] * kv[e + 4] * r1[e];
        bs = sum8(bs);
        const int pl = dir ? pos0_local - tl : pos0_local + tl;
        *(LAS v4u*)(lds_vb + (pl * 64 + 8 * o) * 2) = (v4u){vp[0], vp[1], vp[2], vp[3]}; if (o == 0) lds_bon[pl] = bs; }
}
template <bool WANT_Y>
__device__ __forceinline__ void block_package(LAS unsigned char* img, int blk, LAS unsigned* pkg, int lane) {
    const int q = lane >> 4, c = lane & 15;
    f32x4 mab = {0.f, 0.f, 0.f, 0.f}, mak = mab, mbr = mab, mkr = mab;
#pragma unroll
    for (int k = 0; k < 2; ++k) { const int o = blk * 2304 + c * 144 + k * 64 + q * 16;
        const bf16x8 bi = *(const LAS bf16x8*)(img + IM_BI + o), ki = *(const LAS bf16x8*)(img + IM_KI + o), ai = *(const LAS bf16x8*)(img + IM_AI + o);
        mab = MFMA16(bi, ai, mab); mak = MFMA16(ki, ai, mak);
        if constexpr (WANT_Y) { const bf16x8 ri = *(const LAS bf16x8*)(img + IM_RI + o); mbr = MFMA16(bi, ri, mbr); mkr = MFMA16(ki, ri, mkr); } }
#pragma unroll
    for (int e = 0; e < 4; ++e) { const int s = 4 * q + e; if (!(s < c)) { mab[e] = 0.f; mak[e] = 0.f; } if (!(s <= c)) { mbr[e] = 0.f; mkr[e] = 0.f; } }
    f32x4 mabT = {0.f, 0.f, 0.f, 0.f};
#pragma unroll
    for (int k = 0; k < 2; ++k) { const int o = blk * 2304 + c * 144 + k * 64 + q * 16; mabT = MFMA16(*(const LAS bf16x8*)(img + IM_AI + o), *(const LAS bf16x8*)(img + IM_BI + o), mabT); }
#pragma unroll
    for (int e = 0; e < 4; ++e) if (!(c < 4 * q + e)) mabT[e] = 0.f;
    const f32x4 z4 = {0.f, 0.f, 0.f, 0.f};
#define OPND(x) mk8(cvtpk((x)[0], (x)[1]), cvtpk((x)[2], (x)[3]), 0u, 0u)
    const bf16x8 oM = OPND(mab), oMT = OPND(mabT);
    const f32x4 m2 = MFMA16(oMT, oM, z4), m2T = MFMA16(oM, oMT, z4);
    const bf16x8 oM2 = OPND(m2), oM2T = OPND(m2T);
    const f32x4 m4 = MFMA16(oM2T, oM2, z4), m4T = MFMA16(oM2, oM2T, z4);
    const f32x4 m8T = MFMA16(OPND(m4), OPND(m4T), z4);
    f32x4 nn = m2;
#pragma unroll
    for (int e = 0; e < 4; ++e) nn[e] += (4 * q + e == c) ? 1.0f : 0.0f;
    nn = MFMA16(oMT, OPND(nn), nn);
    nn = MFMA16(OPND(m4T), OPND(nn), nn);
    nn = MFMA16(OPND(m8T), OPND(nn), nn);
#undef OPND
    pkg[0 * 64 + lane] = cvtpk(nn[0], nn[1]); pkg[1 * 64 + lane] = cvtpk(nn[2], nn[3]);
    pkg[2 * 64 + lane] = cvtpk(mak[0], mak[1]); pkg[3 * 64 + lane] = cvtpk(mak[2], mak[3]);
    if constexpr (WANT_Y) { pkg[4 * 64 + lane] = cvtpk(mbr[0], mbr[1]); pkg[5 * 64 + lane] = cvtpk(mbr[2], mbr[3]); pkg[6 * 64 + lane] = cvtpk(mkr[0], mkr[1]); pkg[7 * 64 + lane] = cvtpk(mkr[2], mkr[3]); }
}
template <bool WANT_Y, bool HAS_V>
__device__ __forceinline__ f32x4 block_scan(LAS unsigned char* img, int blk, const LAS unsigned* pkg, f32x4 (&S)[4], int wq, int lane) {
    const int q = lane >> 4, c = lane & 15;
    bf16x8 Sb[2];
#pragma unroll
    for (int k = 0; k < 2; ++k) Sb[k] = mk8(cvtpk(S[2 * k][0], S[2 * k][1]), cvtpk(S[2 * k][2], S[2 * k][3]), cvtpk(S[2 * k + 1][0], S[2 * k + 1][1]), cvtpk(S[2 * k + 1][2], S[2 * k + 1][3]));
    v2u vpk = {0u, 0u};
    if constexpr (HAS_V) vpk = *(const LAS v2u*)(img + IM_VT + blk * 2624 + (c + 16 * wq) * 40 + ((c + 16 * wq) >> 3) * 8 + q * 8);
    const int ao = blk * 2304 + c * 144 + q * 16;
    f32x4 rhs = {0.f, 0.f, 0.f, 0.f};
    rhs = MFMA16(*(const LAS bf16x8*)(img + IM_AI + ao), Sb[0], rhs); rhs = MFMA16(*(const LAS bf16x8*)(img + IM_AI + ao + 64), Sb[1], rhs);
    if constexpr (HAS_V) rhs = MFMA16(mk8(0u, 0u, pkg[2 * 64 + lane], pkg[3 * 64 + lane]), mk8(0u, 0u, vpk.x, vpk.y), rhs);
    f32x4 u = {0.f, 0.f, 0.f, 0.f};
    u = MFMA16(mk8(pkg[0 * 64 + lane], pkg[1 * 64 + lane], 0u, 0u), mk8(cvtpk(rhs[0], rhs[1]), cvtpk(rhs[2], rhs[3]), 0u, 0u), u);
    const bf16x8 UV = mk8(cvtpk(u[0], u[1]), cvtpk(u[2], u[3]), vpk.x, vpk.y);
    f32x4 y = {0.f, 0.f, 0.f, 0.f};
    if constexpr (WANT_Y) { y = MFMA16(*(const LAS bf16x8*)(img + IM_RI + ao), Sb[0], y); y = MFMA16(*(const LAS bf16x8*)(img + IM_RI + ao + 64), Sb[1], y);
        y = MFMA16(mk8(pkg[4 * 64 + lane], pkg[5 * 64 + lane], pkg[6 * 64 + lane], pkg[7 * 64 + lane]), UV, y); }
#pragma unroll
    for (int T = 0; T < 4; ++T) { const bf16x8 bkt = *(const LAS bf16x8*)(img + IM_BKT + blk * 5248 + (16 * T + c) * 80 + ((16 * T + c) >> 3) * 16 + q * 16);
        S[T] = MFMA16(bkt, UV, S[T]); const f32x4 g = *(const LAS f32x4*)(img + IM_GAM + blk * 256 + (16 * T + 4 * q) * 4); S[T] = S[T] * g; }
    return y;
}
__device__ __forceinline__ unsigned char* sum_slot(Frame& F, int chain, int sc) { return (unsigned char*)F.out + OUT_SUM + (size_t)(chain * NSC + sc) * SUM_SLOT; }

__device__ __forceinline__ void rwkv_pass1_pair(Frame& F, int li, int pair) {
    const int g = F.wave >> 2, wq = F.wave & 3, u = 2 * pair + g;
    const int chain = u / (NSC - 1), sc = u % (NSC - 1);
    const int dir = chain / 12, b = (chain / 6) & 1, h = chain % 6;
    const bool isctx = sc < 2; const int scl = isctx ? sc : sc - 2;
    LAS unsigned char* img = F.lds + (g ? L_IMG1 : L_IMG0); LAS unsigned* pkg = (LAS unsigned*)(F.lds + L_PKG) + g * 1024;
    LAS float* cst = (LAS float*)(F.lds + L_CST) + g * 768;
    __syncthreads();
    chain_consts_lds(F, cst, li, h, F.tid & 255);
    const int q = F.lane >> 4, c = F.lane & 15;
    f32x4 SB[4], SA[4];
#pragma unroll
    for (int T = 0; T < 4; ++T)
#pragma unroll
        for (int e = 0; e < 4; ++e) { SB[T][e] = 0.0f; SA[T][e] = (16 * T + 4 * q + e == c + 16 * wq) ? 1.0f : 0.0f; }
    PrepRaw R;
    prep_load(F, R, dir, b, h, 8 * wq + (F.lane >> 3), F.lane & 7, isctx, 128 * scl);
#pragma unroll 1
    for (int rd = 0; rd < 4; ++rd) {
        __syncthreads();
        prep_compute(F, R, cst, img, dir, b, h, 8 * wq + (F.lane >> 3), F.lane & 7, isctx, 128 * scl + 32 * rd, nullptr, nullptr, 0);
        __syncthreads();
        if (rd < 3) prep_load(F, R, dir, b, h, 8 * wq + (F.lane >> 3), F.lane & 7, isctx, 128 * scl + 32 * (rd + 1));
        if (wq < 2) block_package<false>(img, wq, pkg + wq * 512, F.lane);
        __syncthreads();
#pragma unroll
        for (int blk = 0; blk < 2; ++blk) { block_scan<false, true>(img, blk, pkg + blk * 512, SB, wq, F.lane); block_scan<false, false>(img, blk, pkg + blk * 512, SA, wq, F.lane); }
    }
    unsigned char* slot = sum_slot(F, chain, sc);
    { f32x4* braw = (f32x4*)slot;
#pragma unroll
      for (int T = 0; T < 4; ++T) braw[(wq * 4 + T) * 64 + F.lane] = SB[T]; }
    { bf16* aim = (bf16*)(slot + 16384); const int kap = wq >> 1, e = (F.lane & 3) + 4 * (wq & 1), qc = c >> 2;
#pragma unroll
      for (int T = 0; T < 4; ++T)
#pragma unroll
          for (int r = 0; r < 4; ++r) { const int lc = (4 * q + r) + 16 * qc; aim[((T * 2 + kap) * 64 + lc) * 8 + e] = (bf16)f2bf(SA[T][r]); } }
}
struct P2Buf { f32x4 Bc[4]; bf16x8 af[4][2]; };
__device__ __forceinline__ void p2_load(Frame& F, P2Buf& X, int chain, int sc, int wq) {
    unsigned char* slot = sum_slot(F, chain, sc); const f32x4* braw = (const f32x4*)slot; const bf16* aim = (const bf16*)(slot + 16384);
#pragma unroll
    for (int T = 0; T < 4; ++T) { X.Bc[T] = braw[(wq * 4 + T) * 64 + F.lane];
#pragma unroll
        for (int k = 0; k < 2; ++k) X.af[T][k] = *(const bf16x8*)(aim + ((T * 2 + k) * 64 + F.lane) * 8); }
}
__device__ __forceinline__ void p2_step(Frame& F, const P2Buf& X, f32x4 (&S)[4], int chain, int sc, int wq) {
    f32x4* braw = (f32x4*)sum_slot(F, chain, sc);
    bf16x8 Sb[2];
#pragma unroll
    for (int k = 0; k < 2; ++k) Sb[k] = mk8(cvtpk(S[2 * k][0], S[2 * k][1]), cvtpk(S[2 * k][2], S[2 * k][3]), cvtpk(S[2 * k + 1][0], S[2 * k + 1][1]), cvtpk(S[2 * k + 1][2], S[2 * k + 1][3]));
#pragma unroll
    for (int T = 0; T < 4; ++T) { braw[(wq * 4 + T) * 64 + F.lane] = S[T]; const f32x4 a = MFMA16(X.af[T][0], Sb[0], X.Bc[T]); S[T] = MFMA16(X.af[T][1], Sb[1], a); }
}
__device__ __forceinline__ void rwkv_pass2_chain(Frame& F, int chain) {
    if (F.wave >= 4) return;
    const int wq = F.wave; constexpr int NS = NSC - 1;
    f32x4 S[4];
#pragma unroll
    for (int T = 0; T < 4; ++T) S[T] = (f32x4){0.f, 0.f, 0.f, 0.f};
    P2Buf X0, X1, X2;
    p2_load(F, X0, chain, 0, wq); p2_load(F, X1, chain, 1, wq); p2_load(F, X2, chain, 2, wq);
#pragma unroll 1
    for (int sc = 0; sc < NS; sc += 3) {
        p2_step(F, X0, S, chain, sc, wq); if (sc + 3 < NS) p2_load(F, X0, chain, sc + 3, wq);
        if (sc + 1 < NS) { p2_step(F, X1, S, chain, sc + 1, wq); if (sc + 4 < NS) p2_load(F, X1, chain, sc + 4, wq); }
        if (sc + 2 < NS) { p2_step(F, X2, S, chain, sc + 2, wq); if (sc + 5 < NS) p2_load(F, X2, chain, sc + 5, wq); }
    }
    { f32x4* braw = (f32x4*)sum_slot(F, chain, NSC - 1);
#pragma unroll
      for (int T = 0; T < 4; ++T) braw[(wq * 4 + T) * 64 + F.lane] = S[T]; }
}
__device__ __forceinline__ void rwkv_pass3_unit(Frame& F, int li, int u) {
    const int pc = u % NSC, bh = u / NSC, b = bh / 6, h = bh % 6;
    const bool isctx = pc < 2; const int pcl = isctx ? pc : pc - 2, nsc = isctx ? 2 : 64;
    const int dir = F.wave >> 2, wq = F.wave & 3, q = F.lane >> 4, c = F.lane & 15;
    const int sc = dir == 0 ? pc : (isctx ? 1 - pcl : 2 + 63 - pcl);
    const int scl = dir == 0 ? pcl : nsc - 1 - pcl;
    const int chain = dir * 12 + b * 6 + h;
    LAS unsigned char* img = F.lds + (dir ? L_IMG1 : L_IMG0); LAS unsigned* pkg = (LAS unsigned*)(F.lds + L_PKG) + dir * 1024;
    LAS float* YL = (LAS float*)(F.lds + L_YL); LAS unsigned char* VB = F.lds + L_VB; LAS float* BON = (LAS float*)(F.lds + L_BON);
    LAS float* cst = (LAS float*)(F.lds + L_CST);
    __syncthreads();
    if (F.tid < 256) chain_consts_lds(F, cst, li, h, F.tid);
    f32x4 S[4];
    { const f32x4* braw = (const f32x4*)sum_slot(F, chain, sc);
#pragma unroll
      for (int T = 0; T < 4; ++T) S[T] = braw[(wq * 4 + T) * 64 + F.lane]; }
    __syncthreads();
    for (int i = F.tid; i < 128 * 68; i += NTHR) YL[i] = 0.f;
    PrepRaw R;
    prep_load(F, R, dir, b, h, 8 * wq + (F.lane >> 3), F.lane & 7, isctx, 128 * scl);
#pragma unroll 1
    for (int rd = 0; rd < 4; ++rd) {
        __syncthreads();
        prep_compute(F, R, cst, img, dir, b, h, 8 * wq + (F.lane >> 3), F.lane & 7, isctx, 128 * scl + 32 * rd, dir == 0 ? VB : (LAS unsigned char*)nullptr, BON, 32 * rd);
        __syncthreads();
        if (rd < 3) prep_load(F, R, dir, b, h, 8 * wq + (F.lane >> 3), F.lane & 7, isctx, 128 * scl + 32 * (rd + 1));
        if (wq < 2) block_package<true>(img, wq, pkg + wq * 512, F.lane);
        __syncthreads();
#pragma unroll
        for (int blk = 0; blk < 2; ++blk) { const f32x4 y = block_scan<true, true>(img, blk, pkg + blk * 512, S, wq, F.lane);
#pragma unroll
            for (int e = 0; e < 4; ++e) { const int t = 32 * rd + 16 * blk + 4 * q + e; const int pl = dir ? 127 - t : t; YL[pl * 68 + c + 16 * wq] += y[e]; } }
    }
    __syncthreads();
    const int wv = F.wave; const int rbase = (isctx ? TL + b * CTX : b * SEQ) + 128 * pcl;
    const bf16* g2t = (const bf16*)(F.ws + WS_G2T) + (size_t)li * 384 * 128;
    f32x4 gate[4];
#pragma unroll
    for (int nt = 0; nt < 4; ++nt) gate[nt] = (f32x4){0.f, 0.f, 0.f, 0.f};
#pragma unroll
    for (int k = 0; k < 4; ++k) { const v4u zg = *(const v4u*)(zrow(F, rbase + 16 * wv + c) + ZG + 32 * k + 8 * q);
#define SG(x) (1.0f / (1.0f + __expf(-(x))))
        const bf16x8 a = mk8(pk2(SG(bflo(zg.x)), SG(bfhi(zg.x))), pk2(SG(bflo(zg.y)), SG(bfhi(zg.y))), pk2(SG(bflo(zg.z)), SG(bfhi(zg.z))), pk2(SG(bflo(zg.w)), SG(bfhi(zg.w))));
#undef SG
#pragma unroll
        for (int nt = 0; nt < 4; ++nt) { const bf16x8 bb = *(const bf16x8*)(g2t + (size_t)(64 * h + 16 * nt + c) * 128 + 32 * k + 8 * q); gate[nt] = MFMA16(a, bb, gate[nt]); } }
    bf16* mix = (bf16*)(F.ws + WS_H);
    float lg[4], lb[4];
#pragma unroll
    for (int nt = 0; nt < 4; ++nt) { lg[nt] = inp(I_LNG)[li * RW + 64 * h + 16 * nt + c]; lb[nt] = inp(I_LNB)[li * RW + 64 * h + 16 * nt + c]; }
#pragma unroll
    for (int e = 0; e < 4; ++e) { const int tl = 16 * wv + 4 * q + e;
        float yv[4], s = 0.f;
#pragma unroll
        for (int nt = 0; nt < 4; ++nt) { yv[nt] = YL[tl * 68 + 16 * nt + c]; s += yv[nt]; }
        s = sum16(s);
        const float mu = s * (1.0f / 64.0f); float v2 = 0.f;
#pragma unroll
        for (int nt = 0; nt < 4; ++nt) { yv[nt] -= mu; v2 += yv[nt] * yv[nt]; }
        v2 = sum16(v2);
        const float rs = 1.0f / sqrtf(v2 * (1.0f / 64.0f) + GN_EPS); const float bon = BON[tl];
#pragma unroll
        for (int nt = 0; nt < 4; ++nt) { const float vv = bf2f(((const LAS bf16*)VB)[tl * 64 + 16 * nt + c]);
            const float o = (yv[nt] * rs * lg[nt] + lb[nt] + bon * vv) * gate[nt][e];
            mix[(size_t)(rbase + tl) * DM + 640 + 64 * h + 16 * nt + c] = (bf16)f2bf(o); } }
}

constexpr int AT_KROW = 144;
__device__ __forceinline__ void attn_unit(Frame& F, int li, int u) {
    const bool cq = u >= 256;
    int b, kvh, qb;
    if (!cq) { b = u >> 7; kvh = (u >> 6) & 1; qb = u & 63; } else { const int uu = u - 256; b = uu >> 2; kvh = (uu >> 1) & 1; qb = uu & 1; }
    const int c = F.lane & 15, q = F.lane >> 4, tb = F.wave;
    bf16* mix = (bf16*)(F.ws + WS_H);
    const float* rct = (const float*)(F.ws + WS_ROPE); const float* rst = rct + SEQ * 32;
    const int qrow = (cq ? TL + b * CTX : b * SEQ) + 128 * qb + 16 * tb + c;
    const int qpos = 128 * qb + 16 * tb + c;
    bf16x8 Q[3][2];
    { float cs[8], sn[8];
      if (!cq) { const f32x4 c0 = *(const f32x4*)(rct + qpos * 32 + 8 * q), c1 = *(const f32x4*)(rct + qpos * 32 + 8 * q + 4), s0 = *(const f32x4*)(rst + qpos * 32 + 8 * q), s1 = *(const f32x4*)(rst + qpos * 32 + 8 * q + 4);
#pragma unroll
          for (int e = 0; e < 4; ++e) { cs[e] = c0[e]; cs[e + 4] = c1[e]; sn[e] = s0[e]; sn[e + 4] = s1[e]; } }
      else {
#pragma unroll
          for (int e = 0; e < 8; ++e) { cs[e] = 1.0f; sn[e] = 0.0f; } }
#pragma unroll
      for (int hh = 0; hh < 3; ++hh) { const bf16* zq = zrow(F, qrow) + ZQ + 64 * (3 * kvh + hh) + 8 * q; float x1[8], x2[8]; unpack8(*(const v4u*)zq, x1); unpack8(*(const v4u*)(zq + 32), x2);
          float o1[8], o2[8];
#pragma unroll
          for (int e = 0; e < 8; ++e) { o1[e] = 0.125f * (x1[e] * cs[e] - x2[e] * sn[e]); o2[e] = 0.125f * (x2[e] * cs[e] + x1[e] * sn[e]); }
          Q[hh][0] = mk8(pk2(o1[0], o1[1]), pk2(o1[2], o1[3]), pk2(o1[4], o1[5]), pk2(o1[6], o1[7])); Q[hh][1] = mk8(pk2(o2[0], o2[1]), pk2(o2[2], o2[3]), pk2(o2[4], o2[5]), pk2(o2[6], o2[7])); } }
    float m[3], l[3]; f32x4 O[3][4];
#pragma unroll
    for (int hh = 0; hh < 3; ++hh) { m[hh] = inp(I_SINK)[li * 6 + 3 * kvh + hh]; l[hh] = q == 0 ? 1.0f : 0.0f;
#pragma unroll
        for (int dt = 0; dt < 4; ++dt) O[hh][dt] = (f32x4){0.f, 0.f, 0.f, 0.f}; }
    LAS unsigned char* KI = F.lds;
#pragma unroll 1
    for (int stage = cq ? 1 : 0; stage < 2; ++stage) {
        const int nkeys = stage == 0 ? 384 : 256; const int vstride = (nkeys + 8) * 2;
        LAS unsigned char* VTI = F.lds + 384 * AT_KROW;
        const int kpos0 = 128 * (qb - 1);
        __syncthreads();
        for (int pc = F.tid; pc < nkeys * 4; pc += NTHR) { const int key = pc >> 2, o = pc & 3;
            const bf16* zk; float cs[8], sn[8];
            if (stage == 0) { int kp = kpos0 + key; kp = kp < 0 ? 0 : (kp >= SEQ ? SEQ - 1 : kp); zk = zrow(F, b * SEQ + kp) + 64 * kvh + 8 * o;
                const f32x4 c0 = *(const f32x4*)(rct + kp * 32 + 8 * o), c1 = *(const f32x4*)(rct + kp * 32 + 8 * o + 4), s0 = *(const f32x4*)(rst + kp * 32 + 8 * o), s1 = *(const f32x4*)(rst + kp * 32 + 8 * o + 4);
#pragma unroll
                for (int e = 0; e < 4; ++e) { cs[e] = c0[e]; cs[e + 4] = c1[e]; sn[e] = s0[e]; sn[e + 4] = s1[e]; } }
            else { zk = zrow(F, TL + b * CTX + key) + 64 * kvh + 8 * o;
#pragma unroll
                for (int e = 0; e < 8; ++e) { cs[e] = 1.0f; sn[e] = 0.0f; } }
            const v4u k1 = *(const v4u*)(zk + ZK), k2 = *(const v4u*)(zk + ZK + 32), v1 = *(const v4u*)(zk + ZV), v2 = *(const v4u*)(zk + ZV + 32);
            float x1[8], x2[8]; unpack8(k1, x1); unpack8(k2, x2);
            float o1[8], o2[8];
#pragma unroll
            for (int e = 0; e < 8; ++e) { o1[e] = x1[e] * cs[e] - x2[e] * sn[e]; o2[e] = x2[e] * cs[e] + x1[e] * sn[e]; }
            *(LAS v4u*)(KI + key * AT_KROW + o * 16) = (v4u){pk2(o1[0], o1[1]), pk2(o1[2], o1[3]), pk2(o1[4], o1[5]), pk2(o1[6], o1[7])};
            *(LAS v4u*)(KI + key * AT_KROW + 64 + o * 16) = (v4u){pk2(o2[0], o2[1]), pk2(o2[2], o2[3]), pk2(o2[4], o2[5]), pk2(o2[6], o2[7])};
            const int kl = key & 31; const int col = (key & ~31) | (((kl & 15) >> 2) << 3) | ((kl >> 4) << 2) | (kl & 3);
#pragma unroll
            for (int hv = 0; hv < 2; ++hv) { const v4u vv = hv ? v2 : v1; LAS bf16* vt = (LAS bf16*)(VTI + (8 * (o + 4 * hv)) * vstride) + col;
                vt[0] = (bf16)(vv.x & 0xffff); *(LAS bf16*)((LAS unsigned char*)vt + vstride) = (bf16)(vv.x >> 16);
                *(LAS bf16*)((LAS unsigned char*)vt + 2 * vstride) = (bf16)(vv.y & 0xffff); *(LAS bf16*)((LAS unsigned char*)vt + 3 * vstride) = (bf16)(vv.y >> 16);
                *(LAS bf16*)((LAS unsigned char*)vt + 4 * vstride) = (bf16)(vv.z & 0xffff); *(LAS bf16*)((LAS unsigned char*)vt + 5 * vstride) = (bf16)(vv.z >> 16);
                *(LAS bf16*)((LAS unsigned char*)vt + 6 * vstride) = (bf16)(vv.w & 0xffff); *(LAS bf16*)((LAS unsigned char*)vt + 7 * vstride) = (bf16)(vv.w >> 16); } }
        __syncthreads();
        const int npair = nkeys / 32;
        const int Q0 = 128 * qb + 16 * tb;
#pragma unroll 1
        for (int kp = 0; kp < npair; ++kp) {
            const int kb = kpos0 + 32 * kp;
            if (stage == 0 && (kb + 31 < Q0 - 128 || kb > Q0 + 143 || kb + 31 < 0 || kb >= SEQ)) continue;
            bf16x8 K[2][2], V[4];
#pragma unroll
            for (int t = 0; t < 2; ++t)
#pragma unroll
                for (int k = 0; k < 2; ++k) K[t][k] = *(const LAS bf16x8*)(KI + (32 * kp + 16 * t + c) * AT_KROW + k * 64 + q * 16);
#pragma unroll
            for (int dt = 0; dt < 4; ++dt) V[dt] = *(const LAS bf16x8*)(VTI + (16 * dt + c) * vstride + kp * 64 + q * 16);
            bool ok0[4], ok1[4];
#pragma unroll
            for (int e = 0; e < 4; ++e) { const int k0 = kb + 4 * q + e, k1 = k0 + 16;
                ok0[e] = stage == 1 || (k0 >= 0 && k0 < SEQ && k0 >= qpos - 128 && k0 <= qpos + 128);
                ok1[e] = stage == 1 || (k1 >= 0 && k1 < SEQ && k1 >= qpos - 128 && k1 <= qpos + 128); }
#pragma unroll
            for (int hh = 0; hh < 3; ++hh) {
                f32x4 s0 = {0.f, 0.f, 0.f, 0.f}, s1 = {0.f, 0.f, 0.f, 0.f};
                s0 = MFMA16(K[0][0], Q[hh][0], s0); s0 = MFMA16(K[0][1], Q[hh][1], s0);
                s1 = MFMA16(K[1][0], Q[hh][0], s1); s1 = MFMA16(K[1][1], Q[hh][1], s1);
                float mx = -INFINITY;
#pragma unroll
                for (int e = 0; e < 4; ++e) { s0[e] = ok0[e] ? s0[e] : -INFINITY; s1[e] = ok1[e] ? s1[e] : -INFINITY; mx = fmaxf(mx, fmaxf(s0[e], s1[e])); }
                mx = xrow_max(mx);
                const float mn = fmaxf(m[hh], mx); const float alpha = __expf(m[hh] - mn); m[hh] = mn;
                float ps = 0.f;
#pragma unroll
                for (int e = 0; e < 4; ++e) { s0[e] = __expf(s0[e] - mn); s1[e] = __expf(s1[e] - mn); ps += s0[e] + s1[e]; }
                l[hh] = l[hh] * alpha + ps;
                const bf16x8 P = mk8(cvtpk(s0[0], s0[1]), cvtpk(s0[2], s0[3]), cvtpk(s1[0], s1[1]), cvtpk(s1[2], s1[3]));
#pragma unroll
                for (int dt = 0; dt < 4; ++dt) { O[hh][dt] = O[hh][dt] * alpha; O[hh][dt] = MFMA16(V[dt], P, O[hh][dt]); }
            }
        }
    }
#pragma unroll
    for (int hh = 0; hh < 3; ++hh) { const float lt = xrow_sum(l[hh]); const float inv = 1.0f / lt;
#pragma unroll
        for (int dt = 0; dt < 4; ++dt) { v2u w; w.x = pk2(O[hh][dt][0] * inv, O[hh][dt][1] * inv); w.y = pk2(O[hh][dt][2] * inv, O[hh][dt][3] * inv);
            *(v2u*)(mix + (size_t)qrow * DM + 256 + 64 * (3 * kvh + hh) + 16 * dt + 4 * q) = w; } }
}

__device__ __forceinline__ void fourier_tables(Frame& F) {
    bf16* t = (bf16*)(F.ws + WS_FT);
    for (int i = F.bid * NTHR + F.tid; i < 64 * 64; i += F.G * NTHR) { const int r = i >> 6, cc = i & 63; const float a = (float)((r * cc) & 63) * (1.0f / 64.0f);
        const float cs = __builtin_amdgcn_cosf(a), sn = __builtin_amdgcn_sinf(a);
        t[FT_W64C / 2 + i] = (bf16)f2bf(cs); t[FT_W64S / 2 + i] = (bf16)f2bf(sn);
        const int pj = (cc & ~31) | (((cc & 15) >> 2) << 3) | (((cc >> 4) & 1) << 2) | (cc & 3);
        t[FT_T64C / 2 + r * 64 + pj] = (bf16)f2bf(cs); t[FT_T64S / 2 + r * 64 + pj] = (bf16)f2bf(sn); }
    for (int i = F.bid * NTHR + F.tid; i < 128 * 128; i += F.G * NTHR) { const int r = i >> 7, cc = i & 127; const float a = (float)((r * cc) & 127) * (1.0f / 128.0f);
        t[FT_W128C / 2 + i] = (bf16)f2bf(__builtin_amdgcn_cosf(a)); t[FT_W128S / 2 + i] = (bf16)f2bf(__builtin_amdgcn_sinf(a)); }
}
__device__ __forceinline__ void fourier_a_fast(Frame& F, int u) {
    const int b = u >> 7, n2 = u & 127, c = F.lane & 15, q = F.lane >> 4;
    LAS unsigned char* IMG = F.lds;
    __syncthreads();
    for (int pc = F.tid; pc < 64 * 32; pc += NTHR) { const int n1 = pc >> 5, c8 = pc & 31;
        const v4u v = *(const v4u*)(zrow(F, b * SEQ + 128 * n1 + n2) + ZF + 8 * c8);
        LAS bf16* d = (LAS bf16*)(IMG + (8 * c8) * 144) + n1;
        d[0] = (bf16)(v.x & 0xffff); d[72] = (bf16)(v.x >> 16); d[144] = (bf16)(v.y & 0xffff); d[216] = (bf16)(v.y >> 16);
        d[288] = (bf16)(v.z & 0xffff); d[360] = (bf16)(v.z >> 16); d[432] = (bf16)(v.w & 0xffff); d[504] = (bf16)(v.w >> 16); }
    __syncthreads();
    const bf16* wc = (const bf16*)(F.ws + WS_FT + FT_W64C); const bf16* wsn = (const bf16*)(F.ws + WS_FT + FT_W64S);
    bf16* far = (bf16*)((unsigned char*)F.out + OUT_FA); bf16* fai = far + (size_t)NB * 64 * 128 * 256;
    bf16x8 Bc[4][2], Bs[4][2];
#pragma unroll
    for (int kt = 0; kt < 4; ++kt)
#pragma unroll
        for (int k = 0; k < 2; ++k) { Bc[kt][k] = *(const bf16x8*)(wc + (16 * kt + c) * 64 + 32 * k + 8 * q); Bs[kt][k] = *(const bf16x8*)(wsn + (16 * kt + c) * 64 + 32 * k + 8 * q); }
#pragma unroll
    for (int ci = 0; ci < 2; ++ci) { const int ct = 2 * F.wave + ci;
        bf16x8 A[2];
#pragma unroll
        for (int k = 0; k < 2; ++k) A[k] = *(const LAS bf16x8*)(IMG + (16 * ct + c) * 144 + k * 64 + q * 16);
#pragma unroll
        for (int kt = 0; kt < 4; ++kt) { f32x4 sr = {0.f, 0.f, 0.f, 0.f}, si = {0.f, 0.f, 0.f, 0.f};
#pragma unroll
            for (int k = 0; k < 2; ++k) { sr = MFMA16(A[k], Bc[kt][k], sr); si = MFMA16(A[k], Bs[kt][k], si); }
            const int k1 = 16 * kt + c; const float tw = (float)(n2 * k1) * (1.0f / 8192.0f); const float tc = __builtin_amdgcn_cosf(tw), ts = __builtin_amdgcn_sinf(tw);
            float xr[4], xi[4];
#pragma unroll
            for (int e = 0; e < 4; ++e) { const float ar = sr[e], ai = -si[e]; xr[e] = ar * tc + ai * ts; xi[e] = ai * tc - ar * ts; }
            const size_t o = (((size_t)b * 64 + k1) * 128 + n2) * 256 + 16 * ct + 4 * q;
            v2u w; w.x = pk2(xr[0], xr[1]); w.y = pk2(xr[2], xr[3]); *(v2u*)(far + o) = w; w.x = pk2(xi[0], xi[1]); w.y = pk2(xi[2], xi[3]); *(v2u*)(fai + o) = w; } }
}
__device__ __forceinline__ void fourier_c_fast(Frame& F, int u) {
    const int g = u & 3, k1 = (u >> 2) & 63, b = u >> 8, c = F.lane & 15, q = F.lane >> 4;
    LAS unsigned char* IR = F.lds; LAS unsigned char* II = F.lds + 64 * 272;
    const bf16* far = (const bf16*)((unsigned char*)F.out + OUT_FA) + (((size_t)b * 64 + k1) * 128) * 256 + 64 * g; const bf16* fai = far + (size_t)NB * 64 * 128 * 256;
    __syncthreads();
    for (int pc = F.tid; pc < 128 * 8; pc += NTHR) { const int n2 = pc >> 3, c8 = pc & 7;
        const v4u vr = *(const v4u*)(far + (size_t)n2 * 256 + 8 * c8), vi = *(const v4u*)(fai + (size_t)n2 * 256 + 8 * c8);
        LAS bf16* dr = (LAS bf16*)(IR + (8 * c8) * 272) + n2; LAS bf16* di = (LAS bf16*)(II + (8 * c8) * 272) + n2;
        dr[0] = (bf16)(vr.x & 0xffff); dr[136] = (bf16)(vr.x >> 16); dr[272] = (bf16)(vr.y & 0xffff); dr[408] = (bf16)(vr.y >> 16);
        dr[544] = (bf16)(vr.z & 0xffff); dr[680] = (bf16)(vr.z >> 16); dr[816] = (bf16)(vr.w & 0xffff); dr[952] = (bf16)(vr.w >> 16);
        di[0] = (bf16)(vi.x & 0xffff); di[136] = (bf16)(vi.x >> 16); di[272] = (bf16)(vi.y & 0xffff); di[408] = (bf16)(vi.y >> 16);
        di[544] = (bf16)(vi.z & 0xffff); di[680] = (bf16)(vi.z >> 16); di[816] = (bf16)(vi.w & 0xffff); di[952] = (bf16)(vi.w >> 16); }
    __syncthreads();
    const bf16* wc = (const bf16*)(F.ws + WS_FT + FT_W128C); const bf16* wsn = (const bf16*)(F.ws + WS_FT + FT_W128S);
    const bf16* tcn = (const bf16*)(F.ws + WS_FT + FT_T64C); const bf16* tsn = (const bf16*)(F.ws + WS_FT + FT_T64S);
    f32x4 Pr[4], Pi[4];
#pragma unroll
    for (int ct = 0; ct < 4; ++ct) { Pr[ct] = (f32x4){0.f, 0.f, 0.f, 0.f}; Pi[ct] = (f32x4){0.f, 0.f, 0.f, 0.f}; }
#pragma unroll
    for (int k = 0; k < 4; ++k) { const bf16x8 bc = *(const bf16x8*)(wc + (16 * F.wave + c) * 128 + 32 * k + 8 * q), bs = *(const bf16x8*)(wsn + (16 * F.wave + c) * 128 + 32 * k + 8 * q);
        const v4u bsu = __builtin_bit_cast(v4u, bs); const bf16x8 bsn = mk8(bsu.x ^ 0x80008000u, bsu.y ^ 0x80008000u, bsu.z ^ 0x80008000u, bsu.w ^ 0x80008000u);
#pragma unroll
        for (int ct = 0; ct < 4; ++ct) { const bf16x8 ar = *(const LAS bf16x8*)(IR + (16 * ct + c) * 272 + k * 64 + q * 16), ai = *(const LAS bf16x8*)(II + (16 * ct + c) * 272 + k * 64 + q * 16);
            Pr[ct] = MFMA16(ar, bc, Pr[ct]); Pr[ct] = MFMA16(ai, bs, Pr[ct]); Pi[ct] = MFMA16(ai, bc, Pi[ct]); Pi[ct] = MFMA16(ar, bsn, Pi[ct]); } }
    bf16x8 Br[2], Bi[2];
#pragma unroll
    for (int k = 0; k < 2; ++k) { Br[k] = mk8(cvtpk(Pr[2 * k][0], Pr[2 * k][1]), cvtpk(Pr[2 * k][2], Pr[2 * k][3]), cvtpk(Pr[2 * k + 1][0], Pr[2 * k + 1][1]), cvtpk(Pr[2 * k + 1][2], Pr[2 * k + 1][3]));
        Bi[k] = mk8(cvtpk(Pi[2 * k][0], Pi[2 * k][1]), cvtpk(Pi[2 * k][2], Pi[2 * k][3]), cvtpk(Pi[2 * k + 1][0], Pi[2 * k + 1][1]), cvtpk(Pi[2 * k + 1][2], Pi[2 * k + 1][3])); }
    bf16* mix = (bf16*)(F.ws + WS_H);
    const float scale = 0.0013810679320049757f;
    const int k2 = 16 * F.wave + c; const size_t row = (size_t)b * SEQ + k1 + 64 * k2;
#pragma unroll
    for (int mt = 0; mt < 4; ++mt) { f32x4 y = {0.f, 0.f, 0.f, 0.f};
#pragma unroll
        for (int k = 0; k < 2; ++k) { const bf16x8 ac = *(const bf16x8*)(tcn + (16 * mt + c) * 64 + 32 * k + 8 * q), as = *(const bf16x8*)(tsn + (16 * mt + c) * 64 + 32 * k + 8 * q);
            y = MFMA16(ac, Br[k], y); y = MFMA16(as, Bi[k], y); }
        v2u w; w.x = pk2(y[0] * scale, y[1] * scale); w.y = pk2(y[2] * scale, y[3] * scale);
        *(v2u*)(mix + row * DM + 64 * g + 16 * mt + 4 * q) = w; }
}

#define XB_TMO      128
#define XB_XCNT(j)  (256  + 64 * (j))
#define XB_XSUB(j)  (1280 + 64 * (j))
#define XB_XGEN(j)  (2304 + 64 * (j))
#define XB_TOP      3328
#define XB_TOPGEN   3392
#define XCD_BAR_WORDS 3456
#define XB_SPIN_CAP (1u << 23)
__device__ __forceinline__ unsigned xb_ld(unsigned* p)              { return __hip_atomic_load(p, __ATOMIC_RELAXED, __HIP_MEMORY_SCOPE_AGENT); }
__device__ __forceinline__ unsigned xb_add(unsigned* p, unsigned v) { return __hip_atomic_fetch_add(p, v, __ATOMIC_RELAXED, __HIP_MEMORY_SCOPE_AGENT); }
__device__ __forceinline__ unsigned xb_xcc_id() { return (unsigned)__builtin_amdgcn_s_getreg((3 << 11) | 20) & 0xFu; }
#define XB_SPIN(cond, bar) do { unsigned _sp = 0; while (cond) { __builtin_amdgcn_s_sleep(1); \
    if ((++_sp & 255u) == 0u) { if (xb_ld(&(bar)[XB_TMO])) break; if (_sp > XB_SPIN_CAP) { atomicAdd(&(bar)[XB_TMO], 1u); break; } } } } while (0)
struct XcdBarrier { unsigned* bar; unsigned x; volatile LAS unsigned* st; };
__device__ __forceinline__ XcdBarrier xcd_barrier_post(unsigned* bar, volatile LAS unsigned* st) {
    XcdBarrier b; b.bar = bar; b.x = xb_xcc_id(); b.st = st;
    if (threadIdx.x == 0) (void)xb_add(&bar[XB_XCNT(b.x)], 1u);
    return b;
}
__device__ __forceinline__ void xcd_barrier_complete(unsigned* bar, unsigned x, unsigned& nloc, unsigned& nx) {
    const unsigned G = gridDim.x * gridDim.y * gridDim.z;
    unsigned sum, cnt, mine, sp = 0u;
    for (;;) {
        sum = 0u; cnt = 0u; mine = 0u;
#pragma unroll
        for (unsigned j = 0; j < 16; ++j) { const unsigned c = xb_ld(&bar[XB_XCNT(j)]); sum += c; cnt += (c > 0u) ? 1u : 0u; mine = (j == x) ? c : mine; }
        if (sum == G) break;
        __builtin_amdgcn_s_sleep(1);
        if ((++sp & 255u) == 0u) { if (xb_ld(&bar[XB_TMO])) break; if (sp > XB_SPIN_CAP) { atomicAdd(&bar[XB_TMO], 1u); break; } }
    }
    nloc = mine > 0u ? mine : 1u; nx = cnt > 0u ? cnt : 1u;
}
__device__ __forceinline__ void xcd_barrier(const XcdBarrier& b0) {
    XcdBarrier b; { unsigned* p = b0.bar; unsigned x = __builtin_amdgcn_readfirstlane(b0.x); unsigned st = (unsigned)(size_t)b0.st; asm volatile("" : "+s"(p), "+s"(x), "+s"(st)); b.bar = p; b.x = x; b.st = (volatile LAS unsigned*)(size_t)st; }
    asm volatile("s_waitcnt vmcnt(0)" ::: "memory");
    __syncthreads();
    if (threadIdx.x == 0) {
        unsigned* bar = b.bar;
        __builtin_amdgcn_s_waitcnt(0);
        unsigned nloc = b.st[0], nx = b.st[1];
        if (nloc == 0u) { xcd_barrier_complete(bar, b.x, nloc, nx); b.st[0] = nloc; b.st[1] = nx; }
        const unsigned old = xb_add(&bar[XB_XSUB(b.x)], 1u);
        const unsigned gen = old / nloc;
        if (old + 1u == (gen + 1u) * nloc) {
            __builtin_amdgcn_fence(__ATOMIC_RELEASE, "agent");
            asm volatile("s_waitcnt vmcnt(0)" ::: "memory");
            const unsigned og = xb_add(&bar[XB_TOP], 1u);
            const unsigned tg = og / nx;
            if (og + 1u == (tg + 1u) * nx) xb_add(&bar[XB_TOPGEN], 1u);
            else XB_SPIN(xb_ld(&bar[XB_TOPGEN]) == tg, bar);
            __builtin_amdgcn_fence(__ATOMIC_ACQUIRE, "agent");
            xb_add(&bar[XB_XGEN(b.x)], 1u);
            asm volatile("s_waitcnt vmcnt(0)" ::: "memory");
        } else {
            XB_SPIN(xb_ld(&bar[XB_XGEN(b.x)]) == gen, bar);
            __builtin_amdgcn_fence(__ATOMIC_ACQUIRE, "agent");
            asm volatile("s_waitcnt vmcnt(0)" ::: "memory");
        }
    }
    __syncthreads();
}

__device__ __forceinline__ int queue_next(Frame& F, unsigned* cnt) {
    volatile LAS int* slot = (volatile LAS int*)(F.lds + MISC_OFF + 64);
    __syncthreads();
    if (F.tid == 0) *slot = (int)__hip_atomic_fetch_add(cnt, 1u, __ATOMIC_RELAXED, __HIP_MEMORY_SCOPE_AGENT);
    __syncthreads();
    return *slot;
}
template <int KIND> __device__ __forceinline__ void run_phase(const Frame& F0, int li, int second) {
    Frame F;
    { int t = threadIdx.x; asm volatile("" : "+v"(t)); F.tid = t; F.lane = t & 63; F.wave = __builtin_amdgcn_readfirstlane(t >> 6);
      int g = F0.G, b = F0.bid; asm volatile("" : "+s"(g), "+s"(b)); F.G = g; F.bid = b;
      unsigned char* w = F0.ws; float* o = F0.out; asm volatile("" : "+s"(w), "+s"(o)); F.ws = w; F.out = o;
      unsigned l = (unsigned)(size_t)F0.lds; asm volatile("" : "+s"(l)); F.lds = (LAS unsigned char*)(size_t)l;
      asm volatile("" : "+s"(li), "+s"(second)); }
    float* modv = (float*)(F.ws + WS_MOD);
    bf16* XB = (bf16*)(F.ws + WS_XB);
    bf16* H = (bf16*)(F.ws + WS_H); bf16* ACT = (bf16*)(F.ws + WS_ACT); bf16* O = (bf16*)(F.ws + WS_O);
    const float* ng = inp(I_NORMG) + (size_t)li * 6 * DM; const float* mv = modv + (size_t)li * 3 * 9216;
    const bool last = li == 1;
    if constexpr (KIND == 100) { convert_weights(F, 0); mod_gemv(F); rope_tables(F); lora_transposes(F); fourier_tables(F); }
    if constexpr (KIND == 101) { EArgs A{}; A.xl_src = inp(I_X); A.xc_src = inp(I_CTX); A.o = nullptr; A.hdst = H; A.modv_h = modv; A.shidx = 0; A.scidx = 1; A.gpre = inp(I_NORMG); A.nrows = TT; e_phase(F, A); }
    if constexpr (KIND == 0) {
        const bf16* wi = (const bf16*)(F.ws + (second ? WS_WI2 : WS_WI1)); const bool withctx = !(last && second);
        if (!withctx || F.G != 256) { pg8::Gemm g{H, wi, withctx ? TT : TL, NWI, DM}; pg8::StaticOrder S; S.init(g.M, g.N, F.G, F.bid);
            pg8::EpiSwiglu E{ACT, FFNP}; pg8::gemm_phase<pg8::EpiSwiglu, pg8::StaticOrder, true, true>(F.lds, g, S, E, F.tid); }
        else { unsigned* cnt = (unsigned*)(F.ws + WS_CTL) + 8192 + 64 * (li * 2 + second);
            pg8::Gemm g{H, wi, TT, NWI, DM}; pg8::UpOrder S; S.init(NWI, F.G, F.bid, cnt);
            pg8::EpiSwiglu E{ACT, FFNP}; pg8::gemm_phase<pg8::EpiSwiglu, pg8::UpOrder, true, true>(F.lds, g, S, E, F.tid);
            if (F.bid >= 248) {
                if (F.tid == 0) { unsigned sp = 0; while (__hip_atomic_load(cnt, __ATOMIC_RELAXED, __HIP_MEMORY_SCOPE_AGENT) < 352u && ++sp < (1u << 24)) __builtin_amdgcn_s_sleep(8);
                    __builtin_amdgcn_fence(__ATOMIC_ACQUIRE, "agent"); asm volatile("s_waitcnt vmcnt(0)" ::: "memory"); }
                __syncthreads();
                const int k = F.bid - 248; pg8::Gemm g2{ACT, (const bf16*)(F.ws + (second ? WS_WO2 : WS_WO1)), TT, DM, FFNP}; pg8::OneUnit S2{64 + (k >> 2), k & 3};
                pg8::EpiBf16 E2{O, DM}; pg8::gemm_phase<pg8::EpiBf16, pg8::OneUnit, false, true>(F.lds, g2, S2, E2, F.tid); } } }
    if constexpr (KIND == 1) {
        const bool ctxhere = F.G != 256 && !(last && second);
        pg8::Gemm g{ACT, (const bf16*)(F.ws + (second ? WS_WO2 : WS_WO1)), ctxhere ? TT : TL, DM, FFNP}; pg8::StaticOrder S; S.init(g.M, g.N, F.G, F.bid);
        pg8::EpiBf16 E{O, DM}; pg8::gemm_phase<pg8::EpiBf16, pg8::StaticOrder, true, true>(F.lds, g, S, E, F.tid); }
    if constexpr (KIND == 2) {
        EArgs A{}; A.xl_src = inp(I_X); A.xc_src = inp(I_CTX); A.xb_src = li == 0 ? (const bf16*)nullptr : XB; A.xb_dst = XB; A.o = O; A.modv_g = mv; A.gidx = 2; A.gmul = 0.5f; A.gpost = ng + 1 * DM;
        A.hdst = H; A.modv_h = mv; A.shidx = 3; A.scidx = 4; A.gpre = ng + 2 * DM; A.nrows = TT; e_phase(F, A); }
    if constexpr (KIND == 3) {
        pg8::Gemm g{H, (const bf16*)(F.ws + WS_WIN), TT, INWP, DM}; pg8::StaticOrder S; S.init(g.M, g.N, F.G, F.bid);
        pg8::EpiBf16 E{ACT, INWP}; pg8::gemm_phase<pg8::EpiBf16, pg8::StaticOrder, true, true>(F.lds, g, S, E, F.tid); }
    if constexpr (KIND == 4) {
        lora_pass(F, li);
        for (int u = F.bid; u < 256; u += F.G) fourier_a_fast(F, u);
        if (li == 0) fourier_ctx1_all(F); }
    if constexpr (KIND == 5) {
        unsigned* cnt = (unsigned*)(F.ws + WS_CTL) + 8192 + 64 * (4 + 2 * li);
        const int na = li == 0 ? 264 : 256;
        for (int it = queue_next(F, cnt); it < na; it = queue_next(F, cnt)) attn_unit(F, li, it);
        for (int it = queue_next(F, cnt + 16); it < 12 * (NSC - 1); it = queue_next(F, cnt + 16)) rwkv_pass1_pair(F, li, it); }
    if constexpr (KIND == 11) {
        if (F.bid < 24) rwkv_pass2_chain(F, F.bid);
        else convert_weights(F, 1, li == 0 ? 1 : 2, 24, F.G - 24);
        if (li == 0) fourier_ctx2_all(F); }
    if constexpr (KIND == 12) {
        unsigned* cnt = (unsigned*)(F.ws + WS_CTL) + 8192 + 64 * (5 + 2 * li);
        const int np3 = li == 0 ? 12 * NSC : 12 * 64;
        for (int it = queue_next(F, cnt); it < np3; it = queue_next(F, cnt)) rwkv_pass3_unit(F, li, li == 0 ? it : (it / 64) * NSC + 2 + it % 64);
        for (int it = queue_next(F, cnt + 16); it < 512; it = queue_next(F, cnt + 16)) fourier_c_fast(F, it); }
    if constexpr (KIND == 6) {
        pg8::Gemm g{H, (const bf16*)(F.ws + WS_WOUT), last ? TL : TT, DM, DM}; pg8::StaticOrder S; S.init(g.M, g.N, F.G, F.bid);
        pg8::EpiBf16 E{O, DM}; pg8::gemm_phase<pg8::EpiBf16, pg8::StaticOrder, true, true>(F.lds, g, S, E, F.tid); }
    if constexpr (KIND == 7) {
        EArgs A{}; A.xb_src = XB; A.xb_dst = XB; A.o = O; A.modv_g = mv; A.gidx = 5; A.gmul = 1.0f; A.gpost = ng + 3 * DM;
        A.hdst = H; A.modv_h = mv; A.shidx = 6; A.scidx = 7; A.gpre = ng + 4 * DM; A.nrows = last ? TL : TT; e_phase(F, A); }
    if constexpr (KIND == 10) {
        EArgs A{}; A.xb_src = XB; A.xb_dst = XB; A.out32 = last ? F.out : (float*)nullptr; A.o = O; A.modv_g = mv; A.gidx = 8; A.gmul = 0.5f; A.gpost = ng + 5 * DM;
        if (!last) { A.hdst = H; A.modv_h = mv + 3 * 9216; A.shidx = 0; A.scidx = 1; A.gpre = ng + 6 * DM; }
        A.nrows = last ? TL : TT; e_phase(F, A);
        }
}
__global__ void __launch_bounds__(NTHR, 2) mega_one(Args args) {
    extern __shared__ __attribute__((aligned(16))) unsigned char lds[];
    Frame F; F.lds = (LAS unsigned char*)lds; F.tid = threadIdx.x; F.lane = F.tid & 63; F.wave = __builtin_amdgcn_readfirstlane(F.tid >> 6); F.G = gridDim.x; F.bid = blockIdx.x;
    F.out = args.out; F.ws = args.ws;
    volatile LAS unsigned* MISC = (volatile LAS unsigned*)(F.lds + MISC_OFF);
    if (F.tid < 32) MISC[F.tid] = 0u;
    __syncthreads();
    XcdBarrier bar = xcd_barrier_post((unsigned*)(F.ws + WS_CTL) + 4096, MISC + 8);
#define GRID_BAR() xcd_barrier(bar)
    run_phase<100>(F, 0, 0); GRID_BAR();
    run_phase<101>(F, 0, 0); GRID_BAR();
#pragma unroll 1
    for (int li = 0; li < 2; ++li) {
        run_phase<0>(F, li, 0); GRID_BAR();
        run_phase<1>(F, li, 0); GRID_BAR();
        run_phase<2>(F, li, 0); GRID_BAR();
        run_phase<3>(F, li, 0); GRID_BAR();
        run_phase<4>(F, li, 0); GRID_BAR();
        run_phase<5>(F, li, 0); GRID_BAR();
        run_phase<11>(F, li, 0); GRID_BAR();
        run_phase<12>(F, li, 0); GRID_BAR();
        run_phase<6>(F, li, 0); GRID_BAR();
        run_phase<7>(F, li, 0); GRID_BAR();
        run_phase<0>(F, li, 1); GRID_BAR();
        run_phase<1>(F, li, 1); GRID_BAR();
        run_phase<10>(F, li, 0); GRID_BAR();
    }
}

extern "C" void kernel_launch(void* const* d_in, const int* in_sizes, int n_in, void* d_out, int out_size, void* d_ws, size_t ws_size, hipStream_t stream) {
    static int ready = 0;
    if (!ready) {
        if (n_in != 25 || out_size != TL * DM || ws_size < WS_END) { fprintf(stderr, "kernel_launch: unexpected shapes (n_in %d out %d ws %zu)\n", n_in, out_size, ws_size); ready = -1; return; }
        if (hipFuncSetAttribute((const void*)mega_one, hipFuncAttributeMaxDynamicSharedMemorySize, LDS_BYTES) != hipSuccess) { fprintf(stderr, "kernel_launch: hipFuncSetAttribute failed\n"); ready = -1; return; }
        int dev = 0, cus = 0; if (hipGetDevice(&dev) != hipSuccess || hipDeviceGetAttribute(&cus, hipDeviceAttributeMultiprocessorCount, dev) != hipSuccess || cus < 32) cus = 256;
        ready = cus < 256 ? cus : 256;
    }
    if (ready < 0) return;
    if (hipMemsetAsync((char*)d_ws + WS_CTL, 0, 65536, stream) != hipSuccess) { fprintf(stderr, "kernel_launch: memset failed\n"); return; }
    Args a{};
    for (int i = 0; i < 25; ++i) a.in[i] = (const float*)d_in[i];
    a.out = (float*)d_out; a.ws = (unsigned char*)d_ws;
    hipLaunchKernelGGL(mega_one, dim3(ready), dim3(NTHR), LDS_BYTES, stream, a);
}
```

```cpp
#include <hip/hip_runtime.h>
#include <cstdio>
#include <cstdint>

namespace pg8 {
#define PG8_LAS __attribute__((address_space(3)))
typedef unsigned short bf16_t;
typedef short bf16x8 __attribute__((ext_vector_type(8)));
typedef float f32x4 __attribute__((ext_vector_type(4)));
typedef unsigned u32x4 __attribute__((ext_vector_type(4)));
constexpr int BM = 256, BK = 64, HALF = 128, HTB = HALF * BK * 2, STAGE_BYTES = 8 * HTB, NXCD = 8, WGM = 8;

__host__ __device__ __forceinline__ int lds_byte(int r, int c) { const int st = (r >> 4) * 2 + (c >> 5), rr = r & 15, cc = c & 31, ob = rr * 64 + cc * 2; return st * 1024 + (ob ^ (((ob >> 9) & 1) << 5)); }
__host__ __device__ __forceinline__ void stage_rc(int b, int& R, int& C) { const int st = b / 1024, sb = b % 1024, swz = sb ^ (((sb >> 9) & 1) << 5); R = (st >> 1) * 16 + swz / 64; C = (st & 1) * 32 + (swz % 64) / 2; }
__host__ __device__ __forceinline__ int perm32(int rho) { const int n = rho >> 4, i = rho & 15; return 8 * (i >> 2) + 4 * n + (i & 3); }

struct Unit { int pm, pn; };
struct Gemm { const bf16_t* A; const bf16_t* Bt; int M, N, K; };

struct StaticOrder {
    int nM, nN, nwg, G, c;
    __host__ __device__ void init(int M, int N, int G_, int c_) { nM = M / BM; nN = N / BM; nwg = nM * nN; G = G_; c = c_; }
    __host__ __device__ bool next(int i, Unit& u) const {
        const long L = (long)i * G + c; if (L >= nwg) return false;
        int wgid = (int)L; { const int q = nwg / NXCD, r = nwg % NXCD, xcd = wgid % NXCD, off = wgid / NXCD; wgid = (xcd < r ? xcd * (q + 1) : r * (q + 1) + (xcd - r) * q) + off; }
        const int nig = WGM * nN, gid = wgid / nig, fm = gid * WGM, gsz = (nM - fm) < WGM ? (nM - fm) : WGM;
        u.pm = fm + ((wgid % nig) % gsz); u.pn = (wgid % nig) / gsz; return true;
    }
    __device__ __forceinline__ void a_ready(const Unit&) const {}
    __device__ __forceinline__ void done(const Unit&) const {}
};

struct UpOrder {
    StaticOrder lat; int G, c, nN; unsigned* cnt;
    __device__ void init(int N, int G_, int c_, unsigned* cnt_) { lat.init(16384, N, G_, c_); G = G_; c = c_; nN = N / BM; cnt = cnt_; }
    __device__ bool next(int i, Unit& u) const {
        const int nctx = 2 * nN, total = nctx + lat.nwg;
        long L;
        if (G != 256) L = (long)i * G + c;
        else if (c >= 248) { if (i >= 3) return false; L = (long)i * G + c; }
        else if (c >= 172 && c < 188 && i == 5) L = (long)(3 + (c - 172) / 8) * G + 248 + (c - 172) % 8;
        else L = (long)i * G + c;
        if (L >= total) return false;
        if (L < nctx) { u.pm = 64 + (int)L / nN; u.pn = (int)L % nN; return true; }
        int wgid = (int)L - nctx; { const int nwg = lat.nwg, q = nwg / NXCD, r = nwg % NXCD, xcd = wgid % NXCD, off = wgid / NXCD; wgid = (xcd < r ? xcd * (q + 1) : r * (q + 1) + (xcd - r) * q) + off; }
        const int nig = WGM * nN, gid = wgid / nig, fm = gid * WGM, gsz = (lat.nM - fm) < WGM ? (lat.nM - fm) : WGM;
        u.pm = fm + ((wgid % nig) % gsz); u.pn = (wgid % nig) / gsz; return true;
    }
    __device__ __forceinline__ void a_ready(const Unit&) const {}
    __device__ __forceinline__ void done(const Unit& u) const {
        if (u.pm >= 64) { asm volatile("s_waitcnt vmcnt(0)" ::: "memory"); __builtin_amdgcn_fence(__ATOMIC_RELEASE, "agent"); asm volatile("s_waitcnt vmcnt(0)" ::: "memory");
            if ((threadIdx.x & 63) == 0) __hip_atomic_fetch_add(cnt, 1u, __ATOMIC_RELAXED, __HIP_MEMORY_SCOPE_AGENT); }
    }
};
struct OneUnit {
    int pm, pn;
    __device__ bool next(int i, Unit& u) const { if (i != 0) return false; u.pm = pm; u.pn = pn; return true; }
    __device__ __forceinline__ void a_ready(const Unit&) const {}
    __device__ __forceinline__ void done(const Unit&) const {}
};

__device__ __forceinline__ unsigned cvt_pk_bf16(float lo, float hi) { unsigned r; asm volatile("v_cvt_pk_bf16_f32 %0, %1, %2" : "=v"(r) : "v"(lo), "v"(hi)); return r; }

struct EpiBf16 {
    static constexpr bool PERM = true, AFTER_DRAIN = false;
    bf16_t* O; int ldc;
    __device__ __forceinline__ void operator()(const f32x4 (&acc)[2][2][4][2], const Unit& u, int wr, int wc, int fr, int fq) const {
        const int row0 = u.pm * BM + wr * 64 + fr; const int col0 = u.pn * BM + wc * 32 + 8 * fq;
#pragma unroll
        for (int ai = 0; ai < 2; ++ai)
#pragma unroll
            for (int m = 0; m < 4; ++m) { bf16_t* rowp = O + (size_t)(row0 + ai * HALF + m * 16) * ldc + col0;
#pragma unroll
                for (int bj = 0; bj < 2; ++bj) { const f32x4 v0 = acc[ai][bj][m][0], v1 = acc[ai][bj][m][1];
                    u32x4 w; w.x = cvt_pk_bf16(v0[0], v0[1]); w.y = cvt_pk_bf16(v0[2], v0[3]); w.z = cvt_pk_bf16(v1[0], v1[1]); w.w = cvt_pk_bf16(v1[2], v1[3]);
                    *(u32x4*)(rowp + bj * HALF) = w; } }
    }
};
struct EpiF32 {
    static constexpr bool PERM = true, AFTER_DRAIN = false;
    float* O; int ldc;
    __device__ __forceinline__ void operator()(const f32x4 (&acc)[2][2][4][2], const Unit& u, int wr, int wc, int fr, int fq) const {
        const int row0 = u.pm * BM + wr * 64 + fr; const int col0 = u.pn * BM + wc * 32 + 8 * fq;
#pragma unroll
        for (int ai = 0; ai < 2; ++ai)
#pragma unroll
            for (int m = 0; m < 4; ++m) { float* rowp = O + (size_t)(row0 + ai * HALF + m * 16) * ldc + col0;
#pragma unroll
                for (int bj = 0; bj < 2; ++bj) { *(f32x4*)(rowp + bj * HALF) = acc[ai][bj][m][0]; *(f32x4*)(rowp + bj * HALF + 4) = acc[ai][bj][m][1]; } }
    }
};
__device__ __forceinline__ float silu_f(float x) { return x * __builtin_amdgcn_rcpf(1.0f + __expf(-x)); }
struct EpiSwiglu {
    static constexpr bool PERM = true, AFTER_DRAIN = false;
    bf16_t* O; int ldc;
    __device__ __forceinline__ void operator()(const f32x4 (&acc)[2][2][4][2], const Unit& u, int wr, int wc, int fr, int fq) const {
        const int row0 = u.pm * BM + wr * 64 + fr; const int col0 = u.pn * HALF + wc * 32 + 8 * fq;
#pragma unroll
        for (int ai = 0; ai < 2; ++ai)
#pragma unroll
            for (int m = 0; m < 4; ++m) { bf16_t* rowp = O + (size_t)(row0 + ai * HALF + m * 16) * ldc + col0;
                const f32x4 g0 = acc[ai][0][m][0], g1 = acc[ai][0][m][1], u0 = acc[ai][1][m][0], u1 = acc[ai][1][m][1];
                u32x4 w; w.x = cvt_pk_bf16(silu_f(g0[0]) * u0[0], silu_f(g0[1]) * u0[1]); w.y = cvt_pk_bf16(silu_f(g0[2]) * u0[2], silu_f(g0[3]) * u0[3]);
                w.z = cvt_pk_bf16(silu_f(g1[0]) * u1[0], silu_f(g1[1]) * u1[1]); w.w = cvt_pk_bf16(silu_f(g1[2]) * u1[2], silu_f(g1[3]) * u1[3]);
                *(u32x4*)rowp = w; }
    }
};

template <class Epi, class Sched, bool ALIGN_EPI = false, bool SP2 = false>
__device__ __forceinline__ void gemm_phase(PG8_LAS unsigned char* lds, const Gemm g, const Sched& S, const Epi& E, const int tid) {
    const int wid = __builtin_amdgcn_readfirstlane(tid >> 6), lane = tid & 63, wr = wid >> 2, wc = wid & 3, fr = lane & 15, fq = lane >> 4;
    const int K = g.K, nt = K / BK;
    unsigned voffA[2], voffB[2];
#pragma unroll
    for (int i = 0; i < 2; ++i) { int R, C; stage_rc(tid * 16 + i * 8192, R, C); const int Rb = Epi::PERM ? ((R & ~31) + perm32(R & 31)) : R;
        voffA[i] = (unsigned)(R * K + C) * 2u; voffB[i] = (unsigned)(Rb * K + C) * 2u; }
    const size_t kstep = (size_t)(BK * 2);
    const size_t hstep = (size_t)HALF * K * 2;
    const size_t tstep = 2 * hstep;
    const unsigned ldsw = (unsigned)wid * 1024u;
    const int aoff = lds_byte(wr * 64 + fr, fq * 8), boff = lds_byte(wc * 32 + fr, fq * 8);
#define PG8_SA(b, h) (((b) * 2 + (h)) * HTB)
#define PG8_SB(b, h) ((4 + (b) * 2 + (h)) * HTB)
#define PG8_STAGE(bufoff, gbase, voff) do { _Pragma("unroll") for (int _i = 0; _i < 2; ++_i) \
        __builtin_amdgcn_global_load_lds((const unsigned*)((const char*)(gbase) + (voff)[_i]), (PG8_LAS unsigned*)(lds + (bufoff) + ldsw + _i * 8192), 16, 0, 0); } while (0)
#define PG8_LDA(dst, b, h) do { _Pragma("unroll") for (int m = 0; m < 4; ++m) _Pragma("unroll") for (int k = 0; k < 2; ++k) dst[m][k] = *(const PG8_LAS bf16x8*)(lds + PG8_SA(b, h) + aoff + m * 2048 + k * 1024); } while (0)
#define PG8_LDB(dst, b, h) do { _Pragma("unroll") for (int n = 0; n < 2; ++n) _Pragma("unroll") for (int k = 0; k < 2; ++k) dst[n][k] = *(const PG8_LAS bf16x8*)(lds + PG8_SB(b, h) + boff + n * 2048 + k * 1024); } while (0)
#define PG8_MMA(ai, bj, At, Bt) do { __builtin_amdgcn_s_setprio(1); _Pragma("unroll") for (int m = 0; m < 4; ++m) _Pragma("unroll") for (int n = 0; n < 2; ++n) _Pragma("unroll") for (int k = 0; k < 2; ++k) \
        acc[ai][bj][m][n] = __builtin_amdgcn_mfma_f32_16x16x32_bf16(Bt[n][k], At[m][k], acc[ai][bj][m][n], 0, 0, 0); __builtin_amdgcn_s_setprio(0); } while (0)
#define PG8_WAIT_V(n) asm volatile("s_waitcnt vmcnt(" #n ")" ::: "memory")
#define PG8_WAIT_L(n) asm volatile("s_waitcnt lgkmcnt(" #n ")" ::: "memory")
#define PG8_BAR __builtin_amdgcn_s_barrier()
#define PG8_SCHED __builtin_amdgcn_sched_barrier(0)
    Unit cur, nxt; int ui = 0;
    if (!S.next(0, cur)) return;
    f32x4 acc[2][2][4][2];
#pragma unroll
    for (int a = 0; a < 2; ++a)
#pragma unroll
        for (int b = 0; b < 2; ++b)
#pragma unroll
            for (int m = 0; m < 4; ++m)
#pragma unroll
                for (int n = 0; n < 2; ++n) acc[a][b][m][n] = (f32x4){0.f, 0.f, 0.f, 0.f};
    bf16x8 At[4][2], B0[2][2], B1[2][2];
    const char* cA = (const char*)g.A + (size_t)cur.pm * tstep; const char* cB = (const char*)g.Bt + (size_t)cur.pn * tstep;
    S.a_ready(cur);
    if constexpr (SP2) {
        PG8_STAGE(PG8_SB(0, 0), cB, voffB); PG8_STAGE(PG8_SB(0, 1), cB + hstep, voffB); PG8_STAGE(PG8_SA(0, 0), cA, voffA); PG8_STAGE(PG8_SA(0, 1), cA + hstep, voffA);
        if (wr == 1) PG8_BAR;
        PG8_WAIT_V(2); PG8_BAR;
        PG8_STAGE(PG8_SB(1, 0), cB + kstep, voffB); PG8_STAGE(PG8_SA(1, 0), cA + kstep, voffA); PG8_STAGE(PG8_SB(1, 1), cB + hstep + kstep, voffB);
        PG8_WAIT_V(6); PG8_BAR;
    } else {
        PG8_STAGE(PG8_SB(0, 0), cB, voffB); PG8_STAGE(PG8_SA(0, 0), cA, voffA); PG8_STAGE(PG8_SB(0, 1), cB + hstep, voffB); PG8_STAGE(PG8_SA(0, 1), cA + hstep, voffA);
        if (wr == 1) PG8_BAR;
        PG8_WAIT_V(4); PG8_BAR;
        PG8_STAGE(PG8_SB(1, 0), cB + kstep, voffB); PG8_STAGE(PG8_SA(1, 0), cA + kstep, voffA); PG8_STAGE(PG8_SB(1, 1), cB + hstep + kstep, voffB);
        PG8_WAIT_V(6); PG8_BAR;
    }
    for (;;) {
        const bool has_next = S.next(ui + 1, nxt);
        const char* nA = has_next ? (const char*)g.A + (size_t)nxt.pm * tstep : cA; const char* nB = has_next ? (const char*)g.Bt + (size_t)nxt.pn * tstep : cB;
        for (int t = 0; t < nt; t += 2) {
            const bool last = (t == nt - 2);
            const char* a1 = cA + (size_t)(t + 1) * kstep;
            const char* a2 = last ? nA : cA + (size_t)(t + 2) * kstep; const char* b2 = last ? nB : cB + (size_t)(t + 2) * kstep;
            const char* a3 = a2 + kstep; const char* b3 = b2 + kstep;
            if (last && has_next) S.a_ready(nxt);
            if constexpr (SP2) {
            PG8_LDB(B0, 0, 0); PG8_LDB(B1, 0, 1); PG8_SCHED; PG8_LDA(At, 0, 0); PG8_STAGE(PG8_SA(1, 1), a1 + hstep, voffA);
            PG8_WAIT_V(8); PG8_WAIT_L(0); PG8_BAR; PG8_MMA(0, 0, At, B0); PG8_MMA(0, 1, At, B1); PG8_BAR; PG8_SCHED;
            PG8_LDA(At, 0, 1); PG8_STAGE(PG8_SB(0, 0), b2, voffB); PG8_STAGE(PG8_SB(0, 1), b2 + hstep, voffB); PG8_STAGE(PG8_SA(0, 0), a2, voffA);
            PG8_WAIT_V(8); PG8_WAIT_L(0); PG8_BAR; PG8_MMA(1, 0, At, B0); PG8_MMA(1, 1, At, B1); PG8_BAR; PG8_SCHED;
            PG8_LDB(B0, 1, 0); PG8_LDB(B1, 1, 1); PG8_SCHED; PG8_LDA(At, 1, 0); PG8_STAGE(PG8_SA(0, 1), a2 + hstep, voffA);
            PG8_WAIT_V(8); PG8_WAIT_L(0); PG8_BAR; PG8_MMA(0, 0, At, B0); PG8_MMA(0, 1, At, B1); PG8_BAR; PG8_SCHED;
            PG8_LDA(At, 1, 1); PG8_STAGE(PG8_SB(1, 0), b3, voffB); PG8_STAGE(PG8_SB(1, 1), b3 + hstep, voffB); PG8_STAGE(PG8_SA(1, 0), a3, voffA);
            PG8_WAIT_V(8); PG8_WAIT_L(0); PG8_BAR; PG8_MMA(1, 0, At, B0); PG8_MMA(1, 1, At, B1); PG8_BAR; PG8_SCHED;
            } else {
            PG8_LDB(B0, 0, 0); PG8_SCHED; PG8_LDA(At, 0, 0); PG8_STAGE(PG8_SA(1, 1), a1 + hstep, voffA);
            PG8_WAIT_L(8); PG8_BAR; PG8_WAIT_L(0); PG8_MMA(0, 0, At, B0); PG8_BAR; PG8_SCHED;
            PG8_LDB(B1, 0, 1); PG8_STAGE(PG8_SB(0, 0), b2, voffB);
            PG8_BAR; PG8_WAIT_L(0); PG8_MMA(0, 1, At, B1); PG8_BAR;
            PG8_LDA(At, 0, 1); PG8_STAGE(PG8_SA(0, 0), a2, voffA);
            PG8_BAR; PG8_WAIT_L(0); PG8_MMA(1, 0, At, B0); PG8_BAR; PG8_SCHED;
            PG8_STAGE(PG8_SB(0, 1), b2 + hstep, voffB);
            PG8_WAIT_V(6); PG8_BAR; PG8_MMA(1, 1, At, B1); PG8_BAR;
            PG8_LDB(B0, 1, 0); PG8_SCHED; PG8_LDA(At, 1, 0); PG8_STAGE(PG8_SA(0, 1), a2 + hstep, voffA);
            PG8_WAIT_L(8); PG8_BAR; PG8_WAIT_L(0); PG8_MMA(0, 0, At, B0); PG8_BAR; PG8_SCHED;
            PG8_LDB(B1, 1, 1); PG8_STAGE(PG8_SB(1, 0), b3, voffB);
            PG8_BAR; PG8_WAIT_L(0); PG8_MMA(0, 1, At, B1); PG8_BAR;
            PG8_LDA(At, 1, 1); PG8_STAGE(PG8_SA(1, 0), a3, voffA);
            PG8_BAR; PG8_WAIT_L(0); PG8_MMA(1, 0, At, B0); PG8_BAR; PG8_SCHED;
            PG8_STAGE(PG8_SB(1, 1), b3 + hstep, voffB);
            PG8_WAIT_V(6); PG8_BAR; PG8_MMA(1, 1, At, B1); PG8_BAR;
            }
        }
        if constexpr (ALIGN_EPI) { if (wr == 0) PG8_BAR; }
        if constexpr (!Epi::AFTER_DRAIN) { E(acc, cur, wr, wc, fr, fq); S.done(cur); }
        if (!has_next) break;
#pragma unroll
        for (int a = 0; a < 2; ++a)
#pragma unroll
            for (int b = 0; b < 2; ++b)
#pragma unroll
                for (int m = 0; m < 4; ++m)
#pragma unroll
                    for (int n = 0; n < 2; ++n) acc[a][b][m][n] = (f32x4){0.f, 0.f, 0.f, 0.f};
        cur = nxt; cA = nA; cB = nB; ++ui;
        if constexpr (ALIGN_EPI) { if (wr == 1) PG8_BAR; }
    }
    PG8_WAIT_V(0);
    if constexpr (!ALIGN_EPI) { if (wr == 0) PG8_BAR; }
    PG8_BAR;
#undef PG8_SA
#undef PG8_SB
#undef PG8_STAGE
#undef PG8_LDA
#undef PG8_LDB
#undef PG8_MMA
#undef PG8_WAIT_V
#undef PG8_WAIT_L
#undef PG8_BAR
#undef PG8_SCHED
}
}

constexpr int NWAVES = 8, NTHR = 512;
constexpr int DM = 1024, SEQ = 8192, NB = 2, CTX = 256, TL = NB * SEQ, TC = NB * CTX, TT = TL + TC;
constexpr int FFN = 2752, FFNP = 2816, NWI = 5632, INW = 2432, INWP = 2560, NMOD = 9;
constexpr int ZF = 0, ZQ = 256, ZK = 640, ZV = 768, ZRR = 896, ZRK = 1280, ZRV = 1664, ZW = 2048, ZA = 2176, ZG = 2304;
constexpr int RW = 384;
constexpr float NORM_EPS = 1e-6f, GN_EPS = 64e-5f;

constexpr size_t MiB = 1u << 20;
constexpr size_t WS_CTL = 0, WS_MOD = 1 * MiB, WS_ROPE = 2 * MiB, WS_XC = 4 * MiB, WS_GC = 6 * MiB;
constexpr size_t WS_WI1 = 8 * MiB, WS_WO1 = 19 * MiB, WS_WIN = 25 * MiB, WS_WOUT = 30 * MiB, WS_WI2 = 32 * MiB, WS_WO2 = 43 * MiB;
constexpr size_t WS_H = 49 * MiB;
constexpr size_t WS_ACT = 82 * MiB;
constexpr size_t WS_O = 173 * MiB;
constexpr size_t WS_W2T = WS_MOD + 256 * 1024, WS_A2T = WS_MOD + 512 * 1024, WS_G2T = WS_MOD + 768 * 1024;
constexpr size_t WS_LW = WS_O, WS_IC = WS_O + 25 * MiB;
constexpr size_t WS_GAM32 = 165 * MiB;
constexpr size_t WS_XB = 239 * MiB;
constexpr size_t OUT_FA = 0;
constexpr size_t OUT_SUM = 16 * MiB;
constexpr size_t WS_END = 272 * MiB;

constexpr size_t WS_FT = 7 * MiB;
constexpr size_t FT_W64C = 0, FT_W64S = 8192, FT_W128C = 16384, FT_W128S = 49152, FT_T64C = 81920, FT_T64S = 90112;
constexpr int LDS_BYTES = 147456;
constexpr int MISC_OFF = 146432;

typedef unsigned short bf16;
typedef float f32x4 __attribute__((ext_vector_type(4)));
typedef unsigned v4u __attribute__((ext_vector_type(4)));
typedef unsigned v2u __attribute__((ext_vector_type(2)));
#define LAS __attribute__((address_space(3)))
#define LDS_WAIT() asm volatile("s_waitcnt lgkmcnt(0)" ::: "memory")

__device__ __forceinline__ unsigned f2bf(float f) { unsigned u = __builtin_bit_cast(unsigned, f); return (u + 0x7fffu + ((u >> 16) & 1u)) >> 16; }
__device__ __forceinline__ unsigned pk2(float lo, float hi) { return f2bf(lo) | (f2bf(hi) << 16); }
__device__ __forceinline__ float bf2f(unsigned short u) { return __builtin_bit_cast(float, (unsigned)u << 16); }
__device__ __forceinline__ float bflo(unsigned u) { return __builtin_bit_cast(float, u << 16); }
__device__ __forceinline__ float bfhi(unsigned u) { return __builtin_bit_cast(float, u & 0xffff0000u); }
__device__ __forceinline__ void unpack8(const v4u w, float (&f)[8]) { f[0] = bflo(w.x); f[1] = bfhi(w.x); f[2] = bflo(w.y); f[3] = bfhi(w.y); f[4] = bflo(w.z); f[5] = bfhi(w.z); f[6] = bflo(w.w); f[7] = bfhi(w.w); }
template <int CTRL> __device__ __forceinline__ float dppx(float v) { return __builtin_bit_cast(float, __builtin_amdgcn_update_dpp(0, __builtin_bit_cast(int, v), CTRL, 0xf, 0xf, true)); }
__device__ __forceinline__ float sum8(float v) { v += dppx<0xB1>(v); v += dppx<0x4E>(v); v += dppx<0x141>(v); return v; }
__device__ __forceinline__ float sum16(float v) { v = sum8(v); v += dppx<0x140>(v); return v; }
__device__ __forceinline__ float xrow_sum(float v) {
    float a = v, b2 = v; asm volatile("s_nop 1\n\tv_permlane16_swap_b32 %0, %1" : "+v"(a), "+v"(b2)); v = a + b2;
    a = v; b2 = v; asm volatile("s_nop 1\n\tv_permlane32_swap_b32 %0, %1" : "+v"(a), "+v"(b2)); return a + b2; }
__device__ __forceinline__ float xrow_max(float v) {
    float a = v, b2 = v; asm volatile("s_nop 1\n\tv_permlane16_swap_b32 %0, %1" : "+v"(a), "+v"(b2)); v = fmaxf(a, b2);
    a = v; b2 = v; asm volatile("s_nop 1\n\tv_permlane32_swap_b32 %0, %1" : "+v"(a), "+v"(b2)); return fmaxf(a, b2); }
__device__ __forceinline__ float wave_sum(float v) { return xrow_sum(sum16(v)); }
__device__ __forceinline__ float wave_max(float v) {
#pragma unroll
    for (int o = 1; o < 64; o <<= 1) v = fmaxf(v, __shfl_xor(v, o));
    return v;
}

struct Args { const float* in[25]; float* out; unsigned char* ws; int ph_lo, ph_hi; };

struct Frame {
    LAS unsigned char* lds;
    int tid, lane, wave, G, bid;
    float* out; unsigned char* ws;
};
enum { I_X = 0, I_C, I_CTX, I_CCTX, I_MODW, I_MODB, I_NORMG, I_F1WI, I_F1WO, I_WIN, I_WOUT, I_SINK, I_CONV, I_W0, I_W2, I_A0, I_A2, I_G2, I_KK, I_KA, I_RK, I_LNG, I_LNB, I_F2WI, I_F2WO };

__device__ __forceinline__ const float* inp(int i) {
    const __attribute__((address_space(4))) char* p = (const __attribute__((address_space(4))) char*)__builtin_amdgcn_kernarg_segment_ptr();
    asm volatile("" : "+s"(p));
    return *(const float* const __attribute__((address_space(4)))*)(p + 8 * i);
}
struct CvtDesc { const float* W; bf16* WT; int ldw, k0, sc, Kd, n0d; bool valid, live; };
__device__ __forceinline__ void cvt_load(const CvtDesc& d, f32x4 (&v)[8], int lane) {
    const int c4 = lane & 7, r8 = lane >> 3;
#pragma unroll
    for (int i = 0; i < 8; ++i) v[i] = (d.live && d.valid) ? *(const f32x4*)(d.W + (size_t)(d.k0 + 8 * i + r8) * d.ldw + d.sc + 4 * c4) : (f32x4){0.f, 0.f, 0.f, 0.f};
}
__device__ __forceinline__ void cvt_finish(const CvtDesc& d, const f32x4 (&v)[8], LAS float* scr, int lane) {
    if (!d.live) return;
    const int c4 = lane & 7, r8 = lane >> 3;
#pragma unroll
    for (int i = 0; i < 8; ++i) *(LAS f32x4*)(scr + (8 * i + r8) * 36 + 4 * c4) = v[i];
    LDS_WAIT(); asm volatile("" ::: "memory");
    const int c = lane & 7;
#pragma unroll
    for (int j = 0; j < 4; ++j) { const int n = (lane >> 3) + 8 * j; const LAS float* s = scr + (8 * c) * 36 + n;
        v4u o; o.x = pk2(s[0 * 36], s[1 * 36]); o.y = pk2(s[2 * 36], s[3 * 36]); o.z = pk2(s[4 * 36], s[5 * 36]); o.w = pk2(s[6 * 36], s[7 * 36]);
        *(v4u*)(d.WT + (size_t)(d.n0d + n) * d.Kd + d.k0 + 8 * c) = o; }
    LDS_WAIT(); asm volatile("" ::: "memory");
}
__device__ __forceinline__ CvtDesc cvt_decode(Frame& F, int li, int set, int it) {
    constexpr int I_WI = 16 * (NWI / 32), I_WO = (FFNP / 64) * 32, I_IN = 16 * (INWP / 32), I_OUT = 16 * 32;
    constexpr int NITEMS = 2 * I_WI + 2 * I_WO + I_IN + I_OUT;
    CvtDesc d{}; d.live = it < NITEMS; if (!d.live) return d;
    int r = it;
    if (set) { const bool inA = r < I_WI || (r >= 2 * I_WI && r < 2 * I_WI + I_WO) || (r >= 2 * I_WI + 2 * I_WO && r < 2 * I_WI + 2 * I_WO + I_IN); if (inA != (set == 1)) { d.live = false; return d; } }
    if (r < 2 * I_WI) { const int f = r / I_WI; r -= f * I_WI; const int nblk = NWI / 32, kb = r / nblk, nb = r % nblk;
        const int n0 = 32 * nb, pn = n0 >> 8, i = n0 & 255; const int j = 128 * pn + (i & 127);
        d.W = (f ? inp(I_F2WI) : inp(I_F1WI)) + (size_t)li * DM * 2 * FFN; d.ldw = 2 * FFN; d.k0 = 64 * kb; d.sc = (i < 128) ? j : FFN + j; d.valid = j < FFN; d.WT = (bf16*)(F.ws + (f ? WS_WI2 : WS_WI1)); d.Kd = DM; d.n0d = n0; return d; }
    r -= 2 * I_WI;
    if (r < 2 * I_WO) { const int f = r / I_WO; r -= f * I_WO; const int kb = r / 32, nb = r % 32;
        d.W = (f ? inp(I_F2WO) : inp(I_F1WO)) + (size_t)li * FFN * DM; d.ldw = DM; d.k0 = 64 * kb; d.sc = 32 * nb; d.valid = 64 * kb < FFN; d.WT = (bf16*)(F.ws + (f ? WS_WO2 : WS_WO1)); d.Kd = FFNP; d.n0d = 32 * nb; return d; }
    r -= 2 * I_WO;
    if (r < I_IN) { const int nblk = INWP / 32, kb = r / nblk, nb = r % nblk;
        d.W = inp(I_WIN) + (size_t)li * DM * INW; d.ldw = INW; d.k0 = 64 * kb; d.sc = 32 * nb; d.valid = 32 * nb < INW; d.WT = (bf16*)(F.ws + WS_WIN); d.Kd = DM; d.n0d = 32 * nb; return d; }
    r -= I_IN;
    { const int kb = r / 32, nb = r % 32;
        d.W = inp(I_WOUT) + (size_t)li * DM * DM; d.ldw = DM; d.k0 = 64 * kb; d.sc = 32 * nb; d.valid = true; d.WT = (bf16*)(F.ws + WS_WOUT); d.Kd = DM; d.n0d = 32 * nb; return d; }
}
__device__ __forceinline__ void convert_weights(Frame& F, int li, int set = 0, int bid0 = 0, int nblk = 0) {
    if (nblk == 0) nblk = F.G;
    if (F.bid < bid0 || F.bid >= bid0 + nblk) return;
    LAS float* scr = (LAS float*)(F.lds + F.wave * 16384);
    const int gw = (F.bid - bid0) * NWAVES + F.wave, NGW = nblk * NWAVES;
    constexpr int NITEMS = 2 * 16 * (NWI / 32) + 2 * (FFNP / 64) * 32 + 16 * (INWP / 32) + 16 * 32;
    for (int it = gw; it < NITEMS; it += 2 * NGW) {
        const CvtDesc d0 = cvt_decode(F, li, set, it), d1 = cvt_decode(F, li, set, it + NGW);
        f32x4 v0[8], v1[8];
        cvt_load(d0, v0, F.lane); cvt_load(d1, v1, F.lane);
        cvt_finish(d0, v0, scr, F.lane); cvt_finish(d1, v1, scr, F.lane);
    }
}
__device__ __forceinline__ void mod_gemv(Frame& F) {
    LAS float* sc = (LAS float*)F.lds;
    LAS float* red = sc + 3 * 1024;
    __syncthreads();
    for (int i = F.tid; i < 3 * 1024; i += NTHR) { const int v = i >> 10, k = i & 1023; const float x = v < 2 ? inp(I_C)[v * 1024 + k] : inp(I_CCTX)[k]; sc[i] = x / (1.0f + __expf(-x)); }
    __syncthreads();
    float* modv = (float*)(F.ws + WS_MOD);
    for (int u = F.bid; u < 2 * 72; u += F.G) {
        const int l = u / 72, n0 = (u % 72) * 128;
        const float* w = inp(I_MODW) + (size_t)l * DM * 9216 + n0 + 2 * F.lane;
        float a0 = 0.f, a1 = 0.f, b0 = 0.f, b1 = 0.f, c0 = 0.f, c1 = 0.f;
        const int k0 = F.wave * 128;
#pragma unroll 8
        for (int k = 0; k < 128; ++k) { const float2 wv = *(const float2*)(w + (size_t)(k0 + k) * 9216); const float s0 = sc[k0 + k], s1 = sc[1024 + k0 + k], s2 = sc[2048 + k0 + k];
            a0 += s0 * wv.x; a1 += s0 * wv.y; b0 += s1 * wv.x; b1 += s1 * wv.y; c0 += s2 * wv.x; c1 += s2 * wv.y; }
        LAS float* rw = red + F.wave * 384 + 2 * F.lane;
        rw[0] = a0; rw[1] = a1; rw[128] = b0; rw[129] = b1; rw[256] = c0; rw[257] = c1;
        __syncthreads();
        if (F.tid < 384) { float s = 0.f;
#pragma unroll
            for (int w8 = 0; w8 < 8; ++w8) s += red[w8 * 384 + F.tid];
            const int v = F.tid >> 7, n = n0 + (F.tid & 127);
            modv[(size_t)(l * 3 + v) * 9216 + n] = s + inp(I_MODB)[l * 9216 + n]; }
        __syncthreads();
    }
}
__device__ __forceinline__ void rope_tables(Frame& F) {
    float* ct = (float*)(F.ws + WS_ROPE); float* st = ct + SEQ * 32;
    for (int i = F.bid * NTHR + F.tid; i < SEQ * 32; i += F.G * NTHR) {
        const int t = i >> 5, j = i & 31; const int f = j & 15;
        const float inv = exp2f(-(float)f * (13.287712379549449f / 16.0f));
        const float pos = (float)(j < 16 ? (t >> 6) : (t & 63));
        const float ang = pos * inv;
        const double a = (double)ang; const double k = __builtin_rint(a * 0.15915494309189535); const float r = (float)(a - k * 6.283185307179586);
        ct[i] = __cosf(r); st[i] = __sinf(r);
    }
}

struct EArgs { const float* xl_src; const float* xc_src; const bf16* xb_src; bf16* xb_dst; float* out32; const bf16* o; const float* modv_g; int gidx; float gmul; const float* gpost;
               bf16* hdst; const float* modv_h; int shidx, scidx; const float* gpre; int nrows; };
template <int R>
__device__ __forceinline__ void e_rows(Frame& F, const EArgs& A, int v, int r0) {
    f32x4 cg[4], ch[4], cs[4];
#pragma unroll
    for (int j = 0; j < 4; ++j) { const int c = F.lane + 64 * j;
        if (A.o) cg[j] = ((const f32x4*)(A.modv_g + (size_t)v * 9216 + A.gidx * DM))[c] * ((const f32x4*)A.gpost)[c] * A.gmul;
        if (A.hdst) { ch[j] = ((const f32x4*)A.gpre)[c] * (1.0f + ((const f32x4*)(A.modv_h + (size_t)v * 9216 + A.scidx * DM))[c]); cs[j] = ((const f32x4*)(A.modv_h + (size_t)v * 9216 + A.shidx * DM))[c]; } }
    f32x4 x[R][4]; v2u ow[R][4];
#pragma unroll
    for (int i = 0; i < R; ++i) { const int r = r0 + i;
        if (A.xb_src) { const v2u* xs = (const v2u*)(A.xb_src + (size_t)r * DM);
#pragma unroll
            for (int j = 0; j < 4; ++j) { const v2u w = xs[F.lane + 64 * j]; x[i][j] = (f32x4){bflo(w.x), bfhi(w.x), bflo(w.y), bfhi(w.y)}; } }
        else { const float* xs = r < TL ? A.xl_src + (size_t)r * DM : A.xc_src + (size_t)(r - TL) * DM;
#pragma unroll
            for (int j = 0; j < 4; ++j) x[i][j] = ((const f32x4*)xs)[F.lane + 64 * j]; }
        if (A.o) { const v2u* orow = (const v2u*)(A.o + (size_t)r * DM);
#pragma unroll
            for (int j = 0; j < 4; ++j) ow[i][j] = orow[F.lane + 64 * j]; } }
#pragma unroll
    for (int i = 0; i < R; ++i) { const int r = r0 + i;
        if (A.o) { f32x4 ov[4]; float ss = 0.f;
#pragma unroll
            for (int j = 0; j < 4; ++j) { const v2u w = ow[i][j]; ov[j] = (f32x4){bflo(w.x), bfhi(w.x), bflo(w.y), bfhi(w.y)}; ss += (ov[j].x * ov[j].x + ov[j].y * ov[j].y) + (ov[j].z * ov[j].z + ov[j].w * ov[j].w); }
            const float rstd = 1.0f / sqrtf(wave_sum(ss) * (1.0f / DM) + NORM_EPS);
#pragma unroll
            for (int j = 0; j < 4; ++j) x[i][j] = x[i][j] + cg[j] * (ov[j] * rstd);
            if (A.out32) {
#pragma unroll
                for (int j = 0; j < 4; ++j) ((f32x4*)(A.out32 + (size_t)r * DM))[F.lane + 64 * j] = x[i][j]; }
            else { v2u* xd = (v2u*)(A.xb_dst + (size_t)r * DM);
#pragma unroll
                for (int j = 0; j < 4; ++j) { v2u w; w.x = pk2(x[i][j].x, x[i][j].y); w.y = pk2(x[i][j].z, x[i][j].w); xd[F.lane + 64 * j] = w; } } }
        if (A.hdst) { float ss = 0.f;
#pragma unroll
            for (int j = 0; j < 4; ++j) ss += (x[i][j].x * x[i][j].x + x[i][j].y * x[i][j].y) + (x[i][j].z * x[i][j].z + x[i][j].w * x[i][j].w);
            const float rstd = 1.0f / sqrtf(wave_sum(ss) * (1.0f / DM) + NORM_EPS);
            v2u* hd = (v2u*)(A.hdst + (size_t)r * DM);
#pragma unroll
            for (int j = 0; j < 4; ++j) { const f32x4 hv = (x[i][j] * rstd) * ch[j] + cs[j]; v2u w; w.x = pk2(hv.x, hv.y); w.y = pk2(hv.z, hv.w); hd[F.lane + 64 * j] = w; } } }
}
__device__ __forceinline__ void e_phase(Frame& F, const EArgs& A) {
    const int gw = F.bid * NWAVES + F.wave, NGW = F.G * NWAVES;
    if (NGW == 2048) {
        const int b = gw >> 10, r0 = b * SEQ + (gw & 1023) * 8;
        e_rows<4>(F, A, b, r0); e_rows<4>(F, A, b, r0 + 4);
        if (A.nrows > TL && (gw & 3) == 0) e_rows<1>(F, A, 2, TL + (gw >> 2));
    } else { for (int r = gw; r < A.nrows; r += NGW) e_rows<1>(F, A, r < TL ? (r >> 13) : 2, r); }
}

__device__ __forceinline__ const bf16* zrow(const Frame& F, int row) { return (const bf16*)(F.ws + WS_ACT) + (size_t)row * INWP; }

__device__ __forceinline__ void fourier_ctx1_all(Frame& F) {
    float* gr = (float*)(F.ws + WS_GC); float* gi = gr + TC * 256;
    const bf16* wc = (const bf16*)(F.ws + WS_FT + FT_W64C); const bf16* wsn = (const bf16*)(F.ws + WS_FT + FT_W64S);
    for (int i = F.bid * NTHR + F.tid; i < TC * 256; i += F.G * NTHR) { const int tok = i >> 8, gm = i & 255, g = gm >> 6, m = gm & 63;
        const bf16* z = zrow(F, TL + tok) + ZF + 64 * g; float sr = 0.f, si = 0.f;
#pragma unroll
        for (int c8 = 0; c8 < 8; ++c8) { float x[8], cs[8], sn[8]; unpack8(*(const v4u*)(z + 8 * c8), x); unpack8(*(const v4u*)(wc + m * 64 + 8 * c8), cs); unpack8(*(const v4u*)(wsn + m * 64 + 8 * c8), sn);
#pragma unroll
            for (int e = 0; e < 8; ++e) { sr += x[e] * cs[e]; si -= x[e] * sn[e]; } }
        gr[i] = sr; gi[i] = si; }
}
__device__ __forceinline__ void fourier_ctx2_all(Frame& F) {
    const float* gr = (const float*)(F.ws + WS_GC); const float* gi = gr + TC * 256; bf16* mix = (bf16*)(F.ws + WS_H);
    for (int i = F.bid * NTHR + F.tid; i < TC * 256; i += F.G * NTHR) { const int row = i >> 8, gm = i & 255, b = row >> 8, k = row & 255; float y = 0.f;
#pragma unroll 8
        for (int n = 0; n < 256; ++n) { const float a = (float)((k * n) & 255) * (1.0f / 256.0f); y += gr[(b * 256 + n) * 256 + gm] * __builtin_amdgcn_cosf(a) + gi[(b * 256 + n) * 256 + gm] * __builtin_amdgcn_sinf(a); }
        mix[(size_t)(TL + row) * DM + gm] = (bf16)f2bf(y * 0.0078125f); }
}
typedef short bf16x8 __attribute__((ext_vector_type(8)));
#define MFMA16(a, b, c) __builtin_amdgcn_mfma_f32_16x16x32_bf16(a, b, c, 0, 0, 0)
__device__ __forceinline__ bf16x8 mk8(unsigned a, unsigned b, unsigned c, unsigned d) { const v4u v = {a, b, c, d}; return __builtin_bit_cast(bf16x8, v); }
typedef __bf16 bf16x2_t __attribute__((ext_vector_type(2)));
typedef float f32x2_t __attribute__((ext_vector_type(2)));
__device__ __forceinline__ unsigned cvtpk(float lo, float hi) { const f32x2_t f = {lo, hi}; return __builtin_bit_cast(unsigned, __builtin_convertvector(f, bf16x2_t)); }
constexpr int NSC = 66;
constexpr int IM_AI = 0, IM_RI = 4608, IM_BI = 9216, IM_KI = 13824, IM_BKT = 18432, IM_VT = 28928, IM_GAM = 34176, IMG_BYTES = 34816;
constexpr int L_IMG0 = 0, L_IMG1 = IMG_BYTES, L_PKG = 2 * IMG_BYTES, L_YL = L_PKG + 8192, L_VB = L_YL + 128 * 68 * 4, L_BON = L_VB + 128 * 64 * 2, L_CST = L_BON + 512, L_RW_END = L_CST + 2 * 3072;
static_assert(L_RW_END <= 146432, "rwkv LDS map");
constexpr size_t SUM_SLOT = 24576;

__device__ __forceinline__ void lora_transposes(Frame& F) {
    bf16* w2t = (bf16*)(F.ws + WS_W2T); bf16* a2t = (bf16*)(F.ws + WS_A2T); bf16* g2t = (bf16*)(F.ws + WS_G2T);
    const float* w2 = inp(I_W2); const float* a2 = inp(I_A2); const float* g2 = inp(I_G2);
    for (int i = F.bid * NTHR + F.tid; i < 4 * 384 * 64; i += F.G * NTHR) { const int r = i & 63, col = (i >> 6) % 384, ld = i / (384 * 64);
        w2t[i] = (bf16)f2bf(w2[((size_t)ld * 64 + r) * RW + col]); a2t[i] = (bf16)f2bf(a2[((size_t)ld * 64 + r) * RW + col]); }
    for (int i = F.bid * NTHR + F.tid; i < 2 * 384 * 128; i += F.G * NTHR) { const int r = i & 127, col = (i >> 7) % 384, l = i / (384 * 128);
        g2t[i] = (bf16)f2bf(g2[((size_t)l * 128 + r) * RW + col]); }
}

__device__ __forceinline__ float softplus_fast(float x) { return fmaxf(x, 0.f) + __logf(1.0f + __expf(-fabsf(x))); }
__device__ __forceinline__ float tanh_fast(float x) { return 1.0f - 2.0f * __builtin_amdgcn_rcpf(1.0f + __expf(2.0f * x)); }
template <int CTRL> __device__ __forceinline__ float dpp_f(float v) { return __builtin_bit_cast(float, __builtin_amdgcn_update_dpp(0, __builtin_bit_cast(int, v), CTRL, 0xf, 0xf, true)); }
__device__ __forceinline__ void lora_pass(Frame& F, int li) {
    const int q = F.lane >> 4, c16 = F.lane & 15;
#pragma unroll 1
    for (int dir = 0; dir < 2; ++dir) {
        bf16* LW = (bf16*)(F.ws + WS_LW) + (size_t)dir * TT * RW; bf16* IC = (bf16*)(F.ws + WS_IC) + (size_t)dir * TT * RW;
        const bf16* w2t = (const bf16*)(F.ws + WS_W2T) + (size_t)(li * 2 + dir) * 384 * 64; const bf16* a2t = (const bf16*)(F.ws + WS_A2T) + (size_t)(li * 2 + dir) * 384 * 64;
        bf16x8 aw[3][2], aa[3][2]; f32x4 w0v[3], a0v[3];
#pragma unroll
        for (int cti = 0; cti < 3; ++cti) { const int ct = 3 * F.wave + cti, col = 16 * ct + c16;
#pragma unroll
            for (int k = 0; k < 2; ++k) { aw[cti][k] = *(const bf16x8*)(w2t + (size_t)col * 64 + 32 * k + 8 * q); aa[cti][k] = *(const bf16x8*)(a2t + (size_t)col * 64 + 32 * k + 8 * q); }
            w0v[cti] = *(const f32x4*)(inp(I_W0) + (li * 2 + dir) * RW + 16 * ct + 4 * q); a0v[cti] = *(const f32x4*)(inp(I_A0) + (li * 2 + dir) * RW + 16 * ct + 4 * q); }
#pragma unroll 1
        for (int rt = F.bid; rt < TT / 16; rt += F.G) {
            const bf16* z = zrow(F, 16 * rt + c16);
            bf16x8 bw[2], ba[2];
#pragma unroll
            for (int k = 0; k < 2; ++k) { const v4u zw = *(const v4u*)(z + ZW + 64 * dir + 32 * k + 8 * q); ba[k] = *(const bf16x8*)(z + ZA + 64 * dir + 32 * k + 8 * q);
                bw[k] = mk8(cvtpk(tanh_fast(bflo(zw.x)), tanh_fast(bfhi(zw.x))), cvtpk(tanh_fast(bflo(zw.y)), tanh_fast(bfhi(zw.y))), cvtpk(tanh_fast(bflo(zw.z)), tanh_fast(bfhi(zw.z))), cvtpk(tanh_fast(bflo(zw.w)), tanh_fast(bfhi(zw.w)))); }
#pragma unroll
            for (int cti = 0; cti < 3; ++cti) { const int ct = 3 * F.wave + cti;
                f32x4 dw = {0.f, 0.f, 0.f, 0.f}, da = {0.f, 0.f, 0.f, 0.f};
#pragma unroll
                for (int k = 0; k < 2; ++k) { dw = MFMA16(aw[cti][k], bw[k], dw); da = MFMA16(aa[cti][k], ba[k], da); }
                float lw[4], ic[4];
#pragma unroll
                for (int e = 0; e < 4; ++e) { const float x = w0v[cti][e] + dw[e]; const float wl = -softplus_fast(-x) - 0.5f; lw[e] = -__expf(wl); ic[e] = __builtin_amdgcn_rcpf(1.0f + __expf(-(a0v[cti][e] + da[e]))); }
                if (dir == 0) {
#pragma unroll
                    for (int e = 0; e < 4; ++e) { lw[e] += dpp_f<0x111>(lw[e]); lw[e] += dpp_f<0x112>(lw[e]); lw[e] += dpp_f<0x114>(lw[e]); lw[e] += dpp_f<0x118>(lw[e]); } }
                else {
#pragma unroll
                    for (int e = 0; e < 4; ++e) { lw[e] += dpp_f<0x101>(lw[e]); lw[e] += dpp_f<0x102>(lw[e]); lw[e] += dpp_f<0x104>(lw[e]); lw[e] += dpp_f<0x108>(lw[e]); } }
#pragma unroll
                for (int e = 0; e < 4; ++e) lw[e] = __expf(lw[e]);
                if (c16 == (dir == 0 ? 15 : 0)) *(f32x4*)((float*)(F.ws + WS_GAM32) + ((size_t)dir * (TT / 16) + rt) * RW + 16 * ct + 4 * q) = (f32x4){lw[0], lw[1], lw[2], lw[3]};
                const size_t o = (size_t)(16 * rt + c16) * RW + 16 * ct + 4 * q;
                v2u w; w.x = cvtpk(lw[0], lw[1]); w.y = cvtpk(lw[2], lw[3]); *(v2u*)(LW + o) = w; w.x = cvtpk(ic[0], ic[1]); w.y = cvtpk(ic[2], ic[3]); *(v2u*)(IC + o) = w; }
        }
    }
}
__device__ __forceinline__ void chain_consts_lds(Frame& F, LAS float* cst, int li, int h, int t256) {
    for (int i = t256; i < 12 * 64; i += 256) { const int k = i >> 6, j = i & 63, ch = 64 * h + j; float v;
        if (k == 0) v = inp(I_KK)[li * RW + ch]; else if (k == 1) v = inp(I_KA)[li * RW + ch]; else if (k == 2) v = inp(I_RK)[li * RW + ch];
        else { const int tt = (k - 3) / 3, w = (k - 3) % 3; v = inp(I_CONV)[(size_t)(li * 3 + tt) * (3 * RW) + w * RW + ch]; }
        cst[i] = v; }
}
struct PrepRaw { v4u ecw, icv, epw, zr[3], zk[3], zv[3]; f32x4 g0, g1; };
__device__ __forceinline__ void prep_load(Frame& F, PrepRaw& R, int dir, int b, int h, int tl, int o, bool isctx, int step0) {
    const int L = isctx ? CTX : SEQ, rbase = isctx ? TL + b * CTX : b * SEQ, ch0 = 64 * h + 8 * o;
    const int s = step0 + tl; const int p = dir ? L - 1 - s : s; const int row = rbase + p, tb = tl & 15;
    { const bf16* LW = (const bf16*)(F.ws + WS_LW) + (size_t)dir * TT * RW + ch0; const bf16* IC = (const bf16*)(F.ws + WS_IC) + (size_t)dir * TT * RW + ch0;
      R.ecw = *(const v4u*)(LW + (size_t)row * RW); R.icv = *(const v4u*)(IC + (size_t)row * RW); R.epw = *(const v4u*)(LW + (size_t)(tb == 0 ? row : (dir ? row + 1 : row - 1)) * RW); }
#pragma unroll
    for (int tt = 0; tt < 3; ++tt) { const int pp = p + tt - 1; const bool ok = pp >= 0 && pp < L; const bf16* z = zrow(F, rbase + (ok ? pp : p)) + ch0;
        const v4u z0 = {0u, 0u, 0u, 0u};
        R.zr[tt] = ok ? *(const v4u*)(z + ZRR) : z0; R.zk[tt] = ok ? *(const v4u*)(z + ZRK) : z0; R.zv[tt] = ok ? *(const v4u*)(z + ZRV) : z0; }
    if (tb == 15) { const f32x4* gs = (const f32x4*)((const float*)(F.ws + WS_GAM32) + ((size_t)dir * (TT / 16) + (row >> 4)) * RW + ch0); R.g0 = gs[0]; R.g1 = gs[1]; }
}
__device__ __forceinline__ void prep_compute(Frame& F, const PrepRaw& R, const LAS float* cst, LAS unsigned char* img, int dir, int b, int h, int tl, int o, bool isctx, int step0, LAS unsigned char* lds_vb, LAS float* lds_bon, int pos0_local) {
    const bool BONUS = lds_vb != nullptr;
    const int L = isctx ? CTX : SEQ, rbase = isctx ? TL + b * CTX : b * SEQ, ch0 = 64 * h + 8 * o;
    const int blk = tl >> 4, tb = tl & 15;
    const int s = step0 + tl; const int p = dir ? L - 1 - s : s; const int row = rbase + p;
    const v4u ecw = R.ecw, icv = R.icv, epw = R.epw;
    v4u zr[3], zk[3], zv[3];
#pragma unroll
    for (int tt = 0; tt < 3; ++tt) { zr[tt] = R.zr[tt]; zk[tt] = R.zk[tt]; zv[tt] = R.zv[tt]; }
    float ecf[8], epf[8], ai[8], rv[8], kv[8], vv[8];
    unpack8(ecw, ecf); unpack8(epw, epf); unpack8(icv, ai);
#pragma unroll
    for (int e = 0; e < 8; ++e) { rv[e] = 0.f; kv[e] = 0.f; vv[e] = 0.f; }
#pragma unroll
    for (int tt = 0; tt < 3; ++tt) { float a[8], bq[8], cq[8]; unpack8(zr[tt], a); unpack8(zk[tt], bq); unpack8(zv[tt], cq);
        const LAS f32x4* w0 = (const LAS f32x4*)(cst + (3 + tt * 3 + 0) * 64 + 8 * o); const LAS f32x4* w1 = (const LAS f32x4*)(cst + (3 + tt * 3 + 1) * 64 + 8 * o); const LAS f32x4* w2 = (const LAS f32x4*)(cst + (3 + tt * 3 + 2) * 64 + 8 * o);
        const f32x4 w0a = w0[0], w0b = w0[1], w1a = w1[0], w1b = w1[1], w2a = w2[0], w2b = w2[1];
#pragma unroll
        for (int e = 0; e < 4; ++e) { rv[e] += w0a[e] * a[e]; rv[e + 4] += w0b[e] * a[e + 4]; kv[e] += w1a[e] * bq[e]; kv[e + 4] += w1b[e] * bq[e + 4]; vv[e] += w2a[e] * cq[e]; vv[e + 4] += w2b[e] * cq[e + 4]; } }
    float kkw[8], kaw[8];
    { const LAS f32x4* a = (const LAS f32x4*)(cst + 0 * 64 + 8 * o); const LAS f32x4* bq = (const LAS f32x4*)(cst + 1 * 64 + 8 * o); const f32x4 a0 = a[0], a1 = a[1], b0 = bq[0], b1 = bq[1];
#pragma unroll
      for (int e = 0; e < 4; ++e) { kkw[e] = a0[e]; kkw[e + 4] = a1[e]; kaw[e] = b0[e]; kaw[e + 4] = b1[e]; } }
    float kkr[8], ss = 0.f;
#pragma unroll
    for (int e = 0; e < 8; ++e) { kkr[e] = kv[e] * kkw[e]; ss += kkr[e] * kkr[e]; }
    ss = sum8(ss);
    const float rn = 1.0f / sqrtf(fmaxf(ss, 1e-24f));
    float At[8], Rt[8], Bt[8], Kt[8];
#pragma unroll
    for (int e = 0; e < 8; ++e) { const float kk = kkr[e] * rn, kd = kv[e] * (1.0f + (ai[e] - 1.0f) * kaw[e]); const float eprev = tb == 0 ? 1.0f : epf[e]; const float ec = ecf[e], en = 1.0f / ec;
        At[e] = -kk * eprev; Rt[e] = rv[e] * ec; Bt[e] = kk * ai[e] * en; Kt[e] = kd * en; }
    const int P0 = 32 * (o >> 2) + 16 * (o & 1) + 4 * ((o >> 1) & 1);
    LAS bf16* AI = (LAS bf16*)(img + IM_AI) + blk * 1152 + tb * 72 + P0, *RI = (LAS bf16*)(img + IM_RI) + blk * 1152 + tb * 72 + P0, *BI = (LAS bf16*)(img + IM_BI) + blk * 1152 + tb * 72 + P0, *KI = (LAS bf16*)(img + IM_KI) + blk * 1152 + tb * 72 + P0;
    unsigned bp[4], kp[4];
#pragma unroll
    for (int e = 0; e < 4; ++e) { bp[e] = cvtpk(Bt[2 * e], Bt[2 * e + 1]); kp[e] = cvtpk(Kt[2 * e], Kt[2 * e + 1]); }
    *(LAS v2u*)AI = (v2u){cvtpk(At[0], At[1]), cvtpk(At[2], At[3])}; *(LAS v2u*)(AI + 8) = (v2u){cvtpk(At[4], At[5]), cvtpk(At[6], At[7])};
    *(LAS v2u*)RI = (v2u){cvtpk(Rt[0], Rt[1]), cvtpk(Rt[2], Rt[3])}; *(LAS v2u*)(RI + 8) = (v2u){cvtpk(Rt[4], Rt[5]), cvtpk(Rt[6], Rt[7])};
    *(LAS v2u*)BI = (v2u){bp[0], bp[1]}; *(LAS v2u*)(BI + 8) = (v2u){bp[2], bp[3]};
    *(LAS v2u*)KI = (v2u){kp[0], kp[1]}; *(LAS v2u*)(KI + 8) = (v2u){kp[2], kp[3]};
    LAS bf16* BKT = (LAS bf16*)(img + IM_BKT) + blk * 2624 + (8 * o) * 40 + o * 8 + (tb >> 2) * 8 + (tb & 3); LAS bf16* VT = (LAS bf16*)(img + IM_VT) + blk * 1312 + (8 * o) * 20 + o * 4 + tb;
    const unsigned vp[4] = {cvtpk(vv[0], vv[1]), cvtpk(vv[2], vv[3]), cvtpk(vv[4], vv[5]), cvtpk(vv[6], vv[7])};
#pragma unroll
    for (int e = 0; e < 8; ++e) { const unsigned bb = bp[e >> 1], kq = kp[e >> 1], vq = vp[e >> 1];
        BKT[e * 40] = (bf16)((e & 1) ? (bb >> 16) : (bb & 0xffff)); BKT[e * 40 + 4] = (bf16)((e & 1) ? (kq >> 16) : (kq & 0xffff)); VT[e * 20] = (bf16)((e & 1) ? (vq >> 16) : (vq & 0xffff)); }
    if (tb == 15) { LAS f32x4* G = (LAS f32x4*)((LAS float*)(img + IM_GAM) + blk * 64 + 8 * o); G[0] = R.g0; G[1] = R.g1; }
    if (BONUS) { float bs = 0.f; const LAS f32x4* rk = (const LAS f32x4*)(cst + 2 * 64 + 8 * o); const f32x4 r0 = rk[0], r1 = rk[1];
#pragma unroll
        for (int e = 0; e < 4; ++e) bs += rv[e] * kv[e] * r0[e] + rv[e + 4] * kv[e + 4] * r1[e];
        bs = sum8(bs);
        const int pl = dir ? pos0_local - tl : pos0_local + tl;
        *(LAS v4u*)(lds_vb + (pl * 64 + 8 * o) * 2) = (v4u){vp[0], vp[1], vp[2], vp[3]}; if (o == 0) lds_bon[pl] = bs; }
}
template <bool WANT_Y>
__device__ __forceinline__ void block_package(LAS unsigned char* img, int blk, LAS unsigned* pkg, int lane) {
    const int q = lane >> 4, c = lane & 15;
    f32x4 mab = {0.f, 0.f, 0.f, 0.f}, mak = mab, mbr = mab, mkr = mab;
#pragma unroll
    for (int k = 0; k < 2; ++k) { const int o = blk * 2304 + c * 144 + k * 64 + q * 16;
        const bf16x8 bi = *(const LAS bf16x8*)(img + IM_BI + o), ki = *(const LAS bf16x8*)(img + IM_KI + o), ai = *(const LAS bf16x8*)(img + IM_AI + o);
        mab = MFMA16(bi, ai, mab); mak = MFMA16(ki, ai, mak);
        if constexpr (WANT_Y) { const bf16x8 ri = *(const LAS bf16x8*)(img + IM_RI + o); mbr = MFMA16(bi, ri, mbr); mkr = MFMA16(ki, ri, mkr); } }
#pragma unroll
    for (int e = 0; e < 4; ++e) { const int s = 4 * q + e; if (!(s < c)) { mab[e] = 0.f; mak[e] = 0.f; } if (!(s <= c)) { mbr[e] = 0.f; mkr[e] = 0.f; } }
    f32x4 mabT = {0.f, 0.f, 0.f, 0.f};
#pragma unroll
    for (int k = 0; k < 2; ++k) { const int o = blk * 2304 + c * 144 + k * 64 + q * 16; mabT = MFMA16(*(const LAS bf16x8*)(img + IM_AI + o), *(const LAS bf16x8*)(img + IM_BI + o), mabT); }
#pragma unroll
    for (int e = 0; e < 4; ++e) if (!(c < 4 * q + e)) mabT[e] = 0.f;
    const f32x4 z4 = {0.f, 0.f, 0.f, 0.f};
#define OPND(x) mk8(cvtpk((x)[0], (x)[1]), cvtpk((x)[2], (x)[3]), 0u, 0u)
    const bf16x8 oM = OPND(mab), oMT = OPND(mabT);
    const f32x4 m2 = MFMA16(oMT, oM, z4), m2T = MFMA16(oM, oMT, z4);
    const bf16x8 oM2 = OPND(m2), oM2T = OPND(m2T);
    const f32x4 m4 = MFMA16(oM2T, oM2, z4), m4T = MFMA16(oM2, oM2T, z4);
    const f32x4 m8T = MFMA16(OPND(m4), OPND(m4T), z4);
    f32x4 nn = m2;
#pragma unroll
    for (int e = 0; e < 4; ++e) nn[e] += (4 * q + e == c) ? 1.0f : 0.0f;
    nn = MFMA16(oMT, OPND(nn), nn);
    nn = MFMA16(OPND(m4T), OPND(nn), nn);
    nn = MFMA16(OPND(m8T), OPND(nn), nn);
#undef OPND
    pkg[0 * 64 + lane] = cvtpk(nn[0], nn[1]); pkg[1 * 64 + lane] = cvtpk(nn[2], nn[3]);
    pkg[2 * 64 + lane] = cvtpk(mak[0], mak[1]); pkg[3 * 64 + lane] = cvtpk(mak[2], mak[3]);
    if constexpr (WANT_Y) { pkg[4 * 64 + lane] = cvtpk(mbr[0], mbr[1]); pkg[5 * 64 + lane] = cvtpk(mbr[2], mbr[3]); pkg[6 * 64 + lane] = cvtpk(mkr[0], mkr[1]); pkg[7 * 64 + lane] = cvtpk(mkr[2], mkr[3]); }
}
template <bool WANT_Y, bool HAS_V>
__device__ __forceinline__ f32x4 block_scan(LAS unsigned char* img, int blk, const LAS unsigned* pkg, f32x4 (&S)[4], int wq, int lane) {
    const int q = lane >> 4, c = lane & 15;
    bf16x8 Sb[2];
#pragma unroll
    for (int k = 0; k < 2; ++k) Sb[k] = mk8(cvtpk(S[2 * k][0], S[2 * k][1]), cvtpk(S[2 * k][2], S[2 * k][3]), cvtpk(S[2 * k + 1][0], S[2 * k + 1][1]), cvtpk(S[2 * k + 1][2], S[2 * k + 1][3]));
    v2u vpk = {0u, 0u};
    if constexpr (HAS_V) vpk = *(const LAS v2u*)(img + IM_VT + blk * 2624 + (c + 16 * wq) * 40 + ((c + 16 * wq) >> 3) * 8 + q * 8);
    const int ao = blk * 2304 + c * 144 + q * 16;
    f32x4 rhs = {0.f, 0.f, 0.f, 0.f};
    rhs = MFMA16(*(const LAS bf16x8*)(img + IM_AI + ao), Sb[0], rhs); rhs = MFMA16(*(const LAS bf16x8*)(img + IM_AI + ao + 64), Sb[1], rhs);
    if constexpr (HAS_V) rhs = MFMA16(mk8(0u, 0u, pkg[2 * 64 + lane], pkg[3 * 64 + lane]), mk8(0u, 0u, vpk.x, vpk.y), rhs);
    f32x4 u = {0.f, 0.f, 0.f, 0.f};
    u = MFMA16(mk8(pkg[0 * 64 + lane], pkg[1 * 64 + lane], 0u, 0u), mk8(cvtpk(rhs[0], rhs[1]), cvtpk(rhs[2], rhs[3]), 0u, 0u), u);
    const bf16x8 UV = mk8(cvtpk(u[0], u[1]), cvtpk(u[2], u[3]), vpk.x, vpk.y);
    f32x4 y = {0.f, 0.f, 0.f, 0.f};
    if constexpr (WANT_Y) { y = MFMA16(*(const LAS bf16x8*)(img + IM_RI + ao), Sb[0], y); y = MFMA16(*(const LAS bf16x8*)(img + IM_RI + ao + 64), Sb[1], y);
        y = MFMA16(mk8(pkg[4 * 64 + lane], pkg[5 * 64 + lane], pkg[6 * 64 + lane], pkg[7 * 64 + lane]), UV, y); }
#pragma unroll
    for (int T = 0; T < 4; ++T) { const bf16x8 bkt = *(const LAS bf16x8*)(img + IM_BKT + blk * 5248 + (16 * T + c) * 80 + ((16 * T + c) >> 3) * 16 + q * 16);
        S[T] = MFMA16(bkt, UV, S[T]); const f32x4 g = *(const LAS f32x4*)(img + IM_GAM + blk * 256 + (16 * T + 4 * q) * 4); S[T] = S[T] * g; }
    return y;
}
__device__ __forceinline__ unsigned char* sum_slot(Frame& F, int chain, int sc) { return (unsigned char*)F.out + OUT_SUM + (size_t)(chain * NSC + sc) * SUM_SLOT; }

__device__ __forceinline__ void rwkv_pass1_pair(Frame& F, int li, int pair) {
    const int g = F.wave >> 2, wq = F.wave & 3, u = 2 * pair + g;
    const int chain = u / (NSC - 1), sc = u % (NSC - 1);
    const int dir = chain / 12, b = (chain / 6) & 1, h = chain % 6;
    const bool isctx = sc < 2; const int scl = isctx ? sc : sc - 2;
    LAS unsigned char* img = F.lds + (g ? L_IMG1 : L_IMG0); LAS unsigned* pkg = (LAS unsigned*)(F.lds + L_PKG) + g * 1024;
    LAS float* cst = (LAS float*)(F.lds + L_CST) + g * 768;
    __syncthreads();
    chain_consts_lds(F, cst, li, h, F.tid & 255);
    const int q = F.lane >> 4, c = F.lane & 15;
    f32x4 SB[4], SA[4];
#pragma unroll
    for (int T = 0; T < 4; ++T)
#pragma unroll
        for (int e = 0; e < 4; ++e) { SB[T][e] = 0.0f; SA[T][e] = (16 * T + 4 * q + e == c + 16 * wq) ? 1.0f : 0.0f; }
    PrepRaw R;
    prep_load(F, R, dir, b, h, 8 * wq + (F.lane >> 3), F.lane & 7, isctx, 128 * scl);
#pragma unroll 1
    for (int rd = 0; rd < 4; ++rd) {
        __syncthreads();
        prep_compute(F, R, cst, img, dir, b, h, 8 * wq + (F.lane >> 3), F.lane & 7, isctx, 128 * scl + 32 * rd, nullptr, nullptr, 0);
        __syncthreads();
        if (rd < 3) prep_load(F, R, dir, b, h, 8 * wq + (F.lane >> 3), F.lane & 7, isctx, 128 * scl + 32 * (rd + 1));
        if (wq < 2) block_package<false>(img, wq, pkg + wq * 512, F.lane);
        __syncthreads();
#pragma unroll
        for (int blk = 0; blk < 2; ++blk) { block_scan<false, true>(img, blk, pkg + blk * 512, SB, wq, F.lane); block_scan<false, false>(img, blk, pkg + blk * 512, SA, wq, F.lane); }
    }
    unsigned char* slot = sum_slot(F, chain, sc);
    { f32x4* braw = (f32x4*)slot;
#pragma unroll
      for (int T = 0; T < 4; ++T) braw[(wq * 4 + T) * 64 + F.lane] = SB[T]; }
    { bf16* aim = (bf16*)(slot + 16384); const int kap = wq >> 1, e = (F.lane & 3) + 4 * (wq & 1), qc = c >> 2;
#pragma unroll
      for (int T = 0; T < 4; ++T)
#pragma unroll
          for (int r = 0; r < 4; ++r) { const int lc = (4 * q + r) + 16 * qc; aim[((T * 2 + kap) * 64 + lc) * 8 + e] = (bf16)f2bf(SA[T][r]); } }
}
struct P2Buf { f32x4 Bc[4]; bf16x8 af[4][2]; };
__device__ __forceinline__ void p2_load(Frame& F, P2Buf& X, int chain, int sc, int wq) {
    unsigned char* slot = sum_slot(F, chain, sc); const f32x4* braw = (const f32x4*)slot; const bf16* aim = (const bf16*)(slot + 16384);
#pragma unroll
    for (int T = 0; T < 4; ++T) { X.Bc[T] = braw[(wq * 4 + T) * 64 + F.lane];
#pragma unroll
        for (int k = 0; k < 2; ++k) X.af[T][k] = *(const bf16x8*)(aim + ((T * 2 + k) * 64 + F.lane) * 8); }
}
__device__ __forceinline__ void p2_step(Frame& F, const P2Buf& X, f32x4 (&S)[4], int chain, int sc, int wq) {
    f32x4* braw = (f32x4*)sum_slot(F, chain, sc);
    bf16x8 Sb[2];
#pragma unroll
    for (int k = 0; k < 2; ++k) Sb[k] = mk8(cvtpk(S[2 * k][0], S[2 * k][1]), cvtpk(S[2 * k][2], S[2 * k][3]), cvtpk(S[2 * k + 1][0], S[2 * k + 1][1]), cvtpk(S[2 * k + 1][2], S[2 * k + 1][3]));
#pragma unroll
    for (int T = 0; T < 4; ++T) { braw[(wq * 4 + T) * 64 + F.lane] = S[T]; const f32x4 a = MFMA16(X.af[T][0], Sb[0], X.Bc[T]); S[T] = MFMA16(X.af[T][1], Sb[1], a); }
}
__device__ __forceinline__ void rwkv_pass2_chain(Frame& F, int chain) {
    if (F.wave >= 4) return;
    const int wq = F.wave; constexpr int NS = NSC - 1;
    f32x4 S[4];
#pragma unroll
    for (int T = 0; T < 4; ++T) S[T] = (f32x4){0.f, 0.f, 0.f, 0.f};
    P2Buf X0, X1, X2;
    p2_load(F, X0, chain, 0, wq); p2_load(F, X1, chain, 1, wq); p2_load(F, X2, chain, 2, wq);
#pragma unroll 1
    for (int sc = 0; sc < NS; sc += 3) {
        p2_step(F, X0, S, chain, sc, wq); if (sc + 3 < NS) p2_load(F, X0, chain, sc + 3, wq);
        if (sc + 1 < NS) { p2_step(F, X1, S, chain, sc + 1, wq); if (sc + 4 < NS) p2_load(F, X1, chain, sc + 4, wq); }
        if (sc + 2 < NS) { p2_step(F, X2, S, chain, sc + 2, wq); if (sc + 5 < NS) p2_load(F, X2, chain, sc + 5, wq); }
    }
    { f32x4* braw = (f32x4*)sum_slot(F, chain, NSC - 1);
#pragma unroll
      for (int T = 0; T < 4; ++T) braw[(wq * 4 + T) * 64 + F.lane] = S[T]; }
}
__device__ __forceinline__ void rwkv_pass3_unit(Frame& F, int li, int u) {
    const int pc = u % NSC, bh = u / NSC, b = bh / 6, h = bh % 6;
    const bool isctx = pc < 2; const int pcl = isctx ? pc : pc - 2, nsc = isctx ? 2 : 64;
    const int dir = F.wave >> 2, wq = F.wave & 3, q = F.lane >> 4, c = F.lane & 15;
    const int sc = dir == 0 ? pc : (isctx ? 1 - pcl : 2 + 63 - pcl);
    const int scl = dir == 0 ? pcl : nsc - 1 - pcl;
    const int chain = dir * 12 + b * 6 + h;
    LAS unsigned char* img = F.lds + (dir ? L_IMG1 : L_IMG0); LAS unsigned* pkg = (LAS unsigned*)(F.lds + L_PKG) + dir * 1024;
    LAS float* YL = (LAS float*)(F.lds + L_YL); LAS unsigned char* VB = F.lds + L_VB; LAS float* BON = (LAS float*)(F.lds + L_BON);
    LAS float* cst = (LAS float*)(F.lds + L_CST);
    __syncthreads();
    if (F.tid < 256) chain_consts_lds(F, cst, li, h, F.tid);
    f32x4 S[4];
    { const f32x4* braw = (const f32x4*)sum_slot(F, chain, sc);
#pragma unroll
      for (int T = 0; T < 4; ++T) S[T] = braw[(wq * 4 + T) * 64 + F.lane]; }
    __syncthreads();
    for (int i = F.tid; i < 128 * 68; i += NTHR) YL[i] = 0.f;
    PrepRaw R;
    prep_load(F, R, dir, b, h, 8 * wq + (F.lane >> 3), F.lane & 7, isctx, 128 * scl);
#pragma unroll 1
    for (int rd = 0; rd < 4; ++rd) {
        __syncthreads();
        prep_compute(F, R, cst, img, dir, b, h, 8 * wq + (F.lane >> 3), F.lane & 7, isctx, 128 * scl + 32 * rd, dir == 0 ? VB : (LAS unsigned char*)nullptr, BON, 32 * rd);
        __syncthreads();
        if (rd < 3) prep_load(F, R, dir, b, h, 8 * wq + (F.lane >> 3), F.lane & 7, isctx, 128 * scl + 32 * (rd + 1));
        if (wq < 2) block_package<true>(img, wq, pkg + wq * 512, F.lane);
        __syncthreads();
#pragma unroll
        for (int blk = 0; blk < 2; ++blk) { const f32x4 y = block_scan<true, true>(img, blk, pkg + blk * 512, S, wq, F.lane);
#pragma unroll
            for (int e = 0; e < 4; ++e) { const int t = 32 * rd + 16 * blk + 4 * q + e; const int pl = dir ? 127 - t : t; YL[pl * 68 + c + 16 * wq] += y[e]; } }
    }
    __syncthreads();
    const int wv = F.wave; const int rbase = (isctx ? TL + b * CTX : b * SEQ) + 128 * pcl;
    const bf16* g2t = (const bf16*)(F.ws + WS_G2T) + (size_t)li * 384 * 128;
    f32x4 gate[4];
#pragma unroll
    for (int nt = 0; nt < 4; ++nt) gate[nt] = (f32x4){0.f, 0.f, 0.f, 0.f};
#pragma unroll
    for (int k = 0; k < 4; ++k) { const v4u zg = *(const v4u*)(zrow(F, rbase + 16 * wv + c) + ZG + 32 * k + 8 * q);
#define SG(x) (1.0f / (1.0f + __expf(-(x))))
        const bf16x8 a = mk8(pk2(SG(bflo(zg.x)), SG(bfhi(zg.x))), pk2(SG(bflo(zg.y)), SG(bfhi(zg.y))), pk2(SG(bflo(zg.z)), SG(bfhi(zg.z))), pk2(SG(bflo(zg.w)), SG(bfhi(zg.w))));
#undef SG
#pragma unroll
        for (int nt = 0; nt < 4; ++nt) { const bf16x8 bb = *(const bf16x8*)(g2t + (size_t)(64 * h + 16 * nt + c) * 128 + 32 * k + 8 * q); gate[nt] = MFMA16(a, bb, gate[nt]); } }
    bf16* mix = (bf16*)(F.ws + WS_H);
    float lg[4], lb[4];
#pragma unroll
    for (int nt = 0; nt < 4; ++nt) { lg[nt] = inp(I_LNG)[li * RW + 64 * h + 16 * nt + c]; lb[nt] = inp(I_LNB)[li * RW + 64 * h + 16 * nt + c]; }
#pragma unroll
    for (int e = 0; e < 4; ++e) { const int tl = 16 * wv + 4 * q + e;
        float yv[4], s = 0.f;
#pragma unroll
        for (int nt = 0; nt < 4; ++nt) { yv[nt] = YL[tl * 68 + 16 * nt + c]; s += yv[nt]; }
        s = sum16(s);
        const float mu = s * (1.0f / 64.0f); float v2 = 0.f;
#pragma unroll
        for (int nt = 0; nt < 4; ++nt) { yv[nt] -= mu; v2 += yv[nt] * yv[nt]; }
        v2 = sum16(v2);
        const float rs = 1.0f / sqrtf(v2 * (1.0f / 64.0f) + GN_EPS); const float bon = BON[tl];
#pragma unroll
        for (int nt = 0; nt < 4; ++nt) { const float vv = bf2f(((const LAS bf16*)VB)[tl * 64 + 16 * nt + c]);
            const float o = (yv[nt] * rs * lg[nt] + lb[nt] + bon * vv) * gate[nt][e];
            mix[(size_t)(rbase + tl) * DM + 640 + 64 * h + 16 * nt + c] = (bf16)f2bf(o); } }
}

constexpr int AT_KROW = 144;
__device__ __forceinline__ void attn_unit(Frame& F, int li, int u) {
    const bool cq = u >= 256;
    int b, kvh, qb;
    if (!cq) { b = u >> 7; kvh = (u >> 6) & 1; qb = u & 63; } else { const int uu = u - 256; b = uu >> 2; kvh = (uu >> 1) & 1; qb = uu & 1; }
    const int c = F.lane & 15, q = F.lane >> 4, tb = F.wave;
    bf16* mix = (bf16*)(F.ws + WS_H);
    const float* rct = (const float*)(F.ws + WS_ROPE); const float* rst = rct + SEQ * 32;
    const int qrow = (cq ? TL + b * CTX : b * SEQ) + 128 * qb + 16 * tb + c;
    const int qpos = 128 * qb + 16 * tb + c;
    bf16x8 Q[3][2];
    { float cs[8], sn[8];
      if (!cq) { const f32x4 c0 = *(const f32x4*)(rct + qpos * 32 + 8 * q), c1 = *(const f32x4*)(rct + qpos * 32 + 8 * q + 4), s0 = *(const f32x4*)(rst + qpos * 32 + 8 * q), s1 = *(const f32x4*)(rst + qpos * 32 + 8 * q + 4);
#pragma unroll
          for (int e = 0; e < 4; ++e) { cs[e] = c0[e]; cs[e + 4] = c1[e]; sn[e] = s0[e]; sn[e + 4] = s1[e]; } }
      else {
#pragma unroll
          for (int e = 0; e < 8; ++e) { cs[e] = 1.0f; sn[e] = 0.0f; } }
#pragma unroll
      for (int hh = 0; hh < 3; ++hh) { const bf16* zq = zrow(F, qrow) + ZQ + 64 * (3 * kvh + hh) + 8 * q; float x1[8], x2[8]; unpack8(*(const v4u*)zq, x1); unpack8(*(const v4u*)(zq + 32), x2);
          float o1[8], o2[8];
#pragma unroll
          for (int e = 0; e < 8; ++e) { o1[e] = 0.125f * (x1[e] * cs[e] - x2[e] * sn[e]); o2[e] = 0.125f * (x2[e] * cs[e] + x1[e] * sn[e]); }
          Q[hh][0] = mk8(pk2(o1[0], o1[1]), pk2(o1[2], o1[3]), pk2(o1[4], o1[5]), pk2(o1[6], o1[7])); Q[hh][1] = mk8(pk2(o2[0], o2[1]), pk2(o2[2], o2[3]), pk2(o2[4], o2[5]), pk2(o2[6], o2[7])); } }
    float m[3], l[3]; f32x4 O[3][4];
#pragma unroll
    for (int hh = 0; hh < 3; ++hh) { m[hh] = inp(I_SINK)[li * 6 + 3 * kvh + hh]; l[hh] = q == 0 ? 1.0f : 0.0f;
#pragma unroll
        for (int dt = 0; dt < 4; ++dt) O[hh][dt] = (f32x4){0.f, 0.f, 0.f, 0.f}; }
    LAS unsigned char* KI = F.lds;
#pragma unroll 1
    for (int stage = cq ? 1 : 0; stage < 2; ++stage) {
        const int nkeys = stage == 0 ? 384 : 256; const int vstride = (nkeys + 8) * 2;
        LAS unsigned char* VTI = F.lds + 384 * AT_KROW;
        const int kpos0 = 128 * (qb - 1);
        __syncthreads();
        for (int pc = F.tid; pc < nkeys * 4; pc += NTHR) { const int key = pc >> 2, o = pc & 3;
            const bf16* zk; float cs[8], sn[8];
            if (stage == 0) { int kp = kpos0 + key; kp = kp < 0 ? 0 : (kp >= SEQ ? SEQ - 1 : kp); zk = zrow(F, b * SEQ + kp) + 64 * kvh + 8 * o;
                const f32x4 c0 = *(const f32x4*)(rct + kp * 32 + 8 * o), c1 = *(const f32x4*)(rct + kp * 32 + 8 * o + 4), s0 = *(const f32x4*)(rst + kp * 32 + 8 * o), s1 = *(const f32x4*)(rst + kp * 32 + 8 * o + 4);
#pragma unroll
                for (int e = 0; e < 4; ++e) { cs[e] = c0[e]; cs[e + 4] = c1[e]; sn[e] = s0[e]; sn[e + 4] = s1[e]; } }
            else { zk = zrow(F, TL + b * CTX + key) + 64 * kvh + 8 * o;
#pragma unroll
                for (int e = 0; e < 8; ++e) { cs[e] = 1.0f; sn[e] = 0.0f; } }
            const v4u k1 = *(const v4u*)(zk + ZK), k2 = *(const v4u*)(zk + ZK + 32), v1 = *(const v4u*)(zk + ZV), v2 = *(const v4u*)(zk + ZV + 32);
            float x1[8], x2[8]; unpack8(k1, x1); unpack8(k2, x2);
            float o1[8], o2[8];
#pragma unroll
            for (int e = 0; e < 8; ++e) { o1[e] = x1[e] * cs[e] - x2[e] * sn[e]; o2[e] = x2[e] * cs[e] + x1[e] * sn[e]; }
            *(LAS v4u*)(KI + key * AT_KROW + o * 16) = (v4u){pk2(o1[0], o1[1]), pk2(o1[2], o1[3]), pk2(o1[4], o1[5]), pk2(o1[6], o1[7])};
            *(LAS v4u*)(KI + key * AT_KROW + 64 + o * 16) = (v4u){pk2(o2[0], o2[1]), pk2(o2[2], o2[3]), pk2(o2[4], o2[5]), pk2(o2[6], o2[7])};
            const int kl = key & 31; const int col = (key & ~31) | (((kl & 15) >> 2) << 3) | ((kl >> 4) << 2) | (kl & 3);
#pragma unroll
            for (int hv = 0; hv < 2; ++hv) { const v4u vv = hv ? v2 : v1; LAS bf16* vt = (LAS bf16*)(VTI + (8 * (o + 4 * hv)) * vstride) + col;
                vt[0] = (bf16)(vv.x & 0xffff); *(LAS bf16*)((LAS unsigned char*)vt + vstride) = (bf16)(vv.x >> 16);
                *(LAS bf16*)((LAS unsigned char*)vt + 2 * vstride) = (bf16)(vv.y & 0xffff); *(LAS bf16*)((LAS unsigned char*)vt + 3 * vstride) = (bf16)(vv.y >> 16);
                *(LAS bf16*)((LAS unsigned char*)vt + 4 * vstride) = (bf16)(vv.z & 0xffff); *(LAS bf16*)((LAS unsigned char*)vt + 5 * vstride) = (bf16)(vv.z >> 16);
                *(LAS bf16*)((LAS unsigned char*)vt + 6 * vstride) = (bf16)(vv.w & 0xffff); *(LAS bf16*)((LAS unsigned char*)vt + 7 * vstride) = (bf16)(vv.w >> 16); } }
        __syncthreads();
        const int npair = nkeys / 32;
        const int Q0 = 128 * qb + 16 * tb;
#pragma unroll 1
        for (int kp = 0; kp < npair; ++kp) {
            const int kb = kpos0 + 32 * kp;
            if (stage == 0 && (kb + 31 < Q0 - 128 || kb > Q0 + 143 || kb + 31 < 0 || kb >= SEQ)) continue;
            bf16x8 K[2][2], V[4];
#pragma unroll
            for (int t = 0; t < 2; ++t)
#pragma unroll
                for (int k = 0; k < 2; ++k) K[t][k] = *(const LAS bf16x8*)(KI + (32 * kp + 16 * t + c) * AT_KROW + k * 64 + q * 16);
#pragma unroll
            for (int dt = 0; dt < 4; ++dt) V[dt] = *(const LAS bf16x8*)(VTI + (16 * dt + c) * vstride + kp * 64 + q * 16);
            bool ok0[4], ok1[4];
#pragma unroll
            for (int e = 0; e < 4; ++e) { const int k0 = kb + 4 * q + e, k1 = k0 + 16;
                ok0[e] = stage == 1 || (k0 >= 0 && k0 < SEQ && k0 >= qpos - 128 && k0 <= qpos + 128);
                ok1[e] = stage == 1 || (k1 >= 0 && k1 < SEQ && k1 >= qpos - 128 && k1 <= qpos + 128); }
#pragma unroll
            for (int hh = 0; hh < 3; ++hh) {
                f32x4 s0 = {0.f, 0.f, 0.f, 0.f}, s1 = {0.f, 0.f, 0.f, 0.f};
                s0 = MFMA16(K[0][0], Q[hh][0], s0); s0 = MFMA16(K[0][1], Q[hh][1], s0);
                s1 = MFMA16(K[1][0], Q[hh][0], s1); s1 = MFMA16(K[1][1], Q[hh][1], s1);
                float mx = -INFINITY;
#pragma unroll
                for (int e = 0; e < 4; ++e) { s0[e] = ok0[e] ? s0[e] : -INFINITY; s1[e] = ok1[e] ? s1[e] : -INFINITY; mx = fmaxf(mx, fmaxf(s0[e], s1[e])); }
                mx = xrow_max(mx);
                const float mn = fmaxf(m[hh], mx); const float alpha = __expf(m[hh] - mn); m[hh] = mn;
                float ps = 0.f;
#pragma unroll
                for (int e = 0; e < 4; ++e) { s0[e] = __expf(s0[e] - mn); s1[e] = __expf(s1[e] - mn); ps += s0[e] + s1[e]; }
                l[hh] = l[hh] * alpha + ps;
                const bf16x8 P = mk8(cvtpk(s0[0], s0[1]), cvtpk(s0[2], s0[3]), cvtpk(s1[0], s1[1]), cvtpk(s1[2], s1[3]));
#pragma unroll
                for (int dt = 0; dt < 4; ++dt) { O[hh][dt] = O[hh][dt] * alpha; O[hh][dt] = MFMA16(V[dt], P, O[hh][dt]); }
            }
        }
    }
#pragma unroll
    for (int hh = 0; hh < 3; ++hh) { const float lt = xrow_sum(l[hh]); const float inv = 1.0f / lt;
#pragma unroll
        for (int dt = 0; dt < 4; ++dt) { v2u w; w.x = pk2(O[hh][dt][0] * inv, O[hh][dt][1] * inv); w.y = pk2(O[hh][dt][2] * inv, O[hh][dt][3] * inv);
            *(v2u*)(mix + (size_t)qrow * DM + 256 + 64 * (3 * kvh + hh) + 16 * dt + 4 * q) = w; } }
}

__device__ __forceinline__ void fourier_tables(Frame& F) {
    bf16* t = (bf16*)(F.ws + WS_FT);
    for (int i = F.bid * NTHR + F.tid; i < 64 * 64; i += F.G * NTHR) { const int r = i >> 6, cc = i & 63; const float a = (float)((r * cc) & 63) * (1.0f / 64.0f);
        const float cs = __builtin_amdgcn_cosf(a), sn = __builtin_amdgcn_sinf(a);
        t[FT_W64C / 2 + i] = (bf16)f2bf(cs); t[FT_W64S / 2 + i] = (bf16)f2bf(sn);
        const int pj = (cc & ~31) | (((cc & 15) >> 2) << 3) | (((cc >> 4) & 1) << 2) | (cc & 3);
        t[FT_T64C / 2 + r * 64 + pj] = (bf16)f2bf(cs); t[FT_T64S / 2 + r * 64 + pj] = (bf16)f2bf(sn); }
    for (int i = F.bid * NTHR + F.tid; i < 128 * 128; i += F.G * NTHR) { const int r = i >> 7, cc = i & 127; const float a = (float)((r * cc) & 127) * (1.0f / 128.0f);
        t[FT_W128C / 2 + i] = (bf16)f2bf(__builtin_amdgcn_cosf(a)); t[FT_W128S / 2 + i] = (bf16)f2bf(__builtin_amdgcn_sinf(a)); }
}
__device__ __forceinline__ void fourier_a_fast(Frame& F, int u) {
    const int b = u >> 7, n2 = u & 127, c = F.lane & 15, q = F.lane >> 4;
    LAS unsigned char* IMG = F.lds;
    __syncthreads();
    for (int pc = F.tid; pc < 64 * 32; pc += NTHR) { const int n1 = pc >> 5, c8 = pc & 31;
        const v4u v = *(const v4u*)(zrow(F, b * SEQ + 128 * n1 + n2) + ZF + 8 * c8);
        LAS bf16* d = (LAS bf16*)(IMG + (8 * c8) * 144) + n1;
        d[0] = (bf16)(v.x & 0xffff); d[72] = (bf16)(v.x >> 16); d[144] = (bf16)(v.y & 0xffff); d[216] = (bf16)(v.y >> 16);
        d[288] = (bf16)(v.z & 0xffff); d[360] = (bf16)(v.z >> 16); d[432] = (bf16)(v.w & 0xffff); d[504] = (bf16)(v.w >> 16); }
    __syncthreads();
    const bf16* wc = (const bf16*)(F.ws + WS_FT + FT_W64C); const bf16* wsn = (const bf16*)(F.ws + WS_FT + FT_W64S);
    bf16* far = (bf16*)((unsigned char*)F.out + OUT_FA); bf16* fai = far + (size_t)NB * 64 * 128 * 256;
    bf16x8 Bc[4][2], Bs[4][2];
#pragma unroll
    for (int kt = 0; kt < 4; ++kt)
#pragma unroll
        for (int k = 0; k < 2; ++k) { Bc[kt][k] = *(const bf16x8*)(wc + (16 * kt + c) * 64 + 32 * k + 8 * q); Bs[kt][k] = *(const bf16x8*)(wsn + (16 * kt + c) * 64 + 32 * k + 8 * q); }
#pragma unroll
    for (int ci = 0; ci < 2; ++ci) { const int ct = 2 * F.wave + ci;
        bf16x8 A[2];
#pragma unroll
        for (int k = 0; k < 2; ++k) A[k] = *(const LAS bf16x8*)(IMG + (16 * ct + c) * 144 + k * 64 + q * 16);
#pragma unroll
        for (int kt = 0; kt < 4; ++kt) { f32x4 sr = {0.f, 0.f, 0.f, 0.f}, si = {0.f, 0.f, 0.f, 0.f};
#pragma unroll
            for (int k = 0; k < 2; ++k) { sr = MFMA16(A[k], Bc[kt][k], sr); si = MFMA16(A[k], Bs[kt][k], si); }
            const int k1 = 16 * kt + c; const float tw = (float)(n2 * k1) * (1.0f / 8192.0f); const float tc = __builtin_amdgcn_cosf(tw), ts = __builtin_amdgcn_sinf(tw);
            float xr[4], xi[4];
#pragma unroll
            for (int e = 0; e < 4; ++e) { const float ar = sr[e], ai = -si[e]; xr[e] = ar * tc + ai * ts; xi[e] = ai * tc - ar * ts; }
            const size_t o = (((size_t)b * 64 + k1) * 128 + n2) * 256 + 16 * ct + 4 * q;
            v2u w; w.x = pk2(xr[0], xr[1]); w.y = pk2(xr[2], xr[3]); *(v2u*)(far + o) = w; w.x = pk2(xi[0], xi[1]); w.y = pk2(xi[2], xi[3]); *(v2u*)(fai + o) = w; } }
}
__device__ __forceinline__ void fourier_c_fast(Frame& F, int u) {
    const int g = u & 3, k1 = (u >> 2) & 63, b = u >> 8, c = F.lane & 15, q = F.lane >> 4;
    LAS unsigned char* IR = F.lds; LAS unsigned char* II = F.lds + 64 * 272;
    const bf16* far = (const bf16*)((unsigned char*)F.out + OUT_FA) + (((size_t)b * 64 + k1) * 128) * 256 + 64 * g; const bf16* fai = far + (size_t)NB * 64 * 128 * 256;
    __syncthreads();
    for (int pc = F.tid; pc < 128 * 8; pc += NTHR) { const int n2 = pc >> 3, c8 = pc & 7;
        const v4u vr = *(const v4u*)(far + (size_t)n2 * 256 + 8 * c8), vi = *(const v4u*)(fai + (size_t)n2 * 256 + 8 * c8);
        LAS bf16* dr = (LAS bf16*)(IR + (8 * c8) * 272) + n2; LAS bf16* di = (LAS bf16*)(II + (8 * c8) * 272) + n2;
        dr[0] = (bf16)(vr.x & 0xffff); dr[136] = (bf16)(vr.x >> 16); dr[272] = (bf16)(vr.y & 0xffff); dr[408] = (bf16)(vr.y >> 16);
        dr[544] = (bf16)(vr.z & 0xffff); dr[680] = (bf16)(vr.z >> 16); dr[816] = (bf16)(vr.w & 0xffff); dr[952] = (bf16)(vr.w >> 16);
        di[0] = (bf16)(vi.x & 0xffff); di[136] = (bf16)(vi.x >> 16); di[272] = (bf16)(vi.y & 0xffff); di[408] = (bf16)(vi.y >> 16);
        di[544] = (bf16)(vi.z & 0xffff); di[680] = (bf16)(vi.z >> 16); di[816] = (bf16)(vi.w & 0xffff); di[952] = (bf16)(vi.w >> 16); }
    __syncthreads();
    const bf16* wc = (const bf16*)(F.ws + WS_FT + FT_W128C); const bf16* wsn = (const bf16*)(F.ws + WS_FT + FT_W128S);
    const bf16* tcn = (const bf16*)(F.ws + WS_FT + FT_T64C); const bf16* tsn = (const bf16*)(F.ws + WS_FT + FT_T64S);
    f32x4 Pr[4], Pi[4];
#pragma unroll
    for (int ct = 0; ct < 4; ++ct) { Pr[ct] = (f32x4){0.f, 0.f, 0.f, 0.f}; Pi[ct] = (f32x4){0.f, 0.f, 0.f, 0.f}; }
#pragma unroll
    for (int k = 0; k < 4; ++k) { const bf16x8 bc = *(const bf16x8*)(wc + (16 * F.wave + c) * 128 + 32 * k + 8 * q), bs = *(const bf16x8*)(wsn + (16 * F.wave + c) * 128 + 32 * k + 8 * q);
        const v4u bsu = __builtin_bit_cast(v4u, bs); const bf16x8 bsn = mk8(bsu.x ^ 0x80008000u, bsu.y ^ 0x80008000u, bsu.z ^ 0x80008000u, bsu.w ^ 0x80008000u);
#pragma unroll
        for (int ct = 0; ct < 4; ++ct) { const bf16x8 ar = *(const LAS bf16x8*)(IR + (16 * ct + c) * 272 + k * 64 + q * 16), ai = *(const LAS bf16x8*)(II + (16 * ct + c) * 272 + k * 64 + q * 16);
            Pr[ct] = MFMA16(ar, bc, Pr[ct]); Pr[ct] = MFMA16(ai, bs, Pr[ct]); Pi[ct] = MFMA16(ai, bc, Pi[ct]); Pi[ct] = MFMA16(ar, bsn, Pi[ct]); } }
    bf16x8 Br[2], Bi[2];
#pragma unroll
    for (int k = 0; k < 2; ++k) { Br[k] = mk8(cvtpk(Pr[2 * k][0], Pr[2 * k][1]), cvtpk(Pr[2 * k][2], Pr[2 * k][3]), cvtpk(Pr[2 * k + 1][0], Pr[2 * k + 1][1]), cvtpk(Pr[2 * k + 1][2], Pr[2 * k + 1][3]));
        Bi[k] = mk8(cvtpk(Pi[2 * k][0], Pi[2 * k][1]), cvtpk(Pi[2 * k][2], Pi[2 * k][3]), cvtpk(Pi[2 * k + 1][0], Pi[2 * k + 1][1]), cvtpk(Pi[2 * k + 1][2], Pi[2 * k + 1][3])); }
    bf16* mix = (bf16*)(F.ws + WS_H);
    const float scale = 0.0013810679320049757f;
    const int k2 = 16 * F.wave + c; const size_t row = (size_t)b * SEQ + k1 + 64 * k2;
#pragma unroll
    for (int mt = 0; mt < 4; ++mt) { f32x4 y = {0.f, 0.f, 0.f, 0.f};
#pragma unroll
        for (int k = 0; k < 2; ++k) { const bf16x8 ac = *(const bf16x8*)(tcn + (16 * mt + c) * 64 + 32 * k + 8 * q), as = *(const bf16x8*)(tsn + (16 * mt + c) * 64 + 32 * k + 8 * q);
            y = MFMA16(ac, Br[k], y); y = MFMA16(as, Bi[k], y); }
        v2u w; w.x = pk2(y[0] * scale, y[1] * scale); w.y = pk2(y[2] * scale, y[3] * scale);
        *(v2u*)(mix + row * DM + 64 * g + 16 * mt + 4 * q) = w; }
}

#define XB_TMO      128
#define XB_XCNT(j)  (256  + 64 * (j))
#define XB_XSUB(j)  (1280 + 64 * (j))
#define XB_XGEN(j)  (2304 + 64 * (j))
#define XB_TOP      3328
#define XB_TOPGEN   3392
#define XCD_BAR_WORDS 3456
#define XB_SPIN_CAP (1u << 23)
__device__ __forceinline__ unsigned xb_ld(unsigned* p)              { return __hip_atomic_load(p, __ATOMIC_RELAXED, __HIP_MEMORY_SCOPE_AGENT); }
__device__ __forceinline__ unsigned xb_add(unsigned* p, unsigned v) { return __hip_atomic_fetch_add(p, v, __ATOMIC_RELAXED, __HIP_MEMORY_SCOPE_AGENT); }
__device__ __forceinline__ unsigned xb_xcc_id() { return (unsigned)__builtin_amdgcn_s_getreg((3 << 11) | 20) & 0xFu; }
#define XB_SPIN(cond, bar) do { unsigned _sp = 0; while (cond) { __builtin_amdgcn_s_sleep(1); \
    if ((++_sp & 255u) == 0u) { if (xb_ld(&(bar)[XB_TMO])) break; if (_sp > XB_SPIN_CAP) { atomicAdd(&(bar)[XB_TMO], 1u); break; } } } } while (0)
struct XcdBarrier { unsigned* bar; unsigned x; volatile LAS unsigned* st; };
__device__ __forceinline__ XcdBarrier xcd_barrier_post(unsigned* bar, volatile LAS unsigned* st) {
    XcdBarrier b; b.bar = bar; b.x = xb_xcc_id(); b.st = st;
    if (threadIdx.x == 0) (void)xb_add(&bar[XB_XCNT(b.x)], 1u);
    return b;
}
__device__ __forceinline__ void xcd_barrier_complete(unsigned* bar, unsigned x, unsigned& nloc, unsigned& nx) {
    const unsigned G = gridDim.x * gridDim.y * gridDim.z;
    unsigned sum, cnt, mine, sp = 0u;
    for (;;) {
        sum = 0u; cnt = 0u; mine = 0u;
#pragma unroll
        for (unsigned j = 0; j < 16; ++j) { const unsigned c = xb_ld(&bar[XB_XCNT(j)]); sum += c; cnt += (c > 0u) ? 1u : 0u; mine = (j == x) ? c : mine; }
        if (sum == G) break;
        __builtin_amdgcn_s_sleep(1);
        if ((++sp & 255u) == 0u) { if (xb_ld(&bar[XB_TMO])) break; if (sp > XB_SPIN_CAP) { atomicAdd(&bar[XB_TMO], 1u); break; } }
    }
    nloc = mine > 0u ? mine : 1u; nx = cnt > 0u ? cnt : 1u;
}
__device__ __forceinline__ void xcd_barrier(const XcdBarrier& b0) {
    XcdBarrier b; { unsigned* p = b0.bar; unsigned x = __builtin_amdgcn_readfirstlane(b0.x); unsigned st = (unsigned)(size_t)b0.st; asm volatile("" : "+s"(p), "+s"(x), "+s"(st)); b.bar = p; b.x = x; b.st = (volatile LAS unsigned*)(size_t)st; }
    asm volatile("s_waitcnt vmcnt(0)" ::: "memory");
    __syncthreads();
    if (threadIdx.x == 0) {
        unsigned* bar = b.bar;
        __builtin_amdgcn_s_waitcnt(0);
        unsigned nloc = b.st[0], nx = b.st[1];
        if (nloc == 0u) { xcd_barrier_complete(bar, b.x, nloc, nx); b.st[0] = nloc; b.st[1] = nx; }
        const unsigned old = xb_add(&bar[XB_XSUB(b.x)], 1u);
        const unsigned gen = old / nloc;
        if (old + 1u == (gen + 1u) * nloc) {
            __builtin_amdgcn_fence(__ATOMIC_RELEASE, "agent");
            asm volatile("s_waitcnt vmcnt(0)" ::: "memory");
            const unsigned og = xb_add(&bar[XB_TOP], 1u);
            const unsigned tg = og / nx;
            if (og + 1u == (tg + 1u) * nx) xb_add(&bar[XB_TOPGEN], 1u);
            else XB_SPIN(xb_ld(&bar[XB_TOPGEN]) == tg, bar);
            __builtin_amdgcn_fence(__ATOMIC_ACQUIRE, "agent");
            xb_add(&bar[XB_XGEN(b.x)], 1u);
            asm volatile("s_waitcnt vmcnt(0)" ::: "memory");
        } else {
            XB_SPIN(xb_ld(&bar[XB_XGEN(b.x)]) == gen, bar);
            __builtin_amdgcn_fence(__ATOMIC_ACQUIRE, "agent");
            asm volatile("s_waitcnt vmcnt(0)" ::: "memory");
        }
    }
    __syncthreads();
}

__device__ __forceinline__ int queue_next(Frame& F, unsigned* cnt) {
    volatile LAS int* slot = (volatile LAS int*)(F.lds + MISC_OFF + 64);
    __syncthreads();
    if (F.tid == 0) *slot = (int)__hip_atomic_fetch_add(cnt, 1u, __ATOMIC_RELAXED, __HIP_MEMORY_SCOPE_AGENT);
    __syncthreads();
    return *slot;
}
template <int KIND> __device__ __forceinline__ void run_phase(const Frame& F0, int li, int second) {
    Frame F;
    { int t = threadIdx.x; asm volatile("" : "+v"(t)); F.tid = t; F.lane = t & 63; F.wave = __builtin_amdgcn_readfirstlane(t >> 6);
      int g = F0.G, b = F0.bid; asm volatile("" : "+s"(g), "+s"(b)); F.G = g; F.bid = b;
      unsigned char* w = F0.ws; float* o = F0.out; asm volatile("" : "+s"(w), "+s"(o)); F.ws = w; F.out = o;
      unsigned l = (unsigned)(size_t)F0.lds; asm volatile("" : "+s"(l)); F.lds = (LAS unsigned char*)(size_t)l;
      asm volatile("" : "+s"(li), "+s"(second)); }
    float* modv = (float*)(F.ws + WS_MOD);
    bf16* XB = (bf16*)(F.ws + WS_XB);
    bf16* H = (bf16*)(F.ws + WS_H); bf16* ACT = (bf16*)(F.ws + WS_ACT); bf16* O = (bf16*)(F.ws + WS_O);
    const float* ng = inp(I_NORMG) + (size_t)li * 6 * DM; const float* mv = modv + (size_t)li * 3 * 9216;
    const bool last = li == 1;
    if constexpr (KIND == 100) { convert_weights(F, 0); mod_gemv(F); rope_tables(F); lora_transposes(F); fourier_tables(F); }
    if constexpr (KIND == 101) { EArgs A{}; A.xl_src = inp(I_X); A.xc_src = inp(I_CTX); A.o = nullptr; A.hdst = H; A.modv_h = modv; A.shidx = 0; A.scidx = 1; A.gpre = inp(I_NORMG); A.nrows = TT; e_phase(F, A); }
    if constexpr (KIND == 0) {
        const bf16* wi = (const bf16*)(F.ws + (second ? WS_WI2 : WS_WI1)); const bool withctx = !(last && second);
        if (!withctx || F.G != 256) { pg8::Gemm g{H, wi, withctx ? TT : TL, NWI, DM}; pg8::StaticOrder S; S.init(g.M, g.N, F.G, F.bid);
            pg8::EpiSwiglu E{ACT, FFNP}; pg8::gemm_phase<pg8::EpiSwiglu, pg8::StaticOrder, true, true>(F.lds, g, S, E, F.tid); }
        else { unsigned* cnt = (unsigned*)(F.ws + WS_CTL) + 8192 + 64 * (li * 2 + second);
            pg8::Gemm g{H, wi, TT, NWI, DM}; pg8::UpOrder S; S.init(NWI, F.G, F.bid, cnt);
            pg8::EpiSwiglu E{ACT, FFNP}; pg8::gemm_phase<pg8::EpiSwiglu, pg8::UpOrder, true, true>(F.lds, g, S, E, F.tid);
            if (F.bid >= 248) {
                if (F.tid == 0) { unsigned sp = 0; while (__hip_atomic_load(cnt, __ATOMIC_RELAXED, __HIP_MEMORY_SCOPE_AGENT) < 352u && ++sp < (1u << 24)) __builtin_amdgcn_s_sleep(8);
                    __builtin_amdgcn_fence(__ATOMIC_ACQUIRE, "agent"); asm volatile("s_waitcnt vmcnt(0)" ::: "memory"); }
                __syncthreads();
                const int k = F.bid - 248; pg8::Gemm g2{ACT, (const bf16*)(F.ws + (second ? WS_WO2 : WS_WO1)), TT, DM, FFNP}; pg8::OneUnit S2{64 + (k >> 2), k & 3};
                pg8::EpiBf16 E2{O, DM}; pg8::gemm_phase<pg8::EpiBf16, pg8::OneUnit, false, true>(F.lds, g2, S2, E2, F.tid); } } }
    if constexpr (KIND == 1) {
        const bool ctxhere = F.G != 256 && !(last && second);
        pg8::Gemm g{ACT, (const bf16*)(F.ws + (second ? WS_WO2 : WS_WO1)), ctxhere ? TT : TL, DM, FFNP}; pg8::StaticOrder S; S.init(g.M, g.N, F.G, F.bid);
        pg8::EpiBf16 E{O, DM}; pg8::gemm_phase<pg8::EpiBf16, pg8::StaticOrder, true, true>(F.lds, g, S, E, F.tid); }
    if constexpr (KIND == 2) {
        EArgs A{}; A.xl_src = inp(I_X); A.xc_src = inp(I_CTX); A.xb_src = li == 0 ? (const bf16*)nullptr : XB; A.xb_dst = XB; A.o = O; A.modv_g = mv; A.gidx = 2; A.gmul = 0.5f; A.gpost = ng + 1 * DM;
        A.hdst = H; A.modv_h = mv; A.shidx = 3; A.scidx = 4; A.gpre = ng + 2 * DM; A.nrows = TT; e_phase(F, A); }
    if constexpr (KIND == 3) {
        pg8::Gemm g{H, (const bf16*)(F.ws + WS_WIN), TT, INWP, DM}; pg8::StaticOrder S; S.init(g.M, g.N, F.G, F.bid);
        pg8::EpiBf16 E{ACT, INWP}; pg8::gemm_phase<pg8::EpiBf16, pg8::StaticOrder, true, true>(F.lds, g, S, E, F.tid); }
    if constexpr (KIND == 4) {
        lora_pass(F, li);
        for (int u = F.bid; u < 256; u += F.G) fourier_a_fast(F, u);
        if (li == 0) fourier_ctx1_all(F); }
    if constexpr (KIND == 5) {
        unsigned* cnt = (unsigned*)(F.ws + WS_CTL) + 8192 + 64 * (4 + 2 * li);
        const int na = li == 0 ? 264 : 256;
        for (int it = queue_next(F, cnt); it < na; it = queue_next(F, cnt)) attn_unit(F, li, it);
        for (int it = queue_next(F, cnt + 16); it < 12 * (NSC - 1); it = queue_next(F, cnt + 16)) rwkv_pass1_pair(F, li, it); }
    if constexpr (KIND == 11) {
        if (F.bid < 24) rwkv_pass2_chain(F, F.bid);
        else convert_weights(F, 1, li == 0 ? 1 : 2, 24, F.G - 24);
        if (li == 0) fourier_ctx2_all(F); }
    if constexpr (KIND == 12) {
        unsigned* cnt = (unsigned*)(F.ws + WS_CTL) + 8192 + 64 * (5 + 2 * li);
        const int np3 = li == 0 ? 12 * NSC : 12 * 64;
        for (int it = queue_next(F, cnt); it < np3; it = queue_next(F, cnt)) rwkv_pass3_unit(F, li, li == 0 ? it : (it / 64) * NSC + 2 + it % 64);
        for (int it = queue_next(F, cnt + 16); it < 512; it = queue_next(F, cnt + 16)) fourier_c_fast(F, it); }
    if constexpr (KIND == 6) {
        pg8::Gemm g{H, (const bf16*)(F.ws + WS_WOUT), last ? TL : TT, DM, DM}; pg8::StaticOrder S; S.init(g.M, g.N, F.G, F.bid);
        pg8::EpiBf16 E{O, DM}; pg8::gemm_phase<pg8::EpiBf16, pg8::StaticOrder, true, true>(F.lds, g, S, E, F.tid); }
    if constexpr (KIND == 7) {
        EArgs A{}; A.xb_src = XB; A.xb_dst = XB; A.o = O; A.modv_g = mv; A.gidx = 5; A.gmul = 1.0f; A.gpost = ng + 3 * DM;
        A.hdst = H; A.modv_h = mv; A.shidx = 6; A.scidx = 7; A.gpre = ng + 4 * DM; A.nrows = last ? TL : TT; e_phase(F, A); }
    if constexpr (KIND == 10) {
        EArgs A{}; A.xb_src = XB; A.xb_dst = XB; A.out32 = last ? F.out : (float*)nullptr; A.o = O; A.modv_g = mv; A.gidx = 8; A.gmul = 0.5f; A.gpost = ng + 5 * DM;
        if (!last) { A.hdst = H; A.modv_h = mv + 3 * 9216; A.shidx = 0; A.scidx = 1; A.gpre = ng + 6 * DM; }
        A.nrows = last ? TL : TT; e_phase(F, A);
        }
}
__global__ void __launch_bounds__(NTHR, 2) mega_one(Args args) {
    extern __shared__ __attribute__((aligned(16))) unsigned char lds[];
    Frame F; F.lds = (LAS unsigned char*)lds; F.tid = threadIdx.x; F.lane = F.tid & 63; F.wave = __builtin_amdgcn_readfirstlane(F.tid >> 6); F.G = gridDim.x; F.bid = blockIdx.x;
    F.out = args.out; F.ws = args.ws;
    volatile LAS unsigned* MISC = (volatile LAS unsigned*)(F.lds + MISC_OFF);
    if (F.tid < 32) MISC[F.tid] = 0u;
    __syncthreads();
    XcdBarrier bar = xcd_barrier_post((unsigned*)(F.ws + WS_CTL) + 4096, MISC + 8);
#define GRID_BAR() xcd_barrier(bar)
    run_phase<100>(F, 0, 0); GRID_BAR();
    run_phase<101>(F, 0, 0); GRID_BAR();
#pragma unroll 1
    for (int li = 0; li < 2; ++li) {
        run_phase<0>(F, li, 0); GRID_BAR();
        run_phase<1>(F, li, 0); GRID_BAR();
        run_phase<2>(F, li, 0); GRID_BAR();
        run_phase<3>(F, li, 0); GRID_BAR();
        run_phase<4>(F, li, 0); GRID_BAR();
        run_phase<5>(F, li, 0); GRID_BAR();
        run_phase<11>(F, li, 0); GRID_BAR();
        run_phase<12>(F, li, 0); GRID_BAR();
        run_phase<6>(F, li, 0); GRID_BAR();
        run_phase<7>(F, li, 0); GRID_BAR();
        run_phase<0>(F, li, 1); GRID_BAR();
        run_phase<1>(F, li, 1); GRID_BAR();
        run_phase<10>(F, li, 0); GRID_BAR();
    }
}

extern "C" void kernel_launch(void* const* d_in, const int* in_sizes, int n_in, void* d_out, int out_size, void* d_ws, size_t ws_size, hipStream_t stream) {
    static int ready = 0;
    if (!ready) {
        if (n_in != 25 || out_size != TL * DM || ws_size < WS_END) { fprintf(stderr, "kernel_launch: unexpected shapes (n_in %d out %d ws %zu)\n", n_in, out_size, ws_size); ready = -1; return; }
        if (hipFuncSetAttribute((const void*)mega_one, hipFuncAttributeMaxDynamicSharedMemorySize, LDS_BYTES) != hipSuccess) { fprintf(stderr, "kernel_launch: hipFuncSetAttribute failed\n"); ready = -1; return; }
        int dev = 0, cus = 0; if (hipGetDevice(&dev) != hipSuccess || hipDeviceGetAttribute(&cus, hipDeviceAttributeMultiprocessorCount, dev) != hipSuccess || cus < 32) cus = 256;
        ready = cus < 256 ? cus : 256;
    }
    if (ready < 0) return;
    if (hipMemsetAsync((char*)d_ws + WS_CTL, 0, 65536, stream) != hipSuccess) { fprintf(stderr, "kernel_launch: memset failed\n"); return; }
    Args a{};
    for (int i = 0; i < 25; ++i) a.in[i] = (const float*)d_in[i];
    a.out = (float*)d_out; a.ws = (unsigned char*)d_ws;
    hipLaunchKernelGGL(mega_one, dim3(ready), dim3(NTHR), LDS_BYTES, stream, a);
}
```

```cpp
#include <hip/hip_runtime.h>
#include <cstdio>
#include <cstdint>

namespace pg8 {
#define PG8_LAS __attribute__((address_space(3)))
typedef unsigned short bf16_t;
typedef short bf16x8 __attribute__((ext_vector_type(8)));
typedef float f32x4 __attribute__((ext_vector_type(4)));
typedef unsigned u32x4 __attribute__((ext_vector_type(4)));
constexpr int BM = 256, BK = 64, HALF = 128, HTB = HALF * BK * 2, STAGE_BYTES = 8 * HTB, NXCD = 8, WGM = 8;

__host__ __device__ __forceinline__ int lds_byte(int r, int c) { const int st = (r >> 4) * 2 + (c >> 5), rr = r & 15, cc = c & 31, ob = rr * 64 + cc * 2; return st * 1024 + (ob ^ (((ob >> 9) & 1) << 5)); }
__host__ __device__ __forceinline__ void stage_rc(int b, int& R, int& C) { const int st = b / 1024, sb = b % 1024, swz = sb ^ (((sb >> 9) & 1) << 5); R = (st >> 1) * 16 + swz / 64; C = (st & 1) * 32 + (swz % 64) / 2; }
__host__ __device__ __forceinline__ int perm32(int rho) { const int n = rho >> 4, i = rho & 15; return 8 * (i >> 2) + 4 * n + (i & 3); }

struct Unit { int pm, pn; };
struct Gemm { const bf16_t* A; const bf16_t* Bt; int M, N, K; };

struct StaticOrder {
    int nM, nN, nwg, G, c;
    __host__ __device__ void init(int M, int N, int G_, int c_) { nM = M / BM; nN = N / BM; nwg = nM * nN; G = G_; c = c_; }
    __host__ __device__ bool next(int i, Unit& u) const {
        const long L = (long)i * G + c; if (L >= nwg) return false;
        int wgid = (int)L; { const int q = nwg / NXCD, r = nwg % NXCD, xcd = wgid % NXCD, off = wgid / NXCD; wgid = (xcd < r ? xcd * (q + 1) : r * (q + 1) + (xcd - r) * q) + off; }
        const int nig = WGM * nN, gid = wgid / nig, fm = gid * WGM, gsz = (nM - fm) < WGM ? (nM - fm) : WGM;
        u.pm = fm + ((wgid % nig) % gsz); u.pn = (wgid % nig) / gsz; return true;
    }
    __device__ __forceinline__ void a_ready(const Unit&) const {}
    __device__ __forceinline__ void done(const Unit&) const {}
};

struct UpOrder {
    StaticOrder lat; int G, c, nN; unsigned* cnt;
    __device__ void init(int N, int G_, int c_, unsigned* cnt_) { lat.init(16384, N, G_, c_); G = G_; c = c_; nN = N / BM; cnt = cnt_; }
    __device__ bool next(int i, Unit& u) const {
        const int nctx = 2 * nN, total = nctx + lat.nwg;
        long L;
        if (G != 256) L = (long)i * G + c;
        else if (c >= 248) { if (i >= 3) return false; L = (long)i * G + c; }
        else if (c >= 172 && c < 188 && i == 5) L = (long)(3 + (c - 172) / 8) * G + 248 + (c - 172) % 8;
        else L = (long)i * G + c;
        if (L >= total) return false;
        if (L < nctx) { u.pm = 64 + (int)L / nN; u.pn = (int)L % nN; return true; }
        int wgid = (int)L - nctx; { const int nwg = lat.nwg, q = nwg / NXCD, r = nwg % NXCD, xcd = wgid % NXCD, off = wgid / NXCD; wgid = (xcd < r ? xcd * (q + 1) : r * (q + 1) + (xcd - r) * q) + off; }
        const int nig = WGM * nN, gid = wgid / nig, fm = gid * WGM, gsz = (lat.nM - fm) < WGM ? (lat.nM - fm) : WGM;
        u.pm = fm + ((wgid % nig) % gsz); u.pn = (wgid % nig) / gsz; return true;
    }
    __device__ __forceinline__ void a_ready(const Unit&) const {}
    __device__ __forceinline__ void done(const Unit& u) const {
        if (u.pm >= 64) { asm volatile("s_waitcnt vmcnt(0)" ::: "memory"); __builtin_amdgcn_fence(__ATOMIC_RELEASE, "agent"); asm volatile("s_waitcnt vmcnt(0)" ::: "memory");
            if ((threadIdx.x & 63) == 0) __hip_atomic_fetch_add(cnt, 1u, __ATOMIC_RELAXED, __HIP_MEMORY_SCOPE_AGENT); }
    }
};
struct OneUnit {
    int pm, pn;
    __device__ bool next(int i, Unit& u) const { if (i != 0) return false; u.pm = pm; u.pn = pn; return true; }
    __device__ __forceinline__ void a_ready(const Unit&) const {}
    __device__ __forceinline__ void done(const Unit&) const {}
};

__device__ __forceinline__ unsigned cvt_pk_bf16(float lo, float hi) { unsigned r; asm volatile("v_cvt_pk_bf16_f32 %0, %1, %2" : "=v"(r) : "v"(lo), "v"(hi)); return r; }

struct EpiBf16 {
    static constexpr bool PERM = true, AFTER_DRAIN = false;
    bf16_t* O; int ldc;
    __device__ __forceinline__ void operator()(const f32x4 (&acc)[2][2][4][2], const Unit& u, int wr, int wc, int fr, int fq) const {
        const int row0 = u.pm * BM + wr * 64 + fr; const int col0 = u.pn * BM + wc * 32 + 8 * fq;
#pragma unroll
        for (int ai = 0; ai < 2; ++ai)
#pragma unroll
            for (int m = 0; m < 4; ++m) { bf16_t* rowp = O + (size_t)(row0 + ai * HALF + m * 16) * ldc + col0;
#pragma unroll
                for (int bj = 0; bj < 2; ++bj) { const f32x4 v0 = acc[ai][bj][m][0], v1 = acc[ai][bj][m][1];
                    u32x4 w; w.x = cvt_pk_bf16(v0[0], v0[1]); w.y = cvt_pk_bf16(v0[2], v0[3]); w.z = cvt_pk_bf16(v1[0], v1[1]); w.w = cvt_pk_bf16(v1[2], v1[3]);
                    *(u32x4*)(rowp + bj * HALF) = w; } }
    }
};
struct EpiF32 {
    static constexpr bool PERM = true, AFTER_DRAIN = false;
    float* O; int ldc;
    __device__ __forceinline__ void operator()(const f32x4 (&acc)[2][2][4][2], const Unit& u, int wr, int wc, int fr, int fq) const {
        const int row0 = u.pm * BM + wr * 64 + fr; const int col0 = u.pn * BM + wc * 32 + 8 * fq;
#pragma unroll
        for (int ai = 0; ai < 2; ++ai)
#pragma unroll
            for (int m = 0; m < 4; ++m) { float* rowp = O + (size_t)(row0 + ai * HALF + m * 16) * ldc + col0;
#pragma unroll
                for (int bj = 0; bj < 2; ++bj) { *(f32x4*)(rowp + bj * HALF) = acc[ai][bj][m][0]; *(f32x4*)(rowp + bj * HALF + 4) = acc[ai][bj][m][1]; } }
    }
};
__device__ __forceinline__ float silu_f(float x) { return x * __builtin_amdgcn_rcpf(1.0f + __expf(-x)); }
struct EpiSwiglu {
    static constexpr bool PERM = true, AFTER_DRAIN = false;
    bf16_t* O; int ldc;
    __device__ __forceinline__ void operator()(const f32x4 (&acc)[2][2][4][2], const Unit& u, int wr, int wc, int fr, int fq) const {
        const int row0 = u.pm * BM + wr * 64 + fr; const int col0 = u.pn * HALF + wc * 32 + 8 * fq;
#pragma unroll
        for (int ai = 0; ai < 2; ++ai)
#pragma unroll
            for (int m = 0; m < 4; ++m) { bf16_t* rowp = O + (size_t)(row0 + ai * HALF + m * 16) * ldc + col0;
                const f32x4 g0 = acc[ai][0][m][0], g1 = acc[ai][0][m][1], u0 = acc[ai][1][m][0], u1 = acc[ai][1][m][1];
                u32x4 w; w.x = cvt_pk_bf16(silu_f(g0[0]) * u0[0], silu_f(g0[1]) * u0[1]); w.y = cvt_pk_bf16(silu_f(g0[2]) * u0[2], silu_f(g0[3]) * u0[3]);
                w.z = cvt_pk_bf16(silu_f(g1[0]) * u1[0], silu_f(g1[1]) * u1[1]); w.w = cvt_pk_bf16(silu_f(g1[2]) * u1[2], silu_f(g1[3]) * u1[3]);
                *(u32x4*)rowp = w; }
    }
};

template <class Epi, class Sched, bool ALIGN_EPI = false, bool SP2 = false>
__device__ __forceinline__ void gemm_phase(PG8_LAS unsigned char* lds, const Gemm g, const Sched& S, const Epi& E, const int tid) {
    const int wid = __builtin_amdgcn_readfirstlane(tid >> 6), lane = tid & 63, wr = wid >> 2, wc = wid & 3, fr = lane & 15, fq = lane >> 4;
    const int K = g.K, nt = K / BK;
    unsigned voffA[2], voffB[2];
#pragma unroll
    for (int i = 0; i < 2; ++i) { int R, C; stage_rc(tid * 16 + i * 8192, R, C); const int Rb = Epi::PERM ? ((R & ~31) + perm32(R & 31)) : R;
        voffA[i] = (unsigned)(R * K + C) * 2u; voffB[i] = (unsigned)(Rb * K + C) * 2u; }
    const size_t kstep = (size_t)(BK * 2);
    const size_t hstep = (size_t)HALF * K * 2;
    const size_t tstep = 2 * hstep;
    const unsigned ldsw = (unsigned)wid * 1024u;
    const int aoff = lds_byte(wr * 64 + fr, fq * 8), boff = lds_byte(wc * 32 + fr, fq * 8);
#define PG8_SA(b, h) (((b) * 2 + (h)) * HTB)
#define PG8_SB(b, h) ((4 + (b) * 2 + (h)) * HTB)
#define PG8_STAGE(bufoff, gbase, voff) do { _Pragma("unroll") for (int _i = 0; _i < 2; ++_i) \
        __builtin_amdgcn_global_load_lds((const unsigned*)((const char*)(gbase) + (voff)[_i]), (PG8_LAS unsigned*)(lds + (bufoff) + ldsw + _i * 8192), 16, 0, 0); } while (0)
#define PG8_LDA(dst, b, h) do { _Pragma("unroll") for (int m = 0; m < 4; ++m) _Pragma("unroll") for (int k = 0; k < 2; ++k) dst[m][k] = *(const PG8_LAS bf16x8*)(lds + PG8_SA(b, h) + aoff + m * 2048 + k * 1024); } while (0)
#define PG8_LDB(dst, b, h) do { _Pragma("unroll") for (int n = 0; n < 2; ++n) _Pragma("unroll") for (int k = 0; k < 2; ++k) dst[n][k] = *(const PG8_LAS bf16x8*)(lds + PG8_SB(b, h) + boff + n * 2048 + k * 1024); } while (0)
#define PG8_MMA(ai, bj, At, Bt) do { __builtin_amdgcn_s_setprio(1); _Pragma("unroll") for (int m = 0; m < 4; ++m) _Pragma("unroll") for (int n = 0; n < 2; ++n) _Pragma("unroll") for (int k = 0; k < 2; ++k) \
        acc[ai][bj][m][n] = __builtin_amdgcn_mfma_f32_16x16x32_bf16(Bt[n][k], At[m][k], acc[ai][bj][m][n], 0, 0, 0); __builtin_amdgcn_s_setprio(0); } while (0)
#define PG8_WAIT_V(n) asm volatile("s_waitcnt vmcnt(" #n ")" ::: "memory")
#define PG8_WAIT_L(n) asm volatile("s_waitcnt lgkmcnt(" #n ")" ::: "memory")
#define PG8_BAR __builtin_amdgcn_s_barrier()
#define PG8_SCHED __builtin_amdgcn_sched_barrier(0)
    Unit cur, nxt; int ui = 0;
    if (!S.next(0, cur)) return;
    f32x4 acc[2][2][4][2];
#pragma unroll
    for (int a = 0; a < 2; ++a)
#pragma unroll
        for (int b = 0; b < 2; ++b)
#pragma unroll
            for (int m = 0; m < 4; ++m)
#pragma unroll
                for (int n = 0; n < 2; ++n) acc[a][b][m][n] = (f32x4){0.f, 0.f, 0.f, 0.f};
    bf16x8 At[4][2], B0[2][2], B1[2][2];
    const char* cA = (const char*)g.A + (size_t)cur.pm * tstep; const char* cB = (const char*)g.Bt + (size_t)cur.pn * tstep;
    S.a_ready(cur);
    if constexpr (SP2) {
        PG8_STAGE(PG8_SB(0, 0), cB, voffB); PG8_STAGE(PG8_SB(0, 1), cB + hstep, voffB); PG8_STAGE(PG8_SA(0, 0), cA, voffA); PG8_STAGE(PG8_SA(0, 1), cA + hstep, voffA);
        if (wr == 1) PG8_BAR;
        PG8_WAIT_V(2); PG8_BAR;
        PG8_STAGE(PG8_SB(1, 0), cB + kstep, voffB); PG8_STAGE(PG8_SA(1, 0), cA + kstep, voffA); PG8_STAGE(PG8_SB(1, 1), cB + hstep + kstep, voffB);
        PG8_WAIT_V(6); PG8_BAR;
    } else {
        PG8_STAGE(PG8_SB(0, 0), cB, voffB); PG8_STAGE(PG8_SA(0, 0), cA, voffA); PG8_STAGE(PG8_SB(0, 1), cB + hstep, voffB); PG8_STAGE(PG8_SA(0, 1), cA + hstep, voffA);
        if (wr == 1) PG8_BAR;
        PG8_WAIT_V(4); PG8_BAR;
        PG8_STAGE(PG8_SB(1, 0), cB + kstep, voffB); PG8_STAGE(PG8_SA(1, 0), cA + kstep, voffA); PG8_STAGE(PG8_SB(1, 1), cB + hstep + kstep, voffB);
        PG8_WAIT_V(6); PG8_BAR;
    }
    for (;;) {
        const bool has_next = S.next(ui + 1, nxt);
        const char* nA = has_next ? (const char*)g.A + (size_t)nxt.pm * tstep : cA; const char* nB = has_next ? (const char*)g.Bt + (size_t)nxt.pn * tstep : cB;
        for (int t = 0; t < nt; t += 2) {
            const bool last = (t == nt - 2);
            const char* a1 = cA + (size_t)(t + 1) * kstep;
            const char* a2 = last ? nA : cA + (size_t)(t + 2) * kstep; const char* b2 = last ? nB : cB + (size_t)(t + 2) * kstep;
            const char* a3 = a2 + kstep; const char* b3 = b2 + kstep;
            if (last && has_next) S.a_ready(nxt);
            if constexpr (SP2) {
            PG8_LDB(B0, 0, 0); PG8_LDB(B1, 0, 1); PG8_SCHED; PG8_LDA(At, 0, 0); PG8_STAGE(PG8_SA(1, 1), a1 + hstep, voffA);
            PG8_WAIT_V(8); PG8_WAIT_L(0); PG8_BAR; PG8_MMA(0, 0, At, B0); PG8_MMA(0, 1, At, B1); PG8_BAR; PG8_SCHED;
            PG8_LDA(At, 0, 1); PG8_STAGE(PG8_SB(0, 0), b2, voffB); PG8_STAGE(PG8_SB(0, 1), b2 + hstep, voffB); PG8_STAGE(PG8_SA(0, 0), a2, voffA);
            PG8_WAIT_V(8); PG8_WAIT_L(0); PG8_BAR; PG8_MMA(1, 0, At, B0); PG8_MMA(1, 1, At, B1); PG8_BAR; PG8_SCHED;
            PG8_LDB(B0, 1, 0); PG8_LDB(B1, 1, 1); PG8_SCHED; PG8_LDA(At, 1, 0); PG8_STAGE(PG8_SA(0, 1), a2 + hstep, voffA);
            PG8_WAIT_V(8); PG8_WAIT_L(0); PG8_BAR; PG8_MMA(0, 0, At, B0); PG8_MMA(0, 1, At, B1); PG8_BAR; PG8_SCHED;
            PG8_LDA(At, 1, 1); PG8_STAGE(PG8_SB(1, 0), b3, voffB); PG8_STAGE(PG8_SB(1, 1), b3 + hstep, voffB); PG8_STAGE(PG8_SA(1, 0), a3, voffA);
            PG8_WAIT_V(8); PG8_WAIT_L(0); PG8_BAR; PG8_MMA(1, 0, At, B0); PG8_MMA(1, 1, At, B1); PG8_BAR; PG8_SCHED;
            } else {
            PG8_LDB(B0, 0, 0); PG8_SCHED; PG8_LDA(At, 0, 0); PG8_STAGE(PG8_SA(1, 1), a1 + hstep, voffA);
            PG8_WAIT_L(8); PG8_BAR; PG8_WAIT_L(0); PG8_MMA(0, 0, At, B0); PG8_BAR; PG8_SCHED;
            PG8_LDB(B1, 0, 1); PG8_STAGE(PG8_SB(0, 0), b2, voffB);
            PG8_BAR; PG8_WAIT_L(0); PG8_MMA(0, 1, At, B1); PG8_BAR;
            PG8_LDA(At, 0, 1); PG8_STAGE(PG8_SA(0, 0), a2, voffA);
            PG8_BAR; PG8_WAIT_L(0); PG8_MMA(1, 0, At, B0); PG8_BAR; PG8_SCHED;
            PG8_STAGE(PG8_SB(0, 1), b2 + hstep, voffB);
            PG8_WAIT_V(6); PG8_BAR; PG8_MMA(1, 1, At, B1); PG8_BAR;
            PG8_LDB(B0, 1, 0); PG8_SCHED; PG8_LDA(At, 1, 0); PG8_STAGE(PG8_SA(0, 1), a2 + hstep, voffA);
            PG8_WAIT_L(8); PG8_BAR; PG8_WAIT_L(0); PG8_MMA(0, 0, At, B0); PG8_BAR; PG8_SCHED;
            PG8_LDB(B1, 1, 1); PG8_STAGE(PG8_SB(1, 0), b3, voffB);
            PG8_BAR; PG8_WAIT_L(0); PG8_MMA(0, 1, At, B1); PG8_BAR;
            PG8_LDA(At, 1, 1); PG8_STAGE(PG8_SA(1, 0), a3, voffA);
            PG8_BAR; PG8_WAIT_L(0); PG8_MMA(1, 0, At, B0); PG8_BAR; PG8_SCHED;
            PG8_STAGE(PG8_SB(1, 1), b3 + hstep, voffB);
            PG8_WAIT_V(6); PG8_BAR; PG8_MMA(1, 1, At, B1); PG8_BAR;
            }
        }
        if constexpr (ALIGN_EPI) { if (wr == 0) PG8_BAR; }
        if constexpr (!Epi::AFTER_DRAIN) { E(acc, cur, wr, wc, fr, fq); S.done(cur); }
        if (!has_next) break;
#pragma unroll
        for (int a = 0; a < 2; ++a)
#pragma unroll
            for (int b = 0; b < 2; ++b)
#pragma unroll
                for (int m = 0; m < 4; ++m)
#pragma unroll
                    for (int n = 0; n < 2; ++n) acc[a][b][m][n] = (f32x4){0.f, 0.f, 0.f, 0.f};
        cur = nxt; cA = nA; cB = nB; ++ui;
        if constexpr (ALIGN_EPI) { if (wr == 1) PG8_BAR; }
    }
    PG8_WAIT_V(0);
    if constexpr (!ALIGN_EPI) { if (wr == 0) PG8_BAR; }
    PG8_BAR;
#undef PG8_SA
#undef PG8_SB
#undef PG8_STAGE
#undef PG8_LDA
#undef PG8_LDB
#undef PG8_MMA
#undef PG8_WAIT_V
#undef PG8_WAIT_L
#undef PG8_BAR
#undef PG8_SCHED
}
}

constexpr int NWAVES = 8, NTHR = 512;
constexpr int DM = 1024, SEQ = 8192, NB = 2, CTX = 256, TL = NB * SEQ, TC = NB * CTX, TT = TL + TC;
constexpr int FFN = 2752, FFNP = 2816, NWI = 5632, INW = 2432, INWP = 2560, NMOD = 9;
constexpr int ZF = 0, ZQ = 256, ZK = 640, ZV = 768, ZRR = 896, ZRK = 1280, ZRV = 1664, ZW = 2048, ZA = 2176, ZG = 2304;
constexpr int RW = 384;
constexpr float NORM_EPS = 1e-6f, GN_EPS = 64e-5f;

constexpr size_t MiB = 1u << 20;
constexpr size_t WS_CTL = 0, WS_MOD = 1 * MiB, WS_ROPE = 2 * MiB, WS_XC = 4 * MiB, WS_GC = 6 * MiB;
constexpr size_t WS_WI1 = 8 * MiB, WS_WO1 = 19 * MiB, WS_WIN = 25 * MiB, WS_WOUT = 30 * MiB, WS_WI2 = 32 * MiB, WS_WO2 = 43 * MiB;
constexpr size_t WS_H = 49 * MiB;
constexpr size_t WS_ACT = 82 * MiB;
constexpr size_t WS_O = 173 * MiB;
constexpr size_t WS_W2T = WS_MOD + 256 * 1024, WS_A2T = WS_MOD + 512 * 1024, WS_G2T = WS_MOD + 768 * 1024;
constexpr size_t WS_LW = WS_O, WS_IC = WS_O + 25 * MiB;
constexpr size_t WS_GAM32 = 165 * MiB;
constexpr size_t WS_XB = 239 * MiB;
constexpr size_t OUT_FA = 0;
constexpr size_t OUT_SUM = 16 * MiB;
constexpr size_t WS_END = 272 * MiB;

constexpr size_t WS_FT = 7 * MiB;
constexpr size_t FT_W64C = 0, FT_W64S = 8192, FT_W128C = 16384, FT_W128S = 49152, FT_T64C = 81920, FT_T64S = 90112;
constexpr int LDS_BYTES = 147456;
constexpr int MISC_OFF = 146432;
#define TPROBE -1
#define TPROBE2 -1
#if TPROBE >= 0
#define T0(v) const unsigned long long v = __builtin_amdgcn_s_memrealtime()
#define TACC(F, id, v) do { if (((id) == TPROBE || (id) == TPROBE2) && (F).tid == 0) { volatile LAS unsigned* _m = (volatile LAS unsigned*)((F).lds + MISC_OFF); _m[(id) == TPROBE ? 24 : 25] += (unsigned)(__builtin_amdgcn_s_memrealtime() - (v)); } } while (0)
#else
#define T0(v)
#define TACC(F, id, v)
#endif

typedef unsigned short bf16;
typedef float f32x4 __attribute__((ext_vector_type(4)));
typedef unsigned v4u __attribute__((ext_vector_type(4)));
typedef unsigned v2u __attribute__((ext_vector_type(2)));
#define LAS __attribute__((address_space(3)))
#define LDS_WAIT() asm volatile("s_waitcnt lgkmcnt(0)" ::: "memory")

__device__ __forceinline__ unsigned f2bf(float f) { unsigned u = __builtin_bit_cast(unsigned, f); return (u + 0x7fffu + ((u >> 16) & 1u)) >> 16; }
__device__ __forceinline__ unsigned pk2(float lo, float hi) { return f2bf(lo) | (f2bf(hi) << 16); }
__device__ __forceinline__ float bf2f(unsigned short u) { return __builtin_bit_cast(float, (unsigned)u << 16); }
__device__ __forceinline__ float bflo(unsigned u) { return __builtin_bit_cast(float, u << 16); }
__device__ __forceinline__ float bfhi(unsigned u) { return __builtin_bit_cast(float, u & 0xffff0000u); }
__device__ __forceinline__ void unpack8(const v4u w, float (&f)[8]) { f[0] = bflo(w.x); f[1] = bfhi(w.x); f[2] = bflo(w.y); f[3] = bfhi(w.y); f[4] = bflo(w.z); f[5] = bfhi(w.z); f[6] = bflo(w.w); f[7] = bfhi(w.w); }
template <int CTRL> __device__ __forceinline__ float dppx(float v) { return __builtin_bit_cast(float, __builtin_amdgcn_update_dpp(0, __builtin_bit_cast(int, v), CTRL, 0xf, 0xf, true)); }
__device__ __forceinline__ float sum8(float v) { v += dppx<0xB1>(v); v += dppx<0x4E>(v); v += dppx<0x141>(v); return v; }
__device__ __forceinline__ float sum16(float v) { v = sum8(v); v += dppx<0x140>(v); return v; }
__device__ __forceinline__ float xrow_sum(float v) {
    float a = v, b2 = v; asm volatile("s_nop 1\n\tv_permlane16_swap_b32 %0, %1" : "+v"(a), "+v"(b2)); v = a + b2;
    a = v; b2 = v; asm volatile("s_nop 1\n\tv_permlane32_swap_b32 %0, %1" : "+v"(a), "+v"(b2)); return a + b2; }
__device__ __forceinline__ float xrow_max(float v) {
    float a = v, b2 = v; asm volatile("s_nop 1\n\tv_permlane16_swap_b32 %0, %1" : "+v"(a), "+v"(b2)); v = fmaxf(a, b2);
    a = v; b2 = v; asm volatile("s_nop 1\n\tv_permlane32_swap_b32 %0, %1" : "+v"(a), "+v"(b2)); return fmaxf(a, b2); }
__device__ __forceinline__ float wave_sum(float v) { return xrow_sum(sum16(v)); }
__device__ __forceinline__ float wave_max(float v) {
#pragma unroll
    for (int o = 1; o < 64; o <<= 1) v = fmaxf(v, __shfl_xor(v, o));
    return v;
}

struct Args { const float* in[25]; float* out; unsigned char* ws; int ph_lo, ph_hi; };

struct Frame {
    LAS unsigned char* lds;
    int tid, lane, wave, G, bid;
    float* out; unsigned char* ws;
};
enum { I_X = 0, I_C, I_CTX, I_CCTX, I_MODW, I_MODB, I_NORMG, I_F1WI, I_F1WO, I_WIN, I_WOUT, I_SINK, I_CONV, I_W0, I_W2, I_A0, I_A2, I_G2, I_KK, I_KA, I_RK, I_LNG, I_LNB, I_F2WI, I_F2WO };

__device__ __forceinline__ const float* inp(int i) {
    const __attribute__((address_space(4))) char* p = (const __attribute__((address_space(4))) char*)__builtin_amdgcn_kernarg_segment_ptr();
    asm volatile("" : "+s"(p));
    return (const float*)*(const __attribute__((address_space(1))) float* const __attribute__((address_space(4)))*)(p + 8 * i);
}
struct CvtDesc { const float* W; bf16* WT; int ldw, k0, sc, Kd, n0d; bool valid, live; };
__device__ __forceinline__ void cvt_load(const CvtDesc& d, f32x4 (&v)[8], int lane) {
    const int c4 = lane & 7, r8 = lane >> 3;
#pragma unroll
    for (int i = 0; i < 8; ++i) v[i] = (d.live && d.valid) ? *(const f32x4*)(d.W + (size_t)(d.k0 + 8 * i + r8) * d.ldw + d.sc + 4 * c4) : (f32x4){0.f, 0.f, 0.f, 0.f};
}
__device__ __forceinline__ void cvt_finish(const CvtDesc& d, const f32x4 (&v)[8], LAS float* scr, int lane) {
    if (!d.live) return;
    const int c4 = lane & 7, r8 = lane >> 3;
#pragma unroll
    for (int i = 0; i < 8; ++i) *(LAS f32x4*)(scr + (8 * i + r8) * 36 + 4 * c4) = v[i];
    LDS_WAIT(); asm volatile("" ::: "memory");
    const int c = lane & 7;
#pragma unroll
    for (int j = 0; j < 4; ++j) { const int n = (lane >> 3) + 8 * j; const LAS float* s = scr + (8 * c) * 36 + n;
        v4u o; o.x = pk2(s[0 * 36], s[1 * 36]); o.y = pk2(s[2 * 36], s[3 * 36]); o.z = pk2(s[4 * 36], s[5 * 36]); o.w = pk2(s[6 * 36], s[7 * 36]);
        *(v4u*)(d.WT + (size_t)(d.n0d + n) * d.Kd + d.k0 + 8 * c) = o; }
    LDS_WAIT(); asm volatile("" ::: "memory");
}
__device__ __forceinline__ CvtDesc cvt_decode(Frame& F, int li, int set, int it) {
    constexpr int I_WI = 16 * (NWI / 32), I_WO = (FFNP / 64) * 32, I_IN = 16 * (INWP / 32), I_OUT = 16 * 32;
    constexpr int NITEMS = 2 * I_WI + 2 * I_WO + I_IN + I_OUT;
    CvtDesc d{}; d.live = it < NITEMS; if (!d.live) return d;
    int r = it;
    if (set) { const bool inA = r < I_WI || (r >= 2 * I_WI && r < 2 * I_WI + I_WO) || (r >= 2 * I_WI + 2 * I_WO && r < 2 * I_WI + 2 * I_WO + I_IN); if (inA != (set == 1)) { d.live = false; return d; } }
    if (r < 2 * I_WI) { const int f = r / I_WI; r -= f * I_WI; const int nblk = NWI / 32, kb = r / nblk, nb = r % nblk;
        const int n0 = 32 * nb, pn = n0 >> 8, i = n0 & 255; const int j = 128 * pn + (i & 127);
        d.W = (f ? inp(I_F2WI) : inp(I_F1WI)) + (size_t)li * DM * 2 * FFN; d.ldw = 2 * FFN; d.k0 = 64 * kb; d.sc = (i < 128) ? j : FFN + j; d.valid = j < FFN; d.WT = (bf16*)(F.ws + (f ? WS_WI2 : WS_WI1)); d.Kd = DM; d.n0d = n0; return d; }
    r -= 2 * I_WI;
    if (r < 2 * I_WO) { const int f = r / I_WO; r -= f * I_WO; const int kb = r / 32, nb = r % 32;
        d.W = (f ? inp(I_F2WO) : inp(I_F1WO)) + (size_t)li * FFN * DM; d.ldw = DM; d.k0 = 64 * kb; d.sc = 32 * nb; d.valid = 64 * kb < FFN; d.WT = (bf16*)(F.ws + (f ? WS_WO2 : WS_WO1)); d.Kd = FFNP; d.n0d = 32 * nb; return d; }
    r -= 2 * I_WO;
    if (r < I_IN) { const int nblk = INWP / 32, kb = r / nblk, nb = r % nblk;
        d.W = inp(I_WIN) + (size_t)li * DM * INW; d.ldw = INW; d.k0 = 64 * kb; d.sc = 32 * nb; d.valid = 32 * nb < INW; d.WT = (bf16*)(F.ws + WS_WIN); d.Kd = DM; d.n0d = 32 * nb; return d; }
    r -= I_IN;
    { const int kb = r / 32, nb = r % 32;
        d.W = inp(I_WOUT) + (size_t)li * DM * DM; d.ldw = DM; d.k0 = 64 * kb; d.sc = 32 * nb; d.valid = true; d.WT = (bf16*)(F.ws + WS_WOUT); d.Kd = DM; d.n0d = 32 * nb; return d; }
}
__device__ __forceinline__ void convert_weights(Frame& F, int li, int set = 0, int bid0 = 0, int nblk = 0) {
    if (nblk == 0) nblk = F.G;
    if (F.bid < bid0 || F.bid >= bid0 + nblk) return;
    LAS float* scr = (LAS float*)(F.lds + F.wave * 16384);
    const int gw = (F.bid - bid0) * NWAVES + F.wave, NGW = nblk * NWAVES;
    constexpr int NITEMS = 2 * 16 * (NWI / 32) + 2 * (FFNP / 64) * 32 + 16 * (INWP / 32) + 16 * 32;
    for (int it = gw; it < NITEMS; it += 2 * NGW) {
        const CvtDesc d0 = cvt_decode(F, li, set, it), d1 = cvt_decode(F, li, set, it + NGW);
        f32x4 v0[8], v1[8];
        cvt_load(d0, v0, F.lane); cvt_load(d1, v1, F.lane);
        cvt_finish(d0, v0, scr, F.lane); cvt_finish(d1, v1, scr, F.lane);
    }
}
__device__ __forceinline__ void mod_gemv(Frame& F) {
    LAS float* sc = (LAS float*)F.lds;
    LAS float* red = sc + 3 * 1024;
    __syncthreads();
    for (int i = F.tid; i < 3 * 1024; i += NTHR) { const int v = i >> 10, k = i & 1023; const float x = v < 2 ? inp(I_C)[v * 1024 + k] : inp(I_CCTX)[k]; sc[i] = x / (1.0f + __expf(-x)); }
    __syncthreads();
    float* modv = (float*)(F.ws + WS_MOD);
    for (int u = F.bid; u < 2 * 72; u += F.G) {
        const int l = u / 72, n0 = (u % 72) * 128;
        const float* w = inp(I_MODW) + (size_t)l * DM * 9216 + n0 + 2 * F.lane;
        float a0 = 0.f, a1 = 0.f, b0 = 0.f, b1 = 0.f, c0 = 0.f, c1 = 0.f;
        const int k0 = F.wave * 128;
#pragma unroll 8
        for (int k = 0; k < 128; ++k) { const float2 wv = *(const float2*)(w + (size_t)(k0 + k) * 9216); const float s0 = sc[k0 + k], s1 = sc[1024 + k0 + k], s2 = sc[2048 + k0 + k];
            a0 += s0 * wv.x; a1 += s0 * wv.y; b0 += s1 * wv.x; b1 += s1 * wv.y; c0 += s2 * wv.x; c1 += s2 * wv.y; }
        LAS float* rw = red + F.wave * 384 + 2 * F.lane;
        rw[0] = a0; rw[1] = a1; rw[128] = b0; rw[129] = b1; rw[256] = c0; rw[257] = c1;
        __syncthreads();
        if (F.tid < 384) { float s = 0.f;
#pragma unroll
            for (int w8 = 0; w8 < 8; ++w8) s += red[w8 * 384 + F.tid];
            const int v = F.tid >> 7, n = n0 + (F.tid & 127);
            modv[(size_t)(l * 3 + v) * 9216 + n] = s + inp(I_MODB)[l * 9216 + n]; }
        __syncthreads();
    }
}
__device__ __forceinline__ void rope_tables(Frame& F) {
    float* ct = (float*)(F.ws + WS_ROPE); float* st = ct + SEQ * 32;
    for (int i = F.bid * NTHR + F.tid; i < SEQ * 32; i += F.G * NTHR) {
        const int t = i >> 5, j = i & 31; const int f = j & 15;
        const float inv = exp2f(-(float)f * (13.287712379549449f / 16.0f));
        const float pos = (float)(j < 16 ? (t >> 6) : (t & 63));
        const float ang = pos * inv;
        const double a = (double)ang; const double k = __builtin_rint(a * 0.15915494309189535); const float r = (float)(a - k * 6.283185307179586);
        ct[i] = __cosf(r); st[i] = __sinf(r);
    }
}

struct EArgs { const float* xl_src; const float* xc_src; const bf16* xb_src; bf16* xb_dst; float* out32; const bf16* o; const float* modv_g; int gidx; float gmul; const float* gpost;
               bf16* hdst; const float* modv_h; int shidx, scidx; const float* gpre; int nrows; };
template <int R>
__device__ __forceinline__ void e_rows(Frame& F, const EArgs& A, int v, int r0) {
    f32x4 cg[4], ch[4], cs[4];
#pragma unroll
    for (int j = 0; j < 4; ++j) { const int c = F.lane + 64 * j;
        if (A.o) cg[j] = ((const f32x4*)(A.modv_g + (size_t)v * 9216 + A.gidx * DM))[c] * ((const f32x4*)A.gpost)[c] * A.gmul;
        if (A.hdst) { ch[j] = ((const f32x4*)A.gpre)[c] * (1.0f + ((const f32x4*)(A.modv_h + (size_t)v * 9216 + A.scidx * DM))[c]); cs[j] = ((const f32x4*)(A.modv_h + (size_t)v * 9216 + A.shidx * DM))[c]; } }
    f32x4 x[R][4]; v2u ow[R][4];
#pragma unroll
    for (int i = 0; i < R; ++i) { const int r = r0 + i;
        if (A.xb_src) { const v2u* xs = (const v2u*)(A.xb_src + (size_t)r * DM);
#pragma unroll
            for (int j = 0; j < 4; ++j) { const v2u w = xs[F.lane + 64 * j]; x[i][j] = (f32x4){bflo(w.x), bfhi(w.x), bflo(w.y), bfhi(w.y)}; } }
        else { const float* xs = r < TL ? A.xl_src + (size_t)r * DM : A.xc_src + (size_t)(r - TL) * DM;
#pragma unroll
            for (int j = 0; j < 4; ++j) x[i][j] = ((const f32x4*)xs)[F.lane + 64 * j]; }
        if (A.o) { const v2u* orow = (const v2u*)(A.o + (size_t)r * DM);
#pragma unroll
            for (int j = 0; j < 4; ++j) ow[i][j] = orow[F.lane + 64 * j]; } }
#pragma unroll
    for (int i = 0; i < R; ++i) { const int r = r0 + i;
        if (A.o) { f32x4 ov[4]; float ss = 0.f;
#pragma unroll
            for (int j = 0; j < 4; ++j) { const v2u w = ow[i][j]; ov[j] = (f32x4){bflo(w.x), bfhi(w.x), bflo(w.y), bfhi(w.y)}; ss += (ov[j].x * ov[j].x + ov[j].y * ov[j].y) + (ov[j].z * ov[j].z + ov[j].w * ov[j].w); }
            const float rstd = 1.0f / sqrtf(wave_sum(ss) * (1.0f / DM) + NORM_EPS);
#pragma unroll
            for (int j = 0; j < 4; ++j) x[i][j] = x[i][j] + cg[j] * (ov[j] * rstd);
            if (A.out32) {
#pragma unroll
                for (int j = 0; j < 4; ++j) ((f32x4*)(A.out32 + (size_t)r * DM))[F.lane + 64 * j] = x[i][j]; }
            else { v2u* xd = (v2u*)(A.xb_dst + (size_t)r * DM);
#pragma unroll
                for (int j = 0; j < 4; ++j) { v2u w; w.x = pk2(x[i][j].x, x[i][j].y); w.y = pk2(x[i][j].z, x[i][j].w); xd[F.lane + 64 * j] = w; } } }
        if (A.hdst) { float ss = 0.f;
#pragma unroll
            for (int j = 0; j < 4; ++j) ss += (x[i][j].x * x[i][j].x + x[i][j].y * x[i][j].y) + (x[i][j].z * x[i][j].z + x[i][j].w * x[i][j].w);
            const float rstd = 1.0f / sqrtf(wave_sum(ss) * (1.0f / DM) + NORM_EPS);
            v2u* hd = (v2u*)(A.hdst + (size_t)r * DM);
#pragma unroll
            for (int j = 0; j < 4; ++j) { const f32x4 hv = (x[i][j] * rstd) * ch[j] + cs[j]; v2u w; w.x = pk2(hv.x, hv.y); w.y = pk2(hv.z, hv.w); hd[F.lane + 64 * j] = w; } } }
}
__device__ __forceinline__ void e_phase(Frame& F, const EArgs& A) {
    const int gw = F.bid * NWAVES + F.wave, NGW = F.G * NWAVES;
    if (NGW == 2048) {
        const int b = gw >> 10, r0 = b * SEQ + (gw & 1023) * 8;
        e_rows<4>(F, A, b, r0); e_rows<4>(F, A, b, r0 + 4);
        if (A.nrows > TL && (gw & 3) == 0) e_rows<1>(F, A, 2, TL + (gw >> 2));
    } else { for (int r = gw; r < A.nrows; r += NGW) e_rows<1>(F, A, r < TL ? (r >> 13) : 2, r); }
}

__device__ __forceinline__ const bf16* zrow(const Frame& F, int row) { return (const bf16*)(F.ws + WS_ACT) + (size_t)row * INWP; }

typedef short bf16x8 __attribute__((ext_vector_type(8)));
#define MFMA16(a, b, c) __builtin_amdgcn_mfma_f32_16x16x32_bf16(a, b, c, 0, 0, 0)
__device__ __forceinline__ bf16x8 mk8(unsigned a, unsigned b, unsigned c, unsigned d) { const v4u v = {a, b, c, d}; return __builtin_bit_cast(bf16x8, v); }
typedef __bf16 bf16x2_t __attribute__((ext_vector_type(2)));
typedef float f32x2_t __attribute__((ext_vector_type(2)));
__device__ __forceinline__ unsigned cvtpk(float lo, float hi) { const f32x2_t f = {lo, hi}; return __builtin_bit_cast(unsigned, __builtin_convertvector(f, bf16x2_t)); }
constexpr int NSC = 66;
constexpr int IM_AI = 0, IM_RI = 4608, IM_BI = 9216, IM_KI = 13824, IM_BKT = 18432, IM_VT = 28928, IM_GAM = 34176, IMG_BYTES = 34816;
constexpr int L_IMG0 = 0, L_IMG1 = IMG_BYTES, L_PKG = 2 * IMG_BYTES, L_YL = L_PKG + 8192, L_VB = L_YL + 128 * 68 * 4, L_BON = L_VB + 128 * 64 * 2, L_CST = L_BON + 512, L_RW_END = L_CST + 2 * 3072;
static_assert(L_RW_END <= 146432, "rwkv LDS map");
constexpr size_t SUM_SLOT = 24576;

__device__ __forceinline__ void fourier_ctx1_all(Frame& F) {
    bf16* gre = (bf16*)(F.ws + WS_GC); bf16* gim = gre + TC * 256;
    const bf16* wc = (const bf16*)(F.ws + WS_FT + FT_W64C); const bf16* wsn = (const bf16*)(F.ws + WS_FT + FT_W64S);
    for (int i = F.bid * NTHR + F.tid; i < TC * 256; i += F.G * NTHR) { const int tok = i & (TC - 1), gm = i >> 9, g = gm >> 6, m = gm & 63;
        const bf16* z = zrow(F, TL + tok) + ZF + 64 * g; float sr = 0.f, si = 0.f;
#pragma unroll
        for (int c8 = 0; c8 < 8; ++c8) { float x[8], cs[8], sn[8]; unpack8(*(const v4u*)(z + 8 * c8), x); unpack8(*(const v4u*)(wc + m * 64 + 8 * c8), cs); unpack8(*(const v4u*)(wsn + m * 64 + 8 * c8), sn);
#pragma unroll
            for (int e = 0; e < 8; ++e) { sr += x[e] * cs[e]; si -= x[e] * sn[e]; } }
        const int o = ((tok >> 8) * 256 + gm) * 256 + (tok & 255);
        gre[o] = (bf16)f2bf(sr); gim[o] = (bf16)f2bf(si); }
}
__device__ __forceinline__ void fourier_ctx2_all(Frame& F, int bid0) {
    const bf16* gre = (const bf16*)(F.ws + WS_GC); const bf16* gim = gre + TC * 256; bf16* mix = (bf16*)(F.ws + WS_H);
    const int q = F.lane >> 4, c = F.lane & 15;
#pragma unroll 1
    for (int u = (F.bid - bid0) * 8 + F.wave; u < 512; u += (F.G - bid0) * 8) { const int b = u >> 8, kt = (u >> 4) & 15, gt = u & 15;
        const int k = 16 * kt + c; const bf16* pr = gre + (size_t)((b * 256 + 16 * gt + c) * 256 + 8 * q); const bf16* pi = gim + (size_t)((b * 256 + 16 * gt + c) * 256 + 8 * q);
        f32x4 acc = {0.f, 0.f, 0.f, 0.f};
#pragma unroll
        for (int cc = 0; cc < 8; ++cc) { const bf16x8 re = *(const bf16x8*)(pr + 32 * cc), im = *(const bf16x8*)(pi + 32 * cc);
            float cv[8], sv[8];
#pragma unroll
            for (int e = 0; e < 8; ++e) { const float a = (float)((k * (32 * cc + 8 * q + e)) & 255) * (1.0f / 256.0f); cv[e] = __builtin_amdgcn_cosf(a); sv[e] = __builtin_amdgcn_sinf(a); }
            acc = MFMA16(mk8(cvtpk(cv[0], cv[1]), cvtpk(cv[2], cv[3]), cvtpk(cv[4], cv[5]), cvtpk(cv[6], cv[7])), re, acc);
            acc = MFMA16(mk8(cvtpk(sv[0], sv[1]), cvtpk(sv[2], sv[3]), cvtpk(sv[4], sv[5]), cvtpk(sv[6], sv[7])), im, acc); }
#pragma unroll
        for (int r = 0; r < 4; ++r) mix[(size_t)(TL + b * 256 + 16 * kt + 4 * q + r) * DM + 16 * gt + c] = (bf16)f2bf(acc[r] * 0.0078125f); }
}
__device__ __forceinline__ void lora_transposes(Frame& F) {
    bf16* w2t = (bf16*)(F.ws + WS_W2T); bf16* a2t = (bf16*)(F.ws + WS_A2T); bf16* g2t = (bf16*)(F.ws + WS_G2T);
    const float* w2 = inp(I_W2); const float* a2 = inp(I_A2); const float* g2 = inp(I_G2);
    for (int i = F.bid * NTHR + F.tid; i < 4 * 384 * 64; i += F.G * NTHR) { const int r = i & 63, col = (i >> 6) % 384, ld = i / (384 * 64);
        w2t[i] = (bf16)f2bf(w2[((size_t)ld * 64 + r) * RW + col]); a2t[i] = (bf16)f2bf(a2[((size_t)ld * 64 + r) * RW + col]); }
    for (int i = F.bid * NTHR + F.tid; i < 2 * 384 * 128; i += F.G * NTHR) { const int r = i & 127, col = (i >> 7) % 384, l = i / (384 * 128);
        g2t[i] = (bf16)f2bf(g2[((size_t)l * 128 + r) * RW + col]); }
}

__device__ __forceinline__ float softplus_fast(float x) { return fmaxf(x, 0.f) + __logf(1.0f + __expf(-fabsf(x))); }
__device__ __forceinline__ float tanh_fast(float x) { return 1.0f - 2.0f * __builtin_amdgcn_rcpf(1.0f + __expf(2.0f * x)); }
template <int CTRL> __device__ __forceinline__ float dpp_f(float v) { return __builtin_bit_cast(float, __builtin_amdgcn_update_dpp(0, __builtin_bit_cast(int, v), CTRL, 0xf, 0xf, true)); }
__device__ __forceinline__ void lora_pass(Frame& F, int li) {
    const int q = F.lane >> 4, c16 = F.lane & 15;
#pragma unroll 1
    for (int dir = 0; dir < 2; ++dir) {
        bf16* LW = (bf16*)(F.ws + WS_LW) + (size_t)dir * TT * RW; bf16* IC = (bf16*)(F.ws + WS_IC) + (size_t)dir * TT * RW;
        const bf16* w2t = (const bf16*)(F.ws + WS_W2T) + (size_t)(li * 2 + dir) * 384 * 64; const bf16* a2t = (const bf16*)(F.ws + WS_A2T) + (size_t)(li * 2 + dir) * 384 * 64;
        bf16x8 aw[3][2], aa[3][2]; f32x4 w0v[3], a0v[3];
#pragma unroll
        for (int cti = 0; cti < 3; ++cti) { const int ct = 3 * F.wave + cti, col = 16 * ct + c16;
#pragma unroll
            for (int k = 0; k < 2; ++k) { aw[cti][k] = *(const bf16x8*)(w2t + (size_t)col * 64 + 32 * k + 8 * q); aa[cti][k] = *(const bf16x8*)(a2t + (size_t)col * 64 + 32 * k + 8 * q); }
            w0v[cti] = *(const f32x4*)(inp(I_W0) + (li * 2 + dir) * RW + 16 * ct + 4 * q); a0v[cti] = *(const f32x4*)(inp(I_A0) + (li * 2 + dir) * RW + 16 * ct + 4 * q); }
#pragma unroll 1
        for (int rt = F.bid; rt < TT / 16; rt += F.G) {
            const bf16* z = zrow(F, 16 * rt + c16);
            bf16x8 bw[2], ba[2];
#pragma unroll
            for (int k = 0; k < 2; ++k) { const v4u zw = *(const v4u*)(z + ZW + 64 * dir + 32 * k + 8 * q); ba[k] = *(const bf16x8*)(z + ZA + 64 * dir + 32 * k + 8 * q);
                bw[k] = mk8(cvtpk(tanh_fast(bflo(zw.x)), tanh_fast(bfhi(zw.x))), cvtpk(tanh_fast(bflo(zw.y)), tanh_fast(bfhi(zw.y))), cvtpk(tanh_fast(bflo(zw.z)), tanh_fast(bfhi(zw.z))), cvtpk(tanh_fast(bflo(zw.w)), tanh_fast(bfhi(zw.w)))); }
#pragma unroll
            for (int cti = 0; cti < 3; ++cti) { const int ct = 3 * F.wave + cti;
                f32x4 dw = {0.f, 0.f, 0.f, 0.f}, da = {0.f, 0.f, 0.f, 0.f};
#pragma unroll
                for (int k = 0; k < 2; ++k) { dw = MFMA16(aw[cti][k], bw[k], dw); da = MFMA16(aa[cti][k], ba[k], da); }
                float lw[4], ic[4];
#pragma unroll
                for (int e = 0; e < 4; ++e) { const float x = w0v[cti][e] + dw[e]; const float wl = -softplus_fast(-x) - 0.5f; lw[e] = -__expf(wl); ic[e] = __builtin_amdgcn_rcpf(1.0f + __expf(-(a0v[cti][e] + da[e]))); }
                if (dir == 0) {
#pragma unroll
                    for (int e = 0; e < 4; ++e) { lw[e] += dpp_f<0x111>(lw[e]); lw[e] += dpp_f<0x112>(lw[e]); lw[e] += dpp_f<0x114>(lw[e]); lw[e] += dpp_f<0x118>(lw[e]); } }
                else {
#pragma unroll
                    for (int e = 0; e < 4; ++e) { lw[e] += dpp_f<0x101>(lw[e]); lw[e] += dpp_f<0x102>(lw[e]); lw[e] += dpp_f<0x104>(lw[e]); lw[e] += dpp_f<0x108>(lw[e]); } }
#pragma unroll
                for (int e = 0; e < 4; ++e) lw[e] = __expf(lw[e]);
                if (c16 == (dir == 0 ? 15 : 0)) *(f32x4*)((float*)(F.ws + WS_GAM32) + ((size_t)dir * (TT / 16) + rt) * RW + 16 * ct + 4 * q) = (f32x4){lw[0], lw[1], lw[2], lw[3]};
                const size_t o = (size_t)(16 * rt + c16) * RW + 16 * ct + 4 * q;
                v2u w; w.x = cvtpk(lw[0], lw[1]); w.y = cvtpk(lw[2], lw[3]); *(v2u*)(LW + o) = w; w.x = cvtpk(ic[0], ic[1]); w.y = cvtpk(ic[2], ic[3]); *(v2u*)(IC + o) = w; }
        }
    }
}
__device__ __forceinline__ void chain_consts_lds(Frame& F, LAS float* cst, int li, int h, int t256) {
    for (int i = t256; i < 12 * 64; i += 256) { const int k = i >> 6, j = i & 63, ch = 64 * h + j; float v;
        if (k == 0) v = inp(I_KK)[li * RW + ch]; else if (k == 1) v = inp(I_KA)[li * RW + ch]; else if (k == 2) v = inp(I_RK)[li * RW + ch];
        else { const int tt = (k - 3) / 3, w = (k - 3) % 3; v = inp(I_CONV)[(size_t)(li * 3 + tt) * (3 * RW) + w * RW + ch]; }
        cst[i] = v; }
}
struct PrepRaw { v4u ecw, icv, epw, zr[3], zk[3], zv[3]; f32x4 g0, g1; };
__device__ __forceinline__ void prep_load(Frame& F, PrepRaw& R, int dir, int b, int h, int tl, int o, bool isctx, int step0) {
    const int L = isctx ? CTX : SEQ, rbase = isctx ? TL + b * CTX : b * SEQ, ch0 = 64 * h + 8 * o;
    const int s = step0 + tl; const int p = dir ? L - 1 - s : s; const int row = rbase + p, tb = tl & 15;
    { const bf16* LW = (const bf16*)(F.ws + WS_LW) + (size_t)dir * TT * RW + ch0; const bf16* IC = (const bf16*)(F.ws + WS_IC) + (size_t)dir * TT * RW + ch0;
      R.ecw = *(const v4u*)(LW + (size_t)row * RW); R.icv = *(const v4u*)(IC + (size_t)row * RW); R.epw = *(const v4u*)(LW + (size_t)(tb == 0 ? row : (dir ? row + 1 : row - 1)) * RW); }
#pragma unroll
    for (int tt = 0; tt < 3; ++tt) { const int pp = p + tt - 1; const bool ok = pp >= 0 && pp < L; const bf16* z = zrow(F, rbase + (ok ? pp : p)) + ch0;
        const v4u z0 = {0u, 0u, 0u, 0u};
        R.zr[tt] = ok ? *(const v4u*)(z + ZRR) : z0; R.zk[tt] = ok ? *(const v4u*)(z + ZRK) : z0; R.zv[tt] = ok ? *(const v4u*)(z + ZRV) : z0; }
    if (tb == 15) { const f32x4* gs = (const f32x4*)((const float*)(F.ws + WS_GAM32) + ((size_t)dir * (TT / 16) + (row >> 4)) * RW + ch0); R.g0 = gs[0]; R.g1 = gs[1]; }
}
__device__ __forceinline__ void prep_compute(Frame& F, const PrepRaw& R, const LAS float* cst, LAS unsigned char* img, int dir, int b, int h, int tl, int o, bool isctx, int step0, LAS unsigned char* lds_vb, LAS float* lds_bon, int pos0_local) {
    const bool BONUS = lds_vb != nullptr;
    const int L = isctx ? CTX : SEQ, rbase = isctx ? TL + b * CTX : b * SEQ, ch0 = 64 * h + 8 * o;
    const int blk = tl >> 4, tb = tl & 15;
    const int s = step0 + tl; const int p = dir ? L - 1 - s : s; const int row = rbase + p;
    const v4u ecw = R.ecw, icv = R.icv, epw = R.epw;
    v4u zr[3], zk[3], zv[3];
#pragma unroll
    for (int tt = 0; tt < 3; ++tt) { zr[tt] = R.zr[tt]; zk[tt] = R.zk[tt]; zv[tt] = R.zv[tt]; }
    float ecf[8], epf[8], ai[8], rv[8], kv[8], vv[8];
    unpack8(ecw, ecf); unpack8(epw, epf); unpack8(icv, ai);
#pragma unroll
    for (int e = 0; e < 8; ++e) { rv[e] = 0.f; kv[e] = 0.f; vv[e] = 0.f; }
#pragma unroll
    for (int tt = 0; tt < 3; ++tt) { float a[8], bq[8], cq[8]; unpack8(zr[tt], a); unpack8(zk[tt], bq); unpack8(zv[tt], cq);
        const LAS f32x4* w0 = (const LAS f32x4*)(cst + (3 + tt * 3 + 0) * 64 + 8 * o); const LAS f32x4* w1 = (const LAS f32x4*)(cst + (3 + tt * 3 + 1) * 64 + 8 * o); const LAS f32x4* w2 = (const LAS f32x4*)(cst + (3 + tt * 3 + 2) * 64 + 8 * o);
        const f32x4 w0a = w0[0], w0b = w0[1], w1a = w1[0], w1b = w1[1], w2a = w2[0], w2b = w2[1];
#pragma unroll
        for (int e = 0; e < 4; ++e) { rv[e] += w0a[e] * a[e]; rv[e + 4] += w0b[e] * a[e + 4]; kv[e] += w1a[e] * bq[e]; kv[e + 4] += w1b[e] * bq[e + 4]; vv[e] += w2a[e] * cq[e]; vv[e + 4] += w2b[e] * cq[e + 4]; } }
    float kkw[8], kaw[8];
    { const LAS f32x4* a = (const LAS f32x4*)(cst + 0 * 64 + 8 * o); const LAS f32x4* bq = (const LAS f32x4*)(cst + 1 * 64 + 8 * o); const f32x4 a0 = a[0], a1 = a[1], b0 = bq[0], b1 = bq[1];
#pragma unroll
      for (int e = 0; e < 4; ++e) { kkw[e] = a0[e]; kkw[e + 4] = a1[e]; kaw[e] = b0[e]; kaw[e + 4] = b1[e]; } }
    float kkr[8], ss = 0.f;
#pragma unroll
    for (int e = 0; e < 8; ++e) { kkr[e] = kv[e] * kkw[e]; ss += kkr[e] * kkr[e]; }
    ss = sum8(ss);
    const float rn = 1.0f / sqrtf(fmaxf(ss, 1e-24f));
    float At[8], Rt[8], Bt[8], Kt[8];
#pragma unroll
    for (int e = 0; e < 8; ++e) { const float kk = kkr[e] * rn, kd = kv[e] * (1.0f + (ai[e] - 1.0f) * kaw[e]); const float eprev = tb == 0 ? 1.0f : epf[e]; const float ec = ecf[e], en = 1.0f / ec;
        At[e] = -kk * eprev; Rt[e] = rv[e] * ec; Bt[e] = kk * ai[e] * en; Kt[e] = kd * en; }
    const int P0 = 32 * (o >> 2) + 16 * (o & 1) + 4 * ((o >> 1) & 1);
    LAS bf16* AI = (LAS bf16*)(img + IM_AI) + blk * 1152 + tb * 72 + P0, *RI = (LAS bf16*)(img + IM_RI) + blk * 1152 + tb * 72 + P0, *BI = (LAS bf16*)(img + IM_BI) + blk * 1152 + tb * 72 + P0, *KI = (LAS bf16*)(img + IM_KI) + blk * 1152 + tb * 72 + P0;
    unsigned bp[4], kp[4];
#pragma unroll
    for (int e = 0; e < 4; ++e) { bp[e] = cvtpk(Bt[2 * e], Bt[2 * e + 1]); kp[e] = cvtpk(Kt[2 * e], Kt[2 * e + 1]); }
    *(LAS v2u*)AI = (v2u){cvtpk(At[0], At[1]), cvtpk(At[2], At[3])}; *(LAS v2u*)(AI + 8) = (v2u){cvtpk(At[4], At[5]), cvtpk(At[6], At[7])};
    *(LAS v2u*)RI = (v2u){cvtpk(Rt[0], Rt[1]), cvtpk(Rt[2], Rt[3])}; *(LAS v2u*)(RI + 8) = (v2u){cvtpk(Rt[4], Rt[5]), cvtpk(Rt[6], Rt[7])};
    *(LAS v2u*)BI = (v2u){bp[0], bp[1]}; *(LAS v2u*)(BI + 8) = (v2u){bp[2], bp[3]};
    *(LAS v2u*)KI = (v2u){kp[0], kp[1]}; *(LAS v2u*)(KI + 8) = (v2u){kp[2], kp[3]};
    LAS bf16* BKT = (LAS bf16*)(img + IM_BKT) + blk * 2624 + (8 * o) * 40 + o * 8 + (tb >> 2) * 8 + (tb & 3); LAS bf16* VT = (LAS bf16*)(img + IM_VT) + blk * 1312 + (8 * o) * 20 + o * 4 + tb;
    const unsigned vp[4] = {cvtpk(vv[0], vv[1]), cvtpk(vv[2], vv[3]), cvtpk(vv[4], vv[5]), cvtpk(vv[6], vv[7])};
#pragma unroll
    for (int e = 0; e < 8; ++e) { const unsigned bb = bp[e >> 1], kq = kp[e >> 1], vq = vp[e >> 1];
        BKT[e * 40] = (bf16)((e & 1) ? (bb >> 16) : (bb & 0xffff)); BKT[e * 40 + 4] = (bf16)((e & 1) ? (kq >> 16) : (kq & 0xffff)); VT[e * 20] = (bf16)((e & 1) ? (vq >> 16) : (vq & 0xffff)); }
    if (tb == 15) { LAS f32x4* G = (LAS f32x4*)((LAS float*)(img + IM_GAM) + blk * 64 + 8 * o); G[0] = R.g0; G[1] = R.g1; }
    if (BONUS) { float bs = 0.f; const LAS f32x4* rk = (const LAS f32x4*)(cst + 2 * 64 + 8 * o); const f32x4 r0 = rk[0], r1 = rk[1];
#pragma unroll
        for (int e = 0; e < 4; ++e) bs += rv[e] * kv[e] * r0[e] + rv[e + 4] * kv[e + 4] * r1[e];
        bs = sum8(bs);
        const int pl = dir ? pos0_local - tl : pos0_local + tl;
        *(LAS v4u*)(lds_vb + (pl * 64 + 8 * o) * 2) = (v4u){vp[0], vp[1], vp[2], vp[3]}; if (o == 0) lds_bon[pl] = bs; }
}
template <bool WANT_Y>
__device__ __forceinline__ void block_package(LAS unsigned char* img, int blk, LAS unsigned* pkg, int lane) {
    const int q = lane >> 4, c = lane & 15;
    f32x4 mab = {0.f, 0.f, 0.f, 0.f}, mak = mab, mbr = mab, mkr = mab;
#pragma unroll
    for (int k = 0; k < 2; ++k) { const int o = blk * 2304 + c * 144 + k * 64 + q * 16;
        const bf16x8 bi = *(const LAS bf16x8*)(img + IM_BI + o), ki = *(const LAS bf16x8*)(img + IM_KI + o), ai = *(const LAS bf16x8*)(img + IM_AI + o);
        mab = MFMA16(bi, ai, mab); mak = MFMA16(ki, ai, mak);
        if constexpr (WANT_Y) { const bf16x8 ri = *(const LAS bf16x8*)(img + IM_RI + o); mbr = MFMA16(bi, ri, mbr); mkr = MFMA16(ki, ri, mkr); } }
#pragma unroll
    for (int e = 0; e < 4; ++e) { const int s = 4 * q + e; if (!(s < c)) { mab[e] = 0.f; mak[e] = 0.f; } if (!(s <= c)) { mbr[e] = 0.f; mkr[e] = 0.f; } }
    f32x4 mabT = {0.f, 0.f, 0.f, 0.f};
#pragma unroll
    for (int k = 0; k < 2; ++k) { const int o = blk * 2304 + c * 144 + k * 64 + q * 16; mabT = MFMA16(*(const LAS bf16x8*)(img + IM_AI + o), *(const LAS bf16x8*)(img + IM_BI + o), mabT); }
#pragma unroll
    for (int e = 0; e < 4; ++e) if (!(c < 4 * q + e)) mabT[e] = 0.f;
    const f32x4 z4 = {0.f, 0.f, 0.f, 0.f};
#define OPND(x) mk8(cvtpk((x)[0], (x)[1]), cvtpk((x)[2], (x)[3]), 0u, 0u)
    const bf16x8 oM = OPND(mab), oMT = OPND(mabT);
    const f32x4 m2 = MFMA16(oMT, oM, z4), m2T = MFMA16(oM, oMT, z4);
    const bf16x8 oM2 = OPND(m2), oM2T = OPND(m2T);
    const f32x4 m4 = MFMA16(oM2T, oM2, z4), m4T = MFMA16(oM2, oM2T, z4);
    const f32x4 m8T = MFMA16(OPND(m4), OPND(m4T), z4);
    f32x4 nn = m2;
#pragma unroll
    for (int e = 0; e < 4; ++e) nn[e] += (4 * q + e == c) ? 1.0f : 0.0f;
    nn = MFMA16(oMT, OPND(nn), nn);
    nn = MFMA16(OPND(m4T), OPND(nn), nn);
    nn = MFMA16(OPND(m8T), OPND(nn), nn);
#undef OPND
    pkg[0 * 64 + lane] = cvtpk(nn[0], nn[1]); pkg[1 * 64 + lane] = cvtpk(nn[2], nn[3]);
    pkg[2 * 64 + lane] = cvtpk(mak[0], mak[1]); pkg[3 * 64 + lane] = cvtpk(mak[2], mak[3]);
    if constexpr (WANT_Y) { pkg[4 * 64 + lane] = cvtpk(mbr[0], mbr[1]); pkg[5 * 64 + lane] = cvtpk(mbr[2], mbr[3]); pkg[6 * 64 + lane] = cvtpk(mkr[0], mkr[1]); pkg[7 * 64 + lane] = cvtpk(mkr[2], mkr[3]); }
}
template <bool WANT_Y, bool HAS_V>
__device__ __forceinline__ f32x4 block_scan(LAS unsigned char* img, int blk, const LAS unsigned* pkg, f32x4 (&S)[4], int wq, int lane) {
    const int q = lane >> 4, c = lane & 15;
    bf16x8 Sb[2];
#pragma unroll
    for (int k = 0; k < 2; ++k) Sb[k] = mk8(cvtpk(S[2 * k][0], S[2 * k][1]), cvtpk(S[2 * k][2], S[2 * k][3]), cvtpk(S[2 * k + 1][0], S[2 * k + 1][1]), cvtpk(S[2 * k + 1][2], S[2 * k + 1][3]));
    v2u vpk = {0u, 0u};
    if constexpr (HAS_V) vpk = *(const LAS v2u*)(img + IM_VT + blk * 2624 + (c + 16 * wq) * 40 + ((c + 16 * wq) >> 3) * 8 + q * 8);
    const int ao = blk * 2304 + c * 144 + q * 16;
    f32x4 rhs = {0.f, 0.f, 0.f, 0.f};
    rhs = MFMA16(*(const LAS bf16x8*)(img + IM_AI + ao), Sb[0], rhs); rhs = MFMA16(*(const LAS bf16x8*)(img + IM_AI + ao + 64), Sb[1], rhs);
    if constexpr (HAS_V) rhs = MFMA16(mk8(0u, 0u, pkg[2 * 64 + lane], pkg[3 * 64 + lane]), mk8(0u, 0u, vpk.x, vpk.y), rhs);
    f32x4 u = {0.f, 0.f, 0.f, 0.f};
    u = MFMA16(mk8(pkg[0 * 64 + lane], pkg[1 * 64 + lane], 0u, 0u), mk8(cvtpk(rhs[0], rhs[1]), cvtpk(rhs[2], rhs[3]), 0u, 0u), u);
    const bf16x8 UV = mk8(cvtpk(u[0], u[1]), cvtpk(u[2], u[3]), vpk.x, vpk.y);
    f32x4 y = {0.f, 0.f, 0.f, 0.f};
    if constexpr (WANT_Y) { y = MFMA16(*(const LAS bf16x8*)(img + IM_RI + ao), Sb[0], y); y = MFMA16(*(const LAS bf16x8*)(img + IM_RI + ao + 64), Sb[1], y);
        y = MFMA16(mk8(pkg[4 * 64 + lane], pkg[5 * 64 + lane], pkg[6 * 64 + lane], pkg[7 * 64 + lane]), UV, y); }
#pragma unroll
    for (int T = 0; T < 4; ++T) { const bf16x8 bkt = *(const LAS bf16x8*)(img + IM_BKT + blk * 5248 + (16 * T + c) * 80 + ((16 * T + c) >> 3) * 16 + q * 16);
        S[T] = MFMA16(bkt, UV, S[T]); const f32x4 g = *(const LAS f32x4*)(img + IM_GAM + blk * 256 + (16 * T + 4 * q) * 4); S[T] = S[T] * g; }
    return y;
}
__device__ __forceinline__ unsigned char* sum_slot(Frame& F, int chain, int sc) { return (unsigned char*)F.out + OUT_SUM + (size_t)(chain * NSC + sc) * SUM_SLOT; }

__device__ __forceinline__ void rwkv_pass1_pair(Frame& F, int li, int pair) {
    const int g = F.wave >> 2, wq = F.wave & 3, u = 2 * pair + g;
    const int chain = u / (NSC - 1), sc = u % (NSC - 1);
    const int dir = chain / 12, b = (chain / 6) & 1, h = chain % 6;
    const bool isctx = sc < 2; const int scl = isctx ? sc : sc - 2;
    LAS unsigned char* img = F.lds + (g ? L_IMG1 : L_IMG0); LAS unsigned* pkg = (LAS unsigned*)(F.lds + L_PKG) + g * 1024;
    LAS float* cst = (LAS float*)(F.lds + L_CST) + g * 768;
    __syncthreads();
    chain_consts_lds(F, cst, li, h, F.tid & 255);
    const int q = F.lane >> 4, c = F.lane & 15;
    f32x4 SB[4], SA[4];
#pragma unroll
    for (int T = 0; T < 4; ++T)
#pragma unroll
        for (int e = 0; e < 4; ++e) { SB[T][e] = 0.0f; SA[T][e] = (16 * T + 4 * q + e == c + 16 * wq) ? 1.0f : 0.0f; }
    PrepRaw R;
    prep_load(F, R, dir, b, h, 8 * wq + (F.lane >> 3), F.lane & 7, isctx, 128 * scl);
#pragma unroll 1
    for (int rd = 0; rd < 4; ++rd) {
        __syncthreads();
        prep_compute(F, R, cst, img, dir, b, h, 8 * wq + (F.lane >> 3), F.lane & 7, isctx, 128 * scl + 32 * rd, nullptr, nullptr, 0);
        __syncthreads();
        if (rd < 3) prep_load(F, R, dir, b, h, 8 * wq + (F.lane >> 3), F.lane & 7, isctx, 128 * scl + 32 * (rd + 1));
        if (wq < 2) block_package<false>(img, wq, pkg + wq * 512, F.lane);
        __syncthreads();
#pragma unroll
        for (int blk = 0; blk < 2; ++blk) { block_scan<false, true>(img, blk, pkg + blk * 512, SB, wq, F.lane); block_scan<false, false>(img, blk, pkg + blk * 512, SA, wq, F.lane); }
    }
    unsigned char* slot = sum_slot(F, chain, sc);
    { f32x4* braw = (f32x4*)slot;
#pragma unroll
      for (int T = 0; T < 4; ++T) braw[(wq * 4 + T) * 64 + F.lane] = SB[T]; }
    { bf16* aim = (bf16*)(slot + 16384); const int kap = wq >> 1, e = (F.lane & 3) + 4 * (wq & 1), qc = c >> 2;
#pragma unroll
      for (int T = 0; T < 4; ++T)
#pragma unroll
          for (int r = 0; r < 4; ++r) { const int lc = (4 * q + r) + 16 * qc; aim[((T * 2 + kap) * 64 + lc) * 8 + e] = (bf16)f2bf(SA[T][r]); } }
}
struct P2Stage { v4u b0, b1, a; };
__device__ __forceinline__ void p2_ld(Frame& F, P2Stage& X, int chain, int sc) {
    const v4u* s = (const v4u*)sum_slot(F, chain, sc);
    X.b0 = s[F.tid]; X.b1 = s[512 + F.tid]; X.a = s[1024 + F.tid];
}
__device__ __forceinline__ void p2_put(Frame& F, const P2Stage& X, LAS unsigned char* bb) {
    *(LAS v4u*)(bb + 16 * F.tid) = X.b0; *(LAS v4u*)(bb + 8192 + 16 * F.tid) = X.b1; *(LAS v4u*)(bb + 16384 + 16 * F.tid) = X.a;
}
constexpr int P2D = 8;
__device__ __forceinline__ void p2_math(Frame& F, const LAS unsigned char* bb, f32x4 (&S)[4], int chain, int sc, int wq) {
    f32x4* braw = (f32x4*)sum_slot(F, chain, sc);
    bf16x8 Sb[2];
#pragma unroll
    for (int k = 0; k < 2; ++k) Sb[k] = mk8(cvtpk(S[2 * k][0], S[2 * k][1]), cvtpk(S[2 * k][2], S[2 * k][3]), cvtpk(S[2 * k + 1][0], S[2 * k + 1][1]), cvtpk(S[2 * k + 1][2], S[2 * k + 1][3]));
#pragma unroll
    for (int T = 0; T < 4; ++T) { braw[(wq * 4 + T) * 64 + F.lane] = S[T];
        const f32x4 bc = *(const LAS f32x4*)(bb + ((wq * 4 + T) * 64 + F.lane) * 16);
        const bf16x8 a0 = *(const LAS bf16x8*)(bb + 16384 + ((T * 2 + 0) * 64 + F.lane) * 16), a1 = *(const LAS bf16x8*)(bb + 16384 + ((T * 2 + 1) * 64 + F.lane) * 16);
        S[T] = MFMA16(a1, Sb[1], MFMA16(a0, Sb[0], bc)); }
}
__device__ __forceinline__ void rwkv_pass2_chain(Frame& F, int chain) {
    constexpr int NS = NSC - 1;
    LAS unsigned char* buf = F.lds;
    P2Stage X[P2D];
#pragma unroll
    for (int j = 0; j < P2D; ++j) p2_ld(F, X[j], chain, j);
    __syncthreads();
    if (F.wave >= 4) {
#pragma unroll 1
        for (int sc0 = 0; sc0 < NS - 1; sc0 += P2D) {
#pragma unroll
            for (int j = 0; j < P2D; ++j) { const int sc = sc0 + j; p2_put(F, X[j], buf + (j & 1) * 24576); p2_ld(F, X[j], chain, min(sc + P2D, NS - 1)); __syncthreads(); } }
        p2_put(F, X[0], buf); __syncthreads();
        return;
    }
    const int wq = F.wave;
    f32x4 S[4];
#pragma unroll
    for (int T = 0; T < 4; ++T) S[T] = (f32x4){0.f, 0.f, 0.f, 0.f};
#pragma unroll 1
    for (int sc0 = 0; sc0 < NS - 1; sc0 += P2D) {
#pragma unroll
        for (int j = 0; j < P2D; ++j) { const int sc = sc0 + j; LAS unsigned char* bb = buf + (j & 1) * 24576;
            p2_put(F, X[j], bb); p2_ld(F, X[j], chain, min(sc + P2D, NS - 1));
            __syncthreads();
            p2_math(F, bb, S, chain, sc, wq); } }
    p2_put(F, X[0], buf); __syncthreads();
    p2_math(F, buf, S, chain, NS - 1, wq);
    { f32x4* braw = (f32x4*)sum_slot(F, chain, NSC - 1);
#pragma unroll
      for (int T = 0; T < 4; ++T) braw[(wq * 4 + T) * 64 + F.lane] = S[T]; }
}
__device__ __forceinline__ void rwkv_pass3_unit(Frame& F, int li, int u) {
    T0(tu_); T0(ts_);
    const int pc = u % NSC, bh = u / NSC, b = bh / 6, h = bh % 6;
    const bool isctx = pc < 2; const int pcl = isctx ? pc : pc - 2, nsc = isctx ? 2 : 64;
    const int dir = F.wave >> 2, wq = F.wave & 3, q = F.lane >> 4, c = F.lane & 15;
    const int sc = dir == 0 ? pc : (isctx ? 1 - pcl : 2 + 63 - pcl);
    const int scl = dir == 0 ? pcl : nsc - 1 - pcl;
    const int chain = dir * 12 + b * 6 + h;
    LAS unsigned char* img = F.lds + (dir ? L_IMG1 : L_IMG0); LAS unsigned* pkg = (LAS unsigned*)(F.lds + L_PKG) + dir * 1024;
    LAS float* YL = (LAS float*)(F.lds + L_YL); LAS unsigned char* VB = F.lds + L_VB; LAS float* BON = (LAS float*)(F.lds + L_BON);
    LAS float* cst = (LAS float*)(F.lds + L_CST);
    __syncthreads();
    if (F.tid < 256) chain_consts_lds(F, cst, li, h, F.tid);
    f32x4 S[4];
    { const f32x4* braw = (const f32x4*)sum_slot(F, chain, sc);
#pragma unroll
      for (int T = 0; T < 4; ++T) S[T] = braw[(wq * 4 + T) * 64 + F.lane]; }
    __syncthreads();
    for (int i = F.tid; i < 128 * 68; i += NTHR) YL[i] = 0.f;
    PrepRaw R;
    prep_load(F, R, dir, b, h, 8 * wq + (F.lane >> 3), F.lane & 7, isctx, 128 * scl);
    TACC(F, 11, ts_);
#pragma unroll 1
    for (int rd = 0; rd < 4; ++rd) {
        T0(ta_);
        __syncthreads();
        prep_compute(F, R, cst, img, dir, b, h, 8 * wq + (F.lane >> 3), F.lane & 7, isctx, 128 * scl + 32 * rd, dir == 0 ? VB : (LAS unsigned char*)nullptr, BON, 32 * rd);
        TACC(F, 12, ta_); T0(tb_);
        __syncthreads();
        if (rd < 3) prep_load(F, R, dir, b, h, 8 * wq + (F.lane >> 3), F.lane & 7, isctx, 128 * scl + 32 * (rd + 1));
        if (wq < 2) block_package<true>(img, wq, pkg + wq * 512, F.lane);
        __syncthreads();
        TACC(F, 13, tb_); T0(tc_);
#pragma unroll
        for (int blk = 0; blk < 2; ++blk) { const f32x4 y = block_scan<true, true>(img, blk, pkg + blk * 512, S, wq, F.lane);
#pragma unroll
            for (int e = 0; e < 4; ++e) { const int t = 32 * rd + 16 * blk + 4 * q + e; const int pl = dir ? 127 - t : t; YL[pl * 68 + c + 16 * wq] += y[e]; } }
        TACC(F, 14, tc_);
    }
    T0(td_);
    __syncthreads();
    const int wv = F.wave; const int rbase = (isctx ? TL + b * CTX : b * SEQ) + 128 * pcl;
    const bf16* g2t = (const bf16*)(F.ws + WS_G2T) + (size_t)li * 384 * 128;
    f32x4 gate[4];
#pragma unroll
    for (int nt = 0; nt < 4; ++nt) gate[nt] = (f32x4){0.f, 0.f, 0.f, 0.f};
#pragma unroll
    for (int k = 0; k < 4; ++k) { const v4u zg = *(const v4u*)(zrow(F, rbase + 16 * wv + c) + ZG + 32 * k + 8 * q);
#define SG(x) (1.0f / (1.0f + __expf(-(x))))
        const bf16x8 a = mk8(pk2(SG(bflo(zg.x)), SG(bfhi(zg.x))), pk2(SG(bflo(zg.y)), SG(bfhi(zg.y))), pk2(SG(bflo(zg.z)), SG(bfhi(zg.z))), pk2(SG(bflo(zg.w)), SG(bfhi(zg.w))));
#undef SG
#pragma unroll
        for (int nt = 0; nt < 4; ++nt) { const bf16x8 bb = *(const bf16x8*)(g2t + (size_t)(64 * h + 16 * nt + c) * 128 + 32 * k + 8 * q); gate[nt] = MFMA16(a, bb, gate[nt]); } }
    bf16* mix = (bf16*)(F.ws + WS_H);
    float lg[4], lb[4];
#pragma unroll
    for (int nt = 0; nt < 4; ++nt) { lg[nt] = inp(I_LNG)[li * RW + 64 * h + 16 * nt + c]; lb[nt] = inp(I_LNB)[li * RW + 64 * h + 16 * nt + c]; }
#pragma unroll
    for (int e = 0; e < 4; ++e) { const int tl = 16 * wv + 4 * q + e;
        float yv[4], s = 0.f;
#pragma unroll
        for (int nt = 0; nt < 4; ++nt) { yv[nt] = YL[tl * 68 + 16 * nt + c]; s += yv[nt]; }
        s = sum16(s);
        const float mu = s * (1.0f / 64.0f); float v2 = 0.f;
#pragma unroll
        for (int nt = 0; nt < 4; ++nt) { yv[nt] -= mu; v2 += yv[nt] * yv[nt]; }
        v2 = sum16(v2);
        const float rs = 1.0f / sqrtf(v2 * (1.0f / 64.0f) + GN_EPS); const float bon = BON[tl];
#pragma unroll
        for (int nt = 0; nt < 4; ++nt) { const float vv = bf2f(((const LAS bf16*)VB)[tl * 64 + 16 * nt + c]);
            const float o = (yv[nt] * rs * lg[nt] + lb[nt] + bon * vv) * gate[nt][e];
            mix[(size_t)(rbase + tl) * DM + 640 + 64 * h + 16 * nt + c] = (bf16)f2bf(o); } }
    TACC(F, 15, td_); TACC(F, 10, tu_);
}

constexpr int AT_KROW = 144;
__device__ __forceinline__ void attn_unit(Frame& F, int li, int u) {
    const bool cq = u >= 256;
    int b, kvh, qb;
    if (!cq) { b = u >> 7; kvh = (u >> 6) & 1; qb = u & 63; } else { const int uu = u - 256; b = uu >> 2; kvh = (uu >> 1) & 1; qb = uu & 1; }
    const int c = F.lane & 15, q = F.lane >> 4, tb = F.wave;
    bf16* mix = (bf16*)(F.ws + WS_H);
    const float* rct = (const float*)(F.ws + WS_ROPE); const float* rst = rct + SEQ * 32;
    const int qrow = (cq ? TL + b * CTX : b * SEQ) + 128 * qb + 16 * tb + c;
    const int qpos = 128 * qb + 16 * tb + c;
    bf16x8 Q[3][2];
    { float cs[8], sn[8];
      if (!cq) { const f32x4 c0 = *(const f32x4*)(rct + qpos * 32 + 8 * q), c1 = *(const f32x4*)(rct + qpos * 32 + 8 * q + 4), s0 = *(const f32x4*)(rst + qpos * 32 + 8 * q), s1 = *(const f32x4*)(rst + qpos * 32 + 8 * q + 4);
#pragma unroll
          for (int e = 0; e < 4; ++e) { cs[e] = c0[e]; cs[e + 4] = c1[e]; sn[e] = s0[e]; sn[e + 4] = s1[e]; } }
      else {
#pragma unroll
          for (int e = 0; e < 8; ++e) { cs[e] = 1.0f; sn[e] = 0.0f; } }
#pragma unroll
      for (int hh = 0; hh < 3; ++hh) { const bf16* zq = zrow(F, qrow) + ZQ + 64 * (3 * kvh + hh) + 8 * q; float x1[8], x2[8]; unpack8(*(const v4u*)zq, x1); unpack8(*(const v4u*)(zq + 32), x2);
          float o1[8], o2[8];
#pragma unroll
          for (int e = 0; e < 8; ++e) { o1[e] = 0.125f * (x1[e] * cs[e] - x2[e] * sn[e]); o2[e] = 0.125f * (x2[e] * cs[e] + x1[e] * sn[e]); }
          Q[hh][0] = mk8(pk2(o1[0], o1[1]), pk2(o1[2], o1[3]), pk2(o1[4], o1[5]), pk2(o1[6], o1[7])); Q[hh][1] = mk8(pk2(o2[0], o2[1]), pk2(o2[2], o2[3]), pk2(o2[4], o2[5]), pk2(o2[6], o2[7])); } }
    float m[3], l[3]; f32x4 O[3][4];
#pragma unroll
    for (int hh = 0; hh < 3; ++hh) { m[hh] = inp(I_SINK)[li * 6 + 3 * kvh + hh]; l[hh] = q == 0 ? 1.0f : 0.0f;
#pragma unroll
        for (int dt = 0; dt < 4; ++dt) O[hh][dt] = (f32x4){0.f, 0.f, 0.f, 0.f}; }
    LAS unsigned char* KI = F.lds;
#pragma unroll 1
    for (int stage = cq ? 1 : 0; stage < 2; ++stage) {
        const int nkeys = stage == 0 ? 384 : 256; const int vstride = (nkeys + 8) * 2;
        LAS unsigned char* VTI = F.lds + 384 * AT_KROW;
        const int kpos0 = 128 * (qb - 1);
        __syncthreads();
        for (int pc = F.tid; pc < nkeys * 4; pc += NTHR) { const int key = pc >> 2, o = pc & 3;
            const bf16* zk; float cs[8], sn[8];
            if (stage == 0) { int kp = kpos0 + key; kp = kp < 0 ? 0 : (kp >= SEQ ? SEQ - 1 : kp); zk = zrow(F, b * SEQ + kp) + 64 * kvh + 8 * o;
                const f32x4 c0 = *(const f32x4*)(rct + kp * 32 + 8 * o), c1 = *(const f32x4*)(rct + kp * 32 + 8 * o + 4), s0 = *(const f32x4*)(rst + kp * 32 + 8 * o), s1 = *(const f32x4*)(rst + kp * 32 + 8 * o + 4);
#pragma unroll
                for (int e = 0; e < 4; ++e) { cs[e] = c0[e]; cs[e + 4] = c1[e]; sn[e] = s0[e]; sn[e + 4] = s1[e]; } }
            else { zk = zrow(F, TL + b * CTX + key) + 64 * kvh + 8 * o;
#pragma unroll
                for (int e = 0; e < 8; ++e) { cs[e] = 1.0f; sn[e] = 0.0f; } }
            const v4u k1 = *(const v4u*)(zk + ZK), k2 = *(const v4u*)(zk + ZK + 32), v1 = *(const v4u*)(zk + ZV), v2 = *(const v4u*)(zk + ZV + 32);
            float x1[8], x2[8]; unpack8(k1, x1); unpack8(k2, x2);
            float o1[8], o2[8];
#pragma unroll
            for (int e = 0; e < 8; ++e) { o1[e] = x1[e] * cs[e] - x2[e] * sn[e]; o2[e] = x2[e] * cs[e] + x1[e] * sn[e]; }
            *(LAS v4u*)(KI + key * AT_KROW + o * 16) = (v4u){pk2(o1[0], o1[1]), pk2(o1[2], o1[3]), pk2(o1[4], o1[5]), pk2(o1[6], o1[7])};
            *(LAS v4u*)(KI + key * AT_KROW + 64 + o * 16) = (v4u){pk2(o2[0], o2[1]), pk2(o2[2], o2[3]), pk2(o2[4], o2[5]), pk2(o2[6], o2[7])};
            const int kl = key & 31; const int col = (key & ~31) | (((kl & 15) >> 2) << 3) | ((kl >> 4) << 2) | (kl & 3);
#pragma unroll
            for (int hv = 0; hv < 2; ++hv) { const v4u vv = hv ? v2 : v1; LAS bf16* vt = (LAS bf16*)(VTI + (8 * (o + 4 * hv)) * vstride) + col;
                vt[0] = (bf16)(vv.x & 0xffff); *(LAS bf16*)((LAS unsigned char*)vt + vstride) = (bf16)(vv.x >> 16);
                *(LAS bf16*)((LAS unsigned char*)vt + 2 * vstride) = (bf16)(vv.y & 0xffff); *(LAS bf16*)((LAS unsigned char*)vt + 3 * vstride) = (bf16)(vv.y >> 16);
                *(LAS bf16*)((LAS unsigned char*)vt + 4 * vstride) = (bf16)(vv.z & 0xffff); *(LAS bf16*)((LAS unsigned char*)vt + 5 * vstride) = (bf16)(vv.z >> 16);
                *(LAS bf16*)((LAS unsigned char*)vt + 6 * vstride) = (bf16)(vv.w & 0xffff); *(LAS bf16*)((LAS unsigned char*)vt + 7 * vstride) = (bf16)(vv.w >> 16); } }
        __syncthreads();
        const int npair = nkeys / 32;
        const int Q0 = 128 * qb + 16 * tb;
#pragma unroll 1
        for (int kp = 0; kp < npair; ++kp) {
            const int kb = kpos0 + 32 * kp;
            if (stage == 0 && (kb + 31 < Q0 - 128 || kb > Q0 + 143 || kb + 31 < 0 || kb >= SEQ)) continue;
            bf16x8 K[2][2], V[4];
#pragma unroll
            for (int t = 0; t < 2; ++t)
#pragma unroll
                for (int k = 0; k < 2; ++k) K[t][k] = *(const LAS bf16x8*)(KI + (32 * kp + 16 * t + c) * AT_KROW + k * 64 + q * 16);
#pragma unroll
            for (int dt = 0; dt < 4; ++dt) V[dt] = *(const LAS bf16x8*)(VTI + (16 * dt + c) * vstride + kp * 64 + q * 16);
            bool ok0[4], ok1[4];
#pragma unroll
            for (int e = 0; e < 4; ++e) { const int k0 = kb + 4 * q + e, k1 = k0 + 16;
                ok0[e] = stage == 1 || (k0 >= 0 && k0 < SEQ && k0 >= qpos - 128 && k0 <= qpos + 128);
                ok1[e] = stage == 1 || (k1 >= 0 && k1 < SEQ && k1 >= qpos - 128 && k1 <= qpos + 128); }
#pragma unroll
            for (int hh = 0; hh < 3; ++hh) {
                f32x4 s0 = {0.f, 0.f, 0.f, 0.f}, s1 = {0.f, 0.f, 0.f, 0.f};
                s0 = MFMA16(K[0][0], Q[hh][0], s0); s0 = MFMA16(K[0][1], Q[hh][1], s0);
                s1 = MFMA16(K[1][0], Q[hh][0], s1); s1 = MFMA16(K[1][1], Q[hh][1], s1);
                float mx = -INFINITY;
#pragma unroll
                for (int e = 0; e < 4; ++e) { s0[e] = ok0[e] ? s0[e] : -INFINITY; s1[e] = ok1[e] ? s1[e] : -INFINITY; mx = fmaxf(mx, fmaxf(s0[e], s1[e])); }
                mx = xrow_max(mx);
                const float mn = fmaxf(m[hh], mx); const float alpha = __expf(m[hh] - mn); m[hh] = mn;
                float ps = 0.f;
#pragma unroll
                for (int e = 0; e < 4; ++e) { s0[e] = __expf(s0[e] - mn); s1[e] = __expf(s1[e] - mn); ps += s0[e] + s1[e]; }
                l[hh] = l[hh] * alpha + ps;
                const bf16x8 P = mk8(cvtpk(s0[0], s0[1]), cvtpk(s0[2], s0[3]), cvtpk(s1[0], s1[1]), cvtpk(s1[2], s1[3]));
#pragma unroll
                for (int dt = 0; dt < 4; ++dt) { O[hh][dt] = O[hh][dt] * alpha; O[hh][dt] = MFMA16(V[dt], P, O[hh][dt]); }
            }
        }
    }
#pragma unroll
    for (int hh = 0; hh < 3; ++hh) { const float lt = xrow_sum(l[hh]); const float inv = 1.0f / lt;
#pragma unroll
        for (int dt = 0; dt < 4; ++dt) { v2u w; w.x = pk2(O[hh][dt][0] * inv, O[hh][dt][1] * inv); w.y = pk2(O[hh][dt][2] * inv, O[hh][dt][3] * inv);
            *(v2u*)(mix + (size_t)qrow * DM + 256 + 64 * (3 * kvh + hh) + 16 * dt + 4 * q) = w; } }
}

__device__ __forceinline__ void fourier_tables(Frame& F) {
    bf16* t = (bf16*)(F.ws + WS_FT);
    for (int i = F.bid * NTHR + F.tid; i < 64 * 64; i += F.G * NTHR) { const int r = i >> 6, cc = i & 63; const float a = (float)((r * cc) & 63) * (1.0f / 64.0f);
        const float cs = __builtin_amdgcn_cosf(a), sn = __builtin_amdgcn_sinf(a);
        t[FT_W64C / 2 + i] = (bf16)f2bf(cs); t[FT_W64S / 2 + i] = (bf16)f2bf(sn);
        const int pj = (cc & ~31) | (((cc & 15) >> 2) << 3) | (((cc >> 4) & 1) << 2) | (cc & 3);
        t[FT_T64C / 2 + r * 64 + pj] = (bf16)f2bf(cs); t[FT_T64S / 2 + r * 64 + pj] = (bf16)f2bf(sn); }
    for (int i = F.bid * NTHR + F.tid; i < 128 * 128; i += F.G * NTHR) { const int r = i >> 7, cc = i & 127; const float a = (float)((r * cc) & 127) * (1.0f / 128.0f);
        t[FT_W128C / 2 + i] = (bf16)f2bf(__builtin_amdgcn_cosf(a)); t[FT_W128S / 2 + i] = (bf16)f2bf(__builtin_amdgcn_sinf(a)); }
}
__device__ __forceinline__ void fourier_a_fast(Frame& F, int u) {
    const int b = u >> 7, n2 = u & 127, c = F.lane & 15, q = F.lane >> 4;
    LAS unsigned char* IMG = F.lds;
    __syncthreads();
    for (int pc = F.tid; pc < 64 * 32; pc += NTHR) { const int n1 = pc >> 5, c8 = pc & 31;
        const v4u v = *(const v4u*)(zrow(F, b * SEQ + 128 * n1 + n2) + ZF + 8 * c8);
        LAS bf16* d = (LAS bf16*)(IMG + (8 * c8) * 144) + n1;
        d[0] = (bf16)(v.x & 0xffff); d[72] = (bf16)(v.x >> 16); d[144] = (bf16)(v.y & 0xffff); d[216] = (bf16)(v.y >> 16);
        d[288] = (bf16)(v.z & 0xffff); d[360] = (bf16)(v.z >> 16); d[432] = (bf16)(v.w & 0xffff); d[504] = (bf16)(v.w >> 16); }
    __syncthreads();
    const bf16* wc = (const bf16*)(F.ws + WS_FT + FT_W64C); const bf16* wsn = (const bf16*)(F.ws + WS_FT + FT_W64S);
    bf16* far = (bf16*)((unsigned char*)F.out + OUT_FA); bf16* fai = far + (size_t)NB * 64 * 128 * 256;
    bf16x8 Bc[4][2], Bs[4][2];
#pragma unroll
    for (int kt = 0; kt < 4; ++kt)
#pragma unroll
        for (int k = 0; k < 2; ++k) { Bc[kt][k] = *(const bf16x8*)(wc + (16 * kt + c) * 64 + 32 * k + 8 * q); Bs[kt][k] = *(const bf16x8*)(wsn + (16 * kt + c) * 64 + 32 * k + 8 * q); }
#pragma unroll
    for (int ci = 0; ci < 2; ++ci) { const int ct = 2 * F.wave + ci;
        bf16x8 A[2];
#pragma unroll
        for (int k = 0; k < 2; ++k) A[k] = *(const LAS bf16x8*)(IMG + (16 * ct + c) * 144 + k * 64 + q * 16);
#pragma unroll
        for (int kt = 0; kt < 4; ++kt) { f32x4 sr = {0.f, 0.f, 0.f, 0.f}, si = {0.f, 0.f, 0.f, 0.f};
#pragma unroll
            for (int k = 0; k < 2; ++k) { sr = MFMA16(A[k], Bc[kt][k], sr); si = MFMA16(A[k], Bs[kt][k], si); }
            const int k1 = 16 * kt + c; const float tw = (float)(n2 * k1) * (1.0f / 8192.0f); const float tc = __builtin_amdgcn_cosf(tw), ts = __builtin_amdgcn_sinf(tw);
            float xr[4], xi[4];
#pragma unroll
            for (int e = 0; e < 4; ++e) { const float ar = sr[e], ai = -si[e]; xr[e] = ar * tc + ai * ts; xi[e] = ai * tc - ar * ts; }
            const size_t o = (((size_t)b * 64 + k1) * 128 + n2) * 256 + 16 * ct + 4 * q;
            v2u w; w.x = pk2(xr[0], xr[1]); w.y = pk2(xr[2], xr[3]); *(v2u*)(far + o) = w; w.x = pk2(xi[0], xi[1]); w.y = pk2(xi[2], xi[3]); *(v2u*)(fai + o) = w; } }
}
__device__ __forceinline__ void fourier_c_fast(Frame& F, int u) {
    const int g = u & 3, k1 = (u >> 2) & 63, b = u >> 8, c = F.lane & 15, q = F.lane >> 4;
    LAS unsigned char* IR = F.lds; LAS unsigned char* II = F.lds + 64 * 272;
    const bf16* far = (const bf16*)((unsigned char*)F.out + OUT_FA) + (((size_t)b * 64 + k1) * 128) * 256 + 64 * g; const bf16* fai = far + (size_t)NB * 64 * 128 * 256;
    __syncthreads();
    for (int pc = F.tid; pc < 128 * 8; pc += NTHR) { const int n2 = pc >> 3, c8 = pc & 7;
        const v4u vr = *(const v4u*)(far + (size_t)n2 * 256 + 8 * c8), vi = *(const v4u*)(fai + (size_t)n2 * 256 + 8 * c8);
        LAS bf16* dr = (LAS bf16*)(IR + (8 * c8) * 272) + n2; LAS bf16* di = (LAS bf16*)(II + (8 * c8) * 272) + n2;
        dr[0] = (bf16)(vr.x & 0xffff); dr[136] = (bf16)(vr.x >> 16); dr[272] = (bf16)(vr.y & 0xffff); dr[408] = (bf16)(vr.y >> 16);
        dr[544] = (bf16)(vr.z & 0xffff); dr[680] = (bf16)(vr.z >> 16); dr[816] = (bf16)(vr.w & 0xffff); dr[952] = (bf16)(vr.w >> 16);
        di[0] = (bf16)(vi.x & 0xffff); di[136] = (bf16)(vi.x >> 16); di[272] = (bf16)(vi.y & 0xffff); di[408] = (bf16)(vi.y >> 16);
        di[544] = (bf16)(vi.z & 0xffff); di[680] = (bf16)(vi.z >> 16); di[816] = (bf16)(vi.w & 0xffff); di[952] = (bf16)(vi.w >> 16); }
    __syncthreads();
    const bf16* wc = (const bf16*)(F.ws + WS_FT + FT_W128C); const bf16* wsn = (const bf16*)(F.ws + WS_FT + FT_W128S);
    const bf16* tcn = (const bf16*)(F.ws + WS_FT + FT_T64C); const bf16* tsn = (const bf16*)(F.ws + WS_FT + FT_T64S);
    f32x4 Pr[4], Pi[4];
#pragma unroll
    for (int ct = 0; ct < 4; ++ct) { Pr[ct] = (f32x4){0.f, 0.f, 0.f, 0.f}; Pi[ct] = (f32x4){0.f, 0.f, 0.f, 0.f}; }
#pragma unroll
    for (int k = 0; k < 4; ++k) { const bf16x8 bc = *(const bf16x8*)(wc + (16 * F.wave + c) * 128 + 32 * k + 8 * q), bs = *(const bf16x8*)(wsn + (16 * F.wave + c) * 128 + 32 * k + 8 * q);
        const v4u bsu = __builtin_bit_cast(v4u, bs); const bf16x8 bsn = mk8(bsu.x ^ 0x80008000u, bsu.y ^ 0x80008000u, bsu.z ^ 0x80008000u, bsu.w ^ 0x80008000u);
#pragma unroll
        for (int ct = 0; ct < 4; ++ct) { const bf16x8 ar = *(const LAS bf16x8*)(IR + (16 * ct + c) * 272 + k * 64 + q * 16), ai = *(const LAS bf16x8*)(II + (16 * ct + c) * 272 + k * 64 + q * 16);
            Pr[ct] = MFMA16(ar, bc, Pr[ct]); Pr[ct] = MFMA16(ai, bs, Pr[ct]); Pi[ct] = MFMA16(ai, bc, Pi[ct]); Pi[ct] = MFMA16(ar, bsn, Pi[ct]); } }
    bf16x8 Br[2], Bi[2];
#pragma unroll
    for (int k = 0; k < 2; ++k) { Br[k] = mk8(cvtpk(Pr[2 * k][0], Pr[2 * k][1]), cvtpk(Pr[2 * k][2], Pr[2 * k][3]), cvtpk(Pr[2 * k + 1][0], Pr[2 * k + 1][1]), cvtpk(Pr[2 * k + 1][2], Pr[2 * k + 1][3]));
        Bi[k] = mk8(cvtpk(Pi[2 * k][0], Pi[2 * k][1]), cvtpk(Pi[2 * k][2], Pi[2 * k][3]), cvtpk(Pi[2 * k + 1][0], Pi[2 * k + 1][1]), cvtpk(Pi[2 * k + 1][2], Pi[2 * k + 1][3])); }
    bf16* mix = (bf16*)(F.ws + WS_H);
    const float scale = 0.0013810679320049757f;
    const int k2 = 16 * F.wave + c; const size_t row = (size_t)b * SEQ + k1 + 64 * k2;
#pragma unroll
    for (int mt = 0; mt < 4; ++mt) { f32x4 y = {0.f, 0.f, 0.f, 0.f};
#pragma unroll
        for (int k = 0; k < 2; ++k) { const bf16x8 ac = *(const bf16x8*)(tcn + (16 * mt + c) * 64 + 32 * k + 8 * q), as = *(const bf16x8*)(tsn + (16 * mt + c) * 64 + 32 * k + 8 * q);
            y = MFMA16(ac, Br[k], y); y = MFMA16(as, Bi[k], y); }
        v2u w; w.x = pk2(y[0] * scale, y[1] * scale); w.y = pk2(y[2] * scale, y[3] * scale);
        *(v2u*)(mix + row * DM + 64 * g + 16 * mt + 4 * q) = w; }
}

#define XB_TMO      128
#define XB_XCNT(j)  (256  + 64 * (j))
#define XB_XSUB(j)  (1280 + 64 * (j))
#define XB_XGEN(j)  (2304 + 64 * (j))
#define XB_TOP      3328
#define XB_TOPGEN   3392
#define XCD_BAR_WORDS 3456
#define XB_SPIN_CAP (1u << 23)
__device__ __forceinline__ unsigned xb_ld(unsigned* p)              { return __hip_atomic_load(p, __ATOMIC_RELAXED, __HIP_MEMORY_SCOPE_AGENT); }
__device__ __forceinline__ unsigned xb_add(unsigned* p, unsigned v) { return __hip_atomic_fetch_add(p, v, __ATOMIC_RELAXED, __HIP_MEMORY_SCOPE_AGENT); }
__device__ __forceinline__ unsigned xb_xcc_id() { return (unsigned)__builtin_amdgcn_s_getreg((3 << 11) | 20) & 0xFu; }
#define XB_SPIN(cond, bar) do { unsigned _sp = 0; while (cond) { __builtin_amdgcn_s_sleep(1); \
    if ((++_sp & 255u) == 0u) { if (xb_ld(&(bar)[XB_TMO])) break; if (_sp > XB_SPIN_CAP) { atomicAdd(&(bar)[XB_TMO], 1u); break; } } } } while (0)
struct XcdBarrier { unsigned* bar; unsigned x; volatile LAS unsigned* st; };
__device__ __forceinline__ XcdBarrier xcd_barrier_post(unsigned* bar, volatile LAS unsigned* st) {
    XcdBarrier b; b.bar = bar; b.x = xb_xcc_id(); b.st = st;
    if (threadIdx.x == 0) (void)xb_add(&bar[XB_XCNT(b.x)], 1u);
    return b;
}
__device__ __forceinline__ void xcd_barrier_complete(unsigned* bar, unsigned x, unsigned& nloc, unsigned& nx) {
    const unsigned G = gridDim.x * gridDim.y * gridDim.z;
    unsigned sum, cnt, mine, sp = 0u;
    for (;;) {
        sum = 0u; cnt = 0u; mine = 0u;
#pragma unroll
        for (unsigned j = 0; j < 16; ++j) { const unsigned c = xb_ld(&bar[XB_XCNT(j)]); sum += c; cnt += (c > 0u) ? 1u : 0u; mine = (j == x) ? c : mine; }
        if (sum == G) break;
        __builtin_amdgcn_s_sleep(1);
        if ((++sp & 255u) == 0u) { if (xb_ld(&bar[XB_TMO])) break; if (sp > XB_SPIN_CAP) { atomicAdd(&bar[XB_TMO], 1u); break; } }
    }
    nloc = mine > 0u ? mine : 1u; nx = cnt > 0u ? cnt : 1u;
}
__device__ __forceinline__ void xcd_barrier(const XcdBarrier& b0) {
    XcdBarrier b; { unsigned* p = b0.bar; unsigned x = __builtin_amdgcn_readfirstlane(b0.x); unsigned st = (unsigned)(size_t)b0.st; asm volatile("" : "+s"(p), "+s"(x), "+s"(st)); b.bar = p; b.x = x; b.st = (volatile LAS unsigned*)(size_t)st; }
    asm volatile("s_waitcnt vmcnt(0)" ::: "memory");
    __syncthreads();
    if (threadIdx.x == 0) {
        unsigned* bar = b.bar;
        __builtin_amdgcn_s_waitcnt(0);
        unsigned nloc = b.st[0], nx = b.st[1];
        if (nloc == 0u) { xcd_barrier_complete(bar, b.x, nloc, nx); b.st[0] = nloc; b.st[1] = nx; }
        const unsigned old = xb_add(&bar[XB_XSUB(b.x)], 1u);
        const unsigned gen = old / nloc;
        if (old + 1u == (gen + 1u) * nloc) {
            __builtin_amdgcn_fence(__ATOMIC_RELEASE, "agent");
            asm volatile("s_waitcnt vmcnt(0)" ::: "memory");
            const unsigned og = xb_add(&bar[XB_TOP], 1u);
            const unsigned tg = og / nx;
            if (og + 1u == (tg + 1u) * nx) xb_add(&bar[XB_TOPGEN], 1u);
            else XB_SPIN(xb_ld(&bar[XB_TOPGEN]) == tg, bar);
            __builtin_amdgcn_fence(__ATOMIC_ACQUIRE, "agent");
            xb_add(&bar[XB_XGEN(b.x)], 1u);
            asm volatile("s_waitcnt vmcnt(0)" ::: "memory");
        } else {
            XB_SPIN(xb_ld(&bar[XB_XGEN(b.x)]) == gen, bar);
            __builtin_amdgcn_fence(__ATOMIC_ACQUIRE, "agent");
            asm volatile("s_waitcnt vmcnt(0)" ::: "memory");
        }
    }
    __syncthreads();
}

__device__ __forceinline__ int queue_next(Frame& F, unsigned* cnt) {
    volatile LAS int* slot = (volatile LAS int*)(F.lds + MISC_OFF + 64);
    __syncthreads();
    if (F.tid == 0) *slot = (int)__hip_atomic_fetch_add(cnt, 1u, __ATOMIC_RELAXED, __HIP_MEMORY_SCOPE_AGENT);
    __syncthreads();
    return *slot;
}
template <int KIND> __device__ __forceinline__ void run_phase(const Frame& F0, int li, int second) {
    Frame F;
    { int t = threadIdx.x; asm volatile("" : "+v"(t)); F.tid = t; F.lane = t & 63; F.wave = __builtin_amdgcn_readfirstlane(t >> 6);
      int g = F0.G, b = F0.bid; asm volatile("" : "+s"(g), "+s"(b)); F.G = g; F.bid = b;
      __attribute__((address_space(1))) unsigned char* w = (__attribute__((address_space(1))) unsigned char*)F0.ws; __attribute__((address_space(1))) float* o = (__attribute__((address_space(1))) float*)F0.out;
      asm volatile("" : "+s"(w), "+s"(o)); F.ws = (unsigned char*)w; F.out = (float*)o;
      unsigned l = (unsigned)(size_t)F0.lds; asm volatile("" : "+s"(l)); F.lds = (LAS unsigned char*)(size_t)l;
      asm volatile("" : "+s"(li), "+s"(second)); }
    float* modv = (float*)(F.ws + WS_MOD);
    bf16* XB = (bf16*)(F.ws + WS_XB);
    bf16* H = (bf16*)(F.ws + WS_H); bf16* ACT = (bf16*)(F.ws + WS_ACT); bf16* O = (bf16*)(F.ws + WS_O);
    const float* ng = inp(I_NORMG) + (size_t)li * 6 * DM; const float* mv = modv + (size_t)li * 3 * 9216;
    const bool last = li == 1;
    if constexpr (KIND == 100) { convert_weights(F, 0); mod_gemv(F); rope_tables(F); lora_transposes(F); fourier_tables(F); }
    if constexpr (KIND == 101) { EArgs A{}; A.xl_src = inp(I_X); A.xc_src = inp(I_CTX); A.o = nullptr; A.hdst = H; A.modv_h = modv; A.shidx = 0; A.scidx = 1; A.gpre = inp(I_NORMG); A.nrows = TT; e_phase(F, A); }
    if constexpr (KIND == 0) {
        const bf16* wi = (const bf16*)(F.ws + (second ? WS_WI2 : WS_WI1)); const bool withctx = !(last && second);
        if (!withctx || F.G != 256) { pg8::Gemm g{H, wi, withctx ? TT : TL, NWI, DM}; pg8::StaticOrder S; S.init(g.M, g.N, F.G, F.bid);
            pg8::EpiSwiglu E{ACT, FFNP}; pg8::gemm_phase<pg8::EpiSwiglu, pg8::StaticOrder, true, true>(F.lds, g, S, E, F.tid); }
        else { unsigned* cnt = (unsigned*)(F.ws + WS_CTL) + 8192 + 64 * (li * 2 + second);
            pg8::Gemm g{H, wi, TT, NWI, DM}; pg8::UpOrder S; S.init(NWI, F.G, F.bid, cnt);
            pg8::EpiSwiglu E{ACT, FFNP}; pg8::gemm_phase<pg8::EpiSwiglu, pg8::UpOrder, true, true>(F.lds, g, S, E, F.tid);
            if (F.bid >= 248) {
                if (F.tid == 0) { unsigned sp = 0; while (__hip_atomic_load(cnt, __ATOMIC_RELAXED, __HIP_MEMORY_SCOPE_AGENT) < 352u && ++sp < (1u << 24)) __builtin_amdgcn_s_sleep(8);
                    __builtin_amdgcn_fence(__ATOMIC_ACQUIRE, "agent"); asm volatile("s_waitcnt vmcnt(0)" ::: "memory"); }
                __syncthreads();
                const int k = F.bid - 248; pg8::Gemm g2{ACT, (const bf16*)(F.ws + (second ? WS_WO2 : WS_WO1)), TT, DM, FFNP}; pg8::OneUnit S2{64 + (k >> 2), k & 3};
                pg8::EpiBf16 E2{O, DM}; pg8::gemm_phase<pg8::EpiBf16, pg8::OneUnit, false, true>(F.lds, g2, S2, E2, F.tid); } } }
    if constexpr (KIND == 1) {
        const bool ctxhere = F.G != 256 && !(last && second);
        pg8::Gemm g{ACT, (const bf16*)(F.ws + (second ? WS_WO2 : WS_WO1)), ctxhere ? TT : TL, DM, FFNP}; pg8::StaticOrder S; S.init(g.M, g.N, F.G, F.bid);
        pg8::EpiBf16 E{O, DM}; pg8::gemm_phase<pg8::EpiBf16, pg8::StaticOrder, true, true>(F.lds, g, S, E, F.tid); }
    if constexpr (KIND == 2) {
        EArgs A{}; A.xl_src = inp(I_X); A.xc_src = inp(I_CTX); A.xb_src = li == 0 ? (const bf16*)nullptr : XB; A.xb_dst = XB; A.o = O; A.modv_g = mv; A.gidx = 2; A.gmul = 0.5f; A.gpost = ng + 1 * DM;
        A.hdst = H; A.modv_h = mv; A.shidx = 3; A.scidx = 4; A.gpre = ng + 2 * DM; A.nrows = TT; e_phase(F, A); }
    if constexpr (KIND == 3) {
        pg8::Gemm g{H, (const bf16*)(F.ws + WS_WIN), TT, INWP, DM}; pg8::StaticOrder S; S.init(g.M, g.N, F.G, F.bid);
        pg8::EpiBf16 E{ACT, INWP}; pg8::gemm_phase<pg8::EpiBf16, pg8::StaticOrder, true, true>(F.lds, g, S, E, F.tid); }
    if constexpr (KIND == 4) {
        lora_pass(F, li);
        for (int u = F.bid; u < 256; u += F.G) fourier_a_fast(F, u);
        if (li == 0) fourier_ctx1_all(F); }
    if constexpr (KIND == 5) {
        unsigned* cnt = (unsigned*)(F.ws + WS_CTL) + 8192 + 64 * (4 + 2 * li);
        const int na = li == 0 ? 264 : 256;
        for (int it = queue_next(F, cnt); it < na; it = queue_next(F, cnt)) attn_unit(F, li, it);
        for (int it = queue_next(F, cnt + 16); it < 12 * (NSC - 1); it = queue_next(F, cnt + 16)) rwkv_pass1_pair(F, li, it); }
    if constexpr (KIND == 11) {
        if (F.bid < 24) { T0(tp_); rwkv_pass2_chain(F, F.bid); TACC(F, 30, tp_); }
        else { T0(tq_); convert_weights(F, 1, li == 0 ? 1 : 2, 24, F.G - 24);
            TACC(F, 31, tq_); T0(tr_);
            if (li == 0) fourier_ctx2_all(F, 24); TACC(F, 32, tr_); } }
    if constexpr (KIND == 12) {
        unsigned* cnt = (unsigned*)(F.ws + WS_CTL) + 8192 + 64 * (5 + 2 * li);
        const int np3 = li == 0 ? 12 * NSC : 12 * 64;
        for (int it = queue_next(F, cnt); it < np3; it = queue_next(F, cnt)) rwkv_pass3_unit(F, li, li == 0 ? it : (it / 64) * NSC + 2 + it % 64);
        for (int it = queue_next(F, cnt + 16); it < 512; it = queue_next(F, cnt + 16)) fourier_c_fast(F, it); }
    if constexpr (KIND == 6) {
        pg8::Gemm g{H, (const bf16*)(F.ws + WS_WOUT), last ? TL : TT, DM, DM}; pg8::StaticOrder S; S.init(g.M, g.N, F.G, F.bid);
        pg8::EpiBf16 E{O, DM}; pg8::gemm_phase<pg8::EpiBf16, pg8::StaticOrder, true, true>(F.lds, g, S, E, F.tid); }
    if constexpr (KIND == 7) {
        EArgs A{}; A.xb_src = XB; A.xb_dst = XB; A.o = O; A.modv_g = mv; A.gidx = 5; A.gmul = 1.0f; A.gpost = ng + 3 * DM;
        A.hdst = H; A.modv_h = mv; A.shidx = 6; A.scidx = 7; A.gpre = ng + 4 * DM; A.nrows = last ? TL : TT; e_phase(F, A); }
    if constexpr (KIND == 10) {
        EArgs A{}; A.xb_src = XB; A.xb_dst = XB; A.out32 = last ? F.out : (float*)nullptr; A.o = O; A.modv_g = mv; A.gidx = 8; A.gmul = 0.5f; A.gpost = ng + 5 * DM;
        if (!last) { A.hdst = H; A.modv_h = mv + 3 * 9216; A.shidx = 0; A.scidx = 1; A.gpre = ng + 6 * DM; }
        A.nrows = last ? TL : TT; e_phase(F, A);
        }
}
__global__ void __launch_bounds__(NTHR, 2) mega_one(Args args) {
    extern __shared__ __attribute__((aligned(16))) unsigned char lds[];
    Frame F; F.lds = (LAS unsigned char*)lds; F.tid = threadIdx.x; F.lane = F.tid & 63; F.wave = __builtin_amdgcn_readfirstlane(F.tid >> 6); F.G = gridDim.x; F.bid = blockIdx.x;
    F.out = args.out; F.ws = args.ws;
    volatile LAS unsigned* MISC = (volatile LAS unsigned*)(F.lds + MISC_OFF);
    if (F.tid < 32) MISC[F.tid] = 0u;
    __syncthreads();
    XcdBarrier bar = xcd_barrier_post((unsigned*)(F.ws + WS_CTL) + 4096, MISC + 8);
#define GRID_BAR() xcd_barrier(bar)
#define PH(K, li, sec) { T0(t_); run_phase<K>(F, li, sec); TACC(F, 100 + K + 20 * sec, t_); T0(u_); GRID_BAR(); TACC(F, 200 + K + 20 * sec, u_); }
    PH(100, 0, 0)
    PH(101, 0, 0)
#pragma unroll 1
    for (int li = 0; li < 2; ++li) {
        PH(0, li, 0)
        PH(1, li, 0)
        PH(2, li, 0)
        PH(3, li, 0)
        PH(4, li, 0)
        PH(5, li, 0)
        PH(11, li, 0)
        PH(12, li, 0)
        PH(6, li, 0)
        PH(7, li, 0)
        PH(0, li, 1)
        PH(1, li, 1)
        PH(10, li, 0)
    }
#if TPROBE >= 0
    if (F.tid == 0) { atomicAdd((unsigned*)(F.ws + WS_CTL) + 12288, MISC[24]); atomicAdd((unsigned*)(F.ws + WS_CTL) + 12289, MISC[25]); }
    GRID_BAR();
    if (F.bid == 0) { const unsigned t1 = __hip_atomic_load((unsigned*)(F.ws + WS_CTL) + 12288, __ATOMIC_RELAXED, __HIP_MEMORY_SCOPE_AGENT), t2 = __hip_atomic_load((unsigned*)(F.ws + WS_CTL) + 12289, __ATOMIC_RELAXED, __HIP_MEMORY_SCOPE_AGENT);
        const float v1 = (float)t1 * (1.0f / 25600.0f), v2 = TPROBE2 >= 0 ? (float)t2 * (1.0f / 25600.0f) : 100.0f;
        if (F.tid == 0) F.out[0] += v1 * (1.0f / 64.0f);
        (void)v2; }
#endif
}

extern "C" void kernel_launch(void* const* d_in, const int* in_sizes, int n_in, void* d_out, int out_size, void* d_ws, size_t ws_size, hipStream_t stream) {
    static int ready = 0;
    if (!ready) {
        if (n_in != 25 || out_size != TL * DM || ws_size < WS_END) { fprintf(stderr, "kernel_launch: unexpected shapes (n_in %d out %d ws %zu)\n", n_in, out_size, ws_size); ready = -1; return; }
        if (hipFuncSetAttribute((const void*)mega_one, hipFuncAttributeMaxDynamicSharedMemorySize, LDS_BYTES) != hipSuccess) { fprintf(stderr, "kernel_launch: hipFuncSetAttribute failed\n"); ready = -1; return; }
        int dev = 0, cus = 0; if (hipGetDevice(&dev) != hipSuccess || hipDeviceGetAttribute(&cus, hipDeviceAttributeMultiprocessorCount, dev) != hipSuccess || cus < 32) cus = 256;
        ready = cus < 256 ? cus : 256;
    }
    if (ready < 0) return;
    if (hipMemsetAsync((char*)d_ws + WS_CTL, 0, 65536, stream) != hipSuccess) { fprintf(stderr, "kernel_launch: memset failed\n"); return; }
    Args a{};
    for (int i = 0; i < 25; ++i) a.in[i] = (const float*)d_in[i];
    a.out = (float*)d_out; a.ws = (unsigned char*)d_ws;
    hipLaunchKernelGGL(mega_one, dim3(ready), dim3(NTHR), LDS_BYTES, stream, a);
}
```

```cpp
#include <hip/hip_runtime.h>
#include <cstdio>
#include <cstdint>

namespace pg8 {
#define PG8_LAS __attribute__((address_space(3)))
typedef unsigned short bf16_t;
typedef short bf16x8 __attribute__((ext_vector_type(8)));
typedef float f32x4 __attribute__((ext_vector_type(4)));
typedef unsigned u32x4 __attribute__((ext_vector_type(4)));
constexpr int BM = 256, BK = 64, HALF = 128, HTB = HALF * BK * 2, STAGE_BYTES = 8 * HTB, NXCD = 8, WGM = 8;

__host__ __device__ __forceinline__ int lds_byte(int r, int c) { const int st = (r >> 4) * 2 + (c >> 5), rr = r & 15, cc = c & 31, ob = rr * 64 + cc * 2; return st * 1024 + (ob ^ (((ob >> 9) & 1) << 5)); }
__host__ __device__ __forceinline__ void stage_rc(int b, int& R, int& C) { const int st = b / 1024, sb = b % 1024, swz = sb ^ (((sb >> 9) & 1) << 5); R = (st >> 1) * 16 + swz / 64; C = (st & 1) * 32 + (swz % 64) / 2; }
__host__ __device__ __forceinline__ int perm32(int rho) { const int n = rho >> 4, i = rho & 15; return 8 * (i >> 2) + 4 * n + (i & 3); }

struct Unit { int pm, pn; };
struct Gemm { const bf16_t* A; const bf16_t* Bt; int M, N, K; };

struct StaticOrder {
    int nM, nN, nwg, G, c;
    __host__ __device__ void init(int M, int N, int G_, int c_) { nM = M / BM; nN = N / BM; nwg = nM * nN; G = G_; c = c_; }
    __host__ __device__ bool next(int i, Unit& u) const {
        const long L = (long)i * G + c; if (L >= nwg) return false;
        int wgid = (int)L; { const int q = nwg / NXCD, r = nwg % NXCD, xcd = wgid % NXCD, off = wgid / NXCD; wgid = (xcd < r ? xcd * (q + 1) : r * (q + 1) + (xcd - r) * q) + off; }
        const int nig = WGM * nN, gid = wgid / nig, fm = gid * WGM, gsz = (nM - fm) < WGM ? (nM - fm) : WGM;
        u.pm = fm + ((wgid % nig) % gsz); u.pn = (wgid % nig) / gsz; return true;
    }
    __device__ __forceinline__ void a_ready(const Unit&) const {}
    __device__ __forceinline__ void done(const Unit&) const {}
};

struct UpOrder {
    StaticOrder lat; int G, c, nN; unsigned* cnt;
    __device__ void init(int N, int G_, int c_, unsigned* cnt_) { lat.init(16384, N, G_, c_); G = G_; c = c_; nN = N / BM; cnt = cnt_; }
    __device__ bool next(int i, Unit& u) const {
        const int nctx = 2 * nN, total = nctx + lat.nwg;
        long L;
        if (G != 256) L = (long)i * G + c;
        else if (c >= 248) { if (i >= 3) return false; L = (long)i * G + c; }
        else if (c >= 172 && c < 188 && i == 5) L = (long)(3 + (c - 172) / 8) * G + 248 + (c - 172) % 8;
        else L = (long)i * G + c;
        if (L >= total) return false;
        if (L < nctx) { u.pm = 64 + (int)L / nN; u.pn = (int)L % nN; return true; }
        int wgid = (int)L - nctx; { const int nwg = lat.nwg, q = nwg / NXCD, r = nwg % NXCD, xcd = wgid % NXCD, off = wgid / NXCD; wgid = (xcd < r ? xcd * (q + 1) : r * (q + 1) + (xcd - r) * q) + off; }
        const int nig = WGM * nN, gid = wgid / nig, fm = gid * WGM, gsz = (lat.nM - fm) < WGM ? (lat.nM - fm) : WGM;
        u.pm = fm + ((wgid % nig) % gsz); u.pn = (wgid % nig) / gsz; return true;
    }
    __device__ __forceinline__ void a_ready(const Unit&) const {}
    __device__ __forceinline__ void done(const Unit& u) const {
        if (u.pm >= 64) { asm volatile("s_waitcnt vmcnt(0)" ::: "memory"); __builtin_amdgcn_fence(__ATOMIC_RELEASE, "agent"); asm volatile("s_waitcnt vmcnt(0)" ::: "memory");
            if ((threadIdx.x & 63) == 0) __hip_atomic_fetch_add(cnt, 1u, __ATOMIC_RELAXED, __HIP_MEMORY_SCOPE_AGENT); }
    }
};
struct OneUnit {
    int pm, pn;
    __device__ bool next(int i, Unit& u) const { if (i != 0) return false; u.pm = pm; u.pn = pn; return true; }
    __device__ __forceinline__ void a_ready(const Unit&) const {}
    __device__ __forceinline__ void done(const Unit&) const {}
};

__device__ __forceinline__ unsigned cvt_pk_bf16(float lo, float hi) { unsigned r; asm volatile("v_cvt_pk_bf16_f32 %0, %1, %2" : "=v"(r) : "v"(lo), "v"(hi)); return r; }

struct EpiBf16 {
    static constexpr bool PERM = true, AFTER_DRAIN = false;
    bf16_t* O; int ldc;
    __device__ __forceinline__ void operator()(const f32x4 (&acc)[2][2][4][2], const Unit& u, int wr, int wc, int fr, int fq) const {
        const int row0 = u.pm * BM + wr * 64 + fr; const int col0 = u.pn * BM + wc * 32 + 8 * fq;
#pragma unroll
        for (int ai = 0; ai < 2; ++ai)
#pragma unroll
            for (int m = 0; m < 4; ++m) { bf16_t* rowp = O + (size_t)(row0 + ai * HALF + m * 16) * ldc + col0;
#pragma unroll
                for (int bj = 0; bj < 2; ++bj) { const f32x4 v0 = acc[ai][bj][m][0], v1 = acc[ai][bj][m][1];
                    u32x4 w; w.x = cvt_pk_bf16(v0[0], v0[1]); w.y = cvt_pk_bf16(v0[2], v0[3]); w.z = cvt_pk_bf16(v1[0], v1[1]); w.w = cvt_pk_bf16(v1[2], v1[3]);
                    *(u32x4*)(rowp + bj * HALF) = w; } }
    }
};
struct EpiF32 {
    static constexpr bool PERM = true, AFTER_DRAIN = false;
    float* O; int ldc;
    __device__ __forceinline__ void operator()(const f32x4 (&acc)[2][2][4][2], const Unit& u, int wr, int wc, int fr, int fq) const {
        const int row0 = u.pm * BM + wr * 64 + fr; const int col0 = u.pn * BM + wc * 32 + 8 * fq;
#pragma unroll
        for (int ai = 0; ai < 2; ++ai)
#pragma unroll
            for (int m = 0; m < 4; ++m) { float* rowp = O + (size_t)(row0 + ai * HALF + m * 16) * ldc + col0;
#pragma unroll
                for (int bj = 0; bj < 2; ++bj) { *(f32x4*)(rowp + bj * HALF) = acc[ai][bj][m][0]; *(f32x4*)(rowp + bj * HALF + 4) = acc[ai][bj][m][1]; } }
    }
};
__device__ __forceinline__ float silu_f(float x) { return x * __builtin_amdgcn_rcpf(1.0f + __expf(-x)); }
struct EpiSwiglu {
    static constexpr bool PERM = true, AFTER_DRAIN = false;
    bf16_t* O; int ldc;
    __device__ __forceinline__ void operator()(const f32x4 (&acc)[2][2][4][2], const Unit& u, int wr, int wc, int fr, int fq) const {
        const int row0 = u.pm * BM + wr * 64 + fr; const int col0 = u.pn * HALF + wc * 32 + 8 * fq;
#pragma unroll
        for (int ai = 0; ai < 2; ++ai)
#pragma unroll
            for (int m = 0; m < 4; ++m) { bf16_t* rowp = O + (size_t)(row0 + ai * HALF + m * 16) * ldc + col0;
                const f32x4 g0 = acc[ai][0][m][0], g1 = acc[ai][0][m][1], u0 = acc[ai][1][m][0], u1 = acc[ai][1][m][1];
                u32x4 w; w.x = cvt_pk_bf16(silu_f(g0[0]) * u0[0], silu_f(g0[1]) * u0[1]); w.y = cvt_pk_bf16(silu_f(g0[2]) * u0[2], silu_f(g0[3]) * u0[3]);
                w.z = cvt_pk_bf16(silu_f(g1[0]) * u1[0], silu_f(g1[1]) * u1[1]); w.w = cvt_pk_bf16(silu_f(g1[2]) * u1[2], silu_f(g1[3]) * u1[3]);
                *(u32x4*)rowp = w; }
    }
};

template <class Epi, class Sched, bool ALIGN_EPI = false, bool SP2 = false>
__device__ __forceinline__ void gemm_phase(PG8_LAS unsigned char* lds, const Gemm g, const Sched& S, const Epi& E, const int tid) {
    const int wid = __builtin_amdgcn_readfirstlane(tid >> 6), lane = tid & 63, wr = wid >> 2, wc = wid & 3, fr = lane & 15, fq = lane >> 4;
    const int K = g.K, nt = K / BK;
    unsigned voffA[2], voffB[2];
#pragma unroll
    for (int i = 0; i < 2; ++i) { int R, C; stage_rc(tid * 16 + i * 8192, R, C); const int Rb = Epi::PERM ? ((R & ~31) + perm32(R & 31)) : R;
        voffA[i] = (unsigned)(R * K + C) * 2u; voffB[i] = (unsigned)(Rb * K + C) * 2u; }
    const size_t kstep = (size_t)(BK * 2);
    const size_t hstep = (size_t)HALF * K * 2;
    const size_t tstep = 2 * hstep;
    const unsigned ldsw = (unsigned)wid * 1024u;
    const int aoff = lds_byte(wr * 64 + fr, fq * 8), boff = lds_byte(wc * 32 + fr, fq * 8);
#define PG8_SA(b, h) (((b) * 2 + (h)) * HTB)
#define PG8_SB(b, h) ((4 + (b) * 2 + (h)) * HTB)
#define PG8_STAGE(bufoff, gbase, voff) do { _Pragma("unroll") for (int _i = 0; _i < 2; ++_i) \
        __builtin_amdgcn_global_load_lds((const unsigned*)((const char*)(gbase) + (voff)[_i]), (PG8_LAS unsigned*)(lds + (bufoff) + ldsw + _i * 8192), 16, 0, 0); } while (0)
#define PG8_LDA(dst, b, h) do { _Pragma("unroll") for (int m = 0; m < 4; ++m) _Pragma("unroll") for (int k = 0; k < 2; ++k) dst[m][k] = *(const PG8_LAS bf16x8*)(lds + PG8_SA(b, h) + aoff + m * 2048 + k * 1024); } while (0)
#define PG8_LDB(dst, b, h) do { _Pragma("unroll") for (int n = 0; n < 2; ++n) _Pragma("unroll") for (int k = 0; k < 2; ++k) dst[n][k] = *(const PG8_LAS bf16x8*)(lds + PG8_SB(b, h) + boff + n * 2048 + k * 1024); } while (0)
#define PG8_MMA(ai, bj, At, Bt) do { __builtin_amdgcn_s_setprio(1); _Pragma("unroll") for (int m = 0; m < 4; ++m) _Pragma("unroll") for (int n = 0; n < 2; ++n) _Pragma("unroll") for (int k = 0; k < 2; ++k) \
        acc[ai][bj][m][n] = __builtin_amdgcn_mfma_f32_16x16x32_bf16(Bt[n][k], At[m][k], acc[ai][bj][m][n], 0, 0, 0); __builtin_amdgcn_s_setprio(0); } while (0)
#define PG8_WAIT_V(n) asm volatile("s_waitcnt vmcnt(" #n ")" ::: "memory")
#define PG8_WAIT_L(n) asm volatile("s_waitcnt lgkmcnt(" #n ")" ::: "memory")
#define PG8_BAR __builtin_amdgcn_s_barrier()
#define PG8_SCHED __builtin_amdgcn_sched_barrier(0)
    Unit cur, nxt; int ui = 0;
    if (!S.next(0, cur)) return;
    f32x4 acc[2][2][4][2];
#pragma unroll
    for (int a = 0; a < 2; ++a)
#pragma unroll
        for (int b = 0; b < 2; ++b)
#pragma unroll
            for (int m = 0; m < 4; ++m)
#pragma unroll
                for (int n = 0; n < 2; ++n) acc[a][b][m][n] = (f32x4){0.f, 0.f, 0.f, 0.f};
    bf16x8 At[4][2], B0[2][2], B1[2][2];
    const char* cA = (const char*)g.A + (size_t)cur.pm * tstep; const char* cB = (const char*)g.Bt + (size_t)cur.pn * tstep;
    S.a_ready(cur);
    if constexpr (SP2) {
        PG8_STAGE(PG8_SB(0, 0), cB, voffB); PG8_STAGE(PG8_SB(0, 1), cB + hstep, voffB); PG8_STAGE(PG8_SA(0, 0), cA, voffA); PG8_STAGE(PG8_SA(0, 1), cA + hstep, voffA);
        if (wr == 1) PG8_BAR;
        PG8_WAIT_V(2); PG8_BAR;
        PG8_STAGE(PG8_SB(1, 0), cB + kstep, voffB); PG8_STAGE(PG8_SA(1, 0), cA + kstep, voffA); PG8_STAGE(PG8_SB(1, 1), cB + hstep + kstep, voffB);
        PG8_WAIT_V(6); PG8_BAR;
    } else {
        PG8_STAGE(PG8_SB(0, 0), cB, voffB); PG8_STAGE(PG8_SA(0, 0), cA, voffA); PG8_STAGE(PG8_SB(0, 1), cB + hstep, voffB); PG8_STAGE(PG8_SA(0, 1), cA + hstep, voffA);
        if (wr == 1) PG8_BAR;
        PG8_WAIT_V(4); PG8_BAR;
        PG8_STAGE(PG8_SB(1, 0), cB + kstep, voffB); PG8_STAGE(PG8_SA(1, 0), cA + kstep, voffA); PG8_STAGE(PG8_SB(1, 1), cB + hstep + kstep, voffB);
        PG8_WAIT_V(6); PG8_BAR;
    }
    for (;;) {
        const bool has_next = S.next(ui + 1, nxt);
        const char* nA = has_next ? (const char*)g.A + (size_t)nxt.pm * tstep : cA; const char* nB = has_next ? (const char*)g.Bt + (size_t)nxt.pn * tstep : cB;
        for (int t = 0; t < nt; t += 2) {
            const bool last = (t == nt - 2);
            const char* a1 = cA + (size_t)(t + 1) * kstep;
            const char* a2 = last ? nA : cA + (size_t)(t + 2) * kstep; const char* b2 = last ? nB : cB + (size_t)(t + 2) * kstep;
            const char* a3 = a2 + kstep; const char* b3 = b2 + kstep;
            if (last && has_next) S.a_ready(nxt);
            if constexpr (SP2) {
            PG8_LDB(B0, 0, 0); PG8_LDB(B1, 0, 1); PG8_SCHED; PG8_LDA(At, 0, 0); PG8_STAGE(PG8_SA(1, 1), a1 + hstep, voffA);
            PG8_WAIT_V(8); PG8_WAIT_L(0); PG8_BAR; PG8_MMA(0, 0, At, B0); PG8_MMA(0, 1, At, B1); PG8_BAR; PG8_SCHED;
            PG8_LDA(At, 0, 1); PG8_STAGE(PG8_SB(0, 0), b2, voffB); PG8_STAGE(PG8_SB(0, 1), b2 + hstep, voffB); PG8_STAGE(PG8_SA(0, 0), a2, voffA);
            PG8_WAIT_V(8); PG8_WAIT_L(0); PG8_BAR; PG8_MMA(1, 0, At, B0); PG8_MMA(1, 1, At, B1); PG8_BAR; PG8_SCHED;
            PG8_LDB(B0, 1, 0); PG8_LDB(B1, 1, 1); PG8_SCHED; PG8_LDA(At, 1, 0); PG8_STAGE(PG8_SA(0, 1), a2 + hstep, voffA);
            PG8_WAIT_V(8); PG8_WAIT_L(0); PG8_BAR; PG8_MMA(0, 0, At, B0); PG8_MMA(0, 1, At, B1); PG8_BAR; PG8_SCHED;
            PG8_LDA(At, 1, 1); PG8_STAGE(PG8_SB(1, 0), b3, voffB); PG8_STAGE(PG8_SB(1, 1), b3 + hstep, voffB); PG8_STAGE(PG8_SA(1, 0), a3, voffA);
            PG8_WAIT_V(8); PG8_WAIT_L(0); PG8_BAR; PG8_MMA(1, 0, At, B0); PG8_MMA(1, 1, At, B1); PG8_BAR; PG8_SCHED;
            } else {
            PG8_LDB(B0, 0, 0); PG8_SCHED; PG8_LDA(At, 0, 0); PG8_STAGE(PG8_SA(1, 1), a1 + hstep, voffA);
            PG8_WAIT_L(8); PG8_BAR; PG8_WAIT_L(0); PG8_MMA(0, 0, At, B0); PG8_BAR; PG8_SCHED;
            PG8_LDB(B1, 0, 1); PG8_STAGE(PG8_SB(0, 0), b2, voffB);
            PG8_BAR; PG8_WAIT_L(0); PG8_MMA(0, 1, At, B1); PG8_BAR;
            PG8_LDA(At, 0, 1); PG8_STAGE(PG8_SA(0, 0), a2, voffA);
            PG8_BAR; PG8_WAIT_L(0); PG8_MMA(1, 0, At, B0); PG8_BAR; PG8_SCHED;
            PG8_STAGE(PG8_SB(0, 1), b2 + hstep, voffB);
            PG8_WAIT_V(6); PG8_BAR; PG8_MMA(1, 1, At, B1); PG8_BAR;
            PG8_LDB(B0, 1, 0); PG8_SCHED; PG8_LDA(At, 1, 0); PG8_STAGE(PG8_SA(0, 1), a2 + hstep, voffA);
            PG8_WAIT_L(8); PG8_BAR; PG8_WAIT_L(0); PG8_MMA(0, 0, At, B0); PG8_BAR; PG8_SCHED;
            PG8_LDB(B1, 1, 1); PG8_STAGE(PG8_SB(1, 0), b3, voffB);
            PG8_BAR; PG8_WAIT_L(0); PG8_MMA(0, 1, At, B1); PG8_BAR;
            PG8_LDA(At, 1, 1); PG8_STAGE(PG8_SA(1, 0), a3, voffA);
            PG8_BAR; PG8_WAIT_L(0); PG8_MMA(1, 0, At, B0); PG8_BAR; PG8_SCHED;
            PG8_STAGE(PG8_SB(1, 1), b3 + hstep, voffB);
            PG8_WAIT_V(6); PG8_BAR; PG8_MMA(1, 1, At, B1); PG8_BAR;
            }
        }
        if constexpr (ALIGN_EPI) { if (wr == 0) PG8_BAR; }
        if constexpr (!Epi::AFTER_DRAIN) { E(acc, cur, wr, wc, fr, fq); S.done(cur); }
        if (!has_next) break;
#pragma unroll
        for (int a = 0; a < 2; ++a)
#pragma unroll
            for (int b = 0; b < 2; ++b)
#pragma unroll
                for (int m = 0; m < 4; ++m)
#pragma unroll
                    for (int n = 0; n < 2; ++n) acc[a][b][m][n] = (f32x4){0.f, 0.f, 0.f, 0.f};
        cur = nxt; cA = nA; cB = nB; ++ui;
        if constexpr (ALIGN_EPI) { if (wr == 1) PG8_BAR; }
    }
    PG8_WAIT_V(0);
    if constexpr (!ALIGN_EPI) { if (wr == 0) PG8_BAR; }
    PG8_BAR;
#undef PG8_SA
#undef PG8_SB
#undef PG8_STAGE
#undef PG8_LDA
#undef PG8_LDB
#undef PG8_MMA
#undef PG8_WAIT_V
#undef PG8_WAIT_L
#undef PG8_BAR
#undef PG8_SCHED
}
}

constexpr int NWAVES = 8, NTHR = 512;
constexpr int DM = 1024, SEQ = 8192, NB = 2, CTX = 256, TL = NB * SEQ, TC = NB * CTX, TT = TL + TC;
constexpr int FFN = 2752, FFNP = 2816, NWI = 5632, INW = 2432, INWP = 2560, NMOD = 9;
constexpr int ZF = 0, ZQ = 256, ZK = 640, ZV = 768, ZRR = 896, ZRK = 1280, ZRV = 1664, ZW = 2048, ZA = 2176, ZG = 2304;
constexpr int RW = 384;
constexpr float NORM_EPS = 1e-6f, GN_EPS = 64e-5f;

constexpr size_t MiB = 1u << 20;
constexpr size_t WS_CTL = 0, WS_MOD = 1 * MiB, WS_ROPE = 2 * MiB, WS_XC = 4 * MiB, WS_GC = 6 * MiB;
constexpr size_t WS_WI1 = 8 * MiB, WS_WO1 = 19 * MiB, WS_WIN = 25 * MiB, WS_WOUT = 30 * MiB, WS_WI2 = 32 * MiB, WS_WO2 = 43 * MiB;
constexpr size_t WS_H = 49 * MiB;
constexpr size_t WS_ACT = 82 * MiB;
constexpr size_t WS_O = 173 * MiB;
constexpr size_t WS_W2T = WS_MOD + 256 * 1024, WS_A2T = WS_MOD + 512 * 1024, WS_G2T = WS_MOD + 768 * 1024;
constexpr size_t WS_LW = WS_O, WS_IC = WS_O + 25 * MiB;
constexpr size_t WS_GAM32 = 165 * MiB;
constexpr size_t WS_XB = 239 * MiB;
constexpr size_t OUT_FA = 0;
constexpr size_t OUT_SUM = 16 * MiB;
constexpr size_t WS_END = 272 * MiB;

constexpr size_t WS_FT = 7 * MiB;
constexpr size_t FT_W64C = 0, FT_W64S = 8192, FT_W128C = 16384, FT_W128S = 49152, FT_T64C = 81920, FT_T64S = 90112;
constexpr int LDS_BYTES = 147456;
constexpr int MISC_OFF = 146432;
#define TPROBE -1
#define TPROBE2 -1
#define TSCALE 64.0f
#if TPROBE >= 0
#define T0(v) const unsigned long long v = __builtin_amdgcn_s_memrealtime()
#define TACC(F, id, v) do { if (((id) == TPROBE || (id) == TPROBE2) && (F).tid == 0) { volatile LAS unsigned* _m = (volatile LAS unsigned*)((F).lds + MISC_OFF); _m[(id) == TPROBE ? 24 : 25] += (unsigned)(__builtin_amdgcn_s_memrealtime() - (v)); } } while (0)
#else
#define T0(v)
#define TACC(F, id, v)
#endif

typedef unsigned short bf16;
typedef float f32x4 __attribute__((ext_vector_type(4)));
typedef unsigned v4u __attribute__((ext_vector_type(4)));
typedef unsigned v2u __attribute__((ext_vector_type(2)));
#define LAS __attribute__((address_space(3)))
#define LDS_WAIT() asm volatile("s_waitcnt lgkmcnt(0)" ::: "memory")

__device__ __forceinline__ unsigned f2bf(float f) { unsigned u = __builtin_bit_cast(unsigned, f); return (u + 0x7fffu + ((u >> 16) & 1u)) >> 16; }
__device__ __forceinline__ unsigned pk2(float lo, float hi) { return f2bf(lo) | (f2bf(hi) << 16); }
__device__ __forceinline__ float bf2f(unsigned short u) { return __builtin_bit_cast(float, (unsigned)u << 16); }
__device__ __forceinline__ float bflo(unsigned u) { return __builtin_bit_cast(float, u << 16); }
__device__ __forceinline__ float bfhi(unsigned u) { return __builtin_bit_cast(float, u & 0xffff0000u); }
__device__ __forceinline__ void unpack8(const v4u w, float (&f)[8]) { f[0] = bflo(w.x); f[1] = bfhi(w.x); f[2] = bflo(w.y); f[3] = bfhi(w.y); f[4] = bflo(w.z); f[5] = bfhi(w.z); f[6] = bflo(w.w); f[7] = bfhi(w.w); }
template <int CTRL> __device__ __forceinline__ float dppx(float v) { return __builtin_bit_cast(float, __builtin_amdgcn_update_dpp(0, __builtin_bit_cast(int, v), CTRL, 0xf, 0xf, true)); }
__device__ __forceinline__ float sum8(float v) { v += dppx<0xB1>(v); v += dppx<0x4E>(v); v += dppx<0x141>(v); return v; }
__device__ __forceinline__ float sum16(float v) { v = sum8(v); v += dppx<0x140>(v); return v; }
__device__ __forceinline__ float xrow_sum(float v) {
    float a = v, b2 = v; asm volatile("s_nop 1\n\tv_permlane16_swap_b32 %0, %1" : "+v"(a), "+v"(b2)); v = a + b2;
    a = v; b2 = v; asm volatile("s_nop 1\n\tv_permlane32_swap_b32 %0, %1" : "+v"(a), "+v"(b2)); return a + b2; }
__device__ __forceinline__ float xrow_max(float v) {
    float a = v, b2 = v; asm volatile("s_nop 1\n\tv_permlane16_swap_b32 %0, %1" : "+v"(a), "+v"(b2)); v = fmaxf(a, b2);
    a = v; b2 = v; asm volatile("s_nop 1\n\tv_permlane32_swap_b32 %0, %1" : "+v"(a), "+v"(b2)); return fmaxf(a, b2); }
__device__ __forceinline__ float wave_sum(float v) { return xrow_sum(sum16(v)); }
__device__ __forceinline__ float wave_max(float v) {
#pragma unroll
    for (int o = 1; o < 64; o <<= 1) v = fmaxf(v, __shfl_xor(v, o));
    return v;
}

struct Args { const float* in[25]; float* out; unsigned char* ws; int ph_lo, ph_hi; };

struct Frame {
    LAS unsigned char* lds;
    int tid, lane, wave, G, bid;
    float* out; unsigned char* ws;
};
enum { I_X = 0, I_C, I_CTX, I_CCTX, I_MODW, I_MODB, I_NORMG, I_F1WI, I_F1WO, I_WIN, I_WOUT, I_SINK, I_CONV, I_W0, I_W2, I_A0, I_A2, I_G2, I_KK, I_KA, I_RK, I_LNG, I_LNB, I_F2WI, I_F2WO };

__device__ __forceinline__ const float* inp(int i) {
    const __attribute__((address_space(4))) char* p = (const __attribute__((address_space(4))) char*)__builtin_amdgcn_kernarg_segment_ptr();
    asm volatile("" : "+s"(p));
    return (const float*)*(const __attribute__((address_space(1))) float* const __attribute__((address_space(4)))*)(p + 8 * i);
}
struct CvtDesc { const float* W; bf16* WT; int ldw, k0, sc, Kd, n0d; bool valid, live; };
__device__ __forceinline__ void cvt_load(const CvtDesc& d, f32x4 (&v)[8], int lane) {
    const int c4 = lane & 7, r8 = lane >> 3;
#pragma unroll
    for (int i = 0; i < 8; ++i) v[i] = (d.live && d.valid) ? *(const f32x4*)(d.W + (size_t)(d.k0 + 8 * i + r8) * d.ldw + d.sc + 4 * c4) : (f32x4){0.f, 0.f, 0.f, 0.f};
}
__device__ __forceinline__ void cvt_finish(const CvtDesc& d, const f32x4 (&v)[8], LAS float* scr, int lane) {
    if (!d.live) return;
    const int c4 = lane & 7, r8 = lane >> 3;
#pragma unroll
    for (int i = 0; i < 8; ++i) *(LAS f32x4*)(scr + (8 * i + r8) * 36 + 4 * c4) = v[i];
    LDS_WAIT(); asm volatile("" ::: "memory");
    const int c = lane & 7;
#pragma unroll
    for (int j = 0; j < 4; ++j) { const int n = (lane >> 3) + 8 * j; const LAS float* s = scr + (8 * c) * 36 + n;
        v4u o; o.x = pk2(s[0 * 36], s[1 * 36]); o.y = pk2(s[2 * 36], s[3 * 36]); o.z = pk2(s[4 * 36], s[5 * 36]); o.w = pk2(s[6 * 36], s[7 * 36]);
        *(v4u*)(d.WT + (size_t)(d.n0d + n) * d.Kd + d.k0 + 8 * c) = o; }
    LDS_WAIT(); asm volatile("" ::: "memory");
}
__device__ __forceinline__ CvtDesc cvt_decode(Frame& F, int li, int set, int it) {
    constexpr int I_WI = 16 * (NWI / 32), I_WO = (FFNP / 64) * 32, I_IN = 16 * (INWP / 32), I_OUT = 16 * 32;
    constexpr int NITEMS = 2 * I_WI + 2 * I_WO + I_IN + I_OUT;
    CvtDesc d{}; d.live = it < NITEMS; if (!d.live) return d;
    int r = it;
    if (set) { const bool inA = r < I_WI || (r >= 2 * I_WI && r < 2 * I_WI + I_WO) || (r >= 2 * I_WI + 2 * I_WO && r < 2 * I_WI + 2 * I_WO + I_IN); if (inA != (set == 1)) { d.live = false; return d; } }
    if (r < 2 * I_WI) { const int f = r / I_WI; r -= f * I_WI; const int nblk = NWI / 32, kb = r / nblk, nb = r % nblk;
        const int n0 = 32 * nb, pn = n0 >> 8, i = n0 & 255; const int j = 128 * pn + (i & 127);
        d.W = (f ? inp(I_F2WI) : inp(I_F1WI)) + (size_t)li * DM * 2 * FFN; d.ldw = 2 * FFN; d.k0 = 64 * kb; d.sc = (i < 128) ? j : FFN + j; d.valid = j < FFN; d.WT = (bf16*)(F.ws + (f ? WS_WI2 : WS_WI1)); d.Kd = DM; d.n0d = n0; return d; }
    r -= 2 * I_WI;
    if (r < 2 * I_WO) { const int f = r / I_WO; r -= f * I_WO; const int kb = r / 32, nb = r % 32;
        d.W = (f ? inp(I_F2WO) : inp(I_F1WO)) + (size_t)li * FFN * DM; d.ldw = DM; d.k0 = 64 * kb; d.sc = 32 * nb; d.valid = 64 * kb < FFN; d.WT = (bf16*)(F.ws + (f ? WS_WO2 : WS_WO1)); d.Kd = FFNP; d.n0d = 32 * nb; return d; }
    r -= 2 * I_WO;
    if (r < I_IN) { const int nblk = INWP / 32, kb = r / nblk, nb = r % nblk;
        d.W = inp(I_WIN) + (size_t)li * DM * INW; d.ldw = INW; d.k0 = 64 * kb; d.sc = 32 * nb; d.valid = 32 * nb < INW; d.WT = (bf16*)(F.ws + WS_WIN); d.Kd = DM; d.n0d = 32 * nb; return d; }
    r -= I_IN;
    { const int kb = r / 32, nb = r % 32;
        d.W = inp(I_WOUT) + (size_t)li * DM * DM; d.ldw = DM; d.k0 = 64 * kb; d.sc = 32 * nb; d.valid = true; d.WT = (bf16*)(F.ws + WS_WOUT); d.Kd = DM; d.n0d = 32 * nb; return d; }
}
__device__ __forceinline__ void convert_weights(Frame& F, int li, int set = 0, int bid0 = 0, int nblk = 0) {
    if (nblk == 0) nblk = F.G;
    if (F.bid < bid0 || F.bid >= bid0 + nblk) return;
    LAS float* scr = (LAS float*)(F.lds + F.wave * 16384);
    const int gw = (F.bid - bid0) * NWAVES + F.wave, NGW = nblk * NWAVES;
    constexpr int NITEMS = 2 * 16 * (NWI / 32) + 2 * (FFNP / 64) * 32 + 16 * (INWP / 32) + 16 * 32;
    for (int it = gw; it < NITEMS; it += 2 * NGW) {
        const CvtDesc d0 = cvt_decode(F, li, set, it), d1 = cvt_decode(F, li, set, it + NGW);
        f32x4 v0[8], v1[8];
        cvt_load(d0, v0, F.lane); cvt_load(d1, v1, F.lane);
        cvt_finish(d0, v0, scr, F.lane); cvt_finish(d1, v1, scr, F.lane);
    }
}
__device__ __forceinline__ void mod_gemv(Frame& F) {
    LAS float* sc = (LAS float*)F.lds;
    LAS float* red = sc + 3 * 1024;
    __syncthreads();
    for (int i = F.tid; i < 3 * 1024; i += NTHR) { const int v = i >> 10, k = i & 1023; const float x = v < 2 ? inp(I_C)[v * 1024 + k] : inp(I_CCTX)[k]; sc[i] = x / (1.0f + __expf(-x)); }
    __syncthreads();
    float* modv = (float*)(F.ws + WS_MOD);
    for (int u = F.bid; u < 2 * 72; u += F.G) {
        const int l = u / 72, n0 = (u % 72) * 128;
        const float* w = inp(I_MODW) + (size_t)l * DM * 9216 + n0 + 2 * F.lane;
        float a0 = 0.f, a1 = 0.f, b0 = 0.f, b1 = 0.f, c0 = 0.f, c1 = 0.f;
        const int k0 = F.wave * 128;
#pragma unroll 8
        for (int k = 0; k < 128; ++k) { const float2 wv = *(const float2*)(w + (size_t)(k0 + k) * 9216); const float s0 = sc[k0 + k], s1 = sc[1024 + k0 + k], s2 = sc[2048 + k0 + k];
            a0 += s0 * wv.x; a1 += s0 * wv.y; b0 += s1 * wv.x; b1 += s1 * wv.y; c0 += s2 * wv.x; c1 += s2 * wv.y; }
        LAS float* rw = red + F.wave * 384 + 2 * F.lane;
        rw[0] = a0; rw[1] = a1; rw[128] = b0; rw[129] = b1; rw[256] = c0; rw[257] = c1;
        __syncthreads();
        if (F.tid < 384) { float s = 0.f;
#pragma unroll
            for (int w8 = 0; w8 < 8; ++w8) s += red[w8 * 384 + F.tid];
            const int v = F.tid >> 7, n = n0 + (F.tid & 127);
            modv[(size_t)(l * 3 + v) * 9216 + n] = s + inp(I_MODB)[l * 9216 + n]; }
        __syncthreads();
    }
}
__device__ __forceinline__ void rope_tables(Frame& F) {
    float* ct = (float*)(F.ws + WS_ROPE); float* st = ct + SEQ * 32;
    for (int i = F.bid * NTHR + F.tid; i < SEQ * 32; i += F.G * NTHR) {
        const int t = i >> 5, j = i & 31; const int f = j & 15;
        const float inv = exp2f(-(float)f * (13.287712379549449f / 16.0f));
        const float pos = (float)(j < 16 ? (t >> 6) : (t & 63));
        const float ang = pos * inv;
        const double a = (double)ang; const double k = __builtin_rint(a * 0.15915494309189535); const float r = (float)(a - k * 6.283185307179586);
        ct[i] = __cosf(r); st[i] = __sinf(r);
    }
}

struct EArgs { const float* xl_src; const float* xc_src; const bf16* xb_src; bf16* xb_dst; float* out32; const bf16* o; const float* modv_g; int gidx; float gmul; const float* gpost;
               bf16* hdst; const float* modv_h; int shidx, scidx; const float* gpre; int nrows; };
template <int R>
__device__ __forceinline__ void e_rows(Frame& F, const EArgs& A, int v, int r0) {
    f32x4 cg[4], ch[4], cs[4];
#pragma unroll
    for (int j = 0; j < 4; ++j) { const int c = F.lane + 64 * j;
        if (A.o) cg[j] = ((const f32x4*)(A.modv_g + (size_t)v * 9216 + A.gidx * DM))[c] * ((const f32x4*)A.gpost)[c] * A.gmul;
        if (A.hdst) { ch[j] = ((const f32x4*)A.gpre)[c] * (1.0f + ((const f32x4*)(A.modv_h + (size_t)v * 9216 + A.scidx * DM))[c]); cs[j] = ((const f32x4*)(A.modv_h + (size_t)v * 9216 + A.shidx * DM))[c]; } }
    f32x4 x[R][4]; v2u ow[R][4];
#pragma unroll
    for (int i = 0; i < R; ++i) { const int r = r0 + i;
        if (A.xb_src) { const v2u* xs = (const v2u*)(A.xb_src + (size_t)r * DM);
#pragma unroll
            for (int j = 0; j < 4; ++j) { const v2u w = xs[F.lane + 64 * j]; x[i][j] = (f32x4){bflo(w.x), bfhi(w.x), bflo(w.y), bfhi(w.y)}; } }
        else { const float* xs = r < TL ? A.xl_src + (size_t)r * DM : A.xc_src + (size_t)(r - TL) * DM;
#pragma unroll
            for (int j = 0; j < 4; ++j) x[i][j] = ((const f32x4*)xs)[F.lane + 64 * j]; }
        if (A.o) { const v2u* orow = (const v2u*)(A.o + (size_t)r * DM);
#pragma unroll
            for (int j = 0; j < 4; ++j) ow[i][j] = orow[F.lane + 64 * j]; } }
#pragma unroll
    for (int i = 0; i < R; ++i) { const int r = r0 + i;
        if (A.o) { f32x4 ov[4]; float ss = 0.f;
#pragma unroll
            for (int j = 0; j < 4; ++j) { const v2u w = ow[i][j]; ov[j] = (f32x4){bflo(w.x), bfhi(w.x), bflo(w.y), bfhi(w.y)}; ss += (ov[j].x * ov[j].x + ov[j].y * ov[j].y) + (ov[j].z * ov[j].z + ov[j].w * ov[j].w); }
            const float rstd = __builtin_amdgcn_rsqf(wave_sum(ss) * (1.0f / DM) + NORM_EPS);
#pragma unroll
            for (int j = 0; j < 4; ++j) x[i][j] = x[i][j] + cg[j] * (ov[j] * rstd);
            if (A.out32) {
#pragma unroll
                for (int j = 0; j < 4; ++j) ((f32x4*)(A.out32 + (size_t)r * DM))[F.lane + 64 * j] = x[i][j]; }
            else { v2u* xd = (v2u*)(A.xb_dst + (size_t)r * DM);
#pragma unroll
                for (int j = 0; j < 4; ++j) { v2u w; w.x = pk2(x[i][j].x, x[i][j].y); w.y = pk2(x[i][j].z, x[i][j].w); xd[F.lane + 64 * j] = w; } } }
        if (A.hdst) { float ss = 0.f;
#pragma unroll
            for (int j = 0; j < 4; ++j) ss += (x[i][j].x * x[i][j].x + x[i][j].y * x[i][j].y) + (x[i][j].z * x[i][j].z + x[i][j].w * x[i][j].w);
            const float rstd = __builtin_amdgcn_rsqf(wave_sum(ss) * (1.0f / DM) + NORM_EPS);
            v2u* hd = (v2u*)(A.hdst + (size_t)r * DM);
#pragma unroll
            for (int j = 0; j < 4; ++j) { const f32x4 hv = (x[i][j] * rstd) * ch[j] + cs[j]; v2u w; w.x = pk2(hv.x, hv.y); w.y = pk2(hv.z, hv.w); hd[F.lane + 64 * j] = w; } } }
}
__device__ __forceinline__ void e_phase(Frame& F, const EArgs& A) {
    const int gw = F.bid * NWAVES + F.wave, NGW = F.G * NWAVES;
    if (NGW == 2048) {
        const int b = gw >> 10, r0 = b * SEQ + (gw & 1023) * 8;
        e_rows<4>(F, A, b, r0); e_rows<4>(F, A, b, r0 + 4);
        if (A.nrows > TL && (gw & 3) == 0) e_rows<1>(F, A, 2, TL + (gw >> 2));
    } else { for (int r = gw; r < A.nrows; r += NGW) e_rows<1>(F, A, r < TL ? (r >> 13) : 2, r); }
}

__device__ __forceinline__ const bf16* zrow(const Frame& F, int row) { return (const bf16*)(F.ws + WS_ACT) + (size_t)row * INWP; }

typedef short bf16x8 __attribute__((ext_vector_type(8)));
#define MFMA16(a, b, c) __builtin_amdgcn_mfma_f32_16x16x32_bf16(a, b, c, 0, 0, 0)
__device__ __forceinline__ bf16x8 mk8(unsigned a, unsigned b, unsigned c, unsigned d) { const v4u v = {a, b, c, d}; return __builtin_bit_cast(bf16x8, v); }
typedef __bf16 bf16x2_t __attribute__((ext_vector_type(2)));
typedef float f32x2_t __attribute__((ext_vector_type(2)));
__device__ __forceinline__ unsigned cvtpk(float lo, float hi) { const f32x2_t f = {lo, hi}; return __builtin_bit_cast(unsigned, __builtin_convertvector(f, bf16x2_t)); }
constexpr int NSC = 66;
constexpr int IM_AI = 0, IM_RI = 4608, IM_BI = 9216, IM_KI = 13824, IM_BKT = 18432, IM_VT = 28928, IM_GAM = 34176, IMG_BYTES = 34816;
constexpr int L_IMG0 = 0, L_IMG1 = IMG_BYTES, L_PKG = 2 * IMG_BYTES, L_YL = L_PKG + 8192, L_VB = L_YL + 128 * 68 * 4, L_BON = L_VB + 128 * 64 * 2, L_CST = L_BON + 512, L_RW_END = L_CST + 2 * 3072;
static_assert(L_RW_END <= 146432, "rwkv LDS map");
constexpr size_t SUM_SLOT = 24576;

__device__ __forceinline__ void fourier_ctx1_all(Frame& F) {
    bf16* gre = (bf16*)(F.ws + WS_GC); bf16* gim = gre + TC * 256;
    const bf16* wc = (const bf16*)(F.ws + WS_FT + FT_W64C); const bf16* wsn = (const bf16*)(F.ws + WS_FT + FT_W64S);
    for (int i = F.bid * NTHR + F.tid; i < TC * 256; i += F.G * NTHR) { const int tok = i & (TC - 1), gm = i >> 9, g = gm >> 6, m = gm & 63;
        const bf16* z = zrow(F, TL + tok) + ZF + 64 * g; float sr = 0.f, si = 0.f;
#pragma unroll
        for (int c8 = 0; c8 < 8; ++c8) { float x[8], cs[8], sn[8]; unpack8(*(const v4u*)(z + 8 * c8), x); unpack8(*(const v4u*)(wc + m * 64 + 8 * c8), cs); unpack8(*(const v4u*)(wsn + m * 64 + 8 * c8), sn);
#pragma unroll
            for (int e = 0; e < 8; ++e) { sr += x[e] * cs[e]; si -= x[e] * sn[e]; } }
        const int o = ((tok >> 8) * 256 + gm) * 256 + (tok & 255);
        gre[o] = (bf16)f2bf(sr); gim[o] = (bf16)f2bf(si); }
}
__device__ __forceinline__ void fourier_ctx2_all(Frame& F, int bid0) {
    const bf16* gre = (const bf16*)(F.ws + WS_GC); const bf16* gim = gre + TC * 256; bf16* mix = (bf16*)(F.ws + WS_H);
    const int q = F.lane >> 4, c = F.lane & 15;
#pragma unroll 1
    for (int u = (F.bid - bid0) * 8 + F.wave; u < 512; u += (F.G - bid0) * 8) { const int b = u >> 8, kt = (u >> 4) & 15, gt = u & 15;
        const int k = 16 * kt + c; const bf16* pr = gre + (size_t)((b * 256 + 16 * gt + c) * 256 + 8 * q); const bf16* pi = gim + (size_t)((b * 256 + 16 * gt + c) * 256 + 8 * q);
        f32x4 acc = {0.f, 0.f, 0.f, 0.f};
#pragma unroll
        for (int cc = 0; cc < 8; ++cc) { const bf16x8 re = *(const bf16x8*)(pr + 32 * cc), im = *(const bf16x8*)(pi + 32 * cc);
            float cv[8], sv[8];
#pragma unroll
            for (int e = 0; e < 8; ++e) { const float a = (float)((k * (32 * cc + 8 * q + e)) & 255) * (1.0f / 256.0f); cv[e] = __builtin_amdgcn_cosf(a); sv[e] = __builtin_amdgcn_sinf(a); }
            acc = MFMA16(mk8(cvtpk(cv[0], cv[1]), cvtpk(cv[2], cv[3]), cvtpk(cv[4], cv[5]), cvtpk(cv[6], cv[7])), re, acc);
            acc = MFMA16(mk8(cvtpk(sv[0], sv[1]), cvtpk(sv[2], sv[3]), cvtpk(sv[4], sv[5]), cvtpk(sv[6], sv[7])), im, acc); }
#pragma unroll
        for (int r = 0; r < 4; ++r) mix[(size_t)(TL + b * 256 + 16 * kt + 4 * q + r) * DM + 16 * gt + c] = (bf16)f2bf(acc[r] * 0.0078125f); }
}
__device__ __forceinline__ void lora_transposes(Frame& F) {
    bf16* w2t = (bf16*)(F.ws + WS_W2T); bf16* a2t = (bf16*)(F.ws + WS_A2T); bf16* g2t = (bf16*)(F.ws + WS_G2T);
    const float* w2 = inp(I_W2); const float* a2 = inp(I_A2); const float* g2 = inp(I_G2);
    for (int i = F.bid * NTHR + F.tid; i < 4 * 384 * 64; i += F.G * NTHR) { const int r = i & 63, col = (i >> 6) % 384, ld = i / (384 * 64);
        w2t[i] = (bf16)f2bf(w2[((size_t)ld * 64 + r) * RW + col]); a2t[i] = (bf16)f2bf(a2[((size_t)ld * 64 + r) * RW + col]); }
    for (int i = F.bid * NTHR + F.tid; i < 2 * 384 * 128; i += F.G * NTHR) { const int r = i & 127, col = (i >> 7) % 384, l = i / (384 * 128);
        g2t[i] = (bf16)f2bf(g2[((size_t)l * 128 + r) * RW + col]); }
}

__device__ __forceinline__ float softplus_fast(float x) { return fmaxf(x, 0.f) + __logf(1.0f + __expf(-fabsf(x))); }
__device__ __forceinline__ float tanh_fast(float x) { return 1.0f - 2.0f * __builtin_amdgcn_rcpf(1.0f + __expf(2.0f * x)); }
template <int CTRL> __device__ __forceinline__ float dpp_f(float v) { return __builtin_bit_cast(float, __builtin_amdgcn_update_dpp(0, __builtin_bit_cast(int, v), CTRL, 0xf, 0xf, true)); }
__device__ __forceinline__ void lora_pass(Frame& F, int li) {
    const int q = F.lane >> 4, c16 = F.lane & 15;
#pragma unroll 1
    for (int dir = 0; dir < 2; ++dir) {
        bf16* LW = (bf16*)(F.ws + WS_LW) + (size_t)dir * TT * RW; bf16* IC = (bf16*)(F.ws + WS_IC) + (size_t)dir * TT * RW;
        const bf16* w2t = (const bf16*)(F.ws + WS_W2T) + (size_t)(li * 2 + dir) * 384 * 64; const bf16* a2t = (const bf16*)(F.ws + WS_A2T) + (size_t)(li * 2 + dir) * 384 * 64;
        bf16x8 aw[3][2], aa[3][2]; f32x4 w0v[3], a0v[3];
#pragma unroll
        for (int cti = 0; cti < 3; ++cti) { const int ct = 3 * F.wave + cti, col = 16 * ct + c16;
#pragma unroll
            for (int k = 0; k < 2; ++k) { aw[cti][k] = *(const bf16x8*)(w2t + (size_t)col * 64 + 32 * k + 8 * q); aa[cti][k] = *(const bf16x8*)(a2t + (size_t)col * 64 + 32 * k + 8 * q); }
            w0v[cti] = *(const f32x4*)(inp(I_W0) + (li * 2 + dir) * RW + 16 * ct + 4 * q); a0v[cti] = *(const f32x4*)(inp(I_A0) + (li * 2 + dir) * RW + 16 * ct + 4 * q); }
#pragma unroll 1
        for (int rt = F.bid; rt < TT / 16; rt += F.G) {
            const bf16* z = zrow(F, 16 * rt + c16);
            bf16x8 bw[2], ba[2];
#pragma unroll
            for (int k = 0; k < 2; ++k) { const v4u zw = *(const v4u*)(z + ZW + 64 * dir + 32 * k + 8 * q); ba[k] = *(const bf16x8*)(z + ZA + 64 * dir + 32 * k + 8 * q);
                bw[k] = mk8(cvtpk(tanh_fast(bflo(zw.x)), tanh_fast(bfhi(zw.x))), cvtpk(tanh_fast(bflo(zw.y)), tanh_fast(bfhi(zw.y))), cvtpk(tanh_fast(bflo(zw.z)), tanh_fast(bfhi(zw.z))), cvtpk(tanh_fast(bflo(zw.w)), tanh_fast(bfhi(zw.w)))); }
#pragma unroll
            for (int cti = 0; cti < 3; ++cti) { const int ct = 3 * F.wave + cti;
                f32x4 dw = {0.f, 0.f, 0.f, 0.f}, da = {0.f, 0.f, 0.f, 0.f};
#pragma unroll
                for (int k = 0; k < 2; ++k) { dw = MFMA16(aw[cti][k], bw[k], dw); da = MFMA16(aa[cti][k], ba[k], da); }
                float lw[4], ic[4];
#pragma unroll
                for (int e = 0; e < 4; ++e) { const float x = w0v[cti][e] + dw[e]; const float wl = -softplus_fast(-x) - 0.5f; lw[e] = -__expf(wl); ic[e] = __builtin_amdgcn_rcpf(1.0f + __expf(-(a0v[cti][e] + da[e]))); }
                if (dir == 0) {
#pragma unroll
                    for (int e = 0; e < 4; ++e) { lw[e] += dpp_f<0x111>(lw[e]); lw[e] += dpp_f<0x112>(lw[e]); lw[e] += dpp_f<0x114>(lw[e]); lw[e] += dpp_f<0x118>(lw[e]); } }
                else {
#pragma unroll
                    for (int e = 0; e < 4; ++e) { lw[e] += dpp_f<0x101>(lw[e]); lw[e] += dpp_f<0x102>(lw[e]); lw[e] += dpp_f<0x104>(lw[e]); lw[e] += dpp_f<0x108>(lw[e]); } }
#pragma unroll
                for (int e = 0; e < 4; ++e) lw[e] = __expf(lw[e]);
                if (c16 == (dir == 0 ? 15 : 0)) *(f32x4*)((float*)(F.ws + WS_GAM32) + ((size_t)dir * (TT / 16) + rt) * RW + 16 * ct + 4 * q) = (f32x4){lw[0], lw[1], lw[2], lw[3]};
                const size_t o = (size_t)(16 * rt + c16) * RW + 16 * ct + 4 * q;
                v2u w; w.x = cvtpk(lw[0], lw[1]); w.y = cvtpk(lw[2], lw[3]); *(v2u*)(LW + o) = w; w.x = cvtpk(ic[0], ic[1]); w.y = cvtpk(ic[2], ic[3]); *(v2u*)(IC + o) = w; }
        }
    }
}
__device__ __forceinline__ void chain_consts_lds(Frame& F, LAS float* cst, int li, int h, int t256) {
    for (int i = t256; i < 12 * 64; i += 256) { const int k = i >> 6, j = i & 63, ch = 64 * h + j; float v;
        if (k == 0) v = inp(I_KK)[li * RW + ch]; else if (k == 1) v = inp(I_KA)[li * RW + ch]; else if (k == 2) v = inp(I_RK)[li * RW + ch];
        else { const int tt = (k - 3) / 3, w = (k - 3) % 3; v = inp(I_CONV)[(size_t)(li * 3 + tt) * (3 * RW) + w * RW + ch]; }
        cst[i] = v; }
}
struct PrepRaw { v4u ecw, icv, epw, zr[3], zk[3], zv[3]; f32x4 g0, g1; };
__device__ __forceinline__ void prep_load(Frame& F, PrepRaw& R, int dir, int b, int h, int tl, int o, bool isctx, int step0) {
    const int L = isctx ? CTX : SEQ, rbase = isctx ? TL + b * CTX : b * SEQ, ch0 = 64 * h + 8 * o;
    const int s = step0 + tl; const int p = dir ? L - 1 - s : s; const int row = rbase + p, tb = tl & 15;
    { const bf16* LW = (const bf16*)(F.ws + WS_LW) + (size_t)dir * TT * RW + ch0; const bf16* IC = (const bf16*)(F.ws + WS_IC) + (size_t)dir * TT * RW + ch0;
      R.ecw = *(const v4u*)(LW + (size_t)row * RW); R.icv = *(const v4u*)(IC + (size_t)row * RW); R.epw = *(const v4u*)(LW + (size_t)(tb == 0 ? row : (dir ? row + 1 : row - 1)) * RW); }
#pragma unroll
    for (int tt = 0; tt < 3; ++tt) { const int pp = p + tt - 1; const bool ok = pp >= 0 && pp < L; const bf16* z = zrow(F, rbase + (ok ? pp : p)) + ch0;
        const v4u z0 = {0u, 0u, 0u, 0u};
        R.zr[tt] = ok ? *(const v4u*)(z + ZRR) : z0; R.zk[tt] = ok ? *(const v4u*)(z + ZRK) : z0; R.zv[tt] = ok ? *(const v4u*)(z + ZRV) : z0; }
    if (tb == 15) { const f32x4* gs = (const f32x4*)((const float*)(F.ws + WS_GAM32) + ((size_t)dir * (TT / 16) + (row >> 4)) * RW + ch0); R.g0 = gs[0]; R.g1 = gs[1]; }
}
__device__ __forceinline__ void prep_compute(Frame& F, const PrepRaw& R, const LAS float* cst, LAS unsigned char* img, int dir, int b, int h, int tl, int o, bool isctx, int step0, LAS unsigned char* lds_vb, LAS float* lds_bon, int pos0_local) {
    const bool BONUS = lds_vb != nullptr;
    const int L = isctx ? CTX : SEQ, rbase = isctx ? TL + b * CTX : b * SEQ, ch0 = 64 * h + 8 * o;
    const int blk = tl >> 4, tb = tl & 15;
    const int s = step0 + tl; const int p = dir ? L - 1 - s : s; const int row = rbase + p;
    const v4u ecw = R.ecw, icv = R.icv, epw = R.epw;
    v4u zr[3], zk[3], zv[3];
#pragma unroll
    for (int tt = 0; tt < 3; ++tt) { zr[tt] = R.zr[tt]; zk[tt] = R.zk[tt]; zv[tt] = R.zv[tt]; }
    float ecf[8], epf[8], ai[8], rv[8], kv[8], vv[8];
    unpack8(ecw, ecf); unpack8(epw, epf); unpack8(icv, ai);
#pragma unroll
    for (int e = 0; e < 8; ++e) { rv[e] = 0.f; kv[e] = 0.f; vv[e] = 0.f; }
#pragma unroll
    for (int tt = 0; tt < 3; ++tt) { float a[8], bq[8], cq[8]; unpack8(zr[tt], a); unpack8(zk[tt], bq); unpack8(zv[tt], cq);
        const LAS f32x4* w0 = (const LAS f32x4*)(cst + (3 + tt * 3 + 0) * 64 + 8 * o); const LAS f32x4* w1 = (const LAS f32x4*)(cst + (3 + tt * 3 + 1) * 64 + 8 * o); const LAS f32x4* w2 = (const LAS f32x4*)(cst + (3 + tt * 3 + 2) * 64 + 8 * o);
        const f32x4 w0a = w0[0], w0b = w0[1], w1a = w1[0], w1b = w1[1], w2a = w2[0], w2b = w2[1];
#pragma unroll
        for (int e = 0; e < 4; ++e) { rv[e] += w0a[e] * a[e]; rv[e + 4] += w0b[e] * a[e + 4]; kv[e] += w1a[e] * bq[e]; kv[e + 4] += w1b[e] * bq[e + 4]; vv[e] += w2a[e] * cq[e]; vv[e + 4] += w2b[e] * cq[e + 4]; } }
    float kkw[8], kaw[8];
    { const LAS f32x4* a = (const LAS f32x4*)(cst + 0 * 64 + 8 * o); const LAS f32x4* bq = (const LAS f32x4*)(cst + 1 * 64 + 8 * o); const f32x4 a0 = a[0], a1 = a[1], b0 = bq[0], b1 = bq[1];
#pragma unroll
      for (int e = 0; e < 4; ++e) { kkw[e] = a0[e]; kkw[e + 4] = a1[e]; kaw[e] = b0[e]; kaw[e + 4] = b1[e]; } }
    float kkr[8], ss = 0.f;
#pragma unroll
    for (int e = 0; e < 8; ++e) { kkr[e] = kv[e] * kkw[e]; ss += kkr[e] * kkr[e]; }
    ss = sum8(ss);
    const float rn = __builtin_amdgcn_rsqf(fmaxf(ss, 1e-24f));
    float At[8], Rt[8], Bt[8], Kt[8];
#pragma unroll
    for (int e = 0; e < 8; ++e) { const float kk = kkr[e] * rn, kd = kv[e] * (1.0f + (ai[e] - 1.0f) * kaw[e]); const float eprev = tb == 0 ? 1.0f : epf[e]; const float ec = ecf[e], en = __builtin_amdgcn_rcpf(ec);
        At[e] = -kk * eprev; Rt[e] = rv[e] * ec; Bt[e] = kk * ai[e] * en; Kt[e] = kd * en; }
    const int P0 = 32 * (o >> 2) + 16 * (o & 1) + 4 * ((o >> 1) & 1);
    LAS bf16* AI = (LAS bf16*)(img + IM_AI) + blk * 1152 + tb * 72 + P0, *RI = (LAS bf16*)(img + IM_RI) + blk * 1152 + tb * 72 + P0, *BI = (LAS bf16*)(img + IM_BI) + blk * 1152 + tb * 72 + P0, *KI = (LAS bf16*)(img + IM_KI) + blk * 1152 + tb * 72 + P0;
    unsigned bp[4], kp[4];
#pragma unroll
    for (int e = 0; e < 4; ++e) { bp[e] = cvtpk(Bt[2 * e], Bt[2 * e + 1]); kp[e] = cvtpk(Kt[2 * e], Kt[2 * e + 1]); }
    *(LAS v2u*)AI = (v2u){cvtpk(At[0], At[1]), cvtpk(At[2], At[3])}; *(LAS v2u*)(AI + 8) = (v2u){cvtpk(At[4], At[5]), cvtpk(At[6], At[7])};
    *(LAS v2u*)RI = (v2u){cvtpk(Rt[0], Rt[1]), cvtpk(Rt[2], Rt[3])}; *(LAS v2u*)(RI + 8) = (v2u){cvtpk(Rt[4], Rt[5]), cvtpk(Rt[6], Rt[7])};
    *(LAS v2u*)BI = (v2u){bp[0], bp[1]}; *(LAS v2u*)(BI + 8) = (v2u){bp[2], bp[3]};
    *(LAS v2u*)KI = (v2u){kp[0], kp[1]}; *(LAS v2u*)(KI + 8) = (v2u){kp[2], kp[3]};
    LAS bf16* BKT = (LAS bf16*)(img + IM_BKT) + blk * 2624 + (8 * o) * 40 + o * 8 + (tb >> 2) * 8 + (tb & 3); LAS bf16* VT = (LAS bf16*)(img + IM_VT) + blk * 1312 + (8 * o) * 20 + o * 4 + tb;
    const unsigned vp[4] = {cvtpk(vv[0], vv[1]), cvtpk(vv[2], vv[3]), cvtpk(vv[4], vv[5]), cvtpk(vv[6], vv[7])};
#pragma unroll
    for (int e = 0; e < 8; ++e) { const unsigned bb = bp[e >> 1], kq = kp[e >> 1], vq = vp[e >> 1];
        BKT[e * 40] = (bf16)((e & 1) ? (bb >> 16) : (bb & 0xffff)); BKT[e * 40 + 4] = (bf16)((e & 1) ? (kq >> 16) : (kq & 0xffff)); VT[e * 20] = (bf16)((e & 1) ? (vq >> 16) : (vq & 0xffff)); }
    if (tb == 15) { LAS f32x4* G = (LAS f32x4*)((LAS float*)(img + IM_GAM) + blk * 64 + 8 * o); G[0] = R.g0; G[1] = R.g1; }
    if (BONUS) { float bs = 0.f; const LAS f32x4* rk = (const LAS f32x4*)(cst + 2 * 64 + 8 * o); const f32x4 r0 = rk[0], r1 = rk[1];
#pragma unroll
        for (int e = 0; e < 4; ++e) bs += rv[e] * kv[e] * r0[e] + rv[e + 4] * kv[e + 4] * r1[e];
        bs = sum8(bs);
        const int pl = dir ? pos0_local - tl : pos0_local + tl;
        *(LAS v4u*)(lds_vb + (pl * 64 + 8 * o) * 2) = (v4u){vp[0], vp[1], vp[2], vp[3]}; if (o == 0) lds_bon[pl] = bs; }
}
template <bool WANT_Y>
__device__ __forceinline__ void block_package(LAS unsigned char* img, int blk, LAS unsigned* pkg, int lane) {
    const int q = lane >> 4, c = lane & 15;
    f32x4 mab = {0.f, 0.f, 0.f, 0.f}, mak = mab, mbr = mab, mkr = mab;
#pragma unroll
    for (int k = 0; k < 2; ++k) { const int o = blk * 2304 + c * 144 + k * 64 + q * 16;
        const bf16x8 bi = *(const LAS bf16x8*)(img + IM_BI + o), ki = *(const LAS bf16x8*)(img + IM_KI + o), ai = *(const LAS bf16x8*)(img + IM_AI + o);
        mab = MFMA16(bi, ai, mab); mak = MFMA16(ki, ai, mak);
        if constexpr (WANT_Y) { const bf16x8 ri = *(const LAS bf16x8*)(img + IM_RI + o); mbr = MFMA16(bi, ri, mbr); mkr = MFMA16(ki, ri, mkr); } }
#pragma unroll
    for (int e = 0; e < 4; ++e) { const int s = 4 * q + e; if (!(s < c)) { mab[e] = 0.f; mak[e] = 0.f; } if (!(s <= c)) { mbr[e] = 0.f; mkr[e] = 0.f; } }
    f32x4 mabT = {0.f, 0.f, 0.f, 0.f};
#pragma unroll
    for (int k = 0; k < 2; ++k) { const int o = blk * 2304 + c * 144 + k * 64 + q * 16; mabT = MFMA16(*(const LAS bf16x8*)(img + IM_AI + o), *(const LAS bf16x8*)(img + IM_BI + o), mabT); }
#pragma unroll
    for (int e = 0; e < 4; ++e) if (!(c < 4 * q + e)) mabT[e] = 0.f;
    const f32x4 z4 = {0.f, 0.f, 0.f, 0.f};
#define OPND(x) mk8(cvtpk((x)[0], (x)[1]), cvtpk((x)[2], (x)[3]), 0u, 0u)
    const bf16x8 oM = OPND(mab), oMT = OPND(mabT);
    const f32x4 m2 = MFMA16(oMT, oM, z4), m2T = MFMA16(oM, oMT, z4);
    const bf16x8 oM2 = OPND(m2), oM2T = OPND(m2T);
    const f32x4 m4 = MFMA16(oM2T, oM2, z4), m4T = MFMA16(oM2, oM2T, z4);
    const f32x4 m8T = MFMA16(OPND(m4), OPND(m4T), z4);
    f32x4 nn = m2;
#pragma unroll
    for (int e = 0; e < 4; ++e) nn[e] += (4 * q + e == c) ? 1.0f : 0.0f;
    nn = MFMA16(oMT, OPND(nn), nn);
    nn = MFMA16(OPND(m4T), OPND(nn), nn);
    nn = MFMA16(OPND(m8T), OPND(nn), nn);
#undef OPND
    pkg[0 * 64 + lane] = cvtpk(nn[0], nn[1]); pkg[1 * 64 + lane] = cvtpk(nn[2], nn[3]);
    pkg[2 * 64 + lane] = cvtpk(mak[0], mak[1]); pkg[3 * 64 + lane] = cvtpk(mak[2], mak[3]);
    if constexpr (WANT_Y) { pkg[4 * 64 + lane] = cvtpk(mbr[0], mbr[1]); pkg[5 * 64 + lane] = cvtpk(mbr[2], mbr[3]); pkg[6 * 64 + lane] = cvtpk(mkr[0], mkr[1]); pkg[7 * 64 + lane] = cvtpk(mkr[2], mkr[3]); }
}
template <bool WANT_Y, bool HAS_V>
__device__ __forceinline__ f32x4 block_scan(LAS unsigned char* img, int blk, const LAS unsigned* pkg, f32x4 (&S)[4], int wq, int lane) {
    const int q = lane >> 4, c = lane & 15;
    bf16x8 Sb[2];
#pragma unroll
    for (int k = 0; k < 2; ++k) Sb[k] = mk8(cvtpk(S[2 * k][0], S[2 * k][1]), cvtpk(S[2 * k][2], S[2 * k][3]), cvtpk(S[2 * k + 1][0], S[2 * k + 1][1]), cvtpk(S[2 * k + 1][2], S[2 * k + 1][3]));
    v2u vpk = {0u, 0u};
    if constexpr (HAS_V) vpk = *(const LAS v2u*)(img + IM_VT + blk * 2624 + (c + 16 * wq) * 40 + ((c + 16 * wq) >> 3) * 8 + q * 8);
    const int ao = blk * 2304 + c * 144 + q * 16;
    f32x4 rhs = {0.f, 0.f, 0.f, 0.f};
    rhs = MFMA16(*(const LAS bf16x8*)(img + IM_AI + ao), Sb[0], rhs); rhs = MFMA16(*(const LAS bf16x8*)(img + IM_AI + ao + 64), Sb[1], rhs);
    if constexpr (HAS_V) rhs = MFMA16(mk8(0u, 0u, pkg[2 * 64 + lane], pkg[3 * 64 + lane]), mk8(0u, 0u, vpk.x, vpk.y), rhs);
    f32x4 u = {0.f, 0.f, 0.f, 0.f};
    u = MFMA16(mk8(pkg[0 * 64 + lane], pkg[1 * 64 + lane], 0u, 0u), mk8(cvtpk(rhs[0], rhs[1]), cvtpk(rhs[2], rhs[3]), 0u, 0u), u);
    const bf16x8 UV = mk8(cvtpk(u[0], u[1]), cvtpk(u[2], u[3]), vpk.x, vpk.y);
    f32x4 y = {0.f, 0.f, 0.f, 0.f};
    if constexpr (WANT_Y) { y = MFMA16(*(const LAS bf16x8*)(img + IM_RI + ao), Sb[0], y); y = MFMA16(*(const LAS bf16x8*)(img + IM_RI + ao + 64), Sb[1], y);
        y = MFMA16(mk8(pkg[4 * 64 + lane], pkg[5 * 64 + lane], pkg[6 * 64 + lane], pkg[7 * 64 + lane]), UV, y); }
#pragma unroll
    for (int T = 0; T < 4; ++T) { const bf16x8 bkt = *(const LAS bf16x8*)(img + IM_BKT + blk * 5248 + (16 * T + c) * 80 + ((16 * T + c) >> 3) * 16 + q * 16);
        S[T] = MFMA16(bkt, UV, S[T]); const f32x4 g = *(const LAS f32x4*)(img + IM_GAM + blk * 256 + (16 * T + 4 * q) * 4); S[T] = S[T] * g; }
    return y;
}
__device__ __forceinline__ unsigned char* sum_slot(Frame& F, int chain, int sc) { return (unsigned char*)F.out + OUT_SUM + (size_t)(chain * NSC + sc) * SUM_SLOT; }

__device__ __forceinline__ void rwkv_pass1_pair(Frame& F, int li, int pair) {
    const int g = F.wave >> 2, wq = F.wave & 3, u = 2 * pair + g;
    const int chain = u / (NSC - 1), sc = u % (NSC - 1);
    const int dir = chain / 12, b = (chain / 6) & 1, h = chain % 6;
    const bool isctx = sc < 2; const int scl = isctx ? sc : sc - 2;
    LAS unsigned char* img = F.lds + (g ? L_IMG1 : L_IMG0); LAS unsigned* pkg = (LAS unsigned*)(F.lds + L_PKG) + g * 1024;
    LAS float* cst = (LAS float*)(F.lds + L_CST) + g * 768;
    __syncthreads();
    chain_consts_lds(F, cst, li, h, F.tid & 255);
    const int q = F.lane >> 4, c = F.lane & 15;
    f32x4 SB[4], SA[4];
#pragma unroll
    for (int T = 0; T < 4; ++T)
#pragma unroll
        for (int e = 0; e < 4; ++e) { SB[T][e] = 0.0f; SA[T][e] = (16 * T + 4 * q + e == c + 16 * wq) ? 1.0f : 0.0f; }
    PrepRaw R;
    prep_load(F, R, dir, b, h, 8 * wq + (F.lane >> 3), F.lane & 7, isctx, 128 * scl);
#pragma unroll 1
    for (int rd = 0; rd < 4; ++rd) {
        __syncthreads();
        prep_compute(F, R, cst, img, dir, b, h, 8 * wq + (F.lane >> 3), F.lane & 7, isctx, 128 * scl + 32 * rd, nullptr, nullptr, 0);
        __syncthreads();
        if (rd < 3) prep_load(F, R, dir, b, h, 8 * wq + (F.lane >> 3), F.lane & 7, isctx, 128 * scl + 32 * (rd + 1));
        if (wq < 2) block_package<false>(img, wq, pkg + wq * 512, F.lane);
        __syncthreads();
#pragma unroll
        for (int blk = 0; blk < 2; ++blk) { block_scan<false, true>(img, blk, pkg + blk * 512, SB, wq, F.lane); block_scan<false, false>(img, blk, pkg + blk * 512, SA, wq, F.lane); }
    }
    unsigned char* slot = sum_slot(F, chain, sc);
    { f32x4* braw = (f32x4*)slot;
#pragma unroll
      for (int T = 0; T < 4; ++T) braw[(wq * 4 + T) * 64 + F.lane] = SB[T]; }
    { bf16* aim = (bf16*)(slot + 16384); const int kap = wq >> 1, e = (F.lane & 3) + 4 * (wq & 1), qc = c >> 2;
#pragma unroll
      for (int T = 0; T < 4; ++T)
#pragma unroll
          for (int r = 0; r < 4; ++r) { const int lc = (4 * q + r) + 16 * qc; aim[((T * 2 + kap) * 64 + lc) * 8 + e] = (bf16)f2bf(SA[T][r]); } }
}
struct P2Stage { v4u v[3]; };
__device__ __forceinline__ void p2_ld(Frame& F, P2Stage& X, int chain, int sc, int wq) {
    const v4u* s = (const v4u*)sum_slot(F, chain, sc) + (F.tid - 256);
    X.v[0] = s[wq * 256]; X.v[1] = s[1024]; X.v[2] = s[1280];
}
__device__ __forceinline__ void p2_put(Frame& F, const P2Stage& X, LAS unsigned char* bb) {
#pragma unroll
    for (int i = 0; i < 3; ++i) *(LAS v4u*)(bb + 4096 * i + 16 * (F.tid - 256)) = X.v[i];
}
constexpr int P2D = 8;
__device__ __forceinline__ void p2_math(Frame& F, const LAS unsigned char* bb, f32x4 (&S)[4], int chain, int sc, int wq) {
    f32x4* braw = (f32x4*)sum_slot(F, chain, sc);
    bf16x8 Sb[2];
#pragma unroll
    for (int k = 0; k < 2; ++k) Sb[k] = mk8(cvtpk(S[2 * k][0], S[2 * k][1]), cvtpk(S[2 * k][2], S[2 * k][3]), cvtpk(S[2 * k + 1][0], S[2 * k + 1][1]), cvtpk(S[2 * k + 1][2], S[2 * k + 1][3]));
#pragma unroll
    for (int T = 0; T < 4; ++T) { braw[(wq * 4 + T) * 64 + F.lane] = S[T];
        const f32x4 bc = *(const LAS f32x4*)(bb + (T * 64 + F.lane) * 16);
        const bf16x8 a0 = *(const LAS bf16x8*)(bb + 4096 + ((T * 2 + 0) * 64 + F.lane) * 16), a1 = *(const LAS bf16x8*)(bb + 4096 + ((T * 2 + 1) * 64 + F.lane) * 16);
        S[T] = MFMA16(a1, Sb[1], MFMA16(a0, Sb[0], bc)); }
}
__device__ __forceinline__ void rwkv_pass2_part(Frame& F, int chain, int wq) {
    constexpr int NS = NSC - 1;
    LAS unsigned char* buf = F.lds;
    __syncthreads();
    if (F.wave >= 4) {
        P2Stage X[P2D];
#pragma unroll
        for (int j = 0; j < P2D; ++j) p2_ld(F, X[j], chain, j, wq);
#pragma unroll 1
        for (int sc0 = 0; sc0 < NS - 1; sc0 += P2D) {
#pragma unroll
            for (int j = 0; j < P2D; ++j) { const int sc = sc0 + j; p2_put(F, X[j], buf + (j & 1) * 12288); p2_ld(F, X[j], chain, min(sc + P2D, NS - 1), wq); __syncthreads(); } }
        p2_put(F, X[0], buf); __syncthreads();
        return;
    }
    if (F.wave > 0) {
#pragma unroll 1
        for (int sc = 0; sc < NS; ++sc) __syncthreads();
        return;
    }
    f32x4 S[4];
#pragma unroll
    for (int T = 0; T < 4; ++T) S[T] = (f32x4){0.f, 0.f, 0.f, 0.f};
#pragma unroll 1
    for (int sc = 0; sc < NS; ++sc) { __syncthreads(); p2_math(F, buf + (sc & 1) * 12288, S, chain, sc, wq); }
    { f32x4* braw = (f32x4*)sum_slot(F, chain, NSC - 1);
#pragma unroll
      for (int T = 0; T < 4; ++T) braw[(wq * 4 + T) * 64 + F.lane] = S[T]; }
}
__device__ __forceinline__ void rwkv_pass3_unit(Frame& F, int li, int u) {
    T0(tu_); T0(ts_);
    const int pc = u % NSC, bh = u / NSC, b = bh / 6, h = bh % 6;
    const bool isctx = pc < 2; const int pcl = isctx ? pc : pc - 2, nsc = isctx ? 2 : 64;
    const int dir = F.wave >> 2, wq = F.wave & 3, q = F.lane >> 4, c = F.lane & 15;
    const int sc = dir == 0 ? pc : (isctx ? 1 - pcl : 2 + 63 - pcl);
    const int scl = dir == 0 ? pcl : nsc - 1 - pcl;
    const int chain = dir * 12 + b * 6 + h;
    LAS unsigned char* img = F.lds + (dir ? L_IMG1 : L_IMG0); LAS unsigned* pkg = (LAS unsigned*)(F.lds + L_PKG) + dir * 1024;
    LAS float* YL = (LAS float*)(F.lds + L_YL); LAS unsigned char* VB = F.lds + L_VB; LAS float* BON = (LAS float*)(F.lds + L_BON);
    LAS float* cst = (LAS float*)(F.lds + L_CST);
    __syncthreads();
    if (F.tid < 256) chain_consts_lds(F, cst, li, h, F.tid);
    f32x4 S[4];
    { const f32x4* braw = (const f32x4*)sum_slot(F, chain, sc);
#pragma unroll
      for (int T = 0; T < 4; ++T) S[T] = braw[(wq * 4 + T) * 64 + F.lane]; }
    __syncthreads();
    for (int i = F.tid; i < 128 * 68; i += NTHR) YL[i] = 0.f;
    PrepRaw R;
    prep_load(F, R, dir, b, h, 8 * wq + (F.lane >> 3), F.lane & 7, isctx, 128 * scl);
    TACC(F, 11, ts_);
#pragma unroll 1
    for (int rd = 0; rd < 4; ++rd) {
        T0(ta_);
        __syncthreads();
        TACC(F, 16, ta_);
        prep_compute(F, R, cst, img, dir, b, h, 8 * wq + (F.lane >> 3), F.lane & 7, isctx, 128 * scl + 32 * rd, dir == 0 ? VB : (LAS unsigned char*)nullptr, BON, 32 * rd);
        TACC(F, 12, ta_); T0(tb_);
        __syncthreads();
        TACC(F, 17, tb_); T0(tb2_);
        if (rd < 3) prep_load(F, R, dir, b, h, 8 * wq + (F.lane >> 3), F.lane & 7, isctx, 128 * scl + 32 * (rd + 1));
        TACC(F, 18, tb2_); T0(tb3_);
        if (wq < 2) block_package<true>(img, wq, pkg + wq * 512, F.lane);
        TACC(F, 19, tb3_);
        __syncthreads();
        TACC(F, 13, tb_); T0(tc_);
#pragma unroll
        for (int blk = 0; blk < 2; ++blk) { const f32x4 y = block_scan<true, true>(img, blk, pkg + blk * 512, S, wq, F.lane);
#pragma unroll
            for (int e = 0; e < 4; ++e) { const int t = 32 * rd + 16 * blk + 4 * q + e; const int pl = dir ? 127 - t : t; YL[pl * 68 + c + 16 * wq] += y[e]; } }
        TACC(F, 14, tc_);
    }
    T0(td_);
    __syncthreads();
    const int wv = F.wave; const int rbase = (isctx ? TL + b * CTX : b * SEQ) + 128 * pcl;
    const bf16* g2t = (const bf16*)(F.ws + WS_G2T) + (size_t)li * 384 * 128;
    f32x4 gate[4];
#pragma unroll
    for (int nt = 0; nt < 4; ++nt) gate[nt] = (f32x4){0.f, 0.f, 0.f, 0.f};
#pragma unroll
    for (int k = 0; k < 4; ++k) { const v4u zg = *(const v4u*)(zrow(F, rbase + 16 * wv + c) + ZG + 32 * k + 8 * q);
#define SG(x) __builtin_amdgcn_rcpf(1.0f + __expf(-(x)))
        const bf16x8 a = mk8(pk2(SG(bflo(zg.x)), SG(bfhi(zg.x))), pk2(SG(bflo(zg.y)), SG(bfhi(zg.y))), pk2(SG(bflo(zg.z)), SG(bfhi(zg.z))), pk2(SG(bflo(zg.w)), SG(bfhi(zg.w))));
#undef SG
#pragma unroll
        for (int nt = 0; nt < 4; ++nt) { const bf16x8 bb = *(const bf16x8*)(g2t + (size_t)(64 * h + 16 * nt + c) * 128 + 32 * k + 8 * q); gate[nt] = MFMA16(a, bb, gate[nt]); } }
    bf16* mix = (bf16*)(F.ws + WS_H);
    float lg[4], lb[4];
#pragma unroll
    for (int nt = 0; nt < 4; ++nt) { lg[nt] = inp(I_LNG)[li * RW + 64 * h + 16 * nt + c]; lb[nt] = inp(I_LNB)[li * RW + 64 * h + 16 * nt + c]; }
#pragma unroll
    for (int e = 0; e < 4; ++e) { const int tl = 16 * wv + 4 * q + e;
        float yv[4], s = 0.f;
#pragma unroll
        for (int nt = 0; nt < 4; ++nt) { yv[nt] = YL[tl * 68 + 16 * nt + c]; s += yv[nt]; }
        s = sum16(s);
        const float mu = s * (1.0f / 64.0f); float v2 = 0.f;
#pragma unroll
        for (int nt = 0; nt < 4; ++nt) { yv[nt] -= mu; v2 += yv[nt] * yv[nt]; }
        v2 = sum16(v2);
        const float rs = __builtin_amdgcn_rsqf(v2 * (1.0f / 64.0f) + GN_EPS); const float bon = BON[tl];
#pragma unroll
        for (int nt = 0; nt < 4; ++nt) { const float vv = bf2f(((const LAS bf16*)VB)[tl * 64 + 16 * nt + c]);
            const float o = (yv[nt] * rs * lg[nt] + lb[nt] + bon * vv) * gate[nt][e];
            mix[(size_t)(rbase + tl) * DM + 640 + 64 * h + 16 * nt + c] = (bf16)f2bf(o); } }
    TACC(F, 15, td_); TACC(F, 10, tu_);
}

constexpr int AT_KROW = 144;
__device__ __forceinline__ void attn_unit(Frame& F, int li, int u) {
    const bool cq = u >= 256;
    int b, kvh, qb;
    if (!cq) { b = u >> 7; kvh = (u >> 6) & 1; qb = u & 63; } else { const int uu = u - 256; b = uu >> 2; kvh = (uu >> 1) & 1; qb = uu & 1; }
    const int c = F.lane & 15, q = F.lane >> 4, tb = F.wave;
    bf16* mix = (bf16*)(F.ws + WS_H);
    const float* rct = (const float*)(F.ws + WS_ROPE); const float* rst = rct + SEQ * 32;
    const int qrow = (cq ? TL + b * CTX : b * SEQ) + 128 * qb + 16 * tb + c;
    const int qpos = 128 * qb + 16 * tb + c;
    bf16x8 Q[3][2];
    { float cs[8], sn[8];
      if (!cq) { const f32x4 c0 = *(const f32x4*)(rct + qpos * 32 + 8 * q), c1 = *(const f32x4*)(rct + qpos * 32 + 8 * q + 4), s0 = *(const f32x4*)(rst + qpos * 32 + 8 * q), s1 = *(const f32x4*)(rst + qpos * 32 + 8 * q + 4);
#pragma unroll
          for (int e = 0; e < 4; ++e) { cs[e] = c0[e]; cs[e + 4] = c1[e]; sn[e] = s0[e]; sn[e + 4] = s1[e]; } }
      else {
#pragma unroll
          for (int e = 0; e < 8; ++e) { cs[e] = 1.0f; sn[e] = 0.0f; } }
#pragma unroll
      for (int hh = 0; hh < 3; ++hh) { const bf16* zq = zrow(F, qrow) + ZQ + 64 * (3 * kvh + hh) + 8 * q; float x1[8], x2[8]; unpack8(*(const v4u*)zq, x1); unpack8(*(const v4u*)(zq + 32), x2);
          float o1[8], o2[8];
#pragma unroll
          for (int e = 0; e < 8; ++e) { o1[e] = 0.125f * (x1[e] * cs[e] - x2[e] * sn[e]); o2[e] = 0.125f * (x2[e] * cs[e] + x1[e] * sn[e]); }
          Q[hh][0] = mk8(pk2(o1[0], o1[1]), pk2(o1[2], o1[3]), pk2(o1[4], o1[5]), pk2(o1[6], o1[7])); Q[hh][1] = mk8(pk2(o2[0], o2[1]), pk2(o2[2], o2[3]), pk2(o2[4], o2[5]), pk2(o2[6], o2[7])); } }
    float m[3], l[3]; f32x4 O[3][4];
#pragma unroll
    for (int hh = 0; hh < 3; ++hh) { m[hh] = inp(I_SINK)[li * 6 + 3 * kvh + hh]; l[hh] = q == 0 ? 1.0f : 0.0f;
#pragma unroll
        for (int dt = 0; dt < 4; ++dt) O[hh][dt] = (f32x4){0.f, 0.f, 0.f, 0.f}; }
    LAS unsigned char* KI = F.lds;
#pragma unroll 1
    for (int stage = cq ? 1 : 0; stage < 2; ++stage) {
        const int nkeys = stage == 0 ? 384 : 256; const int vstride = (nkeys + 8) * 2;
        LAS unsigned char* VTI = F.lds + 384 * AT_KROW;
        const int kpos0 = 128 * (qb - 1);
        __syncthreads();
        for (int pc = F.tid; pc < nkeys * 4; pc += NTHR) { const int key = pc >> 2, o = pc & 3;
            const bf16* zk; float cs[8], sn[8];
            if (stage == 0) { int kp = kpos0 + key; kp = kp < 0 ? 0 : (kp >= SEQ ? SEQ - 1 : kp); zk = zrow(F, b * SEQ + kp) + 64 * kvh + 8 * o;
                const f32x4 c0 = *(const f32x4*)(rct + kp * 32 + 8 * o), c1 = *(const f32x4*)(rct + kp * 32 + 8 * o + 4), s0 = *(const f32x4*)(rst + kp * 32 + 8 * o), s1 = *(const f32x4*)(rst + kp * 32 + 8 * o + 4);
#pragma unroll
                for (int e = 0; e < 4; ++e) { cs[e] = c0[e]; cs[e + 4] = c1[e]; sn[e] = s0[e]; sn[e + 4] = s1[e]; } }
            else { zk = zrow(F, TL + b * CTX + key) + 64 * kvh + 8 * o;
#pragma unroll
                for (int e = 0; e < 8; ++e) { cs[e] = 1.0f; sn[e] = 0.0f; } }
            const v4u k1 = *(const v4u*)(zk + ZK), k2 = *(const v4u*)(zk + ZK + 32), v1 = *(const v4u*)(zk + ZV), v2 = *(const v4u*)(zk + ZV + 32);
            float x1[8], x2[8]; unpack8(k1, x1); unpack8(k2, x2);
            float o1[8], o2[8];
#pragma unroll
            for (int e = 0; e < 8; ++e) { o1[e] = x1[e] * cs[e] - x2[e] * sn[e]; o2[e] = x2[e] * cs[e] + x1[e] * sn[e]; }
            *(LAS v4u*)(KI + key * AT_KROW + o * 16) = (v4u){pk2(o1[0], o1[1]), pk2(o1[2], o1[3]), pk2(o1[4], o1[5]), pk2(o1[6], o1[7])};
            *(LAS v4u*)(KI + key * AT_KROW + 64 + o * 16) = (v4u){pk2(o2[0], o2[1]), pk2(o2[2], o2[3]), pk2(o2[4], o2[5]), pk2(o2[6], o2[7])};
            const int kl = key & 31; const int col = (key & ~31) | (((kl & 15) >> 2) << 3) | ((kl >> 4) << 2) | (kl & 3);
#pragma unroll
            for (int hv = 0; hv < 2; ++hv) { const v4u vv = hv ? v2 : v1; LAS bf16* vt = (LAS bf16*)(VTI + (8 * (o + 4 * hv)) * vstride) + col;
                vt[0] = (bf16)(vv.x & 0xffff); *(LAS bf16*)((LAS unsigned char*)vt + vstride) = (bf16)(vv.x >> 16);
                *(LAS bf16*)((LAS unsigned char*)vt + 2 * vstride) = (bf16)(vv.y & 0xffff); *(LAS bf16*)((LAS unsigned char*)vt + 3 * vstride) = (bf16)(vv.y >> 16);
                *(LAS bf16*)((LAS unsigned char*)vt + 4 * vstride) = (bf16)(vv.z & 0xffff); *(LAS bf16*)((LAS unsigned char*)vt + 5 * vstride) = (bf16)(vv.z >> 16);
                *(LAS bf16*)((LAS unsigned char*)vt + 6 * vstride) = (bf16)(vv.w & 0xffff); *(LAS bf16*)((LAS unsigned char*)vt + 7 * vstride) = (bf16)(vv.w >> 16); } }
        __syncthreads();
        const int npair = nkeys / 32;
        const int Q0 = 128 * qb + 16 * tb;
#pragma unroll 1
        for (int kp = 0; kp < npair; ++kp) {
            const int kb = kpos0 + 32 * kp;
            if (stage == 0 && (kb + 31 < Q0 - 128 || kb > Q0 + 143 || kb + 31 < 0 || kb >= SEQ)) continue;
            bf16x8 K[2][2], V[4];
#pragma unroll
            for (int t = 0; t < 2; ++t)
#pragma unroll
                for (int k = 0; k < 2; ++k) K[t][k] = *(const LAS bf16x8*)(KI + (32 * kp + 16 * t + c) * AT_KROW + k * 64 + q * 16);
#pragma unroll
            for (int dt = 0; dt < 4; ++dt) V[dt] = *(const LAS bf16x8*)(VTI + (16 * dt + c) * vstride + kp * 64 + q * 16);
            bool ok0[4], ok1[4];
#pragma unroll
            for (int e = 0; e < 4; ++e) { const int k0 = kb + 4 * q + e, k1 = k0 + 16;
                ok0[e] = stage == 1 || (k0 >= 0 && k0 < SEQ && k0 >= qpos - 128 && k0 <= qpos + 128);
                ok1[e] = stage == 1 || (k1 >= 0 && k1 < SEQ && k1 >= qpos - 128 && k1 <= qpos + 128); }
#pragma unroll
            for (int hh = 0; hh < 3; ++hh) {
                f32x4 s0 = {0.f, 0.f, 0.f, 0.f}, s1 = {0.f, 0.f, 0.f, 0.f};
                s0 = MFMA16(K[0][0], Q[hh][0], s0); s0 = MFMA16(K[0][1], Q[hh][1], s0);
                s1 = MFMA16(K[1][0], Q[hh][0], s1); s1 = MFMA16(K[1][1], Q[hh][1], s1);
                float mx = -INFINITY;
#pragma unroll
                for (int e = 0; e < 4; ++e) { s0[e] = ok0[e] ? s0[e] : -INFINITY; s1[e] = ok1[e] ? s1[e] : -INFINITY; mx = fmaxf(mx, fmaxf(s0[e], s1[e])); }
                mx = xrow_max(mx);
                const float mn = fmaxf(m[hh], mx); const float alpha = __expf(m[hh] - mn); m[hh] = mn;
                float ps = 0.f;
#pragma unroll
                for (int e = 0; e < 4; ++e) { s0[e] = __expf(s0[e] - mn); s1[e] = __expf(s1[e] - mn); ps += s0[e] + s1[e]; }
                l[hh] = l[hh] * alpha + ps;
                const bf16x8 P = mk8(cvtpk(s0[0], s0[1]), cvtpk(s0[2], s0[3]), cvtpk(s1[0], s1[1]), cvtpk(s1[2], s1[3]));
#pragma unroll
                for (int dt = 0; dt < 4; ++dt) { O[hh][dt] = O[hh][dt] * alpha; O[hh][dt] = MFMA16(V[dt], P, O[hh][dt]); }
            }
        }
    }
#pragma unroll
    for (int hh = 0; hh < 3; ++hh) { const float lt = xrow_sum(l[hh]); const float inv = __builtin_amdgcn_rcpf(lt);
#pragma unroll
        for (int dt = 0; dt < 4; ++dt) { v2u w; w.x = pk2(O[hh][dt][0] * inv, O[hh][dt][1] * inv); w.y = pk2(O[hh][dt][2] * inv, O[hh][dt][3] * inv);
            *(v2u*)(mix + (size_t)qrow * DM + 256 + 64 * (3 * kvh + hh) + 16 * dt + 4 * q) = w; } }
}

__device__ __forceinline__ void fourier_tables(Frame& F) {
    bf16* t = (bf16*)(F.ws + WS_FT);
    for (int i = F.bid * NTHR + F.tid; i < 64 * 64; i += F.G * NTHR) { const int r = i >> 6, cc = i & 63; const float a = (float)((r * cc) & 63) * (1.0f / 64.0f);
        const float cs = __builtin_amdgcn_cosf(a), sn = __builtin_amdgcn_sinf(a);
        t[FT_W64C / 2 + i] = (bf16)f2bf(cs); t[FT_W64S / 2 + i] = (bf16)f2bf(sn);
        const int pj = (cc & ~31) | (((cc & 15) >> 2) << 3) | (((cc >> 4) & 1) << 2) | (cc & 3);
        t[FT_T64C / 2 + r * 64 + pj] = (bf16)f2bf(cs); t[FT_T64S / 2 + r * 64 + pj] = (bf16)f2bf(sn); }
    for (int i = F.bid * NTHR + F.tid; i < 128 * 128; i += F.G * NTHR) { const int r = i >> 7, cc = i & 127; const float a = (float)((r * cc) & 127) * (1.0f / 128.0f);
        t[FT_W128C / 2 + i] = (bf16)f2bf(__builtin_amdgcn_cosf(a)); t[FT_W128S / 2 + i] = (bf16)f2bf(__builtin_amdgcn_sinf(a)); }
}
__device__ __forceinline__ void fourier_a_fast(Frame& F, int u) {
    const int b = u >> 7, n2 = u & 127, c = F.lane & 15, q = F.lane >> 4;
    LAS unsigned char* IMG = F.lds;
    __syncthreads();
    for (int pc = F.tid; pc < 64 * 32; pc += NTHR) { const int n1 = pc >> 5, c8 = pc & 31;
        const v4u v = *(const v4u*)(zrow(F, b * SEQ + 128 * n1 + n2) + ZF + 8 * c8);
        LAS bf16* d = (LAS bf16*)(IMG + (8 * c8) * 144) + n1;
        d[0] = (bf16)(v.x & 0xffff); d[72] = (bf16)(v.x >> 16); d[144] = (bf16)(v.y & 0xffff); d[216] = (bf16)(v.y >> 16);
        d[288] = (bf16)(v.z & 0xffff); d[360] = (bf16)(v.z >> 16); d[432] = (bf16)(v.w & 0xffff); d[504] = (bf16)(v.w >> 16); }
    __syncthreads();
    const bf16* wc = (const bf16*)(F.ws + WS_FT + FT_W64C); const bf16* wsn = (const bf16*)(F.ws + WS_FT + FT_W64S);
    bf16* far = (bf16*)((unsigned char*)F.out + OUT_FA); bf16* fai = far + (size_t)NB * 64 * 128 * 256;
    bf16x8 Bc[4][2], Bs[4][2];
#pragma unroll
    for (int kt = 0; kt < 4; ++kt)
#pragma unroll
        for (int k = 0; k < 2; ++k) { Bc[kt][k] = *(const bf16x8*)(wc + (16 * kt + c) * 64 + 32 * k + 8 * q); Bs[kt][k] = *(const bf16x8*)(wsn + (16 * kt + c) * 64 + 32 * k + 8 * q); }
#pragma unroll
    for (int ci = 0; ci < 2; ++ci) { const int ct = 2 * F.wave + ci;
        bf16x8 A[2];
#pragma unroll
        for (int k = 0; k < 2; ++k) A[k] = *(const LAS bf16x8*)(IMG + (16 * ct + c) * 144 + k * 64 + q * 16);
#pragma unroll
        for (int kt = 0; kt < 4; ++kt) { f32x4 sr = {0.f, 0.f, 0.f, 0.f}, si = {0.f, 0.f, 0.f, 0.f};
#pragma unroll
            for (int k = 0; k < 2; ++k) { sr = MFMA16(A[k], Bc[kt][k], sr); si = MFMA16(A[k], Bs[kt][k], si); }
            const int k1 = 16 * kt + c; const float tw = (float)(n2 * k1) * (1.0f / 8192.0f); const float tc = __builtin_amdgcn_cosf(tw), ts = __builtin_amdgcn_sinf(tw);
            float xr[4], xi[4];
#pragma unroll
            for (int e = 0; e < 4; ++e) { const float ar = sr[e], ai = -si[e]; xr[e] = ar * tc + ai * ts; xi[e] = ai * tc - ar * ts; }
            const size_t o = (((size_t)b * 64 + k1) * 128 + n2) * 256 + 16 * ct + 4 * q;
            v2u w; w.x = pk2(xr[0], xr[1]); w.y = pk2(xr[2], xr[3]); *(v2u*)(far + o) = w; w.x = pk2(xi[0], xi[1]); w.y = pk2(xi[2], xi[3]); *(v2u*)(fai + o) = w; } }
}
__device__ __forceinline__ void fourier_c_fast(Frame& F, int u) {
    const int g = u & 3, k1 = (u >> 2) & 63, b = u >> 8, c = F.lane & 15, q = F.lane >> 4;
    LAS unsigned char* IR = F.lds; LAS unsigned char* II = F.lds + 64 * 272;
    const bf16* far = (const bf16*)((unsigned char*)F.out + OUT_FA) + (((size_t)b * 64 + k1) * 128) * 256 + 64 * g; const bf16* fai = far + (size_t)NB * 64 * 128 * 256;
    __syncthreads();
    for (int pc = F.tid; pc < 128 * 8; pc += NTHR) { const int n2 = pc >> 3, c8 = pc & 7;
        const v4u vr = *(const v4u*)(far + (size_t)n2 * 256 + 8 * c8), vi = *(const v4u*)(fai + (size_t)n2 * 256 + 8 * c8);
        LAS bf16* dr = (LAS bf16*)(IR + (8 * c8) * 272) + n2; LAS bf16* di = (LAS bf16*)(II + (8 * c8) * 272) + n2;
        dr[0] = (bf16)(vr.x & 0xffff); dr[136] = (bf16)(vr.x >> 16); dr[272] = (bf16)(vr.y & 0xffff); dr[408] = (bf16)(vr.y >> 16);
        dr[544] = (bf16)(vr.z & 0xffff); dr[680] = (bf16)(vr.z >> 16); dr[816] = (bf16)(vr.w & 0xffff); dr[952] = (bf16)(vr.w >> 16);
        di[0] = (bf16)(vi.x & 0xffff); di[136] = (bf16)(vi.x >> 16); di[272] = (bf16)(vi.y & 0xffff); di[408] = (bf16)(vi.y >> 16);
        di[544] = (bf16)(vi.z & 0xffff); di[680] = (bf16)(vi.z >> 16); di[816] = (bf16)(vi.w & 0xffff); di[952] = (bf16)(vi.w >> 16); }
    __syncthreads();
    const bf16* wc = (const bf16*)(F.ws + WS_FT + FT_W128C); const bf16* wsn = (const bf16*)(F.ws + WS_FT + FT_W128S);
    const bf16* tcn = (const bf16*)(F.ws + WS_FT + FT_T64C); const bf16* tsn = (const bf16*)(F.ws + WS_FT + FT_T64S);
    f32x4 Pr[4], Pi[4];
#pragma unroll
    for (int ct = 0; ct < 4; ++ct) { Pr[ct] = (f32x4){0.f, 0.f, 0.f, 0.f}; Pi[ct] = (f32x4){0.f, 0.f, 0.f, 0.f}; }
#pragma unroll
    for (int k = 0; k < 4; ++k) { const bf16x8 bc = *(const bf16x8*)(wc + (16 * F.wave + c) * 128 + 32 * k + 8 * q), bs = *(const bf16x8*)(wsn + (16 * F.wave + c) * 128 + 32 * k + 8 * q);
        const v4u bsu = __builtin_bit_cast(v4u, bs); const bf16x8 bsn = mk8(bsu.x ^ 0x80008000u, bsu.y ^ 0x80008000u, bsu.z ^ 0x80008000u, bsu.w ^ 0x80008000u);
#pragma unroll
        for (int ct = 0; ct < 4; ++ct) { const bf16x8 ar = *(const LAS bf16x8*)(IR + (16 * ct + c) * 272 + k * 64 + q * 16), ai = *(const LAS bf16x8*)(II + (16 * ct + c) * 272 + k * 64 + q * 16);
            Pr[ct] = MFMA16(ar, bc, Pr[ct]); Pr[ct] = MFMA16(ai, bs, Pr[ct]); Pi[ct] = MFMA16(ai, bc, Pi[ct]); Pi[ct] = MFMA16(ar, bsn, Pi[ct]); } }
    bf16x8 Br[2], Bi[2];
#pragma unroll
    for (int k = 0; k < 2; ++k) { Br[k] = mk8(cvtpk(Pr[2 * k][0], Pr[2 * k][1]), cvtpk(Pr[2 * k][2], Pr[2 * k][3]), cvtpk(Pr[2 * k + 1][0], Pr[2 * k + 1][1]), cvtpk(Pr[2 * k + 1][2], Pr[2 * k + 1][3]));
        Bi[k] = mk8(cvtpk(Pi[2 * k][0], Pi[2 * k][1]), cvtpk(Pi[2 * k][2], Pi[2 * k][3]), cvtpk(Pi[2 * k + 1][0], Pi[2 * k + 1][1]), cvtpk(Pi[2 * k + 1][2], Pi[2 * k + 1][3])); }
    bf16* mix = (bf16*)(F.ws + WS_H);
    const float scale = 0.0013810679320049757f;
    const int k2 = 16 * F.wave + c; const size_t row = (size_t)b * SEQ + k1 + 64 * k2;
#pragma unroll
    for (int mt = 0; mt < 4; ++mt) { f32x4 y = {0.f, 0.f, 0.f, 0.f};
#pragma unroll
        for (int k = 0; k < 2; ++k) { const bf16x8 ac = *(const bf16x8*)(tcn + (16 * mt + c) * 64 + 32 * k + 8 * q), as = *(const bf16x8*)(tsn + (16 * mt + c) * 64 + 32 * k + 8 * q);
            y = MFMA16(ac, Br[k], y); y = MFMA16(as, Bi[k], y); }
        v2u w; w.x = pk2(y[0] * scale, y[1] * scale); w.y = pk2(y[2] * scale, y[3] * scale);
        *(v2u*)(mix + row * DM + 64 * g + 16 * mt + 4 * q) = w; }
}

#define XB_TMO      128
#define XB_XCNT(j)  (256  + 64 * (j))
#define XB_XSUB(j)  (1280 + 64 * (j))
#define XB_XGEN(j)  (2304 + 64 * (j))
#define XB_TOP      3328
#define XB_TOPGEN   3392
#define XCD_BAR_WORDS 3456
#define XB_SPIN_CAP (1u << 23)
__device__ __forceinline__ unsigned xb_ld(unsigned* p)              { return __hip_atomic_load(p, __ATOMIC_RELAXED, __HIP_MEMORY_SCOPE_AGENT); }
__device__ __forceinline__ unsigned xb_add(unsigned* p, unsigned v) { return __hip_atomic_fetch_add(p, v, __ATOMIC_RELAXED, __HIP_MEMORY_SCOPE_AGENT); }
__device__ __forceinline__ unsigned xb_xcc_id() { return (unsigned)__builtin_amdgcn_s_getreg((3 << 11) | 20) & 0xFu; }
#define XB_SPIN(cond, bar) do { unsigned _sp = 0; while (cond) { __builtin_amdgcn_s_sleep(1); \
    if ((++_sp & 255u) == 0u) { if (xb_ld(&(bar)[XB_TMO])) break; if (_sp > XB_SPIN_CAP) { atomicAdd(&(bar)[XB_TMO], 1u); break; } } } } while (0)
struct XcdBarrier { unsigned* bar; unsigned x; volatile LAS unsigned* st; };
__device__ __forceinline__ XcdBarrier xcd_barrier_post(unsigned* bar, volatile LAS unsigned* st) {
    XcdBarrier b; b.bar = bar; b.x = xb_xcc_id(); b.st = st;
    if (threadIdx.x == 0) (void)xb_add(&bar[XB_XCNT(b.x)], 1u);
    return b;
}
__device__ __forceinline__ void xcd_barrier_complete(unsigned* bar, unsigned x, unsigned& nloc, unsigned& nx) {
    const unsigned G = gridDim.x * gridDim.y * gridDim.z;
    unsigned sum, cnt, mine, sp = 0u;
    for (;;) {
        sum = 0u; cnt = 0u; mine = 0u;
#pragma unroll
        for (unsigned j = 0; j < 16; ++j) { const unsigned c = xb_ld(&bar[XB_XCNT(j)]); sum += c; cnt += (c > 0u) ? 1u : 0u; mine = (j == x) ? c : mine; }
        if (sum == G) break;
        __builtin_amdgcn_s_sleep(1);
        if ((++sp & 255u) == 0u) { if (xb_ld(&bar[XB_TMO])) break; if (sp > XB_SPIN_CAP) { atomicAdd(&bar[XB_TMO], 1u); break; } }
    }
    nloc = mine > 0u ? mine : 1u; nx = cnt > 0u ? cnt : 1u;
}
__device__ __forceinline__ void xcd_barrier(const XcdBarrier& b0) {
    XcdBarrier b; { unsigned* p = b0.bar; unsigned x = __builtin_amdgcn_readfirstlane(b0.x); unsigned st = (unsigned)(size_t)b0.st; asm volatile("" : "+s"(p), "+s"(x), "+s"(st)); b.bar = p; b.x = x; b.st = (volatile LAS unsigned*)(size_t)st; }
    asm volatile("s_waitcnt vmcnt(0)" ::: "memory");
    __syncthreads();
    if (threadIdx.x == 0) {
        unsigned* bar = b.bar;
        __builtin_amdgcn_s_waitcnt(0);
        unsigned nloc = b.st[0], nx = b.st[1];
        if (nloc == 0u) { xcd_barrier_complete(bar, b.x, nloc, nx); b.st[0] = nloc; b.st[1] = nx; }
        const unsigned old = xb_add(&bar[XB_XSUB(b.x)], 1u);
        const unsigned gen = old / nloc;
        if (old + 1u == (gen + 1u) * nloc) {
            __builtin_amdgcn_fence(__ATOMIC_RELEASE, "agent");
            asm volatile("s_waitcnt vmcnt(0)" ::: "memory");
            const unsigned og = xb_add(&bar[XB_TOP], 1u);
            const unsigned tg = og / nx;
            if (og + 1u == (tg + 1u) * nx) xb_add(&bar[XB_TOPGEN], 1u);
            else XB_SPIN(xb_ld(&bar[XB_TOPGEN]) == tg, bar);
            __builtin_amdgcn_fence(__ATOMIC_ACQUIRE, "agent");
            xb_add(&bar[XB_XGEN(b.x)], 1u);
            asm volatile("s_waitcnt vmcnt(0)" ::: "memory");
        } else {
            XB_SPIN(xb_ld(&bar[XB_XGEN(b.x)]) == gen, bar);
            __builtin_amdgcn_fence(__ATOMIC_ACQUIRE, "agent");
            asm volatile("s_waitcnt vmcnt(0)" ::: "memory");
        }
    }
    __syncthreads();
}

__device__ __forceinline__ int queue_next(Frame& F, unsigned* cnt) {
    volatile LAS int* slot = (volatile LAS int*)(F.lds + MISC_OFF + 64);
    __syncthreads();
    if (F.tid == 0) *slot = (int)__hip_atomic_fetch_add(cnt, 1u, __ATOMIC_RELAXED, __HIP_MEMORY_SCOPE_AGENT);
    __syncthreads();
    return *slot;
}
template <int KIND> __device__ __forceinline__ void run_phase(const Frame& F0, int li, int second) {
    Frame F;
    { int t = threadIdx.x; asm volatile("" : "+v"(t)); F.tid = t; F.lane = t & 63; F.wave = __builtin_amdgcn_readfirstlane(t >> 6);
      int g = F0.G, b = F0.bid; asm volatile("" : "+s"(g), "+s"(b)); F.G = g; F.bid = b;
      __attribute__((address_space(1))) unsigned char* w = (__attribute__((address_space(1))) unsigned char*)F0.ws; __attribute__((address_space(1))) float* o = (__attribute__((address_space(1))) float*)F0.out;
      asm volatile("" : "+s"(w), "+s"(o)); F.ws = (unsigned char*)w; F.out = (float*)o;
      unsigned l = (unsigned)(size_t)F0.lds; asm volatile("" : "+s"(l)); F.lds = (LAS unsigned char*)(size_t)l;
      asm volatile("" : "+s"(li), "+s"(second)); }
    float* modv = (float*)(F.ws + WS_MOD);
    bf16* XB = (bf16*)(F.ws + WS_XB);
    bf16* H = (bf16*)(F.ws + WS_H); bf16* ACT = (bf16*)(F.ws + WS_ACT); bf16* O = (bf16*)(F.ws + WS_O);
    const float* ng = inp(I_NORMG) + (size_t)li * 6 * DM; const float* mv = modv + (size_t)li * 3 * 9216;
    const bool last = li == 1;
    if constexpr (KIND == 100) { convert_weights(F, 0); mod_gemv(F); rope_tables(F); lora_transposes(F); fourier_tables(F); }
    if constexpr (KIND == 101) { EArgs A{}; A.xl_src = inp(I_X); A.xc_src = inp(I_CTX); A.o = nullptr; A.hdst = H; A.modv_h = modv; A.shidx = 0; A.scidx = 1; A.gpre = inp(I_NORMG); A.nrows = TT; e_phase(F, A); }
    if constexpr (KIND == 0) {
        const bf16* wi = (const bf16*)(F.ws + (second ? WS_WI2 : WS_WI1)); const bool withctx = !(last && second);
        if (!withctx || F.G != 256) { pg8::Gemm g{H, wi, withctx ? TT : TL, NWI, DM}; pg8::StaticOrder S; S.init(g.M, g.N, F.G, F.bid);
            pg8::EpiSwiglu E{ACT, FFNP}; pg8::gemm_phase<pg8::EpiSwiglu, pg8::StaticOrder, true, true>(F.lds, g, S, E, F.tid); }
        else { unsigned* cnt = (unsigned*)(F.ws + WS_CTL) + 8192 + 64 * (li * 2 + second);
            pg8::Gemm g{H, wi, TT, NWI, DM}; pg8::UpOrder S; S.init(NWI, F.G, F.bid, cnt);
            pg8::EpiSwiglu E{ACT, FFNP}; pg8::gemm_phase<pg8::EpiSwiglu, pg8::UpOrder, true, true>(F.lds, g, S, E, F.tid);
            if (F.bid >= 248) {
                if (F.tid == 0) { unsigned sp = 0; while (__hip_atomic_load(cnt, __ATOMIC_RELAXED, __HIP_MEMORY_SCOPE_AGENT) < 352u && ++sp < (1u << 24)) __builtin_amdgcn_s_sleep(8);
                    __builtin_amdgcn_fence(__ATOMIC_ACQUIRE, "agent"); asm volatile("s_waitcnt vmcnt(0)" ::: "memory"); }
                __syncthreads();
                const int k = F.bid - 248; pg8::Gemm g2{ACT, (const bf16*)(F.ws + (second ? WS_WO2 : WS_WO1)), TT, DM, FFNP}; pg8::OneUnit S2{64 + (k >> 2), k & 3};
                pg8::EpiBf16 E2{O, DM}; pg8::gemm_phase<pg8::EpiBf16, pg8::OneUnit, false, true>(F.lds, g2, S2, E2, F.tid); } } }
    if constexpr (KIND == 1) {
        const bool ctxhere = F.G != 256 && !(last && second);
        pg8::Gemm g{ACT, (const bf16*)(F.ws + (second ? WS_WO2 : WS_WO1)), ctxhere ? TT : TL, DM, FFNP}; pg8::StaticOrder S; S.init(g.M, g.N, F.G, F.bid);
        pg8::EpiBf16 E{O, DM}; pg8::gemm_phase<pg8::EpiBf16, pg8::StaticOrder, true, true>(F.lds, g, S, E, F.tid); }
    if constexpr (KIND == 2) {
        EArgs A{}; A.xl_src = inp(I_X); A.xc_src = inp(I_CTX); A.xb_src = li == 0 ? (const bf16*)nullptr : XB; A.xb_dst = XB; A.o = O; A.modv_g = mv; A.gidx = 2; A.gmul = 0.5f; A.gpost = ng + 1 * DM;
        A.hdst = H; A.modv_h = mv; A.shidx = 3; A.scidx = 4; A.gpre = ng + 2 * DM; A.nrows = TT; e_phase(F, A); }
    if constexpr (KIND == 3) {
        pg8::Gemm g{H, (const bf16*)(F.ws + WS_WIN), TT, INWP, DM}; pg8::StaticOrder S; S.init(g.M, g.N, F.G, F.bid);
        pg8::EpiBf16 E{ACT, INWP}; pg8::gemm_phase<pg8::EpiBf16, pg8::StaticOrder, true, true>(F.lds, g, S, E, F.tid); }
    if constexpr (KIND == 4) {
        { T0(t40_); lora_pass(F, li); TACC(F, 40, t40_); }
        { T0(t41_); for (int u = F.bid; u < 256; u += F.G) fourier_a_fast(F, u); TACC(F, 41, t41_); }
        { T0(t42_); if (li == 0) fourier_ctx1_all(F); TACC(F, 42, t42_); } }
    if constexpr (KIND == 5) {
        unsigned* cnt = (unsigned*)(F.ws + WS_CTL) + 8192 + 64 * (4 + 2 * li);
        const int na = li == 0 ? 264 : 256;
        { T0(t50_); for (int it = queue_next(F, cnt); it < na; it = queue_next(F, cnt)) attn_unit(F, li, it); TACC(F, 50, t50_); }
        { T0(t51_); for (int it = queue_next(F, cnt + 16); it < 12 * (NSC - 1); it = queue_next(F, cnt + 16)) rwkv_pass1_pair(F, li, it); TACC(F, 51, t51_); } }
    if constexpr (KIND == 11) {
        if (F.bid < 96) { T0(tp_); const int xcd = F.bid & 7, slot = F.bid >> 3; rwkv_pass2_part(F, (slot >> 2) * 8 + xcd, slot & 3); TACC(F, 30, tp_); }
        else { T0(tq_); convert_weights(F, 1, li == 0 ? 1 : 2, 96, F.G - 96);
            TACC(F, 31, tq_); T0(tr_);
            if (li == 0) fourier_ctx2_all(F, 96); TACC(F, 32, tr_); } }
    if constexpr (KIND == 12) {
        unsigned* cnt = (unsigned*)(F.ws + WS_CTL) + 8192 + 64 * (5 + 2 * li);
        const int np3 = li == 0 ? 12 * NSC : 12 * 64;
        { T0(t60_); for (int it = queue_next(F, cnt); it < np3; it = queue_next(F, cnt)) rwkv_pass3_unit(F, li, li == 0 ? it : (it / 64) * NSC + 2 + it % 64); TACC(F, 60, t60_); }
        { T0(t61_); for (int it = queue_next(F, cnt + 16); it < 512; it = queue_next(F, cnt + 16)) fourier_c_fast(F, it); TACC(F, 61, t61_); } }
    if constexpr (KIND == 6) {
        pg8::Gemm g{H, (const bf16*)(F.ws + WS_WOUT), last ? TL : TT, DM, DM}; pg8::StaticOrder S; S.init(g.M, g.N, F.G, F.bid);
        pg8::EpiBf16 E{O, DM}; pg8::gemm_phase<pg8::EpiBf16, pg8::StaticOrder, true, true>(F.lds, g, S, E, F.tid); }
    if constexpr (KIND == 7) {
        EArgs A{}; A.xb_src = XB; A.xb_dst = XB; A.o = O; A.modv_g = mv; A.gidx = 5; A.gmul = 1.0f; A.gpost = ng + 3 * DM;
        A.hdst = H; A.modv_h = mv; A.shidx = 6; A.scidx = 7; A.gpre = ng + 4 * DM; A.nrows = last ? TL : TT; e_phase(F, A); }
    if constexpr (KIND == 10) {
        EArgs A{}; A.xb_src = XB; A.xb_dst = XB; A.out32 = last ? F.out : (float*)nullptr; A.o = O; A.modv_g = mv; A.gidx = 8; A.gmul = 0.5f; A.gpost = ng + 5 * DM;
        if (!last) { A.hdst = H; A.modv_h = mv + 3 * 9216; A.shidx = 0; A.scidx = 1; A.gpre = ng + 6 * DM; }
        A.nrows = last ? TL : TT; e_phase(F, A);
        }
}
__global__ void __launch_bounds__(NTHR, 2) mega_one(Args args) {
    extern __shared__ __attribute__((aligned(16))) unsigned char lds[];
    Frame F; F.lds = (LAS unsigned char*)lds; F.tid = threadIdx.x; F.lane = F.tid & 63; F.wave = __builtin_amdgcn_readfirstlane(F.tid >> 6); F.G = gridDim.x; F.bid = blockIdx.x;
    F.out = args.out; F.ws = args.ws;
    volatile LAS unsigned* MISC = (volatile LAS unsigned*)(F.lds + MISC_OFF);
    if (F.tid < 32) MISC[F.tid] = 0u;
    __syncthreads();
    XcdBarrier bar = xcd_barrier_post((unsigned*)(F.ws + WS_CTL) + 4096, MISC + 8);
#define GRID_BAR() xcd_barrier(bar)
#define PH(K, li, sec) { T0(t_); run_phase<K>(F, li, sec); TACC(F, 100 + K + 20 * sec, t_); T0(u_); GRID_BAR(); TACC(F, 300 + K + 20 * sec, u_); }
    PH(100, 0, 0)
    PH(101, 0, 0)
#pragma unroll 1
    for (int li = 0; li < 2; ++li) {
        PH(0, li, 0)
        PH(1, li, 0)
        PH(2, li, 0)
        PH(3, li, 0)
        PH(4, li, 0)
        PH(5, li, 0)
        PH(11, li, 0)
        PH(12, li, 0)
        PH(6, li, 0)
        PH(7, li, 0)
        PH(0, li, 1)
        PH(1, li, 1)
        PH(10, li, 0)
    }
#if TPROBE >= 0
    if (F.tid == 0) { atomicAdd((unsigned*)(F.ws + WS_CTL) + 12288, MISC[24]); atomicAdd((unsigned*)(F.ws + WS_CTL) + 12289, MISC[25]); }
    GRID_BAR();
    if (F.bid == 0) { const unsigned t1 = __hip_atomic_load((unsigned*)(F.ws + WS_CTL) + 12288, __ATOMIC_RELAXED, __HIP_MEMORY_SCOPE_AGENT), t2 = __hip_atomic_load((unsigned*)(F.ws + WS_CTL) + 12289, __ATOMIC_RELAXED, __HIP_MEMORY_SCOPE_AGENT);
        const float v1 = (float)t1 * (1.0f / 25600.0f), v2 = TPROBE2 >= 0 ? (float)t2 * (1.0f / 25600.0f) : 100.0f;
        if (F.tid == 0) F.out[0] += v1 * (1.0f / TSCALE);
        (void)v2; }
#endif
}

extern "C" void kernel_launch(void* const* d_in, const int* in_sizes, int n_in, void* d_out, int out_size, void* d_ws, size_t ws_size, hipStream_t stream) {
    static int ready = 0;
    if (!ready) {
        if (n_in != 25 || out_size != TL * DM || ws_size < WS_END) { fprintf(stderr, "kernel_launch: unexpected shapes (n_in %d out %d ws %zu)\n", n_in, out_size, ws_size); ready = -1; return; }
        if (hipFuncSetAttribute((const void*)mega_one, hipFuncAttributeMaxDynamicSharedMemorySize, LDS_BYTES) != hipSuccess) { fprintf(stderr, "kernel_launch: hipFuncSetAttribute failed\n"); ready = -1; return; }
        int dev = 0, cus = 0; if (hipGetDevice(&dev) != hipSuccess || hipDeviceGetAttribute(&cus, hipDeviceAttributeMultiprocessorCount, dev) != hipSuccess || cus < 32) cus = 256;
        ready = cus < 256 ? cus : 256;
    }
    if (ready < 0) return;
    if (hipMemsetAsync((char*)d_ws + WS_CTL, 0, 65536, stream) != hipSuccess) { fprintf(stderr, "kernel_launch: memset failed\n"); return; }
    Args a{};
    for (int i = 0; i < 25; ++i) a.in[i] = (const float*)d_in[i];
    a.out = (float*)d_out; a.ws = (unsigned char*)d_ws;
    hipLaunchKernelGGL(mega_one, dim3(ready), dim3(NTHR), LDS_BYTES, stream, a);
}
```

```cpp
#include <hip/hip_runtime.h>
#include <cstdio>
#include <cstdint>

namespace pg8 {
#define PG8_LAS __attribute__((address_space(3)))
typedef unsigned short bf16_t;
typedef short bf16x8 __attribute__((ext_vector_type(8)));
typedef float f32x4 __attribute__((ext_vector_type(4)));
typedef unsigned u32x4 __attribute__((ext_vector_type(4)));
constexpr int BM = 256, BK = 64, HALF = 128, HTB = HALF * BK * 2, STAGE_BYTES = 8 * HTB, NXCD = 8, WGM = 8;

__host__ __device__ __forceinline__ int lds_byte(int r, int c) { const int st = (r >> 4) * 2 + (c >> 5), rr = r & 15, cc = c & 31, ob = rr * 64 + cc * 2; return st * 1024 + (ob ^ (((ob >> 9) & 1) << 5)); }
__host__ __device__ __forceinline__ void stage_rc(int b, int& R, int& C) { const int st = b / 1024, sb = b % 1024, swz = sb ^ (((sb >> 9) & 1) << 5); R = (st >> 1) * 16 + swz / 64; C = (st & 1) * 32 + (swz % 64) / 2; }
__host__ __device__ __forceinline__ int perm32(int rho) { const int n = rho >> 4, i = rho & 15; return 8 * (i >> 2) + 4 * n + (i & 3); }

struct Unit { int pm, pn; };
struct Gemm { const bf16_t* A; const bf16_t* Bt; int M, N, K; };

struct StaticOrder {
    int nM, nN, nwg, G, c;
    __host__ __device__ void init(int M, int N, int G_, int c_) { nM = M / BM; nN = N / BM; nwg = nM * nN; G = G_; c = c_; }
    __host__ __device__ bool next(int i, Unit& u) const {
        const long L = (long)i * G + c; if (L >= nwg) return false;
        int wgid = (int)L; { const int q = nwg / NXCD, r = nwg % NXCD, xcd = wgid % NXCD, off = wgid / NXCD; wgid = (xcd < r ? xcd * (q + 1) : r * (q + 1) + (xcd - r) * q) + off; }
        const int nig = WGM * nN, gid = wgid / nig, fm = gid * WGM, gsz = (nM - fm) < WGM ? (nM - fm) : WGM;
        u.pm = fm + ((wgid % nig) % gsz); u.pn = (wgid % nig) / gsz; return true;
    }
    __device__ __forceinline__ void a_ready(const Unit&) const {}
    __device__ __forceinline__ void done(const Unit&) const {}
};

struct UpOrder {
    StaticOrder lat; int G, c, nN; unsigned* cnt;
    __device__ void init(int N, int G_, int c_, unsigned* cnt_) { lat.init(16384, N, G_, c_); G = G_; c = c_; nN = N / BM; cnt = cnt_; }
    __device__ bool next(int i, Unit& u) const {
        const int nctx = 2 * nN, total = nctx + lat.nwg;
        long L;
        if (G != 256) L = (long)i * G + c;
        else if (c >= 248) { if (i >= 3) return false; L = (long)i * G + c; }
        else if (c >= 172 && c < 188 && i == 5) L = (long)(3 + (c - 172) / 8) * G + 248 + (c - 172) % 8;
        else L = (long)i * G + c;
        if (L >= total) return false;
        if (L < nctx) { u.pm = 64 + (int)L / nN; u.pn = (int)L % nN; return true; }
        int wgid = (int)L - nctx; { const int nwg = lat.nwg, q = nwg / NXCD, r = nwg % NXCD, xcd = wgid % NXCD, off = wgid / NXCD; wgid = (xcd < r ? xcd * (q + 1) : r * (q + 1) + (xcd - r) * q) + off; }
        const int nig = WGM * nN, gid = wgid / nig, fm = gid * WGM, gsz = (lat.nM - fm) < WGM ? (lat.nM - fm) : WGM;
        u.pm = fm + ((wgid % nig) % gsz); u.pn = (wgid % nig) / gsz; return true;
    }
    __device__ __forceinline__ void a_ready(const Unit&) const {}
    __device__ __forceinline__ void done(const Unit& u) const {
        if (u.pm >= 64) { asm volatile("s_waitcnt vmcnt(0)" ::: "memory"); __builtin_amdgcn_fence(__ATOMIC_RELEASE, "agent"); asm volatile("s_waitcnt vmcnt(0)" ::: "memory");
            if ((threadIdx.x & 63) == 0) __hip_atomic_fetch_add(cnt, 1u, __ATOMIC_RELAXED, __HIP_MEMORY_SCOPE_AGENT); }
    }
};
struct OneUnit {
    int pm, pn;
    __device__ bool next(int i, Unit& u) const { if (i != 0) return false; u.pm = pm; u.pn = pn; return true; }
    __device__ __forceinline__ void a_ready(const Unit&) const {}
    __device__ __forceinline__ void done(const Unit&) const {}
};

__device__ __forceinline__ unsigned cvt_pk_bf16(float lo, float hi) { unsigned r; asm volatile("v_cvt_pk_bf16_f32 %0, %1, %2" : "=v"(r) : "v"(lo), "v"(hi)); return r; }

struct EpiBf16 {
    static constexpr bool PERM = true, AFTER_DRAIN = false;
    bf16_t* O; int ldc;
    __device__ __forceinline__ void operator()(const f32x4 (&acc)[2][2][4][2], const Unit& u, int wr, int wc, int fr, int fq) const {
        const int row0 = u.pm * BM + wr * 64 + fr; const int col0 = u.pn * BM + wc * 32 + 8 * fq;
#pragma unroll
        for (int ai = 0; ai < 2; ++ai)
#pragma unroll
            for (int m = 0; m < 4; ++m) { bf16_t* rowp = O + (size_t)(row0 + ai * HALF + m * 16) * ldc + col0;
#pragma unroll
                for (int bj = 0; bj < 2; ++bj) { const f32x4 v0 = acc[ai][bj][m][0], v1 = acc[ai][bj][m][1];
                    u32x4 w; w.x = cvt_pk_bf16(v0[0], v0[1]); w.y = cvt_pk_bf16(v0[2], v0[3]); w.z = cvt_pk_bf16(v1[0], v1[1]); w.w = cvt_pk_bf16(v1[2], v1[3]);
                    *(u32x4*)(rowp + bj * HALF) = w; } }
    }
};
struct EpiF32 {
    static constexpr bool PERM = true, AFTER_DRAIN = false;
    float* O; int ldc;
    __device__ __forceinline__ void operator()(const f32x4 (&acc)[2][2][4][2], const Unit& u, int wr, int wc, int fr, int fq) const {
        const int row0 = u.pm * BM + wr * 64 + fr; const int col0 = u.pn * BM + wc * 32 + 8 * fq;
#pragma unroll
        for (int ai = 0; ai < 2; ++ai)
#pragma unroll
            for (int m = 0; m < 4; ++m) { float* rowp = O + (size_t)(row0 + ai * HALF + m * 16) * ldc + col0;
#pragma unroll
                for (int bj = 0; bj < 2; ++bj) { *(f32x4*)(rowp + bj * HALF) = acc[ai][bj][m][0]; *(f32x4*)(rowp + bj * HALF + 4) = acc[ai][bj][m][1]; } }
    }
};
__device__ __forceinline__ float silu_f(float x) { return x * __builtin_amdgcn_rcpf(1.0f + __expf(-x)); }
struct EpiSwiglu {
    static constexpr bool PERM = true, AFTER_DRAIN = false;
    bf16_t* O; int ldc;
    __device__ __forceinline__ void operator()(const f32x4 (&acc)[2][2][4][2], const Unit& u, int wr, int wc, int fr, int fq) const {
        const int row0 = u.pm * BM + wr * 64 + fr; const int col0 = u.pn * HALF + wc * 32 + 8 * fq;
#pragma unroll
        for (int ai = 0; ai < 2; ++ai)
#pragma unroll
            for (int m = 0; m < 4; ++m) { bf16_t* rowp = O + (size_t)(row0 + ai * HALF + m * 16) * ldc + col0;
                const f32x4 g0 = acc[ai][0][m][0], g1 = acc[ai][0][m][1], u0 = acc[ai][1][m][0], u1 = acc[ai][1][m][1];
                u32x4 w; w.x = cvt_pk_bf16(silu_f(g0[0]) * u0[0], silu_f(g0[1]) * u0[1]); w.y = cvt_pk_bf16(silu_f(g0[2]) * u0[2], silu_f(g0[3]) * u0[3]);
                w.z = cvt_pk_bf16(silu_f(g1[0]) * u1[0], silu_f(g1[1]) * u1[1]); w.w = cvt_pk_bf16(silu_f(g1[2]) * u1[2], silu_f(g1[3]) * u1[3]);
                *(u32x4*)rowp = w; }
    }
};

template <class Epi, class Sched, bool ALIGN_EPI = false, bool SP2 = false>
__device__ __forceinline__ void gemm_phase(PG8_LAS unsigned char* lds, const Gemm g, const Sched& S, const Epi& E, const int tid) {
    const int wid = __builtin_amdgcn_readfirstlane(tid >> 6), lane = tid & 63, wr = wid >> 2, wc = wid & 3, fr = lane & 15, fq = lane >> 4;
    const int K = g.K, nt = K / BK;
    unsigned voffA[2], voffB[2];
#pragma unroll
    for (int i = 0; i < 2; ++i) { int R, C; stage_rc(tid * 16 + i * 8192, R, C); const int Rb = Epi::PERM ? ((R & ~31) + perm32(R & 31)) : R;
        voffA[i] = (unsigned)(R * K + C) * 2u; voffB[i] = (unsigned)(Rb * K + C) * 2u; }
    const size_t kstep = (size_t)(BK * 2);
    const size_t hstep = (size_t)HALF * K * 2;
    const size_t tstep = 2 * hstep;
    const unsigned ldsw = (unsigned)wid * 1024u;
    const int aoff = lds_byte(wr * 64 + fr, fq * 8), boff = lds_byte(wc * 32 + fr, fq * 8);
#define PG8_SA(b, h) (((b) * 2 + (h)) * HTB)
#define PG8_SB(b, h) ((4 + (b) * 2 + (h)) * HTB)
#define PG8_STAGE(bufoff, gbase, voff) do { _Pragma("unroll") for (int _i = 0; _i < 2; ++_i) \
        __builtin_amdgcn_global_load_lds((const unsigned*)((const char*)(gbase) + (voff)[_i]), (PG8_LAS unsigned*)(lds + (bufoff) + ldsw + _i * 8192), 16, 0, 0); } while (0)
#define PG8_LDA(dst, b, h) do { _Pragma("unroll") for (int m = 0; m < 4; ++m) _Pragma("unroll") for (int k = 0; k < 2; ++k) dst[m][k] = *(const PG8_LAS bf16x8*)(lds + PG8_SA(b, h) + aoff + m * 2048 + k * 1024); } while (0)
#define PG8_LDB(dst, b, h) do { _Pragma("unroll") for (int n = 0; n < 2; ++n) _Pragma("unroll") for (int k = 0; k < 2; ++k) dst[n][k] = *(const PG8_LAS bf16x8*)(lds + PG8_SB(b, h) + boff + n * 2048 + k * 1024); } while (0)
#define PG8_MMA(ai, bj, At, Bt) do { __builtin_amdgcn_s_setprio(1); _Pragma("unroll") for (int m = 0; m < 4; ++m) _Pragma("unroll") for (int n = 0; n < 2; ++n) _Pragma("unroll") for (int k = 0; k < 2; ++k) \
        acc[ai][bj][m][n] = __builtin_amdgcn_mfma_f32_16x16x32_bf16(Bt[n][k], At[m][k], acc[ai][bj][m][n], 0, 0, 0); __builtin_amdgcn_s_setprio(0); } while (0)
#define PG8_WAIT_V(n) asm volatile("s_waitcnt vmcnt(" #n ")" ::: "memory")
#define PG8_WAIT_L(n) asm volatile("s_waitcnt lgkmcnt(" #n ")" ::: "memory")
#define PG8_BAR __builtin_amdgcn_s_barrier()
#define PG8_SCHED __builtin_amdgcn_sched_barrier(0)
    Unit cur, nxt; int ui = 0;
    if (!S.next(0, cur)) return;
    f32x4 acc[2][2][4][2];
#pragma unroll
    for (int a = 0; a < 2; ++a)
#pragma unroll
        for (int b = 0; b < 2; ++b)
#pragma unroll
            for (int m = 0; m < 4; ++m)
#pragma unroll
                for (int n = 0; n < 2; ++n) acc[a][b][m][n] = (f32x4){0.f, 0.f, 0.f, 0.f};
    bf16x8 At[4][2], B0[2][2], B1[2][2];
    const char* cA = (const char*)g.A + (size_t)cur.pm * tstep; const char* cB = (const char*)g.Bt + (size_t)cur.pn * tstep;
    S.a_ready(cur);
    if constexpr (SP2) {
        PG8_STAGE(PG8_SB(0, 0), cB, voffB); PG8_STAGE(PG8_SB(0, 1), cB + hstep, voffB); PG8_STAGE(PG8_SA(0, 0), cA, voffA); PG8_STAGE(PG8_SA(0, 1), cA + hstep, voffA);
        if (wr == 1) PG8_BAR;
        PG8_WAIT_V(2); PG8_BAR;
        PG8_STAGE(PG8_SB(1, 0), cB + kstep, voffB); PG8_STAGE(PG8_SA(1, 0), cA + kstep, voffA); PG8_STAGE(PG8_SB(1, 1), cB + hstep + kstep, voffB);
        PG8_WAIT_V(6); PG8_BAR;
    } else {
        PG8_STAGE(PG8_SB(0, 0), cB, voffB); PG8_STAGE(PG8_SA(0, 0), cA, voffA); PG8_STAGE(PG8_SB(0, 1), cB + hstep, voffB); PG8_STAGE(PG8_SA(0, 1), cA + hstep, voffA);
        if (wr == 1) PG8_BAR;
        PG8_WAIT_V(4); PG8_BAR;
        PG8_STAGE(PG8_SB(1, 0), cB + kstep, voffB); PG8_STAGE(PG8_SA(1, 0), cA + kstep, voffA); PG8_STAGE(PG8_SB(1, 1), cB + hstep + kstep, voffB);
        PG8_WAIT_V(6); PG8_BAR;
    }
    for (;;) {
        const bool has_next = S.next(ui + 1, nxt);
        const char* nA = has_next ? (const char*)g.A + (size_t)nxt.pm * tstep : cA; const char* nB = has_next ? (const char*)g.Bt + (size_t)nxt.pn * tstep : cB;
        for (int t = 0; t < nt; t += 2) {
            const bool last = (t == nt - 2);
            const char* a1 = cA + (size_t)(t + 1) * kstep;
            const char* a2 = last ? nA : cA + (size_t)(t + 2) * kstep; const char* b2 = last ? nB : cB + (size_t)(t + 2) * kstep;
            const char* a3 = a2 + kstep; const char* b3 = b2 + kstep;
            if (last && has_next) S.a_ready(nxt);
            if constexpr (SP2) {
            PG8_LDB(B0, 0, 0); PG8_LDB(B1, 0, 1); PG8_SCHED; PG8_LDA(At, 0, 0); PG8_STAGE(PG8_SA(1, 1), a1 + hstep, voffA);
            PG8_WAIT_V(8); PG8_WAIT_L(0); PG8_BAR; PG8_MMA(0, 0, At, B0); PG8_MMA(0, 1, At, B1); PG8_BAR; PG8_SCHED;
            PG8_LDA(At, 0, 1); PG8_STAGE(PG8_SB(0, 0), b2, voffB); PG8_STAGE(PG8_SB(0, 1), b2 + hstep, voffB); PG8_STAGE(PG8_SA(0, 0), a2, voffA);
            PG8_WAIT_V(8); PG8_WAIT_L(0); PG8_BAR; PG8_MMA(1, 0, At, B0); PG8_MMA(1, 1, At, B1); PG8_BAR; PG8_SCHED;
            PG8_LDB(B0, 1, 0); PG8_LDB(B1, 1, 1); PG8_SCHED; PG8_LDA(At, 1, 0); PG8_STAGE(PG8_SA(0, 1), a2 + hstep, voffA);
            PG8_WAIT_V(8); PG8_WAIT_L(0); PG8_BAR; PG8_MMA(0, 0, At, B0); PG8_MMA(0, 1, At, B1); PG8_BAR; PG8_SCHED;
            PG8_LDA(At, 1, 1); PG8_STAGE(PG8_SB(1, 0), b3, voffB); PG8_STAGE(PG8_SB(1, 1), b3 + hstep, voffB); PG8_STAGE(PG8_SA(1, 0), a3, voffA);
            PG8_WAIT_V(8); PG8_WAIT_L(0); PG8_BAR; PG8_MMA(1, 0, At, B0); PG8_MMA(1, 1, At, B1); PG8_BAR; PG8_SCHED;
            } else {
            PG8_LDB(B0, 0, 0); PG8_SCHED; PG8_LDA(At, 0, 0); PG8_STAGE(PG8_SA(1, 1), a1 + hstep, voffA);
            PG8_WAIT_L(8); PG8_BAR; PG8_WAIT_L(0); PG8_MMA(0, 0, At, B0); PG8_BAR; PG8_SCHED;
            PG8_LDB(B1, 0, 1); PG8_STAGE(PG8_SB(0, 0), b2, voffB);
            PG8_BAR; PG8_WAIT_L(0); PG8_MMA(0, 1, At, B1); PG8_BAR;
            PG8_LDA(At, 0, 1); PG8_STAGE(PG8_SA(0, 0), a2, voffA);
            PG8_BAR; PG8_WAIT_L(0); PG8_MMA(1, 0, At, B0); PG8_BAR; PG8_SCHED;
            PG8_STAGE(PG8_SB(0, 1), b2 + hstep, voffB);
            PG8_WAIT_V(6); PG8_BAR; PG8_MMA(1, 1, At, B1); PG8_BAR;
            PG8_LDB(B0, 1, 0); PG8_SCHED; PG8_LDA(At, 1, 0); PG8_STAGE(PG8_SA(0, 1), a2 + hstep, voffA);
            PG8_WAIT_L(8); PG8_BAR; PG8_WAIT_L(0); PG8_MMA(0, 0, At, B0); PG8_BAR; PG8_SCHED;
            PG8_LDB(B1, 1, 1); PG8_STAGE(PG8_SB(1, 0), b3, voffB);
            PG8_BAR; PG8_WAIT_L(0); PG8_MMA(0, 1, At, B1); PG8_BAR;
            PG8_LDA(At, 1, 1); PG8_STAGE(PG8_SA(1, 0), a3, voffA);
            PG8_BAR; PG8_WAIT_L(0); PG8_MMA(1, 0, At, B0); PG8_BAR; PG8_SCHED;
            PG8_STAGE(PG8_SB(1, 1), b3 + hstep, voffB);
            PG8_WAIT_V(6); PG8_BAR; PG8_MMA(1, 1, At, B1); PG8_BAR;
            }
        }
        if constexpr (ALIGN_EPI) { if (wr == 0) PG8_BAR; }
        if constexpr (!Epi::AFTER_DRAIN) { E(acc, cur, wr, wc, fr, fq); S.done(cur); }
        if (!has_next) break;
#pragma unroll
        for (int a = 0; a < 2; ++a)
#pragma unroll
            for (int b = 0; b < 2; ++b)
#pragma unroll
                for (int m = 0; m < 4; ++m)
#pragma unroll
                    for (int n = 0; n < 2; ++n) acc[a][b][m][n] = (f32x4){0.f, 0.f, 0.f, 0.f};
        cur = nxt; cA = nA; cB = nB; ++ui;
        if constexpr (ALIGN_EPI) { if (wr == 1) PG8_BAR; }
    }
    PG8_WAIT_V(0);
    if constexpr (!ALIGN_EPI) { if (wr == 0) PG8_BAR; }
    PG8_BAR;
#undef PG8_SA
#undef PG8_SB
#undef PG8_STAGE
#undef PG8_LDA
#undef PG8_LDB
#undef PG8_MMA
#undef PG8_WAIT_V
#undef PG8_WAIT_L
#undef PG8_BAR
#undef PG8_SCHED
}
}

constexpr int NWAVES = 8, NTHR = 512;
constexpr int DM = 1024, SEQ = 8192, NB = 2, CTX = 256, TL = NB * SEQ, TC = NB * CTX, TT = TL + TC;
constexpr int FFN = 2752, FFNP = 2816, NWI = 5632, INW = 2432, INWP = 2560, NMOD = 9;
constexpr int ZF = 0, ZQ = 256, ZK = 640, ZV = 768, ZRR = 896, ZRK = 1280, ZRV = 1664, ZW = 2048, ZA = 2176, ZG = 2304;
constexpr int RW = 384;
constexpr float NORM_EPS = 1e-6f, GN_EPS = 64e-5f;

constexpr size_t MiB = 1u << 20;
constexpr size_t WS_CTL = 0, WS_MOD = 1 * MiB, WS_ROPE = 2 * MiB, WS_XC = 4 * MiB, WS_GC = 6 * MiB;
constexpr size_t WS_WI1 = 8 * MiB, WS_WO1 = 19 * MiB, WS_WIN = 25 * MiB, WS_WOUT = 30 * MiB, WS_WI2 = 32 * MiB, WS_WO2 = 43 * MiB;
constexpr size_t WS_H = 49 * MiB;
constexpr size_t WS_ACT = 82 * MiB;
constexpr size_t WS_O = 173 * MiB;
constexpr size_t WS_W2T = WS_MOD + 256 * 1024, WS_A2T = WS_MOD + 512 * 1024, WS_G2T = WS_MOD + 768 * 1024;
constexpr size_t WS_LW = WS_O, WS_IC = WS_O + 25 * MiB;
constexpr size_t WS_GATE = WS_O + 50 * MiB;
constexpr size_t WS_GAM32 = 165 * MiB;
constexpr size_t WS_XB = 239 * MiB;
constexpr size_t OUT_FA = 0;
constexpr size_t OUT_SUM = 16 * MiB;
constexpr size_t WS_END = 272 * MiB;

constexpr size_t WS_FT = 7 * MiB;
constexpr size_t FT_W64C = 0, FT_W64S = 8192, FT_W128C = 16384, FT_W128S = 49152, FT_T64C = 81920, FT_T64S = 90112;
constexpr int LDS_BYTES = 147456;
constexpr int MISC_OFF = 146432;
#define TPROBE -1
#define TPROBE2 -1
#define TSCALE 64.0f
#if TPROBE >= 0
#define T0(v) const unsigned long long v = __builtin_amdgcn_s_memrealtime()
#define TACC(F, id, v) do { if (((id) == TPROBE || (id) == TPROBE2) && (F).tid == 0) { volatile LAS unsigned* _m = (volatile LAS unsigned*)((F).lds + MISC_OFF); _m[(id) == TPROBE ? 24 : 25] += (unsigned)(__builtin_amdgcn_s_memrealtime() - (v)); } } while (0)
#else
#define T0(v)
#define TACC(F, id, v)
#endif

typedef unsigned short bf16;
typedef float f32x4 __attribute__((ext_vector_type(4)));
typedef unsigned v4u __attribute__((ext_vector_type(4)));
typedef unsigned v2u __attribute__((ext_vector_type(2)));
#define LAS __attribute__((address_space(3)))
#define LDS_WAIT() asm volatile("s_waitcnt lgkmcnt(0)" ::: "memory")

__device__ __forceinline__ unsigned f2bf(float f) { unsigned u = __builtin_bit_cast(unsigned, f); return (u + 0x7fffu + ((u >> 16) & 1u)) >> 16; }
__device__ __forceinline__ unsigned pk2(float lo, float hi) { return f2bf(lo) | (f2bf(hi) << 16); }
__device__ __forceinline__ float bf2f(unsigned short u) { return __builtin_bit_cast(float, (unsigned)u << 16); }
__device__ __forceinline__ float bflo(unsigned u) { return __builtin_bit_cast(float, u << 16); }
__device__ __forceinline__ float bfhi(unsigned u) { return __builtin_bit_cast(float, u & 0xffff0000u); }
__device__ __forceinline__ void unpack8(const v4u w, float (&f)[8]) { f[0] = bflo(w.x); f[1] = bfhi(w.x); f[2] = bflo(w.y); f[3] = bfhi(w.y); f[4] = bflo(w.z); f[5] = bfhi(w.z); f[6] = bflo(w.w); f[7] = bfhi(w.w); }
template <int CTRL> __device__ __forceinline__ float dppx(float v) { return __builtin_bit_cast(float, __builtin_amdgcn_update_dpp(0, __builtin_bit_cast(int, v), CTRL, 0xf, 0xf, true)); }
__device__ __forceinline__ float sum8(float v) { v += dppx<0xB1>(v); v += dppx<0x4E>(v); v += dppx<0x141>(v); return v; }
__device__ __forceinline__ float sum16(float v) { v = sum8(v); v += dppx<0x140>(v); return v; }
__device__ __forceinline__ float xrow_sum(float v) {
    float a = v, b2 = v; asm volatile("s_nop 1\n\tv_permlane16_swap_b32 %0, %1" : "+v"(a), "+v"(b2)); v = a + b2;
    a = v; b2 = v; asm volatile("s_nop 1\n\tv_permlane32_swap_b32 %0, %1" : "+v"(a), "+v"(b2)); return a + b2; }
__device__ __forceinline__ float xrow_max(float v) {
    float a = v, b2 = v; asm volatile("s_nop 1\n\tv_permlane16_swap_b32 %0, %1" : "+v"(a), "+v"(b2)); v = fmaxf(a, b2);
    a = v; b2 = v; asm volatile("s_nop 1\n\tv_permlane32_swap_b32 %0, %1" : "+v"(a), "+v"(b2)); return fmaxf(a, b2); }
__device__ __forceinline__ float wave_sum(float v) { return xrow_sum(sum16(v)); }
__device__ __forceinline__ float wave_max(float v) {
#pragma unroll
    for (int o = 1; o < 64; o <<= 1) v = fmaxf(v, __shfl_xor(v, o));
    return v;
}

struct Args { const float* in[25]; float* out; unsigned char* ws; int ph_lo, ph_hi; };

struct Frame {
    LAS unsigned char* lds;
    int tid, lane, wave, G, bid;
    float* out; unsigned char* ws;
};
enum { I_X = 0, I_C, I_CTX, I_CCTX, I_MODW, I_MODB, I_NORMG, I_F1WI, I_F1WO, I_WIN, I_WOUT, I_SINK, I_CONV, I_W0, I_W2, I_A0, I_A2, I_G2, I_KK, I_KA, I_RK, I_LNG, I_LNB, I_F2WI, I_F2WO };

__device__ __forceinline__ const float* inp(int i) {
    const __attribute__((address_space(4))) char* p = (const __attribute__((address_space(4))) char*)__builtin_amdgcn_kernarg_segment_ptr();
    asm volatile("" : "+s"(p));
    return (const float*)*(const __attribute__((address_space(1))) float* const __attribute__((address_space(4)))*)(p + 8 * i);
}
struct CvtDesc { const float* W; bf16* WT; int ldw, k0, sc, Kd, n0d; bool valid, live; };
__device__ __forceinline__ void cvt_load(const CvtDesc& d, f32x4 (&v)[8], int lane) {
    const int c4 = lane & 7, r8 = lane >> 3;
#pragma unroll
    for (int i = 0; i < 8; ++i) v[i] = (d.live && d.valid) ? *(const f32x4*)(d.W + (size_t)(d.k0 + 8 * i + r8) * d.ldw + d.sc + 4 * c4) : (f32x4){0.f, 0.f, 0.f, 0.f};
}
__device__ __forceinline__ void cvt_finish(const CvtDesc& d, const f32x4 (&v)[8], LAS float* scr, int lane) {
    if (!d.live) return;
    const int c4 = lane & 7, r8 = lane >> 3;
#pragma unroll
    for (int i = 0; i < 8; ++i) *(LAS f32x4*)(scr + (8 * i + r8) * 36 + 4 * c4) = v[i];
    LDS_WAIT(); asm volatile("" ::: "memory");
    const int c = lane & 7;
#pragma unroll
    for (int j = 0; j < 4; ++j) { const int n = (lane >> 3) + 8 * j; const LAS float* s = scr + (8 * c) * 36 + n;
        v4u o; o.x = pk2(s[0 * 36], s[1 * 36]); o.y = pk2(s[2 * 36], s[3 * 36]); o.z = pk2(s[4 * 36], s[5 * 36]); o.w = pk2(s[6 * 36], s[7 * 36]);
        *(v4u*)(d.WT + (size_t)(d.n0d + n) * d.Kd + d.k0 + 8 * c) = o; }
    LDS_WAIT(); asm volatile("" ::: "memory");
}
__device__ __forceinline__ CvtDesc cvt_decode(Frame& F, int li, int set, int it) {
    constexpr int I_WI = 16 * (NWI / 32), I_WO = (FFNP / 64) * 32, I_IN = 16 * (INWP / 32), I_OUT = 16 * 32;
    constexpr int NITEMS = 2 * I_WI + 2 * I_WO + I_IN + I_OUT;
    CvtDesc d{}; d.live = it < NITEMS; if (!d.live) return d;
    int r = it;
    if (set) { const bool inA = r < I_WI || (r >= 2 * I_WI && r < 2 * I_WI + I_WO) || (r >= 2 * I_WI + 2 * I_WO && r < 2 * I_WI + 2 * I_WO + I_IN); if (inA != (set == 1)) { d.live = false; return d; } }
    if (r < 2 * I_WI) { const int f = r / I_WI; r -= f * I_WI; const int nblk = NWI / 32, kb = r / nblk, nb = r % nblk;
        const int n0 = 32 * nb, pn = n0 >> 8, i = n0 & 255; const int j = 128 * pn + (i & 127);
        d.W = (f ? inp(I_F2WI) : inp(I_F1WI)) + (size_t)li * DM * 2 * FFN; d.ldw = 2 * FFN; d.k0 = 64 * kb; d.sc = (i < 128) ? j : FFN + j; d.valid = j < FFN; d.WT = (bf16*)(F.ws + (f ? WS_WI2 : WS_WI1)); d.Kd = DM; d.n0d = n0; return d; }
    r -= 2 * I_WI;
    if (r < 2 * I_WO) { const int f = r / I_WO; r -= f * I_WO; const int kb = r / 32, nb = r % 32;
        d.W = (f ? inp(I_F2WO) : inp(I_F1WO)) + (size_t)li * FFN * DM; d.ldw = DM; d.k0 = 64 * kb; d.sc = 32 * nb; d.valid = 64 * kb < FFN; d.WT = (bf16*)(F.ws + (f ? WS_WO2 : WS_WO1)); d.Kd = FFNP; d.n0d = 32 * nb; return d; }
    r -= 2 * I_WO;
    if (r < I_IN) { const int nblk = INWP / 32, kb = r / nblk, nb = r % nblk;
        d.W = inp(I_WIN) + (size_t)li * DM * INW; d.ldw = INW; d.k0 = 64 * kb; d.sc = 32 * nb; d.valid = 32 * nb < INW; d.WT = (bf16*)(F.ws + WS_WIN); d.Kd = DM; d.n0d = 32 * nb; return d; }
    r -= I_IN;
    { const int kb = r / 32, nb = r % 32;
        d.W = inp(I_WOUT) + (size_t)li * DM * DM; d.ldw = DM; d.k0 = 64 * kb; d.sc = 32 * nb; d.valid = true; d.WT = (bf16*)(F.ws + WS_WOUT); d.Kd = DM; d.n0d = 32 * nb; return d; }
}
__device__ __forceinline__ void convert_weights(Frame& F, int li, int set = 0, int bid0 = 0, int nblk = 0) {
    if (nblk == 0) nblk = F.G;
    if (F.bid < bid0 || F.bid >= bid0 + nblk) return;
    LAS float* scr = (LAS float*)(F.lds + F.wave * 16384);
    const int gw = (F.bid - bid0) * NWAVES + F.wave, NGW = nblk * NWAVES;
    constexpr int NITEMS = 2 * 16 * (NWI / 32) + 2 * (FFNP / 64) * 32 + 16 * (INWP / 32) + 16 * 32;
    for (int it = gw; it < NITEMS; it += 2 * NGW) {
        const CvtDesc d0 = cvt_decode(F, li, set, it), d1 = cvt_decode(F, li, set, it + NGW);
        f32x4 v0[8], v1[8];
        cvt_load(d0, v0, F.lane); cvt_load(d1, v1, F.lane);
        cvt_finish(d0, v0, scr, F.lane); cvt_finish(d1, v1, scr, F.lane);
    }
}
__device__ __forceinline__ void mod_gemv(Frame& F) {
    LAS float* sc = (LAS float*)F.lds;
    LAS float* red = sc + 3 * 1024;
    __syncthreads();
    for (int i = F.tid; i < 3 * 1024; i += NTHR) { const int v = i >> 10, k = i & 1023; const float x = v < 2 ? inp(I_C)[v * 1024 + k] : inp(I_CCTX)[k]; sc[i] = x / (1.0f + __expf(-x)); }
    __syncthreads();
    float* modv = (float*)(F.ws + WS_MOD);
    for (int u = F.bid; u < 2 * 72; u += F.G) {
        const int l = u / 72, n0 = (u % 72) * 128;
        const float* w = inp(I_MODW) + (size_t)l * DM * 9216 + n0 + 2 * F.lane;
        float a0 = 0.f, a1 = 0.f, b0 = 0.f, b1 = 0.f, c0 = 0.f, c1 = 0.f;
        const int k0 = F.wave * 128;
#pragma unroll 8
        for (int k = 0; k < 128; ++k) { const float2 wv = *(const float2*)(w + (size_t)(k0 + k) * 9216); const float s0 = sc[k0 + k], s1 = sc[1024 + k0 + k], s2 = sc[2048 + k0 + k];
            a0 += s0 * wv.x; a1 += s0 * wv.y; b0 += s1 * wv.x; b1 += s1 * wv.y; c0 += s2 * wv.x; c1 += s2 * wv.y; }
        LAS float* rw = red + F.wave * 384 + 2 * F.lane;
        rw[0] = a0; rw[1] = a1; rw[128] = b0; rw[129] = b1; rw[256] = c0; rw[257] = c1;
        __syncthreads();
        if (F.tid < 384) { float s = 0.f;
#pragma unroll
            for (int w8 = 0; w8 < 8; ++w8) s += red[w8 * 384 + F.tid];
            const int v = F.tid >> 7, n = n0 + (F.tid & 127);
            modv[(size_t)(l * 3 + v) * 9216 + n] = s + inp(I_MODB)[l * 9216 + n]; }
        __syncthreads();
    }
}
__device__ __forceinline__ void rope_tables(Frame& F) {
    float* ct = (float*)(F.ws + WS_ROPE); float* st = ct + SEQ * 32;
    for (int i = F.bid * NTHR + F.tid; i < SEQ * 32; i += F.G * NTHR) {
        const int t = i >> 5, j = i & 31; const int f = j & 15;
        const float inv = exp2f(-(float)f * (13.287712379549449f / 16.0f));
        const float pos = (float)(j < 16 ? (t >> 6) : (t & 63));
        const float ang = pos * inv;
        const double a = (double)ang; const double k = __builtin_rint(a * 0.15915494309189535); const float r = (float)(a - k * 6.283185307179586);
        ct[i] = __cosf(r); st[i] = __sinf(r);
    }
}

struct EArgs { const float* xl_src; const float* xc_src; const bf16* xb_src; bf16* xb_dst; float* out32; const bf16* o; const float* modv_g; int gidx; float gmul; const float* gpost;
               bf16* hdst; const float* modv_h; int shidx, scidx; const float* gpre; int nrows; };
template <int R>
__device__ __forceinline__ void e_rows(Frame& F, const EArgs& A, int v, int r0) {
    f32x4 cg[4], ch[4], cs[4];
#pragma unroll
    for (int j = 0; j < 4; ++j) { const int c = F.lane + 64 * j;
        if (A.o) cg[j] = ((const f32x4*)(A.modv_g + (size_t)v * 9216 + A.gidx * DM))[c] * ((const f32x4*)A.gpost)[c] * A.gmul;
        if (A.hdst) { ch[j] = ((const f32x4*)A.gpre)[c] * (1.0f + ((const f32x4*)(A.modv_h + (size_t)v * 9216 + A.scidx * DM))[c]); cs[j] = ((const f32x4*)(A.modv_h + (size_t)v * 9216 + A.shidx * DM))[c]; } }
    f32x4 x[R][4]; v2u ow[R][4];
#pragma unroll
    for (int i = 0; i < R; ++i) { const int r = r0 + i;
        if (A.xb_src) { const v2u* xs = (const v2u*)(A.xb_src + (size_t)r * DM);
#pragma unroll
            for (int j = 0; j < 4; ++j) { const v2u w = xs[F.lane + 64 * j]; x[i][j] = (f32x4){bflo(w.x), bfhi(w.x), bflo(w.y), bfhi(w.y)}; } }
        else { const float* xs = r < TL ? A.xl_src + (size_t)r * DM : A.xc_src + (size_t)(r - TL) * DM;
#pragma unroll
            for (int j = 0; j < 4; ++j) x[i][j] = ((const f32x4*)xs)[F.lane + 64 * j]; }
        if (A.o) { const v2u* orow = (const v2u*)(A.o + (size_t)r * DM);
#pragma unroll
            for (int j = 0; j < 4; ++j) ow[i][j] = orow[F.lane + 64 * j]; } }
#pragma unroll
    for (int i = 0; i < R; ++i) { const int r = r0 + i;
        if (A.o) { f32x4 ov[4]; float ss = 0.f;
#pragma unroll
            for (int j = 0; j < 4; ++j) { const v2u w = ow[i][j]; ov[j] = (f32x4){bflo(w.x), bfhi(w.x), bflo(w.y), bfhi(w.y)}; ss += (ov[j].x * ov[j].x + ov[j].y * ov[j].y) + (ov[j].z * ov[j].z + ov[j].w * ov[j].w); }
            const float rstd = __builtin_amdgcn_rsqf(wave_sum(ss) * (1.0f / DM) + NORM_EPS);
#pragma unroll
            for (int j = 0; j < 4; ++j) x[i][j] = x[i][j] + cg[j] * (ov[j] * rstd);
            if (A.out32) {
#pragma unroll
                for (int j = 0; j < 4; ++j) ((f32x4*)(A.out32 + (size_t)r * DM))[F.lane + 64 * j] = x[i][j]; }
            else { v2u* xd = (v2u*)(A.xb_dst + (size_t)r * DM);
#pragma unroll
                for (int j = 0; j < 4; ++j) { v2u w; w.x = pk2(x[i][j].x, x[i][j].y); w.y = pk2(x[i][j].z, x[i][j].w); xd[F.lane + 64 * j] = w; } } }
        if (A.hdst) { float ss = 0.f;
#pragma unroll
            for (int j = 0; j < 4; ++j) ss += (x[i][j].x * x[i][j].x + x[i][j].y * x[i][j].y) + (x[i][j].z * x[i][j].z + x[i][j].w * x[i][j].w);
            const float rstd = __builtin_amdgcn_rsqf(wave_sum(ss) * (1.0f / DM) + NORM_EPS);
            v2u* hd = (v2u*)(A.hdst + (size_t)r * DM);
#pragma unroll
            for (int j = 0; j < 4; ++j) { const f32x4 hv = (x[i][j] * rstd) * ch[j] + cs[j]; v2u w; w.x = pk2(hv.x, hv.y); w.y = pk2(hv.z, hv.w); hd[F.lane + 64 * j] = w; } } }
}
__device__ __forceinline__ void e_phase(Frame& F, const EArgs& A) {
    const int gw = F.bid * NWAVES + F.wave, NGW = F.G * NWAVES;
    if (NGW == 2048) {
        const int b = gw >> 10, r0 = b * SEQ + (gw & 1023) * 8;
        e_rows<4>(F, A, b, r0); e_rows<4>(F, A, b, r0 + 4);
        if (A.nrows > TL && (gw & 3) == 0) e_rows<1>(F, A, 2, TL + (gw >> 2));
    } else { for (int r = gw; r < A.nrows; r += NGW) e_rows<1>(F, A, r < TL ? (r >> 13) : 2, r); }
}

__device__ __forceinline__ const bf16* zrow(const Frame& F, int row) { return (const bf16*)(F.ws + WS_ACT) + (size_t)row * INWP; }

typedef short bf16x8 __attribute__((ext_vector_type(8)));
#define MFMA16(a, b, c) __builtin_amdgcn_mfma_f32_16x16x32_bf16(a, b, c, 0, 0, 0)
__device__ __forceinline__ bf16x8 mk8(unsigned a, unsigned b, unsigned c, unsigned d) { const v4u v = {a, b, c, d}; return __builtin_bit_cast(bf16x8, v); }
typedef __bf16 bf16x2_t __attribute__((ext_vector_type(2)));
typedef float f32x2_t __attribute__((ext_vector_type(2)));
__device__ __forceinline__ unsigned cvtpk(float lo, float hi) { const f32x2_t f = {lo, hi}; return __builtin_bit_cast(unsigned, __builtin_convertvector(f, bf16x2_t)); }
constexpr int NSC = 66;
constexpr int IM_AI = 0, IM_RI = 4608, IM_BI = 9216, IM_KI = 13824, IM_BKT = 18432, IM_VT = 28928, IM_GAM = 34176, IMG_BYTES = 34816;
constexpr int L_IMG0 = 0, L_IMG1 = IMG_BYTES, L_PKG = 2 * IMG_BYTES, L_YL = L_PKG + 8192, L_VB = L_YL + 128 * 68 * 4, L_BON = L_VB + 128 * 64 * 2, L_CST = L_BON + 512, L_RW_END = L_CST + 2 * 3072;
static_assert(L_RW_END <= 146432, "rwkv LDS map");
constexpr size_t SUM_SLOT = 24576;

__device__ __forceinline__ void fourier_ctx1_all(Frame& F) {
    bf16* gre = (bf16*)(F.ws + WS_GC); bf16* gim = gre + TC * 256;
    const bf16* wc = (const bf16*)(F.ws + WS_FT + FT_W64C); const bf16* wsn = (const bf16*)(F.ws + WS_FT + FT_W64S);
    for (int i = F.bid * NTHR + F.tid; i < TC * 256; i += F.G * NTHR) { const int tok = i & (TC - 1), gm = i >> 9, g = gm >> 6, m = gm & 63;
        const bf16* z = zrow(F, TL + tok) + ZF + 64 * g; float sr = 0.f, si = 0.f;
#pragma unroll
        for (int c8 = 0; c8 < 8; ++c8) { float x[8], cs[8], sn[8]; unpack8(*(const v4u*)(z + 8 * c8), x); unpack8(*(const v4u*)(wc + m * 64 + 8 * c8), cs); unpack8(*(const v4u*)(wsn + m * 64 + 8 * c8), sn);
#pragma unroll
            for (int e = 0; e < 8; ++e) { sr += x[e] * cs[e]; si -= x[e] * sn[e]; } }
        const int o = ((tok >> 8) * 256 + gm) * 256 + (tok & 255);
        gre[o] = (bf16)f2bf(sr); gim[o] = (bf16)f2bf(si); }
}
__device__ __forceinline__ void fourier_ctx2_all(Frame& F, int bid0) {
    const bf16* gre = (const bf16*)(F.ws + WS_GC); const bf16* gim = gre + TC * 256; bf16* mix = (bf16*)(F.ws + WS_H);
    const int q = F.lane >> 4, c = F.lane & 15;
#pragma unroll 1
    for (int u = (F.bid - bid0) * 8 + F.wave; u < 512; u += (F.G - bid0) * 8) { const int b = u >> 8, kt = (u >> 4) & 15, gt = u & 15;
        const int k = 16 * kt + c; const bf16* pr = gre + (size_t)((b * 256 + 16 * gt + c) * 256 + 8 * q); const bf16* pi = gim + (size_t)((b * 256 + 16 * gt + c) * 256 + 8 * q);
        f32x4 acc = {0.f, 0.f, 0.f, 0.f};
#pragma unroll
        for (int cc = 0; cc < 8; ++cc) { const bf16x8 re = *(const bf16x8*)(pr + 32 * cc), im = *(const bf16x8*)(pi + 32 * cc);
            float cv[8], sv[8];
#pragma unroll
            for (int e = 0; e < 8; ++e) { const float a = (float)((k * (32 * cc + 8 * q + e)) & 255) * (1.0f / 256.0f); cv[e] = __builtin_amdgcn_cosf(a); sv[e] = __builtin_amdgcn_sinf(a); }
            acc = MFMA16(mk8(cvtpk(cv[0], cv[1]), cvtpk(cv[2], cv[3]), cvtpk(cv[4], cv[5]), cvtpk(cv[6], cv[7])), re, acc);
            acc = MFMA16(mk8(cvtpk(sv[0], sv[1]), cvtpk(sv[2], sv[3]), cvtpk(sv[4], sv[5]), cvtpk(sv[6], sv[7])), im, acc); }
#pragma unroll
        for (int r = 0; r < 4; ++r) mix[(size_t)(TL + b * 256 + 16 * kt + 4 * q + r) * DM + 16 * gt + c] = (bf16)f2bf(acc[r] * 0.0078125f); }
}
__device__ __forceinline__ void lora_transposes(Frame& F) {
    bf16* w2t = (bf16*)(F.ws + WS_W2T); bf16* a2t = (bf16*)(F.ws + WS_A2T); bf16* g2t = (bf16*)(F.ws + WS_G2T);
    const float* w2 = inp(I_W2); const float* a2 = inp(I_A2); const float* g2 = inp(I_G2);
    for (int i = F.bid * NTHR + F.tid; i < 4 * 384 * 64; i += F.G * NTHR) { const int r = i & 63, col = (i >> 6) % 384, ld = i / (384 * 64);
        w2t[i] = (bf16)f2bf(w2[((size_t)ld * 64 + r) * RW + col]); a2t[i] = (bf16)f2bf(a2[((size_t)ld * 64 + r) * RW + col]); }
    for (int i = F.bid * NTHR + F.tid; i < 2 * 384 * 128; i += F.G * NTHR) { const int r = i & 127, col = (i >> 7) % 384, l = i / (384 * 128);
        g2t[i] = (bf16)f2bf(g2[((size_t)l * 128 + r) * RW + col]); }
}

__device__ __forceinline__ float softplus_fast(float x) { return fmaxf(x, 0.f) + __logf(1.0f + __expf(-fabsf(x))); }
__device__ __forceinline__ float tanh_fast(float x) { return 1.0f - 2.0f * __builtin_amdgcn_rcpf(1.0f + __expf(2.0f * x)); }
template <int CTRL> __device__ __forceinline__ float dpp_f(float v) { return __builtin_bit_cast(float, __builtin_amdgcn_update_dpp(0, __builtin_bit_cast(int, v), CTRL, 0xf, 0xf, true)); }
__device__ __forceinline__ void lora_pass(Frame& F, int li) {
    const int q = F.lane >> 4, c16 = F.lane & 15;
#pragma unroll 1
    for (int dir = 0; dir < 2; ++dir) {
        bf16* LW = (bf16*)(F.ws + WS_LW) + (size_t)dir * TT * RW; bf16* IC = (bf16*)(F.ws + WS_IC) + (size_t)dir * TT * RW;
        const bf16* w2t = (const bf16*)(F.ws + WS_W2T) + (size_t)(li * 2 + dir) * 384 * 64; const bf16* a2t = (const bf16*)(F.ws + WS_A2T) + (size_t)(li * 2 + dir) * 384 * 64;
        bf16x8 aw[3][2], aa[3][2]; f32x4 w0v[3], a0v[3];
#pragma unroll
        for (int cti = 0; cti < 3; ++cti) { const int ct = 3 * F.wave + cti, col = 16 * ct + c16;
#pragma unroll
            for (int k = 0; k < 2; ++k) { aw[cti][k] = *(const bf16x8*)(w2t + (size_t)col * 64 + 32 * k + 8 * q); aa[cti][k] = *(const bf16x8*)(a2t + (size_t)col * 64 + 32 * k + 8 * q); }
            w0v[cti] = *(const f32x4*)(inp(I_W0) + (li * 2 + dir) * RW + 16 * ct + 4 * q); a0v[cti] = *(const f32x4*)(inp(I_A0) + (li * 2 + dir) * RW + 16 * ct + 4 * q); }
#pragma unroll 1
        for (int rt = F.bid; rt < TT / 16; rt += F.G) {
            const bf16* z = zrow(F, 16 * rt + c16);
            bf16x8 bw[2], ba[2];
#pragma unroll
            for (int k = 0; k < 2; ++k) { const v4u zw = *(const v4u*)(z + ZW + 64 * dir + 32 * k + 8 * q); ba[k] = *(const bf16x8*)(z + ZA + 64 * dir + 32 * k + 8 * q);
                bw[k] = mk8(cvtpk(tanh_fast(bflo(zw.x)), tanh_fast(bfhi(zw.x))), cvtpk(tanh_fast(bflo(zw.y)), tanh_fast(bfhi(zw.y))), cvtpk(tanh_fast(bflo(zw.z)), tanh_fast(bfhi(zw.z))), cvtpk(tanh_fast(bflo(zw.w)), tanh_fast(bfhi(zw.w)))); }
#pragma unroll
            for (int cti = 0; cti < 3; ++cti) { const int ct = 3 * F.wave + cti;
                f32x4 dw = {0.f, 0.f, 0.f, 0.f}, da = {0.f, 0.f, 0.f, 0.f};
#pragma unroll
                for (int k = 0; k < 2; ++k) { dw = MFMA16(aw[cti][k], bw[k], dw); da = MFMA16(aa[cti][k], ba[k], da); }
                float lw[4], ic[4];
#pragma unroll
                for (int e = 0; e < 4; ++e) { const float x = w0v[cti][e] + dw[e]; const float wl = -softplus_fast(-x) - 0.5f; lw[e] = -__expf(wl); ic[e] = __builtin_amdgcn_rcpf(1.0f + __expf(-(a0v[cti][e] + da[e]))); }
                if (dir == 0) {
#pragma unroll
                    for (int e = 0; e < 4; ++e) { lw[e] += dpp_f<0x111>(lw[e]); lw[e] += dpp_f<0x112>(lw[e]); lw[e] += dpp_f<0x114>(lw[e]); lw[e] += dpp_f<0x118>(lw[e]); } }
                else {
#pragma unroll
                    for (int e = 0; e < 4; ++e) { lw[e] += dpp_f<0x101>(lw[e]); lw[e] += dpp_f<0x102>(lw[e]); lw[e] += dpp_f<0x104>(lw[e]); lw[e] += dpp_f<0x108>(lw[e]); } }
#pragma unroll
                for (int e = 0; e < 4; ++e) lw[e] = __expf(lw[e]);
                if (c16 == (dir == 0 ? 15 : 0)) *(f32x4*)((float*)(F.ws + WS_GAM32) + ((size_t)dir * (TT / 16) + rt) * RW + 16 * ct + 4 * q) = (f32x4){lw[0], lw[1], lw[2], lw[3]};
                const size_t o = (size_t)(16 * rt + c16) * RW + 16 * ct + 4 * q;
                v2u w; w.x = cvtpk(lw[0], lw[1]); w.y = cvtpk(lw[2], lw[3]); *(v2u*)(LW + o) = w; w.x = cvtpk(ic[0], ic[1]); w.y = cvtpk(ic[2], ic[3]); *(v2u*)(IC + o) = w; }
        }
    }
}
__device__ __forceinline__ void gate_pass(Frame& F, int li) {
    const int q = F.lane >> 4, c16 = F.lane & 15;
    bf16* GT = (bf16*)(F.ws + WS_GATE);
    const bf16* g2t = (const bf16*)(F.ws + WS_G2T) + (size_t)li * 384 * 128;
    bf16x8 ag[3][4];
#pragma unroll
    for (int cti = 0; cti < 3; ++cti)
#pragma unroll
        for (int k = 0; k < 4; ++k) ag[cti][k] = *(const bf16x8*)(g2t + (size_t)(16 * (3 * F.wave + cti) + c16) * 128 + 32 * k + 8 * q);
#pragma unroll 1
    for (int rt = F.bid; rt < TT / 16; rt += F.G) {
        const bf16* z = zrow(F, 16 * rt + c16);
        bf16x8 bg[4];
#define SG(x) __builtin_amdgcn_rcpf(1.0f + __expf(-(x)))
#pragma unroll
        for (int k = 0; k < 4; ++k) { const v4u zg = *(const v4u*)(z + ZG + 32 * k + 8 * q);
            bg[k] = mk8(cvtpk(SG(bflo(zg.x)), SG(bfhi(zg.x))), cvtpk(SG(bflo(zg.y)), SG(bfhi(zg.y))), cvtpk(SG(bflo(zg.z)), SG(bfhi(zg.z))), cvtpk(SG(bflo(zg.w)), SG(bfhi(zg.w)))); }
#undef SG
#pragma unroll
        for (int cti = 0; cti < 3; ++cti) { f32x4 d = {0.f, 0.f, 0.f, 0.f};
#pragma unroll
            for (int k = 0; k < 4; ++k) d = MFMA16(ag[cti][k], bg[k], d);
            v2u w; w.x = cvtpk(d[0], d[1]); w.y = cvtpk(d[2], d[3]); *(v2u*)(GT + (size_t)(16 * rt + c16) * RW + 16 * (3 * F.wave + cti) + 4 * q) = w; }
    }
}
__device__ __forceinline__ void chain_consts_lds(Frame& F, LAS float* cst, int li, int h, int t256) {
    for (int i = t256; i < 12 * 64; i += 256) { const int k = i >> 6, j = i & 63, ch = 64 * h + j; float v;
        if (k == 0) v = inp(I_KK)[li * RW + ch]; else if (k == 1) v = inp(I_KA)[li * RW + ch]; else if (k == 2) v = inp(I_RK)[li * RW + ch];
        else { const int tt = (k - 3) / 3, w = (k - 3) % 3; v = inp(I_CONV)[(size_t)(li * 3 + tt) * (3 * RW) + w * RW + ch]; }
        cst[i] = v; }
}
struct PrepRaw { v4u ecw, icv, epw, zr[3], zk[3], zv[3]; f32x4 g0, g1; };
__device__ __forceinline__ void prep_load(Frame& F, PrepRaw& R, int dir, int b, int h, int tl, int o, bool isctx, int step0) {
    const int L = isctx ? CTX : SEQ, rbase = isctx ? TL + b * CTX : b * SEQ, ch0 = 64 * h + 8 * o;
    const int s = step0 + tl; const int p = dir ? L - 1 - s : s; const int row = rbase + p, tb = tl & 15;
    { const bf16* LW = (const bf16*)(F.ws + WS_LW) + (size_t)dir * TT * RW + ch0; const bf16* IC = (const bf16*)(F.ws + WS_IC) + (size_t)dir * TT * RW + ch0;
      R.ecw = *(const v4u*)(LW + (size_t)row * RW); R.icv = *(const v4u*)(IC + (size_t)row * RW); R.epw = *(const v4u*)(LW + (size_t)(tb == 0 ? row : (dir ? row + 1 : row - 1)) * RW); }
#pragma unroll
    for (int tt = 0; tt < 3; ++tt) { const int pp = p + tt - 1; const bool ok = pp >= 0 && pp < L; const bf16* z = zrow(F, rbase + (ok ? pp : p)) + ch0;
        const v4u z0 = {0u, 0u, 0u, 0u};
        R.zr[tt] = ok ? *(const v4u*)(z + ZRR) : z0; R.zk[tt] = ok ? *(const v4u*)(z + ZRK) : z0; R.zv[tt] = ok ? *(const v4u*)(z + ZRV) : z0; }
    if (tb == 15) { const f32x4* gs = (const f32x4*)((const float*)(F.ws + WS_GAM32) + ((size_t)dir * (TT / 16) + (row >> 4)) * RW + ch0); R.g0 = gs[0]; R.g1 = gs[1]; }
}
__device__ __forceinline__ void prep_compute(Frame& F, const PrepRaw& R, const LAS float* cst, LAS unsigned char* img, int dir, int b, int h, int tl, int o, bool isctx, int step0, LAS unsigned char* lds_vb, LAS float* lds_bon, int pos0_local) {
    const bool BONUS = lds_vb != nullptr;
    const int L = isctx ? CTX : SEQ, rbase = isctx ? TL + b * CTX : b * SEQ, ch0 = 64 * h + 8 * o;
    const int blk = tl >> 4, tb = tl & 15;
    const int s = step0 + tl; const int p = dir ? L - 1 - s : s; const int row = rbase + p;
    const v4u ecw = R.ecw, icv = R.icv, epw = R.epw;
    v4u zr[3], zk[3], zv[3];
#pragma unroll
    for (int tt = 0; tt < 3; ++tt) { zr[tt] = R.zr[tt]; zk[tt] = R.zk[tt]; zv[tt] = R.zv[tt]; }
    float ecf[8], epf[8], ai[8], rv[8], kv[8], vv[8];
    unpack8(ecw, ecf); unpack8(epw, epf); unpack8(icv, ai);
#pragma unroll
    for (int e = 0; e < 8; ++e) { rv[e] = 0.f; kv[e] = 0.f; vv[e] = 0.f; }
#pragma unroll
    for (int tt = 0; tt < 3; ++tt) { float a[8], bq[8], cq[8]; unpack8(zr[tt], a); unpack8(zk[tt], bq); unpack8(zv[tt], cq);
        const LAS f32x4* w0 = (const LAS f32x4*)(cst + (3 + tt * 3 + 0) * 64 + 8 * o); const LAS f32x4* w1 = (const LAS f32x4*)(cst + (3 + tt * 3 + 1) * 64 + 8 * o); const LAS f32x4* w2 = (const LAS f32x4*)(cst + (3 + tt * 3 + 2) * 64 + 8 * o);
        const f32x4 w0a = w0[0], w0b = w0[1], w1a = w1[0], w1b = w1[1], w2a = w2[0], w2b = w2[1];
#pragma unroll
        for (int e = 0; e < 4; ++e) { rv[e] += w0a[e] * a[e]; rv[e + 4] += w0b[e] * a[e + 4]; kv[e] += w1a[e] * bq[e]; kv[e + 4] += w1b[e] * bq[e + 4]; vv[e] += w2a[e] * cq[e]; vv[e + 4] += w2b[e] * cq[e + 4]; } }
    float kkw[8], kaw[8];
    { const LAS f32x4* a = (const LAS f32x4*)(cst + 0 * 64 + 8 * o); const LAS f32x4* bq = (const LAS f32x4*)(cst + 1 * 64 + 8 * o); const f32x4 a0 = a[0], a1 = a[1], b0 = bq[0], b1 = bq[1];
#pragma unroll
      for (int e = 0; e < 4; ++e) { kkw[e] = a0[e]; kkw[e + 4] = a1[e]; kaw[e] = b0[e]; kaw[e + 4] = b1[e]; } }
    float kkr[8], ss = 0.f;
#pragma unroll
    for (int e = 0; e < 8; ++e) { kkr[e] = kv[e] * kkw[e]; ss += kkr[e] * kkr[e]; }
    ss = sum8(ss);
    const float rn = __builtin_amdgcn_rsqf(fmaxf(ss, 1e-24f));
    float At[8], Rt[8], Bt[8], Kt[8];
#pragma unroll
    for (int e = 0; e < 8; ++e) { const float kk = kkr[e] * rn, kd = kv[e] * (1.0f + (ai[e] - 1.0f) * kaw[e]); const float eprev = tb == 0 ? 1.0f : epf[e]; const float ec = ecf[e], en = __builtin_amdgcn_rcpf(ec);
        At[e] = -kk * eprev; Rt[e] = rv[e] * ec; Bt[e] = kk * ai[e] * en; Kt[e] = kd * en; }
    const int P0 = 32 * (o >> 2) + 16 * (o & 1) + 4 * ((o >> 1) & 1);
    LAS bf16* AI = (LAS bf16*)(img + IM_AI) + blk * 1152 + tb * 72 + P0, *RI = (LAS bf16*)(img + IM_RI) + blk * 1152 + tb * 72 + P0, *BI = (LAS bf16*)(img + IM_BI) + blk * 1152 + tb * 72 + P0, *KI = (LAS bf16*)(img + IM_KI) + blk * 1152 + tb * 72 + P0;
    unsigned bp[4], kp[4];
#pragma unroll
    for (int e = 0; e < 4; ++e) { bp[e] = cvtpk(Bt[2 * e], Bt[2 * e + 1]); kp[e] = cvtpk(Kt[2 * e], Kt[2 * e + 1]); }
    *(LAS v2u*)AI = (v2u){cvtpk(At[0], At[1]), cvtpk(At[2], At[3])}; *(LAS v2u*)(AI + 8) = (v2u){cvtpk(At[4], At[5]), cvtpk(At[6], At[7])};
    *(LAS v2u*)RI = (v2u){cvtpk(Rt[0], Rt[1]), cvtpk(Rt[2], Rt[3])}; *(LAS v2u*)(RI + 8) = (v2u){cvtpk(Rt[4], Rt[5]), cvtpk(Rt[6], Rt[7])};
    *(LAS v2u*)BI = (v2u){bp[0], bp[1]}; *(LAS v2u*)(BI + 8) = (v2u){bp[2], bp[3]};
    *(LAS v2u*)KI = (v2u){kp[0], kp[1]}; *(LAS v2u*)(KI + 8) = (v2u){kp[2], kp[3]};
    LAS bf16* BKT = (LAS bf16*)(img + IM_BKT) + blk * 2624 + (8 * o) * 40 + o * 8 + (tb >> 2) * 8 + (tb & 3); LAS bf16* VT = (LAS bf16*)(img + IM_VT) + blk * 1312 + (8 * o) * 20 + o * 4 + tb;
    const unsigned vp[4] = {cvtpk(vv[0], vv[1]), cvtpk(vv[2], vv[3]), cvtpk(vv[4], vv[5]), cvtpk(vv[6], vv[7])};
#pragma unroll
    for (int e = 0; e < 8; ++e) { const unsigned bb = bp[e >> 1], kq = kp[e >> 1], vq = vp[e >> 1];
        BKT[e * 40] = (bf16)((e & 1) ? (bb >> 16) : (bb & 0xffff)); BKT[e * 40 + 4] = (bf16)((e & 1) ? (kq >> 16) : (kq & 0xffff)); VT[e * 20] = (bf16)((e & 1) ? (vq >> 16) : (vq & 0xffff)); }
    if (tb == 15) { LAS f32x4* G = (LAS f32x4*)((LAS float*)(img + IM_GAM) + blk * 64 + 8 * o); G[0] = R.g0; G[1] = R.g1; }
    if (BONUS) { float bs = 0.f; const LAS f32x4* rk = (const LAS f32x4*)(cst + 2 * 64 + 8 * o); const f32x4 r0 = rk[0], r1 = rk[1];
#pragma unroll
        for (int e = 0; e < 4; ++e) bs += rv[e] * kv[e] * r0[e] + rv[e + 4] * kv[e + 4] * r1[e];
        bs = sum8(bs);
        const int pl = dir ? pos0_local - tl : pos0_local + tl;
        *(LAS v4u*)(lds_vb + (pl * 64 + 8 * o) * 2) = (v4u){vp[0], vp[1], vp[2], vp[3]}; if (o == 0) lds_bon[pl] = bs; }
}
template <bool WANT_Y>
__device__ __forceinline__ void block_package(LAS unsigned char* img, int blk, LAS unsigned* pkg, int lane) {
    const int q = lane >> 4, c = lane & 15;
    f32x4 mab = {0.f, 0.f, 0.f, 0.f}, mak = mab, mbr = mab, mkr = mab;
#pragma unroll
    for (int k = 0; k < 2; ++k) { const int o = blk * 2304 + c * 144 + k * 64 + q * 16;
        const bf16x8 bi = *(const LAS bf16x8*)(img + IM_BI + o), ki = *(const LAS bf16x8*)(img + IM_KI + o), ai = *(const LAS bf16x8*)(img + IM_AI + o);
        mab = MFMA16(bi, ai, mab); mak = MFMA16(ki, ai, mak);
        if constexpr (WANT_Y) { const bf16x8 ri = *(const LAS bf16x8*)(img + IM_RI + o); mbr = MFMA16(bi, ri, mbr); mkr = MFMA16(ki, ri, mkr); } }
#pragma unroll
    for (int e = 0; e < 4; ++e) { const int s = 4 * q + e; if (!(s < c)) { mab[e] = 0.f; mak[e] = 0.f; } if (!(s <= c)) { mbr[e] = 0.f; mkr[e] = 0.f; } }
    f32x4 mabT = {0.f, 0.f, 0.f, 0.f};
#pragma unroll
    for (int k = 0; k < 2; ++k) { const int o = blk * 2304 + c * 144 + k * 64 + q * 16; mabT = MFMA16(*(const LAS bf16x8*)(img + IM_AI + o), *(const LAS bf16x8*)(img + IM_BI + o), mabT); }
#pragma unroll
    for (int e = 0; e < 4; ++e) if (!(c < 4 * q + e)) mabT[e] = 0.f;
    const f32x4 z4 = {0.f, 0.f, 0.f, 0.f};
#define OPND(x) mk8(cvtpk((x)[0], (x)[1]), cvtpk((x)[2], (x)[3]), 0u, 0u)
    const bf16x8 oM = OPND(mab), oMT = OPND(mabT);
    const f32x4 m2 = MFMA16(oMT, oM, z4), m2T = MFMA16(oM, oMT, z4);
    const bf16x8 oM2 = OPND(m2), oM2T = OPND(m2T);
    const f32x4 m4 = MFMA16(oM2T, oM2, z4), m4T = MFMA16(oM2, oM2T, z4);
    const f32x4 m8T = MFMA16(OPND(m4), OPND(m4T), z4);
    f32x4 nn = m2;
#pragma unroll
    for (int e = 0; e < 4; ++e) nn[e] += (4 * q + e == c) ? 1.0f : 0.0f;
    nn = MFMA16(oMT, OPND(nn), nn);
    nn = MFMA16(OPND(m4T), OPND(nn), nn);
    nn = MFMA16(OPND(m8T), OPND(nn), nn);
#undef OPND
    pkg[0 * 64 + lane] = cvtpk(nn[0], nn[1]); pkg[1 * 64 + lane] = cvtpk(nn[2], nn[3]);
    pkg[2 * 64 + lane] = cvtpk(mak[0], mak[1]); pkg[3 * 64 + lane] = cvtpk(mak[2], mak[3]);
    if constexpr (WANT_Y) { pkg[4 * 64 + lane] = cvtpk(mbr[0], mbr[1]); pkg[5 * 64 + lane] = cvtpk(mbr[2], mbr[3]); pkg[6 * 64 + lane] = cvtpk(mkr[0], mkr[1]); pkg[7 * 64 + lane] = cvtpk(mkr[2], mkr[3]); }
}
template <bool WANT_Y, bool HAS_V>
__device__ __forceinline__ f32x4 block_scan(LAS unsigned char* img, int blk, const LAS unsigned* pkg, f32x4 (&S)[4], int wq, int lane) {
    const int q = lane >> 4, c = lane & 15;
    bf16x8 Sb[2];
#pragma unroll
    for (int k = 0; k < 2; ++k) Sb[k] = mk8(cvtpk(S[2 * k][0], S[2 * k][1]), cvtpk(S[2 * k][2], S[2 * k][3]), cvtpk(S[2 * k + 1][0], S[2 * k + 1][1]), cvtpk(S[2 * k + 1][2], S[2 * k + 1][3]));
    v2u vpk = {0u, 0u};
    if constexpr (HAS_V) vpk = *(const LAS v2u*)(img + IM_VT + blk * 2624 + (c + 16 * wq) * 40 + ((c + 16 * wq) >> 3) * 8 + q * 8);
    const int ao = blk * 2304 + c * 144 + q * 16;
    f32x4 rhs = {0.f, 0.f, 0.f, 0.f};
    rhs = MFMA16(*(const LAS bf16x8*)(img + IM_AI + ao), Sb[0], rhs); rhs = MFMA16(*(const LAS bf16x8*)(img + IM_AI + ao + 64), Sb[1], rhs);
    if constexpr (HAS_V) rhs = MFMA16(mk8(0u, 0u, pkg[2 * 64 + lane], pkg[3 * 64 + lane]), mk8(0u, 0u, vpk.x, vpk.y), rhs);
    f32x4 u = {0.f, 0.f, 0.f, 0.f};
    u = MFMA16(mk8(pkg[0 * 64 + lane], pkg[1 * 64 + lane], 0u, 0u), mk8(cvtpk(rhs[0], rhs[1]), cvtpk(rhs[2], rhs[3]), 0u, 0u), u);
    const bf16x8 UV = mk8(cvtpk(u[0], u[1]), cvtpk(u[2], u[3]), vpk.x, vpk.y);
    f32x4 y = {0.f, 0.f, 0.f, 0.f};
    if constexpr (WANT_Y) { y = MFMA16(*(const LAS bf16x8*)(img + IM_RI + ao), Sb[0], y); y = MFMA16(*(const LAS bf16x8*)(img + IM_RI + ao + 64), Sb[1], y);
        y = MFMA16(mk8(pkg[4 * 64 + lane], pkg[5 * 64 + lane], pkg[6 * 64 + lane], pkg[7 * 64 + lane]), UV, y); }
#pragma unroll
    for (int T = 0; T < 4; ++T) { const bf16x8 bkt = *(const LAS bf16x8*)(img + IM_BKT + blk * 5248 + (16 * T + c) * 80 + ((16 * T + c) >> 3) * 16 + q * 16);
        S[T] = MFMA16(bkt, UV, S[T]); const f32x4 g = *(const LAS f32x4*)(img + IM_GAM + blk * 256 + (16 * T + 4 * q) * 4); S[T] = S[T] * g; }
    return y;
}
__device__ __forceinline__ unsigned char* sum_slot(Frame& F, int chain, int sc) { return (unsigned char*)F.out + OUT_SUM + (size_t)(chain * NSC + sc) * SUM_SLOT; }

__device__ __forceinline__ void rwkv_pass1_pair(Frame& F, int li, int pair) {
    const int g = F.wave >> 2, wq = F.wave & 3, u = 2 * pair + g;
    const int chain = u / (NSC - 1), sc = u % (NSC - 1);
    const int dir = chain / 12, b = (chain / 6) & 1, h = chain % 6;
    const bool isctx = sc < 2; const int scl = isctx ? sc : sc - 2;
    LAS unsigned char* img = F.lds + (g ? L_IMG1 : L_IMG0); LAS unsigned* pkg = (LAS unsigned*)(F.lds + L_PKG) + g * 1024;
    LAS float* cst = (LAS float*)(F.lds + L_CST) + g * 768;
    __syncthreads();
    chain_consts_lds(F, cst, li, h, F.tid & 255);
    const int q = F.lane >> 4, c = F.lane & 15;
    f32x4 SB[4], SA[4];
#pragma unroll
    for (int T = 0; T < 4; ++T)
#pragma unroll
        for (int e = 0; e < 4; ++e) { SB[T][e] = 0.0f; SA[T][e] = (16 * T + 4 * q + e == c + 16 * wq) ? 1.0f : 0.0f; }
    PrepRaw R;
    prep_load(F, R, dir, b, h, 8 * wq + (F.lane >> 3), F.lane & 7, isctx, 128 * scl);
    if (g == 1) __syncthreads();
#pragma unroll 1
    for (int rd = 0; rd < 4; ++rd) {
        __syncthreads();
        prep_compute(F, R, cst, img, dir, b, h, 8 * wq + (F.lane >> 3), F.lane & 7, isctx, 128 * scl + 32 * rd, nullptr, nullptr, 0);
        __syncthreads();
        if (rd < 3) prep_load(F, R, dir, b, h, 8 * wq + (F.lane >> 3), F.lane & 7, isctx, 128 * scl + 32 * (rd + 1));
        if (wq < 2) block_package<false>(img, wq, pkg + wq * 512, F.lane);
        __syncthreads();
        __builtin_amdgcn_s_setprio(3);
#pragma unroll
        for (int blk = 0; blk < 2; ++blk) { block_scan<false, true>(img, blk, pkg + blk * 512, SB, wq, F.lane); block_scan<false, false>(img, blk, pkg + blk * 512, SA, wq, F.lane); }
        __builtin_amdgcn_s_setprio(0);
    }
    if (g == 0) __syncthreads();
    unsigned char* slot = sum_slot(F, chain, sc);
    { f32x4* braw = (f32x4*)slot;
#pragma unroll
      for (int T = 0; T < 4; ++T) braw[(wq * 4 + T) * 64 + F.lane] = SB[T]; }
    { bf16* aim = (bf16*)(slot + 16384); const int kap = wq >> 1, e = (F.lane & 3) + 4 * (wq & 1), qc = c >> 2;
#pragma unroll
      for (int T = 0; T < 4; ++T)
#pragma unroll
          for (int r = 0; r < 4; ++r) { const int lc = (4 * q + r) + 16 * qc; aim[((T * 2 + kap) * 64 + lc) * 8 + e] = (bf16)f2bf(SA[T][r]); } }
}
struct P2Stage { v4u v[3]; };
__device__ __forceinline__ void p2_ld(Frame& F, P2Stage& X, int chain, int sc, int wq) {
    const v4u* s = (const v4u*)sum_slot(F, chain, sc) + (F.tid - 256);
    X.v[0] = s[wq * 256]; X.v[1] = s[1024]; X.v[2] = s[1280];
}
__device__ __forceinline__ void p2_put(Frame& F, const P2Stage& X, LAS unsigned char* bb) {
#pragma unroll
    for (int i = 0; i < 3; ++i) *(LAS v4u*)(bb + 4096 * i + 16 * (F.tid - 256)) = X.v[i];
}
constexpr int P2D = 8;
__device__ __forceinline__ void p2_math(Frame& F, const LAS unsigned char* bb, f32x4 (&S)[4], int chain, int sc, int wq) {
    f32x4* braw = (f32x4*)sum_slot(F, chain, sc);
    bf16x8 Sb[2];
#pragma unroll
    for (int k = 0; k < 2; ++k) Sb[k] = mk8(cvtpk(S[2 * k][0], S[2 * k][1]), cvtpk(S[2 * k][2], S[2 * k][3]), cvtpk(S[2 * k + 1][0], S[2 * k + 1][1]), cvtpk(S[2 * k + 1][2], S[2 * k + 1][3]));
#pragma unroll
    for (int T = 0; T < 4; ++T) { braw[(wq * 4 + T) * 64 + F.lane] = S[T];
        const f32x4 bc = *(const LAS f32x4*)(bb + (T * 64 + F.lane) * 16);
        const bf16x8 a0 = *(const LAS bf16x8*)(bb + 4096 + ((T * 2 + 0) * 64 + F.lane) * 16), a1 = *(const LAS bf16x8*)(bb + 4096 + ((T * 2 + 1) * 64 + F.lane) * 16);
        S[T] = MFMA16(a1, Sb[1], MFMA16(a0, Sb[0], bc)); }
}
__device__ __forceinline__ void rwkv_pass2_part(Frame& F, int chain, int wq) {
    constexpr int NS = NSC - 1;
    LAS unsigned char* buf = F.lds;
    __syncthreads();
    if (F.wave >= 4) {
        P2Stage X[P2D];
#pragma unroll
        for (int j = 0; j < P2D; ++j) p2_ld(F, X[j], chain, j, wq);
#pragma unroll 1
        for (int sc0 = 0; sc0 < NS - 1; sc0 += P2D) {
#pragma unroll
            for (int j = 0; j < P2D; ++j) { const int sc = sc0 + j; p2_put(F, X[j], buf + (j & 1) * 12288); p2_ld(F, X[j], chain, min(sc + P2D, NS - 1), wq); __syncthreads(); } }
        p2_put(F, X[0], buf); __syncthreads();
        return;
    }
    if (F.wave > 0) {
#pragma unroll 1
        for (int sc = 0; sc < NS; ++sc) __syncthreads();
        return;
    }
    f32x4 S[4];
#pragma unroll
    for (int T = 0; T < 4; ++T) S[T] = (f32x4){0.f, 0.f, 0.f, 0.f};
#pragma unroll 1
    for (int sc = 0; sc < NS; ++sc) { __syncthreads(); p2_math(F, buf + (sc & 1) * 12288, S, chain, sc, wq); }
    { f32x4* braw = (f32x4*)sum_slot(F, chain, NSC - 1);
#pragma unroll
      for (int T = 0; T < 4; ++T) braw[(wq * 4 + T) * 64 + F.lane] = S[T]; }
}
__device__ __forceinline__ void rwkv_pass3_unit(Frame& F, int li, int u) {
    T0(tu_); T0(ts_);
    const int pc = u % NSC, bh = u / NSC, b = bh / 6, h = bh % 6;
    const bool isctx = pc < 2; const int pcl = isctx ? pc : pc - 2, nsc = isctx ? 2 : 64;
    const int dir = F.wave >> 2, wq = F.wave & 3, q = F.lane >> 4, c = F.lane & 15;
    const int sc = dir == 0 ? pc : (isctx ? 1 - pcl : 2 + 63 - pcl);
    const int scl = dir == 0 ? pcl : nsc - 1 - pcl;
    const int chain = dir * 12 + b * 6 + h;
    LAS unsigned char* img = F.lds + (dir ? L_IMG1 : L_IMG0); LAS unsigned* pkg = (LAS unsigned*)(F.lds + L_PKG) + dir * 1024;
    LAS float* YL = (LAS float*)(F.lds + L_YL); LAS unsigned char* VB = F.lds + L_VB; LAS float* BON = (LAS float*)(F.lds + L_BON);
    LAS float* cst = (LAS float*)(F.lds + L_CST);
    __syncthreads();
    if (F.tid < 256) chain_consts_lds(F, cst, li, h, F.tid);
    f32x4 S[4];
    { const f32x4* braw = (const f32x4*)sum_slot(F, chain, sc);
#pragma unroll
      for (int T = 0; T < 4; ++T) S[T] = braw[(wq * 4 + T) * 64 + F.lane]; }
    __syncthreads();
    for (int i = F.tid; i < 128 * 68; i += NTHR) YL[i] = 0.f;
    PrepRaw R;
    prep_load(F, R, dir, b, h, 8 * wq + (F.lane >> 3), F.lane & 7, isctx, 128 * scl);
    TACC(F, 11, ts_);
    if (dir == 1) __syncthreads();
#pragma unroll 1
    for (int rd = 0; rd < 4; ++rd) {
        T0(ta_);
        __syncthreads();
        TACC(F, 16, ta_);
        prep_compute(F, R, cst, img, dir, b, h, 8 * wq + (F.lane >> 3), F.lane & 7, isctx, 128 * scl + 32 * rd, dir == 0 ? VB : (LAS unsigned char*)nullptr, BON, 32 * rd);
        TACC(F, 12, ta_); T0(tb_);
        __syncthreads();
        TACC(F, 17, tb_); T0(tb2_);
        if (rd < 3) prep_load(F, R, dir, b, h, 8 * wq + (F.lane >> 3), F.lane & 7, isctx, 128 * scl + 32 * (rd + 1));
        TACC(F, 18, tb2_); T0(tb3_);
        if (wq < 2) block_package<true>(img, wq, pkg + wq * 512, F.lane);
        TACC(F, 19, tb3_);
        __syncthreads();
        TACC(F, 13, tb_); T0(tc_);
        __builtin_amdgcn_s_setprio(3);
#pragma unroll
        for (int blk = 0; blk < 2; ++blk) { const f32x4 y = block_scan<true, true>(img, blk, pkg + blk * 512, S, wq, F.lane);
#pragma unroll
            for (int e = 0; e < 4; ++e) { const int t = 32 * rd + 16 * blk + 4 * q + e; const int pl = dir ? 127 - t : t; YL[pl * 68 + c + 16 * wq] += y[e]; } }
        __builtin_amdgcn_s_setprio(0);
        TACC(F, 14, tc_);
    }
    if (dir == 0) __syncthreads();
    T0(td_);
    __syncthreads();
    const int rbase = (isctx ? TL + b * CTX : b * SEQ) + 128 * pcl;
    bf16* mix = (bf16*)(F.ws + WS_H);
    const int o8 = F.tid & 7;
    const f32x4 lg0 = *(const f32x4*)(inp(I_LNG) + li * RW + 64 * h + 8 * o8), lg1 = *(const f32x4*)(inp(I_LNG) + li * RW + 64 * h + 8 * o8 + 4);
    const f32x4 lb0 = *(const f32x4*)(inp(I_LNB) + li * RW + 64 * h + 8 * o8), lb1 = *(const f32x4*)(inp(I_LNB) + li * RW + 64 * h + 8 * o8 + 4);
#pragma unroll
    for (int it = 0; it < 2; ++it) { const int tl = (F.tid >> 3) + 64 * it;
        const v4u gw = *(const v4u*)((const bf16*)(F.ws + WS_GATE) + (size_t)(rbase + tl) * RW + 64 * h + 8 * o8);
        const f32x4 y0 = *(const LAS f32x4*)(YL + tl * 68 + 8 * o8), y1 = *(const LAS f32x4*)(YL + tl * 68 + 8 * o8 + 4);
        const v4u vw = *(const LAS v4u*)(VB + (tl * 64 + 8 * o8) * 2); const float bon = BON[tl];
        float yv[8], gv[8], vv[8];
#pragma unroll
        for (int e = 0; e < 4; ++e) { yv[e] = y0[e]; yv[e + 4] = y1[e]; }
        unpack8(gw, gv); unpack8(vw, vv);
        float s = 0.f;
#pragma unroll
        for (int e = 0; e < 8; ++e) s += yv[e];
        const float mu = sum8(s) * (1.0f / 64.0f); float v2 = 0.f;
#pragma unroll
        for (int e = 0; e < 8; ++e) { yv[e] -= mu; v2 += yv[e] * yv[e]; }
        const float rs = __builtin_amdgcn_rsqf(sum8(v2) * (1.0f / 64.0f) + GN_EPS);
        float ov[8];
#pragma unroll
        for (int e = 0; e < 4; ++e) { ov[e] = (yv[e] * rs * lg0[e] + lb0[e] + bon * vv[e]) * gv[e]; ov[e + 4] = (yv[e + 4] * rs * lg1[e] + lb1[e] + bon * vv[e + 4]) * gv[e + 4]; }
        *(v4u*)(mix + (size_t)(rbase + tl) * DM + 640 + 64 * h + 8 * o8) = (v4u){cvtpk(ov[0], ov[1]), cvtpk(ov[2], ov[3]), cvtpk(ov[4], ov[5]), cvtpk(ov[6], ov[7])}; }
    TACC(F, 15, td_); TACC(F, 10, tu_);
}

constexpr int AT_KROW = 144;
__device__ __forceinline__ void attn_unit(Frame& F, int li, int u) {
    const bool cq = u >= 256;
    int b, kvh, qb;
    if (!cq) { b = u >> 7; kvh = (u >> 6) & 1; qb = u & 63; } else { const int uu = u - 256; b = uu >> 2; kvh = (uu >> 1) & 1; qb = uu & 1; }
    const int c = F.lane & 15, q = F.lane >> 4, tb = F.wave;
    bf16* mix = (bf16*)(F.ws + WS_H);
    const float* rct = (const float*)(F.ws + WS_ROPE); const float* rst = rct + SEQ * 32;
    const int qrow = (cq ? TL + b * CTX : b * SEQ) + 128 * qb + 16 * tb + c;
    const int qpos = 128 * qb + 16 * tb + c;
    bf16x8 Q[3][2];
    { float cs[8], sn[8];
      if (!cq) { const f32x4 c0 = *(const f32x4*)(rct + qpos * 32 + 8 * q), c1 = *(const f32x4*)(rct + qpos * 32 + 8 * q + 4), s0 = *(const f32x4*)(rst + qpos * 32 + 8 * q), s1 = *(const f32x4*)(rst + qpos * 32 + 8 * q + 4);
#pragma unroll
          for (int e = 0; e < 4; ++e) { cs[e] = c0[e]; cs[e + 4] = c1[e]; sn[e] = s0[e]; sn[e + 4] = s1[e]; } }
      else {
#pragma unroll
          for (int e = 0; e < 8; ++e) { cs[e] = 1.0f; sn[e] = 0.0f; } }
#pragma unroll
      for (int hh = 0; hh < 3; ++hh) { const bf16* zq = zrow(F, qrow) + ZQ + 64 * (3 * kvh + hh) + 8 * q; float x1[8], x2[8]; unpack8(*(const v4u*)zq, x1); unpack8(*(const v4u*)(zq + 32), x2);
          float o1[8], o2[8];
#pragma unroll
          for (int e = 0; e < 8; ++e) { o1[e] = 0.125f * (x1[e] * cs[e] - x2[e] * sn[e]); o2[e] = 0.125f * (x2[e] * cs[e] + x1[e] * sn[e]); }
          Q[hh][0] = mk8(pk2(o1[0], o1[1]), pk2(o1[2], o1[3]), pk2(o1[4], o1[5]), pk2(o1[6], o1[7])); Q[hh][1] = mk8(pk2(o2[0], o2[1]), pk2(o2[2], o2[3]), pk2(o2[4], o2[5]), pk2(o2[6], o2[7])); } }
    float m[3], l[3]; f32x4 O[3][4];
#pragma unroll
    for (int hh = 0; hh < 3; ++hh) { m[hh] = inp(I_SINK)[li * 6 + 3 * kvh + hh]; l[hh] = q == 0 ? 1.0f : 0.0f;
#pragma unroll
        for (int dt = 0; dt < 4; ++dt) O[hh][dt] = (f32x4){0.f, 0.f, 0.f, 0.f}; }
    LAS unsigned char* KI = F.lds;
#pragma unroll 1
    for (int stage = cq ? 1 : 0; stage < 2; ++stage) {
        const int nkeys = stage == 0 ? 384 : 256; const int vstride = (nkeys + 8) * 2;
        LAS unsigned char* VTI = F.lds + 384 * AT_KROW;
        const int kpos0 = 128 * (qb - 1);
        __syncthreads();
        for (int pc = F.tid; pc < nkeys * 4; pc += NTHR) { const int key = pc >> 2, o = pc & 3;
            const bf16* zk; float cs[8], sn[8];
            if (stage == 0) { int kp = kpos0 + key; kp = kp < 0 ? 0 : (kp >= SEQ ? SEQ - 1 : kp); zk = zrow(F, b * SEQ + kp) + 64 * kvh + 8 * o;
                const f32x4 c0 = *(const f32x4*)(rct + kp * 32 + 8 * o), c1 = *(const f32x4*)(rct + kp * 32 + 8 * o + 4), s0 = *(const f32x4*)(rst + kp * 32 + 8 * o), s1 = *(const f32x4*)(rst + kp * 32 + 8 * o + 4);
#pragma unroll
                for (int e = 0; e < 4; ++e) { cs[e] = c0[e]; cs[e + 4] = c1[e]; sn[e] = s0[e]; sn[e + 4] = s1[e]; } }
            else { zk = zrow(F, TL + b * CTX + key) + 64 * kvh + 8 * o;
#pragma unroll
                for (int e = 0; e < 8; ++e) { cs[e] = 1.0f; sn[e] = 0.0f; } }
            const v4u k1 = *(const v4u*)(zk + ZK), k2 = *(const v4u*)(zk + ZK + 32), v1 = *(const v4u*)(zk + ZV), v2 = *(const v4u*)(zk + ZV + 32);
            float x1[8], x2[8]; unpack8(k1, x1); unpack8(k2, x2);
            float o1[8], o2[8];
#pragma unroll
            for (int e = 0; e < 8; ++e) { o1[e] = x1[e] * cs[e] - x2[e] * sn[e]; o2[e] = x2[e] * cs[e] + x1[e] * sn[e]; }
            *(LAS v4u*)(KI + key * AT_KROW + o * 16) = (v4u){pk2(o1[0], o1[1]), pk2(o1[2], o1[3]), pk2(o1[4], o1[5]), pk2(o1[6], o1[7])};
            *(LAS v4u*)(KI + key * AT_KROW + 64 + o * 16) = (v4u){pk2(o2[0], o2[1]), pk2(o2[2], o2[3]), pk2(o2[4], o2[5]), pk2(o2[6], o2[7])};
            const int kl = key & 31; const int col = (key & ~31) | (((kl & 15) >> 2) << 3) | ((kl >> 4) << 2) | (kl & 3);
#pragma unroll
            for (int hv = 0; hv < 2; ++hv) { const v4u vv = hv ? v2 : v1; LAS bf16* vt = (LAS bf16*)(VTI + (8 * (o + 4 * hv)) * vstride) + col;
                vt[0] = (bf16)(vv.x & 0xffff); *(LAS bf16*)((LAS unsigned char*)vt + vstride) = (bf16)(vv.x >> 16);
                *(LAS bf16*)((LAS unsigned char*)vt + 2 * vstride) = (bf16)(vv.y & 0xffff); *(LAS bf16*)((LAS unsigned char*)vt + 3 * vstride) = (bf16)(vv.y >> 16);
                *(LAS bf16*)((LAS unsigned char*)vt + 4 * vstride) = (bf16)(vv.z & 0xffff); *(LAS bf16*)((LAS unsigned char*)vt + 5 * vstride) = (bf16)(vv.z >> 16);
                *(LAS bf16*)((LAS unsigned char*)vt + 6 * vstride) = (bf16)(vv.w & 0xffff); *(LAS bf16*)((LAS unsigned char*)vt + 7 * vstride) = (bf16)(vv.w >> 16); } }
        __syncthreads();
        const int npair = nkeys / 32;
        const int Q0 = 128 * qb + 16 * tb;
#pragma unroll 1
        for (int kp = 0; kp < npair; ++kp) {
            const int kb = kpos0 + 32 * kp;
            if (stage == 0 && (kb + 31 < Q0 - 128 || kb > Q0 + 143 || kb + 31 < 0 || kb >= SEQ)) continue;
            bf16x8 K[2][2], V[4];
#pragma unroll
            for (int t = 0; t < 2; ++t)
#pragma unroll
                for (int k = 0; k < 2; ++k) K[t][k] = *(const LAS bf16x8*)(KI + (32 * kp + 16 * t + c) * AT_KROW + k * 64 + q * 16);
#pragma unroll
            for (int dt = 0; dt < 4; ++dt) V[dt] = *(const LAS bf16x8*)(VTI + (16 * dt + c) * vstride + kp * 64 + q * 16);
            bool ok0[4], ok1[4];
#pragma unroll
            for (int e = 0; e < 4; ++e) { const int k0 = kb + 4 * q + e, k1 = k0 + 16;
                ok0[e] = stage == 1 || (k0 >= 0 && k0 < SEQ && k0 >= qpos - 128 && k0 <= qpos + 128);
                ok1[e] = stage == 1 || (k1 >= 0 && k1 < SEQ && k1 >= qpos - 128 && k1 <= qpos + 128); }
#pragma unroll
            for (int hh = 0; hh < 3; ++hh) {
                f32x4 s0 = {0.f, 0.f, 0.f, 0.f}, s1 = {0.f, 0.f, 0.f, 0.f};
                s0 = MFMA16(K[0][0], Q[hh][0], s0); s0 = MFMA16(K[0][1], Q[hh][1], s0);
                s1 = MFMA16(K[1][0], Q[hh][0], s1); s1 = MFMA16(K[1][1], Q[hh][1], s1);
                float mx = -INFINITY;
#pragma unroll
                for (int e = 0; e < 4; ++e) { s0[e] = ok0[e] ? s0[e] : -INFINITY; s1[e] = ok1[e] ? s1[e] : -INFINITY; mx = fmaxf(mx, fmaxf(s0[e], s1[e])); }
                mx = xrow_max(mx);
                const float mn = fmaxf(m[hh], mx); const float alpha = __expf(m[hh] - mn); m[hh] = mn;
                float ps = 0.f;
#pragma unroll
                for (int e = 0; e < 4; ++e) { s0[e] = __expf(s0[e] - mn); s1[e] = __expf(s1[e] - mn); ps += s0[e] + s1[e]; }
                l[hh] = l[hh] * alpha + ps;
                const bf16x8 P = mk8(cvtpk(s0[0], s0[1]), cvtpk(s0[2], s0[3]), cvtpk(s1[0], s1[1]), cvtpk(s1[2], s1[3]));
#pragma unroll
                for (int dt = 0; dt < 4; ++dt) { O[hh][dt] = O[hh][dt] * alpha; O[hh][dt] = MFMA16(V[dt], P, O[hh][dt]); }
            }
        }
    }
#pragma unroll
    for (int hh = 0; hh < 3; ++hh) { const float lt = xrow_sum(l[hh]); const float inv = __builtin_amdgcn_rcpf(lt);
#pragma unroll
        for (int dt = 0; dt < 4; ++dt) { v2u w; w.x = pk2(O[hh][dt][0] * inv, O[hh][dt][1] * inv); w.y = pk2(O[hh][dt][2] * inv, O[hh][dt][3] * inv);
            *(v2u*)(mix + (size_t)qrow * DM + 256 + 64 * (3 * kvh + hh) + 16 * dt + 4 * q) = w; } }
}

__device__ __forceinline__ void fourier_tables(Frame& F) {
    bf16* t = (bf16*)(F.ws + WS_FT);
    for (int i = F.bid * NTHR + F.tid; i < 64 * 64; i += F.G * NTHR) { const int r = i >> 6, cc = i & 63; const float a = (float)((r * cc) & 63) * (1.0f / 64.0f);
        const float cs = __builtin_amdgcn_cosf(a), sn = __builtin_amdgcn_sinf(a);
        t[FT_W64C / 2 + i] = (bf16)f2bf(cs); t[FT_W64S / 2 + i] = (bf16)f2bf(sn);
        const int pj = (cc & ~31) | (((cc & 15) >> 2) << 3) | (((cc >> 4) & 1) << 2) | (cc & 3);
        t[FT_T64C / 2 + r * 64 + pj] = (bf16)f2bf(cs); t[FT_T64S / 2 + r * 64 + pj] = (bf16)f2bf(sn); }
    for (int i = F.bid * NTHR + F.tid; i < 128 * 128; i += F.G * NTHR) { const int r = i >> 7, cc = i & 127; const float a = (float)((r * cc) & 127) * (1.0f / 128.0f);
        t[FT_W128C / 2 + i] = (bf16)f2bf(__builtin_amdgcn_cosf(a)); t[FT_W128S / 2 + i] = (bf16)f2bf(__builtin_amdgcn_sinf(a)); }
}
__device__ __forceinline__ void fourier_a_fast(Frame& F, int u) {
    const int b = u >> 7, n2 = u & 127, c = F.lane & 15, q = F.lane >> 4;
    LAS unsigned char* IMG = F.lds;
    __syncthreads();
    for (int pc = F.tid; pc < 64 * 32; pc += NTHR) { const int n1 = pc >> 5, c8 = pc & 31;
        const v4u v = *(const v4u*)(zrow(F, b * SEQ + 128 * n1 + n2) + ZF + 8 * c8);
        LAS bf16* d = (LAS bf16*)(IMG + (8 * c8) * 144) + n1;
        d[0] = (bf16)(v.x & 0xffff); d[72] = (bf16)(v.x >> 16); d[144] = (bf16)(v.y & 0xffff); d[216] = (bf16)(v.y >> 16);
        d[288] = (bf16)(v.z & 0xffff); d[360] = (bf16)(v.z >> 16); d[432] = (bf16)(v.w & 0xffff); d[504] = (bf16)(v.w >> 16); }
    __syncthreads();
    const bf16* wc = (const bf16*)(F.ws + WS_FT + FT_W64C); const bf16* wsn = (const bf16*)(F.ws + WS_FT + FT_W64S);
    bf16* far = (bf16*)((unsigned char*)F.out + OUT_FA); bf16* fai = far + (size_t)NB * 64 * 128 * 256;
    bf16x8 Bc[4][2], Bs[4][2];
#pragma unroll
    for (int kt = 0; kt < 4; ++kt)
#pragma unroll
        for (int k = 0; k < 2; ++k) { Bc[kt][k] = *(const bf16x8*)(wc + (16 * kt + c) * 64 + 32 * k + 8 * q); Bs[kt][k] = *(const bf16x8*)(wsn + (16 * kt + c) * 64 + 32 * k + 8 * q); }
#pragma unroll
    for (int ci = 0; ci < 2; ++ci) { const int ct = 2 * F.wave + ci;
        bf16x8 A[2];
#pragma unroll
        for (int k = 0; k < 2; ++k) A[k] = *(const LAS bf16x8*)(IMG + (16 * ct + c) * 144 + k * 64 + q * 16);
#pragma unroll
        for (int kt = 0; kt < 4; ++kt) { f32x4 sr = {0.f, 0.f, 0.f, 0.f}, si = {0.f, 0.f, 0.f, 0.f};
#pragma unroll
            for (int k = 0; k < 2; ++k) { sr = MFMA16(A[k], Bc[kt][k], sr); si = MFMA16(A[k], Bs[kt][k], si); }
            const int k1 = 16 * kt + c; const float tw = (float)(n2 * k1) * (1.0f / 8192.0f); const float tc = __builtin_amdgcn_cosf(tw), ts = __builtin_amdgcn_sinf(tw);
            float xr[4], xi[4];
#pragma unroll
            for (int e = 0; e < 4; ++e) { const float ar = sr[e], ai = -si[e]; xr[e] = ar * tc + ai * ts; xi[e] = ai * tc - ar * ts; }
            const size_t o = (((size_t)b * 64 + k1) * 128 + n2) * 256 + 16 * ct + 4 * q;
            v2u w; w.x = pk2(xr[0], xr[1]); w.y = pk2(xr[2], xr[3]); *(v2u*)(far + o) = w; w.x = pk2(xi[0], xi[1]); w.y = pk2(xi[2], xi[3]); *(v2u*)(fai + o) = w; } }
}
__device__ __forceinline__ void fourier_c_fast(Frame& F, int u) {
    const int g = u & 3, k1 = (u >> 2) & 63, b = u >> 8, c = F.lane & 15, q = F.lane >> 4;
    LAS unsigned char* IR = F.lds; LAS unsigned char* II = F.lds + 64 * 272;
    const bf16* far = (const bf16*)((unsigned char*)F.out + OUT_FA) + (((size_t)b * 64 + k1) * 128) * 256 + 64 * g; const bf16* fai = far + (size_t)NB * 64 * 128 * 256;
    __syncthreads();
    for (int pc = F.tid; pc < 128 * 8; pc += NTHR) { const int n2 = pc >> 3, c8 = pc & 7;
        const v4u vr = *(const v4u*)(far + (size_t)n2 * 256 + 8 * c8), vi = *(const v4u*)(fai + (size_t)n2 * 256 + 8 * c8);
        LAS bf16* dr = (LAS bf16*)(IR + (8 * c8) * 272) + n2; LAS bf16* di = (LAS bf16*)(II + (8 * c8) * 272) + n2;
        dr[0] = (bf16)(vr.x & 0xffff); dr[136] = (bf16)(vr.x >> 16); dr[272] = (bf16)(vr.y & 0xffff); dr[408] = (bf16)(vr.y >> 16);
        dr[544] = (bf16)(vr.z & 0xffff); dr[680] = (bf16)(vr.z >> 16); dr[816] = (bf16)(vr.w & 0xffff); dr[952] = (bf16)(vr.w >> 16);
        di[0] = (bf16)(vi.x & 0xffff); di[136] = (bf16)(vi.x >> 16); di[272] = (bf16)(vi.y & 0xffff); di[408] = (bf16)(vi.y >> 16);
        di[544] = (bf16)(vi.z & 0xffff); di[680] = (bf16)(vi.z >> 16); di[816] = (bf16)(vi.w & 0xffff); di[952] = (bf16)(vi.w >> 16); }
    __syncthreads();
    const bf16* wc = (const bf16*)(F.ws + WS_FT + FT_W128C); const bf16* wsn = (const bf16*)(F.ws + WS_FT + FT_W128S);
    const bf16* tcn = (const bf16*)(F.ws + WS_FT + FT_T64C); const bf16* tsn = (const bf16*)(F.ws + WS_FT + FT_T64S);
    f32x4 Pr[4], Pi[4];
#pragma unroll
    for (int ct = 0; ct < 4; ++ct) { Pr[ct] = (f32x4){0.f, 0.f, 0.f, 0.f}; Pi[ct] = (f32x4){0.f, 0.f, 0.f, 0.f}; }
#pragma unroll
    for (int k = 0; k < 4; ++k) { const bf16x8 bc = *(const bf16x8*)(wc + (16 * F.wave + c) * 128 + 32 * k + 8 * q), bs = *(const bf16x8*)(wsn + (16 * F.wave + c) * 128 + 32 * k + 8 * q);
        const v4u bsu = __builtin_bit_cast(v4u, bs); const bf16x8 bsn = mk8(bsu.x ^ 0x80008000u, bsu.y ^ 0x80008000u, bsu.z ^ 0x80008000u, bsu.w ^ 0x80008000u);
#pragma unroll
        for (int ct = 0; ct < 4; ++ct) { const bf16x8 ar = *(const LAS bf16x8*)(IR + (16 * ct + c) * 272 + k * 64 + q * 16), ai = *(const LAS bf16x8*)(II + (16 * ct + c) * 272 + k * 64 + q * 16);
            Pr[ct] = MFMA16(ar, bc, Pr[ct]); Pr[ct] = MFMA16(ai, bs, Pr[ct]); Pi[ct] = MFMA16(ai, bc, Pi[ct]); Pi[ct] = MFMA16(ar, bsn, Pi[ct]); } }
    bf16x8 Br[2], Bi[2];
#pragma unroll
    for (int k = 0; k < 2; ++k) { Br[k] = mk8(cvtpk(Pr[2 * k][0], Pr[2 * k][1]), cvtpk(Pr[2 * k][2], Pr[2 * k][3]), cvtpk(Pr[2 * k + 1][0], Pr[2 * k + 1][1]), cvtpk(Pr[2 * k + 1][2], Pr[2 * k + 1][3]));
        Bi[k] = mk8(cvtpk(Pi[2 * k][0], Pi[2 * k][1]), cvtpk(Pi[2 * k][2], Pi[2 * k][3]), cvtpk(Pi[2 * k + 1][0], Pi[2 * k + 1][1]), cvtpk(Pi[2 * k + 1][2], Pi[2 * k + 1][3])); }
    bf16* mix = (bf16*)(F.ws + WS_H);
    const float scale = 0.0013810679320049757f;
    const int k2 = 16 * F.wave + c; const size_t row = (size_t)b * SEQ + k1 + 64 * k2;
#pragma unroll
    for (int mt = 0; mt < 4; ++mt) { f32x4 y = {0.f, 0.f, 0.f, 0.f};
#pragma unroll
        for (int k = 0; k < 2; ++k) { const bf16x8 ac = *(const bf16x8*)(tcn + (16 * mt + c) * 64 + 32 * k + 8 * q), as = *(const bf16x8*)(tsn + (16 * mt + c) * 64 + 32 * k + 8 * q);
            y = MFMA16(ac, Br[k], y); y = MFMA16(as, Bi[k], y); }
        v2u w; w.x = pk2(y[0] * scale, y[1] * scale); w.y = pk2(y[2] * scale, y[3] * scale);
        *(v2u*)(mix + row * DM + 64 * g + 16 * mt + 4 * q) = w; }
}

#define XB_TMO      128
#define XB_XCNT(j)  (256  + 64 * (j))
#define XB_XSUB(j)  (1280 + 64 * (j))
#define XB_XGEN(j)  (2304 + 64 * (j))
#define XB_TOP      3328
#define XB_TOPGEN   3392
#define XCD_BAR_WORDS 3456
#define XB_SPIN_CAP (1u << 23)
__device__ __forceinline__ unsigned xb_ld(unsigned* p)              { return __hip_atomic_load(p, __ATOMIC_RELAXED, __HIP_MEMORY_SCOPE_AGENT); }
__device__ __forceinline__ unsigned xb_add(unsigned* p, unsigned v) { return __hip_atomic_fetch_add(p, v, __ATOMIC_RELAXED, __HIP_MEMORY_SCOPE_AGENT); }
__device__ __forceinline__ unsigned xb_xcc_id() { return (unsigned)__builtin_amdgcn_s_getreg((3 << 11) | 20) & 0xFu; }
#define XB_SPIN(cond, bar) do { unsigned _sp = 0; while (cond) { __builtin_amdgcn_s_sleep(1); \
    if ((++_sp & 255u) == 0u) { if (xb_ld(&(bar)[XB_TMO])) break; if (_sp > XB_SPIN_CAP) { atomicAdd(&(bar)[XB_TMO], 1u); break; } } } } while (0)
struct XcdBarrier { unsigned* bar; unsigned x; volatile LAS unsigned* st; };
__device__ __forceinline__ XcdBarrier xcd_barrier_post(unsigned* bar, volatile LAS unsigned* st) {
    XcdBarrier b; b.bar = bar; b.x = xb_xcc_id(); b.st = st;
    if (threadIdx.x == 0) (void)xb_add(&bar[XB_XCNT(b.x)], 1u);
    return b;
}
__device__ __forceinline__ void xcd_barrier_complete(unsigned* bar, unsigned x, unsigned& nloc, unsigned& nx) {
    const unsigned G = gridDim.x * gridDim.y * gridDim.z;
    unsigned sum, cnt, mine, sp = 0u;
    for (;;) {
        sum = 0u; cnt = 0u; mine = 0u;
#pragma unroll
        for (unsigned j = 0; j < 16; ++j) { const unsigned c = xb_ld(&bar[XB_XCNT(j)]); sum += c; cnt += (c > 0u) ? 1u : 0u; mine = (j == x) ? c : mine; }
        if (sum == G) break;
        __builtin_amdgcn_s_sleep(1);
        if ((++sp & 255u) == 0u) { if (xb_ld(&bar[XB_TMO])) break; if (sp > XB_SPIN_CAP) { atomicAdd(&bar[XB_TMO], 1u); break; } }
    }
    nloc = mine > 0u ? mine : 1u; nx = cnt > 0u ? cnt : 1u;
}
__device__ __forceinline__ void xcd_barrier(const XcdBarrier& b0) {
    XcdBarrier b; { unsigned* p = b0.bar; unsigned x = __builtin_amdgcn_readfirstlane(b0.x); unsigned st = (unsigned)(size_t)b0.st; asm volatile("" : "+s"(p), "+s"(x), "+s"(st)); b.bar = p; b.x = x; b.st = (volatile LAS unsigned*)(size_t)st; }
    asm volatile("s_waitcnt vmcnt(0)" ::: "memory");
    __syncthreads();
    if (threadIdx.x == 0) {
        unsigned* bar = b.bar;
        __builtin_amdgcn_s_waitcnt(0);
        unsigned nloc = b.st[0], nx = b.st[1];
        if (nloc == 0u) { xcd_barrier_complete(bar, b.x, nloc, nx); b.st[0] = nloc; b.st[1] = nx; }
        const unsigned old = xb_add(&bar[XB_XSUB(b.x)], 1u);
        const unsigned gen = old / nloc;
        if (old + 1u == (gen + 1u) * nloc) {
            __builtin_amdgcn_fence(__ATOMIC_RELEASE, "agent");
            asm volatile("s_waitcnt vmcnt(0)" ::: "memory");
            const unsigned og = xb_add(&bar[XB_TOP], 1u);
            const unsigned tg = og / nx;
            if (og + 1u == (tg + 1u) * nx) xb_add(&bar[XB_TOPGEN], 1u);
            else XB_SPIN(xb_ld(&bar[XB_TOPGEN]) == tg, bar);
            __builtin_amdgcn_fence(__ATOMIC_ACQUIRE, "agent");
            xb_add(&bar[XB_XGEN(b.x)], 1u);
            asm volatile("s_waitcnt vmcnt(0)" ::: "memory");
        } else {
            XB_SPIN(xb_ld(&bar[XB_XGEN(b.x)]) == gen, bar);
            __builtin_amdgcn_fence(__ATOMIC_ACQUIRE, "agent");
            asm volatile("s_waitcnt vmcnt(0)" ::: "memory");
        }
    }
    __syncthreads();
}

__device__ __forceinline__ int queue_next(Frame& F, unsigned* cnt) {
    volatile LAS int* slot = (volatile LAS int*)(F.lds + MISC_OFF + 64);
    __syncthreads();
    if (F.tid == 0) *slot = (int)__hip_atomic_fetch_add(cnt, 1u, __ATOMIC_RELAXED, __HIP_MEMORY_SCOPE_AGENT);
    __syncthreads();
    return *slot;
}
template <int KIND> __device__ __forceinline__ void run_phase(const Frame& F0, int li, int second) {
    Frame F;
    { int t = threadIdx.x; asm volatile("" : "+v"(t)); F.tid = t; F.lane = t & 63; F.wave = __builtin_amdgcn_readfirstlane(t >> 6);
      int g = F0.G, b = F0.bid; asm volatile("" : "+s"(g), "+s"(b)); F.G = g; F.bid = b;
      __attribute__((address_space(1))) unsigned char* w = (__attribute__((address_space(1))) unsigned char*)F0.ws; __attribute__((address_space(1))) float* o = (__attribute__((address_space(1))) float*)F0.out;
      asm volatile("" : "+s"(w), "+s"(o)); F.ws = (unsigned char*)w; F.out = (float*)o;
      unsigned l = (unsigned)(size_t)F0.lds; asm volatile("" : "+s"(l)); F.lds = (LAS unsigned char*)(size_t)l;
      asm volatile("" : "+s"(li), "+s"(second)); }
    float* modv = (float*)(F.ws + WS_MOD);
    bf16* XB = (bf16*)(F.ws + WS_XB);
    bf16* H = (bf16*)(F.ws + WS_H); bf16* ACT = (bf16*)(F.ws + WS_ACT); bf16* O = (bf16*)(F.ws + WS_O);
    const float* ng = inp(I_NORMG) + (size_t)li * 6 * DM; const float* mv = modv + (size_t)li * 3 * 9216;
    const bool last = li == 1;
    if constexpr (KIND == 100) { convert_weights(F, 0); mod_gemv(F); rope_tables(F); lora_transposes(F); fourier_tables(F); }
    if constexpr (KIND == 101) { EArgs A{}; A.xl_src = inp(I_X); A.xc_src = inp(I_CTX); A.o = nullptr; A.hdst = H; A.modv_h = modv; A.shidx = 0; A.scidx = 1; A.gpre = inp(I_NORMG); A.nrows = TT; e_phase(F, A); }
    if constexpr (KIND == 0) {
        const bf16* wi = (const bf16*)(F.ws + (second ? WS_WI2 : WS_WI1)); const bool withctx = !(last && second);
        if (!withctx || F.G != 256) { pg8::Gemm g{H, wi, withctx ? TT : TL, NWI, DM}; pg8::StaticOrder S; S.init(g.M, g.N, F.G, F.bid);
            pg8::EpiSwiglu E{ACT, FFNP}; pg8::gemm_phase<pg8::EpiSwiglu, pg8::StaticOrder, true, true>(F.lds, g, S, E, F.tid); }
        else { unsigned* cnt = (unsigned*)(F.ws + WS_CTL) + 8192 + 64 * (li * 2 + second);
            pg8::Gemm g{H, wi, TT, NWI, DM}; pg8::UpOrder S; S.init(NWI, F.G, F.bid, cnt);
            pg8::EpiSwiglu E{ACT, FFNP}; pg8::gemm_phase<pg8::EpiSwiglu, pg8::UpOrder, true, true>(F.lds, g, S, E, F.tid);
            if (F.bid >= 248) {
                if (F.tid == 0) { unsigned sp = 0; while (__hip_atomic_load(cnt, __ATOMIC_RELAXED, __HIP_MEMORY_SCOPE_AGENT) < 352u && ++sp < (1u << 24)) __builtin_amdgcn_s_sleep(8);
                    __builtin_amdgcn_fence(__ATOMIC_ACQUIRE, "agent"); asm volatile("s_waitcnt vmcnt(0)" ::: "memory"); }
                __syncthreads();
                const int k = F.bid - 248; pg8::Gemm g2{ACT, (const bf16*)(F.ws + (second ? WS_WO2 : WS_WO1)), TT, DM, FFNP}; pg8::OneUnit S2{64 + (k >> 2), k & 3};
                pg8::EpiBf16 E2{O, DM}; pg8::gemm_phase<pg8::EpiBf16, pg8::OneUnit, false, true>(F.lds, g2, S2, E2, F.tid); } } }
    if constexpr (KIND == 1) {
        const bool ctxhere = F.G != 256 && !(last && second);
        pg8::Gemm g{ACT, (const bf16*)(F.ws + (second ? WS_WO2 : WS_WO1)), ctxhere ? TT : TL, DM, FFNP}; pg8::StaticOrder S; S.init(g.M, g.N, F.G, F.bid);
        pg8::EpiBf16 E{O, DM}; pg8::gemm_phase<pg8::EpiBf16, pg8::StaticOrder, true, true>(F.lds, g, S, E, F.tid); }
    if constexpr (KIND == 2) {
        EArgs A{}; A.xl_src = inp(I_X); A.xc_src = inp(I_CTX); A.xb_src = li == 0 ? (const bf16*)nullptr : XB; A.xb_dst = XB; A.o = O; A.modv_g = mv; A.gidx = 2; A.gmul = 0.5f; A.gpost = ng + 1 * DM;
        A.hdst = H; A.modv_h = mv; A.shidx = 3; A.scidx = 4; A.gpre = ng + 2 * DM; A.nrows = TT; e_phase(F, A); }
    if constexpr (KIND == 3) {
        pg8::Gemm g{H, (const bf16*)(F.ws + WS_WIN), TT, INWP, DM}; pg8::StaticOrder S; S.init(g.M, g.N, F.G, F.bid);
        pg8::EpiBf16 E{ACT, INWP}; pg8::gemm_phase<pg8::EpiBf16, pg8::StaticOrder, true, true>(F.lds, g, S, E, F.tid); }
    if constexpr (KIND == 4) {
        { T0(t40_); lora_pass(F, li); TACC(F, 40, t40_); }
        { T0(t43_); gate_pass(F, li); TACC(F, 43, t43_); }
        { T0(t41_); for (int u = F.bid; u < 256; u += F.G) fourier_a_fast(F, u); TACC(F, 41, t41_); }
        { T0(t42_); if (li == 0) fourier_ctx1_all(F); TACC(F, 42, t42_); } }
    if constexpr (KIND == 5) {
        unsigned* cnt = (unsigned*)(F.ws + WS_CTL) + 8192 + 64 * (4 + 2 * li);
        const int na = li == 0 ? 264 : 256;
        { T0(t50_); for (int it = queue_next(F, cnt); it < na; it = queue_next(F, cnt)) attn_unit(F, li, it); TACC(F, 50, t50_); }
        { T0(t51_); for (int it = queue_next(F, cnt + 16); it < 12 * (NSC - 1); it = queue_next(F, cnt + 16)) rwkv_pass1_pair(F, li, it); TACC(F, 51, t51_); } }
    if constexpr (KIND == 11) {
        if (F.bid < 96) { T0(tp_); const int xcd = F.bid & 7, slot = F.bid >> 3; rwkv_pass2_part(F, (slot >> 2) * 8 + xcd, slot & 3); TACC(F, 30, tp_); }
        else { T0(tq_); convert_weights(F, 1, li == 0 ? 1 : 2, 96, F.G - 96);
            TACC(F, 31, tq_); T0(tr_);
            if (li == 0) fourier_ctx2_all(F, 96); TACC(F, 32, tr_); } }
    if constexpr (KIND == 12) {
        unsigned* cnt = (unsigned*)(F.ws + WS_CTL) + 8192 + 64 * (5 + 2 * li);
        const int np3 = li == 0 ? 12 * NSC : 12 * 64;
        { T0(t60_); for (int it = queue_next(F, cnt); it < np3; it = queue_next(F, cnt)) rwkv_pass3_unit(F, li, li == 0 ? it : (it / 64) * NSC + 2 + it % 64); TACC(F, 60, t60_); }
        { T0(t61_); for (int it = queue_next(F, cnt + 16); it < 512; it = queue_next(F, cnt + 16)) fourier_c_fast(F, it); TACC(F, 61, t61_); } }
    if constexpr (KIND == 6) {
        pg8::Gemm g{H, (const bf16*)(F.ws + WS_WOUT), last ? TL : TT, DM, DM}; pg8::StaticOrder S; S.init(g.M, g.N, F.G, F.bid);
        pg8::EpiBf16 E{O, DM}; pg8::gemm_phase<pg8::EpiBf16, pg8::StaticOrder, true, true>(F.lds, g, S, E, F.tid); }
    if constexpr (KIND == 7) {
        EArgs A{}; A.xb_src = XB; A.xb_dst = XB; A.o = O; A.modv_g = mv; A.gidx = 5; A.gmul = 1.0f; A.gpost = ng + 3 * DM;
        A.hdst = H; A.modv_h = mv; A.shidx = 6; A.scidx = 7; A.gpre = ng + 4 * DM; A.nrows = last ? TL : TT; e_phase(F, A); }
    if constexpr (KIND == 10) {
        EArgs A{}; A.xb_src = XB; A.xb_dst = XB; A.out32 = last ? F.out : (float*)nullptr; A.o = O; A.modv_g = mv; A.gidx = 8; A.gmul = 0.5f; A.gpost = ng + 5 * DM;
        if (!last) { A.hdst = H; A.modv_h = mv + 3 * 9216; A.shidx = 0; A.scidx = 1; A.gpre = ng + 6 * DM; }
        A.nrows = last ? TL : TT; e_phase(F, A);
        }
}
__global__ void __launch_bounds__(NTHR, 2) mega_one(Args args) {
    extern __shared__ __attribute__((aligned(16))) unsigned char lds[];
    Frame F; F.lds = (LAS unsigned char*)lds; F.tid = threadIdx.x; F.lane = F.tid & 63; F.wave = __builtin_amdgcn_readfirstlane(F.tid >> 6); F.G = gridDim.x; F.bid = blockIdx.x;
    F.out = args.out; F.ws = args.ws;
    volatile LAS unsigned* MISC = (volatile LAS unsigned*)(F.lds + MISC_OFF);
    if (F.tid < 32) MISC[F.tid] = 0u;
    __syncthreads();
    XcdBarrier bar = xcd_barrier_post((unsigned*)(F.ws + WS_CTL) + 4096, MISC + 8);
#define GRID_BAR() xcd_barrier(bar)
#define PH(K, li, sec) { T0(t_); run_phase<K>(F, li, sec); TACC(F, 100 + K + 20 * sec, t_); T0(u_); GRID_BAR(); TACC(F, 300 + K + 20 * sec, u_); }
    PH(100, 0, 0)
    PH(101, 0, 0)
#pragma unroll 1
    for (int li = 0; li < 2; ++li) {
        PH(0, li, 0)
        PH(1, li, 0)
        PH(2, li, 0)
        PH(3, li, 0)
        PH(4, li, 0)
        PH(5, li, 0)
        PH(11, li, 0)
        PH(12, li, 0)
        PH(6, li, 0)
        PH(7, li, 0)
        PH(0, li, 1)
        PH(1, li, 1)
        PH(10, li, 0)
    }
#if TPROBE >= 0
    if (F.tid == 0) { atomicAdd((unsigned*)(F.ws + WS_CTL) + 12288, MISC[24]); atomicAdd((unsigned*)(F.ws + WS_CTL) + 12289, MISC[25]); }
    GRID_BAR();
    if (F.bid == 0) { const unsigned t1 = __hip_atomic_load((unsigned*)(F.ws + WS_CTL) + 12288, __ATOMIC_RELAXED, __HIP_MEMORY_SCOPE_AGENT), t2 = __hip_atomic_load((unsigned*)(F.ws + WS_CTL) + 12289, __ATOMIC_RELAXED, __HIP_MEMORY_SCOPE_AGENT);
        const float v1 = (float)t1 * (1.0f / 25600.0f), v2 = TPROBE2 >= 0 ? (float)t2 * (1.0f / 25600.0f) : 100.0f;
        if (F.tid == 0) F.out[0] += v1 * (1.0f / TSCALE);
        (void)v2; }
#endif
}

extern "C" void kernel_launch(void* const* d_in, const int* in_sizes, int n_in, void* d_out, int out_size, void* d_ws, size_t ws_size, hipStream_t stream) {
    static int ready = 0;
    if (!ready) {
        if (n_in != 25 || out_size != TL * DM || ws_size < WS_END) { fprintf(stderr, "kernel_launch: unexpected shapes (n_in %d out %d ws %zu)\n", n_in, out_size, ws_size); ready = -1; return; }
        if (hipFuncSetAttribute((const void*)mega_one, hipFuncAttributeMaxDynamicSharedMemorySize, LDS_BYTES) != hipSuccess) { fprintf(stderr, "kernel_launch: hipFuncSetAttribute failed\n"); ready = -1; return; }
        int dev = 0, cus = 0; if (hipGetDevice(&dev) != hipSuccess || hipDeviceGetAttribute(&cus, hipDeviceAttributeMultiprocessorCount, dev) != hipSuccess || cus < 32) cus = 256;
        ready = cus < 256 ? cus : 256;
    }
    if (ready < 0) return;
    if (hipMemsetAsync((char*)d_ws + WS_CTL, 0, 65536, stream) != hipSuccess) { fprintf(stderr, "kernel_launch: memset failed\n"); return; }
    Args a{};
    for (int i = 0; i < 25; ++i) a.in[i] = (const float*)d_in[i];
    a.out = (float*)d_out; a.ws = (unsigned char*)d_ws;
    hipLaunchKernelGGL(mega_one, dim3(ready), dim3(NTHR), LDS_BYTES, stream, a);
}
```

```cpp
#include <hip/hip_runtime.h>
#include <cstdio>
#include <cstdint>

namespace pg8 {
#define PG8_LAS __attribute__((address_space(3)))
typedef unsigned short bf16_t;
typedef short bf16x8 __attribute__((ext_vector_type(8)));
typedef float f32x4 __attribute__((ext_vector_type(4)));
typedef unsigned u32x4 __attribute__((ext_vector_type(4)));
constexpr int BM = 256, BK = 64, HALF = 128, HTB = HALF * BK * 2, STAGE_BYTES = 8 * HTB, NXCD = 8, WGM = 8;

__host__ __device__ __forceinline__ int lds_byte(int r, int c) { const int st = (r >> 4) * 2 + (c >> 5), rr = r & 15, cc = c & 31, ob = rr * 64 + cc * 2; return st * 1024 + (ob ^ (((ob >> 9) & 1) << 5)); }
__host__ __device__ __forceinline__ void stage_rc(int b, int& R, int& C) { const int st = b / 1024, sb = b % 1024, swz = sb ^ (((sb >> 9) & 1) << 5); R = (st >> 1) * 16 + swz / 64; C = (st & 1) * 32 + (swz % 64) / 2; }
__host__ __device__ __forceinline__ int perm32(int rho) { const int n = rho >> 4, i = rho & 15; return 8 * (i >> 2) + 4 * n + (i & 3); }

struct Unit { int pm, pn; };
struct Gemm { const bf16_t* A; const bf16_t* Bt; int M, N, K; };

struct StaticOrder {
    int nM, nN, nwg, G, c;
    __host__ __device__ void init(int M, int N, int G_, int c_) { nM = M / BM; nN = N / BM; nwg = nM * nN; G = G_; c = c_; }
    __host__ __device__ bool next(int i, Unit& u) const {
        const long L = (long)i * G + c; if (L >= nwg) return false;
        int wgid = (int)L; { const int q = nwg / NXCD, r = nwg % NXCD, xcd = wgid % NXCD, off = wgid / NXCD; wgid = (xcd < r ? xcd * (q + 1) : r * (q + 1) + (xcd - r) * q) + off; }
        const int nig = WGM * nN, gid = wgid / nig, fm = gid * WGM, gsz = (nM - fm) < WGM ? (nM - fm) : WGM;
        u.pm = fm + ((wgid % nig) % gsz); u.pn = (wgid % nig) / gsz; return true;
    }
    __device__ __forceinline__ void a_ready(const Unit&) const {}
    __device__ __forceinline__ void done(const Unit&) const {}
};

struct UpOrder {
    StaticOrder lat; int G, c, nN; unsigned* cnt;
    __device__ void init(int N, int G_, int c_, unsigned* cnt_) { lat.init(16384, N, G_, c_); G = G_; c = c_; nN = N / BM; cnt = cnt_; }
    __device__ bool next(int i, Unit& u) const {
        const int nctx = 2 * nN, total = nctx + lat.nwg;
        long L;
        if (G != 256) L = (long)i * G + c;
        else if (c >= 248) { if (i >= 3) return false; L = (long)i * G + c; }
        else if (c >= 172 && c < 188 && i == 5) L = (long)(3 + (c - 172) / 8) * G + 248 + (c - 172) % 8;
        else L = (long)i * G + c;
        if (L >= total) return false;
        if (L < nctx) { u.pm = 64 + (int)L / nN; u.pn = (int)L % nN; return true; }
        int wgid = (int)L - nctx; { const int nwg = lat.nwg, q = nwg / NXCD, r = nwg % NXCD, xcd = wgid % NXCD, off = wgid / NXCD; wgid = (xcd < r ? xcd * (q + 1) : r * (q + 1) + (xcd - r) * q) + off; }
        const int nig = WGM * nN, gid = wgid / nig, fm = gid * WGM, gsz = (lat.nM - fm) < WGM ? (lat.nM - fm) : WGM;
        u.pm = fm + ((wgid % nig) % gsz); u.pn = (wgid % nig) / gsz; return true;
    }
    __device__ __forceinline__ void a_ready(const Unit&) const {}
    __device__ __forceinline__ void done(const Unit& u) const {
        if (u.pm >= 64) { asm volatile("s_waitcnt vmcnt(0)" ::: "memory"); __builtin_amdgcn_fence(__ATOMIC_RELEASE, "agent"); asm volatile("s_waitcnt vmcnt(0)" ::: "memory");
            if ((threadIdx.x & 63) == 0) __hip_atomic_fetch_add(cnt, 1u, __ATOMIC_RELAXED, __HIP_MEMORY_SCOPE_AGENT); }
    }
};
struct OneUnit {
    int pm, pn;
    __device__ bool next(int i, Unit& u) const { if (i != 0) return false; u.pm = pm; u.pn = pn; return true; }
    __device__ __forceinline__ void a_ready(const Unit&) const {}
    __device__ __forceinline__ void done(const Unit&) const {}
};

__device__ __forceinline__ unsigned cvt_pk_bf16(float lo, float hi) { unsigned r; asm volatile("v_cvt_pk_bf16_f32 %0, %1, %2" : "=v"(r) : "v"(lo), "v"(hi)); return r; }

struct EpiBf16 {
    static constexpr bool PERM = true, AFTER_DRAIN = false;
    bf16_t* O; int ldc;
    __device__ __forceinline__ void operator()(const f32x4 (&acc)[2][2][4][2], const Unit& u, int wr, int wc, int fr, int fq) const {
        const int row0 = u.pm * BM + wr * 64 + fr; const int col0 = u.pn * BM + wc * 32 + 8 * fq;
#pragma unroll
        for (int ai = 0; ai < 2; ++ai)
#pragma unroll
            for (int m = 0; m < 4; ++m) { bf16_t* rowp = O + (size_t)(row0 + ai * HALF + m * 16) * ldc + col0;
#pragma unroll
                for (int bj = 0; bj < 2; ++bj) { const f32x4 v0 = acc[ai][bj][m][0], v1 = acc[ai][bj][m][1];
                    u32x4 w; w.x = cvt_pk_bf16(v0[0], v0[1]); w.y = cvt_pk_bf16(v0[2], v0[3]); w.z = cvt_pk_bf16(v1[0], v1[1]); w.w = cvt_pk_bf16(v1[2], v1[3]);
                    *(u32x4*)(rowp + bj * HALF) = w; } }
    }
};
struct EpiF32 {
    static constexpr bool PERM = true, AFTER_DRAIN = false;
    float* O; int ldc;
    __device__ __forceinline__ void operator()(const f32x4 (&acc)[2][2][4][2], const Unit& u, int wr, int wc, int fr, int fq) const {
        const int row0 = u.pm * BM + wr * 64 + fr; const int col0 = u.pn * BM + wc * 32 + 8 * fq;
#pragma unroll
        for (int ai = 0; ai < 2; ++ai)
#pragma unroll
            for (int m = 0; m < 4; ++m) { float* rowp = O + (size_t)(row0 + ai * HALF + m * 16) * ldc + col0;
#pragma unroll
                for (int bj = 0; bj < 2; ++bj) { *(f32x4*)(rowp + bj * HALF) = acc[ai][bj][m][0]; *(f32x4*)(rowp + bj * HALF + 4) = acc[ai][bj][m][1]; } }
    }
};
__device__ __forceinline__ float silu_f(float x) { return x * __builtin_amdgcn_rcpf(1.0f + __expf(-x)); }
struct EpiSwiglu {
    static constexpr bool PERM = true, AFTER_DRAIN = false;
    bf16_t* O; int ldc;
    __device__ __forceinline__ void operator()(const f32x4 (&acc)[2][2][4][2], const Unit& u, int wr, int wc, int fr, int fq) const {
        const int row0 = u.pm * BM + wr * 64 + fr; const int col0 = u.pn * HALF + wc * 32 + 8 * fq;
#pragma unroll
        for (int ai = 0; ai < 2; ++ai)
#pragma unroll
            for (int m = 0; m < 4; ++m) { bf16_t* rowp = O + (size_t)(row0 + ai * HALF + m * 16) * ldc + col0;
                const f32x4 g0 = acc[ai][0][m][0], g1 = acc[ai][0][m][1], u0 = acc[ai][1][m][0], u1 = acc[ai][1][m][1];
                u32x4 w; w.x = cvt_pk_bf16(silu_f(g0[0]) * u0[0], silu_f(g0[1]) * u0[1]); w.y = cvt_pk_bf16(silu_f(g0[2]) * u0[2], silu_f(g0[3]) * u0[3]);
                w.z = cvt_pk_bf16(silu_f(g1[0]) * u1[0], silu_f(g1[1]) * u1[1]); w.w = cvt_pk_bf16(silu_f(g1[2]) * u1[2], silu_f(g1[3]) * u1[3]);
                *(u32x4*)rowp = w; }
    }
};

template <class Epi, class Sched, bool ALIGN_EPI = false, bool SP2 = false>
__device__ __forceinline__ void gemm_phase(PG8_LAS unsigned char* lds, const Gemm g, const Sched& S, const Epi& E, const int tid) {
    const int wid = __builtin_amdgcn_readfirstlane(tid >> 6), lane = tid & 63, wr = wid >> 2, wc = wid & 3, fr = lane & 15, fq = lane >> 4;
    const int K = g.K, nt = K / BK;
    unsigned voffA[2], voffB[2];
#pragma unroll
    for (int i = 0; i < 2; ++i) { int R, C; stage_rc(tid * 16 + i * 8192, R, C); const int Rb = Epi::PERM ? ((R & ~31) + perm32(R & 31)) : R;
        voffA[i] = (unsigned)(R * K + C) * 2u; voffB[i] = (unsigned)(Rb * K + C) * 2u; }
    const size_t kstep = (size_t)(BK * 2);
    const size_t hstep = (size_t)HALF * K * 2;
    const size_t tstep = 2 * hstep;
    const unsigned ldsw = (unsigned)wid * 1024u;
    const int aoff = lds_byte(wr * 64 + fr, fq * 8), boff = lds_byte(wc * 32 + fr, fq * 8);
#define PG8_SA(b, h) (((b) * 2 + (h)) * HTB)
#define PG8_SB(b, h) ((4 + (b) * 2 + (h)) * HTB)
#define PG8_STAGE(bufoff, gbase, voff) do { _Pragma("unroll") for (int _i = 0; _i < 2; ++_i) \
        __builtin_amdgcn_global_load_lds((const unsigned*)((const char*)(gbase) + (voff)[_i]), (PG8_LAS unsigned*)(lds + (bufoff) + ldsw + _i * 8192), 16, 0, 0); } while (0)
#define PG8_LDA(dst, b, h) do { _Pragma("unroll") for (int m = 0; m < 4; ++m) _Pragma("unroll") for (int k = 0; k < 2; ++k) dst[m][k] = *(const PG8_LAS bf16x8*)(lds + PG8_SA(b, h) + aoff + m * 2048 + k * 1024); } while (0)
#define PG8_LDB(dst, b, h) do { _Pragma("unroll") for (int n = 0; n < 2; ++n) _Pragma("unroll") for (int k = 0; k < 2; ++k) dst[n][k] = *(const PG8_LAS bf16x8*)(lds + PG8_SB(b, h) + boff + n * 2048 + k * 1024); } while (0)
#define PG8_MMA(ai, bj, At, Bt) do { __builtin_amdgcn_s_setprio(1); _Pragma("unroll") for (int m = 0; m < 4; ++m) _Pragma("unroll") for (int n = 0; n < 2; ++n) _Pragma("unroll") for (int k = 0; k < 2; ++k) \
        acc[ai][bj][m][n] = __builtin_amdgcn_mfma_f32_16x16x32_bf16(Bt[n][k], At[m][k], acc[ai][bj][m][n], 0, 0, 0); __builtin_amdgcn_s_setprio(0); } while (0)
#define PG8_WAIT_V(n) asm volatile("s_waitcnt vmcnt(" #n ")" ::: "memory")
#define PG8_WAIT_L(n) asm volatile("s_waitcnt lgkmcnt(" #n ")" ::: "memory")
#define PG8_BAR __builtin_amdgcn_s_barrier()
#define PG8_SCHED __builtin_amdgcn_sched_barrier(0)
    Unit cur, nxt; int ui = 0;
    if (!S.next(0, cur)) return;
    f32x4 acc[2][2][4][2];
#pragma unroll
    for (int a = 0; a < 2; ++a)
#pragma unroll
        for (int b = 0; b < 2; ++b)
#pragma unroll
            for (int m = 0; m < 4; ++m)
#pragma unroll
                for (int n = 0; n < 2; ++n) acc[a][b][m][n] = (f32x4){0.f, 0.f, 0.f, 0.f};
    bf16x8 At[4][2], B0[2][2], B1[2][2];
    const char* cA = (const char*)g.A + (size_t)cur.pm * tstep; const char* cB = (const char*)g.Bt + (size_t)cur.pn * tstep;
    S.a_ready(cur);
    if constexpr (SP2) {
        PG8_STAGE(PG8_SB(0, 0), cB, voffB); PG8_STAGE(PG8_SB(0, 1), cB + hstep, voffB); PG8_STAGE(PG8_SA(0, 0), cA, voffA); PG8_STAGE(PG8_SA(0, 1), cA + hstep, voffA);
        if (wr == 1) PG8_BAR;
        PG8_WAIT_V(2); PG8_BAR;
        PG8_STAGE(PG8_SB(1, 0), cB + kstep, voffB); PG8_STAGE(PG8_SA(1, 0), cA + kstep, voffA); PG8_STAGE(PG8_SB(1, 1), cB + hstep + kstep, voffB);
        PG8_WAIT_V(6); PG8_BAR;
    } else {
        PG8_STAGE(PG8_SB(0, 0), cB, voffB); PG8_STAGE(PG8_SA(0, 0), cA, voffA); PG8_STAGE(PG8_SB(0, 1), cB + hstep, voffB); PG8_STAGE(PG8_SA(0, 1), cA + hstep, voffA);
        if (wr == 1) PG8_BAR;
        PG8_WAIT_V(4); PG8_BAR;
        PG8_STAGE(PG8_SB(1, 0), cB + kstep, voffB); PG8_STAGE(PG8_SA(1, 0), cA + kstep, voffA); PG8_STAGE(PG8_SB(1, 1), cB + hstep + kstep, voffB);
        PG8_WAIT_V(6); PG8_BAR;
    }
    for (;;) {
        const bool has_next = S.next(ui + 1, nxt);
        const char* nA = has_next ? (const char*)g.A + (size_t)nxt.pm * tstep : cA; const char* nB = has_next ? (const char*)g.Bt + (size_t)nxt.pn * tstep : cB;
        for (int t = 0; t < nt; t += 2) {
            const bool last = (t == nt - 2);
            const char* a1 = cA + (size_t)(t + 1) * kstep;
            const char* a2 = last ? nA : cA + (size_t)(t + 2) * kstep; const char* b2 = last ? nB : cB + (size_t)(t + 2) * kstep;
            const char* a3 = a2 + kstep; const char* b3 = b2 + kstep;
            if (last && has_next) S.a_ready(nxt);
            if constexpr (SP2) {
            PG8_LDB(B0, 0, 0); PG8_LDB(B1, 0, 1); PG8_SCHED; PG8_LDA(At, 0, 0); PG8_STAGE(PG8_SA(1, 1), a1 + hstep, voffA);
            PG8_WAIT_V(8); PG8_WAIT_L(0); PG8_BAR; PG8_MMA(0, 0, At, B0); PG8_MMA(0, 1, At, B1); PG8_BAR; PG8_SCHED;
            PG8_LDA(At, 0, 1); PG8_STAGE(PG8_SB(0, 0), b2, voffB); PG8_STAGE(PG8_SB(0, 1), b2 + hstep, voffB); PG8_STAGE(PG8_SA(0, 0), a2, voffA);
            PG8_WAIT_V(8); PG8_WAIT_L(0); PG8_BAR; PG8_MMA(1, 0, At, B0); PG8_MMA(1, 1, At, B1); PG8_BAR; PG8_SCHED;
            PG8_LDB(B0, 1, 0); PG8_LDB(B1, 1, 1); PG8_SCHED; PG8_LDA(At, 1, 0); PG8_STAGE(PG8_SA(0, 1), a2 + hstep, voffA);
            PG8_WAIT_V(8); PG8_WAIT_L(0); PG8_BAR; PG8_MMA(0, 0, At, B0); PG8_MMA(0, 1, At, B1); PG8_BAR; PG8_SCHED;
            PG8_LDA(At, 1, 1); PG8_STAGE(PG8_SB(1, 0), b3, voffB); PG8_STAGE(PG8_SB(1, 1), b3 + hstep, voffB); PG8_STAGE(PG8_SA(1, 0), a3, voffA);
            PG8_WAIT_V(8); PG8_WAIT_L(0); PG8_BAR; PG8_MMA(1, 0, At, B0); PG8_MMA(1, 1, At, B1); PG8_BAR; PG8_SCHED;
            } else {
            PG8_LDB(B0, 0, 0); PG8_SCHED; PG8_LDA(At, 0, 0); PG8_STAGE(PG8_SA(1, 1), a1 + hstep, voffA);
            PG8_WAIT_L(8); PG8_BAR; PG8_WAIT_L(0); PG8_MMA(0, 0, At, B0); PG8_BAR; PG8_SCHED;
            PG8_LDB(B1, 0, 1); PG8_STAGE(PG8_SB(0, 0), b2, voffB);
            PG8_BAR; PG8_WAIT_L(0); PG8_MMA(0, 1, At, B1); PG8_BAR;
            PG8_LDA(At, 0, 1); PG8_STAGE(PG8_SA(0, 0), a2, voffA);
            PG8_BAR; PG8_WAIT_L(0); PG8_MMA(1, 0, At, B0); PG8_BAR; PG8_SCHED;
            PG8_STAGE(PG8_SB(0, 1), b2 + hstep, voffB);
            PG8_WAIT_V(6); PG8_BAR; PG8_MMA(1, 1, At, B1); PG8_BAR;
            PG8_LDB(B0, 1, 0); PG8_SCHED; PG8_LDA(At, 1, 0); PG8_STAGE(PG8_SA(0, 1), a2 + hstep, voffA);
            PG8_WAIT_L(8); PG8_BAR; PG8_WAIT_L(0); PG8_MMA(0, 0, At, B0); PG8_BAR; PG8_SCHED;
            PG8_LDB(B1, 1, 1); PG8_STAGE(PG8_SB(1, 0), b3, voffB);
            PG8_BAR; PG8_WAIT_L(0); PG8_MMA(0, 1, At, B1); PG8_BAR;
            PG8_LDA(At, 1, 1); PG8_STAGE(PG8_SA(1, 0), a3, voffA);
            PG8_BAR; PG8_WAIT_L(0); PG8_MMA(1, 0, At, B0); PG8_BAR; PG8_SCHED;
            PG8_STAGE(PG8_SB(1, 1), b3 + hstep, voffB);
            PG8_WAIT_V(6); PG8_BAR; PG8_MMA(1, 1, At, B1); PG8_BAR;
            }
        }
        if constexpr (ALIGN_EPI) { if (wr == 0) PG8_BAR; }
        if constexpr (!Epi::AFTER_DRAIN) { E(acc, cur, wr, wc, fr, fq); S.done(cur); }
        if (!has_next) break;
#pragma unroll
        for (int a = 0; a < 2; ++a)
#pragma unroll
            for (int b = 0; b < 2; ++b)
#pragma unroll
                for (int m = 0; m < 4; ++m)
#pragma unroll
                    for (int n = 0; n < 2; ++n) acc[a][b][m][n] = (f32x4){0.f, 0.f, 0.f, 0.f};
        cur = nxt; cA = nA; cB = nB; ++ui;
        if constexpr (ALIGN_EPI) { if (wr == 1) PG8_BAR; }
    }
    PG8_WAIT_V(0);
    if constexpr (!ALIGN_EPI) { if (wr == 0) PG8_BAR; }
    PG8_BAR;
#undef PG8_SA
#undef PG8_SB
#undef PG8_STAGE
#undef PG8_LDA
#undef PG8_LDB
#undef PG8_MMA
#undef PG8_WAIT_V
#undef PG8_WAIT_L
#undef PG8_BAR
#undef PG8_SCHED
}
}

constexpr int NWAVES = 8, NTHR = 512;
constexpr int DM = 1024, SEQ = 8192, NB = 2, CTX = 256, TL = NB * SEQ, TC = NB * CTX, TT = TL + TC;
constexpr int FFN = 2752, FFNP = 2816, NWI = 5632, INW = 2432, INWP = 2560, NMOD = 9;
constexpr int ZF = 0, ZQ = 256, ZK = 640, ZV = 768, ZRR = 896, ZRK = 1280, ZRV = 1664, ZW = 2048, ZA = 2176, ZG = 2304;
constexpr int RW = 384;
constexpr float NORM_EPS = 1e-6f, GN_EPS = 64e-5f;

constexpr size_t MiB = 1u << 20;
constexpr size_t WS_CTL = 0, WS_MOD = 1 * MiB, WS_ROPE = 2 * MiB, WS_XC = 4 * MiB, WS_GC = 6 * MiB;
constexpr size_t WS_WI1 = 8 * MiB, WS_WO1 = 19 * MiB, WS_WIN = 25 * MiB, WS_WOUT = 30 * MiB, WS_WI2 = 32 * MiB, WS_WO2 = 43 * MiB;
constexpr size_t WS_H = 49 * MiB;
constexpr size_t WS_ACT = 82 * MiB;
constexpr size_t WS_O = 173 * MiB;
constexpr size_t WS_W2T = WS_MOD + 256 * 1024, WS_A2T = WS_MOD + 512 * 1024, WS_G2T = WS_MOD + 768 * 1024;
constexpr size_t WS_LW = WS_O, WS_IC = WS_O + 25 * MiB;
constexpr size_t WS_GATE = WS_O + 50 * MiB;
constexpr size_t WS_GAM32 = 165 * MiB;
constexpr size_t WS_XB = 239 * MiB;
constexpr size_t OUT_FA = 0;
constexpr size_t OUT_SUM = 16 * MiB;
constexpr size_t WS_END = 272 * MiB;

constexpr size_t WS_FT = 7 * MiB;
constexpr size_t FT_W64C = 0, FT_W64S = 8192, FT_W128C = 16384, FT_W128S = 49152, FT_T64C = 81920, FT_T64S = 90112;
constexpr int LDS_BYTES = 147456;
constexpr int MISC_OFF = 146432;
#define TPROBE -1
#define TPROBE2 -1
#define TSCALE 64.0f
#if TPROBE >= 0
#define T0(v) const unsigned long long v = __builtin_amdgcn_s_memrealtime()
#define TACC(F, id, v) do { if (((id) == TPROBE || (id) == TPROBE2) && (F).tid == 0) { volatile LAS unsigned* _m = (volatile LAS unsigned*)((F).lds + MISC_OFF); _m[(id) == TPROBE ? 24 : 25] += (unsigned)(__builtin_amdgcn_s_memrealtime() - (v)); } } while (0)
#else
#define T0(v)
#define TACC(F, id, v)
#endif

typedef unsigned short bf16;
typedef float f32x4 __attribute__((ext_vector_type(4)));
typedef unsigned v4u __attribute__((ext_vector_type(4)));
typedef unsigned v2u __attribute__((ext_vector_type(2)));
#define LAS __attribute__((address_space(3)))
#define LDS_WAIT() asm volatile("s_waitcnt lgkmcnt(0)" ::: "memory")

__device__ __forceinline__ unsigned f2bf(float f) { unsigned u = __builtin_bit_cast(unsigned, f); return (u + 0x7fffu + ((u >> 16) & 1u)) >> 16; }
__device__ __forceinline__ unsigned pk2(float lo, float hi) { return f2bf(lo) | (f2bf(hi) << 16); }
__device__ __forceinline__ float bf2f(unsigned short u) { return __builtin_bit_cast(float, (unsigned)u << 16); }
__device__ __forceinline__ float bflo(unsigned u) { return __builtin_bit_cast(float, u << 16); }
__device__ __forceinline__ float bfhi(unsigned u) { return __builtin_bit_cast(float, u & 0xffff0000u); }
__device__ __forceinline__ void unpack8(const v4u w, float (&f)[8]) { f[0] = bflo(w.x); f[1] = bfhi(w.x); f[2] = bflo(w.y); f[3] = bfhi(w.y); f[4] = bflo(w.z); f[5] = bfhi(w.z); f[6] = bflo(w.w); f[7] = bfhi(w.w); }
template <int CTRL> __device__ __forceinline__ float dppx(float v) { return __builtin_bit_cast(float, __builtin_amdgcn_update_dpp(0, __builtin_bit_cast(int, v), CTRL, 0xf, 0xf, true)); }
__device__ __forceinline__ float sum8(float v) { v += dppx<0xB1>(v); v += dppx<0x4E>(v); v += dppx<0x141>(v); return v; }
__device__ __forceinline__ float sum16(float v) { v = sum8(v); v += dppx<0x140>(v); return v; }
__device__ __forceinline__ float xrow_sum(float v) {
    float a = v, b2 = v; asm volatile("s_nop 1\n\tv_permlane16_swap_b32 %0, %1" : "+v"(a), "+v"(b2)); v = a + b2;
    a = v; b2 = v; asm volatile("s_nop 1\n\tv_permlane32_swap_b32 %0, %1" : "+v"(a), "+v"(b2)); return a + b2; }
__device__ __forceinline__ float xrow_max(float v) {
    float a = v, b2 = v; asm volatile("s_nop 1\n\tv_permlane16_swap_b32 %0, %1" : "+v"(a), "+v"(b2)); v = fmaxf(a, b2);
    a = v; b2 = v; asm volatile("s_nop 1\n\tv_permlane32_swap_b32 %0, %1" : "+v"(a), "+v"(b2)); return fmaxf(a, b2); }
__device__ __forceinline__ float wave_sum(float v) { return xrow_sum(sum16(v)); }
__device__ __forceinline__ float wave_max(float v) {
#pragma unroll
    for (int o = 1; o < 64; o <<= 1) v = fmaxf(v, __shfl_xor(v, o));
    return v;
}

struct Args { const float* in[25]; float* out; unsigned char* ws; int ph_lo, ph_hi; };

struct Frame {
    LAS unsigned char* lds;
    int tid, lane, wave, G, bid;
    float* out; unsigned char* ws;
};
enum { I_X = 0, I_C, I_CTX, I_CCTX, I_MODW, I_MODB, I_NORMG, I_F1WI, I_F1WO, I_WIN, I_WOUT, I_SINK, I_CONV, I_W0, I_W2, I_A0, I_A2, I_G2, I_KK, I_KA, I_RK, I_LNG, I_LNB, I_F2WI, I_F2WO };

__device__ __forceinline__ const float* inp(int i) {
    const __attribute__((address_space(4))) char* p = (const __attribute__((address_space(4))) char*)__builtin_amdgcn_kernarg_segment_ptr();
    asm volatile("" : "+s"(p));
    return (const float*)*(const __attribute__((address_space(1))) float* const __attribute__((address_space(4)))*)(p + 8 * i);
}
struct CvtDesc { const float* W; bf16* WT; int ldw, k0, sc, Kd, n0d; bool valid, live; };
__device__ __forceinline__ void cvt_load(const CvtDesc& d, f32x4 (&v)[8], int lane) {
    const int c4 = lane & 7, r8 = lane >> 3;
#pragma unroll
    for (int i = 0; i < 8; ++i) v[i] = (d.live && d.valid) ? *(const f32x4*)(d.W + (size_t)(d.k0 + 8 * i + r8) * d.ldw + d.sc + 4 * c4) : (f32x4){0.f, 0.f, 0.f, 0.f};
}
__device__ __forceinline__ void cvt_finish(const CvtDesc& d, const f32x4 (&v)[8], LAS float* scr, int lane) {
    if (!d.live) return;
    const int c4 = lane & 7, r8 = lane >> 3;
#pragma unroll
    for (int i = 0; i < 8; ++i) *(LAS f32x4*)(scr + (8 * i + r8) * 36 + 4 * c4) = v[i];
    LDS_WAIT(); asm volatile("" ::: "memory");
    const int c = lane & 7;
#pragma unroll
    for (int j = 0; j < 4; ++j) { const int n = (lane >> 3) + 8 * j; const LAS float* s = scr + (8 * c) * 36 + n;
        v4u o; o.x = pk2(s[0 * 36], s[1 * 36]); o.y = pk2(s[2 * 36], s[3 * 36]); o.z = pk2(s[4 * 36], s[5 * 36]); o.w = pk2(s[6 * 36], s[7 * 36]);
        *(v4u*)(d.WT + (size_t)(d.n0d + n) * d.Kd + d.k0 + 8 * c) = o; }
    LDS_WAIT(); asm volatile("" ::: "memory");
}
__device__ __forceinline__ CvtDesc cvt_decode(Frame& F, int li, int set, int it) {
    constexpr int I_WI = 16 * (NWI / 32), I_WO = (FFNP / 64) * 32, I_IN = 16 * (INWP / 32), I_OUT = 16 * 32;
    constexpr int NITEMS = 2 * I_WI + 2 * I_WO + I_IN + I_OUT;
    CvtDesc d{}; d.live = it < NITEMS; if (!d.live) return d;
    int r = it;
    if (set) { const bool inA = r < I_WI || (r >= 2 * I_WI && r < 2 * I_WI + I_WO) || (r >= 2 * I_WI + 2 * I_WO && r < 2 * I_WI + 2 * I_WO + I_IN); if (inA != (set == 1)) { d.live = false; return d; } }
    if (r < 2 * I_WI) { const int f = r / I_WI; r -= f * I_WI; const int nblk = NWI / 32, kb = r / nblk, nb = r % nblk;
        const int n0 = 32 * nb, pn = n0 >> 8, i = n0 & 255; const int j = 128 * pn + (i & 127);
        d.W = (f ? inp(I_F2WI) : inp(I_F1WI)) + (size_t)li * DM * 2 * FFN; d.ldw = 2 * FFN; d.k0 = 64 * kb; d.sc = (i < 128) ? j : FFN + j; d.valid = j < FFN; d.WT = (bf16*)(F.ws + (f ? WS_WI2 : WS_WI1)); d.Kd = DM; d.n0d = n0; return d; }
    r -= 2 * I_WI;
    if (r < 2 * I_WO) { const int f = r / I_WO; r -= f * I_WO; const int kb = r / 32, nb = r % 32;
        d.W = (f ? inp(I_F2WO) : inp(I_F1WO)) + (size_t)li * FFN * DM; d.ldw = DM; d.k0 = 64 * kb; d.sc = 32 * nb; d.valid = 64 * kb < FFN; d.WT = (bf16*)(F.ws + (f ? WS_WO2 : WS_WO1)); d.Kd = FFNP; d.n0d = 32 * nb; return d; }
    r -= 2 * I_WO;
    if (r < I_IN) { const int nblk = INWP / 32, kb = r / nblk, nb = r % nblk;
        d.W = inp(I_WIN) + (size_t)li * DM * INW; d.ldw = INW; d.k0 = 64 * kb; d.sc = 32 * nb; d.valid = 32 * nb < INW; d.WT = (bf16*)(F.ws + WS_WIN); d.Kd = DM; d.n0d = 32 * nb; return d; }
    r -= I_IN;
    { const int kb = r / 32, nb = r % 32;
        d.W = inp(I_WOUT) + (size_t)li * DM * DM; d.ldw = DM; d.k0 = 64 * kb; d.sc = 32 * nb; d.valid = true; d.WT = (bf16*)(F.ws + WS_WOUT); d.Kd = DM; d.n0d = 32 * nb; return d; }
}
__device__ __forceinline__ void convert_weights(Frame& F, int li, int set = 0, int bid0 = 0, int nblk = 0) {
    if (nblk == 0) nblk = F.G;
    if (F.bid < bid0 || F.bid >= bid0 + nblk) return;
    LAS float* scr = (LAS float*)(F.lds + F.wave * 16384);
    const int gw = (F.bid - bid0) * NWAVES + F.wave, NGW = nblk * NWAVES;
    constexpr int NITEMS = 2 * 16 * (NWI / 32) + 2 * (FFNP / 64) * 32 + 16 * (INWP / 32) + 16 * 32;
    for (int it = gw; it < NITEMS; it += 2 * NGW) {
        const CvtDesc d0 = cvt_decode(F, li, set, it), d1 = cvt_decode(F, li, set, it + NGW);
        f32x4 v0[8], v1[8];
        cvt_load(d0, v0, F.lane); cvt_load(d1, v1, F.lane);
        cvt_finish(d0, v0, scr, F.lane); cvt_finish(d1, v1, scr, F.lane);
    }
}
__device__ __forceinline__ void mod_gemv(Frame& F) {
    LAS float* sc = (LAS float*)F.lds;
    LAS float* red = sc + 3 * 1024;
    __syncthreads();
    for (int i = F.tid; i < 3 * 1024; i += NTHR) { const int v = i >> 10, k = i & 1023; const float x = v < 2 ? inp(I_C)[v * 1024 + k] : inp(I_CCTX)[k]; sc[i] = x / (1.0f + __expf(-x)); }
    __syncthreads();
    float* modv = (float*)(F.ws + WS_MOD);
    for (int u = F.bid; u < 2 * 72; u += F.G) {
        const int l = u / 72, n0 = (u % 72) * 128;
        const float* w = inp(I_MODW) + (size_t)l * DM * 9216 + n0 + 2 * F.lane;
        float a0 = 0.f, a1 = 0.f, b0 = 0.f, b1 = 0.f, c0 = 0.f, c1 = 0.f;
        const int k0 = F.wave * 128;
#pragma unroll 8
        for (int k = 0; k < 128; ++k) { const float2 wv = *(const float2*)(w + (size_t)(k0 + k) * 9216); const float s0 = sc[k0 + k], s1 = sc[1024 + k0 + k], s2 = sc[2048 + k0 + k];
            a0 += s0 * wv.x; a1 += s0 * wv.y; b0 += s1 * wv.x; b1 += s1 * wv.y; c0 += s2 * wv.x; c1 += s2 * wv.y; }
        LAS float* rw = red + F.wave * 384 + 2 * F.lane;
        rw[0] = a0; rw[1] = a1; rw[128] = b0; rw[129] = b1; rw[256] = c0; rw[257] = c1;
        __syncthreads();
        if (F.tid < 384) { float s = 0.f;
#pragma unroll
            for (int w8 = 0; w8 < 8; ++w8) s += red[w8 * 384 + F.tid];
            const int v = F.tid >> 7, n = n0 + (F.tid & 127);
            modv[(size_t)(l * 3 + v) * 9216 + n] = s + inp(I_MODB)[l * 9216 + n]; }
        __syncthreads();
    }
}
__device__ __forceinline__ void rope_tables(Frame& F) {
    float* ct = (float*)(F.ws + WS_ROPE); float* st = ct + SEQ * 32;
    for (int i = F.bid * NTHR + F.tid; i < SEQ * 32; i += F.G * NTHR) {
        const int t = i >> 5, j = i & 31; const int f = j & 15;
        const float inv = exp2f(-(float)f * (13.287712379549449f / 16.0f));
        const float pos = (float)(j < 16 ? (t >> 6) : (t & 63));
        const float ang = pos * inv;
        const double a = (double)ang; const double k = __builtin_rint(a * 0.15915494309189535); const float r = (float)(a - k * 6.283185307179586);
        ct[i] = __cosf(r); st[i] = __sinf(r);
    }
}

struct EArgs { const float* xl_src; const float* xc_src; const bf16* xb_src; bf16* xb_dst; float* out32; const bf16* o; const float* modv_g; int gidx; float gmul; const float* gpost;
               bf16* hdst; const float* modv_h; int shidx, scidx; const float* gpre; int nrows; };
template <int R>
__device__ __forceinline__ void e_rows(Frame& F, const EArgs& A, int v, int r0) {
    f32x4 cg[4], ch[4], cs[4];
#pragma unroll
    for (int j = 0; j < 4; ++j) { const int c = F.lane + 64 * j;
        if (A.o) cg[j] = ((const f32x4*)(A.modv_g + (size_t)v * 9216 + A.gidx * DM))[c] * ((const f32x4*)A.gpost)[c] * A.gmul;
        if (A.hdst) { ch[j] = ((const f32x4*)A.gpre)[c] * (1.0f + ((const f32x4*)(A.modv_h + (size_t)v * 9216 + A.scidx * DM))[c]); cs[j] = ((const f32x4*)(A.modv_h + (size_t)v * 9216 + A.shidx * DM))[c]; } }
    f32x4 x[R][4]; v2u ow[R][4];
#pragma unroll
    for (int i = 0; i < R; ++i) { const int r = r0 + i;
        if (A.xb_src) { const v2u* xs = (const v2u*)(A.xb_src + (size_t)r * DM);
#pragma unroll
            for (int j = 0; j < 4; ++j) { const v2u w = xs[F.lane + 64 * j]; x[i][j] = (f32x4){bflo(w.x), bfhi(w.x), bflo(w.y), bfhi(w.y)}; } }
        else { const float* xs = r < TL ? A.xl_src + (size_t)r * DM : A.xc_src + (size_t)(r - TL) * DM;
#pragma unroll
            for (int j = 0; j < 4; ++j) x[i][j] = ((const f32x4*)xs)[F.lane + 64 * j]; }
        if (A.o) { const v2u* orow = (const v2u*)(A.o + (size_t)r * DM);
#pragma unroll
            for (int j = 0; j < 4; ++j) ow[i][j] = orow[F.lane + 64 * j]; } }
#pragma unroll
    for (int i = 0; i < R; ++i) { const int r = r0 + i;
        if (A.o) { f32x4 ov[4]; float ss = 0.f;
#pragma unroll
            for (int j = 0; j < 4; ++j) { const v2u w = ow[i][j]; ov[j] = (f32x4){bflo(w.x), bfhi(w.x), bflo(w.y), bfhi(w.y)}; ss += (ov[j].x * ov[j].x + ov[j].y * ov[j].y) + (ov[j].z * ov[j].z + ov[j].w * ov[j].w); }
            const float rstd = __builtin_amdgcn_rsqf(wave_sum(ss) * (1.0f / DM) + NORM_EPS);
#pragma unroll
            for (int j = 0; j < 4; ++j) x[i][j] = x[i][j] + cg[j] * (ov[j] * rstd);
            if (A.out32) {
#pragma unroll
                for (int j = 0; j < 4; ++j) ((f32x4*)(A.out32 + (size_t)r * DM))[F.lane + 64 * j] = x[i][j]; }
            else { v2u* xd = (v2u*)(A.xb_dst + (size_t)r * DM);
#pragma unroll
                for (int j = 0; j < 4; ++j) { v2u w; w.x = pk2(x[i][j].x, x[i][j].y); w.y = pk2(x[i][j].z, x[i][j].w); xd[F.lane + 64 * j] = w; } } }
        if (A.hdst) { float ss = 0.f;
#pragma unroll
            for (int j = 0; j < 4; ++j) ss += (x[i][j].x * x[i][j].x + x[i][j].y * x[i][j].y) + (x[i][j].z * x[i][j].z + x[i][j].w * x[i][j].w);
            const float rstd = __builtin_amdgcn_rsqf(wave_sum(ss) * (1.0f / DM) + NORM_EPS);
            v2u* hd = (v2u*)(A.hdst + (size_t)r * DM);
#pragma unroll
            for (int j = 0; j < 4; ++j) { const f32x4 hv = (x[i][j] * rstd) * ch[j] + cs[j]; v2u w; w.x = pk2(hv.x, hv.y); w.y = pk2(hv.z, hv.w); hd[F.lane + 64 * j] = w; } } }
}
__device__ __forceinline__ void e_phase(Frame& F, const EArgs& A) {
    const int gw = F.bid * NWAVES + F.wave, NGW = F.G * NWAVES;
    if (NGW == 2048) {
        const int b = gw >> 10, r0 = b * SEQ + (gw & 1023) * 8;
        e_rows<4>(F, A, b, r0); e_rows<4>(F, A, b, r0 + 4);
        if (A.nrows > TL && (gw & 3) == 0) e_rows<1>(F, A, 2, TL + (gw >> 2));
    } else { for (int r = gw; r < A.nrows; r += NGW) e_rows<1>(F, A, r < TL ? (r >> 13) : 2, r); }
}

__device__ __forceinline__ const bf16* zrow(const Frame& F, int row) { return (const bf16*)(F.ws + WS_ACT) + (size_t)row * INWP; }

typedef short bf16x8 __attribute__((ext_vector_type(8)));
#define MFMA16(a, b, c) __builtin_amdgcn_mfma_f32_16x16x32_bf16(a, b, c, 0, 0, 0)
__device__ __forceinline__ bf16x8 mk8(unsigned a, unsigned b, unsigned c, unsigned d) { const v4u v = {a, b, c, d}; return __builtin_bit_cast(bf16x8, v); }
typedef __bf16 bf16x2_t __attribute__((ext_vector_type(2)));
typedef float f32x2_t __attribute__((ext_vector_type(2)));
__device__ __forceinline__ unsigned cvtpk(float lo, float hi) { const f32x2_t f = {lo, hi}; return __builtin_bit_cast(unsigned, __builtin_convertvector(f, bf16x2_t)); }
constexpr int NSC = 66;
constexpr int IM_AI = 0, IM_RI = 4608, IM_BI = 9216, IM_KI = 13824, IM_BKT = 18432, IM_VT = 28928, IM_GAM = 34176, IMG_BYTES = 34816;
constexpr int L_IMG0 = 0, L_IMG1 = IMG_BYTES, L_PKG = 2 * IMG_BYTES, L_YL = L_PKG + 8192, L_VB = L_YL + 128 * 68 * 4, L_BON = L_VB + 128 * 64 * 2, L_CST = L_BON + 512, L_RW_END = L_CST + 2 * 3072;
static_assert(L_RW_END <= 146432, "rwkv LDS map");
constexpr size_t SUM_SLOT = 24576;

__device__ __forceinline__ void fourier_ctx1_all(Frame& F) {
    bf16* gre = (bf16*)(F.ws + WS_GC); bf16* gim = gre + TC * 256;
    const bf16* wc = (const bf16*)(F.ws + WS_FT + FT_W64C); const bf16* wsn = (const bf16*)(F.ws + WS_FT + FT_W64S);
    for (int i = F.bid * NTHR + F.tid; i < TC * 256; i += F.G * NTHR) { const int tok = i & (TC - 1), gm = i >> 9, g = gm >> 6, m = gm & 63;
        const bf16* z = zrow(F, TL + tok) + ZF + 64 * g; float sr = 0.f, si = 0.f;
#pragma unroll
        for (int c8 = 0; c8 < 8; ++c8) { float x[8], cs[8], sn[8]; unpack8(*(const v4u*)(z + 8 * c8), x); unpack8(*(const v4u*)(wc + m * 64 + 8 * c8), cs); unpack8(*(const v4u*)(wsn + m * 64 + 8 * c8), sn);
#pragma unroll
            for (int e = 0; e < 8; ++e) { sr += x[e] * cs[e]; si -= x[e] * sn[e]; } }
        const int o = ((tok >> 8) * 256 + gm) * 256 + (tok & 255);
        gre[o] = (bf16)f2bf(sr); gim[o] = (bf16)f2bf(si); }
}
__device__ __forceinline__ void fourier_ctx2_all(Frame& F, int bid0) {
    const bf16* gre = (const bf16*)(F.ws + WS_GC); const bf16* gim = gre + TC * 256; bf16* mix = (bf16*)(F.ws + WS_H);
    const int q = F.lane >> 4, c = F.lane & 15;
#pragma unroll 1
    for (int u = (F.bid - bid0) * 8 + F.wave; u < 512; u += (F.G - bid0) * 8) { const int b = u >> 8, kt = (u >> 4) & 15, gt = u & 15;
        const int k = 16 * kt + c; const bf16* pr = gre + (size_t)((b * 256 + 16 * gt + c) * 256 + 8 * q); const bf16* pi = gim + (size_t)((b * 256 + 16 * gt + c) * 256 + 8 * q);
        f32x4 acc = {0.f, 0.f, 0.f, 0.f};
#pragma unroll
        for (int cc = 0; cc < 8; ++cc) { const bf16x8 re = *(const bf16x8*)(pr + 32 * cc), im = *(const bf16x8*)(pi + 32 * cc);
            float cv[8], sv[8];
#pragma unroll
            for (int e = 0; e < 8; ++e) { const float a = (float)((k * (32 * cc + 8 * q + e)) & 255) * (1.0f / 256.0f); cv[e] = __builtin_amdgcn_cosf(a); sv[e] = __builtin_amdgcn_sinf(a); }
            acc = MFMA16(mk8(cvtpk(cv[0], cv[1]), cvtpk(cv[2], cv[3]), cvtpk(cv[4], cv[5]), cvtpk(cv[6], cv[7])), re, acc);
            acc = MFMA16(mk8(cvtpk(sv[0], sv[1]), cvtpk(sv[2], sv[3]), cvtpk(sv[4], sv[5]), cvtpk(sv[6], sv[7])), im, acc); }
#pragma unroll
        for (int r = 0; r < 4; ++r) mix[(size_t)(TL + b * 256 + 16 * kt + 4 * q + r) * DM + 16 * gt + c] = (bf16)f2bf(acc[r] * 0.0078125f); }
}
__device__ __forceinline__ void lora_transposes(Frame& F) {
    bf16* w2t = (bf16*)(F.ws + WS_W2T); bf16* a2t = (bf16*)(F.ws + WS_A2T); bf16* g2t = (bf16*)(F.ws + WS_G2T);
    const float* w2 = inp(I_W2); const float* a2 = inp(I_A2); const float* g2 = inp(I_G2);
    for (int i = F.bid * NTHR + F.tid; i < 4 * 384 * 64; i += F.G * NTHR) { const int r = i & 63, col = (i >> 6) % 384, ld = i / (384 * 64);
        w2t[i] = (bf16)f2bf(w2[((size_t)ld * 64 + r) * RW + col]); a2t[i] = (bf16)f2bf(a2[((size_t)ld * 64 + r) * RW + col]); }
    for (int i = F.bid * NTHR + F.tid; i < 2 * 384 * 128; i += F.G * NTHR) { const int r = i & 127, col = (i >> 7) % 384, l = i / (384 * 128);
        g2t[i] = (bf16)f2bf(g2[((size_t)l * 128 + r) * RW + col]); }
}

__device__ __forceinline__ float softplus_fast(float x) { return fmaxf(x, 0.f) + __logf(1.0f + __expf(-fabsf(x))); }
__device__ __forceinline__ float tanh_fast(float x) { return 1.0f - 2.0f * __builtin_amdgcn_rcpf(1.0f + __expf(2.0f * x)); }
template <int CTRL> __device__ __forceinline__ float dpp_f(float v) { return __builtin_bit_cast(float, __builtin_amdgcn_update_dpp(0, __builtin_bit_cast(int, v), CTRL, 0xf, 0xf, true)); }
__device__ __forceinline__ void lora_pass(Frame& F, int li) {
    const int q = F.lane >> 4, c16 = F.lane & 15;
    const int srow = F.tid >> 5, sk = 2 * (F.tid & 31);
    const int soff = ((sk >> 5) * 64 + srow + 16 * ((sk & 31) >> 3)) * 16 + (sk & 7) * 2;
    LAS unsigned char* BIMG = F.lds;
#pragma unroll 1
    for (int dir = 0; dir < 2; ++dir) {
        bf16* LW = (bf16*)(F.ws + WS_LW) + (size_t)dir * TT * RW; bf16* IC = (bf16*)(F.ws + WS_IC) + (size_t)dir * TT * RW;
        const bf16* w2t = (const bf16*)(F.ws + WS_W2T) + (size_t)(li * 2 + dir) * 384 * 64; const bf16* a2t = (const bf16*)(F.ws + WS_A2T) + (size_t)(li * 2 + dir) * 384 * 64;
        bf16x8 aw[3][2], aa[3][2]; f32x4 w0v[3], a0v[3];
#pragma unroll
        for (int cti = 0; cti < 3; ++cti) { const int ct = 3 * F.wave + cti, col = 16 * ct + c16;
#pragma unroll
            for (int k = 0; k < 2; ++k) { aw[cti][k] = *(const bf16x8*)(w2t + (size_t)col * 64 + 32 * k + 8 * q); aa[cti][k] = *(const bf16x8*)(a2t + (size_t)col * 64 + 32 * k + 8 * q); }
            w0v[cti] = *(const f32x4*)(inp(I_W0) + (li * 2 + dir) * RW + 16 * ct + 4 * q); a0v[cti] = *(const f32x4*)(inp(I_A0) + (li * 2 + dir) * RW + 16 * ct + 4 * q); }
        unsigned zwn = 0u; bf16x8 ban[2];
        if (F.bid < TT / 16) { zwn = *(const unsigned*)(zrow(F, 16 * F.bid + srow) + ZW + 64 * dir + sk);
#pragma unroll
            for (int k = 0; k < 2; ++k) ban[k] = *(const bf16x8*)(zrow(F, 16 * F.bid + c16) + ZA + 64 * dir + 32 * k + 8 * q); }
        int par = 0;
        __syncthreads();
#pragma unroll 1
        for (int rt = F.bid; rt < TT / 16; rt += F.G, par ^= 1) {
            LAS unsigned char* bi = BIMG + par * 2048;
            *(LAS unsigned*)(bi + soff) = cvtpk(tanh_fast(bflo(zwn)), tanh_fast(bfhi(zwn)));
            bf16x8 ba[2] = {ban[0], ban[1]};
            if (rt + F.G < TT / 16) { zwn = *(const unsigned*)(zrow(F, 16 * (rt + F.G) + srow) + ZW + 64 * dir + sk);
#pragma unroll
                for (int k = 0; k < 2; ++k) ban[k] = *(const bf16x8*)(zrow(F, 16 * (rt + F.G) + c16) + ZA + 64 * dir + 32 * k + 8 * q); }
            __syncthreads();
            bf16x8 bw[2];
#pragma unroll
            for (int k = 0; k < 2; ++k) bw[k] = *(const LAS bf16x8*)(bi + (k * 64 + F.lane) * 16);
#pragma unroll
            for (int cti = 0; cti < 3; ++cti) { const int ct = 3 * F.wave + cti;
                f32x4 dw = {0.f, 0.f, 0.f, 0.f}, da = {0.f, 0.f, 0.f, 0.f};
#pragma unroll
                for (int k = 0; k < 2; ++k) { dw = MFMA16(aw[cti][k], bw[k], dw); da = MFMA16(aa[cti][k], ba[k], da); }
                float lw[4], ic[4];
#pragma unroll
                for (int e = 0; e < 4; ++e) { lw[e] = -0.60653066f * __builtin_amdgcn_rcpf(1.0f + __expf(-(w0v[cti][e] + dw[e]))); ic[e] = __builtin_amdgcn_rcpf(1.0f + __expf(-(a0v[cti][e] + da[e]))); }
                if (dir == 0) {
#pragma unroll
                    for (int e = 0; e < 4; ++e) { lw[e] += dpp_f<0x111>(lw[e]); lw[e] += dpp_f<0x112>(lw[e]); lw[e] += dpp_f<0x114>(lw[e]); lw[e] += dpp_f<0x118>(lw[e]); } }
                else {
#pragma unroll
                    for (int e = 0; e < 4; ++e) { lw[e] += dpp_f<0x101>(lw[e]); lw[e] += dpp_f<0x102>(lw[e]); lw[e] += dpp_f<0x104>(lw[e]); lw[e] += dpp_f<0x108>(lw[e]); } }
#pragma unroll
                for (int e = 0; e < 4; ++e) lw[e] = __expf(lw[e]);
                if (c16 == (dir == 0 ? 15 : 0)) *(f32x4*)((float*)(F.ws + WS_GAM32) + ((size_t)dir * (TT / 16) + rt) * RW + 16 * ct + 4 * q) = (f32x4){lw[0], lw[1], lw[2], lw[3]};
                const size_t o = (size_t)(16 * rt + c16) * RW + 16 * ct + 4 * q;
                v2u w; w.x = cvtpk(lw[0], lw[1]); w.y = cvtpk(lw[2], lw[3]); *(v2u*)(LW + o) = w; w.x = cvtpk(ic[0], ic[1]); w.y = cvtpk(ic[2], ic[3]); *(v2u*)(IC + o) = w; }
        }
    }
}
__device__ __forceinline__ void gate_pass(Frame& F, int li) {
    const int q = F.lane >> 4, c16 = F.lane & 15;
    const int srow = F.tid >> 5, sk = 4 * (F.tid & 31);
    const int soff = ((sk >> 5) * 64 + srow + 16 * ((sk & 31) >> 3)) * 16 + (sk & 7) * 2;
    LAS unsigned char* BIMG = F.lds + 4096;
    bf16* GT = (bf16*)(F.ws + WS_GATE);
    const bf16* g2t = (const bf16*)(F.ws + WS_G2T) + (size_t)li * 384 * 128;
    bf16x8 ag[3][4];
#pragma unroll
    for (int cti = 0; cti < 3; ++cti)
#pragma unroll
        for (int k = 0; k < 4; ++k) ag[cti][k] = *(const bf16x8*)(g2t + (size_t)(16 * (3 * F.wave + cti) + c16) * 128 + 32 * k + 8 * q);
    v2u zgn = {0u, 0u};
    if (F.bid < TT / 16) zgn = *(const v2u*)(zrow(F, 16 * F.bid + srow) + ZG + sk);
    int par = 0;
    __syncthreads();
#define SG(x) __builtin_amdgcn_rcpf(1.0f + __expf(-(x)))
#pragma unroll 1
    for (int rt = F.bid; rt < TT / 16; rt += F.G, par ^= 1) {
        LAS unsigned char* bi = BIMG + par * 4096;
        *(LAS v2u*)(bi + soff) = (v2u){cvtpk(SG(bflo(zgn.x)), SG(bfhi(zgn.x))), cvtpk(SG(bflo(zgn.y)), SG(bfhi(zgn.y)))};
        if (rt + F.G < TT / 16) zgn = *(const v2u*)(zrow(F, 16 * (rt + F.G) + srow) + ZG + sk);
        __syncthreads();
        bf16x8 bg[4];
#pragma unroll
        for (int k = 0; k < 4; ++k) bg[k] = *(const LAS bf16x8*)(bi + (k * 64 + F.lane) * 16);
#pragma unroll
        for (int cti = 0; cti < 3; ++cti) { f32x4 d = {0.f, 0.f, 0.f, 0.f};
#pragma unroll
            for (int k = 0; k < 4; ++k) d = MFMA16(ag[cti][k], bg[k], d);
            v2u w; w.x = cvtpk(d[0], d[1]); w.y = cvtpk(d[2], d[3]); *(v2u*)(GT + (size_t)(16 * rt + c16) * RW + 16 * (3 * F.wave + cti) + 4 * q) = w; }
    }
#undef SG
}
__device__ __forceinline__ void chain_consts_lds(Frame& F, LAS float* cst, int li, int h, int t256) {
    for (int i = t256; i < 12 * 64; i += 256) { const int k = i >> 6, j = i & 63, ch = 64 * h + j; float v;
        if (k == 0) v = inp(I_KK)[li * RW + ch]; else if (k == 1) v = inp(I_KA)[li * RW + ch]; else if (k == 2) v = inp(I_RK)[li * RW + ch];
        else { const int tt = (k - 3) / 3, w = (k - 3) % 3; v = inp(I_CONV)[(size_t)(li * 3 + tt) * (3 * RW) + w * RW + ch]; }
        cst[i] = v; }
}
struct PrepRaw { v4u ecw, icv, epw, zr[3], zk[3], zv[3]; f32x4 g0, g1; };
__device__ __forceinline__ void prep_load(Frame& F, PrepRaw& R, int dir, int b, int h, int tl, int o, bool isctx, int step0) {
    const int L = isctx ? CTX : SEQ, rbase = isctx ? TL + b * CTX : b * SEQ, ch0 = 64 * h + 8 * o;
    const int s = step0 + tl; const int p = dir ? L - 1 - s : s; const int row = rbase + p, tb = tl & 15;
    { const bf16* LW = (const bf16*)(F.ws + WS_LW) + (size_t)dir * TT * RW + ch0; const bf16* IC = (const bf16*)(F.ws + WS_IC) + (size_t)dir * TT * RW + ch0;
      R.ecw = *(const v4u*)(LW + (size_t)row * RW); R.icv = *(const v4u*)(IC + (size_t)row * RW); R.epw = *(const v4u*)(LW + (size_t)(tb == 0 ? row : (dir ? row + 1 : row - 1)) * RW); }
#pragma unroll
    for (int tt = 0; tt < 3; ++tt) { const int pp = p + tt - 1; const bool ok = pp >= 0 && pp < L; const bf16* z = zrow(F, rbase + (ok ? pp : p)) + ch0;
        const v4u z0 = {0u, 0u, 0u, 0u};
        R.zr[tt] = ok ? *(const v4u*)(z + ZRR) : z0; R.zk[tt] = ok ? *(const v4u*)(z + ZRK) : z0; R.zv[tt] = ok ? *(const v4u*)(z + ZRV) : z0; }
    if (tb == 15) { const f32x4* gs = (const f32x4*)((const float*)(F.ws + WS_GAM32) + ((size_t)dir * (TT / 16) + (row >> 4)) * RW + ch0); R.g0 = gs[0]; R.g1 = gs[1]; }
}
__device__ __forceinline__ void prep_compute(Frame& F, const PrepRaw& R, const LAS float* cst, LAS unsigned char* img, int dir, int b, int h, int tl, int o, bool isctx, int step0, LAS unsigned char* lds_vb, LAS float* lds_bon, int pos0_local) {
    const bool BONUS = lds_vb != nullptr;
    const int L = isctx ? CTX : SEQ, rbase = isctx ? TL + b * CTX : b * SEQ, ch0 = 64 * h + 8 * o;
    const int blk = tl >> 4, tb = tl & 15;
    const int s = step0 + tl; const int p = dir ? L - 1 - s : s; const int row = rbase + p;
    const v4u ecw = R.ecw, icv = R.icv, epw = R.epw;
    v4u zr[3], zk[3], zv[3];
#pragma unroll
    for (int tt = 0; tt < 3; ++tt) { zr[tt] = R.zr[tt]; zk[tt] = R.zk[tt]; zv[tt] = R.zv[tt]; }
    float ecf[8], epf[8], ai[8], rv[8], kv[8], vv[8];
    unpack8(ecw, ecf); unpack8(epw, epf); unpack8(icv, ai);
#pragma unroll
    for (int e = 0; e < 8; ++e) { rv[e] = 0.f; kv[e] = 0.f; vv[e] = 0.f; }
#pragma unroll
    for (int tt = 0; tt < 3; ++tt) { float a[8], bq[8], cq[8]; unpack8(zr[tt], a); unpack8(zk[tt], bq); unpack8(zv[tt], cq);
        const LAS f32x4* w0 = (const LAS f32x4*)(cst + (3 + tt * 3 + 0) * 64 + 8 * o); const LAS f32x4* w1 = (const LAS f32x4*)(cst + (3 + tt * 3 + 1) * 64 + 8 * o); const LAS f32x4* w2 = (const LAS f32x4*)(cst + (3 + tt * 3 + 2) * 64 + 8 * o);
        const f32x4 w0a = w0[0], w0b = w0[1], w1a = w1[0], w1b = w1[1], w2a = w2[0], w2b = w2[1];
#pragma unroll
        for (int e = 0; e < 4; ++e) { rv[e] += w0a[e] * a[e]; rv[e + 4] += w0b[e] * a[e + 4]; kv[e] += w1a[e] * bq[e]; kv[e + 4] += w1b[e] * bq[e + 4]; vv[e] += w2a[e] * cq[e]; vv[e + 4] += w2b[e] * cq[e + 4]; } }
    float kkw[8], kaw[8];
    { const LAS f32x4* a = (const LAS f32x4*)(cst + 0 * 64 + 8 * o); const LAS f32x4* bq = (const LAS f32x4*)(cst + 1 * 64 + 8 * o); const f32x4 a0 = a[0], a1 = a[1], b0 = bq[0], b1 = bq[1];
#pragma unroll
      for (int e = 0; e < 4; ++e) { kkw[e] = a0[e]; kkw[e + 4] = a1[e]; kaw[e] = b0[e]; kaw[e + 4] = b1[e]; } }
    float kkr[8], ss = 0.f;
#pragma unroll
    for (int e = 0; e < 8; ++e) { kkr[e] = kv[e] * kkw[e]; ss += kkr[e] * kkr[e]; }
    ss = sum8(ss);
    const float rn = __builtin_amdgcn_rsqf(fmaxf(ss, 1e-24f));
    float At[8], Rt[8], Bt[8], Kt[8];
#pragma unroll
    for (int e = 0; e < 8; ++e) { const float kk = kkr[e] * rn, kd = kv[e] * (1.0f + (ai[e] - 1.0f) * kaw[e]); const float eprev = tb == 0 ? 1.0f : epf[e]; const float ec = ecf[e], en = __builtin_amdgcn_rcpf(ec);
        At[e] = -kk * eprev; Rt[e] = rv[e] * ec; Bt[e] = kk * ai[e] * en; Kt[e] = kd * en; }
    const int P0 = 32 * (o >> 2) + 16 * (o & 1) + 4 * ((o >> 1) & 1);
    LAS bf16* AI = (LAS bf16*)(img + IM_AI) + blk * 1152 + tb * 72 + P0, *RI = (LAS bf16*)(img + IM_RI) + blk * 1152 + tb * 72 + P0, *BI = (LAS bf16*)(img + IM_BI) + blk * 1152 + tb * 72 + P0, *KI = (LAS bf16*)(img + IM_KI) + blk * 1152 + tb * 72 + P0;
    unsigned bp[4], kp[4];
#pragma unroll
    for (int e = 0; e < 4; ++e) { bp[e] = cvtpk(Bt[2 * e], Bt[2 * e + 1]); kp[e] = cvtpk(Kt[2 * e], Kt[2 * e + 1]); }
    *(LAS v2u*)AI = (v2u){cvtpk(At[0], At[1]), cvtpk(At[2], At[3])}; *(LAS v2u*)(AI + 8) = (v2u){cvtpk(At[4], At[5]), cvtpk(At[6], At[7])};
    *(LAS v2u*)RI = (v2u){cvtpk(Rt[0], Rt[1]), cvtpk(Rt[2], Rt[3])}; *(LAS v2u*)(RI + 8) = (v2u){cvtpk(Rt[4], Rt[5]), cvtpk(Rt[6], Rt[7])};
    *(LAS v2u*)BI = (v2u){bp[0], bp[1]}; *(LAS v2u*)(BI + 8) = (v2u){bp[2], bp[3]};
    *(LAS v2u*)KI = (v2u){kp[0], kp[1]}; *(LAS v2u*)(KI + 8) = (v2u){kp[2], kp[3]};
    LAS bf16* BKT = (LAS bf16*)(img + IM_BKT) + blk * 2624 + (8 * o) * 40 + o * 8 + (tb >> 2) * 8 + (tb & 3); LAS bf16* VT = (LAS bf16*)(img + IM_VT) + blk * 1312 + (8 * o) * 20 + o * 4 + tb;
    const unsigned vp[4] = {cvtpk(vv[0], vv[1]), cvtpk(vv[2], vv[3]), cvtpk(vv[4], vv[5]), cvtpk(vv[6], vv[7])};
#pragma unroll
    for (int e = 0; e < 8; ++e) { const unsigned bb = bp[e >> 1], kq = kp[e >> 1], vq = vp[e >> 1];
        BKT[e * 40] = (bf16)((e & 1) ? (bb >> 16) : (bb & 0xffff)); BKT[e * 40 + 4] = (bf16)((e & 1) ? (kq >> 16) : (kq & 0xffff)); VT[e * 20] = (bf16)((e & 1) ? (vq >> 16) : (vq & 0xffff)); }
    if (tb == 15) { LAS f32x4* G = (LAS f32x4*)((LAS float*)(img + IM_GAM) + blk * 64 + 8 * o); G[0] = R.g0; G[1] = R.g1; }
    if (BONUS) { float bs = 0.f; const LAS f32x4* rk = (const LAS f32x4*)(cst + 2 * 64 + 8 * o); const f32x4 r0 = rk[0], r1 = rk[1];
#pragma unroll
        for (int e = 0; e < 4; ++e) bs += rv[e] * kv[e] * r0[e] + rv[e + 4] * kv[e + 4] * r1[e];
        bs = sum8(bs);
        const int pl = dir ? pos0_local - tl : pos0_local + tl;
        *(LAS v4u*)(lds_vb + (pl * 64 + 8 * o) * 2) = (v4u){vp[0], vp[1], vp[2], vp[3]}; if (o == 0) lds_bon[pl] = bs; }
}
template <bool WANT_Y>
__device__ __forceinline__ void block_package(LAS unsigned char* img, int blk, LAS unsigned* pkg, int lane) {
    const int q = lane >> 4, c = lane & 15;
    f32x4 mab = {0.f, 0.f, 0.f, 0.f}, mak = mab, mbr = mab, mkr = mab;
#pragma unroll
    for (int k = 0; k < 2; ++k) { const int o = blk * 2304 + c * 144 + k * 64 + q * 16;
        const bf16x8 bi = *(const LAS bf16x8*)(img + IM_BI + o), ki = *(const LAS bf16x8*)(img + IM_KI + o), ai = *(const LAS bf16x8*)(img + IM_AI + o);
        mab = MFMA16(bi, ai, mab); mak = MFMA16(ki, ai, mak);
        if constexpr (WANT_Y) { const bf16x8 ri = *(const LAS bf16x8*)(img + IM_RI + o); mbr = MFMA16(bi, ri, mbr); mkr = MFMA16(ki, ri, mkr); } }
#pragma unroll
    for (int e = 0; e < 4; ++e) { const int s = 4 * q + e; if (!(s < c)) { mab[e] = 0.f; mak[e] = 0.f; } if (!(s <= c)) { mbr[e] = 0.f; mkr[e] = 0.f; } }
    f32x4 mabT = {0.f, 0.f, 0.f, 0.f};
#pragma unroll
    for (int k = 0; k < 2; ++k) { const int o = blk * 2304 + c * 144 + k * 64 + q * 16; mabT = MFMA16(*(const LAS bf16x8*)(img + IM_AI + o), *(const LAS bf16x8*)(img + IM_BI + o), mabT); }
#pragma unroll
    for (int e = 0; e < 4; ++e) if (!(c < 4 * q + e)) mabT[e] = 0.f;
    const f32x4 z4 = {0.f, 0.f, 0.f, 0.f};
#define OPND(x) mk8(cvtpk((x)[0], (x)[1]), cvtpk((x)[2], (x)[3]), 0u, 0u)
    const bf16x8 oM = OPND(mab), oMT = OPND(mabT);
    const f32x4 m2 = MFMA16(oMT, oM, z4), m2T = MFMA16(oM, oMT, z4);
    const bf16x8 oM2 = OPND(m2), oM2T = OPND(m2T);
    const f32x4 m4 = MFMA16(oM2T, oM2, z4), m4T = MFMA16(oM2, oM2T, z4);
    const f32x4 m8T = MFMA16(OPND(m4), OPND(m4T), z4);
    f32x4 nn = m2;
#pragma unroll
    for (int e = 0; e < 4; ++e) nn[e] += (4 * q + e == c) ? 1.0f : 0.0f;
    nn = MFMA16(oMT, OPND(nn), nn);
    nn = MFMA16(OPND(m4T), OPND(nn), nn);
    nn = MFMA16(OPND(m8T), OPND(nn), nn);
#undef OPND
    pkg[0 * 64 + lane] = cvtpk(nn[0], nn[1]); pkg[1 * 64 + lane] = cvtpk(nn[2], nn[3]);
    pkg[2 * 64 + lane] = cvtpk(mak[0], mak[1]); pkg[3 * 64 + lane] = cvtpk(mak[2], mak[3]);
    if constexpr (WANT_Y) { pkg[4 * 64 + lane] = cvtpk(mbr[0], mbr[1]); pkg[5 * 64 + lane] = cvtpk(mbr[2], mbr[3]); pkg[6 * 64 + lane] = cvtpk(mkr[0], mkr[1]); pkg[7 * 64 + lane] = cvtpk(mkr[2], mkr[3]); }
}
template <bool WANT_Y, bool HAS_V>
__device__ __forceinline__ f32x4 block_scan(LAS unsigned char* img, int blk, const LAS unsigned* pkg, f32x4 (&S)[4], int wq, int lane) {
    const int q = lane >> 4, c = lane & 15;
    bf16x8 Sb[2];
#pragma unroll
    for (int k = 0; k < 2; ++k) Sb[k] = mk8(cvtpk(S[2 * k][0], S[2 * k][1]), cvtpk(S[2 * k][2], S[2 * k][3]), cvtpk(S[2 * k + 1][0], S[2 * k + 1][1]), cvtpk(S[2 * k + 1][2], S[2 * k + 1][3]));
    v2u vpk = {0u, 0u};
    if constexpr (HAS_V) vpk = *(const LAS v2u*)(img + IM_VT + blk * 2624 + (c + 16 * wq) * 40 + ((c + 16 * wq) >> 3) * 8 + q * 8);
    const int ao = blk * 2304 + c * 144 + q * 16;
    f32x4 rhs = {0.f, 0.f, 0.f, 0.f};
    rhs = MFMA16(*(const LAS bf16x8*)(img + IM_AI + ao), Sb[0], rhs); rhs = MFMA16(*(const LAS bf16x8*)(img + IM_AI + ao + 64), Sb[1], rhs);
    if constexpr (HAS_V) rhs = MFMA16(mk8(0u, 0u, pkg[2 * 64 + lane], pkg[3 * 64 + lane]), mk8(0u, 0u, vpk.x, vpk.y), rhs);
    f32x4 u = {0.f, 0.f, 0.f, 0.f};
    u = MFMA16(mk8(pkg[0 * 64 + lane], pkg[1 * 64 + lane], 0u, 0u), mk8(cvtpk(rhs[0], rhs[1]), cvtpk(rhs[2], rhs[3]), 0u, 0u), u);
    const bf16x8 UV = mk8(cvtpk(u[0], u[1]), cvtpk(u[2], u[3]), vpk.x, vpk.y);
    f32x4 y = {0.f, 0.f, 0.f, 0.f};
    if constexpr (WANT_Y) { y = MFMA16(*(const LAS bf16x8*)(img + IM_RI + ao), Sb[0], y); y = MFMA16(*(const LAS bf16x8*)(img + IM_RI + ao + 64), Sb[1], y);
        y = MFMA16(mk8(pkg[4 * 64 + lane], pkg[5 * 64 + lane], pkg[6 * 64 + lane], pkg[7 * 64 + lane]), UV, y); }
#pragma unroll
    for (int T = 0; T < 4; ++T) { const bf16x8 bkt = *(const LAS bf16x8*)(img + IM_BKT + blk * 5248 + (16 * T + c) * 80 + ((16 * T + c) >> 3) * 16 + q * 16);
        S[T] = MFMA16(bkt, UV, S[T]); const f32x4 g = *(const LAS f32x4*)(img + IM_GAM + blk * 256 + (16 * T + 4 * q) * 4); S[T] = S[T] * g; }
    return y;
}
__device__ __forceinline__ unsigned char* sum_slot(Frame& F, int chain, int sc) { return (unsigned char*)F.out + OUT_SUM + (size_t)(chain * NSC + sc) * SUM_SLOT; }

__device__ __forceinline__ void rwkv_pass1_pair(Frame& F, int li, int pair) {
    const int g = F.wave >> 2, wq = F.wave & 3, u = 2 * pair + g;
    const int chain = u / (NSC - 1), sc = u % (NSC - 1);
    const int dir = chain / 12, b = (chain / 6) & 1, h = chain % 6;
    const bool isctx = sc < 2; const int scl = isctx ? sc : sc - 2;
    LAS unsigned char* img = F.lds + (g ? L_IMG1 : L_IMG0); LAS unsigned* pkg = (LAS unsigned*)(F.lds + L_PKG) + g * 1024;
    LAS float* cst = (LAS float*)(F.lds + L_CST) + g * 768;
    __syncthreads();
    chain_consts_lds(F, cst, li, h, F.tid & 255);
    const int q = F.lane >> 4, c = F.lane & 15;
    f32x4 SB[4], SA[4];
#pragma unroll
    for (int T = 0; T < 4; ++T)
#pragma unroll
        for (int e = 0; e < 4; ++e) { SB[T][e] = 0.0f; SA[T][e] = (16 * T + 4 * q + e == c + 16 * wq) ? 1.0f : 0.0f; }
    PrepRaw R;
    prep_load(F, R, dir, b, h, 8 * wq + (F.lane >> 3), F.lane & 7, isctx, 128 * scl);
    if (g == 1) __syncthreads();
#pragma unroll 1
    for (int rd = 0; rd < 4; ++rd) {
        __syncthreads();
        prep_compute(F, R, cst, img, dir, b, h, 8 * wq + (F.lane >> 3), F.lane & 7, isctx, 128 * scl + 32 * rd, nullptr, nullptr, 0);
        __syncthreads();
        if (rd < 3) prep_load(F, R, dir, b, h, 8 * wq + (F.lane >> 3), F.lane & 7, isctx, 128 * scl + 32 * (rd + 1));
        if (wq < 2) block_package<false>(img, wq, pkg + wq * 512, F.lane);
        __syncthreads();
        __builtin_amdgcn_s_setprio(3);
#pragma unroll
        for (int blk = 0; blk < 2; ++blk) { block_scan<false, true>(img, blk, pkg + blk * 512, SB, wq, F.lane); block_scan<false, false>(img, blk, pkg + blk * 512, SA, wq, F.lane); }
        __builtin_amdgcn_s_setprio(0);
    }
    if (g == 0) __syncthreads();
    unsigned char* slot = sum_slot(F, chain, sc);
    { f32x4* braw = (f32x4*)slot;
#pragma unroll
      for (int T = 0; T < 4; ++T) braw[(wq * 4 + T) * 64 + F.lane] = SB[T]; }
    { bf16* aim = (bf16*)(slot + 16384); const int kap = wq >> 1, e = (F.lane & 3) + 4 * (wq & 1), qc = c >> 2;
#pragma unroll
      for (int T = 0; T < 4; ++T)
#pragma unroll
          for (int r = 0; r < 4; ++r) { const int lc = (4 * q + r) + 16 * qc; aim[((T * 2 + kap) * 64 + lc) * 8 + e] = (bf16)f2bf(SA[T][r]); } }
}
struct P2Stage { v4u v[3]; };
__device__ __forceinline__ void p2_ld(Frame& F, P2Stage& X, int chain, int sc, int wq) {
    const v4u* s = (const v4u*)sum_slot(F, chain, sc) + (F.tid - 256);
    X.v[0] = s[wq * 256]; X.v[1] = s[1024]; X.v[2] = s[1280];
}
__device__ __forceinline__ void p2_put(Frame& F, const P2Stage& X, LAS unsigned char* bb) {
#pragma unroll
    for (int i = 0; i < 3; ++i) *(LAS v4u*)(bb + 4096 * i + 16 * (F.tid - 256)) = X.v[i];
}
constexpr int P2D = 8;
__device__ __forceinline__ void p2_math(Frame& F, const LAS unsigned char* bb, f32x4 (&S)[4], int chain, int sc, int wq) {
    f32x4* braw = (f32x4*)sum_slot(F, chain, sc);
    bf16x8 Sb[2];
#pragma unroll
    for (int k = 0; k < 2; ++k) Sb[k] = mk8(cvtpk(S[2 * k][0], S[2 * k][1]), cvtpk(S[2 * k][2], S[2 * k][3]), cvtpk(S[2 * k + 1][0], S[2 * k + 1][1]), cvtpk(S[2 * k + 1][2], S[2 * k + 1][3]));
#pragma unroll
    for (int T = 0; T < 4; ++T) { braw[(wq * 4 + T) * 64 + F.lane] = S[T];
        const f32x4 bc = *(const LAS f32x4*)(bb + (T * 64 + F.lane) * 16);
        const bf16x8 a0 = *(const LAS bf16x8*)(bb + 4096 + ((T * 2 + 0) * 64 + F.lane) * 16), a1 = *(const LAS bf16x8*)(bb + 4096 + ((T * 2 + 1) * 64 + F.lane) * 16);
        S[T] = MFMA16(a1, Sb[1], MFMA16(a0, Sb[0], bc)); }
}
__device__ __forceinline__ void rwkv_pass2_part(Frame& F, int chain, int wq) {
    constexpr int NS = NSC - 1;
    LAS unsigned char* buf = F.lds;
    __syncthreads();
    if (F.wave >= 4) {
        P2Stage X[P2D];
#pragma unroll
        for (int j = 0; j < P2D; ++j) p2_ld(F, X[j], chain, j, wq);
#pragma unroll 1
        for (int sc0 = 0; sc0 < NS - 1; sc0 += P2D) {
#pragma unroll
            for (int j = 0; j < P2D; ++j) { const int sc = sc0 + j; p2_put(F, X[j], buf + (j & 1) * 12288); p2_ld(F, X[j], chain, min(sc + P2D, NS - 1), wq); __syncthreads(); } }
        p2_put(F, X[0], buf); __syncthreads();
        return;
    }
    if (F.wave > 0) {
#pragma unroll 1
        for (int sc = 0; sc < NS; ++sc) __syncthreads();
        return;
    }
    f32x4 S[4];
#pragma unroll
    for (int T = 0; T < 4; ++T) S[T] = (f32x4){0.f, 0.f, 0.f, 0.f};
#pragma unroll 1
    for (int sc = 0; sc < NS; ++sc) { __syncthreads(); p2_math(F, buf + (sc & 1) * 12288, S, chain, sc, wq); }
    { f32x4* braw = (f32x4*)sum_slot(F, chain, NSC - 1);
#pragma unroll
      for (int T = 0; T < 4; ++T) braw[(wq * 4 + T) * 64 + F.lane] = S[T]; }
}
__device__ __forceinline__ void rwkv_pass3_unit(Frame& F, int li, int u) {
    T0(tu_); T0(ts_);
    const int pc = u % NSC, bh = u / NSC, b = bh / 6, h = bh % 6;
    const bool isctx = pc < 2; const int pcl = isctx ? pc : pc - 2, nsc = isctx ? 2 : 64;
    const int dir = F.wave >> 2, wq = F.wave & 3, q = F.lane >> 4, c = F.lane & 15;
    const int sc = dir == 0 ? pc : (isctx ? 1 - pcl : 2 + 63 - pcl);
    const int scl = dir == 0 ? pcl : nsc - 1 - pcl;
    const int chain = dir * 12 + b * 6 + h;
    LAS unsigned char* img = F.lds + (dir ? L_IMG1 : L_IMG0); LAS unsigned* pkg = (LAS unsigned*)(F.lds + L_PKG) + dir * 1024;
    LAS float* YL = (LAS float*)(F.lds + L_YL); LAS unsigned char* VB = F.lds + L_VB; LAS float* BON = (LAS float*)(F.lds + L_BON);
    LAS float* cst = (LAS float*)(F.lds + L_CST);
    __syncthreads();
    if (F.tid < 256) chain_consts_lds(F, cst, li, h, F.tid);
    f32x4 S[4];
    { const f32x4* braw = (const f32x4*)sum_slot(F, chain, sc);
#pragma unroll
      for (int T = 0; T < 4; ++T) S[T] = braw[(wq * 4 + T) * 64 + F.lane]; }
    __syncthreads();
    for (int i = F.tid; i < 128 * 68; i += NTHR) YL[i] = 0.f;
    PrepRaw R;
    prep_load(F, R, dir, b, h, 8 * wq + (F.lane >> 3), F.lane & 7, isctx, 128 * scl);
    TACC(F, 11, ts_);
    if (dir == 1) __syncthreads();
#pragma unroll 1
    for (int rd = 0; rd < 4; ++rd) {
        T0(ta_);
        __syncthreads();
        TACC(F, 16, ta_);
        prep_compute(F, R, cst, img, dir, b, h, 8 * wq + (F.lane >> 3), F.lane & 7, isctx, 128 * scl + 32 * rd, dir == 0 ? VB : (LAS unsigned char*)nullptr, BON, 32 * rd);
        TACC(F, 12, ta_); T0(tb_);
        __syncthreads();
        TACC(F, 17, tb_); T0(tb2_);
        if (rd < 3) prep_load(F, R, dir, b, h, 8 * wq + (F.lane >> 3), F.lane & 7, isctx, 128 * scl + 32 * (rd + 1));
        TACC(F, 18, tb2_); T0(tb3_);
        if (wq < 2) block_package<true>(img, wq, pkg + wq * 512, F.lane);
        TACC(F, 19, tb3_);
        __syncthreads();
        TACC(F, 13, tb_); T0(tc_);
        __builtin_amdgcn_s_setprio(3);
#pragma unroll
        for (int blk = 0; blk < 2; ++blk) { const f32x4 y = block_scan<true, true>(img, blk, pkg + blk * 512, S, wq, F.lane);
#pragma unroll
            for (int e = 0; e < 4; ++e) { const int t = 32 * rd + 16 * blk + 4 * q + e; const int pl = dir ? 127 - t : t; YL[pl * 68 + c + 16 * wq] += y[e]; } }
        __builtin_amdgcn_s_setprio(0);
        TACC(F, 14, tc_);
    }
    if (dir == 0) __syncthreads();
    T0(td_);
    __syncthreads();
    const int rbase = (isctx ? TL + b * CTX : b * SEQ) + 128 * pcl;
    bf16* mix = (bf16*)(F.ws + WS_H);
    const int o8 = F.tid & 7;
    const f32x4 lg0 = *(const f32x4*)(inp(I_LNG) + li * RW + 64 * h + 8 * o8), lg1 = *(const f32x4*)(inp(I_LNG) + li * RW + 64 * h + 8 * o8 + 4);
    const f32x4 lb0 = *(const f32x4*)(inp(I_LNB) + li * RW + 64 * h + 8 * o8), lb1 = *(const f32x4*)(inp(I_LNB) + li * RW + 64 * h + 8 * o8 + 4);
#pragma unroll
    for (int it = 0; it < 2; ++it) { const int tl = (F.tid >> 3) + 64 * it;
        const v4u gw = *(const v4u*)((const bf16*)(F.ws + WS_GATE) + (size_t)(rbase + tl) * RW + 64 * h + 8 * o8);
        const f32x4 y0 = *(const LAS f32x4*)(YL + tl * 68 + 8 * o8), y1 = *(const LAS f32x4*)(YL + tl * 68 + 8 * o8 + 4);
        const v4u vw = *(const LAS v4u*)(VB + (tl * 64 + 8 * o8) * 2); const float bon = BON[tl];
        float yv[8], gv[8], vv[8];
#pragma unroll
        for (int e = 0; e < 4; ++e) { yv[e] = y0[e]; yv[e + 4] = y1[e]; }
        unpack8(gw, gv); unpack8(vw, vv);
        float s = 0.f;
#pragma unroll
        for (int e = 0; e < 8; ++e) s += yv[e];
        const float mu = sum8(s) * (1.0f / 64.0f); float v2 = 0.f;
#pragma unroll
        for (int e = 0; e < 8; ++e) { yv[e] -= mu; v2 += yv[e] * yv[e]; }
        const float rs = __builtin_amdgcn_rsqf(sum8(v2) * (1.0f / 64.0f) + GN_EPS);
        float ov[8];
#pragma unroll
        for (int e = 0; e < 4; ++e) { ov[e] = (yv[e] * rs * lg0[e] + lb0[e] + bon * vv[e]) * gv[e]; ov[e + 4] = (yv[e + 4] * rs * lg1[e] + lb1[e] + bon * vv[e + 4]) * gv[e + 4]; }
        *(v4u*)(mix + (size_t)(rbase + tl) * DM + 640 + 64 * h + 8 * o8) = (v4u){cvtpk(ov[0], ov[1]), cvtpk(ov[2], ov[3]), cvtpk(ov[4], ov[5]), cvtpk(ov[6], ov[7])}; }
    TACC(F, 15, td_); TACC(F, 10, tu_);
}

constexpr int AT_KROW = 144;
__device__ __forceinline__ void attn_unit(Frame& F, int li, int u) {
    const bool cq = u >= 256;
    int b, kvh, qb;
    if (!cq) { b = u >> 7; kvh = (u >> 6) & 1; qb = u & 63; } else { const int uu = u - 256; b = uu >> 2; kvh = (uu >> 1) & 1; qb = uu & 1; }
    const int c = F.lane & 15, q = F.lane >> 4, tb = F.wave;
    bf16* mix = (bf16*)(F.ws + WS_H);
    const float* rct = (const float*)(F.ws + WS_ROPE); const float* rst = rct + SEQ * 32;
    const int qrow = (cq ? TL + b * CTX : b * SEQ) + 128 * qb + 16 * tb + c;
    const int qpos = 128 * qb + 16 * tb + c;
    bf16x8 Q[3][2];
    { float cs[8], sn[8];
      if (!cq) { const f32x4 c0 = *(const f32x4*)(rct + qpos * 32 + 8 * q), c1 = *(const f32x4*)(rct + qpos * 32 + 8 * q + 4), s0 = *(const f32x4*)(rst + qpos * 32 + 8 * q), s1 = *(const f32x4*)(rst + qpos * 32 + 8 * q + 4);
#pragma unroll
          for (int e = 0; e < 4; ++e) { cs[e] = c0[e]; cs[e + 4] = c1[e]; sn[e] = s0[e]; sn[e + 4] = s1[e]; } }
      else {
#pragma unroll
          for (int e = 0; e < 8; ++e) { cs[e] = 1.0f; sn[e] = 0.0f; } }
#pragma unroll
      for (int hh = 0; hh < 3; ++hh) { const bf16* zq = zrow(F, qrow) + ZQ + 64 * (3 * kvh + hh) + 8 * q; float x1[8], x2[8]; unpack8(*(const v4u*)zq, x1); unpack8(*(const v4u*)(zq + 32), x2);
          float o1[8], o2[8];
#pragma unroll
          for (int e = 0; e < 8; ++e) { o1[e] = 0.125f * (x1[e] * cs[e] - x2[e] * sn[e]); o2[e] = 0.125f * (x2[e] * cs[e] + x1[e] * sn[e]); }
          Q[hh][0] = mk8(pk2(o1[0], o1[1]), pk2(o1[2], o1[3]), pk2(o1[4], o1[5]), pk2(o1[6], o1[7])); Q[hh][1] = mk8(pk2(o2[0], o2[1]), pk2(o2[2], o2[3]), pk2(o2[4], o2[5]), pk2(o2[6], o2[7])); } }
    float m[3], l[3]; f32x4 O[3][4];
#pragma unroll
    for (int hh = 0; hh < 3; ++hh) { m[hh] = inp(I_SINK)[li * 6 + 3 * kvh + hh]; l[hh] = q == 0 ? 1.0f : 0.0f;
#pragma unroll
        for (int dt = 0; dt < 4; ++dt) O[hh][dt] = (f32x4){0.f, 0.f, 0.f, 0.f}; }
    LAS unsigned char* KI = F.lds;
#pragma unroll 1
    for (int stage = cq ? 1 : 0; stage < 2; ++stage) {
        const int nkeys = stage == 0 ? 384 : 256; const int vstride = (nkeys + 8) * 2;
        LAS unsigned char* VTI = F.lds + 384 * AT_KROW;
        const int kpos0 = 128 * (qb - 1);
        __syncthreads();
        for (int pc = F.tid; pc < nkeys * 4; pc += NTHR) { const int key = pc >> 2, o = pc & 3;
            const bf16* zk; float cs[8], sn[8];
            if (stage == 0) { int kp = kpos0 + key; kp = kp < 0 ? 0 : (kp >= SEQ ? SEQ - 1 : kp); zk = zrow(F, b * SEQ + kp) + 64 * kvh + 8 * o;
                const f32x4 c0 = *(const f32x4*)(rct + kp * 32 + 8 * o), c1 = *(const f32x4*)(rct + kp * 32 + 8 * o + 4), s0 = *(const f32x4*)(rst + kp * 32 + 8 * o), s1 = *(const f32x4*)(rst + kp * 32 + 8 * o + 4);
#pragma unroll
                for (int e = 0; e < 4; ++e) { cs[e] = c0[e]; cs[e + 4] = c1[e]; sn[e] = s0[e]; sn[e + 4] = s1[e]; } }
            else { zk = zrow(F, TL + b * CTX + key) + 64 * kvh + 8 * o;
#pragma unroll
                for (int e = 0; e < 8; ++e) { cs[e] = 1.0f; sn[e] = 0.0f; } }
            const v4u k1 = *(const v4u*)(zk + ZK), k2 = *(const v4u*)(zk + ZK + 32), v1 = *(const v4u*)(zk + ZV), v2 = *(const v4u*)(zk + ZV + 32);
            float x1[8], x2[8]; unpack8(k1, x1); unpack8(k2, x2);
            float o1[8], o2[8];
#pragma unroll
            for (int e = 0; e < 8; ++e) { o1[e] = x1[e] * cs[e] - x2[e] * sn[e]; o2[e] = x2[e] * cs[e] + x1[e] * sn[e]; }
            *(LAS v4u*)(KI + key * AT_KROW + o * 16) = (v4u){pk2(o1[0], o1[1]), pk2(o1[2], o1[3]), pk2(o1[4], o1[5]), pk2(o1[6], o1[7])};
            *(LAS v4u*)(KI + key * AT_KROW + 64 + o * 16) = (v4u){pk2(o2[0], o2[1]), pk2(o2[2], o2[3]), pk2(o2[4], o2[5]), pk2(o2[6], o2[7])};
            const int kl = key & 31; const int col = (key & ~31) | (((kl & 15) >> 2) << 3) | ((kl >> 4) << 2) | (kl & 3);
#pragma unroll
            for (int hv = 0; hv < 2; ++hv) { const v4u vv = hv ? v2 : v1; LAS bf16* vt = (LAS bf16*)(VTI + (8 * (o + 4 * hv)) * vstride) + col;
                vt[0] = (bf16)(vv.x & 0xffff); *(LAS bf16*)((LAS unsigned char*)vt + vstride) = (bf16)(vv.x >> 16);
                *(LAS bf16*)((LAS unsigned char*)vt + 2 * vstride) = (bf16)(vv.y & 0xffff); *(LAS bf16*)((LAS unsigned char*)vt + 3 * vstride) = (bf16)(vv.y >> 16);
                *(LAS bf16*)((LAS unsigned char*)vt + 4 * vstride) = (bf16)(vv.z & 0xffff); *(LAS bf16*)((LAS unsigned char*)vt + 5 * vstride) = (bf16)(vv.z >> 16);
                *(LAS bf16*)((LAS unsigned char*)vt + 6 * vstride) = (bf16)(vv.w & 0xffff); *(LAS bf16*)((LAS unsigned char*)vt + 7 * vstride) = (bf16)(vv.w >> 16); } }
        __syncthreads();
        const int npair = nkeys / 32;
        const int Q0 = 128 * qb + 16 * tb;
#pragma unroll 1
        for (int kp = 0; kp < npair; ++kp) {
            const int kb = kpos0 + 32 * kp;
            if (stage == 0 && (kb + 31 < Q0 - 128 || kb > Q0 + 143 || kb + 31 < 0 || kb >= SEQ)) continue;
            bf16x8 K[2][2], V[4];
#pragma unroll
            for (int t = 0; t < 2; ++t)
#pragma unroll
                for (int k = 0; k < 2; ++k) K[t][k] = *(const LAS bf16x8*)(KI + (32 * kp + 16 * t + c) * AT_KROW + k * 64 + q * 16);
#pragma unroll
            for (int dt = 0; dt < 4; ++dt) V[dt] = *(const LAS bf16x8*)(VTI + (16 * dt + c) * vstride + kp * 64 + q * 16);
            bool ok0[4], ok1[4];
#pragma unroll
            for (int e = 0; e < 4; ++e) { const int k0 = kb + 4 * q + e, k1 = k0 + 16;
                ok0[e] = stage == 1 || (k0 >= 0 && k0 < SEQ && k0 >= qpos - 128 && k0 <= qpos + 128);
                ok1[e] = stage == 1 || (k1 >= 0 && k1 < SEQ && k1 >= qpos - 128 && k1 <= qpos + 128); }
#pragma unroll
            for (int hh = 0; hh < 3; ++hh) {
                f32x4 s0 = {0.f, 0.f, 0.f, 0.f}, s1 = {0.f, 0.f, 0.f, 0.f};
                s0 = MFMA16(K[0][0], Q[hh][0], s0); s0 = MFMA16(K[0][1], Q[hh][1], s0);
                s1 = MFMA16(K[1][0], Q[hh][0], s1); s1 = MFMA16(K[1][1], Q[hh][1], s1);
                float mx = -INFINITY;
#pragma unroll
                for (int e = 0; e < 4; ++e) { s0[e] = ok0[e] ? s0[e] : -INFINITY; s1[e] = ok1[e] ? s1[e] : -INFINITY; mx = fmaxf(mx, fmaxf(s0[e], s1[e])); }
                mx = xrow_max(mx);
                const float mn = fmaxf(m[hh], mx); const float alpha = __expf(m[hh] - mn); m[hh] = mn;
                float ps = 0.f;
#pragma unroll
                for (int e = 0; e < 4; ++e) { s0[e] = __expf(s0[e] - mn); s1[e] = __expf(s1[e] - mn); ps += s0[e] + s1[e]; }
                l[hh] = l[hh] * alpha + ps;
                const bf16x8 P = mk8(cvtpk(s0[0], s0[1]), cvtpk(s0[2], s0[3]), cvtpk(s1[0], s1[1]), cvtpk(s1[2], s1[3]));
#pragma unroll
                for (int dt = 0; dt < 4; ++dt) { O[hh][dt] = O[hh][dt] * alpha; O[hh][dt] = MFMA16(V[dt], P, O[hh][dt]); }
            }
        }
    }
#pragma unroll
    for (int hh = 0; hh < 3; ++hh) { const float lt = xrow_sum(l[hh]); const float inv = __builtin_amdgcn_rcpf(lt);
#pragma unroll
        for (int dt = 0; dt < 4; ++dt) { v2u w; w.x = pk2(O[hh][dt][0] * inv, O[hh][dt][1] * inv); w.y = pk2(O[hh][dt][2] * inv, O[hh][dt][3] * inv);
            *(v2u*)(mix + (size_t)qrow * DM + 256 + 64 * (3 * kvh + hh) + 16 * dt + 4 * q) = w; } }
}

__device__ __forceinline__ void fourier_tables(Frame& F) {
    bf16* t = (bf16*)(F.ws + WS_FT);
    for (int i = F.bid * NTHR + F.tid; i < 64 * 64; i += F.G * NTHR) { const int r = i >> 6, cc = i & 63; const float a = (float)((r * cc) & 63) * (1.0f / 64.0f);
        const float cs = __builtin_amdgcn_cosf(a), sn = __builtin_amdgcn_sinf(a);
        t[FT_W64C / 2 + i] = (bf16)f2bf(cs); t[FT_W64S / 2 + i] = (bf16)f2bf(sn);
        const int pj = (cc & ~31) | (((cc & 15) >> 2) << 3) | (((cc >> 4) & 1) << 2) | (cc & 3);
        t[FT_T64C / 2 + r * 64 + pj] = (bf16)f2bf(cs); t[FT_T64S / 2 + r * 64 + pj] = (bf16)f2bf(sn); }
    for (int i = F.bid * NTHR + F.tid; i < 128 * 128; i += F.G * NTHR) { const int r = i >> 7, cc = i & 127; const float a = (float)((r * cc) & 127) * (1.0f / 128.0f);
        t[FT_W128C / 2 + i] = (bf16)f2bf(__builtin_amdgcn_cosf(a)); t[FT_W128S / 2 + i] = (bf16)f2bf(__builtin_amdgcn_sinf(a)); }
}
__device__ __forceinline__ void fourier_a_fast(Frame& F, int u) {
    T0(tfa_);
    const int b = u >> 7, n2 = u & 127, c = F.lane & 15, q = F.lane >> 4;
    LAS unsigned char* IMG = F.lds;
    v4u sv[4];
#pragma unroll
    for (int i = 0; i < 4; ++i) { const int pc = F.tid + NTHR * i, n1 = pc >> 5, c8 = pc & 31; sv[i] = *(const v4u*)(zrow(F, b * SEQ + 128 * n1 + n2) + ZF + 8 * c8); }
    const bf16* wc = (const bf16*)(F.ws + WS_FT + FT_W64C); const bf16* wsn = (const bf16*)(F.ws + WS_FT + FT_W64S);
    bf16* far = (bf16*)((unsigned char*)F.out + OUT_FA); bf16* fai = far + (size_t)NB * 64 * 128 * 256;
    bf16x8 Bc[4][2], Bs[4][2];
#pragma unroll
    for (int kt = 0; kt < 4; ++kt)
#pragma unroll
        for (int k = 0; k < 2; ++k) { Bc[kt][k] = *(const bf16x8*)(wc + (16 * kt + c) * 64 + 32 * k + 8 * q); Bs[kt][k] = *(const bf16x8*)(wsn + (16 * kt + c) * 64 + 32 * k + 8 * q); }
    TACC(F, 46, tfa_);
#if TPROBE >= 0
    asm volatile("s_waitcnt vmcnt(0)" ::: "memory");
#endif
    TACC(F, 47, tfa_);
    __syncthreads();
    TACC(F, 48, tfa_);
#pragma unroll
    for (int i = 0; i < 4; ++i) { const int pc = F.tid + NTHR * i, n1 = pc >> 5, c8 = pc & 31; const v4u v = sv[i];
        LAS bf16* d = (LAS bf16*)(IMG + (8 * c8) * 144) + n1;
        d[0] = (bf16)(v.x & 0xffff); d[72] = (bf16)(v.x >> 16); d[144] = (bf16)(v.y & 0xffff); d[216] = (bf16)(v.y >> 16);
        d[288] = (bf16)(v.z & 0xffff); d[360] = (bf16)(v.z >> 16); d[432] = (bf16)(v.w & 0xffff); d[504] = (bf16)(v.w >> 16); }
    __syncthreads();
    TACC(F, 44, tfa_); T0(tfb_);
#pragma unroll
    for (int ci = 0; ci < 2; ++ci) { const int ct = 2 * F.wave + ci;
        bf16x8 A[2];
#pragma unroll
        for (int k = 0; k < 2; ++k) A[k] = *(const LAS bf16x8*)(IMG + (16 * ct + c) * 144 + k * 64 + q * 16);
#pragma unroll
        for (int kt = 0; kt < 4; ++kt) { f32x4 sr = {0.f, 0.f, 0.f, 0.f}, si = {0.f, 0.f, 0.f, 0.f};
#pragma unroll
            for (int k = 0; k < 2; ++k) { sr = MFMA16(A[k], Bc[kt][k], sr); si = MFMA16(A[k], Bs[kt][k], si); }
            const int k1 = 16 * kt + c; const float tw = (float)(n2 * k1) * (1.0f / 8192.0f); const float tc = __builtin_amdgcn_cosf(tw), ts = __builtin_amdgcn_sinf(tw);
            float xr[4], xi[4];
#pragma unroll
            for (int e = 0; e < 4; ++e) { const float ar = sr[e], ai = -si[e]; xr[e] = ar * tc + ai * ts; xi[e] = ai * tc - ar * ts; }
            const size_t o = (((size_t)b * 64 + k1) * 128 + n2) * 256 + 16 * ct + 4 * q;
            v2u w; w.x = pk2(xr[0], xr[1]); w.y = pk2(xr[2], xr[3]); *(v2u*)(far + o) = w; w.x = pk2(xi[0], xi[1]); w.y = pk2(xi[2], xi[3]); *(v2u*)(fai + o) = w; } }
    TACC(F, 45, tfb_);
}
__device__ __forceinline__ void fourier_c_fast(Frame& F, int u) {
    const int g = u & 3, k1 = (u >> 2) & 63, b = u >> 8, c = F.lane & 15, q = F.lane >> 4;
    LAS unsigned char* IR = F.lds; LAS unsigned char* II = F.lds + 64 * 272;
    const bf16* far = (const bf16*)((unsigned char*)F.out + OUT_FA) + (((size_t)b * 64 + k1) * 128) * 256 + 64 * g; const bf16* fai = far + (size_t)NB * 64 * 128 * 256;
    v4u svr[2], svi[2];
#pragma unroll
    for (int i = 0; i < 2; ++i) { const int pc = F.tid + NTHR * i, n2 = pc >> 3, c8 = pc & 7; svr[i] = *(const v4u*)(far + (size_t)n2 * 256 + 8 * c8); svi[i] = *(const v4u*)(fai + (size_t)n2 * 256 + 8 * c8); }
    __syncthreads();
#pragma unroll
    for (int i = 0; i < 2; ++i) { const int pc = F.tid + NTHR * i, n2 = pc >> 3, c8 = pc & 7;
        const v4u vr = svr[i], vi = svi[i];
        LAS bf16* dr = (LAS bf16*)(IR + (8 * c8) * 272) + n2; LAS bf16* di = (LAS bf16*)(II + (8 * c8) * 272) + n2;
        dr[0] = (bf16)(vr.x & 0xffff); dr[136] = (bf16)(vr.x >> 16); dr[272] = (bf16)(vr.y & 0xffff); dr[408] = (bf16)(vr.y >> 16);
        dr[544] = (bf16)(vr.z & 0xffff); dr[680] = (bf16)(vr.z >> 16); dr[816] = (bf16)(vr.w & 0xffff); dr[952] = (bf16)(vr.w >> 16);
        di[0] = (bf16)(vi.x & 0xffff); di[136] = (bf16)(vi.x >> 16); di[272] = (bf16)(vi.y & 0xffff); di[408] = (bf16)(vi.y >> 16);
        di[544] = (bf16)(vi.z & 0xffff); di[680] = (bf16)(vi.z >> 16); di[816] = (bf16)(vi.w & 0xffff); di[952] = (bf16)(vi.w >> 16); }
    __syncthreads();
    const bf16* wc = (const bf16*)(F.ws + WS_FT + FT_W128C); const bf16* wsn = (const bf16*)(F.ws + WS_FT + FT_W128S);
    const bf16* tcn = (const bf16*)(F.ws + WS_FT + FT_T64C); const bf16* tsn = (const bf16*)(F.ws + WS_FT + FT_T64S);
    f32x4 Pr[4], Pi[4];
#pragma unroll
    for (int ct = 0; ct < 4; ++ct) { Pr[ct] = (f32x4){0.f, 0.f, 0.f, 0.f}; Pi[ct] = (f32x4){0.f, 0.f, 0.f, 0.f}; }
#pragma unroll
    for (int k = 0; k < 4; ++k) { const bf16x8 bc = *(const bf16x8*)(wc + (16 * F.wave + c) * 128 + 32 * k + 8 * q), bs = *(const bf16x8*)(wsn + (16 * F.wave + c) * 128 + 32 * k + 8 * q);
        const v4u bsu = __builtin_bit_cast(v4u, bs); const bf16x8 bsn = mk8(bsu.x ^ 0x80008000u, bsu.y ^ 0x80008000u, bsu.z ^ 0x80008000u, bsu.w ^ 0x80008000u);
#pragma unroll
        for (int ct = 0; ct < 4; ++ct) { const bf16x8 ar = *(const LAS bf16x8*)(IR + (16 * ct + c) * 272 + k * 64 + q * 16), ai = *(const LAS bf16x8*)(II + (16 * ct + c) * 272 + k * 64 + q * 16);
            Pr[ct] = MFMA16(ar, bc, Pr[ct]); Pr[ct] = MFMA16(ai, bs, Pr[ct]); Pi[ct] = MFMA16(ai, bc, Pi[ct]); Pi[ct] = MFMA16(ar, bsn, Pi[ct]); } }
    bf16x8 Br[2], Bi[2];
#pragma unroll
    for (int k = 0; k < 2; ++k) { Br[k] = mk8(cvtpk(Pr[2 * k][0], Pr[2 * k][1]), cvtpk(Pr[2 * k][2], Pr[2 * k][3]), cvtpk(Pr[2 * k + 1][0], Pr[2 * k + 1][1]), cvtpk(Pr[2 * k + 1][2], Pr[2 * k + 1][3]));
        Bi[k] = mk8(cvtpk(Pi[2 * k][0], Pi[2 * k][1]), cvtpk(Pi[2 * k][2], Pi[2 * k][3]), cvtpk(Pi[2 * k + 1][0], Pi[2 * k + 1][1]), cvtpk(Pi[2 * k + 1][2], Pi[2 * k + 1][3])); }
    bf16* mix = (bf16*)(F.ws + WS_H);
    const float scale = 0.0013810679320049757f;
    const int k2 = 16 * F.wave + c; const size_t row = (size_t)b * SEQ + k1 + 64 * k2;
#pragma unroll
    for (int mt = 0; mt < 4; ++mt) { f32x4 y = {0.f, 0.f, 0.f, 0.f};
#pragma unroll
        for (int k = 0; k < 2; ++k) { const bf16x8 ac = *(const bf16x8*)(tcn + (16 * mt + c) * 64 + 32 * k + 8 * q), as = *(const bf16x8*)(tsn + (16 * mt + c) * 64 + 32 * k + 8 * q);
            y = MFMA16(ac, Br[k], y); y = MFMA16(as, Bi[k], y); }
        v2u w; w.x = pk2(y[0] * scale, y[1] * scale); w.y = pk2(y[2] * scale, y[3] * scale);
        *(v2u*)(mix + row * DM + 64 * g + 16 * mt + 4 * q) = w; }
}

#define XB_TMO      128
#define XB_XCNT(j)  (256  + 64 * (j))
#define XB_XSUB(j)  (1280 + 64 * (j))
#define XB_XGEN(j)  (2304 + 64 * (j))
#define XB_TOP      3328
#define XB_TOPGEN   3392
#define XCD_BAR_WORDS 3456
#define XB_SPIN_CAP (1u << 23)
__device__ __forceinline__ unsigned xb_ld(unsigned* p)              { return __hip_atomic_load(p, __ATOMIC_RELAXED, __HIP_MEMORY_SCOPE_AGENT); }
__device__ __forceinline__ unsigned xb_add(unsigned* p, unsigned v) { return __hip_atomic_fetch_add(p, v, __ATOMIC_RELAXED, __HIP_MEMORY_SCOPE_AGENT); }
__device__ __forceinline__ unsigned xb_xcc_id() { return (unsigned)__builtin_amdgcn_s_getreg((3 << 11) | 20) & 0xFu; }
#define XB_SPIN(cond, bar) do { unsigned _sp = 0; while (cond) { __builtin_amdgcn_s_sleep(1); \
    if ((++_sp & 255u) == 0u) { if (xb_ld(&(bar)[XB_TMO])) break; if (_sp > XB_SPIN_CAP) { atomicAdd(&(bar)[XB_TMO], 1u); break; } } } } while (0)
struct XcdBarrier { unsigned* bar; unsigned x; volatile LAS unsigned* st; };
__device__ __forceinline__ XcdBarrier xcd_barrier_post(unsigned* bar, volatile LAS unsigned* st) {
    XcdBarrier b; b.bar = bar; b.x = xb_xcc_id(); b.st = st;
    if (threadIdx.x == 0) (void)xb_add(&bar[XB_XCNT(b.x)], 1u);
    return b;
}
__device__ __forceinline__ void xcd_barrier_complete(unsigned* bar, unsigned x, unsigned& nloc, unsigned& nx) {
    const unsigned G = gridDim.x * gridDim.y * gridDim.z;
    unsigned sum, cnt, mine, sp = 0u;
    for (;;) {
        sum = 0u; cnt = 0u; mine = 0u;
#pragma unroll
        for (unsigned j = 0; j < 16; ++j) { const unsigned c = xb_ld(&bar[XB_XCNT(j)]); sum += c; cnt += (c > 0u) ? 1u : 0u; mine = (j == x) ? c : mine; }
        if (sum == G) break;
        __builtin_amdgcn_s_sleep(1);
        if ((++sp & 255u) == 0u) { if (xb_ld(&bar[XB_TMO])) break; if (sp > XB_SPIN_CAP) { atomicAdd(&bar[XB_TMO], 1u); break; } }
    }
    nloc = mine > 0u ? mine : 1u; nx = cnt > 0u ? cnt : 1u;
}
__device__ __forceinline__ void xcd_barrier(const XcdBarrier& b0) {
    XcdBarrier b; { unsigned* p = b0.bar; unsigned x = __builtin_amdgcn_readfirstlane(b0.x); unsigned st = (unsigned)(size_t)b0.st; asm volatile("" : "+s"(p), "+s"(x), "+s"(st)); b.bar = p; b.x = x; b.st = (volatile LAS unsigned*)(size_t)st; }
    asm volatile("s_waitcnt vmcnt(0)" ::: "memory");
    __syncthreads();
    if (threadIdx.x == 0) {
        unsigned* bar = b.bar;
        __builtin_amdgcn_s_waitcnt(0);
        unsigned nloc = b.st[0], nx = b.st[1];
        if (nloc == 0u) { xcd_barrier_complete(bar, b.x, nloc, nx); b.st[0] = nloc; b.st[1] = nx; }
        const unsigned old = xb_add(&bar[XB_XSUB(b.x)], 1u);
        const unsigned gen = old / nloc;
        if (old + 1u == (gen + 1u) * nloc) {
            __builtin_amdgcn_fence(__ATOMIC_RELEASE, "agent");
            asm volatile("s_waitcnt vmcnt(0)" ::: "memory");
            const unsigned og = xb_add(&bar[XB_TOP], 1u);
            const unsigned tg = og / nx;
            if (og + 1u == (tg + 1u) * nx) xb_add(&bar[XB_TOPGEN], 1u);
            else XB_SPIN(xb_ld(&bar[XB_TOPGEN]) == tg, bar);
            __builtin_amdgcn_fence(__ATOMIC_ACQUIRE, "agent");
            xb_add(&bar[XB_XGEN(b.x)], 1u);
            asm volatile("s_waitcnt vmcnt(0)" ::: "memory");
        } else {
            XB_SPIN(xb_ld(&bar[XB_XGEN(b.x)]) == gen, bar);
            __builtin_amdgcn_fence(__ATOMIC_ACQUIRE, "agent");
            asm volatile("s_waitcnt vmcnt(0)" ::: "memory");
        }
    }
    __syncthreads();
}

__device__ __forceinline__ int queue_next(Frame& F, unsigned* cnt) {
    volatile LAS int* slot = (volatile LAS int*)(F.lds + MISC_OFF + 64);
    __syncthreads();
    if (F.tid == 0) *slot = (int)__hip_atomic_fetch_add(cnt, 1u, __ATOMIC_RELAXED, __HIP_MEMORY_SCOPE_AGENT);
    __syncthreads();
    return *slot;
}
template <int KIND> __device__ __forceinline__ void run_phase(const Frame& F0, int li, int second) {
    Frame F;
    { int t = threadIdx.x; asm volatile("" : "+v"(t)); F.tid = t; F.lane = t & 63; F.wave = __builtin_amdgcn_readfirstlane(t >> 6);
      int g = F0.G, b = F0.bid; asm volatile("" : "+s"(g), "+s"(b)); F.G = g; F.bid = b;
      __attribute__((address_space(1))) unsigned char* w = (__attribute__((address_space(1))) unsigned char*)F0.ws; __attribute__((address_space(1))) float* o = (__attribute__((address_space(1))) float*)F0.out;
      asm volatile("" : "+s"(w), "+s"(o)); F.ws = (unsigned char*)w; F.out = (float*)o;
      unsigned l = (unsigned)(size_t)F0.lds; asm volatile("" : "+s"(l)); F.lds = (LAS unsigned char*)(size_t)l;
      asm volatile("" : "+s"(li), "+s"(second)); }
    float* modv = (float*)(F.ws + WS_MOD);
    bf16* XB = (bf16*)(F.ws + WS_XB);
    bf16* H = (bf16*)(F.ws + WS_H); bf16* ACT = (bf16*)(F.ws + WS_ACT); bf16* O = (bf16*)(F.ws + WS_O);
    const float* ng = inp(I_NORMG) + (size_t)li * 6 * DM; const float* mv = modv + (size_t)li * 3 * 9216;
    const bool last = li == 1;
    if constexpr (KIND == 100) { convert_weights(F, 0); mod_gemv(F); rope_tables(F); lora_transposes(F); fourier_tables(F); }
    if constexpr (KIND == 101) { EArgs A{}; A.xl_src = inp(I_X); A.xc_src = inp(I_CTX); A.o = nullptr; A.hdst = H; A.modv_h = modv; A.shidx = 0; A.scidx = 1; A.gpre = inp(I_NORMG); A.nrows = TT; e_phase(F, A); }
    if constexpr (KIND == 0) {
        const bf16* wi = (const bf16*)(F.ws + (second ? WS_WI2 : WS_WI1)); const bool withctx = !(last && second);
        if (!withctx || F.G != 256) { pg8::Gemm g{H, wi, withctx ? TT : TL, NWI, DM}; pg8::StaticOrder S; S.init(g.M, g.N, F.G, F.bid);
            pg8::EpiSwiglu E{ACT, FFNP}; pg8::gemm_phase<pg8::EpiSwiglu, pg8::StaticOrder, true, true>(F.lds, g, S, E, F.tid); }
        else { unsigned* cnt = (unsigned*)(F.ws + WS_CTL) + 8192 + 64 * (li * 2 + second);
            pg8::Gemm g{H, wi, TT, NWI, DM}; pg8::UpOrder S; S.init(NWI, F.G, F.bid, cnt);
            pg8::EpiSwiglu E{ACT, FFNP}; pg8::gemm_phase<pg8::EpiSwiglu, pg8::UpOrder, true, true>(F.lds, g, S, E, F.tid);
            if (F.bid >= 248) {
                if (F.tid == 0) { unsigned sp = 0; while (__hip_atomic_load(cnt, __ATOMIC_RELAXED, __HIP_MEMORY_SCOPE_AGENT) < 352u && ++sp < (1u << 24)) __builtin_amdgcn_s_sleep(8);
                    __builtin_amdgcn_fence(__ATOMIC_ACQUIRE, "agent"); asm volatile("s_waitcnt vmcnt(0)" ::: "memory"); }
                __syncthreads();
                const int k = F.bid - 248; pg8::Gemm g2{ACT, (const bf16*)(F.ws + (second ? WS_WO2 : WS_WO1)), TT, DM, FFNP}; pg8::OneUnit S2{64 + (k >> 2), k & 3};
                pg8::EpiBf16 E2{O, DM}; pg8::gemm_phase<pg8::EpiBf16, pg8::OneUnit, false, true>(F.lds, g2, S2, E2, F.tid); } } }
    if constexpr (KIND == 1) {
        const bool ctxhere = F.G != 256 && !(last && second);
        pg8::Gemm g{ACT, (const bf16*)(F.ws + (second ? WS_WO2 : WS_WO1)), ctxhere ? TT : TL, DM, FFNP}; pg8::StaticOrder S; S.init(g.M, g.N, F.G, F.bid);
        pg8::EpiBf16 E{O, DM}; pg8::gemm_phase<pg8::EpiBf16, pg8::StaticOrder, true, true>(F.lds, g, S, E, F.tid); }
    if constexpr (KIND == 2) {
        EArgs A{}; A.xl_src = inp(I_X); A.xc_src = inp(I_CTX); A.xb_src = li == 0 ? (const bf16*)nullptr : XB; A.xb_dst = XB; A.o = O; A.modv_g = mv; A.gidx = 2; A.gmul = 0.5f; A.gpost = ng + 1 * DM;
        A.hdst = H; A.modv_h = mv; A.shidx = 3; A.scidx = 4; A.gpre = ng + 2 * DM; A.nrows = TT; e_phase(F, A); }
    if constexpr (KIND == 3) {
        pg8::Gemm g{H, (const bf16*)(F.ws + WS_WIN), TT, INWP, DM}; pg8::StaticOrder S; S.init(g.M, g.N, F.G, F.bid);
        pg8::EpiBf16 E{ACT, INWP}; pg8::gemm_phase<pg8::EpiBf16, pg8::StaticOrder, true, true>(F.lds, g, S, E, F.tid); }
    if constexpr (KIND == 4) {
        { T0(t40_); lora_pass(F, li); TACC(F, 40, t40_); }
        { T0(t43_); gate_pass(F, li); TACC(F, 43, t43_); }
        { T0(t41_); for (int u = F.bid; u < 256; u += F.G) fourier_a_fast(F, u); TACC(F, 41, t41_); }
        { T0(t42_); if (li == 0) fourier_ctx1_all(F); TACC(F, 42, t42_); } }
    if constexpr (KIND == 5) {
        unsigned* cnt = (unsigned*)(F.ws + WS_CTL) + 8192 + 64 * (4 + 2 * li);
        const int na = li == 0 ? 264 : 256;
        { T0(t50_); for (int it = queue_next(F, cnt); it < na; it = queue_next(F, cnt)) attn_unit(F, li, it); TACC(F, 50, t50_); }
        { T0(t51_); for (int it = queue_next(F, cnt + 16); it < 12 * (NSC - 1); it = queue_next(F, cnt + 16)) rwkv_pass1_pair(F, li, it); TACC(F, 51, t51_); } }
    if constexpr (KIND == 11) {
        if (F.bid < 96) { T0(tp_); const int xcd = F.bid & 7, slot = F.bid >> 3; rwkv_pass2_part(F, (slot >> 2) * 8 + xcd, slot & 3); TACC(F, 30, tp_); }
        else { T0(tq_); convert_weights(F, 1, li == 0 ? 1 : 2, 96, F.G - 96);
            TACC(F, 31, tq_); T0(tr_);
            if (li == 0) fourier_ctx2_all(F, 96); TACC(F, 32, tr_); } }
    if constexpr (KIND == 12) {
        unsigned* cnt = (unsigned*)(F.ws + WS_CTL) + 8192 + 64 * (5 + 2 * li);
        const int np3 = li == 0 ? 12 * NSC : 12 * 64;
        { T0(t60_); for (int it = queue_next(F, cnt); it < np3; it = queue_next(F, cnt)) rwkv_pass3_unit(F, li, li == 0 ? it : (it / 64) * NSC + 2 + it % 64); TACC(F, 60, t60_); }
        { T0(t61_); for (int it = queue_next(F, cnt + 16); it < 512; it = queue_next(F, cnt + 16)) fourier_c_fast(F, it); TACC(F, 61, t61_); } }
    if constexpr (KIND == 6) {
        pg8::Gemm g{H, (const bf16*)(F.ws + WS_WOUT), last ? TL : TT, DM, DM}; pg8::StaticOrder S; S.init(g.M, g.N, F.G, F.bid);
        pg8::EpiBf16 E{O, DM}; pg8::gemm_phase<pg8::EpiBf16, pg8::StaticOrder, true, true>(F.lds, g, S, E, F.tid); }
    if constexpr (KIND == 7) {
        EArgs A{}; A.xb_src = XB; A.xb_dst = XB; A.o = O; A.modv_g = mv; A.gidx = 5; A.gmul = 1.0f; A.gpost = ng + 3 * DM;
        A.hdst = H; A.modv_h = mv; A.shidx = 6; A.scidx = 7; A.gpre = ng + 4 * DM; A.nrows = last ? TL : TT; e_phase(F, A); }
    if constexpr (KIND == 10) {
        EArgs A{}; A.xb_src = XB; A.xb_dst = XB; A.out32 = last ? F.out : (float*)nullptr; A.o = O; A.modv_g = mv; A.gidx = 8; A.gmul = 0.5f; A.gpost = ng + 5 * DM;
        if (!last) { A.hdst = H; A.modv_h = mv + 3 * 9216; A.shidx = 0; A.scidx = 1; A.gpre = ng + 6 * DM; }
        A.nrows = last ? TL : TT; e_phase(F, A);
        }
}
__global__ void __launch_bounds__(NTHR, 2) mega_one(Args args) {
    extern __shared__ __attribute__((aligned(16))) unsigned char lds[];
    Frame F; F.lds = (LAS unsigned char*)lds; F.tid = threadIdx.x; F.lane = F.tid & 63; F.wave = __builtin_amdgcn_readfirstlane(F.tid >> 6); F.G = gridDim.x; F.bid = blockIdx.x;
    F.out = args.out; F.ws = args.ws;
    volatile LAS unsigned* MISC = (volatile LAS unsigned*)(F.lds + MISC_OFF);
    if (F.tid < 32) MISC[F.tid] = 0u;
    __syncthreads();
    XcdBarrier bar = xcd_barrier_post((unsigned*)(F.ws + WS_CTL) + 4096, MISC + 8);
#define GRID_BAR() xcd_barrier(bar)
#define PH(K, li, sec) { T0(t_); run_phase<K>(F, li, sec); TACC(F, 100 + K + 20 * sec, t_); T0(u_); GRID_BAR(); TACC(F, 300 + K + 20 * sec, u_); }
    PH(100, 0, 0)
    PH(101, 0, 0)
#pragma unroll 1
    for (int li = 0; li < 2; ++li) {
        PH(0, li, 0)
        PH(1, li, 0)
        PH(2, li, 0)
        PH(3, li, 0)
        PH(4, li, 0)
        PH(5, li, 0)
        PH(11, li, 0)
        PH(12, li, 0)
        PH(6, li, 0)
        PH(7, li, 0)
        PH(0, li, 1)
        PH(1, li, 1)
        PH(10, li, 0)
    }
#if TPROBE >= 0
    if (F.tid == 0) { atomicAdd((unsigned*)(F.ws + WS_CTL) + 12288, MISC[24]); atomicAdd((unsigned*)(F.ws + WS_CTL) + 12289, MISC[25]); }
    GRID_BAR();
    if (F.bid == 0) { const unsigned t1 = __hip_atomic_load((unsigned*)(F.ws + WS_CTL) + 12288, __ATOMIC_RELAXED, __HIP_MEMORY_SCOPE_AGENT), t2 = __hip_atomic_load((unsigned*)(F.ws + WS_CTL) + 12289, __ATOMIC_RELAXED, __HIP_MEMORY_SCOPE_AGENT);
        const float v1 = (float)t1 * (1.0f / 25600.0f), v2 = TPROBE2 >= 0 ? (float)t2 * (1.0f / 25600.0f) : 100.0f;
        if (F.tid == 0) F.out[0] += v1 * (1.0f / TSCALE);
        (void)v2; }
#endif
}

extern "C" void kernel_launch(void* const* d_in, const int* in_sizes, int n_in, void* d_out, int out_size, void* d_ws, size_t ws_size, hipStream_t stream) {
    static int ready = 0;
    if (!ready) {
        if (n_in != 25 || out_size != TL * DM || ws_size < WS_END) { fprintf(stderr, "kernel_launch: unexpected shapes (n_in %d out %d ws %zu)\n", n_in, out_size, ws_size); ready = -1; return; }
        if (hipFuncSetAttribute((const void*)mega_one, hipFuncAttributeMaxDynamicSharedMemorySize, LDS_BYTES) != hipSuccess) { fprintf(stderr, "kernel_launch: hipFuncSetAttribute failed\n"); ready = -1; return; }
        int dev = 0, cus = 0; if (hipGetDevice(&dev) != hipSuccess || hipDeviceGetAttribute(&cus, hipDeviceAttributeMultiprocessorCount, dev) != hipSuccess || cus < 32) cus = 256;
        ready = cus < 256 ? cus : 256;
    }
    if (ready < 0) return;
    if (hipMemsetAsync((char*)d_ws + WS_CTL, 0, 65536, stream) != hipSuccess) { fprintf(stderr, "kernel_launch: memset failed\n"); return; }
    Args a{};
    for (int i = 0; i < 25; ++i) a.in[i] = (const float*)d_in[i];
    a.out = (float*)d_out; a.ws = (unsigned char*)d_ws;
    hipLaunchKernelGGL(mega_one, dim3(ready), dim3(NTHR), LDS_BYTES, stream, a);
}
```

```cpp
#include <hip/hip_runtime.h>
#include <cstdio>
#include <cstdint>

namespace pg8 {
#define PG8_LAS __attribute__((address_space(3)))
typedef unsigned short bf16_t;
typedef short bf16x8 __attribute__((ext_vector_type(8)));
typedef float f32x4 __attribute__((ext_vector_type(4)));
typedef unsigned u32x4 __attribute__((ext_vector_type(4)));
constexpr int BM = 256, BK = 64, HALF = 128, HTB = HALF * BK * 2, STAGE_BYTES = 8 * HTB, NXCD = 8, WGM = 8;

__host__ __device__ __forceinline__ int lds_byte(int r, int c) { const int st = (r >> 4) * 2 + (c >> 5), rr = r & 15, cc = c & 31, ob = rr * 64 + cc * 2; return st * 1024 + (ob ^ (((ob >> 9) & 1) << 5)); }
__host__ __device__ __forceinline__ void stage_rc(int b, int& R, int& C) { const int st = b / 1024, sb = b % 1024, swz = sb ^ (((sb >> 9) & 1) << 5); R = (st >> 1) * 16 + swz / 64; C = (st & 1) * 32 + (swz % 64) / 2; }
__host__ __device__ __forceinline__ int perm32(int rho) { const int n = rho >> 4, i = rho & 15; return 8 * (i >> 2) + 4 * n + (i & 3); }

struct Unit { int pm, pn; };
struct Gemm { const bf16_t* A; const bf16_t* Bt; int M, N, K; };

struct StaticOrder {
    int nM, nN, nwg, G, c;
    __host__ __device__ void init(int M, int N, int G_, int c_) { nM = M / BM; nN = N / BM; nwg = nM * nN; G = G_; c = c_; }
    __host__ __device__ bool next(int i, Unit& u) const {
        const long L = (long)i * G + c; if (L >= nwg) return false;
        int wgid = (int)L; { const int q = nwg / NXCD, r = nwg % NXCD, xcd = wgid % NXCD, off = wgid / NXCD; wgid = (xcd < r ? xcd * (q + 1) : r * (q + 1) + (xcd - r) * q) + off; }
        const int nig = WGM * nN, gid = wgid / nig, fm = gid * WGM, gsz = (nM - fm) < WGM ? (nM - fm) : WGM;
        u.pm = fm + ((wgid % nig) % gsz); u.pn = (wgid % nig) / gsz; return true;
    }
    __device__ __forceinline__ void a_ready(const Unit&) const {}
    __device__ __forceinline__ void done(const Unit&) const {}
};

struct UpOrder {
    StaticOrder lat; int G, c, nN; unsigned* cnt;
    __device__ void init(int N, int G_, int c_, unsigned* cnt_) { lat.init(16384, N, G_, c_); G = G_; c = c_; nN = N / BM; cnt = cnt_; }
    __device__ bool next(int i, Unit& u) const {
        const int nctx = 2 * nN, total = nctx + lat.nwg;
        long L;
        if (G != 256) L = (long)i * G + c;
        else if (c >= 248) { if (i >= 3) return false; L = (long)i * G + c; }
        else if (c >= 172 && c < 188 && i == 5) L = (long)(3 + (c - 172) / 8) * G + 248 + (c - 172) % 8;
        else L = (long)i * G + c;
        if (L >= total) return false;
        if (L < nctx) { u.pm = 64 + (int)L / nN; u.pn = (int)L % nN; return true; }
        int wgid = (int)L - nctx; { const int nwg = lat.nwg, q = nwg / NXCD, r = nwg % NXCD, xcd = wgid % NXCD, off = wgid / NXCD; wgid = (xcd < r ? xcd * (q + 1) : r * (q + 1) + (xcd - r) * q) + off; }
        const int nig = WGM * nN, gid = wgid / nig, fm = gid * WGM, gsz = (lat.nM - fm) < WGM ? (lat.nM - fm) : WGM;
        u.pm = fm + ((wgid % nig) % gsz); u.pn = (wgid % nig) / gsz; return true;
    }
    __device__ __forceinline__ void a_ready(const Unit&) const {}
    __device__ __forceinline__ void done(const Unit& u) const {
        if (u.pm >= 64) { asm volatile("s_waitcnt vmcnt(0)" ::: "memory"); __builtin_amdgcn_fence(__ATOMIC_RELEASE, "agent"); asm volatile("s_waitcnt vmcnt(0)" ::: "memory");
            if ((threadIdx.x & 63) == 0) __hip_atomic_fetch_add(cnt, 1u, __ATOMIC_RELAXED, __HIP_MEMORY_SCOPE_AGENT); }
    }
};
struct OneUnit {
    int pm, pn;
    __device__ bool next(int i, Unit& u) const { if (i != 0) return false; u.pm = pm; u.pn = pn; return true; }
    __device__ __forceinline__ void a_ready(const Unit&) const {}
    __device__ __forceinline__ void done(const Unit&) const {}
};

__device__ __forceinline__ unsigned cvt_pk_bf16(float lo, float hi) { unsigned r; asm volatile("v_cvt_pk_bf16_f32 %0, %1, %2" : "=v"(r) : "v"(lo), "v"(hi)); return r; }

struct EpiBf16 {
    static constexpr bool PERM = true, AFTER_DRAIN = false;
    bf16_t* O; int ldc;
    __device__ __forceinline__ void operator()(const f32x4 (&acc)[2][2][4][2], const Unit& u, int wr, int wc, int fr, int fq) const {
        const int row0 = u.pm * BM + wr * 64 + fr; const int col0 = u.pn * BM + wc * 32 + 8 * fq;
#pragma unroll
        for (int ai = 0; ai < 2; ++ai)
#pragma unroll
            for (int m = 0; m < 4; ++m) { bf16_t* rowp = O + (size_t)(row0 + ai * HALF + m * 16) * ldc + col0;
#pragma unroll
                for (int bj = 0; bj < 2; ++bj) { const f32x4 v0 = acc[ai][bj][m][0], v1 = acc[ai][bj][m][1];
                    u32x4 w; w.x = cvt_pk_bf16(v0[0], v0[1]); w.y = cvt_pk_bf16(v0[2], v0[3]); w.z = cvt_pk_bf16(v1[0], v1[1]); w.w = cvt_pk_bf16(v1[2], v1[3]);
                    *(u32x4*)(rowp + bj * HALF) = w; } }
    }
};
struct EpiF32 {
    static constexpr bool PERM = true, AFTER_DRAIN = false;
    float* O; int ldc;
    __device__ __forceinline__ void operator()(const f32x4 (&acc)[2][2][4][2], const Unit& u, int wr, int wc, int fr, int fq) const {
        const int row0 = u.pm * BM + wr * 64 + fr; const int col0 = u.pn * BM + wc * 32 + 8 * fq;
#pragma unroll
        for (int ai = 0; ai < 2; ++ai)
#pragma unroll
            for (int m = 0; m < 4; ++m) { float* rowp = O + (size_t)(row0 + ai * HALF + m * 16) * ldc + col0;
#pragma unroll
                for (int bj = 0; bj < 2; ++bj) { *(f32x4*)(rowp + bj * HALF) = acc[ai][bj][m][0]; *(f32x4*)(rowp + bj * HALF + 4) = acc[ai][bj][m][1]; } }
    }
};
__device__ __forceinline__ float silu_f(float x) { return x * __builtin_amdgcn_rcpf(1.0f + __expf(-x)); }
struct EpiSwiglu {
    static constexpr bool PERM = true, AFTER_DRAIN = false;
    bf16_t* O; int ldc;
    __device__ __forceinline__ void operator()(const f32x4 (&acc)[2][2][4][2], const Unit& u, int wr, int wc, int fr, int fq) const {
        const int row0 = u.pm * BM + wr * 64 + fr; const int col0 = u.pn * HALF + wc * 32 + 8 * fq;
#pragma unroll
        for (int ai = 0; ai < 2; ++ai)
#pragma unroll
            for (int m = 0; m < 4; ++m) { bf16_t* rowp = O + (size_t)(row0 + ai * HALF + m * 16) * ldc + col0;
                const f32x4 g0 = acc[ai][0][m][0], g1 = acc[ai][0][m][1], u0 = acc[ai][1][m][0], u1 = acc[ai][1][m][1];
                u32x4 w; w.x = cvt_pk_bf16(silu_f(g0[0]) * u0[0], silu_f(g0[1]) * u0[1]); w.y = cvt_pk_bf16(silu_f(g0[2]) * u0[2], silu_f(g0[3]) * u0[3]);
                w.z = cvt_pk_bf16(silu_f(g1[0]) * u1[0], silu_f(g1[1]) * u1[1]); w.w = cvt_pk_bf16(silu_f(g1[2]) * u1[2], silu_f(g1[3]) * u1[3]);
                *(u32x4*)rowp = w; }
    }
};

template <class Epi, class Sched, bool ALIGN_EPI = false, bool SP2 = false>
__device__ __forceinline__ void gemm_phase(PG8_LAS unsigned char* lds, const Gemm g, const Sched& S, const Epi& E, const int tid) {
    const int wid = __builtin_amdgcn_readfirstlane(tid >> 6), lane = tid & 63, wr = wid >> 2, wc = wid & 3, fr = lane & 15, fq = lane >> 4;
    const int K = g.K, nt = K / BK;
    unsigned voffA[2], voffB[2];
#pragma unroll
    for (int i = 0; i < 2; ++i) { int R, C; stage_rc(tid * 16 + i * 8192, R, C); const int Rb = Epi::PERM ? ((R & ~31) + perm32(R & 31)) : R;
        voffA[i] = (unsigned)(R * K + C) * 2u; voffB[i] = (unsigned)(Rb * K + C) * 2u; }
    const size_t kstep = (size_t)(BK * 2);
    const size_t hstep = (size_t)HALF * K * 2;
    const size_t tstep = 2 * hstep;
    const unsigned ldsw = (unsigned)wid * 1024u;
    const int aoff = lds_byte(wr * 64 + fr, fq * 8), boff = lds_byte(wc * 32 + fr, fq * 8);
#define PG8_SA(b, h) (((b) * 2 + (h)) * HTB)
#define PG8_SB(b, h) ((4 + (b) * 2 + (h)) * HTB)
#define PG8_STAGE(bufoff, gbase, voff) do { _Pragma("unroll") for (int _i = 0; _i < 2; ++_i) \
        __builtin_amdgcn_global_load_lds((const unsigned*)((const char*)(gbase) + (voff)[_i]), (PG8_LAS unsigned*)(lds + (bufoff) + ldsw + _i * 8192), 16, 0, 0); } while (0)
#define PG8_LDA(dst, b, h) do { _Pragma("unroll") for (int m = 0; m < 4; ++m) _Pragma("unroll") for (int k = 0; k < 2; ++k) dst[m][k] = *(const PG8_LAS bf16x8*)(lds + PG8_SA(b, h) + aoff + m * 2048 + k * 1024); } while (0)
#define PG8_LDB(dst, b, h) do { _Pragma("unroll") for (int n = 0; n < 2; ++n) _Pragma("unroll") for (int k = 0; k < 2; ++k) dst[n][k] = *(const PG8_LAS bf16x8*)(lds + PG8_SB(b, h) + boff + n * 2048 + k * 1024); } while (0)
#define PG8_MMA(ai, bj, At, Bt) do { __builtin_amdgcn_s_setprio(1); _Pragma("unroll") for (int m = 0; m < 4; ++m) _Pragma("unroll") for (int n = 0; n < 2; ++n) _Pragma("unroll") for (int k = 0; k < 2; ++k) \
        acc[ai][bj][m][n] = __builtin_amdgcn_mfma_f32_16x16x32_bf16(Bt[n][k], At[m][k], acc[ai][bj][m][n], 0, 0, 0); __builtin_amdgcn_s_setprio(0); } while (0)
#define PG8_WAIT_V(n) asm volatile("s_waitcnt vmcnt(" #n ")" ::: "memory")
#define PG8_WAIT_L(n) asm volatile("s_waitcnt lgkmcnt(" #n ")" ::: "memory")
#define PG8_BAR __builtin_amdgcn_s_barrier()
#define PG8_SCHED __builtin_amdgcn_sched_barrier(0)
    Unit cur, nxt; int ui = 0;
    if (!S.next(0, cur)) return;
    f32x4 acc[2][2][4][2];
#pragma unroll
    for (int a = 0; a < 2; ++a)
#pragma unroll
        for (int b = 0; b < 2; ++b)
#pragma unroll
            for (int m = 0; m < 4; ++m)
#pragma unroll
                for (int n = 0; n < 2; ++n) acc[a][b][m][n] = (f32x4){0.f, 0.f, 0.f, 0.f};
    bf16x8 At[4][2], B0[2][2], B1[2][2];
    const char* cA = (const char*)g.A + (size_t)cur.pm * tstep; const char* cB = (const char*)g.Bt + (size_t)cur.pn * tstep;
    S.a_ready(cur);
    if constexpr (SP2) {
        PG8_STAGE(PG8_SB(0, 0), cB, voffB); PG8_STAGE(PG8_SB(0, 1), cB + hstep, voffB); PG8_STAGE(PG8_SA(0, 0), cA, voffA); PG8_STAGE(PG8_SA(0, 1), cA + hstep, voffA);
        if (wr == 1) PG8_BAR;
        PG8_WAIT_V(2); PG8_BAR;
        PG8_STAGE(PG8_SB(1, 0), cB + kstep, voffB); PG8_STAGE(PG8_SA(1, 0), cA + kstep, voffA); PG8_STAGE(PG8_SB(1, 1), cB + hstep + kstep, voffB);
        PG8_WAIT_V(6); PG8_BAR;
    } else {
        PG8_STAGE(PG8_SB(0, 0), cB, voffB); PG8_STAGE(PG8_SA(0, 0), cA, voffA); PG8_STAGE(PG8_SB(0, 1), cB + hstep, voffB); PG8_STAGE(PG8_SA(0, 1), cA + hstep, voffA);
        if (wr == 1) PG8_BAR;
        PG8_WAIT_V(4); PG8_BAR;
        PG8_STAGE(PG8_SB(1, 0), cB + kstep, voffB); PG8_STAGE(PG8_SA(1, 0), cA + kstep, voffA); PG8_STAGE(PG8_SB(1, 1), cB + hstep + kstep, voffB);
        PG8_WAIT_V(6); PG8_BAR;
    }
    for (;;) {
        const bool has_next = S.next(ui + 1, nxt);
        const char* nA = has_next ? (const char*)g.A + (size_t)nxt.pm * tstep : cA; const char* nB = has_next ? (const char*)g.Bt + (size_t)nxt.pn * tstep : cB;
        for (int t = 0; t < nt; t += 2) {
            const bool last = (t == nt - 2);
            const char* a1 = cA + (size_t)(t + 1) * kstep;
            const char* a2 = last ? nA : cA + (size_t)(t + 2) * kstep; const char* b2 = last ? nB : cB + (size_t)(t + 2) * kstep;
            const char* a3 = a2 + kstep; const char* b3 = b2 + kstep;
            if (last && has_next) S.a_ready(nxt);
            if constexpr (SP2) {
            PG8_LDB(B0, 0, 0); PG8_LDB(B1, 0, 1); PG8_SCHED; PG8_LDA(At, 0, 0); PG8_STAGE(PG8_SA(1, 1), a1 + hstep, voffA);
            PG8_WAIT_V(8); PG8_WAIT_L(0); PG8_BAR; PG8_MMA(0, 0, At, B0); PG8_MMA(0, 1, At, B1); PG8_BAR; PG8_SCHED;
            PG8_LDA(At, 0, 1); PG8_STAGE(PG8_SB(0, 0), b2, voffB); PG8_STAGE(PG8_SB(0, 1), b2 + hstep, voffB); PG8_STAGE(PG8_SA(0, 0), a2, voffA);
            PG8_WAIT_V(8); PG8_WAIT_L(0); PG8_BAR; PG8_MMA(1, 0, At, B0); PG8_MMA(1, 1, At, B1); PG8_BAR; PG8_SCHED;
            PG8_LDB(B0, 1, 0); PG8_LDB(B1, 1, 1); PG8_SCHED; PG8_LDA(At, 1, 0); PG8_STAGE(PG8_SA(0, 1), a2 + hstep, voffA);
            PG8_WAIT_V(8); PG8_WAIT_L(0); PG8_BAR; PG8_MMA(0, 0, At, B0); PG8_MMA(0, 1, At, B1); PG8_BAR; PG8_SCHED;
            PG8_LDA(At, 1, 1); PG8_STAGE(PG8_SB(1, 0), b3, voffB); PG8_STAGE(PG8_SB(1, 1), b3 + hstep, voffB); PG8_STAGE(PG8_SA(1, 0), a3, voffA);
            PG8_WAIT_V(8); PG8_WAIT_L(0); PG8_BAR; PG8_MMA(1, 0, At, B0); PG8_MMA(1, 1, At, B1); PG8_BAR; PG8_SCHED;
            } else {
            PG8_LDB(B0, 0, 0); PG8_SCHED; PG8_LDA(At, 0, 0); PG8_STAGE(PG8_SA(1, 1), a1 + hstep, voffA);
            PG8_WAIT_L(8); PG8_BAR; PG8_WAIT_L(0); PG8_MMA(0, 0, At, B0); PG8_BAR; PG8_SCHED;
            PG8_LDB(B1, 0, 1); PG8_STAGE(PG8_SB(0, 0), b2, voffB);
            PG8_BAR; PG8_WAIT_L(0); PG8_MMA(0, 1, At, B1); PG8_BAR;
            PG8_LDA(At, 0, 1); PG8_STAGE(PG8_SA(0, 0), a2, voffA);
            PG8_BAR; PG8_WAIT_L(0); PG8_MMA(1, 0, At, B0); PG8_BAR; PG8_SCHED;
            PG8_STAGE(PG8_SB(0, 1), b2 + hstep, voffB);
            PG8_WAIT_V(6); PG8_BAR; PG8_MMA(1, 1, At, B1); PG8_BAR;
            PG8_LDB(B0, 1, 0); PG8_SCHED; PG8_LDA(At, 1, 0); PG8_STAGE(PG8_SA(0, 1), a2 + hstep, voffA);
            PG8_WAIT_L(8); PG8_BAR; PG8_WAIT_L(0); PG8_MMA(0, 0, At, B0); PG8_BAR; PG8_SCHED;
            PG8_LDB(B1, 1, 1); PG8_STAGE(PG8_SB(1, 0), b3, voffB);
            PG8_BAR; PG8_WAIT_L(0); PG8_MMA(0, 1, At, B1); PG8_BAR;
            PG8_LDA(At, 1, 1); PG8_STAGE(PG8_SA(1, 0), a3, voffA);
            PG8_BAR; PG8_WAIT_L(0); PG8_MMA(1, 0, At, B0); PG8_BAR; PG8_SCHED;
            PG8_STAGE(PG8_SB(1, 1), b3 + hstep, voffB);
            PG8_WAIT_V(6); PG8_BAR; PG8_MMA(1, 1, At, B1); PG8_BAR;
            }
        }
        if constexpr (ALIGN_EPI) { if (wr == 0) PG8_BAR; }
        if constexpr (!Epi::AFTER_DRAIN) { E(acc, cur, wr, wc, fr, fq); S.done(cur); }
        if (!has_next) break;
#pragma unroll
        for (int a = 0; a < 2; ++a)
#pragma unroll
            for (int b = 0; b < 2; ++b)
#pragma unroll
                for (int m = 0; m < 4; ++m)
#pragma unroll
                    for (int n = 0; n < 2; ++n) acc[a][b][m][n] = (f32x4){0.f, 0.f, 0.f, 0.f};
        cur = nxt; cA = nA; cB = nB; ++ui;
        if constexpr (ALIGN_EPI) { if (wr == 1) PG8_BAR; }
    }
    PG8_WAIT_V(0);
    if constexpr (!ALIGN_EPI) { if (wr == 0) PG8_BAR; }
    PG8_BAR;
#undef PG8_SA
#undef PG8_SB
#undef PG8_STAGE
#undef PG8_LDA
#undef PG8_LDB
#undef PG8_MMA
#undef PG8_WAIT_V
#undef PG8_WAIT_L
#undef PG8_BAR
#undef PG8_SCHED
}
}

constexpr int NWAVES = 8, NTHR = 512;
constexpr int DM = 1024, SEQ = 8192, NB = 2, CTX = 256, TL = NB * SEQ, TC = NB * CTX, TT = TL + TC;
constexpr int FFN = 2752, FFNP = 2816, NWI = 5632, INW = 2432, INWP = 2560, NMOD = 9;
constexpr int ZF = 0, ZQ = 256, ZK = 640, ZV = 768, ZRR = 896, ZRK = 1280, ZRV = 1664, ZW = 2048, ZA = 2176, ZG = 2304;
constexpr int RW = 384;
constexpr float NORM_EPS = 1e-6f, GN_EPS = 64e-5f;

constexpr size_t MiB = 1u << 20;
constexpr size_t WS_CTL = 0, WS_MOD = 1 * MiB, WS_ROPE = 2 * MiB, WS_XC = 4 * MiB, WS_GC = 6 * MiB;
constexpr size_t WS_WI1 = 8 * MiB, WS_WO1 = 19 * MiB, WS_WIN = 25 * MiB, WS_WOUT = 30 * MiB, WS_WI2 = 32 * MiB, WS_WO2 = 43 * MiB;
constexpr size_t WS_H = 49 * MiB;
constexpr size_t WS_ACT = 82 * MiB;
constexpr size_t WS_O = 173 * MiB;
constexpr size_t WS_W2T = WS_MOD + 256 * 1024, WS_A2T = WS_MOD + 512 * 1024, WS_G2T = WS_MOD + 768 * 1024;
constexpr size_t WS_LW = WS_O, WS_IC = WS_O + 25 * MiB;
constexpr size_t WS_GATE = WS_O + 50 * MiB;
constexpr size_t WS_GAM32 = 165 * MiB;
constexpr size_t WS_XB = 239 * MiB;
constexpr size_t OUT_FA = 0;
constexpr size_t OUT_SUM = 16 * MiB;
constexpr size_t WS_END = 272 * MiB;

constexpr size_t WS_FT = 7 * MiB;
constexpr size_t FT_W64C = 0, FT_W64S = 8192, FT_W128C = 16384, FT_W128S = 49152, FT_T64C = 81920, FT_T64S = 90112, FT_T128C = 98304, FT_T128S = 131072;
constexpr int LDS_BYTES = 147456;
constexpr int MISC_OFF = 146432;

typedef unsigned short bf16;
typedef float f32x4 __attribute__((ext_vector_type(4)));
typedef unsigned v4u __attribute__((ext_vector_type(4)));
typedef unsigned v2u __attribute__((ext_vector_type(2)));
#define LAS __attribute__((address_space(3)))
#define LDS_WAIT() asm volatile("s_waitcnt lgkmcnt(0)" ::: "memory")

__device__ __forceinline__ unsigned f2bf(float f) { unsigned u = __builtin_bit_cast(unsigned, f); return (u + 0x7fffu + ((u >> 16) & 1u)) >> 16; }
__device__ __forceinline__ unsigned pk2(float lo, float hi) { return f2bf(lo) | (f2bf(hi) << 16); }
__device__ __forceinline__ float bf2f(unsigned short u) { return __builtin_bit_cast(float, (unsigned)u << 16); }
__device__ __forceinline__ float bflo(unsigned u) { return __builtin_bit_cast(float, u << 16); }
__device__ __forceinline__ float bfhi(unsigned u) { return __builtin_bit_cast(float, u & 0xffff0000u); }
__device__ __forceinline__ void unpack8(const v4u w, float (&f)[8]) { f[0] = bflo(w.x); f[1] = bfhi(w.x); f[2] = bflo(w.y); f[3] = bfhi(w.y); f[4] = bflo(w.z); f[5] = bfhi(w.z); f[6] = bflo(w.w); f[7] = bfhi(w.w); }
template <int CTRL> __device__ __forceinline__ float dppx(float v) { return __builtin_bit_cast(float, __builtin_amdgcn_update_dpp(0, __builtin_bit_cast(int, v), CTRL, 0xf, 0xf, true)); }
__device__ __forceinline__ float sum8(float v) { v += dppx<0xB1>(v); v += dppx<0x4E>(v); v += dppx<0x141>(v); return v; }
__device__ __forceinline__ float sum16(float v) { v = sum8(v); v += dppx<0x140>(v); return v; }
__device__ __forceinline__ float xrow_sum(float v) {
    float a = v, b2 = v; asm volatile("s_nop 1\n\tv_permlane16_swap_b32 %0, %1" : "+v"(a), "+v"(b2)); v = a + b2;
    a = v; b2 = v; asm volatile("s_nop 1\n\tv_permlane32_swap_b32 %0, %1" : "+v"(a), "+v"(b2)); return a + b2; }
__device__ __forceinline__ float xrow_max(float v) {
    float a = v, b2 = v; asm volatile("s_nop 1\n\tv_permlane16_swap_b32 %0, %1" : "+v"(a), "+v"(b2)); v = fmaxf(a, b2);
    a = v; b2 = v; asm volatile("s_nop 1\n\tv_permlane32_swap_b32 %0, %1" : "+v"(a), "+v"(b2)); return fmaxf(a, b2); }
__device__ __forceinline__ float wave_sum(float v) { return xrow_sum(sum16(v)); }
__device__ __forceinline__ float wave_max(float v) {
#pragma unroll
    for (int o = 1; o < 64; o <<= 1) v = fmaxf(v, __shfl_xor(v, o));
    return v;
}

struct Args { const float* in[25]; float* out; unsigned char* ws; int ph_lo, ph_hi; };

struct Frame {
    LAS unsigned char* lds;
    int tid, lane, wave, G, bid;
    float* out; unsigned char* ws;
};
enum { I_X = 0, I_C, I_CTX, I_CCTX, I_MODW, I_MODB, I_NORMG, I_F1WI, I_F1WO, I_WIN, I_WOUT, I_SINK, I_CONV, I_W0, I_W2, I_A0, I_A2, I_G2, I_KK, I_KA, I_RK, I_LNG, I_LNB, I_F2WI, I_F2WO };

__device__ __forceinline__ const float* inp(int i) {
    const __attribute__((address_space(4))) char* p = (const __attribute__((address_space(4))) char*)__builtin_amdgcn_kernarg_segment_ptr();
    asm volatile("" : "+s"(p));
    return (const float*)*(const __attribute__((address_space(1))) float* const __attribute__((address_space(4)))*)(p + 8 * i);
}
struct CvtDesc { const float* W; bf16* WT; int ldw, k0, sc, Kd, n0d; bool valid, live; };
__device__ __forceinline__ void cvt_load(const CvtDesc& d, f32x4 (&v)[8], int lane) {
    const int c4 = lane & 7, r8 = lane >> 3;
#pragma unroll
    for (int i = 0; i < 8; ++i) v[i] = (d.live && d.valid) ? *(const f32x4*)(d.W + (size_t)(d.k0 + 8 * i + r8) * d.ldw + d.sc + 4 * c4) : (f32x4){0.f, 0.f, 0.f, 0.f};
}
__device__ __forceinline__ void cvt_finish(const CvtDesc& d, const f32x4 (&v)[8], LAS float* scr, int lane) {
    if (!d.live) return;
    const int c4 = lane & 7, r8 = lane >> 3;
#pragma unroll
    for (int i = 0; i < 8; ++i) *(LAS f32x4*)(scr + (8 * i + r8) * 36 + 4 * c4) = v[i];
    LDS_WAIT(); asm volatile("" ::: "memory");
    const int c = lane & 7;
#pragma unroll
    for (int j = 0; j < 4; ++j) { const int n = (lane >> 3) + 8 * j; const LAS float* s = scr + (8 * c) * 36 + n;
        v4u o; o.x = pk2(s[0 * 36], s[1 * 36]); o.y = pk2(s[2 * 36], s[3 * 36]); o.z = pk2(s[4 * 36], s[5 * 36]); o.w = pk2(s[6 * 36], s[7 * 36]);
        *(v4u*)(d.WT + (size_t)(d.n0d + n) * d.Kd + d.k0 + 8 * c) = o; }
    LDS_WAIT(); asm volatile("" ::: "memory");
}
__device__ __forceinline__ CvtDesc cvt_decode(Frame& F, int li, int set, int it) {
    constexpr int I_WI = 16 * (NWI / 32), I_WO = (FFNP / 64) * 32, I_IN = 16 * (INWP / 32), I_OUT = 16 * 32;
    constexpr int NITEMS = 2 * I_WI + 2 * I_WO + I_IN + I_OUT;
    CvtDesc d{}; d.live = it < NITEMS; if (!d.live) return d;
    int r = it;
    if (set) { const bool inA = r < I_WI || (r >= 2 * I_WI && r < 2 * I_WI + I_WO) || (r >= 2 * I_WI + 2 * I_WO && r < 2 * I_WI + 2 * I_WO + I_IN); if (inA != (set == 1)) { d.live = false; return d; } }
    if (r < 2 * I_WI) { const int f = r / I_WI; r -= f * I_WI; const int nblk = NWI / 32, kb = r / nblk, nb = r % nblk;
        const int n0 = 32 * nb, pn = n0 >> 8, i = n0 & 255; const int j = 128 * pn + (i & 127);
        d.W = (f ? inp(I_F2WI) : inp(I_F1WI)) + (size_t)li * DM * 2 * FFN; d.ldw = 2 * FFN; d.k0 = 64 * kb; d.sc = (i < 128) ? j : FFN + j; d.valid = j < FFN; d.WT = (bf16*)(F.ws + (f ? WS_WI2 : WS_WI1)); d.Kd = DM; d.n0d = n0; return d; }
    r -= 2 * I_WI;
    if (r < 2 * I_WO) { const int f = r / I_WO; r -= f * I_WO; const int kb = r / 32, nb = r % 32;
        d.W = (f ? inp(I_F2WO) : inp(I_F1WO)) + (size_t)li * FFN * DM; d.ldw = DM; d.k0 = 64 * kb; d.sc = 32 * nb; d.valid = 64 * kb < FFN; d.WT = (bf16*)(F.ws + (f ? WS_WO2 : WS_WO1)); d.Kd = FFNP; d.n0d = 32 * nb; return d; }
    r -= 2 * I_WO;
    if (r < I_IN) { const int nblk = INWP / 32, kb = r / nblk, nb = r % nblk;
        d.W = inp(I_WIN) + (size_t)li * DM * INW; d.ldw = INW; d.k0 = 64 * kb; d.sc = 32 * nb; d.valid = 32 * nb < INW; d.WT = (bf16*)(F.ws + WS_WIN); d.Kd = DM; d.n0d = 32 * nb; return d; }
    r -= I_IN;
    { const int kb = r / 32, nb = r % 32;
        d.W = inp(I_WOUT) + (size_t)li * DM * DM; d.ldw = DM; d.k0 = 64 * kb; d.sc = 32 * nb; d.valid = true; d.WT = (bf16*)(F.ws + WS_WOUT); d.Kd = DM; d.n0d = 32 * nb; return d; }
}
__device__ __forceinline__ void convert_weights(Frame& F, int li, int set = 0, int bid0 = 0, int nblk = 0) {
    if (nblk == 0) nblk = F.G;
    if (F.bid < bid0 || F.bid >= bid0 + nblk) return;
    LAS float* scr = (LAS float*)(F.lds + F.wave * 16384);
    const int gw = (F.bid - bid0) * NWAVES + F.wave, NGW = nblk * NWAVES;
    constexpr int NITEMS = 2 * 16 * (NWI / 32) + 2 * (FFNP / 64) * 32 + 16 * (INWP / 32) + 16 * 32;
    for (int it = gw; it < NITEMS; it += 2 * NGW) {
        const CvtDesc d0 = cvt_decode(F, li, set, it), d1 = cvt_decode(F, li, set, it + NGW);
        f32x4 v0[8], v1[8];
        cvt_load(d0, v0, F.lane); cvt_load(d1, v1, F.lane);
        cvt_finish(d0, v0, scr, F.lane); cvt_finish(d1, v1, scr, F.lane);
    }
}
__device__ __forceinline__ void mod_gemv(Frame& F) {
    LAS float* sc = (LAS float*)F.lds;
    LAS float* red = sc + 3 * 1024;
    __syncthreads();
    for (int i = F.tid; i < 3 * 1024; i += NTHR) { const int v = i >> 10, k = i & 1023; const float x = v < 2 ? inp(I_C)[v * 1024 + k] : inp(I_CCTX)[k]; sc[i] = x / (1.0f + __expf(-x)); }
    __syncthreads();
    float* modv = (float*)(F.ws + WS_MOD);
    for (int u = F.bid; u < 2 * 72; u += F.G) {
        const int l = u / 72, n0 = (u % 72) * 128;
        const float* w = inp(I_MODW) + (size_t)l * DM * 9216 + n0 + 2 * F.lane;
        float a0 = 0.f, a1 = 0.f, b0 = 0.f, b1 = 0.f, c0 = 0.f, c1 = 0.f;
        const int k0 = F.wave * 128;
#pragma unroll 8
        for (int k = 0; k < 128; ++k) { const float2 wv = *(const float2*)(w + (size_t)(k0 + k) * 9216); const float s0 = sc[k0 + k], s1 = sc[1024 + k0 + k], s2 = sc[2048 + k0 + k];
            a0 += s0 * wv.x; a1 += s0 * wv.y; b0 += s1 * wv.x; b1 += s1 * wv.y; c0 += s2 * wv.x; c1 += s2 * wv.y; }
        LAS float* rw = red + F.wave * 384 + 2 * F.lane;
        rw[0] = a0; rw[1] = a1; rw[128] = b0; rw[129] = b1; rw[256] = c0; rw[257] = c1;
        __syncthreads();
        if (F.tid < 384) { float s = 0.f;
#pragma unroll
            for (int w8 = 0; w8 < 8; ++w8) s += red[w8 * 384 + F.tid];
            const int v = F.tid >> 7, n = n0 + (F.tid & 127);
            modv[(size_t)(l * 3 + v) * 9216 + n] = s + inp(I_MODB)[l * 9216 + n]; }
        __syncthreads();
    }
}
__device__ __forceinline__ void rope_tables(Frame& F) {
    float* ct = (float*)(F.ws + WS_ROPE); float* st = ct + SEQ * 32;
    for (int i = F.bid * NTHR + F.tid; i < SEQ * 32; i += F.G * NTHR) {
        const int t = i >> 5, j = i & 31; const int f = j & 15;
        const float inv = exp2f(-(float)f * (13.287712379549449f / 16.0f));
        const float pos = (float)(j < 16 ? (t >> 6) : (t & 63));
        const float ang = pos * inv;
        const double a = (double)ang; const double k = __builtin_rint(a * 0.15915494309189535); const float r = (float)(a - k * 6.283185307179586);
        ct[i] = __cosf(r); st[i] = __sinf(r);
    }
}

struct EArgs { const float* xl_src; const float* xc_src; const bf16* xb_src; bf16* xb_dst; float* out32; const bf16* o; const bf16* octx; const float* modv_g; int gidx; float gmul; const float* gpost;
               bf16* hdst; const float* modv_h; int shidx, scidx; const float* gpre; int nrows; };
template <int R>
__device__ __forceinline__ void e_rows(Frame& F, const EArgs& A, int v, int r0) {
    f32x4 cg[4], ch[4], cs[4];
#pragma unroll
    for (int j = 0; j < 4; ++j) { const int c = F.lane + 64 * j;
        if (A.o) cg[j] = ((const f32x4*)(A.modv_g + (size_t)v * 9216 + A.gidx * DM))[c] * ((const f32x4*)A.gpost)[c] * A.gmul;
        if (A.hdst) { ch[j] = ((const f32x4*)A.gpre)[c] * (1.0f + ((const f32x4*)(A.modv_h + (size_t)v * 9216 + A.scidx * DM))[c]); cs[j] = ((const f32x4*)(A.modv_h + (size_t)v * 9216 + A.shidx * DM))[c]; } }
    f32x4 x[R][4]; v2u ow[R][4];
#pragma unroll
    for (int i = 0; i < R; ++i) { const int r = r0 + i;
        if (A.xb_src) { const v2u* xs = (const v2u*)(A.xb_src + (size_t)r * DM);
#pragma unroll
            for (int j = 0; j < 4; ++j) { const v2u w = xs[F.lane + 64 * j]; x[i][j] = (f32x4){bflo(w.x), bfhi(w.x), bflo(w.y), bfhi(w.y)}; } }
        else { const float* xs = r < TL ? A.xl_src + (size_t)r * DM : A.xc_src + (size_t)(r - TL) * DM;
#pragma unroll
            for (int j = 0; j < 4; ++j) x[i][j] = ((const f32x4*)xs)[F.lane + 64 * j]; }
        if (A.o) { const v2u* orow = (const v2u*)(((r >= TL && A.octx) ? A.octx : A.o) + (size_t)r * DM);
#pragma unroll
            for (int j = 0; j < 4; ++j) ow[i][j] = orow[F.lane + 64 * j]; } }
#pragma unroll
    for (int i = 0; i < R; ++i) { const int r = r0 + i;
        if (A.o) { f32x4 ov[4]; float ss = 0.f;
#pragma unroll
            for (int j = 0; j < 4; ++j) { const v2u w = ow[i][j]; ov[j] = (f32x4){bflo(w.x), bfhi(w.x), bflo(w.y), bfhi(w.y)}; ss += (ov[j].x * ov[j].x + ov[j].y * ov[j].y) + (ov[j].z * ov[j].z + ov[j].w * ov[j].w); }
            const float rstd = __builtin_amdgcn_rsqf(wave_sum(ss) * (1.0f / DM) + NORM_EPS);
#pragma unroll
            for (int j = 0; j < 4; ++j) x[i][j] = x[i][j] + cg[j] * (ov[j] * rstd);
            if (A.out32) {
#pragma unroll
                for (int j = 0; j < 4; ++j) ((f32x4*)(A.out32 + (size_t)r * DM))[F.lane + 64 * j] = x[i][j]; }
            else { v2u* xd = (v2u*)(A.xb_dst + (size_t)r * DM);
#pragma unroll
                for (int j = 0; j < 4; ++j) { v2u w; w.x = pk2(x[i][j].x, x[i][j].y); w.y = pk2(x[i][j].z, x[i][j].w); xd[F.lane + 64 * j] = w; } } }
        if (A.hdst) { float ss = 0.f;
#pragma unroll
            for (int j = 0; j < 4; ++j) ss += (x[i][j].x * x[i][j].x + x[i][j].y * x[i][j].y) + (x[i][j].z * x[i][j].z + x[i][j].w * x[i][j].w);
            const float rstd = __builtin_amdgcn_rsqf(wave_sum(ss) * (1.0f / DM) + NORM_EPS);
            v2u* hd = (v2u*)(A.hdst + (size_t)r * DM);
#pragma unroll
            for (int j = 0; j < 4; ++j) { const f32x4 hv = (x[i][j] * rstd) * ch[j] + cs[j]; v2u w; w.x = pk2(hv.x, hv.y); w.y = pk2(hv.z, hv.w); hd[F.lane + 64 * j] = w; } } }
}
__device__ __forceinline__ void e_phase(Frame& F, const EArgs& A) {
    const int gw = F.bid * NWAVES + F.wave, NGW = F.G * NWAVES;
    if (NGW == 2048) {
        const int b = gw >> 10, r0 = b * SEQ + (gw & 1023) * 8;
        e_rows<4>(F, A, b, r0); e_rows<4>(F, A, b, r0 + 4);
        if (A.nrows > TL && (gw & 3) == 0) e_rows<1>(F, A, 2, TL + (gw >> 2));
    } else { for (int r = gw; r < A.nrows; r += NGW) e_rows<1>(F, A, r < TL ? (r >> 13) : 2, r); }
}

__device__ __forceinline__ const bf16* zrow(const Frame& F, int row) { return (const bf16*)(F.ws + WS_ACT) + (size_t)row * INWP; }

typedef short bf16x8 __attribute__((ext_vector_type(8)));
#define MFMA16(a, b, c) __builtin_amdgcn_mfma_f32_16x16x32_bf16(a, b, c, 0, 0, 0)
__device__ __forceinline__ bf16x8 mk8(unsigned a, unsigned b, unsigned c, unsigned d) { const v4u v = {a, b, c, d}; return __builtin_bit_cast(bf16x8, v); }
typedef short s16x4 __attribute__((ext_vector_type(4)));
__device__ __forceinline__ v2u lds_tr16(const LAS unsigned char* p) { return __builtin_bit_cast(v2u, __builtin_amdgcn_ds_read_tr16_b64_v4i16((LAS s16x4*)p)); }
typedef __bf16 bf16x2_t __attribute__((ext_vector_type(2)));
typedef float f32x2_t __attribute__((ext_vector_type(2)));
__device__ __forceinline__ unsigned cvtpk(float lo, float hi) { const f32x2_t f = {lo, hi}; return __builtin_bit_cast(unsigned, __builtin_convertvector(f, bf16x2_t)); }
constexpr int NSC = 66;
constexpr int IM_AI = 0, IM_RI = 4608, IM_BI = 9216, IM_KI = 13824, IM_VI = 18432, IM_GAM = 34176, IMG_BYTES = 34816;
constexpr int L_IMG0 = 0, L_IMG1 = IMG_BYTES, L_PKG = 2 * IMG_BYTES, L_YL = L_PKG + 8192, L_VB = L_YL + 128 * 68 * 4, L_BON = L_VB + 128 * 64 * 2, L_CST = L_BON + 512, L_RW_END = L_CST + 2 * 3072;
static_assert(L_RW_END <= 146432, "rwkv LDS map");
constexpr size_t SUM_SLOT = 24576;

__device__ __forceinline__ void fourier_ctx1_all(Frame& F) {
    bf16* gre = (bf16*)(F.ws + WS_GC); bf16* gim = gre + TC * 256;
    const bf16* wc = (const bf16*)(F.ws + WS_FT + FT_W64C); const bf16* wsn = (const bf16*)(F.ws + WS_FT + FT_W64S);
    for (int i = F.bid * NTHR + F.tid; i < TC * 256; i += F.G * NTHR) { const int tok = i & (TC - 1), gm = i >> 9, g = gm >> 6, m = gm & 63;
        const bf16* z = zrow(F, TL + tok) + ZF + 64 * g; float sr = 0.f, si = 0.f;
#pragma unroll
        for (int c8 = 0; c8 < 8; ++c8) { float x[8], cs[8], sn[8]; unpack8(*(const v4u*)(z + 8 * c8), x); unpack8(*(const v4u*)(wc + m * 64 + 8 * c8), cs); unpack8(*(const v4u*)(wsn + m * 64 + 8 * c8), sn);
#pragma unroll
            for (int e = 0; e < 8; ++e) { sr += x[e] * cs[e]; si -= x[e] * sn[e]; } }
        const int o = ((tok >> 8) * 256 + gm) * 256 + (tok & 255);
        gre[o] = (bf16)f2bf(sr); gim[o] = (bf16)f2bf(si); }
}
__device__ __forceinline__ void fourier_ctx2_all(Frame& F, int bid0) {
    const bf16* gre = (const bf16*)(F.ws + WS_GC); const bf16* gim = gre + TC * 256; bf16* mix = (bf16*)(F.ws + WS_H);
    const int q = F.lane >> 4, c = F.lane & 15;
#pragma unroll 1
    for (int u = (F.bid - bid0) * 8 + F.wave; u < 512; u += (F.G - bid0) * 8) { const int b = u >> 8, kt = (u >> 4) & 15, gt = u & 15;
        const int k = 16 * kt + c; const bf16* pr = gre + (size_t)((b * 256 + 16 * gt + c) * 256 + 8 * q); const bf16* pi = gim + (size_t)((b * 256 + 16 * gt + c) * 256 + 8 * q);
        f32x4 acc = {0.f, 0.f, 0.f, 0.f};
#pragma unroll
        for (int cc = 0; cc < 8; ++cc) { const bf16x8 re = *(const bf16x8*)(pr + 32 * cc), im = *(const bf16x8*)(pi + 32 * cc);
            float cv[8], sv[8];
#pragma unroll
            for (int e = 0; e < 8; ++e) { const float a = (float)((k * (32 * cc + 8 * q + e)) & 255) * (1.0f / 256.0f); cv[e] = __builtin_amdgcn_cosf(a); sv[e] = __builtin_amdgcn_sinf(a); }
            acc = MFMA16(mk8(cvtpk(cv[0], cv[1]), cvtpk(cv[2], cv[3]), cvtpk(cv[4], cv[5]), cvtpk(cv[6], cv[7])), re, acc);
            acc = MFMA16(mk8(cvtpk(sv[0], sv[1]), cvtpk(sv[2], sv[3]), cvtpk(sv[4], sv[5]), cvtpk(sv[6], sv[7])), im, acc); }
#pragma unroll
        for (int r = 0; r < 4; ++r) mix[(size_t)(TL + b * 256 + 16 * kt + 4 * q + r) * DM + 16 * gt + c] = (bf16)f2bf(acc[r] * 0.0078125f); }
}
__device__ __forceinline__ void lora_transposes(Frame& F) {
    bf16* w2t = (bf16*)(F.ws + WS_W2T); bf16* a2t = (bf16*)(F.ws + WS_A2T); bf16* g2t = (bf16*)(F.ws + WS_G2T);
    const float* w2 = inp(I_W2); const float* a2 = inp(I_A2); const float* g2 = inp(I_G2);
    for (int i = F.bid * NTHR + F.tid; i < 4 * 384 * 64; i += F.G * NTHR) { const int r = i & 63, col = (i >> 6) % 384, ld = i / (384 * 64);
        w2t[i] = (bf16)f2bf(w2[((size_t)ld * 64 + r) * RW + col]); a2t[i] = (bf16)f2bf(a2[((size_t)ld * 64 + r) * RW + col]); }
    for (int i = F.bid * NTHR + F.tid; i < 2 * 384 * 128; i += F.G * NTHR) { const int r = i & 127, col = (i >> 7) % 384, l = i / (384 * 128);
        g2t[i] = (bf16)f2bf(g2[((size_t)l * 128 + r) * RW + col]); }
}

__device__ __forceinline__ float softplus_fast(float x) { return fmaxf(x, 0.f) + __logf(1.0f + __expf(-fabsf(x))); }
__device__ __forceinline__ float tanh_fast(float x) { return 1.0f - 2.0f * __builtin_amdgcn_rcpf(1.0f + __expf(2.0f * x)); }
template <int CTRL> __device__ __forceinline__ float dpp_f(float v) { return __builtin_bit_cast(float, __builtin_amdgcn_update_dpp(0, __builtin_bit_cast(int, v), CTRL, 0xf, 0xf, true)); }
__device__ __forceinline__ void lora_pass(Frame& F, int li) {
    const int q = F.lane >> 4, c16 = F.lane & 15;
    const int srow = F.tid >> 5, sk = 2 * (F.tid & 31);
    const int soff = ((sk >> 5) * 64 + srow + 16 * ((sk & 31) >> 3)) * 16 + (sk & 7) * 2;
    LAS unsigned char* BIMG = F.lds;
#pragma unroll 1
    for (int dir = 0; dir < 2; ++dir) {
        bf16* LW = (bf16*)(F.ws + WS_LW) + (size_t)dir * TT * RW; bf16* IC = (bf16*)(F.ws + WS_IC) + (size_t)dir * TT * RW;
        const bf16* w2t = (const bf16*)(F.ws + WS_W2T) + (size_t)(li * 2 + dir) * 384 * 64; const bf16* a2t = (const bf16*)(F.ws + WS_A2T) + (size_t)(li * 2 + dir) * 384 * 64;
        bf16x8 aw[3][2], aa[3][2]; f32x4 w0v[3], a0v[3];
#pragma unroll
        for (int cti = 0; cti < 3; ++cti) { const int ct = 3 * F.wave + cti, col = 16 * ct + c16;
#pragma unroll
            for (int k = 0; k < 2; ++k) { aw[cti][k] = *(const bf16x8*)(w2t + (size_t)col * 64 + 32 * k + 8 * q); aa[cti][k] = *(const bf16x8*)(a2t + (size_t)col * 64 + 32 * k + 8 * q); }
            w0v[cti] = *(const f32x4*)(inp(I_W0) + (li * 2 + dir) * RW + 16 * ct + 4 * q); a0v[cti] = *(const f32x4*)(inp(I_A0) + (li * 2 + dir) * RW + 16 * ct + 4 * q); }
        unsigned zwn = 0u; bf16x8 ban[2];
        if (F.bid < TT / 16) { zwn = *(const unsigned*)(zrow(F, 16 * F.bid + srow) + ZW + 64 * dir + sk);
#pragma unroll
            for (int k = 0; k < 2; ++k) ban[k] = *(const bf16x8*)(zrow(F, 16 * F.bid + c16) + ZA + 64 * dir + 32 * k + 8 * q); }
        int par = 0;
        __syncthreads();
#pragma unroll 1
        for (int rt = F.bid; rt < TT / 16; rt += F.G, par ^= 1) {
            LAS unsigned char* bi = BIMG + par * 2048;
            *(LAS unsigned*)(bi + soff) = cvtpk(tanh_fast(bflo(zwn)), tanh_fast(bfhi(zwn)));
            bf16x8 ba[2] = {ban[0], ban[1]};
            if (rt + F.G < TT / 16) { zwn = *(const unsigned*)(zrow(F, 16 * (rt + F.G) + srow) + ZW + 64 * dir + sk);
#pragma unroll
                for (int k = 0; k < 2; ++k) ban[k] = *(const bf16x8*)(zrow(F, 16 * (rt + F.G) + c16) + ZA + 64 * dir + 32 * k + 8 * q); }
            __syncthreads();
            bf16x8 bw[2];
#pragma unroll
            for (int k = 0; k < 2; ++k) bw[k] = *(const LAS bf16x8*)(bi + (k * 64 + F.lane) * 16);
#pragma unroll
            for (int cti = 0; cti < 3; ++cti) { const int ct = 3 * F.wave + cti;
                f32x4 dw = {0.f, 0.f, 0.f, 0.f}, da = {0.f, 0.f, 0.f, 0.f};
#pragma unroll
                for (int k = 0; k < 2; ++k) { dw = MFMA16(aw[cti][k], bw[k], dw); da = MFMA16(aa[cti][k], ba[k], da); }
                float lw[4], ic[4];
#pragma unroll
                for (int e = 0; e < 4; ++e) { lw[e] = -0.60653066f * __builtin_amdgcn_rcpf(1.0f + __expf(-(w0v[cti][e] + dw[e]))); ic[e] = __builtin_amdgcn_rcpf(1.0f + __expf(-(a0v[cti][e] + da[e]))); }
                if (dir == 0) {
#pragma unroll
                    for (int e = 0; e < 4; ++e) { lw[e] += dpp_f<0x111>(lw[e]); lw[e] += dpp_f<0x112>(lw[e]); lw[e] += dpp_f<0x114>(lw[e]); lw[e] += dpp_f<0x118>(lw[e]); } }
                else {
#pragma unroll
                    for (int e = 0; e < 4; ++e) { lw[e] += dpp_f<0x101>(lw[e]); lw[e] += dpp_f<0x102>(lw[e]); lw[e] += dpp_f<0x104>(lw[e]); lw[e] += dpp_f<0x108>(lw[e]); } }
#pragma unroll
                for (int e = 0; e < 4; ++e) lw[e] = __expf(lw[e]);
                if (c16 == (dir == 0 ? 15 : 0)) *(f32x4*)((float*)(F.ws + WS_GAM32) + ((size_t)dir * (TT / 16) + rt) * RW + 16 * ct + 4 * q) = (f32x4){lw[0], lw[1], lw[2], lw[3]};
                const size_t o = (size_t)(16 * rt + c16) * RW + 16 * ct + 4 * q;
                v2u w; w.x = cvtpk(lw[0], lw[1]); w.y = cvtpk(lw[2], lw[3]); *(v2u*)(LW + o) = w; w.x = cvtpk(ic[0], ic[1]); w.y = cvtpk(ic[2], ic[3]); *(v2u*)(IC + o) = w; }
        }
    }
}
__device__ __forceinline__ void gate_pass(Frame& F, int li) {
    const int q = F.lane >> 4, c16 = F.lane & 15;
    const int srow = F.tid >> 5, sk = 4 * (F.tid & 31);
    const int soff = ((sk >> 5) * 64 + srow + 16 * ((sk & 31) >> 3)) * 16 + (sk & 7) * 2;
    LAS unsigned char* BIMG = F.lds + 4096;
    bf16* GT = (bf16*)(F.ws + WS_GATE);
    const bf16* g2t = (const bf16*)(F.ws + WS_G2T) + (size_t)li * 384 * 128;
    bf16x8 ag[3][4];
#pragma unroll
    for (int cti = 0; cti < 3; ++cti)
#pragma unroll
        for (int k = 0; k < 4; ++k) ag[cti][k] = *(const bf16x8*)(g2t + (size_t)(16 * (3 * F.wave + cti) + c16) * 128 + 32 * k + 8 * q);
    v2u zgn = {0u, 0u};
    if (F.bid < TT / 16) zgn = *(const v2u*)(zrow(F, 16 * F.bid + srow) + ZG + sk);
    int par = 0;
    __syncthreads();
#define SG(x) __builtin_amdgcn_rcpf(1.0f + __expf(-(x)))
#pragma unroll 1
    for (int rt = F.bid; rt < TT / 16; rt += F.G, par ^= 1) {
        LAS unsigned char* bi = BIMG + par * 4096;
        *(LAS v2u*)(bi + soff) = (v2u){cvtpk(SG(bflo(zgn.x)), SG(bfhi(zgn.x))), cvtpk(SG(bflo(zgn.y)), SG(bfhi(zgn.y)))};
        if (rt + F.G < TT / 16) zgn = *(const v2u*)(zrow(F, 16 * (rt + F.G) + srow) + ZG + sk);
        __syncthreads();
        bf16x8 bg[4];
#pragma unroll
        for (int k = 0; k < 4; ++k) bg[k] = *(const LAS bf16x8*)(bi + (k * 64 + F.lane) * 16);
#pragma unroll
        for (int cti = 0; cti < 3; ++cti) { f32x4 d = {0.f, 0.f, 0.f, 0.f};
#pragma unroll
            for (int k = 0; k < 4; ++k) d = MFMA16(ag[cti][k], bg[k], d);
            v2u w; w.x = cvtpk(d[0], d[1]); w.y = cvtpk(d[2], d[3]); *(v2u*)(GT + (size_t)(16 * rt + c16) * RW + 16 * (3 * F.wave + cti) + 4 * q) = w; }
    }
#undef SG
}
__device__ __forceinline__ void chain_consts_lds(Frame& F, LAS float* cst, int li, int h, int t256) {
    for (int i = t256; i < 12 * 64; i += 256) { const int k = i >> 6, j = i & 63, ch = 64 * h + j; float v;
        if (k == 0) v = inp(I_KK)[li * RW + ch]; else if (k == 1) v = inp(I_KA)[li * RW + ch]; else if (k == 2) v = inp(I_RK)[li * RW + ch];
        else { const int tt = (k - 3) / 3, w = (k - 3) % 3; v = inp(I_CONV)[(size_t)(li * 3 + tt) * (3 * RW) + w * RW + ch]; }
        cst[i] = v; }
}
struct PrepRaw { v4u ecw, icv, epw, zr[3], zk[3], zv[3]; f32x4 g0, g1; };
__device__ __forceinline__ void prep_load(Frame& F, PrepRaw& R, int dir, int b, int h, int tl, int o, bool isctx, int step0, bool need_r = true) {
    const int L = isctx ? CTX : SEQ, rbase = isctx ? TL + b * CTX : b * SEQ, ch0 = 64 * h + 8 * o;
    const int s = step0 + tl; const int p = dir ? L - 1 - s : s; const int row = rbase + p, tb = tl & 15;
    { const bf16* LW = (const bf16*)(F.ws + WS_LW) + (size_t)dir * TT * RW + ch0; const bf16* IC = (const bf16*)(F.ws + WS_IC) + (size_t)dir * TT * RW + ch0;
      R.ecw = *(const v4u*)(LW + (size_t)row * RW); R.icv = *(const v4u*)(IC + (size_t)row * RW); R.epw = *(const v4u*)(LW + (size_t)(tb == 0 ? row : (dir ? row + 1 : row - 1)) * RW); }
#pragma unroll
    for (int tt = 0; tt < 3; ++tt) { const int pp = p + tt - 1; const bool ok = pp >= 0 && pp < L; const bf16* z = zrow(F, rbase + (ok ? pp : p)) + ch0;
        const v4u z0 = {0u, 0u, 0u, 0u};
        if (need_r) R.zr[tt] = ok ? *(const v4u*)(z + ZRR) : z0;
        R.zk[tt] = ok ? *(const v4u*)(z + ZRK) : z0; R.zv[tt] = ok ? *(const v4u*)(z + ZRV) : z0; }
    if (tb == 15) { const f32x4* gs = (const f32x4*)((const float*)(F.ws + WS_GAM32) + ((size_t)dir * (TT / 16) + (row >> 4)) * RW + ch0); R.g0 = gs[0]; R.g1 = gs[1]; }
}
__device__ __forceinline__ void prep_compute(Frame& F, const PrepRaw& R, const LAS float* cst, LAS unsigned char* img, int dir, int b, int h, int tl, int o, bool isctx, int step0, LAS unsigned char* lds_vb, LAS float* lds_bon, int pos0_local, bool need_r = true) {
    const bool BONUS = lds_vb != nullptr;
    const int L = isctx ? CTX : SEQ, rbase = isctx ? TL + b * CTX : b * SEQ, ch0 = 64 * h + 8 * o;
    const int blk = tl >> 4, tb = tl & 15;
    const int s = step0 + tl; const int p = dir ? L - 1 - s : s; const int row = rbase + p;
    const v4u ecw = R.ecw, icv = R.icv, epw = R.epw;
    v4u zr[3], zk[3], zv[3];
#pragma unroll
    for (int tt = 0; tt < 3; ++tt) { zr[tt] = need_r ? R.zr[tt] : (v4u){0u, 0u, 0u, 0u}; zk[tt] = R.zk[tt]; zv[tt] = R.zv[tt]; }
    float ecf[8], epf[8], ai[8], rv[8], kv[8], vv[8];
    unpack8(ecw, ecf); unpack8(epw, epf); unpack8(icv, ai);
#pragma unroll
    for (int e = 0; e < 8; ++e) { rv[e] = 0.f; kv[e] = 0.f; vv[e] = 0.f; }
#pragma unroll
    for (int tt = 0; tt < 3; ++tt) { float a[8], bq[8], cq[8]; unpack8(zr[tt], a); unpack8(zk[tt], bq); unpack8(zv[tt], cq);
        const LAS f32x4* w0 = (const LAS f32x4*)(cst + (3 + tt * 3 + 0) * 64 + 8 * o); const LAS f32x4* w1 = (const LAS f32x4*)(cst + (3 + tt * 3 + 1) * 64 + 8 * o); const LAS f32x4* w2 = (const LAS f32x4*)(cst + (3 + tt * 3 + 2) * 64 + 8 * o);
        const f32x4 w0a = w0[0], w0b = w0[1], w1a = w1[0], w1b = w1[1], w2a = w2[0], w2b = w2[1];
#pragma unroll
        for (int e = 0; e < 4; ++e) { if (need_r) { rv[e] += w0a[e] * a[e]; rv[e + 4] += w0b[e] * a[e + 4]; } kv[e] += w1a[e] * bq[e]; kv[e + 4] += w1b[e] * bq[e + 4]; vv[e] += w2a[e] * cq[e]; vv[e + 4] += w2b[e] * cq[e + 4]; } }
    float kkw[8], kaw[8];
    { const LAS f32x4* a = (const LAS f32x4*)(cst + 0 * 64 + 8 * o); const LAS f32x4* bq = (const LAS f32x4*)(cst + 1 * 64 + 8 * o); const f32x4 a0 = a[0], a1 = a[1], b0 = bq[0], b1 = bq[1];
#pragma unroll
      for (int e = 0; e < 4; ++e) { kkw[e] = a0[e]; kkw[e + 4] = a1[e]; kaw[e] = b0[e]; kaw[e + 4] = b1[e]; } }
    float kkr[8], ss = 0.f;
#pragma unroll
    for (int e = 0; e < 8; ++e) { kkr[e] = kv[e] * kkw[e]; ss += kkr[e] * kkr[e]; }
    ss = sum8(ss);
    const float rn = __builtin_amdgcn_rsqf(fmaxf(ss, 1e-24f));
    float At[8], Rt[8], Bt[8], Kt[8];
#pragma unroll
    for (int e = 0; e < 8; ++e) { const float kk = kkr[e] * rn, kd = kv[e] * (1.0f + (ai[e] - 1.0f) * kaw[e]); const float eprev = tb == 0 ? 1.0f : epf[e]; const float ec = ecf[e], en = __builtin_amdgcn_rcpf(ec);
        At[e] = -kk * eprev; Rt[e] = rv[e] * ec; Bt[e] = kk * ai[e] * en; Kt[e] = kd * en; }
    const int P0 = 32 * (o >> 2) + 16 * (o & 1) + 4 * ((o >> 1) & 1);
    LAS bf16* AI = (LAS bf16*)(img + IM_AI) + blk * 1152 + tb * 72 + P0, *RI = (LAS bf16*)(img + IM_RI) + blk * 1152 + tb * 72 + P0, *BI = (LAS bf16*)(img + IM_BI) + blk * 1152 + tb * 72 + P0, *KI = (LAS bf16*)(img + IM_KI) + blk * 1152 + tb * 72 + P0;
    unsigned bp[4], kp[4];
#pragma unroll
    for (int e = 0; e < 4; ++e) { bp[e] = cvtpk(Bt[2 * e], Bt[2 * e + 1]); kp[e] = cvtpk(Kt[2 * e], Kt[2 * e + 1]); }
    *(LAS v2u*)AI = (v2u){cvtpk(At[0], At[1]), cvtpk(At[2], At[3])}; *(LAS v2u*)(AI + 8) = (v2u){cvtpk(At[4], At[5]), cvtpk(At[6], At[7])};
    *(LAS v2u*)RI = (v2u){cvtpk(Rt[0], Rt[1]), cvtpk(Rt[2], Rt[3])}; *(LAS v2u*)(RI + 8) = (v2u){cvtpk(Rt[4], Rt[5]), cvtpk(Rt[6], Rt[7])};
    *(LAS v2u*)BI = (v2u){bp[0], bp[1]}; *(LAS v2u*)(BI + 8) = (v2u){bp[2], bp[3]};
    *(LAS v2u*)KI = (v2u){kp[0], kp[1]}; *(LAS v2u*)(KI + 8) = (v2u){kp[2], kp[3]};
    const unsigned vp[4] = {cvtpk(vv[0], vv[1]), cvtpk(vv[2], vv[3]), cvtpk(vv[4], vv[5]), cvtpk(vv[6], vv[7])};
    *(LAS v4u*)(img + IM_VI + blk * 2304 + tb * 144 + o * 16) = (v4u){vp[0], vp[1], vp[2], vp[3]};
    if (tb == 15) { LAS f32x4* G = (LAS f32x4*)((LAS float*)(img + IM_GAM) + blk * 64 + 8 * o); G[0] = R.g0; G[1] = R.g1; }
    if (BONUS) { float bs = 0.f; const LAS f32x4* rk = (const LAS f32x4*)(cst + 2 * 64 + 8 * o); const f32x4 r0 = rk[0], r1 = rk[1];
#pragma unroll
        for (int e = 0; e < 4; ++e) bs += rv[e] * kv[e] * r0[e] + rv[e + 4] * kv[e + 4] * r1[e];
        bs = sum8(bs);
        const int pl = dir ? pos0_local - tl : pos0_local + tl;
        *(LAS v4u*)(lds_vb + (pl * 64 + 8 * o) * 2) = (v4u){vp[0], vp[1], vp[2], vp[3]}; if (o == 0) lds_bon[pl] = bs; }
}
template <bool WANT_Y>
__device__ __forceinline__ void block_package(LAS unsigned char* img, int blk, LAS unsigned* pkg, int lane) {
    const int q = lane >> 4, c = lane & 15;
    f32x4 mab = {0.f, 0.f, 0.f, 0.f}, mak = mab, mbr = mab, mkr = mab;
#pragma unroll
    for (int k = 0; k < 2; ++k) { const int o = blk * 2304 + c * 144 + k * 64 + q * 16;
        const bf16x8 bi = *(const LAS bf16x8*)(img + IM_BI + o), ki = *(const LAS bf16x8*)(img + IM_KI + o), ai = *(const LAS bf16x8*)(img + IM_AI + o);
        mab = MFMA16(bi, ai, mab); mak = MFMA16(ki, ai, mak);
        if constexpr (WANT_Y) { const bf16x8 ri = *(const LAS bf16x8*)(img + IM_RI + o); mbr = MFMA16(bi, ri, mbr); mkr = MFMA16(ki, ri, mkr); } }
#pragma unroll
    for (int e = 0; e < 4; ++e) { const int s = 4 * q + e; if (!(s < c)) { mab[e] = 0.f; mak[e] = 0.f; } if (!(s <= c)) { mbr[e] = 0.f; mkr[e] = 0.f; } }
    f32x4 mabT = {0.f, 0.f, 0.f, 0.f};
#pragma unroll
    for (int k = 0; k < 2; ++k) { const int o = blk * 2304 + c * 144 + k * 64 + q * 16; mabT = MFMA16(*(const LAS bf16x8*)(img + IM_AI + o), *(const LAS bf16x8*)(img + IM_BI + o), mabT); }
#pragma unroll
    for (int e = 0; e < 4; ++e) if (!(c < 4 * q + e)) mabT[e] = 0.f;
    const f32x4 z4 = {0.f, 0.f, 0.f, 0.f};
#define OPND(x) mk8(cvtpk((x)[0], (x)[1]), cvtpk((x)[2], (x)[3]), 0u, 0u)
    const bf16x8 oM = OPND(mab), oMT = OPND(mabT);
    const f32x4 m2 = MFMA16(oMT, oM, z4), m2T = MFMA16(oM, oMT, z4);
    const bf16x8 oM2 = OPND(m2), oM2T = OPND(m2T);
    const f32x4 m4 = MFMA16(oM2T, oM2, z4), m4T = MFMA16(oM2, oM2T, z4);
    const f32x4 m8T = MFMA16(OPND(m4), OPND(m4T), z4);
    f32x4 nn = m2;
#pragma unroll
    for (int e = 0; e < 4; ++e) nn[e] += (4 * q + e == c) ? 1.0f : 0.0f;
    nn = MFMA16(oMT, OPND(nn), nn);
    nn = MFMA16(OPND(m4T), OPND(nn), nn);
    nn = MFMA16(OPND(m8T), OPND(nn), nn);
#undef OPND
    pkg[0 * 64 + lane] = cvtpk(nn[0], nn[1]); pkg[1 * 64 + lane] = cvtpk(nn[2], nn[3]);
    pkg[2 * 64 + lane] = cvtpk(mak[0], mak[1]); pkg[3 * 64 + lane] = cvtpk(mak[2], mak[3]);
    if constexpr (WANT_Y) { pkg[4 * 64 + lane] = cvtpk(mbr[0], mbr[1]); pkg[5 * 64 + lane] = cvtpk(mbr[2], mbr[3]); pkg[6 * 64 + lane] = cvtpk(mkr[0], mkr[1]); pkg[7 * 64 + lane] = cvtpk(mkr[2], mkr[3]); }
}
template <bool WANT_Y, bool HAS_V>
__device__ __forceinline__ f32x4 block_scan(LAS unsigned char* img, int blk, const LAS unsigned* pkg, f32x4 (&S)[4], int wq, int lane) {
    const int q = lane >> 4, c = lane & 15;
    const int trow = (4 * q + (c >> 2)) * 144, tp = c & 3;
    const int ao = blk * 2304 + c * 144 + q * 16;
    v2u vpk = {0u, 0u};
    if constexpr (HAS_V) vpk = lds_tr16(img + IM_VI + blk * 2304 + trow + (16 * wq + 4 * tp) * 2);
    unsigned pk[8];
#pragma unroll
    for (int i = 0; i < (WANT_Y ? 8 : 4); ++i) pk[i] = pkg[i * 64 + lane];
    const bf16x8 ai0 = *(const LAS bf16x8*)(img + IM_AI + ao), ai1 = *(const LAS bf16x8*)(img + IM_AI + ao + 64);
    bf16x8 ri0 = ai0, ri1 = ai1;
    if constexpr (WANT_Y) { ri0 = *(const LAS bf16x8*)(img + IM_RI + ao); ri1 = *(const LAS bf16x8*)(img + IM_RI + ao + 64); }
    bf16x8 bkt[4]; f32x4 g[4];
#pragma unroll
    for (int T = 0; T < 4; ++T) { const int po = blk * 2304 + trow + (32 * (T >> 1) + 4 * (T & 1) + 8 * tp) * 2;
        const v2u tb_ = lds_tr16(img + IM_BI + po), tk_ = lds_tr16(img + IM_KI + po); bkt[T] = mk8(tb_.x, tb_.y, tk_.x, tk_.y);
        g[T] = *(const LAS f32x4*)(img + IM_GAM + blk * 256 + (16 * T + 4 * q) * 4); }
    bf16x8 Sb[2];
#pragma unroll
    for (int k = 0; k < 2; ++k) Sb[k] = mk8(cvtpk(S[2 * k][0], S[2 * k][1]), cvtpk(S[2 * k][2], S[2 * k][3]), cvtpk(S[2 * k + 1][0], S[2 * k + 1][1]), cvtpk(S[2 * k + 1][2], S[2 * k + 1][3]));
    f32x4 rhs = {0.f, 0.f, 0.f, 0.f};
    if constexpr (HAS_V) rhs = MFMA16(mk8(0u, 0u, pk[2], pk[3]), mk8(0u, 0u, vpk.x, vpk.y), rhs);
    rhs = MFMA16(ai0, Sb[0], rhs); rhs = MFMA16(ai1, Sb[1], rhs);
    f32x4 u = {0.f, 0.f, 0.f, 0.f};
    u = MFMA16(mk8(pk[0], pk[1], 0u, 0u), mk8(cvtpk(rhs[0], rhs[1]), cvtpk(rhs[2], rhs[3]), 0u, 0u), u);
    const bf16x8 UV = mk8(cvtpk(u[0], u[1]), cvtpk(u[2], u[3]), vpk.x, vpk.y);
#pragma unroll
    for (int T = 0; T < 4; ++T) { S[T] = MFMA16(bkt[T], UV, S[T]); S[T] = S[T] * g[T]; }
    f32x4 y = {0.f, 0.f, 0.f, 0.f};
    if constexpr (WANT_Y) { y = MFMA16(ri0, Sb[0], y); y = MFMA16(ri1, Sb[1], y); y = MFMA16(mk8(pk[4], pk[5], pk[6], pk[7]), UV, y); }
    return y;
}
__device__ __forceinline__ unsigned char* sum_slot(Frame& F, int chain, int sc) { return (unsigned char*)F.out + OUT_SUM + (size_t)(chain * NSC + sc) * SUM_SLOT; }

__device__ __forceinline__ void rwkv_pass1_pair(Frame& F, int li, int pair) {
    const int g = F.wave >> 2, wq = F.wave & 3, u = 2 * pair + g;
    const int chain = u / (NSC - 1), sc = u % (NSC - 1);
    const int dir = chain / 12, b = (chain / 6) & 1, h = chain % 6;
    const bool isctx = sc < 2; const int scl = isctx ? sc : sc - 2;
    LAS unsigned char* img = F.lds + (g ? L_IMG1 : L_IMG0); LAS unsigned* pkg = (LAS unsigned*)(F.lds + L_PKG) + g * 1024;
    LAS float* cst = (LAS float*)(F.lds + L_CST) + g * 768;
    __syncthreads();
    chain_consts_lds(F, cst, li, h, F.tid & 255);
    const int q = F.lane >> 4, c = F.lane & 15;
    f32x4 SB[4], SA[4];
#pragma unroll
    for (int T = 0; T < 4; ++T)
#pragma unroll
        for (int e = 0; e < 4; ++e) { SB[T][e] = 0.0f; SA[T][e] = (16 * T + 4 * q + e == c + 16 * wq) ? 1.0f : 0.0f; }
    PrepRaw R;
    prep_load(F, R, dir, b, h, 8 * wq + (F.lane >> 3), F.lane & 7, isctx, 128 * scl, false);
    if (g == 1) __syncthreads();
#pragma unroll 1
    for (int rd = 0; rd < 4; ++rd) {
        __syncthreads();
        prep_compute(F, R, cst, img, dir, b, h, 8 * wq + (F.lane >> 3), F.lane & 7, isctx, 128 * scl + 32 * rd, nullptr, nullptr, 0, false);
        __syncthreads();
        if (rd < 3) prep_load(F, R, dir, b, h, 8 * wq + (F.lane >> 3), F.lane & 7, isctx, 128 * scl + 32 * (rd + 1), false);
        if (wq < 2) block_package<false>(img, wq, pkg + wq * 512, F.lane);
        __syncthreads();
        __builtin_amdgcn_s_setprio(3);
#pragma unroll
        for (int blk = 0; blk < 2; ++blk) { block_scan<false, true>(img, blk, pkg + blk * 512, SB, wq, F.lane); block_scan<false, false>(img, blk, pkg + blk * 512, SA, wq, F.lane); }
        __builtin_amdgcn_s_setprio(0);
    }
    if (g == 0) __syncthreads();
    unsigned char* slot = sum_slot(F, chain, sc);
    { f32x4* braw = (f32x4*)slot;
#pragma unroll
      for (int T = 0; T < 4; ++T) braw[(wq * 4 + T) * 64 + F.lane] = SB[T]; }
    { bf16* aim = (bf16*)(slot + 16384); const int kap = wq >> 1, e = (F.lane & 3) + 4 * (wq & 1), qc = c >> 2;
#pragma unroll
      for (int T = 0; T < 4; ++T)
#pragma unroll
          for (int r = 0; r < 4; ++r) { const int lc = (4 * q + r) + 16 * qc; aim[((T * 2 + kap) * 64 + lc) * 8 + e] = (bf16)f2bf(SA[T][r]); } }
}
struct P2Stage { v4u v[3]; };
__device__ __forceinline__ void p2_ld(Frame& F, P2Stage& X, int chain, int sc, int wq) {
    const v4u* s = (const v4u*)sum_slot(F, chain, sc) + (F.tid - 256);
    X.v[0] = s[wq * 256]; X.v[1] = s[1024]; X.v[2] = s[1280];
}
__device__ __forceinline__ void p2_put(Frame& F, const P2Stage& X, LAS unsigned char* bb) {
#pragma unroll
    for (int i = 0; i < 3; ++i) *(LAS v4u*)(bb + 4096 * i + 16 * (F.tid - 256)) = X.v[i];
}
constexpr int P2D = 8;
__device__ __forceinline__ void p2_math(Frame& F, const LAS unsigned char* bb, f32x4 (&S)[4], int chain, int sc, int wq) {
    f32x4* braw = (f32x4*)sum_slot(F, chain, sc);
    bf16x8 Sb[2];
#pragma unroll
    for (int k = 0; k < 2; ++k) Sb[k] = mk8(cvtpk(S[2 * k][0], S[2 * k][1]), cvtpk(S[2 * k][2], S[2 * k][3]), cvtpk(S[2 * k + 1][0], S[2 * k + 1][1]), cvtpk(S[2 * k + 1][2], S[2 * k + 1][3]));
#pragma unroll
    for (int T = 0; T < 4; ++T) { braw[(wq * 4 + T) * 64 + F.lane] = S[T];
        const f32x4 bc = *(const LAS f32x4*)(bb + (T * 64 + F.lane) * 16);
        const bf16x8 a0 = *(const LAS bf16x8*)(bb + 4096 + ((T * 2 + 0) * 64 + F.lane) * 16), a1 = *(const LAS bf16x8*)(bb + 4096 + ((T * 2 + 1) * 64 + F.lane) * 16);
        S[T] = MFMA16(a1, Sb[1], MFMA16(a0, Sb[0], bc)); }
}
__device__ __forceinline__ void rwkv_pass2_part(Frame& F, int chain, int wq) {
    constexpr int NS = NSC - 1;
    LAS unsigned char* buf = F.lds;
    __syncthreads();
    if (F.wave >= 4) {
        P2Stage X[P2D];
#pragma unroll
        for (int j = 0; j < P2D; ++j) p2_ld(F, X[j], chain, j, wq);
#pragma unroll 1
        for (int sc0 = 0; sc0 < NS - 1; sc0 += P2D) {
#pragma unroll
            for (int j = 0; j < P2D; ++j) { const int sc = sc0 + j; p2_put(F, X[j], buf + (j & 1) * 12288); p2_ld(F, X[j], chain, min(sc + P2D, NS - 1), wq); __syncthreads(); } }
        p2_put(F, X[0], buf); __syncthreads();
        return;
    }
    if (F.wave > 0) {
#pragma unroll 1
        for (int sc = 0; sc < NS; ++sc) __syncthreads();
        return;
    }
    f32x4 S[4];
#pragma unroll
    for (int T = 0; T < 4; ++T) S[T] = (f32x4){0.f, 0.f, 0.f, 0.f};
#pragma unroll 1
    for (int sc = 0; sc < NS; ++sc) { __syncthreads(); p2_math(F, buf + (sc & 1) * 12288, S, chain, sc, wq); }
    { f32x4* braw = (f32x4*)sum_slot(F, chain, NSC - 1);
#pragma unroll
      for (int T = 0; T < 4; ++T) braw[(wq * 4 + T) * 64 + F.lane] = S[T]; }
}
__device__ __forceinline__ void rwkv_pass3_unit(Frame& F, int li, int u) {

    const int pc = u % NSC, bh = u / NSC, b = bh / 6, h = bh % 6;
    const bool isctx = pc < 2; const int pcl = isctx ? pc : pc - 2, nsc = isctx ? 2 : 64;
    const int dir = F.wave >> 2, wq = F.wave & 3, q = F.lane >> 4, c = F.lane & 15;
    const int sc = dir == 0 ? pc : (isctx ? 1 - pcl : 2 + 63 - pcl);
    const int scl = dir == 0 ? pcl : nsc - 1 - pcl;
    const int chain = dir * 12 + b * 6 + h;
    LAS unsigned char* img = F.lds + (dir ? L_IMG1 : L_IMG0); LAS unsigned* pkg = (LAS unsigned*)(F.lds + L_PKG) + dir * 1024;
    LAS float* YL = (LAS float*)(F.lds + L_YL); LAS unsigned char* VB = F.lds + L_VB; LAS float* BON = (LAS float*)(F.lds + L_BON);
    LAS float* cst = (LAS float*)(F.lds + L_CST);
    __syncthreads();
    if (F.tid < 256) chain_consts_lds(F, cst, li, h, F.tid);
    f32x4 S[4];
    { const f32x4* braw = (const f32x4*)sum_slot(F, chain, sc);
#pragma unroll
      for (int T = 0; T < 4; ++T) S[T] = braw[(wq * 4 + T) * 64 + F.lane]; }
    __syncthreads();
    PrepRaw R;
    prep_load(F, R, dir, b, h, 8 * wq + (F.lane >> 3), F.lane & 7, isctx, 128 * scl);

    if (dir == 1) __syncthreads();
#pragma unroll 1
    for (int rd = 0; rd < 4; ++rd) {

        __syncthreads();

        prep_compute(F, R, cst, img, dir, b, h, 8 * wq + (F.lane >> 3), F.lane & 7, isctx, 128 * scl + 32 * rd, dir == 0 ? VB : (LAS unsigned char*)nullptr, BON, 32 * rd);

        __syncthreads();

        if (rd < 3) prep_load(F, R, dir, b, h, 8 * wq + (F.lane >> 3), F.lane & 7, isctx, 128 * scl + 32 * (rd + 1));

        if (wq < 2) block_package<true>(img, wq, pkg + wq * 512, F.lane);

        __syncthreads();

        __builtin_amdgcn_s_setprio(3);
#pragma unroll
        for (int blk = 0; blk < 2; ++blk) {
            const int t0 = 32 * rd + 16 * blk + 4 * q; LAS float* yp = YL + (dir ? 127 - t0 : t0) * 68 + c + 16 * wq; const int ys = dir ? -68 : 68;
            float yo[4] = {0.f, 0.f, 0.f, 0.f};
            if (rd >= 2) {
#pragma unroll
                for (int e = 0; e < 4; ++e) yo[e] = yp[ys * e]; }
            const f32x4 y = block_scan<true, true>(img, blk, pkg + blk * 512, S, wq, F.lane);
#pragma unroll
            for (int e = 0; e < 4; ++e) yp[ys * e] = yo[e] + y[e]; }
        __builtin_amdgcn_s_setprio(0);

    }
    if (dir == 0) __syncthreads();

    __syncthreads();
    const int rbase = (isctx ? TL + b * CTX : b * SEQ) + 128 * pcl;
    bf16* mix = (bf16*)(F.ws + WS_H);
    const int o8 = F.tid & 7;
    const f32x4 lg0 = *(const f32x4*)(inp(I_LNG) + li * RW + 64 * h + 8 * o8), lg1 = *(const f32x4*)(inp(I_LNG) + li * RW + 64 * h + 8 * o8 + 4);
    const f32x4 lb0 = *(const f32x4*)(inp(I_LNB) + li * RW + 64 * h + 8 * o8), lb1 = *(const f32x4*)(inp(I_LNB) + li * RW + 64 * h + 8 * o8 + 4);
#pragma unroll
    for (int it = 0; it < 2; ++it) { const int tl = (F.tid >> 3) + 64 * it;
        const v4u gw = *(const v4u*)((const bf16*)(F.ws + WS_GATE) + (size_t)(rbase + tl) * RW + 64 * h + 8 * o8);
        const f32x4 y0 = *(const LAS f32x4*)(YL + tl * 68 + 8 * o8), y1 = *(const LAS f32x4*)(YL + tl * 68 + 8 * o8 + 4);
        const v4u vw = *(const LAS v4u*)(VB + (tl * 64 + 8 * o8) * 2); const float bon = BON[tl];
        float yv[8], gv[8], vv[8];
#pragma unroll
        for (int e = 0; e < 4; ++e) { yv[e] = y0[e]; yv[e + 4] = y1[e]; }
        unpack8(gw, gv); unpack8(vw, vv);
        float s = 0.f;
#pragma unroll
        for (int e = 0; e < 8; ++e) s += yv[e];
        const float mu = sum8(s) * (1.0f / 64.0f); float v2 = 0.f;
#pragma unroll
        for (int e = 0; e < 8; ++e) { yv[e] -= mu; v2 += yv[e] * yv[e]; }
        const float rs = __builtin_amdgcn_rsqf(sum8(v2) * (1.0f / 64.0f) + GN_EPS);
        float ov[8];
#pragma unroll
        for (int e = 0; e < 4; ++e) { ov[e] = (yv[e] * rs * lg0[e] + lb0[e] + bon * vv[e]) * gv[e]; ov[e + 4] = (yv[e + 4] * rs * lg1[e] + lb1[e] + bon * vv[e + 4]) * gv[e + 4]; }
        *(v4u*)(mix + (size_t)(rbase + tl) * DM + 640 + 64 * h + 8 * o8) = (v4u){cvtpk(ov[0], ov[1]), cvtpk(ov[2], ov[3]), cvtpk(ov[4], ov[5]), cvtpk(ov[6], ov[7])}; }

}

constexpr int AT_KROW = 144;
constexpr int AT_VROW = 160;
__device__ __forceinline__ void attn_unit(Frame& F, int li, int u) {
    const bool cq = u >= 256;
    int b, kvh, qb;
    if (!cq) { b = u >> 7; kvh = (u >> 6) & 1; qb = u & 63; } else { const int uu = u - 256; b = uu >> 2; kvh = (uu >> 1) & 1; qb = uu & 1; }
    const int c = F.lane & 15, q = F.lane >> 4, tb = F.wave;
    bf16* mix = (bf16*)(F.ws + WS_H);
    const float* rct = (const float*)(F.ws + WS_ROPE); const float* rst = rct + SEQ * 32;
    const int qrow = (cq ? TL + b * CTX : b * SEQ) + 128 * qb + 16 * tb + c;
    const int qpos = 128 * qb + 16 * tb + c;
    bf16x8 Q[3][2];
    { float cs[8], sn[8];
      if (!cq) { const f32x4 c0 = *(const f32x4*)(rct + qpos * 32 + 8 * q), c1 = *(const f32x4*)(rct + qpos * 32 + 8 * q + 4), s0 = *(const f32x4*)(rst + qpos * 32 + 8 * q), s1 = *(const f32x4*)(rst + qpos * 32 + 8 * q + 4);
#pragma unroll
          for (int e = 0; e < 4; ++e) { cs[e] = c0[e]; cs[e + 4] = c1[e]; sn[e] = s0[e]; sn[e + 4] = s1[e]; } }
      else {
#pragma unroll
          for (int e = 0; e < 8; ++e) { cs[e] = 1.0f; sn[e] = 0.0f; } }
#pragma unroll
      for (int hh = 0; hh < 3; ++hh) { const bf16* zq = zrow(F, qrow) + ZQ + 64 * (3 * kvh + hh) + 8 * q; float x1[8], x2[8]; unpack8(*(const v4u*)zq, x1); unpack8(*(const v4u*)(zq + 32), x2);
          float o1[8], o2[8];
#pragma unroll
          for (int e = 0; e < 8; ++e) { o1[e] = 0.125f * (x1[e] * cs[e] - x2[e] * sn[e]); o2[e] = 0.125f * (x2[e] * cs[e] + x1[e] * sn[e]); }
          Q[hh][0] = mk8(pk2(o1[0], o1[1]), pk2(o1[2], o1[3]), pk2(o1[4], o1[5]), pk2(o1[6], o1[7])); Q[hh][1] = mk8(pk2(o2[0], o2[1]), pk2(o2[2], o2[3]), pk2(o2[4], o2[5]), pk2(o2[6], o2[7])); } }
    float m[3], l[3]; f32x4 O[3][4];
#pragma unroll
    for (int hh = 0; hh < 3; ++hh) { m[hh] = inp(I_SINK)[li * 6 + 3 * kvh + hh]; l[hh] = q == 0 ? 1.0f : 0.0f;
#pragma unroll
        for (int dt = 0; dt < 4; ++dt) O[hh][dt] = (f32x4){0.f, 0.f, 0.f, 0.f}; }
    LAS unsigned char* KI = F.lds;
#pragma unroll 1
    for (int stage = cq ? 1 : 0; stage < 2; ++stage) {
        const int nkeys = stage == 0 ? 384 : 256;
        LAS unsigned char* VTI = F.lds + 384 * AT_KROW;
        const int kpos0 = 128 * (qb - 1);

        __syncthreads();
        struct KVRaw { v4u k1, k2, v1, v2; f32x4 c0, c1, s0, s1; };
        auto kv_load = [&](int pc, KVRaw& r) { const int key = pc >> 2, o = pc & 3; const bf16* zk;
            if (stage == 0) { int kp = kpos0 + key; kp = kp < 0 ? 0 : (kp >= SEQ ? SEQ - 1 : kp); zk = zrow(F, b * SEQ + kp) + 64 * kvh + 8 * o;
                r.c0 = *(const f32x4*)(rct + kp * 32 + 8 * o); r.c1 = *(const f32x4*)(rct + kp * 32 + 8 * o + 4); r.s0 = *(const f32x4*)(rst + kp * 32 + 8 * o); r.s1 = *(const f32x4*)(rst + kp * 32 + 8 * o + 4); }
            else { zk = zrow(F, TL + b * CTX + key) + 64 * kvh + 8 * o; r.c0 = (f32x4){1.f, 1.f, 1.f, 1.f}; r.c1 = r.c0; r.s0 = (f32x4){0.f, 0.f, 0.f, 0.f}; r.s1 = r.s0; }
            r.k1 = *(const v4u*)(zk + ZK); r.k2 = *(const v4u*)(zk + ZK + 32); r.v1 = *(const v4u*)(zk + ZV); r.v2 = *(const v4u*)(zk + ZV + 32); };
        auto kv_put = [&](int pc, const KVRaw& r) { const int key = pc >> 2, o = pc & 3;
            float cs[8], sn[8];
#pragma unroll
            for (int e = 0; e < 4; ++e) { cs[e] = r.c0[e]; cs[e + 4] = r.c1[e]; sn[e] = r.s0[e]; sn[e + 4] = r.s1[e]; }
            float x1[8], x2[8]; unpack8(r.k1, x1); unpack8(r.k2, x2);
            float o1[8], o2[8];
#pragma unroll
            for (int e = 0; e < 8; ++e) { o1[e] = x1[e] * cs[e] - x2[e] * sn[e]; o2[e] = x2[e] * cs[e] + x1[e] * sn[e]; }
            *(LAS v4u*)(KI + key * AT_KROW + o * 16) = (v4u){pk2(o1[0], o1[1]), pk2(o1[2], o1[3]), pk2(o1[4], o1[5]), pk2(o1[6], o1[7])};
            *(LAS v4u*)(KI + key * AT_KROW + 64 + o * 16) = (v4u){pk2(o2[0], o2[1]), pk2(o2[2], o2[3]), pk2(o2[4], o2[5]), pk2(o2[6], o2[7])};
            *(LAS v4u*)(VTI + key * AT_VROW + o * 16) = r.v1; *(LAS v4u*)(VTI + key * AT_VROW + 64 + o * 16) = r.v2; };
        { KVRaw RA, RB; kv_load(F.tid, RA); kv_load(F.tid + NTHR, RB);
          kv_put(F.tid, RA);
          if (stage == 0) kv_load(F.tid + 2 * NTHR, RA);
          kv_put(F.tid + NTHR, RB);
          if (stage == 0) kv_put(F.tid + 2 * NTHR, RA); }
        __syncthreads();

        const int npair = nkeys / 32;
        const int Q0 = 128 * qb + 16 * tb;
#pragma unroll 1
        for (int kp = 0; kp < npair; ++kp) {
            const int kb = kpos0 + 32 * kp;
            if (stage == 0 && (kb + 31 < Q0 - 128 || kb > Q0 + 143 || kb + 31 < 0 || kb >= SEQ)) continue;
            bf16x8 K[2][2], V[4];
#pragma unroll
            for (int t = 0; t < 2; ++t)
#pragma unroll
                for (int k = 0; k < 2; ++k) K[t][k] = *(const LAS bf16x8*)(KI + (32 * kp + 16 * t + c) * AT_KROW + k * 64 + q * 16);
#pragma unroll
            for (int dt = 0; dt < 4; ++dt) { const int off = (32 * kp + 4 * q + (c >> 2)) * AT_VROW + (16 * dt + 4 * (c & 3)) * 2;
                const v2u t0 = lds_tr16(VTI + off), t1 = lds_tr16(VTI + off + 16 * AT_VROW); V[dt] = mk8(t0.x, t0.y, t1.x, t1.y); }
            bool ok0[4], ok1[4];
#pragma unroll
            for (int e = 0; e < 4; ++e) { const int k0 = kb + 4 * q + e, k1 = k0 + 16;
                ok0[e] = stage == 1 || (k0 >= 0 && k0 < SEQ && k0 >= qpos - 128 && k0 <= qpos + 128);
                ok1[e] = stage == 1 || (k1 >= 0 && k1 < SEQ && k1 >= qpos - 128 && k1 <= qpos + 128); }
#pragma unroll
            for (int hh = 0; hh < 3; ++hh) {
                f32x4 s0 = {0.f, 0.f, 0.f, 0.f}, s1 = {0.f, 0.f, 0.f, 0.f};
                s0 = MFMA16(K[0][0], Q[hh][0], s0); s0 = MFMA16(K[0][1], Q[hh][1], s0);
                s1 = MFMA16(K[1][0], Q[hh][0], s1); s1 = MFMA16(K[1][1], Q[hh][1], s1);
                float mx = -INFINITY;
#pragma unroll
                for (int e = 0; e < 4; ++e) { s0[e] = ok0[e] ? s0[e] : -INFINITY; s1[e] = ok1[e] ? s1[e] : -INFINITY; mx = fmaxf(mx, fmaxf(s0[e], s1[e])); }
                mx = xrow_max(mx);
                const float mn = fmaxf(m[hh], mx); const float alpha = __expf(m[hh] - mn); m[hh] = mn;
                float ps = 0.f;
#pragma unroll
                for (int e = 0; e < 4; ++e) { s0[e] = __expf(s0[e] - mn); s1[e] = __expf(s1[e] - mn); ps += s0[e] + s1[e]; }
                l[hh] = l[hh] * alpha + ps;
                const bf16x8 P = mk8(cvtpk(s0[0], s0[1]), cvtpk(s0[2], s0[3]), cvtpk(s1[0], s1[1]), cvtpk(s1[2], s1[3]));
#pragma unroll
                for (int dt = 0; dt < 4; ++dt) { O[hh][dt] = O[hh][dt] * alpha; O[hh][dt] = MFMA16(V[dt], P, O[hh][dt]); }
            }
        }

    }
#pragma unroll
    for (int hh = 0; hh < 3; ++hh) { const float lt = xrow_sum(l[hh]); const float inv = __builtin_amdgcn_rcpf(lt);
#pragma unroll
        for (int dt = 0; dt < 4; ++dt) { v2u w; w.x = pk2(O[hh][dt][0] * inv, O[hh][dt][1] * inv); w.y = pk2(O[hh][dt][2] * inv, O[hh][dt][3] * inv);
            *(v2u*)(mix + (size_t)qrow * DM + 256 + 64 * (3 * kvh + hh) + 16 * dt + 4 * q) = w; } }
}

__device__ __forceinline__ void fourier_tables(Frame& F) {
    bf16* t = (bf16*)(F.ws + WS_FT);
    for (int i = F.bid * NTHR + F.tid; i < 64 * 64; i += F.G * NTHR) { const int r = i >> 6, cc = i & 63; const float a = (float)((r * cc) & 63) * (1.0f / 64.0f);
        const float cs = __builtin_amdgcn_cosf(a), sn = __builtin_amdgcn_sinf(a);
        t[FT_W64C / 2 + i] = (bf16)f2bf(cs); t[FT_W64S / 2 + i] = (bf16)f2bf(sn);
        const int pj = (cc & ~31) | (((cc & 15) >> 2) << 3) | (((cc >> 4) & 1) << 2) | (cc & 3);
        t[FT_T64C / 2 + r * 64 + pj] = (bf16)f2bf(cs); t[FT_T64S / 2 + r * 64 + pj] = (bf16)f2bf(sn); }
    for (int i = F.bid * NTHR + F.tid; i < 128 * 128; i += F.G * NTHR) { const int r = i >> 7, cc = i & 127; const float a = (float)((r * cc) & 127) * (1.0f / 128.0f);
        const float cs = __builtin_amdgcn_cosf(a), sn = __builtin_amdgcn_sinf(a);
        t[FT_W128C / 2 + i] = (bf16)f2bf(cs); t[FT_W128S / 2 + i] = (bf16)f2bf(sn);
        const int pj = (cc & ~31) | (((cc & 15) >> 2) << 3) | (((cc >> 4) & 1) << 2) | (cc & 3);
        t[FT_T128C / 2 + r * 128 + pj] = (bf16)f2bf(cs); t[FT_T128S / 2 + r * 128 + pj] = (bf16)f2bf(sn); }
}
constexpr int FA_ROW = 544;
__device__ __forceinline__ void fourier_a_fast(Frame& F, int u) {
    const int b = u >> 7, n2 = u & 127, c = F.lane & 15, q = F.lane >> 4;
    LAS unsigned char* IMG = F.lds;
    v4u sv[4];
#pragma unroll
    for (int i = 0; i < 4; ++i) { const int pc = F.tid + NTHR * i, n1 = pc >> 5, c8 = pc & 31; sv[i] = *(const v4u*)(zrow(F, b * SEQ + 128 * n1 + n2) + ZF + 8 * c8); }
    const bf16* wc = (const bf16*)(F.ws + WS_FT + FT_T64C); const bf16* wsn = (const bf16*)(F.ws + WS_FT + FT_T64S);
    bf16* far = (bf16*)((unsigned char*)F.out + OUT_FA); bf16* fai = far + (size_t)NB * 64 * 128 * 256;
    bf16x8 Bc[4][2], Bs[4][2];
#pragma unroll
    for (int kt = 0; kt < 4; ++kt)
#pragma unroll
        for (int k = 0; k < 2; ++k) { Bc[kt][k] = *(const bf16x8*)(wc + (16 * kt + c) * 64 + 32 * k + 8 * q); Bs[kt][k] = *(const bf16x8*)(wsn + (16 * kt + c) * 64 + 32 * k + 8 * q); }
    __syncthreads();
#pragma unroll
    for (int i = 0; i < 4; ++i) { const int pc = F.tid + NTHR * i, n1 = pc >> 5, c8 = pc & 31; *(LAS v4u*)(IMG + n1 * FA_ROW + c8 * 16) = sv[i]; }
    __syncthreads();
    const int tq = c >> 2, tp = c & 3;
#pragma unroll
    for (int ci = 0; ci < 2; ++ci) { const int ct = 2 * F.wave + ci;
        bf16x8 A[2];
#pragma unroll
        for (int k = 0; k < 2; ++k) { const LAS unsigned char* p = IMG + (32 * k + 4 * q + tq) * FA_ROW + (16 * ct + 4 * tp) * 2;
            const v2u t0 = lds_tr16(p), t1 = lds_tr16(p + 16 * FA_ROW); A[k] = mk8(t0.x, t0.y, t1.x, t1.y); }
#pragma unroll
        for (int kt = 0; kt < 4; ++kt) { f32x4 sr = {0.f, 0.f, 0.f, 0.f}, si = {0.f, 0.f, 0.f, 0.f};
#pragma unroll
            for (int k = 0; k < 2; ++k) { sr = MFMA16(A[k], Bc[kt][k], sr); si = MFMA16(A[k], Bs[kt][k], si); }
            const int k1 = 16 * kt + c; const float tw = (float)(n2 * k1) * (1.0f / 8192.0f); const float tc = __builtin_amdgcn_cosf(tw), ts = __builtin_amdgcn_sinf(tw);
            float xr[4], xi[4];
#pragma unroll
            for (int e = 0; e < 4; ++e) { const float ar = sr[e], ai = -si[e]; xr[e] = ar * tc + ai * ts; xi[e] = ai * tc - ar * ts; }
            const size_t o = (((size_t)b * 64 + k1) * 128 + n2) * 256 + 16 * ct + 4 * q;
            v2u w; w.x = pk2(xr[0], xr[1]); w.y = pk2(xr[2], xr[3]); *(v2u*)(far + o) = w; w.x = pk2(xi[0], xi[1]); w.y = pk2(xi[2], xi[3]); *(v2u*)(fai + o) = w; } }
}
constexpr int FC_ROW = 160;
__device__ __forceinline__ void fourier_c_fast(Frame& F, int u) {
    const int g = u & 3, k1 = (u >> 2) & 63, b = u >> 8, c = F.lane & 15, q = F.lane >> 4;
    LAS unsigned char* IR = F.lds; LAS unsigned char* II = F.lds + 128 * FC_ROW;
    const bf16* far = (const bf16*)((unsigned char*)F.out + OUT_FA) + (((size_t)b * 64 + k1) * 128) * 256 + 64 * g; const bf16* fai = far + (size_t)NB * 64 * 128 * 256;
    v4u svr[2], svi[2];
#pragma unroll
    for (int i = 0; i < 2; ++i) { const int pc = F.tid + NTHR * i, n2 = pc >> 3, c8 = pc & 7; svr[i] = *(const v4u*)(far + (size_t)n2 * 256 + 8 * c8); svi[i] = *(const v4u*)(fai + (size_t)n2 * 256 + 8 * c8); }
    __syncthreads();
#pragma unroll
    for (int i = 0; i < 2; ++i) { const int pc = F.tid + NTHR * i, n2 = pc >> 3, c8 = pc & 7; *(LAS v4u*)(IR + n2 * FC_ROW + c8 * 16) = svr[i]; *(LAS v4u*)(II + n2 * FC_ROW + c8 * 16) = svi[i]; }
    __syncthreads();
    const bf16* wc = (const bf16*)(F.ws + WS_FT + FT_T128C); const bf16* wsn = (const bf16*)(F.ws + WS_FT + FT_T128S);
    const bf16* tcn = (const bf16*)(F.ws + WS_FT + FT_T64C); const bf16* tsn = (const bf16*)(F.ws + WS_FT + FT_T64S);
    f32x4 Pr[4], Pi[4];
#pragma unroll
    for (int ct = 0; ct < 4; ++ct) { Pr[ct] = (f32x4){0.f, 0.f, 0.f, 0.f}; Pi[ct] = (f32x4){0.f, 0.f, 0.f, 0.f}; }
    const int tq = c >> 2, tp = c & 3;
#pragma unroll
    for (int k = 0; k < 4; ++k) { const bf16x8 bc = *(const bf16x8*)(wc + (16 * F.wave + c) * 128 + 32 * k + 8 * q), bs = *(const bf16x8*)(wsn + (16 * F.wave + c) * 128 + 32 * k + 8 * q);
        const v4u bsu = __builtin_bit_cast(v4u, bs); const bf16x8 bsn = mk8(bsu.x ^ 0x80008000u, bsu.y ^ 0x80008000u, bsu.z ^ 0x80008000u, bsu.w ^ 0x80008000u);
#pragma unroll
        for (int ct = 0; ct < 4; ++ct) { const int off = (32 * k + 4 * q + tq) * FC_ROW + (16 * ct + 4 * tp) * 2;
            const v2u r0 = lds_tr16(IR + off), r1 = lds_tr16(IR + off + 16 * FC_ROW), i0 = lds_tr16(II + off), i1 = lds_tr16(II + off + 16 * FC_ROW);
            const bf16x8 ar = mk8(r0.x, r0.y, r1.x, r1.y), ai = mk8(i0.x, i0.y, i1.x, i1.y);
            Pr[ct] = MFMA16(ar, bc, Pr[ct]); Pr[ct] = MFMA16(ai, bs, Pr[ct]); Pi[ct] = MFMA16(ai, bc, Pi[ct]); Pi[ct] = MFMA16(ar, bsn, Pi[ct]); } }
    bf16x8 Br[2], Bi[2];
#pragma unroll
    for (int k = 0; k < 2; ++k) { Br[k] = mk8(cvtpk(Pr[2 * k][0], Pr[2 * k][1]), cvtpk(Pr[2 * k][2], Pr[2 * k][3]), cvtpk(Pr[2 * k + 1][0], Pr[2 * k + 1][1]), cvtpk(Pr[2 * k + 1][2], Pr[2 * k + 1][3]));
        Bi[k] = mk8(cvtpk(Pi[2 * k][0], Pi[2 * k][1]), cvtpk(Pi[2 * k][2], Pi[2 * k][3]), cvtpk(Pi[2 * k + 1][0], Pi[2 * k + 1][1]), cvtpk(Pi[2 * k + 1][2], Pi[2 * k + 1][3])); }
    bf16* mix = (bf16*)(F.ws + WS_H);
    const float scale = 0.0013810679320049757f;
    const int k2 = 16 * F.wave + c; const size_t row = (size_t)b * SEQ + k1 + 64 * k2;
#pragma unroll
    for (int mt = 0; mt < 4; ++mt) { f32x4 y = {0.f, 0.f, 0.f, 0.f};
#pragma unroll
        for (int k = 0; k < 2; ++k) { const bf16x8 ac = *(const bf16x8*)(tcn + (16 * mt + c) * 64 + 32 * k + 8 * q), as = *(const bf16x8*)(tsn + (16 * mt + c) * 64 + 32 * k + 8 * q);
            y = MFMA16(ac, Br[k], y); y = MFMA16(as, Bi[k], y); }
        v2u w; w.x = pk2(y[0] * scale, y[1] * scale); w.y = pk2(y[2] * scale, y[3] * scale);
        *(v2u*)(mix + row * DM + 64 * g + 16 * mt + 4 * q) = w; }
}

#define XB_TMO      128
#define XB_XCNT(j)  (256  + 64 * (j))
#define XB_XSUB(j)  (1280 + 64 * (j))
#define XB_XGEN(j)  (2304 + 64 * (j))
#define XB_TOP      3328
#define XB_TOPGEN   3392
#define XCD_BAR_WORDS 3456
#define XB_SPIN_CAP (1u << 23)
__device__ __forceinline__ unsigned xb_ld(unsigned* p)              { return __hip_atomic_load(p, __ATOMIC_RELAXED, __HIP_MEMORY_SCOPE_AGENT); }
__device__ __forceinline__ unsigned xb_add(unsigned* p, unsigned v) { return __hip_atomic_fetch_add(p, v, __ATOMIC_RELAXED, __HIP_MEMORY_SCOPE_AGENT); }
__device__ __forceinline__ unsigned xb_xcc_id() { return (unsigned)__builtin_amdgcn_s_getreg((3 << 11) | 20) & 0xFu; }
#define XB_SPIN(cond, bar) do { unsigned _sp = 0; while (cond) { __builtin_amdgcn_s_sleep(1); \
    if ((++_sp & 255u) == 0u) { if (xb_ld(&(bar)[XB_TMO])) break; if (_sp > XB_SPIN_CAP) { atomicAdd(&(bar)[XB_TMO], 1u); break; } } } } while (0)
struct XcdBarrier { unsigned* bar; unsigned x; volatile LAS unsigned* st; };
__device__ __forceinline__ XcdBarrier xcd_barrier_post(unsigned* bar, volatile LAS unsigned* st) {
    XcdBarrier b; b.bar = bar; b.x = xb_xcc_id(); b.st = st;
    if (threadIdx.x == 0) (void)xb_add(&bar[XB_XCNT(b.x)], 1u);
    return b;
}
__device__ __forceinline__ void xcd_barrier_complete(unsigned* bar, unsigned x, unsigned& nloc, unsigned& nx) {
    const unsigned G = gridDim.x * gridDim.y * gridDim.z;
    unsigned sum, cnt, mine, sp = 0u;
    for (;;) {
        sum = 0u; cnt = 0u; mine = 0u;
#pragma unroll
        for (unsigned j = 0; j < 16; ++j) { const unsigned c = xb_ld(&bar[XB_XCNT(j)]); sum += c; cnt += (c > 0u) ? 1u : 0u; mine = (j == x) ? c : mine; }
        if (sum == G) break;
        __builtin_amdgcn_s_sleep(1);
        if ((++sp & 255u) == 0u) { if (xb_ld(&bar[XB_TMO])) break; if (sp > XB_SPIN_CAP) { atomicAdd(&bar[XB_TMO], 1u); break; } }
    }
    nloc = mine > 0u ? mine : 1u; nx = cnt > 0u ? cnt : 1u;
}
__device__ __forceinline__ void xcd_barrier(const XcdBarrier& b0) {
    XcdBarrier b; { unsigned* p = b0.bar; unsigned x = __builtin_amdgcn_readfirstlane(b0.x); unsigned st = (unsigned)(size_t)b0.st; asm volatile("" : "+s"(p), "+s"(x), "+s"(st)); b.bar = p; b.x = x; b.st = (volatile LAS unsigned*)(size_t)st; }
    asm volatile("s_waitcnt vmcnt(0)" ::: "memory");
    __syncthreads();
    if (threadIdx.x == 0) {
        unsigned* bar = b.bar;
        __builtin_amdgcn_s_waitcnt(0);
        unsigned nloc = b.st[0], nx = b.st[1];
        if (nloc == 0u) { xcd_barrier_complete(bar, b.x, nloc, nx); b.st[0] = nloc; b.st[1] = nx; }
        const unsigned old = xb_add(&bar[XB_XSUB(b.x)], 1u);
        const unsigned gen = old / nloc;
        if (old + 1u == (gen + 1u) * nloc) {
            __builtin_amdgcn_fence(__ATOMIC_RELEASE, "agent");
            asm volatile("s_waitcnt vmcnt(0)" ::: "memory");
            const unsigned og = xb_add(&bar[XB_TOP], 1u);
            const unsigned tg = og / nx;
            if (og + 1u == (tg + 1u) * nx) xb_add(&bar[XB_TOPGEN], 1u);
            else XB_SPIN(xb_ld(&bar[XB_TOPGEN]) == tg, bar);
            __builtin_amdgcn_fence(__ATOMIC_ACQUIRE, "agent");
            xb_add(&bar[XB_XGEN(b.x)], 1u);
            asm volatile("s_waitcnt vmcnt(0)" ::: "memory");
        } else {
            XB_SPIN(xb_ld(&bar[XB_XGEN(b.x)]) == gen, bar);
            __builtin_amdgcn_fence(__ATOMIC_ACQUIRE, "agent");
            asm volatile("s_waitcnt vmcnt(0)" ::: "memory");
        }
    }
    __syncthreads();
}

__device__ __forceinline__ int queue_next(Frame& F, unsigned* cnt) {
    volatile LAS int* slot = (volatile LAS int*)(F.lds + MISC_OFF + 64);
    __syncthreads();
    if (F.tid == 0) *slot = (int)__hip_atomic_fetch_add(cnt, 1u, __ATOMIC_RELAXED, __HIP_MEMORY_SCOPE_AGENT);
    __syncthreads();
    return *slot;
}
template <int KIND> __device__ __forceinline__ void run_phase(const Frame& F0, int li, int second) {
    Frame F;
    { int t = threadIdx.x; asm volatile("" : "+v"(t)); F.tid = t; F.lane = t & 63; F.wave = __builtin_amdgcn_readfirstlane(t >> 6);
      int g = F0.G, b = F0.bid; asm volatile("" : "+s"(g), "+s"(b)); F.G = g; F.bid = b;
      __attribute__((address_space(1))) unsigned char* w = (__attribute__((address_space(1))) unsigned char*)F0.ws; __attribute__((address_space(1))) float* o = (__attribute__((address_space(1))) float*)F0.out;
      asm volatile("" : "+s"(w), "+s"(o)); F.ws = (unsigned char*)w; F.out = (float*)o;
      unsigned l = (unsigned)(size_t)F0.lds; asm volatile("" : "+s"(l)); F.lds = (LAS unsigned char*)(size_t)l;
      asm volatile("" : "+s"(li), "+s"(second)); }
    float* modv = (float*)(F.ws + WS_MOD);
    bf16* XB = (bf16*)(F.ws + WS_XB);
    bf16* H = (bf16*)(F.ws + WS_H); bf16* ACT = (bf16*)(F.ws + WS_ACT); bf16* O = (bf16*)(F.ws + WS_O);
    const float* ng = inp(I_NORMG) + (size_t)li * 6 * DM; const float* mv = modv + (size_t)li * 3 * 9216;
    const bool last = li == 1;
    if constexpr (KIND == 100) { convert_weights(F, 0); mod_gemv(F); rope_tables(F); lora_transposes(F); fourier_tables(F); }
    if constexpr (KIND == 101) { EArgs A{}; A.xl_src = inp(I_X); A.xc_src = inp(I_CTX); A.o = nullptr; A.hdst = H; A.modv_h = modv; A.shidx = 0; A.scidx = 1; A.gpre = inp(I_NORMG); A.nrows = TT; e_phase(F, A); }
    if constexpr (KIND == 0) {
        const bf16* wi = (const bf16*)(F.ws + (second ? WS_WI2 : WS_WI1)); const bool withctx = !(last && second);
        if (!withctx || F.G != 256) { pg8::Gemm g{H, wi, withctx ? TT : TL, NWI, DM}; pg8::StaticOrder S; S.init(g.M, g.N, F.G, F.bid);
            pg8::EpiSwiglu E{ACT, FFNP}; pg8::gemm_phase<pg8::EpiSwiglu, pg8::StaticOrder, true, true>(F.lds, g, S, E, F.tid); }
        else { unsigned* cnt = (unsigned*)(F.ws + WS_CTL) + 8192 + 64 * (li * 2 + second);
            pg8::Gemm g{H, wi, TT, NWI, DM}; pg8::UpOrder S; S.init(NWI, F.G, F.bid, cnt);
            pg8::EpiSwiglu E{ACT, FFNP}; pg8::gemm_phase<pg8::EpiSwiglu, pg8::UpOrder, true, true>(F.lds, g, S, E, F.tid);
            if (F.bid >= 248) {
                if (F.tid == 0) { unsigned sp = 0; while (__hip_atomic_load(cnt, __ATOMIC_RELAXED, __HIP_MEMORY_SCOPE_AGENT) < 352u && ++sp < (1u << 24)) __builtin_amdgcn_s_sleep(8);
                    __builtin_amdgcn_fence(__ATOMIC_ACQUIRE, "agent"); asm volatile("s_waitcnt vmcnt(0)" ::: "memory"); }
                __syncthreads();
                const int k = F.bid - 248; pg8::Gemm g2{ACT, (const bf16*)(F.ws + (second ? WS_WO2 : WS_WO1)), TT, DM, FFNP}; pg8::OneUnit S2{64 + (k >> 2), k & 3};
                pg8::EpiBf16 E2{O, DM}; pg8::gemm_phase<pg8::EpiBf16, pg8::OneUnit, false, true>(F.lds, g2, S2, E2, F.tid); } } }
    if constexpr (KIND == 1) {
        const bool ctxhere = F.G != 256 && !(last && second);
        pg8::Gemm g{ACT, (const bf16*)(F.ws + (second ? WS_WO2 : WS_WO1)), ctxhere ? TT : TL, DM, FFNP}; pg8::StaticOrder S; S.init(g.M, g.N, F.G, F.bid);
        pg8::EpiBf16 E{O, DM}; pg8::gemm_phase<pg8::EpiBf16, pg8::StaticOrder, true, true>(F.lds, g, S, E, F.tid); }
    if constexpr (KIND == 2) {
        EArgs A{}; A.xl_src = inp(I_X); A.xc_src = inp(I_CTX); A.xb_src = li == 0 ? (const bf16*)nullptr : XB; A.xb_dst = XB; A.o = O; A.modv_g = mv; A.gidx = 2; A.gmul = 0.5f; A.gpost = ng + 1 * DM;
        A.hdst = H; A.modv_h = mv; A.shidx = 3; A.scidx = 4; A.gpre = ng + 2 * DM; A.nrows = TT; e_phase(F, A); }
    if constexpr (KIND == 3) {
        pg8::Gemm g{H, (const bf16*)(F.ws + WS_WIN), TT, INWP, DM}; pg8::StaticOrder S; S.init(g.M, g.N, F.G, F.bid);
        pg8::EpiBf16 E{ACT, INWP}; pg8::gemm_phase<pg8::EpiBf16, pg8::StaticOrder, true, true>(F.lds, g, S, E, F.tid); }
    if constexpr (KIND == 4) {
        { lora_pass(F, li); }
        { gate_pass(F, li); }
        { if (li == 0) fourier_ctx1_all(F); }
        asm volatile("s_waitcnt vmcnt(0)" ::: "memory"); __syncthreads();
        if (F.tid == 0) { __builtin_amdgcn_fence(__ATOMIC_RELEASE, "agent"); asm volatile("s_waitcnt vmcnt(0)" ::: "memory");
            __hip_atomic_fetch_add((unsigned*)(F.ws + WS_CTL) + 8192 + 64 * (4 + 2 * li) + 32, 1u, __ATOMIC_RELAXED, __HIP_MEMORY_SCOPE_AGENT); } }
    if constexpr (KIND == 5) {
        unsigned* cnt = (unsigned*)(F.ws + WS_CTL) + 8192 + 64 * (4 + 2 * li);
        const int na = li == 0 ? 264 : 256;
        { for (int it = queue_next(F, cnt); it < na; it = queue_next(F, cnt)) attn_unit(F, li, it); }
        __syncthreads();
        if (F.tid == 0) { unsigned sp = 0; while (__hip_atomic_load(cnt + 32, __ATOMIC_RELAXED, __HIP_MEMORY_SCOPE_AGENT) < (unsigned)F.G && ++sp < (1u << 24)) __builtin_amdgcn_s_sleep(8);
            __builtin_amdgcn_fence(__ATOMIC_ACQUIRE, "agent"); asm volatile("s_waitcnt vmcnt(0)" ::: "memory"); }
        __syncthreads();
        { for (int it = queue_next(F, cnt + 16); it < 12 * (NSC - 1); it = queue_next(F, cnt + 16)) rwkv_pass1_pair(F, li, it); }
        { for (int it = queue_next(F, cnt + 48); it < 256; it = queue_next(F, cnt + 48)) fourier_a_fast(F, it); } }
    if constexpr (KIND == 11) {
        if (F.bid < 96) { const int xcd = F.bid & 7, slot = F.bid >> 3; rwkv_pass2_part(F, (slot >> 2) * 8 + xcd, slot & 3); }
        else { convert_weights(F, 1, li == 0 ? 1 : 2, 96, F.G - 96);

            if (li == 0) fourier_ctx2_all(F, 96); } }
    if constexpr (KIND == 12) {
        unsigned* cnt = (unsigned*)(F.ws + WS_CTL) + 8192 + 64 * (5 + 2 * li);
        const int np3 = li == 0 ? 12 * NSC : 12 * 64;
        const bool early = li == 0 && F.G == 256;
#define P3_UNIT(it) do { rwkv_pass3_unit(F, li, li == 0 ? ((it) < 24 ? ((it) >> 1) * NSC + ((it) & 1) : (((it) - 24) / 64) * NSC + 2 + ((it) - 24) % 64) : ((it) / 64) * NSC + 2 + (it) % 64); \
            if (early && (it) < 24) { asm volatile("s_waitcnt vmcnt(0)" ::: "memory"); __builtin_amdgcn_fence(__ATOMIC_RELEASE, "agent"); asm volatile("s_waitcnt vmcnt(0)" ::: "memory"); \
                if (F.lane == 0) __hip_atomic_fetch_add(cnt + 32, 1u, __ATOMIC_RELAXED, __HIP_MEMORY_SCOPE_AGENT); } } while (0)
        {
          if (early && F.bid >= 248) {
              { const int it = queue_next(F, cnt); if (it < np3) P3_UNIT(it); }
              __syncthreads();
              if (F.tid == 0) { unsigned sp = 0; while (__hip_atomic_load(cnt + 32, __ATOMIC_RELAXED, __HIP_MEMORY_SCOPE_AGENT) < 192u && ++sp < (1u << 24)) __builtin_amdgcn_s_sleep(8);
                  __builtin_amdgcn_fence(__ATOMIC_ACQUIRE, "agent"); asm volatile("s_waitcnt vmcnt(0)" ::: "memory"); }
              __syncthreads();
              const int k = F.bid - 248; pg8::Gemm g2{H, (const bf16*)(F.ws + WS_WOUT), TT, DM, DM}; pg8::OneUnit S2{64 + (k >> 2), k & 3};
              pg8::EpiBf16 E2{(bf16*)(F.ws + WS_XC) - (size_t)TL * DM, DM}; pg8::gemm_phase<pg8::EpiBf16, pg8::OneUnit, false, true>(F.lds, g2, S2, E2, F.tid); }
          for (int it = queue_next(F, cnt); it < np3; it = queue_next(F, cnt)) P3_UNIT(it);
 }
#undef P3_UNIT
        { for (int it = queue_next(F, cnt + 16); it < 512; it = queue_next(F, cnt + 16)) fourier_c_fast(F, it); } }
    if constexpr (KIND == 6) {
        pg8::Gemm g{H, (const bf16*)(F.ws + WS_WOUT), (last || F.G == 256) ? TL : TT, DM, DM}; pg8::StaticOrder S; S.init(g.M, g.N, F.G, F.bid);
        pg8::EpiBf16 E{O, DM}; pg8::gemm_phase<pg8::EpiBf16, pg8::StaticOrder, true, true>(F.lds, g, S, E, F.tid); }
    if constexpr (KIND == 7) {
        EArgs A{}; A.xb_src = XB; A.xb_dst = XB; A.o = O; A.octx = (!last && F.G == 256) ? (const bf16*)(F.ws + WS_XC) - (size_t)TL * DM : (const bf16*)nullptr; A.modv_g = mv; A.gidx = 5; A.gmul = 1.0f; A.gpost = ng + 3 * DM;
        A.hdst = H; A.modv_h = mv; A.shidx = 6; A.scidx = 7; A.gpre = ng + 4 * DM; A.nrows = last ? TL : TT; e_phase(F, A); }
    if constexpr (KIND == 10) {
        EArgs A{}; A.xb_src = XB; A.xb_dst = XB; A.out32 = last ? F.out : (float*)nullptr; A.o = O; A.modv_g = mv; A.gidx = 8; A.gmul = 0.5f; A.gpost = ng + 5 * DM;
        if (!last) { A.hdst = H; A.modv_h = mv + 3 * 9216; A.shidx = 0; A.scidx = 1; A.gpre = ng + 6 * DM; }
        A.nrows = last ? TL : TT; e_phase(F, A);
        }
}
__global__ void __launch_bounds__(NTHR, 2) mega_one(Args args) {
    extern __shared__ __attribute__((aligned(16))) unsigned char lds[];
    Frame F; F.lds = (LAS unsigned char*)lds; F.tid = threadIdx.x; F.lane = F.tid & 63; F.wave = __builtin_amdgcn_readfirstlane(F.tid >> 6); F.G = gridDim.x; F.bid = blockIdx.x;
    F.out = args.out; F.ws = args.ws;
    volatile LAS unsigned* MISC = (volatile LAS unsigned*)(F.lds + MISC_OFF);
    if (F.tid < 32) MISC[F.tid] = 0u;
    __syncthreads();
    XcdBarrier bar = xcd_barrier_post((unsigned*)(F.ws + WS_CTL) + 4096, MISC + 8);
#define GRID_BAR() xcd_barrier(bar)
#define PH(K, li, sec) { run_phase<K>(F, li, sec); GRID_BAR(); }
    PH(100, 0, 0)
    PH(101, 0, 0)
#pragma unroll 1
    for (int li = 0; li < 2; ++li) {
        PH(0, li, 0)
        PH(1, li, 0)
        PH(2, li, 0)
        PH(3, li, 0)
        { run_phase<4>(F, li, 0); }
        PH(5, li, 0)
        PH(11, li, 0)
        PH(12, li, 0)
        PH(6, li, 0)
        PH(7, li, 0)
        PH(0, li, 1)
        PH(1, li, 1)
        PH(10, li, 0)
    }
}

extern "C" void kernel_launch(void* const* d_in, const int* in_sizes, int n_in, void* d_out, int out_size, void* d_ws, size_t ws_size, hipStream_t stream) {
    static int ready = 0;
    if (!ready) {
        if (n_in != 25 || out_size != TL * DM || ws_size < WS_END) { fprintf(stderr, "kernel_launch: unexpected shapes (n_in %d out %d ws %zu)\n", n_in, out_size, ws_size); ready = -1; return; }
        if (hipFuncSetAttribute((const void*)mega_one, hipFuncAttributeMaxDynamicSharedMemorySize, LDS_BYTES) != hipSuccess) { fprintf(stderr, "kernel_launch: hipFuncSetAttribute failed\n"); ready = -1; return; }
        int dev = 0, cus = 0; if (hipGetDevice(&dev) != hipSuccess || hipDeviceGetAttribute(&cus, hipDeviceAttributeMultiprocessorCount, dev) != hipSuccess || cus < 32) cus = 256;
        ready = cus < 256 ? cus : 256;
    }
    if (ready < 0) return;
    if (hipMemsetAsync((char*)d_ws + WS_CTL, 0, 65536, stream) != hipSuccess) { fprintf(stderr, "kernel_launch: memset failed\n"); return; }
    Args a{};
    for (int i = 0; i < 25; ++i) a.in[i] = (const float*)d_in[i];
    a.out = (float*)d_out; a.ws = (unsigned char*)d_ws;
    hipLaunchKernelGGL(mega_one, dim3(ready), dim3(NTHR), LDS_BYTES, stream, a);
}
```
